# Optimizing an MI355X kernel written in HIP

```python
import math
import jax, jax.numpy as jnp
from jax import lax
import numpy as np

D_MODEL = 2048
BATCH = 8
SEQ = 2048
DEPTH = 4
DEC_BATCH = 16
DEC_SEQ = 2048
PAST_LEN = 128

D_MIX = D_MODEL
POOL_DIM = D_MIX // 4
POOL_WINDOWS = (2, 4, 8, 16)
POOL_GROUP = POOL_DIM // len(POOL_WINDOWS)
MLA_HEADS = 8
QK_NOPE = 128
QK_ROPE = 64
QK_HEAD = QK_NOPE + QK_ROPE
V_HEAD = 128
MLA_DIM = MLA_HEADS * V_HEAD
Q_LORA = D_MODEL // 4
KV_LORA = D_MODEL // 8
ROPE_THETA = 10000.0
Q_BLOCK = 128
HY_DIM = D_MIX - POOL_DIM - MLA_DIM
HY_ORDER = 2
N_BANDS = 8
N_POS_FEAT = 1 + 2 * N_BANDS
FILT_HIDDEN = 64
HY_FAST_DECAY = 0.3
HY_SLOW_DECAY = 1.5
HY_DECAY_TARGET = 1e-2
D_FF = 5632
NORM_EPS = 1e-6
D_IN = POOL_DIM + Q_LORA + KV_LORA + QK_ROPE + (HY_ORDER + 1) * HY_DIM

kernel_name = 'hybrid_pool_mla_hyena_encoder'


def _rms_norm(x, g):
    xf = x.astype(jnp.float32)
    y = xf * lax.rsqrt(jnp.mean(xf * xf, axis=-1, keepdims=True) + NORM_EPS)
    return (y * g.astype(jnp.float32)).astype(x.dtype)


def _dwconv3(x, w, b):
    xp = jnp.pad(x, ((0, 0), (1, 1), (0, 0)))
    return xp[:, :-2] * w[0] + xp[:, 1:-1] * w[1] + xp[:, 2:] * w[2] + b


def _pool_mixer(u, pool_w, pool_scale):
    B, L, _ = u.shape
    uf = u.astype(jnp.float32)
    csum = jnp.concatenate([jnp.zeros((B, 1, POOL_DIM), jnp.float32), jnp.cumsum(uf, axis=1)], axis=1)
    pos = jnp.arange(L)
    outs = []
    for g, w in enumerate(POOL_WINDOWS):
        half = w // 2
        lo = jnp.maximum(pos - half, 0)
        hi = jnp.minimum(pos + half, L)
        sl = slice(g * POOL_GROUP, (g + 1) * POOL_GROUP)
        cg = csum[..., sl]
        mean = (cg[:, hi] - cg[:, lo]) / (hi - lo).astype(jnp.float32)[:, None]
        pooled = (mean - uf[..., sl]).astype(u.dtype)
        outs.append(pooled @ pool_w[g])
    return jnp.concatenate(outs, axis=-1) * pool_scale


def _rope(x, L):
    freqs = ROPE_THETA ** (-jnp.arange(0, QK_ROPE, 2, dtype=jnp.float32) / QK_ROPE)
    ang = jnp.arange(L, dtype=jnp.float32)[:, None] * freqs[None, :]
    cos = jnp.cos(ang)[None, :, None, :]
    sin = jnp.sin(ang)[None, :, None, :]
    xf = x.astype(jnp.float32)
    x1, x2 = xf[..., :QK_ROPE // 2], xf[..., QK_ROPE // 2:]
    return jnp.concatenate([x1 * cos - x2 * sin, x1 * sin + x2 * cos], axis=-1).astype(x.dtype)


def _mla(c_q, c_kv, k_pe, q_norm_g, w_uq, kv_norm_g, w_ukv, qh_g, kh_g):
    B, L, _ = c_q.shape
    q = (_rms_norm(c_q, q_norm_g) @ w_uq).reshape(B, L, MLA_HEADS, QK_HEAD)
    kv = (_rms_norm(c_kv, kv_norm_g) @ w_ukv).reshape(B, L, MLA_HEADS, QK_NOPE + V_HEAD)
    k_nope, v = kv[..., :QK_NOPE], kv[..., QK_NOPE:]
    k = jnp.concatenate([k_nope, jnp.broadcast_to(k_pe[:, :, None, :], (B, L, MLA_HEADS, QK_ROPE))], axis=-1)
    q = _rms_norm(q, qh_g)
    k = _rms_norm(k, kh_g)
    q = jnp.concatenate([q[..., :QK_NOPE], _rope(q[..., QK_NOPE:], L)], axis=-1)
    k = jnp.concatenate([k[..., :QK_NOPE], _rope(k[..., QK_NOPE:], L)], axis=-1)
    scale = QK_HEAD ** -0.5
    nblk = L // Q_BLOCK
    qb = q.reshape(B, nblk, Q_BLOCK, MLA_HEADS, QK_HEAD).transpose(1, 0, 2, 3, 4)

    def attend(q_blk):
        s = jnp.einsum('bqhd,bkhd->bhqk', q_blk, k, preferred_element_type=jnp.float32) * scale
        p = jax.nn.softmax(s, axis=-1).astype(v.dtype)
        return jnp.einsum('bhqk,bkhd->bqhd', p, v)

    o = lax.map(attend, qb)
    return o.transpose(1, 0, 2, 3, 4).reshape(B, L, MLA_DIM)


def _hyena_filter(L, w1, b1, freq, w2, b2, w3, b3):
    f32 = jnp.float32
    t = jnp.linspace(0.0, 1.0, L, dtype=f32)[:, None]
    w = 2.0 * math.pi * jnp.arange(L, dtype=f32)[:, None] / L
    bands = jnp.linspace(1e-4, N_BANDS - 1, N_BANDS, dtype=f32)[None, :]
    z = jnp.concatenate([t, jnp.cos(bands * w), -jnp.sin(bands * w)], axis=-1)
    fr = freq.astype(f32)
    h = jnp.sin(fr * (z @ w1.astype(f32) + b1.astype(f32)))
    h = jnp.sin(fr * (h @ w2.astype(f32) + b2.astype(f32)))
    h = (h @ w3.astype(f32) + b3.astype(f32)).reshape(L, 2, HY_DIM)
    max_decay = math.log(HY_DECAY_TARGET) / HY_FAST_DECAY
    min_decay = math.log(HY_DECAY_TARGET) / HY_SLOW_DECAY
    deltas = jnp.linspace(min_decay, max_decay, HY_DIM, dtype=f32)
    h = h * jnp.exp(-t * jnp.abs(deltas))[:, None, :]
    return jnp.concatenate([h[:, 0], jnp.zeros((1, HY_DIM), f32), h[:0:-1, 1]], axis=0)


def _hyena(u, conv_w, conv_b, bias, w1, b1, freq, w2, b2, w3, b3):
    B, L, _ = u.shape
    u = _dwconv3(u, conv_w, conv_b)
    x0, x1, v = u[..., :HY_DIM], u[..., HY_DIM:2 * HY_DIM], u[..., 2 * HY_DIM:]
    z = (v * x1).astype(jnp.float32)
    kern = _hyena_filter(L, w1, b1, freq, w2, b2, w3, b3)
    K = jnp.fft.rfft(kern, n=2 * L, axis=0)
    Z = jnp.fft.rfft(z, n=2 * L, axis=1)
    y = jnp.fft.irfft(Z * K[None], n=2 * L, axis=1)[:, :L] + z * bias.astype(jnp.float32)
    return (y * x0.astype(jnp.float32)).astype(u.dtype)


def _layer(x, attn_norm_g, w_in, pool_w, pool_scale, mla_q_norm_g, mla_w_uq, mla_kv_norm_g, mla_w_ukv,
           mla_q_head_norm_g, mla_k_head_norm_g, hy_conv_w, hy_conv_b, hy_filt_w1, hy_filt_b1, hy_filt_freq,
           hy_filt_w2, hy_filt_b2, hy_filt_w3, hy_filt_b3, hy_bias, grp_norm_g, w_out, ffn_norm_g, ffn_w_up,
           ffn_conv_w, ffn_conv_b, ffn_w_down):
    h = _rms_norm(x, attn_norm_g)
    proj = h @ w_in
    o0 = POOL_DIM
    o1 = o0 + Q_LORA
    o2 = o1 + KV_LORA
    o3 = o2 + QK_ROPE
    y_a = _pool_mixer(proj[..., :o0], pool_w, pool_scale)
    y_b = _mla(proj[..., o0:o1], proj[..., o1:o2], proj[..., o2:o3], mla_q_norm_g, mla_w_uq,
               mla_kv_norm_g, mla_w_ukv, mla_q_head_norm_g, mla_k_head_norm_g)
    y_c = _hyena(proj[..., o3:], hy_conv_w, hy_conv_b, hy_bias, hy_filt_w1, hy_filt_b1, hy_filt_freq,
                 hy_filt_w2, hy_filt_b2, hy_filt_w3, hy_filt_b3)
    mixed = jnp.concatenate([
        _rms_norm(y_a, grp_norm_g[:POOL_DIM]),
        _rms_norm(y_b, grp_norm_g[POOL_DIM:POOL_DIM + MLA_DIM]),
        _rms_norm(y_c, grp_norm_g[POOL_DIM + MLA_DIM:]),
    ], axis=-1)
    x = x + (mixed @ w_out).astype(x.dtype)
    h = _rms_norm(x, ffn_norm_g)
    up = h @ ffn_w_up
    gate = _dwconv3(up[..., :D_FF], ffn_conv_w, ffn_conv_b)
    act = jax.nn.silu(gate) * up[..., D_FF:]
    return x + (act @ ffn_w_down).astype(x.dtype)


def setup_inputs(seed: int = 0) -> dict:
    key = jax.random.key(seed)
    k = jax.random.split(key, 32)

    def nrm(i, shape, scale):
        return jax.random.normal(k[i], shape, jnp.float32) * scale

    def gain(i, shape):
        return 1.0 + nrm(i, shape, 0.02)

    L_ = DEPTH
    return {
        'x_prompt': nrm(0, (BATCH, SEQ, D_MODEL), 1.0),
        'x_sample': nrm(1, (DEC_BATCH, DEC_SEQ, D_MODEL), 1.0),
        'attn_norm_g': gain(2, (L_, D_MODEL)),
        'w_in': nrm(3, (L_, D_MODEL, D_IN), D_MODEL ** -0.5),
        'pool_w': nrm(4, (L_, len(POOL_WINDOWS), POOL_GROUP, POOL_GROUP), POOL_GROUP ** -0.5),
        'pool_scale': 1.0 + nrm(5, (L_, POOL_DIM), 0.1),
        'mla_q_norm_g': gain(6, (L_, Q_LORA)),
        'mla_w_uq': nrm(7, (L_, Q_LORA, MLA_HEADS * QK_HEAD), Q_LORA ** -0.5),
        'mla_kv_norm_g': gain(8, (L_, KV_LORA)),
        'mla_w_ukv': nrm(9, (L_, KV_LORA, MLA_HEADS * (QK_NOPE + V_HEAD)), KV_LORA ** -0.5),
        'mla_q_head_norm_g': gain(10, (L_, QK_HEAD)),
        'mla_k_head_norm_g': gain(11, (L_, QK_HEAD)),
        'hy_conv_w': nrm(12, (L_, 3, (HY_ORDER + 1) * HY_DIM), 3 ** -0.5),
        'hy_conv_b': nrm(13, (L_, (HY_ORDER + 1) * HY_DIM), 0.02),
        'hy_filt_w1': nrm(14, (L_, N_POS_FEAT, FILT_HIDDEN), N_POS_FEAT ** -0.5),
        'hy_filt_b1': nrm(15, (L_, FILT_HIDDEN), 0.1),
        'hy_filt_freq': 1.0 + nrm(16, (L_, FILT_HIDDEN), 0.1),
        'hy_filt_w2': nrm(17, (L_, FILT_HIDDEN, FILT_HIDDEN), FILT_HIDDEN ** -0.5),
        'hy_filt_b2': nrm(18, (L_, FILT_HIDDEN), 0.1),
        'hy_filt_w3': nrm(19, (L_, FILT_HIDDEN, 2 * HY_DIM), 0.1 * FILT_HIDDEN ** -0.5),
        'hy_filt_b3': nrm(20, (L_, 2 * HY_DIM), 0.01),
        'hy_bias': nrm(21, (L_, HY_DIM), 0.5),
        'grp_norm_g': gain(22, (L_, D_MIX)),
        'w_out': nrm(23, (L_, D_MIX, D_MODEL), D_MIX ** -0.5),
        'ffn_norm_g': gain(24, (L_, D_MODEL)),
        'ffn_w_up': nrm(25, (L_, D_MODEL, 2 * D_FF), D_MODEL ** -0.5),
        'ffn_conv_w': nrm(26, (L_, 3, D_FF), 3 ** -0.5),
        'ffn_conv_b': nrm(27, (L_, D_FF), 0.02),
        'ffn_w_down': nrm(28, (L_, D_FF, D_MODEL), D_FF ** -0.5),
    }


def reference(x_prompt, x_sample, attn_norm_g, w_in, pool_w, pool_scale, mla_q_norm_g, mla_w_uq,
              mla_kv_norm_g, mla_w_ukv, mla_q_head_norm_g, mla_k_head_norm_g, hy_conv_w, hy_conv_b,
              hy_filt_w1, hy_filt_b1, hy_filt_freq, hy_filt_w2, hy_filt_b2, hy_filt_w3, hy_filt_b3, hy_bias,
              grp_norm_g, w_out, ffn_norm_g, ffn_w_up, ffn_conv_w, ffn_conv_b, ffn_w_down):
    layer_params = (attn_norm_g, w_in, pool_w, pool_scale, mla_q_norm_g, mla_w_uq, mla_kv_norm_g, mla_w_ukv,
                    mla_q_head_norm_g, mla_k_head_norm_g, hy_conv_w, hy_conv_b, hy_filt_w1, hy_filt_b1,
                    hy_filt_freq, hy_filt_w2, hy_filt_b2, hy_filt_w3, hy_filt_b3, hy_bias, grp_norm_g, w_out,
                    ffn_norm_g, ffn_w_up, ffn_conv_w, ffn_conv_b, ffn_w_down)

    def run(x):
        for l in range(DEPTH):
            x = _layer(x, *[p[l] for p in layer_params])
        return x

    y_prompt = run(x_prompt)
    y_sample = run(x_sample)
    return (y_prompt, y_sample)
```

```cpp
#include <hip/hip_runtime.h>
#include <cstdio>
#include <cstdint>
__device__ __forceinline__ int opq(int x) { asm volatile("" : "+v"(x)); return x; }
namespace pg8 {
#define PG8_LAS __attribute__((address_space(3)))
typedef unsigned short bf16_t;
typedef short bf16x8 __attribute__((ext_vector_type(8)));
typedef float f32x4 __attribute__((ext_vector_type(4)));
typedef unsigned u32x4 __attribute__((ext_vector_type(4)));
constexpr int BM = 256, BK = 64, HALF = 128, HTB = HALF * BK * 2  , STAGE_BYTES = 8 * HTB, NXCD = 8, WGM = 8;

__host__ __device__ __forceinline__ int lds_byte(int r, int c) { const int st = (r >> 4) * 2 + (c >> 5), rr = r & 15, cc = c & 31, ob = rr * 64 + cc * 2; return st * 1024 + (ob ^ (((ob >> 9) & 1) << 5)); }
__host__ __device__ __forceinline__ void stage_rc(int b, int& R, int& C) { const int st = b / 1024, sb = b % 1024, swz = sb ^ (((sb >> 9) & 1) << 5); R = (st >> 1) * 16 + swz / 64; C = (st & 1) * 32 + (swz % 64) / 2; }
__host__ __device__ __forceinline__ int perm32(int rho) { const int n = rho >> 4, i = rho & 15; return 8 * (i >> 2) + 4 * n + (i & 3); }

struct Unit { int pm, pn; };
struct Gemm { const bf16_t* A; const bf16_t* Bt; int M, N, K, lda; };

struct StaticOrder {
    int nM, nN, nwg, G, c;
    __host__ __device__ void init(int M, int N, int G_, int c_) { nM = M / BM; nN = N / BM; nwg = nM * nN; G = G_; c = c_; }
    __host__ __device__ bool next(int i, Unit& u) const {
        const long L = (long)i * G + c; if (L >= nwg) return false;
        int wgid = (int)L; { const int q = nwg / NXCD, r = nwg % NXCD, xcd = wgid % NXCD, off = wgid / NXCD; wgid = (xcd < r ? xcd * (q + 1) : r * (q + 1) + (xcd - r) * q) + off; }
        const int nig = WGM * nN, gid = wgid / nig, fm = gid * WGM, gsz = (nM - fm) < WGM ? (nM - fm) : WGM;
        u.pm = fm + ((wgid % nig) % gsz); u.pn = (wgid % nig) / gsz; return true;
    }
    __device__ __forceinline__ void a_ready(const Unit&) const {}
    __device__ __forceinline__ void done(const Unit&) const {}
};

__device__ __forceinline__ unsigned cvt_pk_bf16(float lo, float hi) { unsigned r; asm volatile("v_cvt_pk_bf16_f32 %0, %1, %2" : "=v"(r) : "v"(lo), "v"(hi)); return r; }

struct EpiBf16 {
    static constexpr bool PERM = true;
    bf16_t* O; int ldc;
    __device__ __forceinline__ void operator()(const f32x4 (&acc)[2][2][4][2], const Unit& u, int wr, int wc, int fr, int fq) const {
        const int row0 = u.pm * BM + wr * 64 + fr; const int col0 = u.pn * BM + wc * 32 + 8 * fq;
#pragma unroll
        for (int ai = 0; ai < 2; ++ai)
#pragma unroll
            for (int m = 0; m < 4; ++m) { bf16_t* rowp = O + (size_t)(row0 + ai * HALF + m * 16) * ldc + col0;
#pragma unroll
                for (int bj = 0; bj < 2; ++bj) { const f32x4 v0 = acc[ai][bj][m][0], v1 = acc[ai][bj][m][1];
                    u32x4 w; w.x = cvt_pk_bf16(v0[0], v0[1]); w.y = cvt_pk_bf16(v0[2], v0[3]); w.z = cvt_pk_bf16(v1[0], v1[1]); w.w = cvt_pk_bf16(v1[2], v1[3]);
                    *(u32x4*)(rowp + bj * HALF) = w; } }
    }
};
struct EpiResid {
    static constexpr bool PERM = false;
    const float* baseA; const float* baseB; int split; float* out; int ldc;
    __device__ __forceinline__ void operator()(const f32x4 (&acc)[2][2][4][2], const Unit& u, int wr, int wc, int fr, int fq) const {
        const int rt = u.pm * BM; const float* bs = (rt < split) ? baseA + (size_t)rt * ldc : baseB + (size_t)(rt - split) * ldc; float* op = out + (size_t)rt * ldc;
        bs += u.pn * BM; op += u.pn * BM;
        const unsigned lo = (unsigned)((wr * 64 + fr) * ldc + wc * 32 + 4 * fq);
#pragma unroll
        for (int ai = 0; ai < 2; ++ai)
#pragma unroll
            for (int m = 0; m < 4; ++m) { const unsigned off = lo + (unsigned)((ai * HALF + m * 16) * ldc);
#pragma unroll
                for (int bj = 0; bj < 2; ++bj)
#pragma unroll
                    for (int n = 0; n < 2; ++n) { const f32x4 b = *(const f32x4*)(bs + off + bj * HALF + n * 16); *(f32x4*)(op + off + bj * HALF + n * 16) = b + acc[ai][bj][m][n]; }
                asm volatile("" ::: "memory"); }
    }
};
__device__ __forceinline__ float silu_f(float x) { return x * __builtin_amdgcn_rcpf(1.0f + __builtin_amdgcn_exp2f(-1.4426950408889634f * x)); }
struct EpiGate {
    static constexpr bool PERM = true;
    bf16_t* act; int ldact; float* edge; const float* cw; const float* cb; int dff; PG8_LAS float* halo;
    __device__ __forceinline__ void operator()(const f32x4 (&acc)[2][2][4][2], const Unit& u, int wr, int wc, int fr, int fq) const {
        const int lane = fq * 16 + fr; const int colL = wc * 32 + 8 * fq; const int colG = u.pn * HALF + colL;
#pragma unroll
        for (int ai = 0; ai < 2; ++ai) { const int q = 2 * ai + wr;
            if (fr == 0) { *(PG8_LAS f32x4*)(halo + (q * 2 + 0) * 128 + colL) = acc[ai][0][0][0]; *(PG8_LAS f32x4*)(halo + (q * 2 + 0) * 128 + colL + 4) = acc[ai][0][0][1]; }
            if (fr == 15) { *(PG8_LAS f32x4*)(halo + (q * 2 + 1) * 128 + colL) = acc[ai][0][3][0]; *(PG8_LAS f32x4*)(halo + (q * 2 + 1) * 128 + colL + 4) = acc[ai][0][3][1]; } }
        asm volatile("s_waitcnt lgkmcnt(0)" ::: "memory"); __builtin_amdgcn_s_barrier(); asm volatile("" ::: "memory");
        const int srcR = (lane & 48) | ((fr - 1) & 15), srcL = (lane & 48) | ((fr + 1) & 15);
        bf16_t* actp = act + (size_t)(u.pm * BM) * ldact + colG; const unsigned rlo = (unsigned)((wr * 64 + fr) * ldact);
#pragma unroll
        for (int ai = 0; ai < 2; ++ai) { const int q = 2 * ai + wr;
#pragma unroll
            for (int n = 0; n < 2; ++n) {
                const f32x4 w0 = *(const f32x4*)(cw + colG + 4 * n), w1 = *(const f32x4*)(cw + dff + colG + 4 * n), w2 = *(const f32x4*)(cw + 2 * dff + colG + 4 * n), bb = *(const f32x4*)(cb + colG + 4 * n);
                f32x4 ht = {0.f, 0.f, 0.f, 0.f}, hb = {0.f, 0.f, 0.f, 0.f};
                if (q > 0) ht = *(PG8_LAS f32x4*)(halo + ((q - 1) * 2 + 1) * 128 + colL + 4 * n);
                if (q < 3) hb = *(PG8_LAS f32x4*)(halo + ((q + 1) * 2 + 0) * 128 + colL + 4 * n);
                f32x4 pre[4];
#pragma unroll
                for (int j = 0; j < 4; ++j) {
                    float g[4], rr[4], rl[4];
#pragma unroll
                    for (int m = 0; m < 4; ++m) { g[m] = acc[ai][0][m][n][j]; rr[m] = __shfl(g[m], srcR); rl[m] = __shfl(g[m], srcL); }
#pragma unroll
                    for (int m = 0; m < 4; ++m) {
                        const float up = (fr > 0) ? rr[m] : (m > 0 ? rr[m > 0 ? m - 1 : 0] : ht[j]);
                        const float dn = (fr < 15) ? rl[m] : (m < 3 ? rl[m < 3 ? m + 1 : 3] : hb[j]);
                        pre[m][j] = w0[j] * up + w1[j] * g[m] + w2[j] * dn + bb[j];
                    }
                }
                if (q == 0 && fr == 0) { float* e = edge + (size_t)((u.pm * 2 + 0) * 3) * dff + colG + 4 * n;
                    *(f32x4*)(e) = acc[ai][0][0][n]; *(f32x4*)(e + dff) = pre[0]; *(f32x4*)(e + 2 * dff) = acc[ai][1][0][n]; }
                if (q == 3 && fr == 15) { float* e = edge + (size_t)((u.pm * 2 + 1) * 3) * dff + colG + 4 * n;
                    *(f32x4*)(e) = acc[ai][0][3][n]; *(f32x4*)(e + dff) = pre[3]; *(f32x4*)(e + 2 * dff) = acc[ai][1][3][n]; }
#pragma unroll
                for (int m = 0; m < 4; ++m) {
                    const f32x4 v = acc[ai][1][m][n];
                    typedef unsigned u32x2 __attribute__((ext_vector_type(2)));
                    u32x2 w; w.x = cvt_pk_bf16(silu_f(pre[m][0]) * v[0], silu_f(pre[m][1]) * v[1]); w.y = cvt_pk_bf16(silu_f(pre[m][2]) * v[2], silu_f(pre[m][3]) * v[3]);
                    *(u32x2*)(actp + rlo + (unsigned)((ai * HALF + m * 16) * ldact) + 4 * n) = w;
                }
            }
        }
    }
};

template <class Epi, class Sched>
__device__ __forceinline__ void gemm_phase(PG8_LAS unsigned char* lds, const Gemm g, const Sched& S, const Epi& E) {
    const int tid = opq(threadIdx.x), wid = __builtin_amdgcn_readfirstlane(tid >> 6), lane = tid & 63, wr = wid >> 2, wc = wid & 3, fr = lane & 15, fq = lane >> 4;
    const int K = g.K, nt = K / BK, lda = g.lda;
    unsigned voffA[2], voffB[2];
#pragma unroll
    for (int i = 0; i < 2; ++i) { int R, C; stage_rc(tid * 16 + i * 8192, R, C); const int Rb = Epi::PERM ? ((R & ~31) + perm32(R & 31)) : R;
        voffA[i] = (unsigned)(R * lda + C) * 2u; voffB[i] = (unsigned)(Rb * K + C) * 2u; }
    const size_t kstep = (size_t)(BK * 2);
    const size_t hstepA = (size_t)HALF * lda * 2, hstepB = (size_t)HALF * K * 2;
    const size_t tstepA = 2 * hstepA, tstepB = 2 * hstepB;
    const unsigned ldsw = (unsigned)wid * 1024u;
    const int aoff = lds_byte(wr * 64 + fr, fq * 8), boff = lds_byte(wc * 32 + fr, fq * 8);
#define PG8_SA(b, h) (((b) * 2 + (h)) * HTB)
#define PG8_SB(b, h) ((4 + (b) * 2 + (h)) * HTB)
#define PG8_STAGE(bufoff, gbase, voff) do { _Pragma("unroll") for (int _i = 0; _i < 2; ++_i) \
        __builtin_amdgcn_global_load_lds((const unsigned*)((const char*)(gbase) + (voff)[_i]), (PG8_LAS unsigned*)(lds + (bufoff) + ldsw + _i * 8192), 16, 0, 0); } while (0)
#define PG8_LDA(dst, b, h) do { _Pragma("unroll") for (int m = 0; m < 4; ++m) _Pragma("unroll") for (int k = 0; k < 2; ++k) dst[m][k] = *(const PG8_LAS bf16x8*)(lds + PG8_SA(b, h) + aoff + m * 2048 + k * 1024); } while (0)
#define PG8_LDB(dst, b, h) do { _Pragma("unroll") for (int n = 0; n < 2; ++n) _Pragma("unroll") for (int k = 0; k < 2; ++k) dst[n][k] = *(const PG8_LAS bf16x8*)(lds + PG8_SB(b, h) + boff + n * 2048 + k * 1024); } while (0)
#define PG8_MMA(ai, bj, At, Bt) do { __builtin_amdgcn_s_setprio(1); _Pragma("unroll") for (int m = 0; m < 4; ++m) _Pragma("unroll") for (int n = 0; n < 2; ++n) _Pragma("unroll") for (int k = 0; k < 2; ++k) \
        acc[ai][bj][m][n] = __builtin_amdgcn_mfma_f32_16x16x32_bf16(Bt[n][k], At[m][k], acc[ai][bj][m][n], 0, 0, 0); __builtin_amdgcn_s_setprio(0); } while (0)
#define PG8_WAIT_V(n) asm volatile("s_waitcnt vmcnt(" #n ")" ::: "memory")
#define PG8_WAIT_L(n) asm volatile("s_waitcnt lgkmcnt(" #n ")" ::: "memory")
#define PG8_BAR __builtin_amdgcn_s_barrier()
#define PG8_SCHED __builtin_amdgcn_sched_barrier(0)
    Unit cur, nxt; int ui = 0;
    if (!S.next(0, cur)) return;
    f32x4 acc[2][2][4][2];
#pragma unroll
    for (int a = 0; a < 2; ++a)
#pragma unroll
        for (int b = 0; b < 2; ++b)
#pragma unroll
            for (int m = 0; m < 4; ++m)
#pragma unroll
                for (int n = 0; n < 2; ++n) acc[a][b][m][n] = (f32x4){0.f, 0.f, 0.f, 0.f};
    bf16x8 At[4][2], B0[2][2], B1[2][2];
    const char* cA = (const char*)g.A + (size_t)cur.pm * tstepA; const char* cB = (const char*)g.Bt + (size_t)cur.pn * tstepB;
    S.a_ready(cur);
    PG8_STAGE(PG8_SB(0, 0), cB, voffB); PG8_STAGE(PG8_SB(0, 1), cB + hstepB, voffB); PG8_STAGE(PG8_SA(0, 0), cA, voffA); PG8_STAGE(PG8_SA(0, 1), cA + hstepA, voffA);
    if (wr == 1) PG8_BAR;
    PG8_WAIT_V(2); PG8_BAR;
    PG8_STAGE(PG8_SB(1, 0), cB + kstep, voffB); PG8_STAGE(PG8_SA(1, 0), cA + kstep, voffA); PG8_STAGE(PG8_SB(1, 1), cB + hstepB + kstep, voffB);
    PG8_WAIT_V(6); PG8_BAR;
    for (;;) {
        const bool has_next = S.next(ui + 1, nxt);
        const char* nA = has_next ? (const char*)g.A + (size_t)nxt.pm * tstepA : cA; const char* nB = has_next ? (const char*)g.Bt + (size_t)nxt.pn * tstepB : cB;
#pragma unroll 1
        for (int t = 0; t < nt; t += 2) {
            const bool last = (t == nt - 2);
            const char* a1 = cA + (size_t)(t + 1) * kstep;
            const char* a2 = last ? nA : cA + (size_t)(t + 2) * kstep; const char* b2 = last ? nB : cB + (size_t)(t + 2) * kstep;
            const char* a3 = a2 + kstep; const char* b3 = b2 + kstep;
            if (last && has_next) S.a_ready(nxt);
            PG8_LDB(B0, 0, 0); PG8_LDB(B1, 0, 1); PG8_SCHED; PG8_LDA(At, 0, 0); PG8_STAGE(PG8_SA(1, 1), a1 + hstepA, voffA);
            PG8_WAIT_V(8); PG8_WAIT_L(0); PG8_BAR; PG8_MMA(0, 0, At, B0); PG8_MMA(0, 1, At, B1); PG8_BAR; PG8_SCHED;
            PG8_LDA(At, 0, 1); PG8_STAGE(PG8_SB(0, 0), b2, voffB); PG8_STAGE(PG8_SB(0, 1), b2 + hstepB, voffB); PG8_STAGE(PG8_SA(0, 0), a2, voffA);
            PG8_WAIT_V(8); PG8_WAIT_L(0); PG8_BAR; PG8_MMA(1, 0, At, B0); PG8_MMA(1, 1, At, B1); PG8_BAR; PG8_SCHED;
            PG8_LDB(B0, 1, 0); PG8_LDB(B1, 1, 1); PG8_SCHED; PG8_LDA(At, 1, 0); PG8_STAGE(PG8_SA(0, 1), a2 + hstepA, voffA);
            PG8_WAIT_V(8); PG8_WAIT_L(0); PG8_BAR; PG8_MMA(0, 0, At, B0); PG8_MMA(0, 1, At, B1); PG8_BAR; PG8_SCHED;
            PG8_LDA(At, 1, 1); PG8_STAGE(PG8_SB(1, 0), b3, voffB); PG8_STAGE(PG8_SB(1, 1), b3 + hstepB, voffB); PG8_STAGE(PG8_SA(1, 0), a3, voffA);
            PG8_WAIT_V(8); PG8_WAIT_L(0); PG8_BAR; PG8_MMA(1, 0, At, B0); PG8_MMA(1, 1, At, B1); PG8_BAR; PG8_SCHED;
        }
        if (wr == 0) PG8_BAR;
        E(acc, cur, wr, wc, fr, fq); S.done(cur);
        if (!has_next) break;
#pragma unroll
        for (int a = 0; a < 2; ++a)
#pragma unroll
            for (int b = 0; b < 2; ++b)
#pragma unroll
                for (int m = 0; m < 4; ++m)
#pragma unroll
                    for (int n = 0; n < 2; ++n) acc[a][b][m][n] = (f32x4){0.f, 0.f, 0.f, 0.f};
        cur = nxt; cA = nA; cB = nB; ++ui;
        if (wr == 1) PG8_BAR;
    }
    PG8_WAIT_V(0);
    PG8_BAR;
#undef PG8_SA
#undef PG8_SB
#undef PG8_STAGE
#undef PG8_LDA
#undef PG8_LDB
#undef PG8_MMA
#undef PG8_WAIT_V
#undef PG8_WAIT_L
#undef PG8_BAR
#undef PG8_SCHED
}
}
namespace at {
using bf16 = unsigned short;
using bf16x8 = __attribute__((ext_vector_type(8))) short;
using s16x4  = __attribute__((ext_vector_type(4))) short;
using f32x16 = __attribute__((ext_vector_type(16))) float;
using u32x4  = __attribute__((ext_vector_type(4))) unsigned;
constexpr int DQK = 192, DV = 128, KVBLK = 64, NW = 8, QBLK = 32;
constexpr float SCALE = 0.07216878364870322f;
constexpr float THR = 8.f;
constexpr int LDQ = 1536, LDK = 2560, LDO = 2048;
constexpr int SHM_V = KVBLK * DV * 2, SHM_K = 12 * 2080;
constexpr int SHM_ATTN = 2 * SHM_V + 2 * SHM_K + NW * 64 * 4;
#define SBAR() __builtin_amdgcn_sched_barrier(0)
constexpr int KPL = 2080;
__host__ __device__ __forceinline__ int k_st(int row, int c) { return (c >> 1) * KPL + row * 32 + (((c & 1) ^ ((row >> 3) & 1)) << 4); }
__host__ __device__ __forceinline__ int k_rd_base(int r32, int hi) { return r32 * 32 + ((hi ^ ((r32 >> 3) & 1)) << 4); }
__device__ __forceinline__ int crow(int r, int hi) { return (r & 3) + 8 * (r >> 2) + 4 * hi; }
__device__ __forceinline__ unsigned cvtpk(float lo, float hi) { unsigned r; asm volatile("v_cvt_pk_bf16_f32 %0, %1, %2" : "=v"(r) : "v"(lo), "v"(hi)); return r; }

__device__ __forceinline__ void partialSM(f32x16& p0, f32x16& p1, float& m_reg, float& mn, float& alpha) {
  constexpr float C = SCALE * 1.4426950408889634f;
  float pmax = p0[0];
#pragma unroll
  for (int r = 1; r < 16; ++r) pmax = fmaxf(pmax, p0[r]);
#pragma unroll
  for (int r = 0; r < 16; ++r) pmax = fmaxf(pmax, p1[r]);
  { auto rr = __builtin_amdgcn_permlane32_swap(__float_as_uint(pmax), __float_as_uint(pmax), false, false);
    pmax = fmaxf(__uint_as_float(rr[0]), __uint_as_float(rr[1])); }
  if (__builtin_expect(__all(pmax - m_reg <= THR / SCALE), 1)) { mn = m_reg; alpha = 1.f; }
  else { mn = fmaxf(m_reg, pmax); alpha = __builtin_amdgcn_exp2f((m_reg - mn) * C); m_reg = mn; }
  float mnC = -mn * C;
#pragma unroll
  for (int r = 0; r < 16; ++r) p0[r] = fmaf(p0[r], C, mnC);
#pragma unroll
  for (int r = 0; r < 16; ++r) p1[r] = fmaf(p1[r], C, mnC);
#pragma unroll
  for (int r = 0; r < 16; ++r) p0[r] = __builtin_amdgcn_exp2f(p0[r]);
}
__device__ __forceinline__ void finishSM(f32x16& p0, f32x16& p1, float alpha, float& l_reg, bf16x8& pa0, bf16x8& pa1, bf16x8& pa2, bf16x8& pa3) {
#pragma unroll
  for (int r = 0; r < 16; ++r) p1[r] = __builtin_amdgcn_exp2f(p1[r]);
  float ps = 0;
#pragma unroll
  for (int r = 0; r < 16; ++r) ps += p0[r];
#pragma unroll
  for (int r = 0; r < 16; ++r) ps += p1[r];
  { auto rr = __builtin_amdgcn_permlane32_swap(__float_as_uint(ps), __float_as_uint(ps), false, false);
    ps = __uint_as_float(rr[0]) + __uint_as_float(rr[1]); }
  l_reg = l_reg * alpha + ps;
#define PK4(P, BASE, OUT) do { unsigned a0 = cvtpk(P[BASE + 0], P[BASE + 1]), a1 = cvtpk(P[BASE + 2], P[BASE + 3]);   \
    unsigned b0 = cvtpk(P[BASE + 4], P[BASE + 5]), b1 = cvtpk(P[BASE + 6], P[BASE + 7]);                              \
    auto r0 = __builtin_amdgcn_permlane32_swap(a0, b0, false, false); auto r1 = __builtin_amdgcn_permlane32_swap(a1, b1, false, false); \
    u32x4 w = {r0[0], r1[0], r0[1], r1[1]}; OUT = *reinterpret_cast<bf16x8*>(&w); } while (0)
  PK4(p0, 0, pa0); PK4(p0, 8, pa1); PK4(p1, 0, pa2); PK4(p1, 8, pa3);
#undef PK4
}
template <int OFF> __device__ __forceinline__ bf16x8 k_read(int kb) {
  bf16x8 r; asm volatile("ds_read_b128 %0, %1 offset:%2" : "=v"(r) : "v"(kb), "i"(OFF) : "memory"); return r;
}
__device__ __forceinline__ void qkt(f32x16& p0, f32x16& p1, int kb, const bf16x8* qr) {
  p0 = f32x16{}; p1 = f32x16{};
#define QK1(d0) { const bf16x8 b0 = *(const __attribute__((address_space(3))) bf16x8*)(kb + d0 * KPL), b1 = *(const __attribute__((address_space(3))) bf16x8*)(kb + d0 * KPL + 1024); \
    p0 = __builtin_amdgcn_mfma_f32_32x32x16_bf16(b0, qr[d0], p0, 0, 0, 0); p1 = __builtin_amdgcn_mfma_f32_32x32x16_bf16(b1, qr[d0], p1, 0, 0, 0); }
  QK1(0) QK1(1) QK1(2) QK1(3) QK1(4) QK1(5) QK1(6) QK1(7) QK1(8) QK1(9) QK1(10) QK1(11)
#undef QK1
}
__host__ __device__ __forceinline__ int v_st(int k, int c) { const int kk = (k & ~0xC) | ((k & 4) << 1) | ((k & 8) >> 1); return ((kk >> 3) * 4 + (c >> 5)) * 512 + ((kk & 7) * 32 + (c & 31)) * 2; }
__device__ __forceinline__ int v_rd_base(int lane) { return ((lane & 3) << 3) | (((lane >> 2) & 3) << 6) | (((lane >> 4) & 1) << 5) | (((lane >> 5) & 1) << 8); }
constexpr int v_rd_off(int d0, int ks, int half) { return d0 * 512 + ks * 4096 + half * 2048; }
template <int OFF> __device__ __forceinline__ s16x4 tr_read(int vb) {
  s16x4 r; asm volatile("ds_read_b64_tr_b16 %0, %1 offset:%2" : "=&v"(r) : "v"(vb), "i"(OFF) : "memory"); return r;
}
template <int D0> __device__ __forceinline__ void pv_one(f32x16& od, int vb, bf16x8 pa0, bf16x8 pa1, bf16x8 pa2, bf16x8 pa3) {
  const s16x4 l0 = tr_read<v_rd_off(D0, 0, 0)>(vb), h0 = tr_read<v_rd_off(D0, 0, 1)>(vb), l1 = tr_read<v_rd_off(D0, 1, 0)>(vb), h1 = tr_read<v_rd_off(D0, 1, 1)>(vb);
  const s16x4 l2 = tr_read<v_rd_off(D0, 2, 0)>(vb), h2 = tr_read<v_rd_off(D0, 2, 1)>(vb), l3 = tr_read<v_rd_off(D0, 3, 0)>(vb), h3 = tr_read<v_rd_off(D0, 3, 1)>(vb);
  asm volatile("s_waitcnt lgkmcnt(0)" ::: "memory"); SBAR();
#define PK(L, H) (bf16x8){L[0], L[1], L[2], L[3], H[0], H[1], H[2], H[3]}
  od = __builtin_amdgcn_mfma_f32_32x32x16_bf16(pa0, PK(l0, h0), od, 0, 0, 0);
  od = __builtin_amdgcn_mfma_f32_32x32x16_bf16(pa1, PK(l1, h1), od, 0, 0, 0);
  od = __builtin_amdgcn_mfma_f32_32x32x16_bf16(pa2, PK(l2, h2), od, 0, 0, 0);
  od = __builtin_amdgcn_mfma_f32_32x32x16_bf16(pa3, PK(l3, h3), od, 0, 0, 0);
#undef PK
}
__device__ __forceinline__ void pv_d0(f32x16* o, int vb, bf16x8 pa0, bf16x8 pa1, bf16x8 pa2, bf16x8 pa3) {
  pv_one<0>(o[0], vb, pa0, pa1, pa2, pa3); pv_one<1>(o[1], vb, pa0, pa1, pa2, pa3); pv_one<2>(o[2], vb, pa0, pa1, pa2, pa3); pv_one<3>(o[3], vb, pa0, pa1, pa2, pa3);
}

__device__ __forceinline__ void attn_unit(const bf16* __restrict__ Qb, const bf16* __restrict__ Kh, const bf16* __restrict__ Vh, bf16* __restrict__ Ob, int seq, char* lds) {
  const int tid = opq(threadIdx.x), wid = tid >> 6, lane = tid & 63, r32 = lane & 31, hi = lane >> 5;
  char* V_lds = lds; char* K_lds = lds + 2 * SHM_V;
  float* ws = (float*)(lds + 2 * SHM_V + 2 * SHM_K) + wid * 64; float* li_l = ws; float* al_l = ws + 32;
  float m_reg = -1e30f, l_reg = 0; f32x16 o[4] = {}; bf16x8 qr[12];
  const bf16* Qw = Qb + (unsigned)((wid * QBLK + r32) * LDQ + hi * 8);
#pragma unroll
  for (int d0 = 0; d0 < 12; ++d0) qr[d0] = *reinterpret_cast<const bf16x8*>(Qw + d0 * 16);
  const int sr = tid >> 4, sc = (tid & 15) * 8, vst0 = v_st(sr, sc), vst1 = v_st(32 + sr, sc);
  unsigned koff[3]; int kst[3];
#pragma unroll
  for (int i = 0; i < 3; ++i) { const int q = tid + 512 * i; koff[i] = (unsigned)((q / 24) * LDK + (q % 24) * 8); kst[i] = k_st(q / 24, q % 24); }
  const unsigned voff0 = (unsigned)(sr * LDK + sc), voff1 = (unsigned)((32 + sr) * LDK + sc);
  const int vb0 = (int)(uintptr_t)V_lds + v_rd_base(lane); const int kb0 = (int)(uintptr_t)K_lds + k_rd_base(r32, hi);
  struct { bf16x8 vs0, vs1, ks0, ks1, ks2; } sr_[1];
#define SLOAD(i, k0) do { const bf16* vt = Vh + (size_t)(k0) * LDK; const bf16* kt = Kh + (size_t)(k0) * LDK; \
    sr_[i].vs0 = *(const bf16x8*)(vt + voff0); sr_[i].vs1 = *(const bf16x8*)(vt + voff1); \
    sr_[i].ks0 = *(const bf16x8*)(kt + koff[0]); sr_[i].ks1 = *(const bf16x8*)(kt + koff[1]); sr_[i].ks2 = *(const bf16x8*)(kt + koff[2]); } while (0)
#define SWRITE(b, i) do { *(bf16x8*)(V_lds + (b) * SHM_V + vst0) = sr_[i].vs0; *(bf16x8*)(V_lds + (b) * SHM_V + vst1) = sr_[i].vs1; \
    *(bf16x8*)(K_lds + (b) * SHM_K + kst[0]) = sr_[i].ks0; *(bf16x8*)(K_lds + (b) * SHM_K + kst[1]) = sr_[i].ks1; *(bf16x8*)(K_lds + (b) * SHM_K + kst[2]) = sr_[i].ks2; } while (0)
#define SWAIT() do { if constexpr (SDEPTH == 2) asm volatile("s_waitcnt vmcnt(5)" ::: "memory"); else asm volatile("s_waitcnt vmcnt(0)" ::: "memory"); } while (0)
#define RESC(a) do { if (__any((a) < 1.f)) { if (hi == 0) al_l[r32] = (a); asm volatile("s_waitcnt lgkmcnt(0)" ::: "memory"); \
    _Pragma("unroll") for (int d = 0; d < 4; ++d) _Pragma("unroll") for (int r = 0; r < 16; ++r) o[d][r] *= al_l[crow(r, hi)]; } } while (0)
  f32x16 p0, p1; float mn, al; bf16x8 pa0, pa1, pa2, pa3; const int NT = seq / KVBLK;
  SLOAD(0, 0); asm volatile("s_waitcnt vmcnt(0)" ::: "memory"); SWRITE(0, 0); __syncthreads();
  for (int j = 0; j < NT; ++j) {
    const int bsel = j & 1;
    if (j + 1 < NT) SLOAD(0, (j + 1) * KVBLK);
    SBAR(); qkt(p0, p1, kb0 + bsel * SHM_K, qr);
    partialSM(p0, p1, m_reg, mn, al);
    RESC(al);
    finishSM(p0, p1, al, l_reg, pa0, pa1, pa2, pa3); SBAR();
    pv_d0(o, vb0 + bsel * (int)SHM_V, pa0, pa1, pa2, pa3);
    if (j + 1 < NT) { asm volatile("s_waitcnt vmcnt(0)" ::: "memory"); SWRITE(bsel ^ 1, 0); }
    __syncthreads();
  }
  if (hi == 0) li_l[r32] = l_reg; asm volatile("s_waitcnt lgkmcnt(0)" ::: "memory");
  bf16* Ow = Ob + (unsigned)(wid * QBLK * LDO + r32);
#pragma unroll
  for (int r = 0; r < 16; ++r) { const int orow = crow(r, hi); const float rl = __builtin_amdgcn_rcpf(li_l[orow]);
#pragma unroll
    for (int d0 = 0; d0 < 4; ++d0) { const unsigned w = cvtpk(o[d0][r] * rl, 0.f); Ow[(unsigned)(orow * LDO + d0 * 32)] = (bf16)(w & 0xffffu); } }
  __syncthreads();
#undef SLOAD
#undef SWRITE
#undef SWAIT
#undef RESC
}
}
namespace hy {
#define HY_LAS __attribute__((address_space(3)))
typedef unsigned short bf16;
typedef short bf16x8 __attribute__((ext_vector_type(8)));
typedef float f32x16 __attribute__((ext_vector_type(16)));
typedef unsigned u32x2 __attribute__((ext_vector_type(2)));
typedef unsigned u32x4 __attribute__((ext_vector_type(4)));
constexpr int L = 2048, NB = 24, CH = 512;
constexpr int RFS = 4112;
constexpr int ZROW = 4112;
constexpr int ZL_BYTES = NB * ZROW;
constexpr int RCS = 8256;
constexpr int RC_OFF = ZL_BYTES;
constexpr int HY_LDS_BYTES = RC_OFF + 4 * RCS;
__device__ __forceinline__ unsigned cvtpk(float lo, float hi) { unsigned r; asm volatile("v_cvt_pk_bf16_f32 %0, %1, %2" : "=v"(r) : "v"(lo), "v"(hi)); return r; }
__host__ __device__ __forceinline__ int frag_base(int tw, int r, int h) { const int a = (4 - (r & 3)) & 3; return RC_OFF + a * RCS + 2 * (2048 - tw - r + 8 * h - a); }
__host__ __device__ __forceinline__ int zfrag_base(int r, int h) { return (r < NB ? r : NB - 1) * ZROW + 16 * h; }

__device__ __forceinline__ bf16x8 ld_frag(HY_LAS unsigned char* lds, int off) {
    const u32x2 lo = *(const HY_LAS u32x2*)(lds + off), hi = *(const HY_LAS u32x2*)(lds + off + 8);
    u32x4 w = {lo.x, lo.y, hi.x, hi.y}; return *reinterpret_cast<bf16x8*>(&w);
}
__device__ __forceinline__ bf16x8 ld_b128(HY_LAS unsigned char* lds, int off) { return *(const HY_LAS bf16x8*)(lds + off); }

__device__ __forceinline__ void conv_unit(HY_LAS unsigned char* lds, const bf16* __restrict__ ZT, const bf16* __restrict__ RF, bf16* __restrict__ YC, int c, int half) {
    const int tid = opq(threadIdx.x), wid = tid >> 6, lane = tid & 63, r = lane & 31, h = lane >> 5;
    { const u32x4* src = (const u32x4*)(ZT + (size_t)c * NB * L);
#pragma unroll
      for (int i = 0; i < 12; ++i) { const int q = tid + 512 * i; const u32x4 v = src[q]; *(HY_LAS u32x4*)(lds + (q >> 8) * ZROW + (q & 255) * 16) = v; } }
    { const bf16* rf = RF + (size_t)c * RFS;
      for (int ch = tid; ch < RFS / 8; ch += 512) {
          const u32x4 v = *(const u32x4*)(rf + ch * 8); const unsigned w[4] = {v.x, v.y, v.z, v.w};
#pragma unroll
          for (int j = 0; j < 8; ++j) { const unsigned short e = (unsigned short)((w[j >> 1] >> ((j & 1) * 16)) & 0xffffu); const int idx = ch * 8 + j;
#pragma unroll
              for (int a = 0; a < 4; ++a) if (idx - a >= 0) *(HY_LAS unsigned short*)(lds + RC_OFF + a * RCS + 2 * (idx - a)) = e; } } }
    __syncthreads();
    const int tw = half * 1024 + wid * 128;
    const int fb = frag_base(tw, r, h), zb = zfrag_base(r, h);
    f32x16 acc[4] = {};
    bf16x8 S0[2], S1[2], S2[2], S3[2], Bc[2], Bn[2];
#define HY_LDG(S, d) do { S[0] = ld_frag(lds, fb + 64 * (d)); S[1] = ld_frag(lds, fb + 64 * (d) + 32); } while (0)
#define HY_LDB(Bx, n) do { Bx[0] = ld_b128(lds, zb + 64 * (n)); Bx[1] = ld_b128(lds, zb + 64 * (n) + 32); } while (0)
#define HY_MM(i, S, Bx) do { acc[i] = __builtin_amdgcn_mfma_f32_32x32x16_bf16(S[0], Bx[0], acc[i], 0, 0, 0); acc[i] = __builtin_amdgcn_mfma_f32_32x32x16_bf16(S[1], Bx[1], acc[i], 0, 0, 0); } while (0)
#define HY_ITER(n, Sa, Sb, Sc, Sd, Bcur, Bnext) do { HY_LDG(Sa, (n)); if ((n) + 1 < 64) HY_LDB(Bnext, (n) + 1); \
        HY_MM(1, Sb, Bcur); HY_MM(2, Sc, Bcur); HY_MM(3, Sd, Bcur); HY_MM(0, Sa, Bcur); } while (0)
    HY_LDG(S3, -1); HY_LDG(S2, -2); HY_LDG(S1, -3); HY_LDB(Bc, 0);
    for (int n = 0; n < 64; n += 4) {
        HY_ITER(n, S0, S3, S2, S1, Bc, Bn);
        HY_ITER(n + 1, S1, S0, S3, S2, Bn, Bc);
        HY_ITER(n + 2, S2, S1, S0, S3, Bc, Bn);
        HY_ITER(n + 3, S3, S2, S1, S0, Bn, Bc);
    }
#undef HY_LDG
#undef HY_LDB
#undef HY_MM
#undef HY_ITER
    if (r < NB) { bf16* yp = YC + ((size_t)c * NB + r) * L + tw + 4 * h;
#pragma unroll
        for (int i = 0; i < 4; ++i)
#pragma unroll
            for (int q4 = 0; q4 < 4; ++q4) { u32x2 w; w.x = cvtpk(acc[i][4 * q4 + 0], acc[i][4 * q4 + 1]); w.y = cvtpk(acc[i][4 * q4 + 2], acc[i][4 * q4 + 3]);
                *(u32x2*)(yp + 32 * i + 8 * q4) = w; } }
    __syncthreads();
}
}
constexpr int NWAVES = 8;
#ifndef MK_ONE_LAUNCH
#define MK_ONE_LAUNCH 1
#endif
constexpr int DM = 2048, NSEQ = 24, SEQ = 2048, M = NSEQ * SEQ, MP = 8 * SEQ;
constexpr int DEPTH = 4;
constexpr int DIN = 2880, DINP = 3072;
constexpr int O_CQ = 512, O_CKV = 1024, O_KPE = 1280, O_HY = 1344;
constexpr int NH = 8, NQ = 1536, NKVP = 2560, KVHS = 320;
constexpr int DFF = 5632, NUP = 11264, HYC = 512;
constexpr float EPS = 1e-6f;
constexpr int NPH = 11;
constexpr size_t WS_CTL = 0, CTL_BYTES = 1u << 20;
constexpr size_t SZ_BTIN = (size_t)DINP * DM * 2, SZ_BTUQ = (size_t)NQ * 512 * 2, SZ_BTKV = (size_t)NKVP * 256 * 2, SZ_BTOUT = (size_t)DM * DM * 2, SZ_BTUP = (size_t)NUP * DM * 2, SZ_BTDN = (size_t)DM * DFF * 2;
constexpr size_t WS_BTIN = WS_CTL + CTL_BYTES, WS_BTUQ = WS_BTIN + SZ_BTIN, WS_BTKV = WS_BTUQ + SZ_BTUQ, WS_BTOUT = WS_BTKV + SZ_BTKV, WS_BTUP = WS_BTOUT + SZ_BTOUT, WS_BTDN = WS_BTUP + SZ_BTUP;
constexpr size_t WS_RF = WS_BTDN + SZ_BTDN, SZ_RF = (size_t)HYC * hy::RFS * 2;
constexpr size_t WS_H = WS_RF + SZ_RF, SZ_H = (size_t)M * DM * 2;
constexpr size_t WS_PROJ = WS_H + SZ_H, SZ_PROJ = (size_t)M * DINP * 2;
constexpr size_t WS_Q = WS_PROJ + SZ_PROJ, SZ_Q = (size_t)M * NQ * 2;
constexpr size_t WS_KV = WS_Q + SZ_Q, SZ_KV = (size_t)M * NKVP * 2;
constexpr size_t WS_ZT = WS_KV + SZ_KV, SZ_ZT = (size_t)HYC * NSEQ * SEQ * 2;
constexpr size_t WS_X0 = WS_ZT + SZ_ZT, WS_YC = WS_X0 + SZ_ZT;
constexpr size_t WS_EDGE = WS_YC + SZ_ZT, SZ_EDGE = (size_t)(M / 256) * 2 * 3 * DFF * 4;
constexpr size_t WS_END = WS_EDGE + SZ_EDGE;
constexpr size_t WS_ACT = WS_PROJ;
static_assert((size_t)M * DFF * 2 <= SZ_PROJ + SZ_Q + SZ_KV, "ACT overlay");
static_assert(WS_BTIN % 256 == 0 && WS_RF % 256 == 0 && WS_H % 256 == 0 && WS_PROJ % 256 == 0 && WS_Q % 256 == 0 && WS_KV % 256 == 0 && WS_ZT % 256 == 0 && WS_EDGE % 256 == 0, "alignment");
constexpr int CW_BAR = 4096;
constexpr int RING_BYTES = 135168;
constexpr int HALO_OFF = RING_BYTES, HALO_BYTES = 4096;
constexpr int MISC_OFF = HALO_OFF + HALO_BYTES;
constexpr int LDS_BYTES = 147456;
static_assert(hy::HY_LDS_BYTES <= RING_BYTES && at::SHM_ATTN <= RING_BYTES && MISC_OFF + 256 <= LDS_BYTES, "LDS map");

#define GAS __attribute__((address_space(1)))
#define LAS __attribute__((address_space(3)))
typedef unsigned short bf16;
typedef unsigned v4u __attribute__((ext_vector_type(4)));
typedef unsigned v2u __attribute__((ext_vector_type(2)));
typedef float f32x4 __attribute__((ext_vector_type(4)));
#define LDS_WAIT() asm volatile("s_waitcnt lgkmcnt(0)" ::: "memory")
__device__ __forceinline__ unsigned f2bf(float f) { unsigned u = __builtin_bit_cast(unsigned, f); return (u + 0x7fffu + ((u >> 16) & 1u)) >> 16; }
__device__ __forceinline__ unsigned pk2(float lo, float hi) { return f2bf(lo) | (f2bf(hi) << 16); }
__device__ __forceinline__ float bf2f(unsigned short b) { return __builtin_bit_cast(float, (unsigned)b << 16); }
__device__ __forceinline__ float bflo(unsigned w) { return __builtin_bit_cast(float, w << 16); }
__device__ __forceinline__ float bfhi(unsigned w) { return __builtin_bit_cast(float, w & 0xffff0000u); }
__device__ __forceinline__ float wave_sum(float v) {
#pragma unroll
    for (int o = 1; o < 64; o <<= 1) v += __shfl_xor(v, o);
    return v;
}

#define XB_TMO      128
#define XB_XCNT(j)  (256  + 64 * (j))
#define XB_XSUB(j)  (1280 + 64 * (j))
#define XB_XGEN(j)  (2304 + 64 * (j))
#define XB_TOP      3328
#define XB_TOPGEN   3392
#define XCD_BAR_WORDS 3456
#define XB_SPIN_CAP (1u << 18)
__device__ __forceinline__ unsigned xb_ld(unsigned* p)              { return __hip_atomic_load(p, __ATOMIC_RELAXED, __HIP_MEMORY_SCOPE_AGENT); }
__device__ __forceinline__ unsigned xb_add(unsigned* p, unsigned v) { return __hip_atomic_fetch_add(p, v, __ATOMIC_RELAXED, __HIP_MEMORY_SCOPE_AGENT); }
__device__ __forceinline__ unsigned xb_xcc_id() { return (unsigned)__builtin_amdgcn_s_getreg((3 << 11) | 20) & 0xFu; }
#define XB_SPIN(cond, bar) do { unsigned _sp = 0; while (cond) { __builtin_amdgcn_s_sleep(1); \
    if ((++_sp & 255u) == 0u) { if (xb_ld(&(bar)[XB_TMO])) break; if (_sp > XB_SPIN_CAP) { atomicAdd(&(bar)[XB_TMO], 1u); break; } } } } while (0)
struct XcdBarrier { unsigned* bar; unsigned x; volatile LAS unsigned* st; };
__device__ __forceinline__ XcdBarrier xcd_barrier_post(unsigned* bar, volatile LAS unsigned* st) {
    XcdBarrier b; b.bar = bar; b.x = xb_xcc_id(); b.st = st;
    if (threadIdx.x == 0) (void)xb_add(&bar[XB_XCNT(b.x)], 1u);
    return b;
}
__device__ __forceinline__ void xcd_barrier_complete(unsigned* bar, unsigned x, unsigned& nloc, unsigned& nx) {
    const unsigned G = gridDim.x * gridDim.y * gridDim.z;
    unsigned sum, cnt, mine, sp = 0u;
    for (;;) {
        sum = 0u; cnt = 0u; mine = 0u;
#pragma unroll
        for (unsigned j = 0; j < 16; ++j) { const unsigned c = xb_ld(&bar[XB_XCNT(j)]); sum += c; cnt += (c > 0u) ? 1u : 0u; mine = (j == x) ? c : mine; }
        if (sum == G) break;
        __builtin_amdgcn_s_sleep(1);
        if ((++sp & 255u) == 0u) { if (xb_ld(&bar[XB_TMO])) break; if (sp > XB_SPIN_CAP) { atomicAdd(&bar[XB_TMO], 1u); break; } }
    }
    nloc = mine > 0u ? mine : 1u; nx = cnt > 0u ? cnt : 1u;
}
__device__ __forceinline__ void xcd_barrier(const XcdBarrier& b) {
    asm volatile("s_waitcnt vmcnt(0)" ::: "memory");
    __syncthreads();
    if (threadIdx.x == 0) {
        unsigned* bar = b.bar;
        __builtin_amdgcn_s_waitcnt(0);
        unsigned nloc = b.st[0], nx = b.st[1];
        if (nloc == 0u) { xcd_barrier_complete(bar, b.x, nloc, nx); b.st[0] = nloc; b.st[1] = nx; }
        const unsigned old = xb_add(&bar[XB_XSUB(b.x)], 1u);
        const unsigned gen = old / nloc;
        if (old + 1u == (gen + 1u) * nloc) {
            __builtin_amdgcn_fence(__ATOMIC_RELEASE, "agent");
            asm volatile("s_waitcnt vmcnt(0)" ::: "memory");
            const unsigned og = xb_add(&bar[XB_TOP], 1u);
            const unsigned tg = og / nx;
            if (og + 1u == (tg + 1u) * nx) xb_add(&bar[XB_TOPGEN], 1u);
            else XB_SPIN(xb_ld(&bar[XB_TOPGEN]) == tg, bar);
            __builtin_amdgcn_fence(__ATOMIC_ACQUIRE, "agent");
            xb_add(&bar[XB_XGEN(b.x)], 1u);
            asm volatile("s_waitcnt vmcnt(0)" ::: "memory");
        } else {
            XB_SPIN(xb_ld(&bar[XB_XGEN(b.x)]) == gen, bar);
            __builtin_amdgcn_fence(__ATOMIC_ACQUIRE, "agent");
            asm volatile("s_waitcnt vmcnt(0)" ::: "memory");
        }
    }
    __syncthreads();
}

struct Frame {
    LAS unsigned char* lds;
    int tid, lane, wave, vcu, G;
};
enum { I_XP = 0, I_XS, I_ANG, I_WIN, I_PW, I_PS, I_QNG, I_WUQ, I_KVNG, I_WUKV, I_QHG, I_KHG, I_HCW, I_HCB, I_FW1, I_FB1, I_FFR, I_FW2, I_FB2, I_FW3, I_FB3, I_HBIAS, I_GNG, I_WOUT, I_FNG, I_WUP, I_FCW, I_FCB, I_WDN, N_IN };
struct Args { const float* in[N_IN]; float* out; unsigned char* ws; int ph_lo, ph_hi; };
static_assert(sizeof(Args) == (N_IN + 2) * 8 + 8, "Args has no padding");

__device__ __forceinline__ void cvt_item(const float* __restrict__ W, int ldw, int K, bf16* WT, int dst_n0, int src_n0, int k0, const float* __restrict__ ks, LAS float* scr, int lane) {
#pragma unroll 8
    for (int i = 0; i < 32; ++i) { const int kk = 2 * i + (lane >> 5); float v = W[(size_t)(k0 + kk) * ldw + src_n0 + (lane & 31)]; if (ks) v *= ks[k0 + kk]; scr[kk * 33 + (lane & 31)] = v; }
    LDS_WAIT(); asm volatile("" ::: "memory");
    const int c = lane & 7;
#pragma unroll
    for (int j = 0; j < 4; ++j) { const int n = (lane >> 3) + 8 * j; const LAS float* s = scr + (8 * c) * 33 + n;
        v4u o; o.x = pk2(s[0 * 33], s[1 * 33]); o.y = pk2(s[2 * 33], s[3 * 33]); o.z = pk2(s[4 * 33], s[5 * 33]); o.w = pk2(s[6 * 33], s[7 * 33]);
        *(v4u*)(WT + (size_t)(dst_n0 + n) * K + k0 + 8 * c) = o; }
    LDS_WAIT(); asm volatile("" ::: "memory");
}
__device__ __forceinline__ void rms_row(const float* xrow, const float* __restrict__ g, bf16* orow, int lane) {
    const f32x4* xr = (const f32x4*)xrow + lane; const f32x4* gr = (const f32x4*)g + lane;
    f32x4 v[8]; float s = 0.f;
#pragma unroll
    for (int j = 0; j < 8; ++j) { v[j] = xr[64 * j]; s += (v[j].x * v[j].x + v[j].y * v[j].y) + (v[j].z * v[j].z + v[j].w * v[j].w); }
    const float rstd = 1.0f / sqrtf(wave_sum(s) * (1.f / DM) + EPS);
    v2u* o8 = (v2u*)orow + lane;
#pragma unroll
    for (int j = 0; j < 8; ++j) { const f32x4 gg = gr[64 * j]; v2u w; w.x = pk2(v[j].x * rstd * gg.x, v[j].y * rstd * gg.y); w.y = pk2(v[j].z * rstd * gg.z, v[j].w * rstd * gg.w); o8[64 * j] = w; }
}
__device__ __forceinline__ void tile_norm_store(LAS float* tile, bf16* dst, int row0, int col_off, int wave, int lane) {
#pragma unroll
    for (int i = 0; i < 8; ++i) { const int t = wave * 8 + i;
        const f32x4 a = *(LAS f32x4*)(tile + t * 512 + 8 * lane), b = *(LAS f32x4*)(tile + t * 512 + 8 * lane + 4);
        const float s = (a.x * a.x + a.y * a.y) + (a.z * a.z + a.w * a.w) + (b.x * b.x + b.y * b.y) + (b.z * b.z + b.w * b.w);
        const float rstd = 1.0f / sqrtf(wave_sum(s) * (1.f / 512.f) + EPS);
        v4u o; o.x = pk2(a.x * rstd, a.y * rstd); o.y = pk2(a.z * rstd, a.w * rstd); o.z = pk2(b.x * rstd, b.y * rstd); o.w = pk2(b.z * rstd, b.w * rstd);
        *(v4u*)(dst + (size_t)(row0 + t) * DM + col_off + 8 * lane) = o; }
}
__device__ __forceinline__ void poolfold_item(Frame& F, const float* __restrict__ win, const float* __restrict__ pw, const float* __restrict__ ps, bf16* BtIn, int g, int kb) {
    LAS float* At = (LAS float*)F.lds; LAS float* Bt = (LAS float*)(F.lds + 32768);
    const int k0 = 64 * kb;
#pragma unroll
    for (int i = 0; i < 4; ++i) { const int q = F.tid + 512 * i, row = q >> 5, c4 = q & 31; *(LAS f32x4*)(At + row * 128 + 4 * c4) = *(const f32x4*)(win + (size_t)(k0 + row) * DIN + 128 * g + 4 * c4); }
#pragma unroll
    for (int i = 0; i < 8; ++i) { const int q = F.tid + 512 * i, row = q >> 5, c4 = q & 31; *(LAS f32x4*)(Bt + row * 128 + 4 * c4) = *(const f32x4*)(pw + (size_t)(g * 128 + row) * 128 + 4 * c4); }
    __syncthreads();
    const int n = F.tid & 127, kg = F.tid >> 7;
    float acc[16];
#pragma unroll
    for (int i = 0; i < 16; ++i) acc[i] = 0.f;
    for (int j = 0; j < 128; j += 4) {
        const float b0 = Bt[(j + 0) * 128 + n], b1 = Bt[(j + 1) * 128 + n], b2 = Bt[(j + 2) * 128 + n], b3 = Bt[(j + 3) * 128 + n];
#pragma unroll
        for (int i = 0; i < 16; ++i) { const f32x4 a = *(LAS f32x4*)(At + (kg * 16 + i) * 128 + j); acc[i] += a.x * b0 + a.y * b1 + a.z * b2 + a.w * b3; }
    }
    const float sc = ps[128 * g + n];
    v4u o0, o1;
    o0.x = pk2(acc[0] * sc, acc[1] * sc); o0.y = pk2(acc[2] * sc, acc[3] * sc); o0.z = pk2(acc[4] * sc, acc[5] * sc); o0.w = pk2(acc[6] * sc, acc[7] * sc);
    o1.x = pk2(acc[8] * sc, acc[9] * sc); o1.y = pk2(acc[10] * sc, acc[11] * sc); o1.z = pk2(acc[12] * sc, acc[13] * sc); o1.w = pk2(acc[14] * sc, acc[15] * sc);
    bf16* dst = BtIn + (size_t)(128 * g + n) * DM + k0 + kg * 16;
    *(v4u*)dst = o0; *(v4u*)(dst + 8) = o1;
    __syncthreads();
}
__device__ __forceinline__ void filter_item(Frame& F, const float* __restrict__ w1, const float* __restrict__ b1, const float* __restrict__ fr, const float* __restrict__ w2, const float* __restrict__ b2,
                                            const float* __restrict__ w3, const float* __restrict__ b3, const float* __restrict__ hbias, bf16* RF, int fi) {
    LAS float* ZF = (LAS float*)F.lds; LAS float* H1 = ZF + 512; LAS float* H2 = ZF + 1536;
    const int t0 = 16 * fi;
    if (F.tid < 272) { const int tt = F.tid / 17, f = F.tid % 17; const float t = (float)(t0 + tt);
        float v;
        if (f == 0) v = t / 2047.0f;
        else { const int j = (f - 1) & 7; const float band = 1e-4f + (float)j * ((7.0f - 1e-4f) / 7.0f); const float w = (6.283185307179586f * t) / 2048.0f; const float a = band * w; v = (f <= 8) ? cosf(a) : -sinf(a); }
        ZF[tt * 17 + f] = v; }
    __syncthreads();
#pragma unroll
    for (int rep = 0; rep < 2; ++rep) { const int p = F.tid + 512 * rep, tt = p >> 6, j = p & 63; float s = b1[j];
        for (int i = 0; i < 17; ++i) s += ZF[tt * 17 + i] * w1[i * 64 + j];
        H1[tt * 64 + j] = sinf(fr[j] * s); }
    __syncthreads();
#pragma unroll
    for (int rep = 0; rep < 2; ++rep) { const int p = F.tid + 512 * rep, tt = p >> 6, j = p & 63; float s = b2[j];
        for (int i = 0; i < 64; ++i) s += H1[tt * 64 + i] * w2[i * 64 + j];
        H2[tt * 64 + j] = sinf(fr[j] * s); }
    __syncthreads();
    const int c = F.tid;
    const float delta = -3.0701134573253944f + (float)c * ((-15.350567286626972f + 3.0701134573253944f) / 511.0f);
    const float ad = fabsf(delta);
    bf16* rf = RF + (size_t)c * hy::RFS;
#pragma unroll 1
    for (int dir = 0; dir < 2; ++dir) { const int o = dir * 512 + c;
        float s[16]; const float bo = b3[o];
#pragma unroll
        for (int tt = 0; tt < 16; ++tt) s[tt] = bo;
#pragma unroll 1
        for (int ib = 0; ib < 64; ib += 16) {
            float wc[16];
#pragma unroll
            for (int i = 0; i < 16; ++i) wc[i] = w3[(ib + i) * 1024 + o];
#pragma unroll
            for (int tt = 0; tt < 16; ++tt) {
#pragma unroll
                for (int i = 0; i < 16; i += 4) { const f32x4 hv = *(LAS f32x4*)(H2 + tt * 64 + ib + i); s[tt] += hv.x * wc[i] + hv.y * wc[i + 1] + hv.z * wc[i + 2] + hv.w * wc[i + 3]; } } }
#pragma unroll
        for (int tt = 0; tt < 16; ++tt) {
            const int t = t0 + tt; const float tl = (float)t / 2047.0f; float val = s[tt] * expf(-tl * ad);
            if (dir == 0) { if (t == 0) val += hbias[c]; rf[2048 - t] = (bf16)f2bf(val); }
            else if (t >= 1) rf[2048 + t] = (bf16)f2bf(val); } }
    if (fi == 0) { rf[0] = 0;
#pragma unroll
        for (int i = 4096; i < hy::RFS; ++i) rf[i] = 0; }
    __syncthreads();
}
__device__ __forceinline__ void hyprep_item(Frame& F, const bf16* __restrict__ PROJ, const float* __restrict__ cw, const float* __restrict__ cb, bf16* ZT, bf16* X0, int b, int tile) {
    const int c = F.tid, t0 = tile * 64; const size_t rb = (size_t)b * SEQ;
    float w[3][3], bs[3];
#pragma unroll
    for (int j = 0; j < 3; ++j) { bs[j] = cb[512 * j + c];
#pragma unroll
        for (int k = 0; k < 3; ++k) w[j][k] = cw[k * 1536 + 512 * j + c]; }
    const bf16* pc = PROJ + O_HY + c;
    float prv[3], cur[3], nxt[3];
#pragma unroll
    for (int j = 0; j < 3; ++j) { prv[j] = (t0 > 0) ? bf2f(pc[(rb + t0 - 1) * DINP + 512 * j]) : 0.f; cur[j] = bf2f(pc[(rb + t0) * DINP + 512 * j]); }
    v4u* zd = (v4u*)(ZT + ((size_t)c * NSEQ + b) * SEQ + t0);
#pragma unroll 1
    for (int grp = 0; grp < 8; ++grp) { unsigned zp[4];
#pragma unroll
        for (int k8 = 0; k8 < 8; ++k8) { const int t = t0 + grp * 8 + k8; float u[3];
#pragma unroll
            for (int j = 0; j < 3; ++j) { nxt[j] = (t + 1 < SEQ) ? bf2f(pc[(rb + t + 1) * DINP + 512 * j]) : 0.f; u[j] = w[j][0] * prv[j] + w[j][1] * cur[j] + w[j][2] * nxt[j] + bs[j]; prv[j] = cur[j]; cur[j] = nxt[j]; }
            X0[(rb + t) * HYC + c] = (bf16)f2bf(u[0]);
            const unsigned zb = f2bf(u[2] * u[1]);
            if (k8 & 1) zp[k8 >> 1] |= zb << 16; else zp[k8 >> 1] = zb; }
        v4u o; o.x = zp[0]; o.y = zp[1]; o.z = zp[2]; o.w = zp[3]; zd[grp] = o; }
}
__device__ __forceinline__ void pool_item(Frame& F, const bf16* __restrict__ PROJ, bf16* MIXED, int b, int tile) {
    const int c = F.tid, t0 = tile * 64, half = 1 << (c >> 7); const size_t rb = (size_t)b * SEQ;
    const bf16* pc = PROJ + c; LAS float* tl = (LAS float*)F.lds;
    float S = 0.f;
    { const int lo = (t0 - half > 0) ? t0 - half : 0, hi = (t0 + half < SEQ) ? t0 + half : SEQ;
      for (int s = lo; s < hi; ++s) S += bf2f(pc[(rb + s) * DINP]); }
#pragma unroll 4
    for (int tt = 0; tt < 64; ++tt) { const int t = t0 + tt; const int lo = (t - half > 0) ? t - half : 0, hi = (t + half < SEQ) ? t + half : SEQ;
        const float u = bf2f(pc[(rb + t) * DINP]);
        tl[tt * 512 + c] = S / (float)(hi - lo) - u;
        if (t + half < SEQ) S += bf2f(pc[(rb + t + half) * DINP]);
        if (t - half >= 0) S -= bf2f(pc[(rb + t - half) * DINP]); }
    __syncthreads();
    tile_norm_store(tl, MIXED, (int)rb + t0, 0, F.wave, F.lane);
    __syncthreads();
}
__device__ __forceinline__ void hyfin_item(Frame& F, const bf16* __restrict__ YC, const bf16* __restrict__ X0, bf16* MIXED, int b, int tile) {
    const int c = F.tid, t0 = tile * 64; const size_t rb = (size_t)b * SEQ; LAS float* tl = (LAS float*)F.lds;
    const v4u* ys = (const v4u*)(YC + ((size_t)c * NSEQ + b) * SEQ + t0);
#pragma unroll 1
    for (int grp = 0; grp < 8; ++grp) { const v4u v = ys[grp]; const unsigned yp[4] = {v.x, v.y, v.z, v.w};
#pragma unroll
        for (int k8 = 0; k8 < 8; ++k8) { const int tt = grp * 8 + k8; const float y = (k8 & 1) ? bfhi(yp[k8 >> 1]) : bflo(yp[k8 >> 1]); tl[tt * 512 + c] = y * bf2f(X0[(rb + t0 + tt) * HYC + c]); } }
    __syncthreads();
    tile_norm_store(tl, MIXED, (int)rb + t0, 1536, F.wave, F.lane);
    __syncthreads();
}
__device__ __forceinline__ void prep_row(const bf16* __restrict__ PROJ, bf16* Q, bf16* KV, const float* __restrict__ qhg, const float* __restrict__ khg, int m, int lane) {
    const bf16* pr = PROJ + (size_t)m * DINP;
    float sq = 0.f, skv = 0.f;
    { const v4u a = *(const v4u*)(pr + O_CQ + 8 * lane); const unsigned w[4] = {a.x, a.y, a.z, a.w};
#pragma unroll
      for (int i = 0; i < 4; ++i) { const float x = bflo(w[i]), y = bfhi(w[i]); sq += x * x + y * y; }
      const v2u k = *(const v2u*)(pr + O_CKV + 4 * lane); const float k0 = bflo(k.x), k1 = bfhi(k.x), k2 = bflo(k.y), k3 = bfhi(k.y); skv = (k0 * k0 + k1 * k1) + (k2 * k2 + k3 * k3); }
    const float rq = 1.0f / sqrtf(wave_sum(sq) * (1.f / 512.f) + EPS), rkv = 1.0f / sqrtf(wave_sum(skv) * (1.f / 256.f) + EPS);
    const float pe = bf2f(pr[O_KPE + lane]);
    const int ri = lane & 31; const float freq = exp2f(-(float)ri * (13.287712379549449f / 32.0f)); const float ang = (float)(m & (SEQ - 1)) * freq;
    float sn, cs; sincosf(ang, &sn, &cs); const float sgn = (lane < 32) ? -sn : sn;
    const float gq0 = qhg[lane], gq1 = qhg[64 + lane], gq2 = qhg[128 + lane], gk0 = khg[lane], gk1 = khg[64 + lane], gk2 = khg[128 + lane];
    bf16* qr = Q + (size_t)m * NQ; bf16* kr = KV + (size_t)m * NKVP;
#pragma unroll
    for (int h = 0; h < NH; ++h) {
        const float a0 = bf2f(qr[192 * h + lane]) * rq, a1 = bf2f(qr[192 * h + 64 + lane]) * rq, a2 = bf2f(qr[192 * h + 128 + lane]) * rq;
        const float sc = 1.0f / sqrtf(wave_sum(a0 * a0 + a1 * a1 + a2 * a2) * (1.f / 192.f) + EPS);
        const float r = a2 * sc * gq2, rp = __shfl_xor(r, 32);
        qr[192 * h + lane] = (bf16)f2bf(a0 * sc * gq0); qr[192 * h + 64 + lane] = (bf16)f2bf(a1 * sc * gq1); qr[192 * h + 128 + lane] = (bf16)f2bf(r * cs + rp * sgn);
        const float k0 = bf2f(kr[KVHS * h + lane]) * rkv, k1 = bf2f(kr[KVHS * h + 64 + lane]) * rkv;
        const float v0 = bf2f(kr[KVHS * h + 192 + lane]) * rkv, v1 = bf2f(kr[KVHS * h + 256 + lane]) * rkv;
        const float sk = 1.0f / sqrtf(wave_sum(k0 * k0 + k1 * k1 + pe * pe) * (1.f / 192.f) + EPS);
        const float kp = pe * sk * gk2, kpp = __shfl_xor(kp, 32);
        kr[KVHS * h + lane] = (bf16)f2bf(k0 * sk * gk0); kr[KVHS * h + 64 + lane] = (bf16)f2bf(k1 * sk * gk1); kr[KVHS * h + 128 + lane] = (bf16)f2bf(kp * cs + kpp * sgn);
        kr[KVHS * h + 192 + lane] = (bf16)f2bf(v0); kr[KVHS * h + 256 + lane] = (bf16)f2bf(v1);
    }
}
__device__ __forceinline__ void attn_norm_row(bf16* MIXED, int m, int lane) {
    v4u* p = (v4u*)(MIXED + (size_t)m * DM + 512 + 16 * lane); v4u a = p[0], b = p[1];
    unsigned w[8] = {a.x, a.y, a.z, a.w, b.x, b.y, b.z, b.w}; float s = 0.f;
#pragma unroll
    for (int i = 0; i < 8; ++i) { const float x = bflo(w[i]), y = bfhi(w[i]); s += x * x + y * y; }
    const float rstd = 1.0f / sqrtf(wave_sum(s) * (1.f / 1024.f) + EPS);
#pragma unroll
    for (int i = 0; i < 8; ++i) w[i] = pk2(bflo(w[i]) * rstd, bfhi(w[i]) * rstd);
    a.x = w[0]; a.y = w[1]; a.z = w[2]; a.w = w[3]; b.x = w[4]; b.y = w[5]; b.z = w[6]; b.w = w[7]; p[0] = a; p[1] = b;
}

__global__ void __launch_bounds__(NWAVES * 64, 2) fwd(Args args) {
    extern __shared__ __attribute__((aligned(16))) unsigned char lds_raw[];
    Frame F;
    F.lds = (LAS unsigned char*)lds_raw;
    F.tid = threadIdx.x; F.lane = F.tid & 63; F.wave = __builtin_amdgcn_readfirstlane(F.tid >> 6);
    F.G = gridDim.x; { const int bx = blockIdx.x; F.vcu = (F.G % 8 == 0) ? (bx % 8) * (F.G / 8) + bx / 8 : bx; }
    volatile LAS unsigned* MISC = (volatile LAS unsigned*)(F.lds + MISC_OFF);
    if (F.tid < 64) MISC[F.tid] = 0u;
    __syncthreads();
    unsigned char* ws = args.ws;
    unsigned* ctl = (unsigned*)(ws + WS_CTL);
    const int lo = args.ph_lo, hi = args.ph_hi;
    XcdBarrier bar; bar.bar = ctl + CW_BAR; bar.x = 0; bar.st = MISC + 8;
    if (hi - lo > 1) bar = xcd_barrier_post(ctl + CW_BAR, MISC + 8);
    bf16* BtIn = (bf16*)(ws + WS_BTIN); bf16* BtUq = (bf16*)(ws + WS_BTUQ); bf16* BtKv = (bf16*)(ws + WS_BTKV); bf16* BtOut = (bf16*)(ws + WS_BTOUT); bf16* BtUp = (bf16*)(ws + WS_BTUP); bf16* BtDn = (bf16*)(ws + WS_BTDN);
    bf16* RF = (bf16*)(ws + WS_RF); bf16* Hb = (bf16*)(ws + WS_H); bf16* PROJ = (bf16*)(ws + WS_PROJ); bf16* Qb = (bf16*)(ws + WS_Q); bf16* KVb = (bf16*)(ws + WS_KV);
    bf16* ZT = (bf16*)(ws + WS_ZT); bf16* X0 = (bf16*)(ws + WS_X0); bf16* YC = (bf16*)(ws + WS_YC); float* EDGE = (float*)(ws + WS_EDGE); bf16* ACT = (bf16*)(ws + WS_ACT);
    float* out = args.out;

#pragma unroll 1
    for (int layer = 0; layer < DEPTH; ++layer) {
        const int pb = layer * NPH;
        if (pb + NPH <= lo || pb >= hi) continue;
#define IN(k) (lo <= pb + (k) && pb + (k) < hi)
#define ENTER() F.tid = opq(threadIdx.x); F.lane = F.tid & 63; F.wave = __builtin_amdgcn_readfirstlane(F.tid >> 6); const int gw = F.vcu * NWAVES + F.wave, NGW = F.G * NWAVES, wg = F.vcu; const size_t gtid = (size_t)wg * 512 + F.tid, gthreads = (size_t)F.G * 512; (void)gw; (void)NGW; (void)wg; (void)gtid; (void)gthreads
#define SEAM(k) do { if (pb + (k) + 1 < hi) xcd_barrier(bar); } while (0)
        const float* xsA = (layer == 0) ? args.in[I_XP] : out; const float* xsB = (layer == 0) ? args.in[I_XS] : out + (size_t)MP * DM;

        if (IN(0)) { ENTER();
            const float* win = args.in[I_WIN] + (size_t)layer * DM * DIN;
            for (int it = wg; it < 256; it += F.G) {
                if (it < 128) poolfold_item(F, win, args.in[I_PW] + (size_t)layer * 4 * 128 * 128, args.in[I_PS] + (size_t)layer * 512, BtIn, it >> 5, it & 31);
                else filter_item(F, args.in[I_FW1] + (size_t)layer * 17 * 64, args.in[I_FB1] + layer * 64, args.in[I_FFR] + layer * 64, args.in[I_FW2] + (size_t)layer * 64 * 64, args.in[I_FB2] + layer * 64,
                                 args.in[I_FW3] + (size_t)layer * 64 * 1024, args.in[I_FB3] + layer * 1024, args.in[I_HBIAS] + layer * 512, RF, it - 128);
            }
            LAS float* scr = (LAS float*)(F.lds + F.wave * 8448);
            constexpr int N_IN_ = 74 * 32, N_UQ = 48 * 8, N_KV = 64 * 4, N_OUT = 64 * 32, N_UP = 352 * 32, N_DN = 64 * 88, N_ALL = N_IN_ + N_UQ + N_KV + N_OUT + N_UP + N_DN;
            for (int it = gw; it < N_ALL; it += NGW) {
                int r = it;
                if (r < N_IN_) { const int nb = 16 + r / 32, kb = r % 32; cvt_item(win, DIN, DM, BtIn, 32 * nb, 32 * nb, 64 * kb, nullptr, scr, F.lane); continue; } r -= N_IN_;
                if (r < N_UQ) { const int nb = r / 8, kb = r % 8; cvt_item(args.in[I_WUQ] + (size_t)layer * 512 * NQ, NQ, 512, BtUq, 32 * nb, 32 * nb, 64 * kb, args.in[I_QNG] + layer * 512, scr, F.lane); continue; } r -= N_UQ;
                if (r < N_KV) { const int nb = r / 4, kb = r % 4, h = nb >> 3, wb = nb & 7; const int dst = KVHS * h + (wb < 4 ? 32 * wb : 192 + 32 * (wb - 4));
                    cvt_item(args.in[I_WUKV] + (size_t)layer * 256 * 2048, 2048, 256, BtKv, dst, 32 * nb, 64 * kb, args.in[I_KVNG] + layer * 256, scr, F.lane); continue; } r -= N_KV;
                if (r < N_OUT) { const int nb = r / 32, kb = r % 32; cvt_item(args.in[I_WOUT] + (size_t)layer * DM * DM, DM, DM, BtOut, 32 * nb, 32 * nb, 64 * kb, args.in[I_GNG] + layer * DM, scr, F.lane); continue; } r -= N_OUT;
                if (r < N_UP) { const int nb = r / 32, kb = r % 32; const int nv = (nb < 176) ? nb : nb - 176; const int dst = 256 * (nv >> 2) + 32 * (nv & 3) + (nb < 176 ? 0 : 128);
                    cvt_item(args.in[I_WUP] + (size_t)layer * DM * NUP, NUP, DM, BtUp, dst, 32 * nb, 64 * kb, nullptr, scr, F.lane); continue; } r -= N_UP;
                { const int nb = r / 88, kb = r % 88; cvt_item(args.in[I_WDN] + (size_t)layer * DFF * DM, DM, DFF, BtDn, 32 * nb, 32 * nb, 64 * kb, nullptr, scr, F.lane); }
            }
            { v4u z = {0u, 0u, 0u, 0u};
              for (size_t i = gtid; i < (size_t)(DINP - DIN) * DM / 8; i += gthreads) *(v4u*)(BtIn + (size_t)DIN * DM + i * 8) = z;
              for (size_t i = gtid; i < (size_t)NH * 64 * 256 / 8; i += gthreads) { const int h = (int)(i / (64 * 256 / 8)), q = (int)(i % (64 * 256 / 8)); *(v4u*)(BtKv + (size_t)(KVHS * h + 128) * 256 + (size_t)q * 8) = z; } }
            const float* g1 = args.in[I_ANG] + layer * DM;
            for (int m = gw; m < M; m += NGW) rms_row(m < MP ? xsA + (size_t)m * DM : xsB + (size_t)(m - MP) * DM, g1, Hb + (size_t)m * DM, F.lane);
            SEAM(0);
        }
        if (IN(1)) { ENTER();
            pg8::Gemm g{Hb, BtIn, M, DINP, DM, DM}; pg8::StaticOrder S; S.init(M, DINP, F.G, (int)blockIdx.x);
            pg8::EpiBf16 E{PROJ, DINP};
            pg8::gemm_phase<pg8::EpiBf16, pg8::StaticOrder>(F.lds, g, S, E);
            SEAM(1);
        }
        if (IN(2)) { ENTER();
            { pg8::Gemm g{PROJ + O_CQ, BtUq, M, NQ, 512, DINP}; pg8::StaticOrder S; S.init(M, NQ, F.G, (int)blockIdx.x); pg8::EpiBf16 E{Qb, NQ};
              pg8::gemm_phase<pg8::EpiBf16, pg8::StaticOrder>(F.lds, g, S, E); }
            { pg8::Gemm g{PROJ + O_CKV, BtKv, M, NKVP, 256, DINP}; pg8::StaticOrder S; S.init(M, NKVP, F.G, (int)blockIdx.x); pg8::EpiBf16 E{KVb, NKVP};
              pg8::gemm_phase<pg8::EpiBf16, pg8::StaticOrder>(F.lds, g, S, E); }
            const float* hcw = args.in[I_HCW] + (size_t)layer * 3 * 1536; const float* hcb = args.in[I_HCB] + layer * 1536;
            for (int it = wg; it < 2 * NSEQ * 32; it += F.G) {
                if (it < NSEQ * 32) hyprep_item(F, PROJ, hcw, hcb, ZT, X0, it >> 5, it & 31);
                else pool_item(F, PROJ, Hb, (it - NSEQ * 32) >> 5, it & 31);
            }
            SEAM(2);
        }
        if (IN(3)) { ENTER();
            for (int u = wg; u < 2 * HYC; u += F.G) hy::conv_unit(F.lds, ZT, RF, YC, u >> 1, u & 1);
            const float* qhg = args.in[I_QHG] + layer * 192; const float* khg = args.in[I_KHG] + layer * 192;
            for (int m = gw; m < M; m += NGW) prep_row(PROJ, Qb, KVb, qhg, khg, m, F.lane);
            SEAM(3);
        }
        if (IN(4)) { ENTER();
            for (int i = 0; i * F.G < NSEQ * NH * 8; ++i) {
                int p, qb; const int c = (int)blockIdx.x;
                if (F.G == 256) { p = i * 32 + (c & 7) * 4 + (c >> 6); qb = (c >> 3) & 7; } else { const int Lq = i * F.G + c; p = Lq >> 3; qb = Lq & 7; }
                if (p < NSEQ * NH) { const int b = p >> 3, h = p & 7;
                    at::attn_unit(Qb + (size_t)(b * SEQ + qb * 256) * NQ + h * 192, KVb + (size_t)(b * SEQ) * NKVP + h * KVHS, KVb + (size_t)(b * SEQ) * NKVP + h * KVHS + 192,
                                  Hb + (size_t)(b * SEQ + qb * 256) * DM + 512 + h * 128, SEQ, (char*)lds_raw); }
            }
            for (int it = wg; it < NSEQ * 32; it += F.G) hyfin_item(F, YC, X0, Hb, it >> 5, it & 31);
            SEAM(4);
        }
        if (IN(5)) { ENTER();
            for (int m = gw; m < M; m += NGW) attn_norm_row(Hb, m, F.lane);
            SEAM(5);
        }
        if (IN(6)) { ENTER();
            pg8::Gemm g{Hb, BtOut, M, DM, DM, DM}; pg8::StaticOrder S; S.init(M, DM, F.G, (int)blockIdx.x);
            pg8::EpiResid E{xsA, xsB, MP, out, DM};
            pg8::gemm_phase<pg8::EpiResid, pg8::StaticOrder>(F.lds, g, S, E);
            SEAM(6);
        }
        if (IN(7)) { ENTER();
            const float* g2 = args.in[I_FNG] + layer * DM;
            for (int m = gw; m < M; m += NGW) rms_row(out + (size_t)m * DM, g2, Hb + (size_t)m * DM, F.lane);
            SEAM(7);
        }
        if (IN(8)) { ENTER();
            pg8::Gemm g{Hb, BtUp, M, NUP, DM, DM}; pg8::StaticOrder S; S.init(M, NUP, F.G, (int)blockIdx.x);
            pg8::EpiGate E{ACT, DFF, EDGE, args.in[I_FCW] + (size_t)layer * 3 * DFF, args.in[I_FCB] + layer * DFF, DFF, (LAS float*)(F.lds + HALO_OFF)};
            pg8::gemm_phase<pg8::EpiGate, pg8::StaticOrder>(F.lds, g, S, E);
            SEAM(8);
        }
        if (IN(9)) { ENTER();
            const float* fcw = args.in[I_FCW] + (size_t)layer * 3 * DFF;
            for (size_t i = gtid; i < (size_t)(M / 256) * 2 * (DFF / 4); i += gthreads) {
                const int ri = (int)(i / (DFF / 4)), c4 = (int)(i % (DFF / 4)) * 4, pm = ri >> 1, e = ri & 1;
                const float* eb = EDGE + (size_t)(ri * 3) * DFF + c4;
                f32x4 pre = *(const f32x4*)(eb + DFF); const f32x4 v = *(const f32x4*)(eb + 2 * DFF);
                if (e == 0 && (pm & 7) != 0) { const f32x4 gp = *(const f32x4*)(EDGE + (size_t)(((pm - 1) * 2 + 1) * 3) * DFF + c4); pre += *(const f32x4*)(fcw + c4) * gp; }
                if (e == 1 && (pm & 7) != 7) { const f32x4 gn = *(const f32x4*)(EDGE + (size_t)(((pm + 1) * 2 + 0) * 3) * DFF + c4); pre += *(const f32x4*)(fcw + 2 * DFF + c4) * gn; }
                v2u o; o.x = pk2(pg8::silu_f(pre.x) * v.x, pg8::silu_f(pre.y) * v.y); o.y = pk2(pg8::silu_f(pre.z) * v.z, pg8::silu_f(pre.w) * v.w);
                *(v2u*)(ACT + (size_t)(pm * 256 + (e ? 255 : 0)) * DFF + c4) = o;
            }
            SEAM(9);
        }
        if (IN(10)) { ENTER();
            pg8::Gemm g{ACT, BtDn, M, DM, DFF, DFF}; pg8::StaticOrder S; S.init(M, DM, F.G, (int)blockIdx.x);
            pg8::EpiResid E{out, out + (size_t)MP * DM, MP, out, DM};
            pg8::gemm_phase<pg8::EpiResid, pg8::StaticOrder>(F.lds, g, S, E);
            SEAM(10);
        }
#undef IN
#undef ENTER
#undef SEAM
    }
}

extern "C" void kernel_launch(void* const* d_in, const int* in_sizes, int n_in, void* d_out, int out_size, void* d_ws, size_t ws_size, hipStream_t stream) {
    static int grid = 0;
    if (grid == 0) {
        if (n_in != N_IN || out_size != M * DM || ws_size < WS_END) { fprintf(stderr, "kernel_launch: unexpected shapes (n_in %d, out %d, ws %zu, need %zu)\n", n_in, out_size, ws_size, (size_t)WS_END); grid = -1; return; }
        int dev = 0, cus = 0;
        if (hipGetDevice(&dev) != hipSuccess || hipDeviceGetAttribute(&cus, hipDeviceAttributeMultiprocessorCount, dev) != hipSuccess) { grid = -1; return; }
        if (hipFuncSetAttribute((const void*)fwd, hipFuncAttributeMaxDynamicSharedMemorySize, LDS_BYTES) != hipSuccess) { fprintf(stderr, "kernel_launch: hipFuncSetAttribute failed\n"); grid = -1; return; }
        int per_cu = 0;
        if (hipOccupancyMaxActiveBlocksPerMultiprocessor(&per_cu, (const void*)fwd, NWAVES * 64, LDS_BYTES) != hipSuccess || per_cu < 1) fprintf(stderr, "kernel_launch: occupancy query reports %d\n", per_cu);
        (void)hipGetLastError();
        grid = cus;
    }
    if (grid < 0) return;
    (void)hipMemsetAsync((char*)d_ws + WS_CTL, 0, CTL_BYTES, stream);
    Args a{};
    for (int i = 0; i < N_IN; ++i) a.in[i] = (const float*)d_in[i];
    a.out = (float*)d_out; a.ws = (unsigned char*)d_ws;
#if MK_ONE_LAUNCH
    a.ph_lo = 0; a.ph_hi = DEPTH * NPH;
    hipLaunchKernelGGL(fwd, dim3(grid), dim3(NWAVES * 64), LDS_BYTES, stream, a);
#else
    for (int p = 0; p < DEPTH * NPH; ++p) { a.ph_lo = p; a.ph_hi = p + 1; hipLaunchKernelGGL(fwd, dim3(grid), dim3(NWAVES * 64), LDS_BYTES, stream, a); }
#endif
    const hipError_t le = hipPeekAtLastError();
    if (le != hipSuccess) fprintf(stderr, "kernel_launch: launch failed: %s\n", hipGetErrorName(le));
}
```

```cpp
#include <hip/hip_runtime.h>
#include <cstdio>
#include <cstdint>
__device__ __forceinline__ int opq(int x) { asm volatile("" : "+v"(x)); return x; }
namespace pg8 {
#define PG8_LAS __attribute__((address_space(3)))
typedef unsigned short bf16_t;
typedef short bf16x8 __attribute__((ext_vector_type(8)));
typedef float f32x4 __attribute__((ext_vector_type(4)));
typedef unsigned u32x4 __attribute__((ext_vector_type(4)));
constexpr int BM = 256, BK = 64, HALF = 128, HTB = HALF * BK * 2  , STAGE_BYTES = 8 * HTB, NXCD = 8, WGM = 8;

__host__ __device__ __forceinline__ int lds_byte(int r, int c) { const int st = (r >> 4) * 2 + (c >> 5), rr = r & 15, cc = c & 31, ob = rr * 64 + cc * 2; return st * 1024 + (ob ^ (((ob >> 9) & 1) << 5)); }
__host__ __device__ __forceinline__ void stage_rc(int b, int& R, int& C) { const int st = b / 1024, sb = b % 1024, swz = sb ^ (((sb >> 9) & 1) << 5); R = (st >> 1) * 16 + swz / 64; C = (st & 1) * 32 + (swz % 64) / 2; }
__host__ __device__ __forceinline__ int perm32(int rho) { const int n = rho >> 4, i = rho & 15; return 8 * (i >> 2) + 4 * n + (i & 3); }

struct Unit { int pm, pn; };
struct Gemm { const bf16_t* A; const bf16_t* Bt; int M, N, K, lda; };

struct StaticOrder {
    int nM, nN, nwg, G, c;
    __host__ __device__ void init(int M, int N, int G_, int c_) { nM = M / BM; nN = N / BM; nwg = nM * nN; G = G_; c = c_; }
    __host__ __device__ bool next(int i, Unit& u) const {
        const long L = (long)i * G + c; if (L >= nwg) return false;
        int wgid = (int)L; { const int q = nwg / NXCD, r = nwg % NXCD, xcd = wgid % NXCD, off = wgid / NXCD; wgid = (xcd < r ? xcd * (q + 1) : r * (q + 1) + (xcd - r) * q) + off; }
        const int nig = WGM * nN, gid = wgid / nig, fm = gid * WGM, gsz = (nM - fm) < WGM ? (nM - fm) : WGM;
        u.pm = fm + ((wgid % nig) % gsz); u.pn = (wgid % nig) / gsz; return true;
    }
    __device__ __forceinline__ void a_ready(const Unit&) const {}
    __device__ __forceinline__ void done(const Unit&) const {}
};

__device__ __forceinline__ unsigned cvt_pk_bf16(float lo, float hi) { unsigned r; asm volatile("v_cvt_pk_bf16_f32 %0, %1, %2" : "=v"(r) : "v"(lo), "v"(hi)); return r; }

struct EpiBf16 {
    static constexpr bool PERM = true;
    bf16_t* O; int ldc; const float* rstd;
    __device__ __forceinline__ void operator()(f32x4 (&acc)[2][2][4][2], const Unit& u, int wr, int wc, int fr, int fq) const {
        const int row0 = u.pm * BM + wr * 64 + fr; const int col0 = u.pn * BM + wc * 32 + 8 * fq;
#pragma unroll
        for (int ai = 0; ai < 2; ++ai)
#pragma unroll
            for (int m = 0; m < 4; ++m) { const int row = row0 + ai * HALF + m * 16; bf16_t* rowp = O + (size_t)row * ldc + col0; const float rs = rstd ? rstd[row] : 1.0f;
#pragma unroll
                for (int bj = 0; bj < 2; ++bj) { const f32x4 v0 = acc[ai][bj][m][0] * rs, v1 = acc[ai][bj][m][1] * rs;
                    u32x4 w; w.x = cvt_pk_bf16(v0[0], v0[1]); w.y = cvt_pk_bf16(v0[2], v0[3]); w.z = cvt_pk_bf16(v1[0], v1[1]); w.w = cvt_pk_bf16(v1[2], v1[3]);
                    *(u32x4*)(rowp + bj * HALF) = w; } }
    }
};
struct EpiResid {
    static constexpr bool PERM = false;
    const float* baseA; const float* baseB; int split; float* out; int ldc; bf16_t* xb; float* ssqp;
    __device__ __forceinline__ void operator()(f32x4 (&acc)[2][2][4][2], const Unit& u, int wr, int wc, int fr, int fq) const {
        typedef unsigned u32x2 __attribute__((ext_vector_type(2)));
        const int rt = u.pm * BM; const float* bs = (rt < split) ? baseA + (size_t)rt * ldc : baseB + (size_t)(rt - split) * ldc; float* op = out + (size_t)rt * ldc;
        bs += u.pn * BM; op += u.pn * BM;
        bf16_t* xp = xb ? xb + (size_t)rt * ldc + u.pn * BM : nullptr;
        const unsigned lo = (unsigned)((wr * 64 + fr) * ldc + wc * 32 + 4 * fq);
#pragma unroll
        for (int ai = 0; ai < 2; ++ai)
#pragma unroll
            for (int m = 0; m < 4; ++m) { const unsigned off = lo + (unsigned)((ai * HALF + m * 16) * ldc); float s = 0.f;
#pragma unroll
                for (int bj = 0; bj < 2; ++bj)
#pragma unroll
                    for (int n = 0; n < 2; ++n) { const f32x4 b = *(const f32x4*)(bs + off + bj * HALF + n * 16); const f32x4 x = b + acc[ai][bj][m][n]; *(f32x4*)(op + off + bj * HALF + n * 16) = x;
                        if (xb) { u32x2 w; w.x = cvt_pk_bf16(x[0], x[1]); w.y = cvt_pk_bf16(x[2], x[3]); *(u32x2*)(xp + off + bj * HALF + n * 16) = w; s += (x[0] * x[0] + x[1] * x[1]) + (x[2] * x[2] + x[3] * x[3]); } }
                if (xb) { s += __shfl_xor(s, 16); s += __shfl_xor(s, 32); if (fq == 0) ssqp[(size_t)(rt + wr * 64 + fr + ai * HALF + m * 16) * 32 + u.pn * 4 + wc] = s; }
                asm volatile("" ::: "memory"); }
    }
};
__device__ __forceinline__ float silu_f(float x) { return x * __builtin_amdgcn_rcpf(1.0f + __builtin_amdgcn_exp2f(-1.4426950408889634f * x)); }
struct EpiGate {
    static constexpr bool PERM = true;
    bf16_t* act; int ldact; float* edge; const float* cw; const float* cb; int dff; PG8_LAS float* halo; const float* rstd;
    __device__ __forceinline__ void operator()(f32x4 (&acc)[2][2][4][2], const Unit& u, int wr, int wc, int fr, int fq) const {
        const int lane = fq * 16 + fr; const int colL = wc * 32 + 8 * fq; const int colG = u.pn * HALF + colL;
#pragma unroll
        for (int ai = 0; ai < 2; ++ai)
#pragma unroll
            for (int m = 0; m < 4; ++m) { const float rs = rstd[u.pm * BM + ai * HALF + wr * 64 + m * 16 + fr];
#pragma unroll
                for (int bj = 0; bj < 2; ++bj) { acc[ai][bj][m][0] *= rs; acc[ai][bj][m][1] *= rs; } }
#pragma unroll
        for (int ai = 0; ai < 2; ++ai) { const int q = 2 * ai + wr;
            if (fr == 0) { *(PG8_LAS f32x4*)(halo + (q * 2 + 0) * 128 + colL) = acc[ai][0][0][0]; *(PG8_LAS f32x4*)(halo + (q * 2 + 0) * 128 + colL + 4) = acc[ai][0][0][1]; }
            if (fr == 15) { *(PG8_LAS f32x4*)(halo + (q * 2 + 1) * 128 + colL) = acc[ai][0][3][0]; *(PG8_LAS f32x4*)(halo + (q * 2 + 1) * 128 + colL + 4) = acc[ai][0][3][1]; } }
        asm volatile("s_waitcnt lgkmcnt(0)" ::: "memory"); __builtin_amdgcn_s_barrier(); asm volatile("" ::: "memory");
        const int srcR = (lane & 48) | ((fr - 1) & 15), srcL = (lane & 48) | ((fr + 1) & 15);
        bf16_t* actp = act + (size_t)(u.pm * BM) * ldact + colG; const unsigned rlo = (unsigned)((wr * 64 + fr) * ldact);
#pragma unroll
        for (int ai = 0; ai < 2; ++ai) { const int q = 2 * ai + wr;
#pragma unroll
            for (int n = 0; n < 2; ++n) {
                const f32x4 w0 = *(const f32x4*)(cw + colG + 4 * n), w1 = *(const f32x4*)(cw + dff + colG + 4 * n), w2 = *(const f32x4*)(cw + 2 * dff + colG + 4 * n), bb = *(const f32x4*)(cb + colG + 4 * n);
                f32x4 ht = {0.f, 0.f, 0.f, 0.f}, hb = {0.f, 0.f, 0.f, 0.f};
                if (q > 0) ht = *(PG8_LAS f32x4*)(halo + ((q - 1) * 2 + 1) * 128 + colL + 4 * n);
                if (q < 3) hb = *(PG8_LAS f32x4*)(halo + ((q + 1) * 2 + 0) * 128 + colL + 4 * n);
                f32x4 pre[4];
#pragma unroll
                for (int j = 0; j < 4; ++j) {
                    float g[4], rr[4], rl[4];
#pragma unroll
                    for (int m = 0; m < 4; ++m) { g[m] = acc[ai][0][m][n][j]; rr[m] = __shfl(g[m], srcR); rl[m] = __shfl(g[m], srcL); }
#pragma unroll
                    for (int m = 0; m < 4; ++m) {
                        const float up = (fr > 0) ? rr[m] : (m > 0 ? rr[m > 0 ? m - 1 : 0] : ht[j]);
                        const float dn = (fr < 15) ? rl[m] : (m < 3 ? rl[m < 3 ? m + 1 : 3] : hb[j]);
                        pre[m][j] = w0[j] * up + w1[j] * g[m] + w2[j] * dn + bb[j];
                    }
                }
                if (q == 0 && fr == 0) { float* e = edge + (size_t)((u.pm * 2 + 0) * 3) * dff + colG + 4 * n;
                    *(f32x4*)(e) = acc[ai][0][0][n]; *(f32x4*)(e + dff) = pre[0]; *(f32x4*)(e + 2 * dff) = acc[ai][1][0][n]; }
                if (q == 3 && fr == 15) { float* e = edge + (size_t)((u.pm * 2 + 1) * 3) * dff + colG + 4 * n;
                    *(f32x4*)(e) = acc[ai][0][3][n]; *(f32x4*)(e + dff) = pre[3]; *(f32x4*)(e + 2 * dff) = acc[ai][1][3][n]; }
#pragma unroll
                for (int m = 0; m < 4; ++m) {
                    const f32x4 v = acc[ai][1][m][n];
                    typedef unsigned u32x2 __attribute__((ext_vector_type(2)));
                    u32x2 w; w.x = cvt_pk_bf16(silu_f(pre[m][0]) * v[0], silu_f(pre[m][1]) * v[1]); w.y = cvt_pk_bf16(silu_f(pre[m][2]) * v[2], silu_f(pre[m][3]) * v[3]);
                    *(u32x2*)(actp + rlo + (unsigned)((ai * HALF + m * 16) * ldact) + 4 * n) = w;
                }
            }
        }
    }
};

template <class Epi, class Sched>
__device__ __forceinline__ void gemm_phase(PG8_LAS unsigned char* lds, const Gemm g, const Sched& S, const Epi& E) {
    const int tid = opq(threadIdx.x), wid = __builtin_amdgcn_readfirstlane(tid >> 6), lane = tid & 63, wr = wid >> 2, wc = wid & 3, fr = lane & 15, fq = lane >> 4;
    const int K = g.K, nt = K / BK, lda = g.lda;
    unsigned voffA[2], voffB[2];
#pragma unroll
    for (int i = 0; i < 2; ++i) { int R, C; stage_rc(tid * 16 + i * 8192, R, C); const int Rb = Epi::PERM ? ((R & ~31) + perm32(R & 31)) : R;
        voffA[i] = (unsigned)(R * lda + C) * 2u; voffB[i] = (unsigned)(Rb * K + C) * 2u; }
    const size_t kstep = (size_t)(BK * 2);
    const size_t hstepA = (size_t)HALF * lda * 2, hstepB = (size_t)HALF * K * 2;
    const size_t tstepA = 2 * hstepA, tstepB = 2 * hstepB;
    const unsigned ldsw = (unsigned)wid * 1024u;
    const int aoff = lds_byte(wr * 64 + fr, fq * 8), boff = lds_byte(wc * 32 + fr, fq * 8);
#define PG8_SA(b, h) (((b) * 2 + (h)) * HTB)
#define PG8_SB(b, h) ((4 + (b) * 2 + (h)) * HTB)
#define PG8_STAGE(bufoff, gbase, voff) do { _Pragma("unroll") for (int _i = 0; _i < 2; ++_i) \
        __builtin_amdgcn_global_load_lds((const unsigned*)((const char*)(gbase) + (voff)[_i]), (PG8_LAS unsigned*)(lds + (bufoff) + ldsw + _i * 8192), 16, 0, 0); } while (0)
#define PG8_LDA(dst, b, h) do { _Pragma("unroll") for (int m = 0; m < 4; ++m) _Pragma("unroll") for (int k = 0; k < 2; ++k) dst[m][k] = *(const PG8_LAS bf16x8*)(lds + PG8_SA(b, h) + aoff + m * 2048 + k * 1024); } while (0)
#define PG8_LDB(dst, b, h) do { _Pragma("unroll") for (int n = 0; n < 2; ++n) _Pragma("unroll") for (int k = 0; k < 2; ++k) dst[n][k] = *(const PG8_LAS bf16x8*)(lds + PG8_SB(b, h) + boff + n * 2048 + k * 1024); } while (0)
#define PG8_MMA(ai, bj, At, Bt) do { __builtin_amdgcn_s_setprio(1); _Pragma("unroll") for (int m = 0; m < 4; ++m) _Pragma("unroll") for (int n = 0; n < 2; ++n) _Pragma("unroll") for (int k = 0; k < 2; ++k) \
        acc[ai][bj][m][n] = __builtin_amdgcn_mfma_f32_16x16x32_bf16(Bt[n][k], At[m][k], acc[ai][bj][m][n], 0, 0, 0); __builtin_amdgcn_s_setprio(0); } while (0)
#define PG8_WAIT_V(n) asm volatile("s_waitcnt vmcnt(" #n ")" ::: "memory")
#define PG8_WAIT_L(n) asm volatile("s_waitcnt lgkmcnt(" #n ")" ::: "memory")
#define PG8_BAR __builtin_amdgcn_s_barrier()
#define PG8_SCHED __builtin_amdgcn_sched_barrier(0)
    Unit cur, nxt; int ui = 0;
    if (!S.next(0, cur)) return;
    f32x4 acc[2][2][4][2];
#pragma unroll
    for (int a = 0; a < 2; ++a)
#pragma unroll
        for (int b = 0; b < 2; ++b)
#pragma unroll
            for (int m = 0; m < 4; ++m)
#pragma unroll
                for (int n = 0; n < 2; ++n) acc[a][b][m][n] = (f32x4){0.f, 0.f, 0.f, 0.f};
    bf16x8 At[4][2], B0[2][2], B1[2][2];
    const char* cA = (const char*)g.A + (size_t)cur.pm * tstepA; const char* cB = (const char*)g.Bt + (size_t)cur.pn * tstepB;
    S.a_ready(cur);
    PG8_STAGE(PG8_SB(0, 0), cB, voffB); PG8_STAGE(PG8_SB(0, 1), cB + hstepB, voffB); PG8_STAGE(PG8_SA(0, 0), cA, voffA); PG8_STAGE(PG8_SA(0, 1), cA + hstepA, voffA);
    if (wr == 1) PG8_BAR;
    PG8_WAIT_V(2); PG8_BAR;
    PG8_STAGE(PG8_SB(1, 0), cB + kstep, voffB); PG8_STAGE(PG8_SA(1, 0), cA + kstep, voffA); PG8_STAGE(PG8_SB(1, 1), cB + hstepB + kstep, voffB);
    PG8_WAIT_V(6); PG8_BAR;
    for (;;) {
        const bool has_next = S.next(ui + 1, nxt);
        const char* nA = has_next ? (const char*)g.A + (size_t)nxt.pm * tstepA : cA; const char* nB = has_next ? (const char*)g.Bt + (size_t)nxt.pn * tstepB : cB;
#pragma unroll 1
        for (int t = 0; t < nt; t += 2) {
            const bool last = (t == nt - 2);
            const char* a1 = cA + (size_t)(t + 1) * kstep;
            const char* a2 = last ? nA : cA + (size_t)(t + 2) * kstep; const char* b2 = last ? nB : cB + (size_t)(t + 2) * kstep;
            const char* a3 = a2 + kstep; const char* b3 = b2 + kstep;
            if (last && has_next) S.a_ready(nxt);
            PG8_LDB(B0, 0, 0); PG8_LDB(B1, 0, 1); PG8_SCHED; PG8_LDA(At, 0, 0); PG8_STAGE(PG8_SA(1, 1), a1 + hstepA, voffA);
            PG8_WAIT_V(8); PG8_WAIT_L(0); PG8_BAR; PG8_MMA(0, 0, At, B0); PG8_MMA(0, 1, At, B1); PG8_BAR; PG8_SCHED;
            PG8_LDA(At, 0, 1); PG8_STAGE(PG8_SB(0, 0), b2, voffB); PG8_STAGE(PG8_SB(0, 1), b2 + hstepB, voffB); PG8_STAGE(PG8_SA(0, 0), a2, voffA);
            PG8_WAIT_V(8); PG8_WAIT_L(0); PG8_BAR; PG8_MMA(1, 0, At, B0); PG8_MMA(1, 1, At, B1); PG8_BAR; PG8_SCHED;
            PG8_LDB(B0, 1, 0); PG8_LDB(B1, 1, 1); PG8_SCHED; PG8_LDA(At, 1, 0); PG8_STAGE(PG8_SA(0, 1), a2 + hstepA, voffA);
            PG8_WAIT_V(8); PG8_WAIT_L(0); PG8_BAR; PG8_MMA(0, 0, At, B0); PG8_MMA(0, 1, At, B1); PG8_BAR; PG8_SCHED;
            PG8_LDA(At, 1, 1); PG8_STAGE(PG8_SB(1, 0), b3, voffB); PG8_STAGE(PG8_SB(1, 1), b3 + hstepB, voffB); PG8_STAGE(PG8_SA(1, 0), a3, voffA);
            PG8_WAIT_V(8); PG8_WAIT_L(0); PG8_BAR; PG8_MMA(1, 0, At, B0); PG8_MMA(1, 1, At, B1); PG8_BAR; PG8_SCHED;
        }
        if (wr == 0) PG8_BAR;
        E(acc, cur, wr, wc, fr, fq); S.done(cur);
        if (!has_next) break;
#pragma unroll
        for (int a = 0; a < 2; ++a)
#pragma unroll
            for (int b = 0; b < 2; ++b)
#pragma unroll
                for (int m = 0; m < 4; ++m)
#pragma unroll
                    for (int n = 0; n < 2; ++n) acc[a][b][m][n] = (f32x4){0.f, 0.f, 0.f, 0.f};
        cur = nxt; cA = nA; cB = nB; ++ui;
        if (wr == 1) PG8_BAR;
    }
    PG8_WAIT_V(0);
    PG8_BAR;
#undef PG8_SA
#undef PG8_SB
#undef PG8_STAGE
#undef PG8_LDA
#undef PG8_LDB
#undef PG8_MMA
#undef PG8_WAIT_V
#undef PG8_WAIT_L
#undef PG8_BAR
#undef PG8_SCHED
}
}
namespace at {
using bf16 = unsigned short;
using bf16x8 = __attribute__((ext_vector_type(8))) short;
using s16x4  = __attribute__((ext_vector_type(4))) short;
using f32x16 = __attribute__((ext_vector_type(16))) float;
using u32x4  = __attribute__((ext_vector_type(4))) unsigned;
constexpr int DQK = 192, DV = 128, KVBLK = 64, NW = 8, QBLK = 32;
constexpr float SCALE = 0.07216878364870322f;
constexpr float THR = 8.f;
constexpr int LDQ = 1536, LDK = 2560, LDO = 2048;
constexpr int SHM_V = KVBLK * DV * 2, SHM_K = 12 * 2080;
constexpr int QR_OFF = 2 * SHM_V + 2 * SHM_K + NW * 64 * 4;
constexpr int SHM_ATTN = QR_OFF + NW * 4096;
#define SBAR() __builtin_amdgcn_sched_barrier(0)
constexpr int KPL = 2080;
__host__ __device__ __forceinline__ int k_st(int row, int c) { return (c >> 1) * KPL + row * 32 + (((c & 1) ^ ((row >> 3) & 1)) << 4); }
__host__ __device__ __forceinline__ int k_rd_base(int r32, int hi) { return r32 * 32 + ((hi ^ ((r32 >> 3) & 1)) << 4); }
__device__ __forceinline__ int crow(int r, int hi) { return (r & 3) + 8 * (r >> 2) + 4 * hi; }
__device__ __forceinline__ unsigned cvtpk(float lo, float hi) { unsigned r; asm volatile("v_cvt_pk_bf16_f32 %0, %1, %2" : "=v"(r) : "v"(lo), "v"(hi)); return r; }

__device__ __forceinline__ void partialSM(f32x16& p0, f32x16& p1, float& m_reg, float& mn, float& alpha) {
  constexpr float C = SCALE * 1.4426950408889634f;
  float pmax = p0[0];
#pragma unroll
  for (int r = 1; r < 16; ++r) pmax = fmaxf(pmax, p0[r]);
#pragma unroll
  for (int r = 0; r < 16; ++r) pmax = fmaxf(pmax, p1[r]);
  { auto rr = __builtin_amdgcn_permlane32_swap(__float_as_uint(pmax), __float_as_uint(pmax), false, false);
    pmax = fmaxf(__uint_as_float(rr[0]), __uint_as_float(rr[1])); }
  if (__builtin_expect(__all(pmax - m_reg <= THR / SCALE), 1)) { mn = m_reg; alpha = 1.f; }
  else { mn = fmaxf(m_reg, pmax); alpha = __builtin_amdgcn_exp2f((m_reg - mn) * C); m_reg = mn; }
  float mnC = -mn * C;
#pragma unroll
  for (int r = 0; r < 16; ++r) p0[r] = fmaf(p0[r], C, mnC);
#pragma unroll
  for (int r = 0; r < 16; ++r) p1[r] = fmaf(p1[r], C, mnC);
#pragma unroll
  for (int r = 0; r < 16; ++r) p0[r] = __builtin_amdgcn_exp2f(p0[r]);
}
__device__ __forceinline__ void finishSM(f32x16& p0, f32x16& p1, float alpha, float& l_reg, bf16x8& pa0, bf16x8& pa1, bf16x8& pa2, bf16x8& pa3) {
#pragma unroll
  for (int r = 0; r < 16; ++r) p1[r] = __builtin_amdgcn_exp2f(p1[r]);
  float ps = 0;
#pragma unroll
  for (int r = 0; r < 16; ++r) ps += p0[r];
#pragma unroll
  for (int r = 0; r < 16; ++r) ps += p1[r];
  { auto rr = __builtin_amdgcn_permlane32_swap(__float_as_uint(ps), __float_as_uint(ps), false, false);
    ps = __uint_as_float(rr[0]) + __uint_as_float(rr[1]); }
  l_reg = l_reg * alpha + ps;
#define PK4(P, BASE, OUT) do { unsigned a0 = cvtpk(P[BASE + 0], P[BASE + 1]), a1 = cvtpk(P[BASE + 2], P[BASE + 3]);   \
    unsigned b0 = cvtpk(P[BASE + 4], P[BASE + 5]), b1 = cvtpk(P[BASE + 6], P[BASE + 7]);                              \
    auto r0 = __builtin_amdgcn_permlane32_swap(a0, b0, false, false); auto r1 = __builtin_amdgcn_permlane32_swap(a1, b1, false, false); \
    u32x4 w = {r0[0], r1[0], r0[1], r1[1]}; OUT = *reinterpret_cast<bf16x8*>(&w); } while (0)
  PK4(p0, 0, pa0); PK4(p0, 8, pa1); PK4(p1, 0, pa2); PK4(p1, 8, pa3);
#undef PK4
}
template <int OFF> __device__ __forceinline__ bf16x8 k_read(int kb) {
  bf16x8 r; asm volatile("ds_read_b128 %0, %1 offset:%2" : "=v"(r) : "v"(kb), "i"(OFF) : "memory"); return r;
}
__device__ __forceinline__ void qkt(f32x16& p0, f32x16& p1, int kb, const bf16x8* qr, int qb) {
  p0 = f32x16{}; p1 = f32x16{};
#define QK1(d0) { const bf16x8 b0 = *(const __attribute__((address_space(3))) bf16x8*)(kb + d0 * KPL), b1 = *(const __attribute__((address_space(3))) bf16x8*)(kb + d0 * KPL + 1024); \
    p0 = __builtin_amdgcn_mfma_f32_32x32x16_bf16(b0, qr[d0], p0, 0, 0, 0); p1 = __builtin_amdgcn_mfma_f32_32x32x16_bf16(b1, qr[d0], p1, 0, 0, 0); }
#define QK2(d0) { const bf16x8 b0 = *(const __attribute__((address_space(3))) bf16x8*)(kb + d0 * KPL), b1 = *(const __attribute__((address_space(3))) bf16x8*)(kb + d0 * KPL + 1024); \
    const bf16x8 qf = *(const __attribute__((address_space(3))) bf16x8*)(qb + (d0 - 8) * 1024); \
    p0 = __builtin_amdgcn_mfma_f32_32x32x16_bf16(b0, qf, p0, 0, 0, 0); p1 = __builtin_amdgcn_mfma_f32_32x32x16_bf16(b1, qf, p1, 0, 0, 0); }
  QK1(0) QK1(1) QK1(2) QK1(3) QK1(4) QK1(5) QK1(6) QK1(7) QK2(8) QK2(9) QK2(10) QK2(11)
#undef QK1
#undef QK2
}
__host__ __device__ __forceinline__ int v_st(int k, int c) { const int kk = (k & ~0xC) | ((k & 4) << 1) | ((k & 8) >> 1); return ((kk >> 3) * 4 + (c >> 5)) * 512 + ((kk & 7) * 32 + (c & 31)) * 2; }
__device__ __forceinline__ int v_rd_base(int lane) { return ((lane & 3) << 3) | (((lane >> 2) & 3) << 6) | (((lane >> 4) & 1) << 5) | (((lane >> 5) & 1) << 8); }
constexpr int v_rd_off(int d0, int ks, int half) { return d0 * 512 + ks * 4096 + half * 2048; }
template <int OFF> __device__ __forceinline__ s16x4 tr_read(int vb) {
  s16x4 r; asm volatile("ds_read_b64_tr_b16 %0, %1 offset:%2" : "=&v"(r) : "v"(vb), "i"(OFF) : "memory"); return r;
}
template <int D0> __device__ __forceinline__ void pv_one(f32x16& od, int vb, bf16x8 pa0, bf16x8 pa1, bf16x8 pa2, bf16x8 pa3) {
  const s16x4 l0 = tr_read<v_rd_off(D0, 0, 0)>(vb), h0 = tr_read<v_rd_off(D0, 0, 1)>(vb), l1 = tr_read<v_rd_off(D0, 1, 0)>(vb), h1 = tr_read<v_rd_off(D0, 1, 1)>(vb);
  const s16x4 l2 = tr_read<v_rd_off(D0, 2, 0)>(vb), h2 = tr_read<v_rd_off(D0, 2, 1)>(vb), l3 = tr_read<v_rd_off(D0, 3, 0)>(vb), h3 = tr_read<v_rd_off(D0, 3, 1)>(vb);
  asm volatile("s_waitcnt lgkmcnt(0)" ::: "memory"); SBAR();
#define PK(L, H) (bf16x8){L[0], L[1], L[2], L[3], H[0], H[1], H[2], H[3]}
  od = __builtin_amdgcn_mfma_f32_32x32x16_bf16(pa0, PK(l0, h0), od, 0, 0, 0);
  od = __builtin_amdgcn_mfma_f32_32x32x16_bf16(pa1, PK(l1, h1), od, 0, 0, 0);
  od = __builtin_amdgcn_mfma_f32_32x32x16_bf16(pa2, PK(l2, h2), od, 0, 0, 0);
  od = __builtin_amdgcn_mfma_f32_32x32x16_bf16(pa3, PK(l3, h3), od, 0, 0, 0);
#undef PK
}
__device__ __forceinline__ void pv_d0(f32x16* o, int vb, bf16x8 pa0, bf16x8 pa1, bf16x8 pa2, bf16x8 pa3) {
  pv_one<0>(o[0], vb, pa0, pa1, pa2, pa3); pv_one<1>(o[1], vb, pa0, pa1, pa2, pa3); pv_one<2>(o[2], vb, pa0, pa1, pa2, pa3); pv_one<3>(o[3], vb, pa0, pa1, pa2, pa3);
}

__device__ __forceinline__ void attn_unit(const bf16* __restrict__ Qb, const bf16* __restrict__ Kh, const bf16* __restrict__ Vh, bf16* __restrict__ Ob, int seq, char* lds) {
  const int tid = opq(threadIdx.x), wid = tid >> 6, lane = tid & 63, r32 = lane & 31, hi = lane >> 5;
  char* V_lds = lds; char* K_lds = lds + 2 * SHM_V;
  float* ws = (float*)(lds + 2 * SHM_V + 2 * SHM_K) + wid * 64; float* li_l = ws; float* al_l = ws + 32;
  float m_reg = -1e30f, l_reg = 0; f32x16 o[4] = {}; bf16x8 qr[8];
  const bf16* Qw = Qb + (unsigned)((wid * QBLK + r32) * LDQ + hi * 8);
#pragma unroll
  for (int d0 = 0; d0 < 8; ++d0) qr[d0] = *reinterpret_cast<const bf16x8*>(Qw + d0 * 16);
  const int qb0 = (int)(uintptr_t)lds + QR_OFF + wid * 4096 + k_rd_base(r32, hi);
#pragma unroll
  for (int d0 = 8; d0 < 12; ++d0) *(__attribute__((address_space(3))) bf16x8*)(qb0 + (d0 - 8) * 1024) = *reinterpret_cast<const bf16x8*>(Qw + d0 * 16);
  const int sr = tid >> 4, sc = (tid & 15) * 8, vst0 = v_st(sr, sc), vst1 = v_st(32 + sr, sc);
  unsigned koff[3]; int kst[3];
#pragma unroll
  for (int i = 0; i < 3; ++i) { const int q = tid + 512 * i; koff[i] = (unsigned)((q / 24) * LDK + (q % 24) * 8); kst[i] = k_st(q / 24, q % 24); }
  const unsigned voff0 = (unsigned)(sr * LDK + sc), voff1 = (unsigned)((32 + sr) * LDK + sc);
  const int vb0 = (int)(uintptr_t)V_lds + v_rd_base(lane); const int kb0 = (int)(uintptr_t)K_lds + k_rd_base(r32, hi);
  struct { bf16x8 vs0, vs1, ks0, ks1, ks2; } sr_[1];
#define SLOAD(i, k0) do { const bf16* vt = Vh + (size_t)(k0) * LDK; const bf16* kt = Kh + (size_t)(k0) * LDK; \
    sr_[i].vs0 = *(const bf16x8*)(vt + voff0); sr_[i].vs1 = *(const bf16x8*)(vt + voff1); \
    sr_[i].ks0 = *(const bf16x8*)(kt + koff[0]); sr_[i].ks1 = *(const bf16x8*)(kt + koff[1]); sr_[i].ks2 = *(const bf16x8*)(kt + koff[2]); } while (0)
#define SWRITE(b, i) do { *(bf16x8*)(V_lds + (b) * SHM_V + vst0) = sr_[i].vs0; *(bf16x8*)(V_lds + (b) * SHM_V + vst1) = sr_[i].vs1; \
    *(bf16x8*)(K_lds + (b) * SHM_K + kst[0]) = sr_[i].ks0; *(bf16x8*)(K_lds + (b) * SHM_K + kst[1]) = sr_[i].ks1; *(bf16x8*)(K_lds + (b) * SHM_K + kst[2]) = sr_[i].ks2; } while (0)
#define SWAIT() do { if constexpr (SDEPTH == 2) asm volatile("s_waitcnt vmcnt(5)" ::: "memory"); else asm volatile("s_waitcnt vmcnt(0)" ::: "memory"); } while (0)
#define RESC(a) do { if (__any((a) < 1.f)) { if (hi == 0) al_l[r32] = (a); asm volatile("s_waitcnt lgkmcnt(0)" ::: "memory"); \
    _Pragma("unroll") for (int d = 0; d < 4; ++d) _Pragma("unroll") for (int r = 0; r < 16; ++r) o[d][r] *= al_l[crow(r, hi)]; } } while (0)
  f32x16 pA0, pA1, pB0, pB1; float mnA, mnB, alA, alB; bf16x8 pa0, pa1, pa2, pa3; const int NT = seq / KVBLK;
  SLOAD(0, 0); asm volatile("s_waitcnt vmcnt(0)" ::: "memory"); SWRITE(0, 0); __syncthreads();
  qkt(pA0, pA1, kb0, qr, qb0); partialSM(pA0, pA1, m_reg, mnA, alA);
  SLOAD(0, KVBLK);
  asm volatile("s_waitcnt vmcnt(0)" ::: "memory"); SWRITE(1, 0); __syncthreads();
  for (int j = 1; j + 1 < NT; j += 2) {
    SBAR(); qkt(pB0, pB1, kb0 + SHM_K, qr, qb0);
    finishSM(pA0, pA1, alA, l_reg, pa0, pa1, pa2, pa3); SBAR();
    SLOAD(0, (j + 1) * KVBLK); SBAR();
    pv_d0(o, vb0, pa0, pa1, pa2, pa3); partialSM(pB0, pB1, m_reg, mnB, alB);
    __syncthreads(); asm volatile("s_waitcnt vmcnt(0)" ::: "memory"); SWRITE(0, 0);
    RESC(alB); __syncthreads();
    SBAR(); qkt(pA0, pA1, kb0, qr, qb0);
    finishSM(pB0, pB1, alB, l_reg, pa0, pa1, pa2, pa3); SBAR();
    SLOAD(0, (j + 2) * KVBLK); SBAR();
    pv_d0(o, vb0 + (int)SHM_V, pa0, pa1, pa2, pa3); partialSM(pA0, pA1, m_reg, mnA, alA);
    __syncthreads(); asm volatile("s_waitcnt vmcnt(0)" ::: "memory"); SWRITE(1, 0);
    RESC(alA); __syncthreads();
  }
  SBAR(); qkt(pB0, pB1, kb0 + SHM_K, qr, qb0);
  finishSM(pA0, pA1, alA, l_reg, pa0, pa1, pa2, pa3); SBAR();
  pv_d0(o, vb0, pa0, pa1, pa2, pa3); partialSM(pB0, pB1, m_reg, mnB, alB);
  __syncthreads(); RESC(alB);
  finishSM(pB0, pB1, alB, l_reg, pa0, pa1, pa2, pa3); SBAR();
  pv_d0(o, vb0 + (int)SHM_V, pa0, pa1, pa2, pa3);
  if (hi == 0) li_l[r32] = l_reg; asm volatile("s_waitcnt lgkmcnt(0)" ::: "memory");
  bf16* Ow = Ob + (unsigned)(wid * QBLK * LDO + r32);
#pragma unroll
  for (int r = 0; r < 16; ++r) { const int orow = crow(r, hi); const float rl = __builtin_amdgcn_rcpf(li_l[orow]);
#pragma unroll
    for (int d0 = 0; d0 < 4; ++d0) { const unsigned w = cvtpk(o[d0][r] * rl, 0.f); Ow[(unsigned)(orow * LDO + d0 * 32)] = (bf16)(w & 0xffffu); } }
  __syncthreads();
#undef SLOAD
#undef SWRITE
#undef SWAIT
#undef RESC
}
}
namespace hy {
#define HY_LAS __attribute__((address_space(3)))
typedef unsigned short bf16;
typedef short bf16x8 __attribute__((ext_vector_type(8)));
typedef float f32x16 __attribute__((ext_vector_type(16)));
typedef unsigned u32x2 __attribute__((ext_vector_type(2)));
typedef unsigned u32x4 __attribute__((ext_vector_type(4)));
constexpr int L = 2048, NB = 24, CH = 512;
constexpr int RFS = 4112;
constexpr int ZROW = 4112;
constexpr int ZL_BYTES = NB * ZROW;
constexpr int RCS = 8256;
constexpr int RC_OFF = ZL_BYTES;
constexpr int HY_LDS_BYTES = RC_OFF + 4 * RCS;
__device__ __forceinline__ unsigned cvtpk(float lo, float hi) { unsigned r; asm volatile("v_cvt_pk_bf16_f32 %0, %1, %2" : "=v"(r) : "v"(lo), "v"(hi)); return r; }
__host__ __device__ __forceinline__ int frag_base(int tw, int r, int h) { const int a = (4 - (r & 3)) & 3; return RC_OFF + a * RCS + 2 * (2048 - tw - r + 8 * h - a); }
__host__ __device__ __forceinline__ int zfrag_base(int r, int h) { return (r < NB ? r : NB - 1) * ZROW + 16 * h; }

__device__ __forceinline__ bf16x8 ld_frag(HY_LAS unsigned char* lds, int off) {
    const u32x2 lo = *(const HY_LAS u32x2*)(lds + off), hi = *(const HY_LAS u32x2*)(lds + off + 8);
    u32x4 w = {lo.x, lo.y, hi.x, hi.y}; return *reinterpret_cast<bf16x8*>(&w);
}
__device__ __forceinline__ bf16x8 ld_b128(HY_LAS unsigned char* lds, int off) { return *(const HY_LAS bf16x8*)(lds + off); }

__device__ __forceinline__ void conv_unit(HY_LAS unsigned char* lds, const bf16* __restrict__ ZT, const bf16* __restrict__ RF, bf16* __restrict__ YC, int c, int half) {
    const int tid = opq(threadIdx.x), wid = tid >> 6, lane = tid & 63, r = lane & 31, h = lane >> 5;
    { const u32x4* src = (const u32x4*)(ZT + (size_t)c * NB * L);
#pragma unroll
      for (int i = 0; i < 12; ++i) { const int q = tid + 512 * i; const u32x4 v = src[q]; *(HY_LAS u32x4*)(lds + (q >> 8) * ZROW + (q & 255) * 16) = v; } }
    { const bf16* rf = RF + (size_t)c * RFS;
      for (int ch = tid; ch < RFS / 8; ch += 512) {
          const u32x4 v = *(const u32x4*)(rf + ch * 8); const unsigned w[4] = {v.x, v.y, v.z, v.w};
#pragma unroll
          for (int j = 0; j < 8; ++j) { const unsigned short e = (unsigned short)((w[j >> 1] >> ((j & 1) * 16)) & 0xffffu); const int idx = ch * 8 + j;
#pragma unroll
              for (int a = 0; a < 4; ++a) if (idx - a >= 0) *(HY_LAS unsigned short*)(lds + RC_OFF + a * RCS + 2 * (idx - a)) = e; } } }
    __syncthreads();
    const int tw = half * 1024 + wid * 128;
    const int fb = frag_base(tw, r, h), zb = zfrag_base(r, h);
    f32x16 acc[4] = {};
    bf16x8 S0[2], S1[2], S2[2], S3[2], Bc[2], Bn[2];
#define HY_LDG(S, d) do { S[0] = ld_frag(lds, fb + 64 * (d)); S[1] = ld_frag(lds, fb + 64 * (d) + 32); } while (0)
#define HY_LDB(Bx, n) do { Bx[0] = ld_b128(lds, zb + 64 * (n)); Bx[1] = ld_b128(lds, zb + 64 * (n) + 32); } while (0)
#define HY_MM(i, S, Bx) do { acc[i] = __builtin_amdgcn_mfma_f32_32x32x16_bf16(S[0], Bx[0], acc[i], 0, 0, 0); acc[i] = __builtin_amdgcn_mfma_f32_32x32x16_bf16(S[1], Bx[1], acc[i], 0, 0, 0); } while (0)
#define HY_ITER(n, Sa, Sb, Sc, Sd, Bcur, Bnext) do { HY_LDG(Sa, (n)); if ((n) + 1 < 64) HY_LDB(Bnext, (n) + 1); \
        HY_MM(1, Sb, Bcur); HY_MM(2, Sc, Bcur); HY_MM(3, Sd, Bcur); HY_MM(0, Sa, Bcur); } while (0)
    HY_LDG(S3, -1); HY_LDG(S2, -2); HY_LDG(S1, -3); HY_LDB(Bc, 0);
    for (int n = 0; n < 64; n += 4) {
        HY_ITER(n, S0, S3, S2, S1, Bc, Bn);
        HY_ITER(n + 1, S1, S0, S3, S2, Bn, Bc);
        HY_ITER(n + 2, S2, S1, S0, S3, Bc, Bn);
        HY_ITER(n + 3, S3, S2, S1, S0, Bn, Bc);
    }
#undef HY_LDG
#undef HY_LDB
#undef HY_MM
#undef HY_ITER
    if (r < NB) { bf16* yp = YC + ((size_t)c * NB + r) * L + tw + 4 * h;
#pragma unroll
        for (int i = 0; i < 4; ++i)
#pragma unroll
            for (int q4 = 0; q4 < 4; ++q4) { u32x2 w; w.x = cvtpk(acc[i][4 * q4 + 0], acc[i][4 * q4 + 1]); w.y = cvtpk(acc[i][4 * q4 + 2], acc[i][4 * q4 + 3]);
                *(u32x2*)(yp + 32 * i + 8 * q4) = w; } }
    __syncthreads();
}
}
constexpr int NWAVES = 8;
#ifndef MK_ONE_LAUNCH
#define MK_ONE_LAUNCH 1
#endif
constexpr int DM = 2048, NSEQ = 24, SEQ = 2048, M = NSEQ * SEQ, MP = 8 * SEQ;
constexpr int DEPTH = 4;
constexpr int DIN = 2880, DINP = 3072;
constexpr int O_CQ = 512, O_CKV = 1024, O_KPE = 1280, O_HY = 1344;
constexpr int NH = 8, NQ = 1536, NKVP = 2560, KVHS = 320;
constexpr int DFF = 5632, NUP = 11264, HYC = 512;
constexpr float EPS = 1e-6f;
constexpr int NPH = 11;
constexpr size_t WS_CTL = 0, CTL_BYTES = 1u << 20;
constexpr size_t SZ_BTIN = (size_t)DINP * DM * 2, SZ_BTUQ = (size_t)NQ * 512 * 2, SZ_BTKV = (size_t)NKVP * 256 * 2, SZ_BTOUT = (size_t)DM * DM * 2, SZ_BTUP = (size_t)NUP * DM * 2, SZ_BTDN = (size_t)DM * DFF * 2;
constexpr size_t WS_BTIN = WS_CTL + CTL_BYTES, WS_BTUQ = WS_BTIN + SZ_BTIN, WS_BTKV = WS_BTUQ + SZ_BTUQ, WS_BTOUT = WS_BTKV + SZ_BTKV, WS_BTUP = WS_BTOUT + SZ_BTOUT, WS_BTDN = WS_BTUP + SZ_BTUP;
constexpr size_t WS_RF = WS_BTDN + SZ_BTDN, SZ_RF = (size_t)HYC * hy::RFS * 2;
constexpr size_t WS_H = WS_RF + SZ_RF, SZ_H = (size_t)M * DM * 2;
constexpr size_t WS_PROJ = WS_H + SZ_H, SZ_PROJ = (size_t)M * DINP * 2;
constexpr size_t WS_Q = WS_PROJ + SZ_PROJ, SZ_Q = (size_t)M * NQ * 2;
constexpr size_t WS_KV = WS_Q + SZ_Q, SZ_KV = (size_t)M * NKVP * 2;
constexpr size_t WS_ZT = WS_KV + SZ_KV, SZ_ZT = (size_t)HYC * NSEQ * SEQ * 2;
constexpr size_t WS_X0 = WS_ZT + SZ_ZT, WS_YC = WS_X0 + SZ_ZT;
constexpr size_t WS_EDGE = WS_YC + SZ_ZT, SZ_EDGE = (size_t)(M / 256) * 2 * 3 * DFF * 4;
constexpr size_t WS_ROPE = WS_EDGE + SZ_EDGE, SZ_ROPE = (size_t)SEQ * 64 * 4;
constexpr size_t WS_SSQP = WS_ROPE + SZ_ROPE, SZ_SSQP = (size_t)M * 32 * 4;
constexpr size_t WS_RSTD = WS_SSQP + SZ_SSQP, SZ_RSTD = (size_t)M * 4;
constexpr size_t WS_END = WS_RSTD + SZ_RSTD;
constexpr size_t WS_ACT = WS_PROJ;
static_assert((size_t)M * DFF * 2 <= SZ_PROJ + SZ_Q + SZ_KV, "ACT overlay");
constexpr size_t WS_XB2 = WS_ACT + (size_t)M * DFF * 2;
static_assert(WS_XB2 + (size_t)M * DM * 2 <= WS_EDGE && WS_XB2 % 256 == 0, "XB2 overlay");
static_assert(WS_BTIN % 256 == 0 && WS_RF % 256 == 0 && WS_H % 256 == 0 && WS_PROJ % 256 == 0 && WS_Q % 256 == 0 && WS_KV % 256 == 0 && WS_ZT % 256 == 0 && WS_EDGE % 256 == 0, "alignment");
constexpr int CW_BAR = 4096;
constexpr int RING_BYTES = 135168;
constexpr int HALO_OFF = RING_BYTES, HALO_BYTES = 4096;
constexpr int MISC_OFF = HALO_OFF + HALO_BYTES;
constexpr int LDS_BYTES = 147456;
static_assert(hy::HY_LDS_BYTES <= RING_BYTES && at::SHM_ATTN <= RING_BYTES && MISC_OFF + 256 <= LDS_BYTES, "LDS map");

#define GAS __attribute__((address_space(1)))
#define LAS __attribute__((address_space(3)))
typedef unsigned short bf16;
typedef unsigned v4u __attribute__((ext_vector_type(4)));
typedef unsigned v2u __attribute__((ext_vector_type(2)));
typedef float f32x4 __attribute__((ext_vector_type(4)));
#define LDS_WAIT() asm volatile("s_waitcnt lgkmcnt(0)" ::: "memory")
__device__ __forceinline__ unsigned f2bf(float f) { unsigned u = __builtin_bit_cast(unsigned, f); return (u + 0x7fffu + ((u >> 16) & 1u)) >> 16; }
__device__ __forceinline__ unsigned pk2(float lo, float hi) { return f2bf(lo) | (f2bf(hi) << 16); }
__device__ __forceinline__ float bf2f(unsigned short b) { return __builtin_bit_cast(float, (unsigned)b << 16); }
__device__ __forceinline__ float bflo(unsigned w) { return __builtin_bit_cast(float, w << 16); }
__device__ __forceinline__ float bfhi(unsigned w) { return __builtin_bit_cast(float, w & 0xffff0000u); }
__device__ __forceinline__ float wave_sum(float v) {
#pragma unroll
    for (int o = 1; o < 64; o <<= 1) v += __shfl_xor(v, o);
    return v;
}

#define XB_TMO      128
#define XB_XCNT(j)  (256  + 64 * (j))
#define XB_XSUB(j)  (1280 + 64 * (j))
#define XB_XGEN(j)  (2304 + 64 * (j))
#define XB_TOP      3328
#define XB_TOPGEN   3392
#define XCD_BAR_WORDS 3456
#define XB_SPIN_CAP (1u << 18)
__device__ __forceinline__ unsigned xb_ld(unsigned* p)              { return __hip_atomic_load(p, __ATOMIC_RELAXED, __HIP_MEMORY_SCOPE_AGENT); }
__device__ __forceinline__ unsigned xb_add(unsigned* p, unsigned v) { return __hip_atomic_fetch_add(p, v, __ATOMIC_RELAXED, __HIP_MEMORY_SCOPE_AGENT); }
__device__ __forceinline__ unsigned xb_xcc_id() { return (unsigned)__builtin_amdgcn_s_getreg((3 << 11) | 20) & 0xFu; }
#define XB_SPIN(cond, bar) do { unsigned _sp = 0; while (cond) { __builtin_amdgcn_s_sleep(1); \
    if ((++_sp & 255u) == 0u) { if (xb_ld(&(bar)[XB_TMO])) break; if (_sp > XB_SPIN_CAP) { atomicAdd(&(bar)[XB_TMO], 1u); break; } } } } while (0)
struct XcdBarrier { unsigned* bar; unsigned x; volatile LAS unsigned* st; };
__device__ __forceinline__ XcdBarrier xcd_barrier_post(unsigned* bar, volatile LAS unsigned* st) {
    XcdBarrier b; b.bar = bar; b.x = xb_xcc_id(); b.st = st;
    if (threadIdx.x == 0) (void)xb_add(&bar[XB_XCNT(b.x)], 1u);
    return b;
}
__device__ __forceinline__ void xcd_barrier_complete(unsigned* bar, unsigned x, unsigned& nloc, unsigned& nx) {
    const unsigned G = gridDim.x * gridDim.y * gridDim.z;
    unsigned sum, cnt, mine, sp = 0u;
    for (;;) {
        sum = 0u; cnt = 0u; mine = 0u;
#pragma unroll
        for (unsigned j = 0; j < 16; ++j) { const unsigned c = xb_ld(&bar[XB_XCNT(j)]); sum += c; cnt += (c > 0u) ? 1u : 0u; mine = (j == x) ? c : mine; }
        if (sum == G) break;
        __builtin_amdgcn_s_sleep(1);
        if ((++sp & 255u) == 0u) { if (xb_ld(&bar[XB_TMO])) break; if (sp > XB_SPIN_CAP) { atomicAdd(&bar[XB_TMO], 1u); break; } }
    }
    nloc = mine > 0u ? mine : 1u; nx = cnt > 0u ? cnt : 1u;
}
__device__ __forceinline__ void xcd_barrier(const XcdBarrier& b) {
    asm volatile("s_waitcnt vmcnt(0)" ::: "memory");
    __syncthreads();
    if (threadIdx.x == 0) {
        unsigned* bar = b.bar;
        __builtin_amdgcn_s_waitcnt(0);
        unsigned nloc = b.st[0], nx = b.st[1];
        if (nloc == 0u) { xcd_barrier_complete(bar, b.x, nloc, nx); b.st[0] = nloc; b.st[1] = nx; }
        const unsigned old = xb_add(&bar[XB_XSUB(b.x)], 1u);
        const unsigned gen = old / nloc;
        if (old + 1u == (gen + 1u) * nloc) {
            __builtin_amdgcn_fence(__ATOMIC_RELEASE, "agent");
            asm volatile("s_waitcnt vmcnt(0)" ::: "memory");
            const unsigned og = xb_add(&bar[XB_TOP], 1u);
            const unsigned tg = og / nx;
            if (og + 1u == (tg + 1u) * nx) xb_add(&bar[XB_TOPGEN], 1u);
            else XB_SPIN(xb_ld(&bar[XB_TOPGEN]) == tg, bar);
            __builtin_amdgcn_fence(__ATOMIC_ACQUIRE, "agent");
            xb_add(&bar[XB_XGEN(b.x)], 1u);
            asm volatile("s_waitcnt vmcnt(0)" ::: "memory");
        } else {
            XB_SPIN(xb_ld(&bar[XB_XGEN(b.x)]) == gen, bar);
            __builtin_amdgcn_fence(__ATOMIC_ACQUIRE, "agent");
            asm volatile("s_waitcnt vmcnt(0)" ::: "memory");
        }
    }
    __syncthreads();
}

struct Frame {
    LAS unsigned char* lds;
    int tid, lane, wave, vcu, G;
};
enum { I_XP = 0, I_XS, I_ANG, I_WIN, I_PW, I_PS, I_QNG, I_WUQ, I_KVNG, I_WUKV, I_QHG, I_KHG, I_HCW, I_HCB, I_FW1, I_FB1, I_FFR, I_FW2, I_FB2, I_FW3, I_FB3, I_HBIAS, I_GNG, I_WOUT, I_FNG, I_WUP, I_FCW, I_FCB, I_WDN, N_IN };
struct Args { const float* in[N_IN]; float* out; unsigned char* ws; int ph_lo, ph_hi; };
static_assert(sizeof(Args) == (N_IN + 2) * 8 + 8, "Args has no padding");

__device__ __forceinline__ void cvt_item(const float* __restrict__ W, int ldw, int K, bf16* WT, int dst_n0, int src_n0, int k0, const float* __restrict__ ks, LAS float* scr, int lane) {
#pragma unroll
    for (int i = 0; i < 32; ++i) { const int kk = 2 * i + (lane >> 5); float v = W[(size_t)(k0 + kk) * ldw + src_n0 + (lane & 31)]; if (ks) v *= ks[k0 + kk]; scr[kk * 33 + (lane & 31)] = v; }
    LDS_WAIT(); asm volatile("" ::: "memory");
    const int c = lane & 7;
#pragma unroll
    for (int j = 0; j < 4; ++j) { const int n = (lane >> 3) + 8 * j; const LAS float* s = scr + (8 * c) * 33 + n;
        v4u o; o.x = pk2(s[0 * 33], s[1 * 33]); o.y = pk2(s[2 * 33], s[3 * 33]); o.z = pk2(s[4 * 33], s[5 * 33]); o.w = pk2(s[6 * 33], s[7 * 33]);
        *(v4u*)(WT + (size_t)(dst_n0 + n) * K + k0 + 8 * c) = o; }
    LDS_WAIT(); asm volatile("" ::: "memory");
}
__device__ __forceinline__ void xb_row(const float* xrow, bf16* orow, float* rstd, int lane) {
    const f32x4* xr = (const f32x4*)xrow + lane;
    f32x4 v[8]; float s = 0.f;
#pragma unroll
    for (int j = 0; j < 8; ++j) { v[j] = xr[64 * j]; s += (v[j].x * v[j].x + v[j].y * v[j].y) + (v[j].z * v[j].z + v[j].w * v[j].w); }
    const float r = 1.0f / sqrtf(wave_sum(s) * (1.f / DM) + EPS);
    if (lane == 0) *rstd = r;
    v2u* o8 = (v2u*)orow + lane;
#pragma unroll
    for (int j = 0; j < 8; ++j) { v2u w; w.x = pk2(v[j].x, v[j].y); w.y = pk2(v[j].z, v[j].w); o8[64 * j] = w; }
}
__device__ __forceinline__ void rstd_from_partials(const float* __restrict__ ssqp, float* rstd, size_t gtid, size_t gthreads) {
    for (size_t r = gtid; r < (size_t)M; r += gthreads) { const f32x4* p = (const f32x4*)(ssqp + r * 32); f32x4 a = p[0];
#pragma unroll
        for (int i = 1; i < 8; ++i) a += p[i];
        rstd[r] = 1.0f / sqrtf(((a.x + a.y) + (a.z + a.w)) * (1.f / DM) + EPS); }
}
__device__ __forceinline__ void tile_norm_store(LAS float* tile, bf16* dst, int row0, int col_off, int wave, int lane) {
#pragma unroll
    for (int i = 0; i < 8; ++i) { const int t = wave * 8 + i;
        const f32x4 a = *(LAS f32x4*)(tile + t * 512 + 8 * lane), b = *(LAS f32x4*)(tile + t * 512 + 8 * lane + 4);
        const float s = (a.x * a.x + a.y * a.y) + (a.z * a.z + a.w * a.w) + (b.x * b.x + b.y * b.y) + (b.z * b.z + b.w * b.w);
        const float rstd = 1.0f / sqrtf(wave_sum(s) * (1.f / 512.f) + EPS);
        v4u o; o.x = pk2(a.x * rstd, a.y * rstd); o.y = pk2(a.z * rstd, a.w * rstd); o.z = pk2(b.x * rstd, b.y * rstd); o.w = pk2(b.z * rstd, b.w * rstd);
        *(v4u*)(dst + (size_t)(row0 + t) * DM + col_off + 8 * lane) = o; }
}
__device__ __forceinline__ void poolfold_item(Frame& F, const float* __restrict__ win, const float* __restrict__ pw, const float* __restrict__ ps, const float* __restrict__ g1, bf16* BtIn, int g, int kb) {
    LAS float* At = (LAS float*)F.lds; LAS float* Bt = (LAS float*)(F.lds + 32768);
    const int k0 = 64 * kb;
#pragma unroll
    for (int i = 0; i < 4; ++i) { const int q = F.tid + 512 * i, row = q >> 5, c4 = q & 31; *(LAS f32x4*)(At + row * 128 + 4 * c4) = *(const f32x4*)(win + (size_t)(k0 + row) * DIN + 128 * g + 4 * c4) * g1[k0 + row]; }
#pragma unroll
    for (int i = 0; i < 8; ++i) { const int q = F.tid + 512 * i, row = q >> 5, c4 = q & 31; *(LAS f32x4*)(Bt + row * 128 + 4 * c4) = *(const f32x4*)(pw + (size_t)(g * 128 + row) * 128 + 4 * c4); }
    __syncthreads();
    const int n = F.tid & 127, kg = F.tid >> 7;
    float acc[16];
#pragma unroll
    for (int i = 0; i < 16; ++i) acc[i] = 0.f;
    for (int j = 0; j < 128; j += 4) {
        const float b0 = Bt[(j + 0) * 128 + n], b1 = Bt[(j + 1) * 128 + n], b2 = Bt[(j + 2) * 128 + n], b3 = Bt[(j + 3) * 128 + n];
#pragma unroll
        for (int i = 0; i < 16; ++i) { const f32x4 a = *(LAS f32x4*)(At + (kg * 16 + i) * 128 + j); acc[i] += a.x * b0 + a.y * b1 + a.z * b2 + a.w * b3; }
    }
    const float sc = ps[128 * g + n];
    v4u o0, o1;
    o0.x = pk2(acc[0] * sc, acc[1] * sc); o0.y = pk2(acc[2] * sc, acc[3] * sc); o0.z = pk2(acc[4] * sc, acc[5] * sc); o0.w = pk2(acc[6] * sc, acc[7] * sc);
    o1.x = pk2(acc[8] * sc, acc[9] * sc); o1.y = pk2(acc[10] * sc, acc[11] * sc); o1.z = pk2(acc[12] * sc, acc[13] * sc); o1.w = pk2(acc[14] * sc, acc[15] * sc);
    bf16* dst = BtIn + (size_t)(128 * g + n) * DM + k0 + kg * 16;
    *(v4u*)dst = o0; *(v4u*)(dst + 8) = o1;
    __syncthreads();
}
__device__ __forceinline__ void filter_item(Frame& F, const float* __restrict__ w1, const float* __restrict__ b1, const float* __restrict__ fr, const float* __restrict__ w2, const float* __restrict__ b2,
                                            const float* __restrict__ w3, const float* __restrict__ b3, const float* __restrict__ hbias, bf16* RF, int fi) {
    LAS float* ZF = (LAS float*)F.lds; LAS float* H1 = ZF + 512; LAS float* H2 = ZF + 1536;
    const int t0 = 16 * fi;
    if (F.tid < 272) { const int tt = F.tid / 17, f = F.tid % 17; const float t = (float)(t0 + tt);
        float v;
        if (f == 0) v = t / 2047.0f;
        else { const int j = (f - 1) & 7; const float band = 1e-4f + (float)j * ((7.0f - 1e-4f) / 7.0f); const float w = (6.283185307179586f * t) / 2048.0f; const float a = band * w; v = (f <= 8) ? __cosf(a) : -__sinf(a); }
        ZF[tt * 17 + f] = v; }
    __syncthreads();
#pragma unroll
    for (int rep = 0; rep < 2; ++rep) { const int p = F.tid + 512 * rep, tt = p >> 6, j = p & 63; float s = b1[j];
        for (int i = 0; i < 17; ++i) s += ZF[tt * 17 + i] * w1[i * 64 + j];
        H1[tt * 64 + j] = __sinf(fr[j] * s); }
    __syncthreads();
#pragma unroll
    for (int rep = 0; rep < 2; ++rep) { const int p = F.tid + 512 * rep, tt = p >> 6, j = p & 63; float s = b2[j];
        for (int i = 0; i < 64; ++i) s += H1[tt * 64 + i] * w2[i * 64 + j];
        H2[tt * 64 + j] = __sinf(fr[j] * s); }
    __syncthreads();
    const int c = F.tid;
    const float delta = -3.0701134573253944f + (float)c * ((-15.350567286626972f + 3.0701134573253944f) / 511.0f);
    const float ad = fabsf(delta);
    bf16* rf = RF + (size_t)c * hy::RFS;
#pragma unroll 1
    for (int dir = 0; dir < 2; ++dir) { const int o = dir * 512 + c; const float bo = b3[o];
#pragma unroll 1
        for (int tt = 0; tt < 16; ++tt) { float s = bo;
#pragma unroll 16
            for (int i = 0; i < 64; ++i) s += H2[tt * 64 + i] * w3[i * 1024 + o];
            const int t = t0 + tt; const float tl = (float)t / 2047.0f; float val = s * __expf(-tl * ad);
            if (dir == 0) { if (t == 0) val += hbias[c]; rf[2048 - t] = (bf16)f2bf(val); }
            else if (t >= 1) rf[2048 + t] = (bf16)f2bf(val); } }
    if (fi == 0) { rf[0] = 0;
#pragma unroll
        for (int i = 4096; i < hy::RFS; ++i) rf[i] = 0; }
    __syncthreads();
}
__device__ __forceinline__ void unpack4(const v2u w, float (&x)[4]) { x[0] = bflo(w.x); x[1] = bfhi(w.x); x[2] = bflo(w.y); x[3] = bfhi(w.y); }
__device__ __forceinline__ void pair_norm_store(Frame& F, const float (&y)[8][4], bf16* dst, size_t row0, int col_off, int cq) {
    LAS float* part = (LAS float*)F.lds;
    float ss[8];
#pragma unroll
    for (int k = 0; k < 8; ++k) ss[k] = wave_sum((y[k][0] * y[k][0] + y[k][1] * y[k][1]) + (y[k][2] * y[k][2] + y[k][3] * y[k][3]));
    if (F.lane == 0) { *(LAS f32x4*)(part + F.wave * 8) = (f32x4){ss[0], ss[1], ss[2], ss[3]}; *(LAS f32x4*)(part + F.wave * 8 + 4) = (f32x4){ss[4], ss[5], ss[6], ss[7]}; }
    __syncthreads();
    const f32x4 pa = *(LAS f32x4*)(part + (F.wave ^ 1) * 8), pb = *(LAS f32x4*)(part + (F.wave ^ 1) * 8 + 4);
    const float po[8] = {pa.x, pa.y, pa.z, pa.w, pb.x, pb.y, pb.z, pb.w};
#pragma unroll
    for (int k = 0; k < 8; ++k) { const float rstd = 1.0f / sqrtf((ss[k] + po[k]) * (1.f / 512.f) + EPS);
        v2u o; o.x = pk2(y[k][0] * rstd, y[k][1] * rstd); o.y = pk2(y[k][2] * rstd, y[k][3] * rstd);
        *(v2u*)(dst + (row0 + k) * DM + col_off + 4 * cq) = o; }
    __syncthreads();
}
__device__ __forceinline__ void hyprep_item(Frame& F, const bf16* __restrict__ PROJ, const float* __restrict__ cw, const float* __restrict__ cb, bf16* ZT, bf16* X0, int b, int tile) {
    const int tb = F.tid >> 7, cq = F.tid & 127, c0 = 4 * cq, tw = tile * 32 + tb * 8; const size_t rb = (size_t)b * SEQ;
    float z[8][4];
#pragma unroll
    for (int jj = 0; jj < 3; ++jj) { const int j = (jj == 0) ? 1 : (jj == 1) ? 2 : 0; const int cc = 512 * j + c0;
        const f32x4 w0 = *(const f32x4*)(cw + cc), w1 = *(const f32x4*)(cw + 1536 + cc), w2 = *(const f32x4*)(cw + 3072 + cc), bs = *(const f32x4*)(cb + cc);
        float x[10][4];
#pragma unroll
        for (int o = 0; o < 10; ++o) { const int t = tw - 1 + o; const bool ok = (t >= 0) && (t < SEQ); const int tc = ok ? t : tw;
            const v2u w = *(const v2u*)(PROJ + (rb + tc) * DINP + O_HY + cc); unpack4(w, x[o]);
            if (!ok) { x[o][0] = 0.f; x[o][1] = 0.f; x[o][2] = 0.f; x[o][3] = 0.f; } }
        if (jj == 0) {
#pragma unroll
            for (int k = 0; k < 8; ++k)
#pragma unroll
                for (int i = 0; i < 4; ++i) z[k][i] = w0[i] * x[k][i] + w1[i] * x[k + 1][i] + w2[i] * x[k + 2][i] + bs[i];
        } else if (jj == 1) {
#pragma unroll
            for (int k = 0; k < 8; ++k)
#pragma unroll
                for (int i = 0; i < 4; ++i) z[k][i] *= w0[i] * x[k][i] + w1[i] * x[k + 1][i] + w2[i] * x[k + 2][i] + bs[i];
#pragma unroll
            for (int i = 0; i < 4; ++i) { v4u o; o.x = pk2(z[0][i], z[1][i]); o.y = pk2(z[2][i], z[3][i]); o.z = pk2(z[4][i], z[5][i]); o.w = pk2(z[6][i], z[7][i]);
                *(v4u*)(ZT + ((size_t)(c0 + i) * NSEQ + b) * SEQ + tw) = o; }
        } else {
#pragma unroll
            for (int k = 0; k < 8; ++k) { float u0[4];
#pragma unroll
                for (int i = 0; i < 4; ++i) u0[i] = w0[i] * x[k][i] + w1[i] * x[k + 1][i] + w2[i] * x[k + 2][i] + bs[i];
                v2u o; o.x = pk2(u0[0], u0[1]); o.y = pk2(u0[2], u0[3]); *(v2u*)(X0 + (rb + tw + k) * HYC + c0) = o; }
        }
    }
}
__device__ __forceinline__ void pool_item(Frame& F, const bf16* __restrict__ PROJ, bf16* MIXED, int b, int tile) {
    const int tb = F.tid >> 7, cq = F.tid & 127, c0 = 4 * cq, g = cq >> 5, half = 1 << g, tw = tile * 32 + tb * 8; const size_t rb = (size_t)b * SEQ;
    float x[23][4];
#pragma unroll
    for (int o = 0; o < 23; ++o) { const int t = tw - 8 + o; const bool ok = (t >= 0) && (t < SEQ); const int tc = ok ? t : tw;
        const v2u w = *(const v2u*)(PROJ + (rb + tc) * DINP + c0); unpack4(w, x[o]);
        if (!ok) { x[o][0] = 0.f; x[o][1] = 0.f; x[o][2] = 0.f; x[o][3] = 0.f; } }
    float y[8][4];
#pragma unroll
    for (int k = 0; k < 8; ++k) { const int oc = 8 + k, t = tw + k; const int lo = (t - half > 0) ? t - half : 0, hi = (t + half < SEQ) ? t + half : SEQ; const float inv = 1.0f / (float)(hi - lo);
#pragma unroll
        for (int i = 0; i < 4; ++i) {
            const float w1 = x[oc - 1][i] + x[oc][i];
            const float w2 = w1 + (x[oc - 2][i] + x[oc + 1][i]);
            const float w4 = w2 + ((x[oc - 4][i] + x[oc - 3][i]) + (x[oc + 2][i] + x[oc + 3][i]));
            const float w8 = w4 + (((x[oc - 8][i] + x[oc - 7][i]) + (x[oc - 6][i] + x[oc - 5][i])) + ((x[oc + 4][i] + x[oc + 5][i]) + (x[oc + 6][i] + x[oc + 7][i])));
            const float S = (g == 0) ? w1 : (g == 1) ? w2 : (g == 2) ? w4 : w8;
            y[k][i] = S * inv - x[oc][i]; } }
    pair_norm_store(F, y, MIXED, rb + tw, 0, cq);
}
__device__ __forceinline__ void hyfin_item(Frame& F, const bf16* __restrict__ YC, const bf16* __restrict__ X0, bf16* MIXED, int b, int tile) {
    const int tb = F.tid >> 7, cq = F.tid & 127, c0 = 4 * cq, tw = tile * 32 + tb * 8; const size_t rb = (size_t)b * SEQ;
    float yc[4][8], y[8][4];
#pragma unroll
    for (int i = 0; i < 4; ++i) { const v4u v = *(const v4u*)(YC + ((size_t)(c0 + i) * NSEQ + b) * SEQ + tw);
        yc[i][0] = bflo(v.x); yc[i][1] = bfhi(v.x); yc[i][2] = bflo(v.y); yc[i][3] = bfhi(v.y); yc[i][4] = bflo(v.z); yc[i][5] = bfhi(v.z); yc[i][6] = bflo(v.w); yc[i][7] = bfhi(v.w); }
#pragma unroll
    for (int k = 0; k < 8; ++k) { float xv[4]; unpack4(*(const v2u*)(X0 + (rb + tw + k) * HYC + c0), xv);
#pragma unroll
        for (int i = 0; i < 4; ++i) y[k][i] = yc[i][k] * xv[i]; }
    pair_norm_store(F, y, MIXED, rb + tw, 1536, cq);
}
struct PrepGains { float q[3][8], k[3][8]; };
__device__ __forceinline__ void load8(const float* p, float (&o)[8]) { const f32x4 a = *(const f32x4*)p, b = *(const f32x4*)(p + 4); o[0] = a.x; o[1] = a.y; o[2] = a.z; o[3] = a.w; o[4] = b.x; o[5] = b.y; o[6] = b.z; o[7] = b.w; }
__device__ __forceinline__ void unpack8(const v4u w, float (&x)[8]) { x[0] = bflo(w.x); x[1] = bfhi(w.x); x[2] = bflo(w.y); x[3] = bfhi(w.y); x[4] = bflo(w.z); x[5] = bfhi(w.z); x[6] = bflo(w.w); x[7] = bfhi(w.w); }
__device__ __forceinline__ v4u pack8(const float (&x)[8]) { v4u o; o.x = pk2(x[0], x[1]); o.y = pk2(x[2], x[3]); o.z = pk2(x[4], x[5]); o.w = pk2(x[6], x[7]); return o; }
__device__ __forceinline__ float ssq8(const float (&x)[8]) { return ((x[0] * x[0] + x[1] * x[1]) + (x[2] * x[2] + x[3] * x[3])) + ((x[4] * x[4] + x[5] * x[5]) + (x[6] * x[6] + x[7] * x[7])); }
__device__ __forceinline__ float sum8lanes(float v) { v += __shfl_xor(v, 1); v += __shfl_xor(v, 2); v += __shfl_xor(v, 4); return v; }
__device__ __forceinline__ void prep_row(const bf16* __restrict__ PROJ, bf16* Q, bf16* KV, const PrepGains& G, const float* __restrict__ ROPE, int m, int lane) {
    const int h = lane >> 3, sub = lane & 7;
    const bf16* pr = PROJ + (size_t)m * DINP; bf16* qr = Q + (size_t)m * NQ + 192 * h + 8 * sub; bf16* kr = KV + (size_t)m * NKVP + KVHS * h + 8 * sub;
    const v4u cqv = *(const v4u*)(pr + O_CQ + 8 * lane); const v4u ckv = *(const v4u*)(pr + O_CKV + 8 * (lane & 31)); const v4u pev = *(const v4u*)(pr + O_KPE + 8 * sub);
    const v4u q0 = *(const v4u*)(qr), q1 = *(const v4u*)(qr + 64), q2 = *(const v4u*)(qr + 128);
    const v4u k0 = *(const v4u*)(kr), k1 = *(const v4u*)(kr + 64), v0 = *(const v4u*)(kr + 192), v1 = *(const v4u*)(kr + 256);
    float cs[8], sn[8]; { const float* rp = ROPE + (size_t)(m & (SEQ - 1)) * 64 + 8 * (sub & 3); load8(rp, cs); load8(rp + 32, sn); }
    float t[8];
    unpack8(cqv, t); const float rq = 1.0f / sqrtf(wave_sum(ssq8(t)) * (1.f / 512.f) + EPS);
    unpack8(ckv, t); const float rkv = 1.0f / sqrtf(wave_sum(lane < 32 ? ssq8(t) : 0.f) * (1.f / 256.f) + EPS);
    const float sg = (sub < 4) ? -1.f : 1.f;
    { float a0[8], a1[8], a2[8]; unpack8(q0, a0); unpack8(q1, a1); unpack8(q2, a2);
      const float ss = sum8lanes(ssq8(a0) + ssq8(a1) + ssq8(a2)) * (rq * rq);
      const float sc = rq / sqrtf(ss * (1.f / 192.f) + EPS);
      float r[8], o[8];
#pragma unroll
      for (int i = 0; i < 8; ++i) { a0[i] *= sc * G.q[0][i]; a1[i] *= sc * G.q[1][i]; r[i] = a2[i] * sc * G.q[2][i]; }
#pragma unroll
      for (int i = 0; i < 8; ++i) { const float rp = __shfl_xor(r[i], 4); o[i] = r[i] * cs[i] + sg * rp * sn[i]; }
      *(v4u*)(qr) = pack8(a0); *(v4u*)(qr + 64) = pack8(a1); *(v4u*)(qr + 128) = pack8(o); }
    { float a0[8], a1[8], pe[8], b0[8], b1[8]; unpack8(k0, a0); unpack8(k1, a1); unpack8(pev, pe); unpack8(v0, b0); unpack8(v1, b1);
      const float ss = sum8lanes((ssq8(a0) + ssq8(a1)) * (rkv * rkv) + ssq8(pe));
      const float sk = 1.0f / sqrtf(ss * (1.f / 192.f) + EPS);
      float r[8], o[8];
#pragma unroll
      for (int i = 0; i < 8; ++i) { a0[i] *= rkv * sk * G.k[0][i]; a1[i] *= rkv * sk * G.k[1][i]; r[i] = pe[i] * sk * G.k[2][i]; b0[i] *= rkv; b1[i] *= rkv; }
#pragma unroll
      for (int i = 0; i < 8; ++i) { const float rp = __shfl_xor(r[i], 4); o[i] = r[i] * cs[i] + sg * rp * sn[i]; }
      *(v4u*)(kr) = pack8(a0); *(v4u*)(kr + 64) = pack8(a1); *(v4u*)(kr + 128) = pack8(o); *(v4u*)(kr + 192) = pack8(b0); *(v4u*)(kr + 256) = pack8(b1); }
}
__device__ __forceinline__ void attn_norm_row(bf16* MIXED, int m, int lane) {
    v4u* p = (v4u*)(MIXED + (size_t)m * DM + 512 + 16 * lane); v4u a = p[0], b = p[1];
    unsigned w[8] = {a.x, a.y, a.z, a.w, b.x, b.y, b.z, b.w}; float s = 0.f;
#pragma unroll
    for (int i = 0; i < 8; ++i) { const float x = bflo(w[i]), y = bfhi(w[i]); s += x * x + y * y; }
    const float rstd = 1.0f / sqrtf(wave_sum(s) * (1.f / 1024.f) + EPS);
#pragma unroll
    for (int i = 0; i < 8; ++i) w[i] = pk2(bflo(w[i]) * rstd, bfhi(w[i]) * rstd);
    a.x = w[0]; a.y = w[1]; a.z = w[2]; a.w = w[3]; b.x = w[4]; b.y = w[5]; b.z = w[6]; b.w = w[7]; p[0] = a; p[1] = b;
}

__global__ void __launch_bounds__(NWAVES * 64, 2) fwd(Args args) {
    extern __shared__ __attribute__((aligned(16))) unsigned char lds_raw[];
    Frame F;
    F.lds = (LAS unsigned char*)lds_raw;
    F.tid = threadIdx.x; F.lane = F.tid & 63; F.wave = __builtin_amdgcn_readfirstlane(F.tid >> 6);
    F.G = gridDim.x; { const int bx = blockIdx.x; F.vcu = (F.G % 8 == 0) ? (bx % 8) * (F.G / 8) + bx / 8 : bx; }
    volatile LAS unsigned* MISC = (volatile LAS unsigned*)(F.lds + MISC_OFF);
    if (F.tid < 64) MISC[F.tid] = 0u;
    __syncthreads();
    unsigned char* ws = args.ws;
    unsigned* ctl = (unsigned*)(ws + WS_CTL);
    const int lo = args.ph_lo, hi = args.ph_hi;
    XcdBarrier bar; bar.bar = ctl + CW_BAR; bar.x = 0; bar.st = MISC + 8;
    if (hi - lo > 1) bar = xcd_barrier_post(ctl + CW_BAR, MISC + 8);
    bf16* BtIn = (bf16*)(ws + WS_BTIN); bf16* BtUq = (bf16*)(ws + WS_BTUQ); bf16* BtKv = (bf16*)(ws + WS_BTKV); bf16* BtOut = (bf16*)(ws + WS_BTOUT); bf16* BtUp = (bf16*)(ws + WS_BTUP); bf16* BtDn = (bf16*)(ws + WS_BTDN);
    bf16* RF = (bf16*)(ws + WS_RF); bf16* Hb = (bf16*)(ws + WS_H); bf16* PROJ = (bf16*)(ws + WS_PROJ); bf16* Qb = (bf16*)(ws + WS_Q); bf16* KVb = (bf16*)(ws + WS_KV);
    bf16* ZT = (bf16*)(ws + WS_ZT); bf16* X0 = (bf16*)(ws + WS_X0); bf16* YC = (bf16*)(ws + WS_YC); float* EDGE = (float*)(ws + WS_EDGE); float* ROPE = (float*)(ws + WS_ROPE); float* SSQP = (float*)(ws + WS_SSQP); float* RSTD = (float*)(ws + WS_RSTD); bf16* XB2 = (bf16*)(ws + WS_XB2); bf16* ACT = (bf16*)(ws + WS_ACT);
    float* out = args.out;

#pragma unroll 1
    for (int layer = 0; layer < DEPTH; ++layer) {
        const int pb = layer * NPH;
        if (pb + NPH <= lo || pb >= hi) continue;
#define IN(k) (lo <= pb + (k) && pb + (k) < hi)
#define ENTER() F.tid = opq(threadIdx.x); F.lane = F.tid & 63; F.wave = __builtin_amdgcn_readfirstlane(F.tid >> 6); const int gw = F.vcu * NWAVES + F.wave, NGW = F.G * NWAVES, wg = F.vcu; const size_t gtid = (size_t)wg * 512 + F.tid, gthreads = (size_t)F.G * 512; (void)gw; (void)NGW; (void)wg; (void)gtid; (void)gthreads
#define SEAM(k) do { if (pb + (k) + 1 < hi) xcd_barrier(bar); } while (0)
        const float* xsA = (layer == 0) ? args.in[I_XP] : out; const float* xsB = (layer == 0) ? args.in[I_XS] : out + (size_t)MP * DM;

        if (IN(0)) { ENTER();
            const float* win = args.in[I_WIN] + (size_t)layer * DM * DIN; const float* g1 = args.in[I_ANG] + layer * DM;
            for (int it = wg; it < 256; it += F.G) {
                if (it < 128) poolfold_item(F, win, args.in[I_PW] + (size_t)layer * 4 * 128 * 128, args.in[I_PS] + (size_t)layer * 512, g1, BtIn, it >> 5, it & 31);
                else filter_item(F, args.in[I_FW1] + (size_t)layer * 17 * 64, args.in[I_FB1] + layer * 64, args.in[I_FFR] + layer * 64, args.in[I_FW2] + (size_t)layer * 64 * 64, args.in[I_FB2] + layer * 64,
                                 args.in[I_FW3] + (size_t)layer * 64 * 1024, args.in[I_FB3] + layer * 1024, args.in[I_HBIAS] + layer * 512, RF, it - 128);
            }
            LAS float* scr = (LAS float*)(F.lds + F.wave * 8448);
            constexpr int N_IN_ = 74 * 32, N_UQ = 48 * 8, N_KV = 64 * 4, N_OUT = 64 * 32, N_UP = 352 * 32, N_DN = 64 * 88, N_ALL = N_IN_ + N_UQ + N_KV + N_OUT + N_UP + N_DN;
            for (int it = gw; it < N_ALL; it += NGW) {
                int r = it;
                if (r < N_IN_) { const int nb = 16 + r / 32, kb = r % 32; cvt_item(win, DIN, DM, BtIn, 32 * nb, 32 * nb, 64 * kb, g1, scr, F.lane); continue; } r -= N_IN_;
                if (r < N_UQ) { const int nb = r / 8, kb = r % 8; cvt_item(args.in[I_WUQ] + (size_t)layer * 512 * NQ, NQ, 512, BtUq, 32 * nb, 32 * nb, 64 * kb, args.in[I_QNG] + layer * 512, scr, F.lane); continue; } r -= N_UQ;
                if (r < N_KV) { const int nb = r / 4, kb = r % 4, h = nb >> 3, wb = nb & 7; const int dst = KVHS * h + (wb < 4 ? 32 * wb : 192 + 32 * (wb - 4));
                    cvt_item(args.in[I_WUKV] + (size_t)layer * 256 * 2048, 2048, 256, BtKv, dst, 32 * nb, 64 * kb, args.in[I_KVNG] + layer * 256, scr, F.lane); continue; } r -= N_KV;
                if (r < N_OUT) { const int nb = r / 32, kb = r % 32; cvt_item(args.in[I_WOUT] + (size_t)layer * DM * DM, DM, DM, BtOut, 32 * nb, 32 * nb, 64 * kb, args.in[I_GNG] + layer * DM, scr, F.lane); continue; } r -= N_OUT;
                if (r < N_UP) { const int nb = r / 32, kb = r % 32; const int nv = (nb < 176) ? nb : nb - 176; const int dst = 256 * (nv >> 2) + 32 * (nv & 3) + (nb < 176 ? 0 : 128);
                    cvt_item(args.in[I_WUP] + (size_t)layer * DM * NUP, NUP, DM, BtUp, dst, 32 * nb, 64 * kb, args.in[I_FNG] + layer * DM, scr, F.lane); continue; } r -= N_UP;
                { const int nb = r / 88, kb = r % 88; cvt_item(args.in[I_WDN] + (size_t)layer * DFF * DM, DM, DFF, BtDn, 32 * nb, 32 * nb, 64 * kb, nullptr, scr, F.lane); }
            }
            { v4u z = {0u, 0u, 0u, 0u};
              for (size_t i = gtid; i < (size_t)(DINP - DIN) * DM / 8; i += gthreads) *(v4u*)(BtIn + (size_t)DIN * DM + i * 8) = z;
              for (size_t i = gtid; i < (size_t)NH * 64 * 256 / 8; i += gthreads) { const int h = (int)(i / (64 * 256 / 8)), q = (int)(i % (64 * 256 / 8)); *(v4u*)(BtKv + (size_t)(KVHS * h + 128) * 256 + (size_t)q * 8) = z; } }
            if (layer == 0) for (size_t i = gtid; i < (size_t)SEQ * 32; i += gthreads) { const int pos = (int)(i >> 5), ri = (int)(i & 31);
                const float freq = exp2f(-(float)ri * (13.287712379549449f / 32.0f)); float sn, cs; sincosf((float)pos * freq, &sn, &cs); ROPE[pos * 64 + ri] = cs; ROPE[pos * 64 + 32 + ri] = sn; }
            if (layer == 0) { for (int m = gw; m < M; m += NGW) xb_row(m < MP ? xsA + (size_t)m * DM : xsB + (size_t)(m - MP) * DM, Hb + (size_t)m * DM, RSTD + m, F.lane); }
            else rstd_from_partials(SSQP, RSTD, gtid, gthreads);
            SEAM(0);
        }
        if (IN(1)) { ENTER();
            pg8::Gemm g{Hb, BtIn, M, DINP, DM, DM}; pg8::StaticOrder S; S.init(M, DINP, F.G, (int)blockIdx.x);
            pg8::EpiBf16 E{PROJ, DINP, RSTD};
            pg8::gemm_phase<pg8::EpiBf16, pg8::StaticOrder>(F.lds, g, S, E);
            SEAM(1);
        }
        if (IN(2)) { ENTER();
            { pg8::Gemm g{PROJ + O_CQ, BtUq, M, NQ, 512, DINP}; pg8::StaticOrder S; S.init(M, NQ, F.G, (int)blockIdx.x); pg8::EpiBf16 E{Qb, NQ, nullptr};
              pg8::gemm_phase<pg8::EpiBf16, pg8::StaticOrder>(F.lds, g, S, E); }
            { pg8::Gemm g{PROJ + O_CKV, BtKv, M, NKVP, 256, DINP}; pg8::StaticOrder S; S.init(M, NKVP, F.G, (int)blockIdx.x); pg8::EpiBf16 E{KVb, NKVP, nullptr};
              pg8::gemm_phase<pg8::EpiBf16, pg8::StaticOrder>(F.lds, g, S, E); }
            const float* hcw = args.in[I_HCW] + (size_t)layer * 3 * 1536; const float* hcb = args.in[I_HCB] + layer * 1536;
            for (int it = wg; it < 2 * NSEQ * 64; it += F.G) {
                if (it < NSEQ * 64) hyprep_item(F, PROJ, hcw, hcb, ZT, X0, it >> 6, it & 63);
                else pool_item(F, PROJ, Hb, (it - NSEQ * 64) >> 6, it & 63);
            }
            SEAM(2);
        }
        if (IN(3)) { ENTER();
            for (int u = wg; u < 2 * HYC; u += F.G) hy::conv_unit(F.lds, ZT, RF, YC, u >> 1, u & 1);
            const float* qhg = args.in[I_QHG] + layer * 192; const float* khg = args.in[I_KHG] + layer * 192;
            PrepGains PG; { const int sub = F.lane & 7;
#pragma unroll
                for (int i = 0; i < 3; ++i) { load8(qhg + 64 * i + 8 * sub, PG.q[i]); load8(khg + 64 * i + 8 * sub, PG.k[i]); } }
            for (int m = gw; m < M; m += NGW) prep_row(PROJ, Qb, KVb, PG, ROPE, m, F.lane);
            SEAM(3);
        }
        if (IN(4)) { ENTER();
            for (int i = 0; i * F.G < NSEQ * NH * 8; ++i) {
                int p, qb; const int c = (int)blockIdx.x;
                if (F.G == 256) { p = i * 32 + (c & 7) * 4 + (c >> 6); qb = (c >> 3) & 7; } else { const int Lq = i * F.G + c; p = Lq >> 3; qb = Lq & 7; }
                if (p < NSEQ * NH) { const int b = p >> 3, h = p & 7;
                    at::attn_unit(Qb + (size_t)(b * SEQ + qb * 256) * NQ + h * 192, KVb + (size_t)(b * SEQ) * NKVP + h * KVHS, KVb + (size_t)(b * SEQ) * NKVP + h * KVHS + 192,
                                  Hb + (size_t)(b * SEQ + qb * 256) * DM + 512 + h * 128, SEQ, (char*)lds_raw); }
            }
            for (int it = wg; it < NSEQ * 64; it += F.G) hyfin_item(F, YC, X0, Hb, it >> 6, it & 63);
            SEAM(4);
        }
        if (IN(5)) { ENTER();
            for (int m = gw; m < M; m += NGW) attn_norm_row(Hb, m, F.lane);
            SEAM(5);
        }
        if (IN(6)) { ENTER();
            pg8::Gemm g{Hb, BtOut, M, DM, DM, DM}; pg8::StaticOrder S; S.init(M, DM, F.G, (int)blockIdx.x);
            pg8::EpiResid E{xsA, xsB, MP, out, DM, XB2, SSQP};
            pg8::gemm_phase<pg8::EpiResid, pg8::StaticOrder>(F.lds, g, S, E);
            SEAM(6);
        }
        if (IN(7)) { ENTER();
            rstd_from_partials(SSQP, RSTD, gtid, gthreads);
            SEAM(7);
        }
        if (IN(8)) { ENTER();
            pg8::Gemm g{XB2, BtUp, M, NUP, DM, DM}; pg8::StaticOrder S; S.init(M, NUP, F.G, (int)blockIdx.x);
            pg8::EpiGate E{ACT, DFF, EDGE, args.in[I_FCW] + (size_t)layer * 3 * DFF, args.in[I_FCB] + layer * DFF, DFF, (LAS float*)(F.lds + HALO_OFF), RSTD};
            pg8::gemm_phase<pg8::EpiGate, pg8::StaticOrder>(F.lds, g, S, E);
            SEAM(8);
        }
        if (IN(9)) { ENTER();
            const float* fcw = args.in[I_FCW] + (size_t)layer * 3 * DFF;
            for (size_t i = gtid; i < (size_t)(M / 256) * 2 * (DFF / 4); i += gthreads) {
                const int ri = (int)(i / (DFF / 4)), c4 = (int)(i % (DFF / 4)) * 4, pm = ri >> 1, e = ri & 1;
                const float* eb = EDGE + (size_t)(ri * 3) * DFF + c4;
                f32x4 pre = *(const f32x4*)(eb + DFF); const f32x4 v = *(const f32x4*)(eb + 2 * DFF);
                if (e == 0 && (pm & 7) != 0) { const f32x4 gp = *(const f32x4*)(EDGE + (size_t)(((pm - 1) * 2 + 1) * 3) * DFF + c4); pre += *(const f32x4*)(fcw + c4) * gp; }
                if (e == 1 && (pm & 7) != 7) { const f32x4 gn = *(const f32x4*)(EDGE + (size_t)(((pm + 1) * 2 + 0) * 3) * DFF + c4); pre += *(const f32x4*)(fcw + 2 * DFF + c4) * gn; }
                v2u o; o.x = pk2(pg8::silu_f(pre.x) * v.x, pg8::silu_f(pre.y) * v.y); o.y = pk2(pg8::silu_f(pre.z) * v.z, pg8::silu_f(pre.w) * v.w);
                *(v2u*)(ACT + (size_t)(pm * 256 + (e ? 255 : 0)) * DFF + c4) = o;
            }
            SEAM(9);
        }
        if (IN(10)) { ENTER();
            pg8::Gemm g{ACT, BtDn, M, DM, DFF, DFF}; pg8::StaticOrder S; S.init(M, DM, F.G, (int)blockIdx.x);
            pg8::EpiResid E{out, out + (size_t)MP * DM, MP, out, DM, (layer + 1 < DEPTH) ? Hb : nullptr, SSQP};
            pg8::gemm_phase<pg8::EpiResid, pg8::StaticOrder>(F.lds, g, S, E);
            SEAM(10);
        }
#undef IN
#undef ENTER
#undef SEAM
    }
}

extern "C" void kernel_launch(void* const* d_in, const int* in_sizes, int n_in, void* d_out, int out_size, void* d_ws, size_t ws_size, hipStream_t stream) {
    static int grid = 0;
    if (grid == 0) {
        if (n_in != N_IN || out_size != M * DM || ws_size < WS_END) { fprintf(stderr, "kernel_launch: unexpected shapes (n_in %d, out %d, ws %zu, need %zu)\n", n_in, out_size, ws_size, (size_t)WS_END); grid = -1; return; }
        int dev = 0, cus = 0;
        if (hipGetDevice(&dev) != hipSuccess || hipDeviceGetAttribute(&cus, hipDeviceAttributeMultiprocessorCount, dev) != hipSuccess) { grid = -1; return; }
        if (hipFuncSetAttribute((const void*)fwd, hipFuncAttributeMaxDynamicSharedMemorySize, LDS_BYTES) != hipSuccess) { fprintf(stderr, "kernel_launch: hipFuncSetAttribute failed\n"); grid = -1; return; }
        int per_cu = 0;
        if (hipOccupancyMaxActiveBlocksPerMultiprocessor(&per_cu, (const void*)fwd, NWAVES * 64, LDS_BYTES) != hipSuccess || per_cu < 1) fprintf(stderr, "kernel_launch: occupancy query reports %d\n", per_cu);
        (void)hipGetLastError();
        grid = cus;
    }
    if (grid < 0) return;
    (void)hipMemsetAsync((char*)d_ws + WS_CTL, 0, CTL_BYTES, stream);
    Args a{};
    for (int i = 0; i < N_IN; ++i) a.in[i] = (const float*)d_in[i];
    a.out = (float*)d_out; a.ws = (unsigned char*)d_ws;
#if MK_ONE_LAUNCH
    a.ph_lo = 0; a.ph_hi = DEPTH * NPH;
    hipLaunchKernelGGL(fwd, dim3(grid), dim3(NWAVES * 64), LDS_BYTES, stream, a);
#else
    for (int p = 0; p < DEPTH * NPH; ++p) { a.ph_lo = p; a.ph_hi = p + 1; hipLaunchKernelGGL(fwd, dim3(grid), dim3(NWAVES * 64), LDS_BYTES, stream, a); }
#endif
    const hipError_t le = hipPeekAtLastError();
    if (le != hipSuccess) fprintf(stderr, "kernel_launch: launch failed: %s\n", hipGetErrorName(le));
}
```

```cpp
#include <hip/hip_runtime.h>
#include <cstdio>
#include <cstdint>
__device__ __forceinline__ int opq(int x) { asm volatile("" : "+v"(x)); return x; }
namespace pg8 {
#define PG8_LAS __attribute__((address_space(3)))
typedef unsigned short bf16_t;
typedef short bf16x8 __attribute__((ext_vector_type(8)));
typedef float f32x4 __attribute__((ext_vector_type(4)));
typedef unsigned u32x4 __attribute__((ext_vector_type(4)));
constexpr int BM = 256, BK = 64, HALF = 128, HTB = HALF * BK * 2  , STAGE_BYTES = 8 * HTB, NXCD = 8, WGM = 8;

__host__ __device__ __forceinline__ int lds_byte(int r, int c) { const int st = (r >> 4) * 2 + (c >> 5), rr = r & 15, cc = c & 31, ob = rr * 64 + cc * 2; return st * 1024 + (ob ^ (((ob >> 9) & 1) << 5)); }
__host__ __device__ __forceinline__ void stage_rc(int b, int& R, int& C) { const int st = b / 1024, sb = b % 1024, swz = sb ^ (((sb >> 9) & 1) << 5); R = (st >> 1) * 16 + swz / 64; C = (st & 1) * 32 + (swz % 64) / 2; }
__host__ __device__ __forceinline__ int perm32(int rho) { const int n = rho >> 4, i = rho & 15; return 8 * (i >> 2) + 4 * n + (i & 3); }

struct Unit { int pm, pn; };
struct Gemm { const bf16_t* A; const bf16_t* Bt; int M, N, K, lda; };

struct StaticOrder {
    int nM, nN, nwg, G, c;
    __host__ __device__ void init(int M, int N, int G_, int c_) { nM = M / BM; nN = N / BM; nwg = nM * nN; G = G_; c = c_; }
    __host__ __device__ bool next(int i, Unit& u) const {
        const long L = (long)i * G + c; if (L >= nwg) return false;
        int wgid = (int)L; { const int q = nwg / NXCD, r = nwg % NXCD, xcd = wgid % NXCD, off = wgid / NXCD; wgid = (xcd < r ? xcd * (q + 1) : r * (q + 1) + (xcd - r) * q) + off; }
        const int nig = WGM * nN, gid = wgid / nig, fm = gid * WGM, gsz = (nM - fm) < WGM ? (nM - fm) : WGM;
        u.pm = fm + ((wgid % nig) % gsz); u.pn = (wgid % nig) / gsz; return true;
    }
    __device__ __forceinline__ void a_ready(const Unit&) const {}
    __device__ __forceinline__ void done(const Unit&) const {}
};

__device__ __forceinline__ unsigned cvt_pk_bf16(float lo, float hi) { unsigned r; asm volatile("v_cvt_pk_bf16_f32 %0, %1, %2" : "=v"(r) : "v"(lo), "v"(hi)); return r; }

struct EpiBf16 {
    static constexpr bool PERM = true;
    bf16_t* O; int ldc; const float* rstd;
    __device__ __forceinline__ void operator()(f32x4 (&acc)[2][2][4][2], const Unit& u, int wr, int wc, int fr, int fq) const {
        const int row0 = u.pm * BM + wr * 64 + fr; const int col0 = u.pn * BM + wc * 32 + 8 * fq;
#pragma unroll
        for (int ai = 0; ai < 2; ++ai)
#pragma unroll
            for (int m = 0; m < 4; ++m) { const int row = row0 + ai * HALF + m * 16; bf16_t* rowp = O + (size_t)row * ldc + col0; const float rs = rstd ? rstd[row] : 1.0f;
#pragma unroll
                for (int bj = 0; bj < 2; ++bj) { const f32x4 v0 = acc[ai][bj][m][0] * rs, v1 = acc[ai][bj][m][1] * rs;
                    u32x4 w; w.x = cvt_pk_bf16(v0[0], v0[1]); w.y = cvt_pk_bf16(v0[2], v0[3]); w.z = cvt_pk_bf16(v1[0], v1[1]); w.w = cvt_pk_bf16(v1[2], v1[3]);
                    *(u32x4*)(rowp + bj * HALF) = w; } }
    }
};
struct EpiResid16 {
    static constexpr bool PERM = true;
    const bf16_t* base; bf16_t* xo; float* out; int ldc; float* ssqp;
    __device__ __forceinline__ void operator()(f32x4 (&acc)[2][2][4][2], const Unit& u, int wr, int wc, int fr, int fq) const {
        const size_t tb = (size_t)(u.pm * BM) * ldc + u.pn * BM;
        const bf16_t* bs = base + tb; bf16_t* xp = xo ? xo + tb : nullptr; float* op = out ? out + tb : nullptr;
        const unsigned lo = (unsigned)((wr * 64 + fr) * ldc + wc * 32 + 8 * fq);
#pragma unroll
        for (int ai = 0; ai < 2; ++ai)
#pragma unroll
            for (int m = 0; m < 4; ++m) { const unsigned off = lo + (unsigned)((ai * HALF + m * 16) * ldc); float s = 0.f;
#pragma unroll
                for (int bj = 0; bj < 2; ++bj) { const u32x4 b = *(const u32x4*)(bs + off + bj * HALF);
                    f32x4 x0, x1;
                    x0[0] = __builtin_bit_cast(float, b.x << 16) + acc[ai][bj][m][0][0]; x0[1] = __builtin_bit_cast(float, b.x & 0xffff0000u) + acc[ai][bj][m][0][1];
                    x0[2] = __builtin_bit_cast(float, b.y << 16) + acc[ai][bj][m][0][2]; x0[3] = __builtin_bit_cast(float, b.y & 0xffff0000u) + acc[ai][bj][m][0][3];
                    x1[0] = __builtin_bit_cast(float, b.z << 16) + acc[ai][bj][m][1][0]; x1[1] = __builtin_bit_cast(float, b.z & 0xffff0000u) + acc[ai][bj][m][1][1];
                    x1[2] = __builtin_bit_cast(float, b.w << 16) + acc[ai][bj][m][1][2]; x1[3] = __builtin_bit_cast(float, b.w & 0xffff0000u) + acc[ai][bj][m][1][3];
                    if (op) { *(f32x4*)(op + off + bj * HALF) = x0; *(f32x4*)(op + off + bj * HALF + 4) = x1; }
                    if (xp) { u32x4 w; w.x = cvt_pk_bf16(x0[0], x0[1]); w.y = cvt_pk_bf16(x0[2], x0[3]); w.z = cvt_pk_bf16(x1[0], x1[1]); w.w = cvt_pk_bf16(x1[2], x1[3]); *(u32x4*)(xp + off + bj * HALF) = w;
                        s += ((x0[0] * x0[0] + x0[1] * x0[1]) + (x0[2] * x0[2] + x0[3] * x0[3])) + ((x1[0] * x1[0] + x1[1] * x1[1]) + (x1[2] * x1[2] + x1[3] * x1[3])); } }
                if (xp) { s += __shfl_xor(s, 16); s += __shfl_xor(s, 32); if (fq == 0) ssqp[(size_t)(u.pm * BM + wr * 64 + fr + ai * HALF + m * 16) * 32 + u.pn * 4 + wc] = s; }
                asm volatile("" ::: "memory"); }
    }
};
__device__ __forceinline__ float silu_f(float x) { return x * __builtin_amdgcn_rcpf(1.0f + __builtin_amdgcn_exp2f(-1.4426950408889634f * x)); }
struct EpiGate {
    static constexpr bool PERM = true;
    bf16_t* act; int ldact; float* edge; const float* cw; const float* cb; int dff; PG8_LAS float* halo; const float* rstd;
    __device__ __forceinline__ void operator()(f32x4 (&acc)[2][2][4][2], const Unit& u, int wr, int wc, int fr, int fq) const {
        const int lane = fq * 16 + fr; const int colL = wc * 32 + 8 * fq; const int colG = u.pn * HALF + colL;
#pragma unroll
        for (int ai = 0; ai < 2; ++ai)
#pragma unroll
            for (int m = 0; m < 4; ++m) { const float rs = rstd[u.pm * BM + ai * HALF + wr * 64 + m * 16 + fr];
#pragma unroll
                for (int bj = 0; bj < 2; ++bj) { acc[ai][bj][m][0] *= rs; acc[ai][bj][m][1] *= rs; } }
#pragma unroll
        for (int ai = 0; ai < 2; ++ai) { const int q = 2 * ai + wr;
            if (fr == 0) { *(PG8_LAS f32x4*)(halo + (q * 2 + 0) * 128 + colL) = acc[ai][0][0][0]; *(PG8_LAS f32x4*)(halo + (q * 2 + 0) * 128 + colL + 4) = acc[ai][0][0][1]; }
            if (fr == 15) { *(PG8_LAS f32x4*)(halo + (q * 2 + 1) * 128 + colL) = acc[ai][0][3][0]; *(PG8_LAS f32x4*)(halo + (q * 2 + 1) * 128 + colL + 4) = acc[ai][0][3][1]; } }
        asm volatile("s_waitcnt lgkmcnt(0)" ::: "memory"); __builtin_amdgcn_s_barrier(); asm volatile("" ::: "memory");
        const int srcR = (lane & 48) | ((fr - 1) & 15), srcL = (lane & 48) | ((fr + 1) & 15);
        bf16_t* actp = act + (size_t)(u.pm * BM) * ldact + colG; const unsigned rlo = (unsigned)((wr * 64 + fr) * ldact);
#pragma unroll
        for (int ai = 0; ai < 2; ++ai) { const int q = 2 * ai + wr;
#pragma unroll
            for (int n = 0; n < 2; ++n) {
                const f32x4 w0 = *(const f32x4*)(cw + colG + 4 * n), w1 = *(const f32x4*)(cw + dff + colG + 4 * n), w2 = *(const f32x4*)(cw + 2 * dff + colG + 4 * n), bb = *(const f32x4*)(cb + colG + 4 * n);
                f32x4 ht = {0.f, 0.f, 0.f, 0.f}, hb = {0.f, 0.f, 0.f, 0.f};
                if (q > 0) ht = *(PG8_LAS f32x4*)(halo + ((q - 1) * 2 + 1) * 128 + colL + 4 * n);
                if (q < 3) hb = *(PG8_LAS f32x4*)(halo + ((q + 1) * 2 + 0) * 128 + colL + 4 * n);
                f32x4 pre[4];
#pragma unroll
                for (int j = 0; j < 4; ++j) {
                    float g[4], rr[4], rl[4];
#pragma unroll
                    for (int m = 0; m < 4; ++m) { g[m] = acc[ai][0][m][n][j]; rr[m] = __shfl(g[m], srcR); rl[m] = __shfl(g[m], srcL); }
#pragma unroll
                    for (int m = 0; m < 4; ++m) {
                        const float up = (fr > 0) ? rr[m] : (m > 0 ? rr[m > 0 ? m - 1 : 0] : ht[j]);
                        const float dn = (fr < 15) ? rl[m] : (m < 3 ? rl[m < 3 ? m + 1 : 3] : hb[j]);
                        pre[m][j] = w0[j] * up + w1[j] * g[m] + w2[j] * dn + bb[j];
                    }
                }
                if (q == 0 && fr == 0) { float* e = edge + (size_t)((u.pm * 2 + 0) * 3) * dff + colG + 4 * n;
                    *(f32x4*)(e) = acc[ai][0][0][n]; *(f32x4*)(e + dff) = pre[0]; *(f32x4*)(e + 2 * dff) = acc[ai][1][0][n]; }
                if (q == 3 && fr == 15) { float* e = edge + (size_t)((u.pm * 2 + 1) * 3) * dff + colG + 4 * n;
                    *(f32x4*)(e) = acc[ai][0][3][n]; *(f32x4*)(e + dff) = pre[3]; *(f32x4*)(e + 2 * dff) = acc[ai][1][3][n]; }
#pragma unroll
                for (int m = 0; m < 4; ++m) {
                    const f32x4 v = acc[ai][1][m][n];
                    typedef unsigned u32x2 __attribute__((ext_vector_type(2)));
                    u32x2 w; w.x = cvt_pk_bf16(silu_f(pre[m][0]) * v[0], silu_f(pre[m][1]) * v[1]); w.y = cvt_pk_bf16(silu_f(pre[m][2]) * v[2], silu_f(pre[m][3]) * v[3]);
                    *(u32x2*)(actp + rlo + (unsigned)((ai * HALF + m * 16) * ldact) + 4 * n) = w;
                }
            }
        }
    }
};

template <class Epi, class Sched>
__device__ __forceinline__ void gemm_phase(PG8_LAS unsigned char* lds, const Gemm g, const Sched& S, const Epi& E) {
    const int tid = opq(threadIdx.x), wid = __builtin_amdgcn_readfirstlane(tid >> 6), lane = tid & 63, wr = wid >> 2, wc = wid & 3, fr = lane & 15, fq = lane >> 4;
    const int K = g.K, nt = K / BK, lda = g.lda;
    unsigned voffA[2], voffB[2];
#pragma unroll
    for (int i = 0; i < 2; ++i) { int R, C; stage_rc(tid * 16 + i * 8192, R, C); const int Rb = Epi::PERM ? ((R & ~31) + perm32(R & 31)) : R;
        voffA[i] = (unsigned)(R * lda + C) * 2u; voffB[i] = (unsigned)(Rb * K + C) * 2u; }
    const size_t kstep = (size_t)(BK * 2);
    const size_t hstepA = (size_t)HALF * lda * 2, hstepB = (size_t)HALF * K * 2;
    const size_t tstepA = 2 * hstepA, tstepB = 2 * hstepB;
    const unsigned ldsw = (unsigned)wid * 1024u;
    const int aoff = lds_byte(wr * 64 + fr, fq * 8), boff = lds_byte(wc * 32 + fr, fq * 8);
#define PG8_SA(b, h) (((b) * 2 + (h)) * HTB)
#define PG8_SB(b, h) ((4 + (b) * 2 + (h)) * HTB)
#define PG8_STAGE(bufoff, gbase, voff) do { _Pragma("unroll") for (int _i = 0; _i < 2; ++_i) \
        __builtin_amdgcn_global_load_lds((const unsigned*)((const char*)(gbase) + (voff)[_i]), (PG8_LAS unsigned*)(lds + (bufoff) + ldsw + _i * 8192), 16, 0, 0); } while (0)
#define PG8_LDA(dst, b, h) do { _Pragma("unroll") for (int m = 0; m < 4; ++m) _Pragma("unroll") for (int k = 0; k < 2; ++k) dst[m][k] = *(const PG8_LAS bf16x8*)(lds + PG8_SA(b, h) + aoff + m * 2048 + k * 1024); } while (0)
#define PG8_LDB(dst, b, h) do { _Pragma("unroll") for (int n = 0; n < 2; ++n) _Pragma("unroll") for (int k = 0; k < 2; ++k) dst[n][k] = *(const PG8_LAS bf16x8*)(lds + PG8_SB(b, h) + boff + n * 2048 + k * 1024); } while (0)
#define PG8_MMA(ai, bj, At, Bt) do { __builtin_amdgcn_s_setprio(1); _Pragma("unroll") for (int m = 0; m < 4; ++m) _Pragma("unroll") for (int n = 0; n < 2; ++n) _Pragma("unroll") for (int k = 0; k < 2; ++k) \
        acc[ai][bj][m][n] = __builtin_amdgcn_mfma_f32_16x16x32_bf16(Bt[n][k], At[m][k], acc[ai][bj][m][n], 0, 0, 0); __builtin_amdgcn_s_setprio(0); } while (0)
#define PG8_WAIT_V(n) asm volatile("s_waitcnt vmcnt(" #n ")" ::: "memory")
#define PG8_WAIT_L(n) asm volatile("s_waitcnt lgkmcnt(" #n ")" ::: "memory")
#define PG8_BAR __builtin_amdgcn_s_barrier()
#define PG8_SCHED __builtin_amdgcn_sched_barrier(0)
    Unit cur, nxt; int ui = 0;
    if (!S.next(0, cur)) return;
    f32x4 acc[2][2][4][2];
#pragma unroll
    for (int a = 0; a < 2; ++a)
#pragma unroll
        for (int b = 0; b < 2; ++b)
#pragma unroll
            for (int m = 0; m < 4; ++m)
#pragma unroll
                for (int n = 0; n < 2; ++n) acc[a][b][m][n] = (f32x4){0.f, 0.f, 0.f, 0.f};
    bf16x8 At[4][2], B0[2][2], B1[2][2];
    const char* cA = (const char*)g.A + (size_t)cur.pm * tstepA; const char* cB = (const char*)g.Bt + (size_t)cur.pn * tstepB;
    S.a_ready(cur);
    PG8_STAGE(PG8_SB(0, 0), cB, voffB); PG8_STAGE(PG8_SB(0, 1), cB + hstepB, voffB); PG8_STAGE(PG8_SA(0, 0), cA, voffA); PG8_STAGE(PG8_SA(0, 1), cA + hstepA, voffA);
    if (wr == 1) PG8_BAR;
    PG8_WAIT_V(2); PG8_BAR;
    PG8_STAGE(PG8_SB(1, 0), cB + kstep, voffB); PG8_STAGE(PG8_SA(1, 0), cA + kstep, voffA); PG8_STAGE(PG8_SB(1, 1), cB + hstepB + kstep, voffB);
    PG8_WAIT_V(6); PG8_BAR;
    for (;;) {
        const bool has_next = S.next(ui + 1, nxt);
        const char* nA = has_next ? (const char*)g.A + (size_t)nxt.pm * tstepA : cA; const char* nB = has_next ? (const char*)g.Bt + (size_t)nxt.pn * tstepB : cB;
#pragma unroll 1
        for (int t = 0; t < nt; t += 2) {
            const bool last = (t == nt - 2);
            const char* a1 = cA + (size_t)(t + 1) * kstep;
            const char* a2 = last ? nA : cA + (size_t)(t + 2) * kstep; const char* b2 = last ? nB : cB + (size_t)(t + 2) * kstep;
            const char* a3 = a2 + kstep; const char* b3 = b2 + kstep;
            if (last && has_next) S.a_ready(nxt);
            PG8_LDB(B0, 0, 0); PG8_LDB(B1, 0, 1); PG8_SCHED; PG8_LDA(At, 0, 0); PG8_STAGE(PG8_SA(1, 1), a1 + hstepA, voffA);
            PG8_WAIT_V(8); PG8_WAIT_L(0); PG8_BAR; PG8_MMA(0, 0, At, B0); PG8_MMA(0, 1, At, B1); PG8_BAR; PG8_SCHED;
            PG8_LDA(At, 0, 1); PG8_STAGE(PG8_SB(0, 0), b2, voffB); PG8_STAGE(PG8_SB(0, 1), b2 + hstepB, voffB); PG8_STAGE(PG8_SA(0, 0), a2, voffA);
            PG8_WAIT_V(8); PG8_WAIT_L(0); PG8_BAR; PG8_MMA(1, 0, At, B0); PG8_MMA(1, 1, At, B1); PG8_BAR; PG8_SCHED;
            PG8_LDB(B0, 1, 0); PG8_LDB(B1, 1, 1); PG8_SCHED; PG8_LDA(At, 1, 0); PG8_STAGE(PG8_SA(0, 1), a2 + hstepA, voffA);
            PG8_WAIT_V(8); PG8_WAIT_L(0); PG8_BAR; PG8_MMA(0, 0, At, B0); PG8_MMA(0, 1, At, B1); PG8_BAR; PG8_SCHED;
            PG8_LDA(At, 1, 1); PG8_STAGE(PG8_SB(1, 0), b3, voffB); PG8_STAGE(PG8_SB(1, 1), b3 + hstepB, voffB); PG8_STAGE(PG8_SA(1, 0), a3, voffA);
            PG8_WAIT_V(8); PG8_WAIT_L(0); PG8_BAR; PG8_MMA(1, 0, At, B0); PG8_MMA(1, 1, At, B1); PG8_BAR; PG8_SCHED;
        }
        if (wr == 0) PG8_BAR;
        E(acc, cur, wr, wc, fr, fq); S.done(cur);
        if (!has_next) break;
#pragma unroll
        for (int a = 0; a < 2; ++a)
#pragma unroll
            for (int b = 0; b < 2; ++b)
#pragma unroll
                for (int m = 0; m < 4; ++m)
#pragma unroll
                    for (int n = 0; n < 2; ++n) acc[a][b][m][n] = (f32x4){0.f, 0.f, 0.f, 0.f};
        cur = nxt; cA = nA; cB = nB; ++ui;
        if (wr == 1) PG8_BAR;
    }
    PG8_WAIT_V(0);
    PG8_BAR;
#undef PG8_SA
#undef PG8_SB
#undef PG8_STAGE
#undef PG8_LDA
#undef PG8_LDB
#undef PG8_MMA
#undef PG8_WAIT_V
#undef PG8_WAIT_L
#undef PG8_BAR
#undef PG8_SCHED
}
}
namespace at {
using bf16 = unsigned short;
using bf16x8 = __attribute__((ext_vector_type(8))) short;
using s16x4  = __attribute__((ext_vector_type(4))) short;
using f32x16 = __attribute__((ext_vector_type(16))) float;
using u32x4  = __attribute__((ext_vector_type(4))) unsigned;
constexpr int DQK = 192, DV = 128, KVBLK = 64, NW = 8, QBLK = 32;
constexpr float SCALE = 0.07216878364870322f;
constexpr float THR = 8.f;
constexpr int LDQ = 1536, LDK = 2560, LDO = 2048;
constexpr int SHM_V = KVBLK * DV * 2, SHM_K = 12 * 2080;
constexpr int QR_OFF = 2 * SHM_V + 2 * SHM_K + NW * 64 * 4;
constexpr int SHM_ATTN = QR_OFF + NW * 4096;
#define SBAR() __builtin_amdgcn_sched_barrier(0)
constexpr int KPL = 2080;
__host__ __device__ __forceinline__ int k_st(int row, int c) { return (c >> 1) * KPL + row * 32 + (((c & 1) ^ ((row >> 3) & 1)) << 4); }
__host__ __device__ __forceinline__ int k_rd_base(int r32, int hi) { return r32 * 32 + ((hi ^ ((r32 >> 3) & 1)) << 4); }
__device__ __forceinline__ int crow(int r, int hi) { return (r & 3) + 8 * (r >> 2) + 4 * hi; }
__device__ __forceinline__ unsigned cvtpk(float lo, float hi) { unsigned r; asm volatile("v_cvt_pk_bf16_f32 %0, %1, %2" : "=v"(r) : "v"(lo), "v"(hi)); return r; }

__device__ __forceinline__ void partialSM(f32x16& p0, f32x16& p1, float& m_reg, float& mn, float& alpha) {
  constexpr float C = SCALE * 1.4426950408889634f;
  float pmax = p0[0];
#pragma unroll
  for (int r = 1; r < 16; ++r) pmax = fmaxf(pmax, p0[r]);
#pragma unroll
  for (int r = 0; r < 16; ++r) pmax = fmaxf(pmax, p1[r]);
  { auto rr = __builtin_amdgcn_permlane32_swap(__float_as_uint(pmax), __float_as_uint(pmax), false, false);
    pmax = fmaxf(__uint_as_float(rr[0]), __uint_as_float(rr[1])); }
  if (__builtin_expect(__all(pmax - m_reg <= THR / SCALE), 1)) { mn = m_reg; alpha = 1.f; }
  else { mn = fmaxf(m_reg, pmax); alpha = __builtin_amdgcn_exp2f((m_reg - mn) * C); m_reg = mn; }
  float mnC = -mn * C;
#pragma unroll
  for (int r = 0; r < 16; ++r) p0[r] = fmaf(p0[r], C, mnC);
#pragma unroll
  for (int r = 0; r < 16; ++r) p1[r] = fmaf(p1[r], C, mnC);
#pragma unroll
  for (int r = 0; r < 16; ++r) p0[r] = __builtin_amdgcn_exp2f(p0[r]);
}
__device__ __forceinline__ void finishSM(f32x16& p0, f32x16& p1, float alpha, float& l_reg, bf16x8& pa0, bf16x8& pa1, bf16x8& pa2, bf16x8& pa3) {
#pragma unroll
  for (int r = 0; r < 16; ++r) p1[r] = __builtin_amdgcn_exp2f(p1[r]);
  float ps = 0;
#pragma unroll
  for (int r = 0; r < 16; ++r) ps += p0[r];
#pragma unroll
  for (int r = 0; r < 16; ++r) ps += p1[r];
  { auto rr = __builtin_amdgcn_permlane32_swap(__float_as_uint(ps), __float_as_uint(ps), false, false);
    ps = __uint_as_float(rr[0]) + __uint_as_float(rr[1]); }
  l_reg = l_reg * alpha + ps;
#define PK4(P, BASE, OUT) do { unsigned a0 = cvtpk(P[BASE + 0], P[BASE + 1]), a1 = cvtpk(P[BASE + 2], P[BASE + 3]);   \
    unsigned b0 = cvtpk(P[BASE + 4], P[BASE + 5]), b1 = cvtpk(P[BASE + 6], P[BASE + 7]);                              \
    auto r0 = __builtin_amdgcn_permlane32_swap(a0, b0, false, false); auto r1 = __builtin_amdgcn_permlane32_swap(a1, b1, false, false); \
    u32x4 w = {r0[0], r1[0], r0[1], r1[1]}; OUT = *reinterpret_cast<bf16x8*>(&w); } while (0)
  PK4(p0, 0, pa0); PK4(p0, 8, pa1); PK4(p1, 0, pa2); PK4(p1, 8, pa3);
#undef PK4
}
template <int OFF> __device__ __forceinline__ bf16x8 k_read(int kb) {
  bf16x8 r; asm volatile("ds_read_b128 %0, %1 offset:%2" : "=v"(r) : "v"(kb), "i"(OFF) : "memory"); return r;
}
__device__ __forceinline__ void qkt(f32x16& p0, f32x16& p1, int kb, const bf16x8* qr, int qb) {
  p0 = f32x16{}; p1 = f32x16{};
#define QK1(d0) { const bf16x8 b0 = *(const __attribute__((address_space(3))) bf16x8*)(kb + d0 * KPL), b1 = *(const __attribute__((address_space(3))) bf16x8*)(kb + d0 * KPL + 1024); \
    p0 = __builtin_amdgcn_mfma_f32_32x32x16_bf16(b0, qr[d0], p0, 0, 0, 0); p1 = __builtin_amdgcn_mfma_f32_32x32x16_bf16(b1, qr[d0], p1, 0, 0, 0); }
#define QK2(d0) { const bf16x8 b0 = *(const __attribute__((address_space(3))) bf16x8*)(kb + d0 * KPL), b1 = *(const __attribute__((address_space(3))) bf16x8*)(kb + d0 * KPL + 1024); \
    const bf16x8 qf = *(const __attribute__((address_space(3))) bf16x8*)(qb + (d0 - 8) * 1024); \
    p0 = __builtin_amdgcn_mfma_f32_32x32x16_bf16(b0, qf, p0, 0, 0, 0); p1 = __builtin_amdgcn_mfma_f32_32x32x16_bf16(b1, qf, p1, 0, 0, 0); }
  QK1(0) QK1(1) QK1(2) QK1(3) QK1(4) QK1(5) QK1(6) QK1(7) QK2(8) QK2(9) QK2(10) QK2(11)
#undef QK1
#undef QK2
}
__host__ __device__ __forceinline__ int v_st(int k, int c) { const int kk = (k & ~0xC) | ((k & 4) << 1) | ((k & 8) >> 1); return ((kk >> 3) * 4 + (c >> 5)) * 512 + ((kk & 7) * 32 + (c & 31)) * 2; }
__device__ __forceinline__ int v_rd_base(int lane) { return ((lane & 3) << 3) | (((lane >> 2) & 3) << 6) | (((lane >> 4) & 1) << 5) | (((lane >> 5) & 1) << 8); }
constexpr int v_rd_off(int d0, int ks, int half) { return d0 * 512 + ks * 4096 + half * 2048; }
template <int OFF> __device__ __forceinline__ s16x4 tr_read(int vb) {
  s16x4 r; asm volatile("ds_read_b64_tr_b16 %0, %1 offset:%2" : "=&v"(r) : "v"(vb), "i"(OFF) : "memory"); return r;
}
template <int D0> __device__ __forceinline__ void pv_one(f32x16& od, int vb, bf16x8 pa0, bf16x8 pa1, bf16x8 pa2, bf16x8 pa3) {
  const s16x4 l0 = tr_read<v_rd_off(D0, 0, 0)>(vb), h0 = tr_read<v_rd_off(D0, 0, 1)>(vb), l1 = tr_read<v_rd_off(D0, 1, 0)>(vb), h1 = tr_read<v_rd_off(D0, 1, 1)>(vb);
  const s16x4 l2 = tr_read<v_rd_off(D0, 2, 0)>(vb), h2 = tr_read<v_rd_off(D0, 2, 1)>(vb), l3 = tr_read<v_rd_off(D0, 3, 0)>(vb), h3 = tr_read<v_rd_off(D0, 3, 1)>(vb);
  asm volatile("s_waitcnt lgkmcnt(0)" ::: "memory"); SBAR();
#define PK(L, H) (bf16x8){L[0], L[1], L[2], L[3], H[0], H[1], H[2], H[3]}
  od = __builtin_amdgcn_mfma_f32_32x32x16_bf16(pa0, PK(l0, h0), od, 0, 0, 0);
  od = __builtin_amdgcn_mfma_f32_32x32x16_bf16(pa1, PK(l1, h1), od, 0, 0, 0);
  od = __builtin_amdgcn_mfma_f32_32x32x16_bf16(pa2, PK(l2, h2), od, 0, 0, 0);
  od = __builtin_amdgcn_mfma_f32_32x32x16_bf16(pa3, PK(l3, h3), od, 0, 0, 0);
#undef PK
}
__device__ __forceinline__ void pv_d0(f32x16* o, int vb, bf16x8 pa0, bf16x8 pa1, bf16x8 pa2, bf16x8 pa3) {
  pv_one<0>(o[0], vb, pa0, pa1, pa2, pa3); pv_one<1>(o[1], vb, pa0, pa1, pa2, pa3); pv_one<2>(o[2], vb, pa0, pa1, pa2, pa3); pv_one<3>(o[3], vb, pa0, pa1, pa2, pa3);
}

__device__ __forceinline__ void attn_unit(const bf16* __restrict__ Qb, const bf16* __restrict__ Kh, const bf16* __restrict__ Vh, bf16* __restrict__ Ob, int seq, char* lds) {
  const int tid = opq(threadIdx.x), wid = tid >> 6, lane = tid & 63, r32 = lane & 31, hi = lane >> 5;
  char* V_lds = lds; char* K_lds = lds + 2 * SHM_V;
  float* ws = (float*)(lds + 2 * SHM_V + 2 * SHM_K) + wid * 64; float* li_l = ws; float* al_l = ws + 32;
  float m_reg = -1e30f, l_reg = 0; f32x16 o[4] = {}; bf16x8 qr[8];
  const bf16* Qw = Qb + (unsigned)((wid * QBLK + r32) * LDQ + hi * 8);
#pragma unroll
  for (int d0 = 0; d0 < 8; ++d0) qr[d0] = *reinterpret_cast<const bf16x8*>(Qw + d0 * 16);
  const int qb0 = (int)(uintptr_t)lds + QR_OFF + wid * 4096 + k_rd_base(r32, hi);
#pragma unroll
  for (int d0 = 8; d0 < 12; ++d0) *(__attribute__((address_space(3))) bf16x8*)(qb0 + (d0 - 8) * 1024) = *reinterpret_cast<const bf16x8*>(Qw + d0 * 16);
  const int sr = tid >> 4, sc = (tid & 15) * 8, vst0 = v_st(sr, sc), vst1 = v_st(32 + sr, sc);
  unsigned koff[3]; int kst[3];
#pragma unroll
  for (int i = 0; i < 3; ++i) { const int q = tid + 512 * i; koff[i] = (unsigned)((q / 24) * LDK + (q % 24) * 8); kst[i] = k_st(q / 24, q % 24); }
  const unsigned voff0 = (unsigned)(sr * LDK + sc), voff1 = (unsigned)((32 + sr) * LDK + sc);
  const int vb0 = (int)(uintptr_t)V_lds + v_rd_base(lane); const int kb0 = (int)(uintptr_t)K_lds + k_rd_base(r32, hi);
  struct { bf16x8 vs0, vs1, ks0, ks1, ks2; } sr_[1];
#define SLOAD(i, k0) do { const bf16* vt = Vh + (size_t)(k0) * LDK; const bf16* kt = Kh + (size_t)(k0) * LDK; \
    sr_[i].vs0 = *(const bf16x8*)(vt + voff0); sr_[i].vs1 = *(const bf16x8*)(vt + voff1); \
    sr_[i].ks0 = *(const bf16x8*)(kt + koff[0]); sr_[i].ks1 = *(const bf16x8*)(kt + koff[1]); sr_[i].ks2 = *(const bf16x8*)(kt + koff[2]); } while (0)
#define SWRITE(b, i) do { *(bf16x8*)(V_lds + (b) * SHM_V + vst0) = sr_[i].vs0; *(bf16x8*)(V_lds + (b) * SHM_V + vst1) = sr_[i].vs1; \
    *(bf16x8*)(K_lds + (b) * SHM_K + kst[0]) = sr_[i].ks0; *(bf16x8*)(K_lds + (b) * SHM_K + kst[1]) = sr_[i].ks1; *(bf16x8*)(K_lds + (b) * SHM_K + kst[2]) = sr_[i].ks2; } while (0)
#define SWAIT() do { if constexpr (SDEPTH == 2) asm volatile("s_waitcnt vmcnt(5)" ::: "memory"); else asm volatile("s_waitcnt vmcnt(0)" ::: "memory"); } while (0)
#define RESC(a) do { if (__any((a) < 1.f)) { if (hi == 0) al_l[r32] = (a); asm volatile("s_waitcnt lgkmcnt(0)" ::: "memory"); \
    _Pragma("unroll") for (int d = 0; d < 4; ++d) _Pragma("unroll") for (int r = 0; r < 16; ++r) o[d][r] *= al_l[crow(r, hi)]; } } while (0)
  f32x16 pA0, pA1, pB0, pB1; float mnA, mnB, alA, alB; bf16x8 pa0, pa1, pa2, pa3; const int NT = seq / KVBLK;
  SLOAD(0, 0); asm volatile("s_waitcnt vmcnt(0)" ::: "memory"); SWRITE(0, 0); __syncthreads();
  qkt(pA0, pA1, kb0, qr, qb0); partialSM(pA0, pA1, m_reg, mnA, alA);
  SLOAD(0, KVBLK);
  asm volatile("s_waitcnt vmcnt(0)" ::: "memory"); SWRITE(1, 0); __syncthreads();
  for (int j = 1; j + 1 < NT; j += 2) {
    SBAR(); qkt(pB0, pB1, kb0 + SHM_K, qr, qb0);
    finishSM(pA0, pA1, alA, l_reg, pa0, pa1, pa2, pa3); SBAR();
    SLOAD(0, (j + 1) * KVBLK); SBAR();
    pv_d0(o, vb0, pa0, pa1, pa2, pa3); partialSM(pB0, pB1, m_reg, mnB, alB);
    __syncthreads(); asm volatile("s_waitcnt vmcnt(0)" ::: "memory"); SWRITE(0, 0);
    RESC(alB); __syncthreads();
    SBAR(); qkt(pA0, pA1, kb0, qr, qb0);
    finishSM(pB0, pB1, alB, l_reg, pa0, pa1, pa2, pa3); SBAR();
    SLOAD(0, (j + 2) * KVBLK); SBAR();
    pv_d0(o, vb0 + (int)SHM_V, pa0, pa1, pa2, pa3); partialSM(pA0, pA1, m_reg, mnA, alA);
    __syncthreads(); asm volatile("s_waitcnt vmcnt(0)" ::: "memory"); SWRITE(1, 0);
    RESC(alA); __syncthreads();
  }
  SBAR(); qkt(pB0, pB1, kb0 + SHM_K, qr, qb0);
  finishSM(pA0, pA1, alA, l_reg, pa0, pa1, pa2, pa3); SBAR();
  pv_d0(o, vb0, pa0, pa1, pa2, pa3); partialSM(pB0, pB1, m_reg, mnB, alB);
  __syncthreads(); RESC(alB);
  finishSM(pB0, pB1, alB, l_reg, pa0, pa1, pa2, pa3); SBAR();
  pv_d0(o, vb0 + (int)SHM_V, pa0, pa1, pa2, pa3);
  if (hi == 0) li_l[r32] = l_reg; asm volatile("s_waitcnt lgkmcnt(0)" ::: "memory");
  bf16* Ow = Ob + (unsigned)(wid * QBLK * LDO + r32);
#pragma unroll
  for (int r = 0; r < 16; ++r) { const int orow = crow(r, hi); const float rl = __builtin_amdgcn_rcpf(li_l[orow]);
#pragma unroll
    for (int d0 = 0; d0 < 4; ++d0) { const unsigned w = cvtpk(o[d0][r] * rl, 0.f); Ow[(unsigned)(orow * LDO + d0 * 32)] = (bf16)(w & 0xffffu); } }
  __syncthreads();
#undef SLOAD
#undef SWRITE
#undef SWAIT
#undef RESC
}
}
namespace hy {
#define HY_LAS __attribute__((address_space(3)))
typedef unsigned short bf16;
typedef short bf16x8 __attribute__((ext_vector_type(8)));
typedef float f32x16 __attribute__((ext_vector_type(16)));
typedef unsigned u32x2 __attribute__((ext_vector_type(2)));
typedef unsigned u32x4 __attribute__((ext_vector_type(4)));
constexpr int L = 2048, NB = 24, CH = 512;
constexpr int RFS = 4112;
constexpr int ZROW = 4112;
constexpr int ZL_BYTES = NB * ZROW;
constexpr int RCS = 8256;
constexpr int RC_OFF = ZL_BYTES;
constexpr int HY_LDS_BYTES = RC_OFF + 4 * RCS;
__device__ __forceinline__ unsigned cvtpk(float lo, float hi) { unsigned r; asm volatile("v_cvt_pk_bf16_f32 %0, %1, %2" : "=v"(r) : "v"(lo), "v"(hi)); return r; }
__host__ __device__ __forceinline__ int frag_base(int tw, int r, int h) { const int a = (4 - (r & 3)) & 3; return RC_OFF + a * RCS + 2 * (2048 - tw - r + 8 * h - a); }
__host__ __device__ __forceinline__ int zfrag_base(int r, int h) { return (r < NB ? r : NB - 1) * ZROW + 16 * h; }

__device__ __forceinline__ bf16x8 ld_frag(HY_LAS unsigned char* lds, int off) {
    const u32x2 lo = *(const HY_LAS u32x2*)(lds + off), hi = *(const HY_LAS u32x2*)(lds + off + 8);
    u32x4 w = {lo.x, lo.y, hi.x, hi.y}; return *reinterpret_cast<bf16x8*>(&w);
}
__device__ __forceinline__ bf16x8 ld_b128(HY_LAS unsigned char* lds, int off) { return *(const HY_LAS bf16x8*)(lds + off); }

__device__ __forceinline__ void conv_unit(HY_LAS unsigned char* lds, const bf16* __restrict__ ZT, const bf16* __restrict__ RF, bf16* __restrict__ YC, int c, int half) {
    const int tid = opq(threadIdx.x), wid = tid >> 6, lane = tid & 63, r = lane & 31, h = lane >> 5;
    { const u32x4* src = (const u32x4*)(ZT + (size_t)c * NB * L);
#pragma unroll
      for (int i = 0; i < 12; ++i) { const int q = tid + 512 * i; const u32x4 v = src[q]; *(HY_LAS u32x4*)(lds + (q >> 8) * ZROW + (q & 255) * 16) = v; } }
    { const bf16* rf = RF + (size_t)c * RFS;
      for (int ch = tid; ch < RFS / 8; ch += 512) {
          const u32x4 v = *(const u32x4*)(rf + ch * 8); const unsigned w[4] = {v.x, v.y, v.z, v.w};
#pragma unroll
          for (int j = 0; j < 8; ++j) { const unsigned short e = (unsigned short)((w[j >> 1] >> ((j & 1) * 16)) & 0xffffu); const int idx = ch * 8 + j;
#pragma unroll
              for (int a = 0; a < 4; ++a) if (idx - a >= 0) *(HY_LAS unsigned short*)(lds + RC_OFF + a * RCS + 2 * (idx - a)) = e; } } }
    __syncthreads();
    const int tw = half * 1024 + wid * 128;
    const int fb = frag_base(tw, r, h), zb = zfrag_base(r, h);
    f32x16 acc[4] = {};
    bf16x8 S0[2], S1[2], S2[2], S3[2], Bc[2], Bn[2];
#define HY_LDG(S, d) do { S[0] = ld_frag(lds, fb + 64 * (d)); S[1] = ld_frag(lds, fb + 64 * (d) + 32); } while (0)
#define HY_LDB(Bx, n) do { Bx[0] = ld_b128(lds, zb + 64 * (n)); Bx[1] = ld_b128(lds, zb + 64 * (n) + 32); } while (0)
#define HY_MM(i, S, Bx) do { acc[i] = __builtin_amdgcn_mfma_f32_32x32x16_bf16(S[0], Bx[0], acc[i], 0, 0, 0); acc[i] = __builtin_amdgcn_mfma_f32_32x32x16_bf16(S[1], Bx[1], acc[i], 0, 0, 0); } while (0)
#define HY_ITER(n, Sa, Sb, Sc, Sd, Bcur, Bnext) do { HY_LDG(Sa, (n)); if ((n) + 1 < 64) HY_LDB(Bnext, (n) + 1); \
        HY_MM(1, Sb, Bcur); HY_MM(2, Sc, Bcur); HY_MM(3, Sd, Bcur); HY_MM(0, Sa, Bcur); } while (0)
    HY_LDG(S3, -1); HY_LDG(S2, -2); HY_LDG(S1, -3); HY_LDB(Bc, 0);
    for (int n = 0; n < 64; n += 4) {
        HY_ITER(n, S0, S3, S2, S1, Bc, Bn);
        HY_ITER(n + 1, S1, S0, S3, S2, Bn, Bc);
        HY_ITER(n + 2, S2, S1, S0, S3, Bc, Bn);
        HY_ITER(n + 3, S3, S2, S1, S0, Bn, Bc);
    }
#undef HY_LDG
#undef HY_LDB
#undef HY_MM
#undef HY_ITER
    if (r < NB) { bf16* yp = YC + ((size_t)c * NB + r) * L + tw + 4 * h;
#pragma unroll
        for (int i = 0; i < 4; ++i)
#pragma unroll
            for (int q4 = 0; q4 < 4; ++q4) { u32x2 w; w.x = cvtpk(acc[i][4 * q4 + 0], acc[i][4 * q4 + 1]); w.y = cvtpk(acc[i][4 * q4 + 2], acc[i][4 * q4 + 3]);
                *(u32x2*)(yp + 32 * i + 8 * q4) = w; } }
    __syncthreads();
}
}
constexpr int NWAVES = 8;
#ifndef MK_ONE_LAUNCH
#define MK_ONE_LAUNCH 1
#endif
constexpr int DM = 2048, NSEQ = 24, SEQ = 2048, M = NSEQ * SEQ, MP = 8 * SEQ;
constexpr int DEPTH = 4;
constexpr int DIN = 2880, DINP = 3072;
constexpr int O_CQ = 512, O_CKV = 1024, O_KPE = 1280, O_HY = 1344;
constexpr int NH = 8, NQ = 1536, NKVP = 2560, KVHS = 320;
constexpr int DFF = 5632, NUP = 11264, HYC = 512;
constexpr float EPS = 1e-6f;
constexpr int NPH = 11;
constexpr size_t WS_CTL = 0, CTL_BYTES = 1u << 20;
constexpr size_t SZ_BTIN = (size_t)DINP * DM * 2, SZ_BTUQ = (size_t)NQ * 512 * 2, SZ_BTKV = (size_t)NKVP * 256 * 2, SZ_BTOUT = (size_t)DM * DM * 2, SZ_BTUP = (size_t)NUP * DM * 2, SZ_BTDN = (size_t)DM * DFF * 2;
constexpr size_t WS_BTIN = WS_CTL + CTL_BYTES, WS_BTUQ = WS_BTIN + SZ_BTIN, WS_BTKV = WS_BTUQ + SZ_BTUQ, WS_BTOUT = WS_BTKV + SZ_BTKV, WS_BTUP = WS_BTOUT + SZ_BTOUT, WS_BTDN = WS_BTUP + SZ_BTUP;
constexpr size_t WS_RF = WS_BTDN + SZ_BTDN, SZ_RF = (size_t)HYC * hy::RFS * 2;
constexpr size_t WS_H = WS_RF + SZ_RF, SZ_H = (size_t)M * DM * 2;
constexpr size_t WS_PROJ = WS_H + SZ_H, SZ_PROJ = (size_t)M * DINP * 2;
constexpr size_t WS_Q = WS_PROJ + SZ_PROJ, SZ_Q = (size_t)M * NQ * 2;
constexpr size_t WS_KV = WS_Q + SZ_Q, SZ_KV = (size_t)M * NKVP * 2;
constexpr size_t WS_ZT = WS_KV + SZ_KV, SZ_ZT = (size_t)HYC * NSEQ * SEQ * 2;
constexpr size_t WS_X0 = WS_ZT + SZ_ZT, WS_YC = WS_X0 + SZ_ZT;
constexpr size_t WS_EDGE = WS_YC + SZ_ZT, SZ_EDGE = (size_t)(M / 256) * 2 * 3 * DFF * 4;
constexpr size_t WS_ROPE = WS_EDGE + SZ_EDGE, SZ_ROPE = (size_t)SEQ * 64 * 4;
constexpr size_t WS_SSQP = WS_ROPE + SZ_ROPE, SZ_SSQP = (size_t)M * 32 * 4;
constexpr size_t WS_RSTD = WS_SSQP + SZ_SSQP, SZ_RSTD = (size_t)M * 4;
constexpr size_t WS_END = WS_RSTD + SZ_RSTD;
constexpr size_t WS_ACT = WS_PROJ;
static_assert((size_t)M * DFF * 2 <= SZ_PROJ + SZ_Q + SZ_KV, "ACT overlay");
constexpr size_t WS_XB2 = WS_ACT + (size_t)M * DFF * 2;
static_assert(WS_XB2 + (size_t)M * DM * 2 <= WS_EDGE && WS_XB2 % 256 == 0, "XB2 overlay");
static_assert(WS_BTIN % 256 == 0 && WS_RF % 256 == 0 && WS_H % 256 == 0 && WS_PROJ % 256 == 0 && WS_Q % 256 == 0 && WS_KV % 256 == 0 && WS_ZT % 256 == 0 && WS_EDGE % 256 == 0, "alignment");
constexpr int CW_BAR = 4096;
constexpr int RING_BYTES = 135168;
constexpr int HALO_OFF = RING_BYTES, HALO_BYTES = 4096;
constexpr int MISC_OFF = HALO_OFF + HALO_BYTES;
constexpr int LDS_BYTES = 147456;
static_assert(hy::HY_LDS_BYTES <= RING_BYTES && at::SHM_ATTN <= RING_BYTES && MISC_OFF + 256 <= LDS_BYTES, "LDS map");

#define GAS __attribute__((address_space(1)))
#define LAS __attribute__((address_space(3)))
typedef unsigned short bf16;
typedef unsigned v4u __attribute__((ext_vector_type(4)));
typedef unsigned v2u __attribute__((ext_vector_type(2)));
typedef float f32x4 __attribute__((ext_vector_type(4)));
#define LDS_WAIT() asm volatile("s_waitcnt lgkmcnt(0)" ::: "memory")
__device__ __forceinline__ unsigned f2bf(float f) { unsigned u = __builtin_bit_cast(unsigned, f); return (u + 0x7fffu + ((u >> 16) & 1u)) >> 16; }
__device__ __forceinline__ unsigned pk2(float lo, float hi) { return f2bf(lo) | (f2bf(hi) << 16); }
__device__ __forceinline__ float bf2f(unsigned short b) { return __builtin_bit_cast(float, (unsigned)b << 16); }
__device__ __forceinline__ float bflo(unsigned w) { return __builtin_bit_cast(float, w << 16); }
__device__ __forceinline__ float bfhi(unsigned w) { return __builtin_bit_cast(float, w & 0xffff0000u); }
__device__ __forceinline__ float wave_sum(float v) {
#pragma unroll
    for (int o = 1; o < 64; o <<= 1) v += __shfl_xor(v, o);
    return v;
}

#define XB_TMO      128
#define XB_XCNT(j)  (256  + 64 * (j))
#define XB_XSUB(j)  (1280 + 64 * (j))
#define XB_XGEN(j)  (2304 + 64 * (j))
#define XB_TOP      3328
#define XB_TOPGEN   3392
#define XCD_BAR_WORDS 3456
#define XB_SPIN_CAP (1u << 18)
__device__ __forceinline__ unsigned xb_ld(unsigned* p)              { return __hip_atomic_load(p, __ATOMIC_RELAXED, __HIP_MEMORY_SCOPE_AGENT); }
__device__ __forceinline__ unsigned xb_add(unsigned* p, unsigned v) { return __hip_atomic_fetch_add(p, v, __ATOMIC_RELAXED, __HIP_MEMORY_SCOPE_AGENT); }
__device__ __forceinline__ unsigned xb_xcc_id() { return (unsigned)__builtin_amdgcn_s_getreg((3 << 11) | 20) & 0xFu; }
#define XB_SPIN(cond, bar) do { unsigned _sp = 0; while (cond) { __builtin_amdgcn_s_sleep(1); \
    if ((++_sp & 255u) == 0u) { if (xb_ld(&(bar)[XB_TMO])) break; if (_sp > XB_SPIN_CAP) { atomicAdd(&(bar)[XB_TMO], 1u); break; } } } } while (0)
struct XcdBarrier { unsigned* bar; unsigned x; volatile LAS unsigned* st; };
__device__ __forceinline__ XcdBarrier xcd_barrier_post(unsigned* bar, volatile LAS unsigned* st) {
    XcdBarrier b; b.bar = bar; b.x = xb_xcc_id(); b.st = st;
    if (threadIdx.x == 0) (void)xb_add(&bar[XB_XCNT(b.x)], 1u);
    return b;
}
__device__ __forceinline__ void xcd_barrier_complete(unsigned* bar, unsigned x, unsigned& nloc, unsigned& nx) {
    const unsigned G = gridDim.x * gridDim.y * gridDim.z;
    unsigned sum, cnt, mine, sp = 0u;
    for (;;) {
        sum = 0u; cnt = 0u; mine = 0u;
#pragma unroll
        for (unsigned j = 0; j < 16; ++j) { const unsigned c = xb_ld(&bar[XB_XCNT(j)]); sum += c; cnt += (c > 0u) ? 1u : 0u; mine = (j == x) ? c : mine; }
        if (sum == G) break;
        __builtin_amdgcn_s_sleep(1);
        if ((++sp & 255u) == 0u) { if (xb_ld(&bar[XB_TMO])) break; if (sp > XB_SPIN_CAP) { atomicAdd(&bar[XB_TMO], 1u); break; } }
    }
    nloc = mine > 0u ? mine : 1u; nx = cnt > 0u ? cnt : 1u;
}
__device__ __forceinline__ void xcd_barrier(const XcdBarrier& b) {
    asm volatile("s_waitcnt vmcnt(0)" ::: "memory");
    __syncthreads();
    if (threadIdx.x == 0) {
        unsigned* bar = b.bar;
        __builtin_amdgcn_s_waitcnt(0);
        unsigned nloc = b.st[0], nx = b.st[1];
        if (nloc == 0u) { xcd_barrier_complete(bar, b.x, nloc, nx); b.st[0] = nloc; b.st[1] = nx; }
        const unsigned old = xb_add(&bar[XB_XSUB(b.x)], 1u);
        const unsigned gen = old / nloc;
        if (old + 1u == (gen + 1u) * nloc) {
            __builtin_amdgcn_fence(__ATOMIC_RELEASE, "agent");
            asm volatile("s_waitcnt vmcnt(0)" ::: "memory");
            const unsigned og = xb_add(&bar[XB_TOP], 1u);
            const unsigned tg = og / nx;
            if (og + 1u == (tg + 1u) * nx) xb_add(&bar[XB_TOPGEN], 1u);
            else XB_SPIN(xb_ld(&bar[XB_TOPGEN]) == tg, bar);
            __builtin_amdgcn_fence(__ATOMIC_ACQUIRE, "agent");
            xb_add(&bar[XB_XGEN(b.x)], 1u);
            asm volatile("s_waitcnt vmcnt(0)" ::: "memory");
        } else {
            XB_SPIN(xb_ld(&bar[XB_XGEN(b.x)]) == gen, bar);
            __builtin_amdgcn_fence(__ATOMIC_ACQUIRE, "agent");
            asm volatile("s_waitcnt vmcnt(0)" ::: "memory");
        }
    }
    __syncthreads();
}

struct Frame {
    LAS unsigned char* lds;
    int tid, lane, wave, vcu, G;
};
enum { I_XP = 0, I_XS, I_ANG, I_WIN, I_PW, I_PS, I_QNG, I_WUQ, I_KVNG, I_WUKV, I_QHG, I_KHG, I_HCW, I_HCB, I_FW1, I_FB1, I_FFR, I_FW2, I_FB2, I_FW3, I_FB3, I_HBIAS, I_GNG, I_WOUT, I_FNG, I_WUP, I_FCW, I_FCB, I_WDN, N_IN };
struct Args { const float* in[N_IN]; float* out; unsigned char* ws; int ph_lo, ph_hi; };
static_assert(sizeof(Args) == (N_IN + 2) * 8 + 8, "Args has no padding");

__device__ __forceinline__ void cvt_item(const float* __restrict__ W, int ldw, int K, bf16* WT, int dst_n0, int src_n0, int k0, const float* __restrict__ ks, LAS float* scr, int lane) {
#pragma unroll
    for (int i = 0; i < 32; ++i) { const int kk = 2 * i + (lane >> 5); float v = W[(size_t)(k0 + kk) * ldw + src_n0 + (lane & 31)]; if (ks) v *= ks[k0 + kk]; scr[kk * 33 + (lane & 31)] = v; }
    LDS_WAIT(); asm volatile("" ::: "memory");
    const int c = lane & 7;
#pragma unroll
    for (int j = 0; j < 4; ++j) { const int n = (lane >> 3) + 8 * j; const LAS float* s = scr + (8 * c) * 33 + n;
        v4u o; o.x = pk2(s[0 * 33], s[1 * 33]); o.y = pk2(s[2 * 33], s[3 * 33]); o.z = pk2(s[4 * 33], s[5 * 33]); o.w = pk2(s[6 * 33], s[7 * 33]);
        *(v4u*)(WT + (size_t)(dst_n0 + n) * K + k0 + 8 * c) = o; }
    LDS_WAIT(); asm volatile("" ::: "memory");
}
__device__ __forceinline__ void xb_row(const float* xrow, bf16* orow, float* rstd, int lane) {
    const f32x4* xr = (const f32x4*)xrow + lane;
    f32x4 v[8]; float s = 0.f;
#pragma unroll
    for (int j = 0; j < 8; ++j) { v[j] = xr[64 * j]; s += (v[j].x * v[j].x + v[j].y * v[j].y) + (v[j].z * v[j].z + v[j].w * v[j].w); }
    const float r = 1.0f / sqrtf(wave_sum(s) * (1.f / DM) + EPS);
    if (lane == 0) *rstd = r;
    v2u* o8 = (v2u*)orow + lane;
#pragma unroll
    for (int j = 0; j < 8; ++j) { v2u w; w.x = pk2(v[j].x, v[j].y); w.y = pk2(v[j].z, v[j].w); o8[64 * j] = w; }
}
__device__ __forceinline__ void rstd_from_partials(const float* __restrict__ ssqp, float* rstd, size_t gtid, size_t gthreads) {
    for (size_t r = gtid; r < (size_t)M; r += gthreads) { const f32x4* p = (const f32x4*)(ssqp + r * 32); f32x4 a = p[0];
#pragma unroll
        for (int i = 1; i < 8; ++i) a += p[i];
        rstd[r] = 1.0f / sqrtf(((a.x + a.y) + (a.z + a.w)) * (1.f / DM) + EPS); }
}
__device__ __forceinline__ void tile_norm_store(LAS float* tile, bf16* dst, int row0, int col_off, int wave, int lane) {
#pragma unroll
    for (int i = 0; i < 8; ++i) { const int t = wave * 8 + i;
        const f32x4 a = *(LAS f32x4*)(tile + t * 512 + 8 * lane), b = *(LAS f32x4*)(tile + t * 512 + 8 * lane + 4);
        const float s = (a.x * a.x + a.y * a.y) + (a.z * a.z + a.w * a.w) + (b.x * b.x + b.y * b.y) + (b.z * b.z + b.w * b.w);
        const float rstd = 1.0f / sqrtf(wave_sum(s) * (1.f / 512.f) + EPS);
        v4u o; o.x = pk2(a.x * rstd, a.y * rstd); o.y = pk2(a.z * rstd, a.w * rstd); o.z = pk2(b.x * rstd, b.y * rstd); o.w = pk2(b.z * rstd, b.w * rstd);
        *(v4u*)(dst + (size_t)(row0 + t) * DM + col_off + 8 * lane) = o; }
}
__device__ __forceinline__ void poolfold_item(Frame& F, const float* __restrict__ win, const float* __restrict__ pw, const float* __restrict__ ps, const float* __restrict__ g1, bf16* BtIn, int g, int kb) {
    LAS float* At = (LAS float*)F.lds; LAS float* Bt = (LAS float*)(F.lds + 32768);
    const int k0 = 64 * kb;
#pragma unroll
    for (int i = 0; i < 4; ++i) { const int q = F.tid + 512 * i, row = q >> 5, c4 = q & 31; *(LAS f32x4*)(At + row * 128 + 4 * c4) = *(const f32x4*)(win + (size_t)(k0 + row) * DIN + 128 * g + 4 * c4) * g1[k0 + row]; }
#pragma unroll
    for (int i = 0; i < 8; ++i) { const int q = F.tid + 512 * i, row = q >> 5, c4 = q & 31; *(LAS f32x4*)(Bt + row * 128 + 4 * c4) = *(const f32x4*)(pw + (size_t)(g * 128 + row) * 128 + 4 * c4); }
    __syncthreads();
    const int n = F.tid & 127, kg = F.tid >> 7;
    float acc[16];
#pragma unroll
    for (int i = 0; i < 16; ++i) acc[i] = 0.f;
    for (int j = 0; j < 128; j += 4) {
        const float b0 = Bt[(j + 0) * 128 + n], b1 = Bt[(j + 1) * 128 + n], b2 = Bt[(j + 2) * 128 + n], b3 = Bt[(j + 3) * 128 + n];
#pragma unroll
        for (int i = 0; i < 16; ++i) { const f32x4 a = *(LAS f32x4*)(At + (kg * 16 + i) * 128 + j); acc[i] += a.x * b0 + a.y * b1 + a.z * b2 + a.w * b3; }
    }
    const float sc = ps[128 * g + n];
    v4u o0, o1;
    o0.x = pk2(acc[0] * sc, acc[1] * sc); o0.y = pk2(acc[2] * sc, acc[3] * sc); o0.z = pk2(acc[4] * sc, acc[5] * sc); o0.w = pk2(acc[6] * sc, acc[7] * sc);
    o1.x = pk2(acc[8] * sc, acc[9] * sc); o1.y = pk2(acc[10] * sc, acc[11] * sc); o1.z = pk2(acc[12] * sc, acc[13] * sc); o1.w = pk2(acc[14] * sc, acc[15] * sc);
    bf16* dst = BtIn + (size_t)(128 * g + n) * DM + k0 + kg * 16;
    *(v4u*)dst = o0; *(v4u*)(dst + 8) = o1;
    __syncthreads();
}
__device__ __forceinline__ void filter_item(Frame& F, const float* __restrict__ w1, const float* __restrict__ b1, const float* __restrict__ fr, const float* __restrict__ w2, const float* __restrict__ b2,
                                            const float* __restrict__ w3, const float* __restrict__ b3, const float* __restrict__ hbias, bf16* RF, int fi) {
    LAS float* ZF = (LAS float*)F.lds; LAS float* H1 = ZF + 512; LAS float* H2 = ZF + 1536;
    const int t0 = 16 * fi;
    if (F.tid < 272) { const int tt = F.tid / 17, f = F.tid % 17; const float t = (float)(t0 + tt);
        float v;
        if (f == 0) v = t / 2047.0f;
        else { const int j = (f - 1) & 7; const float band = 1e-4f + (float)j * ((7.0f - 1e-4f) / 7.0f); const float w = (6.283185307179586f * t) / 2048.0f; const float a = band * w; v = (f <= 8) ? __cosf(a) : -__sinf(a); }
        ZF[tt * 17 + f] = v; }
    __syncthreads();
#pragma unroll
    for (int rep = 0; rep < 2; ++rep) { const int p = F.tid + 512 * rep, tt = p >> 6, j = p & 63; float s = b1[j];
        for (int i = 0; i < 17; ++i) s += ZF[tt * 17 + i] * w1[i * 64 + j];
        H1[tt * 64 + j] = __sinf(fr[j] * s); }
    __syncthreads();
#pragma unroll
    for (int rep = 0; rep < 2; ++rep) { const int p = F.tid + 512 * rep, tt = p >> 6, j = p & 63; float s = b2[j];
        for (int i = 0; i < 64; ++i) s += H1[tt * 64 + i] * w2[i * 64 + j];
        H2[tt * 64 + j] = __sinf(fr[j] * s); }
    __syncthreads();
    const int c = F.tid;
    const float delta = -3.0701134573253944f + (float)c * ((-15.350567286626972f + 3.0701134573253944f) / 511.0f);
    const float ad = fabsf(delta);
    bf16* rf = RF + (size_t)c * hy::RFS;
#pragma unroll 1
    for (int dir = 0; dir < 2; ++dir) { const int o = dir * 512 + c; const float bo = b3[o];
#pragma unroll 1
        for (int tt = 0; tt < 16; ++tt) { float s = bo;
#pragma unroll 16
            for (int i = 0; i < 64; ++i) s += H2[tt * 64 + i] * w3[i * 1024 + o];
            const int t = t0 + tt; const float tl = (float)t / 2047.0f; float val = s * __expf(-tl * ad);
            if (dir == 0) { if (t == 0) val += hbias[c]; rf[2048 - t] = (bf16)f2bf(val); }
            else if (t >= 1) rf[2048 + t] = (bf16)f2bf(val); } }
    if (fi == 0) { rf[0] = 0;
#pragma unroll
        for (int i = 4096; i < hy::RFS; ++i) rf[i] = 0; }
    __syncthreads();
}
__device__ __forceinline__ void unpack4(const v2u w, float (&x)[4]) { x[0] = bflo(w.x); x[1] = bfhi(w.x); x[2] = bflo(w.y); x[3] = bfhi(w.y); }
__device__ __forceinline__ void pair_norm_store(Frame& F, const float (&y)[8][4], bf16* dst, size_t row0, int col_off, int cq) {
    LAS float* part = (LAS float*)F.lds;
    float ss[8];
#pragma unroll
    for (int k = 0; k < 8; ++k) ss[k] = wave_sum((y[k][0] * y[k][0] + y[k][1] * y[k][1]) + (y[k][2] * y[k][2] + y[k][3] * y[k][3]));
    if (F.lane == 0) { *(LAS f32x4*)(part + F.wave * 8) = (f32x4){ss[0], ss[1], ss[2], ss[3]}; *(LAS f32x4*)(part + F.wave * 8 + 4) = (f32x4){ss[4], ss[5], ss[6], ss[7]}; }
    __syncthreads();
    const f32x4 pa = *(LAS f32x4*)(part + (F.wave ^ 1) * 8), pb = *(LAS f32x4*)(part + (F.wave ^ 1) * 8 + 4);
    const float po[8] = {pa.x, pa.y, pa.z, pa.w, pb.x, pb.y, pb.z, pb.w};
#pragma unroll
    for (int k = 0; k < 8; ++k) { const float rstd = 1.0f / sqrtf((ss[k] + po[k]) * (1.f / 512.f) + EPS);
        v2u o; o.x = pk2(y[k][0] * rstd, y[k][1] * rstd); o.y = pk2(y[k][2] * rstd, y[k][3] * rstd);
        *(v2u*)(dst + (row0 + k) * DM + col_off + 4 * cq) = o; }
    __syncthreads();
}
__device__ __forceinline__ void hyprep_item(Frame& F, const bf16* __restrict__ PROJ, const float* __restrict__ cw, const float* __restrict__ cb, bf16* ZT, bf16* X0, int b, int tile) {
    const int tb = F.tid >> 7, cq = F.tid & 127, c0 = 4 * cq, tw = tile * 32 + tb * 8; const size_t rb = (size_t)b * SEQ;
    float z[8][4];
#pragma unroll
    for (int jj = 0; jj < 3; ++jj) { const int j = (jj == 0) ? 1 : (jj == 1) ? 2 : 0; const int cc = 512 * j + c0;
        const f32x4 w0 = *(const f32x4*)(cw + cc), w1 = *(const f32x4*)(cw + 1536 + cc), w2 = *(const f32x4*)(cw + 3072 + cc), bs = *(const f32x4*)(cb + cc);
        float x[10][4];
#pragma unroll
        for (int o = 0; o < 10; ++o) { const int t = tw - 1 + o; const bool ok = (t >= 0) && (t < SEQ); const int tc = ok ? t : tw;
            const v2u w = *(const v2u*)(PROJ + (rb + tc) * DINP + O_HY + cc); unpack4(w, x[o]);
            if (!ok) { x[o][0] = 0.f; x[o][1] = 0.f; x[o][2] = 0.f; x[o][3] = 0.f; } }
        if (jj == 0) {
#pragma unroll
            for (int k = 0; k < 8; ++k)
#pragma unroll
                for (int i = 0; i < 4; ++i) z[k][i] = w0[i] * x[k][i] + w1[i] * x[k + 1][i] + w2[i] * x[k + 2][i] + bs[i];
        } else if (jj == 1) {
#pragma unroll
            for (int k = 0; k < 8; ++k)
#pragma unroll
                for (int i = 0; i < 4; ++i) z[k][i] *= w0[i] * x[k][i] + w1[i] * x[k + 1][i] + w2[i] * x[k + 2][i] + bs[i];
#pragma unroll
            for (int i = 0; i < 4; ++i) { v4u o; o.x = pk2(z[0][i], z[1][i]); o.y = pk2(z[2][i], z[3][i]); o.z = pk2(z[4][i], z[5][i]); o.w = pk2(z[6][i], z[7][i]);
                *(v4u*)(ZT + ((size_t)(c0 + i) * NSEQ + b) * SEQ + tw) = o; }
        } else {
#pragma unroll
            for (int k = 0; k < 8; ++k) { float u0[4];
#pragma unroll
                for (int i = 0; i < 4; ++i) u0[i] = w0[i] * x[k][i] + w1[i] * x[k + 1][i] + w2[i] * x[k + 2][i] + bs[i];
                v2u o; o.x = pk2(u0[0], u0[1]); o.y = pk2(u0[2], u0[3]); *(v2u*)(X0 + (rb + tw + k) * HYC + c0) = o; }
        }
    }
}
__device__ __forceinline__ void pool_item(Frame& F, const bf16* __restrict__ PROJ, bf16* MIXED, int b, int tile) {
    const int tb = F.tid >> 7, cq = F.tid & 127, c0 = 4 * cq, g = cq >> 5, half = 1 << g, tw = tile * 32 + tb * 8; const size_t rb = (size_t)b * SEQ;
    float x[23][4];
#pragma unroll
    for (int o = 0; o < 23; ++o) { const int t = tw - 8 + o; const bool ok = (t >= 0) && (t < SEQ); const int tc = ok ? t : tw;
        const v2u w = *(const v2u*)(PROJ + (rb + tc) * DINP + c0); unpack4(w, x[o]);
        if (!ok) { x[o][0] = 0.f; x[o][1] = 0.f; x[o][2] = 0.f; x[o][3] = 0.f; } }
    float y[8][4];
#pragma unroll
    for (int k = 0; k < 8; ++k) { const int oc = 8 + k, t = tw + k; const int lo = (t - half > 0) ? t - half : 0, hi = (t + half < SEQ) ? t + half : SEQ; const float inv = 1.0f / (float)(hi - lo);
#pragma unroll
        for (int i = 0; i < 4; ++i) {
            const float w1 = x[oc - 1][i] + x[oc][i];
            const float w2 = w1 + (x[oc - 2][i] + x[oc + 1][i]);
            const float w4 = w2 + ((x[oc - 4][i] + x[oc - 3][i]) + (x[oc + 2][i] + x[oc + 3][i]));
            const float w8 = w4 + (((x[oc - 8][i] + x[oc - 7][i]) + (x[oc - 6][i] + x[oc - 5][i])) + ((x[oc + 4][i] + x[oc + 5][i]) + (x[oc + 6][i] + x[oc + 7][i])));
            const float S = (g == 0) ? w1 : (g == 1) ? w2 : (g == 2) ? w4 : w8;
            y[k][i] = S * inv - x[oc][i]; } }
    pair_norm_store(F, y, MIXED, rb + tw, 0, cq);
}
__device__ __forceinline__ void hyfin_item(Frame& F, const bf16* __restrict__ YC, const bf16* __restrict__ X0, bf16* MIXED, int b, int tile) {
    const int tb = F.tid >> 7, cq = F.tid & 127, c0 = 4 * cq, tw = tile * 32 + tb * 8; const size_t rb = (size_t)b * SEQ;
    float yc[4][8], y[8][4];
#pragma unroll
    for (int i = 0; i < 4; ++i) { const v4u v = *(const v4u*)(YC + ((size_t)(c0 + i) * NSEQ + b) * SEQ + tw);
        yc[i][0] = bflo(v.x); yc[i][1] = bfhi(v.x); yc[i][2] = bflo(v.y); yc[i][3] = bfhi(v.y); yc[i][4] = bflo(v.z); yc[i][5] = bfhi(v.z); yc[i][6] = bflo(v.w); yc[i][7] = bfhi(v.w); }
#pragma unroll
    for (int k = 0; k < 8; ++k) { float xv[4]; unpack4(*(const v2u*)(X0 + (rb + tw + k) * HYC + c0), xv);
#pragma unroll
        for (int i = 0; i < 4; ++i) y[k][i] = yc[i][k] * xv[i]; }
    pair_norm_store(F, y, MIXED, rb + tw, 1536, cq);
}
struct PrepGains { float q[3][8], k[3][8]; };
__device__ __forceinline__ void load8(const float* p, float (&o)[8]) { const f32x4 a = *(const f32x4*)p, b = *(const f32x4*)(p + 4); o[0] = a.x; o[1] = a.y; o[2] = a.z; o[3] = a.w; o[4] = b.x; o[5] = b.y; o[6] = b.z; o[7] = b.w; }
__device__ __forceinline__ void unpack8(const v4u w, float (&x)[8]) { x[0] = bflo(w.x); x[1] = bfhi(w.x); x[2] = bflo(w.y); x[3] = bfhi(w.y); x[4] = bflo(w.z); x[5] = bfhi(w.z); x[6] = bflo(w.w); x[7] = bfhi(w.w); }
__device__ __forceinline__ v4u pack8(const float (&x)[8]) { v4u o; o.x = pk2(x[0], x[1]); o.y = pk2(x[2], x[3]); o.z = pk2(x[4], x[5]); o.w = pk2(x[6], x[7]); return o; }
__device__ __forceinline__ float ssq8(const float (&x)[8]) { return ((x[0] * x[0] + x[1] * x[1]) + (x[2] * x[2] + x[3] * x[3])) + ((x[4] * x[4] + x[5] * x[5]) + (x[6] * x[6] + x[7] * x[7])); }
__device__ __forceinline__ float sum8lanes(float v) { v += __shfl_xor(v, 1); v += __shfl_xor(v, 2); v += __shfl_xor(v, 4); return v; }
__device__ __forceinline__ void prep_row(const bf16* __restrict__ PROJ, bf16* Q, bf16* KV, const PrepGains& G, const float* __restrict__ ROPE, int m, int lane) {
    const int h = lane >> 3, sub = lane & 7;
    const bf16* pr = PROJ + (size_t)m * DINP; bf16* qr = Q + (size_t)m * NQ + 192 * h + 8 * sub; bf16* kr = KV + (size_t)m * NKVP + KVHS * h + 8 * sub;
    const v4u cqv = *(const v4u*)(pr + O_CQ + 8 * lane); const v4u ckv = *(const v4u*)(pr + O_CKV + 8 * (lane & 31)); const v4u pev = *(const v4u*)(pr + O_KPE + 8 * sub);
    const v4u q0 = *(const v4u*)(qr), q1 = *(const v4u*)(qr + 64), q2 = *(const v4u*)(qr + 128);
    const v4u k0 = *(const v4u*)(kr), k1 = *(const v4u*)(kr + 64), v0 = *(const v4u*)(kr + 192), v1 = *(const v4u*)(kr + 256);
    float cs[8], sn[8]; { const float* rp = ROPE + (size_t)(m & (SEQ - 1)) * 64 + 8 * (sub & 3); load8(rp, cs); load8(rp + 32, sn); }
    float t[8];
    unpack8(cqv, t); const float rq = 1.0f / sqrtf(wave_sum(ssq8(t)) * (1.f / 512.f) + EPS);
    unpack8(ckv, t); const float rkv = 1.0f / sqrtf(wave_sum(lane < 32 ? ssq8(t) : 0.f) * (1.f / 256.f) + EPS);
    const float sg = (sub < 4) ? -1.f : 1.f;
    { float a0[8], a1[8], a2[8]; unpack8(q0, a0); unpack8(q1, a1); unpack8(q2, a2);
      const float ss = sum8lanes(ssq8(a0) + ssq8(a1) + ssq8(a2)) * (rq * rq);
      const float sc = rq / sqrtf(ss * (1.f / 192.f) + EPS);
      float r[8], o[8];
#pragma unroll
      for (int i = 0; i < 8; ++i) { a0[i] *= sc * G.q[0][i]; a1[i] *= sc * G.q[1][i]; r[i] = a2[i] * sc * G.q[2][i]; }
#pragma unroll
      for (int i = 0; i < 8; ++i) { const float rp = __shfl_xor(r[i], 4); o[i] = r[i] * cs[i] + sg * rp * sn[i]; }
      *(v4u*)(qr) = pack8(a0); *(v4u*)(qr + 64) = pack8(a1); *(v4u*)(qr + 128) = pack8(o); }
    { float a0[8], a1[8], pe[8], b0[8], b1[8]; unpack8(k0, a0); unpack8(k1, a1); unpack8(pev, pe); unpack8(v0, b0); unpack8(v1, b1);
      const float ss = sum8lanes((ssq8(a0) + ssq8(a1)) * (rkv * rkv) + ssq8(pe));
      const float sk = 1.0f / sqrtf(ss * (1.f / 192.f) + EPS);
      float r[8], o[8];
#pragma unroll
      for (int i = 0; i < 8; ++i) { a0[i] *= rkv * sk * G.k[0][i]; a1[i] *= rkv * sk * G.k[1][i]; r[i] = pe[i] * sk * G.k[2][i]; b0[i] *= rkv; b1[i] *= rkv; }
#pragma unroll
      for (int i = 0; i < 8; ++i) { const float rp = __shfl_xor(r[i], 4); o[i] = r[i] * cs[i] + sg * rp * sn[i]; }
      *(v4u*)(kr) = pack8(a0); *(v4u*)(kr + 64) = pack8(a1); *(v4u*)(kr + 128) = pack8(o); *(v4u*)(kr + 192) = pack8(b0); *(v4u*)(kr + 256) = pack8(b1); }
}
__device__ __forceinline__ void attn_norm_row(bf16* MIXED, int m, int lane) {
    v4u* p = (v4u*)(MIXED + (size_t)m * DM + 512 + 16 * lane); v4u a = p[0], b = p[1];
    unsigned w[8] = {a.x, a.y, a.z, a.w, b.x, b.y, b.z, b.w}; float s = 0.f;
#pragma unroll
    for (int i = 0; i < 8; ++i) { const float x = bflo(w[i]), y = bfhi(w[i]); s += x * x + y * y; }
    const float rstd = 1.0f / sqrtf(wave_sum(s) * (1.f / 1024.f) + EPS);
#pragma unroll
    for (int i = 0; i < 8; ++i) w[i] = pk2(bflo(w[i]) * rstd, bfhi(w[i]) * rstd);
    a.x = w[0]; a.y = w[1]; a.z = w[2]; a.w = w[3]; b.x = w[4]; b.y = w[5]; b.z = w[6]; b.w = w[7]; p[0] = a; p[1] = b;
}

__global__ void __launch_bounds__(NWAVES * 64, 2) fwd(Args args) {
    extern __shared__ __attribute__((aligned(16))) unsigned char lds_raw[];
    Frame F;
    F.lds = (LAS unsigned char*)lds_raw;
    F.tid = threadIdx.x; F.lane = F.tid & 63; F.wave = __builtin_amdgcn_readfirstlane(F.tid >> 6);
    F.G = gridDim.x; { const int bx = blockIdx.x; F.vcu = (F.G % 8 == 0) ? (bx % 8) * (F.G / 8) + bx / 8 : bx; }
    volatile LAS unsigned* MISC = (volatile LAS unsigned*)(F.lds + MISC_OFF);
    if (F.tid < 64) MISC[F.tid] = 0u;
    __syncthreads();
    unsigned char* ws = args.ws;
    unsigned* ctl = (unsigned*)(ws + WS_CTL);
    const int lo = args.ph_lo, hi = args.ph_hi;
    XcdBarrier bar; bar.bar = ctl + CW_BAR; bar.x = 0; bar.st = MISC + 8;
    if (hi - lo > 1) bar = xcd_barrier_post(ctl + CW_BAR, MISC + 8);
    bf16* BtIn = (bf16*)(ws + WS_BTIN); bf16* BtUq = (bf16*)(ws + WS_BTUQ); bf16* BtKv = (bf16*)(ws + WS_BTKV); bf16* BtOut = (bf16*)(ws + WS_BTOUT); bf16* BtUp = (bf16*)(ws + WS_BTUP); bf16* BtDn = (bf16*)(ws + WS_BTDN);
    bf16* RF = (bf16*)(ws + WS_RF); bf16* Hb = (bf16*)(ws + WS_H); bf16* PROJ = (bf16*)(ws + WS_PROJ); bf16* Qb = (bf16*)(ws + WS_Q); bf16* KVb = (bf16*)(ws + WS_KV);
    bf16* ZT = (bf16*)(ws + WS_ZT); bf16* X0 = (bf16*)(ws + WS_X0); bf16* YC = (bf16*)(ws + WS_YC); float* EDGE = (float*)(ws + WS_EDGE); float* ROPE = (float*)(ws + WS_ROPE); float* SSQP = (float*)(ws + WS_SSQP); float* RSTD = (float*)(ws + WS_RSTD); bf16* XB2 = (bf16*)(ws + WS_XB2); bf16* ACT = (bf16*)(ws + WS_ACT);
    bf16* XA = (bf16*)args.out;
    float* out = args.out;

#pragma unroll 1
    for (int layer = 0; layer < DEPTH; ++layer) {
        const int pb = layer * NPH;
        if (pb + NPH <= lo || pb >= hi) continue;
#define IN(k) (lo <= pb + (k) && pb + (k) < hi)
#define ENTER() F.tid = opq(threadIdx.x); F.lane = F.tid & 63; F.wave = __builtin_amdgcn_readfirstlane(F.tid >> 6); const int gw = F.vcu * NWAVES + F.wave, NGW = F.G * NWAVES, wg = F.vcu; const size_t gtid = (size_t)wg * 512 + F.tid, gthreads = (size_t)F.G * 512; (void)gw; (void)NGW; (void)wg; (void)gtid; (void)gthreads
#define SEAM(k) do { if (pb + (k) + 1 < hi) xcd_barrier(bar); } while (0)

        if (IN(0)) { ENTER();
            const float* win = args.in[I_WIN] + (size_t)layer * DM * DIN; const float* g1 = args.in[I_ANG] + layer * DM;
            for (int it = wg; it < 256; it += F.G) {
                if (it < 128) poolfold_item(F, win, args.in[I_PW] + (size_t)layer * 4 * 128 * 128, args.in[I_PS] + (size_t)layer * 512, g1, BtIn, it >> 5, it & 31);
                else filter_item(F, args.in[I_FW1] + (size_t)layer * 17 * 64, args.in[I_FB1] + layer * 64, args.in[I_FFR] + layer * 64, args.in[I_FW2] + (size_t)layer * 64 * 64, args.in[I_FB2] + layer * 64,
                                 args.in[I_FW3] + (size_t)layer * 64 * 1024, args.in[I_FB3] + layer * 1024, args.in[I_HBIAS] + layer * 512, RF, it - 128);
            }
            LAS float* scr = (LAS float*)(F.lds + F.wave * 8448);
            constexpr int N_IN_ = 74 * 32, N_UQ = 48 * 8, N_KV = 64 * 4, N_OUT = 64 * 32, N_UP = 352 * 32, N_DN = 64 * 88, N_ALL = N_IN_ + N_UQ + N_KV + N_OUT + N_UP + N_DN;
            for (int it = gw; it < N_ALL; it += NGW) {
                int r = it;
                if (r < N_IN_) { const int nb = 16 + r / 32, kb = r % 32; cvt_item(win, DIN, DM, BtIn, 32 * nb, 32 * nb, 64 * kb, g1, scr, F.lane); continue; } r -= N_IN_;
                if (r < N_UQ) { const int nb = r / 8, kb = r % 8; cvt_item(args.in[I_WUQ] + (size_t)layer * 512 * NQ, NQ, 512, BtUq, 32 * nb, 32 * nb, 64 * kb, args.in[I_QNG] + layer * 512, scr, F.lane); continue; } r -= N_UQ;
                if (r < N_KV) { const int nb = r / 4, kb = r % 4, h = nb >> 3, wb = nb & 7; const int dst = KVHS * h + (wb < 4 ? 32 * wb : 192 + 32 * (wb - 4));
                    cvt_item(args.in[I_WUKV] + (size_t)layer * 256 * 2048, 2048, 256, BtKv, dst, 32 * nb, 64 * kb, args.in[I_KVNG] + layer * 256, scr, F.lane); continue; } r -= N_KV;
                if (r < N_OUT) { const int nb = r / 32, kb = r % 32; cvt_item(args.in[I_WOUT] + (size_t)layer * DM * DM, DM, DM, BtOut, 32 * nb, 32 * nb, 64 * kb, args.in[I_GNG] + layer * DM, scr, F.lane); continue; } r -= N_OUT;
                if (r < N_UP) { const int nb = r / 32, kb = r % 32; const int nv = (nb < 176) ? nb : nb - 176; const int dst = 256 * (nv >> 2) + 32 * (nv & 3) + (nb < 176 ? 0 : 128);
                    cvt_item(args.in[I_WUP] + (size_t)layer * DM * NUP, NUP, DM, BtUp, dst, 32 * nb, 64 * kb, args.in[I_FNG] + layer * DM, scr, F.lane); continue; } r -= N_UP;
                { const int nb = r / 88, kb = r % 88; cvt_item(args.in[I_WDN] + (size_t)layer * DFF * DM, DM, DFF, BtDn, 32 * nb, 32 * nb, 64 * kb, nullptr, scr, F.lane); }
            }
            { v4u z = {0u, 0u, 0u, 0u};
              for (size_t i = gtid; i < (size_t)(DINP - DIN) * DM / 8; i += gthreads) *(v4u*)(BtIn + (size_t)DIN * DM + i * 8) = z;
              for (size_t i = gtid; i < (size_t)NH * 64 * 256 / 8; i += gthreads) { const int h = (int)(i / (64 * 256 / 8)), q = (int)(i % (64 * 256 / 8)); *(v4u*)(BtKv + (size_t)(KVHS * h + 128) * 256 + (size_t)q * 8) = z; } }
            if (layer == 0) for (size_t i = gtid; i < (size_t)SEQ * 32; i += gthreads) { const int pos = (int)(i >> 5), ri = (int)(i & 31);
                const float freq = exp2f(-(float)ri * (13.287712379549449f / 32.0f)); float sn, cs; sincosf((float)pos * freq, &sn, &cs); ROPE[pos * 64 + ri] = cs; ROPE[pos * 64 + 32 + ri] = sn; }
            if (layer == 0) { for (int m = gw; m < M; m += NGW) xb_row(m < MP ? args.in[I_XP] + (size_t)m * DM : args.in[I_XS] + (size_t)(m - MP) * DM, XA + (size_t)m * DM, RSTD + m, F.lane); }
            else rstd_from_partials(SSQP, RSTD, gtid, gthreads);
            SEAM(0);
        }
        if (IN(1)) { ENTER();
            pg8::Gemm g{XA, BtIn, M, DINP, DM, DM}; pg8::StaticOrder S; S.init(M, DINP, F.G, (int)blockIdx.x);
            pg8::EpiBf16 E{PROJ, DINP, RSTD};
            pg8::gemm_phase<pg8::EpiBf16, pg8::StaticOrder>(F.lds, g, S, E);
            SEAM(1);
        }
        if (IN(2)) { ENTER();
            { pg8::Gemm g{PROJ + O_CQ, BtUq, M, NQ, 512, DINP}; pg8::StaticOrder S; S.init(M, NQ, F.G, (int)blockIdx.x); pg8::EpiBf16 E{Qb, NQ, nullptr};
              pg8::gemm_phase<pg8::EpiBf16, pg8::StaticOrder>(F.lds, g, S, E); }
            { pg8::Gemm g{PROJ + O_CKV, BtKv, M, NKVP, 256, DINP}; pg8::StaticOrder S; S.init(M, NKVP, F.G, (int)blockIdx.x); pg8::EpiBf16 E{KVb, NKVP, nullptr};
              pg8::gemm_phase<pg8::EpiBf16, pg8::StaticOrder>(F.lds, g, S, E); }
            const float* hcw = args.in[I_HCW] + (size_t)layer * 3 * 1536; const float* hcb = args.in[I_HCB] + layer * 1536;
            for (int it = wg; it < 2 * NSEQ * 64; it += F.G) {
                if (it < NSEQ * 64) hyprep_item(F, PROJ, hcw, hcb, ZT, X0, it >> 6, it & 63);
                else pool_item(F, PROJ, Hb, (it - NSEQ * 64) >> 6, it & 63);
            }
            SEAM(2);
        }
        if (IN(3)) { ENTER();
            for (int u = wg; u < 2 * HYC; u += F.G) hy::conv_unit(F.lds, ZT, RF, YC, u >> 1, u & 1);
            const float* qhg = args.in[I_QHG] + layer * 192; const float* khg = args.in[I_KHG] + layer * 192;
            PrepGains PG; { const int sub = F.lane & 7;
#pragma unroll
                for (int i = 0; i < 3; ++i) { load8(qhg + 64 * i + 8 * sub, PG.q[i]); load8(khg + 64 * i + 8 * sub, PG.k[i]); } }
            for (int m = gw; m < M; m += NGW) prep_row(PROJ, Qb, KVb, PG, ROPE, m, F.lane);
            SEAM(3);
        }
        if (IN(4)) { ENTER();
            for (int i = 0; i * F.G < NSEQ * NH * 8; ++i) {
                int p, qb; const int c = (int)blockIdx.x;
                if (F.G == 256) { p = i * 32 + (c & 7) * 4 + (c >> 6); qb = (c >> 3) & 7; } else { const int Lq = i * F.G + c; p = Lq >> 3; qb = Lq & 7; }
                if (p < NSEQ * NH) { const int b = p >> 3, h = p & 7;
                    at::attn_unit(Qb + (size_t)(b * SEQ + qb * 256) * NQ + h * 192, KVb + (size_t)(b * SEQ) * NKVP + h * KVHS, KVb + (size_t)(b * SEQ) * NKVP + h * KVHS + 192,
                                  Hb + (size_t)(b * SEQ + qb * 256) * DM + 512 + h * 128, SEQ, (char*)lds_raw); }
            }
            for (int it = wg; it < NSEQ * 64; it += F.G) hyfin_item(F, YC, X0, Hb, it >> 6, it & 63);
            SEAM(4);
        }
        if (IN(5)) { ENTER();
            for (int m = gw; m < M; m += NGW) attn_norm_row(Hb, m, F.lane);
            SEAM(5);
        }
        if (IN(6)) { ENTER();
            pg8::Gemm g{Hb, BtOut, M, DM, DM, DM}; pg8::StaticOrder S; S.init(M, DM, F.G, (int)blockIdx.x);
            pg8::EpiResid16 E{XA, XB2, nullptr, DM, SSQP};
            pg8::gemm_phase<pg8::EpiResid16, pg8::StaticOrder>(F.lds, g, S, E);
            SEAM(6);
        }
        if (IN(7)) { ENTER();
            rstd_from_partials(SSQP, RSTD, gtid, gthreads);
            SEAM(7);
        }
        if (IN(8)) { ENTER();
            pg8::Gemm g{XB2, BtUp, M, NUP, DM, DM}; pg8::StaticOrder S; S.init(M, NUP, F.G, (int)blockIdx.x);
            pg8::EpiGate E{ACT, DFF, EDGE, args.in[I_FCW] + (size_t)layer * 3 * DFF, args.in[I_FCB] + layer * DFF, DFF, (LAS float*)(F.lds + HALO_OFF), RSTD};
            pg8::gemm_phase<pg8::EpiGate, pg8::StaticOrder>(F.lds, g, S, E);
            SEAM(8);
        }
        if (IN(9)) { ENTER();
            const float* fcw = args.in[I_FCW] + (size_t)layer * 3 * DFF;
            for (size_t i = gtid; i < (size_t)(M / 256) * 2 * (DFF / 4); i += gthreads) {
                const int ri = (int)(i / (DFF / 4)), c4 = (int)(i % (DFF / 4)) * 4, pm = ri >> 1, e = ri & 1;
                const float* eb = EDGE + (size_t)(ri * 3) * DFF + c4;
                f32x4 pre = *(const f32x4*)(eb + DFF); const f32x4 v = *(const f32x4*)(eb + 2 * DFF);
                if (e == 0 && (pm & 7) != 0) { const f32x4 gp = *(const f32x4*)(EDGE + (size_t)(((pm - 1) * 2 + 1) * 3) * DFF + c4); pre += *(const f32x4*)(fcw + c4) * gp; }
                if (e == 1 && (pm & 7) != 7) { const f32x4 gn = *(const f32x4*)(EDGE + (size_t)(((pm + 1) * 2 + 0) * 3) * DFF + c4); pre += *(const f32x4*)(fcw + 2 * DFF + c4) * gn; }
                v2u o; o.x = pk2(pg8::silu_f(pre.x) * v.x, pg8::silu_f(pre.y) * v.y); o.y = pk2(pg8::silu_f(pre.z) * v.z, pg8::silu_f(pre.w) * v.w);
                *(v2u*)(ACT + (size_t)(pm * 256 + (e ? 255 : 0)) * DFF + c4) = o;
            }
            SEAM(9);
        }
        if (IN(10)) { ENTER();
            pg8::Gemm g{ACT, BtDn, M, DM, DFF, DFF}; pg8::StaticOrder S; S.init(M, DM, F.G, (int)blockIdx.x);
            pg8::EpiResid16 E{XB2, (layer + 1 < DEPTH) ? XA : nullptr, (layer + 1 < DEPTH) ? nullptr : out, DM, SSQP};
            pg8::gemm_phase<pg8::EpiResid16, pg8::StaticOrder>(F.lds, g, S, E);
            SEAM(10);
        }
#undef IN
#undef ENTER
#undef SEAM
    }
}

extern "C" void kernel_launch(void* const* d_in, const int* in_sizes, int n_in, void* d_out, int out_size, void* d_ws, size_t ws_size, hipStream_t stream) {
    static int grid = 0;
    if (grid == 0) {
        if (n_in != N_IN || out_size != M * DM || ws_size < WS_END) { fprintf(stderr, "kernel_launch: unexpected shapes (n_in %d, out %d, ws %zu, need %zu)\n", n_in, out_size, ws_size, (size_t)WS_END); grid = -1; return; }
        int dev = 0, cus = 0;
        if (hipGetDevice(&dev) != hipSuccess || hipDeviceGetAttribute(&cus, hipDeviceAttributeMultiprocessorCount, dev) != hipSuccess) { grid = -1; return; }
        if (hipFuncSetAttribute((const void*)fwd, hipFuncAttributeMaxDynamicSharedMemorySize, LDS_BYTES) != hipSuccess) { fprintf(stderr, "kernel_launch: hipFuncSetAttribute failed\n"); grid = -1; return; }
        int per_cu = 0;
        if (hipOccupancyMaxActiveBlocksPerMultiprocessor(&per_cu, (const void*)fwd, NWAVES * 64, LDS_BYTES) != hipSuccess || per_cu < 1) fprintf(stderr, "kernel_launch: occupancy query reports %d\n", per_cu);
        (void)hipGetLastError();
        grid = cus;
    }
    if (grid < 0) return;
    (void)hipMemsetAsync((char*)d_ws + WS_CTL, 0, CTL_BYTES, stream);
    Args a{};
    for (int i = 0; i < N_IN; ++i) a.in[i] = (const float*)d_in[i];
    a.out = (float*)d_out; a.ws = (unsigned char*)d_ws;
#if MK_ONE_LAUNCH
    a.ph_lo = 0; a.ph_hi = DEPTH * NPH;
    hipLaunchKernelGGL(fwd, dim3(grid), dim3(NWAVES * 64), LDS_BYTES, stream, a);
#else
    for (int p = 0; p < DEPTH * NPH; ++p) { a.ph_lo = p; a.ph_hi = p + 1; hipLaunchKernelGGL(fwd, dim3(grid), dim3(NWAVES * 64), LDS_BYTES, stream, a); }
#endif
    const hipError_t le = hipPeekAtLastError();
    if (le != hipSuccess) fprintf(stderr, "kernel_launch: launch failed: %s\n", hipGetErrorName(le));
}
```

```cpp
#include <hip/hip_runtime.h>
#include <cstdio>
#include <cstdint>
__device__ __forceinline__ int opq(int x) { asm volatile("" : "+v"(x)); return x; }
#ifndef STAGGER_TICKS
#define STAGGER_TICKS 0
#endif
namespace pg8 {
#define PG8_LAS __attribute__((address_space(3)))
typedef unsigned short bf16_t;
typedef short bf16x8 __attribute__((ext_vector_type(8)));
typedef float f32x4 __attribute__((ext_vector_type(4)));
typedef unsigned u32x4 __attribute__((ext_vector_type(4)));
constexpr int BM = 256, BK = 64, HALF = 128, HTB = HALF * BK * 2  , STAGE_BYTES = 8 * HTB, NXCD = 8, WGM = 8;

__host__ __device__ __forceinline__ int lds_byte(int r, int c) { const int st = (r >> 4) * 2 + (c >> 5), rr = r & 15, cc = c & 31, ob = rr * 64 + cc * 2; return st * 1024 + (ob ^ (((ob >> 9) & 1) << 5)); }
__host__ __device__ __forceinline__ void stage_rc(int b, int& R, int& C) { const int st = b / 1024, sb = b % 1024, swz = sb ^ (((sb >> 9) & 1) << 5); R = (st >> 1) * 16 + swz / 64; C = (st & 1) * 32 + (swz % 64) / 2; }
__host__ __device__ __forceinline__ int perm32(int rho) { const int n = rho >> 4, i = rho & 15; return 8 * (i >> 2) + 4 * n + (i & 3); }

struct Unit { int pm, pn; };
struct Gemm { const bf16_t* A; const bf16_t* Bt; int M, N, K, lda; };

struct StaticOrder {
    int nM, nN, nwg, G, c;
    __host__ __device__ void init(int M, int N, int G_, int c_) { nM = M / BM; nN = N / BM; nwg = nM * nN; G = G_; c = c_; }
    __host__ __device__ bool next(int i, Unit& u) const {
        const long L = (long)i * G + c; if (L >= nwg) return false;
        int wgid = (int)L; { const int q = nwg / NXCD, r = nwg % NXCD, xcd = wgid % NXCD, off = wgid / NXCD; wgid = (xcd < r ? xcd * (q + 1) : r * (q + 1) + (xcd - r) * q) + off; }
        const int nig = WGM * nN, gid = wgid / nig, fm = gid * WGM, gsz = (nM - fm) < WGM ? (nM - fm) : WGM;
        u.pm = fm + ((wgid % nig) % gsz); u.pn = (wgid % nig) / gsz; return true;
    }
    __device__ __forceinline__ void a_ready(const Unit&) const {}
    __device__ __forceinline__ void done(const Unit&) const {}
};

__device__ __forceinline__ unsigned cvt_pk_bf16(float lo, float hi) { unsigned r; asm volatile("v_cvt_pk_bf16_f32 %0, %1, %2" : "=v"(r) : "v"(lo), "v"(hi)); return r; }

struct LineOffs { unsigned o0, o1; bool odd; };
__device__ __forceinline__ LineOffs line_offs(unsigned lo, int pitch, int fr) { LineOffs L; L.odd = fr & 1; L.o0 = L.odd ? lo - (unsigned)pitch + 32u : lo; L.o1 = L.odd ? lo + 32u : lo + (unsigned)pitch; return L; }
__device__ __forceinline__ void store_lines(bf16_t* base, const LineOffs& L, u32x4 a, u32x4 b) {
    const u32x4 snd = L.odd ? a : b; u32x4 rcv;
    rcv.x = (unsigned)__shfl_xor((int)snd.x, 1); rcv.y = (unsigned)__shfl_xor((int)snd.y, 1); rcv.z = (unsigned)__shfl_xor((int)snd.z, 1); rcv.w = (unsigned)__shfl_xor((int)snd.w, 1);
    *(u32x4*)(base + L.o0) = L.odd ? rcv : a;
    *(u32x4*)(base + L.o1) = L.odd ? b : rcv;
}
struct EpiBf16 {
    static constexpr bool PERM = true;
    bf16_t* O; int ldc; const float* rstd;
    __device__ __forceinline__ void operator()(f32x4 (&acc)[2][2][4][2], const Unit& u, int wr, int wc, int fr, int fq) const {
        bf16_t* Ot = O + (size_t)(u.pm * BM) * ldc + u.pn * BM;
        const LineOffs L = line_offs((unsigned)((wr * 64 + fr) * ldc + wc * 64 + 8 * fq), ldc, fr); const int row0 = u.pm * BM + wr * 64 + fr;
#pragma unroll
        for (int ai = 0; ai < 2; ++ai)
#pragma unroll
            for (int m = 0; m < 4; ++m) { const float rs = rstd ? rstd[row0 + ai * HALF + m * 16] : 1.0f;
                u32x4 w[2];
#pragma unroll
                for (int bj = 0; bj < 2; ++bj) { const f32x4 v0 = acc[ai][bj][m][0] * rs, v1 = acc[ai][bj][m][1] * rs;
                    w[bj].x = cvt_pk_bf16(v0[0], v0[1]); w[bj].y = cvt_pk_bf16(v0[2], v0[3]); w[bj].z = cvt_pk_bf16(v1[0], v1[1]); w[bj].w = cvt_pk_bf16(v1[2], v1[3]); }
                store_lines(Ot + (size_t)((ai * HALF + m * 16) * ldc), L, w[0], w[1]);
                asm volatile("" ::: "memory"); }
    }
};
struct EpiResid16 {
    static constexpr bool PERM = true;
    const bf16_t* base; bf16_t* xo; float* out; int ldc; float* ssqp; int f32out;
    __device__ __forceinline__ void operator()(f32x4 (&acc)[2][2][4][2], const Unit& u, int wr, int wc, int fr, int fq) const {
        const size_t tb = (size_t)(u.pm * BM) * ldc + u.pn * BM;
        const bf16_t* bs = base + tb; bf16_t* xp = xo + tb; float* op = out + tb; const bool fo = f32out != 0;
        const unsigned lo = (unsigned)((wr * 64 + fr) * ldc + wc * 64 + 8 * fq); const LineOffs L = line_offs(lo, ldc, fr);
#pragma unroll
        for (int ai = 0; ai < 2; ++ai)
#pragma unroll
            for (int m = 0; m < 4; ++m) { const unsigned off = lo + (unsigned)((ai * HALF + m * 16) * ldc); float s = 0.f; u32x4 wv[2];
#pragma unroll
                for (int bj = 0; bj < 2; ++bj) { const u32x4 b = *(const u32x4*)(bs + off + bj * 32);
                    f32x4 x0, x1;
                    x0[0] = __builtin_bit_cast(float, b.x << 16) + acc[ai][bj][m][0][0]; x0[1] = __builtin_bit_cast(float, b.x & 0xffff0000u) + acc[ai][bj][m][0][1];
                    x0[2] = __builtin_bit_cast(float, b.y << 16) + acc[ai][bj][m][0][2]; x0[3] = __builtin_bit_cast(float, b.y & 0xffff0000u) + acc[ai][bj][m][0][3];
                    x1[0] = __builtin_bit_cast(float, b.z << 16) + acc[ai][bj][m][1][0]; x1[1] = __builtin_bit_cast(float, b.z & 0xffff0000u) + acc[ai][bj][m][1][1];
                    x1[2] = __builtin_bit_cast(float, b.w << 16) + acc[ai][bj][m][1][2]; x1[3] = __builtin_bit_cast(float, b.w & 0xffff0000u) + acc[ai][bj][m][1][3];
                    if (fo) { *(f32x4*)(op + off + bj * 32) = x0; *(f32x4*)(op + off + bj * 32 + 4) = x1; }
                    if (!fo) { u32x4 w; w.x = cvt_pk_bf16(x0[0], x0[1]); w.y = cvt_pk_bf16(x0[2], x0[3]); w.z = cvt_pk_bf16(x1[0], x1[1]); w.w = cvt_pk_bf16(x1[2], x1[3]); wv[bj] = w;
                        s += ((x0[0] * x0[0] + x0[1] * x0[1]) + (x0[2] * x0[2] + x0[3] * x0[3])) + ((x1[0] * x1[0] + x1[1] * x1[1]) + (x1[2] * x1[2] + x1[3] * x1[3])); } }
                if (!fo) { store_lines(xp + (size_t)((ai * HALF + m * 16) * ldc), L, wv[0], wv[1]); s += __shfl_xor(s, 16); s += __shfl_xor(s, 32); if (fq == 0) ssqp[(size_t)(u.pm * BM + wr * 64 + fr + ai * HALF + m * 16) * 32 + u.pn * 4 + wc] = s; }
                asm volatile("" ::: "memory"); }
    }
};
__device__ __forceinline__ float silu_f(float x) { return x * __builtin_amdgcn_rcpf(1.0f + __builtin_amdgcn_exp2f(-1.4426950408889634f * x)); }
struct EpiGate {
    static constexpr bool PERM = true;
    bf16_t* act; int ldact; float* edge; const float* cw; const float* cb; int dff; PG8_LAS float* halo; const float* rstd;
    __device__ __forceinline__ void operator()(f32x4 (&acc)[2][2][4][2], const Unit& u, int wr, int wc, int fr, int fq) const {
        const int lane = fq * 16 + fr; const int colL = wc * 32 + 8 * fq; const int colG = u.pn * HALF + colL;
#pragma unroll
        for (int ai = 0; ai < 2; ++ai)
#pragma unroll
            for (int m = 0; m < 4; ++m) { const float rs = rstd[u.pm * BM + ai * HALF + wr * 64 + m * 16 + fr];
#pragma unroll
                for (int bj = 0; bj < 2; ++bj) { acc[ai][bj][m][0] *= rs; acc[ai][bj][m][1] *= rs; } }
#pragma unroll
        for (int ai = 0; ai < 2; ++ai) { const int q = 2 * ai + wr;
            if (fr == 0) { *(PG8_LAS f32x4*)(halo + (q * 2 + 0) * 128 + colL) = acc[ai][0][0][0]; *(PG8_LAS f32x4*)(halo + (q * 2 + 0) * 128 + colL + 4) = acc[ai][0][0][1]; }
            if (fr == 15) { *(PG8_LAS f32x4*)(halo + (q * 2 + 1) * 128 + colL) = acc[ai][0][3][0]; *(PG8_LAS f32x4*)(halo + (q * 2 + 1) * 128 + colL + 4) = acc[ai][0][3][1]; } }
        asm volatile("s_waitcnt lgkmcnt(0)" ::: "memory"); __builtin_amdgcn_s_barrier(); asm volatile("" ::: "memory");
        const int srcR = (lane & 48) | ((fr - 1) & 15), srcL = (lane & 48) | ((fr + 1) & 15);
        bf16_t* actp = act + (size_t)(u.pm * BM) * ldact + colG; const unsigned rlo = (unsigned)((wr * 64 + fr) * ldact);
#pragma unroll
        for (int ai = 0; ai < 2; ++ai) { const int q = 2 * ai + wr;
            typedef unsigned u32x2 __attribute__((ext_vector_type(2)));
            u32x2 pk[4][2];
#pragma unroll
            for (int n = 0; n < 2; ++n) {
                const f32x4 w0 = *(const f32x4*)(cw + colG + 4 * n), w1 = *(const f32x4*)(cw + dff + colG + 4 * n), w2 = *(const f32x4*)(cw + 2 * dff + colG + 4 * n), bb = *(const f32x4*)(cb + colG + 4 * n);
                f32x4 ht = *(PG8_LAS f32x4*)(halo + ((q > 0 ? q - 1 : 0) * 2 + 1) * 128 + colL + 4 * n), hb = *(PG8_LAS f32x4*)(halo + ((q < 3 ? q + 1 : 3) * 2 + 0) * 128 + colL + 4 * n);
                if (q == 0) ht = ht * 0.f; if (q == 3) hb = hb * 0.f;
                f32x4 pre[4];
#pragma unroll
                for (int j = 0; j < 4; ++j) {
                    float g[4], rr[4], rl[4];
#pragma unroll
                    for (int m = 0; m < 4; ++m) { g[m] = acc[ai][0][m][n][j]; rr[m] = __shfl(g[m], srcR); rl[m] = __shfl(g[m], srcL); }
#pragma unroll
                    for (int m = 0; m < 4; ++m) {
                        const float up = (fr > 0) ? rr[m] : (m > 0 ? rr[m > 0 ? m - 1 : 0] : ht[j]);
                        const float dn = (fr < 15) ? rl[m] : (m < 3 ? rl[m < 3 ? m + 1 : 3] : hb[j]);
                        pre[m][j] = w0[j] * up + w1[j] * g[m] + w2[j] * dn + bb[j];
                    }
                }
                if (q == 0 && fr == 0) { float* e = edge + (size_t)((u.pm * 2 + 0) * 3) * dff + colG + 4 * n;
                    *(f32x4*)(e) = acc[ai][0][0][n]; *(f32x4*)(e + dff) = pre[0]; *(f32x4*)(e + 2 * dff) = acc[ai][1][0][n]; }
                if (q == 3 && fr == 15) { float* e = edge + (size_t)((u.pm * 2 + 1) * 3) * dff + colG + 4 * n;
                    *(f32x4*)(e) = acc[ai][0][3][n]; *(f32x4*)(e + dff) = pre[3]; *(f32x4*)(e + 2 * dff) = acc[ai][1][3][n]; }
#pragma unroll
                for (int m = 0; m < 4; ++m) { const f32x4 v = acc[ai][1][m][n];
                    pk[m][n].x = cvt_pk_bf16(silu_f(pre[m][0]) * v[0], silu_f(pre[m][1]) * v[1]); pk[m][n].y = cvt_pk_bf16(silu_f(pre[m][2]) * v[2], silu_f(pre[m][3]) * v[3]); }
            }
#pragma unroll
            for (int m = 0; m < 4; ++m) { u32x4 w; w.x = pk[m][0].x; w.y = pk[m][0].y; w.z = pk[m][1].x; w.w = pk[m][1].y;
                *(u32x4*)(actp + rlo + (unsigned)((ai * HALF + m * 16) * ldact)) = w; }
        }
    }
};

template <class Epi, class Sched>
__device__ __forceinline__ void gemm_phase(PG8_LAS unsigned char* lds, const Gemm g, const Sched& S, const Epi& E) {
    const int tid = opq(threadIdx.x), wid = __builtin_amdgcn_readfirstlane(tid >> 6), lane = tid & 63, wr = wid >> 2, wc = wid & 3, fr = lane & 15, fq = lane >> 4;
    const int K = g.K, nt = K / BK, lda = g.lda;
    unsigned voffA[2], voffB[2];
#pragma unroll
    for (int i = 0; i < 2; ++i) { int R, C; stage_rc(tid * 16 + i * 8192, R, C); const int Rb = Epi::PERM ? (64 * (R >> 5) + perm32(R & 31)) : R;
        voffA[i] = (unsigned)(R * lda + C) * 2u; voffB[i] = (unsigned)(Rb * K + C) * 2u; }
    const size_t kstep = (size_t)(BK * 2);
    const size_t hstepA = (size_t)HALF * lda * 2, hstepB = (size_t)(Epi::PERM ? 32 : HALF) * K * 2;
    const size_t tstepA = 2 * hstepA, tstepB = (size_t)BM * K * 2;
    const unsigned ldsw = (unsigned)wid * 1024u;
    const int aoff = lds_byte(wr * 64 + fr, fq * 8), boff = lds_byte(wc * 32 + fr, fq * 8);
#define PG8_SA(b, h) (((b) * 2 + (h)) * HTB)
#define PG8_SB(b, h) ((4 + (b) * 2 + (h)) * HTB)
#define PG8_STAGE(bufoff, gbase, voff) do { _Pragma("unroll") for (int _i = 0; _i < 2; ++_i) \
        __builtin_amdgcn_global_load_lds((const unsigned*)((const char*)(gbase) + (voff)[_i]), (PG8_LAS unsigned*)(lds + (bufoff) + ldsw + _i * 8192), 16, 0, 0); } while (0)
#define PG8_LDA(dst, b, h) do { _Pragma("unroll") for (int m = 0; m < 4; ++m) _Pragma("unroll") for (int k = 0; k < 2; ++k) dst[m][k] = *(const PG8_LAS bf16x8*)(lds + PG8_SA(b, h) + aoff + m * 2048 + k * 1024); } while (0)
#define PG8_LDB(dst, b, h) do { _Pragma("unroll") for (int n = 0; n < 2; ++n) _Pragma("unroll") for (int k = 0; k < 2; ++k) dst[n][k] = *(const PG8_LAS bf16x8*)(lds + PG8_SB(b, h) + boff + n * 2048 + k * 1024); } while (0)
#define PG8_MMA(ai, bj, At, Bt) do { __builtin_amdgcn_s_setprio(1); _Pragma("unroll") for (int m = 0; m < 4; ++m) _Pragma("unroll") for (int n = 0; n < 2; ++n) _Pragma("unroll") for (int k = 0; k < 2; ++k) \
        acc[ai][bj][m][n] = __builtin_amdgcn_mfma_f32_16x16x32_bf16(Bt[n][k], At[m][k], acc[ai][bj][m][n], 0, 0, 0); __builtin_amdgcn_s_setprio(0); } while (0)
#define PG8_WAIT_V(n) asm volatile("s_waitcnt vmcnt(" #n ")" ::: "memory")
#define PG8_WAIT_L(n) asm volatile("s_waitcnt lgkmcnt(" #n ")" ::: "memory")
#define PG8_BAR __builtin_amdgcn_s_barrier()
#define PG8_SCHED __builtin_amdgcn_sched_barrier(0)
    Unit cur, nxt; int ui = 0;
    if (!S.next(0, cur)) return;
    if (STAGGER_TICKS > 0) {
        const unsigned long long t0 = __builtin_amdgcn_s_memrealtime(), dt = (unsigned long long)(((unsigned)blockIdx.x >> 3) & 3u) * STAGGER_TICKS;
        while (__builtin_amdgcn_s_memrealtime() - t0 < dt) __builtin_amdgcn_s_sleep(8);
    }
    f32x4 acc[2][2][4][2];
{ float zf = 0.f; asm volatile("" : "+v"(zf));
    #pragma unroll
    for (int a = 0; a < 2; ++a)
#pragma unroll
        for (int b = 0; b < 2; ++b)
#pragma unroll
            for (int m = 0; m < 4; ++m)
#pragma unroll
                for (int n = 0; n < 2; ++n) acc[a][b][m][n] = (f32x4){zf, zf, zf, zf}; }
    bf16x8 At[4][2], B0[2][2], B1[2][2];
    const char* cA = (const char*)g.A + (size_t)cur.pm * tstepA; const char* cB = (const char*)g.Bt + (size_t)cur.pn * tstepB;
    S.a_ready(cur);
    PG8_STAGE(PG8_SB(0, 0), cB, voffB); PG8_STAGE(PG8_SB(0, 1), cB + hstepB, voffB); PG8_STAGE(PG8_SA(0, 0), cA, voffA); PG8_STAGE(PG8_SA(0, 1), cA + hstepA, voffA);
    if (wr == 1) PG8_BAR;
    PG8_WAIT_V(2); PG8_BAR;
    PG8_STAGE(PG8_SB(1, 0), cB + kstep, voffB); PG8_STAGE(PG8_SA(1, 0), cA + kstep, voffA); PG8_STAGE(PG8_SB(1, 1), cB + hstepB + kstep, voffB);
    PG8_WAIT_V(6); PG8_BAR;
    for (;;) {
        const bool has_next = S.next(ui + 1, nxt);
        const char* nA = has_next ? (const char*)g.A + (size_t)nxt.pm * tstepA : cA; const char* nB = has_next ? (const char*)g.Bt + (size_t)nxt.pn * tstepB : cB;
#pragma unroll 1
        for (int t = 0; t < nt; t += 2) {
            const bool last = (t == nt - 2);
            const char* a1 = cA + (size_t)(t + 1) * kstep;
            const char* a2 = last ? nA : cA + (size_t)(t + 2) * kstep; const char* b2 = last ? nB : cB + (size_t)(t + 2) * kstep;
            const char* a3 = a2 + kstep; const char* b3 = b2 + kstep;
            if (last && has_next) S.a_ready(nxt);
            const bool fst = (t == 0) && (ui > 0);
            PG8_LDB(B0, 0, 0); PG8_LDB(B1, 0, 1); PG8_SCHED; PG8_LDA(At, 0, 0); PG8_STAGE(PG8_SA(1, 1), a1 + hstepA, voffA);
            if (fst) PG8_WAIT_V(24); else PG8_WAIT_V(8);
            PG8_WAIT_L(0); PG8_BAR; PG8_MMA(0, 0, At, B0); PG8_MMA(0, 1, At, B1); PG8_BAR; PG8_SCHED;
            PG8_LDA(At, 0, 1); PG8_STAGE(PG8_SB(0, 0), b2, voffB); PG8_STAGE(PG8_SB(0, 1), b2 + hstepB, voffB); PG8_STAGE(PG8_SA(0, 0), a2, voffA);
            if (fst) PG8_WAIT_V(24); else PG8_WAIT_V(8);
            PG8_WAIT_L(0); PG8_BAR; PG8_MMA(1, 0, At, B0); PG8_MMA(1, 1, At, B1); PG8_BAR; PG8_SCHED;
            PG8_LDB(B0, 1, 0); PG8_LDB(B1, 1, 1); PG8_SCHED; PG8_LDA(At, 1, 0); PG8_STAGE(PG8_SA(0, 1), a2 + hstepA, voffA);
            PG8_WAIT_V(8); PG8_WAIT_L(0); PG8_BAR; PG8_MMA(0, 0, At, B0); PG8_MMA(0, 1, At, B1); PG8_BAR; PG8_SCHED;
            PG8_LDA(At, 1, 1); PG8_STAGE(PG8_SB(1, 0), b3, voffB); PG8_STAGE(PG8_SB(1, 1), b3 + hstepB, voffB); PG8_STAGE(PG8_SA(1, 0), a3, voffA);
            PG8_WAIT_V(8); PG8_WAIT_L(0); PG8_BAR; PG8_MMA(1, 0, At, B0); PG8_MMA(1, 1, At, B1); PG8_BAR; PG8_SCHED;
        }
        if (wr == 0) PG8_BAR;
        E(acc, cur, wr, wc, fr, fq); S.done(cur);
        if (!has_next) break;
{ float zf = 0.f; asm volatile("" : "+v"(zf));
        #pragma unroll
        for (int a = 0; a < 2; ++a)
#pragma unroll
            for (int b = 0; b < 2; ++b)
#pragma unroll
                for (int m = 0; m < 4; ++m)
#pragma unroll
                    for (int n = 0; n < 2; ++n) acc[a][b][m][n] = (f32x4){zf, zf, zf, zf}; }
        cur = nxt; cA = nA; cB = nB; ++ui;
        if (wr == 1) PG8_BAR;
    }
    PG8_WAIT_V(0);
    PG8_BAR;
#undef PG8_SA
#undef PG8_SB
#undef PG8_STAGE
#undef PG8_LDA
#undef PG8_LDB
#undef PG8_MMA
#undef PG8_WAIT_V
#undef PG8_WAIT_L
#undef PG8_BAR
#undef PG8_SCHED
}
}
namespace at {
using bf16 = unsigned short;
using bf16x8 = __attribute__((ext_vector_type(8))) short;
using s16x4  = __attribute__((ext_vector_type(4))) short;
using f32x16 = __attribute__((ext_vector_type(16))) float;
using u32x4  = __attribute__((ext_vector_type(4))) unsigned;
constexpr int DQK = 192, DV = 128, KVBLK = 64, NW = 8, QBLK = 32;
constexpr float SCALE = 0.07216878364870322f;
constexpr float THR = 8.f;
constexpr int LDQ = 1536, LDK = 2560, LDO = 2048;
constexpr int SHM_V = KVBLK * DV * 2, SHM_K = 12 * 2080;
constexpr int QR_OFF = 2 * SHM_V + 2 * SHM_K + NW * 64 * 4;
constexpr int SHM_ATTN = QR_OFF + NW * 4096;
#define SBAR() __builtin_amdgcn_sched_barrier(0)
constexpr int KPL = 2080;
__host__ __device__ __forceinline__ int k_st(int row, int c) { return (c >> 1) * KPL + row * 32 + (((c & 1) ^ ((row >> 3) & 1)) << 4); }
__host__ __device__ __forceinline__ int k_rd_base(int r32, int hi) { return r32 * 32 + ((hi ^ ((r32 >> 3) & 1)) << 4); }
__device__ __forceinline__ int crow(int r, int hi) { return (r & 3) + 8 * (r >> 2) + 4 * hi; }
__device__ __forceinline__ unsigned cvtpk(float lo, float hi) { unsigned r; asm volatile("v_cvt_pk_bf16_f32 %0, %1, %2" : "=v"(r) : "v"(lo), "v"(hi)); return r; }

__device__ __forceinline__ void partialSM(f32x16& p0, f32x16& p1, float& m_reg, float& mn, float& alpha) {
  constexpr float C = SCALE * 1.4426950408889634f;
  float pmax = p0[0];
#pragma unroll
  for (int r = 1; r < 16; ++r) pmax = fmaxf(pmax, p0[r]);
#pragma unroll
  for (int r = 0; r < 16; ++r) pmax = fmaxf(pmax, p1[r]);
  { auto rr = __builtin_amdgcn_permlane32_swap(__float_as_uint(pmax), __float_as_uint(pmax), false, false);
    pmax = fmaxf(__uint_as_float(rr[0]), __uint_as_float(rr[1])); }
  if (__builtin_expect(__all(pmax - m_reg <= THR / SCALE), 1)) { mn = m_reg; alpha = 1.f; }
  else { mn = fmaxf(m_reg, pmax); alpha = __builtin_amdgcn_exp2f((m_reg - mn) * C); m_reg = mn; }
  float mnC = -mn * C;
#pragma unroll
  for (int r = 0; r < 16; ++r) p0[r] = fmaf(p0[r], C, mnC);
#pragma unroll
  for (int r = 0; r < 16; ++r) p1[r] = fmaf(p1[r], C, mnC);
#pragma unroll
  for (int r = 0; r < 16; ++r) p0[r] = __builtin_amdgcn_exp2f(p0[r]);
}
__device__ __forceinline__ void finishSM(f32x16& p0, f32x16& p1, float alpha, float& l_reg, bf16x8& pa0, bf16x8& pa1, bf16x8& pa2, bf16x8& pa3) {
#pragma unroll
  for (int r = 0; r < 16; ++r) p1[r] = __builtin_amdgcn_exp2f(p1[r]);
  float ps = 0;
#pragma unroll
  for (int r = 0; r < 16; ++r) ps += p0[r];
#pragma unroll
  for (int r = 0; r < 16; ++r) ps += p1[r];
  { auto rr = __builtin_amdgcn_permlane32_swap(__float_as_uint(ps), __float_as_uint(ps), false, false);
    ps = __uint_as_float(rr[0]) + __uint_as_float(rr[1]); }
  l_reg = l_reg * alpha + ps;
#define PK4(P, BASE, OUT) do { unsigned a0 = cvtpk(P[BASE + 0], P[BASE + 1]), a1 = cvtpk(P[BASE + 2], P[BASE + 3]);   \
    unsigned b0 = cvtpk(P[BASE + 4], P[BASE + 5]), b1 = cvtpk(P[BASE + 6], P[BASE + 7]);                              \
    auto r0 = __builtin_amdgcn_permlane32_swap(a0, b0, false, false); auto r1 = __builtin_amdgcn_permlane32_swap(a1, b1, false, false); \
    u32x4 w = {r0[0], r1[0], r0[1], r1[1]}; OUT = *reinterpret_cast<bf16x8*>(&w); } while (0)
  PK4(p0, 0, pa0); PK4(p0, 8, pa1); PK4(p1, 0, pa2); PK4(p1, 8, pa3);
#undef PK4
}
template <int OFF> __device__ __forceinline__ bf16x8 k_read(int kb) {
  bf16x8 r; asm volatile("ds_read_b128 %0, %1 offset:%2" : "=v"(r) : "v"(kb), "i"(OFF) : "memory"); return r;
}
__device__ __forceinline__ void qkt(f32x16& p0, f32x16& p1, int kb, const bf16x8* qr, int qb) {
  p0 = f32x16{}; p1 = f32x16{};
#define QK1(d0) { const bf16x8 b0 = *(const __attribute__((address_space(3))) bf16x8*)(kb + d0 * KPL), b1 = *(const __attribute__((address_space(3))) bf16x8*)(kb + d0 * KPL + 1024); \
    p0 = __builtin_amdgcn_mfma_f32_32x32x16_bf16(b0, qr[d0], p0, 0, 0, 0); p1 = __builtin_amdgcn_mfma_f32_32x32x16_bf16(b1, qr[d0], p1, 0, 0, 0); }
#define QK2(d0) { const bf16x8 b0 = *(const __attribute__((address_space(3))) bf16x8*)(kb + d0 * KPL), b1 = *(const __attribute__((address_space(3))) bf16x8*)(kb + d0 * KPL + 1024); \
    const bf16x8 qf = *(const __attribute__((address_space(3))) bf16x8*)(qb + (d0 - 8) * 1024); \
    p0 = __builtin_amdgcn_mfma_f32_32x32x16_bf16(b0, qf, p0, 0, 0, 0); p1 = __builtin_amdgcn_mfma_f32_32x32x16_bf16(b1, qf, p1, 0, 0, 0); }
  QK1(0) QK1(1) QK1(2) QK1(3) QK1(4) QK1(5) QK1(6) QK1(7) QK2(8) QK2(9) QK2(10) QK2(11)
#undef QK1
#undef QK2
}
__host__ __device__ __forceinline__ int v_st(int k, int c) { const int kk = (k & ~0xC) | ((k & 4) << 1) | ((k & 8) >> 1); return ((kk >> 3) * 4 + (c >> 5)) * 512 + ((kk & 7) * 32 + (c & 31)) * 2; }
__device__ __forceinline__ int v_rd_base(int lane) { return ((lane & 3) << 3) | (((lane >> 2) & 3) << 6) | (((lane >> 4) & 1) << 5) | (((lane >> 5) & 1) << 8); }
constexpr int v_rd_off(int d0, int ks, int half) { return d0 * 512 + ks * 4096 + half * 2048; }
template <int OFF> __device__ __forceinline__ s16x4 tr_read(int vb) {
  s16x4 r; asm volatile("ds_read_b64_tr_b16 %0, %1 offset:%2" : "=&v"(r) : "v"(vb), "i"(OFF) : "memory"); return r;
}
template <int D0> __device__ __forceinline__ void pv_one(f32x16& od, int vb, bf16x8 pa0, bf16x8 pa1, bf16x8 pa2, bf16x8 pa3) {
  const s16x4 l0 = tr_read<v_rd_off(D0, 0, 0)>(vb), h0 = tr_read<v_rd_off(D0, 0, 1)>(vb), l1 = tr_read<v_rd_off(D0, 1, 0)>(vb), h1 = tr_read<v_rd_off(D0, 1, 1)>(vb);
  const s16x4 l2 = tr_read<v_rd_off(D0, 2, 0)>(vb), h2 = tr_read<v_rd_off(D0, 2, 1)>(vb), l3 = tr_read<v_rd_off(D0, 3, 0)>(vb), h3 = tr_read<v_rd_off(D0, 3, 1)>(vb);
  asm volatile("s_waitcnt lgkmcnt(0)" ::: "memory"); SBAR();
#define PK(L, H) (bf16x8){L[0], L[1], L[2], L[3], H[0], H[1], H[2], H[3]}
  od = __builtin_amdgcn_mfma_f32_32x32x16_bf16(pa0, PK(l0, h0), od, 0, 0, 0);
  od = __builtin_amdgcn_mfma_f32_32x32x16_bf16(pa1, PK(l1, h1), od, 0, 0, 0);
  od = __builtin_amdgcn_mfma_f32_32x32x16_bf16(pa2, PK(l2, h2), od, 0, 0, 0);
  od = __builtin_amdgcn_mfma_f32_32x32x16_bf16(pa3, PK(l3, h3), od, 0, 0, 0);
#undef PK
}
__device__ __forceinline__ void pv_d0(f32x16* o, int vb, bf16x8 pa0, bf16x8 pa1, bf16x8 pa2, bf16x8 pa3) {
  pv_one<0>(o[0], vb, pa0, pa1, pa2, pa3); pv_one<1>(o[1], vb, pa0, pa1, pa2, pa3); pv_one<2>(o[2], vb, pa0, pa1, pa2, pa3); pv_one<3>(o[3], vb, pa0, pa1, pa2, pa3);
}

__device__ __forceinline__ void attn_unit(const bf16* __restrict__ Qb, const bf16* __restrict__ Kh, const bf16* __restrict__ Vh, bf16* __restrict__ Ob, int seq, char* lds) {
  const int tid = opq(threadIdx.x), wid = tid >> 6, lane = tid & 63, r32 = lane & 31, hi = lane >> 5;
  char* V_lds = lds; char* K_lds = lds + 2 * SHM_V;
  float* ws = (float*)(lds + 2 * SHM_V + 2 * SHM_K) + wid * 64; float* li_l = ws; float* al_l = ws + 32;
  float m_reg = -1e30f, l_reg = 0; f32x16 o[4] = {}; bf16x8 qr[8];
  const bf16* Qw = Qb + (unsigned)((wid * QBLK + r32) * LDQ + hi * 8);
#pragma unroll
  for (int d0 = 0; d0 < 8; ++d0) qr[d0] = *reinterpret_cast<const bf16x8*>(Qw + d0 * 16);
  const int qb0 = (int)(uintptr_t)lds + QR_OFF + wid * 4096 + k_rd_base(r32, hi);
#pragma unroll
  for (int d0 = 8; d0 < 12; ++d0) *(__attribute__((address_space(3))) bf16x8*)(qb0 + (d0 - 8) * 1024) = *reinterpret_cast<const bf16x8*>(Qw + d0 * 16);
  const int sr = tid >> 4, sc = (tid & 15) * 8, vst0 = v_st(sr, sc), vst1 = v_st(32 + sr, sc);
  unsigned koff[3]; int kst[3];
#pragma unroll
  for (int i = 0; i < 3; ++i) { const int q = tid + 512 * i; koff[i] = (unsigned)((q / 24) * LDK + (q % 24) * 8); kst[i] = k_st(q / 24, q % 24); }
  const unsigned voff0 = (unsigned)(sr * LDK + sc), voff1 = (unsigned)((32 + sr) * LDK + sc);
  const int vb0 = (int)(uintptr_t)V_lds + v_rd_base(lane); const int kb0 = (int)(uintptr_t)K_lds + k_rd_base(r32, hi);
  struct { bf16x8 vs0, vs1, ks0, ks1, ks2; } sr_[1];
#define SLOAD(i, k0) do { const bf16* vt = Vh + (size_t)(k0) * LDK; const bf16* kt = Kh + (size_t)(k0) * LDK; \
    sr_[i].vs0 = *(const bf16x8*)(vt + voff0); sr_[i].vs1 = *(const bf16x8*)(vt + voff1); \
    sr_[i].ks0 = *(const bf16x8*)(kt + koff[0]); sr_[i].ks1 = *(const bf16x8*)(kt + koff[1]); sr_[i].ks2 = *(const bf16x8*)(kt + koff[2]); } while (0)
#define SWRITE(b, i) do { *(bf16x8*)(V_lds + (b) * SHM_V + vst0) = sr_[i].vs0; *(bf16x8*)(V_lds + (b) * SHM_V + vst1) = sr_[i].vs1; \
    *(bf16x8*)(K_lds + (b) * SHM_K + kst[0]) = sr_[i].ks0; *(bf16x8*)(K_lds + (b) * SHM_K + kst[1]) = sr_[i].ks1; *(bf16x8*)(K_lds + (b) * SHM_K + kst[2]) = sr_[i].ks2; } while (0)
#define SWAIT() do { if constexpr (SDEPTH == 2) asm volatile("s_waitcnt vmcnt(5)" ::: "memory"); else asm volatile("s_waitcnt vmcnt(0)" ::: "memory"); } while (0)
#define RESC(a) do { if (__any((a) < 1.f)) { if (hi == 0) al_l[r32] = (a); asm volatile("s_waitcnt lgkmcnt(0)" ::: "memory"); \
    _Pragma("unroll") for (int d = 0; d < 4; ++d) _Pragma("unroll") for (int r = 0; r < 16; ++r) o[d][r] *= al_l[crow(r, hi)]; } } while (0)
  f32x16 pA0, pA1, pB0, pB1; float mnA, mnB, alA, alB; bf16x8 pa0, pa1, pa2, pa3; const int NT = seq / KVBLK;
  SLOAD(0, 0); asm volatile("s_waitcnt vmcnt(0)" ::: "memory"); SWRITE(0, 0); __syncthreads();
  qkt(pA0, pA1, kb0, qr, qb0); partialSM(pA0, pA1, m_reg, mnA, alA);
  SLOAD(0, KVBLK);
  asm volatile("s_waitcnt vmcnt(0)" ::: "memory"); SWRITE(1, 0); __syncthreads();
  for (int j = 1; j + 1 < NT; j += 2) {
    SBAR(); qkt(pB0, pB1, kb0 + SHM_K, qr, qb0);
    finishSM(pA0, pA1, alA, l_reg, pa0, pa1, pa2, pa3); SBAR();
    SLOAD(0, (j + 1) * KVBLK); SBAR();
    pv_d0(o, vb0, pa0, pa1, pa2, pa3); partialSM(pB0, pB1, m_reg, mnB, alB);
    __syncthreads(); asm volatile("s_waitcnt vmcnt(0)" ::: "memory"); SWRITE(0, 0);
    RESC(alB); __syncthreads();
    SBAR(); qkt(pA0, pA1, kb0, qr, qb0);
    finishSM(pB0, pB1, alB, l_reg, pa0, pa1, pa2, pa3); SBAR();
    SLOAD(0, (j + 2) * KVBLK); SBAR();
    pv_d0(o, vb0 + (int)SHM_V, pa0, pa1, pa2, pa3); partialSM(pA0, pA1, m_reg, mnA, alA);
    __syncthreads(); asm volatile("s_waitcnt vmcnt(0)" ::: "memory"); SWRITE(1, 0);
    RESC(alA); __syncthreads();
  }
  SBAR(); qkt(pB0, pB1, kb0 + SHM_K, qr, qb0);
  finishSM(pA0, pA1, alA, l_reg, pa0, pa1, pa2, pa3); SBAR();
  pv_d0(o, vb0, pa0, pa1, pa2, pa3); partialSM(pB0, pB1, m_reg, mnB, alB);
  __syncthreads(); RESC(alB);
  finishSM(pB0, pB1, alB, l_reg, pa0, pa1, pa2, pa3); SBAR();
  pv_d0(o, vb0 + (int)SHM_V, pa0, pa1, pa2, pa3);
  if (hi == 0) li_l[r32] = l_reg; asm volatile("s_waitcnt lgkmcnt(0)" ::: "memory");
  bf16* Ow = Ob + (unsigned)(wid * QBLK * LDO + r32);
#pragma unroll
  for (int r = 0; r < 16; ++r) { const int orow = crow(r, hi); const float rl = __builtin_amdgcn_rcpf(li_l[orow]);
#pragma unroll
    for (int d0 = 0; d0 < 4; ++d0) { const unsigned w = cvtpk(o[d0][r] * rl, 0.f); Ow[(unsigned)(orow * LDO + d0 * 32)] = (bf16)(w & 0xffffu); } }
  __syncthreads();
#undef SLOAD
#undef SWRITE
#undef SWAIT
#undef RESC
}
}
namespace hy {
#define HY_LAS __attribute__((address_space(3)))
typedef unsigned short bf16;
typedef short bf16x8 __attribute__((ext_vector_type(8)));
typedef float f32x16 __attribute__((ext_vector_type(16)));
typedef unsigned u32x2 __attribute__((ext_vector_type(2)));
typedef unsigned u32x4 __attribute__((ext_vector_type(4)));
constexpr int L = 2048, NB = 24, CH = 512;
constexpr int RFS = 4112;
constexpr int ZROW = 4112;
constexpr int ZL_BYTES = NB * ZROW;
constexpr int RCS = 8256;
constexpr int RC_OFF = ZL_BYTES;
constexpr int HY_LDS_BYTES = RC_OFF + 4 * RCS;
__device__ __forceinline__ unsigned cvtpk(float lo, float hi) { unsigned r; asm volatile("v_cvt_pk_bf16_f32 %0, %1, %2" : "=v"(r) : "v"(lo), "v"(hi)); return r; }
__host__ __device__ __forceinline__ int frag_base(int tw, int r, int h) { const int a = (4 - (r & 3)) & 3; return RC_OFF + a * RCS + 2 * (2048 - tw - r + 8 * h - a); }
__host__ __device__ __forceinline__ int zfrag_base(int r, int h) { return (r < NB ? r : NB - 1) * ZROW + 16 * h; }

__device__ __forceinline__ bf16x8 ld_frag(HY_LAS unsigned char* lds, int off) {
    const u32x2 lo = *(const HY_LAS u32x2*)(lds + off), hi = *(const HY_LAS u32x2*)(lds + off + 8);
    u32x4 w = {lo.x, lo.y, hi.x, hi.y}; return *reinterpret_cast<bf16x8*>(&w);
}
__device__ __forceinline__ bf16x8 ld_b128(HY_LAS unsigned char* lds, int off) { return *(const HY_LAS bf16x8*)(lds + off); }

__device__ __forceinline__ void conv_unit(HY_LAS unsigned char* lds, const bf16* __restrict__ ZT, const bf16* __restrict__ RF, bf16* __restrict__ YC, int c, int half) {
    const int tid = opq(threadIdx.x), wid = tid >> 6, lane = tid & 63, r = lane & 31, h = lane >> 5;
    { const u32x4* src = (const u32x4*)(ZT + (size_t)c * NB * L);
#pragma unroll
      for (int i = 0; i < 12; ++i) { const int q = tid + 512 * i; const u32x4 v = src[q]; *(HY_LAS u32x4*)(lds + (q >> 8) * ZROW + (q & 255) * 16) = v; } }
    { const bf16* rf = RF + (size_t)c * RFS;
      for (int ch = tid; ch < RFS / 8; ch += 512) {
          const u32x4 v = *(const u32x4*)(rf + ch * 8); const unsigned w[4] = {v.x, v.y, v.z, v.w};
#pragma unroll
          for (int j = 0; j < 8; ++j) { const unsigned short e = (unsigned short)((w[j >> 1] >> ((j & 1) * 16)) & 0xffffu); const int idx = ch * 8 + j;
#pragma unroll
              for (int a = 0; a < 4; ++a) if (idx - a >= 0) *(HY_LAS unsigned short*)(lds + RC_OFF + a * RCS + 2 * (idx - a)) = e; } } }
    __syncthreads();
    const int tw = half * 1024 + wid * 128;
    const int fb = frag_base(tw, r, h), zb = zfrag_base(r, h);
    f32x16 acc[4] = {};
    bf16x8 S0[2], S1[2], S2[2], S3[2], Bc[2], Bn[2];
#define HY_LDG(S, d) do { S[0] = ld_frag(lds, fb + 64 * (d)); S[1] = ld_frag(lds, fb + 64 * (d) + 32); } while (0)
#define HY_LDB(Bx, n) do { Bx[0] = ld_b128(lds, zb + 64 * (n)); Bx[1] = ld_b128(lds, zb + 64 * (n) + 32); } while (0)
#define HY_MM(i, S, Bx) do { acc[i] = __builtin_amdgcn_mfma_f32_32x32x16_bf16(S[0], Bx[0], acc[i], 0, 0, 0); acc[i] = __builtin_amdgcn_mfma_f32_32x32x16_bf16(S[1], Bx[1], acc[i], 0, 0, 0); } while (0)
#define HY_ITER(n, Sa, Sb, Sc, Sd, Bcur, Bnext) do { HY_LDG(Sa, (n)); if ((n) + 1 < 64) HY_LDB(Bnext, (n) + 1); \
        HY_MM(1, Sb, Bcur); HY_MM(2, Sc, Bcur); HY_MM(3, Sd, Bcur); HY_MM(0, Sa, Bcur); } while (0)
    HY_LDG(S3, -1); HY_LDG(S2, -2); HY_LDG(S1, -3); HY_LDB(Bc, 0);
    for (int n = 0; n < 64; n += 4) {
        HY_ITER(n, S0, S3, S2, S1, Bc, Bn);
        HY_ITER(n + 1, S1, S0, S3, S2, Bn, Bc);
        HY_ITER(n + 2, S2, S1, S0, S3, Bc, Bn);
        HY_ITER(n + 3, S3, S2, S1, S0, Bn, Bc);
    }
#undef HY_LDG
#undef HY_LDB
#undef HY_MM
#undef HY_ITER
    if (r < NB) { bf16* yp = YC + ((size_t)c * NB + r) * L + tw + 4 * h;
#pragma unroll
        for (int i = 0; i < 4; ++i)
#pragma unroll
            for (int q4 = 0; q4 < 4; ++q4) { u32x2 w; w.x = cvtpk(acc[i][4 * q4 + 0], acc[i][4 * q4 + 1]); w.y = cvtpk(acc[i][4 * q4 + 2], acc[i][4 * q4 + 3]);
                *(u32x2*)(yp + 32 * i + 8 * q4) = w; } }
    __syncthreads();
}
}
constexpr int NWAVES = 8;
#ifndef MK_ONE_LAUNCH
#define MK_ONE_LAUNCH 1
#endif
constexpr int DM = 2048, NSEQ = 24, SEQ = 2048, M = NSEQ * SEQ, MP = 8 * SEQ;
constexpr int DEPTH = 4;
constexpr int DIN = 2880, DINP = 3072;
constexpr int O_CQ = 512, O_CKV = 1024, O_KPE = 1280, O_HY = 1344;
constexpr int NH = 8, NQ = 1536, NKVP = 2560, KVHS = 320;
constexpr int DFF = 5632, NUP = 11264, HYC = 512;
constexpr float EPS = 1e-6f;
constexpr int NPH = 11;
constexpr size_t WS_CTL = 0, CTL_BYTES = 1u << 20;
constexpr size_t SZ_BTIN = (size_t)DINP * DM * 2, SZ_BTUQ = (size_t)NQ * 512 * 2, SZ_BTKV = (size_t)NKVP * 256 * 2, SZ_BTOUT = (size_t)DM * DM * 2, SZ_BTUP = (size_t)NUP * DM * 2, SZ_BTDN = (size_t)DM * DFF * 2;
constexpr size_t WS_BTIN = WS_CTL + CTL_BYTES, WS_BTUQ = WS_BTIN + SZ_BTIN, WS_BTKV = WS_BTUQ + SZ_BTUQ, WS_BTOUT = WS_BTKV + SZ_BTKV, WS_BTUP = WS_BTOUT + SZ_BTOUT, WS_BTDN = WS_BTUP + SZ_BTUP;
constexpr size_t WS_RF = WS_BTDN + SZ_BTDN, SZ_RF = (size_t)HYC * hy::RFS * 2;
constexpr size_t WS_H = WS_RF + SZ_RF, SZ_H = (size_t)M * DM * 2;
constexpr size_t WS_PROJ = WS_H + SZ_H, SZ_PROJ = (size_t)M * DINP * 2;
constexpr size_t WS_Q = WS_PROJ + SZ_PROJ, SZ_Q = (size_t)M * NQ * 2;
constexpr size_t WS_KV = WS_Q + SZ_Q, SZ_KV = (size_t)M * NKVP * 2;
constexpr size_t WS_ZT = WS_KV + SZ_KV, SZ_ZT = (size_t)HYC * NSEQ * SEQ * 2;
constexpr size_t WS_X0 = WS_ZT + SZ_ZT, WS_YC = WS_X0 + SZ_ZT;
constexpr size_t WS_EDGE = WS_YC + SZ_ZT, SZ_EDGE = (size_t)(M / 256) * 2 * 3 * DFF * 4;
constexpr size_t WS_ROPE = WS_EDGE + SZ_EDGE, SZ_ROPE = (size_t)SEQ * 64 * 4;
constexpr size_t WS_SSQP = WS_ROPE + SZ_ROPE, SZ_SSQP = (size_t)M * 32 * 4;
constexpr size_t WS_RSTD = WS_SSQP + SZ_SSQP, SZ_RSTD = (size_t)M * 4;
constexpr size_t WS_END = WS_RSTD + SZ_RSTD;
constexpr size_t WS_ACT = WS_PROJ;
static_assert((size_t)M * DFF * 2 <= SZ_PROJ + SZ_Q + SZ_KV, "ACT overlay");
constexpr size_t WS_XB2 = WS_ACT + (size_t)M * DFF * 2;
static_assert(WS_XB2 + (size_t)M * DM * 2 <= WS_EDGE && WS_XB2 % 256 == 0, "XB2 overlay");
static_assert(WS_BTIN % 256 == 0 && WS_RF % 256 == 0 && WS_H % 256 == 0 && WS_PROJ % 256 == 0 && WS_Q % 256 == 0 && WS_KV % 256 == 0 && WS_ZT % 256 == 0 && WS_EDGE % 256 == 0, "alignment");
constexpr int CW_BAR = 4096;
constexpr int RING_BYTES = 135168;
constexpr int HALO_OFF = RING_BYTES, HALO_BYTES = 4096;
constexpr int MISC_OFF = HALO_OFF + HALO_BYTES;
constexpr int LDS_BYTES = 147456;
static_assert(hy::HY_LDS_BYTES <= RING_BYTES && at::SHM_ATTN <= RING_BYTES && MISC_OFF + 256 <= LDS_BYTES, "LDS map");

#define GAS __attribute__((address_space(1)))
#define LAS __attribute__((address_space(3)))
typedef unsigned short bf16;
typedef unsigned v4u __attribute__((ext_vector_type(4)));
typedef unsigned v2u __attribute__((ext_vector_type(2)));
typedef float f32x4 __attribute__((ext_vector_type(4)));
#define LDS_WAIT() asm volatile("s_waitcnt lgkmcnt(0)" ::: "memory")
__device__ __forceinline__ unsigned f2bf(float f) { unsigned u = __builtin_bit_cast(unsigned, f); return (u + 0x7fffu + ((u >> 16) & 1u)) >> 16; }
__device__ __forceinline__ unsigned pk2(float lo, float hi) { return f2bf(lo) | (f2bf(hi) << 16); }
__device__ __forceinline__ float bf2f(unsigned short b) { return __builtin_bit_cast(float, (unsigned)b << 16); }
__device__ __forceinline__ float bflo(unsigned w) { return __builtin_bit_cast(float, w << 16); }
__device__ __forceinline__ float bfhi(unsigned w) { return __builtin_bit_cast(float, w & 0xffff0000u); }
__device__ __forceinline__ float wave_sum(float v) {
#pragma unroll
    for (int o = 1; o < 64; o <<= 1) v += __shfl_xor(v, o);
    return v;
}

#define XB_TMO      128
#define XB_XCNT(j)  (256  + 64 * (j))
#define XB_XSUB(j)  (1280 + 64 * (j))
#define XB_XGEN(j)  (2304 + 64 * (j))
#define XB_TOP      3328
#define XB_TOPGEN   3392
#define XCD_BAR_WORDS 3456
#define XB_SPIN_CAP (1u << 18)
__device__ __forceinline__ unsigned xb_ld(unsigned* p)              { return __hip_atomic_load(p, __ATOMIC_RELAXED, __HIP_MEMORY_SCOPE_AGENT); }
__device__ __forceinline__ unsigned xb_add(unsigned* p, unsigned v) { return __hip_atomic_fetch_add(p, v, __ATOMIC_RELAXED, __HIP_MEMORY_SCOPE_AGENT); }
__device__ __forceinline__ unsigned xb_xcc_id() { return (unsigned)__builtin_amdgcn_s_getreg((3 << 11) | 20) & 0xFu; }
#define XB_SPIN(cond, bar) do { unsigned _sp = 0; while (cond) { __builtin_amdgcn_s_sleep(1); \
    if ((++_sp & 255u) == 0u) { if (xb_ld(&(bar)[XB_TMO])) break; if (_sp > XB_SPIN_CAP) { atomicAdd(&(bar)[XB_TMO], 1u); break; } } } } while (0)
struct XcdBarrier { unsigned* bar; unsigned x; volatile LAS unsigned* st; };
__device__ __forceinline__ XcdBarrier xcd_barrier_post(unsigned* bar, volatile LAS unsigned* st) {
    XcdBarrier b; b.bar = bar; b.x = xb_xcc_id(); b.st = st;
    if (threadIdx.x == 0) (void)xb_add(&bar[XB_XCNT(b.x)], 1u);
    return b;
}
__device__ __forceinline__ void xcd_barrier_complete(unsigned* bar, unsigned x, unsigned& nloc, unsigned& nx) {
    const unsigned G = gridDim.x * gridDim.y * gridDim.z;
    unsigned sum, cnt, mine, sp = 0u;
    for (;;) {
        sum = 0u; cnt = 0u; mine = 0u;
#pragma unroll
        for (unsigned j = 0; j < 16; ++j) { const unsigned c = xb_ld(&bar[XB_XCNT(j)]); sum += c; cnt += (c > 0u) ? 1u : 0u; mine = (j == x) ? c : mine; }
        if (sum == G) break;
        __builtin_amdgcn_s_sleep(1);
        if ((++sp & 255u) == 0u) { if (xb_ld(&bar[XB_TMO])) break; if (sp > XB_SPIN_CAP) { atomicAdd(&bar[XB_TMO], 1u); break; } }
    }
    nloc = mine > 0u ? mine : 1u; nx = cnt > 0u ? cnt : 1u;
}
__device__ __forceinline__ void xcd_barrier(const XcdBarrier& b) {
    asm volatile("s_waitcnt vmcnt(0)" ::: "memory");
    __syncthreads();
    if (threadIdx.x == 0) {
        unsigned* bar = b.bar;
        __builtin_amdgcn_s_waitcnt(0);
        unsigned nloc = b.st[0], nx = b.st[1];
        if (nloc == 0u) { xcd_barrier_complete(bar, b.x, nloc, nx); b.st[0] = nloc; b.st[1] = nx; }
        const unsigned old = xb_add(&bar[XB_XSUB(b.x)], 1u);
        const unsigned gen = old / nloc;
        if (old + 1u == (gen + 1u) * nloc) {
            __builtin_amdgcn_fence(__ATOMIC_RELEASE, "agent");
            asm volatile("s_waitcnt vmcnt(0)" ::: "memory");
            const unsigned og = xb_add(&bar[XB_TOP], 1u);
            const unsigned tg = og / nx;
            if (og + 1u == (tg + 1u) * nx) xb_add(&bar[XB_TOPGEN], 1u);
            else XB_SPIN(xb_ld(&bar[XB_TOPGEN]) == tg, bar);
            __builtin_amdgcn_fence(__ATOMIC_ACQUIRE, "agent");
            xb_add(&bar[XB_XGEN(b.x)], 1u);
            asm volatile("s_waitcnt vmcnt(0)" ::: "memory");
        } else {
            XB_SPIN(xb_ld(&bar[XB_XGEN(b.x)]) == gen, bar);
            __builtin_amdgcn_fence(__ATOMIC_ACQUIRE, "agent");
            asm volatile("s_waitcnt vmcnt(0)" ::: "memory");
        }
    }
    __syncthreads();
}

struct Frame {
    LAS unsigned char* lds;
    int tid, lane, wave, vcu, G;
};
enum { I_XP = 0, I_XS, I_ANG, I_WIN, I_PW, I_PS, I_QNG, I_WUQ, I_KVNG, I_WUKV, I_QHG, I_KHG, I_HCW, I_HCB, I_FW1, I_FB1, I_FFR, I_FW2, I_FB2, I_FW3, I_FB3, I_HBIAS, I_GNG, I_WOUT, I_FNG, I_WUP, I_FCW, I_FCB, I_WDN, N_IN };
struct Args { const float* in[N_IN]; float* out; unsigned char* ws; int ph_lo, ph_hi; };
static_assert(sizeof(Args) == (N_IN + 2) * 8 + 8, "Args has no padding");

__device__ __forceinline__ void cvt_item(const float* __restrict__ W, int ldw, int K, bf16* WT, int dst_n0, int src_n0, int k0, const float* __restrict__ ks, LAS float* scr, int lane) {
#pragma unroll
    for (int i = 0; i < 32; ++i) { const int kk = 2 * i + (lane >> 5); float v = W[(size_t)(k0 + kk) * ldw + src_n0 + (lane & 31)]; if (ks) v *= ks[k0 + kk]; scr[kk * 33 + (lane & 31)] = v; }
    LDS_WAIT(); asm volatile("" ::: "memory");
    const int c = lane & 7;
#pragma unroll
    for (int j = 0; j < 4; ++j) { const int n = (lane >> 3) + 8 * j; const LAS float* s = scr + (8 * c) * 33 + n;
        v4u o; o.x = pk2(s[0 * 33], s[1 * 33]); o.y = pk2(s[2 * 33], s[3 * 33]); o.z = pk2(s[4 * 33], s[5 * 33]); o.w = pk2(s[6 * 33], s[7 * 33]);
        *(v4u*)(WT + (size_t)(dst_n0 + n) * K + k0 + 8 * c) = o; }
    LDS_WAIT(); asm volatile("" ::: "memory");
}
__device__ __forceinline__ void xb_row(const float* xrow, bf16* orow, float* rstd, int lane) {
    const f32x4* xr = (const f32x4*)xrow + lane;
    f32x4 v[8]; float s = 0.f;
#pragma unroll
    for (int j = 0; j < 8; ++j) { v[j] = xr[64 * j]; s += (v[j].x * v[j].x + v[j].y * v[j].y) + (v[j].z * v[j].z + v[j].w * v[j].w); }
    const float r = 1.0f / sqrtf(wave_sum(s) * (1.f / DM) + EPS);
    if (lane == 0) *rstd = r;
    v2u* o8 = (v2u*)orow + lane;
#pragma unroll
    for (int j = 0; j < 8; ++j) { v2u w; w.x = pk2(v[j].x, v[j].y); w.y = pk2(v[j].z, v[j].w); o8[64 * j] = w; }
}
__device__ __forceinline__ void rstd_from_partials(const float* __restrict__ ssqp, float* rstd, size_t gtid, size_t gthreads) {
    for (size_t r = gtid; r < (size_t)M; r += gthreads) { const f32x4* p = (const f32x4*)(ssqp + r * 32); f32x4 a = p[0];
#pragma unroll
        for (int i = 1; i < 8; ++i) a += p[i];
        rstd[r] = 1.0f / sqrtf(((a.x + a.y) + (a.z + a.w)) * (1.f / DM) + EPS); }
}
__device__ __forceinline__ void tile_norm_store(LAS float* tile, bf16* dst, int row0, int col_off, int wave, int lane) {
#pragma unroll
    for (int i = 0; i < 8; ++i) { const int t = wave * 8 + i;
        const f32x4 a = *(LAS f32x4*)(tile + t * 512 + 8 * lane), b = *(LAS f32x4*)(tile + t * 512 + 8 * lane + 4);
        const float s = (a.x * a.x + a.y * a.y) + (a.z * a.z + a.w * a.w) + (b.x * b.x + b.y * b.y) + (b.z * b.z + b.w * b.w);
        const float rstd = 1.0f / sqrtf(wave_sum(s) * (1.f / 512.f) + EPS);
        v4u o; o.x = pk2(a.x * rstd, a.y * rstd); o.y = pk2(a.z * rstd, a.w * rstd); o.z = pk2(b.x * rstd, b.y * rstd); o.w = pk2(b.z * rstd, b.w * rstd);
        *(v4u*)(dst + (size_t)(row0 + t) * DM + col_off + 8 * lane) = o; }
}
__device__ __forceinline__ void poolfold_item(Frame& F, const float* __restrict__ win, const float* __restrict__ pw, const float* __restrict__ ps, const float* __restrict__ g1, bf16* BtIn, int g, int kb) {
    LAS float* At = (LAS float*)F.lds; LAS float* Bt = (LAS float*)(F.lds + 32768);
    const int k0 = 64 * kb;
#pragma unroll
    for (int i = 0; i < 4; ++i) { const int q = F.tid + 512 * i, row = q >> 5, c4 = q & 31; *(LAS f32x4*)(At + row * 128 + 4 * c4) = *(const f32x4*)(win + (size_t)(k0 + row) * DIN + 128 * g + 4 * c4) * g1[k0 + row]; }
#pragma unroll
    for (int i = 0; i < 8; ++i) { const int q = F.tid + 512 * i, row = q >> 5, c4 = q & 31; *(LAS f32x4*)(Bt + row * 128 + 4 * c4) = *(const f32x4*)(pw + (size_t)(g * 128 + row) * 128 + 4 * c4); }
    __syncthreads();
    const int n = F.tid & 127, kg = F.tid >> 7;
    float acc[16];
#pragma unroll
    for (int i = 0; i < 16; ++i) acc[i] = 0.f;
    for (int j = 0; j < 128; j += 4) {
        const float b0 = Bt[(j + 0) * 128 + n], b1 = Bt[(j + 1) * 128 + n], b2 = Bt[(j + 2) * 128 + n], b3 = Bt[(j + 3) * 128 + n];
#pragma unroll
        for (int i = 0; i < 16; ++i) { const f32x4 a = *(LAS f32x4*)(At + (kg * 16 + i) * 128 + j); acc[i] += a.x * b0 + a.y * b1 + a.z * b2 + a.w * b3; }
    }
    const float sc = ps[128 * g + n];
    v4u o0, o1;
    o0.x = pk2(acc[0] * sc, acc[1] * sc); o0.y = pk2(acc[2] * sc, acc[3] * sc); o0.z = pk2(acc[4] * sc, acc[5] * sc); o0.w = pk2(acc[6] * sc, acc[7] * sc);
    o1.x = pk2(acc[8] * sc, acc[9] * sc); o1.y = pk2(acc[10] * sc, acc[11] * sc); o1.z = pk2(acc[12] * sc, acc[13] * sc); o1.w = pk2(acc[14] * sc, acc[15] * sc);
    bf16* dst = BtIn + (size_t)(128 * g + n) * DM + k0 + kg * 16;
    *(v4u*)dst = o0; *(v4u*)(dst + 8) = o1;
    __syncthreads();
}
__device__ __forceinline__ void filter_item(Frame& F, const float* __restrict__ w1, const float* __restrict__ b1, const float* __restrict__ fr, const float* __restrict__ w2, const float* __restrict__ b2,
                                            const float* __restrict__ w3, const float* __restrict__ b3, const float* __restrict__ hbias, bf16* RF, int fi) {
    LAS float* ZF = (LAS float*)F.lds; LAS float* H1 = ZF + 512; LAS float* H2 = ZF + 1536;
    const int t0 = 16 * fi;
    if (F.tid < 272) { const int tt = F.tid / 17, f = F.tid % 17; const float t = (float)(t0 + tt);
        float v;
        if (f == 0) v = t / 2047.0f;
        else { const int j = (f - 1) & 7; const float band = 1e-4f + (float)j * ((7.0f - 1e-4f) / 7.0f); const float w = (6.283185307179586f * t) / 2048.0f; const float a = band * w; v = (f <= 8) ? __cosf(a) : -__sinf(a); }
        ZF[tt * 17 + f] = v; }
    __syncthreads();
#pragma unroll
    for (int rep = 0; rep < 2; ++rep) { const int p = F.tid + 512 * rep, tt = p >> 6, j = p & 63; float s = b1[j];
        for (int i = 0; i < 17; ++i) s += ZF[tt * 17 + i] * w1[i * 64 + j];
        H1[tt * 64 + j] = __sinf(fr[j] * s); }
    __syncthreads();
#pragma unroll
    for (int rep = 0; rep < 2; ++rep) { const int p = F.tid + 512 * rep, tt = p >> 6, j = p & 63; float s = b2[j];
        for (int i = 0; i < 64; ++i) s += H1[tt * 64 + i] * w2[i * 64 + j];
        H2[tt * 64 + j] = __sinf(fr[j] * s); }
    __syncthreads();
    const int c = F.tid;
    const float delta = -3.0701134573253944f + (float)c * ((-15.350567286626972f + 3.0701134573253944f) / 511.0f);
    const float ad = fabsf(delta);
    bf16* rf = RF + (size_t)c * hy::RFS;
#pragma unroll 1
    for (int dir = 0; dir < 2; ++dir) { const int o = dir * 512 + c; const float bo = b3[o];
#pragma unroll 1
        for (int tt = 0; tt < 16; ++tt) { float s = bo;
#pragma unroll 16
            for (int i = 0; i < 64; ++i) s += H2[tt * 64 + i] * w3[i * 1024 + o];
            const int t = t0 + tt; const float tl = (float)t / 2047.0f; float val = s * __expf(-tl * ad);
            if (dir == 0) { if (t == 0) val += hbias[c]; rf[2048 - t] = (bf16)f2bf(val); }
            else if (t >= 1) rf[2048 + t] = (bf16)f2bf(val); } }
    if (fi == 0) { rf[0] = 0;
#pragma unroll
        for (int i = 4096; i < hy::RFS; ++i) rf[i] = 0; }
    __syncthreads();
}
__device__ __forceinline__ void unpack4(const v2u w, float (&x)[4]) { x[0] = bflo(w.x); x[1] = bfhi(w.x); x[2] = bflo(w.y); x[3] = bfhi(w.y); }
__device__ __forceinline__ void pair_norm_store(Frame& F, const float (&y)[8][4], bf16* dst, size_t row0, int col_off, int cq) {
    LAS float* part = (LAS float*)F.lds;
    float ss[8];
#pragma unroll
    for (int k = 0; k < 8; ++k) ss[k] = wave_sum((y[k][0] * y[k][0] + y[k][1] * y[k][1]) + (y[k][2] * y[k][2] + y[k][3] * y[k][3]));
    if (F.lane == 0) { *(LAS f32x4*)(part + F.wave * 8) = (f32x4){ss[0], ss[1], ss[2], ss[3]}; *(LAS f32x4*)(part + F.wave * 8 + 4) = (f32x4){ss[4], ss[5], ss[6], ss[7]}; }
    __syncthreads();
    const f32x4 pa = *(LAS f32x4*)(part + (F.wave ^ 1) * 8), pb = *(LAS f32x4*)(part + (F.wave ^ 1) * 8 + 4);
    const float po[8] = {pa.x, pa.y, pa.z, pa.w, pb.x, pb.y, pb.z, pb.w};
#pragma unroll
    for (int k = 0; k < 8; ++k) { const float rstd = 1.0f / sqrtf((ss[k] + po[k]) * (1.f / 512.f) + EPS);
        v2u o; o.x = pk2(y[k][0] * rstd, y[k][1] * rstd); o.y = pk2(y[k][2] * rstd, y[k][3] * rstd);
        *(v2u*)(dst + (row0 + k) * DM + col_off + 4 * cq) = o; }
    __syncthreads();
}
__device__ __forceinline__ void hyprep_item(Frame& F, const bf16* __restrict__ PROJ, const float* __restrict__ cw, const float* __restrict__ cb, bf16* ZT, bf16* X0, int b, int tile) {
    const int tb = F.tid >> 7, cq = F.tid & 127, c0 = 4 * cq, tw = tile * 32 + tb * 8; const size_t rb = (size_t)b * SEQ;
    float z[8][4];
#pragma unroll
    for (int jj = 0; jj < 3; ++jj) { const int j = (jj == 0) ? 1 : (jj == 1) ? 2 : 0; const int cc = 512 * j + c0;
        const f32x4 w0 = *(const f32x4*)(cw + cc), w1 = *(const f32x4*)(cw + 1536 + cc), w2 = *(const f32x4*)(cw + 3072 + cc), bs = *(const f32x4*)(cb + cc);
        float x[10][4];
#pragma unroll
        for (int o = 0; o < 10; ++o) { const int t = tw - 1 + o; const bool ok = (t >= 0) && (t < SEQ); const int tc = ok ? t : tw;
            const v2u w = *(const v2u*)(PROJ + (rb + tc) * DINP + O_HY + cc); unpack4(w, x[o]);
            if (!ok) { x[o][0] = 0.f; x[o][1] = 0.f; x[o][2] = 0.f; x[o][3] = 0.f; } }
        if (jj == 0) {
#pragma unroll
            for (int k = 0; k < 8; ++k)
#pragma unroll
                for (int i = 0; i < 4; ++i) z[k][i] = w0[i] * x[k][i] + w1[i] * x[k + 1][i] + w2[i] * x[k + 2][i] + bs[i];
        } else if (jj == 1) {
#pragma unroll
            for (int k = 0; k < 8; ++k)
#pragma unroll
                for (int i = 0; i < 4; ++i) z[k][i] *= w0[i] * x[k][i] + w1[i] * x[k + 1][i] + w2[i] * x[k + 2][i] + bs[i];
#pragma unroll
            for (int i = 0; i < 4; ++i) { v4u o; o.x = pk2(z[0][i], z[1][i]); o.y = pk2(z[2][i], z[3][i]); o.z = pk2(z[4][i], z[5][i]); o.w = pk2(z[6][i], z[7][i]);
                *(v4u*)(ZT + ((size_t)(c0 + i) * NSEQ + b) * SEQ + tw) = o; }
        } else {
#pragma unroll
            for (int k = 0; k < 8; ++k) { float u0[4];
#pragma unroll
                for (int i = 0; i < 4; ++i) u0[i] = w0[i] * x[k][i] + w1[i] * x[k + 1][i] + w2[i] * x[k + 2][i] + bs[i];
                v2u o; o.x = pk2(u0[0], u0[1]); o.y = pk2(u0[2], u0[3]); *(v2u*)(X0 + (rb + tw + k) * HYC + c0) = o; }
        }
    }
}
__device__ __forceinline__ void pool_item(Frame& F, const bf16* __restrict__ PROJ, bf16* MIXED, int b, int tile) {
    const int tb = F.tid >> 7, cq = F.tid & 127, c0 = 4 * cq, g = cq >> 5, half = 1 << g, tw = tile * 32 + tb * 8; const size_t rb = (size_t)b * SEQ;
    float x[23][4];
#pragma unroll
    for (int o = 0; o < 23; ++o) { const int t = tw - 8 + o; const bool ok = (t >= 0) && (t < SEQ); const int tc = ok ? t : tw;
        const v2u w = *(const v2u*)(PROJ + (rb + tc) * DINP + c0); unpack4(w, x[o]);
        if (!ok) { x[o][0] = 0.f; x[o][1] = 0.f; x[o][2] = 0.f; x[o][3] = 0.f; } }
    float y[8][4];
#pragma unroll
    for (int k = 0; k < 8; ++k) { const int oc = 8 + k, t = tw + k; const int lo = (t - half > 0) ? t - half : 0, hi = (t + half < SEQ) ? t + half : SEQ; const float inv = 1.0f / (float)(hi - lo);
#pragma unroll
        for (int i = 0; i < 4; ++i) {
            const float w1 = x[oc - 1][i] + x[oc][i];
            const float w2 = w1 + (x[oc - 2][i] + x[oc + 1][i]);
            const float w4 = w2 + ((x[oc - 4][i] + x[oc - 3][i]) + (x[oc + 2][i] + x[oc + 3][i]));
            const float w8 = w4 + (((x[oc - 8][i] + x[oc - 7][i]) + (x[oc - 6][i] + x[oc - 5][i])) + ((x[oc + 4][i] + x[oc + 5][i]) + (x[oc + 6][i] + x[oc + 7][i])));
            const float S = (g == 0) ? w1 : (g == 1) ? w2 : (g == 2) ? w4 : w8;
            y[k][i] = S * inv - x[oc][i]; } }
    pair_norm_store(F, y, MIXED, rb + tw, 0, cq);
}
__device__ __forceinline__ void hyfin_item(Frame& F, const bf16* __restrict__ YC, const bf16* __restrict__ X0, bf16* MIXED, int b, int tile) {
    const int tb = F.tid >> 7, cq = F.tid & 127, c0 = 4 * cq, tw = tile * 32 + tb * 8; const size_t rb = (size_t)b * SEQ;
    float yc[4][8], y[8][4];
#pragma unroll
    for (int i = 0; i < 4; ++i) { const v4u v = *(const v4u*)(YC + ((size_t)(c0 + i) * NSEQ + b) * SEQ + tw);
        yc[i][0] = bflo(v.x); yc[i][1] = bfhi(v.x); yc[i][2] = bflo(v.y); yc[i][3] = bfhi(v.y); yc[i][4] = bflo(v.z); yc[i][5] = bfhi(v.z); yc[i][6] = bflo(v.w); yc[i][7] = bfhi(v.w); }
#pragma unroll
    for (int k = 0; k < 8; ++k) { float xv[4]; unpack4(*(const v2u*)(X0 + (rb + tw + k) * HYC + c0), xv);
#pragma unroll
        for (int i = 0; i < 4; ++i) y[k][i] = yc[i][k] * xv[i]; }
    pair_norm_store(F, y, MIXED, rb + tw, 1536, cq);
}
struct PrepGains { float q[3][8], k[3][8]; };
__device__ __forceinline__ void load8(const float* p, float (&o)[8]) { const f32x4 a = *(const f32x4*)p, b = *(const f32x4*)(p + 4); o[0] = a.x; o[1] = a.y; o[2] = a.z; o[3] = a.w; o[4] = b.x; o[5] = b.y; o[6] = b.z; o[7] = b.w; }
__device__ __forceinline__ void unpack8(const v4u w, float (&x)[8]) { x[0] = bflo(w.x); x[1] = bfhi(w.x); x[2] = bflo(w.y); x[3] = bfhi(w.y); x[4] = bflo(w.z); x[5] = bfhi(w.z); x[6] = bflo(w.w); x[7] = bfhi(w.w); }
__device__ __forceinline__ v4u pack8(const float (&x)[8]) { v4u o; o.x = pk2(x[0], x[1]); o.y = pk2(x[2], x[3]); o.z = pk2(x[4], x[5]); o.w = pk2(x[6], x[7]); return o; }
__device__ __forceinline__ float ssq8(const float (&x)[8]) { return ((x[0] * x[0] + x[1] * x[1]) + (x[2] * x[2] + x[3] * x[3])) + ((x[4] * x[4] + x[5] * x[5]) + (x[6] * x[6] + x[7] * x[7])); }
__device__ __forceinline__ float sum8lanes(float v) { v += __shfl_xor(v, 1); v += __shfl_xor(v, 2); v += __shfl_xor(v, 4); return v; }
__device__ __forceinline__ void prep_row(const bf16* __restrict__ PROJ, bf16* Q, bf16* KV, const PrepGains& G, const float* __restrict__ ROPE, int m, int lane) {
    const int h = lane >> 3, sub = lane & 7;
    const bf16* pr = PROJ + (size_t)m * DINP; bf16* qr = Q + (size_t)m * NQ + 192 * h + 8 * sub; bf16* kr = KV + (size_t)m * NKVP + KVHS * h + 8 * sub;
    const v4u cqv = *(const v4u*)(pr + O_CQ + 8 * lane); const v4u ckv = *(const v4u*)(pr + O_CKV + 8 * (lane & 31)); const v4u pev = *(const v4u*)(pr + O_KPE + 8 * sub);
    const v4u q0 = *(const v4u*)(qr), q1 = *(const v4u*)(qr + 64), q2 = *(const v4u*)(qr + 128);
    const v4u k0 = *(const v4u*)(kr), k1 = *(const v4u*)(kr + 64), v0 = *(const v4u*)(kr + 192), v1 = *(const v4u*)(kr + 256);
    float cs[8], sn[8]; { const float* rp = ROPE + (size_t)(m & (SEQ - 1)) * 64 + 8 * (sub & 3); load8(rp, cs); load8(rp + 32, sn); }
    float t[8];
    unpack8(cqv, t); const float rq = 1.0f / sqrtf(wave_sum(ssq8(t)) * (1.f / 512.f) + EPS);
    unpack8(ckv, t); const float rkv = 1.0f / sqrtf(wave_sum(lane < 32 ? ssq8(t) : 0.f) * (1.f / 256.f) + EPS);
    const float sg = (sub < 4) ? -1.f : 1.f;
    { float a0[8], a1[8], a2[8]; unpack8(q0, a0); unpack8(q1, a1); unpack8(q2, a2);
      const float ss = sum8lanes(ssq8(a0) + ssq8(a1) + ssq8(a2)) * (rq * rq);
      const float sc = rq / sqrtf(ss * (1.f / 192.f) + EPS);
      float r[8], o[8];
#pragma unroll
      for (int i = 0; i < 8; ++i) { a0[i] *= sc * G.q[0][i]; a1[i] *= sc * G.q[1][i]; r[i] = a2[i] * sc * G.q[2][i]; }
#pragma unroll
      for (int i = 0; i < 8; ++i) { const float rp = __shfl_xor(r[i], 4); o[i] = r[i] * cs[i] + sg * rp * sn[i]; }
      *(v4u*)(qr) = pack8(a0); *(v4u*)(qr + 64) = pack8(a1); *(v4u*)(qr + 128) = pack8(o); }
    { float a0[8], a1[8], pe[8], b0[8], b1[8]; unpack8(k0, a0); unpack8(k1, a1); unpack8(pev, pe); unpack8(v0, b0); unpack8(v1, b1);
      const float ss = sum8lanes((ssq8(a0) + ssq8(a1)) * (rkv * rkv) + ssq8(pe));
      const float sk = 1.0f / sqrtf(ss * (1.f / 192.f) + EPS);
      float r[8], o[8];
#pragma unroll
      for (int i = 0; i < 8; ++i) { a0[i] *= rkv * sk * G.k[0][i]; a1[i] *= rkv * sk * G.k[1][i]; r[i] = pe[i] * sk * G.k[2][i]; b0[i] *= rkv; b1[i] *= rkv; }
#pragma unroll
      for (int i = 0; i < 8; ++i) { const float rp = __shfl_xor(r[i], 4); o[i] = r[i] * cs[i] + sg * rp * sn[i]; }
      *(v4u*)(kr) = pack8(a0); *(v4u*)(kr + 64) = pack8(a1); *(v4u*)(kr + 128) = pack8(o); *(v4u*)(kr + 192) = pack8(b0); *(v4u*)(kr + 256) = pack8(b1); }
}
__device__ __forceinline__ void attn_norm_row(bf16* MIXED, int m, int lane) {
    v4u* p = (v4u*)(MIXED + (size_t)m * DM + 512 + 16 * lane); v4u a = p[0], b = p[1];
    unsigned w[8] = {a.x, a.y, a.z, a.w, b.x, b.y, b.z, b.w}; float s = 0.f;
#pragma unroll
    for (int i = 0; i < 8; ++i) { const float x = bflo(w[i]), y = bfhi(w[i]); s += x * x + y * y; }
    const float rstd = 1.0f / sqrtf(wave_sum(s) * (1.f / 1024.f) + EPS);
#pragma unroll
    for (int i = 0; i < 8; ++i) w[i] = pk2(bflo(w[i]) * rstd, bfhi(w[i]) * rstd);
    a.x = w[0]; a.y = w[1]; a.z = w[2]; a.w = w[3]; b.x = w[4]; b.y = w[5]; b.z = w[6]; b.w = w[7]; p[0] = a; p[1] = b;
}

#define DEFPTRS() unsigned char* ws = args.ws; \
    bf16* BtIn = (bf16*)(ws + WS_BTIN); bf16* BtUq = (bf16*)(ws + WS_BTUQ); bf16* BtKv = (bf16*)(ws + WS_BTKV); bf16* BtOut = (bf16*)(ws + WS_BTOUT); bf16* BtUp = (bf16*)(ws + WS_BTUP); bf16* BtDn = (bf16*)(ws + WS_BTDN); \
    bf16* RF = (bf16*)(ws + WS_RF); bf16* Hb = (bf16*)(ws + WS_H); bf16* PROJ = (bf16*)(ws + WS_PROJ); bf16* Qb = (bf16*)(ws + WS_Q); bf16* KVb = (bf16*)(ws + WS_KV); \
    bf16* ZT = (bf16*)(ws + WS_ZT); bf16* X0 = (bf16*)(ws + WS_X0); bf16* YC = (bf16*)(ws + WS_YC); float* EDGE = (float*)(ws + WS_EDGE); float* ROPE = (float*)(ws + WS_ROPE); float* SSQP = (float*)(ws + WS_SSQP); float* RSTD = (float*)(ws + WS_RSTD); bf16* XB2 = (bf16*)(ws + WS_XB2); bf16* ACT = (bf16*)(ws + WS_ACT); \
    bf16* XA = (bf16*)args.out; \
    (void)BtIn; (void)BtUq; (void)BtKv; (void)BtOut; (void)BtUp; (void)BtDn; (void)RF; (void)Hb; (void)PROJ; (void)Qb; (void)KVb; (void)ZT; (void)X0; (void)YC; (void)EDGE; (void)ROPE; (void)SSQP; (void)RSTD; (void)XB2; (void)ACT; (void)XA
__global__ void __launch_bounds__(NWAVES * 64, 2) fwd(Args args) {
    extern __shared__ __attribute__((aligned(16))) unsigned char lds_raw[];
    Frame F;
    F.lds = (LAS unsigned char*)lds_raw;
    F.tid = threadIdx.x; F.lane = F.tid & 63; F.wave = __builtin_amdgcn_readfirstlane(F.tid >> 6);
    F.G = gridDim.x; { const int bx = blockIdx.x; F.vcu = (F.G % 8 == 0) ? (bx % 8) * (F.G / 8) + bx / 8 : bx; }
    volatile LAS unsigned* MISC = (volatile LAS unsigned*)(F.lds + MISC_OFF);
    if (F.tid < 64) MISC[F.tid] = 0u;
    __syncthreads();
    unsigned* ctl = (unsigned*)(args.ws + WS_CTL);
    const int lo = args.ph_lo, hi = args.ph_hi;
    XcdBarrier bar; bar.bar = ctl + CW_BAR; bar.x = 0; bar.st = MISC + 8;
    if (hi - lo > 1) bar = xcd_barrier_post(ctl + CW_BAR, MISC + 8);
    float* out = args.out;

#pragma unroll 1
    for (int layer = 0; layer < DEPTH; ++layer) {
        const int pb = layer * NPH;
        if (pb + NPH <= lo || pb >= hi) continue;
#define IN(k) (lo <= pb + (k) && pb + (k) < hi)
#define ENTER() DEFPTRS(); F.tid = opq(threadIdx.x); F.lane = F.tid & 63; F.wave = __builtin_amdgcn_readfirstlane(F.tid >> 6); const int gw = F.vcu * NWAVES + F.wave, NGW = F.G * NWAVES, wg = F.vcu; const size_t gtid = (size_t)wg * 512 + F.tid, gthreads = (size_t)F.G * 512; (void)gw; (void)NGW; (void)wg; (void)gtid; (void)gthreads
#define SEAM(k) do { if (pb + (k) + 1 < hi) xcd_barrier(bar); } while (0)

        if (IN(0)) { ENTER();
            const float* win = args.in[I_WIN] + (size_t)layer * DM * DIN; const float* g1 = args.in[I_ANG] + layer * DM;
            for (int it = wg; it < 256; it += F.G) {
                if (it < 128) poolfold_item(F, win, args.in[I_PW] + (size_t)layer * 4 * 128 * 128, args.in[I_PS] + (size_t)layer * 512, g1, BtIn, it >> 5, it & 31);
                else filter_item(F, args.in[I_FW1] + (size_t)layer * 17 * 64, args.in[I_FB1] + layer * 64, args.in[I_FFR] + layer * 64, args.in[I_FW2] + (size_t)layer * 64 * 64, args.in[I_FB2] + layer * 64,
                                 args.in[I_FW3] + (size_t)layer * 64 * 1024, args.in[I_FB3] + layer * 1024, args.in[I_HBIAS] + layer * 512, RF, it - 128);
            }
            LAS float* scr = (LAS float*)(F.lds + F.wave * 8448);
            constexpr int N_IN_ = 74 * 32, N_UQ = 48 * 8, N_KV = 64 * 4, N_OUT = 64 * 32, N_UP = 352 * 32, N_DN = 64 * 88, N_ALL = N_IN_ + N_UQ + N_KV + N_OUT + N_UP + N_DN;
            for (int it = gw; it < N_ALL; it += NGW) {
                int r = it;
                if (r < N_IN_) { const int nb = 16 + r / 32, kb = r % 32; cvt_item(win, DIN, DM, BtIn, 32 * nb, 32 * nb, 64 * kb, g1, scr, F.lane); continue; } r -= N_IN_;
                if (r < N_UQ) { const int nb = r / 8, kb = r % 8; cvt_item(args.in[I_WUQ] + (size_t)layer * 512 * NQ, NQ, 512, BtUq, 32 * nb, 32 * nb, 64 * kb, args.in[I_QNG] + layer * 512, scr, F.lane); continue; } r -= N_UQ;
                if (r < N_KV) { const int nb = r / 4, kb = r % 4, h = nb >> 3, wb = nb & 7; const int dst = KVHS * h + (wb < 4 ? 32 * wb : 192 + 32 * (wb - 4));
                    cvt_item(args.in[I_WUKV] + (size_t)layer * 256 * 2048, 2048, 256, BtKv, dst, 32 * nb, 64 * kb, args.in[I_KVNG] + layer * 256, scr, F.lane); continue; } r -= N_KV;
                if (r < N_OUT) { const int nb = r / 32, kb = r % 32; cvt_item(args.in[I_WOUT] + (size_t)layer * DM * DM, DM, DM, BtOut, 32 * nb, 32 * nb, 64 * kb, args.in[I_GNG] + layer * DM, scr, F.lane); continue; } r -= N_OUT;
                if (r < N_UP) { const int nb = r / 32, kb = r % 32; const int nv = (nb < 176) ? nb : nb - 176; const int dst = 256 * (nv >> 2) + 64 * (nv & 3) + (nb < 176 ? 0 : 32);
                    cvt_item(args.in[I_WUP] + (size_t)layer * DM * NUP, NUP, DM, BtUp, dst, 32 * nb, 64 * kb, args.in[I_FNG] + layer * DM, scr, F.lane); continue; } r -= N_UP;
                { const int nb = r / 88, kb = r % 88; cvt_item(args.in[I_WDN] + (size_t)layer * DFF * DM, DM, DFF, BtDn, 32 * nb, 32 * nb, 64 * kb, nullptr, scr, F.lane); }
            }
            { unsigned zz = 0u; asm volatile("" : "+v"(zz)); v4u z = {zz, zz, zz, zz};
              for (size_t i = gtid; i < (size_t)(DINP - DIN) * DM / 8; i += gthreads) *(v4u*)(BtIn + (size_t)DIN * DM + i * 8) = z;
              for (size_t i = gtid; i < (size_t)NH * 64 * 256 / 8; i += gthreads) { const int h = (int)(i / (64 * 256 / 8)), q = (int)(i % (64 * 256 / 8)); *(v4u*)(BtKv + (size_t)(KVHS * h + 128) * 256 + (size_t)q * 8) = z; } }
            if (layer == 0) for (size_t i = gtid; i < (size_t)SEQ * 32; i += gthreads) { const int pos = (int)(i >> 5), ri = (int)(i & 31);
                const float freq = exp2f(-(float)ri * (13.287712379549449f / 32.0f)); float sn, cs; sincosf((float)pos * freq, &sn, &cs); ROPE[pos * 64 + ri] = cs; ROPE[pos * 64 + 32 + ri] = sn; }
            if (layer == 0) { for (int m = gw; m < M; m += NGW) xb_row(m < MP ? args.in[I_XP] + (size_t)m * DM : args.in[I_XS] + (size_t)(m - MP) * DM, XA + (size_t)m * DM, RSTD + m, F.lane); }
            else rstd_from_partials(SSQP, RSTD, gtid, gthreads);
            SEAM(0);
        }
        if (IN(1)) { ENTER();
            pg8::Gemm g{XA, BtIn, M, DINP, DM, DM}; pg8::StaticOrder S; S.init(M, DINP, F.G, (int)blockIdx.x);
            pg8::EpiBf16 E{PROJ, DINP, RSTD};
            pg8::gemm_phase<pg8::EpiBf16, pg8::StaticOrder>(F.lds, g, S, E);
            SEAM(1);
        }
        if (IN(2)) { ENTER();
            { pg8::Gemm g{PROJ + O_CQ, BtUq, M, NQ, 512, DINP}; pg8::StaticOrder S; S.init(M, NQ, F.G, (int)blockIdx.x); pg8::EpiBf16 E{Qb, NQ, nullptr};
              pg8::gemm_phase<pg8::EpiBf16, pg8::StaticOrder>(F.lds, g, S, E); }
            { pg8::Gemm g{PROJ + O_CKV, BtKv, M, NKVP, 256, DINP}; pg8::StaticOrder S; S.init(M, NKVP, F.G, (int)blockIdx.x); pg8::EpiBf16 E{KVb, NKVP, nullptr};
              pg8::gemm_phase<pg8::EpiBf16, pg8::StaticOrder>(F.lds, g, S, E); }
            const float* hcw = args.in[I_HCW] + (size_t)layer * 3 * 1536; const float* hcb = args.in[I_HCB] + layer * 1536;
            for (int it = wg; it < 2 * NSEQ * 64; it += F.G) {
                if (it < NSEQ * 64) hyprep_item(F, PROJ, hcw, hcb, ZT, X0, it >> 6, it & 63);
                else pool_item(F, PROJ, Hb, (it - NSEQ * 64) >> 6, it & 63);
            }
            SEAM(2);
        }
        if (IN(3)) { ENTER();
            for (int u = wg; u < 2 * HYC; u += F.G) hy::conv_unit(F.lds, ZT, RF, YC, u >> 1, u & 1);
            const float* qhg = args.in[I_QHG] + layer * 192; const float* khg = args.in[I_KHG] + layer * 192;
            PrepGains PG; { const int sub = F.lane & 7;
#pragma unroll
                for (int i = 0; i < 3; ++i) { load8(qhg + 64 * i + 8 * sub, PG.q[i]); load8(khg + 64 * i + 8 * sub, PG.k[i]); } }
            for (int m = gw; m < M; m += NGW) prep_row(PROJ, Qb, KVb, PG, ROPE, m, F.lane);
            SEAM(3);
        }
        if (IN(4)) { ENTER();
            for (int i = 0; i * F.G < NSEQ * NH * 8; ++i) {
                int p, qb; const int c = (int)blockIdx.x;
                if (F.G == 256) { p = i * 32 + (c & 7) * 4 + (c >> 6); qb = (c >> 3) & 7; } else { const int Lq = i * F.G + c; p = Lq >> 3; qb = Lq & 7; }
                if (p < NSEQ * NH) { const int b = p >> 3, h = p & 7;
                    at::attn_unit(Qb + (size_t)(b * SEQ + qb * 256) * NQ + h * 192, KVb + (size_t)(b * SEQ) * NKVP + h * KVHS, KVb + (size_t)(b * SEQ) * NKVP + h * KVHS + 192,
                                  Hb + (size_t)(b * SEQ + qb * 256) * DM + 512 + h * 128, SEQ, (char*)lds_raw); }
            }
            for (int it = wg; it < NSEQ * 64; it += F.G) hyfin_item(F, YC, X0, Hb, it >> 6, it & 63);
            SEAM(4);
        }
        if (IN(5)) { ENTER();
            for (int m = gw; m < M; m += NGW) attn_norm_row(Hb, m, F.lane);
            SEAM(5);
        }
        if (IN(6)) { ENTER();
            pg8::Gemm g{Hb, BtOut, M, DM, DM, DM}; pg8::StaticOrder S; S.init(M, DM, F.G, (int)blockIdx.x);
            pg8::EpiResid16 E{XA, XB2, out, DM, SSQP, 0};
            pg8::gemm_phase<pg8::EpiResid16, pg8::StaticOrder>(F.lds, g, S, E);
            SEAM(6);
        }
        if (IN(7)) { ENTER();
            rstd_from_partials(SSQP, RSTD, gtid, gthreads);
            SEAM(7);
        }
        if (IN(8)) { ENTER();
            pg8::Gemm g{XB2, BtUp, M, NUP, DM, DM}; pg8::StaticOrder S; S.init(M, NUP, F.G, (int)blockIdx.x);
            pg8::EpiGate E{ACT, DFF, EDGE, args.in[I_FCW] + (size_t)layer * 3 * DFF, args.in[I_FCB] + layer * DFF, DFF, (LAS float*)(F.lds + HALO_OFF), RSTD};
            pg8::gemm_phase<pg8::EpiGate, pg8::StaticOrder>(F.lds, g, S, E);
            SEAM(8);
        }
        if (IN(9)) { ENTER();
            const float* fcw = args.in[I_FCW] + (size_t)layer * 3 * DFF;
            for (size_t i = gtid; i < (size_t)(M / 256) * 2 * (DFF / 4); i += gthreads) {
                const int ri = (int)(i / (DFF / 4)), c4 = (int)(i % (DFF / 4)) * 4, pm = ri >> 1, e = ri & 1;
                const float* eb = EDGE + (size_t)(ri * 3) * DFF + c4;
                f32x4 pre = *(const f32x4*)(eb + DFF); const f32x4 v = *(const f32x4*)(eb + 2 * DFF);
                if (e == 0 && (pm & 7) != 0) { const f32x4 gp = *(const f32x4*)(EDGE + (size_t)(((pm - 1) * 2 + 1) * 3) * DFF + c4); pre += *(const f32x4*)(fcw + c4) * gp; }
                if (e == 1 && (pm & 7) != 7) { const f32x4 gn = *(const f32x4*)(EDGE + (size_t)(((pm + 1) * 2 + 0) * 3) * DFF + c4); pre += *(const f32x4*)(fcw + 2 * DFF + c4) * gn; }
                v2u o; o.x = pk2(pg8::silu_f(pre.x) * v.x, pg8::silu_f(pre.y) * v.y); o.y = pk2(pg8::silu_f(pre.z) * v.z, pg8::silu_f(pre.w) * v.w);
                *(v2u*)(ACT + (size_t)(pm * 256 + (e ? 255 : 0)) * DFF + c4) = o;
            }
            SEAM(9);
        }
        if (IN(10)) { ENTER();
            pg8::Gemm g{ACT, BtDn, M, DM, DFF, DFF}; pg8::StaticOrder S; S.init(M, DM, F.G, (int)blockIdx.x);
            pg8::EpiResid16 E{XB2, XA, out, DM, SSQP, (layer + 1 < DEPTH) ? 0 : 1};
            pg8::gemm_phase<pg8::EpiResid16, pg8::StaticOrder>(F.lds, g, S, E);
            SEAM(10);
        }
#undef IN
#undef ENTER
#undef SEAM
    }
}

extern "C" void kernel_launch(void* const* d_in, const int* in_sizes, int n_in, void* d_out, int out_size, void* d_ws, size_t ws_size, hipStream_t stream) {
    static int grid = 0;
    if (grid == 0) {
        if (n_in != N_IN || out_size != M * DM || ws_size < WS_END) { fprintf(stderr, "kernel_launch: unexpected shapes (n_in %d, out %d, ws %zu, need %zu)\n", n_in, out_size, ws_size, (size_t)WS_END); grid = -1; return; }
        int dev = 0, cus = 0;
        if (hipGetDevice(&dev) != hipSuccess || hipDeviceGetAttribute(&cus, hipDeviceAttributeMultiprocessorCount, dev) != hipSuccess) { grid = -1; return; }
        if (hipFuncSetAttribute((const void*)fwd, hipFuncAttributeMaxDynamicSharedMemorySize, LDS_BYTES) != hipSuccess) { fprintf(stderr, "kernel_launch: hipFuncSetAttribute failed\n"); grid = -1; return; }
        int per_cu = 0;
        if (hipOccupancyMaxActiveBlocksPerMultiprocessor(&per_cu, (const void*)fwd, NWAVES * 64, LDS_BYTES) != hipSuccess || per_cu < 1) fprintf(stderr, "kernel_launch: occupancy query reports %d\n", per_cu);
        (void)hipGetLastError();
        grid = cus;
    }
    if (grid < 0) return;
    (void)hipMemsetAsync((char*)d_ws + WS_CTL, 0, CTL_BYTES, stream);
    Args a{};
    for (int i = 0; i < N_IN; ++i) a.in[i] = (const float*)d_in[i];
    a.out = (float*)d_out; a.ws = (unsigned char*)d_ws;
#if MK_ONE_LAUNCH
    a.ph_lo = 0; a.ph_hi = DEPTH * NPH;
    hipLaunchKernelGGL(fwd, dim3(grid), dim3(NWAVES * 64), LDS_BYTES, stream, a);
#else
    for (int p = 0; p < DEPTH * NPH; ++p) { a.ph_lo = p; a.ph_hi = p + 1; hipLaunchKernelGGL(fwd, dim3(grid), dim3(NWAVES * 64), LDS_BYTES, stream, a); }
#endif
    const hipError_t le = hipPeekAtLastError();
    if (le != hipSuccess) fprintf(stderr, "kernel_launch: launch failed: %s\n", hipGetErrorName(le));
}
```

```cpp
#include <hip/hip_runtime.h>
#include <cstdio>
#include <cstdint>
__device__ __forceinline__ int opq(int x) { asm volatile("" : "+v"(x)); return x; }
#ifndef STAGGER_TICKS
#define STAGGER_TICKS 0
#endif
namespace pg8 {
#define PG8_LAS __attribute__((address_space(3)))
typedef unsigned short bf16_t;
typedef short bf16x8 __attribute__((ext_vector_type(8)));
typedef float f32x4 __attribute__((ext_vector_type(4)));
typedef unsigned u32x4 __attribute__((ext_vector_type(4)));
constexpr int BM = 256, BK = 64, HALF = 128, HTB = HALF * BK * 2  , STAGE_BYTES = 8 * HTB, NXCD = 8, WGM = 8;

__host__ __device__ __forceinline__ int lds_byte(int r, int c) { const int st = (r >> 4) * 2 + (c >> 5), rr = r & 15, cc = c & 31, ob = rr * 64 + cc * 2; return st * 1024 + (ob ^ (((ob >> 9) & 1) << 5)); }
__host__ __device__ __forceinline__ void stage_rc(int b, int& R, int& C) { const int st = b / 1024, sb = b % 1024, swz = sb ^ (((sb >> 9) & 1) << 5); R = (st >> 1) * 16 + swz / 64; C = (st & 1) * 32 + (swz % 64) / 2; }
__host__ __device__ __forceinline__ int perm32(int rho) { const int n = rho >> 4, i = rho & 15; return 8 * (i >> 2) + 4 * n + (i & 3); }

struct Unit { int pm, pn; };
struct Gemm { const bf16_t* A; const bf16_t* Bt; int M, N, K, lda; };

struct StaticOrder {
    int nM, nN, nwg, G, c;
    __host__ __device__ void init(int M, int N, int G_, int c_) { nM = M / BM; nN = N / BM; nwg = nM * nN; G = G_; c = c_; }
    __host__ __device__ bool next(int i, Unit& u) const {
        const long L = (long)i * G + c; if (L >= nwg) return false;
        int wgid = (int)L; { const int q = nwg / NXCD, r = nwg % NXCD, xcd = wgid % NXCD, off = wgid / NXCD; wgid = (xcd < r ? xcd * (q + 1) : r * (q + 1) + (xcd - r) * q) + off; }
        const int nig = WGM * nN, gid = wgid / nig, fm = gid * WGM, gsz = (nM - fm) < WGM ? (nM - fm) : WGM;
        u.pm = fm + ((wgid % nig) % gsz); u.pn = (wgid % nig) / gsz; return true;
    }
    __device__ __forceinline__ void a_ready(const Unit&) const {}
    __device__ __forceinline__ void done(const Unit&) const {}
};

__device__ __forceinline__ unsigned cvt_pk_bf16(float lo, float hi) { unsigned r; asm volatile("v_cvt_pk_bf16_f32 %0, %1, %2" : "=v"(r) : "v"(lo), "v"(hi)); return r; }

__device__ __forceinline__ float dpp_ror1(float v) { return __builtin_bit_cast(float, __builtin_amdgcn_update_dpp(0, __builtin_bit_cast(int, v), 0x121, 0xF, 0xF, false)); }
__device__ __forceinline__ float dpp_ror15(float v) { return __builtin_bit_cast(float, __builtin_amdgcn_update_dpp(0, __builtin_bit_cast(int, v), 0x12F, 0xF, 0xF, false)); }
__device__ __forceinline__ unsigned dpp_swap1(unsigned v) { return (unsigned)__builtin_amdgcn_update_dpp(0, (int)v, 0xB1, 0xF, 0xF, false); }
struct LineOffs { unsigned o0, o1; bool odd; };
__device__ __forceinline__ LineOffs line_offs(unsigned lo, int pitch, int fr) { LineOffs L; L.odd = fr & 1; L.o0 = L.odd ? lo - (unsigned)pitch + 32u : lo; L.o1 = L.odd ? lo + 32u : lo + (unsigned)pitch; return L; }
__device__ __forceinline__ void store_lines(bf16_t* base, const LineOffs& L, u32x4 a, u32x4 b) {
    const u32x4 snd = L.odd ? a : b; u32x4 rcv;
    rcv.x = dpp_swap1(snd.x); rcv.y = dpp_swap1(snd.y); rcv.z = dpp_swap1(snd.z); rcv.w = dpp_swap1(snd.w);
    *(u32x4*)(base + L.o0) = L.odd ? rcv : a;
    *(u32x4*)(base + L.o1) = L.odd ? b : rcv;
}
struct EpiBf16 {
    static constexpr bool PERM = true;
    bf16_t* O; int ldc; const float* rstd;
    __device__ __forceinline__ void operator()(f32x4 (&acc)[2][2][4][2], const Unit& u, int wr, int wc, int fr, int fq) const {
        bf16_t* Ot = O + (size_t)(u.pm * BM) * ldc + u.pn * BM;
        const LineOffs L = line_offs((unsigned)((wr * 64 + fr) * ldc + wc * 64 + 8 * fq), ldc, fr); const int row0 = u.pm * BM + wr * 64 + fr;
        float rsv[8];
#pragma unroll
        for (int i = 0; i < 8; ++i) rsv[i] = rstd ? rstd[row0 + (i >> 2) * HALF + (i & 3) * 16] : 1.0f;
#pragma unroll
        for (int ai = 0; ai < 2; ++ai)
#pragma unroll
            for (int m = 0; m < 4; ++m) { const float rs = rsv[ai * 4 + m];
                u32x4 w[2];
#pragma unroll
                for (int bj = 0; bj < 2; ++bj) { const f32x4 v0 = acc[ai][bj][m][0] * rs, v1 = acc[ai][bj][m][1] * rs;
                    w[bj].x = cvt_pk_bf16(v0[0], v0[1]); w[bj].y = cvt_pk_bf16(v0[2], v0[3]); w[bj].z = cvt_pk_bf16(v1[0], v1[1]); w[bj].w = cvt_pk_bf16(v1[2], v1[3]); }
                store_lines(Ot + (size_t)((ai * HALF + m * 16) * ldc), L, w[0], w[1]);
                asm volatile("" ::: "memory"); }
    }
};
struct EpiResid16 {
    static constexpr bool PERM = true;
    const bf16_t* base; bf16_t* xo; float* out; int ldc; float* ssqp; int f32out;
    __device__ __forceinline__ static void addx(const u32x4 b, const f32x4 a0, const f32x4 a1, f32x4& x0, f32x4& x1) {
        x0[0] = __builtin_bit_cast(float, b.x << 16) + a0[0]; x0[1] = __builtin_bit_cast(float, b.x & 0xffff0000u) + a0[1]; x0[2] = __builtin_bit_cast(float, b.y << 16) + a0[2]; x0[3] = __builtin_bit_cast(float, b.y & 0xffff0000u) + a0[3];
        x1[0] = __builtin_bit_cast(float, b.z << 16) + a1[0]; x1[1] = __builtin_bit_cast(float, b.z & 0xffff0000u) + a1[1]; x1[2] = __builtin_bit_cast(float, b.w << 16) + a1[2]; x1[3] = __builtin_bit_cast(float, b.w & 0xffff0000u) + a1[3]; }
    __device__ __forceinline__ void operator()(f32x4 (&acc)[2][2][4][2], const Unit& u, int wr, int wc, int fr, int fq) const {
        const size_t tb = (size_t)(u.pm * BM) * ldc + u.pn * BM;
        const bf16_t* bs = base + tb;
        const unsigned lo = (unsigned)((wr * 64 + fr) * ldc + wc * 64 + 8 * fq);
        if (f32out != 0) {
            float* op = out + tb;
#pragma unroll
            for (int ai = 0; ai < 2; ++ai)
#pragma unroll
                for (int m = 0; m < 4; ++m) { const unsigned off = lo + (unsigned)((ai * HALF + m * 16) * ldc);
#pragma unroll
                    for (int bj = 0; bj < 2; ++bj) { const u32x4 b = *(const u32x4*)(bs + off + bj * 32); f32x4 x0, x1; addx(b, acc[ai][bj][m][0], acc[ai][bj][m][1], x0, x1);
                        *(f32x4*)(op + off + bj * 32) = x0; *(f32x4*)(op + off + bj * 32 + 4) = x1; }
                    asm volatile("" ::: "memory"); }
            return;
        }
        bf16_t* xp = xo + tb; const LineOffs L = line_offs(lo, ldc, fr);
#pragma unroll
        for (int aim = 0; aim < 4; ++aim) { const int ai = aim >> 1, mp = aim & 1;
            u32x4 bv[2][2];
#pragma unroll
            for (int mm = 0; mm < 2; ++mm)
#pragma unroll
                for (int bj = 0; bj < 2; ++bj) bv[mm][bj] = *(const u32x4*)(bs + lo + (unsigned)((ai * HALF + (2 * mp + mm) * 16) * ldc) + bj * 32);
#pragma unroll
            for (int mm = 0; mm < 2; ++mm) { const int m = 2 * mp + mm; float s = 0.f; u32x4 wv[2];
#pragma unroll
                for (int bj = 0; bj < 2; ++bj) { f32x4 x0, x1; addx(bv[mm][bj], acc[ai][bj][m][0], acc[ai][bj][m][1], x0, x1);
                    wv[bj].x = cvt_pk_bf16(x0[0], x0[1]); wv[bj].y = cvt_pk_bf16(x0[2], x0[3]); wv[bj].z = cvt_pk_bf16(x1[0], x1[1]); wv[bj].w = cvt_pk_bf16(x1[2], x1[3]);
                    s += ((x0[0] * x0[0] + x0[1] * x0[1]) + (x0[2] * x0[2] + x0[3] * x0[3])) + ((x1[0] * x1[0] + x1[1] * x1[1]) + (x1[2] * x1[2] + x1[3] * x1[3])); }
                store_lines(xp + (size_t)((ai * HALF + m * 16) * ldc), L, wv[0], wv[1]);
                s += __shfl_xor(s, 16); s += __shfl_xor(s, 32); if (fq == 0) ssqp[(size_t)(u.pm * BM + wr * 64 + fr + ai * HALF + m * 16) * 32 + u.pn * 4 + wc] = s; }
            asm volatile("" ::: "memory"); }
    }
};
__device__ __forceinline__ float silu_f(float x) { return x * __builtin_amdgcn_rcpf(1.0f + __builtin_amdgcn_exp2f(-1.4426950408889634f * x)); }
struct EpiGate {
    static constexpr bool PERM = true;
    bf16_t* act; int ldact; float* edge; const float* cw; const float* cb; int dff; PG8_LAS float* halo; const float* rstd;
    __device__ __forceinline__ void operator()(f32x4 (&acc)[2][2][4][2], const Unit& u, int wr, int wc, int fr, int fq) const {
        const int lane = fq * 16 + fr; const int colL = wc * 32 + 8 * fq; const int colG = u.pn * HALF + colL;
#pragma unroll
        for (int ai = 0; ai < 2; ++ai)
#pragma unroll
            for (int m = 0; m < 4; ++m) { const float rs = rstd[u.pm * BM + ai * HALF + wr * 64 + m * 16 + fr];
#pragma unroll
                for (int bj = 0; bj < 2; ++bj) { acc[ai][bj][m][0] *= rs; acc[ai][bj][m][1] *= rs; } }
#pragma unroll
        for (int ai = 0; ai < 2; ++ai) { const int q = 2 * ai + wr;
            if (fr == 0) { *(PG8_LAS f32x4*)(halo + (q * 2 + 0) * 128 + colL) = acc[ai][0][0][0]; *(PG8_LAS f32x4*)(halo + (q * 2 + 0) * 128 + colL + 4) = acc[ai][0][0][1]; }
            if (fr == 15) { *(PG8_LAS f32x4*)(halo + (q * 2 + 1) * 128 + colL) = acc[ai][0][3][0]; *(PG8_LAS f32x4*)(halo + (q * 2 + 1) * 128 + colL + 4) = acc[ai][0][3][1]; } }
        asm volatile("s_waitcnt lgkmcnt(0)" ::: "memory"); __builtin_amdgcn_s_barrier(); asm volatile("" ::: "memory");
        bf16_t* actp = act + (size_t)(u.pm * BM) * ldact + colG; const unsigned rlo = (unsigned)((wr * 64 + fr) * ldact);
#pragma unroll
        for (int ai = 0; ai < 2; ++ai) { const int q = 2 * ai + wr;
            typedef unsigned u32x2 __attribute__((ext_vector_type(2)));
            u32x2 pk[4][2];
#pragma unroll
            for (int n = 0; n < 2; ++n) {
                const f32x4 w0 = *(const f32x4*)(cw + colG + 4 * n), w1 = *(const f32x4*)(cw + dff + colG + 4 * n), w2 = *(const f32x4*)(cw + 2 * dff + colG + 4 * n), bb = *(const f32x4*)(cb + colG + 4 * n);
                f32x4 ht = *(PG8_LAS f32x4*)(halo + ((q > 0 ? q - 1 : 0) * 2 + 1) * 128 + colL + 4 * n), hb = *(PG8_LAS f32x4*)(halo + ((q < 3 ? q + 1 : 3) * 2 + 0) * 128 + colL + 4 * n);
                if (q == 0) ht = ht * 0.f; if (q == 3) hb = hb * 0.f;
                f32x4 pre[4];
#pragma unroll
                for (int j = 0; j < 4; ++j) {
                    float g[4], rr[4], rl[4];
#pragma unroll
                    for (int m = 0; m < 4; ++m) { g[m] = acc[ai][0][m][n][j]; rr[m] = dpp_ror1(g[m]); rl[m] = dpp_ror15(g[m]); }
#pragma unroll
                    for (int m = 0; m < 4; ++m) {
                        const float up = (fr > 0) ? rr[m] : (m > 0 ? rr[m > 0 ? m - 1 : 0] : ht[j]);
                        const float dn = (fr < 15) ? rl[m] : (m < 3 ? rl[m < 3 ? m + 1 : 3] : hb[j]);
                        pre[m][j] = w0[j] * up + w1[j] * g[m] + w2[j] * dn + bb[j];
                    }
                }
                if (q == 0 && fr == 0) { float* e = edge + (size_t)((u.pm * 2 + 0) * 3) * dff + colG + 4 * n;
                    *(f32x4*)(e) = acc[ai][0][0][n]; *(f32x4*)(e + dff) = pre[0]; *(f32x4*)(e + 2 * dff) = acc[ai][1][0][n]; }
                if (q == 3 && fr == 15) { float* e = edge + (size_t)((u.pm * 2 + 1) * 3) * dff + colG + 4 * n;
                    *(f32x4*)(e) = acc[ai][0][3][n]; *(f32x4*)(e + dff) = pre[3]; *(f32x4*)(e + 2 * dff) = acc[ai][1][3][n]; }
#pragma unroll
                for (int m = 0; m < 4; ++m) { const f32x4 v = acc[ai][1][m][n];
                    pk[m][n].x = cvt_pk_bf16(silu_f(pre[m][0]) * v[0], silu_f(pre[m][1]) * v[1]); pk[m][n].y = cvt_pk_bf16(silu_f(pre[m][2]) * v[2], silu_f(pre[m][3]) * v[3]); }
            }
#pragma unroll
            for (int m = 0; m < 4; ++m) { u32x4 w; w.x = pk[m][0].x; w.y = pk[m][0].y; w.z = pk[m][1].x; w.w = pk[m][1].y;
                *(u32x4*)(actp + rlo + (unsigned)((ai * HALF + m * 16) * ldact)) = w; }
        }
    }
};

template <class Epi, class Sched>
__device__ __forceinline__ void gemm_phase(PG8_LAS unsigned char* lds, const Gemm g, const Sched& S, const Epi& E) {
    const int tid = opq(threadIdx.x), wid = __builtin_amdgcn_readfirstlane(tid >> 6), lane = tid & 63, wr = wid >> 2, wc = wid & 3, fr = lane & 15, fq = lane >> 4;
    const int K = g.K, nt = K / BK, lda = g.lda;
    unsigned voffA[2], voffB[2];
#pragma unroll
    for (int i = 0; i < 2; ++i) { int R, C; stage_rc(tid * 16 + i * 8192, R, C); const int Rb = Epi::PERM ? (64 * (R >> 5) + perm32(R & 31)) : R;
        voffA[i] = (unsigned)(R * lda + C) * 2u; voffB[i] = (unsigned)(Rb * K + C) * 2u; }
    const size_t kstep = (size_t)(BK * 2);
    const size_t hstepA = (size_t)HALF * lda * 2, hstepB = (size_t)(Epi::PERM ? 32 : HALF) * K * 2;
    const size_t tstepA = 2 * hstepA, tstepB = (size_t)BM * K * 2;
    const unsigned ldsw = (unsigned)wid * 1024u;
    const int aoff = lds_byte(wr * 64 + fr, fq * 8), boff = lds_byte(wc * 32 + fr, fq * 8);
#define PG8_SA(b, h) (((b) * 2 + (h)) * HTB)
#define PG8_SB(b, h) ((4 + (b) * 2 + (h)) * HTB)
#define PG8_STAGE(bufoff, gbase, voff) do { _Pragma("unroll") for (int _i = 0; _i < 2; ++_i) \
        __builtin_amdgcn_global_load_lds((const unsigned*)((const char*)(gbase) + (voff)[_i]), (PG8_LAS unsigned*)(lds + (bufoff) + ldsw + _i * 8192), 16, 0, 0); } while (0)
#define PG8_LDA(dst, b, h) do { _Pragma("unroll") for (int m = 0; m < 4; ++m) _Pragma("unroll") for (int k = 0; k < 2; ++k) dst[m][k] = *(const PG8_LAS bf16x8*)(lds + PG8_SA(b, h) + aoff + m * 2048 + k * 1024); } while (0)
#define PG8_LDB(dst, b, h) do { _Pragma("unroll") for (int n = 0; n < 2; ++n) _Pragma("unroll") for (int k = 0; k < 2; ++k) dst[n][k] = *(const PG8_LAS bf16x8*)(lds + PG8_SB(b, h) + boff + n * 2048 + k * 1024); } while (0)
#define PG8_MMA(ai, bj, At, Bt) do { __builtin_amdgcn_s_setprio(1); _Pragma("unroll") for (int m = 0; m < 4; ++m) _Pragma("unroll") for (int n = 0; n < 2; ++n) _Pragma("unroll") for (int k = 0; k < 2; ++k) \
        acc[ai][bj][m][n] = __builtin_amdgcn_mfma_f32_16x16x32_bf16(Bt[n][k], At[m][k], acc[ai][bj][m][n], 0, 0, 0); __builtin_amdgcn_s_setprio(0); } while (0)
#define PG8_WAIT_V(n) asm volatile("s_waitcnt vmcnt(" #n ")" ::: "memory")
#define PG8_WAIT_L(n) asm volatile("s_waitcnt lgkmcnt(" #n ")" ::: "memory")
#define PG8_BAR __builtin_amdgcn_s_barrier()
#define PG8_SCHED __builtin_amdgcn_sched_barrier(0)
    Unit cur, nxt; int ui = 0;
    if (!S.next(0, cur)) return;
    if (STAGGER_TICKS > 0) {
        const unsigned long long t0 = __builtin_amdgcn_s_memrealtime(), dt = (unsigned long long)(((unsigned)blockIdx.x >> 3) & 3u) * STAGGER_TICKS;
        while (__builtin_amdgcn_s_memrealtime() - t0 < dt) __builtin_amdgcn_s_sleep(8);
    }
    f32x4 acc[2][2][4][2];
{ float zf = 0.f; asm volatile("" : "+v"(zf));
    #pragma unroll
    for (int a = 0; a < 2; ++a)
#pragma unroll
        for (int b = 0; b < 2; ++b)
#pragma unroll
            for (int m = 0; m < 4; ++m)
#pragma unroll
                for (int n = 0; n < 2; ++n) acc[a][b][m][n] = (f32x4){zf, zf, zf, zf}; }
    bf16x8 At[4][2], B0[2][2], B1[2][2];
    const char* cA = (const char*)g.A + (size_t)cur.pm * tstepA; const char* cB = (const char*)g.Bt + (size_t)cur.pn * tstepB;
    S.a_ready(cur);
    PG8_STAGE(PG8_SB(0, 0), cB, voffB); PG8_STAGE(PG8_SB(0, 1), cB + hstepB, voffB); PG8_STAGE(PG8_SA(0, 0), cA, voffA); PG8_STAGE(PG8_SA(0, 1), cA + hstepA, voffA);
    if (wr == 1) PG8_BAR;
    PG8_WAIT_V(2); PG8_BAR;
    PG8_STAGE(PG8_SB(1, 0), cB + kstep, voffB); PG8_STAGE(PG8_SA(1, 0), cA + kstep, voffA); PG8_STAGE(PG8_SB(1, 1), cB + hstepB + kstep, voffB);
    PG8_WAIT_V(6); PG8_BAR;
    for (;;) {
        const bool has_next = S.next(ui + 1, nxt);
        const char* nA = has_next ? (const char*)g.A + (size_t)nxt.pm * tstepA : cA; const char* nB = has_next ? (const char*)g.Bt + (size_t)nxt.pn * tstepB : cB;
#pragma unroll 1
        for (int t = 0; t < nt; t += 2) {
            const bool last = (t == nt - 2);
            const char* a1 = cA + (size_t)(t + 1) * kstep;
            const char* a2 = last ? nA : cA + (size_t)(t + 2) * kstep; const char* b2 = last ? nB : cB + (size_t)(t + 2) * kstep;
            const char* a3 = a2 + kstep; const char* b3 = b2 + kstep;
            if (last && has_next) S.a_ready(nxt);
            const bool fst = (t == 0) && (ui > 0);
            PG8_LDB(B0, 0, 0); PG8_LDB(B1, 0, 1); PG8_SCHED; PG8_LDA(At, 0, 0); PG8_STAGE(PG8_SA(1, 1), a1 + hstepA, voffA);
            if (fst) PG8_WAIT_V(24); else PG8_WAIT_V(8);
            PG8_WAIT_L(0); PG8_BAR; PG8_MMA(0, 0, At, B0); PG8_MMA(0, 1, At, B1); PG8_BAR; PG8_SCHED;
            PG8_LDA(At, 0, 1); PG8_STAGE(PG8_SB(0, 0), b2, voffB); PG8_STAGE(PG8_SB(0, 1), b2 + hstepB, voffB); PG8_STAGE(PG8_SA(0, 0), a2, voffA);
            if (fst) PG8_WAIT_V(24); else PG8_WAIT_V(8);
            PG8_WAIT_L(0); PG8_BAR; PG8_MMA(1, 0, At, B0); PG8_MMA(1, 1, At, B1); PG8_BAR; PG8_SCHED;
            PG8_LDB(B0, 1, 0); PG8_LDB(B1, 1, 1); PG8_SCHED; PG8_LDA(At, 1, 0); PG8_STAGE(PG8_SA(0, 1), a2 + hstepA, voffA);
            PG8_WAIT_V(8); PG8_WAIT_L(0); PG8_BAR; PG8_MMA(0, 0, At, B0); PG8_MMA(0, 1, At, B1); PG8_BAR; PG8_SCHED;
            PG8_LDA(At, 1, 1); PG8_STAGE(PG8_SB(1, 0), b3, voffB); PG8_STAGE(PG8_SB(1, 1), b3 + hstepB, voffB); PG8_STAGE(PG8_SA(1, 0), a3, voffA);
            PG8_WAIT_V(8); PG8_WAIT_L(0); PG8_BAR; PG8_MMA(1, 0, At, B0); PG8_MMA(1, 1, At, B1); PG8_BAR; PG8_SCHED;
        }
        if (wr == 0) PG8_BAR;
        E(acc, cur, wr, wc, fr, fq); S.done(cur);
        if (!has_next) break;
{ float zf = 0.f; asm volatile("" : "+v"(zf));
        #pragma unroll
        for (int a = 0; a < 2; ++a)
#pragma unroll
            for (int b = 0; b < 2; ++b)
#pragma unroll
                for (int m = 0; m < 4; ++m)
#pragma unroll
                    for (int n = 0; n < 2; ++n) acc[a][b][m][n] = (f32x4){zf, zf, zf, zf}; }
        cur = nxt; cA = nA; cB = nB; ++ui;
        if (wr == 1) PG8_BAR;
    }
    PG8_WAIT_V(0);
    PG8_BAR;
#undef PG8_SA
#undef PG8_SB
#undef PG8_STAGE
#undef PG8_LDA
#undef PG8_LDB
#undef PG8_MMA
#undef PG8_WAIT_V
#undef PG8_WAIT_L
#undef PG8_BAR
#undef PG8_SCHED
}
}
namespace at {
using bf16 = unsigned short;
using bf16x8 = __attribute__((ext_vector_type(8))) short;
using s16x4  = __attribute__((ext_vector_type(4))) short;
using f32x16 = __attribute__((ext_vector_type(16))) float;
using u32x4  = __attribute__((ext_vector_type(4))) unsigned;
constexpr int DQK = 192, DV = 128, KVBLK = 64, NW = 8, QBLK = 32;
constexpr float SCALE = 0.07216878364870322f;
constexpr float THR = 8.f;
constexpr int LDQ = 1536, LDK = 2560, LDO = 2048;
constexpr int SHM_V = KVBLK * DV * 2, SHM_K = 12 * 2080;
constexpr int QR_OFF = 2 * SHM_V + 2 * SHM_K + NW * 64 * 4;
constexpr int SHM_ATTN = QR_OFF + NW * 4096;
#define SBAR() __builtin_amdgcn_sched_barrier(0)
constexpr int KPL = 2080;
__host__ __device__ __forceinline__ int k_st(int row, int c) { return (c >> 1) * KPL + row * 32 + (((c & 1) ^ ((row >> 3) & 1)) << 4); }
__host__ __device__ __forceinline__ int k_rd_base(int r32, int hi) { return r32 * 32 + ((hi ^ ((r32 >> 3) & 1)) << 4); }
__device__ __forceinline__ int crow(int r, int hi) { return (r & 3) + 8 * (r >> 2) + 4 * hi; }
__device__ __forceinline__ unsigned cvtpk(float lo, float hi) { unsigned r; asm volatile("v_cvt_pk_bf16_f32 %0, %1, %2" : "=v"(r) : "v"(lo), "v"(hi)); return r; }

__device__ __forceinline__ void partialSM(f32x16& p0, f32x16& p1, float& m_reg, float& mn, float& alpha) {
  constexpr float C = SCALE * 1.4426950408889634f;
  float pmax = p0[0];
#pragma unroll
  for (int r = 1; r < 16; ++r) pmax = fmaxf(pmax, p0[r]);
#pragma unroll
  for (int r = 0; r < 16; ++r) pmax = fmaxf(pmax, p1[r]);
  { auto rr = __builtin_amdgcn_permlane32_swap(__float_as_uint(pmax), __float_as_uint(pmax), false, false);
    pmax = fmaxf(__uint_as_float(rr[0]), __uint_as_float(rr[1])); }
  if (__builtin_expect(__all(pmax - m_reg <= THR / SCALE), 1)) { mn = m_reg; alpha = 1.f; }
  else { mn = fmaxf(m_reg, pmax); alpha = __builtin_amdgcn_exp2f((m_reg - mn) * C); m_reg = mn; }
  float mnC = -mn * C;
#pragma unroll
  for (int r = 0; r < 16; ++r) p0[r] = fmaf(p0[r], C, mnC);
#pragma unroll
  for (int r = 0; r < 16; ++r) p1[r] = fmaf(p1[r], C, mnC);
#pragma unroll
  for (int r = 0; r < 16; ++r) p0[r] = __builtin_amdgcn_exp2f(p0[r]);
}
__device__ __forceinline__ void finishSM(f32x16& p0, f32x16& p1, float alpha, float& l_reg, bf16x8& pa0, bf16x8& pa1, bf16x8& pa2, bf16x8& pa3) {
#pragma unroll
  for (int r = 0; r < 16; ++r) p1[r] = __builtin_amdgcn_exp2f(p1[r]);
  float ps = 0;
#pragma unroll
  for (int r = 0; r < 16; ++r) ps += p0[r];
#pragma unroll
  for (int r = 0; r < 16; ++r) ps += p1[r];
  { auto rr = __builtin_amdgcn_permlane32_swap(__float_as_uint(ps), __float_as_uint(ps), false, false);
    ps = __uint_as_float(rr[0]) + __uint_as_float(rr[1]); }
  l_reg = l_reg * alpha + ps;
#define PK4(P, BASE, OUT) do { unsigned a0 = cvtpk(P[BASE + 0], P[BASE + 1]), a1 = cvtpk(P[BASE + 2], P[BASE + 3]);   \
    unsigned b0 = cvtpk(P[BASE + 4], P[BASE + 5]), b1 = cvtpk(P[BASE + 6], P[BASE + 7]);                              \
    auto r0 = __builtin_amdgcn_permlane32_swap(a0, b0, false, false); auto r1 = __builtin_amdgcn_permlane32_swap(a1, b1, false, false); \
    u32x4 w = {r0[0], r1[0], r0[1], r1[1]}; OUT = *reinterpret_cast<bf16x8*>(&w); } while (0)
  PK4(p0, 0, pa0); PK4(p0, 8, pa1); PK4(p1, 0, pa2); PK4(p1, 8, pa3);
#undef PK4
}
template <int OFF> __device__ __forceinline__ bf16x8 k_read(int kb) {
  bf16x8 r; asm volatile("ds_read_b128 %0, %1 offset:%2" : "=v"(r) : "v"(kb), "i"(OFF) : "memory"); return r;
}
__device__ __forceinline__ void qkt(f32x16& p0, f32x16& p1, int kb, const bf16x8* qr, int qb) {
  p0 = f32x16{}; p1 = f32x16{};
#define QK1(d0) { const bf16x8 b0 = *(const __attribute__((address_space(3))) bf16x8*)(kb + d0 * KPL), b1 = *(const __attribute__((address_space(3))) bf16x8*)(kb + d0 * KPL + 1024); \
    p0 = __builtin_amdgcn_mfma_f32_32x32x16_bf16(b0, qr[d0], p0, 0, 0, 0); p1 = __builtin_amdgcn_mfma_f32_32x32x16_bf16(b1, qr[d0], p1, 0, 0, 0); }
#define QK2(d0) { const bf16x8 b0 = *(const __attribute__((address_space(3))) bf16x8*)(kb + d0 * KPL), b1 = *(const __attribute__((address_space(3))) bf16x8*)(kb + d0 * KPL + 1024); \
    const bf16x8 qf = *(const __attribute__((address_space(3))) bf16x8*)(qb + (d0 - 8) * 1024); \
    p0 = __builtin_amdgcn_mfma_f32_32x32x16_bf16(b0, qf, p0, 0, 0, 0); p1 = __builtin_amdgcn_mfma_f32_32x32x16_bf16(b1, qf, p1, 0, 0, 0); }
  QK1(0) QK1(1) QK1(2) QK1(3) QK1(4) QK1(5) QK1(6) QK1(7) QK2(8) QK2(9) QK2(10) QK2(11)
#undef QK1
#undef QK2
}
__host__ __device__ __forceinline__ int v_st(int k, int c) { const int kk = (k & ~0xC) | ((k & 4) << 1) | ((k & 8) >> 1); return ((kk >> 3) * 4 + (c >> 5)) * 512 + ((kk & 7) * 32 + (c & 31)) * 2; }
__device__ __forceinline__ int v_rd_base(int lane) { return ((lane & 3) << 3) | (((lane >> 2) & 3) << 6) | (((lane >> 4) & 1) << 5) | (((lane >> 5) & 1) << 8); }
constexpr int v_rd_off(int d0, int ks, int half) { return d0 * 512 + ks * 4096 + half * 2048; }
template <int OFF> __device__ __forceinline__ s16x4 tr_read(int vb) {
  s16x4 r; asm volatile("ds_read_b64_tr_b16 %0, %1 offset:%2" : "=&v"(r) : "v"(vb), "i"(OFF) : "memory"); return r;
}
template <int D0> __device__ __forceinline__ void pv_one(f32x16& od, int vb, bf16x8 pa0, bf16x8 pa1, bf16x8 pa2, bf16x8 pa3) {
  const s16x4 l0 = tr_read<v_rd_off(D0, 0, 0)>(vb), h0 = tr_read<v_rd_off(D0, 0, 1)>(vb), l1 = tr_read<v_rd_off(D0, 1, 0)>(vb), h1 = tr_read<v_rd_off(D0, 1, 1)>(vb);
  const s16x4 l2 = tr_read<v_rd_off(D0, 2, 0)>(vb), h2 = tr_read<v_rd_off(D0, 2, 1)>(vb), l3 = tr_read<v_rd_off(D0, 3, 0)>(vb), h3 = tr_read<v_rd_off(D0, 3, 1)>(vb);
  asm volatile("s_waitcnt lgkmcnt(0)" ::: "memory"); SBAR();
#define PK(L, H) (bf16x8){L[0], L[1], L[2], L[3], H[0], H[1], H[2], H[3]}
  od = __builtin_amdgcn_mfma_f32_32x32x16_bf16(pa0, PK(l0, h0), od, 0, 0, 0);
  od = __builtin_amdgcn_mfma_f32_32x32x16_bf16(pa1, PK(l1, h1), od, 0, 0, 0);
  od = __builtin_amdgcn_mfma_f32_32x32x16_bf16(pa2, PK(l2, h2), od, 0, 0, 0);
  od = __builtin_amdgcn_mfma_f32_32x32x16_bf16(pa3, PK(l3, h3), od, 0, 0, 0);
#undef PK
}
__device__ __forceinline__ void pv_d0(f32x16* o, int vb, bf16x8 pa0, bf16x8 pa1, bf16x8 pa2, bf16x8 pa3) {
  pv_one<0>(o[0], vb, pa0, pa1, pa2, pa3); pv_one<1>(o[1], vb, pa0, pa1, pa2, pa3); pv_one<2>(o[2], vb, pa0, pa1, pa2, pa3); pv_one<3>(o[3], vb, pa0, pa1, pa2, pa3);
}

__device__ __forceinline__ void attn_unit(const bf16* __restrict__ Qb, const bf16* __restrict__ Kh, const bf16* __restrict__ Vh, bf16* __restrict__ Ob, int seq, char* lds) {
  const int tid = opq(threadIdx.x), wid = tid >> 6, lane = tid & 63, r32 = lane & 31, hi = lane >> 5;
  char* V_lds = lds; char* K_lds = lds + 2 * SHM_V;
  float* ws = (float*)(lds + 2 * SHM_V + 2 * SHM_K) + wid * 64; float* li_l = ws; float* al_l = ws + 32;
  float m_reg = -1e30f, l_reg = 0; f32x16 o[4] = {}; bf16x8 qr[8];
  const bf16* Qw = Qb + (unsigned)((wid * QBLK + r32) * LDQ + hi * 8);
#pragma unroll
  for (int d0 = 0; d0 < 8; ++d0) qr[d0] = *reinterpret_cast<const bf16x8*>(Qw + d0 * 16);
  const int qb0 = (int)(uintptr_t)lds + QR_OFF + wid * 4096 + k_rd_base(r32, hi);
#pragma unroll
  for (int d0 = 8; d0 < 12; ++d0) *(__attribute__((address_space(3))) bf16x8*)(qb0 + (d0 - 8) * 1024) = *reinterpret_cast<const bf16x8*>(Qw + d0 * 16);
  const int sr = tid >> 4, sc = (tid & 15) * 8, vst0 = v_st(sr, sc), vst1 = v_st(32 + sr, sc);
  unsigned koff[3]; int kst[3];
#pragma unroll
  for (int i = 0; i < 3; ++i) { const int q = tid + 512 * i; koff[i] = (unsigned)((q / 24) * LDK + (q % 24) * 8); kst[i] = k_st(q / 24, q % 24); }
  const unsigned voff0 = (unsigned)(sr * LDK + sc), voff1 = (unsigned)((32 + sr) * LDK + sc);
  const int vb0 = (int)(uintptr_t)V_lds + v_rd_base(lane); const int kb0 = (int)(uintptr_t)K_lds + k_rd_base(r32, hi);
  struct { bf16x8 vs0, vs1, ks0, ks1, ks2; } sr_[1];
#define SLOAD(i, k0) do { const bf16* vt = Vh + (size_t)(k0) * LDK; const bf16* kt = Kh + (size_t)(k0) * LDK; \
    sr_[i].vs0 = *(const bf16x8*)(vt + voff0); sr_[i].vs1 = *(const bf16x8*)(vt + voff1); \
    sr_[i].ks0 = *(const bf16x8*)(kt + koff[0]); sr_[i].ks1 = *(const bf16x8*)(kt + koff[1]); sr_[i].ks2 = *(const bf16x8*)(kt + koff[2]); } while (0)
#define SWRITE(b, i) do { *(bf16x8*)(V_lds + (b) * SHM_V + vst0) = sr_[i].vs0; *(bf16x8*)(V_lds + (b) * SHM_V + vst1) = sr_[i].vs1; \
    *(bf16x8*)(K_lds + (b) * SHM_K + kst[0]) = sr_[i].ks0; *(bf16x8*)(K_lds + (b) * SHM_K + kst[1]) = sr_[i].ks1; *(bf16x8*)(K_lds + (b) * SHM_K + kst[2]) = sr_[i].ks2; } while (0)
#define SWAIT() do { if constexpr (SDEPTH == 2) asm volatile("s_waitcnt vmcnt(5)" ::: "memory"); else asm volatile("s_waitcnt vmcnt(0)" ::: "memory"); } while (0)
#define RESC(a) do { if (__any((a) < 1.f)) { if (hi == 0) al_l[r32] = (a); asm volatile("s_waitcnt lgkmcnt(0)" ::: "memory"); \
    _Pragma("unroll") for (int d = 0; d < 4; ++d) _Pragma("unroll") for (int r = 0; r < 16; ++r) o[d][r] *= al_l[crow(r, hi)]; } } while (0)
  f32x16 pA0, pA1, pB0, pB1; float mnA, mnB, alA, alB; bf16x8 pa0, pa1, pa2, pa3; const int NT = seq / KVBLK;
  SLOAD(0, 0); asm volatile("s_waitcnt vmcnt(0)" ::: "memory"); SWRITE(0, 0); __syncthreads();
  qkt(pA0, pA1, kb0, qr, qb0); partialSM(pA0, pA1, m_reg, mnA, alA);
  SLOAD(0, KVBLK);
  asm volatile("s_waitcnt vmcnt(0)" ::: "memory"); SWRITE(1, 0); __syncthreads();
  for (int j = 1; j + 1 < NT; j += 2) {
    SBAR(); qkt(pB0, pB1, kb0 + SHM_K, qr, qb0);
    finishSM(pA0, pA1, alA, l_reg, pa0, pa1, pa2, pa3); SBAR();
    SLOAD(0, (j + 1) * KVBLK); SBAR();
    pv_d0(o, vb0, pa0, pa1, pa2, pa3); partialSM(pB0, pB1, m_reg, mnB, alB);
    __syncthreads(); asm volatile("s_waitcnt vmcnt(0)" ::: "memory"); SWRITE(0, 0);
    RESC(alB); __syncthreads();
    SBAR(); qkt(pA0, pA1, kb0, qr, qb0);
    finishSM(pB0, pB1, alB, l_reg, pa0, pa1, pa2, pa3); SBAR();
    SLOAD(0, (j + 2) * KVBLK); SBAR();
    pv_d0(o, vb0 + (int)SHM_V, pa0, pa1, pa2, pa3); partialSM(pA0, pA1, m_reg, mnA, alA);
    __syncthreads(); asm volatile("s_waitcnt vmcnt(0)" ::: "memory"); SWRITE(1, 0);
    RESC(alA); __syncthreads();
  }
  SBAR(); qkt(pB0, pB1, kb0 + SHM_K, qr, qb0);
  finishSM(pA0, pA1, alA, l_reg, pa0, pa1, pa2, pa3); SBAR();
  pv_d0(o, vb0, pa0, pa1, pa2, pa3); partialSM(pB0, pB1, m_reg, mnB, alB);
  __syncthreads(); RESC(alB);
  finishSM(pB0, pB1, alB, l_reg, pa0, pa1, pa2, pa3); SBAR();
  pv_d0(o, vb0 + (int)SHM_V, pa0, pa1, pa2, pa3);
  if (hi == 0) li_l[r32] = l_reg; asm volatile("s_waitcnt lgkmcnt(0)" ::: "memory");
  bf16* Ow = Ob + (unsigned)(wid * QBLK * LDO + r32);
#pragma unroll
  for (int r = 0; r < 16; ++r) { const int orow = crow(r, hi); const float rl = __builtin_amdgcn_rcpf(li_l[orow]);
#pragma unroll
    for (int d0 = 0; d0 < 4; ++d0) { const unsigned w = cvtpk(o[d0][r] * rl, 0.f); Ow[(unsigned)(orow * LDO + d0 * 32)] = (bf16)(w & 0xffffu); } }
  __syncthreads();
#undef SLOAD
#undef SWRITE
#undef SWAIT
#undef RESC
}
}
namespace hy {
#define HY_LAS __attribute__((address_space(3)))
typedef unsigned short bf16;
typedef short bf16x8 __attribute__((ext_vector_type(8)));
typedef float f32x16 __attribute__((ext_vector_type(16)));
typedef unsigned u32x2 __attribute__((ext_vector_type(2)));
typedef unsigned u32x4 __attribute__((ext_vector_type(4)));
constexpr int L = 2048, NB = 24, CH = 512;
constexpr int RFS = 4112;
constexpr int ZROW = 4112;
constexpr int ZL_BYTES = NB * ZROW;
constexpr int RCS = 8256;
constexpr int RC_OFF = ZL_BYTES;
constexpr int HY_LDS_BYTES = RC_OFF + 4 * RCS;
__device__ __forceinline__ unsigned cvtpk(float lo, float hi) { unsigned r; asm volatile("v_cvt_pk_bf16_f32 %0, %1, %2" : "=v"(r) : "v"(lo), "v"(hi)); return r; }
__host__ __device__ __forceinline__ int frag_base(int tw, int r, int h) { const int a = (4 - (r & 3)) & 3; return RC_OFF + a * RCS + 2 * (2048 - tw - r + 8 * h - a); }
__host__ __device__ __forceinline__ int zfrag_base(int r, int h) { return (r < NB ? r : NB - 1) * ZROW + 16 * h; }

__device__ __forceinline__ bf16x8 ld_frag(HY_LAS unsigned char* lds, int off) {
    const u32x2 lo = *(const HY_LAS u32x2*)(lds + off), hi = *(const HY_LAS u32x2*)(lds + off + 8);
    u32x4 w = {lo.x, lo.y, hi.x, hi.y}; return *reinterpret_cast<bf16x8*>(&w);
}
__device__ __forceinline__ bf16x8 ld_b128(HY_LAS unsigned char* lds, int off) { return *(const HY_LAS bf16x8*)(lds + off); }

__device__ __forceinline__ void conv_unit(HY_LAS unsigned char* lds, const bf16* __restrict__ ZT, const bf16* __restrict__ RF, bf16* __restrict__ YC, int c, int half) {
    const int tid = opq(threadIdx.x), wid = tid >> 6, lane = tid & 63, r = lane & 31, h = lane >> 5;
    { const u32x4* src = (const u32x4*)(ZT + (size_t)c * NB * L);
#pragma unroll
      for (int i = 0; i < 12; ++i) { const int q = tid + 512 * i; const u32x4 v = src[q]; *(HY_LAS u32x4*)(lds + (q >> 8) * ZROW + (q & 255) * 16) = v; } }
    { const bf16* rf = RF + (size_t)c * RFS;
      for (int ch = tid; ch < RFS / 8; ch += 512) {
          const u32x4 v = *(const u32x4*)(rf + ch * 8); const unsigned w[4] = {v.x, v.y, v.z, v.w};
#pragma unroll
          for (int j = 0; j < 8; ++j) { const unsigned short e = (unsigned short)((w[j >> 1] >> ((j & 1) * 16)) & 0xffffu); const int idx = ch * 8 + j;
#pragma unroll
              for (int a = 0; a < 4; ++a) if (idx - a >= 0) *(HY_LAS unsigned short*)(lds + RC_OFF + a * RCS + 2 * (idx - a)) = e; } } }
    __syncthreads();
    const int tw = half * 1024 + wid * 128;
    const int fb = frag_base(tw, r, h), zb = zfrag_base(r, h);
    f32x16 acc[4] = {};
    bf16x8 S0[2], S1[2], S2[2], S3[2], Bc[2], Bn[2];
#define HY_LDG(S, d) do { S[0] = ld_frag(lds, fb + 64 * (d)); S[1] = ld_frag(lds, fb + 64 * (d) + 32); } while (0)
#define HY_LDB(Bx, n) do { Bx[0] = ld_b128(lds, zb + 64 * (n)); Bx[1] = ld_b128(lds, zb + 64 * (n) + 32); } while (0)
#define HY_MM(i, S, Bx) do { acc[i] = __builtin_amdgcn_mfma_f32_32x32x16_bf16(S[0], Bx[0], acc[i], 0, 0, 0); acc[i] = __builtin_amdgcn_mfma_f32_32x32x16_bf16(S[1], Bx[1], acc[i], 0, 0, 0); } while (0)
#define HY_ITER(n, Sa, Sb, Sc, Sd, Bcur, Bnext) do { HY_LDG(Sa, (n)); if ((n) + 1 < 64) HY_LDB(Bnext, (n) + 1); \
        HY_MM(1, Sb, Bcur); HY_MM(2, Sc, Bcur); HY_MM(3, Sd, Bcur); HY_MM(0, Sa, Bcur); } while (0)
    HY_LDG(S3, -1); HY_LDG(S2, -2); HY_LDG(S1, -3); HY_LDB(Bc, 0);
    for (int n = 0; n < 64; n += 4) {
        HY_ITER(n, S0, S3, S2, S1, Bc, Bn);
        HY_ITER(n + 1, S1, S0, S3, S2, Bn, Bc);
        HY_ITER(n + 2, S2, S1, S0, S3, Bc, Bn);
        HY_ITER(n + 3, S3, S2, S1, S0, Bn, Bc);
    }
#undef HY_LDG
#undef HY_LDB
#undef HY_MM
#undef HY_ITER
    if (r < NB) { bf16* yp = YC + ((size_t)c * NB + r) * L + tw + 4 * h;
#pragma unroll
        for (int i = 0; i < 4; ++i)
#pragma unroll
            for (int q4 = 0; q4 < 4; ++q4) { u32x2 w; w.x = cvtpk(acc[i][4 * q4 + 0], acc[i][4 * q4 + 1]); w.y = cvtpk(acc[i][4 * q4 + 2], acc[i][4 * q4 + 3]);
                *(u32x2*)(yp + 32 * i + 8 * q4) = w; } }
    __syncthreads();
}
}
constexpr int NWAVES = 8;
#ifndef MK_ONE_LAUNCH
#define MK_ONE_LAUNCH 1
#endif
constexpr int DM = 2048, NSEQ = 24, SEQ = 2048, M = NSEQ * SEQ, MP = 8 * SEQ;
constexpr int DEPTH = 4;
constexpr int DIN = 2880, DINP = 3072;
constexpr int O_CQ = 512, O_CKV = 1024, O_KPE = 1280, O_HY = 1344;
constexpr int NH = 8, NQ = 1536, NKVP = 2560, KVHS = 320;
constexpr int DFF = 5632, NUP = 11264, HYC = 512;
constexpr float EPS = 1e-6f;
constexpr int NPH = 11;
constexpr size_t WS_CTL = 0, CTL_BYTES = 1u << 20;
constexpr size_t SZ_BTIN = (size_t)DINP * DM * 2, SZ_BTUQ = (size_t)NQ * 512 * 2, SZ_BTKV = (size_t)NKVP * 256 * 2, SZ_BTOUT = (size_t)DM * DM * 2, SZ_BTUP = (size_t)NUP * DM * 2, SZ_BTDN = (size_t)DM * DFF * 2;
constexpr size_t WS_BTIN = WS_CTL + CTL_BYTES, WS_BTUQ = WS_BTIN + SZ_BTIN, WS_BTKV = WS_BTUQ + SZ_BTUQ, WS_BTOUT = WS_BTKV + SZ_BTKV, WS_BTUP = WS_BTOUT + SZ_BTOUT, WS_BTDN = WS_BTUP + SZ_BTUP;
constexpr size_t WS_RF = WS_BTDN + SZ_BTDN, SZ_RF = (size_t)HYC * hy::RFS * 2;
constexpr size_t WS_H = WS_RF + SZ_RF, SZ_H = (size_t)M * DM * 2;
constexpr size_t WS_PROJ = WS_H + SZ_H, SZ_PROJ = (size_t)M * DINP * 2;
constexpr size_t WS_Q = WS_PROJ + SZ_PROJ, SZ_Q = (size_t)M * NQ * 2;
constexpr size_t WS_KV = WS_Q + SZ_Q, SZ_KV = (size_t)M * NKVP * 2;
constexpr size_t WS_ZT = WS_KV + SZ_KV, SZ_ZT = (size_t)HYC * NSEQ * SEQ * 2;
constexpr size_t WS_X0 = WS_ZT + SZ_ZT, WS_YC = WS_X0 + SZ_ZT;
constexpr size_t WS_EDGE = WS_YC + SZ_ZT, SZ_EDGE = (size_t)(M / 256) * 2 * 3 * DFF * 4;
constexpr size_t WS_ROPE = WS_EDGE + SZ_EDGE, SZ_ROPE = (size_t)SEQ * 64 * 4;
constexpr size_t WS_SSQP = WS_ROPE + SZ_ROPE, SZ_SSQP = (size_t)M * 32 * 4;
constexpr size_t WS_RSTD = WS_SSQP + SZ_SSQP, SZ_RSTD = (size_t)M * 4;
constexpr size_t WS_END = WS_RSTD + SZ_RSTD;
constexpr size_t WS_ACT = WS_PROJ;
static_assert((size_t)M * DFF * 2 <= SZ_PROJ + SZ_Q + SZ_KV, "ACT overlay");
constexpr size_t WS_XB2 = WS_ACT + (size_t)M * DFF * 2;
static_assert(WS_XB2 + (size_t)M * DM * 2 <= WS_EDGE && WS_XB2 % 256 == 0, "XB2 overlay");
static_assert(WS_BTIN % 256 == 0 && WS_RF % 256 == 0 && WS_H % 256 == 0 && WS_PROJ % 256 == 0 && WS_Q % 256 == 0 && WS_KV % 256 == 0 && WS_ZT % 256 == 0 && WS_EDGE % 256 == 0, "alignment");
constexpr int CW_BAR = 4096;
constexpr int RING_BYTES = 135168;
constexpr int HALO_OFF = RING_BYTES, HALO_BYTES = 4096;
constexpr int MISC_OFF = HALO_OFF + HALO_BYTES;
constexpr int LDS_BYTES = 147456;
static_assert(hy::HY_LDS_BYTES <= RING_BYTES && at::SHM_ATTN <= RING_BYTES && MISC_OFF + 256 <= LDS_BYTES, "LDS map");

#define GAS __attribute__((address_space(1)))
#define LAS __attribute__((address_space(3)))
typedef unsigned short bf16;
typedef unsigned v4u __attribute__((ext_vector_type(4)));
typedef unsigned v2u __attribute__((ext_vector_type(2)));
typedef float f32x4 __attribute__((ext_vector_type(4)));
#define LDS_WAIT() asm volatile("s_waitcnt lgkmcnt(0)" ::: "memory")
__device__ __forceinline__ unsigned f2bf(float f) { unsigned u = __builtin_bit_cast(unsigned, f); return (u + 0x7fffu + ((u >> 16) & 1u)) >> 16; }
__device__ __forceinline__ unsigned pk2(float lo, float hi) { return f2bf(lo) | (f2bf(hi) << 16); }
__device__ __forceinline__ float bf2f(unsigned short b) { return __builtin_bit_cast(float, (unsigned)b << 16); }
__device__ __forceinline__ float bflo(unsigned w) { return __builtin_bit_cast(float, w << 16); }
__device__ __forceinline__ float bfhi(unsigned w) { return __builtin_bit_cast(float, w & 0xffff0000u); }
__device__ __forceinline__ float wave_sum(float v) {
#pragma unroll
    for (int o = 1; o < 64; o <<= 1) v += __shfl_xor(v, o);
    return v;
}

#define XB_TMO      128
#define XB_XCNT(j)  (256  + 64 * (j))
#define XB_XSUB(j)  (1280 + 64 * (j))
#define XB_XGEN(j)  (2304 + 64 * (j))
#define XB_TOP      3328
#define XB_TOPGEN   3392
#define XCD_BAR_WORDS 3456
#define XB_SPIN_CAP (1u << 18)
__device__ __forceinline__ unsigned xb_ld(unsigned* p)              { return __hip_atomic_load(p, __ATOMIC_RELAXED, __HIP_MEMORY_SCOPE_AGENT); }
__device__ __forceinline__ unsigned xb_add(unsigned* p, unsigned v) { return __hip_atomic_fetch_add(p, v, __ATOMIC_RELAXED, __HIP_MEMORY_SCOPE_AGENT); }
__device__ __forceinline__ unsigned xb_xcc_id() { return (unsigned)__builtin_amdgcn_s_getreg((3 << 11) | 20) & 0xFu; }
#define XB_SPIN(cond, bar) do { unsigned _sp = 0; while (cond) { __builtin_amdgcn_s_sleep(1); \
    if ((++_sp & 255u) == 0u) { if (xb_ld(&(bar)[XB_TMO])) break; if (_sp > XB_SPIN_CAP) { atomicAdd(&(bar)[XB_TMO], 1u); break; } } } } while (0)
struct XcdBarrier { unsigned* bar; unsigned x; volatile LAS unsigned* st; };
__device__ __forceinline__ XcdBarrier xcd_barrier_post(unsigned* bar, volatile LAS unsigned* st) {
    XcdBarrier b; b.bar = bar; b.x = xb_xcc_id(); b.st = st;
    if (threadIdx.x == 0) (void)xb_add(&bar[XB_XCNT(b.x)], 1u);
    return b;
}
__device__ __forceinline__ void xcd_barrier_complete(unsigned* bar, unsigned x, unsigned& nloc, unsigned& nx) {
    const unsigned G = gridDim.x * gridDim.y * gridDim.z;
    unsigned sum, cnt, mine, sp = 0u;
    for (;;) {
        sum = 0u; cnt = 0u; mine = 0u;
#pragma unroll
        for (unsigned j = 0; j < 16; ++j) { const unsigned c = xb_ld(&bar[XB_XCNT(j)]); sum += c; cnt += (c > 0u) ? 1u : 0u; mine = (j == x) ? c : mine; }
        if (sum == G) break;
        __builtin_amdgcn_s_sleep(1);
        if ((++sp & 255u) == 0u) { if (xb_ld(&bar[XB_TMO])) break; if (sp > XB_SPIN_CAP) { atomicAdd(&bar[XB_TMO], 1u); break; } }
    }
    nloc = mine > 0u ? mine : 1u; nx = cnt > 0u ? cnt : 1u;
}
__device__ __forceinline__ void xcd_barrier(const XcdBarrier& b) {
    asm volatile("s_waitcnt vmcnt(0)" ::: "memory");
    __syncthreads();
    if (threadIdx.x == 0) {
        unsigned* bar = b.bar;
        __builtin_amdgcn_s_waitcnt(0);
        unsigned nloc = b.st[0], nx = b.st[1];
        if (nloc == 0u) { xcd_barrier_complete(bar, b.x, nloc, nx); b.st[0] = nloc; b.st[1] = nx; }
        const unsigned old = xb_add(&bar[XB_XSUB(b.x)], 1u);
        const unsigned gen = old / nloc;
        if (old + 1u == (gen + 1u) * nloc) {
            __builtin_amdgcn_fence(__ATOMIC_RELEASE, "agent");
            asm volatile("s_waitcnt vmcnt(0)" ::: "memory");
            const unsigned og = xb_add(&bar[XB_TOP], 1u);
            const unsigned tg = og / nx;
            if (og + 1u == (tg + 1u) * nx) xb_add(&bar[XB_TOPGEN], 1u);
            else XB_SPIN(xb_ld(&bar[XB_TOPGEN]) == tg, bar);
            __builtin_amdgcn_fence(__ATOMIC_ACQUIRE, "agent");
            xb_add(&bar[XB_XGEN(b.x)], 1u);
            asm volatile("s_waitcnt vmcnt(0)" ::: "memory");
        } else {
            XB_SPIN(xb_ld(&bar[XB_XGEN(b.x)]) == gen, bar);
            __builtin_amdgcn_fence(__ATOMIC_ACQUIRE, "agent");
            asm volatile("s_waitcnt vmcnt(0)" ::: "memory");
        }
    }
    __syncthreads();
}

struct Frame {
    LAS unsigned char* lds;
    int tid, lane, wave, vcu, G;
};
enum { I_XP = 0, I_XS, I_ANG, I_WIN, I_PW, I_PS, I_QNG, I_WUQ, I_KVNG, I_WUKV, I_QHG, I_KHG, I_HCW, I_HCB, I_FW1, I_FB1, I_FFR, I_FW2, I_FB2, I_FW3, I_FB3, I_HBIAS, I_GNG, I_WOUT, I_FNG, I_WUP, I_FCW, I_FCB, I_WDN, N_IN };
struct Args { const float* in[N_IN]; float* out; unsigned char* ws; int ph_lo, ph_hi; };
static_assert(sizeof(Args) == (N_IN + 2) * 8 + 8, "Args has no padding");

__device__ __forceinline__ void cvt_item(const float* __restrict__ W, int ldw, int K, bf16* WT, int dst_n0, int src_n0, int k0, const float* __restrict__ ks, LAS float* scr, int lane) {
#pragma unroll
    for (int i = 0; i < 32; ++i) { const int kk = 2 * i + (lane >> 5); float v = W[(size_t)(k0 + kk) * ldw + src_n0 + (lane & 31)]; if (ks) v *= ks[k0 + kk]; scr[kk * 33 + (lane & 31)] = v; }
    LDS_WAIT(); asm volatile("" ::: "memory");
    const int c = lane & 7;
#pragma unroll
    for (int j = 0; j < 4; ++j) { const int n = (lane >> 3) + 8 * j; const LAS float* s = scr + (8 * c) * 33 + n;
        v4u o; o.x = pk2(s[0 * 33], s[1 * 33]); o.y = pk2(s[2 * 33], s[3 * 33]); o.z = pk2(s[4 * 33], s[5 * 33]); o.w = pk2(s[6 * 33], s[7 * 33]);
        *(v4u*)(WT + (size_t)(dst_n0 + n) * K + k0 + 8 * c) = o; }
    LDS_WAIT(); asm volatile("" ::: "memory");
}
__device__ __forceinline__ void xb_row(const float* xrow, bf16* orow, float* rstd, int lane) {
    const f32x4* xr = (const f32x4*)xrow + lane;
    f32x4 v[8]; float s = 0.f;
#pragma unroll
    for (int j = 0; j < 8; ++j) { v[j] = xr[64 * j]; s += (v[j].x * v[j].x + v[j].y * v[j].y) + (v[j].z * v[j].z + v[j].w * v[j].w); }
    const float r = 1.0f / sqrtf(wave_sum(s) * (1.f / DM) + EPS);
    if (lane == 0) *rstd = r;
    v2u* o8 = (v2u*)orow + lane;
#pragma unroll
    for (int j = 0; j < 8; ++j) { v2u w; w.x = pk2(v[j].x, v[j].y); w.y = pk2(v[j].z, v[j].w); o8[64 * j] = w; }
}
__device__ __forceinline__ void rstd_from_partials(const float* __restrict__ ssqp, float* rstd, size_t gtid, size_t gthreads) {
    for (size_t r = gtid; r < (size_t)M; r += gthreads) { const f32x4* p = (const f32x4*)(ssqp + r * 32); f32x4 a = p[0];
#pragma unroll
        for (int i = 1; i < 8; ++i) a += p[i];
        rstd[r] = 1.0f / sqrtf(((a.x + a.y) + (a.z + a.w)) * (1.f / DM) + EPS); }
}
__device__ __forceinline__ void tile_norm_store(LAS float* tile, bf16* dst, int row0, int col_off, int wave, int lane) {
#pragma unroll
    for (int i = 0; i < 8; ++i) { const int t = wave * 8 + i;
        const f32x4 a = *(LAS f32x4*)(tile + t * 512 + 8 * lane), b = *(LAS f32x4*)(tile + t * 512 + 8 * lane + 4);
        const float s = (a.x * a.x + a.y * a.y) + (a.z * a.z + a.w * a.w) + (b.x * b.x + b.y * b.y) + (b.z * b.z + b.w * b.w);
        const float rstd = 1.0f / sqrtf(wave_sum(s) * (1.f / 512.f) + EPS);
        v4u o; o.x = pk2(a.x * rstd, a.y * rstd); o.y = pk2(a.z * rstd, a.w * rstd); o.z = pk2(b.x * rstd, b.y * rstd); o.w = pk2(b.z * rstd, b.w * rstd);
        *(v4u*)(dst + (size_t)(row0 + t) * DM + col_off + 8 * lane) = o; }
}
__device__ __forceinline__ void poolfold_item(Frame& F, const float* __restrict__ win, const float* __restrict__ pw, const float* __restrict__ ps, const float* __restrict__ g1, bf16* BtIn, int g, int kb) {
    LAS float* At = (LAS float*)F.lds; LAS float* Bt = (LAS float*)(F.lds + 32768);
    const int k0 = 64 * kb;
#pragma unroll
    for (int i = 0; i < 4; ++i) { const int q = F.tid + 512 * i, row = q >> 5, c4 = q & 31; *(LAS f32x4*)(At + row * 128 + 4 * c4) = *(const f32x4*)(win + (size_t)(k0 + row) * DIN + 128 * g + 4 * c4) * g1[k0 + row]; }
#pragma unroll
    for (int i = 0; i < 8; ++i) { const int q = F.tid + 512 * i, row = q >> 5, c4 = q & 31; *(LAS f32x4*)(Bt + row * 128 + 4 * c4) = *(const f32x4*)(pw + (size_t)(g * 128 + row) * 128 + 4 * c4); }
    __syncthreads();
    const int n = F.tid & 127, kg = F.tid >> 7;
    float acc[16];
#pragma unroll
    for (int i = 0; i < 16; ++i) acc[i] = 0.f;
    for (int j = 0; j < 128; j += 4) {
        const float b0 = Bt[(j + 0) * 128 + n], b1 = Bt[(j + 1) * 128 + n], b2 = Bt[(j + 2) * 128 + n], b3 = Bt[(j + 3) * 128 + n];
#pragma unroll
        for (int i = 0; i < 16; ++i) { const f32x4 a = *(LAS f32x4*)(At + (kg * 16 + i) * 128 + j); acc[i] += a.x * b0 + a.y * b1 + a.z * b2 + a.w * b3; }
    }
    const float sc = ps[128 * g + n];
    v4u o0, o1;
    o0.x = pk2(acc[0] * sc, acc[1] * sc); o0.y = pk2(acc[2] * sc, acc[3] * sc); o0.z = pk2(acc[4] * sc, acc[5] * sc); o0.w = pk2(acc[6] * sc, acc[7] * sc);
    o1.x = pk2(acc[8] * sc, acc[9] * sc); o1.y = pk2(acc[10] * sc, acc[11] * sc); o1.z = pk2(acc[12] * sc, acc[13] * sc); o1.w = pk2(acc[14] * sc, acc[15] * sc);
    bf16* dst = BtIn + (size_t)(128 * g + n) * DM + k0 + kg * 16;
    *(v4u*)dst = o0; *(v4u*)(dst + 8) = o1;
    __syncthreads();
}
__device__ __forceinline__ void filter_item(Frame& F, const float* __restrict__ w1, const float* __restrict__ b1, const float* __restrict__ fr, const float* __restrict__ w2, const float* __restrict__ b2,
                                            const float* __restrict__ w3, const float* __restrict__ b3, const float* __restrict__ hbias, bf16* RF, int fi) {
    LAS float* ZF = (LAS float*)F.lds; LAS float* H1 = ZF + 512; LAS float* H2 = ZF + 1536;
    const int t0 = 16 * fi;
    if (F.tid < 272) { const int tt = F.tid / 17, f = F.tid % 17; const float t = (float)(t0 + tt);
        float v;
        if (f == 0) v = t / 2047.0f;
        else { const int j = (f - 1) & 7; const float band = 1e-4f + (float)j * ((7.0f - 1e-4f) / 7.0f); const float w = (6.283185307179586f * t) / 2048.0f; const float a = band * w; v = (f <= 8) ? __cosf(a) : -__sinf(a); }
        ZF[tt * 17 + f] = v; }
    __syncthreads();
#pragma unroll
    for (int rep = 0; rep < 2; ++rep) { const int p = F.tid + 512 * rep, tt = p >> 6, j = p & 63; float s = b1[j];
        for (int i = 0; i < 17; ++i) s += ZF[tt * 17 + i] * w1[i * 64 + j];
        H1[tt * 64 + j] = __sinf(fr[j] * s); }
    __syncthreads();
#pragma unroll
    for (int rep = 0; rep < 2; ++rep) { const int p = F.tid + 512 * rep, tt = p >> 6, j = p & 63; float s = b2[j];
        for (int i = 0; i < 64; ++i) s += H1[tt * 64 + i] * w2[i * 64 + j];
        H2[tt * 64 + j] = __sinf(fr[j] * s); }
    __syncthreads();
    const int c = F.tid;
    const float delta = -3.0701134573253944f + (float)c * ((-15.350567286626972f + 3.0701134573253944f) / 511.0f);
    const float ad = fabsf(delta);
    bf16* rf = RF + (size_t)c * hy::RFS;
#pragma unroll 1
    for (int dir = 0; dir < 2; ++dir) { const int o = dir * 512 + c; const float bo = b3[o];
        float s[16];
#pragma unroll
        for (int tt = 0; tt < 16; ++tt) s[tt] = bo;
#pragma unroll 1
        for (int ib = 0; ib < 64; ib += 4) { const float w0 = w3[(ib + 0) * 1024 + o], w1 = w3[(ib + 1) * 1024 + o], w2 = w3[(ib + 2) * 1024 + o], w3v = w3[(ib + 3) * 1024 + o];
#pragma unroll
            for (int tt = 0; tt < 16; ++tt) { const f32x4 hv = *(LAS f32x4*)(H2 + tt * 64 + ib); s[tt] += (hv.x * w0 + hv.y * w1) + (hv.z * w2 + hv.w * w3v); } }
#pragma unroll
        for (int tt = 0; tt < 16; ++tt) { const int t = t0 + tt; const float tl = (float)t / 2047.0f; float val = s[tt] * __expf(-tl * ad);
            if (dir == 0) { if (t == 0) val += hbias[c]; rf[2048 - t] = (bf16)f2bf(val); }
            else if (t >= 1) rf[2048 + t] = (bf16)f2bf(val); } }
    if (fi == 0) { rf[0] = 0;
#pragma unroll
        for (int i = 4096; i < hy::RFS; ++i) rf[i] = 0; }
    __syncthreads();
}
__device__ __forceinline__ void unpack4(const v2u w, float (&x)[4]) { x[0] = bflo(w.x); x[1] = bfhi(w.x); x[2] = bflo(w.y); x[3] = bfhi(w.y); }
__device__ __forceinline__ void pair_norm_store(Frame& F, const float (&y)[8][4], bf16* dst, size_t row0, int col_off, int cq) {
    LAS float* part = (LAS float*)F.lds;
    float ss[8];
#pragma unroll
    for (int k = 0; k < 8; ++k) ss[k] = wave_sum((y[k][0] * y[k][0] + y[k][1] * y[k][1]) + (y[k][2] * y[k][2] + y[k][3] * y[k][3]));
    if (F.lane == 0) { *(LAS f32x4*)(part + F.wave * 8) = (f32x4){ss[0], ss[1], ss[2], ss[3]}; *(LAS f32x4*)(part + F.wave * 8 + 4) = (f32x4){ss[4], ss[5], ss[6], ss[7]}; }
    __syncthreads();
    const f32x4 pa = *(LAS f32x4*)(part + (F.wave ^ 1) * 8), pb = *(LAS f32x4*)(part + (F.wave ^ 1) * 8 + 4);
    const float po[8] = {pa.x, pa.y, pa.z, pa.w, pb.x, pb.y, pb.z, pb.w};
#pragma unroll
    for (int k = 0; k < 8; ++k) { const float rstd = 1.0f / sqrtf((ss[k] + po[k]) * (1.f / 512.f) + EPS);
        v2u o; o.x = pk2(y[k][0] * rstd, y[k][1] * rstd); o.y = pk2(y[k][2] * rstd, y[k][3] * rstd);
        *(v2u*)(dst + (row0 + k) * DM + col_off + 4 * cq) = o; }
    __syncthreads();
}
__device__ __forceinline__ void hyprep_item(Frame& F, const bf16* __restrict__ PROJ, const float* __restrict__ cw, const float* __restrict__ cb, bf16* ZT, bf16* X0, int b, int tile) {
    const int tb = F.tid >> 7, cq = F.tid & 127, c0 = 4 * cq, tw = tile * 32 + tb * 8; const size_t rb = (size_t)b * SEQ;
    float z[8][4];
#pragma unroll
    for (int jj = 0; jj < 3; ++jj) { const int j = (jj == 0) ? 1 : (jj == 1) ? 2 : 0; const int cc = 512 * j + c0;
        const f32x4 w0 = *(const f32x4*)(cw + cc), w1 = *(const f32x4*)(cw + 1536 + cc), w2 = *(const f32x4*)(cw + 3072 + cc), bs = *(const f32x4*)(cb + cc);
        float x[10][4];
#pragma unroll
        for (int o = 0; o < 10; ++o) { const int t = tw - 1 + o; const bool ok = (t >= 0) && (t < SEQ); const int tc = ok ? t : tw;
            const v2u w = *(const v2u*)(PROJ + (rb + tc) * DINP + O_HY + cc); unpack4(w, x[o]);
            if (!ok) { x[o][0] = 0.f; x[o][1] = 0.f; x[o][2] = 0.f; x[o][3] = 0.f; } }
        if (jj == 0) {
#pragma unroll
            for (int k = 0; k < 8; ++k)
#pragma unroll
                for (int i = 0; i < 4; ++i) z[k][i] = w0[i] * x[k][i] + w1[i] * x[k + 1][i] + w2[i] * x[k + 2][i] + bs[i];
        } else if (jj == 1) {
#pragma unroll
            for (int k = 0; k < 8; ++k)
#pragma unroll
                for (int i = 0; i < 4; ++i) z[k][i] *= w0[i] * x[k][i] + w1[i] * x[k + 1][i] + w2[i] * x[k + 2][i] + bs[i];
#pragma unroll
            for (int i = 0; i < 4; ++i) { v4u o; o.x = pk2(z[0][i], z[1][i]); o.y = pk2(z[2][i], z[3][i]); o.z = pk2(z[4][i], z[5][i]); o.w = pk2(z[6][i], z[7][i]);
                *(v4u*)(ZT + ((size_t)(c0 + i) * NSEQ + b) * SEQ + tw) = o; }
        } else {
#pragma unroll
            for (int k = 0; k < 8; ++k) { float u0[4];
#pragma unroll
                for (int i = 0; i < 4; ++i) u0[i] = w0[i] * x[k][i] + w1[i] * x[k + 1][i] + w2[i] * x[k + 2][i] + bs[i];
                v2u o; o.x = pk2(u0[0], u0[1]); o.y = pk2(u0[2], u0[3]); *(v2u*)(X0 + (rb + tw + k) * HYC + c0) = o; }
        }
    }
}
__device__ __forceinline__ void pool_item(Frame& F, const bf16* __restrict__ PROJ, bf16* MIXED, int b, int tile) {
    const int tb = F.tid >> 7, cq = F.tid & 127, c0 = 4 * cq, g = cq >> 5, half = 1 << g, tw = tile * 32 + tb * 8; const size_t rb = (size_t)b * SEQ;
    float x[23][4];
#pragma unroll
    for (int o = 0; o < 23; ++o) { const int t = tw - 8 + o; const bool ok = (t >= 0) && (t < SEQ); const int tc = ok ? t : tw;
        const v2u w = *(const v2u*)(PROJ + (rb + tc) * DINP + c0); unpack4(w, x[o]);
        if (!ok) { x[o][0] = 0.f; x[o][1] = 0.f; x[o][2] = 0.f; x[o][3] = 0.f; } }
    float y[8][4];
#pragma unroll
    for (int k = 0; k < 8; ++k) { const int oc = 8 + k, t = tw + k; const int lo = (t - half > 0) ? t - half : 0, hi = (t + half < SEQ) ? t + half : SEQ; const float inv = 1.0f / (float)(hi - lo);
#pragma unroll
        for (int i = 0; i < 4; ++i) {
            const float w1 = x[oc - 1][i] + x[oc][i];
            const float w2 = w1 + (x[oc - 2][i] + x[oc + 1][i]);
            const float w4 = w2 + ((x[oc - 4][i] + x[oc - 3][i]) + (x[oc + 2][i] + x[oc + 3][i]));
            const float w8 = w4 + (((x[oc - 8][i] + x[oc - 7][i]) + (x[oc - 6][i] + x[oc - 5][i])) + ((x[oc + 4][i] + x[oc + 5][i]) + (x[oc + 6][i] + x[oc + 7][i])));
            const float S = (g == 0) ? w1 : (g == 1) ? w2 : (g == 2) ? w4 : w8;
            y[k][i] = S * inv - x[oc][i]; } }
    pair_norm_store(F, y, MIXED, rb + tw, 0, cq);
}
__device__ __forceinline__ void hyfin_item(Frame& F, const bf16* __restrict__ YC, const bf16* __restrict__ X0, bf16* MIXED, int b, int tile) {
    const int tb = F.tid >> 7, cq = F.tid & 127, c0 = 4 * cq, tw = tile * 32 + tb * 8; const size_t rb = (size_t)b * SEQ;
    float yc[4][8], y[8][4];
#pragma unroll
    for (int i = 0; i < 4; ++i) { const v4u v = *(const v4u*)(YC + ((size_t)(c0 + i) * NSEQ + b) * SEQ + tw);
        yc[i][0] = bflo(v.x); yc[i][1] = bfhi(v.x); yc[i][2] = bflo(v.y); yc[i][3] = bfhi(v.y); yc[i][4] = bflo(v.z); yc[i][5] = bfhi(v.z); yc[i][6] = bflo(v.w); yc[i][7] = bfhi(v.w); }
#pragma unroll
    for (int k = 0; k < 8; ++k) { float xv[4]; unpack4(*(const v2u*)(X0 + (rb + tw + k) * HYC + c0), xv);
#pragma unroll
        for (int i = 0; i < 4; ++i) y[k][i] = yc[i][k] * xv[i]; }
    pair_norm_store(F, y, MIXED, rb + tw, 1536, cq);
}
struct PrepGains { float q[3][8], k[3][8]; };
__device__ __forceinline__ void load8(const float* p, float (&o)[8]) { const f32x4 a = *(const f32x4*)p, b = *(const f32x4*)(p + 4); o[0] = a.x; o[1] = a.y; o[2] = a.z; o[3] = a.w; o[4] = b.x; o[5] = b.y; o[6] = b.z; o[7] = b.w; }
__device__ __forceinline__ void unpack8(const v4u w, float (&x)[8]) { x[0] = bflo(w.x); x[1] = bfhi(w.x); x[2] = bflo(w.y); x[3] = bfhi(w.y); x[4] = bflo(w.z); x[5] = bfhi(w.z); x[6] = bflo(w.w); x[7] = bfhi(w.w); }
__device__ __forceinline__ v4u pack8(const float (&x)[8]) { v4u o; o.x = pk2(x[0], x[1]); o.y = pk2(x[2], x[3]); o.z = pk2(x[4], x[5]); o.w = pk2(x[6], x[7]); return o; }
__device__ __forceinline__ float ssq8(const float (&x)[8]) { return ((x[0] * x[0] + x[1] * x[1]) + (x[2] * x[2] + x[3] * x[3])) + ((x[4] * x[4] + x[5] * x[5]) + (x[6] * x[6] + x[7] * x[7])); }
__device__ __forceinline__ float sum8lanes(float v) { v += __shfl_xor(v, 1); v += __shfl_xor(v, 2); v += __shfl_xor(v, 4); return v; }
__device__ __forceinline__ void prep_row(const bf16* __restrict__ PROJ, bf16* Q, bf16* KV, const PrepGains& G, const float* __restrict__ ROPE, int m, int lane) {
    const int h = lane >> 3, sub = lane & 7;
    const bf16* pr = PROJ + (size_t)m * DINP; bf16* qr = Q + (size_t)m * NQ + 192 * h + 8 * sub; bf16* kr = KV + (size_t)m * NKVP + KVHS * h + 8 * sub;
    const v4u cqv = *(const v4u*)(pr + O_CQ + 8 * lane); const v4u ckv = *(const v4u*)(pr + O_CKV + 8 * (lane & 31)); const v4u pev = *(const v4u*)(pr + O_KPE + 8 * sub);
    const v4u q0 = *(const v4u*)(qr), q1 = *(const v4u*)(qr + 64), q2 = *(const v4u*)(qr + 128);
    const v4u k0 = *(const v4u*)(kr), k1 = *(const v4u*)(kr + 64), v0 = *(const v4u*)(kr + 192), v1 = *(const v4u*)(kr + 256);
    float cs[8], sn[8]; { const float* rp = ROPE + (size_t)(m & (SEQ - 1)) * 64 + 8 * (sub & 3); load8(rp, cs); load8(rp + 32, sn); }
    float t[8];
    unpack8(cqv, t); const float rq = 1.0f / sqrtf(wave_sum(ssq8(t)) * (1.f / 512.f) + EPS);
    unpack8(ckv, t); const float rkv = 1.0f / sqrtf(wave_sum(lane < 32 ? ssq8(t) : 0.f) * (1.f / 256.f) + EPS);
    const float sg = (sub < 4) ? -1.f : 1.f;
    { float a0[8], a1[8], a2[8]; unpack8(q0, a0); unpack8(q1, a1); unpack8(q2, a2);
      const float ss = sum8lanes(ssq8(a0) + ssq8(a1) + ssq8(a2)) * (rq * rq);
      const float sc = rq / sqrtf(ss * (1.f / 192.f) + EPS);
      float r[8], o[8];
#pragma unroll
      for (int i = 0; i < 8; ++i) { a0[i] *= sc * G.q[0][i]; a1[i] *= sc * G.q[1][i]; r[i] = a2[i] * sc * G.q[2][i]; }
#pragma unroll
      for (int i = 0; i < 8; ++i) { const float rp = __shfl_xor(r[i], 4); o[i] = r[i] * cs[i] + sg * rp * sn[i]; }
      *(v4u*)(qr) = pack8(a0); *(v4u*)(qr + 64) = pack8(a1); *(v4u*)(qr + 128) = pack8(o); }
    { float a0[8], a1[8], pe[8], b0[8], b1[8]; unpack8(k0, a0); unpack8(k1, a1); unpack8(pev, pe); unpack8(v0, b0); unpack8(v1, b1);
      const float ss = sum8lanes((ssq8(a0) + ssq8(a1)) * (rkv * rkv) + ssq8(pe));
      const float sk = 1.0f / sqrtf(ss * (1.f / 192.f) + EPS);
      float r[8], o[8];
#pragma unroll
      for (int i = 0; i < 8; ++i) { a0[i] *= rkv * sk * G.k[0][i]; a1[i] *= rkv * sk * G.k[1][i]; r[i] = pe[i] * sk * G.k[2][i]; b0[i] *= rkv; b1[i] *= rkv; }
#pragma unroll
      for (int i = 0; i < 8; ++i) { const float rp = __shfl_xor(r[i], 4); o[i] = r[i] * cs[i] + sg * rp * sn[i]; }
      *(v4u*)(kr) = pack8(a0); *(v4u*)(kr + 64) = pack8(a1); *(v4u*)(kr + 128) = pack8(o); *(v4u*)(kr + 192) = pack8(b0); *(v4u*)(kr + 256) = pack8(b1); }
}
__device__ __forceinline__ void attn_norm_row(bf16* MIXED, int m, int lane) {
    v4u* p = (v4u*)(MIXED + (size_t)m * DM + 512 + 16 * lane); v4u a = p[0], b = p[1];
    unsigned w[8] = {a.x, a.y, a.z, a.w, b.x, b.y, b.z, b.w}; float s = 0.f;
#pragma unroll
    for (int i = 0; i < 8; ++i) { const float x = bflo(w[i]), y = bfhi(w[i]); s += x * x + y * y; }
    const float rstd = 1.0f / sqrtf(wave_sum(s) * (1.f / 1024.f) + EPS);
#pragma unroll
    for (int i = 0; i < 8; ++i) w[i] = pk2(bflo(w[i]) * rstd, bfhi(w[i]) * rstd);
    a.x = w[0]; a.y = w[1]; a.z = w[2]; a.w = w[3]; b.x = w[4]; b.y = w[5]; b.z = w[6]; b.w = w[7]; p[0] = a; p[1] = b;
}

#define DEFPTRS() unsigned char* ws = args.ws; \
    bf16* BtIn = (bf16*)(ws + WS_BTIN); bf16* BtUq = (bf16*)(ws + WS_BTUQ); bf16* BtKv = (bf16*)(ws + WS_BTKV); bf16* BtOut = (bf16*)(ws + WS_BTOUT); bf16* BtUp = (bf16*)(ws + WS_BTUP); bf16* BtDn = (bf16*)(ws + WS_BTDN); \
    bf16* RF = (bf16*)(ws + WS_RF); bf16* Hb = (bf16*)(ws + WS_H); bf16* PROJ = (bf16*)(ws + WS_PROJ); bf16* Qb = (bf16*)(ws + WS_Q); bf16* KVb = (bf16*)(ws + WS_KV); \
    bf16* ZT = (bf16*)(ws + WS_ZT); bf16* X0 = (bf16*)(ws + WS_X0); bf16* YC = (bf16*)(ws + WS_YC); float* EDGE = (float*)(ws + WS_EDGE); float* ROPE = (float*)(ws + WS_ROPE); float* SSQP = (float*)(ws + WS_SSQP); float* RSTD = (float*)(ws + WS_RSTD); bf16* XB2 = (bf16*)(ws + WS_XB2); bf16* ACT = (bf16*)(ws + WS_ACT); \
    bf16* XA = (bf16*)args.out; \
    (void)BtIn; (void)BtUq; (void)BtKv; (void)BtOut; (void)BtUp; (void)BtDn; (void)RF; (void)Hb; (void)PROJ; (void)Qb; (void)KVb; (void)ZT; (void)X0; (void)YC; (void)EDGE; (void)ROPE; (void)SSQP; (void)RSTD; (void)XB2; (void)ACT; (void)XA
__global__ void __launch_bounds__(NWAVES * 64, 2) fwd(Args args) {
    extern __shared__ __attribute__((aligned(16))) unsigned char lds_raw[];
    Frame F;
    F.lds = (LAS unsigned char*)lds_raw;
    F.tid = threadIdx.x; F.lane = F.tid & 63; F.wave = __builtin_amdgcn_readfirstlane(F.tid >> 6);
    F.G = gridDim.x; { const int bx = blockIdx.x; F.vcu = (F.G % 8 == 0) ? (bx % 8) * (F.G / 8) + bx / 8 : bx; }
    volatile LAS unsigned* MISC = (volatile LAS unsigned*)(F.lds + MISC_OFF);
    if (F.tid < 64) MISC[F.tid] = 0u;
    __syncthreads();
    unsigned* ctl = (unsigned*)(args.ws + WS_CTL);
    const int lo = args.ph_lo, hi = args.ph_hi;
    XcdBarrier bar; bar.bar = ctl + CW_BAR; bar.x = 0; bar.st = MISC + 8;
    if (hi - lo > 1) bar = xcd_barrier_post(ctl + CW_BAR, MISC + 8);
    float* out = args.out;

#pragma unroll 1
    for (int layer = 0; layer < DEPTH; ++layer) {
        const int pb = layer * NPH;
        if (pb + NPH <= lo || pb >= hi) continue;
#define IN(k) (lo <= pb + (k) && pb + (k) < hi)
#define ENTER() DEFPTRS(); F.tid = opq(threadIdx.x); F.lane = F.tid & 63; F.wave = __builtin_amdgcn_readfirstlane(F.tid >> 6); const int gw = F.vcu * NWAVES + F.wave, NGW = F.G * NWAVES, wg = F.vcu; const size_t gtid = (size_t)wg * 512 + F.tid, gthreads = (size_t)F.G * 512; (void)gw; (void)NGW; (void)wg; (void)gtid; (void)gthreads
#define SEAM(k) do { if (pb + (k) + 1 < hi) xcd_barrier(bar); } while (0)

        if (IN(0)) { ENTER();
            const float* win = args.in[I_WIN] + (size_t)layer * DM * DIN; const float* g1 = args.in[I_ANG] + layer * DM;
            for (int it = wg; it < 256; it += F.G) {
                if (it < 128) poolfold_item(F, win, args.in[I_PW] + (size_t)layer * 4 * 128 * 128, args.in[I_PS] + (size_t)layer * 512, g1, BtIn, it >> 5, it & 31);
                else filter_item(F, args.in[I_FW1] + (size_t)layer * 17 * 64, args.in[I_FB1] + layer * 64, args.in[I_FFR] + layer * 64, args.in[I_FW2] + (size_t)layer * 64 * 64, args.in[I_FB2] + layer * 64,
                                 args.in[I_FW3] + (size_t)layer * 64 * 1024, args.in[I_FB3] + layer * 1024, args.in[I_HBIAS] + layer * 512, RF, it - 128);
            }
            LAS float* scr = (LAS float*)(F.lds + F.wave * 8448);
            constexpr int N_IN_ = 74 * 32, N_UQ = 48 * 8, N_KV = 64 * 4, N_OUT = 64 * 32, N_UP = 352 * 32, N_DN = 64 * 88, N_ALL = N_IN_ + N_UQ + N_KV + N_OUT + N_UP + N_DN;
            for (int it = gw; it < N_ALL; it += NGW) {
                int r = it;
                if (r < N_IN_) { const int nb = 16 + r / 32, kb = r % 32; cvt_item(win, DIN, DM, BtIn, 32 * nb, 32 * nb, 64 * kb, g1, scr, F.lane); continue; } r -= N_IN_;
                if (r < N_UQ) { const int nb = r / 8, kb = r % 8; cvt_item(args.in[I_WUQ] + (size_t)layer * 512 * NQ, NQ, 512, BtUq, 32 * nb, 32 * nb, 64 * kb, args.in[I_QNG] + layer * 512, scr, F.lane); continue; } r -= N_UQ;
                if (r < N_KV) { const int nb = r / 4, kb = r % 4, h = nb >> 3, wb = nb & 7; const int dst = KVHS * h + (wb < 4 ? 32 * wb : 192 + 32 * (wb - 4));
                    cvt_item(args.in[I_WUKV] + (size_t)layer * 256 * 2048, 2048, 256, BtKv, dst, 32 * nb, 64 * kb, args.in[I_KVNG] + layer * 256, scr, F.lane); continue; } r -= N_KV;
                if (r < N_OUT) { const int nb = r / 32, kb = r % 32; cvt_item(args.in[I_WOUT] + (size_t)layer * DM * DM, DM, DM, BtOut, 32 * nb, 32 * nb, 64 * kb, args.in[I_GNG] + layer * DM, scr, F.lane); continue; } r -= N_OUT;
                if (r < N_UP) { const int nb = r / 32, kb = r % 32; const int nv = (nb < 176) ? nb : nb - 176; const int dst = 256 * (nv >> 2) + 64 * (nv & 3) + (nb < 176 ? 0 : 32);
                    cvt_item(args.in[I_WUP] + (size_t)layer * DM * NUP, NUP, DM, BtUp, dst, 32 * nb, 64 * kb, args.in[I_FNG] + layer * DM, scr, F.lane); continue; } r -= N_UP;
                { const int nb = r / 88, kb = r % 88; cvt_item(args.in[I_WDN] + (size_t)layer * DFF * DM, DM, DFF, BtDn, 32 * nb, 32 * nb, 64 * kb, nullptr, scr, F.lane); }
            }
            { unsigned zz = 0u; asm volatile("" : "+v"(zz)); v4u z = {zz, zz, zz, zz};
              for (size_t i = gtid; i < (size_t)(DINP - DIN) * DM / 8; i += gthreads) *(v4u*)(BtIn + (size_t)DIN * DM + i * 8) = z;
              for (size_t i = gtid; i < (size_t)NH * 64 * 256 / 8; i += gthreads) { const int h = (int)(i / (64 * 256 / 8)), q = (int)(i % (64 * 256 / 8)); *(v4u*)(BtKv + (size_t)(KVHS * h + 128) * 256 + (size_t)q * 8) = z; } }
            if (layer == 0) for (size_t i = gtid; i < (size_t)SEQ * 32; i += gthreads) { const int pos = (int)(i >> 5), ri = (int)(i & 31);
                const float freq = exp2f(-(float)ri * (13.287712379549449f / 32.0f)); float sn, cs; sincosf((float)pos * freq, &sn, &cs); ROPE[pos * 64 + ri] = cs; ROPE[pos * 64 + 32 + ri] = sn; }
            if (layer == 0) { for (int m = gw; m < M; m += NGW) xb_row(m < MP ? args.in[I_XP] + (size_t)m * DM : args.in[I_XS] + (size_t)(m - MP) * DM, XA + (size_t)m * DM, RSTD + m, F.lane); }
            else rstd_from_partials(SSQP, RSTD, gtid, gthreads);
            SEAM(0);
        }
        if (IN(1)) { ENTER();
            pg8::Gemm g{XA, BtIn, M, DINP, DM, DM}; pg8::StaticOrder S; S.init(M, DINP, F.G, (int)blockIdx.x);
            pg8::EpiBf16 E{PROJ, DINP, RSTD};
            pg8::gemm_phase<pg8::EpiBf16, pg8::StaticOrder>(F.lds, g, S, E);
            SEAM(1);
        }
        if (IN(2)) { ENTER();
            { pg8::Gemm g{PROJ + O_CQ, BtUq, M, NQ, 512, DINP}; pg8::StaticOrder S; S.init(M, NQ, F.G, (int)blockIdx.x); pg8::EpiBf16 E{Qb, NQ, nullptr};
              pg8::gemm_phase<pg8::EpiBf16, pg8::StaticOrder>(F.lds, g, S, E); }
            { pg8::Gemm g{PROJ + O_CKV, BtKv, M, NKVP, 256, DINP}; pg8::StaticOrder S; S.init(M, NKVP, F.G, (int)blockIdx.x); pg8::EpiBf16 E{KVb, NKVP, nullptr};
              pg8::gemm_phase<pg8::EpiBf16, pg8::StaticOrder>(F.lds, g, S, E); }
            const float* hcw = args.in[I_HCW] + (size_t)layer * 3 * 1536; const float* hcb = args.in[I_HCB] + layer * 1536;
            for (int it = wg; it < 2 * NSEQ * 64; it += F.G) {
                if (it < NSEQ * 64) hyprep_item(F, PROJ, hcw, hcb, ZT, X0, it >> 6, it & 63);
                else pool_item(F, PROJ, Hb, (it - NSEQ * 64) >> 6, it & 63);
            }
            SEAM(2);
        }
        if (IN(3)) { ENTER();
            for (int u = wg; u < 2 * HYC; u += F.G) hy::conv_unit(F.lds, ZT, RF, YC, u >> 1, u & 1);
            const float* qhg = args.in[I_QHG] + layer * 192; const float* khg = args.in[I_KHG] + layer * 192;
            PrepGains PG; { const int sub = F.lane & 7;
#pragma unroll
                for (int i = 0; i < 3; ++i) { load8(qhg + 64 * i + 8 * sub, PG.q[i]); load8(khg + 64 * i + 8 * sub, PG.k[i]); } }
            for (int m = gw; m < M; m += NGW) prep_row(PROJ, Qb, KVb, PG, ROPE, m, F.lane);
            SEAM(3);
        }
        if (IN(4)) { ENTER();
            for (int i = 0; i * F.G < NSEQ * NH * 8; ++i) {
                int p, qb; const int c = (int)blockIdx.x;
                if (F.G == 256) { p = i * 32 + (c & 7) * 4 + (c >> 6); qb = (c >> 3) & 7; } else { const int Lq = i * F.G + c; p = Lq >> 3; qb = Lq & 7; }
                if (p < NSEQ * NH) { const int b = p >> 3, h = p & 7;
                    at::attn_unit(Qb + (size_t)(b * SEQ + qb * 256) * NQ + h * 192, KVb + (size_t)(b * SEQ) * NKVP + h * KVHS, KVb + (size_t)(b * SEQ) * NKVP + h * KVHS + 192,
                                  Hb + (size_t)(b * SEQ + qb * 256) * DM + 512 + h * 128, SEQ, (char*)lds_raw); }
            }
            for (int it = wg; it < NSEQ * 64; it += F.G) hyfin_item(F, YC, X0, Hb, it >> 6, it & 63);
            SEAM(4);
        }
        if (IN(5)) { ENTER();
            for (int m = gw; m < M; m += NGW) attn_norm_row(Hb, m, F.lane);
            SEAM(5);
        }
        if (IN(6)) { ENTER();
            pg8::Gemm g{Hb, BtOut, M, DM, DM, DM}; pg8::StaticOrder S; S.init(M, DM, F.G, (int)blockIdx.x);
            pg8::EpiResid16 E{XA, XB2, out, DM, SSQP, 0};
            pg8::gemm_phase<pg8::EpiResid16, pg8::StaticOrder>(F.lds, g, S, E);
            SEAM(6);
        }
        if (IN(7)) { ENTER();
            rstd_from_partials(SSQP, RSTD, gtid, gthreads);
            SEAM(7);
        }
        if (IN(8)) { ENTER();
            pg8::Gemm g{XB2, BtUp, M, NUP, DM, DM}; pg8::StaticOrder S; S.init(M, NUP, F.G, (int)blockIdx.x);
            pg8::EpiGate E{ACT, DFF, EDGE, args.in[I_FCW] + (size_t)layer * 3 * DFF, args.in[I_FCB] + layer * DFF, DFF, (LAS float*)(F.lds + HALO_OFF), RSTD};
            pg8::gemm_phase<pg8::EpiGate, pg8::StaticOrder>(F.lds, g, S, E);
            SEAM(8);
        }
        if (IN(9)) { ENTER();
            const float* fcw = args.in[I_FCW] + (size_t)layer * 3 * DFF;
            for (size_t i = gtid; i < (size_t)(M / 256) * 2 * (DFF / 4); i += gthreads) {
                const int ri = (int)(i / (DFF / 4)), c4 = (int)(i % (DFF / 4)) * 4, pm = ri >> 1, e = ri & 1;
                const float* eb = EDGE + (size_t)(ri * 3) * DFF + c4;
                f32x4 pre = *(const f32x4*)(eb + DFF); const f32x4 v = *(const f32x4*)(eb + 2 * DFF);
                if (e == 0 && (pm & 7) != 0) { const f32x4 gp = *(const f32x4*)(EDGE + (size_t)(((pm - 1) * 2 + 1) * 3) * DFF + c4); pre += *(const f32x4*)(fcw + c4) * gp; }
                if (e == 1 && (pm & 7) != 7) { const f32x4 gn = *(const f32x4*)(EDGE + (size_t)(((pm + 1) * 2 + 0) * 3) * DFF + c4); pre += *(const f32x4*)(fcw + 2 * DFF + c4) * gn; }
                v2u o; o.x = pk2(pg8::silu_f(pre.x) * v.x, pg8::silu_f(pre.y) * v.y); o.y = pk2(pg8::silu_f(pre.z) * v.z, pg8::silu_f(pre.w) * v.w);
                *(v2u*)(ACT + (size_t)(pm * 256 + (e ? 255 : 0)) * DFF + c4) = o;
            }
            SEAM(9);
        }
        if (IN(10)) { ENTER();
            pg8::Gemm g{ACT, BtDn, M, DM, DFF, DFF}; pg8::StaticOrder S; S.init(M, DM, F.G, (int)blockIdx.x);
            pg8::EpiResid16 E{XB2, XA, out, DM, SSQP, (layer + 1 < DEPTH) ? 0 : 1};
            pg8::gemm_phase<pg8::EpiResid16, pg8::StaticOrder>(F.lds, g, S, E);
            SEAM(10);
        }
#undef IN
#undef ENTER
#undef SEAM
    }
}

extern "C" void kernel_launch(void* const* d_in, const int* in_sizes, int n_in, void* d_out, int out_size, void* d_ws, size_t ws_size, hipStream_t stream) {
    static int grid = 0;
    if (grid == 0) {
        if (n_in != N_IN || out_size != M * DM || ws_size < WS_END) { fprintf(stderr, "kernel_launch: unexpected shapes (n_in %d, out %d, ws %zu, need %zu)\n", n_in, out_size, ws_size, (size_t)WS_END); grid = -1; return; }
        int dev = 0, cus = 0;
        if (hipGetDevice(&dev) != hipSuccess || hipDeviceGetAttribute(&cus, hipDeviceAttributeMultiprocessorCount, dev) != hipSuccess) { grid = -1; return; }
        if (hipFuncSetAttribute((const void*)fwd, hipFuncAttributeMaxDynamicSharedMemorySize, LDS_BYTES) != hipSuccess) { fprintf(stderr, "kernel_launch: hipFuncSetAttribute failed\n"); grid = -1; return; }
        int per_cu = 0;
        if (hipOccupancyMaxActiveBlocksPerMultiprocessor(&per_cu, (const void*)fwd, NWAVES * 64, LDS_BYTES) != hipSuccess || per_cu < 1) fprintf(stderr, "kernel_launch: occupancy query reports %d\n", per_cu);
        (void)hipGetLastError();
        grid = cus;
    }
    if (grid < 0) return;
    (void)hipMemsetAsync((char*)d_ws + WS_CTL, 0, CTL_BYTES, stream);
    Args a{};
    for (int i = 0; i < N_IN; ++i) a.in[i] = (const float*)d_in[i];
    a.out = (float*)d_out; a.ws = (unsigned char*)d_ws;
#if MK_ONE_LAUNCH
    a.ph_lo = 0; a.ph_hi = DEPTH * NPH;
    hipLaunchKernelGGL(fwd, dim3(grid), dim3(NWAVES * 64), LDS_BYTES, stream, a);
#else
    for (int p = 0; p < DEPTH * NPH; ++p) { a.ph_lo = p; a.ph_hi = p + 1; hipLaunchKernelGGL(fwd, dim3(grid), dim3(NWAVES * 64), LDS_BYTES, stream, a); }
#endif
    const hipError_t le = hipPeekAtLastError();
    if (le != hipSuccess) fprintf(stderr, "kernel_launch: launch failed: %s\n", hipGetErrorName(le));
}
```

```cpp
#include <hip/hip_runtime.h>
#include <cstdio>
#include <cstdint>
__device__ __forceinline__ int opq(int x) { asm volatile("" : "+v"(x)); return x; }
namespace pg8 {
#define PG8_LAS __attribute__((address_space(3)))
typedef unsigned short bf16_t;
typedef short bf16x8 __attribute__((ext_vector_type(8)));
typedef float f32x4 __attribute__((ext_vector_type(4)));
typedef unsigned u32x4 __attribute__((ext_vector_type(4)));
constexpr int BM = 256, BK = 64, HALF = 128, HTB = HALF * BK * 2  , STAGE_BYTES = 8 * HTB, NXCD = 8, WGM = 8;

__host__ __device__ __forceinline__ int lds_byte(int r, int c) { const int st = (r >> 4) * 2 + (c >> 5), rr = r & 15, cc = c & 31, ob = rr * 64 + cc * 2; return st * 1024 + (ob ^ (((ob >> 9) & 1) << 5)); }
__host__ __device__ __forceinline__ void stage_rc(int b, int& R, int& C) { const int st = b / 1024, sb = b % 1024, swz = sb ^ (((sb >> 9) & 1) << 5); R = (st >> 1) * 16 + swz / 64; C = (st & 1) * 32 + (swz % 64) / 2; }
__host__ __device__ __forceinline__ int perm32(int rho) { const int n = rho >> 4, i = rho & 15; return 8 * (i >> 2) + 4 * n + (i & 3); }

struct Unit { int pm, pn; };
struct Gemm { const bf16_t* A; const bf16_t* Bt; int M, N, K, lda; };

struct StaticOrder {
    int nM, nN, nwg, G, c;
    __host__ __device__ void init(int M, int N, int G_, int c_) { nM = M / BM; nN = N / BM; nwg = nM * nN; G = G_; c = c_; }
    __host__ __device__ bool next(int i, Unit& u) const {
        const long L = (long)i * G + c; if (L >= nwg) return false;
        int wgid = (int)L; { const int q = nwg / NXCD, r = nwg % NXCD, xcd = wgid % NXCD, off = wgid / NXCD; wgid = (xcd < r ? xcd * (q + 1) : r * (q + 1) + (xcd - r) * q) + off; }
        const int nig = WGM * nN, gid = wgid / nig, fm = gid * WGM, gsz = (nM - fm) < WGM ? (nM - fm) : WGM;
        u.pm = fm + ((wgid % nig) % gsz); u.pn = (wgid % nig) / gsz; return true;
    }
    __device__ __forceinline__ void a_ready(const Unit&) const {}
    __device__ __forceinline__ void done(const Unit&) const {}
};

__device__ __forceinline__ unsigned cvt_pk_bf16(float lo, float hi) { unsigned r; asm volatile("v_cvt_pk_bf16_f32 %0, %1, %2" : "=v"(r) : "v"(lo), "v"(hi)); return r; }

__device__ __forceinline__ float dpp_ror1(float v) { return __builtin_bit_cast(float, __builtin_amdgcn_update_dpp(0, __builtin_bit_cast(int, v), 0x121, 0xF, 0xF, false)); }
__device__ __forceinline__ float dpp_ror15(float v) { return __builtin_bit_cast(float, __builtin_amdgcn_update_dpp(0, __builtin_bit_cast(int, v), 0x12F, 0xF, 0xF, false)); }
__device__ __forceinline__ unsigned dpp_swap1(unsigned v) { return (unsigned)__builtin_amdgcn_update_dpp(0, (int)v, 0xB1, 0xF, 0xF, false); }
struct LineOffs { unsigned o0, o1; bool odd; };
__device__ __forceinline__ LineOffs line_offs(unsigned lo, int pitch, int fr) { LineOffs L; L.odd = fr & 1; L.o0 = L.odd ? lo - (unsigned)pitch + 32u : lo; L.o1 = L.odd ? lo + 32u : lo + (unsigned)pitch; return L; }
__device__ __forceinline__ void store_lines(bf16_t* base, const LineOffs& L, u32x4 a, u32x4 b) {
    const u32x4 snd = L.odd ? a : b; u32x4 rcv;
    rcv.x = dpp_swap1(snd.x); rcv.y = dpp_swap1(snd.y); rcv.z = dpp_swap1(snd.z); rcv.w = dpp_swap1(snd.w);
    *(u32x4*)(base + L.o0) = L.odd ? rcv : a;
    *(u32x4*)(base + L.o1) = L.odd ? b : rcv;
}
struct EpiBf16 {
    static constexpr bool PERM = true;
    bf16_t* O; int ldc; const float* rstd;
    __device__ __forceinline__ void operator()(f32x4 (&acc)[2][2][4][2], const Unit& u, int wr, int wc, int fr, int fq) const {
        bf16_t* Ot = O + (size_t)(u.pm * BM) * ldc + u.pn * BM;
        const LineOffs L = line_offs((unsigned)((wr * 64 + fr) * ldc + wc * 64 + 8 * fq), ldc, fr); const int row0 = u.pm * BM + wr * 64 + fr;
        float rsv[8];
#pragma unroll
        for (int i = 0; i < 8; ++i) rsv[i] = rstd ? rstd[row0 + (i >> 2) * HALF + (i & 3) * 16] : 1.0f;
#pragma unroll
        for (int ai = 0; ai < 2; ++ai)
#pragma unroll
            for (int m = 0; m < 4; ++m) { const float rs = rsv[ai * 4 + m];
                u32x4 w[2];
#pragma unroll
                for (int bj = 0; bj < 2; ++bj) { const f32x4 v0 = acc[ai][bj][m][0] * rs, v1 = acc[ai][bj][m][1] * rs;
                    w[bj].x = cvt_pk_bf16(v0[0], v0[1]); w[bj].y = cvt_pk_bf16(v0[2], v0[3]); w[bj].z = cvt_pk_bf16(v1[0], v1[1]); w[bj].w = cvt_pk_bf16(v1[2], v1[3]); }
                store_lines(Ot + (size_t)((ai * HALF + m * 16) * ldc), L, w[0], w[1]);
                asm volatile("" ::: "memory"); }
    }
};
struct EpiResid16 {
    static constexpr bool PERM = true;
    const bf16_t* base; bf16_t* xo; float* out; int ldc; float* ssqp; int f32out;
    __device__ __forceinline__ static void addx(const u32x4 b, const f32x4 a0, const f32x4 a1, f32x4& x0, f32x4& x1) {
        x0[0] = __builtin_bit_cast(float, b.x << 16) + a0[0]; x0[1] = __builtin_bit_cast(float, b.x & 0xffff0000u) + a0[1]; x0[2] = __builtin_bit_cast(float, b.y << 16) + a0[2]; x0[3] = __builtin_bit_cast(float, b.y & 0xffff0000u) + a0[3];
        x1[0] = __builtin_bit_cast(float, b.z << 16) + a1[0]; x1[1] = __builtin_bit_cast(float, b.z & 0xffff0000u) + a1[1]; x1[2] = __builtin_bit_cast(float, b.w << 16) + a1[2]; x1[3] = __builtin_bit_cast(float, b.w & 0xffff0000u) + a1[3]; }
    __device__ __forceinline__ void operator()(f32x4 (&acc)[2][2][4][2], const Unit& u, int wr, int wc, int fr, int fq) const {
        const size_t tb = (size_t)(u.pm * BM) * ldc + u.pn * BM;
        const bf16_t* bs = base + tb;
        const unsigned lo = (unsigned)((wr * 64 + fr) * ldc + wc * 64 + 8 * fq);
        if (f32out != 0) {
            float* op = out + tb;
#pragma unroll
            for (int ai = 0; ai < 2; ++ai)
#pragma unroll
                for (int m = 0; m < 4; ++m) { const unsigned off = lo + (unsigned)((ai * HALF + m * 16) * ldc);
#pragma unroll
                    for (int bj = 0; bj < 2; ++bj) { const u32x4 b = *(const u32x4*)(bs + off + bj * 32); f32x4 x0, x1; addx(b, acc[ai][bj][m][0], acc[ai][bj][m][1], x0, x1);
                        *(f32x4*)(op + off + bj * 32) = x0; *(f32x4*)(op + off + bj * 32 + 4) = x1; }
                    asm volatile("" ::: "memory"); }
            return;
        }
        bf16_t* xp = xo + tb; const LineOffs L = line_offs(lo, ldc, fr);
#pragma unroll
        for (int aim = 0; aim < 4; ++aim) { const int ai = aim >> 1, mp = aim & 1;
            u32x4 bv[2][2];
#pragma unroll
            for (int mm = 0; mm < 2; ++mm)
#pragma unroll
                for (int bj = 0; bj < 2; ++bj) bv[mm][bj] = *(const u32x4*)(bs + lo + (unsigned)((ai * HALF + (2 * mp + mm) * 16) * ldc) + bj * 32);
#pragma unroll
            for (int mm = 0; mm < 2; ++mm) { const int m = 2 * mp + mm; float s = 0.f; u32x4 wv[2];
#pragma unroll
                for (int bj = 0; bj < 2; ++bj) { f32x4 x0, x1; addx(bv[mm][bj], acc[ai][bj][m][0], acc[ai][bj][m][1], x0, x1);
                    wv[bj].x = cvt_pk_bf16(x0[0], x0[1]); wv[bj].y = cvt_pk_bf16(x0[2], x0[3]); wv[bj].z = cvt_pk_bf16(x1[0], x1[1]); wv[bj].w = cvt_pk_bf16(x1[2], x1[3]);
                    s += ((x0[0] * x0[0] + x0[1] * x0[1]) + (x0[2] * x0[2] + x0[3] * x0[3])) + ((x1[0] * x1[0] + x1[1] * x1[1]) + (x1[2] * x1[2] + x1[3] * x1[3])); }
                store_lines(xp + (size_t)((ai * HALF + m * 16) * ldc), L, wv[0], wv[1]);
                s += __shfl_xor(s, 16); s += __shfl_xor(s, 32); if (fq == 0) ssqp[(size_t)(u.pm * BM + wr * 64 + fr + ai * HALF + m * 16) * 32 + u.pn * 4 + wc] = s; }
            asm volatile("" ::: "memory"); }
    }
};
__device__ __forceinline__ float silu_f(float x) { return x * __builtin_amdgcn_rcpf(1.0f + __builtin_amdgcn_exp2f(-1.4426950408889634f * x)); }
struct EpiGate {
    static constexpr bool PERM = true;
    bf16_t* act; int ldact; float* edge; const float* cw; const float* cb; int dff; PG8_LAS float* halo; const float* rstd;
    __device__ __forceinline__ void operator()(f32x4 (&acc)[2][2][4][2], const Unit& u, int wr, int wc, int fr, int fq) const {
        const int lane = fq * 16 + fr; const int colL = wc * 32 + 8 * fq; const int colG = u.pn * HALF + colL;
#pragma unroll
        for (int ai = 0; ai < 2; ++ai)
#pragma unroll
            for (int m = 0; m < 4; ++m) { const float rs = rstd[u.pm * BM + ai * HALF + wr * 64 + m * 16 + fr];
#pragma unroll
                for (int bj = 0; bj < 2; ++bj) { acc[ai][bj][m][0] *= rs; acc[ai][bj][m][1] *= rs; } }
#pragma unroll
        for (int ai = 0; ai < 2; ++ai) { const int q = 2 * ai + wr;
            if (fr == 0) { *(PG8_LAS f32x4*)(halo + (q * 2 + 0) * 128 + colL) = acc[ai][0][0][0]; *(PG8_LAS f32x4*)(halo + (q * 2 + 0) * 128 + colL + 4) = acc[ai][0][0][1]; }
            if (fr == 15) { *(PG8_LAS f32x4*)(halo + (q * 2 + 1) * 128 + colL) = acc[ai][0][3][0]; *(PG8_LAS f32x4*)(halo + (q * 2 + 1) * 128 + colL + 4) = acc[ai][0][3][1]; } }
        asm volatile("s_waitcnt lgkmcnt(0)" ::: "memory"); __builtin_amdgcn_s_barrier(); asm volatile("" ::: "memory");
        bf16_t* actp = act + (size_t)(u.pm * BM) * ldact + colG; const unsigned rlo = (unsigned)((wr * 64 + fr) * ldact);
#pragma unroll
        for (int ai = 0; ai < 2; ++ai) { const int q = 2 * ai + wr;
            typedef unsigned u32x2 __attribute__((ext_vector_type(2)));
            u32x2 pk[4][2];
#pragma unroll
            for (int n = 0; n < 2; ++n) {
                const f32x4 w0 = *(const f32x4*)(cw + colG + 4 * n), w1 = *(const f32x4*)(cw + dff + colG + 4 * n), w2 = *(const f32x4*)(cw + 2 * dff + colG + 4 * n), bb = *(const f32x4*)(cb + colG + 4 * n);
                f32x4 ht = *(PG8_LAS f32x4*)(halo + ((q > 0 ? q - 1 : 0) * 2 + 1) * 128 + colL + 4 * n), hb = *(PG8_LAS f32x4*)(halo + ((q < 3 ? q + 1 : 3) * 2 + 0) * 128 + colL + 4 * n);
                if (q == 0) ht = ht * 0.f; if (q == 3) hb = hb * 0.f;
                f32x4 pre[4];
#pragma unroll
                for (int j = 0; j < 4; ++j) {
                    float g[4], rr[4], rl[4];
#pragma unroll
                    for (int m = 0; m < 4; ++m) { g[m] = acc[ai][0][m][n][j]; rr[m] = dpp_ror1(g[m]); rl[m] = dpp_ror15(g[m]); }
#pragma unroll
                    for (int m = 0; m < 4; ++m) {
                        const float up = (fr > 0) ? rr[m] : (m > 0 ? rr[m > 0 ? m - 1 : 0] : ht[j]);
                        const float dn = (fr < 15) ? rl[m] : (m < 3 ? rl[m < 3 ? m + 1 : 3] : hb[j]);
                        pre[m][j] = w0[j] * up + w1[j] * g[m] + w2[j] * dn + bb[j];
                    }
                }
                if (q == 0 && fr == 0) { float* e = edge + (size_t)((u.pm * 2 + 0) * 3) * dff + colG + 4 * n;
                    *(f32x4*)(e) = acc[ai][0][0][n]; *(f32x4*)(e + dff) = pre[0]; *(f32x4*)(e + 2 * dff) = acc[ai][1][0][n]; }
                if (q == 3 && fr == 15) { float* e = edge + (size_t)((u.pm * 2 + 1) * 3) * dff + colG + 4 * n;
                    *(f32x4*)(e) = acc[ai][0][3][n]; *(f32x4*)(e + dff) = pre[3]; *(f32x4*)(e + 2 * dff) = acc[ai][1][3][n]; }
#pragma unroll
                for (int m = 0; m < 4; ++m) { const f32x4 v = acc[ai][1][m][n];
                    pk[m][n].x = cvt_pk_bf16(silu_f(pre[m][0]) * v[0], silu_f(pre[m][1]) * v[1]); pk[m][n].y = cvt_pk_bf16(silu_f(pre[m][2]) * v[2], silu_f(pre[m][3]) * v[3]); }
            }
#pragma unroll
            for (int m = 0; m < 4; ++m) { u32x4 w; w.x = pk[m][0].x; w.y = pk[m][0].y; w.z = pk[m][1].x; w.w = pk[m][1].y;
                *(u32x4*)(actp + rlo + (unsigned)((ai * HALF + m * 16) * ldact)) = w; }
        }
    }
};

template <class Epi, class Sched>
__device__ __forceinline__ void gemm_phase(PG8_LAS unsigned char* lds, const Gemm g, const Sched& S, const Epi& E) {
    const int tid = opq(threadIdx.x), wid = __builtin_amdgcn_readfirstlane(tid >> 6), lane = tid & 63, wr = wid >> 2, wc = wid & 3, fr = lane & 15, fq = lane >> 4;
    const int K = g.K, nt = K / BK, lda = g.lda;
    unsigned voffA[2], voffB[2];
#pragma unroll
    for (int i = 0; i < 2; ++i) { int R, C; stage_rc(tid * 16 + i * 8192, R, C); const int Rb = Epi::PERM ? (64 * (R >> 5) + perm32(R & 31)) : R;
        voffA[i] = (unsigned)(R * lda + C) * 2u; voffB[i] = (unsigned)(Rb * K + C) * 2u; }
    const size_t kstep = (size_t)(BK * 2);
    const size_t hstepA = (size_t)HALF * lda * 2, hstepB = (size_t)(Epi::PERM ? 32 : HALF) * K * 2;
    const size_t tstepA = 2 * hstepA, tstepB = (size_t)BM * K * 2;
    const unsigned ldsw = (unsigned)wid * 1024u;
    const int aoff = lds_byte(wr * 64 + fr, fq * 8), boff = lds_byte(wc * 32 + fr, fq * 8);
#define PG8_SA(b, h) (((b) * 2 + (h)) * HTB)
#define PG8_SB(b, h) ((4 + (b) * 2 + (h)) * HTB)
#define PG8_STAGE(bufoff, gbase, voff) do { _Pragma("unroll") for (int _i = 0; _i < 2; ++_i) \
        __builtin_amdgcn_global_load_lds((const unsigned*)((const char*)(gbase) + (voff)[_i]), (PG8_LAS unsigned*)(lds + (bufoff) + ldsw + _i * 8192), 16, 0, 0); } while (0)
#define PG8_LDA(dst, b, h) do { _Pragma("unroll") for (int m = 0; m < 4; ++m) _Pragma("unroll") for (int k = 0; k < 2; ++k) dst[m][k] = *(const PG8_LAS bf16x8*)(lds + PG8_SA(b, h) + aoff + m * 2048 + k * 1024); } while (0)
#define PG8_LDB(dst, b, h) do { _Pragma("unroll") for (int n = 0; n < 2; ++n) _Pragma("unroll") for (int k = 0; k < 2; ++k) dst[n][k] = *(const PG8_LAS bf16x8*)(lds + PG8_SB(b, h) + boff + n * 2048 + k * 1024); } while (0)
#define PG8_MMA(ai, bj, At, Bt) do { __builtin_amdgcn_s_setprio(1); _Pragma("unroll") for (int m = 0; m < 4; ++m) _Pragma("unroll") for (int n = 0; n < 2; ++n) _Pragma("unroll") for (int k = 0; k < 2; ++k) \
        acc[ai][bj][m][n] = __builtin_amdgcn_mfma_f32_16x16x32_bf16(Bt[n][k], At[m][k], acc[ai][bj][m][n], 0, 0, 0); __builtin_amdgcn_s_setprio(0); } while (0)
#define PG8_WAIT_V(n) asm volatile("s_waitcnt vmcnt(" #n ")" ::: "memory")
#define PG8_WAIT_L(n) asm volatile("s_waitcnt lgkmcnt(" #n ")" ::: "memory")
#define PG8_BAR __builtin_amdgcn_s_barrier()
#define PG8_SCHED __builtin_amdgcn_sched_barrier(0)
    Unit cur, nxt; int ui = 0;
    if (!S.next(0, cur)) return;
    f32x4 acc[2][2][4][2];
{ float zf = 0.f; asm volatile("" : "+v"(zf));
    #pragma unroll
    for (int a = 0; a < 2; ++a)
#pragma unroll
        for (int b = 0; b < 2; ++b)
#pragma unroll
            for (int m = 0; m < 4; ++m)
#pragma unroll
                for (int n = 0; n < 2; ++n) acc[a][b][m][n] = (f32x4){zf, zf, zf, zf}; }
    bf16x8 At[4][2], B0[2][2], B1[2][2];
    const char* cA = (const char*)g.A + (size_t)cur.pm * tstepA; const char* cB = (const char*)g.Bt + (size_t)cur.pn * tstepB;
    S.a_ready(cur);
    PG8_STAGE(PG8_SB(0, 0), cB, voffB); PG8_STAGE(PG8_SB(0, 1), cB + hstepB, voffB); PG8_STAGE(PG8_SA(0, 0), cA, voffA); PG8_STAGE(PG8_SA(0, 1), cA + hstepA, voffA);
    if (wr == 1) PG8_BAR;
    PG8_WAIT_V(2); PG8_BAR;
    PG8_STAGE(PG8_SB(1, 0), cB + kstep, voffB); PG8_STAGE(PG8_SA(1, 0), cA + kstep, voffA); PG8_STAGE(PG8_SB(1, 1), cB + hstepB + kstep, voffB);
    PG8_WAIT_V(6); PG8_BAR;
    for (;;) {
        const bool has_next = S.next(ui + 1, nxt);
        const char* nA = has_next ? (const char*)g.A + (size_t)nxt.pm * tstepA : cA; const char* nB = has_next ? (const char*)g.Bt + (size_t)nxt.pn * tstepB : cB;
#pragma unroll 1
        for (int t = 0; t < nt; t += 2) {
            const bool last = (t == nt - 2);
            const char* a1 = cA + (size_t)(t + 1) * kstep;
            const char* a2 = last ? nA : cA + (size_t)(t + 2) * kstep; const char* b2 = last ? nB : cB + (size_t)(t + 2) * kstep;
            const char* a3 = a2 + kstep; const char* b3 = b2 + kstep;
            if (last && has_next) S.a_ready(nxt);
            PG8_LDB(B0, 0, 0); PG8_LDB(B1, 0, 1); PG8_SCHED; PG8_LDA(At, 0, 0); PG8_STAGE(PG8_SA(1, 1), a1 + hstepA, voffA);
            PG8_WAIT_V(8); PG8_WAIT_L(0); PG8_BAR; PG8_MMA(0, 0, At, B0); PG8_MMA(0, 1, At, B1); PG8_BAR; PG8_SCHED;
            PG8_LDA(At, 0, 1); PG8_STAGE(PG8_SB(0, 0), b2, voffB); PG8_STAGE(PG8_SB(0, 1), b2 + hstepB, voffB); PG8_STAGE(PG8_SA(0, 0), a2, voffA);
            PG8_WAIT_V(8); PG8_WAIT_L(0); PG8_BAR; PG8_MMA(1, 0, At, B0); PG8_MMA(1, 1, At, B1); PG8_BAR; PG8_SCHED;
            PG8_LDB(B0, 1, 0); PG8_LDB(B1, 1, 1); PG8_SCHED; PG8_LDA(At, 1, 0); PG8_STAGE(PG8_SA(0, 1), a2 + hstepA, voffA);
            PG8_WAIT_V(8); PG8_WAIT_L(0); PG8_BAR; PG8_MMA(0, 0, At, B0); PG8_MMA(0, 1, At, B1); PG8_BAR; PG8_SCHED;
            PG8_LDA(At, 1, 1); PG8_STAGE(PG8_SB(1, 0), b3, voffB); PG8_STAGE(PG8_SB(1, 1), b3 + hstepB, voffB); PG8_STAGE(PG8_SA(1, 0), a3, voffA);
            PG8_WAIT_V(8); PG8_WAIT_L(0); PG8_BAR; PG8_MMA(1, 0, At, B0); PG8_MMA(1, 1, At, B1); PG8_BAR; PG8_SCHED;
        }
        if (wr == 0) PG8_BAR;
        E(acc, cur, wr, wc, fr, fq); S.done(cur);
        if (!has_next) break;
{ float zf = 0.f; asm volatile("" : "+v"(zf));
        #pragma unroll
        for (int a = 0; a < 2; ++a)
#pragma unroll
            for (int b = 0; b < 2; ++b)
#pragma unroll
                for (int m = 0; m < 4; ++m)
#pragma unroll
                    for (int n = 0; n < 2; ++n) acc[a][b][m][n] = (f32x4){zf, zf, zf, zf}; }
        cur = nxt; cA = nA; cB = nB; ++ui;
        if (wr == 1) PG8_BAR;
    }
    PG8_WAIT_V(0);
    PG8_BAR;
#undef PG8_SA
#undef PG8_SB
#undef PG8_STAGE
#undef PG8_LDA
#undef PG8_LDB
#undef PG8_MMA
#undef PG8_WAIT_V
#undef PG8_WAIT_L
#undef PG8_BAR
#undef PG8_SCHED
}
}
namespace at {
using bf16 = unsigned short;
using bf16x8 = __attribute__((ext_vector_type(8))) short;
using s16x4  = __attribute__((ext_vector_type(4))) short;
using f32x16 = __attribute__((ext_vector_type(16))) float;
using u32x4  = __attribute__((ext_vector_type(4))) unsigned;
constexpr int DQK = 192, DV = 128, KVBLK = 64, NW = 8, QBLK = 32;
constexpr float SCALE = 0.07216878364870322f;
constexpr float THR = 8.f;
constexpr int LDQ = 1536, LDK = 2560, LDO = 2048;
constexpr int SHM_V = KVBLK * DV * 2, SHM_K = 12 * 2080;
constexpr int QR_OFF = 2 * SHM_V + 2 * SHM_K + NW * 64 * 4;
constexpr int SHM_ATTN = QR_OFF + NW * 4096;
#define SBAR() __builtin_amdgcn_sched_barrier(0)
constexpr int KPL = 2080;
__host__ __device__ __forceinline__ int k_st(int row, int c) { return (c >> 1) * KPL + row * 32 + (((c & 1) ^ ((row >> 3) & 1)) << 4); }
__host__ __device__ __forceinline__ int k_rd_base(int r32, int hi) { return r32 * 32 + ((hi ^ ((r32 >> 3) & 1)) << 4); }
__device__ __forceinline__ int crow(int r, int hi) { return (r & 3) + 8 * (r >> 2) + 4 * hi; }
__device__ __forceinline__ unsigned cvtpk(float lo, float hi) { unsigned r; asm volatile("v_cvt_pk_bf16_f32 %0, %1, %2" : "=v"(r) : "v"(lo), "v"(hi)); return r; }

__device__ __forceinline__ void partialSM(f32x16& p0, f32x16& p1, float& m_reg, float& mn, float& alpha) {
  constexpr float C = SCALE * 1.4426950408889634f;
  float pmax = p0[0];
#pragma unroll
  for (int r = 1; r < 16; ++r) pmax = fmaxf(pmax, p0[r]);
#pragma unroll
  for (int r = 0; r < 16; ++r) pmax = fmaxf(pmax, p1[r]);
  { auto rr = __builtin_amdgcn_permlane32_swap(__float_as_uint(pmax), __float_as_uint(pmax), false, false);
    pmax = fmaxf(__uint_as_float(rr[0]), __uint_as_float(rr[1])); }
  if (__builtin_expect(__all(pmax - m_reg <= THR / SCALE), 1)) { mn = m_reg; alpha = 1.f; }
  else { mn = fmaxf(m_reg, pmax); alpha = __builtin_amdgcn_exp2f((m_reg - mn) * C); m_reg = mn; }
  float mnC = -mn * C;
#pragma unroll
  for (int r = 0; r < 16; ++r) p0[r] = fmaf(p0[r], C, mnC);
#pragma unroll
  for (int r = 0; r < 16; ++r) p1[r] = fmaf(p1[r], C, mnC);
#pragma unroll
  for (int r = 0; r < 16; ++r) p0[r] = __builtin_amdgcn_exp2f(p0[r]);
}
__device__ __forceinline__ void finishSM(f32x16& p0, f32x16& p1, float alpha, float& l_reg, bf16x8& pa0, bf16x8& pa1, bf16x8& pa2, bf16x8& pa3) {
#pragma unroll
  for (int r = 0; r < 16; ++r) p1[r] = __builtin_amdgcn_exp2f(p1[r]);
  float ps = 0;
#pragma unroll
  for (int r = 0; r < 16; ++r) ps += p0[r];
#pragma unroll
  for (int r = 0; r < 16; ++r) ps += p1[r];
  { auto rr = __builtin_amdgcn_permlane32_swap(__float_as_uint(ps), __float_as_uint(ps), false, false);
    ps = __uint_as_float(rr[0]) + __uint_as_float(rr[1]); }
  l_reg = l_reg * alpha + ps;
#define PK4(P, BASE, OUT) do { unsigned a0 = cvtpk(P[BASE + 0], P[BASE + 1]), a1 = cvtpk(P[BASE + 2], P[BASE + 3]);   \
    unsigned b0 = cvtpk(P[BASE + 4], P[BASE + 5]), b1 = cvtpk(P[BASE + 6], P[BASE + 7]);                              \
    auto r0 = __builtin_amdgcn_permlane32_swap(a0, b0, false, false); auto r1 = __builtin_amdgcn_permlane32_swap(a1, b1, false, false); \
    u32x4 w = {r0[0], r1[0], r0[1], r1[1]}; OUT = *reinterpret_cast<bf16x8*>(&w); } while (0)
  PK4(p0, 0, pa0); PK4(p0, 8, pa1); PK4(p1, 0, pa2); PK4(p1, 8, pa3);
#undef PK4
}
template <int OFF> __device__ __forceinline__ bf16x8 k_read(int kb) {
  bf16x8 r; asm volatile("ds_read_b128 %0, %1 offset:%2" : "=v"(r) : "v"(kb), "i"(OFF) : "memory"); return r;
}
__device__ __forceinline__ void qkt(f32x16& p0, f32x16& p1, int kb, const bf16x8* qr, int qb) {
  p0 = f32x16{}; p1 = f32x16{};
#define QK1(d0) { const bf16x8 b0 = *(const __attribute__((address_space(3))) bf16x8*)(kb + d0 * KPL), b1 = *(const __attribute__((address_space(3))) bf16x8*)(kb + d0 * KPL + 1024); \
    p0 = __builtin_amdgcn_mfma_f32_32x32x16_bf16(b0, qr[d0], p0, 0, 0, 0); p1 = __builtin_amdgcn_mfma_f32_32x32x16_bf16(b1, qr[d0], p1, 0, 0, 0); }
#define QK2(d0) { const bf16x8 b0 = *(const __attribute__((address_space(3))) bf16x8*)(kb + d0 * KPL), b1 = *(const __attribute__((address_space(3))) bf16x8*)(kb + d0 * KPL + 1024); \
    const bf16x8 qf = *(const __attribute__((address_space(3))) bf16x8*)(qb + (d0 - 8) * 1024); \
    p0 = __builtin_amdgcn_mfma_f32_32x32x16_bf16(b0, qf, p0, 0, 0, 0); p1 = __builtin_amdgcn_mfma_f32_32x32x16_bf16(b1, qf, p1, 0, 0, 0); }
  QK1(0) QK1(1) QK1(2) QK1(3) QK1(4) QK1(5) QK1(6) QK1(7) QK2(8) QK2(9) QK2(10) QK2(11)
#undef QK1
#undef QK2
}
__host__ __device__ __forceinline__ int v_st(int k, int c) { const int kk = (k & ~0xC) | ((k & 4) << 1) | ((k & 8) >> 1); return ((kk >> 3) * 4 + (c >> 5)) * 512 + ((kk & 7) * 32 + (c & 31)) * 2; }
__device__ __forceinline__ int v_rd_base(int lane) { return ((lane & 3) << 3) | (((lane >> 2) & 3) << 6) | (((lane >> 4) & 1) << 5) | (((lane >> 5) & 1) << 8); }
constexpr int v_rd_off(int d0, int ks, int half) { return d0 * 512 + ks * 4096 + half * 2048; }
template <int OFF> __device__ __forceinline__ s16x4 tr_read(int vb) {
  s16x4 r; asm volatile("ds_read_b64_tr_b16 %0, %1 offset:%2" : "=&v"(r) : "v"(vb), "i"(OFF) : "memory"); return r;
}
template <int D0> __device__ __forceinline__ void pv_one(f32x16& od, int vb, bf16x8 pa0, bf16x8 pa1, bf16x8 pa2, bf16x8 pa3) {
  const s16x4 l0 = tr_read<v_rd_off(D0, 0, 0)>(vb), h0 = tr_read<v_rd_off(D0, 0, 1)>(vb), l1 = tr_read<v_rd_off(D0, 1, 0)>(vb), h1 = tr_read<v_rd_off(D0, 1, 1)>(vb);
  const s16x4 l2 = tr_read<v_rd_off(D0, 2, 0)>(vb), h2 = tr_read<v_rd_off(D0, 2, 1)>(vb), l3 = tr_read<v_rd_off(D0, 3, 0)>(vb), h3 = tr_read<v_rd_off(D0, 3, 1)>(vb);
  asm volatile("s_waitcnt lgkmcnt(0)" ::: "memory"); SBAR();
#define PK(L, H) (bf16x8){L[0], L[1], L[2], L[3], H[0], H[1], H[2], H[3]}
  od = __builtin_amdgcn_mfma_f32_32x32x16_bf16(pa0, PK(l0, h0), od, 0, 0, 0);
  od = __builtin_amdgcn_mfma_f32_32x32x16_bf16(pa1, PK(l1, h1), od, 0, 0, 0);
  od = __builtin_amdgcn_mfma_f32_32x32x16_bf16(pa2, PK(l2, h2), od, 0, 0, 0);
  od = __builtin_amdgcn_mfma_f32_32x32x16_bf16(pa3, PK(l3, h3), od, 0, 0, 0);
#undef PK
}
__device__ __forceinline__ void pv_d0(f32x16* o, int vb, bf16x8 pa0, bf16x8 pa1, bf16x8 pa2, bf16x8 pa3) {
  pv_one<0>(o[0], vb, pa0, pa1, pa2, pa3); pv_one<1>(o[1], vb, pa0, pa1, pa2, pa3); pv_one<2>(o[2], vb, pa0, pa1, pa2, pa3); pv_one<3>(o[3], vb, pa0, pa1, pa2, pa3);
}

__device__ __forceinline__ void attn_unit(const bf16* __restrict__ Qb, const bf16* __restrict__ Kh, const bf16* __restrict__ Vh, bf16* __restrict__ Ob, int seq, char* lds) {
  const int tid = opq(threadIdx.x), wid = tid >> 6, lane = tid & 63, r32 = lane & 31, hi = lane >> 5;
  char* V_lds = lds; char* K_lds = lds + 2 * SHM_V;
  float* ws = (float*)(lds + 2 * SHM_V + 2 * SHM_K) + wid * 64; float* li_l = ws; float* al_l = ws + 32;
  float m_reg = -1e30f, l_reg = 0; f32x16 o[4] = {}; bf16x8 qr[8];
  const bf16* Qw = Qb + (unsigned)((wid * QBLK + r32) * LDQ + hi * 8);
#pragma unroll
  for (int d0 = 0; d0 < 8; ++d0) qr[d0] = *reinterpret_cast<const bf16x8*>(Qw + d0 * 16);
  const int qb0 = (int)(uintptr_t)lds + QR_OFF + wid * 4096 + k_rd_base(r32, hi);
#pragma unroll
  for (int d0 = 8; d0 < 12; ++d0) *(__attribute__((address_space(3))) bf16x8*)(qb0 + (d0 - 8) * 1024) = *reinterpret_cast<const bf16x8*>(Qw + d0 * 16);
  const int sr = tid >> 4, sc = (tid & 15) * 8, vst0 = v_st(sr, sc), vst1 = v_st(32 + sr, sc);
  unsigned koff[3]; int kst[3];
#pragma unroll
  for (int i = 0; i < 3; ++i) { const int q = tid + 512 * i; koff[i] = (unsigned)((q / 24) * LDK + (q % 24) * 8); kst[i] = k_st(q / 24, q % 24); }
  const unsigned voff0 = (unsigned)(sr * LDK + sc), voff1 = (unsigned)((32 + sr) * LDK + sc);
  const int vb0 = (int)(uintptr_t)V_lds + v_rd_base(lane); const int kb0 = (int)(uintptr_t)K_lds + k_rd_base(r32, hi);
  struct { bf16x8 vs0, vs1, ks0, ks1, ks2; } sr_[1];
#define SLOAD(i, k0) do { const bf16* vt = Vh + (size_t)(k0) * LDK; const bf16* kt = Kh + (size_t)(k0) * LDK; \
    sr_[i].vs0 = *(const bf16x8*)(vt + voff0); sr_[i].vs1 = *(const bf16x8*)(vt + voff1); \
    sr_[i].ks0 = *(const bf16x8*)(kt + koff[0]); sr_[i].ks1 = *(const bf16x8*)(kt + koff[1]); sr_[i].ks2 = *(const bf16x8*)(kt + koff[2]); } while (0)
#define SWRITE(b, i) do { *(bf16x8*)(V_lds + (b) * SHM_V + vst0) = sr_[i].vs0; *(bf16x8*)(V_lds + (b) * SHM_V + vst1) = sr_[i].vs1; \
    *(bf16x8*)(K_lds + (b) * SHM_K + kst[0]) = sr_[i].ks0; *(bf16x8*)(K_lds + (b) * SHM_K + kst[1]) = sr_[i].ks1; *(bf16x8*)(K_lds + (b) * SHM_K + kst[2]) = sr_[i].ks2; } while (0)
#define SWAIT() do { if constexpr (SDEPTH == 2) asm volatile("s_waitcnt vmcnt(5)" ::: "memory"); else asm volatile("s_waitcnt vmcnt(0)" ::: "memory"); } while (0)
#define RESC(a) do { if (__any((a) < 1.f)) { if (hi == 0) al_l[r32] = (a); asm volatile("s_waitcnt lgkmcnt(0)" ::: "memory"); \
    _Pragma("unroll") for (int d = 0; d < 4; ++d) _Pragma("unroll") for (int r = 0; r < 16; ++r) o[d][r] *= al_l[crow(r, hi)]; } } while (0)
  f32x16 pA0, pA1, pB0, pB1; float mnA, mnB, alA, alB; bf16x8 pa0, pa1, pa2, pa3; const int NT = seq / KVBLK;
  SLOAD(0, 0); asm volatile("s_waitcnt vmcnt(0)" ::: "memory"); SWRITE(0, 0); __syncthreads();
  qkt(pA0, pA1, kb0, qr, qb0); partialSM(pA0, pA1, m_reg, mnA, alA);
  SLOAD(0, KVBLK);
  asm volatile("s_waitcnt vmcnt(0)" ::: "memory"); SWRITE(1, 0); __syncthreads();
  for (int j = 1; j + 1 < NT; j += 2) {
    SBAR(); qkt(pB0, pB1, kb0 + SHM_K, qr, qb0);
    finishSM(pA0, pA1, alA, l_reg, pa0, pa1, pa2, pa3); SBAR();
    SLOAD(0, (j + 1) * KVBLK); SBAR();
    pv_d0(o, vb0, pa0, pa1, pa2, pa3); partialSM(pB0, pB1, m_reg, mnB, alB);
    __syncthreads(); asm volatile("s_waitcnt vmcnt(0)" ::: "memory"); SWRITE(0, 0);
    RESC(alB); __syncthreads();
    SBAR(); qkt(pA0, pA1, kb0, qr, qb0);
    finishSM(pB0, pB1, alB, l_reg, pa0, pa1, pa2, pa3); SBAR();
    SLOAD(0, (j + 2) * KVBLK); SBAR();
    pv_d0(o, vb0 + (int)SHM_V, pa0, pa1, pa2, pa3); partialSM(pA0, pA1, m_reg, mnA, alA);
    __syncthreads(); asm volatile("s_waitcnt vmcnt(0)" ::: "memory"); SWRITE(1, 0);
    RESC(alA); __syncthreads();
  }
  SBAR(); qkt(pB0, pB1, kb0 + SHM_K, qr, qb0);
  finishSM(pA0, pA1, alA, l_reg, pa0, pa1, pa2, pa3); SBAR();
  pv_d0(o, vb0, pa0, pa1, pa2, pa3); partialSM(pB0, pB1, m_reg, mnB, alB);
  __syncthreads(); RESC(alB);
  finishSM(pB0, pB1, alB, l_reg, pa0, pa1, pa2, pa3); SBAR();
  pv_d0(o, vb0 + (int)SHM_V, pa0, pa1, pa2, pa3);
  if (hi == 0) li_l[r32] = l_reg; asm volatile("s_waitcnt lgkmcnt(0)" ::: "memory");
  bf16* Ow = Ob + (unsigned)(wid * QBLK * LDO + r32);
#pragma unroll
  for (int r = 0; r < 16; ++r) { const int orow = crow(r, hi); const float rl = __builtin_amdgcn_rcpf(li_l[orow]);
#pragma unroll
    for (int d0 = 0; d0 < 4; ++d0) { const unsigned w = cvtpk(o[d0][r] * rl, 0.f); Ow[(unsigned)(orow * LDO + d0 * 32)] = (bf16)(w & 0xffffu); } }
  __syncthreads();
#undef SLOAD
#undef SWRITE
#undef SWAIT
#undef RESC
}
}
namespace hy {
#define HY_LAS __attribute__((address_space(3)))
typedef unsigned short bf16;
typedef short bf16x8 __attribute__((ext_vector_type(8)));
typedef float f32x16 __attribute__((ext_vector_type(16)));
typedef unsigned u32x2 __attribute__((ext_vector_type(2)));
typedef unsigned u32x4 __attribute__((ext_vector_type(4)));
constexpr int L = 2048, NB = 24, CH = 512;
constexpr int RFS = 4112;
constexpr int ZROW = 4112;
constexpr int ZL_BYTES = NB * ZROW;
constexpr int RCS = 8256;
constexpr int RC_OFF = ZL_BYTES;
constexpr int HY_LDS_BYTES = RC_OFF + 4 * RCS;
__device__ __forceinline__ unsigned cvtpk(float lo, float hi) { unsigned r; asm volatile("v_cvt_pk_bf16_f32 %0, %1, %2" : "=v"(r) : "v"(lo), "v"(hi)); return r; }
__host__ __device__ __forceinline__ int frag_base(int tw, int r, int h) { const int a = (4 - (r & 3)) & 3; return RC_OFF + a * RCS + 2 * (2048 - tw - r + 8 * h - a); }
__host__ __device__ __forceinline__ int zfrag_base(int r, int h) { return (r < NB ? r : NB - 1) * ZROW + 16 * h; }

__device__ __forceinline__ bf16x8 ld_frag(HY_LAS unsigned char* lds, int off) {
    const u32x2 lo = *(const HY_LAS u32x2*)(lds + off), hi = *(const HY_LAS u32x2*)(lds + off + 8);
    u32x4 w = {lo.x, lo.y, hi.x, hi.y}; return *reinterpret_cast<bf16x8*>(&w);
}
__device__ __forceinline__ bf16x8 ld_b128(HY_LAS unsigned char* lds, int off) { return *(const HY_LAS bf16x8*)(lds + off); }

__device__ __forceinline__ void conv_unit(HY_LAS unsigned char* lds, const bf16* __restrict__ ZT, const bf16* __restrict__ RF, bf16* __restrict__ YC, int c, int half) {
    const int tid = opq(threadIdx.x), wid = tid >> 6, lane = tid & 63, r = lane & 31, h = lane >> 5;
    { const u32x4* src = (const u32x4*)(ZT + (size_t)c * NB * L);
#pragma unroll
      for (int i = 0; i < 12; ++i) { const int q = tid + 512 * i; const u32x4 v = src[q]; *(HY_LAS u32x4*)(lds + (q >> 8) * ZROW + (q & 255) * 16) = v; } }
    { const bf16* rf = RF + (size_t)c * RFS;
      for (int ch = tid; ch < RFS / 8; ch += 512) {
          const u32x4 v = *(const u32x4*)(rf + ch * 8); const unsigned w[4] = {v.x, v.y, v.z, v.w};
#pragma unroll
          for (int j = 0; j < 8; ++j) { const unsigned short e = (unsigned short)((w[j >> 1] >> ((j & 1) * 16)) & 0xffffu); const int idx = ch * 8 + j;
#pragma unroll
              for (int a = 0; a < 4; ++a) if (idx - a >= 0) *(HY_LAS unsigned short*)(lds + RC_OFF + a * RCS + 2 * (idx - a)) = e; } } }
    __syncthreads();
    const int tw = half * 1024 + wid * 128;
    const int fb = frag_base(tw, r, h), zb = zfrag_base(r, h);
    f32x16 acc[4] = {};
    bf16x8 S0[2], S1[2], S2[2], S3[2], Bc[2], Bn[2];
#define HY_LDG(S, d) do { S[0] = ld_frag(lds, fb + 64 * (d)); S[1] = ld_frag(lds, fb + 64 * (d) + 32); } while (0)
#define HY_LDB(Bx, n) do { Bx[0] = ld_b128(lds, zb + 64 * (n)); Bx[1] = ld_b128(lds, zb + 64 * (n) + 32); } while (0)
#define HY_MM(i, S, Bx) do { acc[i] = __builtin_amdgcn_mfma_f32_32x32x16_bf16(S[0], Bx[0], acc[i], 0, 0, 0); acc[i] = __builtin_amdgcn_mfma_f32_32x32x16_bf16(S[1], Bx[1], acc[i], 0, 0, 0); } while (0)
#define HY_ITER(n, Sa, Sb, Sc, Sd, Bcur, Bnext) do { HY_LDG(Sa, (n)); if ((n) + 1 < 64) HY_LDB(Bnext, (n) + 1); \
        HY_MM(1, Sb, Bcur); HY_MM(2, Sc, Bcur); HY_MM(3, Sd, Bcur); HY_MM(0, Sa, Bcur); } while (0)
    HY_LDG(S3, -1); HY_LDG(S2, -2); HY_LDG(S1, -3); HY_LDB(Bc, 0);
    for (int n = 0; n < 64; n += 4) {
        HY_ITER(n, S0, S3, S2, S1, Bc, Bn);
        HY_ITER(n + 1, S1, S0, S3, S2, Bn, Bc);
        HY_ITER(n + 2, S2, S1, S0, S3, Bc, Bn);
        HY_ITER(n + 3, S3, S2, S1, S0, Bn, Bc);
    }
#undef HY_LDG
#undef HY_LDB
#undef HY_MM
#undef HY_ITER
    if (r < NB) { bf16* yp = YC + ((size_t)c * NB + r) * L + tw + 4 * h;
#pragma unroll
        for (int i = 0; i < 4; ++i)
#pragma unroll
            for (int q4 = 0; q4 < 4; ++q4) { u32x2 w; w.x = cvtpk(acc[i][4 * q4 + 0], acc[i][4 * q4 + 1]); w.y = cvtpk(acc[i][4 * q4 + 2], acc[i][4 * q4 + 3]);
                *(u32x2*)(yp + 32 * i + 8 * q4) = w; } }
    __syncthreads();
}
}
constexpr int NWAVES = 8;
#ifndef MK_ONE_LAUNCH
#define MK_ONE_LAUNCH 1
#endif
constexpr int DM = 2048, NSEQ = 24, SEQ = 2048, M = NSEQ * SEQ, MP = 8 * SEQ;
constexpr int DEPTH = 4;
constexpr int DIN = 2880, DINP = 3072;
constexpr int O_CQ = 512, O_CKV = 1024, O_KPE = 1280, O_HY = 1344;
constexpr int NH = 8, NQ = 1536, NKVP = 2560, KVHS = 320;
constexpr int DFF = 5632, NUP = 11264, HYC = 512;
constexpr float EPS = 1e-6f;
constexpr int NPH = 11;
constexpr size_t WS_CTL = 0, CTL_BYTES = 1u << 20;
constexpr size_t SZ_BTIN = (size_t)DINP * DM * 2, SZ_BTUQ = (size_t)NQ * 512 * 2, SZ_BTKV = (size_t)NKVP * 256 * 2, SZ_BTOUT = (size_t)DM * DM * 2, SZ_BTUP = (size_t)NUP * DM * 2, SZ_BTDN = (size_t)DM * DFF * 2;
constexpr size_t WS_BTIN = WS_CTL + CTL_BYTES, WS_BTUQ = WS_BTIN + SZ_BTIN, WS_BTKV = WS_BTUQ + SZ_BTUQ, WS_BTOUT = WS_BTKV + SZ_BTKV, WS_BTUP = WS_BTOUT + SZ_BTOUT, WS_BTDN = WS_BTUP + SZ_BTUP;
constexpr size_t WS_RF = WS_BTDN + SZ_BTDN, SZ_RF = (size_t)HYC * hy::RFS * 2;
constexpr size_t WS_H = WS_RF + SZ_RF, SZ_H = (size_t)M * DM * 2;
constexpr size_t WS_PROJ = WS_H + SZ_H, SZ_PROJ = (size_t)M * DINP * 2;
constexpr size_t WS_Q = WS_PROJ + SZ_PROJ, SZ_Q = (size_t)M * NQ * 2;
constexpr size_t WS_KV = WS_Q + SZ_Q, SZ_KV = (size_t)M * NKVP * 2;
constexpr size_t WS_ZT = WS_KV + SZ_KV, SZ_ZT = (size_t)HYC * NSEQ * SEQ * 2;
constexpr size_t WS_X0 = WS_ZT + SZ_ZT, WS_YC = WS_X0 + SZ_ZT;
constexpr size_t WS_EDGE = WS_YC + SZ_ZT, SZ_EDGE = (size_t)(M / 256) * 2 * 3 * DFF * 4;
constexpr size_t WS_ROPE = WS_EDGE + SZ_EDGE, SZ_ROPE = (size_t)SEQ * 64 * 4;
constexpr size_t WS_SSQP = WS_ROPE + SZ_ROPE, SZ_SSQP = (size_t)M * 32 * 4;
constexpr size_t WS_RSTD = WS_SSQP + SZ_SSQP, SZ_RSTD = (size_t)M * 4;
constexpr size_t WS_END = WS_RSTD + SZ_RSTD;
constexpr size_t WS_ACT = WS_PROJ;
static_assert((size_t)M * DFF * 2 <= SZ_PROJ + SZ_Q + SZ_KV, "ACT overlay");
constexpr size_t WS_XB2 = WS_ACT + (size_t)M * DFF * 2;
static_assert(WS_XB2 + (size_t)M * DM * 2 <= WS_EDGE && WS_XB2 % 256 == 0, "XB2 overlay");
static_assert(WS_BTIN % 256 == 0 && WS_RF % 256 == 0 && WS_H % 256 == 0 && WS_PROJ % 256 == 0 && WS_Q % 256 == 0 && WS_KV % 256 == 0 && WS_ZT % 256 == 0 && WS_EDGE % 256 == 0, "alignment");
constexpr int CW_BAR = 4096;
constexpr int RING_BYTES = 135168;
constexpr int HALO_OFF = RING_BYTES, HALO_BYTES = 4096;
constexpr int MISC_OFF = HALO_OFF + HALO_BYTES;
constexpr int LDS_BYTES = 147456;
static_assert(hy::HY_LDS_BYTES <= RING_BYTES && at::SHM_ATTN <= RING_BYTES && MISC_OFF + 256 <= LDS_BYTES, "LDS map");

#define GAS __attribute__((address_space(1)))
#define LAS __attribute__((address_space(3)))
typedef unsigned short bf16;
typedef unsigned v4u __attribute__((ext_vector_type(4)));
typedef unsigned v2u __attribute__((ext_vector_type(2)));
typedef float f32x4 __attribute__((ext_vector_type(4)));
#define LDS_WAIT() asm volatile("s_waitcnt lgkmcnt(0)" ::: "memory")
__device__ __forceinline__ unsigned f2bf(float f) { unsigned u = __builtin_bit_cast(unsigned, f); return (u + 0x7fffu + ((u >> 16) & 1u)) >> 16; }
__device__ __forceinline__ unsigned pk2(float lo, float hi) { return f2bf(lo) | (f2bf(hi) << 16); }
__device__ __forceinline__ float bf2f(unsigned short b) { return __builtin_bit_cast(float, (unsigned)b << 16); }
__device__ __forceinline__ float bflo(unsigned w) { return __builtin_bit_cast(float, w << 16); }
__device__ __forceinline__ float bfhi(unsigned w) { return __builtin_bit_cast(float, w & 0xffff0000u); }
__device__ __forceinline__ float wave_sum(float v) {
#pragma unroll
    for (int o = 1; o < 64; o <<= 1) v += __shfl_xor(v, o);
    return v;
}

#define XB_TMO      128
#define XB_XCNT(j)  (256  + 64 * (j))
#define XB_XSUB(j)  (1280 + 64 * (j))
#define XB_XGEN(j)  (2304 + 64 * (j))
#define XB_TOP      3328
#define XB_TOPGEN   3392
#define XCD_BAR_WORDS 3456
#define XB_SPIN_CAP (1u << 18)
__device__ __forceinline__ unsigned xb_ld(unsigned* p)              { return __hip_atomic_load(p, __ATOMIC_RELAXED, __HIP_MEMORY_SCOPE_AGENT); }
__device__ __forceinline__ unsigned xb_add(unsigned* p, unsigned v) { return __hip_atomic_fetch_add(p, v, __ATOMIC_RELAXED, __HIP_MEMORY_SCOPE_AGENT); }
__device__ __forceinline__ unsigned xb_xcc_id() { return (unsigned)__builtin_amdgcn_s_getreg((3 << 11) | 20) & 0xFu; }
#define XB_SPIN(cond, bar) do { unsigned _sp = 0; while (cond) { __builtin_amdgcn_s_sleep(1); \
    if ((++_sp & 255u) == 0u) { if (xb_ld(&(bar)[XB_TMO])) break; if (_sp > XB_SPIN_CAP) { atomicAdd(&(bar)[XB_TMO], 1u); break; } } } } while (0)
struct XcdBarrier { unsigned* bar; unsigned x; volatile LAS unsigned* st; };
__device__ __forceinline__ XcdBarrier xcd_barrier_post(unsigned* bar, volatile LAS unsigned* st) {
    XcdBarrier b; b.bar = bar; b.x = xb_xcc_id(); b.st = st;
    if (threadIdx.x == 0) (void)xb_add(&bar[XB_XCNT(b.x)], 1u);
    return b;
}
__device__ __forceinline__ void xcd_barrier_complete(unsigned* bar, unsigned x, unsigned& nloc, unsigned& nx) {
    const unsigned G = gridDim.x * gridDim.y * gridDim.z;
    unsigned sum, cnt, mine, sp = 0u;
    for (;;) {
        sum = 0u; cnt = 0u; mine = 0u;
#pragma unroll
        for (unsigned j = 0; j < 16; ++j) { const unsigned c = xb_ld(&bar[XB_XCNT(j)]); sum += c; cnt += (c > 0u) ? 1u : 0u; mine = (j == x) ? c : mine; }
        if (sum == G) break;
        __builtin_amdgcn_s_sleep(1);
        if ((++sp & 255u) == 0u) { if (xb_ld(&bar[XB_TMO])) break; if (sp > XB_SPIN_CAP) { atomicAdd(&bar[XB_TMO], 1u); break; } }
    }
    nloc = mine > 0u ? mine : 1u; nx = cnt > 0u ? cnt : 1u;
}
__device__ __forceinline__ void xcd_barrier(const XcdBarrier& b) {
    asm volatile("s_waitcnt vmcnt(0)" ::: "memory");
    __syncthreads();
    if (threadIdx.x == 0) {
        unsigned* bar = b.bar;
        __builtin_amdgcn_s_waitcnt(0);
        unsigned nloc = b.st[0], nx = b.st[1];
        if (nloc == 0u) { xcd_barrier_complete(bar, b.x, nloc, nx); b.st[0] = nloc; b.st[1] = nx; }
        const unsigned old = xb_add(&bar[XB_XSUB(b.x)], 1u);
        const unsigned gen = old / nloc;
        if (old + 1u == (gen + 1u) * nloc) {
            __builtin_amdgcn_fence(__ATOMIC_RELEASE, "agent");
            asm volatile("s_waitcnt vmcnt(0)" ::: "memory");
            const unsigned og = xb_add(&bar[XB_TOP], 1u);
            const unsigned tg = og / nx;
            if (og + 1u == (tg + 1u) * nx) xb_add(&bar[XB_TOPGEN], 1u);
            else XB_SPIN(xb_ld(&bar[XB_TOPGEN]) == tg, bar);
            __builtin_amdgcn_fence(__ATOMIC_ACQUIRE, "agent");
            xb_add(&bar[XB_XGEN(b.x)], 1u);
            asm volatile("s_waitcnt vmcnt(0)" ::: "memory");
        } else {
            XB_SPIN(xb_ld(&bar[XB_XGEN(b.x)]) == gen, bar);
            __builtin_amdgcn_fence(__ATOMIC_ACQUIRE, "agent");
            asm volatile("s_waitcnt vmcnt(0)" ::: "memory");
        }
    }
    __syncthreads();
}

struct Frame {
    LAS unsigned char* lds;
    int tid, lane, wave, vcu, G;
};
enum { I_XP = 0, I_XS, I_ANG, I_WIN, I_PW, I_PS, I_QNG, I_WUQ, I_KVNG, I_WUKV, I_QHG, I_KHG, I_HCW, I_HCB, I_FW1, I_FB1, I_FFR, I_FW2, I_FB2, I_FW3, I_FB3, I_HBIAS, I_GNG, I_WOUT, I_FNG, I_WUP, I_FCW, I_FCB, I_WDN, N_IN };
struct Args { const float* in[N_IN]; float* out; unsigned char* ws; int ph_lo, ph_hi; };
static_assert(sizeof(Args) == (N_IN + 2) * 8 + 8, "Args has no padding");

__device__ __forceinline__ void cvt_item(const float* __restrict__ W, int ldw, int K, bf16* WT, int dst_n0, int src_n0, int k0, const float* __restrict__ ks, LAS float* scr, int lane) {
#pragma unroll
    for (int i = 0; i < 32; ++i) { const int kk = 2 * i + (lane >> 5); float v = W[(size_t)(k0 + kk) * ldw + src_n0 + (lane & 31)]; if (ks) v *= ks[k0 + kk]; scr[kk * 33 + (lane & 31)] = v; }
    LDS_WAIT(); asm volatile("" ::: "memory");
    const int c = lane & 7;
#pragma unroll
    for (int j = 0; j < 4; ++j) { const int n = (lane >> 3) + 8 * j; const LAS float* s = scr + (8 * c) * 33 + n;
        v4u o; o.x = pk2(s[0 * 33], s[1 * 33]); o.y = pk2(s[2 * 33], s[3 * 33]); o.z = pk2(s[4 * 33], s[5 * 33]); o.w = pk2(s[6 * 33], s[7 * 33]);
        *(v4u*)(WT + (size_t)(dst_n0 + n) * K + k0 + 8 * c) = o; }
    LDS_WAIT(); asm volatile("" ::: "memory");
}
__device__ __forceinline__ void xb_row(const float* xrow, bf16* orow, float* rstd, int lane) {
    const f32x4* xr = (const f32x4*)xrow + lane;
    f32x4 v[8]; float s = 0.f;
#pragma unroll
    for (int j = 0; j < 8; ++j) { v[j] = xr[64 * j]; s += (v[j].x * v[j].x + v[j].y * v[j].y) + (v[j].z * v[j].z + v[j].w * v[j].w); }
    const float r = 1.0f / sqrtf(wave_sum(s) * (1.f / DM) + EPS);
    if (lane == 0) *rstd = r;
    v2u* o8 = (v2u*)orow + lane;
#pragma unroll
    for (int j = 0; j < 8; ++j) { v2u w; w.x = pk2(v[j].x, v[j].y); w.y = pk2(v[j].z, v[j].w); o8[64 * j] = w; }
}
__device__ __forceinline__ void rstd_from_partials(const float* __restrict__ ssqp, float* rstd, size_t gtid, size_t gthreads) {
    for (size_t r = gtid; r < (size_t)M; r += gthreads) { const f32x4* p = (const f32x4*)(ssqp + r * 32); f32x4 a = p[0];
#pragma unroll
        for (int i = 1; i < 8; ++i) a += p[i];
        rstd[r] = 1.0f / sqrtf(((a.x + a.y) + (a.z + a.w)) * (1.f / DM) + EPS); }
}
__device__ __forceinline__ void tile_norm_store(LAS float* tile, bf16* dst, int row0, int col_off, int wave, int lane) {
#pragma unroll
    for (int i = 0; i < 8; ++i) { const int t = wave * 8 + i;
        const f32x4 a = *(LAS f32x4*)(tile + t * 512 + 8 * lane), b = *(LAS f32x4*)(tile + t * 512 + 8 * lane + 4);
        const float s = (a.x * a.x + a.y * a.y) + (a.z * a.z + a.w * a.w) + (b.x * b.x + b.y * b.y) + (b.z * b.z + b.w * b.w);
        const float rstd = 1.0f / sqrtf(wave_sum(s) * (1.f / 512.f) + EPS);
        v4u o; o.x = pk2(a.x * rstd, a.y * rstd); o.y = pk2(a.z * rstd, a.w * rstd); o.z = pk2(b.x * rstd, b.y * rstd); o.w = pk2(b.z * rstd, b.w * rstd);
        *(v4u*)(dst + (size_t)(row0 + t) * DM + col_off + 8 * lane) = o; }
}
__device__ __forceinline__ void poolfold_item(Frame& F, const float* __restrict__ win, const float* __restrict__ pw, const float* __restrict__ ps, const float* __restrict__ g1, bf16* BtIn, int g, int kb) {
    LAS float* At = (LAS float*)F.lds; LAS float* Bt = (LAS float*)(F.lds + 32768);
    const int k0 = 64 * kb;
#pragma unroll
    for (int i = 0; i < 4; ++i) { const int q = F.tid + 512 * i, row = q >> 5, c4 = q & 31; *(LAS f32x4*)(At + row * 128 + 4 * c4) = *(const f32x4*)(win + (size_t)(k0 + row) * DIN + 128 * g + 4 * c4) * g1[k0 + row]; }
#pragma unroll
    for (int i = 0; i < 8; ++i) { const int q = F.tid + 512 * i, row = q >> 5, c4 = q & 31; *(LAS f32x4*)(Bt + row * 128 + 4 * c4) = *(const f32x4*)(pw + (size_t)(g * 128 + row) * 128 + 4 * c4); }
    __syncthreads();
    const int n = F.tid & 127, kg = F.tid >> 7;
    float acc[16];
#pragma unroll
    for (int i = 0; i < 16; ++i) acc[i] = 0.f;
    for (int j = 0; j < 128; j += 4) {
        const float b0 = Bt[(j + 0) * 128 + n], b1 = Bt[(j + 1) * 128 + n], b2 = Bt[(j + 2) * 128 + n], b3 = Bt[(j + 3) * 128 + n];
#pragma unroll
        for (int i = 0; i < 16; ++i) { const f32x4 a = *(LAS f32x4*)(At + (kg * 16 + i) * 128 + j); acc[i] += a.x * b0 + a.y * b1 + a.z * b2 + a.w * b3; }
    }
    const float sc = ps[128 * g + n];
    v4u o0, o1;
    o0.x = pk2(acc[0] * sc, acc[1] * sc); o0.y = pk2(acc[2] * sc, acc[3] * sc); o0.z = pk2(acc[4] * sc, acc[5] * sc); o0.w = pk2(acc[6] * sc, acc[7] * sc);
    o1.x = pk2(acc[8] * sc, acc[9] * sc); o1.y = pk2(acc[10] * sc, acc[11] * sc); o1.z = pk2(acc[12] * sc, acc[13] * sc); o1.w = pk2(acc[14] * sc, acc[15] * sc);
    bf16* dst = BtIn + (size_t)(128 * g + n) * DM + k0 + kg * 16;
    *(v4u*)dst = o0; *(v4u*)(dst + 8) = o1;
    __syncthreads();
}
__device__ __forceinline__ void filter_item(Frame& F, const float* __restrict__ w1, const float* __restrict__ b1, const float* __restrict__ fr, const float* __restrict__ w2, const float* __restrict__ b2,
                                            const float* __restrict__ w3, const float* __restrict__ b3, const float* __restrict__ hbias, bf16* RF, int fi) {
    LAS float* ZF = (LAS float*)F.lds; LAS float* H1 = ZF + 512; LAS float* H2 = ZF + 1536;
    const int t0 = 16 * fi;
    if (F.tid < 272) { const int tt = F.tid / 17, f = F.tid % 17; const float t = (float)(t0 + tt);
        float v;
        if (f == 0) v = t / 2047.0f;
        else { const int j = (f - 1) & 7; const float band = 1e-4f + (float)j * ((7.0f - 1e-4f) / 7.0f); const float w = (6.283185307179586f * t) / 2048.0f; const float a = band * w; v = (f <= 8) ? __cosf(a) : -__sinf(a); }
        ZF[tt * 17 + f] = v; }
    __syncthreads();
#pragma unroll
    for (int rep = 0; rep < 2; ++rep) { const int p = F.tid + 512 * rep, tt = p >> 6, j = p & 63; float s = b1[j];
        for (int i = 0; i < 17; ++i) s += ZF[tt * 17 + i] * w1[i * 64 + j];
        H1[tt * 64 + j] = __sinf(fr[j] * s); }
    __syncthreads();
#pragma unroll
    for (int rep = 0; rep < 2; ++rep) { const int p = F.tid + 512 * rep, tt = p >> 6, j = p & 63; float s = b2[j];
        for (int i = 0; i < 64; ++i) s += H1[tt * 64 + i] * w2[i * 64 + j];
        H2[tt * 64 + j] = __sinf(fr[j] * s); }
    __syncthreads();
    const int c = F.tid;
    const float delta = -3.0701134573253944f + (float)c * ((-15.350567286626972f + 3.0701134573253944f) / 511.0f);
    const float ad = fabsf(delta);
    bf16* rf = RF + (size_t)c * hy::RFS;
#pragma unroll 1
    for (int dir = 0; dir < 2; ++dir) { const int o = dir * 512 + c; const float bo = b3[o];
        float s[16];
#pragma unroll
        for (int tt = 0; tt < 16; ++tt) s[tt] = bo;
#pragma unroll 1
        for (int ib = 0; ib < 64; ib += 4) { const float w0 = w3[(ib + 0) * 1024 + o], w1 = w3[(ib + 1) * 1024 + o], w2 = w3[(ib + 2) * 1024 + o], w3v = w3[(ib + 3) * 1024 + o];
#pragma unroll
            for (int tt = 0; tt < 16; ++tt) { const f32x4 hv = *(LAS f32x4*)(H2 + tt * 64 + ib); s[tt] += (hv.x * w0 + hv.y * w1) + (hv.z * w2 + hv.w * w3v); } }
#pragma unroll
        for (int tt = 0; tt < 16; ++tt) { const int t = t0 + tt; const float tl = (float)t / 2047.0f; float val = s[tt] * __expf(-tl * ad);
            if (dir == 0) { if (t == 0) val += hbias[c]; rf[2048 - t] = (bf16)f2bf(val); }
            else if (t >= 1) rf[2048 + t] = (bf16)f2bf(val); } }
    if (fi == 0) { rf[0] = 0;
#pragma unroll
        for (int i = 4096; i < hy::RFS; ++i) rf[i] = 0; }
    __syncthreads();
}
__device__ __forceinline__ void unpack4(const v2u w, float (&x)[4]) { x[0] = bflo(w.x); x[1] = bfhi(w.x); x[2] = bflo(w.y); x[3] = bfhi(w.y); }
__device__ __forceinline__ void pair_norm_store(Frame& F, const float (&y)[8][4], bf16* dst, size_t row0, int col_off, int cq) {
    LAS float* part = (LAS float*)F.lds;
    float ss[8];
#pragma unroll
    for (int k = 0; k < 8; ++k) ss[k] = wave_sum((y[k][0] * y[k][0] + y[k][1] * y[k][1]) + (y[k][2] * y[k][2] + y[k][3] * y[k][3]));
    if (F.lane == 0) { *(LAS f32x4*)(part + F.wave * 8) = (f32x4){ss[0], ss[1], ss[2], ss[3]}; *(LAS f32x4*)(part + F.wave * 8 + 4) = (f32x4){ss[4], ss[5], ss[6], ss[7]}; }
    __syncthreads();
    const f32x4 pa = *(LAS f32x4*)(part + (F.wave ^ 1) * 8), pb = *(LAS f32x4*)(part + (F.wave ^ 1) * 8 + 4);
    const float po[8] = {pa.x, pa.y, pa.z, pa.w, pb.x, pb.y, pb.z, pb.w};
#pragma unroll
    for (int k = 0; k < 8; ++k) { const float rstd = 1.0f / sqrtf((ss[k] + po[k]) * (1.f / 512.f) + EPS);
        v2u o; o.x = pk2(y[k][0] * rstd, y[k][1] * rstd); o.y = pk2(y[k][2] * rstd, y[k][3] * rstd);
        *(v2u*)(dst + (row0 + k) * DM + col_off + 4 * cq) = o; }
    __syncthreads();
}
__device__ __forceinline__ void hyprep_item(Frame& F, const bf16* __restrict__ PROJ, const float* __restrict__ cw, const float* __restrict__ cb, bf16* ZT, bf16* X0, int b, int tile) {
    const int tb = F.tid >> 7, cq = F.tid & 127, c0 = 4 * cq, tw = tile * 32 + tb * 8; const size_t rb = (size_t)b * SEQ;
    float z[8][4];
#pragma unroll
    for (int jj = 0; jj < 3; ++jj) { const int j = (jj == 0) ? 1 : (jj == 1) ? 2 : 0; const int cc = 512 * j + c0;
        const f32x4 w0 = *(const f32x4*)(cw + cc), w1 = *(const f32x4*)(cw + 1536 + cc), w2 = *(const f32x4*)(cw + 3072 + cc), bs = *(const f32x4*)(cb + cc);
        float x[10][4];
#pragma unroll
        for (int o = 0; o < 10; ++o) { const int t = tw - 1 + o; const bool ok = (t >= 0) && (t < SEQ); const int tc = ok ? t : tw;
            const v2u w = *(const v2u*)(PROJ + (rb + tc) * DINP + O_HY + cc); unpack4(w, x[o]);
            if (!ok) { x[o][0] = 0.f; x[o][1] = 0.f; x[o][2] = 0.f; x[o][3] = 0.f; } }
        if (jj == 0) {
#pragma unroll
            for (int k = 0; k < 8; ++k)
#pragma unroll
                for (int i = 0; i < 4; ++i) z[k][i] = w0[i] * x[k][i] + w1[i] * x[k + 1][i] + w2[i] * x[k + 2][i] + bs[i];
        } else if (jj == 1) {
#pragma unroll
            for (int k = 0; k < 8; ++k)
#pragma unroll
                for (int i = 0; i < 4; ++i) z[k][i] *= w0[i] * x[k][i] + w1[i] * x[k + 1][i] + w2[i] * x[k + 2][i] + bs[i];
#pragma unroll
            for (int i = 0; i < 4; ++i) { v4u o; o.x = pk2(z[0][i], z[1][i]); o.y = pk2(z[2][i], z[3][i]); o.z = pk2(z[4][i], z[5][i]); o.w = pk2(z[6][i], z[7][i]);
                *(v4u*)(ZT + ((size_t)(c0 + i) * NSEQ + b) * SEQ + tw) = o; }
        } else {
#pragma unroll
            for (int k = 0; k < 8; ++k) { float u0[4];
#pragma unroll
                for (int i = 0; i < 4; ++i) u0[i] = w0[i] * x[k][i] + w1[i] * x[k + 1][i] + w2[i] * x[k + 2][i] + bs[i];
                v2u o; o.x = pk2(u0[0], u0[1]); o.y = pk2(u0[2], u0[3]); *(v2u*)(X0 + (rb + tw + k) * HYC + c0) = o; }
        }
    }
}
__device__ __forceinline__ void pool_item(Frame& F, const bf16* __restrict__ PROJ, bf16* MIXED, int b, int tile) {
    const int tb = F.tid >> 7, cq = F.tid & 127, c0 = 4 * cq, g = cq >> 5, half = 1 << g, tw = tile * 32 + tb * 8; const size_t rb = (size_t)b * SEQ;
    float x[23][4];
#pragma unroll
    for (int o = 0; o < 23; ++o) { const int t = tw - 8 + o; const bool ok = (t >= 0) && (t < SEQ); const int tc = ok ? t : tw;
        const v2u w = *(const v2u*)(PROJ + (rb + tc) * DINP + c0); unpack4(w, x[o]);
        if (!ok) { x[o][0] = 0.f; x[o][1] = 0.f; x[o][2] = 0.f; x[o][3] = 0.f; } }
    float y[8][4];
#pragma unroll
    for (int k = 0; k < 8; ++k) { const int oc = 8 + k, t = tw + k; const int lo = (t - half > 0) ? t - half : 0, hi = (t + half < SEQ) ? t + half : SEQ; const float inv = 1.0f / (float)(hi - lo);
#pragma unroll
        for (int i = 0; i < 4; ++i) {
            const float w1 = x[oc - 1][i] + x[oc][i];
            const float w2 = w1 + (x[oc - 2][i] + x[oc + 1][i]);
            const float w4 = w2 + ((x[oc - 4][i] + x[oc - 3][i]) + (x[oc + 2][i] + x[oc + 3][i]));
            const float w8 = w4 + (((x[oc - 8][i] + x[oc - 7][i]) + (x[oc - 6][i] + x[oc - 5][i])) + ((x[oc + 4][i] + x[oc + 5][i]) + (x[oc + 6][i] + x[oc + 7][i])));
            const float S = (g == 0) ? w1 : (g == 1) ? w2 : (g == 2) ? w4 : w8;
            y[k][i] = S * inv - x[oc][i]; } }
    pair_norm_store(F, y, MIXED, rb + tw, 0, cq);
}
__device__ __forceinline__ void hyfin_item(Frame& F, const bf16* __restrict__ YC, const bf16* __restrict__ X0, bf16* MIXED, int b, int tile) {
    const int tb = F.tid >> 7, cq = F.tid & 127, c0 = 4 * cq, tw = tile * 32 + tb * 8; const size_t rb = (size_t)b * SEQ;
    float yc[4][8], y[8][4];
#pragma unroll
    for (int i = 0; i < 4; ++i) { const v4u v = *(const v4u*)(YC + ((size_t)(c0 + i) * NSEQ + b) * SEQ + tw);
        yc[i][0] = bflo(v.x); yc[i][1] = bfhi(v.x); yc[i][2] = bflo(v.y); yc[i][3] = bfhi(v.y); yc[i][4] = bflo(v.z); yc[i][5] = bfhi(v.z); yc[i][6] = bflo(v.w); yc[i][7] = bfhi(v.w); }
#pragma unroll
    for (int k = 0; k < 8; ++k) { float xv[4]; unpack4(*(const v2u*)(X0 + (rb + tw + k) * HYC + c0), xv);
#pragma unroll
        for (int i = 0; i < 4; ++i) y[k][i] = yc[i][k] * xv[i]; }
    pair_norm_store(F, y, MIXED, rb + tw, 1536, cq);
}
struct PrepGains { float q[3][8], k[3][8]; };
__device__ __forceinline__ void load8(const float* p, float (&o)[8]) { const f32x4 a = *(const f32x4*)p, b = *(const f32x4*)(p + 4); o[0] = a.x; o[1] = a.y; o[2] = a.z; o[3] = a.w; o[4] = b.x; o[5] = b.y; o[6] = b.z; o[7] = b.w; }
__device__ __forceinline__ void unpack8(const v4u w, float (&x)[8]) { x[0] = bflo(w.x); x[1] = bfhi(w.x); x[2] = bflo(w.y); x[3] = bfhi(w.y); x[4] = bflo(w.z); x[5] = bfhi(w.z); x[6] = bflo(w.w); x[7] = bfhi(w.w); }
__device__ __forceinline__ v4u pack8(const float (&x)[8]) { v4u o; o.x = pk2(x[0], x[1]); o.y = pk2(x[2], x[3]); o.z = pk2(x[4], x[5]); o.w = pk2(x[6], x[7]); return o; }
__device__ __forceinline__ float ssq8(const float (&x)[8]) { return ((x[0] * x[0] + x[1] * x[1]) + (x[2] * x[2] + x[3] * x[3])) + ((x[4] * x[4] + x[5] * x[5]) + (x[6] * x[6] + x[7] * x[7])); }
__device__ __forceinline__ float sum8lanes(float v) { v += __shfl_xor(v, 1); v += __shfl_xor(v, 2); v += __shfl_xor(v, 4); return v; }
__device__ __forceinline__ void prep_row(const bf16* __restrict__ PROJ, bf16* Q, bf16* KV, const PrepGains& G, const float* __restrict__ ROPE, int m, int lane) {
    const int h = lane >> 3, sub = lane & 7;
    const bf16* pr = PROJ + (size_t)m * DINP; bf16* qr = Q + (size_t)m * NQ + 192 * h + 8 * sub; bf16* kr = KV + (size_t)m * NKVP + KVHS * h + 8 * sub;
    const v4u cqv = *(const v4u*)(pr + O_CQ + 8 * lane); const v4u ckv = *(const v4u*)(pr + O_CKV + 8 * (lane & 31)); const v4u pev = *(const v4u*)(pr + O_KPE + 8 * sub);
    const v4u q0 = *(const v4u*)(qr), q1 = *(const v4u*)(qr + 64), q2 = *(const v4u*)(qr + 128);
    const v4u k0 = *(const v4u*)(kr), k1 = *(const v4u*)(kr + 64), v0 = *(const v4u*)(kr + 192), v1 = *(const v4u*)(kr + 256);
    float cs[8], sn[8]; { const float* rp = ROPE + (size_t)(m & (SEQ - 1)) * 64 + 8 * (sub & 3); load8(rp, cs); load8(rp + 32, sn); }
    float t[8];
    unpack8(cqv, t); const float rq = 1.0f / sqrtf(wave_sum(ssq8(t)) * (1.f / 512.f) + EPS);
    unpack8(ckv, t); const float rkv = 1.0f / sqrtf(wave_sum(lane < 32 ? ssq8(t) : 0.f) * (1.f / 256.f) + EPS);
    const float sg = (sub < 4) ? -1.f : 1.f;
    { float a0[8], a1[8], a2[8]; unpack8(q0, a0); unpack8(q1, a1); unpack8(q2, a2);
      const float ss = sum8lanes(ssq8(a0) + ssq8(a1) + ssq8(a2)) * (rq * rq);
      const float sc = rq / sqrtf(ss * (1.f / 192.f) + EPS);
      float r[8], o[8];
#pragma unroll
      for (int i = 0; i < 8; ++i) { a0[i] *= sc * G.q[0][i]; a1[i] *= sc * G.q[1][i]; r[i] = a2[i] * sc * G.q[2][i]; }
#pragma unroll
      for (int i = 0; i < 8; ++i) { const float rp = __shfl_xor(r[i], 4); o[i] = r[i] * cs[i] + sg * rp * sn[i]; }
      *(v4u*)(qr) = pack8(a0); *(v4u*)(qr + 64) = pack8(a1); *(v4u*)(qr + 128) = pack8(o); }
    { float a0[8], a1[8], pe[8], b0[8], b1[8]; unpack8(k0, a0); unpack8(k1, a1); unpack8(pev, pe); unpack8(v0, b0); unpack8(v1, b1);
      const float ss = sum8lanes((ssq8(a0) + ssq8(a1)) * (rkv * rkv) + ssq8(pe));
      const float sk = 1.0f / sqrtf(ss * (1.f / 192.f) + EPS);
      float r[8], o[8];
#pragma unroll
      for (int i = 0; i < 8; ++i) { a0[i] *= rkv * sk * G.k[0][i]; a1[i] *= rkv * sk * G.k[1][i]; r[i] = pe[i] * sk * G.k[2][i]; b0[i] *= rkv; b1[i] *= rkv; }
#pragma unroll
      for (int i = 0; i < 8; ++i) { const float rp = __shfl_xor(r[i], 4); o[i] = r[i] * cs[i] + sg * rp * sn[i]; }
      *(v4u*)(kr) = pack8(a0); *(v4u*)(kr + 64) = pack8(a1); *(v4u*)(kr + 128) = pack8(o); *(v4u*)(kr + 192) = pack8(b0); *(v4u*)(kr + 256) = pack8(b1); }
}
__device__ __forceinline__ void attn_norm_row(bf16* MIXED, int m, int lane) {
    v4u* p = (v4u*)(MIXED + (size_t)m * DM + 512 + 16 * lane); v4u a = p[0], b = p[1];
    unsigned w[8] = {a.x, a.y, a.z, a.w, b.x, b.y, b.z, b.w}; float s = 0.f;
#pragma unroll
    for (int i = 0; i < 8; ++i) { const float x = bflo(w[i]), y = bfhi(w[i]); s += x * x + y * y; }
    const float rstd = 1.0f / sqrtf(wave_sum(s) * (1.f / 1024.f) + EPS);
#pragma unroll
    for (int i = 0; i < 8; ++i) w[i] = pk2(bflo(w[i]) * rstd, bfhi(w[i]) * rstd);
    a.x = w[0]; a.y = w[1]; a.z = w[2]; a.w = w[3]; b.x = w[4]; b.y = w[5]; b.z = w[6]; b.w = w[7]; p[0] = a; p[1] = b;
}

#define DEFPTRS() unsigned char* ws = args.ws; \
    bf16* BtIn = (bf16*)(ws + WS_BTIN); bf16* BtUq = (bf16*)(ws + WS_BTUQ); bf16* BtKv = (bf16*)(ws + WS_BTKV); bf16* BtOut = (bf16*)(ws + WS_BTOUT); bf16* BtUp = (bf16*)(ws + WS_BTUP); bf16* BtDn = (bf16*)(ws + WS_BTDN); \
    bf16* RF = (bf16*)(ws + WS_RF); bf16* Hb = (bf16*)(ws + WS_H); bf16* PROJ = (bf16*)(ws + WS_PROJ); bf16* Qb = (bf16*)(ws + WS_Q); bf16* KVb = (bf16*)(ws + WS_KV); \
    bf16* ZT = (bf16*)(ws + WS_ZT); bf16* X0 = (bf16*)(ws + WS_X0); bf16* YC = (bf16*)(ws + WS_YC); float* EDGE = (float*)(ws + WS_EDGE); float* ROPE = (float*)(ws + WS_ROPE); float* SSQP = (float*)(ws + WS_SSQP); float* RSTD = (float*)(ws + WS_RSTD); bf16* XB2 = (bf16*)(ws + WS_XB2); bf16* ACT = (bf16*)(ws + WS_ACT); \
    bf16* XA = (bf16*)args.out; \
    (void)BtIn; (void)BtUq; (void)BtKv; (void)BtOut; (void)BtUp; (void)BtDn; (void)RF; (void)Hb; (void)PROJ; (void)Qb; (void)KVb; (void)ZT; (void)X0; (void)YC; (void)EDGE; (void)ROPE; (void)SSQP; (void)RSTD; (void)XB2; (void)ACT; (void)XA
__global__ void __launch_bounds__(NWAVES * 64, 2) fwd(Args args) {
    extern __shared__ __attribute__((aligned(16))) unsigned char lds_raw[];
    Frame F;
    F.lds = (LAS unsigned char*)lds_raw;
    F.tid = threadIdx.x; F.lane = F.tid & 63; F.wave = __builtin_amdgcn_readfirstlane(F.tid >> 6);
    F.G = gridDim.x; { const int bx = blockIdx.x; F.vcu = (F.G % 8 == 0) ? (bx % 8) * (F.G / 8) + bx / 8 : bx; }
    volatile LAS unsigned* MISC = (volatile LAS unsigned*)(F.lds + MISC_OFF);
    if (F.tid < 64) MISC[F.tid] = 0u;
    __syncthreads();
    unsigned* ctl = (unsigned*)(args.ws + WS_CTL);
    const int lo = args.ph_lo, hi = args.ph_hi;
    XcdBarrier bar; bar.bar = ctl + CW_BAR; bar.x = 0; bar.st = MISC + 8;
    if (hi - lo > 1) bar = xcd_barrier_post(ctl + CW_BAR, MISC + 8);
    float* out = args.out;

#pragma unroll 1
    for (int layer = 0; layer < DEPTH; ++layer) {
        const int pb = layer * NPH;
        if (pb + NPH <= lo || pb >= hi) continue;
#define IN(k) (lo <= pb + (k) && pb + (k) < hi)
#define ENTER() DEFPTRS(); F.tid = opq(threadIdx.x); F.lane = F.tid & 63; F.wave = __builtin_amdgcn_readfirstlane(F.tid >> 6); const int gw = F.vcu * NWAVES + F.wave, NGW = F.G * NWAVES, wg = F.vcu; const size_t gtid = (size_t)wg * 512 + F.tid, gthreads = (size_t)F.G * 512; (void)gw; (void)NGW; (void)wg; (void)gtid; (void)gthreads
#define SEAM(k) do { if (pb + (k) + 1 < hi) xcd_barrier(bar); } while (0)

        if (IN(0)) { ENTER();
            const float* win = args.in[I_WIN] + (size_t)layer * DM * DIN; const float* g1 = args.in[I_ANG] + layer * DM;
            for (int it = wg; it < 256; it += F.G) {
                if (it < 128) poolfold_item(F, win, args.in[I_PW] + (size_t)layer * 4 * 128 * 128, args.in[I_PS] + (size_t)layer * 512, g1, BtIn, it >> 5, it & 31);
                else filter_item(F, args.in[I_FW1] + (size_t)layer * 17 * 64, args.in[I_FB1] + layer * 64, args.in[I_FFR] + layer * 64, args.in[I_FW2] + (size_t)layer * 64 * 64, args.in[I_FB2] + layer * 64,
                                 args.in[I_FW3] + (size_t)layer * 64 * 1024, args.in[I_FB3] + layer * 1024, args.in[I_HBIAS] + layer * 512, RF, it - 128);
            }
            LAS float* scr = (LAS float*)(F.lds + F.wave * 8448);
            constexpr int N_IN_ = 74 * 32, N_UQ = 48 * 8, N_KV = 64 * 4, N_OUT = 64 * 32, N_UP = 352 * 32, N_DN = 64 * 88, N_ALL = N_IN_ + N_UQ + N_KV + N_OUT + N_UP + N_DN;
            for (int it = gw; it < N_ALL; it += NGW) {
                int r = it;
                if (r < N_IN_) { const int nb = 16 + r / 32, kb = r % 32; cvt_item(win, DIN, DM, BtIn, 32 * nb, 32 * nb, 64 * kb, g1, scr, F.lane); continue; } r -= N_IN_;
                if (r < N_UQ) { const int nb = r / 8, kb = r % 8; cvt_item(args.in[I_WUQ] + (size_t)layer * 512 * NQ, NQ, 512, BtUq, 32 * nb, 32 * nb, 64 * kb, args.in[I_QNG] + layer * 512, scr, F.lane); continue; } r -= N_UQ;
                if (r < N_KV) { const int nb = r / 4, kb = r % 4, h = nb >> 3, wb = nb & 7; const int dst = KVHS * h + (wb < 4 ? 32 * wb : 192 + 32 * (wb - 4));
                    cvt_item(args.in[I_WUKV] + (size_t)layer * 256 * 2048, 2048, 256, BtKv, dst, 32 * nb, 64 * kb, args.in[I_KVNG] + layer * 256, scr, F.lane); continue; } r -= N_KV;
                if (r < N_OUT) { const int nb = r / 32, kb = r % 32; cvt_item(args.in[I_WOUT] + (size_t)layer * DM * DM, DM, DM, BtOut, 32 * nb, 32 * nb, 64 * kb, args.in[I_GNG] + layer * DM, scr, F.lane); continue; } r -= N_OUT;
                if (r < N_UP) { const int nb = r / 32, kb = r % 32; const int nv = (nb < 176) ? nb : nb - 176; const int dst = 256 * (nv >> 2) + 64 * (nv & 3) + (nb < 176 ? 0 : 32);
                    cvt_item(args.in[I_WUP] + (size_t)layer * DM * NUP, NUP, DM, BtUp, dst, 32 * nb, 64 * kb, args.in[I_FNG] + layer * DM, scr, F.lane); continue; } r -= N_UP;
                { const int nb = r / 88, kb = r % 88; cvt_item(args.in[I_WDN] + (size_t)layer * DFF * DM, DM, DFF, BtDn, 32 * nb, 32 * nb, 64 * kb, nullptr, scr, F.lane); }
            }
            { unsigned zz = 0u; asm volatile("" : "+v"(zz)); v4u z = {zz, zz, zz, zz};
              for (size_t i = gtid; i < (size_t)(DINP - DIN) * DM / 8; i += gthreads) *(v4u*)(BtIn + (size_t)DIN * DM + i * 8) = z;
              for (size_t i = gtid; i < (size_t)NH * 64 * 256 / 8; i += gthreads) { const int h = (int)(i / (64 * 256 / 8)), q = (int)(i % (64 * 256 / 8)); *(v4u*)(BtKv + (size_t)(KVHS * h + 128) * 256 + (size_t)q * 8) = z; } }
            if (layer == 0) for (size_t i = gtid; i < (size_t)SEQ * 32; i += gthreads) { const int pos = (int)(i >> 5), ri = (int)(i & 31);
                const float freq = exp2f(-(float)ri * (13.287712379549449f / 32.0f)); float sn, cs; sincosf((float)pos * freq, &sn, &cs); ROPE[pos * 64 + ri] = cs; ROPE[pos * 64 + 32 + ri] = sn; }
            if (layer == 0) { for (int m = gw; m < M; m += NGW) xb_row(m < MP ? args.in[I_XP] + (size_t)m * DM : args.in[I_XS] + (size_t)(m - MP) * DM, XA + (size_t)m * DM, RSTD + m, F.lane); }
            else rstd_from_partials(SSQP, RSTD, gtid, gthreads);
            SEAM(0);
        }
        if (IN(1)) { ENTER();
            pg8::Gemm g{XA, BtIn, M, DINP, DM, DM}; pg8::StaticOrder S; S.init(M, DINP, F.G, (int)blockIdx.x);
            pg8::EpiBf16 E{PROJ, DINP, RSTD};
            pg8::gemm_phase<pg8::EpiBf16, pg8::StaticOrder>(F.lds, g, S, E);
            SEAM(1);
        }
        if (IN(2)) { ENTER();
            { pg8::Gemm g{PROJ + O_CQ, BtUq, M, NQ, 512, DINP}; pg8::StaticOrder S; S.init(M, NQ, F.G, (int)blockIdx.x); pg8::EpiBf16 E{Qb, NQ, nullptr};
              pg8::gemm_phase<pg8::EpiBf16, pg8::StaticOrder>(F.lds, g, S, E); }
            { pg8::Gemm g{PROJ + O_CKV, BtKv, M, NKVP, 256, DINP}; pg8::StaticOrder S; S.init(M, NKVP, F.G, (int)blockIdx.x); pg8::EpiBf16 E{KVb, NKVP, nullptr};
              pg8::gemm_phase<pg8::EpiBf16, pg8::StaticOrder>(F.lds, g, S, E); }
            const float* hcw = args.in[I_HCW] + (size_t)layer * 3 * 1536; const float* hcb = args.in[I_HCB] + layer * 1536;
            for (int it = wg; it < 2 * NSEQ * 64; it += F.G) {
                if (it < NSEQ * 64) hyprep_item(F, PROJ, hcw, hcb, ZT, X0, it >> 6, it & 63);
                else pool_item(F, PROJ, Hb, (it - NSEQ * 64) >> 6, it & 63);
            }
            SEAM(2);
        }
        if (IN(3)) { ENTER();
            for (int u = wg; u < 2 * HYC; u += F.G) hy::conv_unit(F.lds, ZT, RF, YC, u >> 1, u & 1);
            const float* qhg = args.in[I_QHG] + layer * 192; const float* khg = args.in[I_KHG] + layer * 192;
            PrepGains PG; { const int sub = F.lane & 7;
#pragma unroll
                for (int i = 0; i < 3; ++i) { load8(qhg + 64 * i + 8 * sub, PG.q[i]); load8(khg + 64 * i + 8 * sub, PG.k[i]); } }
            for (int m = gw; m < M; m += NGW) prep_row(PROJ, Qb, KVb, PG, ROPE, m, F.lane);
            SEAM(3);
        }
        if (IN(4)) { ENTER();
            for (int i = 0; i * F.G < NSEQ * NH * 8; ++i) {
                int p, qb; const int c = (int)blockIdx.x;
                if (F.G == 256) { p = i * 32 + (c & 7) * 4 + (c >> 6); qb = (c >> 3) & 7; } else { const int Lq = i * F.G + c; p = Lq >> 3; qb = Lq & 7; }
                if (p < NSEQ * NH) { const int b = p >> 3, h = p & 7;
                    at::attn_unit(Qb + (size_t)(b * SEQ + qb * 256) * NQ + h * 192, KVb + (size_t)(b * SEQ) * NKVP + h * KVHS, KVb + (size_t)(b * SEQ) * NKVP + h * KVHS + 192,
                                  Hb + (size_t)(b * SEQ + qb * 256) * DM + 512 + h * 128, SEQ, (char*)lds_raw); }
            }
            for (int it = wg; it < NSEQ * 64; it += F.G) hyfin_item(F, YC, X0, Hb, it >> 6, it & 63);
            SEAM(4);
        }
        if (IN(5)) { ENTER();
            for (int m = gw; m < M; m += NGW) attn_norm_row(Hb, m, F.lane);
            SEAM(5);
        }
        if (IN(6)) { ENTER();
            pg8::Gemm g{Hb, BtOut, M, DM, DM, DM}; pg8::StaticOrder S; S.init(M, DM, F.G, (int)blockIdx.x);
            pg8::EpiResid16 E{XA, XB2, out, DM, SSQP, 0};
            pg8::gemm_phase<pg8::EpiResid16, pg8::StaticOrder>(F.lds, g, S, E);
            SEAM(6);
        }
        if (IN(7)) { ENTER();
            rstd_from_partials(SSQP, RSTD, gtid, gthreads);
            SEAM(7);
        }
        if (IN(8)) { ENTER();
            pg8::Gemm g{XB2, BtUp, M, NUP, DM, DM}; pg8::StaticOrder S; S.init(M, NUP, F.G, (int)blockIdx.x);
            pg8::EpiGate E{ACT, DFF, EDGE, args.in[I_FCW] + (size_t)layer * 3 * DFF, args.in[I_FCB] + layer * DFF, DFF, (LAS float*)(F.lds + HALO_OFF), RSTD};
            pg8::gemm_phase<pg8::EpiGate, pg8::StaticOrder>(F.lds, g, S, E);
            SEAM(8);
        }
        if (IN(9)) { ENTER();
            const float* fcw = args.in[I_FCW] + (size_t)layer * 3 * DFF;
            for (size_t i = gtid; i < (size_t)(M / 256) * 2 * (DFF / 4); i += gthreads) {
                const int ri = (int)(i / (DFF / 4)), c4 = (int)(i % (DFF / 4)) * 4, pm = ri >> 1, e = ri & 1;
                const float* eb = EDGE + (size_t)(ri * 3) * DFF + c4;
                f32x4 pre = *(const f32x4*)(eb + DFF); const f32x4 v = *(const f32x4*)(eb + 2 * DFF);
                if (e == 0 && (pm & 7) != 0) { const f32x4 gp = *(const f32x4*)(EDGE + (size_t)(((pm - 1) * 2 + 1) * 3) * DFF + c4); pre += *(const f32x4*)(fcw + c4) * gp; }
                if (e == 1 && (pm & 7) != 7) { const f32x4 gn = *(const f32x4*)(EDGE + (size_t)(((pm + 1) * 2 + 0) * 3) * DFF + c4); pre += *(const f32x4*)(fcw + 2 * DFF + c4) * gn; }
                v2u o; o.x = pk2(pg8::silu_f(pre.x) * v.x, pg8::silu_f(pre.y) * v.y); o.y = pk2(pg8::silu_f(pre.z) * v.z, pg8::silu_f(pre.w) * v.w);
                *(v2u*)(ACT + (size_t)(pm * 256 + (e ? 255 : 0)) * DFF + c4) = o;
            }
            SEAM(9);
        }
        if (IN(10)) { ENTER();
            pg8::Gemm g{ACT, BtDn, M, DM, DFF, DFF}; pg8::StaticOrder S; S.init(M, DM, F.G, (int)blockIdx.x);
            pg8::EpiResid16 E{XB2, XA, out, DM, SSQP, (layer + 1 < DEPTH) ? 0 : 1};
            pg8::gemm_phase<pg8::EpiResid16, pg8::StaticOrder>(F.lds, g, S, E);
            SEAM(10);
        }
#undef IN
#undef ENTER
#undef SEAM
    }
}

extern "C" void kernel_launch(void* const* d_in, const int* in_sizes, int n_in, void* d_out, int out_size, void* d_ws, size_t ws_size, hipStream_t stream) {
    static int grid = 0;
    if (grid == 0) {
        if (n_in != N_IN || out_size != M * DM || ws_size < WS_END) { fprintf(stderr, "kernel_launch: unexpected shapes (n_in %d, out %d, ws %zu, need %zu)\n", n_in, out_size, ws_size, (size_t)WS_END); grid = -1; return; }
        int dev = 0, cus = 0;
        if (hipGetDevice(&dev) != hipSuccess || hipDeviceGetAttribute(&cus, hipDeviceAttributeMultiprocessorCount, dev) != hipSuccess) { grid = -1; return; }
        if (hipFuncSetAttribute((const void*)fwd, hipFuncAttributeMaxDynamicSharedMemorySize, LDS_BYTES) != hipSuccess) { fprintf(stderr, "kernel_launch: hipFuncSetAttribute failed\n"); grid = -1; return; }
        int per_cu = 0;
        if (hipOccupancyMaxActiveBlocksPerMultiprocessor(&per_cu, (const void*)fwd, NWAVES * 64, LDS_BYTES) != hipSuccess || per_cu < 1) fprintf(stderr, "kernel_launch: occupancy query reports %d\n", per_cu);
        (void)hipGetLastError();
        grid = cus;
    }
    if (grid < 0) return;
    (void)hipMemsetAsync((char*)d_ws + WS_CTL, 0, CTL_BYTES, stream);
    Args a{};
    for (int i = 0; i < N_IN; ++i) a.in[i] = (const float*)d_in[i];
    a.out = (float*)d_out; a.ws = (unsigned char*)d_ws;
#if MK_ONE_LAUNCH
    a.ph_lo = 0; a.ph_hi = DEPTH * NPH;
    hipLaunchKernelGGL(fwd, dim3(grid), dim3(NWAVES * 64), LDS_BYTES, stream, a);
#else
    for (int p = 0; p < DEPTH * NPH; ++p) { a.ph_lo = p; a.ph_hi = p + 1; hipLaunchKernelGGL(fwd, dim3(grid), dim3(NWAVES * 64), LDS_BYTES, stream, a); }
#endif
    const hipError_t le = hipPeekAtLastError();
    if (le != hipSuccess) fprintf(stderr, "kernel_launch: launch failed: %s\n", hipGetErrorName(le));
}
```

```cpp
#include <hip/hip_runtime.h>
#include <cstdio>
#include <cstdint>
__device__ __forceinline__ int opq(int x) { asm volatile("" : "+v"(x)); return x; }
namespace pg8 {
#define PG8_LAS __attribute__((address_space(3)))
typedef unsigned short bf16_t;
typedef short bf16x8 __attribute__((ext_vector_type(8)));
typedef float f32x4 __attribute__((ext_vector_type(4)));
typedef unsigned u32x4 __attribute__((ext_vector_type(4)));
constexpr int BM = 256, BK = 64, HALF = 128, HTB = HALF * BK * 2  , STAGE_BYTES = 8 * HTB, NXCD = 8, WGM = 8;

__host__ __device__ __forceinline__ int lds_byte(int r, int c) { const int st = (r >> 4) * 2 + (c >> 5), rr = r & 15, cc = c & 31, ob = rr * 64 + cc * 2; return st * 1024 + (ob ^ (((ob >> 9) & 1) << 5)); }
__host__ __device__ __forceinline__ void stage_rc(int b, int& R, int& C) { const int st = b / 1024, sb = b % 1024, swz = sb ^ (((sb >> 9) & 1) << 5); R = (st >> 1) * 16 + swz / 64; C = (st & 1) * 32 + (swz % 64) / 2; }
__host__ __device__ __forceinline__ int perm32(int rho) { const int n = rho >> 4, i = rho & 15; return 8 * (i >> 2) + 4 * n + (i & 3); }

struct Unit { int pm, pn; };
struct Gemm { const bf16_t* A; const bf16_t* Bt; int M, N, K, lda; };

struct StaticOrder {
    int nM, nN, nwg, G, c;
    __host__ __device__ void init(int M, int N, int G_, int c_) { nM = M / BM; nN = N / BM; nwg = nM * nN; G = G_; c = c_; }
    __host__ __device__ bool next(int i, Unit& u) const {
        const long L = (long)i * G + c; if (L >= nwg) return false;
        int wgid = (int)L; { const int q = nwg / NXCD, r = nwg % NXCD, xcd = wgid % NXCD, off = wgid / NXCD; wgid = (xcd < r ? xcd * (q + 1) : r * (q + 1) + (xcd - r) * q) + off; }
        const int nig = WGM * nN, gid = wgid / nig, fm = gid * WGM, gsz = (nM - fm) < WGM ? (nM - fm) : WGM;
        u.pm = fm + ((wgid % nig) % gsz); u.pn = (wgid % nig) / gsz; return true;
    }
    __device__ __forceinline__ void a_ready(const Unit&) const {}
    __device__ __forceinline__ void done(const Unit&) const {}
};

__device__ __forceinline__ unsigned cvt_pk_bf16(float lo, float hi) { unsigned r; asm volatile("v_cvt_pk_bf16_f32 %0, %1, %2" : "=v"(r) : "v"(lo), "v"(hi)); return r; }

__device__ __forceinline__ float dpp_ror1(float v) { return __builtin_bit_cast(float, __builtin_amdgcn_update_dpp(0, __builtin_bit_cast(int, v), 0x121, 0xF, 0xF, false)); }
__device__ __forceinline__ float dpp_ror15(float v) { return __builtin_bit_cast(float, __builtin_amdgcn_update_dpp(0, __builtin_bit_cast(int, v), 0x12F, 0xF, 0xF, false)); }
__device__ __forceinline__ unsigned dpp_swap1(unsigned v) { return (unsigned)__builtin_amdgcn_update_dpp(0, (int)v, 0xB1, 0xF, 0xF, false); }
struct LineOffs { unsigned o0, o1; bool odd; };
__device__ __forceinline__ LineOffs line_offs(unsigned lo, int pitch, int fr) { LineOffs L; L.odd = fr & 1; L.o0 = L.odd ? lo - (unsigned)pitch + 32u : lo; L.o1 = L.odd ? lo + 32u : lo + (unsigned)pitch; return L; }
__device__ __forceinline__ void store_lines(bf16_t* base, const LineOffs& L, u32x4 a, u32x4 b) {
    const u32x4 snd = L.odd ? a : b; u32x4 rcv;
    rcv.x = dpp_swap1(snd.x); rcv.y = dpp_swap1(snd.y); rcv.z = dpp_swap1(snd.z); rcv.w = dpp_swap1(snd.w);
    *(u32x4*)(base + L.o0) = L.odd ? rcv : a;
    *(u32x4*)(base + L.o1) = L.odd ? b : rcv;
}
struct EpiBf16 {
    static constexpr bool PERM = true;
    bf16_t* O; int ldc; const float* rstd;
    __device__ __forceinline__ void operator()(f32x4 (&acc)[2][2][4][2], const Unit& u, int wr, int wc, int fr, int fq) const {
        bf16_t* Ot = O + (size_t)(u.pm * BM) * ldc + u.pn * BM;
        const LineOffs L = line_offs((unsigned)((wr * 64 + fr) * ldc + wc * 64 + 8 * fq), ldc, fr); const int row0 = u.pm * BM + wr * 64 + fr;
        float rsv[8];
#pragma unroll
        for (int i = 0; i < 8; ++i) rsv[i] = rstd ? rstd[row0 + (i >> 2) * HALF + (i & 3) * 16] : 1.0f;
#pragma unroll
        for (int ai = 0; ai < 2; ++ai)
#pragma unroll
            for (int m = 0; m < 4; ++m) { const float rs = rsv[ai * 4 + m];
                u32x4 w[2];
#pragma unroll
                for (int bj = 0; bj < 2; ++bj) { const f32x4 v0 = acc[ai][bj][m][0] * rs, v1 = acc[ai][bj][m][1] * rs;
                    w[bj].x = cvt_pk_bf16(v0[0], v0[1]); w[bj].y = cvt_pk_bf16(v0[2], v0[3]); w[bj].z = cvt_pk_bf16(v1[0], v1[1]); w[bj].w = cvt_pk_bf16(v1[2], v1[3]); }
                store_lines(Ot + (size_t)((ai * HALF + m * 16) * ldc), L, w[0], w[1]);
                asm volatile("" ::: "memory"); }
    }
};
struct EpiResid16 {
    static constexpr bool PERM = true;
    const bf16_t* base; bf16_t* xo; float* out; int ldc; float* ssqp; int f32out;
    __device__ __forceinline__ static void addx(const u32x4 b, const f32x4 a0, const f32x4 a1, f32x4& x0, f32x4& x1) {
        x0[0] = __builtin_bit_cast(float, b.x << 16) + a0[0]; x0[1] = __builtin_bit_cast(float, b.x & 0xffff0000u) + a0[1]; x0[2] = __builtin_bit_cast(float, b.y << 16) + a0[2]; x0[3] = __builtin_bit_cast(float, b.y & 0xffff0000u) + a0[3];
        x1[0] = __builtin_bit_cast(float, b.z << 16) + a1[0]; x1[1] = __builtin_bit_cast(float, b.z & 0xffff0000u) + a1[1]; x1[2] = __builtin_bit_cast(float, b.w << 16) + a1[2]; x1[3] = __builtin_bit_cast(float, b.w & 0xffff0000u) + a1[3]; }
    __device__ __forceinline__ void operator()(f32x4 (&acc)[2][2][4][2], const Unit& u, int wr, int wc, int fr, int fq) const {
        const size_t tb = (size_t)(u.pm * BM) * ldc + u.pn * BM;
        const bf16_t* bs = base + tb;
        const unsigned lo = (unsigned)((wr * 64 + fr) * ldc + wc * 64 + 8 * fq);
        if (f32out != 0) {
            float* op = out + tb;
#pragma unroll
            for (int ai = 0; ai < 2; ++ai)
#pragma unroll
                for (int m = 0; m < 4; ++m) { const unsigned off = lo + (unsigned)((ai * HALF + m * 16) * ldc);
#pragma unroll
                    for (int bj = 0; bj < 2; ++bj) { const u32x4 b = *(const u32x4*)(bs + off + bj * 32); f32x4 x0, x1; addx(b, acc[ai][bj][m][0], acc[ai][bj][m][1], x0, x1);
                        *(f32x4*)(op + off + bj * 32) = x0; *(f32x4*)(op + off + bj * 32 + 4) = x1; }
                    asm volatile("" ::: "memory"); }
            return;
        }
        bf16_t* xp = xo + tb; const LineOffs L = line_offs(lo, ldc, fr);
#pragma unroll
        for (int aim = 0; aim < 4; ++aim) { const int ai = aim >> 1, mp = aim & 1;
            u32x4 bv[2][2];
#pragma unroll
            for (int mm = 0; mm < 2; ++mm)
#pragma unroll
                for (int bj = 0; bj < 2; ++bj) bv[mm][bj] = *(const u32x4*)(bs + lo + (unsigned)((ai * HALF + (2 * mp + mm) * 16) * ldc) + bj * 32);
#pragma unroll
            for (int mm = 0; mm < 2; ++mm) { const int m = 2 * mp + mm; float s = 0.f; u32x4 wv[2];
#pragma unroll
                for (int bj = 0; bj < 2; ++bj) { f32x4 x0, x1; addx(bv[mm][bj], acc[ai][bj][m][0], acc[ai][bj][m][1], x0, x1);
                    wv[bj].x = cvt_pk_bf16(x0[0], x0[1]); wv[bj].y = cvt_pk_bf16(x0[2], x0[3]); wv[bj].z = cvt_pk_bf16(x1[0], x1[1]); wv[bj].w = cvt_pk_bf16(x1[2], x1[3]);
                    s += ((x0[0] * x0[0] + x0[1] * x0[1]) + (x0[2] * x0[2] + x0[3] * x0[3])) + ((x1[0] * x1[0] + x1[1] * x1[1]) + (x1[2] * x1[2] + x1[3] * x1[3])); }
                store_lines(xp + (size_t)((ai * HALF + m * 16) * ldc), L, wv[0], wv[1]);
                s += __shfl_xor(s, 16); s += __shfl_xor(s, 32); if (fq == 0) ssqp[(size_t)(u.pm * BM + wr * 64 + fr + ai * HALF + m * 16) * 32 + u.pn * 4 + wc] = s; }
            asm volatile("" ::: "memory"); }
    }
};
__device__ __forceinline__ float silu_f(float x) { return x * __builtin_amdgcn_rcpf(1.0f + __builtin_amdgcn_exp2f(-1.4426950408889634f * x)); }
struct EpiGate {
    static constexpr bool PERM = true;
    bf16_t* act; int ldact; float* edge; const float* cw; const float* cb; int dff; PG8_LAS float* halo; const float* rstd;
    __device__ __forceinline__ void operator()(f32x4 (&acc)[2][2][4][2], const Unit& u, int wr, int wc, int fr, int fq) const {
        const int lane = fq * 16 + fr; const int colL = wc * 32 + 8 * fq; const int colG = u.pn * HALF + colL;
#pragma unroll
        for (int ai = 0; ai < 2; ++ai)
#pragma unroll
            for (int m = 0; m < 4; ++m) { const float rs = rstd[u.pm * BM + ai * HALF + wr * 64 + m * 16 + fr];
#pragma unroll
                for (int bj = 0; bj < 2; ++bj) { acc[ai][bj][m][0] *= rs; acc[ai][bj][m][1] *= rs; } }
#pragma unroll
        for (int ai = 0; ai < 2; ++ai) { const int q = 2 * ai + wr;
            if (fr == 0) { *(PG8_LAS f32x4*)(halo + (q * 2 + 0) * 128 + colL) = acc[ai][0][0][0]; *(PG8_LAS f32x4*)(halo + (q * 2 + 0) * 128 + colL + 4) = acc[ai][0][0][1]; }
            if (fr == 15) { *(PG8_LAS f32x4*)(halo + (q * 2 + 1) * 128 + colL) = acc[ai][0][3][0]; *(PG8_LAS f32x4*)(halo + (q * 2 + 1) * 128 + colL + 4) = acc[ai][0][3][1]; } }
        asm volatile("s_waitcnt lgkmcnt(0)" ::: "memory"); __builtin_amdgcn_s_barrier(); asm volatile("" ::: "memory");
        bf16_t* actp = act + (size_t)(u.pm * BM) * ldact + colG; const unsigned rlo = (unsigned)((wr * 64 + fr) * ldact);
#pragma unroll
        for (int ai = 0; ai < 2; ++ai) { const int q = 2 * ai + wr;
            typedef unsigned u32x2 __attribute__((ext_vector_type(2)));
            u32x2 pk[4][2];
#pragma unroll
            for (int n = 0; n < 2; ++n) {
                const f32x4 w0 = *(const f32x4*)(cw + colG + 4 * n), w1 = *(const f32x4*)(cw + dff + colG + 4 * n), w2 = *(const f32x4*)(cw + 2 * dff + colG + 4 * n), bb = *(const f32x4*)(cb + colG + 4 * n);
                f32x4 ht = *(PG8_LAS f32x4*)(halo + ((q > 0 ? q - 1 : 0) * 2 + 1) * 128 + colL + 4 * n), hb = *(PG8_LAS f32x4*)(halo + ((q < 3 ? q + 1 : 3) * 2 + 0) * 128 + colL + 4 * n);
                if (q == 0) ht = ht * 0.f; if (q == 3) hb = hb * 0.f;
                f32x4 pre[4];
#pragma unroll
                for (int j = 0; j < 4; ++j) {
                    float g[4], rr[4], rl[4];
#pragma unroll
                    for (int m = 0; m < 4; ++m) { g[m] = acc[ai][0][m][n][j]; rr[m] = dpp_ror1(g[m]); rl[m] = dpp_ror15(g[m]); }
#pragma unroll
                    for (int m = 0; m < 4; ++m) {
                        const float up = (fr > 0) ? rr[m] : (m > 0 ? rr[m > 0 ? m - 1 : 0] : ht[j]);
                        const float dn = (fr < 15) ? rl[m] : (m < 3 ? rl[m < 3 ? m + 1 : 3] : hb[j]);
                        pre[m][j] = w0[j] * up + w1[j] * g[m] + w2[j] * dn + bb[j];
                    }
                }
                if (q == 0 && fr == 0) { float* e = edge + (size_t)((u.pm * 2 + 0) * 3) * dff + colG + 4 * n;
                    *(f32x4*)(e) = acc[ai][0][0][n]; *(f32x4*)(e + dff) = pre[0]; *(f32x4*)(e + 2 * dff) = acc[ai][1][0][n]; }
                if (q == 3 && fr == 15) { float* e = edge + (size_t)((u.pm * 2 + 1) * 3) * dff + colG + 4 * n;
                    *(f32x4*)(e) = acc[ai][0][3][n]; *(f32x4*)(e + dff) = pre[3]; *(f32x4*)(e + 2 * dff) = acc[ai][1][3][n]; }
#pragma unroll
                for (int m = 0; m < 4; ++m) { const f32x4 v = acc[ai][1][m][n];
                    pk[m][n].x = cvt_pk_bf16(silu_f(pre[m][0]) * v[0], silu_f(pre[m][1]) * v[1]); pk[m][n].y = cvt_pk_bf16(silu_f(pre[m][2]) * v[2], silu_f(pre[m][3]) * v[3]); }
            }
#pragma unroll
            for (int m = 0; m < 4; ++m) { u32x4 w; w.x = pk[m][0].x; w.y = pk[m][0].y; w.z = pk[m][1].x; w.w = pk[m][1].y;
                *(u32x4*)(actp + rlo + (unsigned)((ai * HALF + m * 16) * ldact)) = w; }
        }
    }
};

template <class Epi, class Sched>
__device__ __forceinline__ void gemm_phase(PG8_LAS unsigned char* lds, const Gemm g, const Sched& S, const Epi& E) {
    const int tid = opq(threadIdx.x), wid = __builtin_amdgcn_readfirstlane(tid >> 6), lane = tid & 63, wr = wid >> 2, wc = wid & 3, fr = lane & 15, fq = lane >> 4;
    const int K = g.K, nt = K / BK, lda = g.lda;
    unsigned voffA[2], voffB[2];
#pragma unroll
    for (int i = 0; i < 2; ++i) { int R, C; stage_rc(tid * 16 + i * 8192, R, C); const int Rb = Epi::PERM ? (64 * (R >> 5) + perm32(R & 31)) : R;
        voffA[i] = (unsigned)(R * lda + C) * 2u; voffB[i] = (unsigned)(Rb * K + C) * 2u; }
    const size_t kstep = (size_t)(BK * 2);
    const size_t hstepA = (size_t)HALF * lda * 2, hstepB = (size_t)(Epi::PERM ? 32 : HALF) * K * 2;
    const size_t tstepA = 2 * hstepA, tstepB = (size_t)BM * K * 2;
    const unsigned ldsw = (unsigned)wid * 1024u;
    const int aoff = lds_byte(wr * 64 + fr, fq * 8), boff = lds_byte(wc * 32 + fr, fq * 8);
#define PG8_SA(b, h) (((b) * 2 + (h)) * HTB)
#define PG8_SB(b, h) ((4 + (b) * 2 + (h)) * HTB)
#define PG8_STAGE(bufoff, gbase, voff) do { _Pragma("unroll") for (int _i = 0; _i < 2; ++_i) \
        __builtin_amdgcn_global_load_lds((const unsigned*)((const char*)(gbase) + (voff)[_i]), (PG8_LAS unsigned*)(lds + (bufoff) + ldsw + _i * 8192), 16, 0, 0); } while (0)
#define PG8_LDA(dst, b, h) do { _Pragma("unroll") for (int m = 0; m < 4; ++m) _Pragma("unroll") for (int k = 0; k < 2; ++k) dst[m][k] = *(const PG8_LAS bf16x8*)(lds + PG8_SA(b, h) + aoff + m * 2048 + k * 1024); } while (0)
#define PG8_LDB(dst, b, h) do { _Pragma("unroll") for (int n = 0; n < 2; ++n) _Pragma("unroll") for (int k = 0; k < 2; ++k) dst[n][k] = *(const PG8_LAS bf16x8*)(lds + PG8_SB(b, h) + boff + n * 2048 + k * 1024); } while (0)
#define PG8_MMA(ai, bj, At, Bt) do { __builtin_amdgcn_s_setprio(1); _Pragma("unroll") for (int m = 0; m < 4; ++m) _Pragma("unroll") for (int n = 0; n < 2; ++n) _Pragma("unroll") for (int k = 0; k < 2; ++k) \
        acc[ai][bj][m][n] = __builtin_amdgcn_mfma_f32_16x16x32_bf16(Bt[n][k], At[m][k], acc[ai][bj][m][n], 0, 0, 0); __builtin_amdgcn_s_setprio(0); } while (0)
#define PG8_WAIT_V(n) asm volatile("s_waitcnt vmcnt(" #n ")" ::: "memory")
#define PG8_WAIT_L(n) asm volatile("s_waitcnt lgkmcnt(" #n ")" ::: "memory")
#define PG8_BAR __builtin_amdgcn_s_barrier()
#define PG8_SCHED __builtin_amdgcn_sched_barrier(0)
    Unit cur, nxt; int ui = 0;
    if (!S.next(0, cur)) return;
    f32x4 acc[2][2][4][2];
{ float zf = 0.f; asm volatile("" : "+v"(zf));
    #pragma unroll
    for (int a = 0; a < 2; ++a)
#pragma unroll
        for (int b = 0; b < 2; ++b)
#pragma unroll
            for (int m = 0; m < 4; ++m)
#pragma unroll
                for (int n = 0; n < 2; ++n) acc[a][b][m][n] = (f32x4){zf, zf, zf, zf}; }
    bf16x8 At[4][2], B0[2][2], B1[2][2];
    const char* cA = (const char*)g.A + (size_t)cur.pm * tstepA; const char* cB = (const char*)g.Bt + (size_t)cur.pn * tstepB;
    S.a_ready(cur);
    PG8_STAGE(PG8_SB(0, 0), cB, voffB); PG8_STAGE(PG8_SB(0, 1), cB + hstepB, voffB); PG8_STAGE(PG8_SA(0, 0), cA, voffA); PG8_STAGE(PG8_SA(0, 1), cA + hstepA, voffA);
    if (wr == 1) PG8_BAR;
    PG8_WAIT_V(2); PG8_BAR;
    PG8_STAGE(PG8_SB(1, 0), cB + kstep, voffB); PG8_STAGE(PG8_SA(1, 0), cA + kstep, voffA); PG8_STAGE(PG8_SB(1, 1), cB + hstepB + kstep, voffB);
    PG8_WAIT_V(6); PG8_BAR;
    for (;;) {
        const bool has_next = S.next(ui + 1, nxt);
        const char* nA = has_next ? (const char*)g.A + (size_t)nxt.pm * tstepA : cA; const char* nB = has_next ? (const char*)g.Bt + (size_t)nxt.pn * tstepB : cB;
#pragma unroll 1
        for (int t = 0; t < nt; t += 2) {
            const bool last = (t == nt - 2);
            const char* a1 = cA + (size_t)(t + 1) * kstep;
            const char* a2 = last ? nA : cA + (size_t)(t + 2) * kstep; const char* b2 = last ? nB : cB + (size_t)(t + 2) * kstep;
            const char* a3 = a2 + kstep; const char* b3 = b2 + kstep;
            if (last && has_next) S.a_ready(nxt);
            PG8_LDB(B0, 0, 0); PG8_LDB(B1, 0, 1); PG8_SCHED; PG8_LDA(At, 0, 0); PG8_STAGE(PG8_SA(1, 1), a1 + hstepA, voffA);
            PG8_WAIT_V(8); PG8_WAIT_L(0); PG8_BAR; PG8_MMA(0, 0, At, B0); PG8_MMA(0, 1, At, B1); PG8_BAR; PG8_SCHED;
            PG8_LDA(At, 0, 1); PG8_STAGE(PG8_SB(0, 0), b2, voffB); PG8_STAGE(PG8_SB(0, 1), b2 + hstepB, voffB); PG8_STAGE(PG8_SA(0, 0), a2, voffA);
            PG8_WAIT_V(8); PG8_WAIT_L(0); PG8_BAR; PG8_MMA(1, 0, At, B0); PG8_MMA(1, 1, At, B1); PG8_BAR; PG8_SCHED;
            PG8_LDB(B0, 1, 0); PG8_LDB(B1, 1, 1); PG8_SCHED; PG8_LDA(At, 1, 0); PG8_STAGE(PG8_SA(0, 1), a2 + hstepA, voffA);
            PG8_WAIT_V(8); PG8_WAIT_L(0); PG8_BAR; PG8_MMA(0, 0, At, B0); PG8_MMA(0, 1, At, B1); PG8_BAR; PG8_SCHED;
            PG8_LDA(At, 1, 1); PG8_STAGE(PG8_SB(1, 0), b3, voffB); PG8_STAGE(PG8_SB(1, 1), b3 + hstepB, voffB); PG8_STAGE(PG8_SA(1, 0), a3, voffA);
            PG8_WAIT_V(8); PG8_WAIT_L(0); PG8_BAR; PG8_MMA(1, 0, At, B0); PG8_MMA(1, 1, At, B1); PG8_BAR; PG8_SCHED;
        }
        if (wr == 0) PG8_BAR;
        E(acc, cur, wr, wc, fr, fq); S.done(cur);
        if (!has_next) break;
{ float zf = 0.f; asm volatile("" : "+v"(zf));
        #pragma unroll
        for (int a = 0; a < 2; ++a)
#pragma unroll
            for (int b = 0; b < 2; ++b)
#pragma unroll
                for (int m = 0; m < 4; ++m)
#pragma unroll
                    for (int n = 0; n < 2; ++n) acc[a][b][m][n] = (f32x4){zf, zf, zf, zf}; }
        cur = nxt; cA = nA; cB = nB; ++ui;
        if (wr == 1) PG8_BAR;
    }
    PG8_WAIT_V(0);
    PG8_BAR;
#undef PG8_SA
#undef PG8_SB
#undef PG8_STAGE
#undef PG8_LDA
#undef PG8_LDB
#undef PG8_MMA
#undef PG8_WAIT_V
#undef PG8_WAIT_L
#undef PG8_BAR
#undef PG8_SCHED
}
}
namespace at {
using bf16 = unsigned short;
using bf16x8 = __attribute__((ext_vector_type(8))) short;
using s16x4  = __attribute__((ext_vector_type(4))) short;
using f32x16 = __attribute__((ext_vector_type(16))) float;
using u32x4  = __attribute__((ext_vector_type(4))) unsigned;
constexpr int DQK = 192, DV = 128, KVBLK = 64, NW = 8, QBLK = 32;
constexpr float SCALE = 0.07216878364870322f;
constexpr float THR = 8.f;
constexpr int LDQ = 1536, LDK = 2560, LDO = 2048;
constexpr int SHM_V = KVBLK * DV * 2, SHM_K = 12 * 2080;
constexpr int QR_OFF = 2 * SHM_V + 2 * SHM_K + NW * 64 * 4;
constexpr int SHM_ATTN = QR_OFF + NW * 4096;
#define SBAR() __builtin_amdgcn_sched_barrier(0)
constexpr int KPL = 2080;
__host__ __device__ __forceinline__ int k_st(int row, int c) { return (c >> 1) * KPL + row * 32 + (((c & 1) ^ ((row >> 3) & 1)) << 4); }
__host__ __device__ __forceinline__ int k_rd_base(int r32, int hi) { return r32 * 32 + ((hi ^ ((r32 >> 3) & 1)) << 4); }
__device__ __forceinline__ int crow(int r, int hi) { return (r & 3) + 8 * (r >> 2) + 4 * hi; }
__device__ __forceinline__ unsigned cvtpk(float lo, float hi) { unsigned r; asm volatile("v_cvt_pk_bf16_f32 %0, %1, %2" : "=v"(r) : "v"(lo), "v"(hi)); return r; }

__device__ __forceinline__ void partialSM(f32x16& p0, f32x16& p1, float& m_reg, float& mn, float& alpha) {
  constexpr float C = SCALE * 1.4426950408889634f;
  float pmax = p0[0];
#pragma unroll
  for (int r = 1; r < 16; ++r) pmax = fmaxf(pmax, p0[r]);
#pragma unroll
  for (int r = 0; r < 16; ++r) pmax = fmaxf(pmax, p1[r]);
  { auto rr = __builtin_amdgcn_permlane32_swap(__float_as_uint(pmax), __float_as_uint(pmax), false, false);
    pmax = fmaxf(__uint_as_float(rr[0]), __uint_as_float(rr[1])); }
  if (__builtin_expect(__all(pmax - m_reg <= THR / SCALE), 1)) { mn = m_reg; alpha = 1.f; }
  else { mn = fmaxf(m_reg, pmax); alpha = __builtin_amdgcn_exp2f((m_reg - mn) * C); m_reg = mn; }
  float mnC = -mn * C;
#pragma unroll
  for (int r = 0; r < 16; ++r) p0[r] = fmaf(p0[r], C, mnC);
#pragma unroll
  for (int r = 0; r < 16; ++r) p1[r] = fmaf(p1[r], C, mnC);
#pragma unroll
  for (int r = 0; r < 16; ++r) p0[r] = __builtin_amdgcn_exp2f(p0[r]);
}
__device__ __forceinline__ void finishSM(f32x16& p0, f32x16& p1, float alpha, float& l_reg, bf16x8& pa0, bf16x8& pa1, bf16x8& pa2, bf16x8& pa3) {
#pragma unroll
  for (int r = 0; r < 16; ++r) p1[r] = __builtin_amdgcn_exp2f(p1[r]);
  float ps = 0;
#pragma unroll
  for (int r = 0; r < 16; ++r) ps += p0[r];
#pragma unroll
  for (int r = 0; r < 16; ++r) ps += p1[r];
  { auto rr = __builtin_amdgcn_permlane32_swap(__float_as_uint(ps), __float_as_uint(ps), false, false);
    ps = __uint_as_float(rr[0]) + __uint_as_float(rr[1]); }
  l_reg = l_reg * alpha + ps;
#define PK4(P, BASE, OUT) do { unsigned a0 = cvtpk(P[BASE + 0], P[BASE + 1]), a1 = cvtpk(P[BASE + 2], P[BASE + 3]);   \
    unsigned b0 = cvtpk(P[BASE + 4], P[BASE + 5]), b1 = cvtpk(P[BASE + 6], P[BASE + 7]);                              \
    auto r0 = __builtin_amdgcn_permlane32_swap(a0, b0, false, false); auto r1 = __builtin_amdgcn_permlane32_swap(a1, b1, false, false); \
    u32x4 w = {r0[0], r1[0], r0[1], r1[1]}; OUT = *reinterpret_cast<bf16x8*>(&w); } while (0)
  PK4(p0, 0, pa0); PK4(p0, 8, pa1); PK4(p1, 0, pa2); PK4(p1, 8, pa3);
#undef PK4
}
template <int OFF> __device__ __forceinline__ bf16x8 k_read(int kb) {
  bf16x8 r; asm volatile("ds_read_b128 %0, %1 offset:%2" : "=v"(r) : "v"(kb), "i"(OFF) : "memory"); return r;
}
__device__ __forceinline__ void qkt(f32x16& p0, f32x16& p1, int kb, const bf16x8* qr, int qb) {
  p0 = f32x16{}; p1 = f32x16{};
#define QK1(d0) { const bf16x8 b0 = *(const __attribute__((address_space(3))) bf16x8*)(kb + d0 * KPL), b1 = *(const __attribute__((address_space(3))) bf16x8*)(kb + d0 * KPL + 1024); \
    p0 = __builtin_amdgcn_mfma_f32_32x32x16_bf16(b0, qr[d0], p0, 0, 0, 0); p1 = __builtin_amdgcn_mfma_f32_32x32x16_bf16(b1, qr[d0], p1, 0, 0, 0); }
#define QK2(d0) { const bf16x8 b0 = *(const __attribute__((address_space(3))) bf16x8*)(kb + d0 * KPL), b1 = *(const __attribute__((address_space(3))) bf16x8*)(kb + d0 * KPL + 1024); \
    const bf16x8 qf = *(const __attribute__((address_space(3))) bf16x8*)(qb + (d0 - 8) * 1024); \
    p0 = __builtin_amdgcn_mfma_f32_32x32x16_bf16(b0, qf, p0, 0, 0, 0); p1 = __builtin_amdgcn_mfma_f32_32x32x16_bf16(b1, qf, p1, 0, 0, 0); }
  QK1(0) QK1(1) QK1(2) QK1(3) QK1(4) QK1(5) QK1(6) QK1(7) QK2(8) QK2(9) QK2(10) QK2(11)
#undef QK1
#undef QK2
}
__host__ __device__ __forceinline__ int v_st(int k, int c) { const int kk = (k & ~0xC) | ((k & 4) << 1) | ((k & 8) >> 1); return ((kk >> 3) * 4 + (c >> 5)) * 512 + ((kk & 7) * 32 + (c & 31)) * 2; }
__device__ __forceinline__ int v_rd_base(int lane) { return ((lane & 3) << 3) | (((lane >> 2) & 3) << 6) | (((lane >> 4) & 1) << 5) | (((lane >> 5) & 1) << 8); }
constexpr int v_rd_off(int d0, int ks, int half) { return d0 * 512 + ks * 4096 + half * 2048; }
template <int OFF> __device__ __forceinline__ s16x4 tr_read(int vb) {
  s16x4 r; asm volatile("ds_read_b64_tr_b16 %0, %1 offset:%2" : "=&v"(r) : "v"(vb), "i"(OFF) : "memory"); return r;
}
template <int D0> __device__ __forceinline__ void pv_one(f32x16& od, int vb, bf16x8 pa0, bf16x8 pa1, bf16x8 pa2, bf16x8 pa3) {
  const s16x4 l0 = tr_read<v_rd_off(D0, 0, 0)>(vb), h0 = tr_read<v_rd_off(D0, 0, 1)>(vb), l1 = tr_read<v_rd_off(D0, 1, 0)>(vb), h1 = tr_read<v_rd_off(D0, 1, 1)>(vb);
  const s16x4 l2 = tr_read<v_rd_off(D0, 2, 0)>(vb), h2 = tr_read<v_rd_off(D0, 2, 1)>(vb), l3 = tr_read<v_rd_off(D0, 3, 0)>(vb), h3 = tr_read<v_rd_off(D0, 3, 1)>(vb);
  asm volatile("s_waitcnt lgkmcnt(0)" ::: "memory"); SBAR();
#define PK(L, H) (bf16x8){L[0], L[1], L[2], L[3], H[0], H[1], H[2], H[3]}
  od = __builtin_amdgcn_mfma_f32_32x32x16_bf16(pa0, PK(l0, h0), od, 0, 0, 0);
  od = __builtin_amdgcn_mfma_f32_32x32x16_bf16(pa1, PK(l1, h1), od, 0, 0, 0);
  od = __builtin_amdgcn_mfma_f32_32x32x16_bf16(pa2, PK(l2, h2), od, 0, 0, 0);
  od = __builtin_amdgcn_mfma_f32_32x32x16_bf16(pa3, PK(l3, h3), od, 0, 0, 0);
#undef PK
}
__device__ __forceinline__ void pv_d0(f32x16* o, int vb, bf16x8 pa0, bf16x8 pa1, bf16x8 pa2, bf16x8 pa3) {
  pv_one<0>(o[0], vb, pa0, pa1, pa2, pa3); pv_one<1>(o[1], vb, pa0, pa1, pa2, pa3); pv_one<2>(o[2], vb, pa0, pa1, pa2, pa3); pv_one<3>(o[3], vb, pa0, pa1, pa2, pa3);
}

__device__ __forceinline__ void attn_unit(const bf16* __restrict__ Qb, const bf16* __restrict__ Kh, const bf16* __restrict__ Vh, bf16* __restrict__ Ob, int seq, char* lds) {
  const int tid = opq(threadIdx.x), wid = tid >> 6, lane = tid & 63, r32 = lane & 31, hi = lane >> 5;
  char* V_lds = lds; char* K_lds = lds + 2 * SHM_V;
  float* ws = (float*)(lds + 2 * SHM_V + 2 * SHM_K) + wid * 64; float* li_l = ws; float* al_l = ws + 32;
  float m_reg = -1e30f, l_reg = 0; f32x16 o[4] = {}; bf16x8 qr[8];
  const bf16* Qw = Qb + (unsigned)((wid * QBLK + r32) * LDQ + hi * 8);
#pragma unroll
  for (int d0 = 0; d0 < 8; ++d0) qr[d0] = *reinterpret_cast<const bf16x8*>(Qw + d0 * 16);
  const int qb0 = (int)(uintptr_t)lds + QR_OFF + wid * 4096 + k_rd_base(r32, hi);
#pragma unroll
  for (int d0 = 8; d0 < 12; ++d0) *(__attribute__((address_space(3))) bf16x8*)(qb0 + (d0 - 8) * 1024) = *reinterpret_cast<const bf16x8*>(Qw + d0 * 16);
  const int sr = tid >> 4, sc = (tid & 15) * 8, vst0 = v_st(sr, sc), vst1 = v_st(32 + sr, sc);
  unsigned koff[3]; int kst[3];
#pragma unroll
  for (int i = 0; i < 3; ++i) { const int q = tid + 512 * i; koff[i] = (unsigned)((q / 24) * LDK + (q % 24) * 8); kst[i] = k_st(q / 24, q % 24); }
  const unsigned voff0 = (unsigned)(sr * LDK + sc), voff1 = (unsigned)((32 + sr) * LDK + sc);
  const int vb0 = (int)(uintptr_t)V_lds + v_rd_base(lane); const int kb0 = (int)(uintptr_t)K_lds + k_rd_base(r32, hi);
  struct { bf16x8 vs0, vs1, ks0, ks1, ks2; } sr_[1];
#define SLOAD(i, k0) do { const bf16* vt = Vh + (size_t)(k0) * LDK; const bf16* kt = Kh + (size_t)(k0) * LDK; \
    sr_[i].vs0 = *(const bf16x8*)(vt + voff0); sr_[i].vs1 = *(const bf16x8*)(vt + voff1); \
    sr_[i].ks0 = *(const bf16x8*)(kt + koff[0]); sr_[i].ks1 = *(const bf16x8*)(kt + koff[1]); sr_[i].ks2 = *(const bf16x8*)(kt + koff[2]); } while (0)
#define SWRITE(b, i) do { *(bf16x8*)(V_lds + (b) * SHM_V + vst0) = sr_[i].vs0; *(bf16x8*)(V_lds + (b) * SHM_V + vst1) = sr_[i].vs1; \
    *(bf16x8*)(K_lds + (b) * SHM_K + kst[0]) = sr_[i].ks0; *(bf16x8*)(K_lds + (b) * SHM_K + kst[1]) = sr_[i].ks1; *(bf16x8*)(K_lds + (b) * SHM_K + kst[2]) = sr_[i].ks2; } while (0)
#define SWAIT() do { if constexpr (SDEPTH == 2) asm volatile("s_waitcnt vmcnt(5)" ::: "memory"); else asm volatile("s_waitcnt vmcnt(0)" ::: "memory"); } while (0)
#define RESC(a) do { if (__any((a) < 1.f)) { if (hi == 0) al_l[r32] = (a); asm volatile("s_waitcnt lgkmcnt(0)" ::: "memory"); \
    _Pragma("unroll") for (int d = 0; d < 4; ++d) _Pragma("unroll") for (int r = 0; r < 16; ++r) o[d][r] *= al_l[crow(r, hi)]; } } while (0)
  f32x16 pA0, pA1, pB0, pB1; float mnA, mnB, alA, alB; bf16x8 pa0, pa1, pa2, pa3; const int NT = seq / KVBLK;
  SLOAD(0, 0); asm volatile("s_waitcnt vmcnt(0)" ::: "memory"); SWRITE(0, 0); __syncthreads();
  qkt(pA0, pA1, kb0, qr, qb0); partialSM(pA0, pA1, m_reg, mnA, alA);
  SLOAD(0, KVBLK);
  asm volatile("s_waitcnt vmcnt(0)" ::: "memory"); SWRITE(1, 0); __syncthreads();
  for (int j = 1; j + 1 < NT; j += 2) {
    SBAR(); qkt(pB0, pB1, kb0 + SHM_K, qr, qb0);
    finishSM(pA0, pA1, alA, l_reg, pa0, pa1, pa2, pa3); SBAR();
    SLOAD(0, (j + 1) * KVBLK); SBAR();
    pv_d0(o, vb0, pa0, pa1, pa2, pa3); partialSM(pB0, pB1, m_reg, mnB, alB);
    __syncthreads(); asm volatile("s_waitcnt vmcnt(0)" ::: "memory"); SWRITE(0, 0);
    RESC(alB); __syncthreads();
    SBAR(); qkt(pA0, pA1, kb0, qr, qb0);
    finishSM(pB0, pB1, alB, l_reg, pa0, pa1, pa2, pa3); SBAR();
    SLOAD(0, (j + 2) * KVBLK); SBAR();
    pv_d0(o, vb0 + (int)SHM_V, pa0, pa1, pa2, pa3); partialSM(pA0, pA1, m_reg, mnA, alA);
    __syncthreads(); asm volatile("s_waitcnt vmcnt(0)" ::: "memory"); SWRITE(1, 0);
    RESC(alA); __syncthreads();
  }
  SBAR(); qkt(pB0, pB1, kb0 + SHM_K, qr, qb0);
  finishSM(pA0, pA1, alA, l_reg, pa0, pa1, pa2, pa3); SBAR();
  pv_d0(o, vb0, pa0, pa1, pa2, pa3); partialSM(pB0, pB1, m_reg, mnB, alB);
  __syncthreads(); RESC(alB);
  finishSM(pB0, pB1, alB, l_reg, pa0, pa1, pa2, pa3); SBAR();
  pv_d0(o, vb0 + (int)SHM_V, pa0, pa1, pa2, pa3);
  if (hi == 0) li_l[r32] = l_reg; asm volatile("s_waitcnt lgkmcnt(0)" ::: "memory");
  bf16* Ow = Ob + (unsigned)(wid * QBLK * LDO + r32);
#pragma unroll
  for (int r = 0; r < 16; ++r) { const int orow = crow(r, hi); const float rl = __builtin_amdgcn_rcpf(li_l[orow]);
#pragma unroll
    for (int d0 = 0; d0 < 4; ++d0) { const unsigned w = cvtpk(o[d0][r] * rl, 0.f); Ow[(unsigned)(orow * LDO + d0 * 32)] = (bf16)(w & 0xffffu); } }
  __syncthreads();
#undef SLOAD
#undef SWRITE
#undef SWAIT
#undef RESC
}
}
namespace hy {
#define HY_LAS __attribute__((address_space(3)))
typedef unsigned short bf16;
typedef short bf16x8 __attribute__((ext_vector_type(8)));
typedef float f32x16 __attribute__((ext_vector_type(16)));
typedef unsigned u32x2 __attribute__((ext_vector_type(2)));
typedef unsigned u32x4 __attribute__((ext_vector_type(4)));
constexpr int L = 2048, NB = 24, CH = 512;
constexpr int RFS = 4112;
constexpr int ZROW = 4112;
constexpr int ZL_BYTES = NB * ZROW;
constexpr int RCS = 8256;
constexpr int RC_OFF = ZL_BYTES;
constexpr int HY_LDS_BYTES = RC_OFF + 4 * RCS;
__device__ __forceinline__ unsigned cvtpk(float lo, float hi) { unsigned r; asm volatile("v_cvt_pk_bf16_f32 %0, %1, %2" : "=v"(r) : "v"(lo), "v"(hi)); return r; }
__host__ __device__ __forceinline__ int frag_base(int tw, int r, int h) { const int a = (4 - (r & 3)) & 3; return RC_OFF + a * RCS + 2 * (2048 - tw - r + 8 * h - a); }
__host__ __device__ __forceinline__ int zfrag_base(int r, int h) { return (r < NB ? r : NB - 1) * ZROW + 16 * h; }

__device__ __forceinline__ bf16x8 ld_frag(HY_LAS unsigned char* lds, int off) {
    const u32x2 lo = *(const HY_LAS u32x2*)(lds + off), hi = *(const HY_LAS u32x2*)(lds + off + 8);
    u32x4 w = {lo.x, lo.y, hi.x, hi.y}; return *reinterpret_cast<bf16x8*>(&w);
}
__device__ __forceinline__ bf16x8 ld_b128(HY_LAS unsigned char* lds, int off) { return *(const HY_LAS bf16x8*)(lds + off); }

__device__ __forceinline__ void conv_unit(HY_LAS unsigned char* lds, const bf16* __restrict__ ZT, const bf16* __restrict__ RF, bf16* __restrict__ YC, int c, int half) {
    const int tid = opq(threadIdx.x), wid = tid >> 6, lane = tid & 63, r = lane & 31, h = lane >> 5;
    { const u32x4* src = (const u32x4*)(ZT + (size_t)c * NB * L);
#pragma unroll
      for (int i = 0; i < 12; ++i) { const int q = tid + 512 * i; const u32x4 v = src[q]; *(HY_LAS u32x4*)(lds + (q >> 8) * ZROW + (q & 255) * 16) = v; } }
    { const bf16* rf = RF + (size_t)c * RFS;
      for (int ch = tid; ch < RFS / 8; ch += 512) {
          const u32x4 v = *(const u32x4*)(rf + ch * 8); const unsigned w[4] = {v.x, v.y, v.z, v.w};
#pragma unroll
          for (int j = 0; j < 8; ++j) { const unsigned short e = (unsigned short)((w[j >> 1] >> ((j & 1) * 16)) & 0xffffu); const int idx = ch * 8 + j;
#pragma unroll
              for (int a = 0; a < 4; ++a) if (idx - a >= 0) *(HY_LAS unsigned short*)(lds + RC_OFF + a * RCS + 2 * (idx - a)) = e; } } }
    __syncthreads();
    const int tw = half * 1024 + wid * 128;
    const int fb = frag_base(tw, r, h), zb = zfrag_base(r, h);
    f32x16 acc[4] = {};
    bf16x8 S0[2], S1[2], S2[2], S3[2], Bc[2], Bn[2];
#define HY_LDG(S, d) do { S[0] = ld_frag(lds, fb + 64 * (d)); S[1] = ld_frag(lds, fb + 64 * (d) + 32); } while (0)
#define HY_LDB(Bx, n) do { Bx[0] = ld_b128(lds, zb + 64 * (n)); Bx[1] = ld_b128(lds, zb + 64 * (n) + 32); } while (0)
#define HY_MM(i, S, Bx) do { acc[i] = __builtin_amdgcn_mfma_f32_32x32x16_bf16(S[0], Bx[0], acc[i], 0, 0, 0); acc[i] = __builtin_amdgcn_mfma_f32_32x32x16_bf16(S[1], Bx[1], acc[i], 0, 0, 0); } while (0)
#define HY_ITER(n, Sa, Sb, Sc, Sd, Bcur, Bnext) do { HY_LDG(Sa, (n)); if ((n) + 1 < 64) HY_LDB(Bnext, (n) + 1); \
        HY_MM(1, Sb, Bcur); HY_MM(2, Sc, Bcur); HY_MM(3, Sd, Bcur); HY_MM(0, Sa, Bcur); } while (0)
    HY_LDG(S3, -1); HY_LDG(S2, -2); HY_LDG(S1, -3); HY_LDB(Bc, 0);
    for (int n = 0; n < 64; n += 4) {
        HY_ITER(n, S0, S3, S2, S1, Bc, Bn);
        HY_ITER(n + 1, S1, S0, S3, S2, Bn, Bc);
        HY_ITER(n + 2, S2, S1, S0, S3, Bc, Bn);
        HY_ITER(n + 3, S3, S2, S1, S0, Bn, Bc);
    }
#undef HY_LDG
#undef HY_LDB
#undef HY_MM
#undef HY_ITER
    if (r < NB) { bf16* yp = YC + ((size_t)c * NB + r) * L + tw + 4 * h;
#pragma unroll
        for (int i = 0; i < 4; ++i)
#pragma unroll
            for (int q4 = 0; q4 < 4; ++q4) { u32x2 w; w.x = cvtpk(acc[i][4 * q4 + 0], acc[i][4 * q4 + 1]); w.y = cvtpk(acc[i][4 * q4 + 2], acc[i][4 * q4 + 3]);
                *(u32x2*)(yp + 32 * i + 8 * q4) = w; } }
    __syncthreads();
}
}
constexpr int NWAVES = 8;
#ifndef MK_ONE_LAUNCH
#define MK_ONE_LAUNCH 1
#endif
constexpr int DM = 2048, NSEQ = 24, SEQ = 2048, M = NSEQ * SEQ, MP = 8 * SEQ;
constexpr int DEPTH = 4;
constexpr int DIN = 2880, DINP = 3072;
constexpr int O_CQ = 512, O_CKV = 1024, O_KPE = 1280, O_HY = 1344;
constexpr int NH = 8, NQ = 1536, NKVP = 2560, KVHS = 320;
constexpr int DFF = 5632, NUP = 11264, HYC = 512;
constexpr float EPS = 1e-6f;
constexpr int NPH = 11;
constexpr size_t WS_CTL = 0, CTL_BYTES = 1u << 20;
constexpr size_t SZ_BTIN = (size_t)DINP * DM * 2, SZ_BTUQ = (size_t)NQ * 512 * 2, SZ_BTKV = (size_t)NKVP * 256 * 2, SZ_BTOUT = (size_t)DM * DM * 2, SZ_BTUP = (size_t)NUP * DM * 2, SZ_BTDN = (size_t)DM * DFF * 2;
constexpr size_t WS_BTIN = WS_CTL + CTL_BYTES, WS_BTUQ = WS_BTIN + SZ_BTIN, WS_BTKV = WS_BTUQ + SZ_BTUQ, WS_BTOUT = WS_BTKV + SZ_BTKV, WS_BTUP = WS_BTOUT + SZ_BTOUT, WS_BTDN = WS_BTUP + SZ_BTUP;
constexpr size_t WS_RF = WS_BTDN + SZ_BTDN, SZ_RF = (size_t)HYC * hy::RFS * 2;
constexpr size_t WS_H = WS_RF + SZ_RF, SZ_H = (size_t)M * DM * 2;
constexpr size_t WS_PROJ = WS_H + SZ_H, SZ_PROJ = (size_t)M * DINP * 2;
constexpr size_t WS_Q = WS_PROJ + SZ_PROJ, SZ_Q = (size_t)M * NQ * 2;
constexpr size_t WS_KV = WS_Q + SZ_Q, SZ_KV = (size_t)M * NKVP * 2;
constexpr size_t WS_ZT = WS_KV + SZ_KV, SZ_ZT = (size_t)HYC * NSEQ * SEQ * 2;
constexpr size_t WS_X0 = WS_ZT + SZ_ZT, WS_YC = WS_X0 + SZ_ZT;
constexpr size_t WS_EDGE = WS_YC + SZ_ZT, SZ_EDGE = (size_t)(M / 256) * 2 * 3 * DFF * 4;
constexpr size_t WS_ROPE = WS_EDGE + SZ_EDGE, SZ_ROPE = (size_t)SEQ * 64 * 4;
constexpr size_t WS_SSQP = WS_ROPE + SZ_ROPE, SZ_SSQP = (size_t)M * 32 * 4;
constexpr size_t WS_RSTD = WS_SSQP + SZ_SSQP, SZ_RSTD = (size_t)M * 4;
constexpr size_t WS_END = WS_RSTD + SZ_RSTD;
constexpr size_t WS_ACT = WS_PROJ;
static_assert((size_t)M * DFF * 2 <= SZ_PROJ + SZ_Q + SZ_KV, "ACT overlay");
constexpr size_t WS_XB2 = WS_ACT + (size_t)M * DFF * 2;
static_assert(WS_XB2 + (size_t)M * DM * 2 <= WS_EDGE && WS_XB2 % 256 == 0, "XB2 overlay");
static_assert(WS_BTIN % 256 == 0 && WS_RF % 256 == 0 && WS_H % 256 == 0 && WS_PROJ % 256 == 0 && WS_Q % 256 == 0 && WS_KV % 256 == 0 && WS_ZT % 256 == 0 && WS_EDGE % 256 == 0, "alignment");
constexpr int CW_BAR = 4096;
constexpr int RING_BYTES = 135168;
constexpr int HALO_OFF = RING_BYTES, HALO_BYTES = 4096;
constexpr int MISC_OFF = HALO_OFF + HALO_BYTES;
constexpr int LDS_BYTES = 147456;
static_assert(hy::HY_LDS_BYTES <= RING_BYTES && at::SHM_ATTN <= RING_BYTES && MISC_OFF + 256 <= LDS_BYTES, "LDS map");

#define GAS __attribute__((address_space(1)))
#define LAS __attribute__((address_space(3)))
typedef unsigned short bf16;
typedef unsigned v4u __attribute__((ext_vector_type(4)));
typedef unsigned v2u __attribute__((ext_vector_type(2)));
typedef float f32x4 __attribute__((ext_vector_type(4)));
#define LDS_WAIT() asm volatile("s_waitcnt lgkmcnt(0)" ::: "memory")
__device__ __forceinline__ unsigned f2bf(float f) { unsigned u = __builtin_bit_cast(unsigned, f); return (u + 0x7fffu + ((u >> 16) & 1u)) >> 16; }
__device__ __forceinline__ unsigned pk2(float lo, float hi) { return f2bf(lo) | (f2bf(hi) << 16); }
__device__ __forceinline__ float bf2f(unsigned short b) { return __builtin_bit_cast(float, (unsigned)b << 16); }
__device__ __forceinline__ float bflo(unsigned w) { return __builtin_bit_cast(float, w << 16); }
__device__ __forceinline__ float bfhi(unsigned w) { return __builtin_bit_cast(float, w & 0xffff0000u); }
__device__ __forceinline__ float wave_sum(float v) {
#pragma unroll
    for (int o = 1; o < 64; o <<= 1) v += __shfl_xor(v, o);
    return v;
}

#define XB_TMO      128
#define XB_XCNT(j)  (256  + 64 * (j))
#define XB_XSUB(j)  (1280 + 64 * (j))
#define XB_XGEN(j)  (2304 + 64 * (j))
#define XB_TOP      3328
#define XB_TOPGEN   3392
#define XCD_BAR_WORDS 3456
#define XB_SPIN_CAP (1u << 18)
__device__ __forceinline__ unsigned xb_ld(unsigned* p)              { return __hip_atomic_load(p, __ATOMIC_RELAXED, __HIP_MEMORY_SCOPE_AGENT); }
__device__ __forceinline__ unsigned xb_add(unsigned* p, unsigned v) { return __hip_atomic_fetch_add(p, v, __ATOMIC_RELAXED, __HIP_MEMORY_SCOPE_AGENT); }
__device__ __forceinline__ unsigned xb_xcc_id() { return (unsigned)__builtin_amdgcn_s_getreg((3 << 11) | 20) & 0xFu; }
#define XB_SPIN(cond, bar) do { unsigned _sp = 0; while (cond) { __builtin_amdgcn_s_sleep(1); \
    if ((++_sp & 255u) == 0u) { if (xb_ld(&(bar)[XB_TMO])) break; if (_sp > XB_SPIN_CAP) { atomicAdd(&(bar)[XB_TMO], 1u); break; } } } } while (0)
struct XcdBarrier { unsigned* bar; unsigned x; volatile LAS unsigned* st; };
__device__ __forceinline__ XcdBarrier xcd_barrier_post(unsigned* bar, volatile LAS unsigned* st) {
    XcdBarrier b; b.bar = bar; b.x = xb_xcc_id(); b.st = st;
    if (threadIdx.x == 0) (void)xb_add(&bar[XB_XCNT(b.x)], 1u);
    return b;
}
__device__ __forceinline__ void xcd_barrier_complete(unsigned* bar, unsigned x, unsigned& nloc, unsigned& nx) {
    const unsigned G = gridDim.x * gridDim.y * gridDim.z;
    unsigned sum, cnt, mine, sp = 0u;
    for (;;) {
        sum = 0u; cnt = 0u; mine = 0u;
#pragma unroll
        for (unsigned j = 0; j < 16; ++j) { const unsigned c = xb_ld(&bar[XB_XCNT(j)]); sum += c; cnt += (c > 0u) ? 1u : 0u; mine = (j == x) ? c : mine; }
        if (sum == G) break;
        __builtin_amdgcn_s_sleep(1);
        if ((++sp & 255u) == 0u) { if (xb_ld(&bar[XB_TMO])) break; if (sp > XB_SPIN_CAP) { atomicAdd(&bar[XB_TMO], 1u); break; } }
    }
    nloc = mine > 0u ? mine : 1u; nx = cnt > 0u ? cnt : 1u;
}
__device__ __forceinline__ void xcd_barrier(const XcdBarrier& b) {
    asm volatile("s_waitcnt vmcnt(0)" ::: "memory");
    __syncthreads();
    if (threadIdx.x == 0) {
        unsigned* bar = b.bar;
        __builtin_amdgcn_s_waitcnt(0);
        unsigned nloc = b.st[0], nx = b.st[1];
        if (nloc == 0u) { xcd_barrier_complete(bar, b.x, nloc, nx); b.st[0] = nloc; b.st[1] = nx; }
        const unsigned old = xb_add(&bar[XB_XSUB(b.x)], 1u);
        const unsigned gen = old / nloc;
        if (old + 1u == (gen + 1u) * nloc) {
            __builtin_amdgcn_fence(__ATOMIC_RELEASE, "agent");
            asm volatile("s_waitcnt vmcnt(0)" ::: "memory");
            const unsigned og = xb_add(&bar[XB_TOP], 1u);
            const unsigned tg = og / nx;
            if (og + 1u == (tg + 1u) * nx) xb_add(&bar[XB_TOPGEN], 1u);
            else XB_SPIN(xb_ld(&bar[XB_TOPGEN]) == tg, bar);
            __builtin_amdgcn_fence(__ATOMIC_ACQUIRE, "agent");
            xb_add(&bar[XB_XGEN(b.x)], 1u);
            asm volatile("s_waitcnt vmcnt(0)" ::: "memory");
        } else {
            XB_SPIN(xb_ld(&bar[XB_XGEN(b.x)]) == gen, bar);
            __builtin_amdgcn_fence(__ATOMIC_ACQUIRE, "agent");
            asm volatile("s_waitcnt vmcnt(0)" ::: "memory");
        }
    }
    __syncthreads();
}

struct Frame {
    LAS unsigned char* lds;
    int tid, lane, wave, vcu, G;
};
enum { I_XP = 0, I_XS, I_ANG, I_WIN, I_PW, I_PS, I_QNG, I_WUQ, I_KVNG, I_WUKV, I_QHG, I_KHG, I_HCW, I_HCB, I_FW1, I_FB1, I_FFR, I_FW2, I_FB2, I_FW3, I_FB3, I_HBIAS, I_GNG, I_WOUT, I_FNG, I_WUP, I_FCW, I_FCB, I_WDN, N_IN };
struct Args { const float* in[N_IN]; float* out; unsigned char* ws; int ph_lo, ph_hi; };
static_assert(sizeof(Args) == (N_IN + 2) * 8 + 8, "Args has no padding");

__device__ __forceinline__ void cvt_item(const float* __restrict__ W, int ldw, int K, bf16* WT, int dst_n0, int src_n0, int k0, const float* __restrict__ ks, LAS float* scr, int lane) {
#pragma unroll
    for (int i = 0; i < 32; ++i) { const int kk = 2 * i + (lane >> 5); float v = W[(size_t)(k0 + kk) * ldw + src_n0 + (lane & 31)]; if (ks) v *= ks[k0 + kk]; scr[kk * 33 + (lane & 31)] = v; }
    LDS_WAIT(); asm volatile("" ::: "memory");
    const int c = lane & 7;
#pragma unroll
    for (int j = 0; j < 4; ++j) { const int n = (lane >> 3) + 8 * j; const LAS float* s = scr + (8 * c) * 33 + n;
        v4u o; o.x = pk2(s[0 * 33], s[1 * 33]); o.y = pk2(s[2 * 33], s[3 * 33]); o.z = pk2(s[4 * 33], s[5 * 33]); o.w = pk2(s[6 * 33], s[7 * 33]);
        *(v4u*)(WT + (size_t)(dst_n0 + n) * K + k0 + 8 * c) = o; }
    LDS_WAIT(); asm volatile("" ::: "memory");
}
struct CvtTile { const float* W; const float* ks; bf16* WT; int ldw, K, src_n0, k0, ncols; int dst[4]; };
__device__ __forceinline__ void cvt_tile(Frame& F, const CvtTile& d) {
    LAS float* T = (LAS float*)F.lds;
#pragma unroll
    for (int i = 0; i < 8; ++i) { const int q = F.tid + 512 * i, row = q >> 5, c4 = q & 31;
        f32x4 v = {0.f, 0.f, 0.f, 0.f};
        if (d.src_n0 + 4 * c4 < d.ncols) v = *(const f32x4*)(d.W + (size_t)(d.k0 + row) * d.ldw + d.src_n0 + 4 * c4);
        if (d.ks) v *= d.ks[d.k0 + row];
        LAS float* t = T + row * 129 + 4 * c4; t[0] = v.x; t[1] = v.y; t[2] = v.z; t[3] = v.w; }
    __syncthreads();
#pragma unroll
    for (int i = 0; i < 4; ++i) { const int n = (F.tid >> 4) + 32 * i, kc = F.tid & 15;
        if (d.src_n0 + n < d.ncols) { const LAS float* s = T + (8 * kc) * 129 + n;
            v4u o; o.x = pk2(s[0], s[129]); o.y = pk2(s[2 * 129], s[3 * 129]); o.z = pk2(s[4 * 129], s[5 * 129]); o.w = pk2(s[6 * 129], s[7 * 129]);
            *(v4u*)(d.WT + (size_t)(d.dst[i] + (n & 31)) * d.K + d.k0 + 8 * kc) = o; } }
    __syncthreads();
}
__device__ __forceinline__ void xb_row(const float* xrow, bf16* orow, float* rstd, int lane) {
    const f32x4* xr = (const f32x4*)xrow + lane;
    f32x4 v[8]; float s = 0.f;
#pragma unroll
    for (int j = 0; j < 8; ++j) { v[j] = xr[64 * j]; s += (v[j].x * v[j].x + v[j].y * v[j].y) + (v[j].z * v[j].z + v[j].w * v[j].w); }
    const float r = 1.0f / sqrtf(wave_sum(s) * (1.f / DM) + EPS);
    if (lane == 0) *rstd = r;
    v2u* o8 = (v2u*)orow + lane;
#pragma unroll
    for (int j = 0; j < 8; ++j) { v2u w; w.x = pk2(v[j].x, v[j].y); w.y = pk2(v[j].z, v[j].w); o8[64 * j] = w; }
}
__device__ __forceinline__ void rstd_from_partials(const float* __restrict__ ssqp, float* rstd, size_t gtid, size_t gthreads) {
    for (size_t r = gtid; r < (size_t)M; r += gthreads) { const f32x4* p = (const f32x4*)(ssqp + r * 32); f32x4 a = p[0];
#pragma unroll
        for (int i = 1; i < 8; ++i) a += p[i];
        rstd[r] = 1.0f / sqrtf(((a.x + a.y) + (a.z + a.w)) * (1.f / DM) + EPS); }
}
__device__ __forceinline__ void tile_norm_store(LAS float* tile, bf16* dst, int row0, int col_off, int wave, int lane) {
#pragma unroll
    for (int i = 0; i < 8; ++i) { const int t = wave * 8 + i;
        const f32x4 a = *(LAS f32x4*)(tile + t * 512 + 8 * lane), b = *(LAS f32x4*)(tile + t * 512 + 8 * lane + 4);
        const float s = (a.x * a.x + a.y * a.y) + (a.z * a.z + a.w * a.w) + (b.x * b.x + b.y * b.y) + (b.z * b.z + b.w * b.w);
        const float rstd = 1.0f / sqrtf(wave_sum(s) * (1.f / 512.f) + EPS);
        v4u o; o.x = pk2(a.x * rstd, a.y * rstd); o.y = pk2(a.z * rstd, a.w * rstd); o.z = pk2(b.x * rstd, b.y * rstd); o.w = pk2(b.z * rstd, b.w * rstd);
        *(v4u*)(dst + (size_t)(row0 + t) * DM + col_off + 8 * lane) = o; }
}
__device__ __forceinline__ void poolfold_item(Frame& F, const float* __restrict__ win, const float* __restrict__ pw, const float* __restrict__ ps, const float* __restrict__ g1, bf16* BtIn, int g, int kb) {
    LAS float* At = (LAS float*)F.lds; LAS float* Bt = (LAS float*)(F.lds + 32768);
    const int k0 = 64 * kb;
#pragma unroll
    for (int i = 0; i < 4; ++i) { const int q = F.tid + 512 * i, row = q >> 5, c4 = q & 31; *(LAS f32x4*)(At + row * 128 + 4 * c4) = *(const f32x4*)(win + (size_t)(k0 + row) * DIN + 128 * g + 4 * c4) * g1[k0 + row]; }
#pragma unroll
    for (int i = 0; i < 8; ++i) { const int q = F.tid + 512 * i, row = q >> 5, c4 = q & 31; *(LAS f32x4*)(Bt + row * 128 + 4 * c4) = *(const f32x4*)(pw + (size_t)(g * 128 + row) * 128 + 4 * c4); }
    __syncthreads();
    const int n = F.tid & 127, kg = F.tid >> 7;
    float acc[16];
#pragma unroll
    for (int i = 0; i < 16; ++i) acc[i] = 0.f;
    for (int j = 0; j < 128; j += 4) {
        const float b0 = Bt[(j + 0) * 128 + n], b1 = Bt[(j + 1) * 128 + n], b2 = Bt[(j + 2) * 128 + n], b3 = Bt[(j + 3) * 128 + n];
#pragma unroll
        for (int i = 0; i < 16; ++i) { const f32x4 a = *(LAS f32x4*)(At + (kg * 16 + i) * 128 + j); acc[i] += a.x * b0 + a.y * b1 + a.z * b2 + a.w * b3; }
    }
    const float sc = ps[128 * g + n];
    v4u o0, o1;
    o0.x = pk2(acc[0] * sc, acc[1] * sc); o0.y = pk2(acc[2] * sc, acc[3] * sc); o0.z = pk2(acc[4] * sc, acc[5] * sc); o0.w = pk2(acc[6] * sc, acc[7] * sc);
    o1.x = pk2(acc[8] * sc, acc[9] * sc); o1.y = pk2(acc[10] * sc, acc[11] * sc); o1.z = pk2(acc[12] * sc, acc[13] * sc); o1.w = pk2(acc[14] * sc, acc[15] * sc);
    bf16* dst = BtIn + (size_t)(128 * g + n) * DM + k0 + kg * 16;
    *(v4u*)dst = o0; *(v4u*)(dst + 8) = o1;
    __syncthreads();
}
__device__ __forceinline__ void filter_item(Frame& F, const float* __restrict__ w1, const float* __restrict__ b1, const float* __restrict__ fr, const float* __restrict__ w2, const float* __restrict__ b2,
                                            const float* __restrict__ w3, const float* __restrict__ b3, const float* __restrict__ hbias, bf16* RF, int fi) {
    LAS float* ZF = (LAS float*)F.lds; LAS float* H1 = ZF + 512; LAS float* H2 = ZF + 1536;
    const int t0 = 16 * fi;
    if (F.tid < 272) { const int tt = F.tid / 17, f = F.tid % 17; const float t = (float)(t0 + tt);
        float v;
        if (f == 0) v = t / 2047.0f;
        else { const int j = (f - 1) & 7; const float band = 1e-4f + (float)j * ((7.0f - 1e-4f) / 7.0f); const float w = (6.283185307179586f * t) / 2048.0f; const float a = band * w; v = (f <= 8) ? __cosf(a) : -__sinf(a); }
        ZF[tt * 17 + f] = v; }
    __syncthreads();
#pragma unroll
    for (int rep = 0; rep < 2; ++rep) { const int p = F.tid + 512 * rep, tt = p >> 6, j = p & 63; float s = b1[j];
        for (int i = 0; i < 17; ++i) s += ZF[tt * 17 + i] * w1[i * 64 + j];
        H1[tt * 64 + j] = __sinf(fr[j] * s); }
    __syncthreads();
#pragma unroll
    for (int rep = 0; rep < 2; ++rep) { const int p = F.tid + 512 * rep, tt = p >> 6, j = p & 63; float s = b2[j];
        for (int i = 0; i < 64; ++i) s += H1[tt * 64 + i] * w2[i * 64 + j];
        H2[tt * 64 + j] = __sinf(fr[j] * s); }
    __syncthreads();
    const int c = F.tid;
    const float delta = -3.0701134573253944f + (float)c * ((-15.350567286626972f + 3.0701134573253944f) / 511.0f);
    const float ad = fabsf(delta);
    bf16* rf = RF + (size_t)c * hy::RFS;
#pragma unroll 1
    for (int dir = 0; dir < 2; ++dir) { const int o = dir * 512 + c; const float bo = b3[o];
        float s[16];
#pragma unroll
        for (int tt = 0; tt < 16; ++tt) s[tt] = bo;
#pragma unroll 1
        for (int ib = 0; ib < 64; ib += 4) { const float w0 = w3[(ib + 0) * 1024 + o], w1 = w3[(ib + 1) * 1024 + o], w2 = w3[(ib + 2) * 1024 + o], w3v = w3[(ib + 3) * 1024 + o];
#pragma unroll
            for (int tt = 0; tt < 16; ++tt) { const f32x4 hv = *(LAS f32x4*)(H2 + tt * 64 + ib); s[tt] += (hv.x * w0 + hv.y * w1) + (hv.z * w2 + hv.w * w3v); } }
#pragma unroll
        for (int tt = 0; tt < 16; ++tt) { const int t = t0 + tt; const float tl = (float)t / 2047.0f; float val = s[tt] * __expf(-tl * ad);
            if (dir == 0) { if (t == 0) val += hbias[c]; rf[2048 - t] = (bf16)f2bf(val); }
            else if (t >= 1) rf[2048 + t] = (bf16)f2bf(val); } }
    if (fi == 0) { rf[0] = 0;
#pragma unroll
        for (int i = 4096; i < hy::RFS; ++i) rf[i] = 0; }
    __syncthreads();
}
__device__ __forceinline__ void unpack4(const v2u w, float (&x)[4]) { x[0] = bflo(w.x); x[1] = bfhi(w.x); x[2] = bflo(w.y); x[3] = bfhi(w.y); }
__device__ __forceinline__ void pair_norm_store(Frame& F, const float (&y)[8][4], bf16* dst, size_t row0, int col_off, int cq) {
    LAS float* part = (LAS float*)F.lds;
    float ss[8];
#pragma unroll
    for (int k = 0; k < 8; ++k) ss[k] = wave_sum((y[k][0] * y[k][0] + y[k][1] * y[k][1]) + (y[k][2] * y[k][2] + y[k][3] * y[k][3]));
    if (F.lane == 0) { *(LAS f32x4*)(part + F.wave * 8) = (f32x4){ss[0], ss[1], ss[2], ss[3]}; *(LAS f32x4*)(part + F.wave * 8 + 4) = (f32x4){ss[4], ss[5], ss[6], ss[7]}; }
    __syncthreads();
    const f32x4 pa = *(LAS f32x4*)(part + (F.wave ^ 1) * 8), pb = *(LAS f32x4*)(part + (F.wave ^ 1) * 8 + 4);
    const float po[8] = {pa.x, pa.y, pa.z, pa.w, pb.x, pb.y, pb.z, pb.w};
#pragma unroll
    for (int k = 0; k < 8; ++k) { const float rstd = 1.0f / sqrtf((ss[k] + po[k]) * (1.f / 512.f) + EPS);
        v2u o; o.x = pk2(y[k][0] * rstd, y[k][1] * rstd); o.y = pk2(y[k][2] * rstd, y[k][3] * rstd);
        *(v2u*)(dst + (row0 + k) * DM + col_off + 4 * cq) = o; }
    __syncthreads();
}
__device__ __forceinline__ void hyprep_item(Frame& F, const bf16* __restrict__ PROJ, const float* __restrict__ cw, const float* __restrict__ cb, bf16* ZT, bf16* X0, int b, int tile) {
    const int tb = F.tid >> 7, cq = F.tid & 127, c0 = 4 * cq, tw = tile * 32 + tb * 8; const size_t rb = (size_t)b * SEQ;
    float z[8][4];
#pragma unroll
    for (int jj = 0; jj < 3; ++jj) { const int j = (jj == 0) ? 1 : (jj == 1) ? 2 : 0; const int cc = 512 * j + c0;
        const f32x4 w0 = *(const f32x4*)(cw + cc), w1 = *(const f32x4*)(cw + 1536 + cc), w2 = *(const f32x4*)(cw + 3072 + cc), bs = *(const f32x4*)(cb + cc);
        float x[10][4];
#pragma unroll
        for (int o = 0; o < 10; ++o) { const int t = tw - 1 + o; const bool ok = (t >= 0) && (t < SEQ); const int tc = ok ? t : tw;
            const v2u w = *(const v2u*)(PROJ + (rb + tc) * DINP + O_HY + cc); unpack4(w, x[o]);
            if (!ok) { x[o][0] = 0.f; x[o][1] = 0.f; x[o][2] = 0.f; x[o][3] = 0.f; } }
        if (jj == 0) {
#pragma unroll
            for (int k = 0; k < 8; ++k)
#pragma unroll
                for (int i = 0; i < 4; ++i) z[k][i] = w0[i] * x[k][i] + w1[i] * x[k + 1][i] + w2[i] * x[k + 2][i] + bs[i];
        } else if (jj == 1) {
#pragma unroll
            for (int k = 0; k < 8; ++k)
#pragma unroll
                for (int i = 0; i < 4; ++i) z[k][i] *= w0[i] * x[k][i] + w1[i] * x[k + 1][i] + w2[i] * x[k + 2][i] + bs[i];
#pragma unroll
            for (int i = 0; i < 4; ++i) { v4u o; o.x = pk2(z[0][i], z[1][i]); o.y = pk2(z[2][i], z[3][i]); o.z = pk2(z[4][i], z[5][i]); o.w = pk2(z[6][i], z[7][i]);
                *(v4u*)(ZT + ((size_t)(c0 + i) * NSEQ + b) * SEQ + tw) = o; }
        } else {
#pragma unroll
            for (int k = 0; k < 8; ++k) { float u0[4];
#pragma unroll
                for (int i = 0; i < 4; ++i) u0[i] = w0[i] * x[k][i] + w1[i] * x[k + 1][i] + w2[i] * x[k + 2][i] + bs[i];
                v2u o; o.x = pk2(u0[0], u0[1]); o.y = pk2(u0[2], u0[3]); *(v2u*)(X0 + (rb + tw + k) * HYC + c0) = o; }
        }
    }
}
__device__ __forceinline__ void pool_item(Frame& F, const bf16* __restrict__ PROJ, bf16* MIXED, int b, int tile) {
    const int tb = F.tid >> 7, cq = F.tid & 127, c0 = 4 * cq, g = cq >> 5, half = 1 << g, tw = tile * 32 + tb * 8; const size_t rb = (size_t)b * SEQ;
    float x[23][4];
#pragma unroll
    for (int o = 0; o < 23; ++o) { const int t = tw - 8 + o; const bool ok = (t >= 0) && (t < SEQ); const int tc = ok ? t : tw;
        const v2u w = *(const v2u*)(PROJ + (rb + tc) * DINP + c0); unpack4(w, x[o]);
        if (!ok) { x[o][0] = 0.f; x[o][1] = 0.f; x[o][2] = 0.f; x[o][3] = 0.f; } }
    float y[8][4];
#pragma unroll
    for (int k = 0; k < 8; ++k) { const int oc = 8 + k, t = tw + k; const int lo = (t - half > 0) ? t - half : 0, hi = (t + half < SEQ) ? t + half : SEQ; const float inv = 1.0f / (float)(hi - lo);
#pragma unroll
        for (int i = 0; i < 4; ++i) {
            const float w1 = x[oc - 1][i] + x[oc][i];
            const float w2 = w1 + (x[oc - 2][i] + x[oc + 1][i]);
            const float w4 = w2 + ((x[oc - 4][i] + x[oc - 3][i]) + (x[oc + 2][i] + x[oc + 3][i]));
            const float w8 = w4 + (((x[oc - 8][i] + x[oc - 7][i]) + (x[oc - 6][i] + x[oc - 5][i])) + ((x[oc + 4][i] + x[oc + 5][i]) + (x[oc + 6][i] + x[oc + 7][i])));
            const float S = (g == 0) ? w1 : (g == 1) ? w2 : (g == 2) ? w4 : w8;
            y[k][i] = S * inv - x[oc][i]; } }
    pair_norm_store(F, y, MIXED, rb + tw, 0, cq);
}
__device__ __forceinline__ void hyfin_item(Frame& F, const bf16* __restrict__ YC, const bf16* __restrict__ X0, bf16* MIXED, int b, int tile) {
    const int tb = F.tid >> 7, cq = F.tid & 127, c0 = 4 * cq, tw = tile * 32 + tb * 8; const size_t rb = (size_t)b * SEQ;
    float yc[4][8], y[8][4];
#pragma unroll
    for (int i = 0; i < 4; ++i) { const v4u v = *(const v4u*)(YC + ((size_t)(c0 + i) * NSEQ + b) * SEQ + tw);
        yc[i][0] = bflo(v.x); yc[i][1] = bfhi(v.x); yc[i][2] = bflo(v.y); yc[i][3] = bfhi(v.y); yc[i][4] = bflo(v.z); yc[i][5] = bfhi(v.z); yc[i][6] = bflo(v.w); yc[i][7] = bfhi(v.w); }
#pragma unroll
    for (int k = 0; k < 8; ++k) { float xv[4]; unpack4(*(const v2u*)(X0 + (rb + tw + k) * HYC + c0), xv);
#pragma unroll
        for (int i = 0; i < 4; ++i) y[k][i] = yc[i][k] * xv[i]; }
    pair_norm_store(F, y, MIXED, rb + tw, 1536, cq);
}
struct PrepGains { float q[3][8], k[3][8]; };
__device__ __forceinline__ void load8(const float* p, float (&o)[8]) { const f32x4 a = *(const f32x4*)p, b = *(const f32x4*)(p + 4); o[0] = a.x; o[1] = a.y; o[2] = a.z; o[3] = a.w; o[4] = b.x; o[5] = b.y; o[6] = b.z; o[7] = b.w; }
__device__ __forceinline__ void unpack8(const v4u w, float (&x)[8]) { x[0] = bflo(w.x); x[1] = bfhi(w.x); x[2] = bflo(w.y); x[3] = bfhi(w.y); x[4] = bflo(w.z); x[5] = bfhi(w.z); x[6] = bflo(w.w); x[7] = bfhi(w.w); }
__device__ __forceinline__ v4u pack8(const float (&x)[8]) { v4u o; o.x = pk2(x[0], x[1]); o.y = pk2(x[2], x[3]); o.z = pk2(x[4], x[5]); o.w = pk2(x[6], x[7]); return o; }
__device__ __forceinline__ float ssq8(const float (&x)[8]) { return ((x[0] * x[0] + x[1] * x[1]) + (x[2] * x[2] + x[3] * x[3])) + ((x[4] * x[4] + x[5] * x[5]) + (x[6] * x[6] + x[7] * x[7])); }
__device__ __forceinline__ float sum8lanes(float v) { v += __shfl_xor(v, 1); v += __shfl_xor(v, 2); v += __shfl_xor(v, 4); return v; }
__device__ __forceinline__ void prep_row(const bf16* __restrict__ PROJ, bf16* Q, bf16* KV, const PrepGains& G, const float* __restrict__ ROPE, int m, int lane) {
    const int h = lane >> 3, sub = lane & 7;
    const bf16* pr = PROJ + (size_t)m * DINP; bf16* qr = Q + (size_t)m * NQ + 192 * h + 8 * sub; bf16* kr = KV + (size_t)m * NKVP + KVHS * h + 8 * sub;
    const v4u cqv = *(const v4u*)(pr + O_CQ + 8 * lane); const v4u ckv = *(const v4u*)(pr + O_CKV + 8 * (lane & 31)); const v4u pev = *(const v4u*)(pr + O_KPE + 8 * sub);
    const v4u q0 = *(const v4u*)(qr), q1 = *(const v4u*)(qr + 64), q2 = *(const v4u*)(qr + 128);
    const v4u k0 = *(const v4u*)(kr), k1 = *(const v4u*)(kr + 64), v0 = *(const v4u*)(kr + 192), v1 = *(const v4u*)(kr + 256);
    float cs[8], sn[8]; { const float* rp = ROPE + (size_t)(m & (SEQ - 1)) * 64 + 8 * (sub & 3); load8(rp, cs); load8(rp + 32, sn); }
    float t[8];
    unpack8(cqv, t); const float rq = 1.0f / sqrtf(wave_sum(ssq8(t)) * (1.f / 512.f) + EPS);
    unpack8(ckv, t); const float rkv = 1.0f / sqrtf(wave_sum(lane < 32 ? ssq8(t) : 0.f) * (1.f / 256.f) + EPS);
    const float sg = (sub < 4) ? -1.f : 1.f;
    { float a0[8], a1[8], a2[8]; unpack8(q0, a0); unpack8(q1, a1); unpack8(q2, a2);
      const float ss = sum8lanes(ssq8(a0) + ssq8(a1) + ssq8(a2)) * (rq * rq);
      const float sc = rq / sqrtf(ss * (1.f / 192.f) + EPS);
      float r[8], o[8];
#pragma unroll
      for (int i = 0; i < 8; ++i) { a0[i] *= sc * G.q[0][i]; a1[i] *= sc * G.q[1][i]; r[i] = a2[i] * sc * G.q[2][i]; }
#pragma unroll
      for (int i = 0; i < 8; ++i) { const float rp = __shfl_xor(r[i], 4); o[i] = r[i] * cs[i] + sg * rp * sn[i]; }
      *(v4u*)(qr) = pack8(a0); *(v4u*)(qr + 64) = pack8(a1); *(v4u*)(qr + 128) = pack8(o); }
    { float a0[8], a1[8], pe[8], b0[8], b1[8]; unpack8(k0, a0); unpack8(k1, a1); unpack8(pev, pe); unpack8(v0, b0); unpack8(v1, b1);
      const float ss = sum8lanes((ssq8(a0) + ssq8(a1)) * (rkv * rkv) + ssq8(pe));
      const float sk = 1.0f / sqrtf(ss * (1.f / 192.f) + EPS);
      float r[8], o[8];
#pragma unroll
      for (int i = 0; i < 8; ++i) { a0[i] *= rkv * sk * G.k[0][i]; a1[i] *= rkv * sk * G.k[1][i]; r[i] = pe[i] * sk * G.k[2][i]; b0[i] *= rkv; b1[i] *= rkv; }
#pragma unroll
      for (int i = 0; i < 8; ++i) { const float rp = __shfl_xor(r[i], 4); o[i] = r[i] * cs[i] + sg * rp * sn[i]; }
      *(v4u*)(kr) = pack8(a0); *(v4u*)(kr + 64) = pack8(a1); *(v4u*)(kr + 128) = pack8(o); *(v4u*)(kr + 192) = pack8(b0); *(v4u*)(kr + 256) = pack8(b1); }
}
__device__ __forceinline__ void attn_norm_row(bf16* MIXED, int m, int lane) {
    v4u* p = (v4u*)(MIXED + (size_t)m * DM + 512 + 16 * lane); v4u a = p[0], b = p[1];
    unsigned w[8] = {a.x, a.y, a.z, a.w, b.x, b.y, b.z, b.w}; float s = 0.f;
#pragma unroll
    for (int i = 0; i < 8; ++i) { const float x = bflo(w[i]), y = bfhi(w[i]); s += x * x + y * y; }
    const float rstd = 1.0f / sqrtf(wave_sum(s) * (1.f / 1024.f) + EPS);
#pragma unroll
    for (int i = 0; i < 8; ++i) w[i] = pk2(bflo(w[i]) * rstd, bfhi(w[i]) * rstd);
    a.x = w[0]; a.y = w[1]; a.z = w[2]; a.w = w[3]; b.x = w[4]; b.y = w[5]; b.z = w[6]; b.w = w[7]; p[0] = a; p[1] = b;
}

#define DEFPTRS() unsigned char* ws = args.ws; \
    bf16* BtIn = (bf16*)(ws + WS_BTIN); bf16* BtUq = (bf16*)(ws + WS_BTUQ); bf16* BtKv = (bf16*)(ws + WS_BTKV); bf16* BtOut = (bf16*)(ws + WS_BTOUT); bf16* BtUp = (bf16*)(ws + WS_BTUP); bf16* BtDn = (bf16*)(ws + WS_BTDN); \
    bf16* RF = (bf16*)(ws + WS_RF); bf16* Hb = (bf16*)(ws + WS_H); bf16* PROJ = (bf16*)(ws + WS_PROJ); bf16* Qb = (bf16*)(ws + WS_Q); bf16* KVb = (bf16*)(ws + WS_KV); \
    bf16* ZT = (bf16*)(ws + WS_ZT); bf16* X0 = (bf16*)(ws + WS_X0); bf16* YC = (bf16*)(ws + WS_YC); float* EDGE = (float*)(ws + WS_EDGE); float* ROPE = (float*)(ws + WS_ROPE); float* SSQP = (float*)(ws + WS_SSQP); float* RSTD = (float*)(ws + WS_RSTD); bf16* XB2 = (bf16*)(ws + WS_XB2); bf16* ACT = (bf16*)(ws + WS_ACT); \
    bf16* XA = (bf16*)args.out; \
    (void)BtIn; (void)BtUq; (void)BtKv; (void)BtOut; (void)BtUp; (void)BtDn; (void)RF; (void)Hb; (void)PROJ; (void)Qb; (void)KVb; (void)ZT; (void)X0; (void)YC; (void)EDGE; (void)ROPE; (void)SSQP; (void)RSTD; (void)XB2; (void)ACT; (void)XA
__global__ void __launch_bounds__(NWAVES * 64, 2) fwd(Args args) {
    extern __shared__ __attribute__((aligned(16))) unsigned char lds_raw[];
    Frame F;
    F.lds = (LAS unsigned char*)lds_raw;
    F.tid = threadIdx.x; F.lane = F.tid & 63; F.wave = __builtin_amdgcn_readfirstlane(F.tid >> 6);
    F.G = gridDim.x; { const int bx = blockIdx.x; F.vcu = (F.G % 8 == 0) ? (bx % 8) * (F.G / 8) + bx / 8 : bx; }
    volatile LAS unsigned* MISC = (volatile LAS unsigned*)(F.lds + MISC_OFF);
    if (F.tid < 64) MISC[F.tid] = 0u;
    __syncthreads();
    unsigned* ctl = (unsigned*)(args.ws + WS_CTL);
    const int lo = args.ph_lo, hi = args.ph_hi;
    XcdBarrier bar; bar.bar = ctl + CW_BAR; bar.x = 0; bar.st = MISC + 8;
    if (hi - lo > 1) bar = xcd_barrier_post(ctl + CW_BAR, MISC + 8);
    float* out = args.out;

#pragma unroll 1
    for (int layer = 0; layer < DEPTH; ++layer) {
        const int pb = layer * NPH;
        if (pb + NPH <= lo || pb >= hi) continue;
#define IN(k) (lo <= pb + (k) && pb + (k) < hi)
#define ENTER() DEFPTRS(); F.tid = opq(threadIdx.x); F.lane = F.tid & 63; F.wave = __builtin_amdgcn_readfirstlane(F.tid >> 6); const int gw = F.vcu * NWAVES + F.wave, NGW = F.G * NWAVES, wg = F.vcu; const size_t gtid = (size_t)wg * 512 + F.tid, gthreads = (size_t)F.G * 512; (void)gw; (void)NGW; (void)wg; (void)gtid; (void)gthreads
#define SEAM(k) do { if (pb + (k) + 1 < hi) xcd_barrier(bar); } while (0)

        if (IN(0)) { ENTER();
            const float* win = args.in[I_WIN] + (size_t)layer * DM * DIN; const float* g1 = args.in[I_ANG] + layer * DM;
            for (int it = wg; it < 256; it += F.G) {
                if (it < 128) poolfold_item(F, win, args.in[I_PW] + (size_t)layer * 4 * 128 * 128, args.in[I_PS] + (size_t)layer * 512, g1, BtIn, it >> 5, it & 31);
                else filter_item(F, args.in[I_FW1] + (size_t)layer * 17 * 64, args.in[I_FB1] + layer * 64, args.in[I_FFR] + layer * 64, args.in[I_FW2] + (size_t)layer * 64 * 64, args.in[I_FB2] + layer * 64,
                                 args.in[I_FW3] + (size_t)layer * 64 * 1024, args.in[I_FB3] + layer * 1024, args.in[I_HBIAS] + layer * 512, RF, it - 128);
            }
            constexpr int T_IN = 19 * 16, T_UQ = 12 * 4, T_KV = 16 * 2, T_OUT = 16 * 16, T_UP = 88 * 16, T_DN = 16 * 44, T_ALL = T_IN + T_UQ + T_KV + T_OUT + T_UP + T_DN;
            for (int it = wg; it < T_ALL; it += F.G) {
                int r = it; CvtTile d;
                if (r < T_IN) { const int nt = r >> 4, kt = r & 15, n0 = 512 + 128 * nt; d = CvtTile{win, g1, BtIn, DIN, DM, n0, 128 * kt, DIN, {n0, n0 + 32, n0 + 64, n0 + 96}}; }
                else if ((r -= T_IN) < T_UQ) { const int nt = r >> 2, kt = r & 3, n0 = 128 * nt; d = CvtTile{args.in[I_WUQ] + (size_t)layer * 512 * NQ, args.in[I_QNG] + layer * 512, BtUq, NQ, 512, n0, 128 * kt, NQ, {n0, n0 + 32, n0 + 64, n0 + 96}}; }
                else if ((r -= T_UQ) < T_KV) { const int nt = r >> 1, kt = r & 1, n0 = 128 * nt, h = nt >> 1, bs = KVHS * h + ((nt & 1) ? 192 : 0);
                    d = CvtTile{args.in[I_WUKV] + (size_t)layer * 256 * 2048, args.in[I_KVNG] + layer * 256, BtKv, 2048, 256, n0, 128 * kt, 2048, {bs, bs + 32, bs + 64, bs + 96}}; }
                else if ((r -= T_KV) < T_OUT) { const int nt = r >> 4, kt = r & 15, n0 = 128 * nt; d = CvtTile{args.in[I_WOUT] + (size_t)layer * DM * DM, args.in[I_GNG] + layer * DM, BtOut, DM, DM, n0, 128 * kt, DM, {n0, n0 + 32, n0 + 64, n0 + 96}}; }
                else if ((r -= T_OUT) < T_UP) { const int nt = r >> 4, kt = r & 15, n0 = 128 * nt; const int nv = (nt < 44) ? nt : nt - 44; const int bs = 256 * nv + ((nt < 44) ? 0 : 32);
                    d = CvtTile{args.in[I_WUP] + (size_t)layer * DM * NUP, args.in[I_FNG] + layer * DM, BtUp, NUP, DM, n0, 128 * kt, NUP, {bs, bs + 64, bs + 128, bs + 192}}; }
                else { r -= T_UP; const int nt = r / 44, kt = r % 44, n0 = 128 * nt; d = CvtTile{args.in[I_WDN] + (size_t)layer * DFF * DM, nullptr, BtDn, DM, DFF, n0, 128 * kt, DM, {n0, n0 + 32, n0 + 64, n0 + 96}}; }
                cvt_tile(F, d);
            }
            { unsigned zz = 0u; asm volatile("" : "+v"(zz)); v4u z = {zz, zz, zz, zz};
              for (size_t i = gtid; i < (size_t)(DINP - DIN) * DM / 8; i += gthreads) *(v4u*)(BtIn + (size_t)DIN * DM + i * 8) = z;
              for (size_t i = gtid; i < (size_t)NH * 64 * 256 / 8; i += gthreads) { const int h = (int)(i / (64 * 256 / 8)), q = (int)(i % (64 * 256 / 8)); *(v4u*)(BtKv + (size_t)(KVHS * h + 128) * 256 + (size_t)q * 8) = z; } }
            if (layer == 0) for (size_t i = gtid; i < (size_t)SEQ * 32; i += gthreads) { const int pos = (int)(i >> 5), ri = (int)(i & 31);
                const float freq = exp2f(-(float)ri * (13.287712379549449f / 32.0f)); float sn, cs; sincosf((float)pos * freq, &sn, &cs); ROPE[pos * 64 + ri] = cs; ROPE[pos * 64 + 32 + ri] = sn; }
            if (layer == 0) { for (int m = gw; m < M; m += NGW) xb_row(m < MP ? args.in[I_XP] + (size_t)m * DM : args.in[I_XS] + (size_t)(m - MP) * DM, XA + (size_t)m * DM, RSTD + m, F.lane); }
            else rstd_from_partials(SSQP, RSTD, gtid, gthreads);
            SEAM(0);
        }
        if (IN(1)) { ENTER();
            pg8::Gemm g{XA, BtIn, M, DINP, DM, DM}; pg8::StaticOrder S; S.init(M, DINP, F.G, (int)blockIdx.x);
            pg8::EpiBf16 E{PROJ, DINP, RSTD};
            pg8::gemm_phase<pg8::EpiBf16, pg8::StaticOrder>(F.lds, g, S, E);
            SEAM(1);
        }
        if (IN(2)) { ENTER();
            { pg8::Gemm g{PROJ + O_CQ, BtUq, M, NQ, 512, DINP}; pg8::StaticOrder S; S.init(M, NQ, F.G, (int)blockIdx.x); pg8::EpiBf16 E{Qb, NQ, nullptr};
              pg8::gemm_phase<pg8::EpiBf16, pg8::StaticOrder>(F.lds, g, S, E); }
            { pg8::Gemm g{PROJ + O_CKV, BtKv, M, NKVP, 256, DINP}; pg8::StaticOrder S; S.init(M, NKVP, F.G, (int)blockIdx.x); pg8::EpiBf16 E{KVb, NKVP, nullptr};
              pg8::gemm_phase<pg8::EpiBf16, pg8::StaticOrder>(F.lds, g, S, E); }
            const float* hcw = args.in[I_HCW] + (size_t)layer * 3 * 1536; const float* hcb = args.in[I_HCB] + layer * 1536;
            for (int it = wg; it < 2 * NSEQ * 64; it += F.G) {
                if (it < NSEQ * 64) hyprep_item(F, PROJ, hcw, hcb, ZT, X0, it >> 6, it & 63);
                else pool_item(F, PROJ, Hb, (it - NSEQ * 64) >> 6, it & 63);
            }
            SEAM(2);
        }
        if (IN(3)) { ENTER();
            for (int u = wg; u < 2 * HYC; u += F.G) hy::conv_unit(F.lds, ZT, RF, YC, u >> 1, u & 1);
            const float* qhg = args.in[I_QHG] + layer * 192; const float* khg = args.in[I_KHG] + layer * 192;
            PrepGains PG; { const int sub = F.lane & 7;
#pragma unroll
                for (int i = 0; i < 3; ++i) { load8(qhg + 64 * i + 8 * sub, PG.q[i]); load8(khg + 64 * i + 8 * sub, PG.k[i]); } }
            for (int m = gw; m < M; m += NGW) prep_row(PROJ, Qb, KVb, PG, ROPE, m, F.lane);
            SEAM(3);
        }
        if (IN(4)) { ENTER();
            for (int i = 0; i * F.G < NSEQ * NH * 8; ++i) {
                int p, qb; const int c = (int)blockIdx.x;
                if (F.G == 256) { p = i * 32 + (c & 7) * 4 + (c >> 6); qb = (c >> 3) & 7; } else { const int Lq = i * F.G + c; p = Lq >> 3; qb = Lq & 7; }
                if (p < NSEQ * NH) { const int b = p >> 3, h = p & 7;
                    at::attn_unit(Qb + (size_t)(b * SEQ + qb * 256) * NQ + h * 192, KVb + (size_t)(b * SEQ) * NKVP + h * KVHS, KVb + (size_t)(b * SEQ) * NKVP + h * KVHS + 192,
                                  Hb + (size_t)(b * SEQ + qb * 256) * DM + 512 + h * 128, SEQ, (char*)lds_raw); }
            }
            for (int it = wg; it < NSEQ * 64; it += F.G) hyfin_item(F, YC, X0, Hb, it >> 6, it & 63);
            SEAM(4);
        }
        if (IN(5)) { ENTER();
            for (int m = gw; m < M; m += NGW) attn_norm_row(Hb, m, F.lane);
            SEAM(5);
        }
        if (IN(6)) { ENTER();
            pg8::Gemm g{Hb, BtOut, M, DM, DM, DM}; pg8::StaticOrder S; S.init(M, DM, F.G, (int)blockIdx.x);
            pg8::EpiResid16 E{XA, XB2, out, DM, SSQP, 0};
            pg8::gemm_phase<pg8::EpiResid16, pg8::StaticOrder>(F.lds, g, S, E);
            SEAM(6);
        }
        if (IN(7)) { ENTER();
            rstd_from_partials(SSQP, RSTD, gtid, gthreads);
            SEAM(7);
        }
        if (IN(8)) { ENTER();
            pg8::Gemm g{XB2, BtUp, M, NUP, DM, DM}; pg8::StaticOrder S; S.init(M, NUP, F.G, (int)blockIdx.x);
            pg8::EpiGate E{ACT, DFF, EDGE, args.in[I_FCW] + (size_t)layer * 3 * DFF, args.in[I_FCB] + layer * DFF, DFF, (LAS float*)(F.lds + HALO_OFF), RSTD};
            pg8::gemm_phase<pg8::EpiGate, pg8::StaticOrder>(F.lds, g, S, E);
            SEAM(8);
        }
        if (IN(9)) { ENTER();
            const float* fcw = args.in[I_FCW] + (size_t)layer * 3 * DFF;
            for (size_t i = gtid; i < (size_t)(M / 256) * 2 * (DFF / 4); i += gthreads) {
                const int ri = (int)(i / (DFF / 4)), c4 = (int)(i % (DFF / 4)) * 4, pm = ri >> 1, e = ri & 1;
                const float* eb = EDGE + (size_t)(ri * 3) * DFF + c4;
                f32x4 pre = *(const f32x4*)(eb + DFF); const f32x4 v = *(const f32x4*)(eb + 2 * DFF);
                if (e == 0 && (pm & 7) != 0) { const f32x4 gp = *(const f32x4*)(EDGE + (size_t)(((pm - 1) * 2 + 1) * 3) * DFF + c4); pre += *(const f32x4*)(fcw + c4) * gp; }
                if (e == 1 && (pm & 7) != 7) { const f32x4 gn = *(const f32x4*)(EDGE + (size_t)(((pm + 1) * 2 + 0) * 3) * DFF + c4); pre += *(const f32x4*)(fcw + 2 * DFF + c4) * gn; }
                v2u o; o.x = pk2(pg8::silu_f(pre.x) * v.x, pg8::silu_f(pre.y) * v.y); o.y = pk2(pg8::silu_f(pre.z) * v.z, pg8::silu_f(pre.w) * v.w);
                *(v2u*)(ACT + (size_t)(pm * 256 + (e ? 255 : 0)) * DFF + c4) = o;
            }
            SEAM(9);
        }
        if (IN(10)) { ENTER();
            pg8::Gemm g{ACT, BtDn, M, DM, DFF, DFF}; pg8::StaticOrder S; S.init(M, DM, F.G, (int)blockIdx.x);
            pg8::EpiResid16 E{XB2, XA, out, DM, SSQP, (layer + 1 < DEPTH) ? 0 : 1};
            pg8::gemm_phase<pg8::EpiResid16, pg8::StaticOrder>(F.lds, g, S, E);
            SEAM(10);
        }
#undef IN
#undef ENTER
#undef SEAM
    }
}

extern "C" void kernel_launch(void* const* d_in, const int* in_sizes, int n_in, void* d_out, int out_size, void* d_ws, size_t ws_size, hipStream_t stream) {
    static int grid = 0;
    if (grid == 0) {
        if (n_in != N_IN || out_size != M * DM || ws_size < WS_END) { fprintf(stderr, "kernel_launch: unexpected shapes (n_in %d, out %d, ws %zu, need %zu)\n", n_in, out_size, ws_size, (size_t)WS_END); grid = -1; return; }
        int dev = 0, cus = 0;
        if (hipGetDevice(&dev) != hipSuccess || hipDeviceGetAttribute(&cus, hipDeviceAttributeMultiprocessorCount, dev) != hipSuccess) { grid = -1; return; }
        if (hipFuncSetAttribute((const void*)fwd, hipFuncAttributeMaxDynamicSharedMemorySize, LDS_BYTES) != hipSuccess) { fprintf(stderr, "kernel_launch: hipFuncSetAttribute failed\n"); grid = -1; return; }
        int per_cu = 0;
        if (hipOccupancyMaxActiveBlocksPerMultiprocessor(&per_cu, (const void*)fwd, NWAVES * 64, LDS_BYTES) != hipSuccess || per_cu < 1) fprintf(stderr, "kernel_launch: occupancy query reports %d\n", per_cu);
        (void)hipGetLastError();
        grid = cus;
    }
    if (grid < 0) return;
    (void)hipMemsetAsync((char*)d_ws + WS_CTL, 0, CTL_BYTES, stream);
    Args a{};
    for (int i = 0; i < N_IN; ++i) a.in[i] = (const float*)d_in[i];
    a.out = (float*)d_out; a.ws = (unsigned char*)d_ws;
#if MK_ONE_LAUNCH
    a.ph_lo = 0; a.ph_hi = DEPTH * NPH;
    hipLaunchKernelGGL(fwd, dim3(grid), dim3(NWAVES * 64), LDS_BYTES, stream, a);
#else
    for (int p = 0; p < DEPTH * NPH; ++p) { a.ph_lo = p; a.ph_hi = p + 1; hipLaunchKernelGGL(fwd, dim3(grid), dim3(NWAVES * 64), LDS_BYTES, stream, a); }
#endif
    const hipError_t le = hipPeekAtLastError();
    if (le != hipSuccess) fprintf(stderr, "kernel_launch: launch failed: %s\n", hipGetErrorName(le));
}
```

```cpp
#include <hip/hip_runtime.h>
#include <cstdio>
#include <cstdint>
__device__ __forceinline__ int opq(int x) { asm volatile("" : "+v"(x)); return x; }
namespace pg8 {
#define PG8_LAS __attribute__((address_space(3)))
typedef unsigned short bf16_t;
typedef short bf16x8 __attribute__((ext_vector_type(8)));
typedef float f32x4 __attribute__((ext_vector_type(4)));
typedef unsigned u32x4 __attribute__((ext_vector_type(4)));
constexpr int BM = 256, BK = 64, HALF = 128, HTB = HALF * BK * 2  , STAGE_BYTES = 8 * HTB, NXCD = 8, WGM = 8;

__host__ __device__ __forceinline__ int lds_byte(int r, int c) { const int st = (r >> 4) * 2 + (c >> 5), rr = r & 15, cc = c & 31, ob = rr * 64 + cc * 2; return st * 1024 + (ob ^ (((ob >> 9) & 1) << 5)); }
__host__ __device__ __forceinline__ void stage_rc(int b, int& R, int& C) { const int st = b / 1024, sb = b % 1024, swz = sb ^ (((sb >> 9) & 1) << 5); R = (st >> 1) * 16 + swz / 64; C = (st & 1) * 32 + (swz % 64) / 2; }
__host__ __device__ __forceinline__ int perm32(int rho) { const int n = rho >> 4, i = rho & 15; return 8 * (i >> 2) + 4 * n + (i & 3); }

struct Unit { int pm, pn; };
struct Gemm { const bf16_t* A; const bf16_t* Bt; int M, N, K, lda; };

struct StaticOrder {
    int nM, nN, nwg, G, c;
    __host__ __device__ void init(int M, int N, int G_, int c_) { nM = M / BM; nN = N / BM; nwg = nM * nN; G = G_; c = c_; }
    __host__ __device__ bool next(int i, Unit& u) const {
        const long L = (long)i * G + c; if (L >= nwg) return false;
        int wgid = (int)L; { const int q = nwg / NXCD, r = nwg % NXCD, xcd = wgid % NXCD, off = wgid / NXCD; wgid = (xcd < r ? xcd * (q + 1) : r * (q + 1) + (xcd - r) * q) + off; }
        const int nig = WGM * nN, gid = wgid / nig, fm = gid * WGM, gsz = (nM - fm) < WGM ? (nM - fm) : WGM;
        u.pm = fm + ((wgid % nig) % gsz); u.pn = (wgid % nig) / gsz; return true;
    }
    __device__ __forceinline__ void a_ready(const Unit&) const {}
    __device__ __forceinline__ void done(const Unit&) const {}
};

__device__ __forceinline__ unsigned cvt_pk_bf16(float lo, float hi) { unsigned r; asm volatile("v_cvt_pk_bf16_f32 %0, %1, %2" : "=v"(r) : "v"(lo), "v"(hi)); return r; }

__device__ __forceinline__ float dpp_ror1(float v) { return __builtin_bit_cast(float, __builtin_amdgcn_update_dpp(0, __builtin_bit_cast(int, v), 0x121, 0xF, 0xF, false)); }
__device__ __forceinline__ float dpp_ror15(float v) { return __builtin_bit_cast(float, __builtin_amdgcn_update_dpp(0, __builtin_bit_cast(int, v), 0x12F, 0xF, 0xF, false)); }
__device__ __forceinline__ unsigned dpp_swap1(unsigned v) { return (unsigned)__builtin_amdgcn_update_dpp(0, (int)v, 0xB1, 0xF, 0xF, false); }
struct LineOffs { unsigned o0, o1; bool odd; };
__device__ __forceinline__ LineOffs line_offs(unsigned lo, int pitch, int fr) { LineOffs L; L.odd = fr & 1; L.o0 = L.odd ? lo - (unsigned)pitch + 32u : lo; L.o1 = L.odd ? lo + 32u : lo + (unsigned)pitch; return L; }
__device__ __forceinline__ void store_lines(bf16_t* base, const LineOffs& L, u32x4 a, u32x4 b) {
    const u32x4 snd = L.odd ? a : b; u32x4 rcv;
    rcv.x = dpp_swap1(snd.x); rcv.y = dpp_swap1(snd.y); rcv.z = dpp_swap1(snd.z); rcv.w = dpp_swap1(snd.w);
    *(u32x4*)(base + L.o0) = L.odd ? rcv : a;
    *(u32x4*)(base + L.o1) = L.odd ? b : rcv;
}
struct EpiBf16 {
    static constexpr bool PERM = true;
    bf16_t* O; int ldc; const float* rstd;
    __device__ __forceinline__ void operator()(f32x4 (&acc)[2][2][4][2], const Unit& u, int wr, int wc, int fr, int fq) const {
        bf16_t* Ot = O + (size_t)(u.pm * BM) * ldc + u.pn * BM;
        const LineOffs L = line_offs((unsigned)((wr * 64 + fr) * ldc + wc * 64 + 8 * fq), ldc, fr); const int row0 = u.pm * BM + wr * 64 + fr;
        float rsv[8];
#pragma unroll
        for (int i = 0; i < 8; ++i) rsv[i] = rstd ? rstd[row0 + (i >> 2) * HALF + (i & 3) * 16] : 1.0f;
#pragma unroll
        for (int ai = 0; ai < 2; ++ai)
#pragma unroll
            for (int m = 0; m < 4; ++m) { const float rs = rsv[ai * 4 + m];
                u32x4 w[2];
#pragma unroll
                for (int bj = 0; bj < 2; ++bj) { const f32x4 v0 = acc[ai][bj][m][0] * rs, v1 = acc[ai][bj][m][1] * rs;
                    w[bj].x = cvt_pk_bf16(v0[0], v0[1]); w[bj].y = cvt_pk_bf16(v0[2], v0[3]); w[bj].z = cvt_pk_bf16(v1[0], v1[1]); w[bj].w = cvt_pk_bf16(v1[2], v1[3]); }
                store_lines(Ot + (size_t)((ai * HALF + m * 16) * ldc), L, w[0], w[1]);
                asm volatile("" ::: "memory"); }
    }
};
struct EpiResid16 {
    static constexpr bool PERM = true;
    const bf16_t* base; bf16_t* xo; float* out; int ldc; float* ssqp; int f32out;
    __device__ __forceinline__ static void addx(const u32x4 b, const f32x4 a0, const f32x4 a1, f32x4& x0, f32x4& x1) {
        x0[0] = __builtin_bit_cast(float, b.x << 16) + a0[0]; x0[1] = __builtin_bit_cast(float, b.x & 0xffff0000u) + a0[1]; x0[2] = __builtin_bit_cast(float, b.y << 16) + a0[2]; x0[3] = __builtin_bit_cast(float, b.y & 0xffff0000u) + a0[3];
        x1[0] = __builtin_bit_cast(float, b.z << 16) + a1[0]; x1[1] = __builtin_bit_cast(float, b.z & 0xffff0000u) + a1[1]; x1[2] = __builtin_bit_cast(float, b.w << 16) + a1[2]; x1[3] = __builtin_bit_cast(float, b.w & 0xffff0000u) + a1[3]; }
    __device__ __forceinline__ void operator()(f32x4 (&acc)[2][2][4][2], const Unit& u, int wr, int wc, int fr, int fq) const {
        const size_t tb = (size_t)(u.pm * BM) * ldc + u.pn * BM;
        const bf16_t* bs = base + tb;
        const unsigned lo = (unsigned)((wr * 64 + fr) * ldc + wc * 64 + 8 * fq);
        if (f32out != 0) {
            float* op = out + tb;
#pragma unroll
            for (int ai = 0; ai < 2; ++ai)
#pragma unroll
                for (int m = 0; m < 4; ++m) { const unsigned off = lo + (unsigned)((ai * HALF + m * 16) * ldc);
#pragma unroll
                    for (int bj = 0; bj < 2; ++bj) { const u32x4 b = *(const u32x4*)(bs + off + bj * 32); f32x4 x0, x1; addx(b, acc[ai][bj][m][0], acc[ai][bj][m][1], x0, x1);
                        *(f32x4*)(op + off + bj * 32) = x0; *(f32x4*)(op + off + bj * 32 + 4) = x1; }
                    asm volatile("" ::: "memory"); }
            return;
        }
        bf16_t* xp = xo + tb; const LineOffs L = line_offs(lo, ldc, fr);
#pragma unroll
        for (int aim = 0; aim < 4; ++aim) { const int ai = aim >> 1, mp = aim & 1;
            u32x4 bv[2][2];
#pragma unroll
            for (int mm = 0; mm < 2; ++mm)
#pragma unroll
                for (int bj = 0; bj < 2; ++bj) bv[mm][bj] = *(const u32x4*)(bs + lo + (unsigned)((ai * HALF + (2 * mp + mm) * 16) * ldc) + bj * 32);
#pragma unroll
            for (int mm = 0; mm < 2; ++mm) { const int m = 2 * mp + mm; float s = 0.f; u32x4 wv[2];
#pragma unroll
                for (int bj = 0; bj < 2; ++bj) { f32x4 x0, x1; addx(bv[mm][bj], acc[ai][bj][m][0], acc[ai][bj][m][1], x0, x1);
                    wv[bj].x = cvt_pk_bf16(x0[0], x0[1]); wv[bj].y = cvt_pk_bf16(x0[2], x0[3]); wv[bj].z = cvt_pk_bf16(x1[0], x1[1]); wv[bj].w = cvt_pk_bf16(x1[2], x1[3]);
                    s += ((x0[0] * x0[0] + x0[1] * x0[1]) + (x0[2] * x0[2] + x0[3] * x0[3])) + ((x1[0] * x1[0] + x1[1] * x1[1]) + (x1[2] * x1[2] + x1[3] * x1[3])); }
                store_lines(xp + (size_t)((ai * HALF + m * 16) * ldc), L, wv[0], wv[1]);
                s += __shfl_xor(s, 16); s += __shfl_xor(s, 32); if (fq == 0) ssqp[(size_t)(u.pm * BM + wr * 64 + fr + ai * HALF + m * 16) * 32 + u.pn * 4 + wc] = s; }
            asm volatile("" ::: "memory"); }
    }
};
__device__ __forceinline__ float silu_f(float x) { return x * __builtin_amdgcn_rcpf(1.0f + __builtin_amdgcn_exp2f(-1.4426950408889634f * x)); }
struct EpiGate {
    static constexpr bool PERM = true;
    bf16_t* act; int ldact; float* edge; const float* cw; const float* cb; int dff; PG8_LAS float* halo; const float* rstd;
    __device__ __forceinline__ void operator()(f32x4 (&acc)[2][2][4][2], const Unit& u, int wr, int wc, int fr, int fq) const {
        const int lane = fq * 16 + fr; const int colL = wc * 32 + 8 * fq; const int colG = u.pn * HALF + colL;
#pragma unroll
        for (int ai = 0; ai < 2; ++ai)
#pragma unroll
            for (int m = 0; m < 4; ++m) { const float rs = rstd[u.pm * BM + ai * HALF + wr * 64 + m * 16 + fr];
#pragma unroll
                for (int bj = 0; bj < 2; ++bj) { acc[ai][bj][m][0] *= rs; acc[ai][bj][m][1] *= rs; } }
#pragma unroll
        for (int ai = 0; ai < 2; ++ai) { const int q = 2 * ai + wr;
            if (fr == 0) { *(PG8_LAS f32x4*)(halo + (q * 2 + 0) * 128 + colL) = acc[ai][0][0][0]; *(PG8_LAS f32x4*)(halo + (q * 2 + 0) * 128 + colL + 4) = acc[ai][0][0][1]; }
            if (fr == 15) { *(PG8_LAS f32x4*)(halo + (q * 2 + 1) * 128 + colL) = acc[ai][0][3][0]; *(PG8_LAS f32x4*)(halo + (q * 2 + 1) * 128 + colL + 4) = acc[ai][0][3][1]; } }
        asm volatile("s_waitcnt lgkmcnt(0)" ::: "memory"); __builtin_amdgcn_s_barrier(); asm volatile("" ::: "memory");
        bf16_t* actp = act + (size_t)(u.pm * BM) * ldact + colG; const unsigned rlo = (unsigned)((wr * 64 + fr) * ldact);
#pragma unroll
        for (int ai = 0; ai < 2; ++ai) { const int q = 2 * ai + wr;
            typedef unsigned u32x2 __attribute__((ext_vector_type(2)));
            u32x2 pk[4][2];
#pragma unroll
            for (int n = 0; n < 2; ++n) {
                const f32x4 w0 = *(const f32x4*)(cw + colG + 4 * n), w1 = *(const f32x4*)(cw + dff + colG + 4 * n), w2 = *(const f32x4*)(cw + 2 * dff + colG + 4 * n), bb = *(const f32x4*)(cb + colG + 4 * n);
                f32x4 ht = *(PG8_LAS f32x4*)(halo + ((q > 0 ? q - 1 : 0) * 2 + 1) * 128 + colL + 4 * n), hb = *(PG8_LAS f32x4*)(halo + ((q < 3 ? q + 1 : 3) * 2 + 0) * 128 + colL + 4 * n);
                if (q == 0) ht = ht * 0.f; if (q == 3) hb = hb * 0.f;
                f32x4 pre[4];
#pragma unroll
                for (int j = 0; j < 4; ++j) {
                    float g[4], rr[4], rl[4];
#pragma unroll
                    for (int m = 0; m < 4; ++m) { g[m] = acc[ai][0][m][n][j]; rr[m] = dpp_ror1(g[m]); rl[m] = dpp_ror15(g[m]); }
#pragma unroll
                    for (int m = 0; m < 4; ++m) {
                        const float up = (fr > 0) ? rr[m] : (m > 0 ? rr[m > 0 ? m - 1 : 0] : ht[j]);
                        const float dn = (fr < 15) ? rl[m] : (m < 3 ? rl[m < 3 ? m + 1 : 3] : hb[j]);
                        pre[m][j] = w0[j] * up + w1[j] * g[m] + w2[j] * dn + bb[j];
                    }
                }
                if (q == 0 && fr == 0) { float* e = edge + (size_t)((u.pm * 2 + 0) * 3) * dff + colG + 4 * n;
                    *(f32x4*)(e) = acc[ai][0][0][n]; *(f32x4*)(e + dff) = pre[0]; *(f32x4*)(e + 2 * dff) = acc[ai][1][0][n]; }
                if (q == 3 && fr == 15) { float* e = edge + (size_t)((u.pm * 2 + 1) * 3) * dff + colG + 4 * n;
                    *(f32x4*)(e) = acc[ai][0][3][n]; *(f32x4*)(e + dff) = pre[3]; *(f32x4*)(e + 2 * dff) = acc[ai][1][3][n]; }
#pragma unroll
                for (int m = 0; m < 4; ++m) { const f32x4 v = acc[ai][1][m][n];
                    pk[m][n].x = cvt_pk_bf16(silu_f(pre[m][0]) * v[0], silu_f(pre[m][1]) * v[1]); pk[m][n].y = cvt_pk_bf16(silu_f(pre[m][2]) * v[2], silu_f(pre[m][3]) * v[3]); }
            }
#pragma unroll
            for (int m = 0; m < 4; ++m) { u32x4 w; w.x = pk[m][0].x; w.y = pk[m][0].y; w.z = pk[m][1].x; w.w = pk[m][1].y;
                *(u32x4*)(actp + rlo + (unsigned)((ai * HALF + m * 16) * ldact)) = w; }
        }
    }
};

template <class Epi, class Sched>
__device__ __forceinline__ void gemm_phase(PG8_LAS unsigned char* lds, const Gemm g, const Sched& S, const Epi& E) {
    const int tid = opq(threadIdx.x), wid = __builtin_amdgcn_readfirstlane(tid >> 6), lane = tid & 63, wr = wid >> 2, wc = wid & 3, fr = lane & 15, fq = lane >> 4;
    const int K = g.K, nt = K / BK, lda = g.lda;
    unsigned voffA[2], voffB[2];
#pragma unroll
    for (int i = 0; i < 2; ++i) { int R, C; stage_rc(tid * 16 + i * 8192, R, C); const int Rb = Epi::PERM ? (64 * (R >> 5) + perm32(R & 31)) : R;
        voffA[i] = (unsigned)(R * lda + C) * 2u; voffB[i] = (unsigned)(Rb * K + C) * 2u; }
    const size_t kstep = (size_t)(BK * 2);
    const size_t hstepA = (size_t)HALF * lda * 2, hstepB = (size_t)(Epi::PERM ? 32 : HALF) * K * 2;
    const size_t tstepA = 2 * hstepA, tstepB = (size_t)BM * K * 2;
    const unsigned ldsw = (unsigned)wid * 1024u;
    const int aoff = lds_byte(wr * 64 + fr, fq * 8), boff = lds_byte(wc * 32 + fr, fq * 8);
#define PG8_SA(b, h) (((b) * 2 + (h)) * HTB)
#define PG8_SB(b, h) ((4 + (b) * 2 + (h)) * HTB)
#define PG8_STAGE(bufoff, gbase, voff) do { _Pragma("unroll") for (int _i = 0; _i < 2; ++_i) \
        __builtin_amdgcn_global_load_lds((const unsigned*)((const char*)(gbase) + (voff)[_i]), (PG8_LAS unsigned*)(lds + (bufoff) + ldsw + _i * 8192), 16, 0, 0); } while (0)
#define PG8_LDA(dst, b, h) do { _Pragma("unroll") for (int m = 0; m < 4; ++m) _Pragma("unroll") for (int k = 0; k < 2; ++k) dst[m][k] = *(const PG8_LAS bf16x8*)(lds + PG8_SA(b, h) + aoff + m * 2048 + k * 1024); } while (0)
#define PG8_LDB(dst, b, h) do { _Pragma("unroll") for (int n = 0; n < 2; ++n) _Pragma("unroll") for (int k = 0; k < 2; ++k) dst[n][k] = *(const PG8_LAS bf16x8*)(lds + PG8_SB(b, h) + boff + n * 2048 + k * 1024); } while (0)
#define PG8_MMA(ai, bj, At, Bt) do { __builtin_amdgcn_s_setprio(1); _Pragma("unroll") for (int m = 0; m < 4; ++m) _Pragma("unroll") for (int n = 0; n < 2; ++n) _Pragma("unroll") for (int k = 0; k < 2; ++k) \
        acc[ai][bj][m][n] = __builtin_amdgcn_mfma_f32_16x16x32_bf16(Bt[n][k], At[m][k], acc[ai][bj][m][n], 0, 0, 0); __builtin_amdgcn_s_setprio(0); } while (0)
#define PG8_WAIT_V(n) asm volatile("s_waitcnt vmcnt(" #n ")" ::: "memory")
#define PG8_WAIT_L(n) asm volatile("s_waitcnt lgkmcnt(" #n ")" ::: "memory")
#define PG8_BAR __builtin_amdgcn_s_barrier()
#define PG8_SCHED __builtin_amdgcn_sched_barrier(0)
    Unit cur, nxt; int ui = 0;
    if (!S.next(0, cur)) return;
    f32x4 acc[2][2][4][2];
{ float zf = 0.f; asm volatile("" : "+v"(zf));
    #pragma unroll
    for (int a = 0; a < 2; ++a)
#pragma unroll
        for (int b = 0; b < 2; ++b)
#pragma unroll
            for (int m = 0; m < 4; ++m)
#pragma unroll
                for (int n = 0; n < 2; ++n) acc[a][b][m][n] = (f32x4){zf, zf, zf, zf}; }
    bf16x8 At[4][2], B0[2][2], B1[2][2];
    const char* cA = (const char*)g.A + (size_t)cur.pm * tstepA; const char* cB = (const char*)g.Bt + (size_t)cur.pn * tstepB;
    S.a_ready(cur);
    PG8_STAGE(PG8_SB(0, 0), cB, voffB); PG8_STAGE(PG8_SB(0, 1), cB + hstepB, voffB); PG8_STAGE(PG8_SA(0, 0), cA, voffA); PG8_STAGE(PG8_SA(0, 1), cA + hstepA, voffA);
    if (wr == 1) PG8_BAR;
    PG8_WAIT_V(2); PG8_BAR;
    PG8_STAGE(PG8_SB(1, 0), cB + kstep, voffB); PG8_STAGE(PG8_SA(1, 0), cA + kstep, voffA); PG8_STAGE(PG8_SB(1, 1), cB + hstepB + kstep, voffB);
    PG8_WAIT_V(6); PG8_BAR;
    for (;;) {
        const bool has_next = S.next(ui + 1, nxt);
        const char* nA = has_next ? (const char*)g.A + (size_t)nxt.pm * tstepA : cA; const char* nB = has_next ? (const char*)g.Bt + (size_t)nxt.pn * tstepB : cB;
#pragma unroll 1
        for (int t = 0; t < nt; t += 2) {
            const bool last = (t == nt - 2);
            const char* a1 = cA + (size_t)(t + 1) * kstep;
            const char* a2 = last ? nA : cA + (size_t)(t + 2) * kstep; const char* b2 = last ? nB : cB + (size_t)(t + 2) * kstep;
            const char* a3 = a2 + kstep; const char* b3 = b2 + kstep;
            if (last && has_next) S.a_ready(nxt);
            PG8_LDB(B0, 0, 0); PG8_LDB(B1, 0, 1); PG8_SCHED; PG8_LDA(At, 0, 0); PG8_STAGE(PG8_SA(1, 1), a1 + hstepA, voffA);
            PG8_WAIT_V(8); PG8_WAIT_L(0); PG8_BAR; PG8_MMA(0, 0, At, B0); PG8_MMA(0, 1, At, B1); PG8_BAR; PG8_SCHED;
            PG8_LDA(At, 0, 1); PG8_STAGE(PG8_SB(0, 0), b2, voffB); PG8_STAGE(PG8_SB(0, 1), b2 + hstepB, voffB); PG8_STAGE(PG8_SA(0, 0), a2, voffA);
            PG8_WAIT_V(8); PG8_WAIT_L(0); PG8_BAR; PG8_MMA(1, 0, At, B0); PG8_MMA(1, 1, At, B1); PG8_BAR; PG8_SCHED;
            PG8_LDB(B0, 1, 0); PG8_LDB(B1, 1, 1); PG8_SCHED; PG8_LDA(At, 1, 0); PG8_STAGE(PG8_SA(0, 1), a2 + hstepA, voffA);
            PG8_WAIT_V(8); PG8_WAIT_L(0); PG8_BAR; PG8_MMA(0, 0, At, B0); PG8_MMA(0, 1, At, B1); PG8_BAR; PG8_SCHED;
            PG8_LDA(At, 1, 1); PG8_STAGE(PG8_SB(1, 0), b3, voffB); PG8_STAGE(PG8_SB(1, 1), b3 + hstepB, voffB); PG8_STAGE(PG8_SA(1, 0), a3, voffA);
            PG8_WAIT_V(8); PG8_WAIT_L(0); PG8_BAR; PG8_MMA(1, 0, At, B0); PG8_MMA(1, 1, At, B1); PG8_BAR; PG8_SCHED;
        }
        if (wr == 0) PG8_BAR;
        E(acc, cur, wr, wc, fr, fq); S.done(cur);
        if (!has_next) break;
{ float zf = 0.f; asm volatile("" : "+v"(zf));
        #pragma unroll
        for (int a = 0; a < 2; ++a)
#pragma unroll
            for (int b = 0; b < 2; ++b)
#pragma unroll
                for (int m = 0; m < 4; ++m)
#pragma unroll
                    for (int n = 0; n < 2; ++n) acc[a][b][m][n] = (f32x4){zf, zf, zf, zf}; }
        cur = nxt; cA = nA; cB = nB; ++ui;
        if (wr == 1) PG8_BAR;
    }
    PG8_WAIT_V(0);
    PG8_BAR;
#undef PG8_SA
#undef PG8_SB
#undef PG8_STAGE
#undef PG8_LDA
#undef PG8_LDB
#undef PG8_MMA
#undef PG8_WAIT_V
#undef PG8_WAIT_L
#undef PG8_BAR
#undef PG8_SCHED
}
}
namespace at {
using bf16 = unsigned short;
using bf16x8 = __attribute__((ext_vector_type(8))) short;
using s16x4  = __attribute__((ext_vector_type(4))) short;
using f32x16 = __attribute__((ext_vector_type(16))) float;
using u32x4  = __attribute__((ext_vector_type(4))) unsigned;
constexpr int DQK = 192, DV = 128, KVBLK = 64, NW = 8, QBLK = 32;
constexpr float SCALE = 0.07216878364870322f;
constexpr float THR = 8.f;
constexpr int LDQ = 1536, LDK = 2560, LDO = 2048;
constexpr int SHM_V = KVBLK * DV * 2, SHM_K = 12 * 2080;
constexpr int QR_OFF = 2 * SHM_V + 2 * SHM_K + NW * 64 * 4;
constexpr int SHM_ATTN = QR_OFF + NW * 4096;
#define SBAR() __builtin_amdgcn_sched_barrier(0)
constexpr int KPL = 2080;
__host__ __device__ __forceinline__ int k_st(int row, int c) { return (c >> 1) * KPL + row * 32 + (((c & 1) ^ ((row >> 3) & 1)) << 4); }
__host__ __device__ __forceinline__ int k_rd_base(int r32, int hi) { return r32 * 32 + ((hi ^ ((r32 >> 3) & 1)) << 4); }
__device__ __forceinline__ int crow(int r, int hi) { return (r & 3) + 8 * (r >> 2) + 4 * hi; }
__device__ __forceinline__ unsigned cvtpk(float lo, float hi) { unsigned r; asm volatile("v_cvt_pk_bf16_f32 %0, %1, %2" : "=v"(r) : "v"(lo), "v"(hi)); return r; }

__device__ __forceinline__ void partialSM(f32x16& p0, f32x16& p1, float& m_reg, float& mn, float& alpha) {
  constexpr float C = SCALE * 1.4426950408889634f;
  float pmax = p0[0];
#pragma unroll
  for (int r = 1; r < 16; ++r) pmax = fmaxf(pmax, p0[r]);
#pragma unroll
  for (int r = 0; r < 16; ++r) pmax = fmaxf(pmax, p1[r]);
  { auto rr = __builtin_amdgcn_permlane32_swap(__float_as_uint(pmax), __float_as_uint(pmax), false, false);
    pmax = fmaxf(__uint_as_float(rr[0]), __uint_as_float(rr[1])); }
  if (__builtin_expect(__all(pmax - m_reg <= THR / SCALE), 1)) { mn = m_reg; alpha = 1.f; }
  else { mn = fmaxf(m_reg, pmax); alpha = __builtin_amdgcn_exp2f((m_reg - mn) * C); m_reg = mn; }
  float mnC = -mn * C;
#pragma unroll
  for (int r = 0; r < 16; ++r) p0[r] = fmaf(p0[r], C, mnC);
#pragma unroll
  for (int r = 0; r < 16; ++r) p1[r] = fmaf(p1[r], C, mnC);
#pragma unroll
  for (int r = 0; r < 16; ++r) p0[r] = __builtin_amdgcn_exp2f(p0[r]);
}
__device__ __forceinline__ void finishSM(f32x16& p0, f32x16& p1, float alpha, float& l_reg, bf16x8& pa0, bf16x8& pa1, bf16x8& pa2, bf16x8& pa3) {
#pragma unroll
  for (int r = 0; r < 16; ++r) p1[r] = __builtin_amdgcn_exp2f(p1[r]);
  float ps = 0;
#pragma unroll
  for (int r = 0; r < 16; ++r) ps += p0[r];
#pragma unroll
  for (int r = 0; r < 16; ++r) ps += p1[r];
  { auto rr = __builtin_amdgcn_permlane32_swap(__float_as_uint(ps), __float_as_uint(ps), false, false);
    ps = __uint_as_float(rr[0]) + __uint_as_float(rr[1]); }
  l_reg = l_reg * alpha + ps;
#define PK4(P, BASE, OUT) do { unsigned a0 = cvtpk(P[BASE + 0], P[BASE + 1]), a1 = cvtpk(P[BASE + 2], P[BASE + 3]);   \
    unsigned b0 = cvtpk(P[BASE + 4], P[BASE + 5]), b1 = cvtpk(P[BASE + 6], P[BASE + 7]);                              \
    auto r0 = __builtin_amdgcn_permlane32_swap(a0, b0, false, false); auto r1 = __builtin_amdgcn_permlane32_swap(a1, b1, false, false); \
    u32x4 w = {r0[0], r1[0], r0[1], r1[1]}; OUT = *reinterpret_cast<bf16x8*>(&w); } while (0)
  PK4(p0, 0, pa0); PK4(p0, 8, pa1); PK4(p1, 0, pa2); PK4(p1, 8, pa3);
#undef PK4
}
template <int OFF> __device__ __forceinline__ bf16x8 k_read(int kb) {
  bf16x8 r; asm volatile("ds_read_b128 %0, %1 offset:%2" : "=v"(r) : "v"(kb), "i"(OFF) : "memory"); return r;
}
__device__ __forceinline__ void qkt(f32x16& p0, f32x16& p1, int kb, const bf16x8* qr, int qb) {
  p0 = f32x16{}; p1 = f32x16{};
#define QK1(d0) { const bf16x8 b0 = *(const __attribute__((address_space(3))) bf16x8*)(kb + d0 * KPL), b1 = *(const __attribute__((address_space(3))) bf16x8*)(kb + d0 * KPL + 1024); \
    p0 = __builtin_amdgcn_mfma_f32_32x32x16_bf16(b0, qr[d0], p0, 0, 0, 0); p1 = __builtin_amdgcn_mfma_f32_32x32x16_bf16(b1, qr[d0], p1, 0, 0, 0); }
#define QK2(d0) { const bf16x8 b0 = *(const __attribute__((address_space(3))) bf16x8*)(kb + d0 * KPL), b1 = *(const __attribute__((address_space(3))) bf16x8*)(kb + d0 * KPL + 1024); \
    const bf16x8 qf = *(const __attribute__((address_space(3))) bf16x8*)(qb + (d0 - 8) * 1024); \
    p0 = __builtin_amdgcn_mfma_f32_32x32x16_bf16(b0, qf, p0, 0, 0, 0); p1 = __builtin_amdgcn_mfma_f32_32x32x16_bf16(b1, qf, p1, 0, 0, 0); }
  QK1(0) QK1(1) QK1(2) QK1(3) QK1(4) QK1(5) QK1(6) QK1(7) QK2(8) QK2(9) QK2(10) QK2(11)
#undef QK1
#undef QK2
}
__host__ __device__ __forceinline__ int v_st(int k, int c) { const int kk = (k & ~0xC) | ((k & 4) << 1) | ((k & 8) >> 1); return ((kk >> 3) * 4 + (c >> 5)) * 512 + ((kk & 7) * 32 + (c & 31)) * 2; }
__device__ __forceinline__ int v_rd_base(int lane) { return ((lane & 3) << 3) | (((lane >> 2) & 3) << 6) | (((lane >> 4) & 1) << 5) | (((lane >> 5) & 1) << 8); }
constexpr int v_rd_off(int d0, int ks, int half) { return d0 * 512 + ks * 4096 + half * 2048; }
template <int OFF> __device__ __forceinline__ s16x4 tr_read(int vb) {
  s16x4 r; asm volatile("ds_read_b64_tr_b16 %0, %1 offset:%2" : "=&v"(r) : "v"(vb), "i"(OFF) : "memory"); return r;
}
template <int D0> __device__ __forceinline__ void pv_one(f32x16& od, int vb, bf16x8 pa0, bf16x8 pa1, bf16x8 pa2, bf16x8 pa3) {
  const s16x4 l0 = tr_read<v_rd_off(D0, 0, 0)>(vb), h0 = tr_read<v_rd_off(D0, 0, 1)>(vb), l1 = tr_read<v_rd_off(D0, 1, 0)>(vb), h1 = tr_read<v_rd_off(D0, 1, 1)>(vb);
  const s16x4 l2 = tr_read<v_rd_off(D0, 2, 0)>(vb), h2 = tr_read<v_rd_off(D0, 2, 1)>(vb), l3 = tr_read<v_rd_off(D0, 3, 0)>(vb), h3 = tr_read<v_rd_off(D0, 3, 1)>(vb);
  asm volatile("s_waitcnt lgkmcnt(0)" ::: "memory"); SBAR();
#define PK(L, H) (bf16x8){L[0], L[1], L[2], L[3], H[0], H[1], H[2], H[3]}
  od = __builtin_amdgcn_mfma_f32_32x32x16_bf16(pa0, PK(l0, h0), od, 0, 0, 0);
  od = __builtin_amdgcn_mfma_f32_32x32x16_bf16(pa1, PK(l1, h1), od, 0, 0, 0);
  od = __builtin_amdgcn_mfma_f32_32x32x16_bf16(pa2, PK(l2, h2), od, 0, 0, 0);
  od = __builtin_amdgcn_mfma_f32_32x32x16_bf16(pa3, PK(l3, h3), od, 0, 0, 0);
#undef PK
}
__device__ __forceinline__ void pv_d0(f32x16* o, int vb, bf16x8 pa0, bf16x8 pa1, bf16x8 pa2, bf16x8 pa3) {
  pv_one<0>(o[0], vb, pa0, pa1, pa2, pa3); pv_one<1>(o[1], vb, pa0, pa1, pa2, pa3); pv_one<2>(o[2], vb, pa0, pa1, pa2, pa3); pv_one<3>(o[3], vb, pa0, pa1, pa2, pa3);
}

__device__ __forceinline__ void attn_unit(const bf16* __restrict__ Qb, const bf16* __restrict__ Kh, const bf16* __restrict__ Vh, bf16* __restrict__ Ob, int seq, char* lds) {
  const int tid = opq(threadIdx.x), wid = tid >> 6, lane = tid & 63, r32 = lane & 31, hi = lane >> 5;
  char* V_lds = lds; char* K_lds = lds + 2 * SHM_V;
  float* ws = (float*)(lds + 2 * SHM_V + 2 * SHM_K) + wid * 64; float* li_l = ws; float* al_l = ws + 32;
  float m_reg = -1e30f, l_reg = 0; f32x16 o[4] = {}; bf16x8 qr[8];
  const bf16* Qw = Qb + (unsigned)((wid * QBLK + r32) * LDQ + hi * 8);
#pragma unroll
  for (int d0 = 0; d0 < 8; ++d0) qr[d0] = *reinterpret_cast<const bf16x8*>(Qw + d0 * 16);
  const int qb0 = (int)(uintptr_t)lds + QR_OFF + wid * 4096 + k_rd_base(r32, hi);
#pragma unroll
  for (int d0 = 8; d0 < 12; ++d0) *(__attribute__((address_space(3))) bf16x8*)(qb0 + (d0 - 8) * 1024) = *reinterpret_cast<const bf16x8*>(Qw + d0 * 16);
  const int sr = tid >> 4, sc = (tid & 15) * 8, vst0 = v_st(sr, sc), vst1 = v_st(32 + sr, sc);
  unsigned koff[3]; int kst[3];
#pragma unroll
  for (int i = 0; i < 3; ++i) { const int q = tid + 512 * i; koff[i] = (unsigned)((q / 24) * LDK + (q % 24) * 8); kst[i] = k_st(q / 24, q % 24); }
  const unsigned voff0 = (unsigned)(sr * LDK + sc), voff1 = (unsigned)((32 + sr) * LDK + sc);
  const int vb0 = (int)(uintptr_t)V_lds + v_rd_base(lane); const int kb0 = (int)(uintptr_t)K_lds + k_rd_base(r32, hi);
  struct { bf16x8 vs0, vs1, ks0, ks1, ks2; } sr_[1];
#define SLOAD(i, k0) do { const bf16* vt = Vh + (size_t)(k0) * LDK; const bf16* kt = Kh + (size_t)(k0) * LDK; \
    sr_[i].vs0 = *(const bf16x8*)(vt + voff0); sr_[i].vs1 = *(const bf16x8*)(vt + voff1); \
    sr_[i].ks0 = *(const bf16x8*)(kt + koff[0]); sr_[i].ks1 = *(const bf16x8*)(kt + koff[1]); sr_[i].ks2 = *(const bf16x8*)(kt + koff[2]); } while (0)
#define SWRITE(b, i) do { *(bf16x8*)(V_lds + (b) * SHM_V + vst0) = sr_[i].vs0; *(bf16x8*)(V_lds + (b) * SHM_V + vst1) = sr_[i].vs1; \
    *(bf16x8*)(K_lds + (b) * SHM_K + kst[0]) = sr_[i].ks0; *(bf16x8*)(K_lds + (b) * SHM_K + kst[1]) = sr_[i].ks1; *(bf16x8*)(K_lds + (b) * SHM_K + kst[2]) = sr_[i].ks2; } while (0)
#define SWAIT() do { if constexpr (SDEPTH == 2) asm volatile("s_waitcnt vmcnt(5)" ::: "memory"); else asm volatile("s_waitcnt vmcnt(0)" ::: "memory"); } while (0)
#define RESC(a) do { if (__any((a) < 1.f)) { if (hi == 0) al_l[r32] = (a); asm volatile("s_waitcnt lgkmcnt(0)" ::: "memory"); \
    _Pragma("unroll") for (int d = 0; d < 4; ++d) _Pragma("unroll") for (int r = 0; r < 16; ++r) o[d][r] *= al_l[crow(r, hi)]; } } while (0)
  f32x16 pA0, pA1, pB0, pB1; float mnA, mnB, alA, alB; bf16x8 pa0, pa1, pa2, pa3; const int NT = seq / KVBLK;
  SLOAD(0, 0); asm volatile("s_waitcnt vmcnt(0)" ::: "memory"); SWRITE(0, 0); __syncthreads();
  qkt(pA0, pA1, kb0, qr, qb0); partialSM(pA0, pA1, m_reg, mnA, alA);
  SLOAD(0, KVBLK);
  asm volatile("s_waitcnt vmcnt(0)" ::: "memory"); SWRITE(1, 0); __syncthreads();
  for (int j = 1; j + 1 < NT; j += 2) {
    SBAR(); qkt(pB0, pB1, kb0 + SHM_K, qr, qb0);
    finishSM(pA0, pA1, alA, l_reg, pa0, pa1, pa2, pa3); SBAR();
    SLOAD(0, (j + 1) * KVBLK); SBAR();
    pv_d0(o, vb0, pa0, pa1, pa2, pa3); partialSM(pB0, pB1, m_reg, mnB, alB);
    __syncthreads(); asm volatile("s_waitcnt vmcnt(0)" ::: "memory"); SWRITE(0, 0);
    RESC(alB); __syncthreads();
    SBAR(); qkt(pA0, pA1, kb0, qr, qb0);
    finishSM(pB0, pB1, alB, l_reg, pa0, pa1, pa2, pa3); SBAR();
    SLOAD(0, (j + 2) * KVBLK); SBAR();
    pv_d0(o, vb0 + (int)SHM_V, pa0, pa1, pa2, pa3); partialSM(pA0, pA1, m_reg, mnA, alA);
    __syncthreads(); asm volatile("s_waitcnt vmcnt(0)" ::: "memory"); SWRITE(1, 0);
    RESC(alA); __syncthreads();
  }
  SBAR(); qkt(pB0, pB1, kb0 + SHM_K, qr, qb0);
  finishSM(pA0, pA1, alA, l_reg, pa0, pa1, pa2, pa3); SBAR();
  pv_d0(o, vb0, pa0, pa1, pa2, pa3); partialSM(pB0, pB1, m_reg, mnB, alB);
  __syncthreads(); RESC(alB);
  finishSM(pB0, pB1, alB, l_reg, pa0, pa1, pa2, pa3); SBAR();
  pv_d0(o, vb0 + (int)SHM_V, pa0, pa1, pa2, pa3);
  if (hi == 0) li_l[r32] = l_reg; asm volatile("s_waitcnt lgkmcnt(0)" ::: "memory");
  bf16* Ow = Ob + (unsigned)(wid * QBLK * LDO + r32);
#pragma unroll
  for (int r = 0; r < 16; ++r) { const int orow = crow(r, hi); const float rl = __builtin_amdgcn_rcpf(li_l[orow]);
#pragma unroll
    for (int d0 = 0; d0 < 4; ++d0) { const unsigned w = cvtpk(o[d0][r] * rl, 0.f); Ow[(unsigned)(orow * LDO + d0 * 32)] = (bf16)(w & 0xffffu); } }
  __syncthreads();
#undef SLOAD
#undef SWRITE
#undef SWAIT
#undef RESC
}
}
namespace hy {
#define HY_LAS __attribute__((address_space(3)))
typedef unsigned short bf16;
typedef short bf16x8 __attribute__((ext_vector_type(8)));
typedef float f32x16 __attribute__((ext_vector_type(16)));
typedef unsigned u32x2 __attribute__((ext_vector_type(2)));
typedef unsigned u32x4 __attribute__((ext_vector_type(4)));
constexpr int L = 2048, NB = 24, CH = 512;
constexpr int RFS = 4112;
constexpr int ZROW = 4112;
constexpr int ZL_BYTES = NB * ZROW;
constexpr int RCS = 8256;
constexpr int RC_OFF = ZL_BYTES;
constexpr int HY_LDS_BYTES = RC_OFF + 4 * RCS;
__device__ __forceinline__ unsigned cvtpk(float lo, float hi) { unsigned r; asm volatile("v_cvt_pk_bf16_f32 %0, %1, %2" : "=v"(r) : "v"(lo), "v"(hi)); return r; }
__host__ __device__ __forceinline__ int frag_base(int tw, int r, int h) { const int a = (4 - (r & 3)) & 3; return RC_OFF + a * RCS + 2 * (2048 - tw - r + 8 * h - a); }
__host__ __device__ __forceinline__ int zfrag_base(int r, int h) { return (r < NB ? r : NB - 1) * ZROW + 16 * h; }

__device__ __forceinline__ bf16x8 ld_frag(HY_LAS unsigned char* lds, int off) {
    const u32x2 lo = *(const HY_LAS u32x2*)(lds + off), hi = *(const HY_LAS u32x2*)(lds + off + 8);
    u32x4 w = {lo.x, lo.y, hi.x, hi.y}; return *reinterpret_cast<bf16x8*>(&w);
}
__device__ __forceinline__ bf16x8 ld_b128(HY_LAS unsigned char* lds, int off) { return *(const HY_LAS bf16x8*)(lds + off); }

__device__ __forceinline__ void conv_unit(HY_LAS unsigned char* lds, const bf16* __restrict__ ZT, const bf16* __restrict__ RF, bf16* __restrict__ YC, int c, int half) {
    const int tid = opq(threadIdx.x), wid = tid >> 6, lane = tid & 63, r = lane & 31, h = lane >> 5;
    { const u32x4* src = (const u32x4*)(ZT + (size_t)c * NB * L);
#pragma unroll
      for (int i = 0; i < 12; ++i) { const int q = tid + 512 * i; const u32x4 v = src[q]; *(HY_LAS u32x4*)(lds + (q >> 8) * ZROW + (q & 255) * 16) = v; } }
    { const bf16* rf = RF + (size_t)c * RFS;
      for (int ch = tid; ch < RFS / 8; ch += 512) {
          const u32x4 v = *(const u32x4*)(rf + ch * 8); const unsigned w[4] = {v.x, v.y, v.z, v.w};
#pragma unroll
          for (int j = 0; j < 8; ++j) { const unsigned short e = (unsigned short)((w[j >> 1] >> ((j & 1) * 16)) & 0xffffu); const int idx = ch * 8 + j;
#pragma unroll
              for (int a = 0; a < 4; ++a) if (idx - a >= 0) *(HY_LAS unsigned short*)(lds + RC_OFF + a * RCS + 2 * (idx - a)) = e; } } }
    __syncthreads();
    const int tw = half * 1024 + wid * 128;
    const int fb = frag_base(tw, r, h), zb = zfrag_base(r, h);
    f32x16 acc[4] = {};
    bf16x8 S0[2], S1[2], S2[2], S3[2], Bc[2], Bn[2];
#define HY_LDG(S, d) do { S[0] = ld_frag(lds, fb + 64 * (d)); S[1] = ld_frag(lds, fb + 64 * (d) + 32); } while (0)
#define HY_LDB(Bx, n) do { Bx[0] = ld_b128(lds, zb + 64 * (n)); Bx[1] = ld_b128(lds, zb + 64 * (n) + 32); } while (0)
#define HY_MM(i, S, Bx) do { acc[i] = __builtin_amdgcn_mfma_f32_32x32x16_bf16(S[0], Bx[0], acc[i], 0, 0, 0); acc[i] = __builtin_amdgcn_mfma_f32_32x32x16_bf16(S[1], Bx[1], acc[i], 0, 0, 0); } while (0)
#define HY_ITER(n, Sa, Sb, Sc, Sd, Bcur, Bnext) do { HY_LDG(Sa, (n)); if ((n) + 1 < 64) HY_LDB(Bnext, (n) + 1); \
        HY_MM(1, Sb, Bcur); HY_MM(2, Sc, Bcur); HY_MM(3, Sd, Bcur); HY_MM(0, Sa, Bcur); } while (0)
    HY_LDG(S3, -1); HY_LDG(S2, -2); HY_LDG(S1, -3); HY_LDB(Bc, 0);
    for (int n = 0; n < 64; n += 4) {
        HY_ITER(n, S0, S3, S2, S1, Bc, Bn);
        HY_ITER(n + 1, S1, S0, S3, S2, Bn, Bc);
        HY_ITER(n + 2, S2, S1, S0, S3, Bc, Bn);
        HY_ITER(n + 3, S3, S2, S1, S0, Bn, Bc);
    }
#undef HY_LDG
#undef HY_LDB
#undef HY_MM
#undef HY_ITER
    if (r < NB) { bf16* yp = YC + ((size_t)c * NB + r) * L + tw + 4 * h;
#pragma unroll
        for (int i = 0; i < 4; ++i)
#pragma unroll
            for (int q4 = 0; q4 < 4; ++q4) { u32x2 w; w.x = cvtpk(acc[i][4 * q4 + 0], acc[i][4 * q4 + 1]); w.y = cvtpk(acc[i][4 * q4 + 2], acc[i][4 * q4 + 3]);
                *(u32x2*)(yp + 32 * i + 8 * q4) = w; } }
    __syncthreads();
}
}
constexpr int NWAVES = 8;
#ifndef MK_ONE_LAUNCH
#define MK_ONE_LAUNCH 1
#endif
constexpr int DM = 2048, NSEQ = 24, SEQ = 2048, M = NSEQ * SEQ, MP = 8 * SEQ;
constexpr int DEPTH = 4;
constexpr int DIN = 2880, DINP = 3072;
constexpr int O_CQ = 512, O_CKV = 1024, O_KPE = 1280, O_HY = 1344;
constexpr int NH = 8, NQ = 1536, NKVP = 2560, KVHS = 320;
constexpr int DFF = 5632, NUP = 11264, HYC = 512;
constexpr float EPS = 1e-6f;
constexpr int NPH = 11;
constexpr size_t WS_CTL = 0, CTL_BYTES = 1u << 20;
constexpr size_t SZ_BTIN = (size_t)DINP * DM * 2, SZ_BTUQ = (size_t)NQ * 512 * 2, SZ_BTKV = (size_t)NKVP * 256 * 2, SZ_BTOUT = (size_t)DM * DM * 2, SZ_BTUP = (size_t)NUP * DM * 2, SZ_BTDN = (size_t)DM * DFF * 2;
constexpr size_t WS_BTIN = WS_CTL + CTL_BYTES, WS_BTUQ = WS_BTIN + SZ_BTIN, WS_BTKV = WS_BTUQ + SZ_BTUQ, WS_BTOUT = WS_BTKV + SZ_BTKV, WS_BTUP = WS_BTOUT + SZ_BTOUT, WS_BTDN = WS_BTUP + SZ_BTUP;
constexpr size_t WS_RF = WS_BTDN + SZ_BTDN, SZ_RF = (size_t)HYC * hy::RFS * 2;
constexpr size_t WS_H = WS_RF + SZ_RF, SZ_H = (size_t)M * DM * 2;
constexpr size_t WS_PROJ = WS_H + SZ_H, SZ_PROJ = (size_t)M * DINP * 2;
constexpr size_t WS_Q = WS_PROJ + SZ_PROJ, SZ_Q = (size_t)M * NQ * 2;
constexpr size_t WS_KV = WS_Q + SZ_Q, SZ_KV = (size_t)M * NKVP * 2;
constexpr size_t WS_ZT = WS_KV + SZ_KV, SZ_ZT = (size_t)HYC * NSEQ * SEQ * 2;
constexpr size_t WS_X0 = WS_ZT + SZ_ZT, WS_YC = WS_X0 + SZ_ZT;
constexpr size_t WS_EDGE = WS_YC + SZ_ZT, SZ_EDGE = (size_t)(M / 256) * 2 * 3 * DFF * 4;
constexpr size_t WS_ROPE = WS_EDGE + SZ_EDGE, SZ_ROPE = (size_t)SEQ * 64 * 4;
constexpr size_t WS_SSQP = WS_ROPE + SZ_ROPE, SZ_SSQP = (size_t)M * 32 * 4;
constexpr size_t WS_RSTD = WS_SSQP + SZ_SSQP, SZ_RSTD = (size_t)M * 4;
constexpr size_t WS_END = WS_RSTD + SZ_RSTD;
constexpr size_t WS_ACT = WS_PROJ;
static_assert((size_t)M * DFF * 2 <= SZ_PROJ + SZ_Q + SZ_KV, "ACT overlay");
constexpr size_t WS_XB2 = WS_ACT + (size_t)M * DFF * 2;
static_assert(WS_XB2 + (size_t)M * DM * 2 <= WS_EDGE && WS_XB2 % 256 == 0, "XB2 overlay");
static_assert(WS_BTIN % 256 == 0 && WS_RF % 256 == 0 && WS_H % 256 == 0 && WS_PROJ % 256 == 0 && WS_Q % 256 == 0 && WS_KV % 256 == 0 && WS_ZT % 256 == 0 && WS_EDGE % 256 == 0, "alignment");
constexpr int CW_BAR = 4096;
constexpr int RING_BYTES = 135168;
constexpr int HALO_OFF = RING_BYTES, HALO_BYTES = 4096;
constexpr int MISC_OFF = HALO_OFF + HALO_BYTES;
constexpr int LDS_BYTES = 147456;
static_assert(hy::HY_LDS_BYTES <= RING_BYTES && at::SHM_ATTN <= RING_BYTES && MISC_OFF + 256 <= LDS_BYTES, "LDS map");

#define GAS __attribute__((address_space(1)))
#define LAS __attribute__((address_space(3)))
typedef unsigned short bf16;
typedef unsigned v4u __attribute__((ext_vector_type(4)));
typedef unsigned v2u __attribute__((ext_vector_type(2)));
typedef float f32x4 __attribute__((ext_vector_type(4)));
#define LDS_WAIT() asm volatile("s_waitcnt lgkmcnt(0)" ::: "memory")
__device__ __forceinline__ unsigned f2bf(float f) { unsigned u = __builtin_bit_cast(unsigned, f); return (u + 0x7fffu + ((u >> 16) & 1u)) >> 16; }
__device__ __forceinline__ unsigned pk2(float lo, float hi) { return f2bf(lo) | (f2bf(hi) << 16); }
__device__ __forceinline__ float bf2f(unsigned short b) { return __builtin_bit_cast(float, (unsigned)b << 16); }
__device__ __forceinline__ float bflo(unsigned w) { return __builtin_bit_cast(float, w << 16); }
__device__ __forceinline__ float bfhi(unsigned w) { return __builtin_bit_cast(float, w & 0xffff0000u); }
__device__ __forceinline__ float wave_sum(float v) {
#pragma unroll
    for (int o = 1; o < 64; o <<= 1) v += __shfl_xor(v, o);
    return v;
}

#define XB_TMO      128
#define XB_XCNT(j)  (256  + 64 * (j))
#define XB_XSUB(j)  (1280 + 64 * (j))
#define XB_XGEN(j)  (2304 + 64 * (j))
#define XB_TOP      3328
#define XB_TOPGEN   3392
#define XCD_BAR_WORDS 3456
#define XB_SPIN_CAP (1u << 18)
__device__ __forceinline__ unsigned xb_ld(unsigned* p)              { return __hip_atomic_load(p, __ATOMIC_RELAXED, __HIP_MEMORY_SCOPE_AGENT); }
__device__ __forceinline__ unsigned xb_add(unsigned* p, unsigned v) { return __hip_atomic_fetch_add(p, v, __ATOMIC_RELAXED, __HIP_MEMORY_SCOPE_AGENT); }
__device__ __forceinline__ unsigned xb_xcc_id() { return (unsigned)__builtin_amdgcn_s_getreg((3 << 11) | 20) & 0xFu; }
#define XB_SPIN(cond, bar) do { unsigned _sp = 0; while (cond) { __builtin_amdgcn_s_sleep(1); \
    if ((++_sp & 255u) == 0u) { if (xb_ld(&(bar)[XB_TMO])) break; if (_sp > XB_SPIN_CAP) { atomicAdd(&(bar)[XB_TMO], 1u); break; } } } } while (0)
struct XcdBarrier { unsigned* bar; unsigned x; volatile LAS unsigned* st; };
__device__ __forceinline__ XcdBarrier xcd_barrier_post(unsigned* bar, volatile LAS unsigned* st) {
    XcdBarrier b; b.bar = bar; b.x = xb_xcc_id(); b.st = st;
    if (threadIdx.x == 0) (void)xb_add(&bar[XB_XCNT(b.x)], 1u);
    return b;
}
__device__ __forceinline__ void xcd_barrier_complete(unsigned* bar, unsigned x, unsigned& nloc, unsigned& nx) {
    const unsigned G = gridDim.x * gridDim.y * gridDim.z;
    unsigned sum, cnt, mine, sp = 0u;
    for (;;) {
        sum = 0u; cnt = 0u; mine = 0u;
#pragma unroll
        for (unsigned j = 0; j < 16; ++j) { const unsigned c = xb_ld(&bar[XB_XCNT(j)]); sum += c; cnt += (c > 0u) ? 1u : 0u; mine = (j == x) ? c : mine; }
        if (sum == G) break;
        __builtin_amdgcn_s_sleep(1);
        if ((++sp & 255u) == 0u) { if (xb_ld(&bar[XB_TMO])) break; if (sp > XB_SPIN_CAP) { atomicAdd(&bar[XB_TMO], 1u); break; } }
    }
    nloc = mine > 0u ? mine : 1u; nx = cnt > 0u ? cnt : 1u;
}
__device__ __forceinline__ void xcd_barrier(const XcdBarrier& b) {
    asm volatile("s_waitcnt vmcnt(0)" ::: "memory");
    __syncthreads();
    if (threadIdx.x == 0) {
        unsigned* bar = b.bar;
        __builtin_amdgcn_s_waitcnt(0);
        unsigned nloc = b.st[0], nx = b.st[1];
        if (nloc == 0u) { xcd_barrier_complete(bar, b.x, nloc, nx); b.st[0] = nloc; b.st[1] = nx; }
        const unsigned old = xb_add(&bar[XB_XSUB(b.x)], 1u);
        const unsigned gen = old / nloc;
        if (old + 1u == (gen + 1u) * nloc) {
            __builtin_amdgcn_fence(__ATOMIC_RELEASE, "agent");
            asm volatile("s_waitcnt vmcnt(0)" ::: "memory");
            const unsigned og = xb_add(&bar[XB_TOP], 1u);
            const unsigned tg = og / nx;
            if (og + 1u == (tg + 1u) * nx) xb_add(&bar[XB_TOPGEN], 1u);
            else XB_SPIN(xb_ld(&bar[XB_TOPGEN]) == tg, bar);
            __builtin_amdgcn_fence(__ATOMIC_ACQUIRE, "agent");
            xb_add(&bar[XB_XGEN(b.x)], 1u);
            asm volatile("s_waitcnt vmcnt(0)" ::: "memory");
        } else {
            XB_SPIN(xb_ld(&bar[XB_XGEN(b.x)]) == gen, bar);
            __builtin_amdgcn_fence(__ATOMIC_ACQUIRE, "agent");
            asm volatile("s_waitcnt vmcnt(0)" ::: "memory");
        }
    }
    __syncthreads();
}

struct Frame {
    LAS unsigned char* lds;
    int tid, lane, wave, vcu, G;
};
enum { I_XP = 0, I_XS, I_ANG, I_WIN, I_PW, I_PS, I_QNG, I_WUQ, I_KVNG, I_WUKV, I_QHG, I_KHG, I_HCW, I_HCB, I_FW1, I_FB1, I_FFR, I_FW2, I_FB2, I_FW3, I_FB3, I_HBIAS, I_GNG, I_WOUT, I_FNG, I_WUP, I_FCW, I_FCB, I_WDN, N_IN };
struct Args { const float* in[N_IN]; float* out; unsigned char* ws; int ph_lo, ph_hi; };
static_assert(sizeof(Args) == (N_IN + 2) * 8 + 8, "Args has no padding");

__device__ __forceinline__ void cvt_item(const float* __restrict__ W, int ldw, int K, bf16* WT, int dst_n0, int src_n0, int k0, const float* __restrict__ ks, LAS float* scr, int lane) {
#pragma unroll
    for (int i = 0; i < 32; ++i) { const int kk = 2 * i + (lane >> 5); float v = W[(size_t)(k0 + kk) * ldw + src_n0 + (lane & 31)]; if (ks) v *= ks[k0 + kk]; scr[kk * 33 + (lane & 31)] = v; }
    LDS_WAIT(); asm volatile("" ::: "memory");
    const int c = lane & 7;
#pragma unroll
    for (int j = 0; j < 4; ++j) { const int n = (lane >> 3) + 8 * j; const LAS float* s = scr + (8 * c) * 33 + n;
        v4u o; o.x = pk2(s[0 * 33], s[1 * 33]); o.y = pk2(s[2 * 33], s[3 * 33]); o.z = pk2(s[4 * 33], s[5 * 33]); o.w = pk2(s[6 * 33], s[7 * 33]);
        *(v4u*)(WT + (size_t)(dst_n0 + n) * K + k0 + 8 * c) = o; }
    LDS_WAIT(); asm volatile("" ::: "memory");
}
struct CvtTile { const float* W; const float* ks; bf16* WT; int ldw, K, src_n0, k0, ncols; int dst[4]; };
__device__ __forceinline__ void cvt_tile(Frame& F, const CvtTile& d) {
    LAS float* T = (LAS float*)F.lds;
#pragma unroll
    for (int i = 0; i < 8; ++i) { const int q = F.tid + 512 * i, row = q >> 5, c4 = q & 31;
        f32x4 v = {0.f, 0.f, 0.f, 0.f};
        if (d.src_n0 + 4 * c4 < d.ncols) v = *(const f32x4*)(d.W + (size_t)(d.k0 + row) * d.ldw + d.src_n0 + 4 * c4);
        if (d.ks) v *= d.ks[d.k0 + row];
        LAS float* t = T + row * 129 + 4 * c4; t[0] = v.x; t[1] = v.y; t[2] = v.z; t[3] = v.w; }
    __syncthreads();
#pragma unroll
    for (int i = 0; i < 4; ++i) { const int n = (F.tid >> 4) + 32 * i, kc = F.tid & 15;
        if (d.src_n0 + n < d.ncols) { const LAS float* s = T + (8 * kc) * 129 + n;
            v4u o; o.x = pk2(s[0], s[129]); o.y = pk2(s[2 * 129], s[3 * 129]); o.z = pk2(s[4 * 129], s[5 * 129]); o.w = pk2(s[6 * 129], s[7 * 129]);
            *(v4u*)(d.WT + (size_t)(d.dst[i] + (n & 31)) * d.K + d.k0 + 8 * kc) = o; } }
    __syncthreads();
}
__device__ __forceinline__ void xb_row(const float* xrow, bf16* orow, float* rstd, int lane) {
    const f32x4* xr = (const f32x4*)xrow + lane;
    f32x4 v[8]; float s = 0.f;
#pragma unroll
    for (int j = 0; j < 8; ++j) { v[j] = xr[64 * j]; s += (v[j].x * v[j].x + v[j].y * v[j].y) + (v[j].z * v[j].z + v[j].w * v[j].w); }
    const float r = 1.0f / sqrtf(wave_sum(s) * (1.f / DM) + EPS);
    if (lane == 0) *rstd = r;
    v2u* o8 = (v2u*)orow + lane;
#pragma unroll
    for (int j = 0; j < 8; ++j) { v2u w; w.x = pk2(v[j].x, v[j].y); w.y = pk2(v[j].z, v[j].w); o8[64 * j] = w; }
}
__device__ __forceinline__ void rstd_from_partials(const float* __restrict__ ssqp, float* rstd, size_t gtid, size_t gthreads) {
    for (size_t r = gtid; r < (size_t)M; r += gthreads) { const f32x4* p = (const f32x4*)(ssqp + r * 32); f32x4 a = p[0];
#pragma unroll
        for (int i = 1; i < 8; ++i) a += p[i];
        rstd[r] = 1.0f / sqrtf(((a.x + a.y) + (a.z + a.w)) * (1.f / DM) + EPS); }
}
__device__ __forceinline__ void tile_norm_store(LAS float* tile, bf16* dst, int row0, int col_off, int wave, int lane) {
#pragma unroll
    for (int i = 0; i < 8; ++i) { const int t = wave * 8 + i;
        const f32x4 a = *(LAS f32x4*)(tile + t * 512 + 8 * lane), b = *(LAS f32x4*)(tile + t * 512 + 8 * lane + 4);
        const float s = (a.x * a.x + a.y * a.y) + (a.z * a.z + a.w * a.w) + (b.x * b.x + b.y * b.y) + (b.z * b.z + b.w * b.w);
        const float rstd = 1.0f / sqrtf(wave_sum(s) * (1.f / 512.f) + EPS);
        v4u o; o.x = pk2(a.x * rstd, a.y * rstd); o.y = pk2(a.z * rstd, a.w * rstd); o.z = pk2(b.x * rstd, b.y * rstd); o.w = pk2(b.z * rstd, b.w * rstd);
        *(v4u*)(dst + (size_t)(row0 + t) * DM + col_off + 8 * lane) = o; }
}
__device__ __forceinline__ void poolfold_item(Frame& F, const float* __restrict__ win, const float* __restrict__ pw, const float* __restrict__ ps, const float* __restrict__ g1, bf16* BtIn, int g, int kb) {
    LAS float* At = (LAS float*)F.lds; LAS float* Bt = (LAS float*)(F.lds + 32768);
    const int k0 = 64 * kb;
#pragma unroll
    for (int i = 0; i < 4; ++i) { const int q = F.tid + 512 * i, row = q >> 5, c4 = q & 31; *(LAS f32x4*)(At + row * 128 + 4 * c4) = *(const f32x4*)(win + (size_t)(k0 + row) * DIN + 128 * g + 4 * c4) * g1[k0 + row]; }
#pragma unroll
    for (int i = 0; i < 8; ++i) { const int q = F.tid + 512 * i, row = q >> 5, c4 = q & 31; *(LAS f32x4*)(Bt + row * 128 + 4 * c4) = *(const f32x4*)(pw + (size_t)(g * 128 + row) * 128 + 4 * c4); }
    __syncthreads();
    const int n = F.tid & 127, kg = F.tid >> 7;
    float acc[16];
#pragma unroll
    for (int i = 0; i < 16; ++i) acc[i] = 0.f;
    for (int j = 0; j < 128; j += 4) {
        const float b0 = Bt[(j + 0) * 128 + n], b1 = Bt[(j + 1) * 128 + n], b2 = Bt[(j + 2) * 128 + n], b3 = Bt[(j + 3) * 128 + n];
#pragma unroll
        for (int i = 0; i < 16; ++i) { const f32x4 a = *(LAS f32x4*)(At + (kg * 16 + i) * 128 + j); acc[i] += a.x * b0 + a.y * b1 + a.z * b2 + a.w * b3; }
    }
    const float sc = ps[128 * g + n];
    v4u o0, o1;
    o0.x = pk2(acc[0] * sc, acc[1] * sc); o0.y = pk2(acc[2] * sc, acc[3] * sc); o0.z = pk2(acc[4] * sc, acc[5] * sc); o0.w = pk2(acc[6] * sc, acc[7] * sc);
    o1.x = pk2(acc[8] * sc, acc[9] * sc); o1.y = pk2(acc[10] * sc, acc[11] * sc); o1.z = pk2(acc[12] * sc, acc[13] * sc); o1.w = pk2(acc[14] * sc, acc[15] * sc);
    bf16* dst = BtIn + (size_t)(128 * g + n) * DM + k0 + kg * 16;
    *(v4u*)dst = o0; *(v4u*)(dst + 8) = o1;
    __syncthreads();
}
__device__ __forceinline__ void filter_item(Frame& F, const float* __restrict__ w1, const float* __restrict__ b1, const float* __restrict__ fr, const float* __restrict__ w2, const float* __restrict__ b2,
                                            const float* __restrict__ w3, const float* __restrict__ b3, const float* __restrict__ hbias, bf16* RF, int fi) {
    LAS float* ZF = (LAS float*)F.lds; LAS float* H1 = ZF + 512; LAS float* H2 = ZF + 1536; LAS float* W1s = ZF + 2560; LAS float* W2s = ZF + 3712;
    const int t0 = 16 * fi;
    for (int q = F.tid; q < 272; q += 512) *(LAS f32x4*)(W1s + 4 * q) = *(const f32x4*)(w1 + 4 * q);
#pragma unroll
    for (int i = 0; i < 2; ++i) { const int q = F.tid + 512 * i; *(LAS f32x4*)(W2s + 4 * q) = *(const f32x4*)(w2 + 4 * q); }
    if (F.tid < 272) { const int tt = F.tid / 17, f = F.tid % 17; const float t = (float)(t0 + tt);
        float v;
        if (f == 0) v = t / 2047.0f;
        else { const int j = (f - 1) & 7; const float band = 1e-4f + (float)j * ((7.0f - 1e-4f) / 7.0f); const float w = (6.283185307179586f * t) / 2048.0f; const float a = band * w; v = (f <= 8) ? __cosf(a) : -__sinf(a); }
        ZF[tt * 17 + f] = v; }
    __syncthreads();
#pragma unroll
    for (int rep = 0; rep < 2; ++rep) { const int p = F.tid + 512 * rep, tt = p >> 6, j = p & 63; float s = b1[j];
#pragma unroll
        for (int i = 0; i < 17; ++i) s += ZF[tt * 17 + i] * W1s[i * 64 + j];
        H1[tt * 64 + j] = __sinf(fr[j] * s); }
    __syncthreads();
#pragma unroll
    for (int rep = 0; rep < 2; ++rep) { const int p = F.tid + 512 * rep, tt = p >> 6, j = p & 63; float s = b2[j];
#pragma unroll 16
        for (int i = 0; i < 64; ++i) s += H1[tt * 64 + i] * W2s[i * 64 + j];
        H2[tt * 64 + j] = __sinf(fr[j] * s); }
    __syncthreads();
    const int c = F.tid;
    const float delta = -3.0701134573253944f + (float)c * ((-15.350567286626972f + 3.0701134573253944f) / 511.0f);
    const float ad = fabsf(delta);
    bf16* rf = RF + (size_t)c * hy::RFS;
#pragma unroll 1
    for (int dir = 0; dir < 2; ++dir) { const int o = dir * 512 + c; const float bo = b3[o];
        float wc[64];
#pragma unroll
        for (int i = 0; i < 64; ++i) wc[i] = w3[i * 1024 + o];
#pragma unroll 1
        for (int tt = 0; tt < 16; ++tt) { float s = bo;
#pragma unroll
            for (int i = 0; i < 64; i += 4) { const f32x4 hv = *(LAS f32x4*)(H2 + tt * 64 + i); s += (hv.x * wc[i] + hv.y * wc[i + 1]) + (hv.z * wc[i + 2] + hv.w * wc[i + 3]); }
            const int t = t0 + tt; const float tl = (float)t / 2047.0f; float val = s * __expf(-tl * ad);
            if (dir == 0) { if (t == 0) val += hbias[c]; rf[2048 - t] = (bf16)f2bf(val); }
            else if (t >= 1) rf[2048 + t] = (bf16)f2bf(val); } }
    if (fi == 0) { rf[0] = 0;
#pragma unroll
        for (int i = 4096; i < hy::RFS; ++i) rf[i] = 0; }
    __syncthreads();
}
__device__ __forceinline__ void unpack4(const v2u w, float (&x)[4]) { x[0] = bflo(w.x); x[1] = bfhi(w.x); x[2] = bflo(w.y); x[3] = bfhi(w.y); }
__device__ __forceinline__ void pair_norm_store(Frame& F, const float (&y)[8][4], bf16* dst, size_t row0, int col_off, int cq) {
    LAS float* part = (LAS float*)F.lds;
    float ss[8];
#pragma unroll
    for (int k = 0; k < 8; ++k) ss[k] = wave_sum((y[k][0] * y[k][0] + y[k][1] * y[k][1]) + (y[k][2] * y[k][2] + y[k][3] * y[k][3]));
    if (F.lane == 0) { *(LAS f32x4*)(part + F.wave * 8) = (f32x4){ss[0], ss[1], ss[2], ss[3]}; *(LAS f32x4*)(part + F.wave * 8 + 4) = (f32x4){ss[4], ss[5], ss[6], ss[7]}; }
    __syncthreads();
    const f32x4 pa = *(LAS f32x4*)(part + (F.wave ^ 1) * 8), pb = *(LAS f32x4*)(part + (F.wave ^ 1) * 8 + 4);
    const float po[8] = {pa.x, pa.y, pa.z, pa.w, pb.x, pb.y, pb.z, pb.w};
#pragma unroll
    for (int k = 0; k < 8; ++k) { const float rstd = 1.0f / sqrtf((ss[k] + po[k]) * (1.f / 512.f) + EPS);
        v2u o; o.x = pk2(y[k][0] * rstd, y[k][1] * rstd); o.y = pk2(y[k][2] * rstd, y[k][3] * rstd);
        *(v2u*)(dst + (row0 + k) * DM + col_off + 4 * cq) = o; }
    __syncthreads();
}
__device__ __forceinline__ void hyprep_item(Frame& F, const bf16* __restrict__ PROJ, const float* __restrict__ cw, const float* __restrict__ cb, bf16* ZT, bf16* X0, int b, int tile) {
    const int tb = F.tid >> 7, cq = F.tid & 127, c0 = 4 * cq, tw = tile * 32 + tb * 8; const size_t rb = (size_t)b * SEQ;
    float z[8][4];
#pragma unroll
    for (int jj = 0; jj < 3; ++jj) { const int j = (jj == 0) ? 1 : (jj == 1) ? 2 : 0; const int cc = 512 * j + c0;
        const f32x4 w0 = *(const f32x4*)(cw + cc), w1 = *(const f32x4*)(cw + 1536 + cc), w2 = *(const f32x4*)(cw + 3072 + cc), bs = *(const f32x4*)(cb + cc);
        float x[10][4];
#pragma unroll
        for (int o = 0; o < 10; ++o) { const int t = tw - 1 + o; const bool ok = (t >= 0) && (t < SEQ); const int tc = ok ? t : tw;
            const v2u w = *(const v2u*)(PROJ + (rb + tc) * DINP + O_HY + cc); unpack4(w, x[o]);
            if (!ok) { x[o][0] = 0.f; x[o][1] = 0.f; x[o][2] = 0.f; x[o][3] = 0.f; } }
        if (jj == 0) {
#pragma unroll
            for (int k = 0; k < 8; ++k)
#pragma unroll
                for (int i = 0; i < 4; ++i) z[k][i] = w0[i] * x[k][i] + w1[i] * x[k + 1][i] + w2[i] * x[k + 2][i] + bs[i];
        } else if (jj == 1) {
#pragma unroll
            for (int k = 0; k < 8; ++k)
#pragma unroll
                for (int i = 0; i < 4; ++i) z[k][i] *= w0[i] * x[k][i] + w1[i] * x[k + 1][i] + w2[i] * x[k + 2][i] + bs[i];
#pragma unroll
            for (int i = 0; i < 4; ++i) { v4u o; o.x = pk2(z[0][i], z[1][i]); o.y = pk2(z[2][i], z[3][i]); o.z = pk2(z[4][i], z[5][i]); o.w = pk2(z[6][i], z[7][i]);
                *(v4u*)(ZT + ((size_t)(c0 + i) * NSEQ + b) * SEQ + tw) = o; }
        } else {
#pragma unroll
            for (int k = 0; k < 8; ++k) { float u0[4];
#pragma unroll
                for (int i = 0; i < 4; ++i) u0[i] = w0[i] * x[k][i] + w1[i] * x[k + 1][i] + w2[i] * x[k + 2][i] + bs[i];
                v2u o; o.x = pk2(u0[0], u0[1]); o.y = pk2(u0[2], u0[3]); *(v2u*)(X0 + (rb + tw + k) * HYC + c0) = o; }
        }
    }
}
__device__ __forceinline__ void pool_item(Frame& F, const bf16* __restrict__ PROJ, bf16* MIXED, int b, int tile) {
    const int tb = F.tid >> 7, cq = F.tid & 127, c0 = 4 * cq, g = cq >> 5, half = 1 << g, tw = tile * 32 + tb * 8; const size_t rb = (size_t)b * SEQ;
    float x[23][4];
#pragma unroll
    for (int o = 0; o < 23; ++o) { const int t = tw - 8 + o; const bool ok = (t >= 0) && (t < SEQ); const int tc = ok ? t : tw;
        const v2u w = *(const v2u*)(PROJ + (rb + tc) * DINP + c0); unpack4(w, x[o]);
        if (!ok) { x[o][0] = 0.f; x[o][1] = 0.f; x[o][2] = 0.f; x[o][3] = 0.f; } }
    float y[8][4];
#pragma unroll
    for (int k = 0; k < 8; ++k) { const int oc = 8 + k, t = tw + k; const int lo = (t - half > 0) ? t - half : 0, hi = (t + half < SEQ) ? t + half : SEQ; const float inv = 1.0f / (float)(hi - lo);
#pragma unroll
        for (int i = 0; i < 4; ++i) {
            const float w1 = x[oc - 1][i] + x[oc][i];
            const float w2 = w1 + (x[oc - 2][i] + x[oc + 1][i]);
            const float w4 = w2 + ((x[oc - 4][i] + x[oc - 3][i]) + (x[oc + 2][i] + x[oc + 3][i]));
            const float w8 = w4 + (((x[oc - 8][i] + x[oc - 7][i]) + (x[oc - 6][i] + x[oc - 5][i])) + ((x[oc + 4][i] + x[oc + 5][i]) + (x[oc + 6][i] + x[oc + 7][i])));
            const float S = (g == 0) ? w1 : (g == 1) ? w2 : (g == 2) ? w4 : w8;
            y[k][i] = S * inv - x[oc][i]; } }
    pair_norm_store(F, y, MIXED, rb + tw, 0, cq);
}
__device__ __forceinline__ void hyfin_item(Frame& F, const bf16* __restrict__ YC, const bf16* __restrict__ X0, bf16* MIXED, int b, int tile) {
    const int tb = F.tid >> 7, cq = F.tid & 127, c0 = 4 * cq, tw = tile * 32 + tb * 8; const size_t rb = (size_t)b * SEQ;
    float yc[4][8], y[8][4];
#pragma unroll
    for (int i = 0; i < 4; ++i) { const v4u v = *(const v4u*)(YC + ((size_t)(c0 + i) * NSEQ + b) * SEQ + tw);
        yc[i][0] = bflo(v.x); yc[i][1] = bfhi(v.x); yc[i][2] = bflo(v.y); yc[i][3] = bfhi(v.y); yc[i][4] = bflo(v.z); yc[i][5] = bfhi(v.z); yc[i][6] = bflo(v.w); yc[i][7] = bfhi(v.w); }
#pragma unroll
    for (int k = 0; k < 8; ++k) { float xv[4]; unpack4(*(const v2u*)(X0 + (rb + tw + k) * HYC + c0), xv);
#pragma unroll
        for (int i = 0; i < 4; ++i) y[k][i] = yc[i][k] * xv[i]; }
    pair_norm_store(F, y, MIXED, rb + tw, 1536, cq);
}
struct PrepGains { float q[3][8], k[3][8]; };
__device__ __forceinline__ void load8(const float* p, float (&o)[8]) { const f32x4 a = *(const f32x4*)p, b = *(const f32x4*)(p + 4); o[0] = a.x; o[1] = a.y; o[2] = a.z; o[3] = a.w; o[4] = b.x; o[5] = b.y; o[6] = b.z; o[7] = b.w; }
__device__ __forceinline__ void unpack8(const v4u w, float (&x)[8]) { x[0] = bflo(w.x); x[1] = bfhi(w.x); x[2] = bflo(w.y); x[3] = bfhi(w.y); x[4] = bflo(w.z); x[5] = bfhi(w.z); x[6] = bflo(w.w); x[7] = bfhi(w.w); }
__device__ __forceinline__ v4u pack8(const float (&x)[8]) { v4u o; o.x = pk2(x[0], x[1]); o.y = pk2(x[2], x[3]); o.z = pk2(x[4], x[5]); o.w = pk2(x[6], x[7]); return o; }
__device__ __forceinline__ float ssq8(const float (&x)[8]) { return ((x[0] * x[0] + x[1] * x[1]) + (x[2] * x[2] + x[3] * x[3])) + ((x[4] * x[4] + x[5] * x[5]) + (x[6] * x[6] + x[7] * x[7])); }
__device__ __forceinline__ float sum8lanes(float v) { v += __shfl_xor(v, 1); v += __shfl_xor(v, 2); v += __shfl_xor(v, 4); return v; }
__device__ __forceinline__ void prep_row(const bf16* __restrict__ PROJ, bf16* Q, bf16* KV, const PrepGains& G, const float* __restrict__ ROPE, int m, int lane) {
    const int h = lane >> 3, sub = lane & 7;
    const bf16* pr = PROJ + (size_t)m * DINP; bf16* qr = Q + (size_t)m * NQ + 192 * h + 8 * sub; bf16* kr = KV + (size_t)m * NKVP + KVHS * h + 8 * sub;
    const v4u cqv = *(const v4u*)(pr + O_CQ + 8 * lane); const v4u ckv = *(const v4u*)(pr + O_CKV + 8 * (lane & 31)); const v4u pev = *(const v4u*)(pr + O_KPE + 8 * sub);
    const v4u q0 = *(const v4u*)(qr), q1 = *(const v4u*)(qr + 64), q2 = *(const v4u*)(qr + 128);
    const v4u k0 = *(const v4u*)(kr), k1 = *(const v4u*)(kr + 64), v0 = *(const v4u*)(kr + 192), v1 = *(const v4u*)(kr + 256);
    float cs[8], sn[8]; { const float* rp = ROPE + (size_t)(m & (SEQ - 1)) * 64 + 8 * (sub & 3); load8(rp, cs); load8(rp + 32, sn); }
    float t[8];
    unpack8(cqv, t); const float rq = 1.0f / sqrtf(wave_sum(ssq8(t)) * (1.f / 512.f) + EPS);
    unpack8(ckv, t); const float rkv = 1.0f / sqrtf(wave_sum(lane < 32 ? ssq8(t) : 0.f) * (1.f / 256.f) + EPS);
    const float sg = (sub < 4) ? -1.f : 1.f;
    { float a0[8], a1[8], a2[8]; unpack8(q0, a0); unpack8(q1, a1); unpack8(q2, a2);
      const float ss = sum8lanes(ssq8(a0) + ssq8(a1) + ssq8(a2)) * (rq * rq);
      const float sc = rq / sqrtf(ss * (1.f / 192.f) + EPS);
      float r[8], o[8];
#pragma unroll
      for (int i = 0; i < 8; ++i) { a0[i] *= sc * G.q[0][i]; a1[i] *= sc * G.q[1][i]; r[i] = a2[i] * sc * G.q[2][i]; }
#pragma unroll
      for (int i = 0; i < 8; ++i) { const float rp = __shfl_xor(r[i], 4); o[i] = r[i] * cs[i] + sg * rp * sn[i]; }
      *(v4u*)(qr) = pack8(a0); *(v4u*)(qr + 64) = pack8(a1); *(v4u*)(qr + 128) = pack8(o); }
    { float a0[8], a1[8], pe[8], b0[8], b1[8]; unpack8(k0, a0); unpack8(k1, a1); unpack8(pev, pe); unpack8(v0, b0); unpack8(v1, b1);
      const float ss = sum8lanes((ssq8(a0) + ssq8(a1)) * (rkv * rkv) + ssq8(pe));
      const float sk = 1.0f / sqrtf(ss * (1.f / 192.f) + EPS);
      float r[8], o[8];
#pragma unroll
      for (int i = 0; i < 8; ++i) { a0[i] *= rkv * sk * G.k[0][i]; a1[i] *= rkv * sk * G.k[1][i]; r[i] = pe[i] * sk * G.k[2][i]; b0[i] *= rkv; b1[i] *= rkv; }
#pragma unroll
      for (int i = 0; i < 8; ++i) { const float rp = __shfl_xor(r[i], 4); o[i] = r[i] * cs[i] + sg * rp * sn[i]; }
      *(v4u*)(kr) = pack8(a0); *(v4u*)(kr + 64) = pack8(a1); *(v4u*)(kr + 128) = pack8(o); *(v4u*)(kr + 192) = pack8(b0); *(v4u*)(kr + 256) = pack8(b1); }
}
__device__ __forceinline__ void attn_norm_row(bf16* MIXED, int m, int lane) {
    v4u* p = (v4u*)(MIXED + (size_t)m * DM + 512 + 16 * lane); v4u a = p[0], b = p[1];
    unsigned w[8] = {a.x, a.y, a.z, a.w, b.x, b.y, b.z, b.w}; float s = 0.f;
#pragma unroll
    for (int i = 0; i < 8; ++i) { const float x = bflo(w[i]), y = bfhi(w[i]); s += x * x + y * y; }
    const float rstd = 1.0f / sqrtf(wave_sum(s) * (1.f / 1024.f) + EPS);
#pragma unroll
    for (int i = 0; i < 8; ++i) w[i] = pk2(bflo(w[i]) * rstd, bfhi(w[i]) * rstd);
    a.x = w[0]; a.y = w[1]; a.z = w[2]; a.w = w[3]; b.x = w[4]; b.y = w[5]; b.z = w[6]; b.w = w[7]; p[0] = a; p[1] = b;
}

#define DEFPTRS() unsigned char* ws = args.ws; \
    bf16* BtIn = (bf16*)(ws + WS_BTIN); bf16* BtUq = (bf16*)(ws + WS_BTUQ); bf16* BtKv = (bf16*)(ws + WS_BTKV); bf16* BtOut = (bf16*)(ws + WS_BTOUT); bf16* BtUp = (bf16*)(ws + WS_BTUP); bf16* BtDn = (bf16*)(ws + WS_BTDN); \
    bf16* RF = (bf16*)(ws + WS_RF); bf16* Hb = (bf16*)(ws + WS_H); bf16* PROJ = (bf16*)(ws + WS_PROJ); bf16* Qb = (bf16*)(ws + WS_Q); bf16* KVb = (bf16*)(ws + WS_KV); \
    bf16* ZT = (bf16*)(ws + WS_ZT); bf16* X0 = (bf16*)(ws + WS_X0); bf16* YC = (bf16*)(ws + WS_YC); float* EDGE = (float*)(ws + WS_EDGE); float* ROPE = (float*)(ws + WS_ROPE); float* SSQP = (float*)(ws + WS_SSQP); float* RSTD = (float*)(ws + WS_RSTD); bf16* XB2 = (bf16*)(ws + WS_XB2); bf16* ACT = (bf16*)(ws + WS_ACT); \
    bf16* XA = (bf16*)args.out; \
    (void)BtIn; (void)BtUq; (void)BtKv; (void)BtOut; (void)BtUp; (void)BtDn; (void)RF; (void)Hb; (void)PROJ; (void)Qb; (void)KVb; (void)ZT; (void)X0; (void)YC; (void)EDGE; (void)ROPE; (void)SSQP; (void)RSTD; (void)XB2; (void)ACT; (void)XA
__global__ void __launch_bounds__(NWAVES * 64, 2) fwd(Args args) {
    extern __shared__ __attribute__((aligned(16))) unsigned char lds_raw[];
    Frame F;
    F.lds = (LAS unsigned char*)lds_raw;
    F.tid = threadIdx.x; F.lane = F.tid & 63; F.wave = __builtin_amdgcn_readfirstlane(F.tid >> 6);
    F.G = gridDim.x; { const int bx = blockIdx.x; F.vcu = (F.G % 8 == 0) ? (bx % 8) * (F.G / 8) + bx / 8 : bx; }
    volatile LAS unsigned* MISC = (volatile LAS unsigned*)(F.lds + MISC_OFF);
    if (F.tid < 64) MISC[F.tid] = 0u;
    __syncthreads();
    unsigned* ctl = (unsigned*)(args.ws + WS_CTL);
    const int lo = args.ph_lo, hi = args.ph_hi;
    XcdBarrier bar; bar.bar = ctl + CW_BAR; bar.x = 0; bar.st = MISC + 8;
    if (hi - lo > 1) bar = xcd_barrier_post(ctl + CW_BAR, MISC + 8);
    float* out = args.out;

#pragma unroll 1
    for (int layer = 0; layer < DEPTH; ++layer) {
        const int pb = layer * NPH;
        if (pb + NPH <= lo || pb >= hi) continue;
#define IN(k) (lo <= pb + (k) && pb + (k) < hi)
#define ENTER() DEFPTRS(); F.tid = opq(threadIdx.x); F.lane = F.tid & 63; F.wave = __builtin_amdgcn_readfirstlane(F.tid >> 6); const int gw = F.vcu * NWAVES + F.wave, NGW = F.G * NWAVES, wg = F.vcu; const size_t gtid = (size_t)wg * 512 + F.tid, gthreads = (size_t)F.G * 512; (void)gw; (void)NGW; (void)wg; (void)gtid; (void)gthreads
#define SEAM(k) do { if (pb + (k) + 1 < hi) xcd_barrier(bar); } while (0)

        if (IN(0)) { ENTER();
            const float* win = args.in[I_WIN] + (size_t)layer * DM * DIN; const float* g1 = args.in[I_ANG] + layer * DM;
            for (int it = wg; it < 256; it += F.G) {
                if (it < 128) poolfold_item(F, win, args.in[I_PW] + (size_t)layer * 4 * 128 * 128, args.in[I_PS] + (size_t)layer * 512, g1, BtIn, it >> 5, it & 31);
                else filter_item(F, args.in[I_FW1] + (size_t)layer * 17 * 64, args.in[I_FB1] + layer * 64, args.in[I_FFR] + layer * 64, args.in[I_FW2] + (size_t)layer * 64 * 64, args.in[I_FB2] + layer * 64,
                                 args.in[I_FW3] + (size_t)layer * 64 * 1024, args.in[I_FB3] + layer * 1024, args.in[I_HBIAS] + layer * 512, RF, it - 128);
            }
            constexpr int T_IN = 19 * 16, T_UQ = 12 * 4, T_KV = 16 * 2, T_OUT = 16 * 16, T_UP = 88 * 16, T_DN = 16 * 44, T_ALL = T_IN + T_UQ + T_KV + T_OUT + T_UP + T_DN;
            for (int it = wg; it < T_ALL; it += F.G) {
                int r = it; CvtTile d;
                if (r < T_IN) { const int nt = r >> 4, kt = r & 15, n0 = 512 + 128 * nt; d = CvtTile{win, g1, BtIn, DIN, DM, n0, 128 * kt, DIN, {n0, n0 + 32, n0 + 64, n0 + 96}}; }
                else if ((r -= T_IN) < T_UQ) { const int nt = r >> 2, kt = r & 3, n0 = 128 * nt; d = CvtTile{args.in[I_WUQ] + (size_t)layer * 512 * NQ, args.in[I_QNG] + layer * 512, BtUq, NQ, 512, n0, 128 * kt, NQ, {n0, n0 + 32, n0 + 64, n0 + 96}}; }
                else if ((r -= T_UQ) < T_KV) { const int nt = r >> 1, kt = r & 1, n0 = 128 * nt, h = nt >> 1, bs = KVHS * h + ((nt & 1) ? 192 : 0);
                    d = CvtTile{args.in[I_WUKV] + (size_t)layer * 256 * 2048, args.in[I_KVNG] + layer * 256, BtKv, 2048, 256, n0, 128 * kt, 2048, {bs, bs + 32, bs + 64, bs + 96}}; }
                else if ((r -= T_KV) < T_OUT) { const int nt = r >> 4, kt = r & 15, n0 = 128 * nt; d = CvtTile{args.in[I_WOUT] + (size_t)layer * DM * DM, args.in[I_GNG] + layer * DM, BtOut, DM, DM, n0, 128 * kt, DM, {n0, n0 + 32, n0 + 64, n0 + 96}}; }
                else if ((r -= T_OUT) < T_UP) { const int nt = r >> 4, kt = r & 15, n0 = 128 * nt; const int nv = (nt < 44) ? nt : nt - 44; const int bs = 256 * nv + ((nt < 44) ? 0 : 32);
                    d = CvtTile{args.in[I_WUP] + (size_t)layer * DM * NUP, args.in[I_FNG] + layer * DM, BtUp, NUP, DM, n0, 128 * kt, NUP, {bs, bs + 64, bs + 128, bs + 192}}; }
                else { r -= T_UP; const int nt = r / 44, kt = r % 44, n0 = 128 * nt; d = CvtTile{args.in[I_WDN] + (size_t)layer * DFF * DM, nullptr, BtDn, DM, DFF, n0, 128 * kt, DM, {n0, n0 + 32, n0 + 64, n0 + 96}}; }
                cvt_tile(F, d);
            }
            { unsigned zz = 0u; asm volatile("" : "+v"(zz)); v4u z = {zz, zz, zz, zz};
              for (size_t i = gtid; i < (size_t)(DINP - DIN) * DM / 8; i += gthreads) *(v4u*)(BtIn + (size_t)DIN * DM + i * 8) = z;
              for (size_t i = gtid; i < (size_t)NH * 64 * 256 / 8; i += gthreads) { const int h = (int)(i / (64 * 256 / 8)), q = (int)(i % (64 * 256 / 8)); *(v4u*)(BtKv + (size_t)(KVHS * h + 128) * 256 + (size_t)q * 8) = z; } }
            if (layer == 0) for (size_t i = gtid; i < (size_t)SEQ * 32; i += gthreads) { const int pos = (int)(i >> 5), ri = (int)(i & 31);
                const float freq = exp2f(-(float)ri * (13.287712379549449f / 32.0f)); float sn, cs; sincosf((float)pos * freq, &sn, &cs); ROPE[pos * 64 + ri] = cs; ROPE[pos * 64 + 32 + ri] = sn; }
            if (layer == 0) { for (int m = gw; m < M; m += NGW) xb_row(m < MP ? args.in[I_XP] + (size_t)m * DM : args.in[I_XS] + (size_t)(m - MP) * DM, XA + (size_t)m * DM, RSTD + m, F.lane); }
            else rstd_from_partials(SSQP, RSTD, gtid, gthreads);
            SEAM(0);
        }
        if (IN(1)) { ENTER();
            pg8::Gemm g{XA, BtIn, M, DINP, DM, DM}; pg8::StaticOrder S; S.init(M, DINP, F.G, (int)blockIdx.x);
            pg8::EpiBf16 E{PROJ, DINP, RSTD};
            pg8::gemm_phase<pg8::EpiBf16, pg8::StaticOrder>(F.lds, g, S, E);
            SEAM(1);
        }
        if (IN(2)) { ENTER();
            { pg8::Gemm g{PROJ + O_CQ, BtUq, M, NQ, 512, DINP}; pg8::StaticOrder S; S.init(M, NQ, F.G, (int)blockIdx.x); pg8::EpiBf16 E{Qb, NQ, nullptr};
              pg8::gemm_phase<pg8::EpiBf16, pg8::StaticOrder>(F.lds, g, S, E); }
            { pg8::Gemm g{PROJ + O_CKV, BtKv, M, NKVP, 256, DINP}; pg8::StaticOrder S; S.init(M, NKVP, F.G, (int)blockIdx.x); pg8::EpiBf16 E{KVb, NKVP, nullptr};
              pg8::gemm_phase<pg8::EpiBf16, pg8::StaticOrder>(F.lds, g, S, E); }
            const float* hcw = args.in[I_HCW] + (size_t)layer * 3 * 1536; const float* hcb = args.in[I_HCB] + layer * 1536;
            for (int it = wg; it < 2 * NSEQ * 64; it += F.G) {
                if (it < NSEQ * 64) hyprep_item(F, PROJ, hcw, hcb, ZT, X0, it >> 6, it & 63);
                else pool_item(F, PROJ, Hb, (it - NSEQ * 64) >> 6, it & 63);
            }
            SEAM(2);
        }
        if (IN(3)) { ENTER();
            for (int u = wg; u < 2 * HYC; u += F.G) hy::conv_unit(F.lds, ZT, RF, YC, u >> 1, u & 1);
            const float* qhg = args.in[I_QHG] + layer * 192; const float* khg = args.in[I_KHG] + layer * 192;
            PrepGains PG; { const int sub = F.lane & 7;
#pragma unroll
                for (int i = 0; i < 3; ++i) { load8(qhg + 64 * i + 8 * sub, PG.q[i]); load8(khg + 64 * i + 8 * sub, PG.k[i]); } }
            for (int m = gw; m < M; m += NGW) prep_row(PROJ, Qb, KVb, PG, ROPE, m, F.lane);
            SEAM(3);
        }
        if (IN(4)) { ENTER();
            for (int i = 0; i * F.G < NSEQ * NH * 8; ++i) {
                int p, qb; const int c = (int)blockIdx.x;
                if (F.G == 256) { p = i * 32 + (c & 7) * 4 + (c >> 6); qb = (c >> 3) & 7; } else { const int Lq = i * F.G + c; p = Lq >> 3; qb = Lq & 7; }
                if (p < NSEQ * NH) { const int b = p >> 3, h = p & 7;
                    at::attn_unit(Qb + (size_t)(b * SEQ + qb * 256) * NQ + h * 192, KVb + (size_t)(b * SEQ) * NKVP + h * KVHS, KVb + (size_t)(b * SEQ) * NKVP + h * KVHS + 192,
                                  Hb + (size_t)(b * SEQ + qb * 256) * DM + 512 + h * 128, SEQ, (char*)lds_raw); }
            }
            for (int it = wg; it < NSEQ * 64; it += F.G) hyfin_item(F, YC, X0, Hb, it >> 6, it & 63);
            SEAM(4);
        }
        if (IN(5)) { ENTER();
            for (int m = gw; m < M; m += NGW) attn_norm_row(Hb, m, F.lane);
            SEAM(5);
        }
        if (IN(6)) { ENTER();
            pg8::Gemm g{Hb, BtOut, M, DM, DM, DM}; pg8::StaticOrder S; S.init(M, DM, F.G, (int)blockIdx.x);
            pg8::EpiResid16 E{XA, XB2, out, DM, SSQP, 0};
            pg8::gemm_phase<pg8::EpiResid16, pg8::StaticOrder>(F.lds, g, S, E);
            SEAM(6);
        }
        if (IN(7)) { ENTER();
            rstd_from_partials(SSQP, RSTD, gtid, gthreads);
            SEAM(7);
        }
        if (IN(8)) { ENTER();
            pg8::Gemm g{XB2, BtUp, M, NUP, DM, DM}; pg8::StaticOrder S; S.init(M, NUP, F.G, (int)blockIdx.x);
            pg8::EpiGate E{ACT, DFF, EDGE, args.in[I_FCW] + (size_t)layer * 3 * DFF, args.in[I_FCB] + layer * DFF, DFF, (LAS float*)(F.lds + HALO_OFF), RSTD};
            pg8::gemm_phase<pg8::EpiGate, pg8::StaticOrder>(F.lds, g, S, E);
            SEAM(8);
        }
        if (IN(9)) { ENTER();
            const float* fcw = args.in[I_FCW] + (size_t)layer * 3 * DFF;
            for (size_t i = gtid; i < (size_t)(M / 256) * 2 * (DFF / 4); i += gthreads) {
                const int ri = (int)(i / (DFF / 4)), c4 = (int)(i % (DFF / 4)) * 4, pm = ri >> 1, e = ri & 1;
                const float* eb = EDGE + (size_t)(ri * 3) * DFF + c4;
                f32x4 pre = *(const f32x4*)(eb + DFF); const f32x4 v = *(const f32x4*)(eb + 2 * DFF);
                if (e == 0 && (pm & 7) != 0) { const f32x4 gp = *(const f32x4*)(EDGE + (size_t)(((pm - 1) * 2 + 1) * 3) * DFF + c4); pre += *(const f32x4*)(fcw + c4) * gp; }
                if (e == 1 && (pm & 7) != 7) { const f32x4 gn = *(const f32x4*)(EDGE + (size_t)(((pm + 1) * 2 + 0) * 3) * DFF + c4); pre += *(const f32x4*)(fcw + 2 * DFF + c4) * gn; }
                v2u o; o.x = pk2(pg8::silu_f(pre.x) * v.x, pg8::silu_f(pre.y) * v.y); o.y = pk2(pg8::silu_f(pre.z) * v.z, pg8::silu_f(pre.w) * v.w);
                *(v2u*)(ACT + (size_t)(pm * 256 + (e ? 255 : 0)) * DFF + c4) = o;
            }
            SEAM(9);
        }
        if (IN(10)) { ENTER();
            pg8::Gemm g{ACT, BtDn, M, DM, DFF, DFF}; pg8::StaticOrder S; S.init(M, DM, F.G, (int)blockIdx.x);
            pg8::EpiResid16 E{XB2, XA, out, DM, SSQP, (layer + 1 < DEPTH) ? 0 : 1};
            pg8::gemm_phase<pg8::EpiResid16, pg8::StaticOrder>(F.lds, g, S, E);
            SEAM(10);
        }
#undef IN
#undef ENTER
#undef SEAM
    }
}

extern "C" void kernel_launch(void* const* d_in, const int* in_sizes, int n_in, void* d_out, int out_size, void* d_ws, size_t ws_size, hipStream_t stream) {
    static int grid = 0;
    if (grid == 0) {
        if (n_in != N_IN || out_size != M * DM || ws_size < WS_END) { fprintf(stderr, "kernel_launch: unexpected shapes (n_in %d, out %d, ws %zu, need %zu)\n", n_in, out_size, ws_size, (size_t)WS_END); grid = -1; return; }
        int dev = 0, cus = 0;
        if (hipGetDevice(&dev) != hipSuccess || hipDeviceGetAttribute(&cus, hipDeviceAttributeMultiprocessorCount, dev) != hipSuccess) { grid = -1; return; }
        if (hipFuncSetAttribute((const void*)fwd, hipFuncAttributeMaxDynamicSharedMemorySize, LDS_BYTES) != hipSuccess) { fprintf(stderr, "kernel_launch: hipFuncSetAttribute failed\n"); grid = -1; return; }
        int per_cu = 0;
        if (hipOccupancyMaxActiveBlocksPerMultiprocessor(&per_cu, (const void*)fwd, NWAVES * 64, LDS_BYTES) != hipSuccess || per_cu < 1) fprintf(stderr, "kernel_launch: occupancy query reports %d\n", per_cu);
        (void)hipGetLastError();
        grid = cus;
    }
    if (grid < 0) return;
    (void)hipMemsetAsync((char*)d_ws + WS_CTL, 0, CTL_BYTES, stream);
    Args a{};
    for (int i = 0; i < N_IN; ++i) a.in[i] = (const float*)d_in[i];
    a.out = (float*)d_out; a.ws = (unsigned char*)d_ws;
#if MK_ONE_LAUNCH
    a.ph_lo = 0; a.ph_hi = DEPTH * NPH;
    hipLaunchKernelGGL(fwd, dim3(grid), dim3(NWAVES * 64), LDS_BYTES, stream, a);
#else
    for (int p = 0; p < DEPTH * NPH; ++p) { a.ph_lo = p; a.ph_hi = p + 1; hipLaunchKernelGGL(fwd, dim3(grid), dim3(NWAVES * 64), LDS_BYTES, stream, a); }
#endif
    const hipError_t le = hipPeekAtLastError();
    if (le != hipSuccess) fprintf(stderr, "kernel_launch: launch failed: %s\n", hipGetErrorName(le));
}
```

```cpp
#include <hip/hip_runtime.h>
#include <cstdio>
#include <cstdint>
__device__ __forceinline__ int opq(int x) { asm volatile("" : "+v"(x)); return x; }
namespace pg8 {
#define PG8_LAS __attribute__((address_space(3)))
typedef unsigned short bf16_t;
typedef short bf16x8 __attribute__((ext_vector_type(8)));
typedef float f32x4 __attribute__((ext_vector_type(4)));
typedef unsigned u32x4 __attribute__((ext_vector_type(4)));
constexpr int BM = 256, BK = 64, HALF = 128, HTB = HALF * BK * 2  , STAGE_BYTES = 8 * HTB, NXCD = 8, WGM = 8;

__host__ __device__ __forceinline__ int lds_byte(int r, int c) { const int st = (r >> 4) * 2 + (c >> 5), rr = r & 15, cc = c & 31, ob = rr * 64 + cc * 2; return st * 1024 + (ob ^ (((ob >> 9) & 1) << 5)); }
__host__ __device__ __forceinline__ void stage_rc(int b, int& R, int& C) { const int st = b / 1024, sb = b % 1024, swz = sb ^ (((sb >> 9) & 1) << 5); R = (st >> 1) * 16 + swz / 64; C = (st & 1) * 32 + (swz % 64) / 2; }
__host__ __device__ __forceinline__ int perm32(int rho) { const int n = rho >> 4, i = rho & 15; return 8 * (i >> 2) + 4 * n + (i & 3); }

struct Unit { int pm, pn; };
struct Gemm { const bf16_t* A; const bf16_t* Bt; int M, N, K, lda; };

struct StaticOrder {
    int nM, nN, nwg, G, c;
    __host__ __device__ void init(int M, int N, int G_, int c_) { nM = M / BM; nN = N / BM; nwg = nM * nN; G = G_; c = c_; }
    __host__ __device__ bool next(int i, Unit& u) const {
        const long L = (long)i * G + c; if (L >= nwg) return false;
        int wgid = (int)L; { const int q = nwg / NXCD, r = nwg % NXCD, xcd = wgid % NXCD, off = wgid / NXCD; wgid = (xcd < r ? xcd * (q + 1) : r * (q + 1) + (xcd - r) * q) + off; }
        const int nig = WGM * nN, gid = wgid / nig, fm = gid * WGM, gsz = (nM - fm) < WGM ? (nM - fm) : WGM;
        u.pm = fm + ((wgid % nig) % gsz); u.pn = (wgid % nig) / gsz; return true;
    }
    __device__ __forceinline__ void a_ready(const Unit&) const {}
    __device__ __forceinline__ void done(const Unit&) const {}
};

__device__ __forceinline__ unsigned cvt_pk_bf16(float lo, float hi) { unsigned r; asm volatile("v_cvt_pk_bf16_f32 %0, %1, %2" : "=v"(r) : "v"(lo), "v"(hi)); return r; }

__device__ __forceinline__ float dpp_ror1(float v) { return __builtin_bit_cast(float, __builtin_amdgcn_update_dpp(0, __builtin_bit_cast(int, v), 0x121, 0xF, 0xF, false)); }
__device__ __forceinline__ float dpp_ror15(float v) { return __builtin_bit_cast(float, __builtin_amdgcn_update_dpp(0, __builtin_bit_cast(int, v), 0x12F, 0xF, 0xF, false)); }
__device__ __forceinline__ unsigned dpp_swap1(unsigned v) { return (unsigned)__builtin_amdgcn_update_dpp(0, (int)v, 0xB1, 0xF, 0xF, false); }
struct LineOffs { unsigned o0, o1; bool odd; };
__device__ __forceinline__ LineOffs line_offs(unsigned lo, int pitch, int fr) { LineOffs L; L.odd = fr & 1; L.o0 = L.odd ? lo - (unsigned)pitch + 32u : lo; L.o1 = L.odd ? lo + 32u : lo + (unsigned)pitch; return L; }
__device__ __forceinline__ void store_lines(bf16_t* base, const LineOffs& L, u32x4 a, u32x4 b) {
    const u32x4 snd = L.odd ? a : b; u32x4 rcv;
    rcv.x = dpp_swap1(snd.x); rcv.y = dpp_swap1(snd.y); rcv.z = dpp_swap1(snd.z); rcv.w = dpp_swap1(snd.w);
    *(u32x4*)(base + L.o0) = L.odd ? rcv : a;
    *(u32x4*)(base + L.o1) = L.odd ? b : rcv;
}
struct EpiBf16 {
    static constexpr bool PERM = true;
    bf16_t* O; int ldc; const float* rstd;
    __device__ __forceinline__ void operator()(f32x4 (&acc)[2][2][4][2], const Unit& u, int wr, int wc, int fr, int fq) const {
        bf16_t* Ot = O + (size_t)(u.pm * BM) * ldc + u.pn * BM;
        const LineOffs L = line_offs((unsigned)((wr * 64 + fr) * ldc + wc * 64 + 8 * fq), ldc, fr); const int row0 = u.pm * BM + wr * 64 + fr;
        float rsv[8];
#pragma unroll
        for (int i = 0; i < 8; ++i) rsv[i] = rstd ? rstd[row0 + (i >> 2) * HALF + (i & 3) * 16] : 1.0f;
#pragma unroll
        for (int ai = 0; ai < 2; ++ai)
#pragma unroll
            for (int m = 0; m < 4; ++m) { const float rs = rsv[ai * 4 + m];
                u32x4 w[2];
#pragma unroll
                for (int bj = 0; bj < 2; ++bj) { const f32x4 v0 = acc[ai][bj][m][0] * rs, v1 = acc[ai][bj][m][1] * rs;
                    w[bj].x = cvt_pk_bf16(v0[0], v0[1]); w[bj].y = cvt_pk_bf16(v0[2], v0[3]); w[bj].z = cvt_pk_bf16(v1[0], v1[1]); w[bj].w = cvt_pk_bf16(v1[2], v1[3]); }
                store_lines(Ot + (size_t)((ai * HALF + m * 16) * ldc), L, w[0], w[1]);
                asm volatile("" ::: "memory"); }
    }
};
struct EpiResid16 {
    static constexpr bool PERM = true;
    const bf16_t* base; bf16_t* xo; float* out; int ldc; float* ssqp; int f32out;
    __device__ __forceinline__ static void addx(const u32x4 b, const f32x4 a0, const f32x4 a1, f32x4& x0, f32x4& x1) {
        x0[0] = __builtin_bit_cast(float, b.x << 16) + a0[0]; x0[1] = __builtin_bit_cast(float, b.x & 0xffff0000u) + a0[1]; x0[2] = __builtin_bit_cast(float, b.y << 16) + a0[2]; x0[3] = __builtin_bit_cast(float, b.y & 0xffff0000u) + a0[3];
        x1[0] = __builtin_bit_cast(float, b.z << 16) + a1[0]; x1[1] = __builtin_bit_cast(float, b.z & 0xffff0000u) + a1[1]; x1[2] = __builtin_bit_cast(float, b.w << 16) + a1[2]; x1[3] = __builtin_bit_cast(float, b.w & 0xffff0000u) + a1[3]; }
    __device__ __forceinline__ void operator()(f32x4 (&acc)[2][2][4][2], const Unit& u, int wr, int wc, int fr, int fq) const {
        const size_t tb = (size_t)(u.pm * BM) * ldc + u.pn * BM;
        const bf16_t* bs = base + tb;
        const unsigned lo = (unsigned)((wr * 64 + fr) * ldc + wc * 64 + 8 * fq);
        if (f32out != 0) {
            float* op = out + tb;
#pragma unroll
            for (int ai = 0; ai < 2; ++ai)
#pragma unroll
                for (int m = 0; m < 4; ++m) { const unsigned off = lo + (unsigned)((ai * HALF + m * 16) * ldc);
#pragma unroll
                    for (int bj = 0; bj < 2; ++bj) { const u32x4 b = *(const u32x4*)(bs + off + bj * 32); f32x4 x0, x1; addx(b, acc[ai][bj][m][0], acc[ai][bj][m][1], x0, x1);
                        *(f32x4*)(op + off + bj * 32) = x0; *(f32x4*)(op + off + bj * 32 + 4) = x1; }
                    asm volatile("" ::: "memory"); }
            return;
        }
        bf16_t* xp = xo + tb; const LineOffs L = line_offs(lo, ldc, fr);
#pragma unroll
        for (int aim = 0; aim < 4; ++aim) { const int ai = aim >> 1, mp = aim & 1;
            u32x4 bv[2][2];
#pragma unroll
            for (int mm = 0; mm < 2; ++mm)
#pragma unroll
                for (int bj = 0; bj < 2; ++bj) bv[mm][bj] = *(const u32x4*)(bs + lo + (unsigned)((ai * HALF + (2 * mp + mm) * 16) * ldc) + bj * 32);
#pragma unroll
            for (int mm = 0; mm < 2; ++mm) { const int m = 2 * mp + mm; float s = 0.f; u32x4 wv[2];
#pragma unroll
                for (int bj = 0; bj < 2; ++bj) { f32x4 x0, x1; addx(bv[mm][bj], acc[ai][bj][m][0], acc[ai][bj][m][1], x0, x1);
                    wv[bj].x = cvt_pk_bf16(x0[0], x0[1]); wv[bj].y = cvt_pk_bf16(x0[2], x0[3]); wv[bj].z = cvt_pk_bf16(x1[0], x1[1]); wv[bj].w = cvt_pk_bf16(x1[2], x1[3]);
                    s += ((x0[0] * x0[0] + x0[1] * x0[1]) + (x0[2] * x0[2] + x0[3] * x0[3])) + ((x1[0] * x1[0] + x1[1] * x1[1]) + (x1[2] * x1[2] + x1[3] * x1[3])); }
                store_lines(xp + (size_t)((ai * HALF + m * 16) * ldc), L, wv[0], wv[1]);
                s += __shfl_xor(s, 16); s += __shfl_xor(s, 32); if (fq == 0) ssqp[(size_t)(u.pm * BM + wr * 64 + fr + ai * HALF + m * 16) * 32 + u.pn * 4 + wc] = s; }
            asm volatile("" ::: "memory"); }
    }
};
__device__ __forceinline__ float silu_f(float x) { return x * __builtin_amdgcn_rcpf(1.0f + __builtin_amdgcn_exp2f(-1.4426950408889634f * x)); }
struct EpiGate {
    static constexpr bool PERM = true;
    bf16_t* act; int ldact; float* edge; const float* cw; const float* cb; int dff; PG8_LAS float* halo; const float* rstd;
    __device__ __forceinline__ void operator()(f32x4 (&acc)[2][2][4][2], const Unit& u, int wr, int wc, int fr, int fq) const {
        const int lane = fq * 16 + fr; const int colL = wc * 32 + 8 * fq; const int colG = u.pn * HALF + colL;
#pragma unroll
        for (int ai = 0; ai < 2; ++ai)
#pragma unroll
            for (int m = 0; m < 4; ++m) { const float rs = rstd[u.pm * BM + ai * HALF + wr * 64 + m * 16 + fr];
#pragma unroll
                for (int bj = 0; bj < 2; ++bj) { acc[ai][bj][m][0] *= rs; acc[ai][bj][m][1] *= rs; } }
#pragma unroll
        for (int ai = 0; ai < 2; ++ai) { const int q = 2 * ai + wr;
            if (fr == 0) { *(PG8_LAS f32x4*)(halo + (q * 2 + 0) * 128 + colL) = acc[ai][0][0][0]; *(PG8_LAS f32x4*)(halo + (q * 2 + 0) * 128 + colL + 4) = acc[ai][0][0][1]; }
            if (fr == 15) { *(PG8_LAS f32x4*)(halo + (q * 2 + 1) * 128 + colL) = acc[ai][0][3][0]; *(PG8_LAS f32x4*)(halo + (q * 2 + 1) * 128 + colL + 4) = acc[ai][0][3][1]; } }
        asm volatile("s_waitcnt lgkmcnt(0)" ::: "memory"); __builtin_amdgcn_s_barrier(); asm volatile("" ::: "memory");
        bf16_t* actp = act + (size_t)(u.pm * BM) * ldact + colG; const unsigned rlo = (unsigned)((wr * 64 + fr) * ldact);
#pragma unroll
        for (int ai = 0; ai < 2; ++ai) { const int q = 2 * ai + wr;
            typedef unsigned u32x2 __attribute__((ext_vector_type(2)));
            u32x2 pk[4][2];
#pragma unroll
            for (int n = 0; n < 2; ++n) {
                const f32x4 w0 = *(const f32x4*)(cw + colG + 4 * n), w1 = *(const f32x4*)(cw + dff + colG + 4 * n), w2 = *(const f32x4*)(cw + 2 * dff + colG + 4 * n), bb = *(const f32x4*)(cb + colG + 4 * n);
                f32x4 ht = *(PG8_LAS f32x4*)(halo + ((q > 0 ? q - 1 : 0) * 2 + 1) * 128 + colL + 4 * n), hb = *(PG8_LAS f32x4*)(halo + ((q < 3 ? q + 1 : 3) * 2 + 0) * 128 + colL + 4 * n);
                if (q == 0) ht = ht * 0.f; if (q == 3) hb = hb * 0.f;
                f32x4 pre[4];
#pragma unroll
                for (int j = 0; j < 4; ++j) {
                    float g[4], rr[4], rl[4];
#pragma unroll
                    for (int m = 0; m < 4; ++m) { g[m] = acc[ai][0][m][n][j]; rr[m] = dpp_ror1(g[m]); rl[m] = dpp_ror15(g[m]); }
#pragma unroll
                    for (int m = 0; m < 4; ++m) {
                        const float up = (fr > 0) ? rr[m] : (m > 0 ? rr[m > 0 ? m - 1 : 0] : ht[j]);
                        const float dn = (fr < 15) ? rl[m] : (m < 3 ? rl[m < 3 ? m + 1 : 3] : hb[j]);
                        pre[m][j] = w0[j] * up + w1[j] * g[m] + w2[j] * dn + bb[j];
                    }
                }
                if (q == 0 && fr == 0) { float* e = edge + (size_t)((u.pm * 2 + 0) * 3) * dff + colG + 4 * n;
                    *(f32x4*)(e) = acc[ai][0][0][n]; *(f32x4*)(e + dff) = pre[0]; *(f32x4*)(e + 2 * dff) = acc[ai][1][0][n]; }
                if (q == 3 && fr == 15) { float* e = edge + (size_t)((u.pm * 2 + 1) * 3) * dff + colG + 4 * n;
                    *(f32x4*)(e) = acc[ai][0][3][n]; *(f32x4*)(e + dff) = pre[3]; *(f32x4*)(e + 2 * dff) = acc[ai][1][3][n]; }
#pragma unroll
                for (int m = 0; m < 4; ++m) { const f32x4 v = acc[ai][1][m][n];
                    pk[m][n].x = cvt_pk_bf16(silu_f(pre[m][0]) * v[0], silu_f(pre[m][1]) * v[1]); pk[m][n].y = cvt_pk_bf16(silu_f(pre[m][2]) * v[2], silu_f(pre[m][3]) * v[3]); }
            }
#pragma unroll
            for (int m = 0; m < 4; ++m) { u32x4 w; w.x = pk[m][0].x; w.y = pk[m][0].y; w.z = pk[m][1].x; w.w = pk[m][1].y;
                *(u32x4*)(actp + rlo + (unsigned)((ai * HALF + m * 16) * ldact)) = w; }
        }
    }
};

template <class Epi, class Sched>
__device__ __forceinline__ void gemm_phase(PG8_LAS unsigned char* lds, const Gemm g, const Sched& S, const Epi& E) {
    const int tid = opq(threadIdx.x), wid = __builtin_amdgcn_readfirstlane(tid >> 6), lane = tid & 63, wr = wid >> 2, wc = wid & 3, fr = lane & 15, fq = lane >> 4;
    const int K = g.K, nt = K / BK, lda = g.lda;
    unsigned voffA[2], voffB[2];
#pragma unroll
    for (int i = 0; i < 2; ++i) { int R, C; stage_rc(tid * 16 + i * 8192, R, C); const int Rb = Epi::PERM ? (64 * (R >> 5) + perm32(R & 31)) : R;
        voffA[i] = (unsigned)(R * lda + C) * 2u; voffB[i] = (unsigned)(Rb * K + C) * 2u; }
    const size_t kstep = (size_t)(BK * 2);
    const size_t hstepA = (size_t)HALF * lda * 2, hstepB = (size_t)(Epi::PERM ? 32 : HALF) * K * 2;
    const size_t tstepA = 2 * hstepA, tstepB = (size_t)BM * K * 2;
    const unsigned ldsw = (unsigned)wid * 1024u;
    const int aoff = lds_byte(wr * 64 + fr, fq * 8), boff = lds_byte(wc * 32 + fr, fq * 8);
#define PG8_SA(b, h) (((b) * 2 + (h)) * HTB)
#define PG8_SB(b, h) ((4 + (b) * 2 + (h)) * HTB)
#define PG8_STAGE(bufoff, gbase, voff) do { _Pragma("unroll") for (int _i = 0; _i < 2; ++_i) \
        __builtin_amdgcn_global_load_lds((const unsigned*)((const char*)(gbase) + (voff)[_i]), (PG8_LAS unsigned*)(lds + (bufoff) + ldsw + _i * 8192), 16, 0, 0); } while (0)
#define PG8_LDA(dst, b, h) do { _Pragma("unroll") for (int m = 0; m < 4; ++m) _Pragma("unroll") for (int k = 0; k < 2; ++k) dst[m][k] = *(const PG8_LAS bf16x8*)(lds + PG8_SA(b, h) + aoff + m * 2048 + k * 1024); } while (0)
#define PG8_LDB(dst, b, h) do { _Pragma("unroll") for (int n = 0; n < 2; ++n) _Pragma("unroll") for (int k = 0; k < 2; ++k) dst[n][k] = *(const PG8_LAS bf16x8*)(lds + PG8_SB(b, h) + boff + n * 2048 + k * 1024); } while (0)
#define PG8_MMA(ai, bj, At, Bt) do { __builtin_amdgcn_s_setprio(1); _Pragma("unroll") for (int m = 0; m < 4; ++m) _Pragma("unroll") for (int n = 0; n < 2; ++n) _Pragma("unroll") for (int k = 0; k < 2; ++k) \
        acc[ai][bj][m][n] = __builtin_amdgcn_mfma_f32_16x16x32_bf16(Bt[n][k], At[m][k], acc[ai][bj][m][n], 0, 0, 0); __builtin_amdgcn_s_setprio(0); } while (0)
#define PG8_WAIT_V(n) asm volatile("s_waitcnt vmcnt(" #n ")" ::: "memory")
#define PG8_WAIT_L(n) asm volatile("s_waitcnt lgkmcnt(" #n ")" ::: "memory")
#define PG8_BAR __builtin_amdgcn_s_barrier()
#define PG8_SCHED __builtin_amdgcn_sched_barrier(0)
    Unit cur, nxt; int ui = 0;
    if (!S.next(0, cur)) return;
    f32x4 acc[2][2][4][2];
{ float zf = 0.f; asm volatile("" : "+v"(zf));
    #pragma unroll
    for (int a = 0; a < 2; ++a)
#pragma unroll
        for (int b = 0; b < 2; ++b)
#pragma unroll
            for (int m = 0; m < 4; ++m)
#pragma unroll
                for (int n = 0; n < 2; ++n) acc[a][b][m][n] = (f32x4){zf, zf, zf, zf}; }
    bf16x8 At[4][2], B0[2][2], B1[2][2];
    const char* cA = (const char*)g.A + (size_t)cur.pm * tstepA; const char* cB = (const char*)g.Bt + (size_t)cur.pn * tstepB;
    S.a_ready(cur);
    PG8_STAGE(PG8_SB(0, 0), cB, voffB); PG8_STAGE(PG8_SB(0, 1), cB + hstepB, voffB); PG8_STAGE(PG8_SA(0, 0), cA, voffA); PG8_STAGE(PG8_SA(0, 1), cA + hstepA, voffA);
    if (wr == 1) PG8_BAR;
    PG8_WAIT_V(2); PG8_BAR;
    PG8_STAGE(PG8_SB(1, 0), cB + kstep, voffB); PG8_STAGE(PG8_SA(1, 0), cA + kstep, voffA); PG8_STAGE(PG8_SB(1, 1), cB + hstepB + kstep, voffB);
    PG8_WAIT_V(6); PG8_BAR;
    for (;;) {
        const bool has_next = S.next(ui + 1, nxt);
        const char* nA = has_next ? (const char*)g.A + (size_t)nxt.pm * tstepA : cA; const char* nB = has_next ? (const char*)g.Bt + (size_t)nxt.pn * tstepB : cB;
#pragma unroll 1
        for (int t = 0; t < nt; t += 2) {
            const bool last = (t == nt - 2);
            const char* a1 = cA + (size_t)(t + 1) * kstep;
            const char* a2 = last ? nA : cA + (size_t)(t + 2) * kstep; const char* b2 = last ? nB : cB + (size_t)(t + 2) * kstep;
            const char* a3 = a2 + kstep; const char* b3 = b2 + kstep;
            if (last && has_next) S.a_ready(nxt);
            PG8_LDB(B0, 0, 0); PG8_LDB(B1, 0, 1); PG8_SCHED; PG8_LDA(At, 0, 0); PG8_STAGE(PG8_SA(1, 1), a1 + hstepA, voffA);
            PG8_WAIT_V(8); PG8_WAIT_L(0); PG8_BAR; PG8_MMA(0, 0, At, B0); PG8_MMA(0, 1, At, B1); PG8_BAR; PG8_SCHED;
            PG8_LDA(At, 0, 1); PG8_STAGE(PG8_SB(0, 0), b2, voffB); PG8_STAGE(PG8_SB(0, 1), b2 + hstepB, voffB); PG8_STAGE(PG8_SA(0, 0), a2, voffA);
            PG8_WAIT_V(8); PG8_WAIT_L(0); PG8_BAR; PG8_MMA(1, 0, At, B0); PG8_MMA(1, 1, At, B1); PG8_BAR; PG8_SCHED;
            PG8_LDB(B0, 1, 0); PG8_LDB(B1, 1, 1); PG8_SCHED; PG8_LDA(At, 1, 0); PG8_STAGE(PG8_SA(0, 1), a2 + hstepA, voffA);
            PG8_WAIT_V(8); PG8_WAIT_L(0); PG8_BAR; PG8_MMA(0, 0, At, B0); PG8_MMA(0, 1, At, B1); PG8_BAR; PG8_SCHED;
            PG8_LDA(At, 1, 1); PG8_STAGE(PG8_SB(1, 0), b3, voffB); PG8_STAGE(PG8_SB(1, 1), b3 + hstepB, voffB); PG8_STAGE(PG8_SA(1, 0), a3, voffA);
            PG8_WAIT_V(8); PG8_WAIT_L(0); PG8_BAR; PG8_MMA(1, 0, At, B0); PG8_MMA(1, 1, At, B1); PG8_BAR; PG8_SCHED;
        }
        if (wr == 0) PG8_BAR;
        E(acc, cur, wr, wc, fr, fq); S.done(cur);
        if (!has_next) break;
{ float zf = 0.f; asm volatile("" : "+v"(zf));
        #pragma unroll
        for (int a = 0; a < 2; ++a)
#pragma unroll
            for (int b = 0; b < 2; ++b)
#pragma unroll
                for (int m = 0; m < 4; ++m)
#pragma unroll
                    for (int n = 0; n < 2; ++n) acc[a][b][m][n] = (f32x4){zf, zf, zf, zf}; }
        cur = nxt; cA = nA; cB = nB; ++ui;
        if (wr == 1) PG8_BAR;
    }
    PG8_WAIT_V(0);
    PG8_BAR;
#undef PG8_SA
#undef PG8_SB
#undef PG8_STAGE
#undef PG8_LDA
#undef PG8_LDB
#undef PG8_MMA
#undef PG8_WAIT_V
#undef PG8_WAIT_L
#undef PG8_BAR
#undef PG8_SCHED
}
}
namespace at {
using bf16 = unsigned short;
using bf16x8 = __attribute__((ext_vector_type(8))) short;
using s16x4  = __attribute__((ext_vector_type(4))) short;
using f32x16 = __attribute__((ext_vector_type(16))) float;
using u32x4  = __attribute__((ext_vector_type(4))) unsigned;
constexpr int DQK = 192, DV = 128, KVBLK = 64, NW = 8, QBLK = 32;
constexpr float SCALE = 0.07216878364870322f;
constexpr float THR = 8.f;
constexpr int LDQ = 1536, LDK = 2560, LDO = 2048;
constexpr int SHM_V = KVBLK * DV * 2, SHM_K = 12 * 2080;
constexpr int QR_OFF = 2 * SHM_V + 2 * SHM_K + NW * 64 * 4;
constexpr int SHM_ATTN = QR_OFF + NW * 4096;
#define SBAR() __builtin_amdgcn_sched_barrier(0)
constexpr int KPL = 2080;
__host__ __device__ __forceinline__ int k_st(int row, int c) { return (c >> 1) * KPL + row * 32 + (((c & 1) ^ ((row >> 3) & 1)) << 4); }
__host__ __device__ __forceinline__ int k_rd_base(int r32, int hi) { return r32 * 32 + ((hi ^ ((r32 >> 3) & 1)) << 4); }
__device__ __forceinline__ int crow(int r, int hi) { return (r & 3) + 8 * (r >> 2) + 4 * hi; }
__device__ __forceinline__ unsigned cvtpk(float lo, float hi) { unsigned r; asm volatile("v_cvt_pk_bf16_f32 %0, %1, %2" : "=v"(r) : "v"(lo), "v"(hi)); return r; }

__device__ __forceinline__ void partialSM(f32x16& p0, f32x16& p1, float& m_reg, float& mn, float& alpha) {
  constexpr float C = SCALE * 1.4426950408889634f;
  float pmax = p0[0];
#pragma unroll
  for (int r = 1; r < 16; ++r) pmax = fmaxf(pmax, p0[r]);
#pragma unroll
  for (int r = 0; r < 16; ++r) pmax = fmaxf(pmax, p1[r]);
  { auto rr = __builtin_amdgcn_permlane32_swap(__float_as_uint(pmax), __float_as_uint(pmax), false, false);
    pmax = fmaxf(__uint_as_float(rr[0]), __uint_as_float(rr[1])); }
  if (__builtin_expect(__all(pmax - m_reg <= THR / SCALE), 1)) { mn = m_reg; alpha = 1.f; }
  else { mn = fmaxf(m_reg, pmax); alpha = __builtin_amdgcn_exp2f((m_reg - mn) * C); m_reg = mn; }
  float mnC = -mn * C;
#pragma unroll
  for (int r = 0; r < 16; ++r) p0[r] = fmaf(p0[r], C, mnC);
#pragma unroll
  for (int r = 0; r < 16; ++r) p1[r] = fmaf(p1[r], C, mnC);
#pragma unroll
  for (int r = 0; r < 16; ++r) p0[r] = __builtin_amdgcn_exp2f(p0[r]);
}
__device__ __forceinline__ void partialSM_fast(f32x16& p0, f32x16& p1, float negMC) {
  constexpr float C = SCALE * 1.4426950408889634f;
#pragma unroll
  for (int r = 0; r < 16; ++r) p0[r] = fmaf(p0[r], C, negMC);
#pragma unroll
  for (int r = 0; r < 16; ++r) p1[r] = fmaf(p1[r], C, negMC);
#pragma unroll
  for (int r = 0; r < 16; ++r) p0[r] = __builtin_amdgcn_exp2f(p0[r]);
}
__device__ __forceinline__ void finishSM(f32x16& p0, f32x16& p1, float alpha, float& l_reg, bf16x8& pa0, bf16x8& pa1, bf16x8& pa2, bf16x8& pa3) {
#pragma unroll
  for (int r = 0; r < 16; ++r) p1[r] = __builtin_amdgcn_exp2f(p1[r]);
  float ps = 0;
#pragma unroll
  for (int r = 0; r < 16; ++r) ps += p0[r];
#pragma unroll
  for (int r = 0; r < 16; ++r) ps += p1[r];
  { auto rr = __builtin_amdgcn_permlane32_swap(__float_as_uint(ps), __float_as_uint(ps), false, false);
    ps = __uint_as_float(rr[0]) + __uint_as_float(rr[1]); }
  l_reg = l_reg * alpha + ps;
#define PK4(P, BASE, OUT) do { unsigned a0 = cvtpk(P[BASE + 0], P[BASE + 1]), a1 = cvtpk(P[BASE + 2], P[BASE + 3]);   \
    unsigned b0 = cvtpk(P[BASE + 4], P[BASE + 5]), b1 = cvtpk(P[BASE + 6], P[BASE + 7]);                              \
    auto r0 = __builtin_amdgcn_permlane32_swap(a0, b0, false, false); auto r1 = __builtin_amdgcn_permlane32_swap(a1, b1, false, false); \
    u32x4 w = {r0[0], r1[0], r0[1], r1[1]}; OUT = *reinterpret_cast<bf16x8*>(&w); } while (0)
  PK4(p0, 0, pa0); PK4(p0, 8, pa1); PK4(p1, 0, pa2); PK4(p1, 8, pa3);
#undef PK4
}
template <int OFF> __device__ __forceinline__ bf16x8 k_read(int kb) {
  bf16x8 r; asm volatile("ds_read_b128 %0, %1 offset:%2" : "=v"(r) : "v"(kb), "i"(OFF) : "memory"); return r;
}
__device__ __forceinline__ void qkt(f32x16& p0, f32x16& p1, int kb, const bf16x8* qr, int qb) {
  p0 = f32x16{}; p1 = f32x16{};
#define QK1(d0) { const bf16x8 b0 = *(const __attribute__((address_space(3))) bf16x8*)(kb + d0 * KPL), b1 = *(const __attribute__((address_space(3))) bf16x8*)(kb + d0 * KPL + 1024); \
    p0 = __builtin_amdgcn_mfma_f32_32x32x16_bf16(b0, qr[d0], p0, 0, 0, 0); p1 = __builtin_amdgcn_mfma_f32_32x32x16_bf16(b1, qr[d0], p1, 0, 0, 0); }
#define QK2(d0) { const bf16x8 b0 = *(const __attribute__((address_space(3))) bf16x8*)(kb + d0 * KPL), b1 = *(const __attribute__((address_space(3))) bf16x8*)(kb + d0 * KPL + 1024); \
    const bf16x8 qf = *(const __attribute__((address_space(3))) bf16x8*)(qb + (d0 - 8) * 1024); \
    p0 = __builtin_amdgcn_mfma_f32_32x32x16_bf16(b0, qf, p0, 0, 0, 0); p1 = __builtin_amdgcn_mfma_f32_32x32x16_bf16(b1, qf, p1, 0, 0, 0); }
  QK1(0) QK1(1) QK1(2) QK1(3) QK1(4) QK1(5) QK1(6) QK1(7) QK2(8) QK2(9) QK2(10) QK2(11)
#undef QK1
#undef QK2
}
__host__ __device__ __forceinline__ int v_st(int k, int c) { const int kk = (k & ~0xC) | ((k & 4) << 1) | ((k & 8) >> 1); return ((kk >> 3) * 4 + (c >> 5)) * 512 + ((kk & 7) * 32 + (c & 31)) * 2; }
__device__ __forceinline__ int v_rd_base(int lane) { return ((lane & 3) << 3) | (((lane >> 2) & 3) << 6) | (((lane >> 4) & 1) << 5) | (((lane >> 5) & 1) << 8); }
constexpr int v_rd_off(int d0, int ks, int half) { return d0 * 512 + ks * 4096 + half * 2048; }
template <int OFF> __device__ __forceinline__ s16x4 tr_read(int vb) {
  s16x4 r; asm volatile("ds_read_b64_tr_b16 %0, %1 offset:%2" : "=&v"(r) : "v"(vb), "i"(OFF) : "memory"); return r;
}
template <int D0> __device__ __forceinline__ void pv_one(f32x16& od, int vb, bf16x8 pa0, bf16x8 pa1, bf16x8 pa2, bf16x8 pa3) {
  const s16x4 l0 = tr_read<v_rd_off(D0, 0, 0)>(vb), h0 = tr_read<v_rd_off(D0, 0, 1)>(vb), l1 = tr_read<v_rd_off(D0, 1, 0)>(vb), h1 = tr_read<v_rd_off(D0, 1, 1)>(vb);
  const s16x4 l2 = tr_read<v_rd_off(D0, 2, 0)>(vb), h2 = tr_read<v_rd_off(D0, 2, 1)>(vb), l3 = tr_read<v_rd_off(D0, 3, 0)>(vb), h3 = tr_read<v_rd_off(D0, 3, 1)>(vb);
  asm volatile("s_waitcnt lgkmcnt(0)" ::: "memory"); SBAR();
#define PK(L, H) (bf16x8){L[0], L[1], L[2], L[3], H[0], H[1], H[2], H[3]}
  od = __builtin_amdgcn_mfma_f32_32x32x16_bf16(pa0, PK(l0, h0), od, 0, 0, 0);
  od = __builtin_amdgcn_mfma_f32_32x32x16_bf16(pa1, PK(l1, h1), od, 0, 0, 0);
  od = __builtin_amdgcn_mfma_f32_32x32x16_bf16(pa2, PK(l2, h2), od, 0, 0, 0);
  od = __builtin_amdgcn_mfma_f32_32x32x16_bf16(pa3, PK(l3, h3), od, 0, 0, 0);
#undef PK
}
__device__ __forceinline__ void pv_d0(f32x16* o, int vb, bf16x8 pa0, bf16x8 pa1, bf16x8 pa2, bf16x8 pa3) {
  pv_one<0>(o[0], vb, pa0, pa1, pa2, pa3); pv_one<1>(o[1], vb, pa0, pa1, pa2, pa3); pv_one<2>(o[2], vb, pa0, pa1, pa2, pa3); pv_one<3>(o[3], vb, pa0, pa1, pa2, pa3);
}

template <bool FAST>
__device__ __forceinline__ void attn_unit(const float negMC, const bf16* __restrict__ Qb, const bf16* __restrict__ Kh, const bf16* __restrict__ Vh, bf16* __restrict__ Ob, int seq, char* lds) {
  const int tid = opq(threadIdx.x), wid = tid >> 6, lane = tid & 63, r32 = lane & 31, hi = lane >> 5;
  char* V_lds = lds; char* K_lds = lds + 2 * SHM_V;
  float* ws = (float*)(lds + 2 * SHM_V + 2 * SHM_K) + wid * 64; float* li_l = ws; float* al_l = ws + 32;
  float m_reg = -1e30f, l_reg = 0; f32x16 o[4] = {}; bf16x8 qr[8];
  const bf16* Qw = Qb + (unsigned)((wid * QBLK + r32) * LDQ + hi * 8);
#pragma unroll
  for (int d0 = 0; d0 < 8; ++d0) qr[d0] = *reinterpret_cast<const bf16x8*>(Qw + d0 * 16);
  const int qb0 = (int)(uintptr_t)lds + QR_OFF + wid * 4096 + k_rd_base(r32, hi);
#pragma unroll
  for (int d0 = 8; d0 < 12; ++d0) *(__attribute__((address_space(3))) bf16x8*)(qb0 + (d0 - 8) * 1024) = *reinterpret_cast<const bf16x8*>(Qw + d0 * 16);
  const int sr = tid >> 4, sc = (tid & 15) * 8, vst0 = v_st(sr, sc), vst1 = v_st(32 + sr, sc);
  unsigned koff[3]; int kst[3];
#pragma unroll
  for (int i = 0; i < 3; ++i) { const int q = tid + 512 * i; koff[i] = (unsigned)((q / 24) * LDK + (q % 24) * 8); kst[i] = k_st(q / 24, q % 24); }
  const unsigned voff0 = (unsigned)(sr * LDK + sc), voff1 = (unsigned)((32 + sr) * LDK + sc);
  const int vb0 = (int)(uintptr_t)V_lds + v_rd_base(lane); const int kb0 = (int)(uintptr_t)K_lds + k_rd_base(r32, hi);
  struct { bf16x8 vs0, vs1, ks0, ks1, ks2; } sr_[1];
#define SLOAD(i, k0) do { const bf16* vt = Vh + (size_t)(k0) * LDK; const bf16* kt = Kh + (size_t)(k0) * LDK; \
    sr_[i].vs0 = *(const bf16x8*)(vt + voff0); sr_[i].vs1 = *(const bf16x8*)(vt + voff1); \
    sr_[i].ks0 = *(const bf16x8*)(kt + koff[0]); sr_[i].ks1 = *(const bf16x8*)(kt + koff[1]); sr_[i].ks2 = *(const bf16x8*)(kt + koff[2]); } while (0)
#define SWRITE(b, i) do { *(bf16x8*)(V_lds + (b) * SHM_V + vst0) = sr_[i].vs0; *(bf16x8*)(V_lds + (b) * SHM_V + vst1) = sr_[i].vs1; \
    *(bf16x8*)(K_lds + (b) * SHM_K + kst[0]) = sr_[i].ks0; *(bf16x8*)(K_lds + (b) * SHM_K + kst[1]) = sr_[i].ks1; *(bf16x8*)(K_lds + (b) * SHM_K + kst[2]) = sr_[i].ks2; } while (0)
#define SWAIT() do { if constexpr (SDEPTH == 2) asm volatile("s_waitcnt vmcnt(5)" ::: "memory"); else asm volatile("s_waitcnt vmcnt(0)" ::: "memory"); } while (0)
#define RESC(a) do { if (__any((a) < 1.f)) { if (hi == 0) al_l[r32] = (a); asm volatile("s_waitcnt lgkmcnt(0)" ::: "memory"); \
    _Pragma("unroll") for (int d = 0; d < 4; ++d) _Pragma("unroll") for (int r = 0; r < 16; ++r) o[d][r] *= al_l[crow(r, hi)]; } } while (0)
  f32x16 pA0, pA1, pB0, pB1; float mnA, mnB, alA, alB; bf16x8 pa0, pa1, pa2, pa3; const int NT = seq / KVBLK;
#define PSM(P0, P1, MN, AL) do { if constexpr (FAST) { partialSM_fast(P0, P1, negMC); AL = 1.f; } else partialSM(P0, P1, m_reg, MN, AL); } while (0)
#define RSC(AL) do { if constexpr (!FAST) RESC(AL); } while (0)
  SLOAD(0, 0); asm volatile("s_waitcnt vmcnt(0)" ::: "memory"); SWRITE(0, 0); __syncthreads();
  qkt(pA0, pA1, kb0, qr, qb0); PSM(pA0, pA1, mnA, alA);
  SLOAD(0, KVBLK);
  asm volatile("s_waitcnt vmcnt(0)" ::: "memory"); SWRITE(1, 0); __syncthreads();
  for (int j = 1; j + 1 < NT; j += 2) {
    SBAR(); qkt(pB0, pB1, kb0 + SHM_K, qr, qb0);
    finishSM(pA0, pA1, alA, l_reg, pa0, pa1, pa2, pa3); SBAR();
    SLOAD(0, (j + 1) * KVBLK); SBAR();
    pv_d0(o, vb0, pa0, pa1, pa2, pa3); PSM(pB0, pB1, mnB, alB);
    __syncthreads(); asm volatile("s_waitcnt vmcnt(0)" ::: "memory"); SWRITE(0, 0);
    RSC(alB); __syncthreads();
    SBAR(); qkt(pA0, pA1, kb0, qr, qb0);
    finishSM(pB0, pB1, alB, l_reg, pa0, pa1, pa2, pa3); SBAR();
    SLOAD(0, (j + 2) * KVBLK); SBAR();
    pv_d0(o, vb0 + (int)SHM_V, pa0, pa1, pa2, pa3); PSM(pA0, pA1, mnA, alA);
    __syncthreads(); asm volatile("s_waitcnt vmcnt(0)" ::: "memory"); SWRITE(1, 0);
    RSC(alA); __syncthreads();
  }
  SBAR(); qkt(pB0, pB1, kb0 + SHM_K, qr, qb0);
  finishSM(pA0, pA1, alA, l_reg, pa0, pa1, pa2, pa3); SBAR();
  pv_d0(o, vb0, pa0, pa1, pa2, pa3); PSM(pB0, pB1, mnB, alB);
  __syncthreads(); RSC(alB);
  finishSM(pB0, pB1, alB, l_reg, pa0, pa1, pa2, pa3); SBAR();
  pv_d0(o, vb0 + (int)SHM_V, pa0, pa1, pa2, pa3);
  if (hi == 0) li_l[r32] = l_reg; asm volatile("s_waitcnt lgkmcnt(0)" ::: "memory");
  bf16* Ow = Ob + (unsigned)(wid * QBLK * LDO + r32);
#pragma unroll
  for (int r = 0; r < 16; ++r) { const int orow = crow(r, hi); const float rl = __builtin_amdgcn_rcpf(li_l[orow]);
#pragma unroll
    for (int d0 = 0; d0 < 4; ++d0) { const unsigned w = cvtpk(o[d0][r] * rl, 0.f); Ow[(unsigned)(orow * LDO + d0 * 32)] = (bf16)(w & 0xffffu); } }
  __syncthreads();
#undef SLOAD
#undef SWRITE
#undef SWAIT
#undef RESC
#undef PSM
#undef RSC
}
}
namespace hy {
#define HY_LAS __attribute__((address_space(3)))
typedef unsigned short bf16;
typedef short bf16x8 __attribute__((ext_vector_type(8)));
typedef float f32x16 __attribute__((ext_vector_type(16)));
typedef unsigned u32x2 __attribute__((ext_vector_type(2)));
typedef unsigned u32x4 __attribute__((ext_vector_type(4)));
constexpr int L = 2048, NB = 24, CH = 512;
constexpr int RFS = 4112;
constexpr int ZROW = 4112;
constexpr int ZL_BYTES = NB * ZROW;
constexpr int RCS = 8256;
constexpr int RC_OFF = ZL_BYTES;
constexpr int HY_LDS_BYTES = RC_OFF + 4 * RCS;
__device__ __forceinline__ unsigned cvtpk(float lo, float hi) { unsigned r; asm volatile("v_cvt_pk_bf16_f32 %0, %1, %2" : "=v"(r) : "v"(lo), "v"(hi)); return r; }
__host__ __device__ __forceinline__ int frag_base(int tw, int r, int h) { const int a = (4 - (r & 3)) & 3; return RC_OFF + a * RCS + 2 * (2048 - tw - r + 8 * h - a); }
__host__ __device__ __forceinline__ int zfrag_base(int r, int h) { return (r < NB ? r : NB - 1) * ZROW + 16 * h; }

__device__ __forceinline__ bf16x8 ld_frag(HY_LAS unsigned char* lds, int off) {
    const u32x2 lo = *(const HY_LAS u32x2*)(lds + off), hi = *(const HY_LAS u32x2*)(lds + off + 8);
    u32x4 w = {lo.x, lo.y, hi.x, hi.y}; return *reinterpret_cast<bf16x8*>(&w);
}
__device__ __forceinline__ bf16x8 ld_b128(HY_LAS unsigned char* lds, int off) { return *(const HY_LAS bf16x8*)(lds + off); }

__device__ __forceinline__ void conv_unit(HY_LAS unsigned char* lds, const bf16* __restrict__ ZT, const bf16* __restrict__ RF, bf16* __restrict__ YC, int c, int half) {
    const int tid = opq(threadIdx.x), wid = tid >> 6, lane = tid & 63, r = lane & 31, h = lane >> 5;
    { const u32x4* src = (const u32x4*)(ZT + (size_t)c * NB * L);
#pragma unroll
      for (int i = 0; i < 12; ++i) { const int q = tid + 512 * i; const u32x4 v = src[q]; *(HY_LAS u32x4*)(lds + (q >> 8) * ZROW + (q & 255) * 16) = v; } }
    { const bf16* rf = RF + (size_t)c * RFS;
      for (int ch = tid; ch < RFS / 8; ch += 512) {
          const u32x4 v = *(const u32x4*)(rf + ch * 8); const unsigned w[4] = {v.x, v.y, v.z, v.w};
#pragma unroll
          for (int j = 0; j < 8; ++j) { const unsigned short e = (unsigned short)((w[j >> 1] >> ((j & 1) * 16)) & 0xffffu); const int idx = ch * 8 + j;
#pragma unroll
              for (int a = 0; a < 4; ++a) if (idx - a >= 0) *(HY_LAS unsigned short*)(lds + RC_OFF + a * RCS + 2 * (idx - a)) = e; } } }
    __syncthreads();
    const int tw = half * 1024 + wid * 128;
    const int fb = frag_base(tw, r, h), zb = zfrag_base(r, h);
    f32x16 acc[4] = {};
    bf16x8 S0[2], S1[2], S2[2], S3[2], Bc[2], Bn[2];
#define HY_LDG(S, d) do { S[0] = ld_frag(lds, fb + 64 * (d)); S[1] = ld_frag(lds, fb + 64 * (d) + 32); } while (0)
#define HY_LDB(Bx, n) do { Bx[0] = ld_b128(lds, zb + 64 * (n)); Bx[1] = ld_b128(lds, zb + 64 * (n) + 32); } while (0)
#define HY_MM(i, S, Bx) do { acc[i] = __builtin_amdgcn_mfma_f32_32x32x16_bf16(S[0], Bx[0], acc[i], 0, 0, 0); acc[i] = __builtin_amdgcn_mfma_f32_32x32x16_bf16(S[1], Bx[1], acc[i], 0, 0, 0); } while (0)
#define HY_ITER(n, Sa, Sb, Sc, Sd, Bcur, Bnext) do { HY_LDG(Sa, (n)); if ((n) + 1 < 64) HY_LDB(Bnext, (n) + 1); \
        HY_MM(1, Sb, Bcur); HY_MM(2, Sc, Bcur); HY_MM(3, Sd, Bcur); HY_MM(0, Sa, Bcur); } while (0)
    HY_LDG(S3, -1); HY_LDG(S2, -2); HY_LDG(S1, -3); HY_LDB(Bc, 0);
    for (int n = 0; n < 64; n += 4) {
        HY_ITER(n, S0, S3, S2, S1, Bc, Bn);
        HY_ITER(n + 1, S1, S0, S3, S2, Bn, Bc);
        HY_ITER(n + 2, S2, S1, S0, S3, Bc, Bn);
        HY_ITER(n + 3, S3, S2, S1, S0, Bn, Bc);
    }
#undef HY_LDG
#undef HY_LDB
#undef HY_MM
#undef HY_ITER
    if (r < NB) { bf16* yp = YC + ((size_t)c * NB + r) * L + tw + 4 * h;
#pragma unroll
        for (int i = 0; i < 4; ++i)
#pragma unroll
            for (int q4 = 0; q4 < 4; ++q4) { u32x2 w; w.x = cvtpk(acc[i][4 * q4 + 0], acc[i][4 * q4 + 1]); w.y = cvtpk(acc[i][4 * q4 + 2], acc[i][4 * q4 + 3]);
                *(u32x2*)(yp + 32 * i + 8 * q4) = w; } }
    __syncthreads();
}
}
constexpr int NWAVES = 8;
#ifndef MK_ONE_LAUNCH
#define MK_ONE_LAUNCH 1
#endif
constexpr int DM = 2048, NSEQ = 24, SEQ = 2048, M = NSEQ * SEQ, MP = 8 * SEQ;
constexpr int DEPTH = 4;
constexpr int DIN = 2880, DINP = 3072;
constexpr int O_CQ = 512, O_CKV = 1024, O_KPE = 1280, O_HY = 1344;
constexpr int NH = 8, NQ = 1536, NKVP = 2560, KVHS = 320;
constexpr int DFF = 5632, NUP = 11264, HYC = 512;
constexpr float EPS = 1e-6f;
constexpr int NPH = 11;
constexpr size_t WS_CTL = 0, CTL_BYTES = 1u << 20;
constexpr size_t SZ_BTIN = (size_t)DINP * DM * 2, SZ_BTUQ = (size_t)NQ * 512 * 2, SZ_BTKV = (size_t)NKVP * 256 * 2, SZ_BTOUT = (size_t)DM * DM * 2, SZ_BTUP = (size_t)NUP * DM * 2, SZ_BTDN = (size_t)DM * DFF * 2;
constexpr size_t WS_BTIN = WS_CTL + CTL_BYTES, WS_BTUQ = WS_BTIN + SZ_BTIN, WS_BTKV = WS_BTUQ + SZ_BTUQ, WS_BTOUT = WS_BTKV + SZ_BTKV, WS_BTUP = WS_BTOUT + SZ_BTOUT, WS_BTDN = WS_BTUP + SZ_BTUP;
constexpr size_t WS_RF = WS_BTDN + SZ_BTDN, SZ_RF = (size_t)HYC * hy::RFS * 2;
constexpr size_t WS_H = WS_RF + SZ_RF, SZ_H = (size_t)M * DM * 2;
constexpr size_t WS_PROJ = WS_H + SZ_H, SZ_PROJ = (size_t)M * DINP * 2;
constexpr size_t WS_Q = WS_PROJ + SZ_PROJ, SZ_Q = (size_t)M * NQ * 2;
constexpr size_t WS_KV = WS_Q + SZ_Q, SZ_KV = (size_t)M * NKVP * 2;
constexpr size_t WS_ZT = WS_KV + SZ_KV, SZ_ZT = (size_t)HYC * NSEQ * SEQ * 2;
constexpr size_t WS_X0 = WS_ZT + SZ_ZT, WS_YC = WS_X0 + SZ_ZT;
constexpr size_t WS_EDGE = WS_YC + SZ_ZT, SZ_EDGE = (size_t)(M / 256) * 2 * 3 * DFF * 4;
constexpr size_t WS_ROPE = WS_EDGE + SZ_EDGE, SZ_ROPE = (size_t)SEQ * 64 * 4;
constexpr size_t WS_SSQP = WS_ROPE + SZ_ROPE, SZ_SSQP = (size_t)M * 32 * 4;
constexpr size_t WS_RSTD = WS_SSQP + SZ_SSQP, SZ_RSTD = (size_t)M * 4;
constexpr size_t WS_END = WS_RSTD + SZ_RSTD;
constexpr size_t WS_ACT = WS_PROJ;
static_assert((size_t)M * DFF * 2 <= SZ_PROJ + SZ_Q + SZ_KV, "ACT overlay");
constexpr size_t WS_XB2 = WS_ACT + (size_t)M * DFF * 2;
static_assert(WS_XB2 + (size_t)M * DM * 2 <= WS_EDGE && WS_XB2 % 256 == 0, "XB2 overlay");
static_assert(WS_BTIN % 256 == 0 && WS_RF % 256 == 0 && WS_H % 256 == 0 && WS_PROJ % 256 == 0 && WS_Q % 256 == 0 && WS_KV % 256 == 0 && WS_ZT % 256 == 0 && WS_EDGE % 256 == 0, "alignment");
constexpr int CW_BAR = 4096;
constexpr int RING_BYTES = 135168;
constexpr int HALO_OFF = RING_BYTES, HALO_BYTES = 4096;
constexpr int MISC_OFF = HALO_OFF + HALO_BYTES;
constexpr int LDS_BYTES = 147456;
static_assert(hy::HY_LDS_BYTES <= RING_BYTES && at::SHM_ATTN <= RING_BYTES && MISC_OFF + 256 <= LDS_BYTES, "LDS map");

#define GAS __attribute__((address_space(1)))
#define LAS __attribute__((address_space(3)))
typedef unsigned short bf16;
typedef unsigned v4u __attribute__((ext_vector_type(4)));
typedef unsigned v2u __attribute__((ext_vector_type(2)));
typedef float f32x4 __attribute__((ext_vector_type(4)));
#define LDS_WAIT() asm volatile("s_waitcnt lgkmcnt(0)" ::: "memory")
__device__ __forceinline__ unsigned f2bf(float f) { unsigned u = __builtin_bit_cast(unsigned, f); return (u + 0x7fffu + ((u >> 16) & 1u)) >> 16; }
__device__ __forceinline__ unsigned pk2(float lo, float hi) { return f2bf(lo) | (f2bf(hi) << 16); }
__device__ __forceinline__ float bf2f(unsigned short b) { return __builtin_bit_cast(float, (unsigned)b << 16); }
__device__ __forceinline__ float bflo(unsigned w) { return __builtin_bit_cast(float, w << 16); }
__device__ __forceinline__ float bfhi(unsigned w) { return __builtin_bit_cast(float, w & 0xffff0000u); }
__device__ __forceinline__ float wave_sum(float v) {
#pragma unroll
    for (int o = 1; o < 64; o <<= 1) v += __shfl_xor(v, o);
    return v;
}

#define XB_TMO      128
#define XB_XCNT(j)  (256  + 64 * (j))
#define XB_XSUB(j)  (1280 + 64 * (j))
#define XB_XGEN(j)  (2304 + 64 * (j))
#define XB_TOP      3328
#define XB_TOPGEN   3392
#define XCD_BAR_WORDS 3456
#define XB_SPIN_CAP (1u << 18)
__device__ __forceinline__ unsigned xb_ld(unsigned* p)              { return __hip_atomic_load(p, __ATOMIC_RELAXED, __HIP_MEMORY_SCOPE_AGENT); }
__device__ __forceinline__ unsigned xb_add(unsigned* p, unsigned v) { return __hip_atomic_fetch_add(p, v, __ATOMIC_RELAXED, __HIP_MEMORY_SCOPE_AGENT); }
__device__ __forceinline__ unsigned xb_xcc_id() { return (unsigned)__builtin_amdgcn_s_getreg((3 << 11) | 20) & 0xFu; }
#define XB_SPIN(cond, bar) do { unsigned _sp = 0; while (cond) { __builtin_amdgcn_s_sleep(1); \
    if ((++_sp & 255u) == 0u) { if (xb_ld(&(bar)[XB_TMO])) break; if (_sp > XB_SPIN_CAP) { atomicAdd(&(bar)[XB_TMO], 1u); break; } } } } while (0)
struct XcdBarrier { unsigned* bar; unsigned x; volatile LAS unsigned* st; };
__device__ __forceinline__ XcdBarrier xcd_barrier_post(unsigned* bar, volatile LAS unsigned* st) {
    XcdBarrier b; b.bar = bar; b.x = xb_xcc_id(); b.st = st;
    if (threadIdx.x == 0) (void)xb_add(&bar[XB_XCNT(b.x)], 1u);
    return b;
}
__device__ __forceinline__ void xcd_barrier_complete(unsigned* bar, unsigned x, unsigned& nloc, unsigned& nx) {
    const unsigned G = gridDim.x * gridDim.y * gridDim.z;
    unsigned sum, cnt, mine, sp = 0u;
    for (;;) {
        sum = 0u; cnt = 0u; mine = 0u;
#pragma unroll
        for (unsigned j = 0; j < 16; ++j) { const unsigned c = xb_ld(&bar[XB_XCNT(j)]); sum += c; cnt += (c > 0u) ? 1u : 0u; mine = (j == x) ? c : mine; }
        if (sum == G) break;
        __builtin_amdgcn_s_sleep(1);
        if ((++sp & 255u) == 0u) { if (xb_ld(&bar[XB_TMO])) break; if (sp > XB_SPIN_CAP) { atomicAdd(&bar[XB_TMO], 1u); break; } }
    }
    nloc = mine > 0u ? mine : 1u; nx = cnt > 0u ? cnt : 1u;
}
__device__ __forceinline__ void xcd_barrier(const XcdBarrier& b) {
    asm volatile("s_waitcnt vmcnt(0)" ::: "memory");
    __syncthreads();
    if (threadIdx.x == 0) {
        unsigned* bar = b.bar;
        __builtin_amdgcn_s_waitcnt(0);
        unsigned nloc = b.st[0], nx = b.st[1];
        if (nloc == 0u) { xcd_barrier_complete(bar, b.x, nloc, nx); b.st[0] = nloc; b.st[1] = nx; }
        const unsigned old = xb_add(&bar[XB_XSUB(b.x)], 1u);
        const unsigned gen = old / nloc;
        if (old + 1u == (gen + 1u) * nloc) {
            __builtin_amdgcn_fence(__ATOMIC_RELEASE, "agent");
            asm volatile("s_waitcnt vmcnt(0)" ::: "memory");
            const unsigned og = xb_add(&bar[XB_TOP], 1u);
            const unsigned tg = og / nx;
            if (og + 1u == (tg + 1u) * nx) xb_add(&bar[XB_TOPGEN], 1u);
            else XB_SPIN(xb_ld(&bar[XB_TOPGEN]) == tg, bar);
            __builtin_amdgcn_fence(__ATOMIC_ACQUIRE, "agent");
            xb_add(&bar[XB_XGEN(b.x)], 1u);
            asm volatile("s_waitcnt vmcnt(0)" ::: "memory");
        } else {
            XB_SPIN(xb_ld(&bar[XB_XGEN(b.x)]) == gen, bar);
            __builtin_amdgcn_fence(__ATOMIC_ACQUIRE, "agent");
            asm volatile("s_waitcnt vmcnt(0)" ::: "memory");
        }
    }
    __syncthreads();
}

struct Frame {
    LAS unsigned char* lds;
    int tid, lane, wave, vcu, G;
};
enum { I_XP = 0, I_XS, I_ANG, I_WIN, I_PW, I_PS, I_QNG, I_WUQ, I_KVNG, I_WUKV, I_QHG, I_KHG, I_HCW, I_HCB, I_FW1, I_FB1, I_FFR, I_FW2, I_FB2, I_FW3, I_FB3, I_HBIAS, I_GNG, I_WOUT, I_FNG, I_WUP, I_FCW, I_FCB, I_WDN, N_IN };
struct Args { const float* in[N_IN]; float* out; unsigned char* ws; int ph_lo, ph_hi; };
static_assert(sizeof(Args) == (N_IN + 2) * 8 + 8, "Args has no padding");

__device__ __forceinline__ void cvt_item(const float* __restrict__ W, int ldw, int K, bf16* WT, int dst_n0, int src_n0, int k0, const float* __restrict__ ks, LAS float* scr, int lane) {
#pragma unroll
    for (int i = 0; i < 32; ++i) { const int kk = 2 * i + (lane >> 5); float v = W[(size_t)(k0 + kk) * ldw + src_n0 + (lane & 31)]; if (ks) v *= ks[k0 + kk]; scr[kk * 33 + (lane & 31)] = v; }
    LDS_WAIT(); asm volatile("" ::: "memory");
    const int c = lane & 7;
#pragma unroll
    for (int j = 0; j < 4; ++j) { const int n = (lane >> 3) + 8 * j; const LAS float* s = scr + (8 * c) * 33 + n;
        v4u o; o.x = pk2(s[0 * 33], s[1 * 33]); o.y = pk2(s[2 * 33], s[3 * 33]); o.z = pk2(s[4 * 33], s[5 * 33]); o.w = pk2(s[6 * 33], s[7 * 33]);
        *(v4u*)(WT + (size_t)(dst_n0 + n) * K + k0 + 8 * c) = o; }
    LDS_WAIT(); asm volatile("" ::: "memory");
}
struct CvtTile { const float* W; const float* ks; bf16* WT; int ldw, K, src_n0, k0, ncols; int dst[4]; };
__device__ __forceinline__ void cvt_tile(Frame& F, const CvtTile& d) {
    LAS float* T = (LAS float*)F.lds;
#pragma unroll
    for (int i = 0; i < 8; ++i) { const int q = F.tid + 512 * i, row = q >> 5, c4 = q & 31;
        f32x4 v = {0.f, 0.f, 0.f, 0.f};
        if (d.src_n0 + 4 * c4 < d.ncols) v = *(const f32x4*)(d.W + (size_t)(d.k0 + row) * d.ldw + d.src_n0 + 4 * c4);
        if (d.ks) v *= d.ks[d.k0 + row];
        LAS float* t = T + row * 129 + 4 * c4; t[0] = v.x; t[1] = v.y; t[2] = v.z; t[3] = v.w; }
    __syncthreads();
#pragma unroll
    for (int i = 0; i < 4; ++i) { const int n = (F.tid >> 4) + 32 * i, kc = F.tid & 15;
        if (d.src_n0 + n < d.ncols) { const LAS float* s = T + (8 * kc) * 129 + n;
            v4u o; o.x = pk2(s[0], s[129]); o.y = pk2(s[2 * 129], s[3 * 129]); o.z = pk2(s[4 * 129], s[5 * 129]); o.w = pk2(s[6 * 129], s[7 * 129]);
            *(v4u*)(d.WT + (size_t)(d.dst[i] + (n & 31)) * d.K + d.k0 + 8 * kc) = o; } }
    __syncthreads();
}
__device__ __forceinline__ void xb_row(const float* xrow, bf16* orow, float* rstd, int lane) {
    const f32x4* xr = (const f32x4*)xrow + lane;
    f32x4 v[8]; float s = 0.f;
#pragma unroll
    for (int j = 0; j < 8; ++j) { v[j] = xr[64 * j]; s += (v[j].x * v[j].x + v[j].y * v[j].y) + (v[j].z * v[j].z + v[j].w * v[j].w); }
    const float r = 1.0f / sqrtf(wave_sum(s) * (1.f / DM) + EPS);
    if (lane == 0) *rstd = r;
    v2u* o8 = (v2u*)orow + lane;
#pragma unroll
    for (int j = 0; j < 8; ++j) { v2u w; w.x = pk2(v[j].x, v[j].y); w.y = pk2(v[j].z, v[j].w); o8[64 * j] = w; }
}
__device__ __forceinline__ void rstd_from_partials(const float* __restrict__ ssqp, float* rstd, size_t gtid, size_t gthreads) {
    for (size_t r = gtid; r < (size_t)M; r += gthreads) { const f32x4* p = (const f32x4*)(ssqp + r * 32); f32x4 a = p[0];
#pragma unroll
        for (int i = 1; i < 8; ++i) a += p[i];
        rstd[r] = 1.0f / sqrtf(((a.x + a.y) + (a.z + a.w)) * (1.f / DM) + EPS); }
}
__device__ __forceinline__ void tile_norm_store(LAS float* tile, bf16* dst, int row0, int col_off, int wave, int lane) {
#pragma unroll
    for (int i = 0; i < 8; ++i) { const int t = wave * 8 + i;
        const f32x4 a = *(LAS f32x4*)(tile + t * 512 + 8 * lane), b = *(LAS f32x4*)(tile + t * 512 + 8 * lane + 4);
        const float s = (a.x * a.x + a.y * a.y) + (a.z * a.z + a.w * a.w) + (b.x * b.x + b.y * b.y) + (b.z * b.z + b.w * b.w);
        const float rstd = 1.0f / sqrtf(wave_sum(s) * (1.f / 512.f) + EPS);
        v4u o; o.x = pk2(a.x * rstd, a.y * rstd); o.y = pk2(a.z * rstd, a.w * rstd); o.z = pk2(b.x * rstd, b.y * rstd); o.w = pk2(b.z * rstd, b.w * rstd);
        *(v4u*)(dst + (size_t)(row0 + t) * DM + col_off + 8 * lane) = o; }
}
__device__ __forceinline__ void poolfold_item(Frame& F, const float* __restrict__ win, const float* __restrict__ pw, const float* __restrict__ ps, const float* __restrict__ g1, bf16* BtIn, int g, int kb) {
    LAS float* At = (LAS float*)F.lds; LAS float* Bt = (LAS float*)(F.lds + 32768);
    const int k0 = 64 * kb;
#pragma unroll
    for (int i = 0; i < 4; ++i) { const int q = F.tid + 512 * i, row = q >> 5, c4 = q & 31; *(LAS f32x4*)(At + row * 128 + 4 * c4) = *(const f32x4*)(win + (size_t)(k0 + row) * DIN + 128 * g + 4 * c4) * g1[k0 + row]; }
#pragma unroll
    for (int i = 0; i < 8; ++i) { const int q = F.tid + 512 * i, row = q >> 5, c4 = q & 31; *(LAS f32x4*)(Bt + row * 128 + 4 * c4) = *(const f32x4*)(pw + (size_t)(g * 128 + row) * 128 + 4 * c4); }
    __syncthreads();
    const int n = F.tid & 127, kg = F.tid >> 7;
    float acc[16];
#pragma unroll
    for (int i = 0; i < 16; ++i) acc[i] = 0.f;
    for (int j = 0; j < 128; j += 4) {
        const float b0 = Bt[(j + 0) * 128 + n], b1 = Bt[(j + 1) * 128 + n], b2 = Bt[(j + 2) * 128 + n], b3 = Bt[(j + 3) * 128 + n];
#pragma unroll
        for (int i = 0; i < 16; ++i) { const f32x4 a = *(LAS f32x4*)(At + (kg * 16 + i) * 128 + j); acc[i] += a.x * b0 + a.y * b1 + a.z * b2 + a.w * b3; }
    }
    const float sc = ps[128 * g + n];
    v4u o0, o1;
    o0.x = pk2(acc[0] * sc, acc[1] * sc); o0.y = pk2(acc[2] * sc, acc[3] * sc); o0.z = pk2(acc[4] * sc, acc[5] * sc); o0.w = pk2(acc[6] * sc, acc[7] * sc);
    o1.x = pk2(acc[8] * sc, acc[9] * sc); o1.y = pk2(acc[10] * sc, acc[11] * sc); o1.z = pk2(acc[12] * sc, acc[13] * sc); o1.w = pk2(acc[14] * sc, acc[15] * sc);
    bf16* dst = BtIn + (size_t)(128 * g + n) * DM + k0 + kg * 16;
    *(v4u*)dst = o0; *(v4u*)(dst + 8) = o1;
    __syncthreads();
}
__device__ __forceinline__ void filter_item(Frame& F, const float* __restrict__ w1, const float* __restrict__ b1, const float* __restrict__ fr, const float* __restrict__ w2, const float* __restrict__ b2,
                                            const float* __restrict__ w3, const float* __restrict__ b3, const float* __restrict__ hbias, bf16* RF, int fi) {
    LAS float* ZF = (LAS float*)F.lds; LAS float* H1 = ZF + 512; LAS float* H2 = ZF + 1536; LAS float* W1s = ZF + 2560; LAS float* W2s = ZF + 3712;
    const int t0 = 16 * fi;
    for (int q = F.tid; q < 272; q += 512) *(LAS f32x4*)(W1s + 4 * q) = *(const f32x4*)(w1 + 4 * q);
#pragma unroll
    for (int i = 0; i < 2; ++i) { const int q = F.tid + 512 * i; *(LAS f32x4*)(W2s + 4 * q) = *(const f32x4*)(w2 + 4 * q); }
    if (F.tid < 272) { const int tt = F.tid / 17, f = F.tid % 17; const float t = (float)(t0 + tt);
        float v;
        if (f == 0) v = t / 2047.0f;
        else { const int j = (f - 1) & 7; const float band = 1e-4f + (float)j * ((7.0f - 1e-4f) / 7.0f); const float w = (6.283185307179586f * t) / 2048.0f; const float a = band * w; v = (f <= 8) ? __cosf(a) : -__sinf(a); }
        ZF[tt * 17 + f] = v; }
    __syncthreads();
#pragma unroll
    for (int rep = 0; rep < 2; ++rep) { const int p = F.tid + 512 * rep, tt = p >> 6, j = p & 63; float s = b1[j];
#pragma unroll
        for (int i = 0; i < 17; ++i) s += ZF[tt * 17 + i] * W1s[i * 64 + j];
        H1[tt * 64 + j] = __sinf(fr[j] * s); }
    __syncthreads();
#pragma unroll
    for (int rep = 0; rep < 2; ++rep) { const int p = F.tid + 512 * rep, tt = p >> 6, j = p & 63; float s = b2[j];
#pragma unroll 16
        for (int i = 0; i < 64; ++i) s += H1[tt * 64 + i] * W2s[i * 64 + j];
        H2[tt * 64 + j] = __sinf(fr[j] * s); }
    __syncthreads();
    const int c = F.tid;
    const float delta = -3.0701134573253944f + (float)c * ((-15.350567286626972f + 3.0701134573253944f) / 511.0f);
    const float ad = fabsf(delta);
    bf16* rf = RF + (size_t)c * hy::RFS;
#pragma unroll 1
    for (int dir = 0; dir < 2; ++dir) { const int o = dir * 512 + c; const float bo = b3[o];
        float wc[64];
#pragma unroll
        for (int i = 0; i < 64; ++i) wc[i] = w3[i * 1024 + o];
#pragma unroll 1
        for (int tt = 0; tt < 16; ++tt) { float s = bo;
#pragma unroll
            for (int i = 0; i < 64; i += 4) { const f32x4 hv = *(LAS f32x4*)(H2 + tt * 64 + i); s += (hv.x * wc[i] + hv.y * wc[i + 1]) + (hv.z * wc[i + 2] + hv.w * wc[i + 3]); }
            const int t = t0 + tt; const float tl = (float)t / 2047.0f; float val = s * __expf(-tl * ad);
            if (dir == 0) { if (t == 0) val += hbias[c]; rf[2048 - t] = (bf16)f2bf(val); }
            else if (t >= 1) rf[2048 + t] = (bf16)f2bf(val); } }
    if (fi == 0) { rf[0] = 0;
#pragma unroll
        for (int i = 4096; i < hy::RFS; ++i) rf[i] = 0; }
    __syncthreads();
}
__device__ __forceinline__ void unpack4(const v2u w, float (&x)[4]) { x[0] = bflo(w.x); x[1] = bfhi(w.x); x[2] = bflo(w.y); x[3] = bfhi(w.y); }
__device__ __forceinline__ void pair_norm_store(Frame& F, const float (&y)[8][4], bf16* dst, size_t row0, int col_off, int cq) {
    LAS float* part = (LAS float*)F.lds;
    float ss[8];
#pragma unroll
    for (int k = 0; k < 8; ++k) ss[k] = wave_sum((y[k][0] * y[k][0] + y[k][1] * y[k][1]) + (y[k][2] * y[k][2] + y[k][3] * y[k][3]));
    if (F.lane == 0) { *(LAS f32x4*)(part + F.wave * 8) = (f32x4){ss[0], ss[1], ss[2], ss[3]}; *(LAS f32x4*)(part + F.wave * 8 + 4) = (f32x4){ss[4], ss[5], ss[6], ss[7]}; }
    __syncthreads();
    const f32x4 pa = *(LAS f32x4*)(part + (F.wave ^ 1) * 8), pb = *(LAS f32x4*)(part + (F.wave ^ 1) * 8 + 4);
    const float po[8] = {pa.x, pa.y, pa.z, pa.w, pb.x, pb.y, pb.z, pb.w};
#pragma unroll
    for (int k = 0; k < 8; ++k) { const float rstd = 1.0f / sqrtf((ss[k] + po[k]) * (1.f / 512.f) + EPS);
        v2u o; o.x = pk2(y[k][0] * rstd, y[k][1] * rstd); o.y = pk2(y[k][2] * rstd, y[k][3] * rstd);
        *(v2u*)(dst + (row0 + k) * DM + col_off + 4 * cq) = o; }
    __syncthreads();
}
__device__ __forceinline__ void hyprep_item(Frame& F, const bf16* __restrict__ PROJ, const float* __restrict__ cw, const float* __restrict__ cb, bf16* ZT, bf16* X0, int b, int tile) {
    const int tb = F.tid >> 7, cq = F.tid & 127, c0 = 4 * cq, tw = tile * 32 + tb * 8; const size_t rb = (size_t)b * SEQ;
    float z[8][4];
#pragma unroll
    for (int jj = 0; jj < 3; ++jj) { const int j = (jj == 0) ? 1 : (jj == 1) ? 2 : 0; const int cc = 512 * j + c0;
        const f32x4 w0 = *(const f32x4*)(cw + cc), w1 = *(const f32x4*)(cw + 1536 + cc), w2 = *(const f32x4*)(cw + 3072 + cc), bs = *(const f32x4*)(cb + cc);
        float x[10][4];
#pragma unroll
        for (int o = 0; o < 10; ++o) { const int t = tw - 1 + o; const bool ok = (t >= 0) && (t < SEQ); const int tc = ok ? t : tw;
            const v2u w = *(const v2u*)(PROJ + (rb + tc) * DINP + O_HY + cc); unpack4(w, x[o]);
            if (!ok) { x[o][0] = 0.f; x[o][1] = 0.f; x[o][2] = 0.f; x[o][3] = 0.f; } }
        if (jj == 0) {
#pragma unroll
            for (int k = 0; k < 8; ++k)
#pragma unroll
                for (int i = 0; i < 4; ++i) z[k][i] = w0[i] * x[k][i] + w1[i] * x[k + 1][i] + w2[i] * x[k + 2][i] + bs[i];
        } else if (jj == 1) {
#pragma unroll
            for (int k = 0; k < 8; ++k)
#pragma unroll
                for (int i = 0; i < 4; ++i) z[k][i] *= w0[i] * x[k][i] + w1[i] * x[k + 1][i] + w2[i] * x[k + 2][i] + bs[i];
#pragma unroll
            for (int i = 0; i < 4; ++i) { v4u o; o.x = pk2(z[0][i], z[1][i]); o.y = pk2(z[2][i], z[3][i]); o.z = pk2(z[4][i], z[5][i]); o.w = pk2(z[6][i], z[7][i]);
                *(v4u*)(ZT + ((size_t)(c0 + i) * NSEQ + b) * SEQ + tw) = o; }
        } else {
#pragma unroll
            for (int k = 0; k < 8; ++k) { float u0[4];
#pragma unroll
                for (int i = 0; i < 4; ++i) u0[i] = w0[i] * x[k][i] + w1[i] * x[k + 1][i] + w2[i] * x[k + 2][i] + bs[i];
                v2u o; o.x = pk2(u0[0], u0[1]); o.y = pk2(u0[2], u0[3]); *(v2u*)(X0 + (rb + tw + k) * HYC + c0) = o; }
        }
    }
}
__device__ __forceinline__ void pool_item(Frame& F, const bf16* __restrict__ PROJ, bf16* MIXED, int b, int tile) {
    const int tb = F.tid >> 7, cq = F.tid & 127, c0 = 4 * cq, g = cq >> 5, half = 1 << g, tw = tile * 32 + tb * 8; const size_t rb = (size_t)b * SEQ;
    float x[23][4];
#pragma unroll
    for (int o = 0; o < 23; ++o) { const int t = tw - 8 + o; const bool ok = (t >= 0) && (t < SEQ); const int tc = ok ? t : tw;
        const v2u w = *(const v2u*)(PROJ + (rb + tc) * DINP + c0); unpack4(w, x[o]);
        if (!ok) { x[o][0] = 0.f; x[o][1] = 0.f; x[o][2] = 0.f; x[o][3] = 0.f; } }
    float y[8][4];
#pragma unroll
    for (int k = 0; k < 8; ++k) { const int oc = 8 + k, t = tw + k; const int lo = (t - half > 0) ? t - half : 0, hi = (t + half < SEQ) ? t + half : SEQ; const float inv = 1.0f / (float)(hi - lo);
#pragma unroll
        for (int i = 0; i < 4; ++i) {
            const float w1 = x[oc - 1][i] + x[oc][i];
            const float w2 = w1 + (x[oc - 2][i] + x[oc + 1][i]);
            const float w4 = w2 + ((x[oc - 4][i] + x[oc - 3][i]) + (x[oc + 2][i] + x[oc + 3][i]));
            const float w8 = w4 + (((x[oc - 8][i] + x[oc - 7][i]) + (x[oc - 6][i] + x[oc - 5][i])) + ((x[oc + 4][i] + x[oc + 5][i]) + (x[oc + 6][i] + x[oc + 7][i])));
            const float S = (g == 0) ? w1 : (g == 1) ? w2 : (g == 2) ? w4 : w8;
            y[k][i] = S * inv - x[oc][i]; } }
    pair_norm_store(F, y, MIXED, rb + tw, 0, cq);
}
__device__ __forceinline__ void hyfin_item(Frame& F, const bf16* __restrict__ YC, const bf16* __restrict__ X0, bf16* MIXED, int b, int tile) {
    const int tb = F.tid >> 7, cq = F.tid & 127, c0 = 4 * cq, tw = tile * 32 + tb * 8; const size_t rb = (size_t)b * SEQ;
    float yc[4][8], y[8][4];
#pragma unroll
    for (int i = 0; i < 4; ++i) { const v4u v = *(const v4u*)(YC + ((size_t)(c0 + i) * NSEQ + b) * SEQ + tw);
        yc[i][0] = bflo(v.x); yc[i][1] = bfhi(v.x); yc[i][2] = bflo(v.y); yc[i][3] = bfhi(v.y); yc[i][4] = bflo(v.z); yc[i][5] = bfhi(v.z); yc[i][6] = bflo(v.w); yc[i][7] = bfhi(v.w); }
#pragma unroll
    for (int k = 0; k < 8; ++k) { float xv[4]; unpack4(*(const v2u*)(X0 + (rb + tw + k) * HYC + c0), xv);
#pragma unroll
        for (int i = 0; i < 4; ++i) y[k][i] = yc[i][k] * xv[i]; }
    pair_norm_store(F, y, MIXED, rb + tw, 1536, cq);
}
struct PrepGains { float q[3][8], k[3][8]; };
__device__ __forceinline__ void load8(const float* p, float (&o)[8]) { const f32x4 a = *(const f32x4*)p, b = *(const f32x4*)(p + 4); o[0] = a.x; o[1] = a.y; o[2] = a.z; o[3] = a.w; o[4] = b.x; o[5] = b.y; o[6] = b.z; o[7] = b.w; }
__device__ __forceinline__ void unpack8(const v4u w, float (&x)[8]) { x[0] = bflo(w.x); x[1] = bfhi(w.x); x[2] = bflo(w.y); x[3] = bfhi(w.y); x[4] = bflo(w.z); x[5] = bfhi(w.z); x[6] = bflo(w.w); x[7] = bfhi(w.w); }
__device__ __forceinline__ v4u pack8(const float (&x)[8]) { v4u o; o.x = pk2(x[0], x[1]); o.y = pk2(x[2], x[3]); o.z = pk2(x[4], x[5]); o.w = pk2(x[6], x[7]); return o; }
__device__ __forceinline__ float ssq8(const float (&x)[8]) { return ((x[0] * x[0] + x[1] * x[1]) + (x[2] * x[2] + x[3] * x[3])) + ((x[4] * x[4] + x[5] * x[5]) + (x[6] * x[6] + x[7] * x[7])); }
__device__ __forceinline__ float sum8lanes(float v) { v += __shfl_xor(v, 1); v += __shfl_xor(v, 2); v += __shfl_xor(v, 4); return v; }
__device__ __forceinline__ void prep_row(const bf16* __restrict__ PROJ, bf16* Q, bf16* KV, const PrepGains& G, const float* __restrict__ ROPE, int m, int lane) {
    const int h = lane >> 3, sub = lane & 7;
    const bf16* pr = PROJ + (size_t)m * DINP; bf16* qr = Q + (size_t)m * NQ + 192 * h + 8 * sub; bf16* kr = KV + (size_t)m * NKVP + KVHS * h + 8 * sub;
    const v4u cqv = *(const v4u*)(pr + O_CQ + 8 * lane); const v4u ckv = *(const v4u*)(pr + O_CKV + 8 * (lane & 31)); const v4u pev = *(const v4u*)(pr + O_KPE + 8 * sub);
    const v4u q0 = *(const v4u*)(qr), q1 = *(const v4u*)(qr + 64), q2 = *(const v4u*)(qr + 128);
    const v4u k0 = *(const v4u*)(kr), k1 = *(const v4u*)(kr + 64), v0 = *(const v4u*)(kr + 192), v1 = *(const v4u*)(kr + 256);
    float cs[8], sn[8]; { const float* rp = ROPE + (size_t)(m & (SEQ - 1)) * 64 + 8 * (sub & 3); load8(rp, cs); load8(rp + 32, sn); }
    float t[8];
    unpack8(cqv, t); const float rq = 1.0f / sqrtf(wave_sum(ssq8(t)) * (1.f / 512.f) + EPS);
    unpack8(ckv, t); const float rkv = 1.0f / sqrtf(wave_sum(lane < 32 ? ssq8(t) : 0.f) * (1.f / 256.f) + EPS);
    const float sg = (sub < 4) ? -1.f : 1.f;
    { float a0[8], a1[8], a2[8]; unpack8(q0, a0); unpack8(q1, a1); unpack8(q2, a2);
      const float ss = sum8lanes(ssq8(a0) + ssq8(a1) + ssq8(a2)) * (rq * rq);
      const float sc = rq / sqrtf(ss * (1.f / 192.f) + EPS);
      float r[8], o[8];
#pragma unroll
      for (int i = 0; i < 8; ++i) { a0[i] *= sc * G.q[0][i]; a1[i] *= sc * G.q[1][i]; r[i] = a2[i] * sc * G.q[2][i]; }
#pragma unroll
      for (int i = 0; i < 8; ++i) { const float rp = __shfl_xor(r[i], 4); o[i] = r[i] * cs[i] + sg * rp * sn[i]; }
      *(v4u*)(qr) = pack8(a0); *(v4u*)(qr + 64) = pack8(a1); *(v4u*)(qr + 128) = pack8(o); }
    { float a0[8], a1[8], pe[8], b0[8], b1[8]; unpack8(k0, a0); unpack8(k1, a1); unpack8(pev, pe); unpack8(v0, b0); unpack8(v1, b1);
      const float ss = sum8lanes((ssq8(a0) + ssq8(a1)) * (rkv * rkv) + ssq8(pe));
      const float sk = 1.0f / sqrtf(ss * (1.f / 192.f) + EPS);
      float r[8], o[8];
#pragma unroll
      for (int i = 0; i < 8; ++i) { a0[i] *= rkv * sk * G.k[0][i]; a1[i] *= rkv * sk * G.k[1][i]; r[i] = pe[i] * sk * G.k[2][i]; b0[i] *= rkv; b1[i] *= rkv; }
#pragma unroll
      for (int i = 0; i < 8; ++i) { const float rp = __shfl_xor(r[i], 4); o[i] = r[i] * cs[i] + sg * rp * sn[i]; }
      *(v4u*)(kr) = pack8(a0); *(v4u*)(kr + 64) = pack8(a1); *(v4u*)(kr + 128) = pack8(o); *(v4u*)(kr + 192) = pack8(b0); *(v4u*)(kr + 256) = pack8(b1); }
}
__device__ __forceinline__ void attn_norm_row(bf16* MIXED, int m, int lane) {
    v4u* p = (v4u*)(MIXED + (size_t)m * DM + 512 + 16 * lane); v4u a = p[0], b = p[1];
    unsigned w[8] = {a.x, a.y, a.z, a.w, b.x, b.y, b.z, b.w}; float s = 0.f;
#pragma unroll
    for (int i = 0; i < 8; ++i) { const float x = bflo(w[i]), y = bfhi(w[i]); s += x * x + y * y; }
    const float rstd = 1.0f / sqrtf(wave_sum(s) * (1.f / 1024.f) + EPS);
#pragma unroll
    for (int i = 0; i < 8; ++i) w[i] = pk2(bflo(w[i]) * rstd, bfhi(w[i]) * rstd);
    a.x = w[0]; a.y = w[1]; a.z = w[2]; a.w = w[3]; b.x = w[4]; b.y = w[5]; b.z = w[6]; b.w = w[7]; p[0] = a; p[1] = b;
}

#define DEFPTRS() unsigned char* ws = args.ws; \
    bf16* BtIn = (bf16*)(ws + WS_BTIN); bf16* BtUq = (bf16*)(ws + WS_BTUQ); bf16* BtKv = (bf16*)(ws + WS_BTKV); bf16* BtOut = (bf16*)(ws + WS_BTOUT); bf16* BtUp = (bf16*)(ws + WS_BTUP); bf16* BtDn = (bf16*)(ws + WS_BTDN); \
    bf16* RF = (bf16*)(ws + WS_RF); bf16* Hb = (bf16*)(ws + WS_H); bf16* PROJ = (bf16*)(ws + WS_PROJ); bf16* Qb = (bf16*)(ws + WS_Q); bf16* KVb = (bf16*)(ws + WS_KV); \
    bf16* ZT = (bf16*)(ws + WS_ZT); bf16* X0 = (bf16*)(ws + WS_X0); bf16* YC = (bf16*)(ws + WS_YC); float* EDGE = (float*)(ws + WS_EDGE); float* ROPE = (float*)(ws + WS_ROPE); float* SSQP = (float*)(ws + WS_SSQP); float* RSTD = (float*)(ws + WS_RSTD); bf16* XB2 = (bf16*)(ws + WS_XB2); bf16* ACT = (bf16*)(ws + WS_ACT); \
    bf16* XA = (bf16*)args.out; \
    (void)BtIn; (void)BtUq; (void)BtKv; (void)BtOut; (void)BtUp; (void)BtDn; (void)RF; (void)Hb; (void)PROJ; (void)Qb; (void)KVb; (void)ZT; (void)X0; (void)YC; (void)EDGE; (void)ROPE; (void)SSQP; (void)RSTD; (void)XB2; (void)ACT; (void)XA
__global__ void __launch_bounds__(NWAVES * 64, 2) fwd(Args args) {
    extern __shared__ __attribute__((aligned(16))) unsigned char lds_raw[];
    Frame F;
    F.lds = (LAS unsigned char*)lds_raw;
    F.tid = threadIdx.x; F.lane = F.tid & 63; F.wave = __builtin_amdgcn_readfirstlane(F.tid >> 6);
    F.G = gridDim.x; { const int bx = blockIdx.x; F.vcu = (F.G % 8 == 0) ? (bx % 8) * (F.G / 8) + bx / 8 : bx; }
    volatile LAS unsigned* MISC = (volatile LAS unsigned*)(F.lds + MISC_OFF);
    if (F.tid < 64) MISC[F.tid] = 0u;
    __syncthreads();
    unsigned* ctl = (unsigned*)(args.ws + WS_CTL);
    const int lo = args.ph_lo, hi = args.ph_hi;
    XcdBarrier bar; bar.bar = ctl + CW_BAR; bar.x = 0; bar.st = MISC + 8;
    if (hi - lo > 1) bar = xcd_barrier_post(ctl + CW_BAR, MISC + 8);
    float* out = args.out;

#pragma unroll 1
    for (int layer = 0; layer < DEPTH; ++layer) {
        const int pb = layer * NPH;
        if (pb + NPH <= lo || pb >= hi) continue;
#define IN(k) (lo <= pb + (k) && pb + (k) < hi)
#define ENTER() DEFPTRS(); F.tid = opq(threadIdx.x); F.lane = F.tid & 63; F.wave = __builtin_amdgcn_readfirstlane(F.tid >> 6); const int gw = F.vcu * NWAVES + F.wave, NGW = F.G * NWAVES, wg = F.vcu; const size_t gtid = (size_t)wg * 512 + F.tid, gthreads = (size_t)F.G * 512; (void)gw; (void)NGW; (void)wg; (void)gtid; (void)gthreads
#define SEAM(k) do { if (pb + (k) + 1 < hi) xcd_barrier(bar); } while (0)

        if (IN(0)) { ENTER();
            const float* win = args.in[I_WIN] + (size_t)layer * DM * DIN; const float* g1 = args.in[I_ANG] + layer * DM;
            for (int it = wg; it < 256; it += F.G) {
                if (it < 128) poolfold_item(F, win, args.in[I_PW] + (size_t)layer * 4 * 128 * 128, args.in[I_PS] + (size_t)layer * 512, g1, BtIn, it >> 5, it & 31);
                else filter_item(F, args.in[I_FW1] + (size_t)layer * 17 * 64, args.in[I_FB1] + layer * 64, args.in[I_FFR] + layer * 64, args.in[I_FW2] + (size_t)layer * 64 * 64, args.in[I_FB2] + layer * 64,
                                 args.in[I_FW3] + (size_t)layer * 64 * 1024, args.in[I_FB3] + layer * 1024, args.in[I_HBIAS] + layer * 512, RF, it - 128);
            }
            constexpr int T_IN = 19 * 16, T_UQ = 12 * 4, T_KV = 16 * 2, T_OUT = 16 * 16, T_UP = 88 * 16, T_DN = 16 * 44, T_ALL = T_IN + T_UQ + T_KV + T_OUT + T_UP + T_DN;
            for (int it = wg; it < T_ALL; it += F.G) {
                int r = it; CvtTile d;
                if (r < T_IN) { const int nt = r >> 4, kt = r & 15, n0 = 512 + 128 * nt; d = CvtTile{win, g1, BtIn, DIN, DM, n0, 128 * kt, DIN, {n0, n0 + 32, n0 + 64, n0 + 96}}; }
                else if ((r -= T_IN) < T_UQ) { const int nt = r >> 2, kt = r & 3, n0 = 128 * nt; d = CvtTile{args.in[I_WUQ] + (size_t)layer * 512 * NQ, args.in[I_QNG] + layer * 512, BtUq, NQ, 512, n0, 128 * kt, NQ, {n0, n0 + 32, n0 + 64, n0 + 96}}; }
                else if ((r -= T_UQ) < T_KV) { const int nt = r >> 1, kt = r & 1, n0 = 128 * nt, h = nt >> 1, bs = KVHS * h + ((nt & 1) ? 192 : 0);
                    d = CvtTile{args.in[I_WUKV] + (size_t)layer * 256 * 2048, args.in[I_KVNG] + layer * 256, BtKv, 2048, 256, n0, 128 * kt, 2048, {bs, bs + 32, bs + 64, bs + 96}}; }
                else if ((r -= T_KV) < T_OUT) { const int nt = r >> 4, kt = r & 15, n0 = 128 * nt; d = CvtTile{args.in[I_WOUT] + (size_t)layer * DM * DM, args.in[I_GNG] + layer * DM, BtOut, DM, DM, n0, 128 * kt, DM, {n0, n0 + 32, n0 + 64, n0 + 96}}; }
                else if ((r -= T_OUT) < T_UP) { const int nt = r >> 4, kt = r & 15, n0 = 128 * nt; const int nv = (nt < 44) ? nt : nt - 44; const int bs = 256 * nv + ((nt < 44) ? 0 : 32);
                    d = CvtTile{args.in[I_WUP] + (size_t)layer * DM * NUP, args.in[I_FNG] + layer * DM, BtUp, NUP, DM, n0, 128 * kt, NUP, {bs, bs + 64, bs + 128, bs + 192}}; }
                else { r -= T_UP; const int nt = r / 44, kt = r % 44, n0 = 128 * nt; d = CvtTile{args.in[I_WDN] + (size_t)layer * DFF * DM, nullptr, BtDn, DM, DFF, n0, 128 * kt, DM, {n0, n0 + 32, n0 + 64, n0 + 96}}; }
                cvt_tile(F, d);
            }
            { unsigned zz = 0u; asm volatile("" : "+v"(zz)); v4u z = {zz, zz, zz, zz};
              for (size_t i = gtid; i < (size_t)(DINP - DIN) * DM / 8; i += gthreads) *(v4u*)(BtIn + (size_t)DIN * DM + i * 8) = z;
              for (size_t i = gtid; i < (size_t)NH * 64 * 256 / 8; i += gthreads) { const int h = (int)(i / (64 * 256 / 8)), q = (int)(i % (64 * 256 / 8)); *(v4u*)(BtKv + (size_t)(KVHS * h + 128) * 256 + (size_t)q * 8) = z; } }
            if (layer == 0) for (size_t i = gtid; i < (size_t)SEQ * 32; i += gthreads) { const int pos = (int)(i >> 5), ri = (int)(i & 31);
                const float freq = exp2f(-(float)ri * (13.287712379549449f / 32.0f)); float sn, cs; sincosf((float)pos * freq, &sn, &cs); ROPE[pos * 64 + ri] = cs; ROPE[pos * 64 + 32 + ri] = sn; }
            if (layer == 0) { for (int m = gw; m < M; m += NGW) xb_row(m < MP ? args.in[I_XP] + (size_t)m * DM : args.in[I_XS] + (size_t)(m - MP) * DM, XA + (size_t)m * DM, RSTD + m, F.lane); }
            else rstd_from_partials(SSQP, RSTD, gtid, gthreads);
            SEAM(0);
        }
        if (IN(1)) { ENTER();
            pg8::Gemm g{XA, BtIn, M, DINP, DM, DM}; pg8::StaticOrder S; S.init(M, DINP, F.G, (int)blockIdx.x);
            pg8::EpiBf16 E{PROJ, DINP, RSTD};
            pg8::gemm_phase<pg8::EpiBf16, pg8::StaticOrder>(F.lds, g, S, E);
            SEAM(1);
        }
        if (IN(2)) { ENTER();
            { pg8::Gemm g{PROJ + O_CQ, BtUq, M, NQ, 512, DINP}; pg8::StaticOrder S; S.init(M, NQ, F.G, (int)blockIdx.x); pg8::EpiBf16 E{Qb, NQ, nullptr};
              pg8::gemm_phase<pg8::EpiBf16, pg8::StaticOrder>(F.lds, g, S, E); }
            { pg8::Gemm g{PROJ + O_CKV, BtKv, M, NKVP, 256, DINP}; pg8::StaticOrder S; S.init(M, NKVP, F.G, (int)blockIdx.x); pg8::EpiBf16 E{KVb, NKVP, nullptr};
              pg8::gemm_phase<pg8::EpiBf16, pg8::StaticOrder>(F.lds, g, S, E); }
            const float* hcw = args.in[I_HCW] + (size_t)layer * 3 * 1536; const float* hcb = args.in[I_HCB] + layer * 1536;
            for (int it = wg; it < 2 * NSEQ * 64; it += F.G) {
                if (it < NSEQ * 64) hyprep_item(F, PROJ, hcw, hcb, ZT, X0, it >> 6, it & 63);
                else pool_item(F, PROJ, Hb, (it - NSEQ * 64) >> 6, it & 63);
            }
            SEAM(2);
        }
        if (IN(3)) { ENTER();
            for (int u = wg; u < 2 * HYC; u += F.G) hy::conv_unit(F.lds, ZT, RF, YC, u >> 1, u & 1);
            const float* qhg = args.in[I_QHG] + layer * 192; const float* khg = args.in[I_KHG] + layer * 192;
            PrepGains PG; { const int sub = F.lane & 7;
#pragma unroll
                for (int i = 0; i < 3; ++i) { load8(qhg + 64 * i + 8 * sub, PG.q[i]); load8(khg + 64 * i + 8 * sub, PG.k[i]); } }
            for (int m = gw; m < M; m += NGW) prep_row(PROJ, Qb, KVb, PG, ROPE, m, F.lane);
            SEAM(3);
        }
        if (IN(4)) { ENTER();
            float gqm, gkm; { const float* qhg = args.in[I_QHG] + layer * 192; const float* khg = args.in[I_KHG] + layer * 192;
                gqm = fmaxf(fmaxf(fabsf(qhg[F.lane]), fabsf(qhg[64 + F.lane])), fabsf(qhg[128 + F.lane])); gkm = fmaxf(fmaxf(fabsf(khg[F.lane]), fabsf(khg[64 + F.lane])), fabsf(khg[128 + F.lane]));
#pragma unroll
                for (int o = 1; o < 64; o <<= 1) { gqm = fmaxf(gqm, __shfl_xor(gqm, o)); gkm = fmaxf(gkm, __shfl_xor(gkm, o)); } }
            const float Mnat = 13.856406460551018f * gqm * gkm;
            const bool sm_fast = __builtin_amdgcn_readfirstlane((Mnat <= 40.0f) ? 1 : 0) != 0;
            const float negMC = __builtin_bit_cast(float, __builtin_amdgcn_readfirstlane(__builtin_bit_cast(int, -Mnat * 1.4426950408889634f)));
            for (int i = 0; i * F.G < NSEQ * NH * 8; ++i) {
                int p, qb; const int c = (int)blockIdx.x;
                if (F.G == 256) { p = i * 32 + (c & 7) * 4 + (c >> 6); qb = (c >> 3) & 7; } else { const int Lq = i * F.G + c; p = Lq >> 3; qb = Lq & 7; }
                if (p < NSEQ * NH) { const int b = p >> 3, h = p & 7;
                    const bf16* qp = Qb + (size_t)(b * SEQ + qb * 256) * NQ + h * 192; const bf16* kp = KVb + (size_t)(b * SEQ) * NKVP + h * KVHS; bf16* op = Hb + (size_t)(b * SEQ + qb * 256) * DM + 512 + h * 128;
                    if (sm_fast) at::attn_unit<true>(negMC, qp, kp, kp + 192, op, SEQ, (char*)lds_raw);
                    else at::attn_unit<false>(0.f, qp, kp, kp + 192, op, SEQ, (char*)lds_raw); }
            }
            for (int it = wg; it < NSEQ * 64; it += F.G) hyfin_item(F, YC, X0, Hb, it >> 6, it & 63);
            SEAM(4);
        }
        if (IN(5)) { ENTER();
            for (int m = gw; m < M; m += NGW) attn_norm_row(Hb, m, F.lane);
            SEAM(5);
        }
        if (IN(6)) { ENTER();
            pg8::Gemm g{Hb, BtOut, M, DM, DM, DM}; pg8::StaticOrder S; S.init(M, DM, F.G, (int)blockIdx.x);
            pg8::EpiResid16 E{XA, XB2, out, DM, SSQP, 0};
            pg8::gemm_phase<pg8::EpiResid16, pg8::StaticOrder>(F.lds, g, S, E);
            SEAM(6);
        }
        if (IN(7)) { ENTER();
            rstd_from_partials(SSQP, RSTD, gtid, gthreads);
            SEAM(7);
        }
        if (IN(8)) { ENTER();
            pg8::Gemm g{XB2, BtUp, M, NUP, DM, DM}; pg8::StaticOrder S; S.init(M, NUP, F.G, (int)blockIdx.x);
            pg8::EpiGate E{ACT, DFF, EDGE, args.in[I_FCW] + (size_t)layer * 3 * DFF, args.in[I_FCB] + layer * DFF, DFF, (LAS float*)(F.lds + HALO_OFF), RSTD};
            pg8::gemm_phase<pg8::EpiGate, pg8::StaticOrder>(F.lds, g, S, E);
            SEAM(8);
        }
        if (IN(9)) { ENTER();
            const float* fcw = args.in[I_FCW] + (size_t)layer * 3 * DFF;
            for (size_t i = gtid; i < (size_t)(M / 256) * 2 * (DFF / 4); i += gthreads) {
                const int ri = (int)(i / (DFF / 4)), c4 = (int)(i % (DFF / 4)) * 4, pm = ri >> 1, e = ri & 1;
                const float* eb = EDGE + (size_t)(ri * 3) * DFF + c4;
                f32x4 pre = *(const f32x4*)(eb + DFF); const f32x4 v = *(const f32x4*)(eb + 2 * DFF);
                if (e == 0 && (pm & 7) != 0) { const f32x4 gp = *(const f32x4*)(EDGE + (size_t)(((pm - 1) * 2 + 1) * 3) * DFF + c4); pre += *(const f32x4*)(fcw + c4) * gp; }
                if (e == 1 && (pm & 7) != 7) { const f32x4 gn = *(const f32x4*)(EDGE + (size_t)(((pm + 1) * 2 + 0) * 3) * DFF + c4); pre += *(const f32x4*)(fcw + 2 * DFF + c4) * gn; }
                v2u o; o.x = pk2(pg8::silu_f(pre.x) * v.x, pg8::silu_f(pre.y) * v.y); o.y = pk2(pg8::silu_f(pre.z) * v.z, pg8::silu_f(pre.w) * v.w);
                *(v2u*)(ACT + (size_t)(pm * 256 + (e ? 255 : 0)) * DFF + c4) = o;
            }
            SEAM(9);
        }
        if (IN(10)) { ENTER();
            pg8::Gemm g{ACT, BtDn, M, DM, DFF, DFF}; pg8::StaticOrder S; S.init(M, DM, F.G, (int)blockIdx.x);
            pg8::EpiResid16 E{XB2, XA, out, DM, SSQP, (layer + 1 < DEPTH) ? 0 : 1};
            pg8::gemm_phase<pg8::EpiResid16, pg8::StaticOrder>(F.lds, g, S, E);
            SEAM(10);
        }
#undef IN
#undef ENTER
#undef SEAM
    }
}

extern "C" void kernel_launch(void* const* d_in, const int* in_sizes, int n_in, void* d_out, int out_size, void* d_ws, size_t ws_size, hipStream_t stream) {
    static int grid = 0;
    if (grid == 0) {
        if (n_in != N_IN || out_size != M * DM || ws_size < WS_END) { fprintf(stderr, "kernel_launch: unexpected shapes (n_in %d, out %d, ws %zu, need %zu)\n", n_in, out_size, ws_size, (size_t)WS_END); grid = -1; return; }
        int dev = 0, cus = 0;
        if (hipGetDevice(&dev) != hipSuccess || hipDeviceGetAttribute(&cus, hipDeviceAttributeMultiprocessorCount, dev) != hipSuccess) { grid = -1; return; }
        if (hipFuncSetAttribute((const void*)fwd, hipFuncAttributeMaxDynamicSharedMemorySize, LDS_BYTES) != hipSuccess) { fprintf(stderr, "kernel_launch: hipFuncSetAttribute failed\n"); grid = -1; return; }
        int per_cu = 0;
        if (hipOccupancyMaxActiveBlocksPerMultiprocessor(&per_cu, (const void*)fwd, NWAVES * 64, LDS_BYTES) != hipSuccess || per_cu < 1) fprintf(stderr, "kernel_launch: occupancy query reports %d\n", per_cu);
        (void)hipGetLastError();
        grid = cus;
    }
    if (grid < 0) return;
    (void)hipMemsetAsync((char*)d_ws + WS_CTL, 0, CTL_BYTES, stream);
    Args a{};
    for (int i = 0; i < N_IN; ++i) a.in[i] = (const float*)d_in[i];
    a.out = (float*)d_out; a.ws = (unsigned char*)d_ws;
#if MK_ONE_LAUNCH
    a.ph_lo = 0; a.ph_hi = DEPTH * NPH;
    hipLaunchKernelGGL(fwd, dim3(grid), dim3(NWAVES * 64), LDS_BYTES, stream, a);
#else
    for (int p = 0; p < DEPTH * NPH; ++p) { a.ph_lo = p; a.ph_hi = p + 1; hipLaunchKernelGGL(fwd, dim3(grid), dim3(NWAVES * 64), LDS_BYTES, stream, a); }
#endif
    const hipError_t le = hipPeekAtLastError();
    if (le != hipSuccess) fprintf(stderr, "kernel_launch: launch failed: %s\n", hipGetErrorName(le));
}
```

```cpp
#include <hip/hip_runtime.h>
#include <cstdio>
#include <cstdint>
__device__ __forceinline__ int opq(int x) { asm volatile("" : "+v"(x)); return x; }
namespace pg8 {
#define PG8_LAS __attribute__((address_space(3)))
typedef unsigned short bf16_t;
typedef short bf16x8 __attribute__((ext_vector_type(8)));
typedef float f32x4 __attribute__((ext_vector_type(4)));
typedef unsigned u32x4 __attribute__((ext_vector_type(4)));
constexpr int BM = 256, BK = 64, HALF = 128, HTB = HALF * BK * 2  , STAGE_BYTES = 8 * HTB, NXCD = 8, WGM = 8;

__host__ __device__ __forceinline__ int lds_byte(int r, int c) { const int st = (r >> 4) * 2 + (c >> 5), rr = r & 15, cc = c & 31, ob = rr * 64 + cc * 2; return st * 1024 + (ob ^ (((ob >> 9) & 1) << 5)); }
__host__ __device__ __forceinline__ void stage_rc(int b, int& R, int& C) { const int st = b / 1024, sb = b % 1024, swz = sb ^ (((sb >> 9) & 1) << 5); R = (st >> 1) * 16 + swz / 64; C = (st & 1) * 32 + (swz % 64) / 2; }
__host__ __device__ __forceinline__ int perm32(int rho) { const int n = rho >> 4, i = rho & 15; return 8 * (i >> 2) + 4 * n + (i & 3); }

struct Unit { int pm, pn; };
struct Gemm { const bf16_t* A; const bf16_t* Bt; int M, N, K, lda; };

struct StaticOrder {
    int nM, nN, nwg, G, c;
    __host__ __device__ void init(int M, int N, int G_, int c_) { nM = M / BM; nN = N / BM; nwg = nM * nN; G = G_; c = c_; }
    __host__ __device__ bool next(int i, Unit& u) const {
        const long L = (long)i * G + c; if (L >= nwg) return false;
        int wgid = (int)L; { const int q = nwg / NXCD, r = nwg % NXCD, xcd = wgid % NXCD, off = wgid / NXCD; wgid = (xcd < r ? xcd * (q + 1) : r * (q + 1) + (xcd - r) * q) + off; }
        const int nig = WGM * nN, gid = wgid / nig, fm = gid * WGM, gsz = (nM - fm) < WGM ? (nM - fm) : WGM;
        u.pm = fm + ((wgid % nig) % gsz); u.pn = (wgid % nig) / gsz; return true;
    }
    __device__ __forceinline__ void a_ready(const Unit&) const {}
    __device__ __forceinline__ void done(const Unit&) const {}
};

__device__ __forceinline__ unsigned cvt_pk_bf16(float lo, float hi) { unsigned r; asm volatile("v_cvt_pk_bf16_f32 %0, %1, %2" : "=v"(r) : "v"(lo), "v"(hi)); return r; }

__device__ __forceinline__ float dpp_ror1(float v) { return __builtin_bit_cast(float, __builtin_amdgcn_update_dpp(0, __builtin_bit_cast(int, v), 0x121, 0xF, 0xF, false)); }
__device__ __forceinline__ float dpp_ror15(float v) { return __builtin_bit_cast(float, __builtin_amdgcn_update_dpp(0, __builtin_bit_cast(int, v), 0x12F, 0xF, 0xF, false)); }
__device__ __forceinline__ unsigned dpp_swap1(unsigned v) { return (unsigned)__builtin_amdgcn_update_dpp(0, (int)v, 0xB1, 0xF, 0xF, false); }
struct LineOffs { unsigned o0, o1; bool odd; };
__device__ __forceinline__ LineOffs line_offs(unsigned lo, int pitch, int fr) { LineOffs L; L.odd = fr & 1; L.o0 = L.odd ? lo - (unsigned)pitch + 32u : lo; L.o1 = L.odd ? lo + 32u : lo + (unsigned)pitch; return L; }
__device__ __forceinline__ void store_lines(bf16_t* base, const LineOffs& L, u32x4 a, u32x4 b) {
    const u32x4 snd = L.odd ? a : b; u32x4 rcv;
    rcv.x = dpp_swap1(snd.x); rcv.y = dpp_swap1(snd.y); rcv.z = dpp_swap1(snd.z); rcv.w = dpp_swap1(snd.w);
    *(u32x4*)(base + L.o0) = L.odd ? rcv : a;
    *(u32x4*)(base + L.o1) = L.odd ? b : rcv;
}
struct EpiBf16 {
    static constexpr bool PERM = true;
    bf16_t* O; int ldc; const float* rstd; int kvscatter;
    __device__ __forceinline__ void operator()(f32x4 (&acc)[2][2][4][2], const Unit& u, int wr, int wc, int fr, int fq) const {
        bf16_t* Ot = O + (size_t)(u.pm * BM) * ldc + (kvscatter ? u.pn * 320 : u.pn * BM);
        const int wcol = kvscatter ? (wc < 2 ? wc * 64 : 64 + wc * 64) : wc * 64;
        const LineOffs L = line_offs((unsigned)((wr * 64 + fr) * ldc + wcol + 8 * fq), ldc, fr); const int row0 = u.pm * BM + wr * 64 + fr;
        float rsv[8];
#pragma unroll
        for (int i = 0; i < 8; ++i) rsv[i] = rstd ? rstd[row0 + (i >> 2) * HALF + (i & 3) * 16] : 1.0f;
#pragma unroll
        for (int ai = 0; ai < 2; ++ai)
#pragma unroll
            for (int m = 0; m < 4; ++m) { const float rs = rsv[ai * 4 + m];
                u32x4 w[2];
#pragma unroll
                for (int bj = 0; bj < 2; ++bj) { const f32x4 v0 = acc[ai][bj][m][0] * rs, v1 = acc[ai][bj][m][1] * rs;
                    w[bj].x = cvt_pk_bf16(v0[0], v0[1]); w[bj].y = cvt_pk_bf16(v0[2], v0[3]); w[bj].z = cvt_pk_bf16(v1[0], v1[1]); w[bj].w = cvt_pk_bf16(v1[2], v1[3]); }
                store_lines(Ot + (size_t)((ai * HALF + m * 16) * ldc), L, w[0], w[1]);
                asm volatile("" ::: "memory"); }
    }
};
struct EpiResid16 {
    static constexpr bool PERM = true;
    const bf16_t* base; bf16_t* xo; float* out; int ldc; float* ssqp; int f32out;
    __device__ __forceinline__ static void addx(const u32x4 b, const f32x4 a0, const f32x4 a1, f32x4& x0, f32x4& x1) {
        x0[0] = __builtin_bit_cast(float, b.x << 16) + a0[0]; x0[1] = __builtin_bit_cast(float, b.x & 0xffff0000u) + a0[1]; x0[2] = __builtin_bit_cast(float, b.y << 16) + a0[2]; x0[3] = __builtin_bit_cast(float, b.y & 0xffff0000u) + a0[3];
        x1[0] = __builtin_bit_cast(float, b.z << 16) + a1[0]; x1[1] = __builtin_bit_cast(float, b.z & 0xffff0000u) + a1[1]; x1[2] = __builtin_bit_cast(float, b.w << 16) + a1[2]; x1[3] = __builtin_bit_cast(float, b.w & 0xffff0000u) + a1[3]; }
    __device__ __forceinline__ void operator()(f32x4 (&acc)[2][2][4][2], const Unit& u, int wr, int wc, int fr, int fq) const {
        const size_t tb = (size_t)(u.pm * BM) * ldc + u.pn * BM;
        const bf16_t* bs = base + tb;
        const unsigned lo = (unsigned)((wr * 64 + fr) * ldc + wc * 64 + 8 * fq);
        if (f32out != 0) {
            float* op = out + tb;
#pragma unroll
            for (int ai = 0; ai < 2; ++ai)
#pragma unroll
                for (int m = 0; m < 4; ++m) { const unsigned off = lo + (unsigned)((ai * HALF + m * 16) * ldc);
#pragma unroll
                    for (int bj = 0; bj < 2; ++bj) { const u32x4 b = *(const u32x4*)(bs + off + bj * 32); f32x4 x0, x1; addx(b, acc[ai][bj][m][0], acc[ai][bj][m][1], x0, x1);
                        *(f32x4*)(op + off + bj * 32) = x0; *(f32x4*)(op + off + bj * 32 + 4) = x1; }
                    asm volatile("" ::: "memory"); }
            return;
        }
        bf16_t* xp = xo + tb; const LineOffs L = line_offs(lo, ldc, fr);
#pragma unroll
        for (int aim = 0; aim < 4; ++aim) { const int ai = aim >> 1, mp = aim & 1;
            u32x4 bv[2][2];
#pragma unroll
            for (int mm = 0; mm < 2; ++mm)
#pragma unroll
                for (int bj = 0; bj < 2; ++bj) bv[mm][bj] = *(const u32x4*)(bs + lo + (unsigned)((ai * HALF + (2 * mp + mm) * 16) * ldc) + bj * 32);
#pragma unroll
            for (int mm = 0; mm < 2; ++mm) { const int m = 2 * mp + mm; float s = 0.f; u32x4 wv[2];
#pragma unroll
                for (int bj = 0; bj < 2; ++bj) { f32x4 x0, x1; addx(bv[mm][bj], acc[ai][bj][m][0], acc[ai][bj][m][1], x0, x1);
                    wv[bj].x = cvt_pk_bf16(x0[0], x0[1]); wv[bj].y = cvt_pk_bf16(x0[2], x0[3]); wv[bj].z = cvt_pk_bf16(x1[0], x1[1]); wv[bj].w = cvt_pk_bf16(x1[2], x1[3]);
                    s += ((x0[0] * x0[0] + x0[1] * x0[1]) + (x0[2] * x0[2] + x0[3] * x0[3])) + ((x1[0] * x1[0] + x1[1] * x1[1]) + (x1[2] * x1[2] + x1[3] * x1[3])); }
                store_lines(xp + (size_t)((ai * HALF + m * 16) * ldc), L, wv[0], wv[1]);
                s += __shfl_xor(s, 16); s += __shfl_xor(s, 32); if (fq == 0) ssqp[(size_t)(u.pm * BM + wr * 64 + fr + ai * HALF + m * 16) * 32 + u.pn * 4 + wc] = s; }
            asm volatile("" ::: "memory"); }
    }
};
__device__ __forceinline__ float silu_f(float x) { return x * __builtin_amdgcn_rcpf(1.0f + __builtin_amdgcn_exp2f(-1.4426950408889634f * x)); }
struct EpiGate {
    static constexpr bool PERM = true;
    bf16_t* act; int ldact; float* edge; const float* cw; const float* cb; int dff; PG8_LAS float* halo; const float* rstd;
    __device__ __forceinline__ void operator()(f32x4 (&acc)[2][2][4][2], const Unit& u, int wr, int wc, int fr, int fq) const {
        const int lane = fq * 16 + fr; const int colL = wc * 32 + 8 * fq; const int colG = u.pn * HALF + colL;
#pragma unroll
        for (int ai = 0; ai < 2; ++ai)
#pragma unroll
            for (int m = 0; m < 4; ++m) { const float rs = rstd[u.pm * BM + ai * HALF + wr * 64 + m * 16 + fr];
#pragma unroll
                for (int bj = 0; bj < 2; ++bj) { acc[ai][bj][m][0] *= rs; acc[ai][bj][m][1] *= rs; } }
#pragma unroll
        for (int ai = 0; ai < 2; ++ai) { const int q = 2 * ai + wr;
            if (fr == 0) { *(PG8_LAS f32x4*)(halo + (q * 2 + 0) * 128 + colL) = acc[ai][0][0][0]; *(PG8_LAS f32x4*)(halo + (q * 2 + 0) * 128 + colL + 4) = acc[ai][0][0][1]; }
            if (fr == 15) { *(PG8_LAS f32x4*)(halo + (q * 2 + 1) * 128 + colL) = acc[ai][0][3][0]; *(PG8_LAS f32x4*)(halo + (q * 2 + 1) * 128 + colL + 4) = acc[ai][0][3][1]; } }
        asm volatile("s_waitcnt lgkmcnt(0)" ::: "memory"); __builtin_amdgcn_s_barrier(); asm volatile("" ::: "memory");
        bf16_t* actp = act + (size_t)(u.pm * BM) * ldact + colG; const unsigned rlo = (unsigned)((wr * 64 + fr) * ldact);
#pragma unroll
        for (int ai = 0; ai < 2; ++ai) { const int q = 2 * ai + wr;
            typedef unsigned u32x2 __attribute__((ext_vector_type(2)));
            u32x2 pk[4][2];
#pragma unroll
            for (int n = 0; n < 2; ++n) {
                const f32x4 w0 = *(const f32x4*)(cw + colG + 4 * n), w1 = *(const f32x4*)(cw + dff + colG + 4 * n), w2 = *(const f32x4*)(cw + 2 * dff + colG + 4 * n), bb = *(const f32x4*)(cb + colG + 4 * n);
                f32x4 ht = *(PG8_LAS f32x4*)(halo + ((q > 0 ? q - 1 : 0) * 2 + 1) * 128 + colL + 4 * n), hb = *(PG8_LAS f32x4*)(halo + ((q < 3 ? q + 1 : 3) * 2 + 0) * 128 + colL + 4 * n);
                if (q == 0) ht = ht * 0.f; if (q == 3) hb = hb * 0.f;
                f32x4 pre[4];
#pragma unroll
                for (int j = 0; j < 4; ++j) {
                    float g[4], rr[4], rl[4];
#pragma unroll
                    for (int m = 0; m < 4; ++m) { g[m] = acc[ai][0][m][n][j]; rr[m] = dpp_ror1(g[m]); rl[m] = dpp_ror15(g[m]); }
#pragma unroll
                    for (int m = 0; m < 4; ++m) {
                        const float up = (fr > 0) ? rr[m] : (m > 0 ? rr[m > 0 ? m - 1 : 0] : ht[j]);
                        const float dn = (fr < 15) ? rl[m] : (m < 3 ? rl[m < 3 ? m + 1 : 3] : hb[j]);
                        pre[m][j] = w0[j] * up + w1[j] * g[m] + w2[j] * dn + bb[j];
                    }
                }
                if (q == 0 && fr == 0) { float* e = edge + (size_t)((u.pm * 2 + 0) * 3) * dff + colG + 4 * n;
                    *(f32x4*)(e) = acc[ai][0][0][n]; *(f32x4*)(e + dff) = pre[0]; *(f32x4*)(e + 2 * dff) = acc[ai][1][0][n]; }
                if (q == 3 && fr == 15) { float* e = edge + (size_t)((u.pm * 2 + 1) * 3) * dff + colG + 4 * n;
                    *(f32x4*)(e) = acc[ai][0][3][n]; *(f32x4*)(e + dff) = pre[3]; *(f32x4*)(e + 2 * dff) = acc[ai][1][3][n]; }
#pragma unroll
                for (int m = 0; m < 4; ++m) { const f32x4 v = acc[ai][1][m][n];
                    pk[m][n].x = cvt_pk_bf16(silu_f(pre[m][0]) * v[0], silu_f(pre[m][1]) * v[1]); pk[m][n].y = cvt_pk_bf16(silu_f(pre[m][2]) * v[2], silu_f(pre[m][3]) * v[3]); }
            }
#pragma unroll
            for (int m = 0; m < 4; ++m) { u32x4 w; w.x = pk[m][0].x; w.y = pk[m][0].y; w.z = pk[m][1].x; w.w = pk[m][1].y;
                *(u32x4*)(actp + rlo + (unsigned)((ai * HALF + m * 16) * ldact)) = w; }
        }
    }
};

template <class Epi, class Sched>
__device__ __forceinline__ void gemm_phase(PG8_LAS unsigned char* lds, const Gemm g, const Sched& S, const Epi& E) {
    const int tid = opq(threadIdx.x), wid = __builtin_amdgcn_readfirstlane(tid >> 6), lane = tid & 63, wr = wid >> 2, wc = wid & 3, fr = lane & 15, fq = lane >> 4;
    const int K = g.K, nt = K / BK, lda = g.lda;
    unsigned voffA[2], voffB[2];
#pragma unroll
    for (int i = 0; i < 2; ++i) { int R, C; stage_rc(tid * 16 + i * 8192, R, C); const int Rb = Epi::PERM ? (64 * (R >> 5) + perm32(R & 31)) : R;
        voffA[i] = (unsigned)(R * lda + C) * 2u; voffB[i] = (unsigned)(Rb * K + C) * 2u; }
    const size_t kstep = (size_t)(BK * 2);
    const size_t hstepA = (size_t)HALF * lda * 2, hstepB = (size_t)(Epi::PERM ? 32 : HALF) * K * 2;
    const size_t tstepA = 2 * hstepA, tstepB = (size_t)BM * K * 2;
    const unsigned ldsw = (unsigned)wid * 1024u;
    const int aoff = lds_byte(wr * 64 + fr, fq * 8), boff = lds_byte(wc * 32 + fr, fq * 8);
#define PG8_SA(b, h) (((b) * 2 + (h)) * HTB)
#define PG8_SB(b, h) ((4 + (b) * 2 + (h)) * HTB)
#define PG8_STAGE(bufoff, gbase, voff) do { _Pragma("unroll") for (int _i = 0; _i < 2; ++_i) \
        __builtin_amdgcn_global_load_lds((const unsigned*)((const char*)(gbase) + (voff)[_i]), (PG8_LAS unsigned*)(lds + (bufoff) + ldsw + _i * 8192), 16, 0, 0); } while (0)
#define PG8_LDA(dst, b, h) do { _Pragma("unroll") for (int m = 0; m < 4; ++m) _Pragma("unroll") for (int k = 0; k < 2; ++k) dst[m][k] = *(const PG8_LAS bf16x8*)(lds + PG8_SA(b, h) + aoff + m * 2048 + k * 1024); } while (0)
#define PG8_LDB(dst, b, h) do { _Pragma("unroll") for (int n = 0; n < 2; ++n) _Pragma("unroll") for (int k = 0; k < 2; ++k) dst[n][k] = *(const PG8_LAS bf16x8*)(lds + PG8_SB(b, h) + boff + n * 2048 + k * 1024); } while (0)
#define PG8_MMA(ai, bj, At, Bt) do { __builtin_amdgcn_s_setprio(1); _Pragma("unroll") for (int m = 0; m < 4; ++m) _Pragma("unroll") for (int n = 0; n < 2; ++n) _Pragma("unroll") for (int k = 0; k < 2; ++k) \
        acc[ai][bj][m][n] = __builtin_amdgcn_mfma_f32_16x16x32_bf16(Bt[n][k], At[m][k], acc[ai][bj][m][n], 0, 0, 0); __builtin_amdgcn_s_setprio(0); } while (0)
#define PG8_WAIT_V(n) asm volatile("s_waitcnt vmcnt(" #n ")" ::: "memory")
#define PG8_WAIT_L(n) asm volatile("s_waitcnt lgkmcnt(" #n ")" ::: "memory")
#define PG8_BAR __builtin_amdgcn_s_barrier()
#define PG8_SCHED __builtin_amdgcn_sched_barrier(0)
    Unit cur, nxt; int ui = 0;
    if (!S.next(0, cur)) return;
    f32x4 acc[2][2][4][2];
{ float zf = 0.f; asm volatile("" : "+v"(zf));
    #pragma unroll
    for (int a = 0; a < 2; ++a)
#pragma unroll
        for (int b = 0; b < 2; ++b)
#pragma unroll
            for (int m = 0; m < 4; ++m)
#pragma unroll
                for (int n = 0; n < 2; ++n) acc[a][b][m][n] = (f32x4){zf, zf, zf, zf}; }
    bf16x8 At[4][2], B0[2][2], B1[2][2];
    const char* cA = (const char*)g.A + (size_t)cur.pm * tstepA; const char* cB = (const char*)g.Bt + (size_t)cur.pn * tstepB;
    S.a_ready(cur);
    PG8_STAGE(PG8_SB(0, 0), cB, voffB); PG8_STAGE(PG8_SB(0, 1), cB + hstepB, voffB); PG8_STAGE(PG8_SA(0, 0), cA, voffA); PG8_STAGE(PG8_SA(0, 1), cA + hstepA, voffA);
    if (wr == 1) PG8_BAR;
    PG8_WAIT_V(2); PG8_BAR;
    PG8_STAGE(PG8_SB(1, 0), cB + kstep, voffB); PG8_STAGE(PG8_SA(1, 0), cA + kstep, voffA); PG8_STAGE(PG8_SB(1, 1), cB + hstepB + kstep, voffB);
    PG8_WAIT_V(6); PG8_BAR;
    for (;;) {
        const bool has_next = S.next(ui + 1, nxt);
        const char* nA = has_next ? (const char*)g.A + (size_t)nxt.pm * tstepA : cA; const char* nB = has_next ? (const char*)g.Bt + (size_t)nxt.pn * tstepB : cB;
#pragma unroll 1
        for (int t = 0; t < nt; t += 2) {
            const bool last = (t == nt - 2);
            const char* a1 = cA + (size_t)(t + 1) * kstep;
            const char* a2 = last ? nA : cA + (size_t)(t + 2) * kstep; const char* b2 = last ? nB : cB + (size_t)(t + 2) * kstep;
            const char* a3 = a2 + kstep; const char* b3 = b2 + kstep;
            if (last && has_next) S.a_ready(nxt);
            PG8_LDB(B0, 0, 0); PG8_LDB(B1, 0, 1); PG8_SCHED; PG8_LDA(At, 0, 0); PG8_STAGE(PG8_SA(1, 1), a1 + hstepA, voffA);
            PG8_WAIT_V(8); PG8_WAIT_L(0); PG8_BAR; PG8_MMA(0, 0, At, B0); PG8_MMA(0, 1, At, B1); PG8_BAR; PG8_SCHED;
            PG8_LDA(At, 0, 1); PG8_STAGE(PG8_SB(0, 0), b2, voffB); PG8_STAGE(PG8_SB(0, 1), b2 + hstepB, voffB); PG8_STAGE(PG8_SA(0, 0), a2, voffA);
            PG8_WAIT_V(8); PG8_WAIT_L(0); PG8_BAR; PG8_MMA(1, 0, At, B0); PG8_MMA(1, 1, At, B1); PG8_BAR; PG8_SCHED;
            PG8_LDB(B0, 1, 0); PG8_LDB(B1, 1, 1); PG8_SCHED; PG8_LDA(At, 1, 0); PG8_STAGE(PG8_SA(0, 1), a2 + hstepA, voffA);
            PG8_WAIT_V(8); PG8_WAIT_L(0); PG8_BAR; PG8_MMA(0, 0, At, B0); PG8_MMA(0, 1, At, B1); PG8_BAR; PG8_SCHED;
            PG8_LDA(At, 1, 1); PG8_STAGE(PG8_SB(1, 0), b3, voffB); PG8_STAGE(PG8_SB(1, 1), b3 + hstepB, voffB); PG8_STAGE(PG8_SA(1, 0), a3, voffA);
            PG8_WAIT_V(8); PG8_WAIT_L(0); PG8_BAR; PG8_MMA(1, 0, At, B0); PG8_MMA(1, 1, At, B1); PG8_BAR; PG8_SCHED;
        }
        if (wr == 0) PG8_BAR;
        E(acc, cur, wr, wc, fr, fq); S.done(cur);
        if (!has_next) break;
{ float zf = 0.f; asm volatile("" : "+v"(zf));
        #pragma unroll
        for (int a = 0; a < 2; ++a)
#pragma unroll
            for (int b = 0; b < 2; ++b)
#pragma unroll
                for (int m = 0; m < 4; ++m)
#pragma unroll
                    for (int n = 0; n < 2; ++n) acc[a][b][m][n] = (f32x4){zf, zf, zf, zf}; }
        cur = nxt; cA = nA; cB = nB; ++ui;
        if (wr == 1) PG8_BAR;
    }
    PG8_WAIT_V(0);
    PG8_BAR;
#undef PG8_SA
#undef PG8_SB
#undef PG8_STAGE
#undef PG8_LDA
#undef PG8_LDB
#undef PG8_MMA
#undef PG8_WAIT_V
#undef PG8_WAIT_L
#undef PG8_BAR
#undef PG8_SCHED
}
}
namespace at {
using bf16 = unsigned short;
using bf16x8 = __attribute__((ext_vector_type(8))) short;
using s16x4  = __attribute__((ext_vector_type(4))) short;
using f32x16 = __attribute__((ext_vector_type(16))) float;
using u32x4  = __attribute__((ext_vector_type(4))) unsigned;
constexpr int DQK = 192, DV = 128, KVBLK = 64, NW = 8, QBLK = 32;
constexpr float SCALE = 0.07216878364870322f;
constexpr float THR = 8.f;
constexpr int LDQ = 1536, LDK = 2560, LDO = 2048;
constexpr int SHM_V = KVBLK * DV * 2, SHM_K = 12 * 2080;
constexpr int QR_OFF = 2 * SHM_V + 2 * SHM_K + NW * 64 * 4;
constexpr int SHM_ATTN = QR_OFF + NW * 4096;
#define SBAR() __builtin_amdgcn_sched_barrier(0)
constexpr int KPL = 2080;
__host__ __device__ __forceinline__ int k_st(int row, int c) { return (c >> 1) * KPL + row * 32 + (((c & 1) ^ ((row >> 3) & 1)) << 4); }
__host__ __device__ __forceinline__ int k_rd_base(int r32, int hi) { return r32 * 32 + ((hi ^ ((r32 >> 3) & 1)) << 4); }
__device__ __forceinline__ int crow(int r, int hi) { return (r & 3) + 8 * (r >> 2) + 4 * hi; }
__device__ __forceinline__ unsigned cvtpk(float lo, float hi) { unsigned r; asm volatile("v_cvt_pk_bf16_f32 %0, %1, %2" : "=v"(r) : "v"(lo), "v"(hi)); return r; }

__device__ __forceinline__ void partialSM(f32x16& p0, f32x16& p1, float& m_reg, float& mn, float& alpha) {
  constexpr float C = SCALE * 1.4426950408889634f;
  float pmax = p0[0];
#pragma unroll
  for (int r = 1; r < 16; ++r) pmax = fmaxf(pmax, p0[r]);
#pragma unroll
  for (int r = 0; r < 16; ++r) pmax = fmaxf(pmax, p1[r]);
  { auto rr = __builtin_amdgcn_permlane32_swap(__float_as_uint(pmax), __float_as_uint(pmax), false, false);
    pmax = fmaxf(__uint_as_float(rr[0]), __uint_as_float(rr[1])); }
  if (__builtin_expect(__all(pmax - m_reg <= THR / SCALE), 1)) { mn = m_reg; alpha = 1.f; }
  else { mn = fmaxf(m_reg, pmax); alpha = __builtin_amdgcn_exp2f((m_reg - mn) * C); m_reg = mn; }
  float mnC = -mn * C;
#pragma unroll
  for (int r = 0; r < 16; ++r) p0[r] = fmaf(p0[r], C, mnC);
#pragma unroll
  for (int r = 0; r < 16; ++r) p1[r] = fmaf(p1[r], C, mnC);
#pragma unroll
  for (int r = 0; r < 16; ++r) p0[r] = __builtin_amdgcn_exp2f(p0[r]);
}
__device__ __forceinline__ void partialSM_fast(f32x16& p0, f32x16& p1, float negMC) {
  constexpr float C = SCALE * 1.4426950408889634f;
#pragma unroll
  for (int r = 0; r < 16; ++r) p0[r] = fmaf(p0[r], C, negMC);
#pragma unroll
  for (int r = 0; r < 16; ++r) p1[r] = fmaf(p1[r], C, negMC);
#pragma unroll
  for (int r = 0; r < 16; ++r) p0[r] = __builtin_amdgcn_exp2f(p0[r]);
}
__device__ __forceinline__ void finishSM(f32x16& p0, f32x16& p1, float alpha, float& l_reg, bf16x8& pa0, bf16x8& pa1, bf16x8& pa2, bf16x8& pa3) {
#pragma unroll
  for (int r = 0; r < 16; ++r) p1[r] = __builtin_amdgcn_exp2f(p1[r]);
  float ps = 0;
#pragma unroll
  for (int r = 0; r < 16; ++r) ps += p0[r];
#pragma unroll
  for (int r = 0; r < 16; ++r) ps += p1[r];
  { auto rr = __builtin_amdgcn_permlane32_swap(__float_as_uint(ps), __float_as_uint(ps), false, false);
    ps = __uint_as_float(rr[0]) + __uint_as_float(rr[1]); }
  l_reg = l_reg * alpha + ps;
#define PK4(P, BASE, OUT) do { unsigned a0 = cvtpk(P[BASE + 0], P[BASE + 1]), a1 = cvtpk(P[BASE + 2], P[BASE + 3]);   \
    unsigned b0 = cvtpk(P[BASE + 4], P[BASE + 5]), b1 = cvtpk(P[BASE + 6], P[BASE + 7]);                              \
    auto r0 = __builtin_amdgcn_permlane32_swap(a0, b0, false, false); auto r1 = __builtin_amdgcn_permlane32_swap(a1, b1, false, false); \
    u32x4 w = {r0[0], r1[0], r0[1], r1[1]}; OUT = *reinterpret_cast<bf16x8*>(&w); } while (0)
  PK4(p0, 0, pa0); PK4(p0, 8, pa1); PK4(p1, 0, pa2); PK4(p1, 8, pa3);
#undef PK4
}
template <int OFF> __device__ __forceinline__ bf16x8 k_read(int kb) {
  bf16x8 r; asm volatile("ds_read_b128 %0, %1 offset:%2" : "=v"(r) : "v"(kb), "i"(OFF) : "memory"); return r;
}
__device__ __forceinline__ void qkt(f32x16& p0, f32x16& p1, int kb, const bf16x8* qr, int qb) {
  p0 = f32x16{}; p1 = f32x16{};
#define QK1(d0) { const bf16x8 b0 = *(const __attribute__((address_space(3))) bf16x8*)(kb + d0 * KPL), b1 = *(const __attribute__((address_space(3))) bf16x8*)(kb + d0 * KPL + 1024); \
    p0 = __builtin_amdgcn_mfma_f32_32x32x16_bf16(b0, qr[d0], p0, 0, 0, 0); p1 = __builtin_amdgcn_mfma_f32_32x32x16_bf16(b1, qr[d0], p1, 0, 0, 0); }
#define QK2(d0) { const bf16x8 b0 = *(const __attribute__((address_space(3))) bf16x8*)(kb + d0 * KPL), b1 = *(const __attribute__((address_space(3))) bf16x8*)(kb + d0 * KPL + 1024); \
    const bf16x8 qf = *(const __attribute__((address_space(3))) bf16x8*)(qb + (d0 - 8) * 1024); \
    p0 = __builtin_amdgcn_mfma_f32_32x32x16_bf16(b0, qf, p0, 0, 0, 0); p1 = __builtin_amdgcn_mfma_f32_32x32x16_bf16(b1, qf, p1, 0, 0, 0); }
  QK1(0) QK1(1) QK1(2) QK1(3) QK1(4) QK1(5) QK1(6) QK1(7) QK2(8) QK2(9) QK2(10) QK2(11)
#undef QK1
#undef QK2
}
__host__ __device__ __forceinline__ int v_st(int k, int c) { const int kk = (k & ~0xC) | ((k & 4) << 1) | ((k & 8) >> 1); return ((kk >> 3) * 4 + (c >> 5)) * 512 + ((kk & 7) * 32 + (c & 31)) * 2; }
__device__ __forceinline__ int v_rd_base(int lane) { return ((lane & 3) << 3) | (((lane >> 2) & 3) << 6) | (((lane >> 4) & 1) << 5) | (((lane >> 5) & 1) << 8); }
constexpr int v_rd_off(int d0, int ks, int half) { return d0 * 512 + ks * 4096 + half * 2048; }
template <int OFF> __device__ __forceinline__ s16x4 tr_read(int vb) {
  s16x4 r; asm volatile("ds_read_b64_tr_b16 %0, %1 offset:%2" : "=&v"(r) : "v"(vb), "i"(OFF) : "memory"); return r;
}
template <int D0> __device__ __forceinline__ void pv_one(f32x16& od, int vb, bf16x8 pa0, bf16x8 pa1, bf16x8 pa2, bf16x8 pa3) {
  const s16x4 l0 = tr_read<v_rd_off(D0, 0, 0)>(vb), h0 = tr_read<v_rd_off(D0, 0, 1)>(vb), l1 = tr_read<v_rd_off(D0, 1, 0)>(vb), h1 = tr_read<v_rd_off(D0, 1, 1)>(vb);
  const s16x4 l2 = tr_read<v_rd_off(D0, 2, 0)>(vb), h2 = tr_read<v_rd_off(D0, 2, 1)>(vb), l3 = tr_read<v_rd_off(D0, 3, 0)>(vb), h3 = tr_read<v_rd_off(D0, 3, 1)>(vb);
  asm volatile("s_waitcnt lgkmcnt(0)" ::: "memory"); SBAR();
#define PK(L, H) (bf16x8){L[0], L[1], L[2], L[3], H[0], H[1], H[2], H[3]}
  od = __builtin_amdgcn_mfma_f32_32x32x16_bf16(pa0, PK(l0, h0), od, 0, 0, 0);
  od = __builtin_amdgcn_mfma_f32_32x32x16_bf16(pa1, PK(l1, h1), od, 0, 0, 0);
  od = __builtin_amdgcn_mfma_f32_32x32x16_bf16(pa2, PK(l2, h2), od, 0, 0, 0);
  od = __builtin_amdgcn_mfma_f32_32x32x16_bf16(pa3, PK(l3, h3), od, 0, 0, 0);
#undef PK
}
__device__ __forceinline__ void pv_d0(f32x16* o, int vb, bf16x8 pa0, bf16x8 pa1, bf16x8 pa2, bf16x8 pa3) {
  pv_one<0>(o[0], vb, pa0, pa1, pa2, pa3); pv_one<1>(o[1], vb, pa0, pa1, pa2, pa3); pv_one<2>(o[2], vb, pa0, pa1, pa2, pa3); pv_one<3>(o[3], vb, pa0, pa1, pa2, pa3);
}

template <bool FAST>
__device__ __forceinline__ void attn_unit(const float negMC, const bf16* __restrict__ Qb, const bf16* __restrict__ Kh, const bf16* __restrict__ Vh, bf16* __restrict__ Ob, int seq, char* lds) {
  const int tid = opq(threadIdx.x), wid = tid >> 6, lane = tid & 63, r32 = lane & 31, hi = lane >> 5;
  char* V_lds = lds; char* K_lds = lds + 2 * SHM_V;
  float* ws = (float*)(lds + 2 * SHM_V + 2 * SHM_K) + wid * 64; float* li_l = ws; float* al_l = ws + 32;
  float m_reg = -1e30f, l_reg = 0; f32x16 o[4] = {}; bf16x8 qr[8];
  const bf16* Qw = Qb + (unsigned)((wid * QBLK + r32) * LDQ + hi * 8);
#pragma unroll
  for (int d0 = 0; d0 < 8; ++d0) qr[d0] = *reinterpret_cast<const bf16x8*>(Qw + d0 * 16);
  const int qb0 = (int)(uintptr_t)lds + QR_OFF + wid * 4096 + k_rd_base(r32, hi);
#pragma unroll
  for (int d0 = 8; d0 < 12; ++d0) *(__attribute__((address_space(3))) bf16x8*)(qb0 + (d0 - 8) * 1024) = *reinterpret_cast<const bf16x8*>(Qw + d0 * 16);
  const int sr = tid >> 4, sc = (tid & 15) * 8, vst0 = v_st(sr, sc), vst1 = v_st(32 + sr, sc);
  unsigned koff[3]; int kst[3];
#pragma unroll
  for (int i = 0; i < 3; ++i) { const int q = tid + 512 * i; koff[i] = (unsigned)((q / 24) * LDK + (q % 24) * 8); kst[i] = k_st(q / 24, q % 24); }
  const unsigned voff0 = (unsigned)(sr * LDK + sc), voff1 = (unsigned)((32 + sr) * LDK + sc);
  const int vb0 = (int)(uintptr_t)V_lds + v_rd_base(lane); const int kb0 = (int)(uintptr_t)K_lds + k_rd_base(r32, hi);
  struct { bf16x8 vs0, vs1, ks0, ks1, ks2; } sr_[1];
#define SLOAD(i, k0) do { const bf16* vt = Vh + (size_t)(k0) * LDK; const bf16* kt = Kh + (size_t)(k0) * LDK; \
    sr_[i].vs0 = *(const bf16x8*)(vt + voff0); sr_[i].vs1 = *(const bf16x8*)(vt + voff1); \
    sr_[i].ks0 = *(const bf16x8*)(kt + koff[0]); sr_[i].ks1 = *(const bf16x8*)(kt + koff[1]); sr_[i].ks2 = *(const bf16x8*)(kt + koff[2]); } while (0)
#define SWRITE(b, i) do { *(bf16x8*)(V_lds + (b) * SHM_V + vst0) = sr_[i].vs0; *(bf16x8*)(V_lds + (b) * SHM_V + vst1) = sr_[i].vs1; \
    *(bf16x8*)(K_lds + (b) * SHM_K + kst[0]) = sr_[i].ks0; *(bf16x8*)(K_lds + (b) * SHM_K + kst[1]) = sr_[i].ks1; *(bf16x8*)(K_lds + (b) * SHM_K + kst[2]) = sr_[i].ks2; } while (0)
#define SWAIT() do { if constexpr (SDEPTH == 2) asm volatile("s_waitcnt vmcnt(5)" ::: "memory"); else asm volatile("s_waitcnt vmcnt(0)" ::: "memory"); } while (0)
#define RESC(a) do { if (__any((a) < 1.f)) { if (hi == 0) al_l[r32] = (a); asm volatile("s_waitcnt lgkmcnt(0)" ::: "memory"); \
    _Pragma("unroll") for (int d = 0; d < 4; ++d) _Pragma("unroll") for (int r = 0; r < 16; ++r) o[d][r] *= al_l[crow(r, hi)]; } } while (0)
  f32x16 pA0, pA1, pB0, pB1; float mnA, mnB, alA, alB; bf16x8 pa0, pa1, pa2, pa3; const int NT = seq / KVBLK;
#define PSM(P0, P1, MN, AL) do { if constexpr (FAST) { partialSM_fast(P0, P1, negMC); AL = 1.f; } else partialSM(P0, P1, m_reg, MN, AL); } while (0)
#define RSC(AL) do { if constexpr (!FAST) RESC(AL); } while (0)
  SLOAD(0, 0); asm volatile("s_waitcnt vmcnt(0)" ::: "memory"); SWRITE(0, 0); __syncthreads();
  qkt(pA0, pA1, kb0, qr, qb0); PSM(pA0, pA1, mnA, alA);
  SLOAD(0, KVBLK);
  asm volatile("s_waitcnt vmcnt(0)" ::: "memory"); SWRITE(1, 0); __syncthreads();
  for (int j = 1; j + 1 < NT; j += 2) {
    SBAR(); qkt(pB0, pB1, kb0 + SHM_K, qr, qb0);
    finishSM(pA0, pA1, alA, l_reg, pa0, pa1, pa2, pa3); SBAR();
    SLOAD(0, (j + 1) * KVBLK); SBAR();
    pv_d0(o, vb0, pa0, pa1, pa2, pa3); PSM(pB0, pB1, mnB, alB);
    __syncthreads(); asm volatile("s_waitcnt vmcnt(0)" ::: "memory"); SWRITE(0, 0);
    RSC(alB); __syncthreads();
    SBAR(); qkt(pA0, pA1, kb0, qr, qb0);
    finishSM(pB0, pB1, alB, l_reg, pa0, pa1, pa2, pa3); SBAR();
    SLOAD(0, (j + 2) * KVBLK); SBAR();
    pv_d0(o, vb0 + (int)SHM_V, pa0, pa1, pa2, pa3); PSM(pA0, pA1, mnA, alA);
    __syncthreads(); asm volatile("s_waitcnt vmcnt(0)" ::: "memory"); SWRITE(1, 0);
    RSC(alA); __syncthreads();
  }
  SBAR(); qkt(pB0, pB1, kb0 + SHM_K, qr, qb0);
  finishSM(pA0, pA1, alA, l_reg, pa0, pa1, pa2, pa3); SBAR();
  pv_d0(o, vb0, pa0, pa1, pa2, pa3); PSM(pB0, pB1, mnB, alB);
  __syncthreads(); RSC(alB);
  finishSM(pB0, pB1, alB, l_reg, pa0, pa1, pa2, pa3); SBAR();
  pv_d0(o, vb0 + (int)SHM_V, pa0, pa1, pa2, pa3);
  if (hi == 0) li_l[r32] = l_reg; asm volatile("s_waitcnt lgkmcnt(0)" ::: "memory");
  bf16* Ow = Ob + (unsigned)(wid * QBLK * LDO + r32);
#pragma unroll
  for (int r = 0; r < 16; ++r) { const int orow = crow(r, hi); const float rl = __builtin_amdgcn_rcpf(li_l[orow]);
#pragma unroll
    for (int d0 = 0; d0 < 4; ++d0) { const unsigned w = cvtpk(o[d0][r] * rl, 0.f); Ow[(unsigned)(orow * LDO + d0 * 32)] = (bf16)(w & 0xffffu); } }
  __syncthreads();
#undef SLOAD
#undef SWRITE
#undef SWAIT
#undef RESC
#undef PSM
#undef RSC
}
}
namespace hy {
#define HY_LAS __attribute__((address_space(3)))
typedef unsigned short bf16;
typedef short bf16x8 __attribute__((ext_vector_type(8)));
typedef float f32x16 __attribute__((ext_vector_type(16)));
typedef unsigned u32x2 __attribute__((ext_vector_type(2)));
typedef unsigned u32x4 __attribute__((ext_vector_type(4)));
constexpr int L = 2048, NB = 24, CH = 512;
constexpr int RFS = 4112;
constexpr int ZROW = 4112;
constexpr int ZL_BYTES = NB * ZROW;
constexpr int RCS = 8256;
constexpr int RC_OFF = ZL_BYTES;
constexpr int HY_LDS_BYTES = RC_OFF + 4 * RCS;
__device__ __forceinline__ unsigned cvtpk(float lo, float hi) { unsigned r; asm volatile("v_cvt_pk_bf16_f32 %0, %1, %2" : "=v"(r) : "v"(lo), "v"(hi)); return r; }
__host__ __device__ __forceinline__ int frag_base(int tw, int r, int h) { const int a = (4 - (r & 3)) & 3; return RC_OFF + a * RCS + 2 * (2048 - tw - r + 8 * h - a); }
__host__ __device__ __forceinline__ int zfrag_base(int r, int h) { return (r < NB ? r : NB - 1) * ZROW + 16 * h; }

__device__ __forceinline__ bf16x8 ld_frag(HY_LAS unsigned char* lds, int off) {
    const u32x2 lo = *(const HY_LAS u32x2*)(lds + off), hi = *(const HY_LAS u32x2*)(lds + off + 8);
    u32x4 w = {lo.x, lo.y, hi.x, hi.y}; return *reinterpret_cast<bf16x8*>(&w);
}
__device__ __forceinline__ bf16x8 ld_b128(HY_LAS unsigned char* lds, int off) { return *(const HY_LAS bf16x8*)(lds + off); }

__device__ __forceinline__ void conv_unit(HY_LAS unsigned char* lds, const bf16* __restrict__ ZT, const bf16* __restrict__ RF, bf16* __restrict__ YC, int c, int half) {
    const int tid = opq(threadIdx.x), wid = tid >> 6, lane = tid & 63, r = lane & 31, h = lane >> 5;
    { const u32x4* src = (const u32x4*)(ZT + (size_t)c * NB * L);
#pragma unroll
      for (int i = 0; i < 12; ++i) { const int q = tid + 512 * i; const u32x4 v = src[q]; *(HY_LAS u32x4*)(lds + (q >> 8) * ZROW + (q & 255) * 16) = v; } }
    { const bf16* rf = RF + (size_t)c * RFS;
      for (int ch = tid; ch < RFS / 8; ch += 512) {
          const u32x4 v = *(const u32x4*)(rf + ch * 8); const unsigned w[4] = {v.x, v.y, v.z, v.w};
#pragma unroll
          for (int j = 0; j < 8; ++j) { const unsigned short e = (unsigned short)((w[j >> 1] >> ((j & 1) * 16)) & 0xffffu); const int idx = ch * 8 + j;
#pragma unroll
              for (int a = 0; a < 4; ++a) if (idx - a >= 0) *(HY_LAS unsigned short*)(lds + RC_OFF + a * RCS + 2 * (idx - a)) = e; } } }
    __syncthreads();
    const int tw = half * 1024 + wid * 128;
    const int fb = frag_base(tw, r, h), zb = zfrag_base(r, h);
    f32x16 acc[4] = {};
    bf16x8 S0[2], S1[2], S2[2], S3[2], Bc[2], Bn[2];
#define HY_LDG(S, d) do { S[0] = ld_frag(lds, fb + 64 * (d)); S[1] = ld_frag(lds, fb + 64 * (d) + 32); } while (0)
#define HY_LDB(Bx, n) do { Bx[0] = ld_b128(lds, zb + 64 * (n)); Bx[1] = ld_b128(lds, zb + 64 * (n) + 32); } while (0)
#define HY_MM(i, S, Bx) do { acc[i] = __builtin_amdgcn_mfma_f32_32x32x16_bf16(S[0], Bx[0], acc[i], 0, 0, 0); acc[i] = __builtin_amdgcn_mfma_f32_32x32x16_bf16(S[1], Bx[1], acc[i], 0, 0, 0); } while (0)
#define HY_ITER(n, Sa, Sb, Sc, Sd, Bcur, Bnext) do { HY_LDG(Sa, (n)); if ((n) + 1 < 64) HY_LDB(Bnext, (n) + 1); \
        HY_MM(1, Sb, Bcur); HY_MM(2, Sc, Bcur); HY_MM(3, Sd, Bcur); HY_MM(0, Sa, Bcur); } while (0)
    HY_LDG(S3, -1); HY_LDG(S2, -2); HY_LDG(S1, -3); HY_LDB(Bc, 0);
    for (int n = 0; n < 64; n += 4) {
        HY_ITER(n, S0, S3, S2, S1, Bc, Bn);
        HY_ITER(n + 1, S1, S0, S3, S2, Bn, Bc);
        HY_ITER(n + 2, S2, S1, S0, S3, Bc, Bn);
        HY_ITER(n + 3, S3, S2, S1, S0, Bn, Bc);
    }
#undef HY_LDG
#undef HY_LDB
#undef HY_MM
#undef HY_ITER
    if (r < NB) { bf16* yp = YC + ((size_t)c * NB + r) * L + tw + 4 * h;
#pragma unroll
        for (int i = 0; i < 4; ++i)
#pragma unroll
            for (int q4 = 0; q4 < 4; ++q4) { u32x2 w; w.x = cvtpk(acc[i][4 * q4 + 0], acc[i][4 * q4 + 1]); w.y = cvtpk(acc[i][4 * q4 + 2], acc[i][4 * q4 + 3]);
                *(u32x2*)(yp + 32 * i + 8 * q4) = w; } }
    __syncthreads();
}
}
constexpr int NWAVES = 8;
#ifndef MK_ONE_LAUNCH
#define MK_ONE_LAUNCH 1
#endif
constexpr int DM = 2048, NSEQ = 24, SEQ = 2048, M = NSEQ * SEQ, MP = 8 * SEQ;
constexpr int DEPTH = 4;
constexpr int DIN = 2880, DINP = 3072;
constexpr int O_CQ = 512, O_CKV = 1024, O_KPE = 1280, O_HY = 1344;
constexpr int NH = 8, NQ = 1536, NKVP = 2560, KVHS = 320;
constexpr int DFF = 5632, NUP = 11264, HYC = 512;
constexpr float EPS = 1e-6f;
constexpr int NPH = 11;
constexpr size_t WS_CTL = 0, CTL_BYTES = 1u << 20;
constexpr size_t SZ_BTIN = (size_t)DINP * DM * 2, SZ_BTUQ = (size_t)NQ * 512 * 2, SZ_BTKV = (size_t)NKVP * 256 * 2, SZ_BTOUT = (size_t)DM * DM * 2, SZ_BTUP = (size_t)NUP * DM * 2, SZ_BTDN = (size_t)DM * DFF * 2;
constexpr size_t WS_BTIN = WS_CTL + CTL_BYTES, WS_BTUQ = WS_BTIN + SZ_BTIN, WS_BTKV = WS_BTUQ + SZ_BTUQ, WS_BTOUT = WS_BTKV + SZ_BTKV, WS_BTUP = WS_BTOUT + SZ_BTOUT, WS_BTDN = WS_BTUP + SZ_BTUP;
constexpr size_t WS_RF = WS_BTDN + SZ_BTDN, SZ_RF = (size_t)HYC * hy::RFS * 2;
constexpr size_t WS_H = WS_RF + SZ_RF, SZ_H = (size_t)M * DM * 2;
constexpr size_t WS_PROJ = WS_H + SZ_H, SZ_PROJ = (size_t)M * DINP * 2;
constexpr size_t WS_Q = WS_PROJ + SZ_PROJ, SZ_Q = (size_t)M * NQ * 2;
constexpr size_t WS_KV = WS_Q + SZ_Q, SZ_KV = (size_t)M * NKVP * 2;
constexpr size_t WS_ZT = WS_KV + SZ_KV, SZ_ZT = (size_t)HYC * NSEQ * SEQ * 2;
constexpr size_t WS_X0 = WS_ZT + SZ_ZT, WS_YC = WS_X0 + SZ_ZT;
constexpr size_t WS_EDGE = WS_YC + SZ_ZT, SZ_EDGE = (size_t)(M / 256) * 2 * 3 * DFF * 4;
constexpr size_t WS_ROPE = WS_EDGE + SZ_EDGE, SZ_ROPE = (size_t)SEQ * 64 * 4;
constexpr size_t WS_SSQP = WS_ROPE + SZ_ROPE, SZ_SSQP = (size_t)M * 32 * 4;
constexpr size_t WS_RSTD = WS_SSQP + SZ_SSQP, SZ_RSTD = (size_t)M * 4;
constexpr size_t WS_END = WS_RSTD + SZ_RSTD;
constexpr size_t WS_ACT = WS_PROJ;
static_assert((size_t)M * DFF * 2 <= SZ_PROJ + SZ_Q + SZ_KV, "ACT overlay");
constexpr size_t WS_XB2 = WS_ACT + (size_t)M * DFF * 2;
static_assert(WS_XB2 + (size_t)M * DM * 2 <= WS_EDGE && WS_XB2 % 256 == 0, "XB2 overlay");
static_assert(WS_BTIN % 256 == 0 && WS_RF % 256 == 0 && WS_H % 256 == 0 && WS_PROJ % 256 == 0 && WS_Q % 256 == 0 && WS_KV % 256 == 0 && WS_ZT % 256 == 0 && WS_EDGE % 256 == 0, "alignment");
constexpr int CW_BAR = 4096;
constexpr int RING_BYTES = 135168;
constexpr int HALO_OFF = RING_BYTES, HALO_BYTES = 4096;
constexpr int MISC_OFF = HALO_OFF + HALO_BYTES;
constexpr int LDS_BYTES = 147456;
static_assert(hy::HY_LDS_BYTES <= RING_BYTES && at::SHM_ATTN <= RING_BYTES && MISC_OFF + 256 <= LDS_BYTES, "LDS map");

#define GAS __attribute__((address_space(1)))
#define LAS __attribute__((address_space(3)))
typedef unsigned short bf16;
typedef unsigned v4u __attribute__((ext_vector_type(4)));
typedef unsigned v2u __attribute__((ext_vector_type(2)));
typedef float f32x4 __attribute__((ext_vector_type(4)));
#define LDS_WAIT() asm volatile("s_waitcnt lgkmcnt(0)" ::: "memory")
__device__ __forceinline__ unsigned f2bf(float f) { unsigned u = __builtin_bit_cast(unsigned, f); return (u + 0x7fffu + ((u >> 16) & 1u)) >> 16; }
__device__ __forceinline__ unsigned pk2(float lo, float hi) { return f2bf(lo) | (f2bf(hi) << 16); }
__device__ __forceinline__ float bf2f(unsigned short b) { return __builtin_bit_cast(float, (unsigned)b << 16); }
__device__ __forceinline__ float bflo(unsigned w) { return __builtin_bit_cast(float, w << 16); }
__device__ __forceinline__ float bfhi(unsigned w) { return __builtin_bit_cast(float, w & 0xffff0000u); }
__device__ __forceinline__ float wave_sum(float v) {
#pragma unroll
    for (int o = 1; o < 64; o <<= 1) v += __shfl_xor(v, o);
    return v;
}

#define XB_TMO      128
#define XB_XCNT(j)  (256  + 64 * (j))
#define XB_XSUB(j)  (1280 + 64 * (j))
#define XB_XGEN(j)  (2304 + 64 * (j))
#define XB_TOP      3328
#define XB_TOPGEN   3392
#define XCD_BAR_WORDS 3456
#define XB_SPIN_CAP (1u << 18)
__device__ __forceinline__ unsigned xb_ld(unsigned* p)              { return __hip_atomic_load(p, __ATOMIC_RELAXED, __HIP_MEMORY_SCOPE_AGENT); }
__device__ __forceinline__ unsigned xb_add(unsigned* p, unsigned v) { return __hip_atomic_fetch_add(p, v, __ATOMIC_RELAXED, __HIP_MEMORY_SCOPE_AGENT); }
__device__ __forceinline__ unsigned xb_xcc_id() { return (unsigned)__builtin_amdgcn_s_getreg((3 << 11) | 20) & 0xFu; }
#define XB_SPIN(cond, bar) do { unsigned _sp = 0; while (cond) { __builtin_amdgcn_s_sleep(1); \
    if ((++_sp & 255u) == 0u) { if (xb_ld(&(bar)[XB_TMO])) break; if (_sp > XB_SPIN_CAP) { atomicAdd(&(bar)[XB_TMO], 1u); break; } } } } while (0)
struct XcdBarrier { unsigned* bar; unsigned x; volatile LAS unsigned* st; };
__device__ __forceinline__ XcdBarrier xcd_barrier_post(unsigned* bar, volatile LAS unsigned* st) {
    XcdBarrier b; b.bar = bar; b.x = xb_xcc_id(); b.st = st;
    if (threadIdx.x == 0) (void)xb_add(&bar[XB_XCNT(b.x)], 1u);
    return b;
}
__device__ __forceinline__ void xcd_barrier_complete(unsigned* bar, unsigned x, unsigned& nloc, unsigned& nx) {
    const unsigned G = gridDim.x * gridDim.y * gridDim.z;
    unsigned sum, cnt, mine, sp = 0u;
    for (;;) {
        sum = 0u; cnt = 0u; mine = 0u;
#pragma unroll
        for (unsigned j = 0; j < 16; ++j) { const unsigned c = xb_ld(&bar[XB_XCNT(j)]); sum += c; cnt += (c > 0u) ? 1u : 0u; mine = (j == x) ? c : mine; }
        if (sum == G) break;
        __builtin_amdgcn_s_sleep(1);
        if ((++sp & 255u) == 0u) { if (xb_ld(&bar[XB_TMO])) break; if (sp > XB_SPIN_CAP) { atomicAdd(&bar[XB_TMO], 1u); break; } }
    }
    nloc = mine > 0u ? mine : 1u; nx = cnt > 0u ? cnt : 1u;
}
__device__ __forceinline__ void xcd_barrier(const XcdBarrier& b) {
    asm volatile("s_waitcnt vmcnt(0)" ::: "memory");
    __syncthreads();
    if (threadIdx.x == 0) {
        unsigned* bar = b.bar;
        __builtin_amdgcn_s_waitcnt(0);
        unsigned nloc = b.st[0], nx = b.st[1];
        if (nloc == 0u) { xcd_barrier_complete(bar, b.x, nloc, nx); b.st[0] = nloc; b.st[1] = nx; }
        const unsigned old = xb_add(&bar[XB_XSUB(b.x)], 1u);
        const unsigned gen = old / nloc;
        if (old + 1u == (gen + 1u) * nloc) {
            __builtin_amdgcn_fence(__ATOMIC_RELEASE, "agent");
            asm volatile("s_waitcnt vmcnt(0)" ::: "memory");
            const unsigned og = xb_add(&bar[XB_TOP], 1u);
            const unsigned tg = og / nx;
            if (og + 1u == (tg + 1u) * nx) xb_add(&bar[XB_TOPGEN], 1u);
            else XB_SPIN(xb_ld(&bar[XB_TOPGEN]) == tg, bar);
            __builtin_amdgcn_fence(__ATOMIC_ACQUIRE, "agent");
            xb_add(&bar[XB_XGEN(b.x)], 1u);
            asm volatile("s_waitcnt vmcnt(0)" ::: "memory");
        } else {
            XB_SPIN(xb_ld(&bar[XB_XGEN(b.x)]) == gen, bar);
            __builtin_amdgcn_fence(__ATOMIC_ACQUIRE, "agent");
            asm volatile("s_waitcnt vmcnt(0)" ::: "memory");
        }
    }
    __syncthreads();
}

struct Frame {
    LAS unsigned char* lds;
    int tid, lane, wave, vcu, G;
};
enum { I_XP = 0, I_XS, I_ANG, I_WIN, I_PW, I_PS, I_QNG, I_WUQ, I_KVNG, I_WUKV, I_QHG, I_KHG, I_HCW, I_HCB, I_FW1, I_FB1, I_FFR, I_FW2, I_FB2, I_FW3, I_FB3, I_HBIAS, I_GNG, I_WOUT, I_FNG, I_WUP, I_FCW, I_FCB, I_WDN, N_IN };
struct Args { const float* in[N_IN]; float* out; unsigned char* ws; int ph_lo, ph_hi; };
static_assert(sizeof(Args) == (N_IN + 2) * 8 + 8, "Args has no padding");

__device__ __forceinline__ void cvt_item(const float* __restrict__ W, int ldw, int K, bf16* WT, int dst_n0, int src_n0, int k0, const float* __restrict__ ks, LAS float* scr, int lane) {
#pragma unroll
    for (int i = 0; i < 32; ++i) { const int kk = 2 * i + (lane >> 5); float v = W[(size_t)(k0 + kk) * ldw + src_n0 + (lane & 31)]; if (ks) v *= ks[k0 + kk]; scr[kk * 33 + (lane & 31)] = v; }
    LDS_WAIT(); asm volatile("" ::: "memory");
    const int c = lane & 7;
#pragma unroll
    for (int j = 0; j < 4; ++j) { const int n = (lane >> 3) + 8 * j; const LAS float* s = scr + (8 * c) * 33 + n;
        v4u o; o.x = pk2(s[0 * 33], s[1 * 33]); o.y = pk2(s[2 * 33], s[3 * 33]); o.z = pk2(s[4 * 33], s[5 * 33]); o.w = pk2(s[6 * 33], s[7 * 33]);
        *(v4u*)(WT + (size_t)(dst_n0 + n) * K + k0 + 8 * c) = o; }
    LDS_WAIT(); asm volatile("" ::: "memory");
}
struct CvtTile { const float* W; const float* ks; bf16* WT; int ldw, K, src_n0, k0, ncols; int dst[4]; };
__device__ __forceinline__ void cvt_tile(Frame& F, const CvtTile& d) {
    LAS float* T = (LAS float*)F.lds;
#pragma unroll
    for (int i = 0; i < 8; ++i) { const int q = F.tid + 512 * i, row = q >> 5, c4 = q & 31;
        f32x4 v = {0.f, 0.f, 0.f, 0.f};
        if (d.src_n0 + 4 * c4 < d.ncols) v = *(const f32x4*)(d.W + (size_t)(d.k0 + row) * d.ldw + d.src_n0 + 4 * c4);
        if (d.ks) v *= d.ks[d.k0 + row];
        LAS float* t = T + row * 129 + 4 * c4; t[0] = v.x; t[1] = v.y; t[2] = v.z; t[3] = v.w; }
    __syncthreads();
#pragma unroll
    for (int i = 0; i < 4; ++i) { const int n = (F.tid >> 4) + 32 * i, kc = F.tid & 15;
        if (d.src_n0 + n < d.ncols) { const LAS float* s = T + (8 * kc) * 129 + n;
            v4u o; o.x = pk2(s[0], s[129]); o.y = pk2(s[2 * 129], s[3 * 129]); o.z = pk2(s[4 * 129], s[5 * 129]); o.w = pk2(s[6 * 129], s[7 * 129]);
            *(v4u*)(d.WT + (size_t)(d.dst[i] + (n & 31)) * d.K + d.k0 + 8 * kc) = o; } }
    __syncthreads();
}
__device__ __forceinline__ void xb_row(const float* xrow, bf16* orow, float* rstd, int lane) {
    const f32x4* xr = (const f32x4*)xrow + lane;
    f32x4 v[8]; float s = 0.f;
#pragma unroll
    for (int j = 0; j < 8; ++j) { v[j] = xr[64 * j]; s += (v[j].x * v[j].x + v[j].y * v[j].y) + (v[j].z * v[j].z + v[j].w * v[j].w); }
    const float r = 1.0f / sqrtf(wave_sum(s) * (1.f / DM) + EPS);
    if (lane == 0) *rstd = r;
    v2u* o8 = (v2u*)orow + lane;
#pragma unroll
    for (int j = 0; j < 8; ++j) { v2u w; w.x = pk2(v[j].x, v[j].y); w.y = pk2(v[j].z, v[j].w); o8[64 * j] = w; }
}
__device__ __forceinline__ void rstd_from_partials(const float* __restrict__ ssqp, float* rstd, size_t gtid, size_t gthreads) {
    for (size_t r = gtid; r < (size_t)M; r += gthreads) { const f32x4* p = (const f32x4*)(ssqp + r * 32); f32x4 a = p[0];
#pragma unroll
        for (int i = 1; i < 8; ++i) a += p[i];
        rstd[r] = 1.0f / sqrtf(((a.x + a.y) + (a.z + a.w)) * (1.f / DM) + EPS); }
}
__device__ __forceinline__ void tile_norm_store(LAS float* tile, bf16* dst, int row0, int col_off, int wave, int lane) {
#pragma unroll
    for (int i = 0; i < 8; ++i) { const int t = wave * 8 + i;
        const f32x4 a = *(LAS f32x4*)(tile + t * 512 + 8 * lane), b = *(LAS f32x4*)(tile + t * 512 + 8 * lane + 4);
        const float s = (a.x * a.x + a.y * a.y) + (a.z * a.z + a.w * a.w) + (b.x * b.x + b.y * b.y) + (b.z * b.z + b.w * b.w);
        const float rstd = 1.0f / sqrtf(wave_sum(s) * (1.f / 512.f) + EPS);
        v4u o; o.x = pk2(a.x * rstd, a.y * rstd); o.y = pk2(a.z * rstd, a.w * rstd); o.z = pk2(b.x * rstd, b.y * rstd); o.w = pk2(b.z * rstd, b.w * rstd);
        *(v4u*)(dst + (size_t)(row0 + t) * DM + col_off + 8 * lane) = o; }
}
__device__ __forceinline__ void poolfold_item(Frame& F, const float* __restrict__ win, const float* __restrict__ pw, const float* __restrict__ ps, const float* __restrict__ g1, bf16* BtIn, int g, int kb) {
    LAS float* At = (LAS float*)F.lds; LAS float* Bt = (LAS float*)(F.lds + 32768);
    const int k0 = 64 * kb;
#pragma unroll
    for (int i = 0; i < 4; ++i) { const int q = F.tid + 512 * i, row = q >> 5, c4 = q & 31; *(LAS f32x4*)(At + row * 128 + 4 * c4) = *(const f32x4*)(win + (size_t)(k0 + row) * DIN + 128 * g + 4 * c4) * g1[k0 + row]; }
#pragma unroll
    for (int i = 0; i < 8; ++i) { const int q = F.tid + 512 * i, row = q >> 5, c4 = q & 31; *(LAS f32x4*)(Bt + row * 128 + 4 * c4) = *(const f32x4*)(pw + (size_t)(g * 128 + row) * 128 + 4 * c4); }
    __syncthreads();
    const int n = F.tid & 127, kg = F.tid >> 7;
    float acc[16];
#pragma unroll
    for (int i = 0; i < 16; ++i) acc[i] = 0.f;
    for (int j = 0; j < 128; j += 4) {
        const float b0 = Bt[(j + 0) * 128 + n], b1 = Bt[(j + 1) * 128 + n], b2 = Bt[(j + 2) * 128 + n], b3 = Bt[(j + 3) * 128 + n];
#pragma unroll
        for (int i = 0; i < 16; ++i) { const f32x4 a = *(LAS f32x4*)(At + (kg * 16 + i) * 128 + j); acc[i] += a.x * b0 + a.y * b1 + a.z * b2 + a.w * b3; }
    }
    const float sc = ps[128 * g + n];
    v4u o0, o1;
    o0.x = pk2(acc[0] * sc, acc[1] * sc); o0.y = pk2(acc[2] * sc, acc[3] * sc); o0.z = pk2(acc[4] * sc, acc[5] * sc); o0.w = pk2(acc[6] * sc, acc[7] * sc);
    o1.x = pk2(acc[8] * sc, acc[9] * sc); o1.y = pk2(acc[10] * sc, acc[11] * sc); o1.z = pk2(acc[12] * sc, acc[13] * sc); o1.w = pk2(acc[14] * sc, acc[15] * sc);
    bf16* dst = BtIn + (size_t)(128 * g + n) * DM + k0 + kg * 16;
    *(v4u*)dst = o0; *(v4u*)(dst + 8) = o1;
    __syncthreads();
}
__device__ __forceinline__ void filter_item(Frame& F, const float* __restrict__ w1, const float* __restrict__ b1, const float* __restrict__ fr, const float* __restrict__ w2, const float* __restrict__ b2,
                                            const float* __restrict__ w3, const float* __restrict__ b3, const float* __restrict__ hbias, bf16* RF, int fi) {
    LAS float* ZF = (LAS float*)F.lds; LAS float* H1 = ZF + 512; LAS float* H2 = ZF + 1536; LAS float* W1s = ZF + 2560; LAS float* W2s = ZF + 3712;
    const int t0 = 16 * fi;
    for (int q = F.tid; q < 272; q += 512) *(LAS f32x4*)(W1s + 4 * q) = *(const f32x4*)(w1 + 4 * q);
#pragma unroll
    for (int i = 0; i < 2; ++i) { const int q = F.tid + 512 * i; *(LAS f32x4*)(W2s + 4 * q) = *(const f32x4*)(w2 + 4 * q); }
    if (F.tid < 272) { const int tt = F.tid / 17, f = F.tid % 17; const float t = (float)(t0 + tt);
        float v;
        if (f == 0) v = t / 2047.0f;
        else { const int j = (f - 1) & 7; const float band = 1e-4f + (float)j * ((7.0f - 1e-4f) / 7.0f); const float w = (6.283185307179586f * t) / 2048.0f; const float a = band * w; v = (f <= 8) ? __cosf(a) : -__sinf(a); }
        ZF[tt * 17 + f] = v; }
    __syncthreads();
#pragma unroll
    for (int rep = 0; rep < 2; ++rep) { const int p = F.tid + 512 * rep, tt = p >> 6, j = p & 63; float s = b1[j];
#pragma unroll
        for (int i = 0; i < 17; ++i) s += ZF[tt * 17 + i] * W1s[i * 64 + j];
        H1[tt * 64 + j] = __sinf(fr[j] * s); }
    __syncthreads();
#pragma unroll
    for (int rep = 0; rep < 2; ++rep) { const int p = F.tid + 512 * rep, tt = p >> 6, j = p & 63; float s = b2[j];
#pragma unroll 16
        for (int i = 0; i < 64; ++i) s += H1[tt * 64 + i] * W2s[i * 64 + j];
        H2[tt * 64 + j] = __sinf(fr[j] * s); }
    __syncthreads();
    const int c = F.tid;
    const float delta = -3.0701134573253944f + (float)c * ((-15.350567286626972f + 3.0701134573253944f) / 511.0f);
    const float ad = fabsf(delta);
    bf16* rf = RF + (size_t)c * hy::RFS;
#pragma unroll 1
    for (int dir = 0; dir < 2; ++dir) { const int o = dir * 512 + c; const float bo = b3[o];
        float wc[64];
#pragma unroll
        for (int i = 0; i < 64; ++i) wc[i] = w3[i * 1024 + o];
#pragma unroll 1
        for (int tt = 0; tt < 16; ++tt) { float s = bo;
#pragma unroll
            for (int i = 0; i < 64; i += 4) { const f32x4 hv = *(LAS f32x4*)(H2 + tt * 64 + i); s += (hv.x * wc[i] + hv.y * wc[i + 1]) + (hv.z * wc[i + 2] + hv.w * wc[i + 3]); }
            const int t = t0 + tt; const float tl = (float)t / 2047.0f; float val = s * __expf(-tl * ad);
            if (dir == 0) { if (t == 0) val += hbias[c]; rf[2048 - t] = (bf16)f2bf(val); }
            else if (t >= 1) rf[2048 + t] = (bf16)f2bf(val); } }
    if (fi == 0) { rf[0] = 0;
#pragma unroll
        for (int i = 4096; i < hy::RFS; ++i) rf[i] = 0; }
    __syncthreads();
}
__device__ __forceinline__ void unpack4(const v2u w, float (&x)[4]) { x[0] = bflo(w.x); x[1] = bfhi(w.x); x[2] = bflo(w.y); x[3] = bfhi(w.y); }
__device__ __forceinline__ void pair_norm_store(Frame& F, const float (&y)[8][4], bf16* dst, size_t row0, int col_off, int cq) {
    LAS float* part = (LAS float*)F.lds;
    float ss[8];
#pragma unroll
    for (int k = 0; k < 8; ++k) ss[k] = wave_sum((y[k][0] * y[k][0] + y[k][1] * y[k][1]) + (y[k][2] * y[k][2] + y[k][3] * y[k][3]));
    if (F.lane == 0) { *(LAS f32x4*)(part + F.wave * 8) = (f32x4){ss[0], ss[1], ss[2], ss[3]}; *(LAS f32x4*)(part + F.wave * 8 + 4) = (f32x4){ss[4], ss[5], ss[6], ss[7]}; }
    __syncthreads();
    const f32x4 pa = *(LAS f32x4*)(part + (F.wave ^ 1) * 8), pb = *(LAS f32x4*)(part + (F.wave ^ 1) * 8 + 4);
    const float po[8] = {pa.x, pa.y, pa.z, pa.w, pb.x, pb.y, pb.z, pb.w};
#pragma unroll
    for (int k = 0; k < 8; ++k) { const float rstd = 1.0f / sqrtf((ss[k] + po[k]) * (1.f / 512.f) + EPS);
        v2u o; o.x = pk2(y[k][0] * rstd, y[k][1] * rstd); o.y = pk2(y[k][2] * rstd, y[k][3] * rstd);
        *(v2u*)(dst + (row0 + k) * DM + col_off + 4 * cq) = o; }
    __syncthreads();
}
__device__ __forceinline__ void hyprep_item(Frame& F, const bf16* __restrict__ PROJ, const float* __restrict__ cw, const float* __restrict__ cb, bf16* ZT, bf16* X0, int b, int tile) {
    const int tb = F.tid >> 7, cq = F.tid & 127, c0 = 4 * cq, tw = tile * 32 + tb * 8; const size_t rb = (size_t)b * SEQ;
    float z[8][4];
#pragma unroll
    for (int jj = 0; jj < 3; ++jj) { const int j = (jj == 0) ? 1 : (jj == 1) ? 2 : 0; const int cc = 512 * j + c0;
        const f32x4 w0 = *(const f32x4*)(cw + cc), w1 = *(const f32x4*)(cw + 1536 + cc), w2 = *(const f32x4*)(cw + 3072 + cc), bs = *(const f32x4*)(cb + cc);
        float x[10][4];
#pragma unroll
        for (int o = 0; o < 10; ++o) { const int t = tw - 1 + o; const bool ok = (t >= 0) && (t < SEQ); const int tc = ok ? t : tw;
            const v2u w = *(const v2u*)(PROJ + (rb + tc) * DINP + O_HY + cc); unpack4(w, x[o]);
            if (!ok) { x[o][0] = 0.f; x[o][1] = 0.f; x[o][2] = 0.f; x[o][3] = 0.f; } }
        if (jj == 0) {
#pragma unroll
            for (int k = 0; k < 8; ++k)
#pragma unroll
                for (int i = 0; i < 4; ++i) z[k][i] = w0[i] * x[k][i] + w1[i] * x[k + 1][i] + w2[i] * x[k + 2][i] + bs[i];
        } else if (jj == 1) {
#pragma unroll
            for (int k = 0; k < 8; ++k)
#pragma unroll
                for (int i = 0; i < 4; ++i) z[k][i] *= w0[i] * x[k][i] + w1[i] * x[k + 1][i] + w2[i] * x[k + 2][i] + bs[i];
#pragma unroll
            for (int i = 0; i < 4; ++i) { v4u o; o.x = pk2(z[0][i], z[1][i]); o.y = pk2(z[2][i], z[3][i]); o.z = pk2(z[4][i], z[5][i]); o.w = pk2(z[6][i], z[7][i]);
                *(v4u*)(ZT + ((size_t)(c0 + i) * NSEQ + b) * SEQ + tw) = o; }
        } else {
#pragma unroll
            for (int k = 0; k < 8; ++k) { float u0[4];
#pragma unroll
                for (int i = 0; i < 4; ++i) u0[i] = w0[i] * x[k][i] + w1[i] * x[k + 1][i] + w2[i] * x[k + 2][i] + bs[i];
                v2u o; o.x = pk2(u0[0], u0[1]); o.y = pk2(u0[2], u0[3]); *(v2u*)(X0 + (rb + tw + k) * HYC + c0) = o; }
        }
    }
}
__device__ __forceinline__ void pool_item(Frame& F, const bf16* __restrict__ PROJ, bf16* MIXED, int b, int tile) {
    const int tb = F.tid >> 7, cq = F.tid & 127, c0 = 4 * cq, g = cq >> 5, half = 1 << g, tw = tile * 32 + tb * 8; const size_t rb = (size_t)b * SEQ;
    float x[23][4];
#pragma unroll
    for (int o = 0; o < 23; ++o) { const int t = tw - 8 + o; const bool ok = (t >= 0) && (t < SEQ); const int tc = ok ? t : tw;
        const v2u w = *(const v2u*)(PROJ + (rb + tc) * DINP + c0); unpack4(w, x[o]);
        if (!ok) { x[o][0] = 0.f; x[o][1] = 0.f; x[o][2] = 0.f; x[o][3] = 0.f; } }
    float y[8][4];
#pragma unroll
    for (int k = 0; k < 8; ++k) { const int oc = 8 + k, t = tw + k; const int lo = (t - half > 0) ? t - half : 0, hi = (t + half < SEQ) ? t + half : SEQ; const float inv = 1.0f / (float)(hi - lo);
#pragma unroll
        for (int i = 0; i < 4; ++i) {
            const float w1 = x[oc - 1][i] + x[oc][i];
            const float w2 = w1 + (x[oc - 2][i] + x[oc + 1][i]);
            const float w4 = w2 + ((x[oc - 4][i] + x[oc - 3][i]) + (x[oc + 2][i] + x[oc + 3][i]));
            const float w8 = w4 + (((x[oc - 8][i] + x[oc - 7][i]) + (x[oc - 6][i] + x[oc - 5][i])) + ((x[oc + 4][i] + x[oc + 5][i]) + (x[oc + 6][i] + x[oc + 7][i])));
            const float S = (g == 0) ? w1 : (g == 1) ? w2 : (g == 2) ? w4 : w8;
            y[k][i] = S * inv - x[oc][i]; } }
    pair_norm_store(F, y, MIXED, rb + tw, 0, cq);
}
__device__ __forceinline__ void hyfin_item(Frame& F, const bf16* __restrict__ YC, const bf16* __restrict__ X0, bf16* MIXED, int b, int tile) {
    const int tb = F.tid >> 7, cq = F.tid & 127, c0 = 4 * cq, tw = tile * 32 + tb * 8; const size_t rb = (size_t)b * SEQ;
    float yc[4][8], y[8][4];
#pragma unroll
    for (int i = 0; i < 4; ++i) { const v4u v = *(const v4u*)(YC + ((size_t)(c0 + i) * NSEQ + b) * SEQ + tw);
        yc[i][0] = bflo(v.x); yc[i][1] = bfhi(v.x); yc[i][2] = bflo(v.y); yc[i][3] = bfhi(v.y); yc[i][4] = bflo(v.z); yc[i][5] = bfhi(v.z); yc[i][6] = bflo(v.w); yc[i][7] = bfhi(v.w); }
#pragma unroll
    for (int k = 0; k < 8; ++k) { float xv[4]; unpack4(*(const v2u*)(X0 + (rb + tw + k) * HYC + c0), xv);
#pragma unroll
        for (int i = 0; i < 4; ++i) y[k][i] = yc[i][k] * xv[i]; }
    pair_norm_store(F, y, MIXED, rb + tw, 1536, cq);
}
struct PrepGains { float q[3][8], k[3][8]; };
__device__ __forceinline__ void load8(const float* p, float (&o)[8]) { const f32x4 a = *(const f32x4*)p, b = *(const f32x4*)(p + 4); o[0] = a.x; o[1] = a.y; o[2] = a.z; o[3] = a.w; o[4] = b.x; o[5] = b.y; o[6] = b.z; o[7] = b.w; }
__device__ __forceinline__ void unpack8(const v4u w, float (&x)[8]) { x[0] = bflo(w.x); x[1] = bfhi(w.x); x[2] = bflo(w.y); x[3] = bfhi(w.y); x[4] = bflo(w.z); x[5] = bfhi(w.z); x[6] = bflo(w.w); x[7] = bfhi(w.w); }
__device__ __forceinline__ v4u pack8(const float (&x)[8]) { v4u o; o.x = pk2(x[0], x[1]); o.y = pk2(x[2], x[3]); o.z = pk2(x[4], x[5]); o.w = pk2(x[6], x[7]); return o; }
__device__ __forceinline__ float ssq8(const float (&x)[8]) { return ((x[0] * x[0] + x[1] * x[1]) + (x[2] * x[2] + x[3] * x[3])) + ((x[4] * x[4] + x[5] * x[5]) + (x[6] * x[6] + x[7] * x[7])); }
__device__ __forceinline__ float sum8lanes(float v) { v += __shfl_xor(v, 1); v += __shfl_xor(v, 2); v += __shfl_xor(v, 4); return v; }
__device__ __forceinline__ void prep_row(const bf16* __restrict__ PROJ, bf16* Q, bf16* KV, const PrepGains& G, const float* __restrict__ ROPE, int m, int lane) {
    const int h = lane >> 3, sub = lane & 7;
    const bf16* pr = PROJ + (size_t)m * DINP; bf16* qr = Q + (size_t)m * NQ + 192 * h + 8 * sub; bf16* kr = KV + (size_t)m * NKVP + KVHS * h + 8 * sub;
    const v4u cqv = *(const v4u*)(pr + O_CQ + 8 * lane); const v4u ckv = *(const v4u*)(pr + O_CKV + 8 * (lane & 31)); const v4u pev = *(const v4u*)(pr + O_KPE + 8 * sub);
    const v4u q0 = *(const v4u*)(qr), q1 = *(const v4u*)(qr + 64), q2 = *(const v4u*)(qr + 128);
    const v4u k0 = *(const v4u*)(kr), k1 = *(const v4u*)(kr + 64), v0 = *(const v4u*)(kr + 192), v1 = *(const v4u*)(kr + 256);
    float cs[8], sn[8]; { const float* rp = ROPE + (size_t)(m & (SEQ - 1)) * 64 + 8 * (sub & 3); load8(rp, cs); load8(rp + 32, sn); }
    float t[8];
    unpack8(cqv, t); const float rq = 1.0f / sqrtf(wave_sum(ssq8(t)) * (1.f / 512.f) + EPS);
    unpack8(ckv, t); const float rkv = 1.0f / sqrtf(wave_sum(lane < 32 ? ssq8(t) : 0.f) * (1.f / 256.f) + EPS);
    const float sg = (sub < 4) ? -1.f : 1.f;
    { float a0[8], a1[8], a2[8]; unpack8(q0, a0); unpack8(q1, a1); unpack8(q2, a2);
      const float ss = sum8lanes(ssq8(a0) + ssq8(a1) + ssq8(a2)) * (rq * rq);
      const float sc = rq / sqrtf(ss * (1.f / 192.f) + EPS);
      float r[8], o[8];
#pragma unroll
      for (int i = 0; i < 8; ++i) { a0[i] *= sc * G.q[0][i]; a1[i] *= sc * G.q[1][i]; r[i] = a2[i] * sc * G.q[2][i]; }
#pragma unroll
      for (int i = 0; i < 8; ++i) { const float rp = __shfl_xor(r[i], 4); o[i] = r[i] * cs[i] + sg * rp * sn[i]; }
      *(v4u*)(qr) = pack8(a0); *(v4u*)(qr + 64) = pack8(a1); *(v4u*)(qr + 128) = pack8(o); }
    { float a0[8], a1[8], pe[8], b0[8], b1[8]; unpack8(k0, a0); unpack8(k1, a1); unpack8(pev, pe); unpack8(v0, b0); unpack8(v1, b1);
      const float ss = sum8lanes((ssq8(a0) + ssq8(a1)) * (rkv * rkv) + ssq8(pe));
      const float sk = 1.0f / sqrtf(ss * (1.f / 192.f) + EPS);
      float r[8], o[8];
#pragma unroll
      for (int i = 0; i < 8; ++i) { a0[i] *= rkv * sk * G.k[0][i]; a1[i] *= rkv * sk * G.k[1][i]; r[i] = pe[i] * sk * G.k[2][i]; b0[i] *= rkv; b1[i] *= rkv; }
#pragma unroll
      for (int i = 0; i < 8; ++i) { const float rp = __shfl_xor(r[i], 4); o[i] = r[i] * cs[i] + sg * rp * sn[i]; }
      *(v4u*)(kr) = pack8(a0); *(v4u*)(kr + 64) = pack8(a1); *(v4u*)(kr + 128) = pack8(o); *(v4u*)(kr + 192) = pack8(b0); *(v4u*)(kr + 256) = pack8(b1); }
}
__device__ __forceinline__ void attn_norm_row(bf16* MIXED, int m, int lane) {
    v4u* p = (v4u*)(MIXED + (size_t)m * DM + 512 + 16 * lane); v4u a = p[0], b = p[1];
    unsigned w[8] = {a.x, a.y, a.z, a.w, b.x, b.y, b.z, b.w}; float s = 0.f;
#pragma unroll
    for (int i = 0; i < 8; ++i) { const float x = bflo(w[i]), y = bfhi(w[i]); s += x * x + y * y; }
    const float rstd = 1.0f / sqrtf(wave_sum(s) * (1.f / 1024.f) + EPS);
#pragma unroll
    for (int i = 0; i < 8; ++i) w[i] = pk2(bflo(w[i]) * rstd, bfhi(w[i]) * rstd);
    a.x = w[0]; a.y = w[1]; a.z = w[2]; a.w = w[3]; b.x = w[4]; b.y = w[5]; b.z = w[6]; b.w = w[7]; p[0] = a; p[1] = b;
}

#define DEFPTRS() unsigned char* ws = args.ws; \
    bf16* BtIn = (bf16*)(ws + WS_BTIN); bf16* BtUq = (bf16*)(ws + WS_BTUQ); bf16* BtKv = (bf16*)(ws + WS_BTKV); bf16* BtOut = (bf16*)(ws + WS_BTOUT); bf16* BtUp = (bf16*)(ws + WS_BTUP); bf16* BtDn = (bf16*)(ws + WS_BTDN); \
    bf16* RF = (bf16*)(ws + WS_RF); bf16* Hb = (bf16*)(ws + WS_H); bf16* PROJ = (bf16*)(ws + WS_PROJ); bf16* Qb = (bf16*)(ws + WS_Q); bf16* KVb = (bf16*)(ws + WS_KV); \
    bf16* ZT = (bf16*)(ws + WS_ZT); bf16* X0 = (bf16*)(ws + WS_X0); bf16* YC = (bf16*)(ws + WS_YC); float* EDGE = (float*)(ws + WS_EDGE); float* ROPE = (float*)(ws + WS_ROPE); float* SSQP = (float*)(ws + WS_SSQP); float* RSTD = (float*)(ws + WS_RSTD); bf16* XB2 = (bf16*)(ws + WS_XB2); bf16* ACT = (bf16*)(ws + WS_ACT); \
    bf16* XA = (bf16*)args.out; \
    (void)BtIn; (void)BtUq; (void)BtKv; (void)BtOut; (void)BtUp; (void)BtDn; (void)RF; (void)Hb; (void)PROJ; (void)Qb; (void)KVb; (void)ZT; (void)X0; (void)YC; (void)EDGE; (void)ROPE; (void)SSQP; (void)RSTD; (void)XB2; (void)ACT; (void)XA
__global__ void __launch_bounds__(NWAVES * 64, 2) fwd(Args args) {
    extern __shared__ __attribute__((aligned(16))) unsigned char lds_raw[];
    Frame F;
    F.lds = (LAS unsigned char*)lds_raw;
    F.tid = threadIdx.x; F.lane = F.tid & 63; F.wave = __builtin_amdgcn_readfirstlane(F.tid >> 6);
    F.G = gridDim.x; { const int bx = blockIdx.x; F.vcu = (F.G % 8 == 0) ? (bx % 8) * (F.G / 8) + bx / 8 : bx; }
    volatile LAS unsigned* MISC = (volatile LAS unsigned*)(F.lds + MISC_OFF);
    if (F.tid < 64) MISC[F.tid] = 0u;
    __syncthreads();
    unsigned* ctl = (unsigned*)(args.ws + WS_CTL);
    const int lo = args.ph_lo, hi = args.ph_hi;
    XcdBarrier bar; bar.bar = ctl + CW_BAR; bar.x = 0; bar.st = MISC + 8;
    if (hi - lo > 1) bar = xcd_barrier_post(ctl + CW_BAR, MISC + 8);
    float* out = args.out;

#pragma unroll 1
    for (int layer = 0; layer < DEPTH; ++layer) {
        const int pb = layer * NPH;
        if (pb + NPH <= lo || pb >= hi) continue;
#define IN(k) (lo <= pb + (k) && pb + (k) < hi)
#define ENTER() DEFPTRS(); F.tid = opq(threadIdx.x); F.lane = F.tid & 63; F.wave = __builtin_amdgcn_readfirstlane(F.tid >> 6); const int gw = F.vcu * NWAVES + F.wave, NGW = F.G * NWAVES, wg = F.vcu; const size_t gtid = (size_t)wg * 512 + F.tid, gthreads = (size_t)F.G * 512; (void)gw; (void)NGW; (void)wg; (void)gtid; (void)gthreads
#define SEAM(k) do { if (pb + (k) + 1 < hi) xcd_barrier(bar); } while (0)

        if (IN(0)) { ENTER();
            const float* win = args.in[I_WIN] + (size_t)layer * DM * DIN; const float* g1 = args.in[I_ANG] + layer * DM;
            for (int it = wg; it < 256; it += F.G) {
                if (it < 128) poolfold_item(F, win, args.in[I_PW] + (size_t)layer * 4 * 128 * 128, args.in[I_PS] + (size_t)layer * 512, g1, BtIn, it >> 5, it & 31);
                else filter_item(F, args.in[I_FW1] + (size_t)layer * 17 * 64, args.in[I_FB1] + layer * 64, args.in[I_FFR] + layer * 64, args.in[I_FW2] + (size_t)layer * 64 * 64, args.in[I_FB2] + layer * 64,
                                 args.in[I_FW3] + (size_t)layer * 64 * 1024, args.in[I_FB3] + layer * 1024, args.in[I_HBIAS] + layer * 512, RF, it - 128);
            }
            constexpr int T_IN = 19 * 16, T_UQ = 12 * 4, T_KV = 16 * 2, T_OUT = 16 * 16, T_UP = 88 * 16, T_DN = 16 * 44, T_ALL = T_IN + T_UQ + T_KV + T_OUT + T_UP + T_DN;
            for (int it = wg; it < T_ALL; it += F.G) {
                int r = it; CvtTile d;
                if (r < T_IN) { const int nt = r >> 4, kt = r & 15, n0 = 512 + 128 * nt; d = CvtTile{win, g1, BtIn, DIN, DM, n0, 128 * kt, DIN, {n0, n0 + 32, n0 + 64, n0 + 96}}; }
                else if ((r -= T_IN) < T_UQ) { const int nt = r >> 2, kt = r & 3, n0 = 128 * nt; d = CvtTile{args.in[I_WUQ] + (size_t)layer * 512 * NQ, args.in[I_QNG] + layer * 512, BtUq, NQ, 512, n0, 128 * kt, NQ, {n0, n0 + 32, n0 + 64, n0 + 96}}; }
                else if ((r -= T_UQ) < T_KV) { const int nt = r >> 1, kt = r & 1, n0 = 128 * nt;
                    d = CvtTile{args.in[I_WUKV] + (size_t)layer * 256 * 2048, args.in[I_KVNG] + layer * 256, BtKv, 2048, 256, n0, 128 * kt, 2048, {n0, n0 + 32, n0 + 64, n0 + 96}}; }
                else if ((r -= T_KV) < T_OUT) { const int nt = r >> 4, kt = r & 15, n0 = 128 * nt; d = CvtTile{args.in[I_WOUT] + (size_t)layer * DM * DM, args.in[I_GNG] + layer * DM, BtOut, DM, DM, n0, 128 * kt, DM, {n0, n0 + 32, n0 + 64, n0 + 96}}; }
                else if ((r -= T_OUT) < T_UP) { const int nt = r >> 4, kt = r & 15, n0 = 128 * nt; const int nv = (nt < 44) ? nt : nt - 44; const int bs = 256 * nv + ((nt < 44) ? 0 : 32);
                    d = CvtTile{args.in[I_WUP] + (size_t)layer * DM * NUP, args.in[I_FNG] + layer * DM, BtUp, NUP, DM, n0, 128 * kt, NUP, {bs, bs + 64, bs + 128, bs + 192}}; }
                else { r -= T_UP; const int nt = r / 44, kt = r % 44, n0 = 128 * nt; d = CvtTile{args.in[I_WDN] + (size_t)layer * DFF * DM, nullptr, BtDn, DM, DFF, n0, 128 * kt, DM, {n0, n0 + 32, n0 + 64, n0 + 96}}; }
                cvt_tile(F, d);
            }
            { unsigned zz = 0u; asm volatile("" : "+v"(zz)); v4u z = {zz, zz, zz, zz};
              for (size_t i = gtid; i < (size_t)(DINP - DIN) * DM / 8; i += gthreads) *(v4u*)(BtIn + (size_t)DIN * DM + i * 8) = z;
}
            if (layer == 0) for (size_t i = gtid; i < (size_t)SEQ * 32; i += gthreads) { const int pos = (int)(i >> 5), ri = (int)(i & 31);
                const float freq = exp2f(-(float)ri * (13.287712379549449f / 32.0f)); float sn, cs; sincosf((float)pos * freq, &sn, &cs); ROPE[pos * 64 + ri] = cs; ROPE[pos * 64 + 32 + ri] = sn; }
            if (layer == 0) { for (int m = gw; m < M; m += NGW) xb_row(m < MP ? args.in[I_XP] + (size_t)m * DM : args.in[I_XS] + (size_t)(m - MP) * DM, XA + (size_t)m * DM, RSTD + m, F.lane); }
            else rstd_from_partials(SSQP, RSTD, gtid, gthreads);
            SEAM(0);
        }
        if (IN(1)) { ENTER();
            pg8::Gemm g{XA, BtIn, M, DINP, DM, DM}; pg8::StaticOrder S; S.init(M, DINP, F.G, (int)blockIdx.x);
            pg8::EpiBf16 E{PROJ, DINP, RSTD, 0};
            pg8::gemm_phase<pg8::EpiBf16, pg8::StaticOrder>(F.lds, g, S, E);
            SEAM(1);
        }
        if (IN(2)) { ENTER();
            { pg8::Gemm g{PROJ + O_CQ, BtUq, M, NQ, 512, DINP}; pg8::StaticOrder S; S.init(M, NQ, F.G, (int)blockIdx.x); pg8::EpiBf16 E{Qb, NQ, nullptr, 0};
              pg8::gemm_phase<pg8::EpiBf16, pg8::StaticOrder>(F.lds, g, S, E); }
            { pg8::Gemm g{PROJ + O_CKV, BtKv, M, 2048, 256, DINP}; pg8::StaticOrder S; S.init(M, 2048, F.G, (int)blockIdx.x); pg8::EpiBf16 E{KVb, NKVP, nullptr, 1};
              pg8::gemm_phase<pg8::EpiBf16, pg8::StaticOrder>(F.lds, g, S, E); }
            const float* hcw = args.in[I_HCW] + (size_t)layer * 3 * 1536; const float* hcb = args.in[I_HCB] + layer * 1536;
            for (int it = wg; it < 2 * NSEQ * 64; it += F.G) {
                if (it < NSEQ * 64) hyprep_item(F, PROJ, hcw, hcb, ZT, X0, it >> 6, it & 63);
                else pool_item(F, PROJ, Hb, (it - NSEQ * 64) >> 6, it & 63);
            }
            SEAM(2);
        }
        if (IN(3)) { ENTER();
            for (int u = wg; u < 2 * HYC; u += F.G) hy::conv_unit(F.lds, ZT, RF, YC, u >> 1, u & 1);
            const float* qhg = args.in[I_QHG] + layer * 192; const float* khg = args.in[I_KHG] + layer * 192;
            PrepGains PG; { const int sub = F.lane & 7;
#pragma unroll
                for (int i = 0; i < 3; ++i) { load8(qhg + 64 * i + 8 * sub, PG.q[i]); load8(khg + 64 * i + 8 * sub, PG.k[i]); } }
            for (int m = gw; m < M; m += NGW) prep_row(PROJ, Qb, KVb, PG, ROPE, m, F.lane);
            SEAM(3);
        }
        if (IN(4)) { ENTER();
            float gqm, gkm; { const float* qhg = args.in[I_QHG] + layer * 192; const float* khg = args.in[I_KHG] + layer * 192;
                gqm = fmaxf(fmaxf(fabsf(qhg[F.lane]), fabsf(qhg[64 + F.lane])), fabsf(qhg[128 + F.lane])); gkm = fmaxf(fmaxf(fabsf(khg[F.lane]), fabsf(khg[64 + F.lane])), fabsf(khg[128 + F.lane]));
#pragma unroll
                for (int o = 1; o < 64; o <<= 1) { gqm = fmaxf(gqm, __shfl_xor(gqm, o)); gkm = fmaxf(gkm, __shfl_xor(gkm, o)); } }
            const float Mnat = 13.856406460551018f * gqm * gkm;
            const bool sm_fast = __builtin_amdgcn_readfirstlane((Mnat <= 40.0f) ? 1 : 0) != 0;
            const float negMC = __builtin_bit_cast(float, __builtin_amdgcn_readfirstlane(__builtin_bit_cast(int, -Mnat * 1.4426950408889634f)));
            for (int i = 0; i * F.G < NSEQ * NH * 8; ++i) {
                int p, qb; const int c = (int)blockIdx.x;
                if (F.G == 256) { p = i * 32 + (c & 7) * 4 + (c >> 6); qb = (c >> 3) & 7; } else { const int Lq = i * F.G + c; p = Lq >> 3; qb = Lq & 7; }
                if (p < NSEQ * NH) { const int b = p >> 3, h = p & 7;
                    const bf16* qp = Qb + (size_t)(b * SEQ + qb * 256) * NQ + h * 192; const bf16* kp = KVb + (size_t)(b * SEQ) * NKVP + h * KVHS; bf16* op = Hb + (size_t)(b * SEQ + qb * 256) * DM + 512 + h * 128;
                    if (sm_fast) at::attn_unit<true>(negMC, qp, kp, kp + 192, op, SEQ, (char*)lds_raw);
                    else at::attn_unit<false>(0.f, qp, kp, kp + 192, op, SEQ, (char*)lds_raw); }
            }
            for (int it = wg; it < NSEQ * 64; it += F.G) hyfin_item(F, YC, X0, Hb, it >> 6, it & 63);
            SEAM(4);
        }
        if (IN(5)) { ENTER();
            for (int m = gw; m < M; m += NGW) attn_norm_row(Hb, m, F.lane);
            SEAM(5);
        }
        if (IN(6)) { ENTER();
            pg8::Gemm g{Hb, BtOut, M, DM, DM, DM}; pg8::StaticOrder S; S.init(M, DM, F.G, (int)blockIdx.x);
            pg8::EpiResid16 E{XA, XB2, out, DM, SSQP, 0};
            pg8::gemm_phase<pg8::EpiResid16, pg8::StaticOrder>(F.lds, g, S, E);
            SEAM(6);
        }
        if (IN(7)) { ENTER();
            rstd_from_partials(SSQP, RSTD, gtid, gthreads);
            SEAM(7);
        }
        if (IN(8)) { ENTER();
            pg8::Gemm g{XB2, BtUp, M, NUP, DM, DM}; pg8::StaticOrder S; S.init(M, NUP, F.G, (int)blockIdx.x);
            pg8::EpiGate E{ACT, DFF, EDGE, args.in[I_FCW] + (size_t)layer * 3 * DFF, args.in[I_FCB] + layer * DFF, DFF, (LAS float*)(F.lds + HALO_OFF), RSTD};
            pg8::gemm_phase<pg8::EpiGate, pg8::StaticOrder>(F.lds, g, S, E);
            SEAM(8);
        }
        if (IN(9)) { ENTER();
            const float* fcw = args.in[I_FCW] + (size_t)layer * 3 * DFF;
            for (size_t i = gtid; i < (size_t)(M / 256) * 2 * (DFF / 4); i += gthreads) {
                const int ri = (int)(i / (DFF / 4)), c4 = (int)(i % (DFF / 4)) * 4, pm = ri >> 1, e = ri & 1;
                const float* eb = EDGE + (size_t)(ri * 3) * DFF + c4;
                f32x4 pre = *(const f32x4*)(eb + DFF); const f32x4 v = *(const f32x4*)(eb + 2 * DFF);
                if (e == 0 && (pm & 7) != 0) { const f32x4 gp = *(const f32x4*)(EDGE + (size_t)(((pm - 1) * 2 + 1) * 3) * DFF + c4); pre += *(const f32x4*)(fcw + c4) * gp; }
                if (e == 1 && (pm & 7) != 7) { const f32x4 gn = *(const f32x4*)(EDGE + (size_t)(((pm + 1) * 2 + 0) * 3) * DFF + c4); pre += *(const f32x4*)(fcw + 2 * DFF + c4) * gn; }
                v2u o; o.x = pk2(pg8::silu_f(pre.x) * v.x, pg8::silu_f(pre.y) * v.y); o.y = pk2(pg8::silu_f(pre.z) * v.z, pg8::silu_f(pre.w) * v.w);
                *(v2u*)(ACT + (size_t)(pm * 256 + (e ? 255 : 0)) * DFF + c4) = o;
            }
            SEAM(9);
        }
        if (IN(10)) { ENTER();
            pg8::Gemm g{ACT, BtDn, M, DM, DFF, DFF}; pg8::StaticOrder S; S.init(M, DM, F.G, (int)blockIdx.x);
            pg8::EpiResid16 E{XB2, XA, out, DM, SSQP, (layer + 1 < DEPTH) ? 0 : 1};
            pg8::gemm_phase<pg8::EpiResid16, pg8::StaticOrder>(F.lds, g, S, E);
            SEAM(10);
        }
#undef IN
#undef ENTER
#undef SEAM
    }
}

extern "C" void kernel_launch(void* const* d_in, const int* in_sizes, int n_in, void* d_out, int out_size, void* d_ws, size_t ws_size, hipStream_t stream) {
    static int grid = 0;
    if (grid == 0) {
        if (n_in != N_IN || out_size != M * DM || ws_size < WS_END) { fprintf(stderr, "kernel_launch: unexpected shapes (n_in %d, out %d, ws %zu, need %zu)\n", n_in, out_size, ws_size, (size_t)WS_END); grid = -1; return; }
        int dev = 0, cus = 0;
        if (hipGetDevice(&dev) != hipSuccess || hipDeviceGetAttribute(&cus, hipDeviceAttributeMultiprocessorCount, dev) != hipSuccess) { grid = -1; return; }
        if (hipFuncSetAttribute((const void*)fwd, hipFuncAttributeMaxDynamicSharedMemorySize, LDS_BYTES) != hipSuccess) { fprintf(stderr, "kernel_launch: hipFuncSetAttribute failed\n"); grid = -1; return; }
        int per_cu = 0;
        if (hipOccupancyMaxActiveBlocksPerMultiprocessor(&per_cu, (const void*)fwd, NWAVES * 64, LDS_BYTES) != hipSuccess || per_cu < 1) fprintf(stderr, "kernel_launch: occupancy query reports %d\n", per_cu);
        (void)hipGetLastError();
        grid = cus;
    }
    if (grid < 0) return;
    (void)hipMemsetAsync((char*)d_ws + WS_CTL, 0, CTL_BYTES, stream);
    Args a{};
    for (int i = 0; i < N_IN; ++i) a.in[i] = (const float*)d_in[i];
    a.out = (float*)d_out; a.ws = (unsigned char*)d_ws;
#if MK_ONE_LAUNCH
    a.ph_lo = 0; a.ph_hi = DEPTH * NPH;
    hipLaunchKernelGGL(fwd, dim3(grid), dim3(NWAVES * 64), LDS_BYTES, stream, a);
#else
    for (int p = 0; p < DEPTH * NPH; ++p) { a.ph_lo = p; a.ph_hi = p + 1; hipLaunchKernelGGL(fwd, dim3(grid), dim3(NWAVES * 64), LDS_BYTES, stream, a); }
#endif
    const hipError_t le = hipPeekAtLastError();
    if (le != hipSuccess) fprintf(stderr, "kernel_launch: launch failed: %s\n", hipGetErrorName(le));
}
```

```cpp
#include <hip/hip_runtime.h>
#include <cstdio>
#include <cstdint>
__device__ __forceinline__ int opq(int x) { asm volatile("" : "+v"(x)); return x; }
namespace pg8 {
#define PG8_LAS __attribute__((address_space(3)))
typedef unsigned short bf16_t;
typedef short bf16x8 __attribute__((ext_vector_type(8)));
typedef float f32x4 __attribute__((ext_vector_type(4)));
typedef unsigned u32x4 __attribute__((ext_vector_type(4)));
constexpr int BM = 256, BK = 64, HALF = 128, HTB = HALF * BK * 2  , STAGE_BYTES = 8 * HTB, NXCD = 8, WGM = 8;

__host__ __device__ __forceinline__ int lds_byte(int r, int c) { const int st = (r >> 4) * 2 + (c >> 5), rr = r & 15, cc = c & 31, ob = rr * 64 + cc * 2; return st * 1024 + (ob ^ (((ob >> 9) & 1) << 5)); }
__host__ __device__ __forceinline__ void stage_rc(int b, int& R, int& C) { const int st = b / 1024, sb = b % 1024, swz = sb ^ (((sb >> 9) & 1) << 5); R = (st >> 1) * 16 + swz / 64; C = (st & 1) * 32 + (swz % 64) / 2; }
__host__ __device__ __forceinline__ int perm32(int rho) { const int n = rho >> 4, i = rho & 15; return 8 * (i >> 2) + 4 * n + (i & 3); }

struct Unit { int pm, pn; };
struct Gemm { const bf16_t* A; const bf16_t* Bt; int M, N, K, lda; };

struct StaticOrder {
    int nM, nN, nwg, G, c;
    __host__ __device__ void init(int M, int N, int G_, int c_) { nM = M / BM; nN = N / BM; nwg = nM * nN; G = G_; c = c_; }
    __host__ __device__ bool next(int i, Unit& u) const {
        const long L = (long)i * G + c; if (L >= nwg) return false;
        int wgid = (int)L; { const int q = nwg / NXCD, r = nwg % NXCD, xcd = wgid % NXCD, off = wgid / NXCD; wgid = (xcd < r ? xcd * (q + 1) : r * (q + 1) + (xcd - r) * q) + off; }
        const int nig = WGM * nN, gid = wgid / nig, fm = gid * WGM, gsz = (nM - fm) < WGM ? (nM - fm) : WGM;
        u.pm = fm + ((wgid % nig) % gsz); u.pn = (wgid % nig) / gsz; return true;
    }
    __device__ __forceinline__ void a_ready(const Unit&) const {}
    __device__ __forceinline__ void done(const Unit&) const {}
};

__device__ __forceinline__ unsigned cvt_pk_bf16(float lo, float hi) { unsigned r; asm volatile("v_cvt_pk_bf16_f32 %0, %1, %2" : "=v"(r) : "v"(lo), "v"(hi)); return r; }

__device__ __forceinline__ float dpp_ror1(float v) { return __builtin_bit_cast(float, __builtin_amdgcn_update_dpp(0, __builtin_bit_cast(int, v), 0x121, 0xF, 0xF, false)); }
__device__ __forceinline__ float dpp_ror15(float v) { return __builtin_bit_cast(float, __builtin_amdgcn_update_dpp(0, __builtin_bit_cast(int, v), 0x12F, 0xF, 0xF, false)); }
__device__ __forceinline__ unsigned dpp_swap1(unsigned v) { return (unsigned)__builtin_amdgcn_update_dpp(0, (int)v, 0xB1, 0xF, 0xF, false); }
struct LineOffs { unsigned o0, o1; bool odd; };
__device__ __forceinline__ LineOffs line_offs(unsigned lo, int pitch, int fr) { LineOffs L; L.odd = fr & 1; L.o0 = L.odd ? lo - (unsigned)pitch + 32u : lo; L.o1 = L.odd ? lo + 32u : lo + (unsigned)pitch; return L; }
__device__ __forceinline__ void store_lines(bf16_t* base, const LineOffs& L, u32x4 a, u32x4 b) {
    const u32x4 snd = L.odd ? a : b; u32x4 rcv;
    rcv.x = dpp_swap1(snd.x); rcv.y = dpp_swap1(snd.y); rcv.z = dpp_swap1(snd.z); rcv.w = dpp_swap1(snd.w);
    *(u32x4*)(base + L.o0) = L.odd ? rcv : a;
    *(u32x4*)(base + L.o1) = L.odd ? b : rcv;
}
struct EpiBf16 {
    static constexpr bool PERM = true;
    bf16_t* O; int ldc; const float* rstd; int kvscatter;
    __device__ __forceinline__ void operator()(f32x4 (&acc)[2][2][4][2], const Unit& u, int wr, int wc, int fr, int fq) const {
        bf16_t* Ot = O + (size_t)(u.pm * BM) * ldc + (kvscatter ? u.pn * 320 : u.pn * BM);
        const int wcol = kvscatter ? (wc < 2 ? wc * 64 : 64 + wc * 64) : wc * 64;
        const LineOffs L = line_offs((unsigned)((wr * 64 + fr) * ldc + wcol + 8 * fq), ldc, fr); const int row0 = u.pm * BM + wr * 64 + fr;
        float rsv[8];
#pragma unroll
        for (int i = 0; i < 8; ++i) rsv[i] = rstd ? rstd[row0 + (i >> 2) * HALF + (i & 3) * 16] : 1.0f;
#pragma unroll
        for (int ai = 0; ai < 2; ++ai)
#pragma unroll
            for (int m = 0; m < 4; ++m) { const float rs = rsv[ai * 4 + m];
                u32x4 w[2];
#pragma unroll
                for (int bj = 0; bj < 2; ++bj) { const f32x4 v0 = acc[ai][bj][m][0] * rs, v1 = acc[ai][bj][m][1] * rs;
                    w[bj].x = cvt_pk_bf16(v0[0], v0[1]); w[bj].y = cvt_pk_bf16(v0[2], v0[3]); w[bj].z = cvt_pk_bf16(v1[0], v1[1]); w[bj].w = cvt_pk_bf16(v1[2], v1[3]); }
                store_lines(Ot + (size_t)((ai * HALF + m * 16) * ldc), L, w[0], w[1]);
                asm volatile("" ::: "memory"); }
    }
};
struct EpiResid16 {
    static constexpr bool PERM = true;
    const bf16_t* base; bf16_t* xo; float* out; int ldc; float* ssqp; int f32out;
    __device__ __forceinline__ static void addx(const u32x4 b, const f32x4 a0, const f32x4 a1, f32x4& x0, f32x4& x1) {
        x0[0] = __builtin_bit_cast(float, b.x << 16) + a0[0]; x0[1] = __builtin_bit_cast(float, b.x & 0xffff0000u) + a0[1]; x0[2] = __builtin_bit_cast(float, b.y << 16) + a0[2]; x0[3] = __builtin_bit_cast(float, b.y & 0xffff0000u) + a0[3];
        x1[0] = __builtin_bit_cast(float, b.z << 16) + a1[0]; x1[1] = __builtin_bit_cast(float, b.z & 0xffff0000u) + a1[1]; x1[2] = __builtin_bit_cast(float, b.w << 16) + a1[2]; x1[3] = __builtin_bit_cast(float, b.w & 0xffff0000u) + a1[3]; }
    __device__ __forceinline__ void operator()(f32x4 (&acc)[2][2][4][2], const Unit& u, int wr, int wc, int fr, int fq) const {
        const size_t tb = (size_t)(u.pm * BM) * ldc + u.pn * BM;
        const bf16_t* bs = base + tb;
        const unsigned lo = (unsigned)((wr * 64 + fr) * ldc + wc * 64 + 8 * fq);
        if (f32out != 0) {
            float* op = out + tb;
#pragma unroll
            for (int ai = 0; ai < 2; ++ai)
#pragma unroll
                for (int m = 0; m < 4; ++m) { const unsigned off = lo + (unsigned)((ai * HALF + m * 16) * ldc);
#pragma unroll
                    for (int bj = 0; bj < 2; ++bj) { const u32x4 b = *(const u32x4*)(bs + off + bj * 32); f32x4 x0, x1; addx(b, acc[ai][bj][m][0], acc[ai][bj][m][1], x0, x1);
                        *(f32x4*)(op + off + bj * 32) = x0; *(f32x4*)(op + off + bj * 32 + 4) = x1; }
                    asm volatile("" ::: "memory"); }
            return;
        }
        bf16_t* xp = xo + tb; const LineOffs L = line_offs(lo, ldc, fr);
#pragma unroll
        for (int aim = 0; aim < 4; ++aim) { const int ai = aim >> 1, mp = aim & 1;
            u32x4 bv[2][2];
#pragma unroll
            for (int mm = 0; mm < 2; ++mm)
#pragma unroll
                for (int bj = 0; bj < 2; ++bj) bv[mm][bj] = *(const u32x4*)(bs + lo + (unsigned)((ai * HALF + (2 * mp + mm) * 16) * ldc) + bj * 32);
#pragma unroll
            for (int mm = 0; mm < 2; ++mm) { const int m = 2 * mp + mm; float s = 0.f; u32x4 wv[2];
#pragma unroll
                for (int bj = 0; bj < 2; ++bj) { f32x4 x0, x1; addx(bv[mm][bj], acc[ai][bj][m][0], acc[ai][bj][m][1], x0, x1);
                    wv[bj].x = cvt_pk_bf16(x0[0], x0[1]); wv[bj].y = cvt_pk_bf16(x0[2], x0[3]); wv[bj].z = cvt_pk_bf16(x1[0], x1[1]); wv[bj].w = cvt_pk_bf16(x1[2], x1[3]);
                    s += ((x0[0] * x0[0] + x0[1] * x0[1]) + (x0[2] * x0[2] + x0[3] * x0[3])) + ((x1[0] * x1[0] + x1[1] * x1[1]) + (x1[2] * x1[2] + x1[3] * x1[3])); }
                store_lines(xp + (size_t)((ai * HALF + m * 16) * ldc), L, wv[0], wv[1]);
                s += __shfl_xor(s, 16); s += __shfl_xor(s, 32); if (fq == 0) ssqp[(size_t)(u.pm * BM + wr * 64 + fr + ai * HALF + m * 16) * 32 + u.pn * 4 + wc] = s; }
            asm volatile("" ::: "memory"); }
    }
};
__device__ __forceinline__ float silu_f(float x) { return x * __builtin_amdgcn_rcpf(1.0f + __builtin_amdgcn_exp2f(-1.4426950408889634f * x)); }
struct EpiGate {
    static constexpr bool PERM = true;
    bf16_t* act; int ldact; float* edge; const float* cw; const float* cb; int dff; PG8_LAS float* halo; const float* rstd;
    __device__ __forceinline__ void operator()(f32x4 (&acc)[2][2][4][2], const Unit& u, int wr, int wc, int fr, int fq) const {
        const int lane = fq * 16 + fr; const int colL = wc * 32 + 8 * fq; const int colG = u.pn * HALF + colL;
#pragma unroll
        for (int ai = 0; ai < 2; ++ai)
#pragma unroll
            for (int m = 0; m < 4; ++m) { const float rs = rstd[u.pm * BM + ai * HALF + wr * 64 + m * 16 + fr];
#pragma unroll
                for (int bj = 0; bj < 2; ++bj) { acc[ai][bj][m][0] *= rs; acc[ai][bj][m][1] *= rs; } }
#pragma unroll
        for (int ai = 0; ai < 2; ++ai) { const int q = 2 * ai + wr;
            if (fr == 0) { *(PG8_LAS f32x4*)(halo + (q * 2 + 0) * 128 + colL) = acc[ai][0][0][0]; *(PG8_LAS f32x4*)(halo + (q * 2 + 0) * 128 + colL + 4) = acc[ai][0][0][1]; }
            if (fr == 15) { *(PG8_LAS f32x4*)(halo + (q * 2 + 1) * 128 + colL) = acc[ai][0][3][0]; *(PG8_LAS f32x4*)(halo + (q * 2 + 1) * 128 + colL + 4) = acc[ai][0][3][1]; } }
        asm volatile("s_waitcnt lgkmcnt(0)" ::: "memory"); __builtin_amdgcn_s_barrier(); asm volatile("" ::: "memory");
        bf16_t* actp = act + (size_t)(u.pm * BM) * ldact + colG; const unsigned rlo = (unsigned)((wr * 64 + fr) * ldact);
#pragma unroll
        for (int ai = 0; ai < 2; ++ai) { const int q = 2 * ai + wr;
            typedef unsigned u32x2 __attribute__((ext_vector_type(2)));
            u32x2 pk[4][2];
#pragma unroll
            for (int n = 0; n < 2; ++n) {
                const f32x4 w0 = *(const f32x4*)(cw + colG + 4 * n), w1 = *(const f32x4*)(cw + dff + colG + 4 * n), w2 = *(const f32x4*)(cw + 2 * dff + colG + 4 * n), bb = *(const f32x4*)(cb + colG + 4 * n);
                f32x4 ht = *(PG8_LAS f32x4*)(halo + ((q > 0 ? q - 1 : 0) * 2 + 1) * 128 + colL + 4 * n), hb = *(PG8_LAS f32x4*)(halo + ((q < 3 ? q + 1 : 3) * 2 + 0) * 128 + colL + 4 * n);
                if (q == 0) ht = ht * 0.f; if (q == 3) hb = hb * 0.f;
                f32x4 pre[4];
#pragma unroll
                for (int j = 0; j < 4; ++j) {
                    float g[4], rr[4], rl[4];
#pragma unroll
                    for (int m = 0; m < 4; ++m) { g[m] = acc[ai][0][m][n][j]; rr[m] = dpp_ror1(g[m]); rl[m] = dpp_ror15(g[m]); }
#pragma unroll
                    for (int m = 0; m < 4; ++m) {
                        const float up = (fr > 0) ? rr[m] : (m > 0 ? rr[m > 0 ? m - 1 : 0] : ht[j]);
                        const float dn = (fr < 15) ? rl[m] : (m < 3 ? rl[m < 3 ? m + 1 : 3] : hb[j]);
                        pre[m][j] = w0[j] * up + w1[j] * g[m] + w2[j] * dn + bb[j];
                    }
                }
                if (q == 0 && fr == 0) { float* e = edge + (size_t)((u.pm * 2 + 0) * 3) * dff + colG + 4 * n;
                    *(f32x4*)(e) = acc[ai][0][0][n]; *(f32x4*)(e + dff) = pre[0]; *(f32x4*)(e + 2 * dff) = acc[ai][1][0][n]; }
                if (q == 3 && fr == 15) { float* e = edge + (size_t)((u.pm * 2 + 1) * 3) * dff + colG + 4 * n;
                    *(f32x4*)(e) = acc[ai][0][3][n]; *(f32x4*)(e + dff) = pre[3]; *(f32x4*)(e + 2 * dff) = acc[ai][1][3][n]; }
#pragma unroll
                for (int m = 0; m < 4; ++m) { const f32x4 v = acc[ai][1][m][n];
                    pk[m][n].x = cvt_pk_bf16(silu_f(pre[m][0]) * v[0], silu_f(pre[m][1]) * v[1]); pk[m][n].y = cvt_pk_bf16(silu_f(pre[m][2]) * v[2], silu_f(pre[m][3]) * v[3]); }
            }
#pragma unroll
            for (int m = 0; m < 4; ++m) { u32x4 w; w.x = pk[m][0].x; w.y = pk[m][0].y; w.z = pk[m][1].x; w.w = pk[m][1].y;
                *(u32x4*)(actp + rlo + (unsigned)((ai * HALF + m * 16) * ldact)) = w; }
        }
    }
};

template <class Epi, class Sched>
__device__ __forceinline__ void gemm_phase(PG8_LAS unsigned char* lds, const Gemm g, const Sched& S, const Epi& E) {
    const int tid = opq(threadIdx.x), wid = __builtin_amdgcn_readfirstlane(tid >> 6), lane = tid & 63, wr = wid >> 2, wc = wid & 3, fr = lane & 15, fq = lane >> 4;
    const int K = g.K, nt = K / BK, lda = g.lda;
    unsigned voffA[2], voffB[2];
#pragma unroll
    for (int i = 0; i < 2; ++i) { int R, C; stage_rc(tid * 16 + i * 8192, R, C); const int Rb = Epi::PERM ? (64 * (R >> 5) + perm32(R & 31)) : R;
        voffA[i] = (unsigned)(R * lda + C) * 2u; voffB[i] = (unsigned)(Rb * K + C) * 2u; }
    const size_t kstep = (size_t)(BK * 2);
    const size_t hstepA = (size_t)HALF * lda * 2, hstepB = (size_t)(Epi::PERM ? 32 : HALF) * K * 2;
    const size_t tstepA = 2 * hstepA, tstepB = (size_t)BM * K * 2;
    const unsigned ldsw = (unsigned)wid * 1024u;
    const int aoff = lds_byte(wr * 64 + fr, fq * 8), boff = lds_byte(wc * 32 + fr, fq * 8);
#define PG8_SA(b, h) (((b) * 2 + (h)) * HTB)
#define PG8_SB(b, h) ((4 + (b) * 2 + (h)) * HTB)
#define PG8_STAGE(bufoff, gbase, voff) do { _Pragma("unroll") for (int _i = 0; _i < 2; ++_i) \
        __builtin_amdgcn_global_load_lds((const unsigned*)((const char*)(gbase) + (voff)[_i]), (PG8_LAS unsigned*)(lds + (bufoff) + ldsw + _i * 8192), 16, 0, 0); } while (0)
#define PG8_LDA(dst, b, h) do { _Pragma("unroll") for (int m = 0; m < 4; ++m) _Pragma("unroll") for (int k = 0; k < 2; ++k) dst[m][k] = *(const PG8_LAS bf16x8*)(lds + PG8_SA(b, h) + aoff + m * 2048 + k * 1024); } while (0)
#define PG8_LDB(dst, b, h) do { _Pragma("unroll") for (int n = 0; n < 2; ++n) _Pragma("unroll") for (int k = 0; k < 2; ++k) dst[n][k] = *(const PG8_LAS bf16x8*)(lds + PG8_SB(b, h) + boff + n * 2048 + k * 1024); } while (0)
#define PG8_MMA(ai, bj, At, Bt) do { __builtin_amdgcn_s_setprio(1); _Pragma("unroll") for (int m = 0; m < 4; ++m) _Pragma("unroll") for (int n = 0; n < 2; ++n) _Pragma("unroll") for (int k = 0; k < 2; ++k) \
        acc[ai][bj][m][n] = __builtin_amdgcn_mfma_f32_16x16x32_bf16(Bt[n][k], At[m][k], acc[ai][bj][m][n], 0, 0, 0); __builtin_amdgcn_s_setprio(0); } while (0)
#define PG8_WAIT_V(n) asm volatile("s_waitcnt vmcnt(" #n ")" ::: "memory")
#define PG8_WAIT_L(n) asm volatile("s_waitcnt lgkmcnt(" #n ")" ::: "memory")
#define PG8_BAR __builtin_amdgcn_s_barrier()
#define PG8_SCHED __builtin_amdgcn_sched_barrier(0)
    Unit cur, nxt; int ui = 0;
    if (!S.next(0, cur)) return;
    f32x4 acc[2][2][4][2];
{ float zf = 0.f; asm volatile("" : "+v"(zf));
    #pragma unroll
    for (int a = 0; a < 2; ++a)
#pragma unroll
        for (int b = 0; b < 2; ++b)
#pragma unroll
            for (int m = 0; m < 4; ++m)
#pragma unroll
                for (int n = 0; n < 2; ++n) acc[a][b][m][n] = (f32x4){zf, zf, zf, zf}; }
    bf16x8 At[4][2], B0[2][2], B1[2][2];
    const char* cA = (const char*)g.A + (size_t)cur.pm * tstepA; const char* cB = (const char*)g.Bt + (size_t)cur.pn * tstepB;
    S.a_ready(cur);
    PG8_STAGE(PG8_SB(0, 0), cB, voffB); PG8_STAGE(PG8_SB(0, 1), cB + hstepB, voffB); PG8_STAGE(PG8_SA(0, 0), cA, voffA); PG8_STAGE(PG8_SA(0, 1), cA + hstepA, voffA);
    if (wr == 1) PG8_BAR;
    PG8_WAIT_V(2); PG8_BAR;
    PG8_STAGE(PG8_SB(1, 0), cB + kstep, voffB); PG8_STAGE(PG8_SA(1, 0), cA + kstep, voffA); PG8_STAGE(PG8_SB(1, 1), cB + hstepB + kstep, voffB);
    PG8_WAIT_V(6); PG8_BAR;
    for (;;) {
        const bool has_next = S.next(ui + 1, nxt);
        const char* nA = has_next ? (const char*)g.A + (size_t)nxt.pm * tstepA : cA; const char* nB = has_next ? (const char*)g.Bt + (size_t)nxt.pn * tstepB : cB;
#pragma unroll 1
        for (int t = 0; t < nt; t += 2) {
            const bool last = (t == nt - 2);
            const char* a1 = cA + (size_t)(t + 1) * kstep;
            const char* a2 = last ? nA : cA + (size_t)(t + 2) * kstep; const char* b2 = last ? nB : cB + (size_t)(t + 2) * kstep;
            const char* a3 = a2 + kstep; const char* b3 = b2 + kstep;
            if (last && has_next) S.a_ready(nxt);
            PG8_LDB(B0, 0, 0); PG8_LDB(B1, 0, 1); PG8_SCHED; PG8_LDA(At, 0, 0); PG8_STAGE(PG8_SA(1, 1), a1 + hstepA, voffA);
            PG8_WAIT_V(8); PG8_WAIT_L(0); PG8_BAR; PG8_MMA(0, 0, At, B0); PG8_MMA(0, 1, At, B1); PG8_BAR; PG8_SCHED;
            PG8_LDA(At, 0, 1); PG8_STAGE(PG8_SB(0, 0), b2, voffB); PG8_STAGE(PG8_SB(0, 1), b2 + hstepB, voffB); PG8_STAGE(PG8_SA(0, 0), a2, voffA);
            PG8_WAIT_V(8); PG8_WAIT_L(0); PG8_BAR; PG8_MMA(1, 0, At, B0); PG8_MMA(1, 1, At, B1); PG8_BAR; PG8_SCHED;
            PG8_LDB(B0, 1, 0); PG8_LDB(B1, 1, 1); PG8_SCHED; PG8_LDA(At, 1, 0); PG8_STAGE(PG8_SA(0, 1), a2 + hstepA, voffA);
            PG8_WAIT_V(8); PG8_WAIT_L(0); PG8_BAR; PG8_MMA(0, 0, At, B0); PG8_MMA(0, 1, At, B1); PG8_BAR; PG8_SCHED;
            PG8_LDA(At, 1, 1); PG8_STAGE(PG8_SB(1, 0), b3, voffB); PG8_STAGE(PG8_SB(1, 1), b3 + hstepB, voffB); PG8_STAGE(PG8_SA(1, 0), a3, voffA);
            PG8_WAIT_V(8); PG8_WAIT_L(0); PG8_BAR; PG8_MMA(1, 0, At, B0); PG8_MMA(1, 1, At, B1); PG8_BAR; PG8_SCHED;
        }
        if (wr == 0) PG8_BAR;
        E(acc, cur, wr, wc, fr, fq); S.done(cur);
        if (!has_next) break;
{ float zf = 0.f; asm volatile("" : "+v"(zf));
        #pragma unroll
        for (int a = 0; a < 2; ++a)
#pragma unroll
            for (int b = 0; b < 2; ++b)
#pragma unroll
                for (int m = 0; m < 4; ++m)
#pragma unroll
                    for (int n = 0; n < 2; ++n) acc[a][b][m][n] = (f32x4){zf, zf, zf, zf}; }
        cur = nxt; cA = nA; cB = nB; ++ui;
        if (wr == 1) PG8_BAR;
    }
    PG8_WAIT_V(0);
    PG8_BAR;
#undef PG8_SA
#undef PG8_SB
#undef PG8_STAGE
#undef PG8_LDA
#undef PG8_LDB
#undef PG8_MMA
#undef PG8_WAIT_V
#undef PG8_WAIT_L
#undef PG8_BAR
#undef PG8_SCHED
}
}
namespace at {
using bf16 = unsigned short;
using bf16x8 = __attribute__((ext_vector_type(8))) short;
using s16x4  = __attribute__((ext_vector_type(4))) short;
using f32x16 = __attribute__((ext_vector_type(16))) float;
using u32x4  = __attribute__((ext_vector_type(4))) unsigned;
constexpr int DQK = 192, DV = 128, KVBLK = 64, NW = 8, QBLK = 32;
constexpr float SCALE = 0.07216878364870322f;
constexpr float THR = 8.f;
constexpr int LDQ = 1536, LDK = 2560, LDO = 2048;
constexpr int SHM_V = KVBLK * DV * 2, SHM_K = 12 * 2080;
constexpr int QR_OFF = 2 * SHM_V + 2 * SHM_K + NW * 64 * 4;
constexpr int SHM_ATTN = QR_OFF + NW * 4096;
#define SBAR() __builtin_amdgcn_sched_barrier(0)
constexpr int KPL = 2080;
__host__ __device__ __forceinline__ int k_st(int row, int c) { return (c >> 1) * KPL + row * 32 + (((c & 1) ^ ((row >> 3) & 1)) << 4); }
__host__ __device__ __forceinline__ int k_rd_base(int r32, int hi) { return r32 * 32 + ((hi ^ ((r32 >> 3) & 1)) << 4); }
__device__ __forceinline__ int crow(int r, int hi) { return (r & 3) + 8 * (r >> 2) + 4 * hi; }
__device__ __forceinline__ unsigned cvtpk(float lo, float hi) { unsigned r; asm volatile("v_cvt_pk_bf16_f32 %0, %1, %2" : "=v"(r) : "v"(lo), "v"(hi)); return r; }

__device__ __forceinline__ void partialSM(f32x16& p0, f32x16& p1, float& m_reg, float& mn, float& alpha) {
  constexpr float C = 1.0f;
  float pmax = p0[0];
#pragma unroll
  for (int r = 1; r < 16; ++r) pmax = fmaxf(pmax, p0[r]);
#pragma unroll
  for (int r = 0; r < 16; ++r) pmax = fmaxf(pmax, p1[r]);
  { auto rr = __builtin_amdgcn_permlane32_swap(__float_as_uint(pmax), __float_as_uint(pmax), false, false);
    pmax = fmaxf(__uint_as_float(rr[0]), __uint_as_float(rr[1])); }
  if (__builtin_expect(__all(pmax - m_reg <= THR * 1.4426950408889634f), 1)) { mn = m_reg; alpha = 1.f; }
  else { mn = fmaxf(m_reg, pmax); alpha = __builtin_amdgcn_exp2f((m_reg - mn) * C); m_reg = mn; }
  float mnC = -mn * C;
#pragma unroll
  for (int r = 0; r < 16; ++r) p0[r] = fmaf(p0[r], C, mnC);
#pragma unroll
  for (int r = 0; r < 16; ++r) p1[r] = fmaf(p1[r], C, mnC);
#pragma unroll
  for (int r = 0; r < 16; ++r) p0[r] = __builtin_amdgcn_exp2f(p0[r]);
}
__device__ __forceinline__ void partialSM_fast(f32x16& p0, f32x16& p1, float negMC) {
  (void)negMC; (void)p1;
#pragma unroll
  for (int r = 0; r < 16; ++r) p0[r] = __builtin_amdgcn_exp2f(p0[r]);
}
__device__ __forceinline__ void finishSM(f32x16& p0, f32x16& p1, float alpha, float& l_reg, bf16x8& pa0, bf16x8& pa1, bf16x8& pa2, bf16x8& pa3) {
#pragma unroll
  for (int r = 0; r < 16; ++r) p1[r] = __builtin_amdgcn_exp2f(p1[r]);
  float ps = 0;
#pragma unroll
  for (int r = 0; r < 16; ++r) ps += p0[r];
#pragma unroll
  for (int r = 0; r < 16; ++r) ps += p1[r];
  { auto rr = __builtin_amdgcn_permlane32_swap(__float_as_uint(ps), __float_as_uint(ps), false, false);
    ps = __uint_as_float(rr[0]) + __uint_as_float(rr[1]); }
  l_reg = l_reg * alpha + ps;
#define PK4(P, BASE, OUT) do { unsigned a0 = cvtpk(P[BASE + 0], P[BASE + 1]), a1 = cvtpk(P[BASE + 2], P[BASE + 3]);   \
    unsigned b0 = cvtpk(P[BASE + 4], P[BASE + 5]), b1 = cvtpk(P[BASE + 6], P[BASE + 7]);                              \
    auto r0 = __builtin_amdgcn_permlane32_swap(a0, b0, false, false); auto r1 = __builtin_amdgcn_permlane32_swap(a1, b1, false, false); \
    u32x4 w = {r0[0], r1[0], r0[1], r1[1]}; OUT = *reinterpret_cast<bf16x8*>(&w); } while (0)
  PK4(p0, 0, pa0); PK4(p0, 8, pa1); PK4(p1, 0, pa2); PK4(p1, 8, pa3);
#undef PK4
}
template <int OFF> __device__ __forceinline__ bf16x8 k_read(int kb) {
  bf16x8 r; asm volatile("ds_read_b128 %0, %1 offset:%2" : "=v"(r) : "v"(kb), "i"(OFF) : "memory"); return r;
}
__device__ __forceinline__ void qkt(f32x16& p0, f32x16& p1, int kb, const bf16x8* qr, int qb) {
  p0 = f32x16{}; p1 = f32x16{};
#define QK1(d0) { const bf16x8 b0 = *(const __attribute__((address_space(3))) bf16x8*)(kb + d0 * KPL), b1 = *(const __attribute__((address_space(3))) bf16x8*)(kb + d0 * KPL + 1024); \
    p0 = __builtin_amdgcn_mfma_f32_32x32x16_bf16(b0, qr[d0], p0, 0, 0, 0); p1 = __builtin_amdgcn_mfma_f32_32x32x16_bf16(b1, qr[d0], p1, 0, 0, 0); }
#define QK2(d0) { const bf16x8 b0 = *(const __attribute__((address_space(3))) bf16x8*)(kb + d0 * KPL), b1 = *(const __attribute__((address_space(3))) bf16x8*)(kb + d0 * KPL + 1024); \
    const bf16x8 qf = *(const __attribute__((address_space(3))) bf16x8*)(qb + (d0 - 8) * 1024); \
    p0 = __builtin_amdgcn_mfma_f32_32x32x16_bf16(b0, qf, p0, 0, 0, 0); p1 = __builtin_amdgcn_mfma_f32_32x32x16_bf16(b1, qf, p1, 0, 0, 0); }
  QK1(0) QK1(1) QK1(2) QK1(3) QK1(4) QK1(5) QK1(6) QK1(7) QK2(8) QK2(9) QK2(10) QK2(11)
#undef QK1
#undef QK2
}
__host__ __device__ __forceinline__ int v_st(int k, int c) { const int kk = (k & ~0xC) | ((k & 4) << 1) | ((k & 8) >> 1); return ((kk >> 3) * 4 + (c >> 5)) * 512 + ((kk & 7) * 32 + (c & 31)) * 2; }
__device__ __forceinline__ int v_rd_base(int lane) { return ((lane & 3) << 3) | (((lane >> 2) & 3) << 6) | (((lane >> 4) & 1) << 5) | (((lane >> 5) & 1) << 8); }
constexpr int v_rd_off(int d0, int ks, int half) { return d0 * 512 + ks * 4096 + half * 2048; }
template <int OFF> __device__ __forceinline__ s16x4 tr_read(int vb) {
  s16x4 r; asm volatile("ds_read_b64_tr_b16 %0, %1 offset:%2" : "=&v"(r) : "v"(vb), "i"(OFF) : "memory"); return r;
}
template <int D0> __device__ __forceinline__ void pv_one(f32x16& od, int vb, bf16x8 pa0, bf16x8 pa1, bf16x8 pa2, bf16x8 pa3) {
  const s16x4 l0 = tr_read<v_rd_off(D0, 0, 0)>(vb), h0 = tr_read<v_rd_off(D0, 0, 1)>(vb), l1 = tr_read<v_rd_off(D0, 1, 0)>(vb), h1 = tr_read<v_rd_off(D0, 1, 1)>(vb);
  const s16x4 l2 = tr_read<v_rd_off(D0, 2, 0)>(vb), h2 = tr_read<v_rd_off(D0, 2, 1)>(vb), l3 = tr_read<v_rd_off(D0, 3, 0)>(vb), h3 = tr_read<v_rd_off(D0, 3, 1)>(vb);
  asm volatile("s_waitcnt lgkmcnt(0)" ::: "memory"); SBAR();
#define PK(L, H) (bf16x8){L[0], L[1], L[2], L[3], H[0], H[1], H[2], H[3]}
  od = __builtin_amdgcn_mfma_f32_32x32x16_bf16(pa0, PK(l0, h0), od, 0, 0, 0);
  od = __builtin_amdgcn_mfma_f32_32x32x16_bf16(pa1, PK(l1, h1), od, 0, 0, 0);
  od = __builtin_amdgcn_mfma_f32_32x32x16_bf16(pa2, PK(l2, h2), od, 0, 0, 0);
  od = __builtin_amdgcn_mfma_f32_32x32x16_bf16(pa3, PK(l3, h3), od, 0, 0, 0);
#undef PK
}
__device__ __forceinline__ void pv_d0(f32x16* o, int vb, bf16x8 pa0, bf16x8 pa1, bf16x8 pa2, bf16x8 pa3) {
  pv_one<0>(o[0], vb, pa0, pa1, pa2, pa3); pv_one<1>(o[1], vb, pa0, pa1, pa2, pa3); pv_one<2>(o[2], vb, pa0, pa1, pa2, pa3); pv_one<3>(o[3], vb, pa0, pa1, pa2, pa3);
}

template <bool FAST>
__device__ __forceinline__ void attn_unit(const float negMC, const bf16* __restrict__ Qb, const bf16* __restrict__ Kh, const bf16* __restrict__ Vh, bf16* __restrict__ Ob, int seq, char* lds) {
  const int tid = opq(threadIdx.x), wid = tid >> 6, lane = tid & 63, r32 = lane & 31, hi = lane >> 5;
  char* V_lds = lds; char* K_lds = lds + 2 * SHM_V;
  float* ws = (float*)(lds + 2 * SHM_V + 2 * SHM_K) + wid * 64; float* li_l = ws; float* al_l = ws + 32;
  float m_reg = -1e30f, l_reg = 0; f32x16 o[4] = {}; bf16x8 qr[8];
  const bf16* Qw = Qb + (unsigned)((wid * QBLK + r32) * LDQ + hi * 8);
#pragma unroll
  for (int d0 = 0; d0 < 8; ++d0) qr[d0] = *reinterpret_cast<const bf16x8*>(Qw + d0 * 16);
  const int qb0 = (int)(uintptr_t)lds + QR_OFF + wid * 4096 + k_rd_base(r32, hi);
#pragma unroll
  for (int d0 = 8; d0 < 12; ++d0) *(__attribute__((address_space(3))) bf16x8*)(qb0 + (d0 - 8) * 1024) = *reinterpret_cast<const bf16x8*>(Qw + d0 * 16);
  const int sr = tid >> 4, sc = (tid & 15) * 8, vst0 = v_st(sr, sc), vst1 = v_st(32 + sr, sc);
  unsigned koff[3]; int kst[3];
#pragma unroll
  for (int i = 0; i < 3; ++i) { const int q = tid + 512 * i; koff[i] = (unsigned)((q / 24) * LDK + (q % 24) * 8); kst[i] = k_st(q / 24, q % 24); }
  const unsigned voff0 = (unsigned)(sr * LDK + sc), voff1 = (unsigned)((32 + sr) * LDK + sc);
  const int vb0 = (int)(uintptr_t)V_lds + v_rd_base(lane); const int kb0 = (int)(uintptr_t)K_lds + k_rd_base(r32, hi);
  struct { bf16x8 vs0, vs1, ks0, ks1, ks2; } sr_[1];
#define SLOAD(i, k0) do { const bf16* vt = Vh + (size_t)(k0) * LDK; const bf16* kt = Kh + (size_t)(k0) * LDK; \
    sr_[i].vs0 = *(const bf16x8*)(vt + voff0); sr_[i].vs1 = *(const bf16x8*)(vt + voff1); \
    sr_[i].ks0 = *(const bf16x8*)(kt + koff[0]); sr_[i].ks1 = *(const bf16x8*)(kt + koff[1]); sr_[i].ks2 = *(const bf16x8*)(kt + koff[2]); } while (0)
#define SWRITE(b, i) do { *(bf16x8*)(V_lds + (b) * SHM_V + vst0) = sr_[i].vs0; *(bf16x8*)(V_lds + (b) * SHM_V + vst1) = sr_[i].vs1; \
    *(bf16x8*)(K_lds + (b) * SHM_K + kst[0]) = sr_[i].ks0; *(bf16x8*)(K_lds + (b) * SHM_K + kst[1]) = sr_[i].ks1; *(bf16x8*)(K_lds + (b) * SHM_K + kst[2]) = sr_[i].ks2; } while (0)
#define SWAIT() do { if constexpr (SDEPTH == 2) asm volatile("s_waitcnt vmcnt(5)" ::: "memory"); else asm volatile("s_waitcnt vmcnt(0)" ::: "memory"); } while (0)
#define RESC(a) do { if (__any((a) < 1.f)) { if (hi == 0) al_l[r32] = (a); asm volatile("s_waitcnt lgkmcnt(0)" ::: "memory"); \
    _Pragma("unroll") for (int d = 0; d < 4; ++d) _Pragma("unroll") for (int r = 0; r < 16; ++r) o[d][r] *= al_l[crow(r, hi)]; } } while (0)
  f32x16 pA0, pA1, pB0, pB1; float mnA, mnB, alA, alB; bf16x8 pa0, pa1, pa2, pa3; const int NT = seq / KVBLK;
#define PSM(P0, P1, MN, AL) do { if constexpr (FAST) { partialSM_fast(P0, P1, negMC); AL = 1.f; } else partialSM(P0, P1, m_reg, MN, AL); } while (0)
#define RSC(AL) do { if constexpr (!FAST) RESC(AL); } while (0)
  SLOAD(0, 0); asm volatile("s_waitcnt vmcnt(0)" ::: "memory"); SWRITE(0, 0); __syncthreads();
  qkt(pA0, pA1, kb0, qr, qb0); PSM(pA0, pA1, mnA, alA);
  SLOAD(0, KVBLK);
  asm volatile("s_waitcnt vmcnt(0)" ::: "memory"); SWRITE(1, 0); __syncthreads();
  for (int j = 1; j + 1 < NT; j += 2) {
    SBAR(); qkt(pB0, pB1, kb0 + SHM_K, qr, qb0);
    finishSM(pA0, pA1, alA, l_reg, pa0, pa1, pa2, pa3); SBAR();
    SLOAD(0, (j + 1) * KVBLK); SBAR();
    pv_d0(o, vb0, pa0, pa1, pa2, pa3); PSM(pB0, pB1, mnB, alB);
    __syncthreads(); asm volatile("s_waitcnt vmcnt(0)" ::: "memory"); SWRITE(0, 0);
    RSC(alB); __syncthreads();
    SBAR(); qkt(pA0, pA1, kb0, qr, qb0);
    finishSM(pB0, pB1, alB, l_reg, pa0, pa1, pa2, pa3); SBAR();
    SLOAD(0, (j + 2) * KVBLK); SBAR();
    pv_d0(o, vb0 + (int)SHM_V, pa0, pa1, pa2, pa3); PSM(pA0, pA1, mnA, alA);
    __syncthreads(); asm volatile("s_waitcnt vmcnt(0)" ::: "memory"); SWRITE(1, 0);
    RSC(alA); __syncthreads();
  }
  SBAR(); qkt(pB0, pB1, kb0 + SHM_K, qr, qb0);
  finishSM(pA0, pA1, alA, l_reg, pa0, pa1, pa2, pa3); SBAR();
  pv_d0(o, vb0, pa0, pa1, pa2, pa3); PSM(pB0, pB1, mnB, alB);
  __syncthreads(); RSC(alB);
  finishSM(pB0, pB1, alB, l_reg, pa0, pa1, pa2, pa3); SBAR();
  pv_d0(o, vb0 + (int)SHM_V, pa0, pa1, pa2, pa3);
  if (hi == 0) li_l[r32] = l_reg; asm volatile("s_waitcnt lgkmcnt(0)" ::: "memory");
  bf16* Ow = Ob + (unsigned)(wid * QBLK * LDO + r32);
#pragma unroll
  for (int r = 0; r < 16; ++r) { const int orow = crow(r, hi); const float rl = __builtin_amdgcn_rcpf(li_l[orow]);
#pragma unroll
    for (int d0 = 0; d0 < 4; ++d0) { const unsigned w = cvtpk(o[d0][r] * rl, 0.f); Ow[(unsigned)(orow * LDO + d0 * 32)] = (bf16)(w & 0xffffu); } }
  __syncthreads();
#undef SLOAD
#undef SWRITE
#undef SWAIT
#undef RESC
#undef PSM
#undef RSC
}
}
namespace hy {
#define HY_LAS __attribute__((address_space(3)))
typedef unsigned short bf16;
typedef short bf16x8 __attribute__((ext_vector_type(8)));
typedef float f32x16 __attribute__((ext_vector_type(16)));
typedef unsigned u32x2 __attribute__((ext_vector_type(2)));
typedef unsigned u32x4 __attribute__((ext_vector_type(4)));
constexpr int L = 2048, NB = 24, CH = 512;
constexpr int RFS = 4112;
constexpr int ZROW = 4112;
constexpr int ZL_BYTES = NB * ZROW;
constexpr int RCS = 8256;
constexpr int RC_OFF = ZL_BYTES;
constexpr int HY_LDS_BYTES = RC_OFF + 4 * RCS;
__device__ __forceinline__ unsigned cvtpk(float lo, float hi) { unsigned r; asm volatile("v_cvt_pk_bf16_f32 %0, %1, %2" : "=v"(r) : "v"(lo), "v"(hi)); return r; }
__host__ __device__ __forceinline__ int frag_base(int tw, int r, int h) { const int a = (4 - (r & 3)) & 3; return RC_OFF + a * RCS + 2 * (2048 - tw - r + 8 * h - a); }
__host__ __device__ __forceinline__ int zfrag_base(int r, int h) { return (r < NB ? r : NB - 1) * ZROW + 16 * h; }

__device__ __forceinline__ bf16x8 ld_frag(HY_LAS unsigned char* lds, int off) {
    const u32x2 lo = *(const HY_LAS u32x2*)(lds + off), hi = *(const HY_LAS u32x2*)(lds + off + 8);
    u32x4 w = {lo.x, lo.y, hi.x, hi.y}; return *reinterpret_cast<bf16x8*>(&w);
}
__device__ __forceinline__ bf16x8 ld_b128(HY_LAS unsigned char* lds, int off) { return *(const HY_LAS bf16x8*)(lds + off); }

__device__ __forceinline__ void conv_unit(HY_LAS unsigned char* lds, const bf16* __restrict__ ZT, const bf16* __restrict__ RF, bf16* __restrict__ YC, int c, int half) {
    const int tid = opq(threadIdx.x), wid = tid >> 6, lane = tid & 63, r = lane & 31, h = lane >> 5;
    { const u32x4* src = (const u32x4*)(ZT + (size_t)c * NB * L);
#pragma unroll
      for (int i = 0; i < 12; ++i) { const int q = tid + 512 * i; const u32x4 v = src[q]; *(HY_LAS u32x4*)(lds + (q >> 8) * ZROW + (q & 255) * 16) = v; } }
    { const bf16* rf = RF + (size_t)c * RFS;
      for (int ch = tid; ch < RFS / 8; ch += 512) {
          const u32x4 v = *(const u32x4*)(rf + ch * 8); const unsigned w[4] = {v.x, v.y, v.z, v.w};
#pragma unroll
          for (int j = 0; j < 8; ++j) { const unsigned short e = (unsigned short)((w[j >> 1] >> ((j & 1) * 16)) & 0xffffu); const int idx = ch * 8 + j;
#pragma unroll
              for (int a = 0; a < 4; ++a) if (idx - a >= 0) *(HY_LAS unsigned short*)(lds + RC_OFF + a * RCS + 2 * (idx - a)) = e; } } }
    __syncthreads();
    const int tw = half * 1024 + wid * 128;
    const int fb = frag_base(tw, r, h), zb = zfrag_base(r, h);
    f32x16 acc[4] = {};
    bf16x8 S0[2], S1[2], S2[2], S3[2], Bc[2], Bn[2];
#define HY_LDG(S, d) do { S[0] = ld_frag(lds, fb + 64 * (d)); S[1] = ld_frag(lds, fb + 64 * (d) + 32); } while (0)
#define HY_LDB(Bx, n) do { Bx[0] = ld_b128(lds, zb + 64 * (n)); Bx[1] = ld_b128(lds, zb + 64 * (n) + 32); } while (0)
#define HY_MM(i, S, Bx) do { acc[i] = __builtin_amdgcn_mfma_f32_32x32x16_bf16(S[0], Bx[0], acc[i], 0, 0, 0); acc[i] = __builtin_amdgcn_mfma_f32_32x32x16_bf16(S[1], Bx[1], acc[i], 0, 0, 0); } while (0)
#define HY_ITER(n, Sa, Sb, Sc, Sd, Bcur, Bnext) do { HY_LDG(Sa, (n)); if ((n) + 1 < 64) HY_LDB(Bnext, (n) + 1); \
        HY_MM(1, Sb, Bcur); HY_MM(2, Sc, Bcur); HY_MM(3, Sd, Bcur); HY_MM(0, Sa, Bcur); } while (0)
    HY_LDG(S3, -1); HY_LDG(S2, -2); HY_LDG(S1, -3); HY_LDB(Bc, 0);
    for (int n = 0; n < 64; n += 4) {
        HY_ITER(n, S0, S3, S2, S1, Bc, Bn);
        HY_ITER(n + 1, S1, S0, S3, S2, Bn, Bc);
        HY_ITER(n + 2, S2, S1, S0, S3, Bc, Bn);
        HY_ITER(n + 3, S3, S2, S1, S0, Bn, Bc);
    }
#undef HY_LDG
#undef HY_LDB
#undef HY_MM
#undef HY_ITER
    if (r < NB) { bf16* yp = YC + ((size_t)c * NB + r) * L + tw + 4 * h;
#pragma unroll
        for (int i = 0; i < 4; ++i)
#pragma unroll
            for (int q4 = 0; q4 < 4; ++q4) { u32x2 w; w.x = cvtpk(acc[i][4 * q4 + 0], acc[i][4 * q4 + 1]); w.y = cvtpk(acc[i][4 * q4 + 2], acc[i][4 * q4 + 3]);
                *(u32x2*)(yp + 32 * i + 8 * q4) = w; } }
    __syncthreads();
}
}
constexpr int NWAVES = 8;
#ifndef MK_ONE_LAUNCH
#define MK_ONE_LAUNCH 1
#endif
constexpr int DM = 2048, NSEQ = 24, SEQ = 2048, M = NSEQ * SEQ, MP = 8 * SEQ;
constexpr int DEPTH = 4;
constexpr int DIN = 2880, DINP = 3072;
constexpr int O_CQ = 512, O_CKV = 1024, O_KPE = 1280, O_HY = 1344;
constexpr int NH = 8, NQ = 1536, NKVP = 2560, KVHS = 320;
constexpr int DFF = 5632, NUP = 11264, HYC = 512;
constexpr float EPS = 1e-6f;
constexpr int NPH = 11;
constexpr size_t WS_CTL = 0, CTL_BYTES = 1u << 20;
constexpr size_t SZ_BTIN = (size_t)DINP * DM * 2, SZ_BTUQ = (size_t)NQ * 512 * 2, SZ_BTKV = (size_t)NKVP * 256 * 2, SZ_BTOUT = (size_t)DM * DM * 2, SZ_BTUP = (size_t)NUP * DM * 2, SZ_BTDN = (size_t)DM * DFF * 2;
constexpr size_t WS_BTIN = WS_CTL + CTL_BYTES, WS_BTUQ = WS_BTIN + SZ_BTIN, WS_BTKV = WS_BTUQ + SZ_BTUQ, WS_BTOUT = WS_BTKV + SZ_BTKV, WS_BTUP = WS_BTOUT + SZ_BTOUT, WS_BTDN = WS_BTUP + SZ_BTUP;
constexpr size_t WS_RF = WS_BTDN + SZ_BTDN, SZ_RF = (size_t)HYC * hy::RFS * 2;
constexpr size_t WS_H = WS_RF + SZ_RF, SZ_H = (size_t)M * DM * 2;
constexpr size_t WS_PROJ = WS_H + SZ_H, SZ_PROJ = (size_t)M * DINP * 2;
constexpr size_t WS_Q = WS_PROJ + SZ_PROJ, SZ_Q = (size_t)M * NQ * 2;
constexpr size_t WS_KV = WS_Q + SZ_Q, SZ_KV = (size_t)M * NKVP * 2;
constexpr size_t WS_ZT = WS_KV + SZ_KV, SZ_ZT = (size_t)HYC * NSEQ * SEQ * 2;
constexpr size_t WS_X0 = WS_ZT + SZ_ZT, WS_YC = WS_X0 + SZ_ZT;
constexpr size_t WS_EDGE = WS_YC + SZ_ZT, SZ_EDGE = (size_t)(M / 256) * 2 * 3 * DFF * 4;
constexpr size_t WS_ROPE = WS_EDGE + SZ_EDGE, SZ_ROPE = (size_t)SEQ * 64 * 4;
constexpr size_t WS_SSQP = WS_ROPE + SZ_ROPE, SZ_SSQP = (size_t)M * 32 * 4;
constexpr size_t WS_RSTD = WS_SSQP + SZ_SSQP, SZ_RSTD = (size_t)M * 4;
constexpr size_t WS_END = WS_RSTD + SZ_RSTD;
constexpr size_t WS_ACT = WS_PROJ;
static_assert((size_t)M * DFF * 2 <= SZ_PROJ + SZ_Q + SZ_KV, "ACT overlay");
constexpr size_t WS_XB2 = WS_ACT + (size_t)M * DFF * 2;
static_assert(WS_XB2 + (size_t)M * DM * 2 <= WS_EDGE && WS_XB2 % 256 == 0, "XB2 overlay");
static_assert(WS_BTIN % 256 == 0 && WS_RF % 256 == 0 && WS_H % 256 == 0 && WS_PROJ % 256 == 0 && WS_Q % 256 == 0 && WS_KV % 256 == 0 && WS_ZT % 256 == 0 && WS_EDGE % 256 == 0, "alignment");
constexpr int CW_BAR = 4096;
constexpr int RING_BYTES = 135168;
constexpr int HALO_OFF = RING_BYTES, HALO_BYTES = 4096;
constexpr int MISC_OFF = HALO_OFF + HALO_BYTES;
constexpr int LDS_BYTES = 147456;
static_assert(hy::HY_LDS_BYTES <= RING_BYTES && at::SHM_ATTN <= RING_BYTES && MISC_OFF + 256 <= LDS_BYTES, "LDS map");

#define GAS __attribute__((address_space(1)))
#define LAS __attribute__((address_space(3)))
typedef unsigned short bf16;
typedef unsigned v4u __attribute__((ext_vector_type(4)));
typedef unsigned v2u __attribute__((ext_vector_type(2)));
typedef float f32x4 __attribute__((ext_vector_type(4)));
#define LDS_WAIT() asm volatile("s_waitcnt lgkmcnt(0)" ::: "memory")
__device__ __forceinline__ unsigned f2bf(float f) { unsigned u = __builtin_bit_cast(unsigned, f); return (u + 0x7fffu + ((u >> 16) & 1u)) >> 16; }
__device__ __forceinline__ unsigned pk2(float lo, float hi) { return f2bf(lo) | (f2bf(hi) << 16); }
__device__ __forceinline__ float bf2f(unsigned short b) { return __builtin_bit_cast(float, (unsigned)b << 16); }
__device__ __forceinline__ float bflo(unsigned w) { return __builtin_bit_cast(float, w << 16); }
__device__ __forceinline__ float bfhi(unsigned w) { return __builtin_bit_cast(float, w & 0xffff0000u); }
__device__ __forceinline__ float wave_sum(float v) {
#pragma unroll
    for (int o = 1; o < 64; o <<= 1) v += __shfl_xor(v, o);
    return v;
}

#define XB_TMO      128
#define XB_XCNT(j)  (256  + 64 * (j))
#define XB_XSUB(j)  (1280 + 64 * (j))
#define XB_XGEN(j)  (2304 + 64 * (j))
#define XB_TOP      3328
#define XB_TOPGEN   3392
#define XCD_BAR_WORDS 3456
#define XB_SPIN_CAP (1u << 18)
__device__ __forceinline__ unsigned xb_ld(unsigned* p)              { return __hip_atomic_load(p, __ATOMIC_RELAXED, __HIP_MEMORY_SCOPE_AGENT); }
__device__ __forceinline__ unsigned xb_add(unsigned* p, unsigned v) { return __hip_atomic_fetch_add(p, v, __ATOMIC_RELAXED, __HIP_MEMORY_SCOPE_AGENT); }
__device__ __forceinline__ unsigned xb_xcc_id() { return (unsigned)__builtin_amdgcn_s_getreg((3 << 11) | 20) & 0xFu; }
#define XB_SPIN(cond, bar) do { unsigned _sp = 0; while (cond) { __builtin_amdgcn_s_sleep(1); \
    if ((++_sp & 255u) == 0u) { if (xb_ld(&(bar)[XB_TMO])) break; if (_sp > XB_SPIN_CAP) { atomicAdd(&(bar)[XB_TMO], 1u); break; } } } } while (0)
struct XcdBarrier { unsigned* bar; unsigned x; volatile LAS unsigned* st; };
__device__ __forceinline__ XcdBarrier xcd_barrier_post(unsigned* bar, volatile LAS unsigned* st) {
    XcdBarrier b; b.bar = bar; b.x = xb_xcc_id(); b.st = st;
    if (threadIdx.x == 0) (void)xb_add(&bar[XB_XCNT(b.x)], 1u);
    return b;
}
__device__ __forceinline__ void xcd_barrier_complete(unsigned* bar, unsigned x, unsigned& nloc, unsigned& nx) {
    const unsigned G = gridDim.x * gridDim.y * gridDim.z;
    unsigned sum, cnt, mine, sp = 0u;
    for (;;) {
        sum = 0u; cnt = 0u; mine = 0u;
#pragma unroll
        for (unsigned j = 0; j < 16; ++j) { const unsigned c = xb_ld(&bar[XB_XCNT(j)]); sum += c; cnt += (c > 0u) ? 1u : 0u; mine = (j == x) ? c : mine; }
        if (sum == G) break;
        __builtin_amdgcn_s_sleep(1);
        if ((++sp & 255u) == 0u) { if (xb_ld(&bar[XB_TMO])) break; if (sp > XB_SPIN_CAP) { atomicAdd(&bar[XB_TMO], 1u); break; } }
    }
    nloc = mine > 0u ? mine : 1u; nx = cnt > 0u ? cnt : 1u;
}
__device__ __forceinline__ void xcd_barrier(const XcdBarrier& b) {
    asm volatile("s_waitcnt vmcnt(0)" ::: "memory");
    __syncthreads();
    if (threadIdx.x == 0) {
        unsigned* bar = b.bar;
        __builtin_amdgcn_s_waitcnt(0);
        unsigned nloc = b.st[0], nx = b.st[1];
        if (nloc == 0u) { xcd_barrier_complete(bar, b.x, nloc, nx); b.st[0] = nloc; b.st[1] = nx; }
        const unsigned old = xb_add(&bar[XB_XSUB(b.x)], 1u);
        const unsigned gen = old / nloc;
        if (old + 1u == (gen + 1u) * nloc) {
            __builtin_amdgcn_fence(__ATOMIC_RELEASE, "agent");
            asm volatile("s_waitcnt vmcnt(0)" ::: "memory");
            const unsigned og = xb_add(&bar[XB_TOP], 1u);
            const unsigned tg = og / nx;
            if (og + 1u == (tg + 1u) * nx) xb_add(&bar[XB_TOPGEN], 1u);
            else XB_SPIN(xb_ld(&bar[XB_TOPGEN]) == tg, bar);
            __builtin_amdgcn_fence(__ATOMIC_ACQUIRE, "agent");
            xb_add(&bar[XB_XGEN(b.x)], 1u);
            asm volatile("s_waitcnt vmcnt(0)" ::: "memory");
        } else {
            XB_SPIN(xb_ld(&bar[XB_XGEN(b.x)]) == gen, bar);
            __builtin_amdgcn_fence(__ATOMIC_ACQUIRE, "agent");
            asm volatile("s_waitcnt vmcnt(0)" ::: "memory");
        }
    }
    __syncthreads();
}

struct Frame {
    LAS unsigned char* lds;
    int tid, lane, wave, vcu, G;
};
enum { I_XP = 0, I_XS, I_ANG, I_WIN, I_PW, I_PS, I_QNG, I_WUQ, I_KVNG, I_WUKV, I_QHG, I_KHG, I_HCW, I_HCB, I_FW1, I_FB1, I_FFR, I_FW2, I_FB2, I_FW3, I_FB3, I_HBIAS, I_GNG, I_WOUT, I_FNG, I_WUP, I_FCW, I_FCB, I_WDN, N_IN };
struct Args { const float* in[N_IN]; float* out; unsigned char* ws; int ph_lo, ph_hi; };
static_assert(sizeof(Args) == (N_IN + 2) * 8 + 8, "Args has no padding");

__device__ __forceinline__ void cvt_item(const float* __restrict__ W, int ldw, int K, bf16* WT, int dst_n0, int src_n0, int k0, const float* __restrict__ ks, LAS float* scr, int lane) {
#pragma unroll
    for (int i = 0; i < 32; ++i) { const int kk = 2 * i + (lane >> 5); float v = W[(size_t)(k0 + kk) * ldw + src_n0 + (lane & 31)]; if (ks) v *= ks[k0 + kk]; scr[kk * 33 + (lane & 31)] = v; }
    LDS_WAIT(); asm volatile("" ::: "memory");
    const int c = lane & 7;
#pragma unroll
    for (int j = 0; j < 4; ++j) { const int n = (lane >> 3) + 8 * j; const LAS float* s = scr + (8 * c) * 33 + n;
        v4u o; o.x = pk2(s[0 * 33], s[1 * 33]); o.y = pk2(s[2 * 33], s[3 * 33]); o.z = pk2(s[4 * 33], s[5 * 33]); o.w = pk2(s[6 * 33], s[7 * 33]);
        *(v4u*)(WT + (size_t)(dst_n0 + n) * K + k0 + 8 * c) = o; }
    LDS_WAIT(); asm volatile("" ::: "memory");
}
struct CvtTile { const float* W; const float* ks; bf16* WT; int ldw, K, src_n0, k0, ncols; int dst[4]; };
__device__ __forceinline__ void cvt_tile(Frame& F, const CvtTile& d) {
    LAS float* T = (LAS float*)F.lds;
#pragma unroll
    for (int i = 0; i < 8; ++i) { const int q = F.tid + 512 * i, row = q >> 5, c4 = q & 31;
        f32x4 v = {0.f, 0.f, 0.f, 0.f};
        if (d.src_n0 + 4 * c4 < d.ncols) v = *(const f32x4*)(d.W + (size_t)(d.k0 + row) * d.ldw + d.src_n0 + 4 * c4);
        if (d.ks) v *= d.ks[d.k0 + row];
        LAS float* t = T + row * 129 + 4 * c4; t[0] = v.x; t[1] = v.y; t[2] = v.z; t[3] = v.w; }
    __syncthreads();
#pragma unroll
    for (int i = 0; i < 4; ++i) { const int n = (F.tid >> 4) + 32 * i, kc = F.tid & 15;
        if (d.src_n0 + n < d.ncols) { const LAS float* s = T + (8 * kc) * 129 + n;
            v4u o; o.x = pk2(s[0], s[129]); o.y = pk2(s[2 * 129], s[3 * 129]); o.z = pk2(s[4 * 129], s[5 * 129]); o.w = pk2(s[6 * 129], s[7 * 129]);
            *(v4u*)(d.WT + (size_t)(d.dst[i] + (n & 31)) * d.K + d.k0 + 8 * kc) = o; } }
    __syncthreads();
}
__device__ __forceinline__ void xb_row(const float* xrow, bf16* orow, float* rstd, int lane) {
    const f32x4* xr = (const f32x4*)xrow + lane;
    f32x4 v[8]; float s = 0.f;
#pragma unroll
    for (int j = 0; j < 8; ++j) { v[j] = xr[64 * j]; s += (v[j].x * v[j].x + v[j].y * v[j].y) + (v[j].z * v[j].z + v[j].w * v[j].w); }
    const float r = 1.0f / sqrtf(wave_sum(s) * (1.f / DM) + EPS);
    if (lane == 0) *rstd = r;
    v2u* o8 = (v2u*)orow + lane;
#pragma unroll
    for (int j = 0; j < 8; ++j) { v2u w; w.x = pk2(v[j].x, v[j].y); w.y = pk2(v[j].z, v[j].w); o8[64 * j] = w; }
}
__device__ __forceinline__ void rstd_from_partials(const float* __restrict__ ssqp, float* rstd, size_t gtid, size_t gthreads) {
    for (size_t r = gtid; r < (size_t)M; r += gthreads) { const f32x4* p = (const f32x4*)(ssqp + r * 32); f32x4 a = p[0];
#pragma unroll
        for (int i = 1; i < 8; ++i) a += p[i];
        rstd[r] = 1.0f / sqrtf(((a.x + a.y) + (a.z + a.w)) * (1.f / DM) + EPS); }
}
__device__ __forceinline__ void tile_norm_store(LAS float* tile, bf16* dst, int row0, int col_off, int wave, int lane) {
#pragma unroll
    for (int i = 0; i < 8; ++i) { const int t = wave * 8 + i;
        const f32x4 a = *(LAS f32x4*)(tile + t * 512 + 8 * lane), b = *(LAS f32x4*)(tile + t * 512 + 8 * lane + 4);
        const float s = (a.x * a.x + a.y * a.y) + (a.z * a.z + a.w * a.w) + (b.x * b.x + b.y * b.y) + (b.z * b.z + b.w * b.w);
        const float rstd = 1.0f / sqrtf(wave_sum(s) * (1.f / 512.f) + EPS);
        v4u o; o.x = pk2(a.x * rstd, a.y * rstd); o.y = pk2(a.z * rstd, a.w * rstd); o.z = pk2(b.x * rstd, b.y * rstd); o.w = pk2(b.z * rstd, b.w * rstd);
        *(v4u*)(dst + (size_t)(row0 + t) * DM + col_off + 8 * lane) = o; }
}
__device__ __forceinline__ void poolfold_item(Frame& F, const float* __restrict__ win, const float* __restrict__ pw, const float* __restrict__ ps, const float* __restrict__ g1, bf16* BtIn, int g, int kb) {
    LAS float* At = (LAS float*)F.lds; LAS float* Bt = (LAS float*)(F.lds + 32768);
    const int k0 = 64 * kb;
#pragma unroll
    for (int i = 0; i < 4; ++i) { const int q = F.tid + 512 * i, row = q >> 5, c4 = q & 31; *(LAS f32x4*)(At + row * 128 + 4 * c4) = *(const f32x4*)(win + (size_t)(k0 + row) * DIN + 128 * g + 4 * c4) * g1[k0 + row]; }
#pragma unroll
    for (int i = 0; i < 8; ++i) { const int q = F.tid + 512 * i, row = q >> 5, c4 = q & 31; *(LAS f32x4*)(Bt + row * 128 + 4 * c4) = *(const f32x4*)(pw + (size_t)(g * 128 + row) * 128 + 4 * c4); }
    __syncthreads();
    const int n = F.tid & 127, kg = F.tid >> 7;
    float acc[16];
#pragma unroll
    for (int i = 0; i < 16; ++i) acc[i] = 0.f;
    for (int j = 0; j < 128; j += 4) {
        const float b0 = Bt[(j + 0) * 128 + n], b1 = Bt[(j + 1) * 128 + n], b2 = Bt[(j + 2) * 128 + n], b3 = Bt[(j + 3) * 128 + n];
#pragma unroll
        for (int i = 0; i < 16; ++i) { const f32x4 a = *(LAS f32x4*)(At + (kg * 16 + i) * 128 + j); acc[i] += a.x * b0 + a.y * b1 + a.z * b2 + a.w * b3; }
    }
    const float sc = ps[128 * g + n];
    v4u o0, o1;
    o0.x = pk2(acc[0] * sc, acc[1] * sc); o0.y = pk2(acc[2] * sc, acc[3] * sc); o0.z = pk2(acc[4] * sc, acc[5] * sc); o0.w = pk2(acc[6] * sc, acc[7] * sc);
    o1.x = pk2(acc[8] * sc, acc[9] * sc); o1.y = pk2(acc[10] * sc, acc[11] * sc); o1.z = pk2(acc[12] * sc, acc[13] * sc); o1.w = pk2(acc[14] * sc, acc[15] * sc);
    bf16* dst = BtIn + (size_t)(128 * g + n) * DM + k0 + kg * 16;
    *(v4u*)dst = o0; *(v4u*)(dst + 8) = o1;
    __syncthreads();
}
__device__ __forceinline__ void filter_item(Frame& F, const float* __restrict__ w1, const float* __restrict__ b1, const float* __restrict__ fr, const float* __restrict__ w2, const float* __restrict__ b2,
                                            const float* __restrict__ w3, const float* __restrict__ b3, const float* __restrict__ hbias, bf16* RF, int fi) {
    LAS float* ZF = (LAS float*)F.lds; LAS float* H1 = ZF + 512; LAS float* H2 = ZF + 1536; LAS float* W1s = ZF + 2560; LAS float* W2s = ZF + 3712;
    const int t0 = 16 * fi;
    for (int q = F.tid; q < 272; q += 512) *(LAS f32x4*)(W1s + 4 * q) = *(const f32x4*)(w1 + 4 * q);
#pragma unroll
    for (int i = 0; i < 2; ++i) { const int q = F.tid + 512 * i; *(LAS f32x4*)(W2s + 4 * q) = *(const f32x4*)(w2 + 4 * q); }
    if (F.tid < 272) { const int tt = F.tid / 17, f = F.tid % 17; const float t = (float)(t0 + tt);
        float v;
        if (f == 0) v = t / 2047.0f;
        else { const int j = (f - 1) & 7; const float band = 1e-4f + (float)j * ((7.0f - 1e-4f) / 7.0f); const float w = (6.283185307179586f * t) / 2048.0f; const float a = band * w; v = (f <= 8) ? __cosf(a) : -__sinf(a); }
        ZF[tt * 17 + f] = v; }
    __syncthreads();
#pragma unroll
    for (int rep = 0; rep < 2; ++rep) { const int p = F.tid + 512 * rep, tt = p >> 6, j = p & 63; float s = b1[j];
#pragma unroll
        for (int i = 0; i < 17; ++i) s += ZF[tt * 17 + i] * W1s[i * 64 + j];
        H1[tt * 64 + j] = __sinf(fr[j] * s); }
    __syncthreads();
#pragma unroll
    for (int rep = 0; rep < 2; ++rep) { const int p = F.tid + 512 * rep, tt = p >> 6, j = p & 63; float s = b2[j];
#pragma unroll 16
        for (int i = 0; i < 64; ++i) s += H1[tt * 64 + i] * W2s[i * 64 + j];
        H2[tt * 64 + j] = __sinf(fr[j] * s); }
    __syncthreads();
    const int c = F.tid;
    const float delta = -3.0701134573253944f + (float)c * ((-15.350567286626972f + 3.0701134573253944f) / 511.0f);
    const float ad = fabsf(delta);
    bf16* rf = RF + (size_t)c * hy::RFS;
#pragma unroll 1
    for (int dir = 0; dir < 2; ++dir) { const int o = dir * 512 + c; const float bo = b3[o];
        float wc[64];
#pragma unroll
        for (int i = 0; i < 64; ++i) wc[i] = w3[i * 1024 + o];
#pragma unroll 1
        for (int tt = 0; tt < 16; ++tt) { float s = bo;
#pragma unroll
            for (int i = 0; i < 64; i += 4) { const f32x4 hv = *(LAS f32x4*)(H2 + tt * 64 + i); s += (hv.x * wc[i] + hv.y * wc[i + 1]) + (hv.z * wc[i + 2] + hv.w * wc[i + 3]); }
            const int t = t0 + tt; const float tl = (float)t / 2047.0f; float val = s * __expf(-tl * ad);
            if (dir == 0) { if (t == 0) val += hbias[c]; rf[2048 - t] = (bf16)f2bf(val); }
            else if (t >= 1) rf[2048 + t] = (bf16)f2bf(val); } }
    if (fi == 0) { rf[0] = 0;
#pragma unroll
        for (int i = 4096; i < hy::RFS; ++i) rf[i] = 0; }
    __syncthreads();
}
__device__ __forceinline__ void unpack4(const v2u w, float (&x)[4]) { x[0] = bflo(w.x); x[1] = bfhi(w.x); x[2] = bflo(w.y); x[3] = bfhi(w.y); }
__device__ __forceinline__ void pair_norm_store(Frame& F, const float (&y)[8][4], bf16* dst, size_t row0, int col_off, int cq) {
    LAS float* part = (LAS float*)F.lds;
    float ss[8];
#pragma unroll
    for (int k = 0; k < 8; ++k) ss[k] = wave_sum((y[k][0] * y[k][0] + y[k][1] * y[k][1]) + (y[k][2] * y[k][2] + y[k][3] * y[k][3]));
    if (F.lane == 0) { *(LAS f32x4*)(part + F.wave * 8) = (f32x4){ss[0], ss[1], ss[2], ss[3]}; *(LAS f32x4*)(part + F.wave * 8 + 4) = (f32x4){ss[4], ss[5], ss[6], ss[7]}; }
    __syncthreads();
    const f32x4 pa = *(LAS f32x4*)(part + (F.wave ^ 1) * 8), pb = *(LAS f32x4*)(part + (F.wave ^ 1) * 8 + 4);
    const float po[8] = {pa.x, pa.y, pa.z, pa.w, pb.x, pb.y, pb.z, pb.w};
#pragma unroll
    for (int k = 0; k < 8; ++k) { const float rstd = 1.0f / sqrtf((ss[k] + po[k]) * (1.f / 512.f) + EPS);
        v2u o; o.x = pk2(y[k][0] * rstd, y[k][1] * rstd); o.y = pk2(y[k][2] * rstd, y[k][3] * rstd);
        *(v2u*)(dst + (row0 + k) * DM + col_off + 4 * cq) = o; }
    __syncthreads();
}
__device__ __forceinline__ void hyprep_item(Frame& F, const bf16* __restrict__ PROJ, const float* __restrict__ cw, const float* __restrict__ cb, bf16* ZT, bf16* X0, int b, int tile) {
    const int tb = F.tid >> 7, cq = F.tid & 127, c0 = 4 * cq, tw = tile * 32 + tb * 8; const size_t rb = (size_t)b * SEQ;
    float z[8][4];
#pragma unroll
    for (int jj = 0; jj < 3; ++jj) { const int j = (jj == 0) ? 1 : (jj == 1) ? 2 : 0; const int cc = 512 * j + c0;
        const f32x4 w0 = *(const f32x4*)(cw + cc), w1 = *(const f32x4*)(cw + 1536 + cc), w2 = *(const f32x4*)(cw + 3072 + cc), bs = *(const f32x4*)(cb + cc);
        float x[10][4];
#pragma unroll
        for (int o = 0; o < 10; ++o) { const int t = tw - 1 + o; const bool ok = (t >= 0) && (t < SEQ); const int tc = ok ? t : tw;
            const v2u w = *(const v2u*)(PROJ + (rb + tc) * DINP + O_HY + cc); unpack4(w, x[o]);
            if (!ok) { x[o][0] = 0.f; x[o][1] = 0.f; x[o][2] = 0.f; x[o][3] = 0.f; } }
        if (jj == 0) {
#pragma unroll
            for (int k = 0; k < 8; ++k)
#pragma unroll
                for (int i = 0; i < 4; ++i) z[k][i] = w0[i] * x[k][i] + w1[i] * x[k + 1][i] + w2[i] * x[k + 2][i] + bs[i];
        } else if (jj == 1) {
#pragma unroll
            for (int k = 0; k < 8; ++k)
#pragma unroll
                for (int i = 0; i < 4; ++i) z[k][i] *= w0[i] * x[k][i] + w1[i] * x[k + 1][i] + w2[i] * x[k + 2][i] + bs[i];
#pragma unroll
            for (int i = 0; i < 4; ++i) { v4u o; o.x = pk2(z[0][i], z[1][i]); o.y = pk2(z[2][i], z[3][i]); o.z = pk2(z[4][i], z[5][i]); o.w = pk2(z[6][i], z[7][i]);
                *(v4u*)(ZT + ((size_t)(c0 + i) * NSEQ + b) * SEQ + tw) = o; }
        } else {
#pragma unroll
            for (int k = 0; k < 8; ++k) { float u0[4];
#pragma unroll
                for (int i = 0; i < 4; ++i) u0[i] = w0[i] * x[k][i] + w1[i] * x[k + 1][i] + w2[i] * x[k + 2][i] + bs[i];
                v2u o; o.x = pk2(u0[0], u0[1]); o.y = pk2(u0[2], u0[3]); *(v2u*)(X0 + (rb + tw + k) * HYC + c0) = o; }
        }
    }
}
__device__ __forceinline__ void pool_item(Frame& F, const bf16* __restrict__ PROJ, bf16* MIXED, int b, int tile) {
    const int tb = F.tid >> 7, cq = F.tid & 127, c0 = 4 * cq, g = cq >> 5, half = 1 << g, tw = tile * 32 + tb * 8; const size_t rb = (size_t)b * SEQ;
    float x[23][4];
#pragma unroll
    for (int o = 0; o < 23; ++o) { const int t = tw - 8 + o; const bool ok = (t >= 0) && (t < SEQ); const int tc = ok ? t : tw;
        const v2u w = *(const v2u*)(PROJ + (rb + tc) * DINP + c0); unpack4(w, x[o]);
        if (!ok) { x[o][0] = 0.f; x[o][1] = 0.f; x[o][2] = 0.f; x[o][3] = 0.f; } }
    float y[8][4];
#pragma unroll
    for (int k = 0; k < 8; ++k) { const int oc = 8 + k, t = tw + k; const int lo = (t - half > 0) ? t - half : 0, hi = (t + half < SEQ) ? t + half : SEQ; const float inv = 1.0f / (float)(hi - lo);
#pragma unroll
        for (int i = 0; i < 4; ++i) {
            const float w1 = x[oc - 1][i] + x[oc][i];
            const float w2 = w1 + (x[oc - 2][i] + x[oc + 1][i]);
            const float w4 = w2 + ((x[oc - 4][i] + x[oc - 3][i]) + (x[oc + 2][i] + x[oc + 3][i]));
            const float w8 = w4 + (((x[oc - 8][i] + x[oc - 7][i]) + (x[oc - 6][i] + x[oc - 5][i])) + ((x[oc + 4][i] + x[oc + 5][i]) + (x[oc + 6][i] + x[oc + 7][i])));
            const float S = (g == 0) ? w1 : (g == 1) ? w2 : (g == 2) ? w4 : w8;
            y[k][i] = S * inv - x[oc][i]; } }
    pair_norm_store(F, y, MIXED, rb + tw, 0, cq);
}
__device__ __forceinline__ void hyfin_item(Frame& F, const bf16* __restrict__ YC, const bf16* __restrict__ X0, bf16* MIXED, int b, int tile) {
    const int tb = F.tid >> 7, cq = F.tid & 127, c0 = 4 * cq, tw = tile * 32 + tb * 8; const size_t rb = (size_t)b * SEQ;
    float yc[4][8], y[8][4];
#pragma unroll
    for (int i = 0; i < 4; ++i) { const v4u v = *(const v4u*)(YC + ((size_t)(c0 + i) * NSEQ + b) * SEQ + tw);
        yc[i][0] = bflo(v.x); yc[i][1] = bfhi(v.x); yc[i][2] = bflo(v.y); yc[i][3] = bfhi(v.y); yc[i][4] = bflo(v.z); yc[i][5] = bfhi(v.z); yc[i][6] = bflo(v.w); yc[i][7] = bfhi(v.w); }
#pragma unroll
    for (int k = 0; k < 8; ++k) { float xv[4]; unpack4(*(const v2u*)(X0 + (rb + tw + k) * HYC + c0), xv);
#pragma unroll
        for (int i = 0; i < 4; ++i) y[k][i] = yc[i][k] * xv[i]; }
    pair_norm_store(F, y, MIXED, rb + tw, 1536, cq);
}
struct PrepGains { float q[3][8], k[3][8]; };
__device__ __forceinline__ void load8(const float* p, float (&o)[8]) { const f32x4 a = *(const f32x4*)p, b = *(const f32x4*)(p + 4); o[0] = a.x; o[1] = a.y; o[2] = a.z; o[3] = a.w; o[4] = b.x; o[5] = b.y; o[6] = b.z; o[7] = b.w; }
__device__ __forceinline__ void unpack8(const v4u w, float (&x)[8]) { x[0] = bflo(w.x); x[1] = bfhi(w.x); x[2] = bflo(w.y); x[3] = bfhi(w.y); x[4] = bflo(w.z); x[5] = bfhi(w.z); x[6] = bflo(w.w); x[7] = bfhi(w.w); }
__device__ __forceinline__ v4u pack8(const float (&x)[8]) { v4u o; o.x = pk2(x[0], x[1]); o.y = pk2(x[2], x[3]); o.z = pk2(x[4], x[5]); o.w = pk2(x[6], x[7]); return o; }
__device__ __forceinline__ float ssq8(const float (&x)[8]) { return ((x[0] * x[0] + x[1] * x[1]) + (x[2] * x[2] + x[3] * x[3])) + ((x[4] * x[4] + x[5] * x[5]) + (x[6] * x[6] + x[7] * x[7])); }
__device__ __forceinline__ float sum8lanes(float v) { v += __shfl_xor(v, 1); v += __shfl_xor(v, 2); v += __shfl_xor(v, 4); return v; }
__device__ __forceinline__ void prep_row(const bf16* __restrict__ PROJ, bf16* Q, bf16* KV, const PrepGains& G, const float* __restrict__ ROPE, int m, int lane) {
    const int h = lane >> 3, sub = lane & 7;
    const bf16* pr = PROJ + (size_t)m * DINP; bf16* qr = Q + (size_t)m * NQ + 192 * h + 8 * sub; bf16* kr = KV + (size_t)m * NKVP + KVHS * h + 8 * sub;
    const v4u cqv = *(const v4u*)(pr + O_CQ + 8 * lane); const v4u ckv = *(const v4u*)(pr + O_CKV + 8 * (lane & 31)); const v4u pev = *(const v4u*)(pr + O_KPE + 8 * sub);
    const v4u q0 = *(const v4u*)(qr), q1 = *(const v4u*)(qr + 64), q2 = *(const v4u*)(qr + 128);
    const v4u k0 = *(const v4u*)(kr), k1 = *(const v4u*)(kr + 64), v0 = *(const v4u*)(kr + 192), v1 = *(const v4u*)(kr + 256);
    float cs[8], sn[8]; { const float* rp = ROPE + (size_t)(m & (SEQ - 1)) * 64 + 8 * (sub & 3); load8(rp, cs); load8(rp + 32, sn); }
    float t[8];
    unpack8(cqv, t); const float rq = 1.0f / sqrtf(wave_sum(ssq8(t)) * (1.f / 512.f) + EPS);
    unpack8(ckv, t); const float rkv = 1.0f / sqrtf(wave_sum(lane < 32 ? ssq8(t) : 0.f) * (1.f / 256.f) + EPS);
    const float sg = (sub < 4) ? -1.f : 1.f;
    { float a0[8], a1[8], a2[8]; unpack8(q0, a0); unpack8(q1, a1); unpack8(q2, a2);
      const float ss = sum8lanes(ssq8(a0) + ssq8(a1) + ssq8(a2)) * (rq * rq);
      const float sc = (rq * (at::SCALE * 1.4426950408889634f)) / sqrtf(ss * (1.f / 192.f) + EPS);
      float r[8], o[8];
#pragma unroll
      for (int i = 0; i < 8; ++i) { a0[i] *= sc * G.q[0][i]; a1[i] *= sc * G.q[1][i]; r[i] = a2[i] * sc * G.q[2][i]; }
#pragma unroll
      for (int i = 0; i < 8; ++i) { const float rp = __shfl_xor(r[i], 4); o[i] = r[i] * cs[i] + sg * rp * sn[i]; }
      *(v4u*)(qr) = pack8(a0); *(v4u*)(qr + 64) = pack8(a1); *(v4u*)(qr + 128) = pack8(o); }
    { float a0[8], a1[8], pe[8], b0[8], b1[8]; unpack8(k0, a0); unpack8(k1, a1); unpack8(pev, pe); unpack8(v0, b0); unpack8(v1, b1);
      const float ss = sum8lanes((ssq8(a0) + ssq8(a1)) * (rkv * rkv) + ssq8(pe));
      const float sk = 1.0f / sqrtf(ss * (1.f / 192.f) + EPS);
      float r[8], o[8];
#pragma unroll
      for (int i = 0; i < 8; ++i) { a0[i] *= rkv * sk * G.k[0][i]; a1[i] *= rkv * sk * G.k[1][i]; r[i] = pe[i] * sk * G.k[2][i]; b0[i] *= rkv; b1[i] *= rkv; }
#pragma unroll
      for (int i = 0; i < 8; ++i) { const float rp = __shfl_xor(r[i], 4); o[i] = r[i] * cs[i] + sg * rp * sn[i]; }
      *(v4u*)(kr) = pack8(a0); *(v4u*)(kr + 64) = pack8(a1); *(v4u*)(kr + 128) = pack8(o); *(v4u*)(kr + 192) = pack8(b0); *(v4u*)(kr + 256) = pack8(b1); }
}
__device__ __forceinline__ void attn_norm_row(bf16* MIXED, int m, int lane) {
    v4u* p = (v4u*)(MIXED + (size_t)m * DM + 512 + 16 * lane); v4u a = p[0], b = p[1];
    unsigned w[8] = {a.x, a.y, a.z, a.w, b.x, b.y, b.z, b.w}; float s = 0.f;
#pragma unroll
    for (int i = 0; i < 8; ++i) { const float x = bflo(w[i]), y = bfhi(w[i]); s += x * x + y * y; }
    const float rstd = 1.0f / sqrtf(wave_sum(s) * (1.f / 1024.f) + EPS);
#pragma unroll
    for (int i = 0; i < 8; ++i) w[i] = pk2(bflo(w[i]) * rstd, bfhi(w[i]) * rstd);
    a.x = w[0]; a.y = w[1]; a.z = w[2]; a.w = w[3]; b.x = w[4]; b.y = w[5]; b.z = w[6]; b.w = w[7]; p[0] = a; p[1] = b;
}

#define DEFPTRS() unsigned char* ws = args.ws; \
    bf16* BtIn = (bf16*)(ws + WS_BTIN); bf16* BtUq = (bf16*)(ws + WS_BTUQ); bf16* BtKv = (bf16*)(ws + WS_BTKV); bf16* BtOut = (bf16*)(ws + WS_BTOUT); bf16* BtUp = (bf16*)(ws + WS_BTUP); bf16* BtDn = (bf16*)(ws + WS_BTDN); \
    bf16* RF = (bf16*)(ws + WS_RF); bf16* Hb = (bf16*)(ws + WS_H); bf16* PROJ = (bf16*)(ws + WS_PROJ); bf16* Qb = (bf16*)(ws + WS_Q); bf16* KVb = (bf16*)(ws + WS_KV); \
    bf16* ZT = (bf16*)(ws + WS_ZT); bf16* X0 = (bf16*)(ws + WS_X0); bf16* YC = (bf16*)(ws + WS_YC); float* EDGE = (float*)(ws + WS_EDGE); float* ROPE = (float*)(ws + WS_ROPE); float* SSQP = (float*)(ws + WS_SSQP); float* RSTD = (float*)(ws + WS_RSTD); bf16* XB2 = (bf16*)(ws + WS_XB2); bf16* ACT = (bf16*)(ws + WS_ACT); \
    bf16* XA = (bf16*)args.out; \
    (void)BtIn; (void)BtUq; (void)BtKv; (void)BtOut; (void)BtUp; (void)BtDn; (void)RF; (void)Hb; (void)PROJ; (void)Qb; (void)KVb; (void)ZT; (void)X0; (void)YC; (void)EDGE; (void)ROPE; (void)SSQP; (void)RSTD; (void)XB2; (void)ACT; (void)XA
__global__ void __launch_bounds__(NWAVES * 64, 2) fwd(Args args) {
    extern __shared__ __attribute__((aligned(16))) unsigned char lds_raw[];
    Frame F;
    F.lds = (LAS unsigned char*)lds_raw;
    F.tid = threadIdx.x; F.lane = F.tid & 63; F.wave = __builtin_amdgcn_readfirstlane(F.tid >> 6);
    F.G = gridDim.x; { const int bx = blockIdx.x; F.vcu = (F.G % 8 == 0) ? (bx % 8) * (F.G / 8) + bx / 8 : bx; }
    volatile LAS unsigned* MISC = (volatile LAS unsigned*)(F.lds + MISC_OFF);
    if (F.tid < 64) MISC[F.tid] = 0u;
    __syncthreads();
    unsigned* ctl = (unsigned*)(args.ws + WS_CTL);
    const int lo = args.ph_lo, hi = args.ph_hi;
    XcdBarrier bar; bar.bar = ctl + CW_BAR; bar.x = 0; bar.st = MISC + 8;
    if (hi - lo > 1) bar = xcd_barrier_post(ctl + CW_BAR, MISC + 8);
    float* out = args.out;

#pragma unroll 1
    for (int layer = 0; layer < DEPTH; ++layer) {
        const int pb = layer * NPH;
        if (pb + NPH <= lo || pb >= hi) continue;
#define IN(k) (lo <= pb + (k) && pb + (k) < hi)
#define ENTER() DEFPTRS(); F.tid = opq(threadIdx.x); F.lane = F.tid & 63; F.wave = __builtin_amdgcn_readfirstlane(F.tid >> 6); const int gw = F.vcu * NWAVES + F.wave, NGW = F.G * NWAVES, wg = F.vcu; const size_t gtid = (size_t)wg * 512 + F.tid, gthreads = (size_t)F.G * 512; (void)gw; (void)NGW; (void)wg; (void)gtid; (void)gthreads
#define SEAM(k) do { if (pb + (k) + 1 < hi) xcd_barrier(bar); } while (0)

        if (IN(0)) { ENTER();
            const float* win = args.in[I_WIN] + (size_t)layer * DM * DIN; const float* g1 = args.in[I_ANG] + layer * DM;
            for (int it = wg; it < 256; it += F.G) {
                if (it < 128) poolfold_item(F, win, args.in[I_PW] + (size_t)layer * 4 * 128 * 128, args.in[I_PS] + (size_t)layer * 512, g1, BtIn, it >> 5, it & 31);
                else filter_item(F, args.in[I_FW1] + (size_t)layer * 17 * 64, args.in[I_FB1] + layer * 64, args.in[I_FFR] + layer * 64, args.in[I_FW2] + (size_t)layer * 64 * 64, args.in[I_FB2] + layer * 64,
                                 args.in[I_FW3] + (size_t)layer * 64 * 1024, args.in[I_FB3] + layer * 1024, args.in[I_HBIAS] + layer * 512, RF, it - 128);
            }
            constexpr int T_IN = 19 * 16, T_UQ = 12 * 4, T_KV = 16 * 2, T_OUT = 16 * 16, T_UP = 88 * 16, T_DN = 16 * 44, T_ALL = T_IN + T_UQ + T_KV + T_OUT + T_UP + T_DN;
            for (int it = wg; it < T_ALL; it += F.G) {
                int r = it; CvtTile d;
                if (r < T_IN) { const int nt = r >> 4, kt = r & 15, n0 = 512 + 128 * nt; d = CvtTile{win, g1, BtIn, DIN, DM, n0, 128 * kt, DIN, {n0, n0 + 32, n0 + 64, n0 + 96}}; }
                else if ((r -= T_IN) < T_UQ) { const int nt = r >> 2, kt = r & 3, n0 = 128 * nt; d = CvtTile{args.in[I_WUQ] + (size_t)layer * 512 * NQ, args.in[I_QNG] + layer * 512, BtUq, NQ, 512, n0, 128 * kt, NQ, {n0, n0 + 32, n0 + 64, n0 + 96}}; }
                else if ((r -= T_UQ) < T_KV) { const int nt = r >> 1, kt = r & 1, n0 = 128 * nt;
                    d = CvtTile{args.in[I_WUKV] + (size_t)layer * 256 * 2048, args.in[I_KVNG] + layer * 256, BtKv, 2048, 256, n0, 128 * kt, 2048, {n0, n0 + 32, n0 + 64, n0 + 96}}; }
                else if ((r -= T_KV) < T_OUT) { const int nt = r >> 4, kt = r & 15, n0 = 128 * nt; d = CvtTile{args.in[I_WOUT] + (size_t)layer * DM * DM, args.in[I_GNG] + layer * DM, BtOut, DM, DM, n0, 128 * kt, DM, {n0, n0 + 32, n0 + 64, n0 + 96}}; }
                else if ((r -= T_OUT) < T_UP) { const int nt = r >> 4, kt = r & 15, n0 = 128 * nt; const int nv = (nt < 44) ? nt : nt - 44; const int bs = 256 * nv + ((nt < 44) ? 0 : 32);
                    d = CvtTile{args.in[I_WUP] + (size_t)layer * DM * NUP, args.in[I_FNG] + layer * DM, BtUp, NUP, DM, n0, 128 * kt, NUP, {bs, bs + 64, bs + 128, bs + 192}}; }
                else { r -= T_UP; const int nt = r / 44, kt = r % 44, n0 = 128 * nt; d = CvtTile{args.in[I_WDN] + (size_t)layer * DFF * DM, nullptr, BtDn, DM, DFF, n0, 128 * kt, DM, {n0, n0 + 32, n0 + 64, n0 + 96}}; }
                cvt_tile(F, d);
            }
            { unsigned zz = 0u; asm volatile("" : "+v"(zz)); v4u z = {zz, zz, zz, zz};
              for (size_t i = gtid; i < (size_t)(DINP - DIN) * DM / 8; i += gthreads) *(v4u*)(BtIn + (size_t)DIN * DM + i * 8) = z;
}
            if (layer == 0) for (size_t i = gtid; i < (size_t)SEQ * 32; i += gthreads) { const int pos = (int)(i >> 5), ri = (int)(i & 31);
                const float freq = exp2f(-(float)ri * (13.287712379549449f / 32.0f)); float sn, cs; sincosf((float)pos * freq, &sn, &cs); ROPE[pos * 64 + ri] = cs; ROPE[pos * 64 + 32 + ri] = sn; }
            if (layer == 0) { for (int m = gw; m < M; m += NGW) xb_row(m < MP ? args.in[I_XP] + (size_t)m * DM : args.in[I_XS] + (size_t)(m - MP) * DM, XA + (size_t)m * DM, RSTD + m, F.lane); }
            else rstd_from_partials(SSQP, RSTD, gtid, gthreads);
            SEAM(0);
        }
        if (IN(1)) { ENTER();
            pg8::Gemm g{XA, BtIn, M, DINP, DM, DM}; pg8::StaticOrder S; S.init(M, DINP, F.G, (int)blockIdx.x);
            pg8::EpiBf16 E{PROJ, DINP, RSTD, 0};
            pg8::gemm_phase<pg8::EpiBf16, pg8::StaticOrder>(F.lds, g, S, E);
            SEAM(1);
        }
        if (IN(2)) { ENTER();
            { pg8::Gemm g{PROJ + O_CQ, BtUq, M, NQ, 512, DINP}; pg8::StaticOrder S; S.init(M, NQ, F.G, (int)blockIdx.x); pg8::EpiBf16 E{Qb, NQ, nullptr, 0};
              pg8::gemm_phase<pg8::EpiBf16, pg8::StaticOrder>(F.lds, g, S, E); }
            { pg8::Gemm g{PROJ + O_CKV, BtKv, M, 2048, 256, DINP}; pg8::StaticOrder S; S.init(M, 2048, F.G, (int)blockIdx.x); pg8::EpiBf16 E{KVb, NKVP, nullptr, 1};
              pg8::gemm_phase<pg8::EpiBf16, pg8::StaticOrder>(F.lds, g, S, E); }
            const float* hcw = args.in[I_HCW] + (size_t)layer * 3 * 1536; const float* hcb = args.in[I_HCB] + layer * 1536;
            for (int it = wg; it < 2 * NSEQ * 64; it += F.G) {
                if (it < NSEQ * 64) hyprep_item(F, PROJ, hcw, hcb, ZT, X0, it >> 6, it & 63);
                else pool_item(F, PROJ, Hb, (it - NSEQ * 64) >> 6, it & 63);
            }
            SEAM(2);
        }
        if (IN(3)) { ENTER();
            for (int u = wg; u < 2 * HYC; u += F.G) hy::conv_unit(F.lds, ZT, RF, YC, u >> 1, u & 1);
            const float* qhg = args.in[I_QHG] + layer * 192; const float* khg = args.in[I_KHG] + layer * 192;
            PrepGains PG; { const int sub = F.lane & 7;
#pragma unroll
                for (int i = 0; i < 3; ++i) { load8(qhg + 64 * i + 8 * sub, PG.q[i]); load8(khg + 64 * i + 8 * sub, PG.k[i]); } }
            for (int m = gw; m < M; m += NGW) prep_row(PROJ, Qb, KVb, PG, ROPE, m, F.lane);
            SEAM(3);
        }
        if (IN(4)) { ENTER();
            float gqm, gkm; { const float* qhg = args.in[I_QHG] + layer * 192; const float* khg = args.in[I_KHG] + layer * 192;
                gqm = fmaxf(fmaxf(fabsf(qhg[F.lane]), fabsf(qhg[64 + F.lane])), fabsf(qhg[128 + F.lane])); gkm = fmaxf(fmaxf(fabsf(khg[F.lane]), fabsf(khg[64 + F.lane])), fabsf(khg[128 + F.lane]));
#pragma unroll
                for (int o = 1; o < 64; o <<= 1) { gqm = fmaxf(gqm, __shfl_xor(gqm, o)); gkm = fmaxf(gkm, __shfl_xor(gkm, o)); } }
            const float Mnat = 13.856406460551018f * gqm * gkm;
            const bool sm_fast = __builtin_amdgcn_readfirstlane((Mnat <= 40.0f) ? 1 : 0) != 0;
            const float negMC = __builtin_bit_cast(float, __builtin_amdgcn_readfirstlane(__builtin_bit_cast(int, -Mnat * 1.4426950408889634f)));
            for (int i = 0; i * F.G < NSEQ * NH * 8; ++i) {
                int p, qb; const int c = (int)blockIdx.x;
                if (F.G == 256) { p = i * 32 + (c & 7) * 4 + (c >> 6); qb = (c >> 3) & 7; } else { const int Lq = i * F.G + c; p = Lq >> 3; qb = Lq & 7; }
                if (p < NSEQ * NH) { const int b = p >> 3, h = p & 7;
                    const bf16* qp = Qb + (size_t)(b * SEQ + qb * 256) * NQ + h * 192; const bf16* kp = KVb + (size_t)(b * SEQ) * NKVP + h * KVHS; bf16* op = Hb + (size_t)(b * SEQ + qb * 256) * DM + 512 + h * 128;
                    if (sm_fast) at::attn_unit<true>(negMC, qp, kp, kp + 192, op, SEQ, (char*)lds_raw);
                    else at::attn_unit<false>(0.f, qp, kp, kp + 192, op, SEQ, (char*)lds_raw); }
            }
            for (int it = wg; it < NSEQ * 64; it += F.G) hyfin_item(F, YC, X0, Hb, it >> 6, it & 63);
            SEAM(4);
        }
        if (IN(5)) { ENTER();
            for (int m = gw; m < M; m += NGW) attn_norm_row(Hb, m, F.lane);
            SEAM(5);
        }
        if (IN(6)) { ENTER();
            pg8::Gemm g{Hb, BtOut, M, DM, DM, DM}; pg8::StaticOrder S; S.init(M, DM, F.G, (int)blockIdx.x);
            pg8::EpiResid16 E{XA, XB2, out, DM, SSQP, 0};
            pg8::gemm_phase<pg8::EpiResid16, pg8::StaticOrder>(F.lds, g, S, E);
            SEAM(6);
        }
        if (IN(7)) { ENTER();
            rstd_from_partials(SSQP, RSTD, gtid, gthreads);
            SEAM(7);
        }
        if (IN(8)) { ENTER();
            pg8::Gemm g{XB2, BtUp, M, NUP, DM, DM}; pg8::StaticOrder S; S.init(M, NUP, F.G, (int)blockIdx.x);
            pg8::EpiGate E{ACT, DFF, EDGE, args.in[I_FCW] + (size_t)layer * 3 * DFF, args.in[I_FCB] + layer * DFF, DFF, (LAS float*)(F.lds + HALO_OFF), RSTD};
            pg8::gemm_phase<pg8::EpiGate, pg8::StaticOrder>(F.lds, g, S, E);
            SEAM(8);
        }
        if (IN(9)) { ENTER();
            const float* fcw = args.in[I_FCW] + (size_t)layer * 3 * DFF;
            for (size_t i = gtid; i < (size_t)(M / 256) * 2 * (DFF / 4); i += gthreads) {
                const int ri = (int)(i / (DFF / 4)), c4 = (int)(i % (DFF / 4)) * 4, pm = ri >> 1, e = ri & 1;
                const float* eb = EDGE + (size_t)(ri * 3) * DFF + c4;
                f32x4 pre = *(const f32x4*)(eb + DFF); const f32x4 v = *(const f32x4*)(eb + 2 * DFF);
                if (e == 0 && (pm & 7) != 0) { const f32x4 gp = *(const f32x4*)(EDGE + (size_t)(((pm - 1) * 2 + 1) * 3) * DFF + c4); pre += *(const f32x4*)(fcw + c4) * gp; }
                if (e == 1 && (pm & 7) != 7) { const f32x4 gn = *(const f32x4*)(EDGE + (size_t)(((pm + 1) * 2 + 0) * 3) * DFF + c4); pre += *(const f32x4*)(fcw + 2 * DFF + c4) * gn; }
                v2u o; o.x = pk2(pg8::silu_f(pre.x) * v.x, pg8::silu_f(pre.y) * v.y); o.y = pk2(pg8::silu_f(pre.z) * v.z, pg8::silu_f(pre.w) * v.w);
                *(v2u*)(ACT + (size_t)(pm * 256 + (e ? 255 : 0)) * DFF + c4) = o;
            }
            SEAM(9);
        }
        if (IN(10)) { ENTER();
            pg8::Gemm g{ACT, BtDn, M, DM, DFF, DFF}; pg8::StaticOrder S; S.init(M, DM, F.G, (int)blockIdx.x);
            pg8::EpiResid16 E{XB2, XA, out, DM, SSQP, (layer + 1 < DEPTH) ? 0 : 1};
            pg8::gemm_phase<pg8::EpiResid16, pg8::StaticOrder>(F.lds, g, S, E);
            SEAM(10);
        }
#undef IN
#undef ENTER
#undef SEAM
    }
}

extern "C" void kernel_launch(void* const* d_in, const int* in_sizes, int n_in, void* d_out, int out_size, void* d_ws, size_t ws_size, hipStream_t stream) {
    static int grid = 0;
    if (grid == 0) {
        if (n_in != N_IN || out_size != M * DM || ws_size < WS_END) { fprintf(stderr, "kernel_launch: unexpected shapes (n_in %d, out %d, ws %zu, need %zu)\n", n_in, out_size, ws_size, (size_t)WS_END); grid = -1; return; }
        int dev = 0, cus = 0;
        if (hipGetDevice(&dev) != hipSuccess || hipDeviceGetAttribute(&cus, hipDeviceAttributeMultiprocessorCount, dev) != hipSuccess) { grid = -1; return; }
        if (hipFuncSetAttribute((const void*)fwd, hipFuncAttributeMaxDynamicSharedMemorySize, LDS_BYTES) != hipSuccess) { fprintf(stderr, "kernel_launch: hipFuncSetAttribute failed\n"); grid = -1; return; }
        int per_cu = 0;
        if (hipOccupancyMaxActiveBlocksPerMultiprocessor(&per_cu, (const void*)fwd, NWAVES * 64, LDS_BYTES) != hipSuccess || per_cu < 1) fprintf(stderr, "kernel_launch: occupancy query reports %d\n", per_cu);
        (void)hipGetLastError();
        grid = cus;
    }
    if (grid < 0) return;
    (void)hipMemsetAsync((char*)d_ws + WS_CTL, 0, CTL_BYTES, stream);
    Args a{};
    for (int i = 0; i < N_IN; ++i) a.in[i] = (const float*)d_in[i];
    a.out = (float*)d_out; a.ws = (unsigned char*)d_ws;
#if MK_ONE_LAUNCH
    a.ph_lo = 0; a.ph_hi = DEPTH * NPH;
    hipLaunchKernelGGL(fwd, dim3(grid), dim3(NWAVES * 64), LDS_BYTES, stream, a);
#else
    for (int p = 0; p < DEPTH * NPH; ++p) { a.ph_lo = p; a.ph_hi = p + 1; hipLaunchKernelGGL(fwd, dim3(grid), dim3(NWAVES * 64), LDS_BYTES, stream, a); }
#endif
    const hipError_t le = hipPeekAtLastError();
    if (le != hipSuccess) fprintf(stderr, "kernel_launch: launch failed: %s\n", hipGetErrorName(le));
}
```

```cpp
#include <hip/hip_runtime.h>
#include <cstdio>
#include <cstdint>
__device__ __forceinline__ int opq(int x) { asm volatile("" : "+v"(x)); return x; }
namespace pg8 {
#define PG8_LAS __attribute__((address_space(3)))
typedef unsigned short bf16_t;
typedef short bf16x8 __attribute__((ext_vector_type(8)));
typedef float f32x4 __attribute__((ext_vector_type(4)));
typedef unsigned u32x4 __attribute__((ext_vector_type(4)));
typedef int i32x4 __attribute__((ext_vector_type(4)));
template <bool I8> struct AccSel { typedef f32x4 T; }; template <> struct AccSel<true> { typedef i32x4 T; };
constexpr int BM = 256, BK = 64, HALF = 128, HTB = HALF * BK * 2  , STAGE_BYTES = 8 * HTB, NXCD = 8, WGM = 8;

__host__ __device__ __forceinline__ int lds_byte(int r, int c) { const int st = (r >> 4) * 2 + (c >> 5), rr = r & 15, cc = c & 31, ob = rr * 64 + cc * 2; return st * 1024 + (ob ^ (((ob >> 9) & 1) << 5)); }
__host__ __device__ __forceinline__ void stage_rc(int b, int& R, int& C) { const int st = b / 1024, sb = b % 1024, swz = sb ^ (((sb >> 9) & 1) << 5); R = (st >> 1) * 16 + swz / 64; C = (st & 1) * 32 + (swz % 64) / 2; }
__host__ __device__ __forceinline__ int perm32(int rho) { const int n = rho >> 4, i = rho & 15; return 8 * (i >> 2) + 4 * n + (i & 3); }

struct Unit { int pm, pn; };
struct Gemm { const bf16_t* A; const bf16_t* Bt; int M, N, K, lda; };

struct StaticOrder {
    int nM, nN, nwg, G, c;
    __host__ __device__ void init(int M, int N, int G_, int c_) { nM = M / BM; nN = N / BM; nwg = nM * nN; G = G_; c = c_; }
    __host__ __device__ bool next(int i, Unit& u) const {
        const long L = (long)i * G + c; if (L >= nwg) return false;
        int wgid = (int)L; { const int q = nwg / NXCD, r = nwg % NXCD, xcd = wgid % NXCD, off = wgid / NXCD; wgid = (xcd < r ? xcd * (q + 1) : r * (q + 1) + (xcd - r) * q) + off; }
        const int nig = WGM * nN, gid = wgid / nig, fm = gid * WGM, gsz = (nM - fm) < WGM ? (nM - fm) : WGM;
        u.pm = fm + ((wgid % nig) % gsz); u.pn = (wgid % nig) / gsz; return true;
    }
    __device__ __forceinline__ void a_ready(const Unit&) const {}
    __device__ __forceinline__ void done(const Unit&) const {}
};

__device__ __forceinline__ unsigned cvt_pk_bf16(float lo, float hi) { unsigned r; asm volatile("v_cvt_pk_bf16_f32 %0, %1, %2" : "=v"(r) : "v"(lo), "v"(hi)); return r; }

__device__ __forceinline__ float dpp_ror1(float v) { return __builtin_bit_cast(float, __builtin_amdgcn_update_dpp(0, __builtin_bit_cast(int, v), 0x121, 0xF, 0xF, false)); }
__device__ __forceinline__ float dpp_ror15(float v) { return __builtin_bit_cast(float, __builtin_amdgcn_update_dpp(0, __builtin_bit_cast(int, v), 0x12F, 0xF, 0xF, false)); }
__device__ __forceinline__ unsigned dpp_swap1(unsigned v) { return (unsigned)__builtin_amdgcn_update_dpp(0, (int)v, 0xB1, 0xF, 0xF, false); }
struct LineOffs { unsigned o0, o1; bool odd; };
__device__ __forceinline__ LineOffs line_offs(unsigned lo, int pitch, int fr) { LineOffs L; L.odd = fr & 1; L.o0 = L.odd ? lo - (unsigned)pitch + 32u : lo; L.o1 = L.odd ? lo + 32u : lo + (unsigned)pitch; return L; }
__device__ __forceinline__ void store_lines(bf16_t* base, const LineOffs& L, u32x4 a, u32x4 b) {
    const u32x4 snd = L.odd ? a : b; u32x4 rcv;
    rcv.x = dpp_swap1(snd.x); rcv.y = dpp_swap1(snd.y); rcv.z = dpp_swap1(snd.z); rcv.w = dpp_swap1(snd.w);
    *(u32x4*)(base + L.o0) = L.odd ? rcv : a;
    *(u32x4*)(base + L.o1) = L.odd ? b : rcv;
}
struct EpiBf16 {
    static constexpr bool PERM = true;
    bf16_t* O; int ldc; const float* rstd; int kvscatter;
    __device__ __forceinline__ void operator()(f32x4 (&acc)[2][2][4][2], const Unit& u, int wr, int wc, int fr, int fq) const {
        bf16_t* Ot = O + (size_t)(u.pm * BM) * ldc + (kvscatter ? u.pn * 320 : u.pn * BM);
        const int wcol = kvscatter ? (wc < 2 ? wc * 64 : 64 + wc * 64) : wc * 64;
        const LineOffs L = line_offs((unsigned)((wr * 64 + fr) * ldc + wcol + 8 * fq), ldc, fr); const int row0 = u.pm * BM + wr * 64 + fr;
        float rsv[8];
#pragma unroll
        for (int i = 0; i < 8; ++i) rsv[i] = rstd ? rstd[row0 + (i >> 2) * HALF + (i & 3) * 16] : 1.0f;
#pragma unroll
        for (int ai = 0; ai < 2; ++ai)
#pragma unroll
            for (int m = 0; m < 4; ++m) { const float rs = rsv[ai * 4 + m];
                u32x4 w[2];
#pragma unroll
                for (int bj = 0; bj < 2; ++bj) { const f32x4 v0 = acc[ai][bj][m][0] * rs, v1 = acc[ai][bj][m][1] * rs;
                    w[bj].x = cvt_pk_bf16(v0[0], v0[1]); w[bj].y = cvt_pk_bf16(v0[2], v0[3]); w[bj].z = cvt_pk_bf16(v1[0], v1[1]); w[bj].w = cvt_pk_bf16(v1[2], v1[3]); }
                store_lines(Ot + (size_t)((ai * HALF + m * 16) * ldc), L, w[0], w[1]);
                asm volatile("" ::: "memory"); }
    }
};
struct EpiResid16 {
    static constexpr bool PERM = true;
    const bf16_t* base; bf16_t* xo; float* out; int ldc; float* ssqp; int f32out;
    __device__ __forceinline__ static void addx(const u32x4 b, const f32x4 a0, const f32x4 a1, f32x4& x0, f32x4& x1) {
        x0[0] = __builtin_bit_cast(float, b.x << 16) + a0[0]; x0[1] = __builtin_bit_cast(float, b.x & 0xffff0000u) + a0[1]; x0[2] = __builtin_bit_cast(float, b.y << 16) + a0[2]; x0[3] = __builtin_bit_cast(float, b.y & 0xffff0000u) + a0[3];
        x1[0] = __builtin_bit_cast(float, b.z << 16) + a1[0]; x1[1] = __builtin_bit_cast(float, b.z & 0xffff0000u) + a1[1]; x1[2] = __builtin_bit_cast(float, b.w << 16) + a1[2]; x1[3] = __builtin_bit_cast(float, b.w & 0xffff0000u) + a1[3]; }
    __device__ __forceinline__ void operator()(f32x4 (&acc)[2][2][4][2], const Unit& u, int wr, int wc, int fr, int fq) const {
        const size_t tb = (size_t)(u.pm * BM) * ldc + u.pn * BM;
        const bf16_t* bs = base + tb;
        const unsigned lo = (unsigned)((wr * 64 + fr) * ldc + wc * 64 + 8 * fq);
        if (f32out != 0) {
            float* op = out + tb;
#pragma unroll
            for (int ai = 0; ai < 2; ++ai)
#pragma unroll
                for (int m = 0; m < 4; ++m) { const unsigned off = lo + (unsigned)((ai * HALF + m * 16) * ldc);
#pragma unroll
                    for (int bj = 0; bj < 2; ++bj) { const u32x4 b = *(const u32x4*)(bs + off + bj * 32); f32x4 x0, x1; addx(b, acc[ai][bj][m][0], acc[ai][bj][m][1], x0, x1);
                        *(f32x4*)(op + off + bj * 32) = x0; *(f32x4*)(op + off + bj * 32 + 4) = x1; }
                    asm volatile("" ::: "memory"); }
            return;
        }
        bf16_t* xp = xo + tb; const LineOffs L = line_offs(lo, ldc, fr);
#pragma unroll
        for (int aim = 0; aim < 4; ++aim) { const int ai = aim >> 1, mp = aim & 1;
            u32x4 bv[2][2];
#pragma unroll
            for (int mm = 0; mm < 2; ++mm)
#pragma unroll
                for (int bj = 0; bj < 2; ++bj) bv[mm][bj] = *(const u32x4*)(bs + lo + (unsigned)((ai * HALF + (2 * mp + mm) * 16) * ldc) + bj * 32);
#pragma unroll
            for (int mm = 0; mm < 2; ++mm) { const int m = 2 * mp + mm; float s = 0.f; u32x4 wv[2];
#pragma unroll
                for (int bj = 0; bj < 2; ++bj) { f32x4 x0, x1; addx(bv[mm][bj], acc[ai][bj][m][0], acc[ai][bj][m][1], x0, x1);
                    wv[bj].x = cvt_pk_bf16(x0[0], x0[1]); wv[bj].y = cvt_pk_bf16(x0[2], x0[3]); wv[bj].z = cvt_pk_bf16(x1[0], x1[1]); wv[bj].w = cvt_pk_bf16(x1[2], x1[3]);
                    s += ((x0[0] * x0[0] + x0[1] * x0[1]) + (x0[2] * x0[2] + x0[3] * x0[3])) + ((x1[0] * x1[0] + x1[1] * x1[1]) + (x1[2] * x1[2] + x1[3] * x1[3])); }
                store_lines(xp + (size_t)((ai * HALF + m * 16) * ldc), L, wv[0], wv[1]);
                s += __shfl_xor(s, 16); s += __shfl_xor(s, 32); if (fq == 0) ssqp[(size_t)(u.pm * BM + wr * 64 + fr + ai * HALF + m * 16) * 32 + u.pn * 4 + wc] = s; }
            asm volatile("" ::: "memory"); }
    }
};
__device__ __forceinline__ float silu_f(float x) { return x * __builtin_amdgcn_rcpf(1.0f + __builtin_amdgcn_exp2f(-1.4426950408889634f * x)); }
struct EpiGate {
    static constexpr bool PERM = true;
    bf16_t* act; int ldact; float* edge; const float* cw; const float* cb; int dff; PG8_LAS float* halo; const float* rstd;
    __device__ __forceinline__ void operator()(f32x4 (&acc)[2][2][4][2], const Unit& u, int wr, int wc, int fr, int fq) const {
        const int lane = fq * 16 + fr; const int colL = wc * 32 + 8 * fq; const int colG = u.pn * HALF + colL;
#pragma unroll
        for (int ai = 0; ai < 2; ++ai)
#pragma unroll
            for (int m = 0; m < 4; ++m) { const float rs = rstd[u.pm * BM + ai * HALF + wr * 64 + m * 16 + fr];
#pragma unroll
                for (int bj = 0; bj < 2; ++bj) { acc[ai][bj][m][0] *= rs; acc[ai][bj][m][1] *= rs; } }
#pragma unroll
        for (int ai = 0; ai < 2; ++ai) { const int q = 2 * ai + wr;
            if (fr == 0) { *(PG8_LAS f32x4*)(halo + (q * 2 + 0) * 128 + colL) = acc[ai][0][0][0]; *(PG8_LAS f32x4*)(halo + (q * 2 + 0) * 128 + colL + 4) = acc[ai][0][0][1]; }
            if (fr == 15) { *(PG8_LAS f32x4*)(halo + (q * 2 + 1) * 128 + colL) = acc[ai][0][3][0]; *(PG8_LAS f32x4*)(halo + (q * 2 + 1) * 128 + colL + 4) = acc[ai][0][3][1]; } }
        asm volatile("s_waitcnt lgkmcnt(0)" ::: "memory"); __builtin_amdgcn_s_barrier(); asm volatile("" ::: "memory");
        bf16_t* actp = act + (size_t)(u.pm * BM) * ldact + colG; const unsigned rlo = (unsigned)((wr * 64 + fr) * ldact);
#pragma unroll
        for (int ai = 0; ai < 2; ++ai) { const int q = 2 * ai + wr;
            typedef unsigned u32x2 __attribute__((ext_vector_type(2)));
            u32x2 pk[4][2];
#pragma unroll
            for (int n = 0; n < 2; ++n) {
                const f32x4 w0 = *(const f32x4*)(cw + colG + 4 * n), w1 = *(const f32x4*)(cw + dff + colG + 4 * n), w2 = *(const f32x4*)(cw + 2 * dff + colG + 4 * n), bb = *(const f32x4*)(cb + colG + 4 * n);
                f32x4 ht = *(PG8_LAS f32x4*)(halo + ((q > 0 ? q - 1 : 0) * 2 + 1) * 128 + colL + 4 * n), hb = *(PG8_LAS f32x4*)(halo + ((q < 3 ? q + 1 : 3) * 2 + 0) * 128 + colL + 4 * n);
                if (q == 0) ht = ht * 0.f; if (q == 3) hb = hb * 0.f;
                f32x4 pre[4];
#pragma unroll
                for (int j = 0; j < 4; ++j) {
                    float g[4], rr[4], rl[4];
#pragma unroll
                    for (int m = 0; m < 4; ++m) { g[m] = acc[ai][0][m][n][j]; rr[m] = dpp_ror1(g[m]); rl[m] = dpp_ror15(g[m]); }
#pragma unroll
                    for (int m = 0; m < 4; ++m) {
                        const float up = (fr > 0) ? rr[m] : (m > 0 ? rr[m > 0 ? m - 1 : 0] : ht[j]);
                        const float dn = (fr < 15) ? rl[m] : (m < 3 ? rl[m < 3 ? m + 1 : 3] : hb[j]);
                        pre[m][j] = w0[j] * up + w1[j] * g[m] + w2[j] * dn + bb[j];
                    }
                }
                if (q == 0 && fr == 0) { float* e = edge + (size_t)((u.pm * 2 + 0) * 3) * dff + colG + 4 * n;
                    *(f32x4*)(e) = acc[ai][0][0][n]; *(f32x4*)(e + dff) = pre[0]; *(f32x4*)(e + 2 * dff) = acc[ai][1][0][n]; }
                if (q == 3 && fr == 15) { float* e = edge + (size_t)((u.pm * 2 + 1) * 3) * dff + colG + 4 * n;
                    *(f32x4*)(e) = acc[ai][0][3][n]; *(f32x4*)(e + dff) = pre[3]; *(f32x4*)(e + 2 * dff) = acc[ai][1][3][n]; }
#pragma unroll
                for (int m = 0; m < 4; ++m) { const f32x4 v = acc[ai][1][m][n];
                    pk[m][n].x = cvt_pk_bf16(silu_f(pre[m][0]) * v[0], silu_f(pre[m][1]) * v[1]); pk[m][n].y = cvt_pk_bf16(silu_f(pre[m][2]) * v[2], silu_f(pre[m][3]) * v[3]); }
            }
#pragma unroll
            for (int m = 0; m < 4; ++m) { u32x4 w; w.x = pk[m][0].x; w.y = pk[m][0].y; w.z = pk[m][1].x; w.w = pk[m][1].y;
                *(u32x4*)(actp + rlo + (unsigned)((ai * HALF + m * 16) * ldact)) = w; }
        }
    }
};

template <class Epi, class Sched, bool I8 = false>
__device__ __forceinline__ void gemm_phase(PG8_LAS unsigned char* lds, const Gemm g, const Sched& S, const Epi& E) {
    typedef typename AccSel<I8>::T acc_t;
    const int tid = opq(threadIdx.x), wid = __builtin_amdgcn_readfirstlane(tid >> 6), lane = tid & 63, wr = wid >> 2, wc = wid & 3, fr = lane & 15, fq = lane >> 4;
    const int K = g.K, nt = K / BK, lda = g.lda;
    unsigned voffA[2], voffB[2];
#pragma unroll
    for (int i = 0; i < 2; ++i) { int R, C; stage_rc(tid * 16 + i * 8192, R, C); const int Rb = Epi::PERM ? (64 * (R >> 5) + perm32(R & 31)) : R;
        voffA[i] = (unsigned)(R * lda + C) * 2u; voffB[i] = (unsigned)(Rb * K + C) * 2u; }
    const size_t kstep = (size_t)(BK * 2);
    const size_t hstepA = (size_t)HALF * lda * 2, hstepB = (size_t)(Epi::PERM ? 32 : HALF) * K * 2;
    const size_t tstepA = 2 * hstepA, tstepB = (size_t)BM * K * 2;
    const unsigned ldsw = (unsigned)wid * 1024u;
    const int aoff = lds_byte(wr * 64 + fr, fq * 8), boff = lds_byte(wc * 32 + fr, fq * 8);
#define PG8_SA(b, h) (((b) * 2 + (h)) * HTB)
#define PG8_SB(b, h) ((4 + (b) * 2 + (h)) * HTB)
#define PG8_STAGE(bufoff, gbase, voff) do { _Pragma("unroll") for (int _i = 0; _i < 2; ++_i) \
        __builtin_amdgcn_global_load_lds((const unsigned*)((const char*)(gbase) + (voff)[_i]), (PG8_LAS unsigned*)(lds + (bufoff) + ldsw + _i * 8192), 16, 0, 0); } while (0)
#define PG8_LDA(dst, b, h) do { _Pragma("unroll") for (int m = 0; m < 4; ++m) _Pragma("unroll") for (int k = 0; k < 2; ++k) dst[m][k] = *(const PG8_LAS bf16x8*)(lds + PG8_SA(b, h) + aoff + m * 2048 + k * 1024); } while (0)
#define PG8_LDB(dst, b, h) do { _Pragma("unroll") for (int n = 0; n < 2; ++n) _Pragma("unroll") for (int k = 0; k < 2; ++k) dst[n][k] = *(const PG8_LAS bf16x8*)(lds + PG8_SB(b, h) + boff + n * 2048 + k * 1024); } while (0)
#define PG8_MMA(ai, bj, At, Bt) do { __builtin_amdgcn_s_setprio(1); _Pragma("unroll") for (int m = 0; m < 4; ++m) _Pragma("unroll") for (int n = 0; n < 2; ++n) _Pragma("unroll") for (int k = 0; k < 2; ++k) { \
        if constexpr (I8) acc[ai][bj][m][n] = __builtin_amdgcn_mfma_i32_16x16x64_i8(__builtin_bit_cast(i32x4, Bt[n][k]), __builtin_bit_cast(i32x4, At[m][k]), acc[ai][bj][m][n], 0, 0, 0); \
        else acc[ai][bj][m][n] = __builtin_amdgcn_mfma_f32_16x16x32_bf16(Bt[n][k], At[m][k], acc[ai][bj][m][n], 0, 0, 0); } __builtin_amdgcn_s_setprio(0); } while (0)
#define PG8_WAIT_V(n) asm volatile("s_waitcnt vmcnt(" #n ")" ::: "memory")
#define PG8_WAIT_L(n) asm volatile("s_waitcnt lgkmcnt(" #n ")" ::: "memory")
#define PG8_BAR __builtin_amdgcn_s_barrier()
#define PG8_SCHED __builtin_amdgcn_sched_barrier(0)
    Unit cur, nxt; int ui = 0;
    if (!S.next(0, cur)) return;
    acc_t acc[2][2][4][2];
{ float zf = 0.f; asm volatile("" : "+v"(zf));
    #pragma unroll
    for (int a = 0; a < 2; ++a)
#pragma unroll
        for (int b = 0; b < 2; ++b)
#pragma unroll
            for (int m = 0; m < 4; ++m)
#pragma unroll
                for (int n = 0; n < 2; ++n) acc[a][b][m][n] = __builtin_bit_cast(acc_t, (f32x4){zf, zf, zf, zf}); }
    bf16x8 At[4][2], B0[2][2], B1[2][2];
    const char* cA = (const char*)g.A + (size_t)cur.pm * tstepA; const char* cB = (const char*)g.Bt + (size_t)cur.pn * tstepB;
    S.a_ready(cur);
    PG8_STAGE(PG8_SB(0, 0), cB, voffB); PG8_STAGE(PG8_SB(0, 1), cB + hstepB, voffB); PG8_STAGE(PG8_SA(0, 0), cA, voffA); PG8_STAGE(PG8_SA(0, 1), cA + hstepA, voffA);
    if (wr == 1) PG8_BAR;
    PG8_WAIT_V(2); PG8_BAR;
    PG8_STAGE(PG8_SB(1, 0), cB + kstep, voffB); PG8_STAGE(PG8_SA(1, 0), cA + kstep, voffA); PG8_STAGE(PG8_SB(1, 1), cB + hstepB + kstep, voffB);
    PG8_WAIT_V(6); PG8_BAR;
    for (;;) {
        const bool has_next = S.next(ui + 1, nxt);
        const char* nA = has_next ? (const char*)g.A + (size_t)nxt.pm * tstepA : cA; const char* nB = has_next ? (const char*)g.Bt + (size_t)nxt.pn * tstepB : cB;
#pragma unroll 1
        for (int t = 0; t < nt; t += 2) {
            const bool last = (t == nt - 2);
            const char* a1 = cA + (size_t)(t + 1) * kstep;
            const char* a2 = last ? nA : cA + (size_t)(t + 2) * kstep; const char* b2 = last ? nB : cB + (size_t)(t + 2) * kstep;
            const char* a3 = a2 + kstep; const char* b3 = b2 + kstep;
            if (last && has_next) S.a_ready(nxt);
            PG8_LDB(B0, 0, 0); PG8_LDB(B1, 0, 1); PG8_SCHED; PG8_LDA(At, 0, 0); PG8_STAGE(PG8_SA(1, 1), a1 + hstepA, voffA);
            PG8_WAIT_V(8); PG8_WAIT_L(0); PG8_BAR; PG8_MMA(0, 0, At, B0); PG8_MMA(0, 1, At, B1); PG8_BAR; PG8_SCHED;
            PG8_LDA(At, 0, 1); PG8_STAGE(PG8_SB(0, 0), b2, voffB); PG8_STAGE(PG8_SB(0, 1), b2 + hstepB, voffB); PG8_STAGE(PG8_SA(0, 0), a2, voffA);
            PG8_WAIT_V(8); PG8_WAIT_L(0); PG8_BAR; PG8_MMA(1, 0, At, B0); PG8_MMA(1, 1, At, B1); PG8_BAR; PG8_SCHED;
            PG8_LDB(B0, 1, 0); PG8_LDB(B1, 1, 1); PG8_SCHED; PG8_LDA(At, 1, 0); PG8_STAGE(PG8_SA(0, 1), a2 + hstepA, voffA);
            PG8_WAIT_V(8); PG8_WAIT_L(0); PG8_BAR; PG8_MMA(0, 0, At, B0); PG8_MMA(0, 1, At, B1); PG8_BAR; PG8_SCHED;
            PG8_LDA(At, 1, 1); PG8_STAGE(PG8_SB(1, 0), b3, voffB); PG8_STAGE(PG8_SB(1, 1), b3 + hstepB, voffB); PG8_STAGE(PG8_SA(1, 0), a3, voffA);
            PG8_WAIT_V(8); PG8_WAIT_L(0); PG8_BAR; PG8_MMA(1, 0, At, B0); PG8_MMA(1, 1, At, B1); PG8_BAR; PG8_SCHED;
        }
        if (wr == 0) PG8_BAR;
        if constexpr (I8) { f32x4 accf[2][2][4][2];
#pragma unroll
            for (int a = 0; a < 2; ++a)
#pragma unroll
                for (int b = 0; b < 2; ++b)
#pragma unroll
                    for (int m = 0; m < 4; ++m)
#pragma unroll
                        for (int n = 0; n < 2; ++n) accf[a][b][m][n] = __builtin_convertvector(acc[a][b][m][n], f32x4);
            E(accf, cur, wr, wc, fr, fq); }
        else E(acc, cur, wr, wc, fr, fq);
        S.done(cur);
        if (!has_next) break;
{ float zf = 0.f; asm volatile("" : "+v"(zf));
        #pragma unroll
        for (int a = 0; a < 2; ++a)
#pragma unroll
            for (int b = 0; b < 2; ++b)
#pragma unroll
                for (int m = 0; m < 4; ++m)
#pragma unroll
                    for (int n = 0; n < 2; ++n) acc[a][b][m][n] = __builtin_bit_cast(acc_t, (f32x4){zf, zf, zf, zf}); }
        cur = nxt; cA = nA; cB = nB; ++ui;
        if (wr == 1) PG8_BAR;
    }
    PG8_WAIT_V(0);
    PG8_BAR;
#undef PG8_SA
#undef PG8_SB
#undef PG8_STAGE
#undef PG8_LDA
#undef PG8_LDB
#undef PG8_MMA
#undef PG8_WAIT_V
#undef PG8_WAIT_L
#undef PG8_BAR
#undef PG8_SCHED
}
}
namespace at {
using bf16 = unsigned short;
using bf16x8 = __attribute__((ext_vector_type(8))) short;
using s16x4  = __attribute__((ext_vector_type(4))) short;
using f32x16 = __attribute__((ext_vector_type(16))) float;
using u32x4  = __attribute__((ext_vector_type(4))) unsigned;
constexpr int DQK = 192, DV = 128, KVBLK = 64, NW = 8, QBLK = 32;
constexpr float SCALE = 0.07216878364870322f;
constexpr float THR = 8.f;
constexpr int LDQ = 1536, LDK = 2560, LDO = 2048;
constexpr int SHM_V = KVBLK * DV * 2, SHM_K = 12 * 2080;
constexpr int QR_OFF = 2 * SHM_V + 2 * SHM_K + NW * 64 * 4;
constexpr int SHM_ATTN = QR_OFF + NW * 4096;
#define SBAR() __builtin_amdgcn_sched_barrier(0)
constexpr int KPL = 2080;
__host__ __device__ __forceinline__ int k_st(int row, int c) { return (c >> 1) * KPL + row * 32 + (((c & 1) ^ ((row >> 3) & 1)) << 4); }
__host__ __device__ __forceinline__ int k_rd_base(int r32, int hi) { return r32 * 32 + ((hi ^ ((r32 >> 3) & 1)) << 4); }
__device__ __forceinline__ int crow(int r, int hi) { return (r & 3) + 8 * (r >> 2) + 4 * hi; }
__device__ __forceinline__ unsigned cvtpk(float lo, float hi) { unsigned r; asm volatile("v_cvt_pk_bf16_f32 %0, %1, %2" : "=v"(r) : "v"(lo), "v"(hi)); return r; }

__device__ __forceinline__ void partialSM(f32x16& p0, f32x16& p1, float& m_reg, float& mn, float& alpha) {
  constexpr float C = 1.0f;
  float pmax = p0[0];
#pragma unroll
  for (int r = 1; r < 16; ++r) pmax = fmaxf(pmax, p0[r]);
#pragma unroll
  for (int r = 0; r < 16; ++r) pmax = fmaxf(pmax, p1[r]);
  { auto rr = __builtin_amdgcn_permlane32_swap(__float_as_uint(pmax), __float_as_uint(pmax), false, false);
    pmax = fmaxf(__uint_as_float(rr[0]), __uint_as_float(rr[1])); }
  if (__builtin_expect(__all(pmax - m_reg <= THR * 1.4426950408889634f), 1)) { mn = m_reg; alpha = 1.f; }
  else { mn = fmaxf(m_reg, pmax); alpha = __builtin_amdgcn_exp2f((m_reg - mn) * C); m_reg = mn; }
  float mnC = -mn * C;
#pragma unroll
  for (int r = 0; r < 16; ++r) p0[r] = fmaf(p0[r], C, mnC);
#pragma unroll
  for (int r = 0; r < 16; ++r) p1[r] = fmaf(p1[r], C, mnC);
#pragma unroll
  for (int r = 0; r < 16; ++r) p0[r] = __builtin_amdgcn_exp2f(p0[r]);
}
__device__ __forceinline__ void partialSM_fast(f32x16& p0, f32x16& p1, float negMC) {
  (void)negMC; (void)p1;
#pragma unroll
  for (int r = 0; r < 16; ++r) p0[r] = __builtin_amdgcn_exp2f(p0[r]);
}
__device__ __forceinline__ void finishSM(f32x16& p0, f32x16& p1, float alpha, float& l_reg, bf16x8& pa0, bf16x8& pa1, bf16x8& pa2, bf16x8& pa3) {
#pragma unroll
  for (int r = 0; r < 16; ++r) p1[r] = __builtin_amdgcn_exp2f(p1[r]);
  float ps = 0;
#pragma unroll
  for (int r = 0; r < 16; ++r) ps += p0[r];
#pragma unroll
  for (int r = 0; r < 16; ++r) ps += p1[r];
  { auto rr = __builtin_amdgcn_permlane32_swap(__float_as_uint(ps), __float_as_uint(ps), false, false);
    ps = __uint_as_float(rr[0]) + __uint_as_float(rr[1]); }
  l_reg = l_reg * alpha + ps;
#define PK4(P, BASE, OUT) do { unsigned a0 = cvtpk(P[BASE + 0], P[BASE + 1]), a1 = cvtpk(P[BASE + 2], P[BASE + 3]);   \
    unsigned b0 = cvtpk(P[BASE + 4], P[BASE + 5]), b1 = cvtpk(P[BASE + 6], P[BASE + 7]);                              \
    auto r0 = __builtin_amdgcn_permlane32_swap(a0, b0, false, false); auto r1 = __builtin_amdgcn_permlane32_swap(a1, b1, false, false); \
    u32x4 w = {r0[0], r1[0], r0[1], r1[1]}; OUT = *reinterpret_cast<bf16x8*>(&w); } while (0)
  PK4(p0, 0, pa0); PK4(p0, 8, pa1); PK4(p1, 0, pa2); PK4(p1, 8, pa3);
#undef PK4
}
template <int OFF> __device__ __forceinline__ bf16x8 k_read(int kb) {
  bf16x8 r; asm volatile("ds_read_b128 %0, %1 offset:%2" : "=v"(r) : "v"(kb), "i"(OFF) : "memory"); return r;
}
__device__ __forceinline__ void qkt(f32x16& p0, f32x16& p1, int kb, const bf16x8* qr, int qb) {
  p0 = f32x16{}; p1 = f32x16{};
#define QK1(d0) { const bf16x8 b0 = *(const __attribute__((address_space(3))) bf16x8*)(kb + d0 * KPL), b1 = *(const __attribute__((address_space(3))) bf16x8*)(kb + d0 * KPL + 1024); \
    p0 = __builtin_amdgcn_mfma_f32_32x32x16_bf16(b0, qr[d0], p0, 0, 0, 0); p1 = __builtin_amdgcn_mfma_f32_32x32x16_bf16(b1, qr[d0], p1, 0, 0, 0); }
#define QK2(d0) { const bf16x8 b0 = *(const __attribute__((address_space(3))) bf16x8*)(kb + d0 * KPL), b1 = *(const __attribute__((address_space(3))) bf16x8*)(kb + d0 * KPL + 1024); \
    const bf16x8 qf = *(const __attribute__((address_space(3))) bf16x8*)(qb + (d0 - 8) * 1024); \
    p0 = __builtin_amdgcn_mfma_f32_32x32x16_bf16(b0, qf, p0, 0, 0, 0); p1 = __builtin_amdgcn_mfma_f32_32x32x16_bf16(b1, qf, p1, 0, 0, 0); }
  QK1(0) QK1(1) QK1(2) QK1(3) QK1(4) QK1(5) QK1(6) QK1(7) QK2(8) QK2(9) QK2(10) QK2(11)
#undef QK1
#undef QK2
}
__host__ __device__ __forceinline__ int v_st(int k, int c) { const int kk = (k & ~0xC) | ((k & 4) << 1) | ((k & 8) >> 1); return ((kk >> 3) * 4 + (c >> 5)) * 512 + ((kk & 7) * 32 + (c & 31)) * 2; }
__device__ __forceinline__ int v_rd_base(int lane) { return ((lane & 3) << 3) | (((lane >> 2) & 3) << 6) | (((lane >> 4) & 1) << 5) | (((lane >> 5) & 1) << 8); }
constexpr int v_rd_off(int d0, int ks, int half) { return d0 * 512 + ks * 4096 + half * 2048; }
template <int OFF> __device__ __forceinline__ s16x4 tr_read(int vb) {
  s16x4 r; asm volatile("ds_read_b64_tr_b16 %0, %1 offset:%2" : "=&v"(r) : "v"(vb), "i"(OFF) : "memory"); return r;
}
template <int D0> __device__ __forceinline__ void pv_one(f32x16& od, int vb, bf16x8 pa0, bf16x8 pa1, bf16x8 pa2, bf16x8 pa3) {
  const s16x4 l0 = tr_read<v_rd_off(D0, 0, 0)>(vb), h0 = tr_read<v_rd_off(D0, 0, 1)>(vb), l1 = tr_read<v_rd_off(D0, 1, 0)>(vb), h1 = tr_read<v_rd_off(D0, 1, 1)>(vb);
  const s16x4 l2 = tr_read<v_rd_off(D0, 2, 0)>(vb), h2 = tr_read<v_rd_off(D0, 2, 1)>(vb), l3 = tr_read<v_rd_off(D0, 3, 0)>(vb), h3 = tr_read<v_rd_off(D0, 3, 1)>(vb);
  asm volatile("s_waitcnt lgkmcnt(0)" ::: "memory"); SBAR();
#define PK(L, H) (bf16x8){L[0], L[1], L[2], L[3], H[0], H[1], H[2], H[3]}
  od = __builtin_amdgcn_mfma_f32_32x32x16_bf16(pa0, PK(l0, h0), od, 0, 0, 0);
  od = __builtin_amdgcn_mfma_f32_32x32x16_bf16(pa1, PK(l1, h1), od, 0, 0, 0);
  od = __builtin_amdgcn_mfma_f32_32x32x16_bf16(pa2, PK(l2, h2), od, 0, 0, 0);
  od = __builtin_amdgcn_mfma_f32_32x32x16_bf16(pa3, PK(l3, h3), od, 0, 0, 0);
#undef PK
}
__device__ __forceinline__ void pv_d0(f32x16* o, int vb, bf16x8 pa0, bf16x8 pa1, bf16x8 pa2, bf16x8 pa3) {
  pv_one<0>(o[0], vb, pa0, pa1, pa2, pa3); pv_one<1>(o[1], vb, pa0, pa1, pa2, pa3); pv_one<2>(o[2], vb, pa0, pa1, pa2, pa3); pv_one<3>(o[3], vb, pa0, pa1, pa2, pa3);
}

template <bool FAST>
__device__ __forceinline__ void attn_unit(const float negMC, const bf16* __restrict__ Qb, const bf16* __restrict__ Kh, const bf16* __restrict__ Vh, bf16* __restrict__ Ob, int seq, char* lds) {
  const int tid = opq(threadIdx.x), wid = tid >> 6, lane = tid & 63, r32 = lane & 31, hi = lane >> 5;
  char* V_lds = lds; char* K_lds = lds + 2 * SHM_V;
  float* ws = (float*)(lds + 2 * SHM_V + 2 * SHM_K) + wid * 64; float* li_l = ws; float* al_l = ws + 32;
  float m_reg = -1e30f, l_reg = 0; f32x16 o[4] = {}; bf16x8 qr[8];
  const bf16* Qw = Qb + (unsigned)((wid * QBLK + r32) * LDQ + hi * 8);
#pragma unroll
  for (int d0 = 0; d0 < 8; ++d0) qr[d0] = *reinterpret_cast<const bf16x8*>(Qw + d0 * 16);
  const int qb0 = (int)(uintptr_t)lds + QR_OFF + wid * 4096 + k_rd_base(r32, hi);
#pragma unroll
  for (int d0 = 8; d0 < 12; ++d0) *(__attribute__((address_space(3))) bf16x8*)(qb0 + (d0 - 8) * 1024) = *reinterpret_cast<const bf16x8*>(Qw + d0 * 16);
  const int sr = tid >> 4, sc = (tid & 15) * 8, vst0 = v_st(sr, sc), vst1 = v_st(32 + sr, sc);
  unsigned koff[3]; int kst[3];
#pragma unroll
  for (int i = 0; i < 3; ++i) { const int q = tid + 512 * i; koff[i] = (unsigned)((q / 24) * LDK + (q % 24) * 8); kst[i] = k_st(q / 24, q % 24); }
  const unsigned voff0 = (unsigned)(sr * LDK + sc), voff1 = (unsigned)((32 + sr) * LDK + sc);
  const int vb0 = (int)(uintptr_t)V_lds + v_rd_base(lane); const int kb0 = (int)(uintptr_t)K_lds + k_rd_base(r32, hi);
  struct { bf16x8 vs0, vs1, ks0, ks1, ks2; } sr_[1];
#define SLOAD(i, k0) do { const bf16* vt = Vh + (size_t)(k0) * LDK; const bf16* kt = Kh + (size_t)(k0) * LDK; \
    sr_[i].vs0 = *(const bf16x8*)(vt + voff0); sr_[i].vs1 = *(const bf16x8*)(vt + voff1); \
    sr_[i].ks0 = *(const bf16x8*)(kt + koff[0]); sr_[i].ks1 = *(const bf16x8*)(kt + koff[1]); sr_[i].ks2 = *(const bf16x8*)(kt + koff[2]); } while (0)
#define SWRITE(b, i) do { *(bf16x8*)(V_lds + (b) * SHM_V + vst0) = sr_[i].vs0; *(bf16x8*)(V_lds + (b) * SHM_V + vst1) = sr_[i].vs1; \
    *(bf16x8*)(K_lds + (b) * SHM_K + kst[0]) = sr_[i].ks0; *(bf16x8*)(K_lds + (b) * SHM_K + kst[1]) = sr_[i].ks1; *(bf16x8*)(K_lds + (b) * SHM_K + kst[2]) = sr_[i].ks2; } while (0)
#define SWAIT() do { if constexpr (SDEPTH == 2) asm volatile("s_waitcnt vmcnt(5)" ::: "memory"); else asm volatile("s_waitcnt vmcnt(0)" ::: "memory"); } while (0)
#define RESC(a) do { if (__any((a) < 1.f)) { if (hi == 0) al_l[r32] = (a); asm volatile("s_waitcnt lgkmcnt(0)" ::: "memory"); \
    _Pragma("unroll") for (int d = 0; d < 4; ++d) _Pragma("unroll") for (int r = 0; r < 16; ++r) o[d][r] *= al_l[crow(r, hi)]; } } while (0)
  f32x16 pA0, pA1, pB0, pB1; float mnA, mnB, alA, alB; bf16x8 pa0, pa1, pa2, pa3; const int NT = seq / KVBLK;
#define PSM(P0, P1, MN, AL) do { if constexpr (FAST) { partialSM_fast(P0, P1, negMC); AL = 1.f; } else partialSM(P0, P1, m_reg, MN, AL); } while (0)
#define RSC(AL) do { if constexpr (!FAST) RESC(AL); } while (0)
  SLOAD(0, 0); asm volatile("s_waitcnt vmcnt(0)" ::: "memory"); SWRITE(0, 0); __syncthreads();
  qkt(pA0, pA1, kb0, qr, qb0); PSM(pA0, pA1, mnA, alA);
  SLOAD(0, KVBLK);
  asm volatile("s_waitcnt vmcnt(0)" ::: "memory"); SWRITE(1, 0); __syncthreads();
  for (int j = 1; j + 1 < NT; j += 2) {
    SBAR(); qkt(pB0, pB1, kb0 + SHM_K, qr, qb0);
    finishSM(pA0, pA1, alA, l_reg, pa0, pa1, pa2, pa3); SBAR();
    SLOAD(0, (j + 1) * KVBLK); SBAR();
    pv_d0(o, vb0, pa0, pa1, pa2, pa3); PSM(pB0, pB1, mnB, alB);
    __syncthreads(); asm volatile("s_waitcnt vmcnt(0)" ::: "memory"); SWRITE(0, 0);
    RSC(alB); __syncthreads();
    SBAR(); qkt(pA0, pA1, kb0, qr, qb0);
    finishSM(pB0, pB1, alB, l_reg, pa0, pa1, pa2, pa3); SBAR();
    SLOAD(0, (j + 2) * KVBLK); SBAR();
    pv_d0(o, vb0 + (int)SHM_V, pa0, pa1, pa2, pa3); PSM(pA0, pA1, mnA, alA);
    __syncthreads(); asm volatile("s_waitcnt vmcnt(0)" ::: "memory"); SWRITE(1, 0);
    RSC(alA); __syncthreads();
  }
  SBAR(); qkt(pB0, pB1, kb0 + SHM_K, qr, qb0);
  finishSM(pA0, pA1, alA, l_reg, pa0, pa1, pa2, pa3); SBAR();
  pv_d0(o, vb0, pa0, pa1, pa2, pa3); PSM(pB0, pB1, mnB, alB);
  __syncthreads(); RSC(alB);
  finishSM(pB0, pB1, alB, l_reg, pa0, pa1, pa2, pa3); SBAR();
  pv_d0(o, vb0 + (int)SHM_V, pa0, pa1, pa2, pa3);
  if (hi == 0) li_l[r32] = l_reg; asm volatile("s_waitcnt lgkmcnt(0)" ::: "memory");
  bf16* Ow = Ob + (unsigned)(wid * QBLK * LDO + r32);
#pragma unroll
  for (int r = 0; r < 16; ++r) { const int orow = crow(r, hi); const float rl = __builtin_amdgcn_rcpf(li_l[orow]);
#pragma unroll
    for (int d0 = 0; d0 < 4; ++d0) { const unsigned w = cvtpk(o[d0][r] * rl, 0.f); Ow[(unsigned)(orow * LDO + d0 * 32)] = (bf16)(w & 0xffffu); } }
  __syncthreads();
#undef SLOAD
#undef SWRITE
#undef SWAIT
#undef RESC
#undef PSM
#undef RSC
}
}
namespace hy {
#define HY_LAS __attribute__((address_space(3)))
typedef unsigned short bf16;
typedef short bf16x8 __attribute__((ext_vector_type(8)));
typedef float f32x16 __attribute__((ext_vector_type(16)));
typedef unsigned u32x2 __attribute__((ext_vector_type(2)));
typedef unsigned u32x4 __attribute__((ext_vector_type(4)));
constexpr int L = 2048, NB = 24, CH = 512;
constexpr int RFS = 4112;
constexpr int ZROW = 4112;
constexpr int ZL_BYTES = NB * ZROW;
constexpr int RCS = 8256;
constexpr int RC_OFF = ZL_BYTES;
constexpr int HY_LDS_BYTES = RC_OFF + 4 * RCS;
__device__ __forceinline__ unsigned cvtpk(float lo, float hi) { unsigned r; asm volatile("v_cvt_pk_bf16_f32 %0, %1, %2" : "=v"(r) : "v"(lo), "v"(hi)); return r; }
__host__ __device__ __forceinline__ int frag_base(int tw, int r, int h) { const int a = (4 - (r & 3)) & 3; return RC_OFF + a * RCS + 2 * (2048 - tw - r + 8 * h - a); }
__host__ __device__ __forceinline__ int zfrag_base(int r, int h) { return (r < NB ? r : NB - 1) * ZROW + 16 * h; }

__device__ __forceinline__ bf16x8 ld_frag(HY_LAS unsigned char* lds, int off) {
    const u32x2 lo = *(const HY_LAS u32x2*)(lds + off), hi = *(const HY_LAS u32x2*)(lds + off + 8);
    u32x4 w = {lo.x, lo.y, hi.x, hi.y}; return *reinterpret_cast<bf16x8*>(&w);
}
__device__ __forceinline__ bf16x8 ld_b128(HY_LAS unsigned char* lds, int off) { return *(const HY_LAS bf16x8*)(lds + off); }

__device__ __forceinline__ void conv_unit(HY_LAS unsigned char* lds, const bf16* __restrict__ ZT, const bf16* __restrict__ RF, bf16* __restrict__ YC, int c, int half) {
    const int tid = opq(threadIdx.x), wid = tid >> 6, lane = tid & 63, r = lane & 31, h = lane >> 5;
    { const u32x4* src = (const u32x4*)(ZT + (size_t)c * NB * L);
#pragma unroll
      for (int i = 0; i < 12; ++i) { const int q = tid + 512 * i; const u32x4 v = src[q]; *(HY_LAS u32x4*)(lds + (q >> 8) * ZROW + (q & 255) * 16) = v; } }
    { const bf16* rf = RF + (size_t)c * RFS;
      for (int ch = tid; ch < RFS / 8; ch += 512) {
          const u32x4 v = *(const u32x4*)(rf + ch * 8); const unsigned w[4] = {v.x, v.y, v.z, v.w};
#pragma unroll
          for (int j = 0; j < 8; ++j) { const unsigned short e = (unsigned short)((w[j >> 1] >> ((j & 1) * 16)) & 0xffffu); const int idx = ch * 8 + j;
#pragma unroll
              for (int a = 0; a < 4; ++a) if (idx - a >= 0) *(HY_LAS unsigned short*)(lds + RC_OFF + a * RCS + 2 * (idx - a)) = e; } } }
    __syncthreads();
    const int tw = half * 1024 + wid * 128;
    const int fb = frag_base(tw, r, h), zb = zfrag_base(r, h);
    f32x16 acc[4] = {};
    bf16x8 S0[2], S1[2], S2[2], S3[2], Bc[2], Bn[2];
#define HY_LDG(S, d) do { S[0] = ld_frag(lds, fb + 64 * (d)); S[1] = ld_frag(lds, fb + 64 * (d) + 32); } while (0)
#define HY_LDB(Bx, n) do { Bx[0] = ld_b128(lds, zb + 64 * (n)); Bx[1] = ld_b128(lds, zb + 64 * (n) + 32); } while (0)
#define HY_MM(i, S, Bx) do { acc[i] = __builtin_amdgcn_mfma_f32_32x32x16_bf16(S[0], Bx[0], acc[i], 0, 0, 0); acc[i] = __builtin_amdgcn_mfma_f32_32x32x16_bf16(S[1], Bx[1], acc[i], 0, 0, 0); } while (0)
#define HY_ITER(n, Sa, Sb, Sc, Sd, Bcur, Bnext) do { HY_LDG(Sa, (n)); if ((n) + 1 < 64) HY_LDB(Bnext, (n) + 1); \
        HY_MM(1, Sb, Bcur); HY_MM(2, Sc, Bcur); HY_MM(3, Sd, Bcur); HY_MM(0, Sa, Bcur); } while (0)
    HY_LDG(S3, -1); HY_LDG(S2, -2); HY_LDG(S1, -3); HY_LDB(Bc, 0);
    for (int n = 0; n < 64; n += 4) {
        HY_ITER(n, S0, S3, S2, S1, Bc, Bn);
        HY_ITER(n + 1, S1, S0, S3, S2, Bn, Bc);
        HY_ITER(n + 2, S2, S1, S0, S3, Bc, Bn);
        HY_ITER(n + 3, S3, S2, S1, S0, Bn, Bc);
    }
#undef HY_LDG
#undef HY_LDB
#undef HY_MM
#undef HY_ITER
    if (r < NB) { bf16* yp = YC + ((size_t)c * NB + r) * L + tw + 4 * h;
#pragma unroll
        for (int i = 0; i < 4; ++i)
#pragma unroll
            for (int q4 = 0; q4 < 4; ++q4) { u32x2 w; w.x = cvtpk(acc[i][4 * q4 + 0], acc[i][4 * q4 + 1]); w.y = cvtpk(acc[i][4 * q4 + 2], acc[i][4 * q4 + 3]);
                *(u32x2*)(yp + 32 * i + 8 * q4) = w; } }
    __syncthreads();
}
}
constexpr int NWAVES = 8;
#ifndef MK_ONE_LAUNCH
#define MK_ONE_LAUNCH 1
#endif
constexpr int DM = 2048, NSEQ = 24, SEQ = 2048, M = NSEQ * SEQ, MP = 8 * SEQ;
constexpr int DEPTH = 4;
constexpr int DIN = 2880, DINP = 3072;
constexpr int O_CQ = 512, O_CKV = 1024, O_KPE = 1280, O_HY = 1344;
constexpr int NH = 8, NQ = 1536, NKVP = 2560, KVHS = 320;
constexpr int DFF = 5632, NUP = 11264, HYC = 512;
constexpr float EPS = 1e-6f;
constexpr int NPH = 11;
constexpr size_t WS_CTL = 0, CTL_BYTES = 1u << 20;
constexpr size_t SZ_BTIN = (size_t)DINP * DM * 2, SZ_BTUQ = (size_t)NQ * 512 * 2, SZ_BTKV = (size_t)NKVP * 256 * 2, SZ_BTOUT = (size_t)DM * DM * 2, SZ_BTUP = (size_t)NUP * DM * 2, SZ_BTDN = (size_t)DM * DFF * 2;
constexpr size_t WS_BTIN = WS_CTL + CTL_BYTES, WS_BTUQ = WS_BTIN + SZ_BTIN, WS_BTKV = WS_BTUQ + SZ_BTUQ, WS_BTOUT = WS_BTKV + SZ_BTKV, WS_BTUP = WS_BTOUT + SZ_BTOUT, WS_BTDN = WS_BTUP + SZ_BTUP;
constexpr size_t WS_RF = WS_BTDN + SZ_BTDN, SZ_RF = (size_t)HYC * hy::RFS * 2;
constexpr size_t WS_H = WS_RF + SZ_RF, SZ_H = (size_t)M * DM * 2;
constexpr size_t WS_PROJ = WS_H + SZ_H, SZ_PROJ = (size_t)M * DINP * 2;
constexpr size_t WS_Q = WS_PROJ + SZ_PROJ, SZ_Q = (size_t)M * NQ * 2;
constexpr size_t WS_KV = WS_Q + SZ_Q, SZ_KV = (size_t)M * NKVP * 2;
constexpr size_t WS_ZT = WS_KV + SZ_KV, SZ_ZT = (size_t)HYC * NSEQ * SEQ * 2;
constexpr size_t WS_X0 = WS_ZT + SZ_ZT, WS_YC = WS_X0 + SZ_ZT;
constexpr size_t WS_EDGE = WS_YC + SZ_ZT, SZ_EDGE = (size_t)(M / 256) * 2 * 3 * DFF * 4;
constexpr size_t WS_ROPE = WS_EDGE + SZ_EDGE, SZ_ROPE = (size_t)SEQ * 64 * 4;
constexpr size_t WS_SSQP = WS_ROPE + SZ_ROPE, SZ_SSQP = (size_t)M * 32 * 4;
constexpr size_t WS_RSTD = WS_SSQP + SZ_SSQP, SZ_RSTD = (size_t)M * 4;
constexpr size_t WS_XQ = WS_RSTD + SZ_RSTD, SZ_XQ = (size_t)M * DM;
constexpr size_t WS_END = WS_XQ + SZ_XQ;
constexpr size_t WS_ACT = WS_PROJ;
static_assert((size_t)M * DFF * 2 <= SZ_PROJ + SZ_Q + SZ_KV, "ACT overlay");
constexpr size_t WS_XB2 = WS_ACT + (size_t)M * DFF * 2;
static_assert(WS_XB2 + (size_t)M * DM * 2 <= WS_EDGE && WS_XB2 % 256 == 0, "XB2 overlay");
static_assert(WS_BTIN % 256 == 0 && WS_RF % 256 == 0 && WS_H % 256 == 0 && WS_PROJ % 256 == 0 && WS_Q % 256 == 0 && WS_KV % 256 == 0 && WS_ZT % 256 == 0 && WS_EDGE % 256 == 0, "alignment");
constexpr int CW_WMAX = 1024;
constexpr int CW_BAR = 4096;
constexpr int RING_BYTES = 135168;
constexpr int HALO_OFF = RING_BYTES, HALO_BYTES = 4096;
constexpr int MISC_OFF = HALO_OFF + HALO_BYTES;
constexpr int LDS_BYTES = 147456;
static_assert(hy::HY_LDS_BYTES <= RING_BYTES && at::SHM_ATTN <= RING_BYTES && MISC_OFF + 256 <= LDS_BYTES, "LDS map");

#define GAS __attribute__((address_space(1)))
#define LAS __attribute__((address_space(3)))
typedef unsigned short bf16;
typedef unsigned v4u __attribute__((ext_vector_type(4)));
typedef unsigned v2u __attribute__((ext_vector_type(2)));
typedef float f32x4 __attribute__((ext_vector_type(4)));
#define LDS_WAIT() asm volatile("s_waitcnt lgkmcnt(0)" ::: "memory")
__device__ __forceinline__ unsigned f2bf(float f) { unsigned u = __builtin_bit_cast(unsigned, f); return (u + 0x7fffu + ((u >> 16) & 1u)) >> 16; }
__device__ __forceinline__ unsigned pk2(float lo, float hi) { return f2bf(lo) | (f2bf(hi) << 16); }
__device__ __forceinline__ float bf2f(unsigned short b) { return __builtin_bit_cast(float, (unsigned)b << 16); }
__device__ __forceinline__ float bflo(unsigned w) { return __builtin_bit_cast(float, w << 16); }
__device__ __forceinline__ float bfhi(unsigned w) { return __builtin_bit_cast(float, w & 0xffff0000u); }
__device__ __forceinline__ float wave_sum(float v) {
#pragma unroll
    for (int o = 1; o < 64; o <<= 1) v += __shfl_xor(v, o);
    return v;
}

#define XB_TMO      128
#define XB_XCNT(j)  (256  + 64 * (j))
#define XB_XSUB(j)  (1280 + 64 * (j))
#define XB_XGEN(j)  (2304 + 64 * (j))
#define XB_TOP      3328
#define XB_TOPGEN   3392
#define XCD_BAR_WORDS 3456
#define XB_SPIN_CAP (1u << 18)
__device__ __forceinline__ unsigned xb_ld(unsigned* p)              { return __hip_atomic_load(p, __ATOMIC_RELAXED, __HIP_MEMORY_SCOPE_AGENT); }
__device__ __forceinline__ unsigned xb_add(unsigned* p, unsigned v) { return __hip_atomic_fetch_add(p, v, __ATOMIC_RELAXED, __HIP_MEMORY_SCOPE_AGENT); }
__device__ __forceinline__ unsigned xb_xcc_id() { return (unsigned)__builtin_amdgcn_s_getreg((3 << 11) | 20) & 0xFu; }
#define XB_SPIN(cond, bar) do { unsigned _sp = 0; while (cond) { __builtin_amdgcn_s_sleep(1); \
    if ((++_sp & 255u) == 0u) { if (xb_ld(&(bar)[XB_TMO])) break; if (_sp > XB_SPIN_CAP) { atomicAdd(&(bar)[XB_TMO], 1u); break; } } } } while (0)
struct XcdBarrier { unsigned* bar; unsigned x; volatile LAS unsigned* st; };
__device__ __forceinline__ XcdBarrier xcd_barrier_post(unsigned* bar, volatile LAS unsigned* st) {
    XcdBarrier b; b.bar = bar; b.x = xb_xcc_id(); b.st = st;
    if (threadIdx.x == 0) (void)xb_add(&bar[XB_XCNT(b.x)], 1u);
    return b;
}
__device__ __forceinline__ void xcd_barrier_complete(unsigned* bar, unsigned x, unsigned& nloc, unsigned& nx) {
    const unsigned G = gridDim.x * gridDim.y * gridDim.z;
    unsigned sum, cnt, mine, sp = 0u;
    for (;;) {
        sum = 0u; cnt = 0u; mine = 0u;
#pragma unroll
        for (unsigned j = 0; j < 16; ++j) { const unsigned c = xb_ld(&bar[XB_XCNT(j)]); sum += c; cnt += (c > 0u) ? 1u : 0u; mine = (j == x) ? c : mine; }
        if (sum == G) break;
        __builtin_amdgcn_s_sleep(1);
        if ((++sp & 255u) == 0u) { if (xb_ld(&bar[XB_TMO])) break; if (sp > XB_SPIN_CAP) { atomicAdd(&bar[XB_TMO], 1u); break; } }
    }
    nloc = mine > 0u ? mine : 1u; nx = cnt > 0u ? cnt : 1u;
}
__device__ __forceinline__ void xcd_barrier(const XcdBarrier& b) {
    asm volatile("s_waitcnt vmcnt(0)" ::: "memory");
    __syncthreads();
    if (threadIdx.x == 0) {
        unsigned* bar = b.bar;
        __builtin_amdgcn_s_waitcnt(0);
        unsigned nloc = b.st[0], nx = b.st[1];
        if (nloc == 0u) { xcd_barrier_complete(bar, b.x, nloc, nx); b.st[0] = nloc; b.st[1] = nx; }
        const unsigned old = xb_add(&bar[XB_XSUB(b.x)], 1u);
        const unsigned gen = old / nloc;
        if (old + 1u == (gen + 1u) * nloc) {
            __builtin_amdgcn_fence(__ATOMIC_RELEASE, "agent");
            asm volatile("s_waitcnt vmcnt(0)" ::: "memory");
            const unsigned og = xb_add(&bar[XB_TOP], 1u);
            const unsigned tg = og / nx;
            if (og + 1u == (tg + 1u) * nx) xb_add(&bar[XB_TOPGEN], 1u);
            else XB_SPIN(xb_ld(&bar[XB_TOPGEN]) == tg, bar);
            __builtin_amdgcn_fence(__ATOMIC_ACQUIRE, "agent");
            xb_add(&bar[XB_XGEN(b.x)], 1u);
            asm volatile("s_waitcnt vmcnt(0)" ::: "memory");
        } else {
            XB_SPIN(xb_ld(&bar[XB_XGEN(b.x)]) == gen, bar);
            __builtin_amdgcn_fence(__ATOMIC_ACQUIRE, "agent");
            asm volatile("s_waitcnt vmcnt(0)" ::: "memory");
        }
    }
    __syncthreads();
}

struct Frame {
    LAS unsigned char* lds;
    int tid, lane, wave, vcu, G;
};
enum { I_XP = 0, I_XS, I_ANG, I_WIN, I_PW, I_PS, I_QNG, I_WUQ, I_KVNG, I_WUKV, I_QHG, I_KHG, I_HCW, I_HCB, I_FW1, I_FB1, I_FFR, I_FW2, I_FB2, I_FW3, I_FB3, I_HBIAS, I_GNG, I_WOUT, I_FNG, I_WUP, I_FCW, I_FCB, I_WDN, N_IN };
struct Args { const float* in[N_IN]; float* out; unsigned char* ws; int ph_lo, ph_hi; };
static_assert(sizeof(Args) == (N_IN + 2) * 8 + 8, "Args has no padding");

__device__ __forceinline__ void cvt_item(const float* __restrict__ W, int ldw, int K, bf16* WT, int dst_n0, int src_n0, int k0, const float* __restrict__ ks, LAS float* scr, int lane) {
#pragma unroll
    for (int i = 0; i < 32; ++i) { const int kk = 2 * i + (lane >> 5); float v = W[(size_t)(k0 + kk) * ldw + src_n0 + (lane & 31)]; if (ks) v *= ks[k0 + kk]; scr[kk * 33 + (lane & 31)] = v; }
    LDS_WAIT(); asm volatile("" ::: "memory");
    const int c = lane & 7;
#pragma unroll
    for (int j = 0; j < 4; ++j) { const int n = (lane >> 3) + 8 * j; const LAS float* s = scr + (8 * c) * 33 + n;
        v4u o; o.x = pk2(s[0 * 33], s[1 * 33]); o.y = pk2(s[2 * 33], s[3 * 33]); o.z = pk2(s[4 * 33], s[5 * 33]); o.w = pk2(s[6 * 33], s[7 * 33]);
        *(v4u*)(WT + (size_t)(dst_n0 + n) * K + k0 + 8 * c) = o; }
    LDS_WAIT(); asm volatile("" ::: "memory");
}
struct CvtTile { const float* W; const float* ks; bf16* WT; int ldw, K, src_n0, k0, ncols; int dst[4]; };
__device__ __forceinline__ void cvt_tile(Frame& F, const CvtTile& d) {
    LAS float* T = (LAS float*)F.lds;
#pragma unroll
    for (int i = 0; i < 8; ++i) { const int q = F.tid + 512 * i, row = q >> 5, c4 = q & 31;
        f32x4 v = {0.f, 0.f, 0.f, 0.f};
        if (d.src_n0 + 4 * c4 < d.ncols) v = *(const f32x4*)(d.W + (size_t)(d.k0 + row) * d.ldw + d.src_n0 + 4 * c4);
        if (d.ks) v *= d.ks[d.k0 + row];
        LAS float* t = T + row * 129 + 4 * c4; t[0] = v.x; t[1] = v.y; t[2] = v.z; t[3] = v.w; }
    __syncthreads();
#pragma unroll
    for (int i = 0; i < 4; ++i) { const int n = (F.tid >> 4) + 32 * i, kc = F.tid & 15;
        if (d.src_n0 + n < d.ncols) { const LAS float* s = T + (8 * kc) * 129 + n;
            v4u o; o.x = pk2(s[0], s[129]); o.y = pk2(s[2 * 129], s[3 * 129]); o.z = pk2(s[4 * 129], s[5 * 129]); o.w = pk2(s[6 * 129], s[7 * 129]);
            *(v4u*)(d.WT + (size_t)(d.dst[i] + (n & 31)) * d.K + d.k0 + 8 * kc) = o; } }
    __syncthreads();
}
__device__ __forceinline__ void absmax_tile(Frame& F, const float* __restrict__ W, const float* __restrict__ ks, int ldw, int src_n0, int k0, unsigned* out) {
    float m = 0.f;
#pragma unroll
    for (int i = 0; i < 8; ++i) { const int q = F.tid + 512 * i, row = q >> 5, c4 = q & 31;
        const f32x4 v = *(const f32x4*)(W + (size_t)(k0 + row) * ldw + src_n0 + 4 * c4) * ks[k0 + row];
        m = fmaxf(m, fmaxf(fmaxf(fabsf(v.x), fabsf(v.y)), fmaxf(fabsf(v.z), fabsf(v.w)))); }
#pragma unroll
    for (int o = 1; o < 64; o <<= 1) m = fmaxf(m, __shfl_xor(m, o));
    if (F.lane == 0) atomicMax(out, __builtin_bit_cast(unsigned, m));
}
__device__ __forceinline__ unsigned q8(float v) { const int q = (int)__builtin_rintf(v); return (unsigned)(q < -127 ? -127 : (q > 127 ? 127 : q)) & 0xffu; }
__device__ __forceinline__ void cvtq_tile(Frame& F, const float* __restrict__ W, const float* __restrict__ ks, int ldw, int K, unsigned char* WT, int src_n0, int k0, int dst0, float inv_s) {
    LAS float* T = (LAS float*)F.lds;
#pragma unroll
    for (int i = 0; i < 8; ++i) { const int q = F.tid + 512 * i, row = q >> 5, c4 = q & 31;
        const f32x4 v = *(const f32x4*)(W + (size_t)(k0 + row) * ldw + src_n0 + 4 * c4) * (ks[k0 + row] * inv_s);
        LAS float* t = T + row * 129 + 4 * c4; t[0] = v.x; t[1] = v.y; t[2] = v.z; t[3] = v.w; }
    __syncthreads();
#pragma unroll
    for (int i = 0; i < 2; ++i) { const int n = (F.tid >> 3) + 64 * i, kc = F.tid & 7;
        const LAS float* s = T + (16 * kc) * 129 + n; unsigned w[4];
#pragma unroll
        for (int j = 0; j < 4; ++j) w[j] = q8(s[(4 * j) * 129]) | (q8(s[(4 * j + 1) * 129]) << 8) | (q8(s[(4 * j + 2) * 129]) << 16) | (q8(s[(4 * j + 3) * 129]) << 24);
        v4u o; o.x = w[0]; o.y = w[1]; o.z = w[2]; o.w = w[3];
        *(v4u*)(WT + (size_t)(dst0 + 64 * (n >> 5) + (n & 31)) * K + k0 + 16 * kc) = o; }
    __syncthreads();
}
__device__ __forceinline__ void xq_row(const bf16* __restrict__ xrow, unsigned char* qrow, const float* __restrict__ ssq32, float* rowf, float s_w, int lane) {
    v4u v[4]; float m = 0.f;
#pragma unroll
    for (int j = 0; j < 4; ++j) { v[j] = *(const v4u*)(xrow + 8 * (lane + 64 * j)); const unsigned w[4] = {v[j].x, v[j].y, v[j].z, v[j].w};
#pragma unroll
        for (int i = 0; i < 4; ++i) m = fmaxf(m, fmaxf(fabsf(bflo(w[i])), fabsf(bfhi(w[i])))); }
    float ss = (lane < 32) ? ssq32[lane] : 0.f;
#pragma unroll
    for (int o = 1; o < 64; o <<= 1) { m = fmaxf(m, __shfl_xor(m, o)); ss += __shfl_xor(ss, o); }
    m = fmaxf(m, 1e-30f); const float inv = 127.0f / m;
    if (lane == 0) *rowf = (1.0f / sqrtf(ss * (1.f / DM) + EPS)) * (m * (1.0f / 127.0f)) * s_w;
#pragma unroll
    for (int j = 0; j < 4; ++j) { const unsigned w[4] = {v[j].x, v[j].y, v[j].z, v[j].w}; v2u o;
        o.x = q8(bflo(w[0]) * inv) | (q8(bfhi(w[0]) * inv) << 8) | (q8(bflo(w[1]) * inv) << 16) | (q8(bfhi(w[1]) * inv) << 24);
        o.y = q8(bflo(w[2]) * inv) | (q8(bfhi(w[2]) * inv) << 8) | (q8(bflo(w[3]) * inv) << 16) | (q8(bfhi(w[3]) * inv) << 24);
        *(v2u*)(qrow + 8 * (lane + 64 * j)) = o; }
}
__device__ __forceinline__ void xb_row(const float* xrow, bf16* orow, float* rstd, int lane) {
    const f32x4* xr = (const f32x4*)xrow + lane;
    f32x4 v[8]; float s = 0.f;
#pragma unroll
    for (int j = 0; j < 8; ++j) { v[j] = xr[64 * j]; s += (v[j].x * v[j].x + v[j].y * v[j].y) + (v[j].z * v[j].z + v[j].w * v[j].w); }
    const float r = 1.0f / sqrtf(wave_sum(s) * (1.f / DM) + EPS);
    if (lane == 0) *rstd = r;
    v2u* o8 = (v2u*)orow + lane;
#pragma unroll
    for (int j = 0; j < 8; ++j) { v2u w; w.x = pk2(v[j].x, v[j].y); w.y = pk2(v[j].z, v[j].w); o8[64 * j] = w; }
}
__device__ __forceinline__ void rstd_from_partials(const float* __restrict__ ssqp, float* rstd, size_t gtid, size_t gthreads) {
    for (size_t r = gtid; r < (size_t)M; r += gthreads) { const f32x4* p = (const f32x4*)(ssqp + r * 32); f32x4 a = p[0];
#pragma unroll
        for (int i = 1; i < 8; ++i) a += p[i];
        rstd[r] = 1.0f / sqrtf(((a.x + a.y) + (a.z + a.w)) * (1.f / DM) + EPS); }
}
__device__ __forceinline__ void tile_norm_store(LAS float* tile, bf16* dst, int row0, int col_off, int wave, int lane) {
#pragma unroll
    for (int i = 0; i < 8; ++i) { const int t = wave * 8 + i;
        const f32x4 a = *(LAS f32x4*)(tile + t * 512 + 8 * lane), b = *(LAS f32x4*)(tile + t * 512 + 8 * lane + 4);
        const float s = (a.x * a.x + a.y * a.y) + (a.z * a.z + a.w * a.w) + (b.x * b.x + b.y * b.y) + (b.z * b.z + b.w * b.w);
        const float rstd = 1.0f / sqrtf(wave_sum(s) * (1.f / 512.f) + EPS);
        v4u o; o.x = pk2(a.x * rstd, a.y * rstd); o.y = pk2(a.z * rstd, a.w * rstd); o.z = pk2(b.x * rstd, b.y * rstd); o.w = pk2(b.z * rstd, b.w * rstd);
        *(v4u*)(dst + (size_t)(row0 + t) * DM + col_off + 8 * lane) = o; }
}
__device__ __forceinline__ void poolfold_item(Frame& F, const float* __restrict__ win, const float* __restrict__ pw, const float* __restrict__ ps, const float* __restrict__ g1, bf16* BtIn, int g, int kb) {
    LAS float* At = (LAS float*)F.lds; LAS float* Bt = (LAS float*)(F.lds + 32768);
    const int k0 = 64 * kb;
#pragma unroll
    for (int i = 0; i < 4; ++i) { const int q = F.tid + 512 * i, row = q >> 5, c4 = q & 31; *(LAS f32x4*)(At + row * 128 + 4 * c4) = *(const f32x4*)(win + (size_t)(k0 + row) * DIN + 128 * g + 4 * c4) * g1[k0 + row]; }
#pragma unroll
    for (int i = 0; i < 8; ++i) { const int q = F.tid + 512 * i, row = q >> 5, c4 = q & 31; *(LAS f32x4*)(Bt + row * 128 + 4 * c4) = *(const f32x4*)(pw + (size_t)(g * 128 + row) * 128 + 4 * c4); }
    __syncthreads();
    const int n = F.tid & 127, kg = F.tid >> 7;
    float acc[16];
#pragma unroll
    for (int i = 0; i < 16; ++i) acc[i] = 0.f;
    for (int j = 0; j < 128; j += 4) {
        const float b0 = Bt[(j + 0) * 128 + n], b1 = Bt[(j + 1) * 128 + n], b2 = Bt[(j + 2) * 128 + n], b3 = Bt[(j + 3) * 128 + n];
#pragma unroll
        for (int i = 0; i < 16; ++i) { const f32x4 a = *(LAS f32x4*)(At + (kg * 16 + i) * 128 + j); acc[i] += a.x * b0 + a.y * b1 + a.z * b2 + a.w * b3; }
    }
    const float sc = ps[128 * g + n];
    v4u o0, o1;
    o0.x = pk2(acc[0] * sc, acc[1] * sc); o0.y = pk2(acc[2] * sc, acc[3] * sc); o0.z = pk2(acc[4] * sc, acc[5] * sc); o0.w = pk2(acc[6] * sc, acc[7] * sc);
    o1.x = pk2(acc[8] * sc, acc[9] * sc); o1.y = pk2(acc[10] * sc, acc[11] * sc); o1.z = pk2(acc[12] * sc, acc[13] * sc); o1.w = pk2(acc[14] * sc, acc[15] * sc);
    bf16* dst = BtIn + (size_t)(128 * g + n) * DM + k0 + kg * 16;
    *(v4u*)dst = o0; *(v4u*)(dst + 8) = o1;
    __syncthreads();
}
__device__ __forceinline__ void filter_item(Frame& F, const float* __restrict__ w1, const float* __restrict__ b1, const float* __restrict__ fr, const float* __restrict__ w2, const float* __restrict__ b2,
                                            const float* __restrict__ w3, const float* __restrict__ b3, const float* __restrict__ hbias, bf16* RF, int fi) {
    LAS float* ZF = (LAS float*)F.lds; LAS float* H1 = ZF + 512; LAS float* H2 = ZF + 1536; LAS float* W1s = ZF + 2560; LAS float* W2s = ZF + 3712;
    const int t0 = 16 * fi;
    for (int q = F.tid; q < 272; q += 512) *(LAS f32x4*)(W1s + 4 * q) = *(const f32x4*)(w1 + 4 * q);
#pragma unroll
    for (int i = 0; i < 2; ++i) { const int q = F.tid + 512 * i; *(LAS f32x4*)(W2s + 4 * q) = *(const f32x4*)(w2 + 4 * q); }
    if (F.tid < 272) { const int tt = F.tid / 17, f = F.tid % 17; const float t = (float)(t0 + tt);
        float v;
        if (f == 0) v = t / 2047.0f;
        else { const int j = (f - 1) & 7; const float band = 1e-4f + (float)j * ((7.0f - 1e-4f) / 7.0f); const float w = (6.283185307179586f * t) / 2048.0f; const float a = band * w; v = (f <= 8) ? __cosf(a) : -__sinf(a); }
        ZF[tt * 17 + f] = v; }
    __syncthreads();
#pragma unroll
    for (int rep = 0; rep < 2; ++rep) { const int p = F.tid + 512 * rep, tt = p >> 6, j = p & 63; float s = b1[j];
#pragma unroll
        for (int i = 0; i < 17; ++i) s += ZF[tt * 17 + i] * W1s[i * 64 + j];
        H1[tt * 64 + j] = __sinf(fr[j] * s); }
    __syncthreads();
#pragma unroll
    for (int rep = 0; rep < 2; ++rep) { const int p = F.tid + 512 * rep, tt = p >> 6, j = p & 63; float s = b2[j];
#pragma unroll 16
        for (int i = 0; i < 64; ++i) s += H1[tt * 64 + i] * W2s[i * 64 + j];
        H2[tt * 64 + j] = __sinf(fr[j] * s); }
    __syncthreads();
    const int c = F.tid;
    const float delta = -3.0701134573253944f + (float)c * ((-15.350567286626972f + 3.0701134573253944f) / 511.0f);
    const float ad = fabsf(delta);
    bf16* rf = RF + (size_t)c * hy::RFS;
#pragma unroll 1
    for (int dir = 0; dir < 2; ++dir) { const int o = dir * 512 + c; const float bo = b3[o];
        float wc[64];
#pragma unroll
        for (int i = 0; i < 64; ++i) wc[i] = w3[i * 1024 + o];
#pragma unroll 1
        for (int tt = 0; tt < 16; ++tt) { float s = bo;
#pragma unroll
            for (int i = 0; i < 64; i += 4) { const f32x4 hv = *(LAS f32x4*)(H2 + tt * 64 + i); s += (hv.x * wc[i] + hv.y * wc[i + 1]) + (hv.z * wc[i + 2] + hv.w * wc[i + 3]); }
            const int t = t0 + tt; const float tl = (float)t / 2047.0f; float val = s * __expf(-tl * ad);
            if (dir == 0) { if (t == 0) val += hbias[c]; rf[2048 - t] = (bf16)f2bf(val); }
            else if (t >= 1) rf[2048 + t] = (bf16)f2bf(val); } }
    if (fi == 0) { rf[0] = 0;
#pragma unroll
        for (int i = 4096; i < hy::RFS; ++i) rf[i] = 0; }
    __syncthreads();
}
__device__ __forceinline__ void unpack4(const v2u w, float (&x)[4]) { x[0] = bflo(w.x); x[1] = bfhi(w.x); x[2] = bflo(w.y); x[3] = bfhi(w.y); }
__device__ __forceinline__ void pair_norm_store(Frame& F, const float (&y)[8][4], bf16* dst, size_t row0, int col_off, int cq) {
    LAS float* part = (LAS float*)F.lds;
    float ss[8];
#pragma unroll
    for (int k = 0; k < 8; ++k) ss[k] = wave_sum((y[k][0] * y[k][0] + y[k][1] * y[k][1]) + (y[k][2] * y[k][2] + y[k][3] * y[k][3]));
    if (F.lane == 0) { *(LAS f32x4*)(part + F.wave * 8) = (f32x4){ss[0], ss[1], ss[2], ss[3]}; *(LAS f32x4*)(part + F.wave * 8 + 4) = (f32x4){ss[4], ss[5], ss[6], ss[7]}; }
    __syncthreads();
    const f32x4 pa = *(LAS f32x4*)(part + (F.wave ^ 1) * 8), pb = *(LAS f32x4*)(part + (F.wave ^ 1) * 8 + 4);
    const float po[8] = {pa.x, pa.y, pa.z, pa.w, pb.x, pb.y, pb.z, pb.w};
#pragma unroll
    for (int k = 0; k < 8; ++k) { const float rstd = 1.0f / sqrtf((ss[k] + po[k]) * (1.f / 512.f) + EPS);
        v2u o; o.x = pk2(y[k][0] * rstd, y[k][1] * rstd); o.y = pk2(y[k][2] * rstd, y[k][3] * rstd);
        *(v2u*)(dst + (row0 + k) * DM + col_off + 4 * cq) = o; }
    __syncthreads();
}
__device__ __forceinline__ void hyprep_item(Frame& F, const bf16* __restrict__ PROJ, const float* __restrict__ cw, const float* __restrict__ cb, bf16* ZT, bf16* X0, int b, int tile) {
    const int tb = F.tid >> 7, cq = F.tid & 127, c0 = 4 * cq, tw = tile * 32 + tb * 8; const size_t rb = (size_t)b * SEQ;
    float z[8][4];
#pragma unroll
    for (int jj = 0; jj < 3; ++jj) { const int j = (jj == 0) ? 1 : (jj == 1) ? 2 : 0; const int cc = 512 * j + c0;
        const f32x4 w0 = *(const f32x4*)(cw + cc), w1 = *(const f32x4*)(cw + 1536 + cc), w2 = *(const f32x4*)(cw + 3072 + cc), bs = *(const f32x4*)(cb + cc);
        float x[10][4];
#pragma unroll
        for (int o = 0; o < 10; ++o) { const int t = tw - 1 + o; const bool ok = (t >= 0) && (t < SEQ); const int tc = ok ? t : tw;
            const v2u w = *(const v2u*)(PROJ + (rb + tc) * DINP + O_HY + cc); unpack4(w, x[o]);
            if (!ok) { x[o][0] = 0.f; x[o][1] = 0.f; x[o][2] = 0.f; x[o][3] = 0.f; } }
        if (jj == 0) {
#pragma unroll
            for (int k = 0; k < 8; ++k)
#pragma unroll
                for (int i = 0; i < 4; ++i) z[k][i] = w0[i] * x[k][i] + w1[i] * x[k + 1][i] + w2[i] * x[k + 2][i] + bs[i];
        } else if (jj == 1) {
#pragma unroll
            for (int k = 0; k < 8; ++k)
#pragma unroll
                for (int i = 0; i < 4; ++i) z[k][i] *= w0[i] * x[k][i] + w1[i] * x[k + 1][i] + w2[i] * x[k + 2][i] + bs[i];
#pragma unroll
            for (int i = 0; i < 4; ++i) { v4u o; o.x = pk2(z[0][i], z[1][i]); o.y = pk2(z[2][i], z[3][i]); o.z = pk2(z[4][i], z[5][i]); o.w = pk2(z[6][i], z[7][i]);
                *(v4u*)(ZT + ((size_t)(c0 + i) * NSEQ + b) * SEQ + tw) = o; }
        } else {
#pragma unroll
            for (int k = 0; k < 8; ++k) { float u0[4];
#pragma unroll
                for (int i = 0; i < 4; ++i) u0[i] = w0[i] * x[k][i] + w1[i] * x[k + 1][i] + w2[i] * x[k + 2][i] + bs[i];
                v2u o; o.x = pk2(u0[0], u0[1]); o.y = pk2(u0[2], u0[3]); *(v2u*)(X0 + (rb + tw + k) * HYC + c0) = o; }
        }
    }
}
__device__ __forceinline__ void pool_item(Frame& F, const bf16* __restrict__ PROJ, bf16* MIXED, int b, int tile) {
    const int tb = F.tid >> 7, cq = F.tid & 127, c0 = 4 * cq, g = cq >> 5, half = 1 << g, tw = tile * 32 + tb * 8; const size_t rb = (size_t)b * SEQ;
    float x[23][4];
#pragma unroll
    for (int o = 0; o < 23; ++o) { const int t = tw - 8 + o; const bool ok = (t >= 0) && (t < SEQ); const int tc = ok ? t : tw;
        const v2u w = *(const v2u*)(PROJ + (rb + tc) * DINP + c0); unpack4(w, x[o]);
        if (!ok) { x[o][0] = 0.f; x[o][1] = 0.f; x[o][2] = 0.f; x[o][3] = 0.f; } }
    float y[8][4];
#pragma unroll
    for (int k = 0; k < 8; ++k) { const int oc = 8 + k, t = tw + k; const int lo = (t - half > 0) ? t - half : 0, hi = (t + half < SEQ) ? t + half : SEQ; const float inv = 1.0f / (float)(hi - lo);
#pragma unroll
        for (int i = 0; i < 4; ++i) {
            const float w1 = x[oc - 1][i] + x[oc][i];
            const float w2 = w1 + (x[oc - 2][i] + x[oc + 1][i]);
            const float w4 = w2 + ((x[oc - 4][i] + x[oc - 3][i]) + (x[oc + 2][i] + x[oc + 3][i]));
            const float w8 = w4 + (((x[oc - 8][i] + x[oc - 7][i]) + (x[oc - 6][i] + x[oc - 5][i])) + ((x[oc + 4][i] + x[oc + 5][i]) + (x[oc + 6][i] + x[oc + 7][i])));
            const float S = (g == 0) ? w1 : (g == 1) ? w2 : (g == 2) ? w4 : w8;
            y[k][i] = S * inv - x[oc][i]; } }
    pair_norm_store(F, y, MIXED, rb + tw, 0, cq);
}
__device__ __forceinline__ void hyfin_item(Frame& F, const bf16* __restrict__ YC, const bf16* __restrict__ X0, bf16* MIXED, int b, int tile) {
    const int tb = F.tid >> 7, cq = F.tid & 127, c0 = 4 * cq, tw = tile * 32 + tb * 8; const size_t rb = (size_t)b * SEQ;
    float yc[4][8], y[8][4];
#pragma unroll
    for (int i = 0; i < 4; ++i) { const v4u v = *(const v4u*)(YC + ((size_t)(c0 + i) * NSEQ + b) * SEQ + tw);
        yc[i][0] = bflo(v.x); yc[i][1] = bfhi(v.x); yc[i][2] = bflo(v.y); yc[i][3] = bfhi(v.y); yc[i][4] = bflo(v.z); yc[i][5] = bfhi(v.z); yc[i][6] = bflo(v.w); yc[i][7] = bfhi(v.w); }
#pragma unroll
    for (int k = 0; k < 8; ++k) { float xv[4]; unpack4(*(const v2u*)(X0 + (rb + tw + k) * HYC + c0), xv);
#pragma unroll
        for (int i = 0; i < 4; ++i) y[k][i] = yc[i][k] * xv[i]; }
    pair_norm_store(F, y, MIXED, rb + tw, 1536, cq);
}
struct PrepGains { float q[3][8], k[3][8]; };
__device__ __forceinline__ void load8(const float* p, float (&o)[8]) { const f32x4 a = *(const f32x4*)p, b = *(const f32x4*)(p + 4); o[0] = a.x; o[1] = a.y; o[2] = a.z; o[3] = a.w; o[4] = b.x; o[5] = b.y; o[6] = b.z; o[7] = b.w; }
__device__ __forceinline__ void unpack8(const v4u w, float (&x)[8]) { x[0] = bflo(w.x); x[1] = bfhi(w.x); x[2] = bflo(w.y); x[3] = bfhi(w.y); x[4] = bflo(w.z); x[5] = bfhi(w.z); x[6] = bflo(w.w); x[7] = bfhi(w.w); }
__device__ __forceinline__ v4u pack8(const float (&x)[8]) { v4u o; o.x = pk2(x[0], x[1]); o.y = pk2(x[2], x[3]); o.z = pk2(x[4], x[5]); o.w = pk2(x[6], x[7]); return o; }
__device__ __forceinline__ float ssq8(const float (&x)[8]) { return ((x[0] * x[0] + x[1] * x[1]) + (x[2] * x[2] + x[3] * x[3])) + ((x[4] * x[4] + x[5] * x[5]) + (x[6] * x[6] + x[7] * x[7])); }
__device__ __forceinline__ float sum8lanes(float v) { v += __shfl_xor(v, 1); v += __shfl_xor(v, 2); v += __shfl_xor(v, 4); return v; }
__device__ __forceinline__ void prep_row(const bf16* __restrict__ PROJ, bf16* Q, bf16* KV, const PrepGains& G, const float* __restrict__ ROPE, int m, int lane) {
    const int h = lane >> 3, sub = lane & 7;
    const bf16* pr = PROJ + (size_t)m * DINP; bf16* qr = Q + (size_t)m * NQ + 192 * h + 8 * sub; bf16* kr = KV + (size_t)m * NKVP + KVHS * h + 8 * sub;
    const v4u cqv = *(const v4u*)(pr + O_CQ + 8 * lane); const v4u ckv = *(const v4u*)(pr + O_CKV + 8 * (lane & 31)); const v4u pev = *(const v4u*)(pr + O_KPE + 8 * sub);
    const v4u q0 = *(const v4u*)(qr), q1 = *(const v4u*)(qr + 64), q2 = *(const v4u*)(qr + 128);
    const v4u k0 = *(const v4u*)(kr), k1 = *(const v4u*)(kr + 64), v0 = *(const v4u*)(kr + 192), v1 = *(const v4u*)(kr + 256);
    float cs[8], sn[8]; { const float* rp = ROPE + (size_t)(m & (SEQ - 1)) * 64 + 8 * (sub & 3); load8(rp, cs); load8(rp + 32, sn); }
    float t[8];
    unpack8(cqv, t); const float rq = 1.0f / sqrtf(wave_sum(ssq8(t)) * (1.f / 512.f) + EPS);
    unpack8(ckv, t); const float rkv = 1.0f / sqrtf(wave_sum(lane < 32 ? ssq8(t) : 0.f) * (1.f / 256.f) + EPS);
    const float sg = (sub < 4) ? -1.f : 1.f;
    { float a0[8], a1[8], a2[8]; unpack8(q0, a0); unpack8(q1, a1); unpack8(q2, a2);
      const float ss = sum8lanes(ssq8(a0) + ssq8(a1) + ssq8(a2)) * (rq * rq);
      const float sc = (rq * (at::SCALE * 1.4426950408889634f)) / sqrtf(ss * (1.f / 192.f) + EPS);
      float r[8], o[8];
#pragma unroll
      for (int i = 0; i < 8; ++i) { a0[i] *= sc * G.q[0][i]; a1[i] *= sc * G.q[1][i]; r[i] = a2[i] * sc * G.q[2][i]; }
#pragma unroll
      for (int i = 0; i < 8; ++i) { const float rp = __shfl_xor(r[i], 4); o[i] = r[i] * cs[i] + sg * rp * sn[i]; }
      *(v4u*)(qr) = pack8(a0); *(v4u*)(qr + 64) = pack8(a1); *(v4u*)(qr + 128) = pack8(o); }
    { float a0[8], a1[8], pe[8], b0[8], b1[8]; unpack8(k0, a0); unpack8(k1, a1); unpack8(pev, pe); unpack8(v0, b0); unpack8(v1, b1);
      const float ss = sum8lanes((ssq8(a0) + ssq8(a1)) * (rkv * rkv) + ssq8(pe));
      const float sk = 1.0f / sqrtf(ss * (1.f / 192.f) + EPS);
      float r[8], o[8];
#pragma unroll
      for (int i = 0; i < 8; ++i) { a0[i] *= rkv * sk * G.k[0][i]; a1[i] *= rkv * sk * G.k[1][i]; r[i] = pe[i] * sk * G.k[2][i]; b0[i] *= rkv; b1[i] *= rkv; }
#pragma unroll
      for (int i = 0; i < 8; ++i) { const float rp = __shfl_xor(r[i], 4); o[i] = r[i] * cs[i] + sg * rp * sn[i]; }
      *(v4u*)(kr) = pack8(a0); *(v4u*)(kr + 64) = pack8(a1); *(v4u*)(kr + 128) = pack8(o); *(v4u*)(kr + 192) = pack8(b0); *(v4u*)(kr + 256) = pack8(b1); }
}
__device__ __forceinline__ void attn_norm_row(bf16* MIXED, int m, int lane) {
    v4u* p = (v4u*)(MIXED + (size_t)m * DM + 512 + 16 * lane); v4u a = p[0], b = p[1];
    unsigned w[8] = {a.x, a.y, a.z, a.w, b.x, b.y, b.z, b.w}; float s = 0.f;
#pragma unroll
    for (int i = 0; i < 8; ++i) { const float x = bflo(w[i]), y = bfhi(w[i]); s += x * x + y * y; }
    const float rstd = 1.0f / sqrtf(wave_sum(s) * (1.f / 1024.f) + EPS);
#pragma unroll
    for (int i = 0; i < 8; ++i) w[i] = pk2(bflo(w[i]) * rstd, bfhi(w[i]) * rstd);
    a.x = w[0]; a.y = w[1]; a.z = w[2]; a.w = w[3]; b.x = w[4]; b.y = w[5]; b.z = w[6]; b.w = w[7]; p[0] = a; p[1] = b;
}

#define DEFPTRS() unsigned char* ws = args.ws; \
    bf16* BtIn = (bf16*)(ws + WS_BTIN); bf16* BtUq = (bf16*)(ws + WS_BTUQ); bf16* BtKv = (bf16*)(ws + WS_BTKV); bf16* BtOut = (bf16*)(ws + WS_BTOUT); bf16* BtUp = (bf16*)(ws + WS_BTUP); bf16* BtDn = (bf16*)(ws + WS_BTDN); \
    bf16* RF = (bf16*)(ws + WS_RF); bf16* Hb = (bf16*)(ws + WS_H); bf16* PROJ = (bf16*)(ws + WS_PROJ); bf16* Qb = (bf16*)(ws + WS_Q); bf16* KVb = (bf16*)(ws + WS_KV); \
    bf16* ZT = (bf16*)(ws + WS_ZT); bf16* X0 = (bf16*)(ws + WS_X0); bf16* YC = (bf16*)(ws + WS_YC); float* EDGE = (float*)(ws + WS_EDGE); float* ROPE = (float*)(ws + WS_ROPE); float* SSQP = (float*)(ws + WS_SSQP); float* RSTD = (float*)(ws + WS_RSTD); bf16* XB2 = (bf16*)(ws + WS_XB2); unsigned char* XQ = (unsigned char*)(ws + WS_XQ); unsigned char* BtUpQ = (unsigned char*)(ws + WS_BTUP); bf16* ACT = (bf16*)(ws + WS_ACT); \
    bf16* XA = (bf16*)args.out; \
    (void)BtIn; (void)BtUq; (void)BtKv; (void)BtOut; (void)BtUp; (void)BtDn; (void)RF; (void)Hb; (void)PROJ; (void)Qb; (void)KVb; (void)ZT; (void)X0; (void)YC; (void)EDGE; (void)ROPE; (void)SSQP; (void)RSTD; (void)XB2; (void)XQ; (void)BtUpQ; (void)ACT; (void)XA
__global__ void __launch_bounds__(NWAVES * 64, 2) fwd(Args args) {
    extern __shared__ __attribute__((aligned(16))) unsigned char lds_raw[];
    Frame F;
    F.lds = (LAS unsigned char*)lds_raw;
    F.tid = threadIdx.x; F.lane = F.tid & 63; F.wave = __builtin_amdgcn_readfirstlane(F.tid >> 6);
    F.G = gridDim.x; { const int bx = blockIdx.x; F.vcu = (F.G % 8 == 0) ? (bx % 8) * (F.G / 8) + bx / 8 : bx; }
    volatile LAS unsigned* MISC = (volatile LAS unsigned*)(F.lds + MISC_OFF);
    if (F.tid < 64) MISC[F.tid] = 0u;
    __syncthreads();
    unsigned* ctl = (unsigned*)(args.ws + WS_CTL);
    const int lo = args.ph_lo, hi = args.ph_hi;
    XcdBarrier bar; bar.bar = ctl + CW_BAR; bar.x = 0; bar.st = MISC + 8;
    if (hi - lo > 1) bar = xcd_barrier_post(ctl + CW_BAR, MISC + 8);
    float* out = args.out;

#pragma unroll 1
    for (int layer = 0; layer < DEPTH; ++layer) {
        const int pb = layer * NPH;
        if (pb + NPH <= lo || pb >= hi) continue;
#define IN(k) (lo <= pb + (k) && pb + (k) < hi)
#define ENTER() DEFPTRS(); F.tid = opq(threadIdx.x); F.lane = F.tid & 63; F.wave = __builtin_amdgcn_readfirstlane(F.tid >> 6); const int gw = F.vcu * NWAVES + F.wave, NGW = F.G * NWAVES, wg = F.vcu; const size_t gtid = (size_t)wg * 512 + F.tid, gthreads = (size_t)F.G * 512; (void)gw; (void)NGW; (void)wg; (void)gtid; (void)gthreads
#define SEAM(k) do { if (pb + (k) + 1 < hi) xcd_barrier(bar); } while (0)

        if (IN(0)) { ENTER();
            const float* win = args.in[I_WIN] + (size_t)layer * DM * DIN; const float* g1 = args.in[I_ANG] + layer * DM;
            for (int it = wg; it < 256; it += F.G) {
                if (it < 128) poolfold_item(F, win, args.in[I_PW] + (size_t)layer * 4 * 128 * 128, args.in[I_PS] + (size_t)layer * 512, g1, BtIn, it >> 5, it & 31);
                else filter_item(F, args.in[I_FW1] + (size_t)layer * 17 * 64, args.in[I_FB1] + layer * 64, args.in[I_FFR] + layer * 64, args.in[I_FW2] + (size_t)layer * 64 * 64, args.in[I_FB2] + layer * 64,
                                 args.in[I_FW3] + (size_t)layer * 64 * 1024, args.in[I_FB3] + layer * 1024, args.in[I_HBIAS] + layer * 512, RF, it - 128);
            }
            constexpr int T_IN = 19 * 16, T_UQ = 12 * 4, T_KV = 16 * 2, T_OUT = 16 * 16, T_UP = 88 * 16, T_DN = 16 * 44, T_ALL = T_IN + T_UQ + T_KV + T_OUT + T_UP + T_DN;
            for (int it = wg; it < T_ALL; it += F.G) {
                int r = it; CvtTile d;
                if (r < T_IN) { const int nt = r >> 4, kt = r & 15, n0 = 512 + 128 * nt; d = CvtTile{win, g1, BtIn, DIN, DM, n0, 128 * kt, DIN, {n0, n0 + 32, n0 + 64, n0 + 96}}; }
                else if ((r -= T_IN) < T_UQ) { const int nt = r >> 2, kt = r & 3, n0 = 128 * nt; d = CvtTile{args.in[I_WUQ] + (size_t)layer * 512 * NQ, args.in[I_QNG] + layer * 512, BtUq, NQ, 512, n0, 128 * kt, NQ, {n0, n0 + 32, n0 + 64, n0 + 96}}; }
                else if ((r -= T_UQ) < T_KV) { const int nt = r >> 1, kt = r & 1, n0 = 128 * nt;
                    d = CvtTile{args.in[I_WUKV] + (size_t)layer * 256 * 2048, args.in[I_KVNG] + layer * 256, BtKv, 2048, 256, n0, 128 * kt, 2048, {n0, n0 + 32, n0 + 64, n0 + 96}}; }
                else if ((r -= T_KV) < T_OUT) { const int nt = r >> 4, kt = r & 15, n0 = 128 * nt; d = CvtTile{args.in[I_WOUT] + (size_t)layer * DM * DM, args.in[I_GNG] + layer * DM, BtOut, DM, DM, n0, 128 * kt, DM, {n0, n0 + 32, n0 + 64, n0 + 96}}; }
                else if ((r -= T_OUT) < T_UP) { const int nt = r >> 4, kt = r & 15;
                    absmax_tile(F, args.in[I_WUP] + (size_t)layer * DM * NUP, args.in[I_FNG] + layer * DM, NUP, 128 * nt, 128 * kt, ctl + CW_WMAX + 64 * layer); continue; }
                else { r -= T_UP; const int nt = r / 44, kt = r % 44, n0 = 128 * nt; d = CvtTile{args.in[I_WDN] + (size_t)layer * DFF * DM, nullptr, BtDn, DM, DFF, n0, 128 * kt, DM, {n0, n0 + 32, n0 + 64, n0 + 96}}; }
                cvt_tile(F, d);
            }
            { unsigned zz = 0u; asm volatile("" : "+v"(zz)); v4u z = {zz, zz, zz, zz};
              for (size_t i = gtid; i < (size_t)(DINP - DIN) * DM / 8; i += gthreads) *(v4u*)(BtIn + (size_t)DIN * DM + i * 8) = z;
}
            if (layer == 0) for (size_t i = gtid; i < (size_t)SEQ * 32; i += gthreads) { const int pos = (int)(i >> 5), ri = (int)(i & 31);
                const float freq = exp2f(-(float)ri * (13.287712379549449f / 32.0f)); float sn, cs; sincosf((float)pos * freq, &sn, &cs); ROPE[pos * 64 + ri] = cs; ROPE[pos * 64 + 32 + ri] = sn; }
            if (layer == 0) { for (int m = gw; m < M; m += NGW) xb_row(m < MP ? args.in[I_XP] + (size_t)m * DM : args.in[I_XS] + (size_t)(m - MP) * DM, XA + (size_t)m * DM, RSTD + m, F.lane); }
            else rstd_from_partials(SSQP, RSTD, gtid, gthreads);
            SEAM(0);
        }
        if (IN(1)) { ENTER();
            pg8::Gemm g{XA, BtIn, M, DINP, DM, DM}; pg8::StaticOrder S; S.init(M, DINP, F.G, (int)blockIdx.x);
            pg8::EpiBf16 E{PROJ, DINP, RSTD, 0};
            pg8::gemm_phase<pg8::EpiBf16, pg8::StaticOrder>(F.lds, g, S, E);
            SEAM(1);
        }
        if (IN(2)) { ENTER();
            { pg8::Gemm g{PROJ + O_CQ, BtUq, M, NQ, 512, DINP}; pg8::StaticOrder S; S.init(M, NQ, F.G, (int)blockIdx.x); pg8::EpiBf16 E{Qb, NQ, nullptr, 0};
              pg8::gemm_phase<pg8::EpiBf16, pg8::StaticOrder>(F.lds, g, S, E); }
            { pg8::Gemm g{PROJ + O_CKV, BtKv, M, 2048, 256, DINP}; pg8::StaticOrder S; S.init(M, 2048, F.G, (int)blockIdx.x); pg8::EpiBf16 E{KVb, NKVP, nullptr, 1};
              pg8::gemm_phase<pg8::EpiBf16, pg8::StaticOrder>(F.lds, g, S, E); }
            const float* hcw = args.in[I_HCW] + (size_t)layer * 3 * 1536; const float* hcb = args.in[I_HCB] + layer * 1536;
            for (int it = wg; it < 2 * NSEQ * 64; it += F.G) {
                if (it < NSEQ * 64) hyprep_item(F, PROJ, hcw, hcb, ZT, X0, it >> 6, it & 63);
                else pool_item(F, PROJ, Hb, (it - NSEQ * 64) >> 6, it & 63);
            }
            SEAM(2);
        }
        if (IN(3)) { ENTER();
            for (int u = wg; u < 2 * HYC; u += F.G) hy::conv_unit(F.lds, ZT, RF, YC, u >> 1, u & 1);
            const float* qhg = args.in[I_QHG] + layer * 192; const float* khg = args.in[I_KHG] + layer * 192;
            PrepGains PG; { const int sub = F.lane & 7;
#pragma unroll
                for (int i = 0; i < 3; ++i) { load8(qhg + 64 * i + 8 * sub, PG.q[i]); load8(khg + 64 * i + 8 * sub, PG.k[i]); } }
            for (int m = gw; m < M; m += NGW) prep_row(PROJ, Qb, KVb, PG, ROPE, m, F.lane);
            SEAM(3);
        }
        if (IN(4)) { ENTER();
            float gqm, gkm; { const float* qhg = args.in[I_QHG] + layer * 192; const float* khg = args.in[I_KHG] + layer * 192;
                gqm = fmaxf(fmaxf(fabsf(qhg[F.lane]), fabsf(qhg[64 + F.lane])), fabsf(qhg[128 + F.lane])); gkm = fmaxf(fmaxf(fabsf(khg[F.lane]), fabsf(khg[64 + F.lane])), fabsf(khg[128 + F.lane]));
#pragma unroll
                for (int o = 1; o < 64; o <<= 1) { gqm = fmaxf(gqm, __shfl_xor(gqm, o)); gkm = fmaxf(gkm, __shfl_xor(gkm, o)); } }
            const float Mnat = 13.856406460551018f * gqm * gkm;
            const bool sm_fast = __builtin_amdgcn_readfirstlane((Mnat <= 40.0f) ? 1 : 0) != 0;
            const float negMC = __builtin_bit_cast(float, __builtin_amdgcn_readfirstlane(__builtin_bit_cast(int, -Mnat * 1.4426950408889634f)));
            for (int i = 0; i * F.G < NSEQ * NH * 8; ++i) {
                int p, qb; const int c = (int)blockIdx.x;
                if (F.G == 256) { p = i * 32 + (c & 7) * 4 + (c >> 6); qb = (c >> 3) & 7; } else { const int Lq = i * F.G + c; p = Lq >> 3; qb = Lq & 7; }
                if (p < NSEQ * NH) { const int b = p >> 3, h = p & 7;
                    const bf16* qp = Qb + (size_t)(b * SEQ + qb * 256) * NQ + h * 192; const bf16* kp = KVb + (size_t)(b * SEQ) * NKVP + h * KVHS; bf16* op = Hb + (size_t)(b * SEQ + qb * 256) * DM + 512 + h * 128;
                    if (sm_fast) at::attn_unit<true>(negMC, qp, kp, kp + 192, op, SEQ, (char*)lds_raw);
                    else at::attn_unit<false>(0.f, qp, kp, kp + 192, op, SEQ, (char*)lds_raw); }
            }
            for (int it = wg; it < NSEQ * 64; it += F.G) hyfin_item(F, YC, X0, Hb, it >> 6, it & 63);
            SEAM(4);
        }
        if (IN(5)) { ENTER();
            for (int m = gw; m < M; m += NGW) attn_norm_row(Hb, m, F.lane);
            SEAM(5);
        }
        if (IN(6)) { ENTER();
            pg8::Gemm g{Hb, BtOut, M, DM, DM, DM}; pg8::StaticOrder S; S.init(M, DM, F.G, (int)blockIdx.x);
            pg8::EpiResid16 E{XA, XB2, out, DM, SSQP, 0};
            pg8::gemm_phase<pg8::EpiResid16, pg8::StaticOrder>(F.lds, g, S, E);
            SEAM(6);
        }
        if (IN(7)) { ENTER();
            const float wmax = fmaxf(__builtin_bit_cast(float, __hip_atomic_load(ctl + CW_WMAX + 64 * layer, __ATOMIC_RELAXED, __HIP_MEMORY_SCOPE_AGENT)), 1e-30f);
            const float s_w = wmax * (1.0f / 127.0f), inv_sw = 127.0f / wmax;
            for (int it = wg; it < 88 * 16; it += F.G) { const int nt = it >> 4, kt = it & 15; const int nv = (nt < 44) ? nt : nt - 44;
                cvtq_tile(F, args.in[I_WUP] + (size_t)layer * DM * NUP, args.in[I_FNG] + layer * DM, NUP, DM, BtUpQ, 128 * nt, 128 * kt, 256 * nv + ((nt < 44) ? 0 : 32), inv_sw); }
            for (int m = gw; m < M; m += NGW) xq_row(XB2 + (size_t)m * DM, XQ + (size_t)m * DM, SSQP + (size_t)m * 32, RSTD + m, s_w, F.lane);
            SEAM(7);
        }
        if (IN(8)) { ENTER();
            pg8::Gemm g{(const bf16*)XQ, (const bf16*)BtUpQ, M, NUP, DM / 2, DM / 2}; pg8::StaticOrder S; S.init(M, NUP, F.G, (int)blockIdx.x);
            pg8::EpiGate E{ACT, DFF, EDGE, args.in[I_FCW] + (size_t)layer * 3 * DFF, args.in[I_FCB] + layer * DFF, DFF, (LAS float*)(F.lds + HALO_OFF), RSTD};
            pg8::gemm_phase<pg8::EpiGate, pg8::StaticOrder, true>(F.lds, g, S, E);
            SEAM(8);
        }
        if (IN(9)) { ENTER();
            const float* fcw = args.in[I_FCW] + (size_t)layer * 3 * DFF;
            for (size_t i = gtid; i < (size_t)(M / 256) * 2 * (DFF / 4); i += gthreads) {
                const int ri = (int)(i / (DFF / 4)), c4 = (int)(i % (DFF / 4)) * 4, pm = ri >> 1, e = ri & 1;
                const float* eb = EDGE + (size_t)(ri * 3) * DFF + c4;
                f32x4 pre = *(const f32x4*)(eb + DFF); const f32x4 v = *(const f32x4*)(eb + 2 * DFF);
                if (e == 0 && (pm & 7) != 0) { const f32x4 gp = *(const f32x4*)(EDGE + (size_t)(((pm - 1) * 2 + 1) * 3) * DFF + c4); pre += *(const f32x4*)(fcw + c4) * gp; }
                if (e == 1 && (pm & 7) != 7) { const f32x4 gn = *(const f32x4*)(EDGE + (size_t)(((pm + 1) * 2 + 0) * 3) * DFF + c4); pre += *(const f32x4*)(fcw + 2 * DFF + c4) * gn; }
                v2u o; o.x = pk2(pg8::silu_f(pre.x) * v.x, pg8::silu_f(pre.y) * v.y); o.y = pk2(pg8::silu_f(pre.z) * v.z, pg8::silu_f(pre.w) * v.w);
                *(v2u*)(ACT + (size_t)(pm * 256 + (e ? 255 : 0)) * DFF + c4) = o;
            }
            SEAM(9);
        }
        if (IN(10)) { ENTER();
            pg8::Gemm g{ACT, BtDn, M, DM, DFF, DFF}; pg8::StaticOrder S; S.init(M, DM, F.G, (int)blockIdx.x);
            pg8::EpiResid16 E{XB2, XA, out, DM, SSQP, (layer + 1 < DEPTH) ? 0 : 1};
            pg8::gemm_phase<pg8::EpiResid16, pg8::StaticOrder>(F.lds, g, S, E);
            SEAM(10);
        }
#undef IN
#undef ENTER
#undef SEAM
    }
}

extern "C" void kernel_launch(void* const* d_in, const int* in_sizes, int n_in, void* d_out, int out_size, void* d_ws, size_t ws_size, hipStream_t stream) {
    static int grid = 0;
    if (grid == 0) {
        if (n_in != N_IN || out_size != M * DM || ws_size < WS_END) { fprintf(stderr, "kernel_launch: unexpected shapes (n_in %d, out %d, ws %zu, need %zu)\n", n_in, out_size, ws_size, (size_t)WS_END); grid = -1; return; }
        int dev = 0, cus = 0;
        if (hipGetDevice(&dev) != hipSuccess || hipDeviceGetAttribute(&cus, hipDeviceAttributeMultiprocessorCount, dev) != hipSuccess) { grid = -1; return; }
        if (hipFuncSetAttribute((const void*)fwd, hipFuncAttributeMaxDynamicSharedMemorySize, LDS_BYTES) != hipSuccess) { fprintf(stderr, "kernel_launch: hipFuncSetAttribute failed\n"); grid = -1; return; }
        int per_cu = 0;
        if (hipOccupancyMaxActiveBlocksPerMultiprocessor(&per_cu, (const void*)fwd, NWAVES * 64, LDS_BYTES) != hipSuccess || per_cu < 1) fprintf(stderr, "kernel_launch: occupancy query reports %d\n", per_cu);
        (void)hipGetLastError();
        grid = cus;
    }
    if (grid < 0) return;
    (void)hipMemsetAsync((char*)d_ws + WS_CTL, 0, CTL_BYTES, stream);
    Args a{};
    for (int i = 0; i < N_IN; ++i) a.in[i] = (const float*)d_in[i];
    a.out = (float*)d_out; a.ws = (unsigned char*)d_ws;
#if MK_ONE_LAUNCH
    a.ph_lo = 0; a.ph_hi = DEPTH * NPH;
    hipLaunchKernelGGL(fwd, dim3(grid), dim3(NWAVES * 64), LDS_BYTES, stream, a);
#else
    for (int p = 0; p < DEPTH * NPH; ++p) { a.ph_lo = p; a.ph_hi = p + 1; hipLaunchKernelGGL(fwd, dim3(grid), dim3(NWAVES * 64), LDS_BYTES, stream, a); }
#endif
    const hipError_t le = hipPeekAtLastError();
    if (le != hipSuccess) fprintf(stderr, "kernel_launch: launch failed: %s\n", hipGetErrorName(le));
}
```

```cpp
#include <hip/hip_runtime.h>
#include <cstdio>
#include <cstdint>
__device__ __forceinline__ int opq(int x) { asm volatile("" : "+v"(x)); return x; }
namespace pg8 {
#define PG8_LAS __attribute__((address_space(3)))
typedef unsigned short bf16_t;
typedef short bf16x8 __attribute__((ext_vector_type(8)));
typedef float f32x4 __attribute__((ext_vector_type(4)));
typedef unsigned u32x4 __attribute__((ext_vector_type(4)));
typedef int i32x4 __attribute__((ext_vector_type(4)));
template <bool I8> struct AccSel { typedef f32x4 T; }; template <> struct AccSel<true> { typedef i32x4 T; };
constexpr int BM = 256, BK = 64, HALF = 128, HTB = HALF * BK * 2  , STAGE_BYTES = 8 * HTB, NXCD = 8, WGM = 8;

__host__ __device__ __forceinline__ int lds_byte(int r, int c) { const int st = (r >> 4) * 2 + (c >> 5), rr = r & 15, cc = c & 31, ob = rr * 64 + cc * 2; return st * 1024 + (ob ^ (((ob >> 9) & 1) << 5)); }
__host__ __device__ __forceinline__ void stage_rc(int b, int& R, int& C) { const int st = b / 1024, sb = b % 1024, swz = sb ^ (((sb >> 9) & 1) << 5); R = (st >> 1) * 16 + swz / 64; C = (st & 1) * 32 + (swz % 64) / 2; }
__host__ __device__ __forceinline__ int perm32(int rho) { const int n = rho >> 4, i = rho & 15; return 8 * (i >> 2) + 4 * n + (i & 3); }

struct Unit { int pm, pn; };
struct Gemm { const bf16_t* A; const bf16_t* Bt; int M, N, K, lda; };

struct StaticOrder {
    int nM, nN, nwg, G, c;
    __host__ __device__ void init(int M, int N, int G_, int c_) { nM = M / BM; nN = N / BM; nwg = nM * nN; G = G_; c = c_; }
    __host__ __device__ bool next(int i, Unit& u) const {
        const long L = (long)i * G + c; if (L >= nwg) return false;
        int wgid = (int)L; { const int q = nwg / NXCD, r = nwg % NXCD, xcd = wgid % NXCD, off = wgid / NXCD; wgid = (xcd < r ? xcd * (q + 1) : r * (q + 1) + (xcd - r) * q) + off; }
        const int nig = WGM * nN, gid = wgid / nig, fm = gid * WGM, gsz = (nM - fm) < WGM ? (nM - fm) : WGM;
        u.pm = fm + ((wgid % nig) % gsz); u.pn = (wgid % nig) / gsz; return true;
    }
    __device__ __forceinline__ void a_ready(const Unit&) const {}
    __device__ __forceinline__ void done(const Unit&) const {}
};

__device__ __forceinline__ unsigned cvt_pk_bf16(float lo, float hi) { unsigned r; asm volatile("v_cvt_pk_bf16_f32 %0, %1, %2" : "=v"(r) : "v"(lo), "v"(hi)); return r; }

__device__ __forceinline__ float dpp_ror1(float v) { return __builtin_bit_cast(float, __builtin_amdgcn_update_dpp(0, __builtin_bit_cast(int, v), 0x121, 0xF, 0xF, false)); }
__device__ __forceinline__ float dpp_ror15(float v) { return __builtin_bit_cast(float, __builtin_amdgcn_update_dpp(0, __builtin_bit_cast(int, v), 0x12F, 0xF, 0xF, false)); }
__device__ __forceinline__ unsigned dpp_swap1(unsigned v) { return (unsigned)__builtin_amdgcn_update_dpp(0, (int)v, 0xB1, 0xF, 0xF, false); }
struct LineOffs { unsigned o0, o1; bool odd; };
__device__ __forceinline__ LineOffs line_offs(unsigned lo, int pitch, int fr) { LineOffs L; L.odd = fr & 1; L.o0 = L.odd ? lo - (unsigned)pitch + 32u : lo; L.o1 = L.odd ? lo + 32u : lo + (unsigned)pitch; return L; }
__device__ __forceinline__ void store_lines(bf16_t* base, const LineOffs& L, u32x4 a, u32x4 b) {
    const u32x4 snd = L.odd ? a : b; u32x4 rcv;
    rcv.x = dpp_swap1(snd.x); rcv.y = dpp_swap1(snd.y); rcv.z = dpp_swap1(snd.z); rcv.w = dpp_swap1(snd.w);
    *(u32x4*)(base + L.o0) = L.odd ? rcv : a;
    *(u32x4*)(base + L.o1) = L.odd ? b : rcv;
}
struct EpiBf16 {
    static constexpr bool PERM = true;
    bf16_t* O; int ldc; const float* rstd; int kvscatter;
    __device__ __forceinline__ void operator()(f32x4 (&acc)[2][2][4][2], const Unit& u, int wr, int wc, int fr, int fq) const {
        bf16_t* Ot = O + (size_t)(u.pm * BM) * ldc + (kvscatter ? u.pn * 320 : u.pn * BM);
        const int wcol = kvscatter ? (wc < 2 ? wc * 64 : 64 + wc * 64) : wc * 64;
        const LineOffs L = line_offs((unsigned)((wr * 64 + fr) * ldc + wcol + 8 * fq), ldc, fr); const int row0 = u.pm * BM + wr * 64 + fr;
        float rsv[8];
#pragma unroll
        for (int i = 0; i < 8; ++i) rsv[i] = rstd ? rstd[row0 + (i >> 2) * HALF + (i & 3) * 16] : 1.0f;
#pragma unroll
        for (int ai = 0; ai < 2; ++ai)
#pragma unroll
            for (int m = 0; m < 4; ++m) { const float rs = rsv[ai * 4 + m];
                u32x4 w[2];
#pragma unroll
                for (int bj = 0; bj < 2; ++bj) { const f32x4 v0 = acc[ai][bj][m][0] * rs, v1 = acc[ai][bj][m][1] * rs;
                    w[bj].x = cvt_pk_bf16(v0[0], v0[1]); w[bj].y = cvt_pk_bf16(v0[2], v0[3]); w[bj].z = cvt_pk_bf16(v1[0], v1[1]); w[bj].w = cvt_pk_bf16(v1[2], v1[3]); }
                store_lines(Ot + (size_t)((ai * HALF + m * 16) * ldc), L, w[0], w[1]);
                asm volatile("" ::: "memory"); }
    }
};
struct EpiResid16 {
    static constexpr bool PERM = true;
    const bf16_t* base; bf16_t* xo; float* out; int ldc; float* ssqp; int f32out;
    __device__ __forceinline__ static void addx(const u32x4 b, const f32x4 a0, const f32x4 a1, f32x4& x0, f32x4& x1) {
        x0[0] = __builtin_bit_cast(float, b.x << 16) + a0[0]; x0[1] = __builtin_bit_cast(float, b.x & 0xffff0000u) + a0[1]; x0[2] = __builtin_bit_cast(float, b.y << 16) + a0[2]; x0[3] = __builtin_bit_cast(float, b.y & 0xffff0000u) + a0[3];
        x1[0] = __builtin_bit_cast(float, b.z << 16) + a1[0]; x1[1] = __builtin_bit_cast(float, b.z & 0xffff0000u) + a1[1]; x1[2] = __builtin_bit_cast(float, b.w << 16) + a1[2]; x1[3] = __builtin_bit_cast(float, b.w & 0xffff0000u) + a1[3]; }
    __device__ __forceinline__ void operator()(f32x4 (&acc)[2][2][4][2], const Unit& u, int wr, int wc, int fr, int fq) const {
        const size_t tb = (size_t)(u.pm * BM) * ldc + u.pn * BM;
        const bf16_t* bs = base + tb;
        const unsigned lo = (unsigned)((wr * 64 + fr) * ldc + wc * 64 + 8 * fq);
        if (f32out != 0) {
            float* op = out + tb;
#pragma unroll
            for (int ai = 0; ai < 2; ++ai)
#pragma unroll
                for (int m = 0; m < 4; ++m) { const unsigned off = lo + (unsigned)((ai * HALF + m * 16) * ldc);
#pragma unroll
                    for (int bj = 0; bj < 2; ++bj) { const u32x4 b = *(const u32x4*)(bs + off + bj * 32); f32x4 x0, x1; addx(b, acc[ai][bj][m][0], acc[ai][bj][m][1], x0, x1);
                        *(f32x4*)(op + off + bj * 32) = x0; *(f32x4*)(op + off + bj * 32 + 4) = x1; }
                    asm volatile("" ::: "memory"); }
            return;
        }
        bf16_t* xp = xo + tb; const LineOffs L = line_offs(lo, ldc, fr);
#pragma unroll
        for (int aim = 0; aim < 4; ++aim) { const int ai = aim >> 1, mp = aim & 1;
            u32x4 bv[2][2];
#pragma unroll
            for (int mm = 0; mm < 2; ++mm)
#pragma unroll
                for (int bj = 0; bj < 2; ++bj) bv[mm][bj] = *(const u32x4*)(bs + lo + (unsigned)((ai * HALF + (2 * mp + mm) * 16) * ldc) + bj * 32);
#pragma unroll
            for (int mm = 0; mm < 2; ++mm) { const int m = 2 * mp + mm; float s = 0.f; u32x4 wv[2];
#pragma unroll
                for (int bj = 0; bj < 2; ++bj) { f32x4 x0, x1; addx(bv[mm][bj], acc[ai][bj][m][0], acc[ai][bj][m][1], x0, x1);
                    wv[bj].x = cvt_pk_bf16(x0[0], x0[1]); wv[bj].y = cvt_pk_bf16(x0[2], x0[3]); wv[bj].z = cvt_pk_bf16(x1[0], x1[1]); wv[bj].w = cvt_pk_bf16(x1[2], x1[3]);
                    s += ((x0[0] * x0[0] + x0[1] * x0[1]) + (x0[2] * x0[2] + x0[3] * x0[3])) + ((x1[0] * x1[0] + x1[1] * x1[1]) + (x1[2] * x1[2] + x1[3] * x1[3])); }
                store_lines(xp + (size_t)((ai * HALF + m * 16) * ldc), L, wv[0], wv[1]);
                s += __shfl_xor(s, 16); s += __shfl_xor(s, 32); if (fq == 0) ssqp[(size_t)(u.pm * BM + wr * 64 + fr + ai * HALF + m * 16) * 32 + u.pn * 4 + wc] = s; }
            asm volatile("" ::: "memory"); }
    }
};
__device__ __forceinline__ float silu_f(float x) { return x * __builtin_amdgcn_rcpf(1.0f + __builtin_amdgcn_exp2f(-1.4426950408889634f * x)); }
struct EpiGate {
    static constexpr bool PERM = true;
    bf16_t* act; int ldact; float* edge; const float* cw; const float* cb; int dff; PG8_LAS float* halo; const float* rstd; const unsigned* wmaxc;
    __device__ __forceinline__ void operator()(f32x4 (&acc)[2][2][4][2], const Unit& u, int wr, int wc, int fr, int fq) const {
        const int lane = fq * 16 + fr; const int colL = wc * 32 + 8 * fq; const int colG = u.pn * HALF + colL;
        f32x4 csc[2][2];
#pragma unroll
        for (int bj = 0; bj < 2; ++bj)
#pragma unroll
            for (int n = 0; n < 2; ++n) { const u32x4 mb = *(const u32x4*)(wmaxc + bj * dff + colG + 4 * n);
                csc[bj][n] = (f32x4){__builtin_bit_cast(float, mb.x), __builtin_bit_cast(float, mb.y), __builtin_bit_cast(float, mb.z), __builtin_bit_cast(float, mb.w)} * (1.0f / 127.0f); }
#pragma unroll
        for (int ai = 0; ai < 2; ++ai)
#pragma unroll
            for (int m = 0; m < 4; ++m) { const float rs = rstd[u.pm * BM + ai * HALF + wr * 64 + m * 16 + fr];
#pragma unroll
                for (int bj = 0; bj < 2; ++bj) { acc[ai][bj][m][0] *= csc[bj][0] * rs; acc[ai][bj][m][1] *= csc[bj][1] * rs; } }
#pragma unroll
        for (int ai = 0; ai < 2; ++ai) { const int q = 2 * ai + wr;
            if (fr == 0) { *(PG8_LAS f32x4*)(halo + (q * 2 + 0) * 128 + colL) = acc[ai][0][0][0]; *(PG8_LAS f32x4*)(halo + (q * 2 + 0) * 128 + colL + 4) = acc[ai][0][0][1]; }
            if (fr == 15) { *(PG8_LAS f32x4*)(halo + (q * 2 + 1) * 128 + colL) = acc[ai][0][3][0]; *(PG8_LAS f32x4*)(halo + (q * 2 + 1) * 128 + colL + 4) = acc[ai][0][3][1]; } }
        asm volatile("s_waitcnt lgkmcnt(0)" ::: "memory"); __builtin_amdgcn_s_barrier(); asm volatile("" ::: "memory");
        bf16_t* actp = act + (size_t)(u.pm * BM) * ldact + colG; const unsigned rlo = (unsigned)((wr * 64 + fr) * ldact);
#pragma unroll
        for (int ai = 0; ai < 2; ++ai) { const int q = 2 * ai + wr;
            typedef unsigned u32x2 __attribute__((ext_vector_type(2)));
            u32x2 pk[4][2];
#pragma unroll
            for (int n = 0; n < 2; ++n) {
                const f32x4 w0 = *(const f32x4*)(cw + colG + 4 * n), w1 = *(const f32x4*)(cw + dff + colG + 4 * n), w2 = *(const f32x4*)(cw + 2 * dff + colG + 4 * n), bb = *(const f32x4*)(cb + colG + 4 * n);
                f32x4 ht = *(PG8_LAS f32x4*)(halo + ((q > 0 ? q - 1 : 0) * 2 + 1) * 128 + colL + 4 * n), hb = *(PG8_LAS f32x4*)(halo + ((q < 3 ? q + 1 : 3) * 2 + 0) * 128 + colL + 4 * n);
                if (q == 0) ht = ht * 0.f; if (q == 3) hb = hb * 0.f;
                f32x4 pre[4];
#pragma unroll
                for (int j = 0; j < 4; ++j) {
                    float g[4], rr[4], rl[4];
#pragma unroll
                    for (int m = 0; m < 4; ++m) { g[m] = acc[ai][0][m][n][j]; rr[m] = dpp_ror1(g[m]); rl[m] = dpp_ror15(g[m]); }
#pragma unroll
                    for (int m = 0; m < 4; ++m) {
                        const float up = (fr > 0) ? rr[m] : (m > 0 ? rr[m > 0 ? m - 1 : 0] : ht[j]);
                        const float dn = (fr < 15) ? rl[m] : (m < 3 ? rl[m < 3 ? m + 1 : 3] : hb[j]);
                        pre[m][j] = w0[j] * up + w1[j] * g[m] + w2[j] * dn + bb[j];
                    }
                }
                if (q == 0 && fr == 0) { float* e = edge + (size_t)((u.pm * 2 + 0) * 3) * dff + colG + 4 * n;
                    *(f32x4*)(e) = acc[ai][0][0][n]; *(f32x4*)(e + dff) = pre[0]; *(f32x4*)(e + 2 * dff) = acc[ai][1][0][n]; }
                if (q == 3 && fr == 15) { float* e = edge + (size_t)((u.pm * 2 + 1) * 3) * dff + colG + 4 * n;
                    *(f32x4*)(e) = acc[ai][0][3][n]; *(f32x4*)(e + dff) = pre[3]; *(f32x4*)(e + 2 * dff) = acc[ai][1][3][n]; }
#pragma unroll
                for (int m = 0; m < 4; ++m) { const f32x4 v = acc[ai][1][m][n];
                    pk[m][n].x = cvt_pk_bf16(silu_f(pre[m][0]) * v[0], silu_f(pre[m][1]) * v[1]); pk[m][n].y = cvt_pk_bf16(silu_f(pre[m][2]) * v[2], silu_f(pre[m][3]) * v[3]); }
            }
#pragma unroll
            for (int m = 0; m < 4; ++m) { u32x4 w; w.x = pk[m][0].x; w.y = pk[m][0].y; w.z = pk[m][1].x; w.w = pk[m][1].y;
                *(u32x4*)(actp + rlo + (unsigned)((ai * HALF + m * 16) * ldact)) = w; }
        }
    }
};

template <class Epi, class Sched, bool I8 = false>
__device__ __forceinline__ void gemm_phase(PG8_LAS unsigned char* lds, const Gemm g, const Sched& S, const Epi& E) {
    typedef typename AccSel<I8>::T acc_t;
    const int tid = opq(threadIdx.x), wid = __builtin_amdgcn_readfirstlane(tid >> 6), lane = tid & 63, wr = wid >> 2, wc = wid & 3, fr = lane & 15, fq = lane >> 4;
    const int K = g.K, nt = K / BK, lda = g.lda;
    unsigned voffA[2], voffB[2];
#pragma unroll
    for (int i = 0; i < 2; ++i) { int R, C; stage_rc(tid * 16 + i * 8192, R, C); const int Rb = Epi::PERM ? (64 * (R >> 5) + perm32(R & 31)) : R;
        voffA[i] = (unsigned)(R * lda + C) * 2u; voffB[i] = (unsigned)(Rb * K + C) * 2u; }
    const size_t kstep = (size_t)(BK * 2);
    const size_t hstepA = (size_t)HALF * lda * 2, hstepB = (size_t)(Epi::PERM ? 32 : HALF) * K * 2;
    const size_t tstepA = 2 * hstepA, tstepB = (size_t)BM * K * 2;
    const unsigned ldsw = (unsigned)wid * 1024u;
    const int aoff = lds_byte(wr * 64 + fr, fq * 8), boff = lds_byte(wc * 32 + fr, fq * 8);
#define PG8_SA(b, h) (((b) * 2 + (h)) * HTB)
#define PG8_SB(b, h) ((4 + (b) * 2 + (h)) * HTB)
#define PG8_STAGE(bufoff, gbase, voff) do { _Pragma("unroll") for (int _i = 0; _i < 2; ++_i) \
        __builtin_amdgcn_global_load_lds((const unsigned*)((const char*)(gbase) + (voff)[_i]), (PG8_LAS unsigned*)(lds + (bufoff) + ldsw + _i * 8192), 16, 0, 0); } while (0)
#define PG8_LDA(dst, b, h) do { _Pragma("unroll") for (int m = 0; m < 4; ++m) _Pragma("unroll") for (int k = 0; k < 2; ++k) dst[m][k] = *(const PG8_LAS bf16x8*)(lds + PG8_SA(b, h) + aoff + m * 2048 + k * 1024); } while (0)
#define PG8_LDB(dst, b, h) do { _Pragma("unroll") for (int n = 0; n < 2; ++n) _Pragma("unroll") for (int k = 0; k < 2; ++k) dst[n][k] = *(const PG8_LAS bf16x8*)(lds + PG8_SB(b, h) + boff + n * 2048 + k * 1024); } while (0)
#define PG8_MMA(ai, bj, At, Bt) do { __builtin_amdgcn_s_setprio(1); _Pragma("unroll") for (int m = 0; m < 4; ++m) _Pragma("unroll") for (int n = 0; n < 2; ++n) _Pragma("unroll") for (int k = 0; k < 2; ++k) { \
        if constexpr (I8) acc[ai][bj][m][n] = __builtin_amdgcn_mfma_i32_16x16x64_i8(__builtin_bit_cast(i32x4, Bt[n][k]), __builtin_bit_cast(i32x4, At[m][k]), acc[ai][bj][m][n], 0, 0, 0); \
        else acc[ai][bj][m][n] = __builtin_amdgcn_mfma_f32_16x16x32_bf16(Bt[n][k], At[m][k], acc[ai][bj][m][n], 0, 0, 0); } __builtin_amdgcn_s_setprio(0); } while (0)
#define PG8_WAIT_V(n) asm volatile("s_waitcnt vmcnt(" #n ")" ::: "memory")
#define PG8_WAIT_L(n) asm volatile("s_waitcnt lgkmcnt(" #n ")" ::: "memory")
#define PG8_BAR __builtin_amdgcn_s_barrier()
#define PG8_SCHED __builtin_amdgcn_sched_barrier(0)
    Unit cur, nxt; int ui = 0;
    if (!S.next(0, cur)) return;
    acc_t acc[2][2][4][2];
{ float zf = 0.f; asm volatile("" : "+v"(zf));
    #pragma unroll
    for (int a = 0; a < 2; ++a)
#pragma unroll
        for (int b = 0; b < 2; ++b)
#pragma unroll
            for (int m = 0; m < 4; ++m)
#pragma unroll
                for (int n = 0; n < 2; ++n) acc[a][b][m][n] = __builtin_bit_cast(acc_t, (f32x4){zf, zf, zf, zf}); }
    bf16x8 At[4][2], B0[2][2], B1[2][2];
    const char* cA = (const char*)g.A + (size_t)cur.pm * tstepA; const char* cB = (const char*)g.Bt + (size_t)cur.pn * tstepB;
    S.a_ready(cur);
    PG8_STAGE(PG8_SB(0, 0), cB, voffB); PG8_STAGE(PG8_SB(0, 1), cB + hstepB, voffB); PG8_STAGE(PG8_SA(0, 0), cA, voffA); PG8_STAGE(PG8_SA(0, 1), cA + hstepA, voffA);
    if (wr == 1) PG8_BAR;
    PG8_WAIT_V(2); PG8_BAR;
    PG8_STAGE(PG8_SB(1, 0), cB + kstep, voffB); PG8_STAGE(PG8_SA(1, 0), cA + kstep, voffA); PG8_STAGE(PG8_SB(1, 1), cB + hstepB + kstep, voffB);
    PG8_WAIT_V(6); PG8_BAR;
    for (;;) {
        const bool has_next = S.next(ui + 1, nxt);
        const char* nA = has_next ? (const char*)g.A + (size_t)nxt.pm * tstepA : cA; const char* nB = has_next ? (const char*)g.Bt + (size_t)nxt.pn * tstepB : cB;
#pragma unroll 1
        for (int t = 0; t < nt; t += 2) {
            const bool last = (t == nt - 2);
            const char* a1 = cA + (size_t)(t + 1) * kstep;
            const char* a2 = last ? nA : cA + (size_t)(t + 2) * kstep; const char* b2 = last ? nB : cB + (size_t)(t + 2) * kstep;
            const char* a3 = a2 + kstep; const char* b3 = b2 + kstep;
            if (last && has_next) S.a_ready(nxt);
            PG8_LDB(B0, 0, 0); PG8_LDB(B1, 0, 1); PG8_SCHED; PG8_LDA(At, 0, 0); PG8_STAGE(PG8_SA(1, 1), a1 + hstepA, voffA);
            PG8_WAIT_V(8); PG8_WAIT_L(0); PG8_BAR; PG8_MMA(0, 0, At, B0); PG8_MMA(0, 1, At, B1); PG8_BAR; PG8_SCHED;
            PG8_LDA(At, 0, 1); PG8_STAGE(PG8_SB(0, 0), b2, voffB); PG8_STAGE(PG8_SB(0, 1), b2 + hstepB, voffB); PG8_STAGE(PG8_SA(0, 0), a2, voffA);
            PG8_WAIT_V(8); PG8_WAIT_L(0); PG8_BAR; PG8_MMA(1, 0, At, B0); PG8_MMA(1, 1, At, B1); PG8_BAR; PG8_SCHED;
            PG8_LDB(B0, 1, 0); PG8_LDB(B1, 1, 1); PG8_SCHED; PG8_LDA(At, 1, 0); PG8_STAGE(PG8_SA(0, 1), a2 + hstepA, voffA);
            PG8_WAIT_V(8); PG8_WAIT_L(0); PG8_BAR; PG8_MMA(0, 0, At, B0); PG8_MMA(0, 1, At, B1); PG8_BAR; PG8_SCHED;
            PG8_LDA(At, 1, 1); PG8_STAGE(PG8_SB(1, 0), b3, voffB); PG8_STAGE(PG8_SB(1, 1), b3 + hstepB, voffB); PG8_STAGE(PG8_SA(1, 0), a3, voffA);
            PG8_WAIT_V(8); PG8_WAIT_L(0); PG8_BAR; PG8_MMA(1, 0, At, B0); PG8_MMA(1, 1, At, B1); PG8_BAR; PG8_SCHED;
        }
        if (wr == 0) PG8_BAR;
        if constexpr (I8) { f32x4 accf[2][2][4][2];
#pragma unroll
            for (int a = 0; a < 2; ++a)
#pragma unroll
                for (int b = 0; b < 2; ++b)
#pragma unroll
                    for (int m = 0; m < 4; ++m)
#pragma unroll
                        for (int n = 0; n < 2; ++n) accf[a][b][m][n] = __builtin_convertvector(acc[a][b][m][n], f32x4);
            E(accf, cur, wr, wc, fr, fq); }
        else E(acc, cur, wr, wc, fr, fq);
        S.done(cur);
        if (!has_next) break;
{ float zf = 0.f; asm volatile("" : "+v"(zf));
        #pragma unroll
        for (int a = 0; a < 2; ++a)
#pragma unroll
            for (int b = 0; b < 2; ++b)
#pragma unroll
                for (int m = 0; m < 4; ++m)
#pragma unroll
                    for (int n = 0; n < 2; ++n) acc[a][b][m][n] = __builtin_bit_cast(acc_t, (f32x4){zf, zf, zf, zf}); }
        cur = nxt; cA = nA; cB = nB; ++ui;
        if (wr == 1) PG8_BAR;
    }
    PG8_WAIT_V(0);
    PG8_BAR;
#undef PG8_SA
#undef PG8_SB
#undef PG8_STAGE
#undef PG8_LDA
#undef PG8_LDB
#undef PG8_MMA
#undef PG8_WAIT_V
#undef PG8_WAIT_L
#undef PG8_BAR
#undef PG8_SCHED
}
}
namespace at {
using bf16 = unsigned short;
using bf16x8 = __attribute__((ext_vector_type(8))) short;
using s16x4  = __attribute__((ext_vector_type(4))) short;
using f32x16 = __attribute__((ext_vector_type(16))) float;
using u32x4  = __attribute__((ext_vector_type(4))) unsigned;
constexpr int DQK = 192, DV = 128, KVBLK = 64, NW = 8, QBLK = 32;
constexpr float SCALE = 0.07216878364870322f;
constexpr float THR = 8.f;
constexpr int LDQ = 1536, LDK = 2560, LDO = 2048;
constexpr int SHM_V = KVBLK * DV * 2, SHM_K = 12 * 2080;
constexpr int QR_OFF = 2 * SHM_V + 2 * SHM_K + NW * 64 * 4;
constexpr int SHM_ATTN = QR_OFF + NW * 4096;
#define SBAR() __builtin_amdgcn_sched_barrier(0)
constexpr int KPL = 2080;
__host__ __device__ __forceinline__ int k_st(int row, int c) { return (c >> 1) * KPL + row * 32 + (((c & 1) ^ ((row >> 3) & 1)) << 4); }
__host__ __device__ __forceinline__ int k_rd_base(int r32, int hi) { return r32 * 32 + ((hi ^ ((r32 >> 3) & 1)) << 4); }
__device__ __forceinline__ int crow(int r, int hi) { return (r & 3) + 8 * (r >> 2) + 4 * hi; }
__device__ __forceinline__ unsigned cvtpk(float lo, float hi) { unsigned r; asm volatile("v_cvt_pk_bf16_f32 %0, %1, %2" : "=v"(r) : "v"(lo), "v"(hi)); return r; }

__device__ __forceinline__ void partialSM(f32x16& p0, f32x16& p1, float& m_reg, float& mn, float& alpha) {
  constexpr float C = 1.0f;
  float pmax = p0[0];
#pragma unroll
  for (int r = 1; r < 16; ++r) pmax = fmaxf(pmax, p0[r]);
#pragma unroll
  for (int r = 0; r < 16; ++r) pmax = fmaxf(pmax, p1[r]);
  { auto rr = __builtin_amdgcn_permlane32_swap(__float_as_uint(pmax), __float_as_uint(pmax), false, false);
    pmax = fmaxf(__uint_as_float(rr[0]), __uint_as_float(rr[1])); }
  if (__builtin_expect(__all(pmax - m_reg <= THR * 1.4426950408889634f), 1)) { mn = m_reg; alpha = 1.f; }
  else { mn = fmaxf(m_reg, pmax); alpha = __builtin_amdgcn_exp2f((m_reg - mn) * C); m_reg = mn; }
  float mnC = -mn * C;
#pragma unroll
  for (int r = 0; r < 16; ++r) p0[r] = fmaf(p0[r], C, mnC);
#pragma unroll
  for (int r = 0; r < 16; ++r) p1[r] = fmaf(p1[r], C, mnC);
#pragma unroll
  for (int r = 0; r < 16; ++r) p0[r] = __builtin_amdgcn_exp2f(p0[r]);
}
__device__ __forceinline__ void partialSM_fast(f32x16& p0, f32x16& p1, float negMC) {
  (void)negMC; (void)p1;
#pragma unroll
  for (int r = 0; r < 16; ++r) p0[r] = __builtin_amdgcn_exp2f(p0[r]);
}
__device__ __forceinline__ void finishSM(f32x16& p0, f32x16& p1, float alpha, float& l_reg, bf16x8& pa0, bf16x8& pa1, bf16x8& pa2, bf16x8& pa3) {
#pragma unroll
  for (int r = 0; r < 16; ++r) p1[r] = __builtin_amdgcn_exp2f(p1[r]);
  float ps = 0;
#pragma unroll
  for (int r = 0; r < 16; ++r) ps += p0[r];
#pragma unroll
  for (int r = 0; r < 16; ++r) ps += p1[r];
  { auto rr = __builtin_amdgcn_permlane32_swap(__float_as_uint(ps), __float_as_uint(ps), false, false);
    ps = __uint_as_float(rr[0]) + __uint_as_float(rr[1]); }
  l_reg = l_reg * alpha + ps;
#define PK4(P, BASE, OUT) do { unsigned a0 = cvtpk(P[BASE + 0], P[BASE + 1]), a1 = cvtpk(P[BASE + 2], P[BASE + 3]);   \
    unsigned b0 = cvtpk(P[BASE + 4], P[BASE + 5]), b1 = cvtpk(P[BASE + 6], P[BASE + 7]);                              \
    auto r0 = __builtin_amdgcn_permlane32_swap(a0, b0, false, false); auto r1 = __builtin_amdgcn_permlane32_swap(a1, b1, false, false); \
    u32x4 w = {r0[0], r1[0], r0[1], r1[1]}; OUT = *reinterpret_cast<bf16x8*>(&w); } while (0)
  PK4(p0, 0, pa0); PK4(p0, 8, pa1); PK4(p1, 0, pa2); PK4(p1, 8, pa3);
#undef PK4
}
template <int OFF> __device__ __forceinline__ bf16x8 k_read(int kb) {
  bf16x8 r; asm volatile("ds_read_b128 %0, %1 offset:%2" : "=v"(r) : "v"(kb), "i"(OFF) : "memory"); return r;
}
__device__ __forceinline__ void qkt(f32x16& p0, f32x16& p1, int kb, const bf16x8* qr, int qb) {
  p0 = f32x16{}; p1 = f32x16{};
#define QK1(d0) { const bf16x8 b0 = *(const __attribute__((address_space(3))) bf16x8*)(kb + d0 * KPL), b1 = *(const __attribute__((address_space(3))) bf16x8*)(kb + d0 * KPL + 1024); \
    p0 = __builtin_amdgcn_mfma_f32_32x32x16_bf16(b0, qr[d0], p0, 0, 0, 0); p1 = __builtin_amdgcn_mfma_f32_32x32x16_bf16(b1, qr[d0], p1, 0, 0, 0); }
#define QK2(d0) { const bf16x8 b0 = *(const __attribute__((address_space(3))) bf16x8*)(kb + d0 * KPL), b1 = *(const __attribute__((address_space(3))) bf16x8*)(kb + d0 * KPL + 1024); \
    const bf16x8 qf = *(const __attribute__((address_space(3))) bf16x8*)(qb + (d0 - 8) * 1024); \
    p0 = __builtin_amdgcn_mfma_f32_32x32x16_bf16(b0, qf, p0, 0, 0, 0); p1 = __builtin_amdgcn_mfma_f32_32x32x16_bf16(b1, qf, p1, 0, 0, 0); }
  QK1(0) QK1(1) QK1(2) QK1(3) QK1(4) QK1(5) QK1(6) QK1(7) QK2(8) QK2(9) QK2(10) QK2(11)
#undef QK1
#undef QK2
}
__host__ __device__ __forceinline__ int v_st(int k, int c) { const int kk = (k & ~0xC) | ((k & 4) << 1) | ((k & 8) >> 1); return ((kk >> 3) * 4 + (c >> 5)) * 512 + ((kk & 7) * 32 + (c & 31)) * 2; }
__device__ __forceinline__ int v_rd_base(int lane) { return ((lane & 3) << 3) | (((lane >> 2) & 3) << 6) | (((lane >> 4) & 1) << 5) | (((lane >> 5) & 1) << 8); }
constexpr int v_rd_off(int d0, int ks, int half) { return d0 * 512 + ks * 4096 + half * 2048; }
template <int OFF> __device__ __forceinline__ s16x4 tr_read(int vb) {
  s16x4 r; asm volatile("ds_read_b64_tr_b16 %0, %1 offset:%2" : "=&v"(r) : "v"(vb), "i"(OFF) : "memory"); return r;
}
template <int D0> __device__ __forceinline__ void pv_one(f32x16& od, int vb, bf16x8 pa0, bf16x8 pa1, bf16x8 pa2, bf16x8 pa3) {
  const s16x4 l0 = tr_read<v_rd_off(D0, 0, 0)>(vb), h0 = tr_read<v_rd_off(D0, 0, 1)>(vb), l1 = tr_read<v_rd_off(D0, 1, 0)>(vb), h1 = tr_read<v_rd_off(D0, 1, 1)>(vb);
  const s16x4 l2 = tr_read<v_rd_off(D0, 2, 0)>(vb), h2 = tr_read<v_rd_off(D0, 2, 1)>(vb), l3 = tr_read<v_rd_off(D0, 3, 0)>(vb), h3 = tr_read<v_rd_off(D0, 3, 1)>(vb);
  asm volatile("s_waitcnt lgkmcnt(0)" ::: "memory"); SBAR();
#define PK(L, H) (bf16x8){L[0], L[1], L[2], L[3], H[0], H[1], H[2], H[3]}
  od = __builtin_amdgcn_mfma_f32_32x32x16_bf16(pa0, PK(l0, h0), od, 0, 0, 0);
  od = __builtin_amdgcn_mfma_f32_32x32x16_bf16(pa1, PK(l1, h1), od, 0, 0, 0);
  od = __builtin_amdgcn_mfma_f32_32x32x16_bf16(pa2, PK(l2, h2), od, 0, 0, 0);
  od = __builtin_amdgcn_mfma_f32_32x32x16_bf16(pa3, PK(l3, h3), od, 0, 0, 0);
#undef PK
}
__device__ __forceinline__ void pv_d0(f32x16* o, int vb, bf16x8 pa0, bf16x8 pa1, bf16x8 pa2, bf16x8 pa3) {
  pv_one<0>(o[0], vb, pa0, pa1, pa2, pa3); pv_one<1>(o[1], vb, pa0, pa1, pa2, pa3); pv_one<2>(o[2], vb, pa0, pa1, pa2, pa3); pv_one<3>(o[3], vb, pa0, pa1, pa2, pa3);
}

template <bool FAST>
__device__ __forceinline__ void attn_unit(const float negMC, const bf16* __restrict__ Qb, const bf16* __restrict__ Kh, const bf16* __restrict__ Vh, bf16* __restrict__ Ob, int seq, char* lds) {
  const int tid = opq(threadIdx.x), wid = tid >> 6, lane = tid & 63, r32 = lane & 31, hi = lane >> 5;
  char* V_lds = lds; char* K_lds = lds + 2 * SHM_V;
  float* ws = (float*)(lds + 2 * SHM_V + 2 * SHM_K) + wid * 64; float* li_l = ws; float* al_l = ws + 32;
  float m_reg = -1e30f, l_reg = 0; f32x16 o[4] = {}; bf16x8 qr[8];
  const bf16* Qw = Qb + (unsigned)((wid * QBLK + r32) * LDQ + hi * 8);
#pragma unroll
  for (int d0 = 0; d0 < 8; ++d0) qr[d0] = *reinterpret_cast<const bf16x8*>(Qw + d0 * 16);
  const int qb0 = (int)(uintptr_t)lds + QR_OFF + wid * 4096 + k_rd_base(r32, hi);
#pragma unroll
  for (int d0 = 8; d0 < 12; ++d0) *(__attribute__((address_space(3))) bf16x8*)(qb0 + (d0 - 8) * 1024) = *reinterpret_cast<const bf16x8*>(Qw + d0 * 16);
  const int sr = tid >> 4, sc = (tid & 15) * 8, vst0 = v_st(sr, sc), vst1 = v_st(32 + sr, sc);
  unsigned koff[3]; int kst[3];
#pragma unroll
  for (int i = 0; i < 3; ++i) { const int q = tid + 512 * i; koff[i] = (unsigned)((q / 24) * LDK + (q % 24) * 8); kst[i] = k_st(q / 24, q % 24); }
  const unsigned voff0 = (unsigned)(sr * LDK + sc), voff1 = (unsigned)((32 + sr) * LDK + sc);
  const int vb0 = (int)(uintptr_t)V_lds + v_rd_base(lane); const int kb0 = (int)(uintptr_t)K_lds + k_rd_base(r32, hi);
  struct { bf16x8 vs0, vs1, ks0, ks1, ks2; } sr_[1];
#define SLOAD(i, k0) do { const bf16* vt = Vh + (size_t)(k0) * LDK; const bf16* kt = Kh + (size_t)(k0) * LDK; \
    sr_[i].vs0 = *(const bf16x8*)(vt + voff0); sr_[i].vs1 = *(const bf16x8*)(vt + voff1); \
    sr_[i].ks0 = *(const bf16x8*)(kt + koff[0]); sr_[i].ks1 = *(const bf16x8*)(kt + koff[1]); sr_[i].ks2 = *(const bf16x8*)(kt + koff[2]); } while (0)
#define SWRITE(b, i) do { *(bf16x8*)(V_lds + (b) * SHM_V + vst0) = sr_[i].vs0; *(bf16x8*)(V_lds + (b) * SHM_V + vst1) = sr_[i].vs1; \
    *(bf16x8*)(K_lds + (b) * SHM_K + kst[0]) = sr_[i].ks0; *(bf16x8*)(K_lds + (b) * SHM_K + kst[1]) = sr_[i].ks1; *(bf16x8*)(K_lds + (b) * SHM_K + kst[2]) = sr_[i].ks2; } while (0)
#define SWAIT() do { if constexpr (SDEPTH == 2) asm volatile("s_waitcnt vmcnt(5)" ::: "memory"); else asm volatile("s_waitcnt vmcnt(0)" ::: "memory"); } while (0)
#define RESC(a) do { if (__any((a) < 1.f)) { if (hi == 0) al_l[r32] = (a); asm volatile("s_waitcnt lgkmcnt(0)" ::: "memory"); \
    _Pragma("unroll") for (int d = 0; d < 4; ++d) _Pragma("unroll") for (int r = 0; r < 16; ++r) o[d][r] *= al_l[crow(r, hi)]; } } while (0)
  f32x16 pA0, pA1, pB0, pB1; float mnA, mnB, alA, alB; bf16x8 pa0, pa1, pa2, pa3; const int NT = seq / KVBLK;
#define PSM(P0, P1, MN, AL) do { if constexpr (FAST) { partialSM_fast(P0, P1, negMC); AL = 1.f; } else partialSM(P0, P1, m_reg, MN, AL); } while (0)
#define RSC(AL) do { if constexpr (!FAST) RESC(AL); } while (0)
  SLOAD(0, 0); asm volatile("s_waitcnt vmcnt(0)" ::: "memory"); SWRITE(0, 0); __syncthreads();
  qkt(pA0, pA1, kb0, qr, qb0); PSM(pA0, pA1, mnA, alA);
  SLOAD(0, KVBLK);
  asm volatile("s_waitcnt vmcnt(0)" ::: "memory"); SWRITE(1, 0); __syncthreads();
  for (int j = 1; j + 1 < NT; j += 2) {
    SBAR(); qkt(pB0, pB1, kb0 + SHM_K, qr, qb0);
    finishSM(pA0, pA1, alA, l_reg, pa0, pa1, pa2, pa3); SBAR();
    SLOAD(0, (j + 1) * KVBLK); SBAR();
    pv_d0(o, vb0, pa0, pa1, pa2, pa3); PSM(pB0, pB1, mnB, alB);
    __syncthreads(); asm volatile("s_waitcnt vmcnt(0)" ::: "memory"); SWRITE(0, 0);
    RSC(alB); __syncthreads();
    SBAR(); qkt(pA0, pA1, kb0, qr, qb0);
    finishSM(pB0, pB1, alB, l_reg, pa0, pa1, pa2, pa3); SBAR();
    SLOAD(0, (j + 2) * KVBLK); SBAR();
    pv_d0(o, vb0 + (int)SHM_V, pa0, pa1, pa2, pa3); PSM(pA0, pA1, mnA, alA);
    __syncthreads(); asm volatile("s_waitcnt vmcnt(0)" ::: "memory"); SWRITE(1, 0);
    RSC(alA); __syncthreads();
  }
  SBAR(); qkt(pB0, pB1, kb0 + SHM_K, qr, qb0);
  finishSM(pA0, pA1, alA, l_reg, pa0, pa1, pa2, pa3); SBAR();
  pv_d0(o, vb0, pa0, pa1, pa2, pa3); PSM(pB0, pB1, mnB, alB);
  __syncthreads(); RSC(alB);
  finishSM(pB0, pB1, alB, l_reg, pa0, pa1, pa2, pa3); SBAR();
  pv_d0(o, vb0 + (int)SHM_V, pa0, pa1, pa2, pa3);
  if (hi == 0) li_l[r32] = l_reg; asm volatile("s_waitcnt lgkmcnt(0)" ::: "memory");
  bf16* Ow = Ob + (unsigned)(wid * QBLK * LDO + r32);
#pragma unroll
  for (int r = 0; r < 16; ++r) { const int orow = crow(r, hi); const float rl = __builtin_amdgcn_rcpf(li_l[orow]);
#pragma unroll
    for (int d0 = 0; d0 < 4; ++d0) { const unsigned w = cvtpk(o[d0][r] * rl, 0.f); Ow[(unsigned)(orow * LDO + d0 * 32)] = (bf16)(w & 0xffffu); } }
  __syncthreads();
#undef SLOAD
#undef SWRITE
#undef SWAIT
#undef RESC
#undef PSM
#undef RSC
}
}
namespace hy {
#define HY_LAS __attribute__((address_space(3)))
typedef unsigned short bf16;
typedef short bf16x8 __attribute__((ext_vector_type(8)));
typedef float f32x16 __attribute__((ext_vector_type(16)));
typedef unsigned u32x2 __attribute__((ext_vector_type(2)));
typedef unsigned u32x4 __attribute__((ext_vector_type(4)));
constexpr int L = 2048, NB = 24, CH = 512;
constexpr int RFS = 4112;
constexpr int ZROW = 4112;
constexpr int ZL_BYTES = NB * ZROW;
constexpr int RCS = 8256;
constexpr int RC_OFF = ZL_BYTES;
constexpr int HY_LDS_BYTES = RC_OFF + 4 * RCS;
__device__ __forceinline__ unsigned cvtpk(float lo, float hi) { unsigned r; asm volatile("v_cvt_pk_bf16_f32 %0, %1, %2" : "=v"(r) : "v"(lo), "v"(hi)); return r; }
__host__ __device__ __forceinline__ int frag_base(int tw, int r, int h) { const int a = (4 - (r & 3)) & 3; return RC_OFF + a * RCS + 2 * (2048 - tw - r + 8 * h - a); }
__host__ __device__ __forceinline__ int zfrag_base(int r, int h) { return (r < NB ? r : NB - 1) * ZROW + 16 * h; }

__device__ __forceinline__ bf16x8 ld_frag(HY_LAS unsigned char* lds, int off) {
    const u32x2 lo = *(const HY_LAS u32x2*)(lds + off), hi = *(const HY_LAS u32x2*)(lds + off + 8);
    u32x4 w = {lo.x, lo.y, hi.x, hi.y}; return *reinterpret_cast<bf16x8*>(&w);
}
__device__ __forceinline__ bf16x8 ld_b128(HY_LAS unsigned char* lds, int off) { return *(const HY_LAS bf16x8*)(lds + off); }

__device__ __forceinline__ void conv_unit(HY_LAS unsigned char* lds, const bf16* __restrict__ ZT, const bf16* __restrict__ RF, bf16* __restrict__ YC, int c, int half) {
    const int tid = opq(threadIdx.x), wid = tid >> 6, lane = tid & 63, r = lane & 31, h = lane >> 5;
    { const u32x4* src = (const u32x4*)(ZT + (size_t)c * NB * L);
#pragma unroll
      for (int i = 0; i < 12; ++i) { const int q = tid + 512 * i; const u32x4 v = src[q]; *(HY_LAS u32x4*)(lds + (q >> 8) * ZROW + (q & 255) * 16) = v; } }
    { const bf16* rf = RF + (size_t)c * RFS;
      for (int ch = tid; ch < RFS / 8; ch += 512) {
          const u32x4 v = *(const u32x4*)(rf + ch * 8); const unsigned w[4] = {v.x, v.y, v.z, v.w};
#pragma unroll
          for (int j = 0; j < 8; ++j) { const unsigned short e = (unsigned short)((w[j >> 1] >> ((j & 1) * 16)) & 0xffffu); const int idx = ch * 8 + j;
#pragma unroll
              for (int a = 0; a < 4; ++a) if (idx - a >= 0) *(HY_LAS unsigned short*)(lds + RC_OFF + a * RCS + 2 * (idx - a)) = e; } } }
    __syncthreads();
    const int tw = half * 1024 + wid * 128;
    const int fb = frag_base(tw, r, h), zb = zfrag_base(r, h);
    f32x16 acc[4] = {};
    bf16x8 S0[2], S1[2], S2[2], S3[2], Bc[2], Bn[2];
#define HY_LDG(S, d) do { S[0] = ld_frag(lds, fb + 64 * (d)); S[1] = ld_frag(lds, fb + 64 * (d) + 32); } while (0)
#define HY_LDB(Bx, n) do { Bx[0] = ld_b128(lds, zb + 64 * (n)); Bx[1] = ld_b128(lds, zb + 64 * (n) + 32); } while (0)
#define HY_MM(i, S, Bx) do { acc[i] = __builtin_amdgcn_mfma_f32_32x32x16_bf16(S[0], Bx[0], acc[i], 0, 0, 0); acc[i] = __builtin_amdgcn_mfma_f32_32x32x16_bf16(S[1], Bx[1], acc[i], 0, 0, 0); } while (0)
#define HY_ITER(n, Sa, Sb, Sc, Sd, Bcur, Bnext) do { HY_LDG(Sa, (n)); if ((n) + 1 < 64) HY_LDB(Bnext, (n) + 1); \
        HY_MM(1, Sb, Bcur); HY_MM(2, Sc, Bcur); HY_MM(3, Sd, Bcur); HY_MM(0, Sa, Bcur); } while (0)
    HY_LDG(S3, -1); HY_LDG(S2, -2); HY_LDG(S1, -3); HY_LDB(Bc, 0);
    for (int n = 0; n < 64; n += 4) {
        HY_ITER(n, S0, S3, S2, S1, Bc, Bn);
        HY_ITER(n + 1, S1, S0, S3, S2, Bn, Bc);
        HY_ITER(n + 2, S2, S1, S0, S3, Bc, Bn);
        HY_ITER(n + 3, S3, S2, S1, S0, Bn, Bc);
    }
#undef HY_LDG
#undef HY_LDB
#undef HY_MM
#undef HY_ITER
    if (r < NB) { bf16* yp = YC + ((size_t)c * NB + r) * L + tw + 4 * h;
#pragma unroll
        for (int i = 0; i < 4; ++i)
#pragma unroll
            for (int q4 = 0; q4 < 4; ++q4) { u32x2 w; w.x = cvtpk(acc[i][4 * q4 + 0], acc[i][4 * q4 + 1]); w.y = cvtpk(acc[i][4 * q4 + 2], acc[i][4 * q4 + 3]);
                *(u32x2*)(yp + 32 * i + 8 * q4) = w; } }
    __syncthreads();
}
}
constexpr int NWAVES = 8;
#ifndef MK_ONE_LAUNCH
#define MK_ONE_LAUNCH 1
#endif
constexpr int DM = 2048, NSEQ = 24, SEQ = 2048, M = NSEQ * SEQ, MP = 8 * SEQ;
constexpr int DEPTH = 4;
constexpr int DIN = 2880, DINP = 3072;
constexpr int O_CQ = 512, O_CKV = 1024, O_KPE = 1280, O_HY = 1344;
constexpr int NH = 8, NQ = 1536, NKVP = 2560, KVHS = 320;
constexpr int DFF = 5632, NUP = 11264, HYC = 512;
constexpr float EPS = 1e-6f;
constexpr int NPH = 11;
constexpr size_t WS_CTL = 0, CTL_BYTES = 1u << 20;
constexpr size_t SZ_BTIN = (size_t)DINP * DM * 2, SZ_BTUQ = (size_t)NQ * 512 * 2, SZ_BTKV = (size_t)NKVP * 256 * 2, SZ_BTOUT = (size_t)DM * DM * 2, SZ_BTUP = (size_t)NUP * DM * 2, SZ_BTDN = (size_t)DM * DFF * 2;
constexpr size_t WS_BTIN = WS_CTL + CTL_BYTES, WS_BTUQ = WS_BTIN + SZ_BTIN, WS_BTKV = WS_BTUQ + SZ_BTUQ, WS_BTOUT = WS_BTKV + SZ_BTKV, WS_BTUP = WS_BTOUT + SZ_BTOUT, WS_BTDN = WS_BTUP + SZ_BTUP;
constexpr size_t WS_RF = WS_BTDN + SZ_BTDN, SZ_RF = (size_t)HYC * hy::RFS * 2;
constexpr size_t WS_H = WS_RF + SZ_RF, SZ_H = (size_t)M * DM * 2;
constexpr size_t WS_PROJ = WS_H + SZ_H, SZ_PROJ = (size_t)M * DINP * 2;
constexpr size_t WS_Q = WS_PROJ + SZ_PROJ, SZ_Q = (size_t)M * NQ * 2;
constexpr size_t WS_KV = WS_Q + SZ_Q, SZ_KV = (size_t)M * NKVP * 2;
constexpr size_t WS_ZT = WS_KV + SZ_KV, SZ_ZT = (size_t)HYC * NSEQ * SEQ * 2;
constexpr size_t WS_X0 = WS_ZT + SZ_ZT, WS_YC = WS_X0 + SZ_ZT;
constexpr size_t WS_EDGE = WS_YC + SZ_ZT, SZ_EDGE = (size_t)(M / 256) * 2 * 3 * DFF * 4;
constexpr size_t WS_ROPE = WS_EDGE + SZ_EDGE, SZ_ROPE = (size_t)SEQ * 64 * 4;
constexpr size_t WS_SSQP = WS_ROPE + SZ_ROPE, SZ_SSQP = (size_t)M * 32 * 4;
constexpr size_t WS_RSTD = WS_SSQP + SZ_SSQP, SZ_RSTD = (size_t)M * 4;
constexpr size_t WS_XQ = WS_RSTD + SZ_RSTD, SZ_XQ = (size_t)M * DM;
constexpr size_t WS_END = WS_XQ + SZ_XQ;
constexpr size_t WS_ACT = WS_PROJ;
static_assert((size_t)M * DFF * 2 <= SZ_PROJ + SZ_Q + SZ_KV, "ACT overlay");
constexpr size_t WS_XB2 = WS_ACT + (size_t)M * DFF * 2;
static_assert(WS_XB2 + (size_t)M * DM * 2 <= WS_EDGE && WS_XB2 % 256 == 0, "XB2 overlay");
static_assert(WS_BTIN % 256 == 0 && WS_RF % 256 == 0 && WS_H % 256 == 0 && WS_PROJ % 256 == 0 && WS_Q % 256 == 0 && WS_KV % 256 == 0 && WS_ZT % 256 == 0 && WS_EDGE % 256 == 0, "alignment");
constexpr int CW_WMAXC = 65536;
constexpr int CW_WMAX = 1024;
constexpr int CW_BAR = 4096;
constexpr int RING_BYTES = 135168;
constexpr int HALO_OFF = RING_BYTES, HALO_BYTES = 4096;
constexpr int MISC_OFF = HALO_OFF + HALO_BYTES;
constexpr int LDS_BYTES = 147456;
static_assert(hy::HY_LDS_BYTES <= RING_BYTES && at::SHM_ATTN <= RING_BYTES && MISC_OFF + 256 <= LDS_BYTES, "LDS map");

#define GAS __attribute__((address_space(1)))
#define LAS __attribute__((address_space(3)))
typedef unsigned short bf16;
typedef unsigned v4u __attribute__((ext_vector_type(4)));
typedef unsigned v2u __attribute__((ext_vector_type(2)));
typedef float f32x4 __attribute__((ext_vector_type(4)));
#define LDS_WAIT() asm volatile("s_waitcnt lgkmcnt(0)" ::: "memory")
__device__ __forceinline__ unsigned f2bf(float f) { unsigned u = __builtin_bit_cast(unsigned, f); return (u + 0x7fffu + ((u >> 16) & 1u)) >> 16; }
__device__ __forceinline__ unsigned pk2(float lo, float hi) { return f2bf(lo) | (f2bf(hi) << 16); }
__device__ __forceinline__ float bf2f(unsigned short b) { return __builtin_bit_cast(float, (unsigned)b << 16); }
__device__ __forceinline__ float bflo(unsigned w) { return __builtin_bit_cast(float, w << 16); }
__device__ __forceinline__ float bfhi(unsigned w) { return __builtin_bit_cast(float, w & 0xffff0000u); }
__device__ __forceinline__ float wave_sum(float v) {
#pragma unroll
    for (int o = 1; o < 64; o <<= 1) v += __shfl_xor(v, o);
    return v;
}

#define XB_TMO      128
#define XB_XCNT(j)  (256  + 64 * (j))
#define XB_XSUB(j)  (1280 + 64 * (j))
#define XB_XGEN(j)  (2304 + 64 * (j))
#define XB_TOP      3328
#define XB_TOPGEN   3392
#define XCD_BAR_WORDS 3456
#define XB_SPIN_CAP (1u << 18)
__device__ __forceinline__ unsigned xb_ld(unsigned* p)              { return __hip_atomic_load(p, __ATOMIC_RELAXED, __HIP_MEMORY_SCOPE_AGENT); }
__device__ __forceinline__ unsigned xb_add(unsigned* p, unsigned v) { return __hip_atomic_fetch_add(p, v, __ATOMIC_RELAXED, __HIP_MEMORY_SCOPE_AGENT); }
__device__ __forceinline__ unsigned xb_xcc_id() { return (unsigned)__builtin_amdgcn_s_getreg((3 << 11) | 20) & 0xFu; }
#define XB_SPIN(cond, bar) do { unsigned _sp = 0; while (cond) { __builtin_amdgcn_s_sleep(1); \
    if ((++_sp & 255u) == 0u) { if (xb_ld(&(bar)[XB_TMO])) break; if (_sp > XB_SPIN_CAP) { atomicAdd(&(bar)[XB_TMO], 1u); break; } } } } while (0)
struct XcdBarrier { unsigned* bar; unsigned x; volatile LAS unsigned* st; };
__device__ __forceinline__ XcdBarrier xcd_barrier_post(unsigned* bar, volatile LAS unsigned* st) {
    XcdBarrier b; b.bar = bar; b.x = xb_xcc_id(); b.st = st;
    if (threadIdx.x == 0) (void)xb_add(&bar[XB_XCNT(b.x)], 1u);
    return b;
}
__device__ __forceinline__ void xcd_barrier_complete(unsigned* bar, unsigned x, unsigned& nloc, unsigned& nx) {
    const unsigned G = gridDim.x * gridDim.y * gridDim.z;
    unsigned sum, cnt, mine, sp = 0u;
    for (;;) {
        sum = 0u; cnt = 0u; mine = 0u;
#pragma unroll
        for (unsigned j = 0; j < 16; ++j) { const unsigned c = xb_ld(&bar[XB_XCNT(j)]); sum += c; cnt += (c > 0u) ? 1u : 0u; mine = (j == x) ? c : mine; }
        if (sum == G) break;
        __builtin_amdgcn_s_sleep(1);
        if ((++sp & 255u) == 0u) { if (xb_ld(&bar[XB_TMO])) break; if (sp > XB_SPIN_CAP) { atomicAdd(&bar[XB_TMO], 1u); break; } }
    }
    nloc = mine > 0u ? mine : 1u; nx = cnt > 0u ? cnt : 1u;
}
__device__ __forceinline__ void xcd_barrier(const XcdBarrier& b) {
    asm volatile("s_waitcnt vmcnt(0)" ::: "memory");
    __syncthreads();
    if (threadIdx.x == 0) {
        unsigned* bar = b.bar;
        __builtin_amdgcn_s_waitcnt(0);
        unsigned nloc = b.st[0], nx = b.st[1];
        if (nloc == 0u) { xcd_barrier_complete(bar, b.x, nloc, nx); b.st[0] = nloc; b.st[1] = nx; }
        const unsigned old = xb_add(&bar[XB_XSUB(b.x)], 1u);
        const unsigned gen = old / nloc;
        if (old + 1u == (gen + 1u) * nloc) {
            __builtin_amdgcn_fence(__ATOMIC_RELEASE, "agent");
            asm volatile("s_waitcnt vmcnt(0)" ::: "memory");
            const unsigned og = xb_add(&bar[XB_TOP], 1u);
            const unsigned tg = og / nx;
            if (og + 1u == (tg + 1u) * nx) xb_add(&bar[XB_TOPGEN], 1u);
            else XB_SPIN(xb_ld(&bar[XB_TOPGEN]) == tg, bar);
            __builtin_amdgcn_fence(__ATOMIC_ACQUIRE, "agent");
            xb_add(&bar[XB_XGEN(b.x)], 1u);
            asm volatile("s_waitcnt vmcnt(0)" ::: "memory");
        } else {
            XB_SPIN(xb_ld(&bar[XB_XGEN(b.x)]) == gen, bar);
            __builtin_amdgcn_fence(__ATOMIC_ACQUIRE, "agent");
            asm volatile("s_waitcnt vmcnt(0)" ::: "memory");
        }
    }
    __syncthreads();
}

struct Frame {
    LAS unsigned char* lds;
    int tid, lane, wave, vcu, G;
};
enum { I_XP = 0, I_XS, I_ANG, I_WIN, I_PW, I_PS, I_QNG, I_WUQ, I_KVNG, I_WUKV, I_QHG, I_KHG, I_HCW, I_HCB, I_FW1, I_FB1, I_FFR, I_FW2, I_FB2, I_FW3, I_FB3, I_HBIAS, I_GNG, I_WOUT, I_FNG, I_WUP, I_FCW, I_FCB, I_WDN, N_IN };
struct Args { const float* in[N_IN]; float* out; unsigned char* ws; int ph_lo, ph_hi; };
static_assert(sizeof(Args) == (N_IN + 2) * 8 + 8, "Args has no padding");

__device__ __forceinline__ void cvt_item(const float* __restrict__ W, int ldw, int K, bf16* WT, int dst_n0, int src_n0, int k0, const float* __restrict__ ks, LAS float* scr, int lane) {
#pragma unroll
    for (int i = 0; i < 32; ++i) { const int kk = 2 * i + (lane >> 5); float v = W[(size_t)(k0 + kk) * ldw + src_n0 + (lane & 31)]; if (ks) v *= ks[k0 + kk]; scr[kk * 33 + (lane & 31)] = v; }
    LDS_WAIT(); asm volatile("" ::: "memory");
    const int c = lane & 7;
#pragma unroll
    for (int j = 0; j < 4; ++j) { const int n = (lane >> 3) + 8 * j; const LAS float* s = scr + (8 * c) * 33 + n;
        v4u o; o.x = pk2(s[0 * 33], s[1 * 33]); o.y = pk2(s[2 * 33], s[3 * 33]); o.z = pk2(s[4 * 33], s[5 * 33]); o.w = pk2(s[6 * 33], s[7 * 33]);
        *(v4u*)(WT + (size_t)(dst_n0 + n) * K + k0 + 8 * c) = o; }
    LDS_WAIT(); asm volatile("" ::: "memory");
}
struct CvtTile { const float* W; const float* ks; bf16* WT; int ldw, K, src_n0, k0, ncols; int dst[4]; };
__device__ __forceinline__ void cvt_tile(Frame& F, const CvtTile& d) {
    LAS float* T = (LAS float*)F.lds;
#pragma unroll
    for (int i = 0; i < 8; ++i) { const int q = F.tid + 512 * i, row = q >> 5, c4 = q & 31;
        f32x4 v = {0.f, 0.f, 0.f, 0.f};
        if (d.src_n0 + 4 * c4 < d.ncols) v = *(const f32x4*)(d.W + (size_t)(d.k0 + row) * d.ldw + d.src_n0 + 4 * c4);
        if (d.ks) v *= d.ks[d.k0 + row];
        LAS float* t = T + row * 129 + 4 * c4; t[0] = v.x; t[1] = v.y; t[2] = v.z; t[3] = v.w; }
    __syncthreads();
#pragma unroll
    for (int i = 0; i < 4; ++i) { const int n = (F.tid >> 4) + 32 * i, kc = F.tid & 15;
        if (d.src_n0 + n < d.ncols) { const LAS float* s = T + (8 * kc) * 129 + n;
            v4u o; o.x = pk2(s[0], s[129]); o.y = pk2(s[2 * 129], s[3 * 129]); o.z = pk2(s[4 * 129], s[5 * 129]); o.w = pk2(s[6 * 129], s[7 * 129]);
            *(v4u*)(d.WT + (size_t)(d.dst[i] + (n & 31)) * d.K + d.k0 + 8 * kc) = o; } }
    __syncthreads();
}
__device__ __forceinline__ void absmax_tile(Frame& F, const float* __restrict__ W, const float* __restrict__ ks, int ldw, int src_n0, int k0, unsigned* outc) {
    LAS float* P = (LAS float*)F.lds;
    f32x4 m = {0.f, 0.f, 0.f, 0.f};
#pragma unroll
    for (int i = 0; i < 8; ++i) { const int q = F.tid + 512 * i, row = q >> 5, c4 = q & 31;
        const f32x4 v = *(const f32x4*)(W + (size_t)(k0 + row) * ldw + src_n0 + 4 * c4) * ks[k0 + row];
        m.x = fmaxf(m.x, fabsf(v.x)); m.y = fmaxf(m.y, fabsf(v.y)); m.z = fmaxf(m.z, fabsf(v.z)); m.w = fmaxf(m.w, fabsf(v.w)); }
    *(LAS f32x4*)(P + (F.tid >> 5) * 128 + 4 * (F.tid & 31)) = m;
    __syncthreads();
    if (F.tid < 128) { float c = P[F.tid];
#pragma unroll
        for (int g = 1; g < 16; ++g) c = fmaxf(c, P[g * 128 + F.tid]);
        atomicMax(outc + src_n0 + F.tid, __builtin_bit_cast(unsigned, c)); }
    __syncthreads();
}
__device__ __forceinline__ unsigned q8(float v) { const int q = (int)__builtin_rintf(v); return (unsigned)(q < -127 ? -127 : (q > 127 ? 127 : q)) & 0xffu; }
__device__ __forceinline__ void cvtq_tile(Frame& F, const float* __restrict__ W, const float* __restrict__ ks, int ldw, int K, unsigned char* WT, int src_n0, int k0, int dst0, const unsigned* __restrict__ wmaxc) {
    LAS float* T = (LAS float*)F.lds;
    f32x4 inv4; { const v4u mb = *(const v4u*)(wmaxc + src_n0 + 4 * (F.tid & 31));
        inv4.x = 127.0f / fmaxf(__builtin_bit_cast(float, mb.x), 1e-30f); inv4.y = 127.0f / fmaxf(__builtin_bit_cast(float, mb.y), 1e-30f); inv4.z = 127.0f / fmaxf(__builtin_bit_cast(float, mb.z), 1e-30f); inv4.w = 127.0f / fmaxf(__builtin_bit_cast(float, mb.w), 1e-30f); }
#pragma unroll
    for (int i = 0; i < 8; ++i) { const int q = F.tid + 512 * i, row = q >> 5, c4 = q & 31;
        const f32x4 v = *(const f32x4*)(W + (size_t)(k0 + row) * ldw + src_n0 + 4 * c4) * ks[k0 + row] * inv4;
        LAS float* t = T + row * 129 + 4 * c4; t[0] = v.x; t[1] = v.y; t[2] = v.z; t[3] = v.w; }
    __syncthreads();
#pragma unroll
    for (int i = 0; i < 2; ++i) { const int n = (F.tid >> 3) + 64 * i, kc = F.tid & 7;
        const LAS float* s = T + (16 * kc) * 129 + n; unsigned w[4];
#pragma unroll
        for (int j = 0; j < 4; ++j) w[j] = q8(s[(4 * j) * 129]) | (q8(s[(4 * j + 1) * 129]) << 8) | (q8(s[(4 * j + 2) * 129]) << 16) | (q8(s[(4 * j + 3) * 129]) << 24);
        v4u o; o.x = w[0]; o.y = w[1]; o.z = w[2]; o.w = w[3];
        *(v4u*)(WT + (size_t)(dst0 + 64 * (n >> 5) + (n & 31)) * K + k0 + 16 * kc) = o; }
    __syncthreads();
}
__device__ __forceinline__ void xq_row(const bf16* __restrict__ xrow, unsigned char* qrow, const float* __restrict__ ssq32, float* rowf, float s_w, int lane) {
    v4u v[4]; float m = 0.f;
#pragma unroll
    for (int j = 0; j < 4; ++j) { v[j] = *(const v4u*)(xrow + 8 * (lane + 64 * j)); const unsigned w[4] = {v[j].x, v[j].y, v[j].z, v[j].w};
#pragma unroll
        for (int i = 0; i < 4; ++i) m = fmaxf(m, fmaxf(fabsf(bflo(w[i])), fabsf(bfhi(w[i])))); }
    float ss = (lane < 32) ? ssq32[lane] : 0.f;
#pragma unroll
    for (int o = 1; o < 64; o <<= 1) { m = fmaxf(m, __shfl_xor(m, o)); ss += __shfl_xor(ss, o); }
    m = fmaxf(m, 1e-30f); const float inv = 127.0f / m;
    if (lane == 0) *rowf = (1.0f / sqrtf(ss * (1.f / DM) + EPS)) * (m * (1.0f / 127.0f)) * s_w;
#pragma unroll
    for (int j = 0; j < 4; ++j) { const unsigned w[4] = {v[j].x, v[j].y, v[j].z, v[j].w}; v2u o;
        o.x = q8(bflo(w[0]) * inv) | (q8(bfhi(w[0]) * inv) << 8) | (q8(bflo(w[1]) * inv) << 16) | (q8(bfhi(w[1]) * inv) << 24);
        o.y = q8(bflo(w[2]) * inv) | (q8(bfhi(w[2]) * inv) << 8) | (q8(bflo(w[3]) * inv) << 16) | (q8(bfhi(w[3]) * inv) << 24);
        *(v2u*)(qrow + 8 * (lane + 64 * j)) = o; }
}
__device__ __forceinline__ void xb_row(const float* xrow, bf16* orow, float* rstd, int lane) {
    const f32x4* xr = (const f32x4*)xrow + lane;
    f32x4 v[8]; float s = 0.f;
#pragma unroll
    for (int j = 0; j < 8; ++j) { v[j] = xr[64 * j]; s += (v[j].x * v[j].x + v[j].y * v[j].y) + (v[j].z * v[j].z + v[j].w * v[j].w); }
    const float r = 1.0f / sqrtf(wave_sum(s) * (1.f / DM) + EPS);
    if (lane == 0) *rstd = r;
    v2u* o8 = (v2u*)orow + lane;
#pragma unroll
    for (int j = 0; j < 8; ++j) { v2u w; w.x = pk2(v[j].x, v[j].y); w.y = pk2(v[j].z, v[j].w); o8[64 * j] = w; }
}
__device__ __forceinline__ void rstd_from_partials(const float* __restrict__ ssqp, float* rstd, size_t gtid, size_t gthreads) {
    for (size_t r = gtid; r < (size_t)M; r += gthreads) { const f32x4* p = (const f32x4*)(ssqp + r * 32); f32x4 a = p[0];
#pragma unroll
        for (int i = 1; i < 8; ++i) a += p[i];
        rstd[r] = 1.0f / sqrtf(((a.x + a.y) + (a.z + a.w)) * (1.f / DM) + EPS); }
}
__device__ __forceinline__ void tile_norm_store(LAS float* tile, bf16* dst, int row0, int col_off, int wave, int lane) {
#pragma unroll
    for (int i = 0; i < 8; ++i) { const int t = wave * 8 + i;
        const f32x4 a = *(LAS f32x4*)(tile + t * 512 + 8 * lane), b = *(LAS f32x4*)(tile + t * 512 + 8 * lane + 4);
        const float s = (a.x * a.x + a.y * a.y) + (a.z * a.z + a.w * a.w) + (b.x * b.x + b.y * b.y) + (b.z * b.z + b.w * b.w);
        const float rstd = 1.0f / sqrtf(wave_sum(s) * (1.f / 512.f) + EPS);
        v4u o; o.x = pk2(a.x * rstd, a.y * rstd); o.y = pk2(a.z * rstd, a.w * rstd); o.z = pk2(b.x * rstd, b.y * rstd); o.w = pk2(b.z * rstd, b.w * rstd);
        *(v4u*)(dst + (size_t)(row0 + t) * DM + col_off + 8 * lane) = o; }
}
__device__ __forceinline__ void poolfold_item(Frame& F, const float* __restrict__ win, const float* __restrict__ pw, const float* __restrict__ ps, const float* __restrict__ g1, bf16* BtIn, int g, int kb) {
    LAS float* At = (LAS float*)F.lds; LAS float* Bt = (LAS float*)(F.lds + 32768);
    const int k0 = 64 * kb;
#pragma unroll
    for (int i = 0; i < 4; ++i) { const int q = F.tid + 512 * i, row = q >> 5, c4 = q & 31; *(LAS f32x4*)(At + row * 128 + 4 * c4) = *(const f32x4*)(win + (size_t)(k0 + row) * DIN + 128 * g + 4 * c4) * g1[k0 + row]; }
#pragma unroll
    for (int i = 0; i < 8; ++i) { const int q = F.tid + 512 * i, row = q >> 5, c4 = q & 31; *(LAS f32x4*)(Bt + row * 128 + 4 * c4) = *(const f32x4*)(pw + (size_t)(g * 128 + row) * 128 + 4 * c4); }
    __syncthreads();
    const int n = F.tid & 127, kg = F.tid >> 7;
    float acc[16];
#pragma unroll
    for (int i = 0; i < 16; ++i) acc[i] = 0.f;
    for (int j = 0; j < 128; j += 4) {
        const float b0 = Bt[(j + 0) * 128 + n], b1 = Bt[(j + 1) * 128 + n], b2 = Bt[(j + 2) * 128 + n], b3 = Bt[(j + 3) * 128 + n];
#pragma unroll
        for (int i = 0; i < 16; ++i) { const f32x4 a = *(LAS f32x4*)(At + (kg * 16 + i) * 128 + j); acc[i] += a.x * b0 + a.y * b1 + a.z * b2 + a.w * b3; }
    }
    const float sc = ps[128 * g + n];
    v4u o0, o1;
    o0.x = pk2(acc[0] * sc, acc[1] * sc); o0.y = pk2(acc[2] * sc, acc[3] * sc); o0.z = pk2(acc[4] * sc, acc[5] * sc); o0.w = pk2(acc[6] * sc, acc[7] * sc);
    o1.x = pk2(acc[8] * sc, acc[9] * sc); o1.y = pk2(acc[10] * sc, acc[11] * sc); o1.z = pk2(acc[12] * sc, acc[13] * sc); o1.w = pk2(acc[14] * sc, acc[15] * sc);
    bf16* dst = BtIn + (size_t)(128 * g + n) * DM + k0 + kg * 16;
    *(v4u*)dst = o0; *(v4u*)(dst + 8) = o1;
    __syncthreads();
}
__device__ __forceinline__ void filter_item(Frame& F, const float* __restrict__ w1, const float* __restrict__ b1, const float* __restrict__ fr, const float* __restrict__ w2, const float* __restrict__ b2,
                                            const float* __restrict__ w3, const float* __restrict__ b3, const float* __restrict__ hbias, bf16* RF, int fi) {
    LAS float* ZF = (LAS float*)F.lds; LAS float* H1 = ZF + 512; LAS float* H2 = ZF + 1536; LAS float* W1s = ZF + 2560; LAS float* W2s = ZF + 3712;
    const int t0 = 16 * fi;
    for (int q = F.tid; q < 272; q += 512) *(LAS f32x4*)(W1s + 4 * q) = *(const f32x4*)(w1 + 4 * q);
#pragma unroll
    for (int i = 0; i < 2; ++i) { const int q = F.tid + 512 * i; *(LAS f32x4*)(W2s + 4 * q) = *(const f32x4*)(w2 + 4 * q); }
    if (F.tid < 272) { const int tt = F.tid / 17, f = F.tid % 17; const float t = (float)(t0 + tt);
        float v;
        if (f == 0) v = t / 2047.0f;
        else { const int j = (f - 1) & 7; const float band = 1e-4f + (float)j * ((7.0f - 1e-4f) / 7.0f); const float w = (6.283185307179586f * t) / 2048.0f; const float a = band * w; v = (f <= 8) ? __cosf(a) : -__sinf(a); }
        ZF[tt * 17 + f] = v; }
    __syncthreads();
#pragma unroll
    for (int rep = 0; rep < 2; ++rep) { const int p = F.tid + 512 * rep, tt = p >> 6, j = p & 63; float s = b1[j];
#pragma unroll
        for (int i = 0; i < 17; ++i) s += ZF[tt * 17 + i] * W1s[i * 64 + j];
        H1[tt * 64 + j] = __sinf(fr[j] * s); }
    __syncthreads();
#pragma unroll
    for (int rep = 0; rep < 2; ++rep) { const int p = F.tid + 512 * rep, tt = p >> 6, j = p & 63; float s = b2[j];
#pragma unroll 16
        for (int i = 0; i < 64; ++i) s += H1[tt * 64 + i] * W2s[i * 64 + j];
        H2[tt * 64 + j] = __sinf(fr[j] * s); }
    __syncthreads();
    const int c = F.tid;
    const float delta = -3.0701134573253944f + (float)c * ((-15.350567286626972f + 3.0701134573253944f) / 511.0f);
    const float ad = fabsf(delta);
    bf16* rf = RF + (size_t)c * hy::RFS;
#pragma unroll 1
    for (int dir = 0; dir < 2; ++dir) { const int o = dir * 512 + c; const float bo = b3[o];
        float wc[64];
#pragma unroll
        for (int i = 0; i < 64; ++i) wc[i] = w3[i * 1024 + o];
#pragma unroll 1
        for (int tt = 0; tt < 16; ++tt) { float s = bo;
#pragma unroll
            for (int i = 0; i < 64; i += 4) { const f32x4 hv = *(LAS f32x4*)(H2 + tt * 64 + i); s += (hv.x * wc[i] + hv.y * wc[i + 1]) + (hv.z * wc[i + 2] + hv.w * wc[i + 3]); }
            const int t = t0 + tt; const float tl = (float)t / 2047.0f; float val = s * __expf(-tl * ad);
            if (dir == 0) { if (t == 0) val += hbias[c]; rf[2048 - t] = (bf16)f2bf(val); }
            else if (t >= 1) rf[2048 + t] = (bf16)f2bf(val); } }
    if (fi == 0) { rf[0] = 0;
#pragma unroll
        for (int i = 4096; i < hy::RFS; ++i) rf[i] = 0; }
    __syncthreads();
}
__device__ __forceinline__ void unpack4(const v2u w, float (&x)[4]) { x[0] = bflo(w.x); x[1] = bfhi(w.x); x[2] = bflo(w.y); x[3] = bfhi(w.y); }
__device__ __forceinline__ void pair_norm_store(Frame& F, const float (&y)[8][4], bf16* dst, size_t row0, int col_off, int cq) {
    LAS float* part = (LAS float*)F.lds;
    float ss[8];
#pragma unroll
    for (int k = 0; k < 8; ++k) ss[k] = wave_sum((y[k][0] * y[k][0] + y[k][1] * y[k][1]) + (y[k][2] * y[k][2] + y[k][3] * y[k][3]));
    if (F.lane == 0) { *(LAS f32x4*)(part + F.wave * 8) = (f32x4){ss[0], ss[1], ss[2], ss[3]}; *(LAS f32x4*)(part + F.wave * 8 + 4) = (f32x4){ss[4], ss[5], ss[6], ss[7]}; }
    __syncthreads();
    const f32x4 pa = *(LAS f32x4*)(part + (F.wave ^ 1) * 8), pb = *(LAS f32x4*)(part + (F.wave ^ 1) * 8 + 4);
    const float po[8] = {pa.x, pa.y, pa.z, pa.w, pb.x, pb.y, pb.z, pb.w};
#pragma unroll
    for (int k = 0; k < 8; ++k) { const float rstd = 1.0f / sqrtf((ss[k] + po[k]) * (1.f / 512.f) + EPS);
        v2u o; o.x = pk2(y[k][0] * rstd, y[k][1] * rstd); o.y = pk2(y[k][2] * rstd, y[k][3] * rstd);
        *(v2u*)(dst + (row0 + k) * DM + col_off + 4 * cq) = o; }
    __syncthreads();
}
__device__ __forceinline__ void hyprep_item(Frame& F, const bf16* __restrict__ PROJ, const float* __restrict__ cw, const float* __restrict__ cb, bf16* ZT, bf16* X0, int b, int tile) {
    const int tb = F.tid >> 7, cq = F.tid & 127, c0 = 4 * cq, tw = tile * 32 + tb * 8; const size_t rb = (size_t)b * SEQ;
    float z[8][4];
#pragma unroll
    for (int jj = 0; jj < 3; ++jj) { const int j = (jj == 0) ? 1 : (jj == 1) ? 2 : 0; const int cc = 512 * j + c0;
        const f32x4 w0 = *(const f32x4*)(cw + cc), w1 = *(const f32x4*)(cw + 1536 + cc), w2 = *(const f32x4*)(cw + 3072 + cc), bs = *(const f32x4*)(cb + cc);
        float x[10][4];
#pragma unroll
        for (int o = 0; o < 10; ++o) { const int t = tw - 1 + o; const bool ok = (t >= 0) && (t < SEQ); const int tc = ok ? t : tw;
            const v2u w = *(const v2u*)(PROJ + (rb + tc) * DINP + O_HY + cc); unpack4(w, x[o]);
            if (!ok) { x[o][0] = 0.f; x[o][1] = 0.f; x[o][2] = 0.f; x[o][3] = 0.f; } }
        if (jj == 0) {
#pragma unroll
            for (int k = 0; k < 8; ++k)
#pragma unroll
                for (int i = 0; i < 4; ++i) z[k][i] = w0[i] * x[k][i] + w1[i] * x[k + 1][i] + w2[i] * x[k + 2][i] + bs[i];
        } else if (jj == 1) {
#pragma unroll
            for (int k = 0; k < 8; ++k)
#pragma unroll
                for (int i = 0; i < 4; ++i) z[k][i] *= w0[i] * x[k][i] + w1[i] * x[k + 1][i] + w2[i] * x[k + 2][i] + bs[i];
#pragma unroll
            for (int i = 0; i < 4; ++i) { v4u o; o.x = pk2(z[0][i], z[1][i]); o.y = pk2(z[2][i], z[3][i]); o.z = pk2(z[4][i], z[5][i]); o.w = pk2(z[6][i], z[7][i]);
                *(v4u*)(ZT + ((size_t)(c0 + i) * NSEQ + b) * SEQ + tw) = o; }
        } else {
#pragma unroll
            for (int k = 0; k < 8; ++k) { float u0[4];
#pragma unroll
                for (int i = 0; i < 4; ++i) u0[i] = w0[i] * x[k][i] + w1[i] * x[k + 1][i] + w2[i] * x[k + 2][i] + bs[i];
                v2u o; o.x = pk2(u0[0], u0[1]); o.y = pk2(u0[2], u0[3]); *(v2u*)(X0 + (rb + tw + k) * HYC + c0) = o; }
        }
    }
}
__device__ __forceinline__ void pool_item(Frame& F, const bf16* __restrict__ PROJ, bf16* MIXED, int b, int tile) {
    const int tb = F.tid >> 7, cq = F.tid & 127, c0 = 4 * cq, g = cq >> 5, half = 1 << g, tw = tile * 32 + tb * 8; const size_t rb = (size_t)b * SEQ;
    float x[23][4];
#pragma unroll
    for (int o = 0; o < 23; ++o) { const int t = tw - 8 + o; const bool ok = (t >= 0) && (t < SEQ); const int tc = ok ? t : tw;
        const v2u w = *(const v2u*)(PROJ + (rb + tc) * DINP + c0); unpack4(w, x[o]);
        if (!ok) { x[o][0] = 0.f; x[o][1] = 0.f; x[o][2] = 0.f; x[o][3] = 0.f; } }
    float y[8][4];
#pragma unroll
    for (int k = 0; k < 8; ++k) { const int oc = 8 + k, t = tw + k; const int lo = (t - half > 0) ? t - half : 0, hi = (t + half < SEQ) ? t + half : SEQ; const float inv = 1.0f / (float)(hi - lo);
#pragma unroll
        for (int i = 0; i < 4; ++i) {
            const float w1 = x[oc - 1][i] + x[oc][i];
            const float w2 = w1 + (x[oc - 2][i] + x[oc + 1][i]);
            const float w4 = w2 + ((x[oc - 4][i] + x[oc - 3][i]) + (x[oc + 2][i] + x[oc + 3][i]));
            const float w8 = w4 + (((x[oc - 8][i] + x[oc - 7][i]) + (x[oc - 6][i] + x[oc - 5][i])) + ((x[oc + 4][i] + x[oc + 5][i]) + (x[oc + 6][i] + x[oc + 7][i])));
            const float S = (g == 0) ? w1 : (g == 1) ? w2 : (g == 2) ? w4 : w8;
            y[k][i] = S * inv - x[oc][i]; } }
    pair_norm_store(F, y, MIXED, rb + tw, 0, cq);
}
__device__ __forceinline__ void hyfin_item(Frame& F, const bf16* __restrict__ YC, const bf16* __restrict__ X0, bf16* MIXED, int b, int tile) {
    const int tb = F.tid >> 7, cq = F.tid & 127, c0 = 4 * cq, tw = tile * 32 + tb * 8; const size_t rb = (size_t)b * SEQ;
    float yc[4][8], y[8][4];
#pragma unroll
    for (int i = 0; i < 4; ++i) { const v4u v = *(const v4u*)(YC + ((size_t)(c0 + i) * NSEQ + b) * SEQ + tw);
        yc[i][0] = bflo(v.x); yc[i][1] = bfhi(v.x); yc[i][2] = bflo(v.y); yc[i][3] = bfhi(v.y); yc[i][4] = bflo(v.z); yc[i][5] = bfhi(v.z); yc[i][6] = bflo(v.w); yc[i][7] = bfhi(v.w); }
#pragma unroll
    for (int k = 0; k < 8; ++k) { float xv[4]; unpack4(*(const v2u*)(X0 + (rb + tw + k) * HYC + c0), xv);
#pragma unroll
        for (int i = 0; i < 4; ++i) y[k][i] = yc[i][k] * xv[i]; }
    pair_norm_store(F, y, MIXED, rb + tw, 1536, cq);
}
struct PrepGains { float q[3][8], k[3][8]; };
__device__ __forceinline__ void load8(const float* p, float (&o)[8]) { const f32x4 a = *(const f32x4*)p, b = *(const f32x4*)(p + 4); o[0] = a.x; o[1] = a.y; o[2] = a.z; o[3] = a.w; o[4] = b.x; o[5] = b.y; o[6] = b.z; o[7] = b.w; }
__device__ __forceinline__ void unpack8(const v4u w, float (&x)[8]) { x[0] = bflo(w.x); x[1] = bfhi(w.x); x[2] = bflo(w.y); x[3] = bfhi(w.y); x[4] = bflo(w.z); x[5] = bfhi(w.z); x[6] = bflo(w.w); x[7] = bfhi(w.w); }
__device__ __forceinline__ v4u pack8(const float (&x)[8]) { v4u o; o.x = pk2(x[0], x[1]); o.y = pk2(x[2], x[3]); o.z = pk2(x[4], x[5]); o.w = pk2(x[6], x[7]); return o; }
__device__ __forceinline__ float ssq8(const float (&x)[8]) { return ((x[0] * x[0] + x[1] * x[1]) + (x[2] * x[2] + x[3] * x[3])) + ((x[4] * x[4] + x[5] * x[5]) + (x[6] * x[6] + x[7] * x[7])); }
__device__ __forceinline__ float sum8lanes(float v) { v += __shfl_xor(v, 1); v += __shfl_xor(v, 2); v += __shfl_xor(v, 4); return v; }
__device__ __forceinline__ void prep_row(const bf16* __restrict__ PROJ, bf16* Q, bf16* KV, const PrepGains& G, const float* __restrict__ ROPE, int m, int lane) {
    const int h = lane >> 3, sub = lane & 7;
    const bf16* pr = PROJ + (size_t)m * DINP; bf16* qr = Q + (size_t)m * NQ + 192 * h + 8 * sub; bf16* kr = KV + (size_t)m * NKVP + KVHS * h + 8 * sub;
    const v4u cqv = *(const v4u*)(pr + O_CQ + 8 * lane); const v4u ckv = *(const v4u*)(pr + O_CKV + 8 * (lane & 31)); const v4u pev = *(const v4u*)(pr + O_KPE + 8 * sub);
    const v4u q0 = *(const v4u*)(qr), q1 = *(const v4u*)(qr + 64), q2 = *(const v4u*)(qr + 128);
    const v4u k0 = *(const v4u*)(kr), k1 = *(const v4u*)(kr + 64), v0 = *(const v4u*)(kr + 192), v1 = *(const v4u*)(kr + 256);
    float cs[8], sn[8]; { const float* rp = ROPE + (size_t)(m & (SEQ - 1)) * 64 + 8 * (sub & 3); load8(rp, cs); load8(rp + 32, sn); }
    float t[8];
    unpack8(cqv, t); const float rq = 1.0f / sqrtf(wave_sum(ssq8(t)) * (1.f / 512.f) + EPS);
    unpack8(ckv, t); const float rkv = 1.0f / sqrtf(wave_sum(lane < 32 ? ssq8(t) : 0.f) * (1.f / 256.f) + EPS);
    const float sg = (sub < 4) ? -1.f : 1.f;
    { float a0[8], a1[8], a2[8]; unpack8(q0, a0); unpack8(q1, a1); unpack8(q2, a2);
      const float ss = sum8lanes(ssq8(a0) + ssq8(a1) + ssq8(a2)) * (rq * rq);
      const float sc = (rq * (at::SCALE * 1.4426950408889634f)) / sqrtf(ss * (1.f / 192.f) + EPS);
      float r[8], o[8];
#pragma unroll
      for (int i = 0; i < 8; ++i) { a0[i] *= sc * G.q[0][i]; a1[i] *= sc * G.q[1][i]; r[i] = a2[i] * sc * G.q[2][i]; }
#pragma unroll
      for (int i = 0; i < 8; ++i) { const float rp = __shfl_xor(r[i], 4); o[i] = r[i] * cs[i] + sg * rp * sn[i]; }
      *(v4u*)(qr) = pack8(a0); *(v4u*)(qr + 64) = pack8(a1); *(v4u*)(qr + 128) = pack8(o); }
    { float a0[8], a1[8], pe[8], b0[8], b1[8]; unpack8(k0, a0); unpack8(k1, a1); unpack8(pev, pe); unpack8(v0, b0); unpack8(v1, b1);
      const float ss = sum8lanes((ssq8(a0) + ssq8(a1)) * (rkv * rkv) + ssq8(pe));
      const float sk = 1.0f / sqrtf(ss * (1.f / 192.f) + EPS);
      float r[8], o[8];
#pragma unroll
      for (int i = 0; i < 8; ++i) { a0[i] *= rkv * sk * G.k[0][i]; a1[i] *= rkv * sk * G.k[1][i]; r[i] = pe[i] * sk * G.k[2][i]; b0[i] *= rkv; b1[i] *= rkv; }
#pragma unroll
      for (int i = 0; i < 8; ++i) { const float rp = __shfl_xor(r[i], 4); o[i] = r[i] * cs[i] + sg * rp * sn[i]; }
      *(v4u*)(kr) = pack8(a0); *(v4u*)(kr + 64) = pack8(a1); *(v4u*)(kr + 128) = pack8(o); *(v4u*)(kr + 192) = pack8(b0); *(v4u*)(kr + 256) = pack8(b1); }
}
__device__ __forceinline__ void attn_norm_row(bf16* MIXED, int m, int lane) {
    v4u* p = (v4u*)(MIXED + (size_t)m * DM + 512 + 16 * lane); v4u a = p[0], b = p[1];
    unsigned w[8] = {a.x, a.y, a.z, a.w, b.x, b.y, b.z, b.w}; float s = 0.f;
#pragma unroll
    for (int i = 0; i < 8; ++i) { const float x = bflo(w[i]), y = bfhi(w[i]); s += x * x + y * y; }
    const float rstd = 1.0f / sqrtf(wave_sum(s) * (1.f / 1024.f) + EPS);
#pragma unroll
    for (int i = 0; i < 8; ++i) w[i] = pk2(bflo(w[i]) * rstd, bfhi(w[i]) * rstd);
    a.x = w[0]; a.y = w[1]; a.z = w[2]; a.w = w[3]; b.x = w[4]; b.y = w[5]; b.z = w[6]; b.w = w[7]; p[0] = a; p[1] = b;
}

#define DEFPTRS() unsigned char* ws = args.ws; \
    bf16* BtIn = (bf16*)(ws + WS_BTIN); bf16* BtUq = (bf16*)(ws + WS_BTUQ); bf16* BtKv = (bf16*)(ws + WS_BTKV); bf16* BtOut = (bf16*)(ws + WS_BTOUT); bf16* BtUp = (bf16*)(ws + WS_BTUP); bf16* BtDn = (bf16*)(ws + WS_BTDN); \
    bf16* RF = (bf16*)(ws + WS_RF); bf16* Hb = (bf16*)(ws + WS_H); bf16* PROJ = (bf16*)(ws + WS_PROJ); bf16* Qb = (bf16*)(ws + WS_Q); bf16* KVb = (bf16*)(ws + WS_KV); \
    bf16* ZT = (bf16*)(ws + WS_ZT); bf16* X0 = (bf16*)(ws + WS_X0); bf16* YC = (bf16*)(ws + WS_YC); float* EDGE = (float*)(ws + WS_EDGE); float* ROPE = (float*)(ws + WS_ROPE); float* SSQP = (float*)(ws + WS_SSQP); float* RSTD = (float*)(ws + WS_RSTD); bf16* XB2 = (bf16*)(ws + WS_XB2); unsigned char* XQ = (unsigned char*)(ws + WS_XQ); unsigned char* BtUpQ = (unsigned char*)(ws + WS_BTUP); bf16* ACT = (bf16*)(ws + WS_ACT); \
    bf16* XA = (bf16*)args.out; \
    (void)BtIn; (void)BtUq; (void)BtKv; (void)BtOut; (void)BtUp; (void)BtDn; (void)RF; (void)Hb; (void)PROJ; (void)Qb; (void)KVb; (void)ZT; (void)X0; (void)YC; (void)EDGE; (void)ROPE; (void)SSQP; (void)RSTD; (void)XB2; (void)XQ; (void)BtUpQ; (void)ACT; (void)XA
__global__ void __launch_bounds__(NWAVES * 64, 2) fwd(Args args) {
    extern __shared__ __attribute__((aligned(16))) unsigned char lds_raw[];
    Frame F;
    F.lds = (LAS unsigned char*)lds_raw;
    F.tid = threadIdx.x; F.lane = F.tid & 63; F.wave = __builtin_amdgcn_readfirstlane(F.tid >> 6);
    F.G = gridDim.x; { const int bx = blockIdx.x; F.vcu = (F.G % 8 == 0) ? (bx % 8) * (F.G / 8) + bx / 8 : bx; }
    volatile LAS unsigned* MISC = (volatile LAS unsigned*)(F.lds + MISC_OFF);
    if (F.tid < 64) MISC[F.tid] = 0u;
    __syncthreads();
    unsigned* ctl = (unsigned*)(args.ws + WS_CTL);
    const int lo = args.ph_lo, hi = args.ph_hi;
    XcdBarrier bar; bar.bar = ctl + CW_BAR; bar.x = 0; bar.st = MISC + 8;
    if (hi - lo > 1) bar = xcd_barrier_post(ctl + CW_BAR, MISC + 8);
    float* out = args.out;

#pragma unroll 1
    for (int layer = 0; layer < DEPTH; ++layer) {
        const int pb = layer * NPH;
        if (pb + NPH <= lo || pb >= hi) continue;
#define IN(k) (lo <= pb + (k) && pb + (k) < hi)
#define ENTER() DEFPTRS(); F.tid = opq(threadIdx.x); F.lane = F.tid & 63; F.wave = __builtin_amdgcn_readfirstlane(F.tid >> 6); const int gw = F.vcu * NWAVES + F.wave, NGW = F.G * NWAVES, wg = F.vcu; const size_t gtid = (size_t)wg * 512 + F.tid, gthreads = (size_t)F.G * 512; (void)gw; (void)NGW; (void)wg; (void)gtid; (void)gthreads
#define SEAM(k) do { if (pb + (k) + 1 < hi) xcd_barrier(bar); } while (0)

        if (IN(0)) { ENTER();
            const float* win = args.in[I_WIN] + (size_t)layer * DM * DIN; const float* g1 = args.in[I_ANG] + layer * DM;
            for (int it = wg; it < 256; it += F.G) {
                if (it < 128) poolfold_item(F, win, args.in[I_PW] + (size_t)layer * 4 * 128 * 128, args.in[I_PS] + (size_t)layer * 512, g1, BtIn, it >> 5, it & 31);
                else filter_item(F, args.in[I_FW1] + (size_t)layer * 17 * 64, args.in[I_FB1] + layer * 64, args.in[I_FFR] + layer * 64, args.in[I_FW2] + (size_t)layer * 64 * 64, args.in[I_FB2] + layer * 64,
                                 args.in[I_FW3] + (size_t)layer * 64 * 1024, args.in[I_FB3] + layer * 1024, args.in[I_HBIAS] + layer * 512, RF, it - 128);
            }
            constexpr int T_IN = 19 * 16, T_UQ = 12 * 4, T_KV = 16 * 2, T_OUT = 16 * 16, T_UP = 88 * 16, T_DN = 16 * 44, T_ALL = T_IN + T_UQ + T_KV + T_OUT + T_UP + T_DN;
            for (int it = wg; it < T_ALL; it += F.G) {
                int r = it; CvtTile d;
                if (r < T_IN) { const int nt = r >> 4, kt = r & 15, n0 = 512 + 128 * nt; d = CvtTile{win, g1, BtIn, DIN, DM, n0, 128 * kt, DIN, {n0, n0 + 32, n0 + 64, n0 + 96}}; }
                else if ((r -= T_IN) < T_UQ) { const int nt = r >> 2, kt = r & 3, n0 = 128 * nt; d = CvtTile{args.in[I_WUQ] + (size_t)layer * 512 * NQ, args.in[I_QNG] + layer * 512, BtUq, NQ, 512, n0, 128 * kt, NQ, {n0, n0 + 32, n0 + 64, n0 + 96}}; }
                else if ((r -= T_UQ) < T_KV) { const int nt = r >> 1, kt = r & 1, n0 = 128 * nt;
                    d = CvtTile{args.in[I_WUKV] + (size_t)layer * 256 * 2048, args.in[I_KVNG] + layer * 256, BtKv, 2048, 256, n0, 128 * kt, 2048, {n0, n0 + 32, n0 + 64, n0 + 96}}; }
                else if ((r -= T_KV) < T_OUT) { const int nt = r >> 4, kt = r & 15, n0 = 128 * nt; d = CvtTile{args.in[I_WOUT] + (size_t)layer * DM * DM, args.in[I_GNG] + layer * DM, BtOut, DM, DM, n0, 128 * kt, DM, {n0, n0 + 32, n0 + 64, n0 + 96}}; }
                else if ((r -= T_OUT) < T_UP) { const int nt = r >> 4, kt = r & 15;
                    absmax_tile(F, args.in[I_WUP] + (size_t)layer * DM * NUP, args.in[I_FNG] + layer * DM, NUP, 128 * nt, 128 * kt, ctl + CW_WMAXC + layer * NUP); continue; }
                else { r -= T_UP; const int nt = r / 44, kt = r % 44, n0 = 128 * nt; d = CvtTile{args.in[I_WDN] + (size_t)layer * DFF * DM, nullptr, BtDn, DM, DFF, n0, 128 * kt, DM, {n0, n0 + 32, n0 + 64, n0 + 96}}; }
                cvt_tile(F, d);
            }
            { unsigned zz = 0u; asm volatile("" : "+v"(zz)); v4u z = {zz, zz, zz, zz};
              for (size_t i = gtid; i < (size_t)(DINP - DIN) * DM / 8; i += gthreads) *(v4u*)(BtIn + (size_t)DIN * DM + i * 8) = z;
}
            if (layer == 0) for (size_t i = gtid; i < (size_t)SEQ * 32; i += gthreads) { const int pos = (int)(i >> 5), ri = (int)(i & 31);
                const float freq = exp2f(-(float)ri * (13.287712379549449f / 32.0f)); float sn, cs; sincosf((float)pos * freq, &sn, &cs); ROPE[pos * 64 + ri] = cs; ROPE[pos * 64 + 32 + ri] = sn; }
            if (layer == 0) { for (int m = gw; m < M; m += NGW) xb_row(m < MP ? args.in[I_XP] + (size_t)m * DM : args.in[I_XS] + (size_t)(m - MP) * DM, XA + (size_t)m * DM, RSTD + m, F.lane); }
            else rstd_from_partials(SSQP, RSTD, gtid, gthreads);
            SEAM(0);
        }
        if (IN(1)) { ENTER();
            pg8::Gemm g{XA, BtIn, M, DINP, DM, DM}; pg8::StaticOrder S; S.init(M, DINP, F.G, (int)blockIdx.x);
            pg8::EpiBf16 E{PROJ, DINP, RSTD, 0};
            pg8::gemm_phase<pg8::EpiBf16, pg8::StaticOrder>(F.lds, g, S, E);
            SEAM(1);
        }
        if (IN(2)) { ENTER();
            { pg8::Gemm g{PROJ + O_CQ, BtUq, M, NQ, 512, DINP}; pg8::StaticOrder S; S.init(M, NQ, F.G, (int)blockIdx.x); pg8::EpiBf16 E{Qb, NQ, nullptr, 0};
              pg8::gemm_phase<pg8::EpiBf16, pg8::StaticOrder>(F.lds, g, S, E); }
            { pg8::Gemm g{PROJ + O_CKV, BtKv, M, 2048, 256, DINP}; pg8::StaticOrder S; S.init(M, 2048, F.G, (int)blockIdx.x); pg8::EpiBf16 E{KVb, NKVP, nullptr, 1};
              pg8::gemm_phase<pg8::EpiBf16, pg8::StaticOrder>(F.lds, g, S, E); }
            const float* hcw = args.in[I_HCW] + (size_t)layer * 3 * 1536; const float* hcb = args.in[I_HCB] + layer * 1536;
            for (int it = wg; it < 2 * NSEQ * 64; it += F.G) {
                if (it < NSEQ * 64) hyprep_item(F, PROJ, hcw, hcb, ZT, X0, it >> 6, it & 63);
                else pool_item(F, PROJ, Hb, (it - NSEQ * 64) >> 6, it & 63);
            }
            SEAM(2);
        }
        if (IN(3)) { ENTER();
            for (int u = wg; u < 2 * HYC; u += F.G) hy::conv_unit(F.lds, ZT, RF, YC, u >> 1, u & 1);
            const float* qhg = args.in[I_QHG] + layer * 192; const float* khg = args.in[I_KHG] + layer * 192;
            PrepGains PG; { const int sub = F.lane & 7;
#pragma unroll
                for (int i = 0; i < 3; ++i) { load8(qhg + 64 * i + 8 * sub, PG.q[i]); load8(khg + 64 * i + 8 * sub, PG.k[i]); } }
            for (int m = gw; m < M; m += NGW) prep_row(PROJ, Qb, KVb, PG, ROPE, m, F.lane);
            SEAM(3);
        }
        if (IN(4)) { ENTER();
            float gqm, gkm; { const float* qhg = args.in[I_QHG] + layer * 192; const float* khg = args.in[I_KHG] + layer * 192;
                gqm = fmaxf(fmaxf(fabsf(qhg[F.lane]), fabsf(qhg[64 + F.lane])), fabsf(qhg[128 + F.lane])); gkm = fmaxf(fmaxf(fabsf(khg[F.lane]), fabsf(khg[64 + F.lane])), fabsf(khg[128 + F.lane]));
#pragma unroll
                for (int o = 1; o < 64; o <<= 1) { gqm = fmaxf(gqm, __shfl_xor(gqm, o)); gkm = fmaxf(gkm, __shfl_xor(gkm, o)); } }
            const float Mnat = 13.856406460551018f * gqm * gkm;
            const bool sm_fast = __builtin_amdgcn_readfirstlane((Mnat <= 40.0f) ? 1 : 0) != 0;
            const float negMC = __builtin_bit_cast(float, __builtin_amdgcn_readfirstlane(__builtin_bit_cast(int, -Mnat * 1.4426950408889634f)));
            for (int i = 0; i * F.G < NSEQ * NH * 8; ++i) {
                int p, qb; const int c = (int)blockIdx.x;
                if (F.G == 256) { p = i * 32 + (c & 7) * 4 + (c >> 6); qb = (c >> 3) & 7; } else { const int Lq = i * F.G + c; p = Lq >> 3; qb = Lq & 7; }
                if (p < NSEQ * NH) { const int b = p >> 3, h = p & 7;
                    const bf16* qp = Qb + (size_t)(b * SEQ + qb * 256) * NQ + h * 192; const bf16* kp = KVb + (size_t)(b * SEQ) * NKVP + h * KVHS; bf16* op = Hb + (size_t)(b * SEQ + qb * 256) * DM + 512 + h * 128;
                    if (sm_fast) at::attn_unit<true>(negMC, qp, kp, kp + 192, op, SEQ, (char*)lds_raw);
                    else at::attn_unit<false>(0.f, qp, kp, kp + 192, op, SEQ, (char*)lds_raw); }
            }
            for (int it = wg; it < NSEQ * 64; it += F.G) hyfin_item(F, YC, X0, Hb, it >> 6, it & 63);
            SEAM(4);
        }
        if (IN(5)) { ENTER();
            for (int m = gw; m < M; m += NGW) attn_norm_row(Hb, m, F.lane);
            SEAM(5);
        }
        if (IN(6)) { ENTER();
            pg8::Gemm g{Hb, BtOut, M, DM, DM, DM}; pg8::StaticOrder S; S.init(M, DM, F.G, (int)blockIdx.x);
            pg8::EpiResid16 E{XA, XB2, out, DM, SSQP, 0};
            pg8::gemm_phase<pg8::EpiResid16, pg8::StaticOrder>(F.lds, g, S, E);
            SEAM(6);
        }
        if (IN(7)) { ENTER();
            const unsigned* wmaxc = ctl + CW_WMAXC + layer * NUP;
            for (int it = wg; it < 88 * 16; it += F.G) { const int nt = it >> 4, kt = it & 15; const int nv = (nt < 44) ? nt : nt - 44;
                cvtq_tile(F, args.in[I_WUP] + (size_t)layer * DM * NUP, args.in[I_FNG] + layer * DM, NUP, DM, BtUpQ, 128 * nt, 128 * kt, 256 * nv + ((nt < 44) ? 0 : 32), wmaxc); }
            for (int m = gw; m < M; m += NGW) xq_row(XB2 + (size_t)m * DM, XQ + (size_t)m * DM, SSQP + (size_t)m * 32, RSTD + m, 1.0f, F.lane);
            SEAM(7);
        }
        if (IN(8)) { ENTER();
            pg8::Gemm g{(const bf16*)XQ, (const bf16*)BtUpQ, M, NUP, DM / 2, DM / 2}; pg8::StaticOrder S; S.init(M, NUP, F.G, (int)blockIdx.x);
            pg8::EpiGate E{ACT, DFF, EDGE, args.in[I_FCW] + (size_t)layer * 3 * DFF, args.in[I_FCB] + layer * DFF, DFF, (LAS float*)(F.lds + HALO_OFF), RSTD, ctl + CW_WMAXC + layer * NUP};
            pg8::gemm_phase<pg8::EpiGate, pg8::StaticOrder, true>(F.lds, g, S, E);
            SEAM(8);
        }
        if (IN(9)) { ENTER();
            const float* fcw = args.in[I_FCW] + (size_t)layer * 3 * DFF;
            for (size_t i = gtid; i < (size_t)(M / 256) * 2 * (DFF / 4); i += gthreads) {
                const int ri = (int)(i / (DFF / 4)), c4 = (int)(i % (DFF / 4)) * 4, pm = ri >> 1, e = ri & 1;
                const float* eb = EDGE + (size_t)(ri * 3) * DFF + c4;
                f32x4 pre = *(const f32x4*)(eb + DFF); const f32x4 v = *(const f32x4*)(eb + 2 * DFF);
                if (e == 0 && (pm & 7) != 0) { const f32x4 gp = *(const f32x4*)(EDGE + (size_t)(((pm - 1) * 2 + 1) * 3) * DFF + c4); pre += *(const f32x4*)(fcw + c4) * gp; }
                if (e == 1 && (pm & 7) != 7) { const f32x4 gn = *(const f32x4*)(EDGE + (size_t)(((pm + 1) * 2 + 0) * 3) * DFF + c4); pre += *(const f32x4*)(fcw + 2 * DFF + c4) * gn; }
                v2u o; o.x = pk2(pg8::silu_f(pre.x) * v.x, pg8::silu_f(pre.y) * v.y); o.y = pk2(pg8::silu_f(pre.z) * v.z, pg8::silu_f(pre.w) * v.w);
                *(v2u*)(ACT + (size_t)(pm * 256 + (e ? 255 : 0)) * DFF + c4) = o;
            }
            SEAM(9);
        }
        if (IN(10)) { ENTER();
            pg8::Gemm g{ACT, BtDn, M, DM, DFF, DFF}; pg8::StaticOrder S; S.init(M, DM, F.G, (int)blockIdx.x);
            pg8::EpiResid16 E{XB2, XA, out, DM, SSQP, (layer + 1 < DEPTH) ? 0 : 1};
            pg8::gemm_phase<pg8::EpiResid16, pg8::StaticOrder>(F.lds, g, S, E);
            SEAM(10);
        }
#undef IN
#undef ENTER
#undef SEAM
    }
}

extern "C" void kernel_launch(void* const* d_in, const int* in_sizes, int n_in, void* d_out, int out_size, void* d_ws, size_t ws_size, hipStream_t stream) {
    static int grid = 0;
    if (grid == 0) {
        if (n_in != N_IN || out_size != M * DM || ws_size < WS_END) { fprintf(stderr, "kernel_launch: unexpected shapes (n_in %d, out %d, ws %zu, need %zu)\n", n_in, out_size, ws_size, (size_t)WS_END); grid = -1; return; }
        int dev = 0, cus = 0;
        if (hipGetDevice(&dev) != hipSuccess || hipDeviceGetAttribute(&cus, hipDeviceAttributeMultiprocessorCount, dev) != hipSuccess) { grid = -1; return; }
        if (hipFuncSetAttribute((const void*)fwd, hipFuncAttributeMaxDynamicSharedMemorySize, LDS_BYTES) != hipSuccess) { fprintf(stderr, "kernel_launch: hipFuncSetAttribute failed\n"); grid = -1; return; }
        int per_cu = 0;
        if (hipOccupancyMaxActiveBlocksPerMultiprocessor(&per_cu, (const void*)fwd, NWAVES * 64, LDS_BYTES) != hipSuccess || per_cu < 1) fprintf(stderr, "kernel_launch: occupancy query reports %d\n", per_cu);
        (void)hipGetLastError();
        grid = cus;
    }
    if (grid < 0) return;
    (void)hipMemsetAsync((char*)d_ws + WS_CTL, 0, CTL_BYTES, stream);
    Args a{};
    for (int i = 0; i < N_IN; ++i) a.in[i] = (const float*)d_in[i];
    a.out = (float*)d_out; a.ws = (unsigned char*)d_ws;
#if MK_ONE_LAUNCH
    a.ph_lo = 0; a.ph_hi = DEPTH * NPH;
    hipLaunchKernelGGL(fwd, dim3(grid), dim3(NWAVES * 64), LDS_BYTES, stream, a);
#else
    for (int p = 0; p < DEPTH * NPH; ++p) { a.ph_lo = p; a.ph_hi = p + 1; hipLaunchKernelGGL(fwd, dim3(grid), dim3(NWAVES * 64), LDS_BYTES, stream, a); }
#endif
    const hipError_t le = hipPeekAtLastError();
    if (le != hipSuccess) fprintf(stderr, "kernel_launch: launch failed: %s\n", hipGetErrorName(le));
}
```

```cpp
#include <hip/hip_runtime.h>
#include <cstdio>
#include <cstdint>
__device__ __forceinline__ int opq(int x) { asm volatile("" : "+v"(x)); return x; }
namespace pg8 {
#define PG8_LAS __attribute__((address_space(3)))
typedef unsigned short bf16_t;
typedef short bf16x8 __attribute__((ext_vector_type(8)));
typedef float f32x4 __attribute__((ext_vector_type(4)));
typedef unsigned u32x4 __attribute__((ext_vector_type(4)));
typedef int i32x4 __attribute__((ext_vector_type(4)));
template <bool I8> struct AccSel { typedef f32x4 T; }; template <> struct AccSel<true> { typedef i32x4 T; };
constexpr int BM = 256, BK = 64, HALF = 128, HTB = HALF * BK * 2  , STAGE_BYTES = 8 * HTB, NXCD = 8, WGM = 8;

__host__ __device__ __forceinline__ int lds_byte(int r, int c) { const int st = (r >> 4) * 2 + (c >> 5), rr = r & 15, cc = c & 31, ob = rr * 64 + cc * 2; return st * 1024 + (ob ^ (((ob >> 9) & 1) << 5)); }
__host__ __device__ __forceinline__ void stage_rc(int b, int& R, int& C) { const int st = b / 1024, sb = b % 1024, swz = sb ^ (((sb >> 9) & 1) << 5); R = (st >> 1) * 16 + swz / 64; C = (st & 1) * 32 + (swz % 64) / 2; }
__host__ __device__ __forceinline__ int perm32(int rho) { const int n = rho >> 4, i = rho & 15; return 8 * (i >> 2) + 4 * n + (i & 3); }

struct Unit { int pm, pn; };
struct Gemm { const bf16_t* A; const bf16_t* Bt; int M, N, K, lda; };

struct StaticOrder {
    int nM, nN, nwg, G, c;
    __host__ __device__ void init(int M, int N, int G_, int c_) { nM = M / BM; nN = N / BM; nwg = nM * nN; G = G_; c = c_; }
    __host__ __device__ bool next(int i, Unit& u) const {
        const long L = (long)i * G + c; if (L >= nwg) return false;
        int wgid = (int)L; { const int q = nwg / NXCD, r = nwg % NXCD, xcd = wgid % NXCD, off = wgid / NXCD; wgid = (xcd < r ? xcd * (q + 1) : r * (q + 1) + (xcd - r) * q) + off; }
        const int nig = WGM * nN, gid = wgid / nig, fm = gid * WGM, gsz = (nM - fm) < WGM ? (nM - fm) : WGM;
        u.pm = fm + ((wgid % nig) % gsz); u.pn = (wgid % nig) / gsz; return true;
    }
    __device__ __forceinline__ void a_ready(const Unit&) const {}
    __device__ __forceinline__ void done(const Unit&) const {}
};

__device__ __forceinline__ unsigned cvt_pk_bf16(float lo, float hi) { unsigned r; asm volatile("v_cvt_pk_bf16_f32 %0, %1, %2" : "=v"(r) : "v"(lo), "v"(hi)); return r; }

__device__ __forceinline__ float dpp_ror1(float v) { return __builtin_bit_cast(float, __builtin_amdgcn_update_dpp(0, __builtin_bit_cast(int, v), 0x121, 0xF, 0xF, false)); }
__device__ __forceinline__ float dpp_ror15(float v) { return __builtin_bit_cast(float, __builtin_amdgcn_update_dpp(0, __builtin_bit_cast(int, v), 0x12F, 0xF, 0xF, false)); }
__device__ __forceinline__ unsigned dpp_swap1(unsigned v) { return (unsigned)__builtin_amdgcn_update_dpp(0, (int)v, 0xB1, 0xF, 0xF, false); }
struct LineOffs { unsigned o0, o1; bool odd; };
__device__ __forceinline__ LineOffs line_offs(unsigned lo, int pitch, int fr) { LineOffs L; L.odd = fr & 1; L.o0 = L.odd ? lo - (unsigned)pitch + 32u : lo; L.o1 = L.odd ? lo + 32u : lo + (unsigned)pitch; return L; }
__device__ __forceinline__ void store_lines(bf16_t* base, const LineOffs& L, u32x4 a, u32x4 b) {
    const u32x4 snd = L.odd ? a : b; u32x4 rcv;
    rcv.x = dpp_swap1(snd.x); rcv.y = dpp_swap1(snd.y); rcv.z = dpp_swap1(snd.z); rcv.w = dpp_swap1(snd.w);
    *(u32x4*)(base + L.o0) = L.odd ? rcv : a;
    *(u32x4*)(base + L.o1) = L.odd ? b : rcv;
}
struct EpiBf16 {
    static constexpr bool PERM = true;
    bf16_t* O; int ldc; const float* rstd; int kvscatter;
    __device__ __forceinline__ void operator()(f32x4 (&acc)[2][2][4][2], const Unit& u, int wr, int wc, int fr, int fq) const {
        bf16_t* Ot = O + (size_t)(u.pm * BM) * ldc + (kvscatter ? u.pn * 320 : u.pn * BM);
        const int wcol = kvscatter ? (wc < 2 ? wc * 64 : 64 + wc * 64) : wc * 64;
        const LineOffs L = line_offs((unsigned)((wr * 64 + fr) * ldc + wcol + 8 * fq), ldc, fr); const int row0 = u.pm * BM + wr * 64 + fr;
        float rsv[8];
#pragma unroll
        for (int i = 0; i < 8; ++i) rsv[i] = rstd ? rstd[row0 + (i >> 2) * HALF + (i & 3) * 16] : 1.0f;
#pragma unroll
        for (int ai = 0; ai < 2; ++ai)
#pragma unroll
            for (int m = 0; m < 4; ++m) { const float rs = rsv[ai * 4 + m];
                u32x4 w[2];
#pragma unroll
                for (int bj = 0; bj < 2; ++bj) { const f32x4 v0 = acc[ai][bj][m][0] * rs, v1 = acc[ai][bj][m][1] * rs;
                    w[bj].x = cvt_pk_bf16(v0[0], v0[1]); w[bj].y = cvt_pk_bf16(v0[2], v0[3]); w[bj].z = cvt_pk_bf16(v1[0], v1[1]); w[bj].w = cvt_pk_bf16(v1[2], v1[3]); }
                store_lines(Ot + (size_t)((ai * HALF + m * 16) * ldc), L, w[0], w[1]);
                asm volatile("" ::: "memory"); }
    }
};
struct EpiResid16 {
    static constexpr bool PERM = true;
    const bf16_t* base; bf16_t* xo; float* out; int ldc; float* ssqp; int f32out;
    __device__ __forceinline__ static void addx(const u32x4 b, const f32x4 a0, const f32x4 a1, f32x4& x0, f32x4& x1) {
        x0[0] = __builtin_bit_cast(float, b.x << 16) + a0[0]; x0[1] = __builtin_bit_cast(float, b.x & 0xffff0000u) + a0[1]; x0[2] = __builtin_bit_cast(float, b.y << 16) + a0[2]; x0[3] = __builtin_bit_cast(float, b.y & 0xffff0000u) + a0[3];
        x1[0] = __builtin_bit_cast(float, b.z << 16) + a1[0]; x1[1] = __builtin_bit_cast(float, b.z & 0xffff0000u) + a1[1]; x1[2] = __builtin_bit_cast(float, b.w << 16) + a1[2]; x1[3] = __builtin_bit_cast(float, b.w & 0xffff0000u) + a1[3]; }
    __device__ __forceinline__ void operator()(f32x4 (&acc)[2][2][4][2], const Unit& u, int wr, int wc, int fr, int fq) const {
        const size_t tb = (size_t)(u.pm * BM) * ldc + u.pn * BM;
        const bf16_t* bs = base + tb;
        const unsigned lo = (unsigned)((wr * 64 + fr) * ldc + wc * 64 + 8 * fq);
        if (f32out != 0) {
            float* op = out + tb;
#pragma unroll
            for (int ai = 0; ai < 2; ++ai)
#pragma unroll
                for (int m = 0; m < 4; ++m) { const unsigned off = lo + (unsigned)((ai * HALF + m * 16) * ldc);
#pragma unroll
                    for (int bj = 0; bj < 2; ++bj) { const u32x4 b = *(const u32x4*)(bs + off + bj * 32); f32x4 x0, x1; addx(b, acc[ai][bj][m][0], acc[ai][bj][m][1], x0, x1);
                        *(f32x4*)(op + off + bj * 32) = x0; *(f32x4*)(op + off + bj * 32 + 4) = x1; }
                    asm volatile("" ::: "memory"); }
            return;
        }
        bf16_t* xp = xo + tb; const LineOffs L = line_offs(lo, ldc, fr);
#pragma unroll
        for (int aim = 0; aim < 4; ++aim) { const int ai = aim >> 1, mp = aim & 1;
            u32x4 bv[2][2];
#pragma unroll
            for (int mm = 0; mm < 2; ++mm)
#pragma unroll
                for (int bj = 0; bj < 2; ++bj) bv[mm][bj] = *(const u32x4*)(bs + lo + (unsigned)((ai * HALF + (2 * mp + mm) * 16) * ldc) + bj * 32);
#pragma unroll
            for (int mm = 0; mm < 2; ++mm) { const int m = 2 * mp + mm; float s = 0.f; u32x4 wv[2];
#pragma unroll
                for (int bj = 0; bj < 2; ++bj) { f32x4 x0, x1; addx(bv[mm][bj], acc[ai][bj][m][0], acc[ai][bj][m][1], x0, x1);
                    wv[bj].x = cvt_pk_bf16(x0[0], x0[1]); wv[bj].y = cvt_pk_bf16(x0[2], x0[3]); wv[bj].z = cvt_pk_bf16(x1[0], x1[1]); wv[bj].w = cvt_pk_bf16(x1[2], x1[3]);
                    s += ((x0[0] * x0[0] + x0[1] * x0[1]) + (x0[2] * x0[2] + x0[3] * x0[3])) + ((x1[0] * x1[0] + x1[1] * x1[1]) + (x1[2] * x1[2] + x1[3] * x1[3])); }
                store_lines(xp + (size_t)((ai * HALF + m * 16) * ldc), L, wv[0], wv[1]);
                s += __shfl_xor(s, 16); s += __shfl_xor(s, 32); if (fq == 0) ssqp[(size_t)(u.pm * BM + wr * 64 + fr + ai * HALF + m * 16) * 32 + u.pn * 4 + wc] = s; }
            asm volatile("" ::: "memory"); }
    }
};
__device__ __forceinline__ float silu_f(float x) { return x * __builtin_amdgcn_rcpf(1.0f + __builtin_amdgcn_exp2f(-1.4426950408889634f * x)); }
struct EpiGate {
    static constexpr bool PERM = true;
    bf16_t* act; int ldact; float* edge; const float* cw; const float* cb; int dff; PG8_LAS float* halo; const float* rstd; const unsigned* wmaxc;
    __device__ __forceinline__ void operator()(f32x4 (&acc)[2][2][4][2], const Unit& u, int wr, int wc, int fr, int fq) const {
        const int lane = fq * 16 + fr; const int colL = wc * 32 + 8 * fq; const int colG = u.pn * HALF + colL;
        f32x4 csc[2][2];
#pragma unroll
        for (int bj = 0; bj < 2; ++bj)
#pragma unroll
            for (int n = 0; n < 2; ++n) { const u32x4 mb = *(const u32x4*)(wmaxc + bj * dff + colG + 4 * n);
                csc[bj][n] = (f32x4){__builtin_bit_cast(float, mb.x), __builtin_bit_cast(float, mb.y), __builtin_bit_cast(float, mb.z), __builtin_bit_cast(float, mb.w)} * (1.0f / 127.0f); }
#pragma unroll
        for (int ai = 0; ai < 2; ++ai)
#pragma unroll
            for (int m = 0; m < 4; ++m) { const float rs = rstd[u.pm * BM + ai * HALF + wr * 64 + m * 16 + fr];
#pragma unroll
                for (int bj = 0; bj < 2; ++bj) { acc[ai][bj][m][0] *= csc[bj][0] * rs; acc[ai][bj][m][1] *= csc[bj][1] * rs; } }
#pragma unroll
        for (int ai = 0; ai < 2; ++ai) { const int q = 2 * ai + wr;
            if (fr == 0) { *(PG8_LAS f32x4*)(halo + (q * 2 + 0) * 128 + colL) = acc[ai][0][0][0]; *(PG8_LAS f32x4*)(halo + (q * 2 + 0) * 128 + colL + 4) = acc[ai][0][0][1]; }
            if (fr == 15) { *(PG8_LAS f32x4*)(halo + (q * 2 + 1) * 128 + colL) = acc[ai][0][3][0]; *(PG8_LAS f32x4*)(halo + (q * 2 + 1) * 128 + colL + 4) = acc[ai][0][3][1]; } }
        asm volatile("s_waitcnt lgkmcnt(0)" ::: "memory"); __builtin_amdgcn_s_barrier(); asm volatile("" ::: "memory");
        bf16_t* actp = act + (size_t)(u.pm * BM) * ldact + colG; const unsigned rlo = (unsigned)((wr * 64 + fr) * ldact);
#pragma unroll
        for (int ai = 0; ai < 2; ++ai) { const int q = 2 * ai + wr;
            typedef unsigned u32x2 __attribute__((ext_vector_type(2)));
            u32x2 pk[4][2];
#pragma unroll
            for (int n = 0; n < 2; ++n) {
                const f32x4 w0 = *(const f32x4*)(cw + colG + 4 * n), w1 = *(const f32x4*)(cw + dff + colG + 4 * n), w2 = *(const f32x4*)(cw + 2 * dff + colG + 4 * n), bb = *(const f32x4*)(cb + colG + 4 * n);
                f32x4 ht = *(PG8_LAS f32x4*)(halo + ((q > 0 ? q - 1 : 0) * 2 + 1) * 128 + colL + 4 * n), hb = *(PG8_LAS f32x4*)(halo + ((q < 3 ? q + 1 : 3) * 2 + 0) * 128 + colL + 4 * n);
                if (q == 0) ht = ht * 0.f; if (q == 3) hb = hb * 0.f;
                f32x4 pre[4];
#pragma unroll
                for (int j = 0; j < 4; ++j) {
                    float g[4], rr[4], rl[4];
#pragma unroll
                    for (int m = 0; m < 4; ++m) { g[m] = acc[ai][0][m][n][j]; rr[m] = dpp_ror1(g[m]); rl[m] = dpp_ror15(g[m]); }
#pragma unroll
                    for (int m = 0; m < 4; ++m) {
                        const float up = (fr > 0) ? rr[m] : (m > 0 ? rr[m > 0 ? m - 1 : 0] : ht[j]);
                        const float dn = (fr < 15) ? rl[m] : (m < 3 ? rl[m < 3 ? m + 1 : 3] : hb[j]);
                        pre[m][j] = w0[j] * up + w1[j] * g[m] + w2[j] * dn + bb[j];
                    }
                }
                if (q == 0 && fr == 0) { float* e = edge + (size_t)((u.pm * 2 + 0) * 3) * dff + colG + 4 * n;
                    *(f32x4*)(e) = acc[ai][0][0][n]; *(f32x4*)(e + dff) = pre[0]; *(f32x4*)(e + 2 * dff) = acc[ai][1][0][n]; }
                if (q == 3 && fr == 15) { float* e = edge + (size_t)((u.pm * 2 + 1) * 3) * dff + colG + 4 * n;
                    *(f32x4*)(e) = acc[ai][0][3][n]; *(f32x4*)(e + dff) = pre[3]; *(f32x4*)(e + 2 * dff) = acc[ai][1][3][n]; }
#pragma unroll
                for (int m = 0; m < 4; ++m) { const f32x4 v = acc[ai][1][m][n];
                    pk[m][n].x = cvt_pk_bf16(silu_f(pre[m][0]) * v[0], silu_f(pre[m][1]) * v[1]); pk[m][n].y = cvt_pk_bf16(silu_f(pre[m][2]) * v[2], silu_f(pre[m][3]) * v[3]); }
            }
#pragma unroll
            for (int m = 0; m < 4; ++m) { u32x4 w; w.x = pk[m][0].x; w.y = pk[m][0].y; w.z = pk[m][1].x; w.w = pk[m][1].y;
                *(u32x4*)(actp + rlo + (unsigned)((ai * HALF + m * 16) * ldact)) = w; }
        }
    }
};

template <class Epi, class Sched, bool I8 = false>
__device__ __forceinline__ void gemm_phase(PG8_LAS unsigned char* lds, const Gemm g, const Sched& S, const Epi& E) {
    typedef typename AccSel<I8>::T acc_t;
    const int tid = opq(threadIdx.x), wid = __builtin_amdgcn_readfirstlane(tid >> 6), lane = tid & 63, wr = wid >> 2, wc = wid & 3, fr = lane & 15, fq = lane >> 4;
    const int K = g.K, nt = K / BK, lda = g.lda;
    unsigned voffA[2], voffB[2];
#pragma unroll
    for (int i = 0; i < 2; ++i) { int R, C; stage_rc(tid * 16 + i * 8192, R, C); const int Rb = Epi::PERM ? (64 * (R >> 5) + perm32(R & 31)) : R;
        voffA[i] = (unsigned)(R * lda + C) * 2u; voffB[i] = (unsigned)(Rb * K + C) * 2u; }
    const size_t kstep = (size_t)(BK * 2);
    const size_t hstepA = (size_t)HALF * lda * 2, hstepB = (size_t)(Epi::PERM ? 32 : HALF) * K * 2;
    const size_t tstepA = 2 * hstepA, tstepB = (size_t)BM * K * 2;
    const unsigned ldsw = (unsigned)wid * 1024u;
    const int aoff = lds_byte(wr * 64 + fr, fq * 8), boff = lds_byte(wc * 32 + fr, fq * 8);
#define PG8_SA(b, h) (((b) * 2 + (h)) * HTB)
#define PG8_SB(b, h) ((4 + (b) * 2 + (h)) * HTB)
#define PG8_STAGE(bufoff, gbase, voff) do { _Pragma("unroll") for (int _i = 0; _i < 2; ++_i) \
        __builtin_amdgcn_global_load_lds((const unsigned*)((const char*)(gbase) + (voff)[_i]), (PG8_LAS unsigned*)(lds + (bufoff) + ldsw + _i * 8192), 16, 0, 0); } while (0)
#define PG8_LDA(dst, b, h) do { _Pragma("unroll") for (int m = 0; m < 4; ++m) _Pragma("unroll") for (int k = 0; k < 2; ++k) dst[m][k] = *(const PG8_LAS bf16x8*)(lds + PG8_SA(b, h) + aoff + m * 2048 + k * 1024); } while (0)
#define PG8_LDB(dst, b, h) do { _Pragma("unroll") for (int n = 0; n < 2; ++n) _Pragma("unroll") for (int k = 0; k < 2; ++k) dst[n][k] = *(const PG8_LAS bf16x8*)(lds + PG8_SB(b, h) + boff + n * 2048 + k * 1024); } while (0)
#define PG8_MMA(ai, bj, At, Bt) do { __builtin_amdgcn_s_setprio(1); _Pragma("unroll") for (int m = 0; m < 4; ++m) _Pragma("unroll") for (int n = 0; n < 2; ++n) _Pragma("unroll") for (int k = 0; k < 2; ++k) { \
        if constexpr (I8) acc[ai][bj][m][n] = __builtin_amdgcn_mfma_i32_16x16x64_i8(__builtin_bit_cast(i32x4, Bt[n][k]), __builtin_bit_cast(i32x4, At[m][k]), acc[ai][bj][m][n], 0, 0, 0); \
        else acc[ai][bj][m][n] = __builtin_amdgcn_mfma_f32_16x16x32_bf16(Bt[n][k], At[m][k], acc[ai][bj][m][n], 0, 0, 0); } __builtin_amdgcn_s_setprio(0); } while (0)
#define PG8_WAIT_V(n) asm volatile("s_waitcnt vmcnt(" #n ")" ::: "memory")
#define PG8_WAIT_L(n) asm volatile("s_waitcnt lgkmcnt(" #n ")" ::: "memory")
#define PG8_BAR __builtin_amdgcn_s_barrier()
#define PG8_SCHED __builtin_amdgcn_sched_barrier(0)
    Unit cur, nxt; int ui = 0;
    if (!S.next(0, cur)) return;
    acc_t acc[2][2][4][2];
{ float zf = 0.f; asm volatile("" : "+v"(zf));
    #pragma unroll
    for (int a = 0; a < 2; ++a)
#pragma unroll
        for (int b = 0; b < 2; ++b)
#pragma unroll
            for (int m = 0; m < 4; ++m)
#pragma unroll
                for (int n = 0; n < 2; ++n) acc[a][b][m][n] = __builtin_bit_cast(acc_t, (f32x4){zf, zf, zf, zf}); }
    bf16x8 At[4][2], B0[2][2], B1[2][2];
    const char* cA = (const char*)g.A + (size_t)cur.pm * tstepA; const char* cB = (const char*)g.Bt + (size_t)cur.pn * tstepB;
    S.a_ready(cur);
    PG8_STAGE(PG8_SB(0, 0), cB, voffB); PG8_STAGE(PG8_SB(0, 1), cB + hstepB, voffB); PG8_STAGE(PG8_SA(0, 0), cA, voffA); PG8_STAGE(PG8_SA(0, 1), cA + hstepA, voffA);
    if (wr == 1) PG8_BAR;
    PG8_WAIT_V(2); PG8_BAR;
    PG8_STAGE(PG8_SB(1, 0), cB + kstep, voffB); PG8_STAGE(PG8_SA(1, 0), cA + kstep, voffA); PG8_STAGE(PG8_SB(1, 1), cB + hstepB + kstep, voffB);
    PG8_WAIT_V(6); PG8_BAR;
    for (;;) {
        const bool has_next = S.next(ui + 1, nxt);
        const char* nA = has_next ? (const char*)g.A + (size_t)nxt.pm * tstepA : cA; const char* nB = has_next ? (const char*)g.Bt + (size_t)nxt.pn * tstepB : cB;
#pragma unroll 1
        for (int t = 0; t < nt; t += 2) {
            const bool last = (t == nt - 2);
            const char* a1 = cA + (size_t)(t + 1) * kstep;
            const char* a2 = last ? nA : cA + (size_t)(t + 2) * kstep; const char* b2 = last ? nB : cB + (size_t)(t + 2) * kstep;
            const char* a3 = a2 + kstep; const char* b3 = b2 + kstep;
            if (last && has_next) S.a_ready(nxt);
            PG8_LDB(B0, 0, 0); PG8_LDB(B1, 0, 1); PG8_SCHED; PG8_LDA(At, 0, 0); PG8_STAGE(PG8_SA(1, 1), a1 + hstepA, voffA);
            PG8_WAIT_V(8); PG8_WAIT_L(0); PG8_BAR; PG8_MMA(0, 0, At, B0); PG8_MMA(0, 1, At, B1); PG8_BAR; PG8_SCHED;
            PG8_LDA(At, 0, 1); PG8_STAGE(PG8_SB(0, 0), b2, voffB); PG8_STAGE(PG8_SB(0, 1), b2 + hstepB, voffB); PG8_STAGE(PG8_SA(0, 0), a2, voffA);
            PG8_WAIT_V(8); PG8_WAIT_L(0); PG8_BAR; PG8_MMA(1, 0, At, B0); PG8_MMA(1, 1, At, B1); PG8_BAR; PG8_SCHED;
            PG8_LDB(B0, 1, 0); PG8_LDB(B1, 1, 1); PG8_SCHED; PG8_LDA(At, 1, 0); PG8_STAGE(PG8_SA(0, 1), a2 + hstepA, voffA);
            PG8_WAIT_V(8); PG8_WAIT_L(0); PG8_BAR; PG8_MMA(0, 0, At, B0); PG8_MMA(0, 1, At, B1); PG8_BAR; PG8_SCHED;
            PG8_LDA(At, 1, 1); PG8_STAGE(PG8_SB(1, 0), b3, voffB); PG8_STAGE(PG8_SB(1, 1), b3 + hstepB, voffB); PG8_STAGE(PG8_SA(1, 0), a3, voffA);
            PG8_WAIT_V(8); PG8_WAIT_L(0); PG8_BAR; PG8_MMA(1, 0, At, B0); PG8_MMA(1, 1, At, B1); PG8_BAR; PG8_SCHED;
        }
        if (wr == 0) PG8_BAR;
        if constexpr (I8) { f32x4 accf[2][2][4][2];
#pragma unroll
            for (int a = 0; a < 2; ++a)
#pragma unroll
                for (int b = 0; b < 2; ++b)
#pragma unroll
                    for (int m = 0; m < 4; ++m)
#pragma unroll
                        for (int n = 0; n < 2; ++n) accf[a][b][m][n] = __builtin_convertvector(acc[a][b][m][n], f32x4);
            E(accf, cur, wr, wc, fr, fq); }
        else E(acc, cur, wr, wc, fr, fq);
        S.done(cur);
        if (!has_next) break;
{ float zf = 0.f; asm volatile("" : "+v"(zf));
        #pragma unroll
        for (int a = 0; a < 2; ++a)
#pragma unroll
            for (int b = 0; b < 2; ++b)
#pragma unroll
                for (int m = 0; m < 4; ++m)
#pragma unroll
                    for (int n = 0; n < 2; ++n) acc[a][b][m][n] = __builtin_bit_cast(acc_t, (f32x4){zf, zf, zf, zf}); }
        cur = nxt; cA = nA; cB = nB; ++ui;
        if (wr == 1) PG8_BAR;
    }
    PG8_WAIT_V(0);
    PG8_BAR;
#undef PG8_SA
#undef PG8_SB
#undef PG8_STAGE
#undef PG8_LDA
#undef PG8_LDB
#undef PG8_MMA
#undef PG8_WAIT_V
#undef PG8_WAIT_L
#undef PG8_BAR
#undef PG8_SCHED
}
}
namespace at {
using bf16 = unsigned short;
using bf16x8 = __attribute__((ext_vector_type(8))) short;
using s16x4  = __attribute__((ext_vector_type(4))) short;
using f32x16 = __attribute__((ext_vector_type(16))) float;
using u32x4  = __attribute__((ext_vector_type(4))) unsigned;
constexpr int DQK = 192, DV = 128, KVBLK = 64, NW = 8, QBLK = 32;
constexpr float SCALE = 0.07216878364870322f;
constexpr float THR = 8.f;
constexpr int LDQ = 1536, LDK = 2560, LDO = 2048;
constexpr int SHM_V = KVBLK * DV * 2, SHM_K = 12 * 2080;
constexpr int QR_OFF = 2 * SHM_V + 2 * SHM_K + NW * 64 * 4;
constexpr int SHM_ATTN = QR_OFF + NW * 4096;
#define SBAR() __builtin_amdgcn_sched_barrier(0)
constexpr int KPL = 2080;
__host__ __device__ __forceinline__ int k_st(int row, int c) { return (c >> 1) * KPL + row * 32 + (((c & 1) ^ ((row >> 3) & 1)) << 4); }
__host__ __device__ __forceinline__ int k_rd_base(int r32, int hi) { return r32 * 32 + ((hi ^ ((r32 >> 3) & 1)) << 4); }
__device__ __forceinline__ int crow(int r, int hi) { return (r & 3) + 8 * (r >> 2) + 4 * hi; }
__device__ __forceinline__ unsigned cvtpk(float lo, float hi) { unsigned r; asm volatile("v_cvt_pk_bf16_f32 %0, %1, %2" : "=v"(r) : "v"(lo), "v"(hi)); return r; }

__device__ __forceinline__ void partialSM(f32x16& p0, f32x16& p1, float& m_reg, float& mn, float& alpha) {
  constexpr float C = 1.0f;
  float pmax = p0[0];
#pragma unroll
  for (int r = 1; r < 16; ++r) pmax = fmaxf(pmax, p0[r]);
#pragma unroll
  for (int r = 0; r < 16; ++r) pmax = fmaxf(pmax, p1[r]);
  { auto rr = __builtin_amdgcn_permlane32_swap(__float_as_uint(pmax), __float_as_uint(pmax), false, false);
    pmax = fmaxf(__uint_as_float(rr[0]), __uint_as_float(rr[1])); }
  if (__builtin_expect(__all(pmax - m_reg <= THR * 1.4426950408889634f), 1)) { mn = m_reg; alpha = 1.f; }
  else { mn = fmaxf(m_reg, pmax); alpha = __builtin_amdgcn_exp2f((m_reg - mn) * C); m_reg = mn; }
  float mnC = -mn * C;
#pragma unroll
  for (int r = 0; r < 16; ++r) p0[r] = fmaf(p0[r], C, mnC);
#pragma unroll
  for (int r = 0; r < 16; ++r) p1[r] = fmaf(p1[r], C, mnC);
#pragma unroll
  for (int r = 0; r < 16; ++r) p0[r] = __builtin_amdgcn_exp2f(p0[r]);
}
__device__ __forceinline__ void partialSM_fast(f32x16& p0, f32x16& p1, float negMC) {
  (void)negMC; (void)p1;
#pragma unroll
  for (int r = 0; r < 16; ++r) p0[r] = __builtin_amdgcn_exp2f(p0[r]);
}
__device__ __forceinline__ void finishSM(f32x16& p0, f32x16& p1, float alpha, float& l_reg, bf16x8& pa0, bf16x8& pa1, bf16x8& pa2, bf16x8& pa3) {
#pragma unroll
  for (int r = 0; r < 16; ++r) p1[r] = __builtin_amdgcn_exp2f(p1[r]);
  float ps = 0;
#pragma unroll
  for (int r = 0; r < 16; ++r) ps += p0[r];
#pragma unroll
  for (int r = 0; r < 16; ++r) ps += p1[r];
  { auto rr = __builtin_amdgcn_permlane32_swap(__float_as_uint(ps), __float_as_uint(ps), false, false);
    ps = __uint_as_float(rr[0]) + __uint_as_float(rr[1]); }
  l_reg = l_reg * alpha + ps;
#define PK4(P, BASE, OUT) do { unsigned a0 = cvtpk(P[BASE + 0], P[BASE + 1]), a1 = cvtpk(P[BASE + 2], P[BASE + 3]);   \
    unsigned b0 = cvtpk(P[BASE + 4], P[BASE + 5]), b1 = cvtpk(P[BASE + 6], P[BASE + 7]);                              \
    auto r0 = __builtin_amdgcn_permlane32_swap(a0, b0, false, false); auto r1 = __builtin_amdgcn_permlane32_swap(a1, b1, false, false); \
    u32x4 w = {r0[0], r1[0], r0[1], r1[1]}; OUT = *reinterpret_cast<bf16x8*>(&w); } while (0)
  PK4(p0, 0, pa0); PK4(p0, 8, pa1); PK4(p1, 0, pa2); PK4(p1, 8, pa3);
#undef PK4
}
template <int OFF> __device__ __forceinline__ bf16x8 k_read(int kb) {
  bf16x8 r; asm volatile("ds_read_b128 %0, %1 offset:%2" : "=v"(r) : "v"(kb), "i"(OFF) : "memory"); return r;
}
__device__ __forceinline__ void qkt(f32x16& p0, f32x16& p1, int kb, const bf16x8* qr, int qb) {
  p0 = f32x16{}; p1 = f32x16{};
#define QK1(d0) { const bf16x8 b0 = *(const __attribute__((address_space(3))) bf16x8*)(kb + d0 * KPL), b1 = *(const __attribute__((address_space(3))) bf16x8*)(kb + d0 * KPL + 1024); \
    p0 = __builtin_amdgcn_mfma_f32_32x32x16_bf16(b0, qr[d0], p0, 0, 0, 0); p1 = __builtin_amdgcn_mfma_f32_32x32x16_bf16(b1, qr[d0], p1, 0, 0, 0); }
#define QK2(d0) { const bf16x8 b0 = *(const __attribute__((address_space(3))) bf16x8*)(kb + d0 * KPL), b1 = *(const __attribute__((address_space(3))) bf16x8*)(kb + d0 * KPL + 1024); \
    const bf16x8 qf = *(const __attribute__((address_space(3))) bf16x8*)(qb + (d0 - 8) * 1024); \
    p0 = __builtin_amdgcn_mfma_f32_32x32x16_bf16(b0, qf, p0, 0, 0, 0); p1 = __builtin_amdgcn_mfma_f32_32x32x16_bf16(b1, qf, p1, 0, 0, 0); }
  QK1(0) QK1(1) QK1(2) QK1(3) QK1(4) QK1(5) QK1(6) QK1(7) QK2(8) QK2(9) QK2(10) QK2(11)
#undef QK1
#undef QK2
}
__host__ __device__ __forceinline__ int v_st(int k, int c) { const int kk = (k & ~0xC) | ((k & 4) << 1) | ((k & 8) >> 1); return ((kk >> 3) * 4 + (c >> 5)) * 512 + ((kk & 7) * 32 + (c & 31)) * 2; }
__device__ __forceinline__ int v_rd_base(int lane) { return ((lane & 3) << 3) | (((lane >> 2) & 3) << 6) | (((lane >> 4) & 1) << 5) | (((lane >> 5) & 1) << 8); }
constexpr int v_rd_off(int d0, int ks, int half) { return d0 * 512 + ks * 4096 + half * 2048; }
template <int OFF> __device__ __forceinline__ s16x4 tr_read(int vb) {
  s16x4 r; asm volatile("ds_read_b64_tr_b16 %0, %1 offset:%2" : "=&v"(r) : "v"(vb), "i"(OFF) : "memory"); return r;
}
template <int D0> __device__ __forceinline__ void pv_one(f32x16& od, int vb, bf16x8 pa0, bf16x8 pa1, bf16x8 pa2, bf16x8 pa3) {
  const s16x4 l0 = tr_read<v_rd_off(D0, 0, 0)>(vb), h0 = tr_read<v_rd_off(D0, 0, 1)>(vb), l1 = tr_read<v_rd_off(D0, 1, 0)>(vb), h1 = tr_read<v_rd_off(D0, 1, 1)>(vb);
  const s16x4 l2 = tr_read<v_rd_off(D0, 2, 0)>(vb), h2 = tr_read<v_rd_off(D0, 2, 1)>(vb), l3 = tr_read<v_rd_off(D0, 3, 0)>(vb), h3 = tr_read<v_rd_off(D0, 3, 1)>(vb);
  asm volatile("s_waitcnt lgkmcnt(0)" ::: "memory"); SBAR();
#define PK(L, H) (bf16x8){L[0], L[1], L[2], L[3], H[0], H[1], H[2], H[3]}
  od = __builtin_amdgcn_mfma_f32_32x32x16_bf16(pa0, PK(l0, h0), od, 0, 0, 0);
  od = __builtin_amdgcn_mfma_f32_32x32x16_bf16(pa1, PK(l1, h1), od, 0, 0, 0);
  od = __builtin_amdgcn_mfma_f32_32x32x16_bf16(pa2, PK(l2, h2), od, 0, 0, 0);
  od = __builtin_amdgcn_mfma_f32_32x32x16_bf16(pa3, PK(l3, h3), od, 0, 0, 0);
#undef PK
}
__device__ __forceinline__ void pv_d0(f32x16* o, int vb, bf16x8 pa0, bf16x8 pa1, bf16x8 pa2, bf16x8 pa3) {
  pv_one<0>(o[0], vb, pa0, pa1, pa2, pa3); pv_one<1>(o[1], vb, pa0, pa1, pa2, pa3); pv_one<2>(o[2], vb, pa0, pa1, pa2, pa3); pv_one<3>(o[3], vb, pa0, pa1, pa2, pa3);
}

template <bool FAST>
__device__ __forceinline__ void attn_unit(const float negMC, const bf16* __restrict__ Qb, const bf16* __restrict__ Kh, const bf16* __restrict__ Vh, bf16* __restrict__ Ob, int seq, char* lds) {
  const int tid = opq(threadIdx.x), wid = tid >> 6, lane = tid & 63, r32 = lane & 31, hi = lane >> 5;
  char* V_lds = lds; char* K_lds = lds + 2 * SHM_V;
  float* ws = (float*)(lds + 2 * SHM_V + 2 * SHM_K) + wid * 64; float* li_l = ws; float* al_l = ws + 32;
  float m_reg = -1e30f, l_reg = 0; f32x16 o[4] = {}; bf16x8 qr[8];
  const bf16* Qw = Qb + (unsigned)((wid * QBLK + r32) * LDQ + hi * 8);
#pragma unroll
  for (int d0 = 0; d0 < 8; ++d0) qr[d0] = *reinterpret_cast<const bf16x8*>(Qw + d0 * 16);
  const int qb0 = (int)(uintptr_t)lds + QR_OFF + wid * 4096 + k_rd_base(r32, hi);
#pragma unroll
  for (int d0 = 8; d0 < 12; ++d0) *(__attribute__((address_space(3))) bf16x8*)(qb0 + (d0 - 8) * 1024) = *reinterpret_cast<const bf16x8*>(Qw + d0 * 16);
  const int sr = tid >> 4, sc = (tid & 15) * 8, vst0 = v_st(sr, sc), vst1 = v_st(32 + sr, sc);
  unsigned koff[3]; int kst[3];
#pragma unroll
  for (int i = 0; i < 3; ++i) { const int q = tid + 512 * i; koff[i] = (unsigned)((q / 24) * LDK + (q % 24) * 8); kst[i] = k_st(q / 24, q % 24); }
  const unsigned voff0 = (unsigned)(sr * LDK + sc), voff1 = (unsigned)((32 + sr) * LDK + sc);
  const int vb0 = (int)(uintptr_t)V_lds + v_rd_base(lane); const int kb0 = (int)(uintptr_t)K_lds + k_rd_base(r32, hi);
  struct { bf16x8 vs0, vs1, ks0, ks1, ks2; } sr_[1];
#define SLOAD(i, k0) do { const bf16* vt = Vh + (size_t)(k0) * LDK; const bf16* kt = Kh + (size_t)(k0) * LDK; \
    sr_[i].vs0 = *(const bf16x8*)(vt + voff0); sr_[i].vs1 = *(const bf16x8*)(vt + voff1); \
    sr_[i].ks0 = *(const bf16x8*)(kt + koff[0]); sr_[i].ks1 = *(const bf16x8*)(kt + koff[1]); sr_[i].ks2 = *(const bf16x8*)(kt + koff[2]); } while (0)
#define SWRITE(b, i) do { *(bf16x8*)(V_lds + (b) * SHM_V + vst0) = sr_[i].vs0; *(bf16x8*)(V_lds + (b) * SHM_V + vst1) = sr_[i].vs1; \
    *(bf16x8*)(K_lds + (b) * SHM_K + kst[0]) = sr_[i].ks0; *(bf16x8*)(K_lds + (b) * SHM_K + kst[1]) = sr_[i].ks1; *(bf16x8*)(K_lds + (b) * SHM_K + kst[2]) = sr_[i].ks2; } while (0)
#define SWAIT() do { if constexpr (SDEPTH == 2) asm volatile("s_waitcnt vmcnt(5)" ::: "memory"); else asm volatile("s_waitcnt vmcnt(0)" ::: "memory"); } while (0)
#define RESC(a) do { if (__any((a) < 1.f)) { if (hi == 0) al_l[r32] = (a); asm volatile("s_waitcnt lgkmcnt(0)" ::: "memory"); \
    _Pragma("unroll") for (int d = 0; d < 4; ++d) _Pragma("unroll") for (int r = 0; r < 16; ++r) o[d][r] *= al_l[crow(r, hi)]; } } while (0)
  f32x16 pA0, pA1, pB0, pB1; float mnA, mnB, alA, alB; bf16x8 pa0, pa1, pa2, pa3; const int NT = seq / KVBLK;
#define PSM(P0, P1, MN, AL) do { if constexpr (FAST) { partialSM_fast(P0, P1, negMC); AL = 1.f; } else partialSM(P0, P1, m_reg, MN, AL); } while (0)
#define RSC(AL) do { if constexpr (!FAST) RESC(AL); } while (0)
  SLOAD(0, 0); asm volatile("s_waitcnt vmcnt(0)" ::: "memory"); SWRITE(0, 0); __syncthreads();
  qkt(pA0, pA1, kb0, qr, qb0); PSM(pA0, pA1, mnA, alA);
  SLOAD(0, KVBLK);
  asm volatile("s_waitcnt vmcnt(0)" ::: "memory"); SWRITE(1, 0); __syncthreads();
  for (int j = 1; j + 1 < NT; j += 2) {
    SBAR(); qkt(pB0, pB1, kb0 + SHM_K, qr, qb0);
    finishSM(pA0, pA1, alA, l_reg, pa0, pa1, pa2, pa3); SBAR();
    SLOAD(0, (j + 1) * KVBLK); SBAR();
    pv_d0(o, vb0, pa0, pa1, pa2, pa3); PSM(pB0, pB1, mnB, alB);
    __syncthreads(); asm volatile("s_waitcnt vmcnt(0)" ::: "memory"); SWRITE(0, 0);
    RSC(alB); __syncthreads();
    SBAR(); qkt(pA0, pA1, kb0, qr, qb0);
    finishSM(pB0, pB1, alB, l_reg, pa0, pa1, pa2, pa3); SBAR();
    SLOAD(0, (j + 2) * KVBLK); SBAR();
    pv_d0(o, vb0 + (int)SHM_V, pa0, pa1, pa2, pa3); PSM(pA0, pA1, mnA, alA);
    __syncthreads(); asm volatile("s_waitcnt vmcnt(0)" ::: "memory"); SWRITE(1, 0);
    RSC(alA); __syncthreads();
  }
  SBAR(); qkt(pB0, pB1, kb0 + SHM_K, qr, qb0);
  finishSM(pA0, pA1, alA, l_reg, pa0, pa1, pa2, pa3); SBAR();
  pv_d0(o, vb0, pa0, pa1, pa2, pa3); PSM(pB0, pB1, mnB, alB);
  __syncthreads(); RSC(alB);
  finishSM(pB0, pB1, alB, l_reg, pa0, pa1, pa2, pa3); SBAR();
  pv_d0(o, vb0 + (int)SHM_V, pa0, pa1, pa2, pa3);
  if (hi == 0) li_l[r32] = l_reg; asm volatile("s_waitcnt lgkmcnt(0)" ::: "memory");
  bf16* Ow = Ob + (unsigned)(wid * QBLK * LDO + r32);
#pragma unroll
  for (int r = 0; r < 16; ++r) { const int orow = crow(r, hi); const float rl = __builtin_amdgcn_rcpf(li_l[orow]);
#pragma unroll
    for (int d0 = 0; d0 < 4; ++d0) { const unsigned w = cvtpk(o[d0][r] * rl, 0.f); Ow[(unsigned)(orow * LDO + d0 * 32)] = (bf16)(w & 0xffffu); } }
  __syncthreads();
#undef SLOAD
#undef SWRITE
#undef SWAIT
#undef RESC
#undef PSM
#undef RSC
}
}
namespace hy {
#define HY_LAS __attribute__((address_space(3)))
typedef unsigned short bf16;
typedef short bf16x8 __attribute__((ext_vector_type(8)));
typedef float f32x16 __attribute__((ext_vector_type(16)));
typedef unsigned u32x2 __attribute__((ext_vector_type(2)));
typedef unsigned u32x4 __attribute__((ext_vector_type(4)));
constexpr int L = 2048, NB = 24, CH = 512;
constexpr int RFS = 4112;
constexpr int ZROW = 4112;
constexpr int ZL_BYTES = NB * ZROW;
constexpr int RCS = 8256;
constexpr int RC_OFF = ZL_BYTES;
constexpr int HY_LDS_BYTES = RC_OFF + 4 * RCS;
__device__ __forceinline__ unsigned cvtpk(float lo, float hi) { unsigned r; asm volatile("v_cvt_pk_bf16_f32 %0, %1, %2" : "=v"(r) : "v"(lo), "v"(hi)); return r; }
__host__ __device__ __forceinline__ int frag_base(int tw, int r, int h) { const int a = (4 - (r & 3)) & 3; return RC_OFF + a * RCS + 2 * (2048 - tw - r + 8 * h - a); }
__host__ __device__ __forceinline__ int zfrag_base(int r, int h) { return (r < NB ? r : NB - 1) * ZROW + 16 * h; }

__device__ __forceinline__ bf16x8 ld_frag(HY_LAS unsigned char* lds, int off) {
    const u32x2 lo = *(const HY_LAS u32x2*)(lds + off), hi = *(const HY_LAS u32x2*)(lds + off + 8);
    u32x4 w = {lo.x, lo.y, hi.x, hi.y}; return *reinterpret_cast<bf16x8*>(&w);
}
__device__ __forceinline__ bf16x8 ld_b128(HY_LAS unsigned char* lds, int off) { return *(const HY_LAS bf16x8*)(lds + off); }

__device__ __forceinline__ void conv_unit(HY_LAS unsigned char* lds, const bf16* __restrict__ ZT, const bf16* __restrict__ RF, bf16* __restrict__ YC, int c, int half) {
    const int tid = opq(threadIdx.x), wid = tid >> 6, lane = tid & 63, r = lane & 31, h = lane >> 5;
    { const u32x4* src = (const u32x4*)(ZT + (size_t)c * NB * L);
#pragma unroll
      for (int i = 0; i < 12; ++i) { const int q = tid + 512 * i; const u32x4 v = src[q]; *(HY_LAS u32x4*)(lds + (q >> 8) * ZROW + (q & 255) * 16) = v; } }
    { const bf16* rf = RF + (size_t)c * RFS;
      for (int ch = tid; ch < RFS / 8; ch += 512) {
          const u32x4 v = *(const u32x4*)(rf + ch * 8); const unsigned w[4] = {v.x, v.y, v.z, v.w};
#pragma unroll
          for (int j = 0; j < 8; ++j) { const unsigned short e = (unsigned short)((w[j >> 1] >> ((j & 1) * 16)) & 0xffffu); const int idx = ch * 8 + j;
#pragma unroll
              for (int a = 0; a < 4; ++a) if (idx - a >= 0) *(HY_LAS unsigned short*)(lds + RC_OFF + a * RCS + 2 * (idx - a)) = e; } } }
    __syncthreads();
    const int tw = half * 1024 + wid * 128;
    const int fb = frag_base(tw, r, h), zb = zfrag_base(r, h);
    f32x16 acc[4] = {};
    bf16x8 S0[2], S1[2], S2[2], S3[2], Bc[2], Bn[2];
#define HY_LDG(S, d) do { S[0] = ld_frag(lds, fb + 64 * (d)); S[1] = ld_frag(lds, fb + 64 * (d) + 32); } while (0)
#define HY_LDB(Bx, n) do { Bx[0] = ld_b128(lds, zb + 64 * (n)); Bx[1] = ld_b128(lds, zb + 64 * (n) + 32); } while (0)
#define HY_MM(i, S, Bx) do { acc[i] = __builtin_amdgcn_mfma_f32_32x32x16_bf16(S[0], Bx[0], acc[i], 0, 0, 0); acc[i] = __builtin_amdgcn_mfma_f32_32x32x16_bf16(S[1], Bx[1], acc[i], 0, 0, 0); } while (0)
#define HY_ITER(n, Sa, Sb, Sc, Sd, Bcur, Bnext) do { HY_LDG(Sa, (n)); if ((n) + 1 < 64) HY_LDB(Bnext, (n) + 1); \
        HY_MM(1, Sb, Bcur); HY_MM(2, Sc, Bcur); HY_MM(3, Sd, Bcur); HY_MM(0, Sa, Bcur); } while (0)
    HY_LDG(S3, -1); HY_LDG(S2, -2); HY_LDG(S1, -3); HY_LDB(Bc, 0);
    for (int n = 0; n < 64; n += 4) {
        HY_ITER(n, S0, S3, S2, S1, Bc, Bn);
        HY_ITER(n + 1, S1, S0, S3, S2, Bn, Bc);
        HY_ITER(n + 2, S2, S1, S0, S3, Bc, Bn);
        HY_ITER(n + 3, S3, S2, S1, S0, Bn, Bc);
    }
#undef HY_LDG
#undef HY_LDB
#undef HY_MM
#undef HY_ITER
    if (r < NB) { bf16* yp = YC + ((size_t)c * NB + r) * L + tw + 4 * h;
#pragma unroll
        for (int i = 0; i < 4; ++i)
#pragma unroll
            for (int q4 = 0; q4 < 4; ++q4) { u32x2 w; w.x = cvtpk(acc[i][4 * q4 + 0], acc[i][4 * q4 + 1]); w.y = cvtpk(acc[i][4 * q4 + 2], acc[i][4 * q4 + 3]);
                *(u32x2*)(yp + 32 * i + 8 * q4) = w; } }
    __syncthreads();
}
}
constexpr int NWAVES = 8;
#ifndef MK_ONE_LAUNCH
#define MK_ONE_LAUNCH 1
#endif
constexpr int DM = 2048, NSEQ = 24, SEQ = 2048, M = NSEQ * SEQ, MP = 8 * SEQ;
constexpr int DEPTH = 4;
constexpr int DIN = 2880, DINP = 3072;
constexpr int O_CQ = 512, O_CKV = 1024, O_KPE = 1280, O_HY = 1344;
constexpr int NH = 8, NQ = 1536, NKVP = 2560, KVHS = 320;
constexpr int DFF = 5632, NUP = 11264, HYC = 512;
constexpr float EPS = 1e-6f;
constexpr int NPH = 11;
constexpr size_t WS_CTL = 0, CTL_BYTES = 1u << 20;
constexpr size_t SZ_BTIN = (size_t)DINP * DM * 2, SZ_BTUQ = (size_t)NQ * 512 * 2, SZ_BTKV = (size_t)NKVP * 256 * 2, SZ_BTOUT = (size_t)DM * DM * 2, SZ_BTUP = (size_t)NUP * DM * 2, SZ_BTDN = (size_t)DM * DFF * 2;
constexpr size_t WS_BTIN = WS_CTL + CTL_BYTES, WS_BTUQ = WS_BTIN + SZ_BTIN, WS_BTKV = WS_BTUQ + SZ_BTUQ, WS_BTOUT = WS_BTKV + SZ_BTKV, WS_BTUP = WS_BTOUT + SZ_BTOUT, WS_BTDN = WS_BTUP + SZ_BTUP;
constexpr size_t WS_RF = WS_BTDN + SZ_BTDN, SZ_RF = (size_t)HYC * hy::RFS * 2;
constexpr size_t WS_H = WS_RF + SZ_RF, SZ_H = (size_t)M * DM * 2;
constexpr size_t WS_PROJ = WS_H + SZ_H, SZ_PROJ = (size_t)M * DINP * 2;
constexpr size_t WS_Q = WS_PROJ + SZ_PROJ, SZ_Q = (size_t)M * NQ * 2;
constexpr size_t WS_KV = WS_Q + SZ_Q, SZ_KV = (size_t)M * NKVP * 2;
constexpr size_t WS_ZT = WS_KV + SZ_KV, SZ_ZT = (size_t)HYC * NSEQ * SEQ * 2;
constexpr size_t WS_X0 = WS_ZT + SZ_ZT, WS_YC = WS_X0 + SZ_ZT;
constexpr size_t WS_EDGE = WS_YC + SZ_ZT, SZ_EDGE = (size_t)(M / 256) * 2 * 3 * DFF * 4;
constexpr size_t WS_ROPE = WS_EDGE + SZ_EDGE, SZ_ROPE = (size_t)SEQ * 64 * 4;
constexpr size_t WS_SSQP = WS_ROPE + SZ_ROPE, SZ_SSQP = (size_t)M * 32 * 4;
constexpr size_t WS_RSTD = WS_SSQP + SZ_SSQP, SZ_RSTD = (size_t)M * 4;
constexpr size_t WS_XQ = WS_RSTD + SZ_RSTD, SZ_XQ = (size_t)M * DM;
constexpr size_t WS_END = WS_XQ + SZ_XQ;
constexpr size_t WS_ACT = WS_PROJ;
static_assert((size_t)M * DFF * 2 <= SZ_PROJ + SZ_Q + SZ_KV, "ACT overlay");
constexpr size_t WS_XB2 = WS_ACT + (size_t)M * DFF * 2;
static_assert(WS_XB2 + (size_t)M * DM * 2 <= WS_EDGE && WS_XB2 % 256 == 0, "XB2 overlay");
static_assert(WS_BTIN % 256 == 0 && WS_RF % 256 == 0 && WS_H % 256 == 0 && WS_PROJ % 256 == 0 && WS_Q % 256 == 0 && WS_KV % 256 == 0 && WS_ZT % 256 == 0 && WS_EDGE % 256 == 0, "alignment");
constexpr int CW_WMAXC = 65536;
constexpr int CW_WMAX = 1024;
constexpr int CW_BAR = 4096;
constexpr int RING_BYTES = 135168;
constexpr int HALO_OFF = RING_BYTES, HALO_BYTES = 4096;
constexpr int MISC_OFF = HALO_OFF + HALO_BYTES;
constexpr int LDS_BYTES = 147456;
static_assert(hy::HY_LDS_BYTES <= RING_BYTES && at::SHM_ATTN <= RING_BYTES && MISC_OFF + 256 <= LDS_BYTES, "LDS map");

#define GAS __attribute__((address_space(1)))
#define LAS __attribute__((address_space(3)))
typedef unsigned short bf16;
typedef unsigned v4u __attribute__((ext_vector_type(4)));
typedef unsigned v2u __attribute__((ext_vector_type(2)));
typedef float f32x4 __attribute__((ext_vector_type(4)));
#define LDS_WAIT() asm volatile("s_waitcnt lgkmcnt(0)" ::: "memory")
__device__ __forceinline__ unsigned f2bf(float f) { unsigned u = __builtin_bit_cast(unsigned, f); return (u + 0x7fffu + ((u >> 16) & 1u)) >> 16; }
__device__ __forceinline__ unsigned pk2(float lo, float hi) { return f2bf(lo) | (f2bf(hi) << 16); }
__device__ __forceinline__ float bf2f(unsigned short b) { return __builtin_bit_cast(float, (unsigned)b << 16); }
__device__ __forceinline__ float bflo(unsigned w) { return __builtin_bit_cast(float, w << 16); }
__device__ __forceinline__ float bfhi(unsigned w) { return __builtin_bit_cast(float, w & 0xffff0000u); }
__device__ __forceinline__ float wave_sum(float v) {
#pragma unroll
    for (int o = 1; o < 64; o <<= 1) v += __shfl_xor(v, o);
    return v;
}

#define XB_TMO      128
#define XB_XCNT(j)  (256  + 64 * (j))
#define XB_XSUB(j)  (1280 + 64 * (j))
#define XB_XGEN(j)  (2304 + 64 * (j))
#define XB_TOP      3328
#define XB_TOPGEN   3392
#define XCD_BAR_WORDS 3456
#define XB_SPIN_CAP (1u << 18)
__device__ __forceinline__ unsigned xb_ld(unsigned* p)              { return __hip_atomic_load(p, __ATOMIC_RELAXED, __HIP_MEMORY_SCOPE_AGENT); }
__device__ __forceinline__ unsigned xb_add(unsigned* p, unsigned v) { return __hip_atomic_fetch_add(p, v, __ATOMIC_RELAXED, __HIP_MEMORY_SCOPE_AGENT); }
__device__ __forceinline__ unsigned xb_xcc_id() { return (unsigned)__builtin_amdgcn_s_getreg((3 << 11) | 20) & 0xFu; }
#define XB_SPIN(cond, bar) do { unsigned _sp = 0; while (cond) { __builtin_amdgcn_s_sleep(1); \
    if ((++_sp & 255u) == 0u) { if (xb_ld(&(bar)[XB_TMO])) break; if (_sp > XB_SPIN_CAP) { atomicAdd(&(bar)[XB_TMO], 1u); break; } } } } while (0)
struct XcdBarrier { unsigned* bar; unsigned x; volatile LAS unsigned* st; };
__device__ __forceinline__ XcdBarrier xcd_barrier_post(unsigned* bar, volatile LAS unsigned* st) {
    XcdBarrier b; b.bar = bar; b.x = xb_xcc_id(); b.st = st;
    if (threadIdx.x == 0) (void)xb_add(&bar[XB_XCNT(b.x)], 1u);
    return b;
}
__device__ __forceinline__ void xcd_barrier_complete(unsigned* bar, unsigned x, unsigned& nloc, unsigned& nx) {
    const unsigned G = gridDim.x * gridDim.y * gridDim.z;
    unsigned sum, cnt, mine, sp = 0u;
    for (;;) {
        sum = 0u; cnt = 0u; mine = 0u;
#pragma unroll
        for (unsigned j = 0; j < 16; ++j) { const unsigned c = xb_ld(&bar[XB_XCNT(j)]); sum += c; cnt += (c > 0u) ? 1u : 0u; mine = (j == x) ? c : mine; }
        if (sum == G) break;
        __builtin_amdgcn_s_sleep(1);
        if ((++sp & 255u) == 0u) { if (xb_ld(&bar[XB_TMO])) break; if (sp > XB_SPIN_CAP) { atomicAdd(&bar[XB_TMO], 1u); break; } }
    }
    nloc = mine > 0u ? mine : 1u; nx = cnt > 0u ? cnt : 1u;
}
__device__ __forceinline__ void xcd_barrier(const XcdBarrier& b) {
    asm volatile("s_waitcnt vmcnt(0)" ::: "memory");
    __syncthreads();
    if (threadIdx.x == 0) {
        unsigned* bar = b.bar;
        __builtin_amdgcn_s_waitcnt(0);
        unsigned nloc = b.st[0], nx = b.st[1];
        if (nloc == 0u) { xcd_barrier_complete(bar, b.x, nloc, nx); b.st[0] = nloc; b.st[1] = nx; }
        const unsigned old = xb_add(&bar[XB_XSUB(b.x)], 1u);
        const unsigned gen = old / nloc;
        if (old + 1u == (gen + 1u) * nloc) {
            __builtin_amdgcn_fence(__ATOMIC_RELEASE, "agent");
            asm volatile("s_waitcnt vmcnt(0)" ::: "memory");
            const unsigned og = xb_add(&bar[XB_TOP], 1u);
            const unsigned tg = og / nx;
            if (og + 1u == (tg + 1u) * nx) xb_add(&bar[XB_TOPGEN], 1u);
            else XB_SPIN(xb_ld(&bar[XB_TOPGEN]) == tg, bar);
            __builtin_amdgcn_fence(__ATOMIC_ACQUIRE, "agent");
            xb_add(&bar[XB_XGEN(b.x)], 1u);
            asm volatile("s_waitcnt vmcnt(0)" ::: "memory");
        } else {
            XB_SPIN(xb_ld(&bar[XB_XGEN(b.x)]) == gen, bar);
            __builtin_amdgcn_fence(__ATOMIC_ACQUIRE, "agent");
            asm volatile("s_waitcnt vmcnt(0)" ::: "memory");
        }
    }
    __syncthreads();
}

struct Frame {
    LAS unsigned char* lds;
    int tid, lane, wave, vcu, G;
};
enum { I_XP = 0, I_XS, I_ANG, I_WIN, I_PW, I_PS, I_QNG, I_WUQ, I_KVNG, I_WUKV, I_QHG, I_KHG, I_HCW, I_HCB, I_FW1, I_FB1, I_FFR, I_FW2, I_FB2, I_FW3, I_FB3, I_HBIAS, I_GNG, I_WOUT, I_FNG, I_WUP, I_FCW, I_FCB, I_WDN, N_IN };
struct Args { const float* in[N_IN]; float* out; unsigned char* ws; int ph_lo, ph_hi; };
static_assert(sizeof(Args) == (N_IN + 2) * 8 + 8, "Args has no padding");

__device__ __forceinline__ void cvt_item(const float* __restrict__ W, int ldw, int K, bf16* WT, int dst_n0, int src_n0, int k0, const float* __restrict__ ks, LAS float* scr, int lane) {
#pragma unroll
    for (int i = 0; i < 32; ++i) { const int kk = 2 * i + (lane >> 5); float v = W[(size_t)(k0 + kk) * ldw + src_n0 + (lane & 31)]; if (ks) v *= ks[k0 + kk]; scr[kk * 33 + (lane & 31)] = v; }
    LDS_WAIT(); asm volatile("" ::: "memory");
    const int c = lane & 7;
#pragma unroll
    for (int j = 0; j < 4; ++j) { const int n = (lane >> 3) + 8 * j; const LAS float* s = scr + (8 * c) * 33 + n;
        v4u o; o.x = pk2(s[0 * 33], s[1 * 33]); o.y = pk2(s[2 * 33], s[3 * 33]); o.z = pk2(s[4 * 33], s[5 * 33]); o.w = pk2(s[6 * 33], s[7 * 33]);
        *(v4u*)(WT + (size_t)(dst_n0 + n) * K + k0 + 8 * c) = o; }
    LDS_WAIT(); asm volatile("" ::: "memory");
}
struct CvtTile { const float* W; const float* ks; bf16* WT; int ldw, K, src_n0, k0, ncols; int dst[4]; };
__device__ __forceinline__ void cvt_tile(Frame& F, const CvtTile& d) {
    LAS float* T = (LAS float*)F.lds;
#pragma unroll
    for (int i = 0; i < 8; ++i) { const int q = F.tid + 512 * i, row = q >> 5, c4 = q & 31;
        f32x4 v = {0.f, 0.f, 0.f, 0.f};
        if (d.src_n0 + 4 * c4 < d.ncols) v = *(const f32x4*)(d.W + (size_t)(d.k0 + row) * d.ldw + d.src_n0 + 4 * c4);
        if (d.ks) v *= d.ks[d.k0 + row];
        LAS float* t = T + row * 129 + 4 * c4; t[0] = v.x; t[1] = v.y; t[2] = v.z; t[3] = v.w; }
    __syncthreads();
#pragma unroll
    for (int i = 0; i < 4; ++i) { const int n = (F.tid >> 4) + 32 * i, kc = F.tid & 15;
        if (d.src_n0 + n < d.ncols) { const LAS float* s = T + (8 * kc) * 129 + n;
            v4u o; o.x = pk2(s[0], s[129]); o.y = pk2(s[2 * 129], s[3 * 129]); o.z = pk2(s[4 * 129], s[5 * 129]); o.w = pk2(s[6 * 129], s[7 * 129]);
            *(v4u*)(d.WT + (size_t)(d.dst[i] + (n & 31)) * d.K + d.k0 + 8 * kc) = o; } }
    __syncthreads();
}
__device__ __forceinline__ void absmax_tile(Frame& F, const float* __restrict__ W, const float* __restrict__ ks, int ldw, int src_n0, int k0, unsigned* outc) {
    LAS float* P = (LAS float*)F.lds;
    f32x4 m = {0.f, 0.f, 0.f, 0.f};
#pragma unroll
    for (int i = 0; i < 8; ++i) { const int q = F.tid + 512 * i, row = q >> 5, c4 = q & 31;
        const f32x4 v = *(const f32x4*)(W + (size_t)(k0 + row) * ldw + src_n0 + 4 * c4) * ks[k0 + row];
        m.x = fmaxf(m.x, fabsf(v.x)); m.y = fmaxf(m.y, fabsf(v.y)); m.z = fmaxf(m.z, fabsf(v.z)); m.w = fmaxf(m.w, fabsf(v.w)); }
    *(LAS f32x4*)(P + (F.tid >> 5) * 128 + 4 * (F.tid & 31)) = m;
    __syncthreads();
    if (F.tid < 128) { float c = P[F.tid];
#pragma unroll
        for (int g = 1; g < 16; ++g) c = fmaxf(c, P[g * 128 + F.tid]);
        atomicMax(outc + src_n0 + F.tid, __builtin_bit_cast(unsigned, c)); }
    __syncthreads();
}
__device__ __forceinline__ unsigned q8(float v) { const int q = (int)__builtin_rintf(v); return (unsigned)(q < -127 ? -127 : (q > 127 ? 127 : q)) & 0xffu; }
__device__ __forceinline__ void cvtq_tile(Frame& F, const float* __restrict__ W, const float* __restrict__ ks, int ldw, int K, unsigned char* WT, int src_n0, int k0, int dst0, const unsigned* __restrict__ wmaxc) {
    LAS float* T = (LAS float*)F.lds;
    f32x4 inv4; { const v4u mb = *(const v4u*)(wmaxc + src_n0 + 4 * (F.tid & 31));
        inv4.x = 127.0f / fmaxf(__builtin_bit_cast(float, mb.x), 1e-30f); inv4.y = 127.0f / fmaxf(__builtin_bit_cast(float, mb.y), 1e-30f); inv4.z = 127.0f / fmaxf(__builtin_bit_cast(float, mb.z), 1e-30f); inv4.w = 127.0f / fmaxf(__builtin_bit_cast(float, mb.w), 1e-30f); }
#pragma unroll
    for (int i = 0; i < 8; ++i) { const int q = F.tid + 512 * i, row = q >> 5, c4 = q & 31;
        const f32x4 v = *(const f32x4*)(W + (size_t)(k0 + row) * ldw + src_n0 + 4 * c4) * ks[k0 + row] * inv4;
        LAS float* t = T + row * 129 + 4 * c4; t[0] = v.x; t[1] = v.y; t[2] = v.z; t[3] = v.w; }
    __syncthreads();
#pragma unroll
    for (int i = 0; i < 2; ++i) { const int n = (F.tid >> 3) + 64 * i, kc = F.tid & 7;
        const LAS float* s = T + (16 * kc) * 129 + n; unsigned w[4];
#pragma unroll
        for (int j = 0; j < 4; ++j) w[j] = q8(s[(4 * j) * 129]) | (q8(s[(4 * j + 1) * 129]) << 8) | (q8(s[(4 * j + 2) * 129]) << 16) | (q8(s[(4 * j + 3) * 129]) << 24);
        v4u o; o.x = w[0]; o.y = w[1]; o.z = w[2]; o.w = w[3];
        *(v4u*)(WT + (size_t)(dst0 + 64 * (n >> 5) + (n & 31)) * K + k0 + 16 * kc) = o; }
    __syncthreads();
}
__device__ __forceinline__ void xq_row(const bf16* __restrict__ xrow, unsigned char* qrow, const float* __restrict__ ssq32, float* rowf, float s_w, int lane) {
    v4u v[4]; float m = 0.f;
#pragma unroll
    for (int j = 0; j < 4; ++j) { v[j] = *(const v4u*)(xrow + 8 * (lane + 64 * j)); const unsigned w[4] = {v[j].x, v[j].y, v[j].z, v[j].w};
#pragma unroll
        for (int i = 0; i < 4; ++i) m = fmaxf(m, fmaxf(fabsf(bflo(w[i])), fabsf(bfhi(w[i])))); }
    float ss = (lane < 32) ? ssq32[lane] : 0.f;
#pragma unroll
    for (int o = 1; o < 64; o <<= 1) { m = fmaxf(m, __shfl_xor(m, o)); ss += __shfl_xor(ss, o); }
    m = fmaxf(m, 1e-30f); const float inv = 127.0f / m;
    if (lane == 0) *rowf = (1.0f / sqrtf(ss * (1.f / DM) + EPS)) * (m * (1.0f / 127.0f)) * s_w;
#pragma unroll
    for (int j = 0; j < 4; ++j) { const unsigned w[4] = {v[j].x, v[j].y, v[j].z, v[j].w}; v2u o;
        o.x = q8(bflo(w[0]) * inv) | (q8(bfhi(w[0]) * inv) << 8) | (q8(bflo(w[1]) * inv) << 16) | (q8(bfhi(w[1]) * inv) << 24);
        o.y = q8(bflo(w[2]) * inv) | (q8(bfhi(w[2]) * inv) << 8) | (q8(bflo(w[3]) * inv) << 16) | (q8(bfhi(w[3]) * inv) << 24);
        *(v2u*)(qrow + 8 * (lane + 64 * j)) = o; }
}
__device__ __forceinline__ void xb_row(const float* xrow, bf16* orow, float* rstd, int lane) {
    const f32x4* xr = (const f32x4*)xrow + lane;
    f32x4 v[8]; float s = 0.f;
#pragma unroll
    for (int j = 0; j < 8; ++j) { v[j] = xr[64 * j]; s += (v[j].x * v[j].x + v[j].y * v[j].y) + (v[j].z * v[j].z + v[j].w * v[j].w); }
    const float r = 1.0f / sqrtf(wave_sum(s) * (1.f / DM) + EPS);
    if (lane == 0) *rstd = r;
    v2u* o8 = (v2u*)orow + lane;
#pragma unroll
    for (int j = 0; j < 8; ++j) { v2u w; w.x = pk2(v[j].x, v[j].y); w.y = pk2(v[j].z, v[j].w); o8[64 * j] = w; }
}
__device__ __forceinline__ void rstd_from_partials(const float* __restrict__ ssqp, float* rstd, size_t gtid, size_t gthreads) {
    for (size_t r = gtid; r < (size_t)M; r += gthreads) { const f32x4* p = (const f32x4*)(ssqp + r * 32); f32x4 a = p[0];
#pragma unroll
        for (int i = 1; i < 8; ++i) a += p[i];
        rstd[r] = 1.0f / sqrtf(((a.x + a.y) + (a.z + a.w)) * (1.f / DM) + EPS); }
}
__device__ __forceinline__ void tile_norm_store(LAS float* tile, bf16* dst, int row0, int col_off, int wave, int lane) {
#pragma unroll
    for (int i = 0; i < 8; ++i) { const int t = wave * 8 + i;
        const f32x4 a = *(LAS f32x4*)(tile + t * 512 + 8 * lane), b = *(LAS f32x4*)(tile + t * 512 + 8 * lane + 4);
        const float s = (a.x * a.x + a.y * a.y) + (a.z * a.z + a.w * a.w) + (b.x * b.x + b.y * b.y) + (b.z * b.z + b.w * b.w);
        const float rstd = 1.0f / sqrtf(wave_sum(s) * (1.f / 512.f) + EPS);
        v4u o; o.x = pk2(a.x * rstd, a.y * rstd); o.y = pk2(a.z * rstd, a.w * rstd); o.z = pk2(b.x * rstd, b.y * rstd); o.w = pk2(b.z * rstd, b.w * rstd);
        *(v4u*)(dst + (size_t)(row0 + t) * DM + col_off + 8 * lane) = o; }
}
__device__ __forceinline__ void poolfold_item(Frame& F, const float* __restrict__ win, const float* __restrict__ pw, const float* __restrict__ ps, const float* __restrict__ g1, bf16* BtIn, int g, int kb) {
    LAS float* At = (LAS float*)F.lds; LAS float* Bt = (LAS float*)(F.lds + 32768);
    const int k0 = 64 * kb;
#pragma unroll
    for (int i = 0; i < 4; ++i) { const int q = F.tid + 512 * i, row = q >> 5, c4 = q & 31; *(LAS f32x4*)(At + row * 128 + 4 * c4) = *(const f32x4*)(win + (size_t)(k0 + row) * DIN + 128 * g + 4 * c4) * g1[k0 + row]; }
#pragma unroll
    for (int i = 0; i < 8; ++i) { const int q = F.tid + 512 * i, row = q >> 5, c4 = q & 31; *(LAS f32x4*)(Bt + row * 128 + 4 * c4) = *(const f32x4*)(pw + (size_t)(g * 128 + row) * 128 + 4 * c4); }
    __syncthreads();
    const int n = F.tid & 127, kg = F.tid >> 7;
    float acc[16];
#pragma unroll
    for (int i = 0; i < 16; ++i) acc[i] = 0.f;
    for (int j = 0; j < 128; j += 4) {
        const float b0 = Bt[(j + 0) * 128 + n], b1 = Bt[(j + 1) * 128 + n], b2 = Bt[(j + 2) * 128 + n], b3 = Bt[(j + 3) * 128 + n];
#pragma unroll
        for (int i = 0; i < 16; ++i) { const f32x4 a = *(LAS f32x4*)(At + (kg * 16 + i) * 128 + j); acc[i] += a.x * b0 + a.y * b1 + a.z * b2 + a.w * b3; }
    }
    const float sc = ps[128 * g + n];
    v4u o0, o1;
    o0.x = pk2(acc[0] * sc, acc[1] * sc); o0.y = pk2(acc[2] * sc, acc[3] * sc); o0.z = pk2(acc[4] * sc, acc[5] * sc); o0.w = pk2(acc[6] * sc, acc[7] * sc);
    o1.x = pk2(acc[8] * sc, acc[9] * sc); o1.y = pk2(acc[10] * sc, acc[11] * sc); o1.z = pk2(acc[12] * sc, acc[13] * sc); o1.w = pk2(acc[14] * sc, acc[15] * sc);
    bf16* dst = BtIn + (size_t)(128 * g + n) * DM + k0 + kg * 16;
    *(v4u*)dst = o0; *(v4u*)(dst + 8) = o1;
    __syncthreads();
}
__device__ __forceinline__ void filter_item(Frame& F, const float* __restrict__ w1, const float* __restrict__ b1, const float* __restrict__ fr, const float* __restrict__ w2, const float* __restrict__ b2,
                                            const float* __restrict__ w3, const float* __restrict__ b3, const float* __restrict__ hbias, bf16* RF, int fi) {
    LAS float* ZF = (LAS float*)F.lds; LAS float* H1 = ZF + 512; LAS float* H2 = ZF + 1536; LAS float* W1s = ZF + 2560; LAS float* W2s = ZF + 3712;
    const int t0 = 16 * fi;
    for (int q = F.tid; q < 272; q += 512) *(LAS f32x4*)(W1s + 4 * q) = *(const f32x4*)(w1 + 4 * q);
#pragma unroll
    for (int i = 0; i < 2; ++i) { const int q = F.tid + 512 * i; *(LAS f32x4*)(W2s + 4 * q) = *(const f32x4*)(w2 + 4 * q); }
    if (F.tid < 272) { const int tt = F.tid / 17, f = F.tid % 17; const float t = (float)(t0 + tt);
        float v;
        if (f == 0) v = t / 2047.0f;
        else { const int j = (f - 1) & 7; const float band = 1e-4f + (float)j * ((7.0f - 1e-4f) / 7.0f); const float w = (6.283185307179586f * t) / 2048.0f; const float a = band * w; v = (f <= 8) ? __cosf(a) : -__sinf(a); }
        ZF[tt * 17 + f] = v; }
    __syncthreads();
#pragma unroll
    for (int rep = 0; rep < 2; ++rep) { const int p = F.tid + 512 * rep, tt = p >> 6, j = p & 63; float s = b1[j];
#pragma unroll
        for (int i = 0; i < 17; ++i) s += ZF[tt * 17 + i] * W1s[i * 64 + j];
        H1[tt * 64 + j] = __sinf(fr[j] * s); }
    __syncthreads();
#pragma unroll
    for (int rep = 0; rep < 2; ++rep) { const int p = F.tid + 512 * rep, tt = p >> 6, j = p & 63; float s = b2[j];
#pragma unroll 16
        for (int i = 0; i < 64; ++i) s += H1[tt * 64 + i] * W2s[i * 64 + j];
        H2[tt * 64 + j] = __sinf(fr[j] * s); }
    __syncthreads();
    const int c = F.tid;
    const float delta = -3.0701134573253944f + (float)c * ((-15.350567286626972f + 3.0701134573253944f) / 511.0f);
    const float ad = fabsf(delta);
    bf16* rf = RF + (size_t)c * hy::RFS;
#pragma unroll 1
    for (int dir = 0; dir < 2; ++dir) { const int o = dir * 512 + c; const float bo = b3[o];
        float wc[64];
#pragma unroll
        for (int i = 0; i < 64; ++i) wc[i] = w3[i * 1024 + o];
#pragma unroll 1
        for (int tt = 0; tt < 16; ++tt) { float s = bo;
#pragma unroll
            for (int i = 0; i < 64; i += 4) { const f32x4 hv = *(LAS f32x4*)(H2 + tt * 64 + i); s += (hv.x * wc[i] + hv.y * wc[i + 1]) + (hv.z * wc[i + 2] + hv.w * wc[i + 3]); }
            const int t = t0 + tt; const float tl = (float)t / 2047.0f; float val = s * __expf(-tl * ad);
            if (dir == 0) { if (t == 0) val += hbias[c]; rf[2048 - t] = (bf16)f2bf(val); }
            else if (t >= 1) rf[2048 + t] = (bf16)f2bf(val); } }
    if (fi == 0) { rf[0] = 0;
#pragma unroll
        for (int i = 4096; i < hy::RFS; ++i) rf[i] = 0; }
    __syncthreads();
}
__device__ __forceinline__ void unpack4(const v2u w, float (&x)[4]) { x[0] = bflo(w.x); x[1] = bfhi(w.x); x[2] = bflo(w.y); x[3] = bfhi(w.y); }
__device__ __forceinline__ void pair_norm_store(Frame& F, const float (&y)[8][4], bf16* dst, size_t row0, int col_off, int cq) {
    LAS float* part = (LAS float*)F.lds;
    float ss[8];
#pragma unroll
    for (int k = 0; k < 8; ++k) ss[k] = wave_sum((y[k][0] * y[k][0] + y[k][1] * y[k][1]) + (y[k][2] * y[k][2] + y[k][3] * y[k][3]));
    if (F.lane == 0) { *(LAS f32x4*)(part + F.wave * 8) = (f32x4){ss[0], ss[1], ss[2], ss[3]}; *(LAS f32x4*)(part + F.wave * 8 + 4) = (f32x4){ss[4], ss[5], ss[6], ss[7]}; }
    __syncthreads();
    const f32x4 pa = *(LAS f32x4*)(part + (F.wave ^ 1) * 8), pb = *(LAS f32x4*)(part + (F.wave ^ 1) * 8 + 4);
    const float po[8] = {pa.x, pa.y, pa.z, pa.w, pb.x, pb.y, pb.z, pb.w};
#pragma unroll
    for (int k = 0; k < 8; ++k) { const float rstd = 1.0f / sqrtf((ss[k] + po[k]) * (1.f / 512.f) + EPS);
        v2u o; o.x = pk2(y[k][0] * rstd, y[k][1] * rstd); o.y = pk2(y[k][2] * rstd, y[k][3] * rstd);
        *(v2u*)(dst + (row0 + k) * DM + col_off + 4 * cq) = o; }
    __syncthreads();
}
__device__ __forceinline__ void hyprep_item(Frame& F, const bf16* __restrict__ PROJ, const float* __restrict__ cw, const float* __restrict__ cb, bf16* ZT, bf16* X0, int b, int tile) {
    const int tb = F.tid >> 7, cq = F.tid & 127, c0 = 4 * cq, tw = tile * 32 + tb * 8; const size_t rb = (size_t)b * SEQ;
    float z[8][4];
    v2u rh[3][10];
#pragma unroll
    for (int j = 0; j < 3; ++j)
#pragma unroll
        for (int o = 0; o < 10; ++o) { const int t = tw - 1 + o; const int tc = ((t >= 0) && (t < SEQ)) ? t : tw; rh[j][o] = *(const v2u*)(PROJ + (rb + tc) * DINP + O_HY + 512 * j + c0); }
#pragma unroll
    for (int jj = 0; jj < 3; ++jj) { const int j = (jj == 0) ? 1 : (jj == 1) ? 2 : 0; const int cc = 512 * j + c0;
        const f32x4 w0 = *(const f32x4*)(cw + cc), w1 = *(const f32x4*)(cw + 1536 + cc), w2 = *(const f32x4*)(cw + 3072 + cc), bs = *(const f32x4*)(cb + cc);
        float x[10][4];
#pragma unroll
        for (int o = 0; o < 10; ++o) { const int t = tw - 1 + o; const bool ok = (t >= 0) && (t < SEQ); unpack4(rh[j][o], x[o]);
            if (!ok) { x[o][0] = 0.f; x[o][1] = 0.f; x[o][2] = 0.f; x[o][3] = 0.f; } }
        if (jj == 0) {
#pragma unroll
            for (int k = 0; k < 8; ++k)
#pragma unroll
                for (int i = 0; i < 4; ++i) z[k][i] = w0[i] * x[k][i] + w1[i] * x[k + 1][i] + w2[i] * x[k + 2][i] + bs[i];
        } else if (jj == 1) {
#pragma unroll
            for (int k = 0; k < 8; ++k)
#pragma unroll
                for (int i = 0; i < 4; ++i) z[k][i] *= w0[i] * x[k][i] + w1[i] * x[k + 1][i] + w2[i] * x[k + 2][i] + bs[i];
#pragma unroll
            for (int i = 0; i < 4; ++i) { v4u o; o.x = pk2(z[0][i], z[1][i]); o.y = pk2(z[2][i], z[3][i]); o.z = pk2(z[4][i], z[5][i]); o.w = pk2(z[6][i], z[7][i]);
                *(v4u*)(ZT + ((size_t)(c0 + i) * NSEQ + b) * SEQ + tw) = o; }
        } else {
#pragma unroll
            for (int k = 0; k < 8; ++k) { float u0[4];
#pragma unroll
                for (int i = 0; i < 4; ++i) u0[i] = w0[i] * x[k][i] + w1[i] * x[k + 1][i] + w2[i] * x[k + 2][i] + bs[i];
                v2u o; o.x = pk2(u0[0], u0[1]); o.y = pk2(u0[2], u0[3]); *(v2u*)(X0 + (rb + tw + k) * HYC + c0) = o; }
        }
    }
}
__device__ __forceinline__ void pool_item(Frame& F, const bf16* __restrict__ PROJ, bf16* MIXED, int b, int tile) {
    const int tb = F.tid >> 7, cq = F.tid & 127, c0 = 4 * cq, g = cq >> 5, half = 1 << g, tw = tile * 32 + tb * 8; const size_t rb = (size_t)b * SEQ;
    float x[23][4];
#pragma unroll
    for (int o = 0; o < 23; ++o) { const int t = tw - 8 + o; const bool ok = (t >= 0) && (t < SEQ); const int tc = ok ? t : tw;
        const v2u w = *(const v2u*)(PROJ + (rb + tc) * DINP + c0); unpack4(w, x[o]);
        if (!ok) { x[o][0] = 0.f; x[o][1] = 0.f; x[o][2] = 0.f; x[o][3] = 0.f; } }
    float y[8][4];
#pragma unroll
    for (int k = 0; k < 8; ++k) { const int oc = 8 + k, t = tw + k; const int lo = (t - half > 0) ? t - half : 0, hi = (t + half < SEQ) ? t + half : SEQ; const float inv = 1.0f / (float)(hi - lo);
#pragma unroll
        for (int i = 0; i < 4; ++i) {
            const float w1 = x[oc - 1][i] + x[oc][i];
            const float w2 = w1 + (x[oc - 2][i] + x[oc + 1][i]);
            const float w4 = w2 + ((x[oc - 4][i] + x[oc - 3][i]) + (x[oc + 2][i] + x[oc + 3][i]));
            const float w8 = w4 + (((x[oc - 8][i] + x[oc - 7][i]) + (x[oc - 6][i] + x[oc - 5][i])) + ((x[oc + 4][i] + x[oc + 5][i]) + (x[oc + 6][i] + x[oc + 7][i])));
            const float S = (g == 0) ? w1 : (g == 1) ? w2 : (g == 2) ? w4 : w8;
            y[k][i] = S * inv - x[oc][i]; } }
    pair_norm_store(F, y, MIXED, rb + tw, 0, cq);
}
__device__ __forceinline__ void hyfin_item(Frame& F, const bf16* __restrict__ YC, const bf16* __restrict__ X0, bf16* MIXED, int b, int tile) {
    const int tb = F.tid >> 7, cq = F.tid & 127, c0 = 4 * cq, tw = tile * 32 + tb * 8; const size_t rb = (size_t)b * SEQ;
    float yc[4][8], y[8][4];
#pragma unroll
    for (int i = 0; i < 4; ++i) { const v4u v = *(const v4u*)(YC + ((size_t)(c0 + i) * NSEQ + b) * SEQ + tw);
        yc[i][0] = bflo(v.x); yc[i][1] = bfhi(v.x); yc[i][2] = bflo(v.y); yc[i][3] = bfhi(v.y); yc[i][4] = bflo(v.z); yc[i][5] = bfhi(v.z); yc[i][6] = bflo(v.w); yc[i][7] = bfhi(v.w); }
#pragma unroll
    for (int k = 0; k < 8; ++k) { float xv[4]; unpack4(*(const v2u*)(X0 + (rb + tw + k) * HYC + c0), xv);
#pragma unroll
        for (int i = 0; i < 4; ++i) y[k][i] = yc[i][k] * xv[i]; }
    pair_norm_store(F, y, MIXED, rb + tw, 1536, cq);
}
struct PrepGains { float q[3][8], k[3][8]; };
__device__ __forceinline__ void load8(const float* p, float (&o)[8]) { const f32x4 a = *(const f32x4*)p, b = *(const f32x4*)(p + 4); o[0] = a.x; o[1] = a.y; o[2] = a.z; o[3] = a.w; o[4] = b.x; o[5] = b.y; o[6] = b.z; o[7] = b.w; }
__device__ __forceinline__ void unpack8(const v4u w, float (&x)[8]) { x[0] = bflo(w.x); x[1] = bfhi(w.x); x[2] = bflo(w.y); x[3] = bfhi(w.y); x[4] = bflo(w.z); x[5] = bfhi(w.z); x[6] = bflo(w.w); x[7] = bfhi(w.w); }
__device__ __forceinline__ v4u pack8(const float (&x)[8]) { v4u o; o.x = pk2(x[0], x[1]); o.y = pk2(x[2], x[3]); o.z = pk2(x[4], x[5]); o.w = pk2(x[6], x[7]); return o; }
__device__ __forceinline__ float ssq8(const float (&x)[8]) { return ((x[0] * x[0] + x[1] * x[1]) + (x[2] * x[2] + x[3] * x[3])) + ((x[4] * x[4] + x[5] * x[5]) + (x[6] * x[6] + x[7] * x[7])); }
__device__ __forceinline__ float sum8lanes(float v) { v += __shfl_xor(v, 1); v += __shfl_xor(v, 2); v += __shfl_xor(v, 4); return v; }
__device__ __forceinline__ void prep_row(const bf16* __restrict__ PROJ, bf16* Q, bf16* KV, const PrepGains& G, const float* __restrict__ ROPE, int m, int lane) {
    const int h = lane >> 3, sub = lane & 7;
    const bf16* pr = PROJ + (size_t)m * DINP; bf16* qr = Q + (size_t)m * NQ + 192 * h + 8 * sub; bf16* kr = KV + (size_t)m * NKVP + KVHS * h + 8 * sub;
    const v4u cqv = *(const v4u*)(pr + O_CQ + 8 * lane); const v4u ckv = *(const v4u*)(pr + O_CKV + 8 * (lane & 31)); const v4u pev = *(const v4u*)(pr + O_KPE + 8 * sub);
    const v4u q0 = *(const v4u*)(qr), q1 = *(const v4u*)(qr + 64), q2 = *(const v4u*)(qr + 128);
    const v4u k0 = *(const v4u*)(kr), k1 = *(const v4u*)(kr + 64), v0 = *(const v4u*)(kr + 192), v1 = *(const v4u*)(kr + 256);
    float cs[8], sn[8]; { const float* rp = ROPE + (size_t)(m & (SEQ - 1)) * 64 + 8 * (sub & 3); load8(rp, cs); load8(rp + 32, sn); }
    float t[8];
    unpack8(cqv, t); const float rq = 1.0f / sqrtf(wave_sum(ssq8(t)) * (1.f / 512.f) + EPS);
    unpack8(ckv, t); const float rkv = 1.0f / sqrtf(wave_sum(lane < 32 ? ssq8(t) : 0.f) * (1.f / 256.f) + EPS);
    const float sg = (sub < 4) ? -1.f : 1.f;
    { float a0[8], a1[8], a2[8]; unpack8(q0, a0); unpack8(q1, a1); unpack8(q2, a2);
      const float ss = sum8lanes(ssq8(a0) + ssq8(a1) + ssq8(a2)) * (rq * rq);
      const float sc = (rq * (at::SCALE * 1.4426950408889634f)) / sqrtf(ss * (1.f / 192.f) + EPS);
      float r[8], o[8];
#pragma unroll
      for (int i = 0; i < 8; ++i) { a0[i] *= sc * G.q[0][i]; a1[i] *= sc * G.q[1][i]; r[i] = a2[i] * sc * G.q[2][i]; }
#pragma unroll
      for (int i = 0; i < 8; ++i) { const float rp = __shfl_xor(r[i], 4); o[i] = r[i] * cs[i] + sg * rp * sn[i]; }
      *(v4u*)(qr) = pack8(a0); *(v4u*)(qr + 64) = pack8(a1); *(v4u*)(qr + 128) = pack8(o); }
    { float a0[8], a1[8], pe[8], b0[8], b1[8]; unpack8(k0, a0); unpack8(k1, a1); unpack8(pev, pe); unpack8(v0, b0); unpack8(v1, b1);
      const float ss = sum8lanes((ssq8(a0) + ssq8(a1)) * (rkv * rkv) + ssq8(pe));
      const float sk = 1.0f / sqrtf(ss * (1.f / 192.f) + EPS);
      float r[8], o[8];
#pragma unroll
      for (int i = 0; i < 8; ++i) { a0[i] *= rkv * sk * G.k[0][i]; a1[i] *= rkv * sk * G.k[1][i]; r[i] = pe[i] * sk * G.k[2][i]; b0[i] *= rkv; b1[i] *= rkv; }
#pragma unroll
      for (int i = 0; i < 8; ++i) { const float rp = __shfl_xor(r[i], 4); o[i] = r[i] * cs[i] + sg * rp * sn[i]; }
      *(v4u*)(kr) = pack8(a0); *(v4u*)(kr + 64) = pack8(a1); *(v4u*)(kr + 128) = pack8(o); *(v4u*)(kr + 192) = pack8(b0); *(v4u*)(kr + 256) = pack8(b1); }
}
__device__ __forceinline__ void attn_norm_row(bf16* MIXED, int m, int lane) {
    v4u* p = (v4u*)(MIXED + (size_t)m * DM + 512 + 16 * lane); v4u a = p[0], b = p[1];
    unsigned w[8] = {a.x, a.y, a.z, a.w, b.x, b.y, b.z, b.w}; float s = 0.f;
#pragma unroll
    for (int i = 0; i < 8; ++i) { const float x = bflo(w[i]), y = bfhi(w[i]); s += x * x + y * y; }
    const float rstd = 1.0f / sqrtf(wave_sum(s) * (1.f / 1024.f) + EPS);
#pragma unroll
    for (int i = 0; i < 8; ++i) w[i] = pk2(bflo(w[i]) * rstd, bfhi(w[i]) * rstd);
    a.x = w[0]; a.y = w[1]; a.z = w[2]; a.w = w[3]; b.x = w[4]; b.y = w[5]; b.z = w[6]; b.w = w[7]; p[0] = a; p[1] = b;
}

#define DEFPTRS() unsigned char* ws = args.ws; \
    bf16* BtIn = (bf16*)(ws + WS_BTIN); bf16* BtUq = (bf16*)(ws + WS_BTUQ); bf16* BtKv = (bf16*)(ws + WS_BTKV); bf16* BtOut = (bf16*)(ws + WS_BTOUT); bf16* BtUp = (bf16*)(ws + WS_BTUP); bf16* BtDn = (bf16*)(ws + WS_BTDN); \
    bf16* RF = (bf16*)(ws + WS_RF); bf16* Hb = (bf16*)(ws + WS_H); bf16* PROJ = (bf16*)(ws + WS_PROJ); bf16* Qb = (bf16*)(ws + WS_Q); bf16* KVb = (bf16*)(ws + WS_KV); \
    bf16* ZT = (bf16*)(ws + WS_ZT); bf16* X0 = (bf16*)(ws + WS_X0); bf16* YC = (bf16*)(ws + WS_YC); float* EDGE = (float*)(ws + WS_EDGE); float* ROPE = (float*)(ws + WS_ROPE); float* SSQP = (float*)(ws + WS_SSQP); float* RSTD = (float*)(ws + WS_RSTD); bf16* XB2 = (bf16*)(ws + WS_XB2); unsigned char* XQ = (unsigned char*)(ws + WS_XQ); unsigned char* BtUpQ = (unsigned char*)(ws + WS_BTUP); bf16* ACT = (bf16*)(ws + WS_ACT); \
    bf16* XA = (bf16*)args.out; \
    (void)BtIn; (void)BtUq; (void)BtKv; (void)BtOut; (void)BtUp; (void)BtDn; (void)RF; (void)Hb; (void)PROJ; (void)Qb; (void)KVb; (void)ZT; (void)X0; (void)YC; (void)EDGE; (void)ROPE; (void)SSQP; (void)RSTD; (void)XB2; (void)XQ; (void)BtUpQ; (void)ACT; (void)XA
__global__ void __launch_bounds__(NWAVES * 64, 2) fwd(Args args) {
    extern __shared__ __attribute__((aligned(16))) unsigned char lds_raw[];
    Frame F;
    F.lds = (LAS unsigned char*)lds_raw;
    F.tid = threadIdx.x; F.lane = F.tid & 63; F.wave = __builtin_amdgcn_readfirstlane(F.tid >> 6);
    F.G = gridDim.x; { const int bx = blockIdx.x; F.vcu = (F.G % 8 == 0) ? (bx % 8) * (F.G / 8) + bx / 8 : bx; }
    volatile LAS unsigned* MISC = (volatile LAS unsigned*)(F.lds + MISC_OFF);
    if (F.tid < 64) MISC[F.tid] = 0u;
    __syncthreads();
    unsigned* ctl = (unsigned*)(args.ws + WS_CTL);
    const int lo = args.ph_lo, hi = args.ph_hi;
    XcdBarrier bar; bar.bar = ctl + CW_BAR; bar.x = 0; bar.st = MISC + 8;
    if (hi - lo > 1) bar = xcd_barrier_post(ctl + CW_BAR, MISC + 8);
    float* out = args.out;

#pragma unroll 1
    for (int layer = 0; layer < DEPTH; ++layer) {
        const int pb = layer * NPH;
        if (pb + NPH <= lo || pb >= hi) continue;
#define IN(k) (lo <= pb + (k) && pb + (k) < hi)
#define ENTER() DEFPTRS(); F.tid = opq(threadIdx.x); F.lane = F.tid & 63; F.wave = __builtin_amdgcn_readfirstlane(F.tid >> 6); const int gw = F.vcu * NWAVES + F.wave, NGW = F.G * NWAVES, wg = F.vcu; const size_t gtid = (size_t)wg * 512 + F.tid, gthreads = (size_t)F.G * 512; (void)gw; (void)NGW; (void)wg; (void)gtid; (void)gthreads
#define SEAM(k) do { if (pb + (k) + 1 < hi) xcd_barrier(bar); } while (0)

        if (IN(0)) { ENTER();
            const float* win = args.in[I_WIN] + (size_t)layer * DM * DIN; const float* g1 = args.in[I_ANG] + layer * DM;
            for (int it = wg; it < 256; it += F.G) {
                if (it < 128) poolfold_item(F, win, args.in[I_PW] + (size_t)layer * 4 * 128 * 128, args.in[I_PS] + (size_t)layer * 512, g1, BtIn, it >> 5, it & 31);
                else filter_item(F, args.in[I_FW1] + (size_t)layer * 17 * 64, args.in[I_FB1] + layer * 64, args.in[I_FFR] + layer * 64, args.in[I_FW2] + (size_t)layer * 64 * 64, args.in[I_FB2] + layer * 64,
                                 args.in[I_FW3] + (size_t)layer * 64 * 1024, args.in[I_FB3] + layer * 1024, args.in[I_HBIAS] + layer * 512, RF, it - 128);
            }
            constexpr int T_IN = 19 * 16, T_UQ = 12 * 4, T_KV = 16 * 2, T_OUT = 16 * 16, T_UP = 88 * 16, T_DN = 16 * 44, T_ALL = T_IN + T_UQ + T_KV + T_OUT + T_UP + T_DN;
            for (int it = wg; it < T_ALL; it += F.G) {
                int r = it; CvtTile d;
                if (r < T_IN) { const int nt = r >> 4, kt = r & 15, n0 = 512 + 128 * nt; d = CvtTile{win, g1, BtIn, DIN, DM, n0, 128 * kt, DIN, {n0, n0 + 32, n0 + 64, n0 + 96}}; }
                else if ((r -= T_IN) < T_UQ) { const int nt = r >> 2, kt = r & 3, n0 = 128 * nt; d = CvtTile{args.in[I_WUQ] + (size_t)layer * 512 * NQ, args.in[I_QNG] + layer * 512, BtUq, NQ, 512, n0, 128 * kt, NQ, {n0, n0 + 32, n0 + 64, n0 + 96}}; }
                else if ((r -= T_UQ) < T_KV) { const int nt = r >> 1, kt = r & 1, n0 = 128 * nt;
                    d = CvtTile{args.in[I_WUKV] + (size_t)layer * 256 * 2048, args.in[I_KVNG] + layer * 256, BtKv, 2048, 256, n0, 128 * kt, 2048, {n0, n0 + 32, n0 + 64, n0 + 96}}; }
                else if ((r -= T_KV) < T_OUT) { const int nt = r >> 4, kt = r & 15, n0 = 128 * nt; d = CvtTile{args.in[I_WOUT] + (size_t)layer * DM * DM, args.in[I_GNG] + layer * DM, BtOut, DM, DM, n0, 128 * kt, DM, {n0, n0 + 32, n0 + 64, n0 + 96}}; }
                else if ((r -= T_OUT) < T_UP) { const int nt = r >> 4, kt = r & 15;
                    absmax_tile(F, args.in[I_WUP] + (size_t)layer * DM * NUP, args.in[I_FNG] + layer * DM, NUP, 128 * nt, 128 * kt, ctl + CW_WMAXC + layer * NUP); continue; }
                else { r -= T_UP; const int nt = r / 44, kt = r % 44, n0 = 128 * nt; d = CvtTile{args.in[I_WDN] + (size_t)layer * DFF * DM, nullptr, BtDn, DM, DFF, n0, 128 * kt, DM, {n0, n0 + 32, n0 + 64, n0 + 96}}; }
                cvt_tile(F, d);
            }
            { unsigned zz = 0u; asm volatile("" : "+v"(zz)); v4u z = {zz, zz, zz, zz};
              for (size_t i = gtid; i < (size_t)(DINP - DIN) * DM / 8; i += gthreads) *(v4u*)(BtIn + (size_t)DIN * DM + i * 8) = z;
}
            if (layer == 0) for (size_t i = gtid; i < (size_t)SEQ * 32; i += gthreads) { const int pos = (int)(i >> 5), ri = (int)(i & 31);
                const float freq = exp2f(-(float)ri * (13.287712379549449f / 32.0f)); float sn, cs; sincosf((float)pos * freq, &sn, &cs); ROPE[pos * 64 + ri] = cs; ROPE[pos * 64 + 32 + ri] = sn; }
            if (layer == 0) { for (int m = gw; m < M; m += NGW) xb_row(m < MP ? args.in[I_XP] + (size_t)m * DM : args.in[I_XS] + (size_t)(m - MP) * DM, XA + (size_t)m * DM, RSTD + m, F.lane); }
            else rstd_from_partials(SSQP, RSTD, gtid, gthreads);
            SEAM(0);
        }
        if (IN(1)) { ENTER();
            pg8::Gemm g{XA, BtIn, M, DINP, DM, DM}; pg8::StaticOrder S; S.init(M, DINP, F.G, (int)blockIdx.x);
            pg8::EpiBf16 E{PROJ, DINP, RSTD, 0};
            pg8::gemm_phase<pg8::EpiBf16, pg8::StaticOrder>(F.lds, g, S, E);
            SEAM(1);
        }
        if (IN(2)) { ENTER();
            { pg8::Gemm g{PROJ + O_CQ, BtUq, M, NQ, 512, DINP}; pg8::StaticOrder S; S.init(M, NQ, F.G, (int)blockIdx.x); pg8::EpiBf16 E{Qb, NQ, nullptr, 0};
              pg8::gemm_phase<pg8::EpiBf16, pg8::StaticOrder>(F.lds, g, S, E); }
            { pg8::Gemm g{PROJ + O_CKV, BtKv, M, 2048, 256, DINP}; pg8::StaticOrder S; S.init(M, 2048, F.G, (int)blockIdx.x); pg8::EpiBf16 E{KVb, NKVP, nullptr, 1};
              pg8::gemm_phase<pg8::EpiBf16, pg8::StaticOrder>(F.lds, g, S, E); }
            const float* hcw = args.in[I_HCW] + (size_t)layer * 3 * 1536; const float* hcb = args.in[I_HCB] + layer * 1536;
            for (int it = wg; it < 2 * NSEQ * 64; it += F.G) {
                if (it < NSEQ * 64) hyprep_item(F, PROJ, hcw, hcb, ZT, X0, it >> 6, it & 63);
                else pool_item(F, PROJ, Hb, (it - NSEQ * 64) >> 6, it & 63);
            }
            SEAM(2);
        }
        if (IN(3)) { ENTER();
            for (int u = wg; u < 2 * HYC; u += F.G) hy::conv_unit(F.lds, ZT, RF, YC, u >> 1, u & 1);
            const float* qhg = args.in[I_QHG] + layer * 192; const float* khg = args.in[I_KHG] + layer * 192;
            PrepGains PG; { const int sub = F.lane & 7;
#pragma unroll
                for (int i = 0; i < 3; ++i) { load8(qhg + 64 * i + 8 * sub, PG.q[i]); load8(khg + 64 * i + 8 * sub, PG.k[i]); } }
            for (int m = gw; m < M; m += NGW) prep_row(PROJ, Qb, KVb, PG, ROPE, m, F.lane);
            SEAM(3);
        }
        if (IN(4)) { ENTER();
            float gqm, gkm; { const float* qhg = args.in[I_QHG] + layer * 192; const float* khg = args.in[I_KHG] + layer * 192;
                gqm = fmaxf(fmaxf(fabsf(qhg[F.lane]), fabsf(qhg[64 + F.lane])), fabsf(qhg[128 + F.lane])); gkm = fmaxf(fmaxf(fabsf(khg[F.lane]), fabsf(khg[64 + F.lane])), fabsf(khg[128 + F.lane]));
#pragma unroll
                for (int o = 1; o < 64; o <<= 1) { gqm = fmaxf(gqm, __shfl_xor(gqm, o)); gkm = fmaxf(gkm, __shfl_xor(gkm, o)); } }
            const float Mnat = 13.856406460551018f * gqm * gkm;
            const bool sm_fast = __builtin_amdgcn_readfirstlane((Mnat <= 40.0f) ? 1 : 0) != 0;
            const float negMC = __builtin_bit_cast(float, __builtin_amdgcn_readfirstlane(__builtin_bit_cast(int, -Mnat * 1.4426950408889634f)));
            for (int i = 0; i * F.G < NSEQ * NH * 8; ++i) {
                int p, qb; const int c = (int)blockIdx.x;
                if (F.G == 256) { p = i * 32 + (c & 7) * 4 + (c >> 6); qb = (c >> 3) & 7; } else { const int Lq = i * F.G + c; p = Lq >> 3; qb = Lq & 7; }
                if (p < NSEQ * NH) { const int b = p >> 3, h = p & 7;
                    const bf16* qp = Qb + (size_t)(b * SEQ + qb * 256) * NQ + h * 192; const bf16* kp = KVb + (size_t)(b * SEQ) * NKVP + h * KVHS; bf16* op = Hb + (size_t)(b * SEQ + qb * 256) * DM + 512 + h * 128;
                    if (sm_fast) at::attn_unit<true>(negMC, qp, kp, kp + 192, op, SEQ, (char*)lds_raw);
                    else at::attn_unit<false>(0.f, qp, kp, kp + 192, op, SEQ, (char*)lds_raw); }
            }
            for (int it = wg; it < NSEQ * 64; it += F.G) hyfin_item(F, YC, X0, Hb, it >> 6, it & 63);
            SEAM(4);
        }
        if (IN(5)) { ENTER();
            for (int m = gw; m < M; m += NGW) attn_norm_row(Hb, m, F.lane);
            SEAM(5);
        }
        if (IN(6)) { ENTER();
            pg8::Gemm g{Hb, BtOut, M, DM, DM, DM}; pg8::StaticOrder S; S.init(M, DM, F.G, (int)blockIdx.x);
            pg8::EpiResid16 E{XA, XB2, out, DM, SSQP, 0};
            pg8::gemm_phase<pg8::EpiResid16, pg8::StaticOrder>(F.lds, g, S, E);
            SEAM(6);
        }
        if (IN(7)) { ENTER();
            const unsigned* wmaxc = ctl + CW_WMAXC + layer * NUP;
            for (int it = wg; it < 88 * 16; it += F.G) { const int nt = it >> 4, kt = it & 15; const int nv = (nt < 44) ? nt : nt - 44;
                cvtq_tile(F, args.in[I_WUP] + (size_t)layer * DM * NUP, args.in[I_FNG] + layer * DM, NUP, DM, BtUpQ, 128 * nt, 128 * kt, 256 * nv + ((nt < 44) ? 0 : 32), wmaxc); }
            for (int m = gw; m < M; m += NGW) xq_row(XB2 + (size_t)m * DM, XQ + (size_t)m * DM, SSQP + (size_t)m * 32, RSTD + m, 1.0f, F.lane);
            SEAM(7);
        }
        if (IN(8)) { ENTER();
            pg8::Gemm g{(const bf16*)XQ, (const bf16*)BtUpQ, M, NUP, DM / 2, DM / 2}; pg8::StaticOrder S; S.init(M, NUP, F.G, (int)blockIdx.x);
            pg8::EpiGate E{ACT, DFF, EDGE, args.in[I_FCW] + (size_t)layer * 3 * DFF, args.in[I_FCB] + layer * DFF, DFF, (LAS float*)(F.lds + HALO_OFF), RSTD, ctl + CW_WMAXC + layer * NUP};
            pg8::gemm_phase<pg8::EpiGate, pg8::StaticOrder, true>(F.lds, g, S, E);
            SEAM(8);
        }
        if (IN(9)) { ENTER();
            const float* fcw = args.in[I_FCW] + (size_t)layer * 3 * DFF;
            for (size_t i = gtid; i < (size_t)(M / 256) * 2 * (DFF / 4); i += gthreads) {
                const int ri = (int)(i / (DFF / 4)), c4 = (int)(i % (DFF / 4)) * 4, pm = ri >> 1, e = ri & 1;
                const float* eb = EDGE + (size_t)(ri * 3) * DFF + c4;
                f32x4 pre = *(const f32x4*)(eb + DFF); const f32x4 v = *(const f32x4*)(eb + 2 * DFF);
                if (e == 0 && (pm & 7) != 0) { const f32x4 gp = *(const f32x4*)(EDGE + (size_t)(((pm - 1) * 2 + 1) * 3) * DFF + c4); pre += *(const f32x4*)(fcw + c4) * gp; }
                if (e == 1 && (pm & 7) != 7) { const f32x4 gn = *(const f32x4*)(EDGE + (size_t)(((pm + 1) * 2 + 0) * 3) * DFF + c4); pre += *(const f32x4*)(fcw + 2 * DFF + c4) * gn; }
                v2u o; o.x = pk2(pg8::silu_f(pre.x) * v.x, pg8::silu_f(pre.y) * v.y); o.y = pk2(pg8::silu_f(pre.z) * v.z, pg8::silu_f(pre.w) * v.w);
                *(v2u*)(ACT + (size_t)(pm * 256 + (e ? 255 : 0)) * DFF + c4) = o;
            }
            SEAM(9);
        }
        if (IN(10)) { ENTER();
            pg8::Gemm g{ACT, BtDn, M, DM, DFF, DFF}; pg8::StaticOrder S; S.init(M, DM, F.G, (int)blockIdx.x);
            pg8::EpiResid16 E{XB2, XA, out, DM, SSQP, (layer + 1 < DEPTH) ? 0 : 1};
            pg8::gemm_phase<pg8::EpiResid16, pg8::StaticOrder>(F.lds, g, S, E);
            SEAM(10);
        }
#undef IN
#undef ENTER
#undef SEAM
    }
}

extern "C" void kernel_launch(void* const* d_in, const int* in_sizes, int n_in, void* d_out, int out_size, void* d_ws, size_t ws_size, hipStream_t stream) {
    static int grid = 0;
    if (grid == 0) {
        if (n_in != N_IN || out_size != M * DM || ws_size < WS_END) { fprintf(stderr, "kernel_launch: unexpected shapes (n_in %d, out %d, ws %zu, need %zu)\n", n_in, out_size, ws_size, (size_t)WS_END); grid = -1; return; }
        int dev = 0, cus = 0;
        if (hipGetDevice(&dev) != hipSuccess || hipDeviceGetAttribute(&cus, hipDeviceAttributeMultiprocessorCount, dev) != hipSuccess) { grid = -1; return; }
        if (hipFuncSetAttribute((const void*)fwd, hipFuncAttributeMaxDynamicSharedMemorySize, LDS_BYTES) != hipSuccess) { fprintf(stderr, "kernel_launch: hipFuncSetAttribute failed\n"); grid = -1; return; }
        int per_cu = 0;
        if (hipOccupancyMaxActiveBlocksPerMultiprocessor(&per_cu, (const void*)fwd, NWAVES * 64, LDS_BYTES) != hipSuccess || per_cu < 1) fprintf(stderr, "kernel_launch: occupancy query reports %d\n", per_cu);
        (void)hipGetLastError();
        grid = cus;
    }
    if (grid < 0) return;
    (void)hipMemsetAsync((char*)d_ws + WS_CTL, 0, CTL_BYTES, stream);
    Args a{};
    for (int i = 0; i < N_IN; ++i) a.in[i] = (const float*)d_in[i];
    a.out = (float*)d_out; a.ws = (unsigned char*)d_ws;
#if MK_ONE_LAUNCH
    a.ph_lo = 0; a.ph_hi = DEPTH * NPH;
    hipLaunchKernelGGL(fwd, dim3(grid), dim3(NWAVES * 64), LDS_BYTES, stream, a);
#else
    for (int p = 0; p < DEPTH * NPH; ++p) { a.ph_lo = p; a.ph_hi = p + 1; hipLaunchKernelGGL(fwd, dim3(grid), dim3(NWAVES * 64), LDS_BYTES, stream, a); }
#endif
    const hipError_t le = hipPeekAtLastError();
    if (le != hipSuccess) fprintf(stderr, "kernel_launch: launch failed: %s\n", hipGetErrorName(le));
}
```

```cpp
#include <hip/hip_runtime.h>
#include <cstdio>
#include <cstdint>
__device__ __forceinline__ int opq(int x) { asm volatile("" : "+v"(x)); return x; }
namespace pg8 {
#define PG8_LAS __attribute__((address_space(3)))
typedef unsigned short bf16_t;
typedef short bf16x8 __attribute__((ext_vector_type(8)));
typedef float f32x4 __attribute__((ext_vector_type(4)));
typedef unsigned u32x4 __attribute__((ext_vector_type(4)));
typedef int i32x4 __attribute__((ext_vector_type(4)));
template <bool I8> struct AccSel { typedef f32x4 T; }; template <> struct AccSel<true> { typedef i32x4 T; };
constexpr int BM = 256, BK = 64, HALF = 128, HTB = HALF * BK * 2  , STAGE_BYTES = 8 * HTB, NXCD = 8, WGM = 8;

__host__ __device__ __forceinline__ int lds_byte(int r, int c) { const int st = (r >> 4) * 2 + (c >> 5), rr = r & 15, cc = c & 31, ob = rr * 64 + cc * 2; return st * 1024 + (ob ^ (((ob >> 9) & 1) << 5)); }
__host__ __device__ __forceinline__ void stage_rc(int b, int& R, int& C) { const int st = b / 1024, sb = b % 1024, swz = sb ^ (((sb >> 9) & 1) << 5); R = (st >> 1) * 16 + swz / 64; C = (st & 1) * 32 + (swz % 64) / 2; }
__host__ __device__ __forceinline__ int perm32(int rho) { const int n = rho >> 4, i = rho & 15; return 8 * (i >> 2) + 4 * n + (i & 3); }

struct Unit { int pm, pn; };
struct Gemm { const bf16_t* A; const bf16_t* Bt; int M, N, K, lda; };

struct StaticOrder {
    int nM, nN, nwg, G, c;
    __host__ __device__ void init(int M, int N, int G_, int c_) { nM = M / BM; nN = N / BM; nwg = nM * nN; G = G_; c = c_; }
    __host__ __device__ bool next(int i, Unit& u) const {
        const long L = (long)i * G + c; if (L >= nwg) return false;
        int wgid = (int)L; { const int q = nwg / NXCD, r = nwg % NXCD, xcd = wgid % NXCD, off = wgid / NXCD; wgid = (xcd < r ? xcd * (q + 1) : r * (q + 1) + (xcd - r) * q) + off; }
        const int nig = WGM * nN, gid = wgid / nig, fm = gid * WGM, gsz = (nM - fm) < WGM ? (nM - fm) : WGM;
        u.pm = fm + ((wgid % nig) % gsz); u.pn = (wgid % nig) / gsz; return true;
    }
    __device__ __forceinline__ void a_ready(const Unit&) const {}
    __device__ __forceinline__ void done(const Unit&) const {}
};

__device__ __forceinline__ unsigned cvt_pk_bf16(float lo, float hi) { unsigned r; asm volatile("v_cvt_pk_bf16_f32 %0, %1, %2" : "=v"(r) : "v"(lo), "v"(hi)); return r; }

__device__ __forceinline__ float dpp_ror1(float v) { return __builtin_bit_cast(float, __builtin_amdgcn_update_dpp(0, __builtin_bit_cast(int, v), 0x121, 0xF, 0xF, false)); }
__device__ __forceinline__ float dpp_ror15(float v) { return __builtin_bit_cast(float, __builtin_amdgcn_update_dpp(0, __builtin_bit_cast(int, v), 0x12F, 0xF, 0xF, false)); }
__device__ __forceinline__ unsigned dpp_swap1(unsigned v) { return (unsigned)__builtin_amdgcn_update_dpp(0, (int)v, 0xB1, 0xF, 0xF, false); }
struct LineOffs { unsigned o0, o1; bool odd; };
__device__ __forceinline__ LineOffs line_offs(unsigned lo, int pitch, int fr) { LineOffs L; L.odd = fr & 1; L.o0 = L.odd ? lo - (unsigned)pitch + 32u : lo; L.o1 = L.odd ? lo + 32u : lo + (unsigned)pitch; return L; }
__device__ __forceinline__ void store_lines(bf16_t* base, const LineOffs& L, u32x4 a, u32x4 b) {
    const u32x4 snd = L.odd ? a : b; u32x4 rcv;
    rcv.x = dpp_swap1(snd.x); rcv.y = dpp_swap1(snd.y); rcv.z = dpp_swap1(snd.z); rcv.w = dpp_swap1(snd.w);
    *(u32x4*)(base + L.o0) = L.odd ? rcv : a;
    *(u32x4*)(base + L.o1) = L.odd ? b : rcv;
}
struct EpiBf16 {
    static constexpr bool PERM = true;
    bf16_t* O; int ldc; const float* rstd; int kvscatter;
    __device__ __forceinline__ void operator()(f32x4 (&acc)[2][2][4][2], const Unit& u, int wr, int wc, int fr, int fq) const {
        bf16_t* Ot = O + (size_t)(u.pm * BM) * ldc + (kvscatter ? u.pn * 320 : u.pn * BM);
        const int wcol = kvscatter ? (wc < 2 ? wc * 64 : 64 + wc * 64) : wc * 64;
        const LineOffs L = line_offs((unsigned)((wr * 64 + fr) * ldc + wcol + 8 * fq), ldc, fr); const int row0 = u.pm * BM + wr * 64 + fr;
        float rsv[8];
#pragma unroll
        for (int i = 0; i < 8; ++i) rsv[i] = rstd ? rstd[row0 + (i >> 2) * HALF + (i & 3) * 16] : 1.0f;
#pragma unroll
        for (int ai = 0; ai < 2; ++ai)
#pragma unroll
            for (int m = 0; m < 4; ++m) { const float rs = rsv[ai * 4 + m];
                u32x4 w[2];
#pragma unroll
                for (int bj = 0; bj < 2; ++bj) { const f32x4 v0 = acc[ai][bj][m][0] * rs, v1 = acc[ai][bj][m][1] * rs;
                    w[bj].x = cvt_pk_bf16(v0[0], v0[1]); w[bj].y = cvt_pk_bf16(v0[2], v0[3]); w[bj].z = cvt_pk_bf16(v1[0], v1[1]); w[bj].w = cvt_pk_bf16(v1[2], v1[3]); }
                store_lines(Ot + (size_t)((ai * HALF + m * 16) * ldc), L, w[0], w[1]);
                asm volatile("" ::: "memory"); }
    }
};
struct EpiResid16 {
    static constexpr bool PERM = true;
    const bf16_t* base; bf16_t* xo; float* out; int ldc; float* ssqp; int f32out;
    __device__ __forceinline__ static void addx(const u32x4 b, const f32x4 a0, const f32x4 a1, f32x4& x0, f32x4& x1) {
        x0[0] = __builtin_bit_cast(float, b.x << 16) + a0[0]; x0[1] = __builtin_bit_cast(float, b.x & 0xffff0000u) + a0[1]; x0[2] = __builtin_bit_cast(float, b.y << 16) + a0[2]; x0[3] = __builtin_bit_cast(float, b.y & 0xffff0000u) + a0[3];
        x1[0] = __builtin_bit_cast(float, b.z << 16) + a1[0]; x1[1] = __builtin_bit_cast(float, b.z & 0xffff0000u) + a1[1]; x1[2] = __builtin_bit_cast(float, b.w << 16) + a1[2]; x1[3] = __builtin_bit_cast(float, b.w & 0xffff0000u) + a1[3]; }
    __device__ __forceinline__ void operator()(f32x4 (&acc)[2][2][4][2], const Unit& u, int wr, int wc, int fr, int fq) const {
        const size_t tb = (size_t)(u.pm * BM) * ldc + u.pn * BM;
        const bf16_t* bs = base + tb;
        const unsigned lo = (unsigned)((wr * 64 + fr) * ldc + wc * 64 + 8 * fq);
        if (f32out != 0) {
            float* op = out + tb;
#pragma unroll
            for (int ai = 0; ai < 2; ++ai)
#pragma unroll
                for (int m = 0; m < 4; ++m) { const unsigned off = lo + (unsigned)((ai * HALF + m * 16) * ldc);
#pragma unroll
                    for (int bj = 0; bj < 2; ++bj) { const u32x4 b = *(const u32x4*)(bs + off + bj * 32); f32x4 x0, x1; addx(b, acc[ai][bj][m][0], acc[ai][bj][m][1], x0, x1);
                        *(f32x4*)(op + off + bj * 32) = x0; *(f32x4*)(op + off + bj * 32 + 4) = x1; }
                    asm volatile("" ::: "memory"); }
            return;
        }
        bf16_t* xp = xo + tb; const LineOffs L = line_offs(lo, ldc, fr);
#pragma unroll
        for (int aim = 0; aim < 4; ++aim) { const int ai = aim >> 1, mp = aim & 1;
            u32x4 bv[2][2];
#pragma unroll
            for (int mm = 0; mm < 2; ++mm)
#pragma unroll
                for (int bj = 0; bj < 2; ++bj) bv[mm][bj] = *(const u32x4*)(bs + lo + (unsigned)((ai * HALF + (2 * mp + mm) * 16) * ldc) + bj * 32);
#pragma unroll
            for (int mm = 0; mm < 2; ++mm) { const int m = 2 * mp + mm; float s = 0.f; u32x4 wv[2];
#pragma unroll
                for (int bj = 0; bj < 2; ++bj) { f32x4 x0, x1; addx(bv[mm][bj], acc[ai][bj][m][0], acc[ai][bj][m][1], x0, x1);
                    wv[bj].x = cvt_pk_bf16(x0[0], x0[1]); wv[bj].y = cvt_pk_bf16(x0[2], x0[3]); wv[bj].z = cvt_pk_bf16(x1[0], x1[1]); wv[bj].w = cvt_pk_bf16(x1[2], x1[3]);
                    s += ((x0[0] * x0[0] + x0[1] * x0[1]) + (x0[2] * x0[2] + x0[3] * x0[3])) + ((x1[0] * x1[0] + x1[1] * x1[1]) + (x1[2] * x1[2] + x1[3] * x1[3])); }
                store_lines(xp + (size_t)((ai * HALF + m * 16) * ldc), L, wv[0], wv[1]);
                s += __shfl_xor(s, 16); s += __shfl_xor(s, 32); if (fq == 0) ssqp[(size_t)(u.pm * BM + wr * 64 + fr + ai * HALF + m * 16) * 32 + u.pn * 4 + wc] = s; }
            asm volatile("" ::: "memory"); }
    }
};
__device__ __forceinline__ float silu_f(float x) { return x * __builtin_amdgcn_rcpf(1.0f + __builtin_amdgcn_exp2f(-1.4426950408889634f * x)); }
struct EpiGate {
    static constexpr bool PERM = true;
    bf16_t* act; int ldact; float* edge; const float* cw; const float* cb; int dff; PG8_LAS float* halo; const float* rstd; const unsigned* wmaxc;
    __device__ __forceinline__ void operator()(f32x4 (&acc)[2][2][4][2], const Unit& u, int wr, int wc, int fr, int fq) const {
        const int lane = fq * 16 + fr; const int colL = wc * 32 + 8 * fq; const int colG = u.pn * HALF + colL;
        f32x4 csc[2][2];
#pragma unroll
        for (int bj = 0; bj < 2; ++bj)
#pragma unroll
            for (int n = 0; n < 2; ++n) { const u32x4 mb = *(const u32x4*)(wmaxc + bj * dff + colG + 4 * n);
                csc[bj][n] = (f32x4){__builtin_bit_cast(float, mb.x), __builtin_bit_cast(float, mb.y), __builtin_bit_cast(float, mb.z), __builtin_bit_cast(float, mb.w)} * (1.0f / 127.0f); }
#pragma unroll
        for (int ai = 0; ai < 2; ++ai)
#pragma unroll
            for (int m = 0; m < 4; ++m) { const float rs = rstd[u.pm * BM + ai * HALF + wr * 64 + m * 16 + fr];
#pragma unroll
                for (int bj = 0; bj < 2; ++bj) { acc[ai][bj][m][0] *= csc[bj][0] * rs; acc[ai][bj][m][1] *= csc[bj][1] * rs; } }
#pragma unroll
        for (int ai = 0; ai < 2; ++ai) { const int q = 2 * ai + wr;
            if (fr == 0) { *(PG8_LAS f32x4*)(halo + (q * 2 + 0) * 128 + colL) = acc[ai][0][0][0]; *(PG8_LAS f32x4*)(halo + (q * 2 + 0) * 128 + colL + 4) = acc[ai][0][0][1]; }
            if (fr == 15) { *(PG8_LAS f32x4*)(halo + (q * 2 + 1) * 128 + colL) = acc[ai][0][3][0]; *(PG8_LAS f32x4*)(halo + (q * 2 + 1) * 128 + colL + 4) = acc[ai][0][3][1]; } }
        asm volatile("s_waitcnt lgkmcnt(0)" ::: "memory"); __builtin_amdgcn_s_barrier(); asm volatile("" ::: "memory");
        bf16_t* actp = act + (size_t)(u.pm * BM) * ldact + colG; const unsigned rlo = (unsigned)((wr * 64 + fr) * ldact);
#pragma unroll
        for (int ai = 0; ai < 2; ++ai) { const int q = 2 * ai + wr;
            typedef unsigned u32x2 __attribute__((ext_vector_type(2)));
            u32x2 pk[4][2];
#pragma unroll
            for (int n = 0; n < 2; ++n) {
                const f32x4 w0 = *(const f32x4*)(cw + colG + 4 * n), w1 = *(const f32x4*)(cw + dff + colG + 4 * n), w2 = *(const f32x4*)(cw + 2 * dff + colG + 4 * n), bb = *(const f32x4*)(cb + colG + 4 * n);
                f32x4 ht = *(PG8_LAS f32x4*)(halo + ((q > 0 ? q - 1 : 0) * 2 + 1) * 128 + colL + 4 * n), hb = *(PG8_LAS f32x4*)(halo + ((q < 3 ? q + 1 : 3) * 2 + 0) * 128 + colL + 4 * n);
                if (q == 0) ht = ht * 0.f; if (q == 3) hb = hb * 0.f;
                f32x4 pre[4];
#pragma unroll
                for (int j = 0; j < 4; ++j) {
                    float g[4], rr[4], rl[4];
#pragma unroll
                    for (int m = 0; m < 4; ++m) { g[m] = acc[ai][0][m][n][j]; rr[m] = dpp_ror1(g[m]); rl[m] = dpp_ror15(g[m]); }
#pragma unroll
                    for (int m = 0; m < 4; ++m) {
                        const float up = (fr > 0) ? rr[m] : (m > 0 ? rr[m > 0 ? m - 1 : 0] : ht[j]);
                        const float dn = (fr < 15) ? rl[m] : (m < 3 ? rl[m < 3 ? m + 1 : 3] : hb[j]);
                        pre[m][j] = w0[j] * up + w1[j] * g[m] + w2[j] * dn + bb[j];
                    }
                }
                if (q == 0 && fr == 0) { float* e = edge + (size_t)((u.pm * 2 + 0) * 3) * dff + colG + 4 * n;
                    *(f32x4*)(e) = acc[ai][0][0][n]; *(f32x4*)(e + dff) = pre[0]; *(f32x4*)(e + 2 * dff) = acc[ai][1][0][n]; }
                if (q == 3 && fr == 15) { float* e = edge + (size_t)((u.pm * 2 + 1) * 3) * dff + colG + 4 * n;
                    *(f32x4*)(e) = acc[ai][0][3][n]; *(f32x4*)(e + dff) = pre[3]; *(f32x4*)(e + 2 * dff) = acc[ai][1][3][n]; }
#pragma unroll
                for (int m = 0; m < 4; ++m) { const f32x4 v = acc[ai][1][m][n];
                    pk[m][n].x = cvt_pk_bf16(silu_f(pre[m][0]) * v[0], silu_f(pre[m][1]) * v[1]); pk[m][n].y = cvt_pk_bf16(silu_f(pre[m][2]) * v[2], silu_f(pre[m][3]) * v[3]); }
            }
#pragma unroll
            for (int m = 0; m < 4; ++m) { u32x4 w; w.x = pk[m][0].x; w.y = pk[m][0].y; w.z = pk[m][1].x; w.w = pk[m][1].y;
                *(u32x4*)(actp + rlo + (unsigned)((ai * HALF + m * 16) * ldact)) = w; }
        }
    }
};

template <class Epi, class Sched, bool I8 = false>
__device__ __forceinline__ void gemm_phase(PG8_LAS unsigned char* lds, const Gemm g, const Sched& S, const Epi& E) {
    typedef typename AccSel<I8>::T acc_t;
    const int tid = opq(threadIdx.x), wid = __builtin_amdgcn_readfirstlane(tid >> 6), lane = tid & 63, wr = wid >> 2, wc = wid & 3, fr = lane & 15, fq = lane >> 4;
    const int K = g.K, nt = K / BK, lda = g.lda;
    unsigned voffA[2], voffB[2];
#pragma unroll
    for (int i = 0; i < 2; ++i) { int R, C; stage_rc(tid * 16 + i * 8192, R, C); const int Rb = Epi::PERM ? (64 * (R >> 5) + perm32(R & 31)) : R;
        voffA[i] = (unsigned)(R * lda + C) * 2u; voffB[i] = (unsigned)(Rb * K + C) * 2u; }
    const size_t kstep = (size_t)(BK * 2);
    const size_t hstepA = (size_t)HALF * lda * 2, hstepB = (size_t)(Epi::PERM ? 32 : HALF) * K * 2;
    const size_t tstepA = 2 * hstepA, tstepB = (size_t)BM * K * 2;
    const unsigned ldsw = (unsigned)wid * 1024u;
    const int aoff = lds_byte(wr * 64 + fr, fq * 8), boff = lds_byte(wc * 32 + fr, fq * 8);
#define PG8_SA(b, h) (((b) * 2 + (h)) * HTB)
#define PG8_SB(b, h) ((4 + (b) * 2 + (h)) * HTB)
#define PG8_STAGE(bufoff, gbase, voff) do { _Pragma("unroll") for (int _i = 0; _i < 2; ++_i) \
        __builtin_amdgcn_global_load_lds((const unsigned*)((const char*)(gbase) + (voff)[_i]), (PG8_LAS unsigned*)(lds + (bufoff) + ldsw + _i * 8192), 16, 0, 0); } while (0)
#define PG8_LDA(dst, b, h) do { _Pragma("unroll") for (int m = 0; m < 4; ++m) _Pragma("unroll") for (int k = 0; k < 2; ++k) dst[m][k] = *(const PG8_LAS bf16x8*)(lds + PG8_SA(b, h) + aoff + m * 2048 + k * 1024); } while (0)
#define PG8_LDB(dst, b, h) do { _Pragma("unroll") for (int n = 0; n < 2; ++n) _Pragma("unroll") for (int k = 0; k < 2; ++k) dst[n][k] = *(const PG8_LAS bf16x8*)(lds + PG8_SB(b, h) + boff + n * 2048 + k * 1024); } while (0)
#define PG8_MMA(ai, bj, At, Bt) do { __builtin_amdgcn_s_setprio(1); _Pragma("unroll") for (int m = 0; m < 4; ++m) _Pragma("unroll") for (int n = 0; n < 2; ++n) _Pragma("unroll") for (int k = 0; k < 2; ++k) { \
        if constexpr (I8) acc[ai][bj][m][n] = __builtin_amdgcn_mfma_i32_16x16x64_i8(__builtin_bit_cast(i32x4, Bt[n][k]), __builtin_bit_cast(i32x4, At[m][k]), acc[ai][bj][m][n], 0, 0, 0); \
        else acc[ai][bj][m][n] = __builtin_amdgcn_mfma_f32_16x16x32_bf16(Bt[n][k], At[m][k], acc[ai][bj][m][n], 0, 0, 0); } __builtin_amdgcn_s_setprio(0); } while (0)
#define PG8_WAIT_V(n) asm volatile("s_waitcnt vmcnt(" #n ")" ::: "memory")
#define PG8_WAIT_L(n) asm volatile("s_waitcnt lgkmcnt(" #n ")" ::: "memory")
#define PG8_BAR __builtin_amdgcn_s_barrier()
#define PG8_SCHED __builtin_amdgcn_sched_barrier(0)
    Unit cur, nxt; int ui = 0;
    if (!S.next(0, cur)) return;
    acc_t acc[2][2][4][2];
{ float zf = 0.f; asm volatile("" : "+v"(zf));
    #pragma unroll
    for (int a = 0; a < 2; ++a)
#pragma unroll
        for (int b = 0; b < 2; ++b)
#pragma unroll
            for (int m = 0; m < 4; ++m)
#pragma unroll
                for (int n = 0; n < 2; ++n) acc[a][b][m][n] = __builtin_bit_cast(acc_t, (f32x4){zf, zf, zf, zf}); }
    bf16x8 At[4][2], B0[2][2], B1[2][2];
    const char* cA = (const char*)g.A + (size_t)cur.pm * tstepA; const char* cB = (const char*)g.Bt + (size_t)cur.pn * tstepB;
    S.a_ready(cur);
    PG8_STAGE(PG8_SB(0, 0), cB, voffB); PG8_STAGE(PG8_SB(0, 1), cB + hstepB, voffB); PG8_STAGE(PG8_SA(0, 0), cA, voffA); PG8_STAGE(PG8_SA(0, 1), cA + hstepA, voffA);
    if (wr == 1) PG8_BAR;
    PG8_WAIT_V(2); PG8_BAR;
    PG8_STAGE(PG8_SB(1, 0), cB + kstep, voffB); PG8_STAGE(PG8_SA(1, 0), cA + kstep, voffA); PG8_STAGE(PG8_SB(1, 1), cB + hstepB + kstep, voffB);
    PG8_WAIT_V(6); PG8_BAR;
    for (;;) {
        const bool has_next = S.next(ui + 1, nxt);
        const char* nA = has_next ? (const char*)g.A + (size_t)nxt.pm * tstepA : cA; const char* nB = has_next ? (const char*)g.Bt + (size_t)nxt.pn * tstepB : cB;
#pragma unroll 1
        for (int t = 0; t < nt; t += 2) {
            const bool last = (t == nt - 2);
            const char* a1 = cA + (size_t)(t + 1) * kstep;
            const char* a2 = last ? nA : cA + (size_t)(t + 2) * kstep; const char* b2 = last ? nB : cB + (size_t)(t + 2) * kstep;
            const char* a3 = a2 + kstep; const char* b3 = b2 + kstep;
            if (last && has_next) S.a_ready(nxt);
            PG8_LDB(B0, 0, 0); PG8_LDB(B1, 0, 1); PG8_SCHED; PG8_LDA(At, 0, 0); PG8_STAGE(PG8_SA(1, 1), a1 + hstepA, voffA);
            PG8_WAIT_V(8); PG8_WAIT_L(0); PG8_BAR; PG8_MMA(0, 0, At, B0); PG8_MMA(0, 1, At, B1); PG8_BAR; PG8_SCHED;
            PG8_LDA(At, 0, 1); PG8_STAGE(PG8_SB(0, 0), b2, voffB); PG8_STAGE(PG8_SB(0, 1), b2 + hstepB, voffB); PG8_STAGE(PG8_SA(0, 0), a2, voffA);
            PG8_WAIT_V(8); PG8_WAIT_L(0); PG8_BAR; PG8_MMA(1, 0, At, B0); PG8_MMA(1, 1, At, B1); PG8_BAR; PG8_SCHED;
            PG8_LDB(B0, 1, 0); PG8_LDB(B1, 1, 1); PG8_SCHED; PG8_LDA(At, 1, 0); PG8_STAGE(PG8_SA(0, 1), a2 + hstepA, voffA);
            PG8_WAIT_V(8); PG8_WAIT_L(0); PG8_BAR; PG8_MMA(0, 0, At, B0); PG8_MMA(0, 1, At, B1); PG8_BAR; PG8_SCHED;
            PG8_LDA(At, 1, 1); PG8_STAGE(PG8_SB(1, 0), b3, voffB); PG8_STAGE(PG8_SB(1, 1), b3 + hstepB, voffB); PG8_STAGE(PG8_SA(1, 0), a3, voffA);
            PG8_WAIT_V(8); PG8_WAIT_L(0); PG8_BAR; PG8_MMA(1, 0, At, B0); PG8_MMA(1, 1, At, B1); PG8_BAR; PG8_SCHED;
        }
        if (wr == 0) PG8_BAR;
        if constexpr (I8) { f32x4 accf[2][2][4][2];
#pragma unroll
            for (int a = 0; a < 2; ++a)
#pragma unroll
                for (int b = 0; b < 2; ++b)
#pragma unroll
                    for (int m = 0; m < 4; ++m)
#pragma unroll
                        for (int n = 0; n < 2; ++n) accf[a][b][m][n] = __builtin_convertvector(acc[a][b][m][n], f32x4);
            E(accf, cur, wr, wc, fr, fq); }
        else E(acc, cur, wr, wc, fr, fq);
        S.done(cur);
        if (!has_next) break;
{ float zf = 0.f; asm volatile("" : "+v"(zf));
        #pragma unroll
        for (int a = 0; a < 2; ++a)
#pragma unroll
            for (int b = 0; b < 2; ++b)
#pragma unroll
                for (int m = 0; m < 4; ++m)
#pragma unroll
                    for (int n = 0; n < 2; ++n) acc[a][b][m][n] = __builtin_bit_cast(acc_t, (f32x4){zf, zf, zf, zf}); }
        cur = nxt; cA = nA; cB = nB; ++ui;
        if (wr == 1) PG8_BAR;
    }
    PG8_WAIT_V(0);
    PG8_BAR;
#undef PG8_SA
#undef PG8_SB
#undef PG8_STAGE
#undef PG8_LDA
#undef PG8_LDB
#undef PG8_MMA
#undef PG8_WAIT_V
#undef PG8_WAIT_L
#undef PG8_BAR
#undef PG8_SCHED
}
}
namespace at {
using bf16 = unsigned short;
using bf16x8 = __attribute__((ext_vector_type(8))) short;
using s16x4  = __attribute__((ext_vector_type(4))) short;
using f32x16 = __attribute__((ext_vector_type(16))) float;
using u32x4  = __attribute__((ext_vector_type(4))) unsigned;
constexpr int DQK = 192, DV = 128, KVBLK = 64, NW = 8, QBLK = 32;
constexpr float SCALE = 0.07216878364870322f;
constexpr float THR = 8.f;
constexpr int LDQ = 1536, LDK = 2560, LDO = 2048;
constexpr int SHM_V = KVBLK * DV * 2, SHM_K = 12 * 2080;
constexpr int QR_OFF = 2 * SHM_V + 2 * SHM_K + NW * 64 * 4;
constexpr int SHM_ATTN = QR_OFF + NW * 4096;
#define SBAR() __builtin_amdgcn_sched_barrier(0)
constexpr int KPL = 2080;
__host__ __device__ __forceinline__ int k_st(int row, int c) { return (c >> 1) * KPL + row * 32 + (((c & 1) ^ ((row >> 3) & 1)) << 4); }
__host__ __device__ __forceinline__ int k_rd_base(int r32, int hi) { return r32 * 32 + ((hi ^ ((r32 >> 3) & 1)) << 4); }
__device__ __forceinline__ int crow(int r, int hi) { return (r & 3) + 8 * (r >> 2) + 4 * hi; }
__device__ __forceinline__ unsigned cvtpk(float lo, float hi) { unsigned r; asm volatile("v_cvt_pk_bf16_f32 %0, %1, %2" : "=v"(r) : "v"(lo), "v"(hi)); return r; }

__device__ __forceinline__ void partialSM(f32x16& p0, f32x16& p1, float& m_reg, float& mn, float& alpha) {
  constexpr float C = 1.0f;
  float pmax = p0[0];
#pragma unroll
  for (int r = 1; r < 16; ++r) pmax = fmaxf(pmax, p0[r]);
#pragma unroll
  for (int r = 0; r < 16; ++r) pmax = fmaxf(pmax, p1[r]);
  { auto rr = __builtin_amdgcn_permlane32_swap(__float_as_uint(pmax), __float_as_uint(pmax), false, false);
    pmax = fmaxf(__uint_as_float(rr[0]), __uint_as_float(rr[1])); }
  if (__builtin_expect(__all(pmax - m_reg <= THR * 1.4426950408889634f), 1)) { mn = m_reg; alpha = 1.f; }
  else { mn = fmaxf(m_reg, pmax); alpha = __builtin_amdgcn_exp2f((m_reg - mn) * C); m_reg = mn; }
  float mnC = -mn * C;
#pragma unroll
  for (int r = 0; r < 16; ++r) p0[r] = fmaf(p0[r], C, mnC);
#pragma unroll
  for (int r = 0; r < 16; ++r) p1[r] = fmaf(p1[r], C, mnC);
#pragma unroll
  for (int r = 0; r < 16; ++r) p0[r] = __builtin_amdgcn_exp2f(p0[r]);
}
__device__ __forceinline__ void partialSM_fast(f32x16& p0, f32x16& p1, float negMC) {
  (void)negMC; (void)p1;
#pragma unroll
  for (int r = 0; r < 16; ++r) p0[r] = __builtin_amdgcn_exp2f(p0[r]);
}
__device__ __forceinline__ void finishSM(f32x16& p0, f32x16& p1, float alpha, float& l_reg, bf16x8& pa0, bf16x8& pa1, bf16x8& pa2, bf16x8& pa3) {
#pragma unroll
  for (int r = 0; r < 16; ++r) p1[r] = __builtin_amdgcn_exp2f(p1[r]);
  float ps = 0;
#pragma unroll
  for (int r = 0; r < 16; ++r) ps += p0[r];
#pragma unroll
  for (int r = 0; r < 16; ++r) ps += p1[r];
  { auto rr = __builtin_amdgcn_permlane32_swap(__float_as_uint(ps), __float_as_uint(ps), false, false);
    ps = __uint_as_float(rr[0]) + __uint_as_float(rr[1]); }
  l_reg = l_reg * alpha + ps;
#define PK4(P, BASE, OUT) do { unsigned a0 = cvtpk(P[BASE + 0], P[BASE + 1]), a1 = cvtpk(P[BASE + 2], P[BASE + 3]);   \
    unsigned b0 = cvtpk(P[BASE + 4], P[BASE + 5]), b1 = cvtpk(P[BASE + 6], P[BASE + 7]);                              \
    auto r0 = __builtin_amdgcn_permlane32_swap(a0, b0, false, false); auto r1 = __builtin_amdgcn_permlane32_swap(a1, b1, false, false); \
    u32x4 w = {r0[0], r1[0], r0[1], r1[1]}; OUT = *reinterpret_cast<bf16x8*>(&w); } while (0)
  PK4(p0, 0, pa0); PK4(p0, 8, pa1); PK4(p1, 0, pa2); PK4(p1, 8, pa3);
#undef PK4
}
template <int OFF> __device__ __forceinline__ bf16x8 k_read(int kb) {
  bf16x8 r; asm volatile("ds_read_b128 %0, %1 offset:%2" : "=v"(r) : "v"(kb), "i"(OFF) : "memory"); return r;
}
__device__ __forceinline__ void qkt(f32x16& p0, f32x16& p1, int kb, const bf16x8* qr, int qb) {
  p0 = f32x16{}; p1 = f32x16{};
#define QK1(d0) { const bf16x8 b0 = *(const __attribute__((address_space(3))) bf16x8*)(kb + d0 * KPL), b1 = *(const __attribute__((address_space(3))) bf16x8*)(kb + d0 * KPL + 1024); \
    p0 = __builtin_amdgcn_mfma_f32_32x32x16_bf16(b0, qr[d0], p0, 0, 0, 0); p1 = __builtin_amdgcn_mfma_f32_32x32x16_bf16(b1, qr[d0], p1, 0, 0, 0); }
#define QK2(d0) { const bf16x8 b0 = *(const __attribute__((address_space(3))) bf16x8*)(kb + d0 * KPL), b1 = *(const __attribute__((address_space(3))) bf16x8*)(kb + d0 * KPL + 1024); \
    const bf16x8 qf = *(const __attribute__((address_space(3))) bf16x8*)(qb + (d0 - 8) * 1024); \
    p0 = __builtin_amdgcn_mfma_f32_32x32x16_bf16(b0, qf, p0, 0, 0, 0); p1 = __builtin_amdgcn_mfma_f32_32x32x16_bf16(b1, qf, p1, 0, 0, 0); }
  QK1(0) QK1(1) QK1(2) QK1(3) QK1(4) QK1(5) QK1(6) QK1(7) QK2(8) QK2(9) QK2(10) QK2(11)
#undef QK1
#undef QK2
}
__host__ __device__ __forceinline__ int v_st(int k, int c) { const int kk = (k & ~0xC) | ((k & 4) << 1) | ((k & 8) >> 1); return ((kk >> 3) * 4 + (c >> 5)) * 512 + ((kk & 7) * 32 + (c & 31)) * 2; }
__device__ __forceinline__ int v_rd_base(int lane) { return ((lane & 3) << 3) | (((lane >> 2) & 3) << 6) | (((lane >> 4) & 1) << 5) | (((lane >> 5) & 1) << 8); }
constexpr int v_rd_off(int d0, int ks, int half) { return d0 * 512 + ks * 4096 + half * 2048; }
template <int OFF> __device__ __forceinline__ s16x4 tr_read(int vb) {
  s16x4 r; asm volatile("ds_read_b64_tr_b16 %0, %1 offset:%2" : "=&v"(r) : "v"(vb), "i"(OFF) : "memory"); return r;
}
template <int D0> __device__ __forceinline__ void pv_one(f32x16& od, int vb, bf16x8 pa0, bf16x8 pa1, bf16x8 pa2, bf16x8 pa3) {
  const s16x4 l0 = tr_read<v_rd_off(D0, 0, 0)>(vb), h0 = tr_read<v_rd_off(D0, 0, 1)>(vb), l1 = tr_read<v_rd_off(D0, 1, 0)>(vb), h1 = tr_read<v_rd_off(D0, 1, 1)>(vb);
  const s16x4 l2 = tr_read<v_rd_off(D0, 2, 0)>(vb), h2 = tr_read<v_rd_off(D0, 2, 1)>(vb), l3 = tr_read<v_rd_off(D0, 3, 0)>(vb), h3 = tr_read<v_rd_off(D0, 3, 1)>(vb);
  asm volatile("s_waitcnt lgkmcnt(0)" ::: "memory"); SBAR();
#define PK(L, H) (bf16x8){L[0], L[1], L[2], L[3], H[0], H[1], H[2], H[3]}
  od = __builtin_amdgcn_mfma_f32_32x32x16_bf16(pa0, PK(l0, h0), od, 0, 0, 0);
  od = __builtin_amdgcn_mfma_f32_32x32x16_bf16(pa1, PK(l1, h1), od, 0, 0, 0);
  od = __builtin_amdgcn_mfma_f32_32x32x16_bf16(pa2, PK(l2, h2), od, 0, 0, 0);
  od = __builtin_amdgcn_mfma_f32_32x32x16_bf16(pa3, PK(l3, h3), od, 0, 0, 0);
#undef PK
}
__device__ __forceinline__ void pv_d0(f32x16* o, int vb, bf16x8 pa0, bf16x8 pa1, bf16x8 pa2, bf16x8 pa3) {
  pv_one<0>(o[0], vb, pa0, pa1, pa2, pa3); pv_one<1>(o[1], vb, pa0, pa1, pa2, pa3); pv_one<2>(o[2], vb, pa0, pa1, pa2, pa3); pv_one<3>(o[3], vb, pa0, pa1, pa2, pa3);
}

template <bool FAST>
__device__ __forceinline__ void attn_unit(const float negMC, const bf16* __restrict__ Qb, const bf16* __restrict__ Kh, const bf16* __restrict__ Vh, bf16* __restrict__ Ob, int seq, char* lds) {
  const int tid = opq(threadIdx.x), wid = tid >> 6, lane = tid & 63, r32 = lane & 31, hi = lane >> 5;
  char* V_lds = lds; char* K_lds = lds + 2 * SHM_V;
  float* ws = (float*)(lds + 2 * SHM_V + 2 * SHM_K) + wid * 64; float* li_l = ws; float* al_l = ws + 32;
  float m_reg = -1e30f, l_reg = 0; f32x16 o[4] = {}; bf16x8 qr[8];
  const bf16* Qw = Qb + (unsigned)((wid * QBLK + r32) * LDQ + hi * 8);
#pragma unroll
  for (int d0 = 0; d0 < 8; ++d0) qr[d0] = *reinterpret_cast<const bf16x8*>(Qw + d0 * 16);
  const int qb0 = (int)(uintptr_t)lds + QR_OFF + wid * 4096 + k_rd_base(r32, hi);
#pragma unroll
  for (int d0 = 8; d0 < 12; ++d0) *(__attribute__((address_space(3))) bf16x8*)(qb0 + (d0 - 8) * 1024) = *reinterpret_cast<const bf16x8*>(Qw + d0 * 16);
  const int sr = tid >> 4, sc = (tid & 15) * 8, vst0 = v_st(sr, sc), vst1 = v_st(32 + sr, sc);
  unsigned koff[3]; int kst[3];
#pragma unroll
  for (int i = 0; i < 3; ++i) { const int q = tid + 512 * i; koff[i] = (unsigned)((q / 24) * LDK + (q % 24) * 8); kst[i] = k_st(q / 24, q % 24); }
  const unsigned voff0 = (unsigned)(sr * LDK + sc), voff1 = (unsigned)((32 + sr) * LDK + sc);
  const int vb0 = (int)(uintptr_t)V_lds + v_rd_base(lane); const int kb0 = (int)(uintptr_t)K_lds + k_rd_base(r32, hi);
  struct { bf16x8 vs0, vs1, ks0, ks1, ks2; } sr_[1];
#define SLOAD(i, k0) do { const bf16* vt = Vh + (size_t)(k0) * LDK; const bf16* kt = Kh + (size_t)(k0) * LDK; \
    sr_[i].vs0 = *(const bf16x8*)(vt + voff0); sr_[i].vs1 = *(const bf16x8*)(vt + voff1); \
    sr_[i].ks0 = *(const bf16x8*)(kt + koff[0]); sr_[i].ks1 = *(const bf16x8*)(kt + koff[1]); sr_[i].ks2 = *(const bf16x8*)(kt + koff[2]); } while (0)
#define SWRITE(b, i) do { *(bf16x8*)(V_lds + (b) * SHM_V + vst0) = sr_[i].vs0; *(bf16x8*)(V_lds + (b) * SHM_V + vst1) = sr_[i].vs1; \
    *(bf16x8*)(K_lds + (b) * SHM_K + kst[0]) = sr_[i].ks0; *(bf16x8*)(K_lds + (b) * SHM_K + kst[1]) = sr_[i].ks1; *(bf16x8*)(K_lds + (b) * SHM_K + kst[2]) = sr_[i].ks2; } while (0)
#define SWAIT() do { if constexpr (SDEPTH == 2) asm volatile("s_waitcnt vmcnt(5)" ::: "memory"); else asm volatile("s_waitcnt vmcnt(0)" ::: "memory"); } while (0)
#define RESC(a) do { if (__any((a) < 1.f)) { if (hi == 0) al_l[r32] = (a); asm volatile("s_waitcnt lgkmcnt(0)" ::: "memory"); \
    _Pragma("unroll") for (int d = 0; d < 4; ++d) _Pragma("unroll") for (int r = 0; r < 16; ++r) o[d][r] *= al_l[crow(r, hi)]; } } while (0)
  f32x16 pA0, pA1, pB0, pB1; float mnA, mnB, alA, alB; bf16x8 pa0, pa1, pa2, pa3; const int NT = seq / KVBLK;
#define PSM(P0, P1, MN, AL) do { if constexpr (FAST) { partialSM_fast(P0, P1, negMC); AL = 1.f; } else partialSM(P0, P1, m_reg, MN, AL); } while (0)
#define RSC(AL) do { if constexpr (!FAST) RESC(AL); } while (0)
  SLOAD(0, 0); asm volatile("s_waitcnt vmcnt(0)" ::: "memory"); SWRITE(0, 0); __syncthreads();
  qkt(pA0, pA1, kb0, qr, qb0); PSM(pA0, pA1, mnA, alA);
  SLOAD(0, KVBLK);
  asm volatile("s_waitcnt vmcnt(0)" ::: "memory"); SWRITE(1, 0); __syncthreads();
  for (int j = 1; j + 1 < NT; j += 2) {
    SBAR(); qkt(pB0, pB1, kb0 + SHM_K, qr, qb0);
    finishSM(pA0, pA1, alA, l_reg, pa0, pa1, pa2, pa3); SBAR();
    SLOAD(0, (j + 1) * KVBLK); SBAR();
    pv_d0(o, vb0, pa0, pa1, pa2, pa3); PSM(pB0, pB1, mnB, alB);
    __syncthreads(); asm volatile("s_waitcnt vmcnt(0)" ::: "memory"); SWRITE(0, 0);
    RSC(alB); __syncthreads();
    SBAR(); qkt(pA0, pA1, kb0, qr, qb0);
    finishSM(pB0, pB1, alB, l_reg, pa0, pa1, pa2, pa3); SBAR();
    SLOAD(0, (j + 2) * KVBLK); SBAR();
    pv_d0(o, vb0 + (int)SHM_V, pa0, pa1, pa2, pa3); PSM(pA0, pA1, mnA, alA);
    __syncthreads(); asm volatile("s_waitcnt vmcnt(0)" ::: "memory"); SWRITE(1, 0);
    RSC(alA); __syncthreads();
  }
  SBAR(); qkt(pB0, pB1, kb0 + SHM_K, qr, qb0);
  finishSM(pA0, pA1, alA, l_reg, pa0, pa1, pa2, pa3); SBAR();
  pv_d0(o, vb0, pa0, pa1, pa2, pa3); PSM(pB0, pB1, mnB, alB);
  __syncthreads(); RSC(alB);
  finishSM(pB0, pB1, alB, l_reg, pa0, pa1, pa2, pa3); SBAR();
  pv_d0(o, vb0 + (int)SHM_V, pa0, pa1, pa2, pa3);
  if (hi == 0) li_l[r32] = l_reg; asm volatile("s_waitcnt lgkmcnt(0)" ::: "memory");
  bf16* Ow = Ob + (unsigned)(wid * QBLK * LDO + r32);
#pragma unroll
  for (int r = 0; r < 16; ++r) { const int orow = crow(r, hi); const float rl = __builtin_amdgcn_rcpf(li_l[orow]);
#pragma unroll
    for (int d0 = 0; d0 < 4; ++d0) { const unsigned w = cvtpk(o[d0][r] * rl, 0.f); Ow[(unsigned)(orow * LDO + d0 * 32)] = (bf16)(w & 0xffffu); } }
  __syncthreads();
#undef SLOAD
#undef SWRITE
#undef SWAIT
#undef RESC
#undef PSM
#undef RSC
}
}
namespace hy {
#define HY_LAS __attribute__((address_space(3)))
typedef unsigned short bf16;
typedef short bf16x8 __attribute__((ext_vector_type(8)));
typedef float f32x16 __attribute__((ext_vector_type(16)));
typedef unsigned u32x2 __attribute__((ext_vector_type(2)));
typedef unsigned u32x4 __attribute__((ext_vector_type(4)));
constexpr int L = 2048, NB = 24, CH = 512;
constexpr int RFS = 4112;
constexpr int ZROW = 4112;
constexpr int ZL_BYTES = NB * ZROW;
constexpr int RCS = 8256;
constexpr int RC_OFF = ZL_BYTES;
constexpr int HY_LDS_BYTES = RC_OFF + 4 * RCS;
__device__ __forceinline__ unsigned cvtpk(float lo, float hi) { unsigned r; asm volatile("v_cvt_pk_bf16_f32 %0, %1, %2" : "=v"(r) : "v"(lo), "v"(hi)); return r; }
__host__ __device__ __forceinline__ int frag_base(int tw, int r, int h) { const int a = (4 - (r & 3)) & 3; return RC_OFF + a * RCS + 2 * (2048 - tw - r + 8 * h - a); }
__host__ __device__ __forceinline__ int zfrag_base(int r, int h) { return (r < NB ? r : NB - 1) * ZROW + 16 * h; }

__device__ __forceinline__ bf16x8 ld_frag(HY_LAS unsigned char* lds, int off) {
    const u32x2 lo = *(const HY_LAS u32x2*)(lds + off), hi = *(const HY_LAS u32x2*)(lds + off + 8);
    u32x4 w = {lo.x, lo.y, hi.x, hi.y}; return *reinterpret_cast<bf16x8*>(&w);
}
__device__ __forceinline__ bf16x8 ld_b128(HY_LAS unsigned char* lds, int off) { return *(const HY_LAS bf16x8*)(lds + off); }

__device__ __forceinline__ void conv_unit(HY_LAS unsigned char* lds, const bf16* __restrict__ ZT, const bf16* __restrict__ RF, bf16* __restrict__ YC, int c, int half) {
    const int tid = opq(threadIdx.x), wid = tid >> 6, lane = tid & 63, r = lane & 31, h = lane >> 5;
    { const u32x4* src = (const u32x4*)(ZT + (size_t)c * NB * L);
#pragma unroll
      for (int i = 0; i < 12; ++i) { const int q = tid + 512 * i; const u32x4 v = src[q]; *(HY_LAS u32x4*)(lds + (q >> 8) * ZROW + (q & 255) * 16) = v; } }
    { const bf16* rf = RF + (size_t)c * RFS;
      for (int ch = tid; ch < RFS / 8; ch += 512) {
          const u32x4 v = *(const u32x4*)(rf + ch * 8); const unsigned w[4] = {v.x, v.y, v.z, v.w};
#pragma unroll
          for (int j = 0; j < 8; ++j) { const unsigned short e = (unsigned short)((w[j >> 1] >> ((j & 1) * 16)) & 0xffffu); const int idx = ch * 8 + j;
#pragma unroll
              for (int a = 0; a < 4; ++a) if (idx - a >= 0) *(HY_LAS unsigned short*)(lds + RC_OFF + a * RCS + 2 * (idx - a)) = e; } } }
    __syncthreads();
    const int tw = half * 1024 + wid * 128;
    const int fb = frag_base(tw, r, h), zb = zfrag_base(r, h);
    f32x16 acc[4] = {};
    bf16x8 S0[2], S1[2], S2[2], S3[2], Bc[2], Bn[2];
#define HY_LDG(S, d) do { S[0] = ld_frag(lds, fb + 64 * (d)); S[1] = ld_frag(lds, fb + 64 * (d) + 32); } while (0)
#define HY_LDB(Bx, n) do { Bx[0] = ld_b128(lds, zb + 64 * (n)); Bx[1] = ld_b128(lds, zb + 64 * (n) + 32); } while (0)
#define HY_MM(i, S, Bx) do { acc[i] = __builtin_amdgcn_mfma_f32_32x32x16_bf16(S[0], Bx[0], acc[i], 0, 0, 0); acc[i] = __builtin_amdgcn_mfma_f32_32x32x16_bf16(S[1], Bx[1], acc[i], 0, 0, 0); } while (0)
#define HY_ITER(n, Sa, Sb, Sc, Sd, Bcur, Bnext) do { HY_LDG(Sa, (n)); if ((n) + 1 < 64) HY_LDB(Bnext, (n) + 1); \
        HY_MM(1, Sb, Bcur); HY_MM(2, Sc, Bcur); HY_MM(3, Sd, Bcur); HY_MM(0, Sa, Bcur); } while (0)
    HY_LDG(S3, -1); HY_LDG(S2, -2); HY_LDG(S1, -3); HY_LDB(Bc, 0);
    for (int n = 0; n < 64; n += 4) {
        HY_ITER(n, S0, S3, S2, S1, Bc, Bn);
        HY_ITER(n + 1, S1, S0, S3, S2, Bn, Bc);
        HY_ITER(n + 2, S2, S1, S0, S3, Bc, Bn);
        HY_ITER(n + 3, S3, S2, S1, S0, Bn, Bc);
    }
#undef HY_LDG
#undef HY_LDB
#undef HY_MM
#undef HY_ITER
    if (r < NB) { bf16* yp = YC + ((size_t)c * NB + r) * L + tw + 4 * h;
#pragma unroll
        for (int i = 0; i < 4; ++i)
#pragma unroll
            for (int q4 = 0; q4 < 4; ++q4) { u32x2 w; w.x = cvtpk(acc[i][4 * q4 + 0], acc[i][4 * q4 + 1]); w.y = cvtpk(acc[i][4 * q4 + 2], acc[i][4 * q4 + 3]);
                *(u32x2*)(yp + 32 * i + 8 * q4) = w; } }
    __syncthreads();
}
}
constexpr int NWAVES = 8;
#ifndef MK_ONE_LAUNCH
#define MK_ONE_LAUNCH 1
#endif
constexpr int DM = 2048, NSEQ = 24, SEQ = 2048, M = NSEQ * SEQ, MP = 8 * SEQ;
constexpr int DEPTH = 4;
constexpr int DIN = 2880, DINP = 3072;
constexpr int O_CQ = 512, O_CKV = 1024, O_KPE = 1280, O_HY = 1344;
constexpr int NH = 8, NQ = 1536, NKVP = 2560, KVHS = 320;
constexpr int DFF = 5632, NUP = 11264, HYC = 512;
constexpr float EPS = 1e-6f;
constexpr int NPH = 11;
constexpr size_t WS_CTL = 0, CTL_BYTES = 1u << 20;
constexpr size_t SZ_BTIN = (size_t)DINP * DM * 2, SZ_BTUQ = (size_t)NQ * 512 * 2, SZ_BTKV = (size_t)NKVP * 256 * 2, SZ_BTOUT = (size_t)DM * DM * 2, SZ_BTUP = (size_t)NUP * DM * 2, SZ_BTDN = (size_t)DM * DFF * 2;
constexpr size_t WS_BTIN = WS_CTL + CTL_BYTES, WS_BTUQ = WS_BTIN + SZ_BTIN, WS_BTKV = WS_BTUQ + SZ_BTUQ, WS_BTOUT = WS_BTKV + SZ_BTKV, WS_BTUP = WS_BTOUT + SZ_BTOUT, WS_BTDN = WS_BTUP + SZ_BTUP;
constexpr size_t WS_RF = WS_BTDN + SZ_BTDN, SZ_RF = (size_t)HYC * hy::RFS * 2;
constexpr size_t WS_H = WS_RF + SZ_RF, SZ_H = (size_t)M * DM * 2;
constexpr size_t WS_PROJ = WS_H + SZ_H, SZ_PROJ = (size_t)M * DINP * 2;
constexpr size_t WS_Q = WS_PROJ + SZ_PROJ, SZ_Q = (size_t)M * NQ * 2;
constexpr size_t WS_KV = WS_Q + SZ_Q, SZ_KV = (size_t)M * NKVP * 2;
constexpr size_t WS_ZT = WS_KV + SZ_KV, SZ_ZT = (size_t)HYC * NSEQ * SEQ * 2;
constexpr size_t WS_X0 = WS_ZT + SZ_ZT, WS_YC = WS_X0 + SZ_ZT;
constexpr size_t WS_EDGE = WS_YC + SZ_ZT, SZ_EDGE = (size_t)(M / 256) * 2 * 3 * DFF * 4;
constexpr size_t WS_ROPE = WS_EDGE + SZ_EDGE, SZ_ROPE = (size_t)SEQ * 64 * 4;
constexpr size_t WS_SSQP = WS_ROPE + SZ_ROPE, SZ_SSQP = (size_t)M * 32 * 4;
constexpr size_t WS_RSTD = WS_SSQP + SZ_SSQP, SZ_RSTD = (size_t)M * 4;
constexpr size_t WS_XQ = WS_RSTD + SZ_RSTD, SZ_XQ = (size_t)M * DM;
constexpr size_t WS_END = WS_XQ + SZ_XQ;
constexpr size_t WS_ACT = WS_PROJ;
static_assert((size_t)M * DFF * 2 <= SZ_PROJ + SZ_Q + SZ_KV, "ACT overlay");
constexpr size_t WS_XB2 = WS_ACT + (size_t)M * DFF * 2;
static_assert(WS_XB2 + (size_t)M * DM * 2 <= WS_EDGE && WS_XB2 % 256 == 0, "XB2 overlay");
static_assert(WS_BTIN % 256 == 0 && WS_RF % 256 == 0 && WS_H % 256 == 0 && WS_PROJ % 256 == 0 && WS_Q % 256 == 0 && WS_KV % 256 == 0 && WS_ZT % 256 == 0 && WS_EDGE % 256 == 0, "alignment");
constexpr int CW_WMAXC = 65536;
constexpr int CW_WMAX = 1024;
constexpr int CW_BAR = 4096;
constexpr int RING_BYTES = 135168;
constexpr int HALO_OFF = RING_BYTES, HALO_BYTES = 4096;
constexpr int MISC_OFF = HALO_OFF + HALO_BYTES;
constexpr int LDS_BYTES = 147456;
static_assert(hy::HY_LDS_BYTES <= RING_BYTES && at::SHM_ATTN <= RING_BYTES && MISC_OFF + 256 <= LDS_BYTES, "LDS map");

#define GAS __attribute__((address_space(1)))
#define LAS __attribute__((address_space(3)))
typedef unsigned short bf16;
typedef unsigned v4u __attribute__((ext_vector_type(4)));
typedef unsigned v2u __attribute__((ext_vector_type(2)));
typedef float f32x4 __attribute__((ext_vector_type(4)));
#define LDS_WAIT() asm volatile("s_waitcnt lgkmcnt(0)" ::: "memory")
__device__ __forceinline__ unsigned f2bf(float f) { unsigned u = __builtin_bit_cast(unsigned, f); return (u + 0x7fffu + ((u >> 16) & 1u)) >> 16; }
__device__ __forceinline__ unsigned pk2(float lo, float hi) { return f2bf(lo) | (f2bf(hi) << 16); }
__device__ __forceinline__ float bf2f(unsigned short b) { return __builtin_bit_cast(float, (unsigned)b << 16); }
__device__ __forceinline__ float bflo(unsigned w) { return __builtin_bit_cast(float, w << 16); }
__device__ __forceinline__ float bfhi(unsigned w) { return __builtin_bit_cast(float, w & 0xffff0000u); }
__device__ __forceinline__ float wave_sum(float v) {
#pragma unroll
    for (int o = 1; o < 64; o <<= 1) v += __shfl_xor(v, o);
    return v;
}

#define XB_TMO      128
#define XB_XCNT(j)  (256  + 64 * (j))
#define XB_XSUB(j)  (1280 + 64 * (j))
#define XB_XGEN(j)  (2304 + 64 * (j))
#define XB_TOP      3328
#define XB_TOPGEN   3392
#define XCD_BAR_WORDS 3456
#define XB_SPIN_CAP (1u << 18)
__device__ __forceinline__ unsigned xb_ld(unsigned* p)              { return __hip_atomic_load(p, __ATOMIC_RELAXED, __HIP_MEMORY_SCOPE_AGENT); }
__device__ __forceinline__ unsigned xb_add(unsigned* p, unsigned v) { return __hip_atomic_fetch_add(p, v, __ATOMIC_RELAXED, __HIP_MEMORY_SCOPE_AGENT); }
__device__ __forceinline__ unsigned xb_xcc_id() { return (unsigned)__builtin_amdgcn_s_getreg((3 << 11) | 20) & 0xFu; }
#define XB_SPIN(cond, bar) do { unsigned _sp = 0; while (cond) { __builtin_amdgcn_s_sleep(1); \
    if ((++_sp & 255u) == 0u) { if (xb_ld(&(bar)[XB_TMO])) break; if (_sp > XB_SPIN_CAP) { atomicAdd(&(bar)[XB_TMO], 1u); break; } } } } while (0)
struct XcdBarrier { unsigned* bar; unsigned x; volatile LAS unsigned* st; };
__device__ __forceinline__ XcdBarrier xcd_barrier_post(unsigned* bar, volatile LAS unsigned* st) {
    XcdBarrier b; b.bar = bar; b.x = xb_xcc_id(); b.st = st;
    if (threadIdx.x == 0) (void)xb_add(&bar[XB_XCNT(b.x)], 1u);
    return b;
}
__device__ __forceinline__ void xcd_barrier_complete(unsigned* bar, unsigned x, unsigned& nloc, unsigned& nx) {
    const unsigned G = gridDim.x * gridDim.y * gridDim.z;
    unsigned sum, cnt, mine, sp = 0u;
    for (;;) {
        sum = 0u; cnt = 0u; mine = 0u;
#pragma unroll
        for (unsigned j = 0; j < 16; ++j) { const unsigned c = xb_ld(&bar[XB_XCNT(j)]); sum += c; cnt += (c > 0u) ? 1u : 0u; mine = (j == x) ? c : mine; }
        if (sum == G) break;
        __builtin_amdgcn_s_sleep(1);
        if ((++sp & 255u) == 0u) { if (xb_ld(&bar[XB_TMO])) break; if (sp > XB_SPIN_CAP) { atomicAdd(&bar[XB_TMO], 1u); break; } }
    }
    nloc = mine > 0u ? mine : 1u; nx = cnt > 0u ? cnt : 1u;
}
__device__ __forceinline__ void xcd_barrier(const XcdBarrier& b) {
    asm volatile("s_waitcnt vmcnt(0)" ::: "memory");
    __syncthreads();
    if (threadIdx.x == 0) {
        unsigned* bar = b.bar;
        __builtin_amdgcn_s_waitcnt(0);
        unsigned nloc = b.st[0], nx = b.st[1];
        if (nloc == 0u) { xcd_barrier_complete(bar, b.x, nloc, nx); b.st[0] = nloc; b.st[1] = nx; }
        const unsigned old = xb_add(&bar[XB_XSUB(b.x)], 1u);
        const unsigned gen = old / nloc;
        if (old + 1u == (gen + 1u) * nloc) {
            __builtin_amdgcn_fence(__ATOMIC_RELEASE, "agent");
            asm volatile("s_waitcnt vmcnt(0)" ::: "memory");
            const unsigned og = xb_add(&bar[XB_TOP], 1u);
            const unsigned tg = og / nx;
            if (og + 1u == (tg + 1u) * nx) xb_add(&bar[XB_TOPGEN], 1u);
            else XB_SPIN(xb_ld(&bar[XB_TOPGEN]) == tg, bar);
            __builtin_amdgcn_fence(__ATOMIC_ACQUIRE, "agent");
            xb_add(&bar[XB_XGEN(b.x)], 1u);
            asm volatile("s_waitcnt vmcnt(0)" ::: "memory");
        } else {
            XB_SPIN(xb_ld(&bar[XB_XGEN(b.x)]) == gen, bar);
            __builtin_amdgcn_fence(__ATOMIC_ACQUIRE, "agent");
            asm volatile("s_waitcnt vmcnt(0)" ::: "memory");
        }
    }
    __syncthreads();
}

struct Frame {
    LAS unsigned char* lds;
    int tid, lane, wave, vcu, G;
};
enum { I_XP = 0, I_XS, I_ANG, I_WIN, I_PW, I_PS, I_QNG, I_WUQ, I_KVNG, I_WUKV, I_QHG, I_KHG, I_HCW, I_HCB, I_FW1, I_FB1, I_FFR, I_FW2, I_FB2, I_FW3, I_FB3, I_HBIAS, I_GNG, I_WOUT, I_FNG, I_WUP, I_FCW, I_FCB, I_WDN, N_IN };
struct Args { const float* in[N_IN]; float* out; unsigned char* ws; int ph_lo, ph_hi; };
static_assert(sizeof(Args) == (N_IN + 2) * 8 + 8, "Args has no padding");

__device__ __forceinline__ void cvt_item(const float* __restrict__ W, int ldw, int K, bf16* WT, int dst_n0, int src_n0, int k0, const float* __restrict__ ks, LAS float* scr, int lane) {
#pragma unroll
    for (int i = 0; i < 32; ++i) { const int kk = 2 * i + (lane >> 5); float v = W[(size_t)(k0 + kk) * ldw + src_n0 + (lane & 31)]; if (ks) v *= ks[k0 + kk]; scr[kk * 33 + (lane & 31)] = v; }
    LDS_WAIT(); asm volatile("" ::: "memory");
    const int c = lane & 7;
#pragma unroll
    for (int j = 0; j < 4; ++j) { const int n = (lane >> 3) + 8 * j; const LAS float* s = scr + (8 * c) * 33 + n;
        v4u o; o.x = pk2(s[0 * 33], s[1 * 33]); o.y = pk2(s[2 * 33], s[3 * 33]); o.z = pk2(s[4 * 33], s[5 * 33]); o.w = pk2(s[6 * 33], s[7 * 33]);
        *(v4u*)(WT + (size_t)(dst_n0 + n) * K + k0 + 8 * c) = o; }
    LDS_WAIT(); asm volatile("" ::: "memory");
}
struct CvtTile { const float* W; const float* ks; bf16* WT; int ldw, K, src_n0, k0, ncols; int dst[4]; };
__device__ __forceinline__ void cvt_tile(Frame& F, const CvtTile& d) {
    LAS float* T = (LAS float*)F.lds;
#pragma unroll
    for (int i = 0; i < 8; ++i) { const int q = F.tid + 512 * i, row = q >> 5, c4 = q & 31;
        f32x4 v = {0.f, 0.f, 0.f, 0.f};
        if (d.src_n0 + 4 * c4 < d.ncols) v = *(const f32x4*)(d.W + (size_t)(d.k0 + row) * d.ldw + d.src_n0 + 4 * c4);
        if (d.ks) v *= d.ks[d.k0 + row];
        LAS float* t = T + row * 129 + 4 * c4; t[0] = v.x; t[1] = v.y; t[2] = v.z; t[3] = v.w; }
    __syncthreads();
#pragma unroll
    for (int i = 0; i < 4; ++i) { const int n = (F.tid >> 4) + 32 * i, kc = F.tid & 15;
        if (d.src_n0 + n < d.ncols) { const LAS float* s = T + (8 * kc) * 129 + n;
            v4u o; o.x = pk2(s[0], s[129]); o.y = pk2(s[2 * 129], s[3 * 129]); o.z = pk2(s[4 * 129], s[5 * 129]); o.w = pk2(s[6 * 129], s[7 * 129]);
            *(v4u*)(d.WT + (size_t)(d.dst[i] + (n & 31)) * d.K + d.k0 + 8 * kc) = o; } }
    __syncthreads();
}
__device__ __forceinline__ void absmax_tile(Frame& F, const float* __restrict__ W, const float* __restrict__ ks, int ldw, int src_n0, int k0, unsigned* outc) {
    LAS float* P = (LAS float*)F.lds;
    f32x4 m = {0.f, 0.f, 0.f, 0.f};
#pragma unroll
    for (int i = 0; i < 8; ++i) { const int q = F.tid + 512 * i, row = q >> 5, c4 = q & 31;
        const f32x4 v = *(const f32x4*)(W + (size_t)(k0 + row) * ldw + src_n0 + 4 * c4) * ks[k0 + row];
        m.x = fmaxf(m.x, fabsf(v.x)); m.y = fmaxf(m.y, fabsf(v.y)); m.z = fmaxf(m.z, fabsf(v.z)); m.w = fmaxf(m.w, fabsf(v.w)); }
    *(LAS f32x4*)(P + (F.tid >> 5) * 128 + 4 * (F.tid & 31)) = m;
    __syncthreads();
    if (F.tid < 128) { float c = P[F.tid];
#pragma unroll
        for (int g = 1; g < 16; ++g) c = fmaxf(c, P[g * 128 + F.tid]);
        atomicMax(outc + src_n0 + F.tid, __builtin_bit_cast(unsigned, c)); }
    __syncthreads();
}
__device__ __forceinline__ unsigned q8(float v) { const int q = (int)__builtin_rintf(v); return (unsigned)(q < -127 ? -127 : (q > 127 ? 127 : q)) & 0xffu; }
__device__ __forceinline__ void cvtq_tile(Frame& F, const float* __restrict__ W, const float* __restrict__ ks, int ldw, int K, unsigned char* WT, int src_n0, int k0, int dst0, const unsigned* __restrict__ wmaxc) {
    LAS float* T = (LAS float*)F.lds;
    f32x4 inv4; { const v4u mb = *(const v4u*)(wmaxc + src_n0 + 4 * (F.tid & 31));
        inv4.x = 127.0f / fmaxf(__builtin_bit_cast(float, mb.x), 1e-30f); inv4.y = 127.0f / fmaxf(__builtin_bit_cast(float, mb.y), 1e-30f); inv4.z = 127.0f / fmaxf(__builtin_bit_cast(float, mb.z), 1e-30f); inv4.w = 127.0f / fmaxf(__builtin_bit_cast(float, mb.w), 1e-30f); }
#pragma unroll
    for (int i = 0; i < 8; ++i) { const int q = F.tid + 512 * i, row = q >> 5, c4 = q & 31;
        const f32x4 v = *(const f32x4*)(W + (size_t)(k0 + row) * ldw + src_n0 + 4 * c4) * ks[k0 + row] * inv4;
        LAS float* t = T + row * 129 + 4 * c4; t[0] = v.x; t[1] = v.y; t[2] = v.z; t[3] = v.w; }
    __syncthreads();
#pragma unroll
    for (int i = 0; i < 2; ++i) { const int n = (F.tid >> 3) + 64 * i, kc = F.tid & 7;
        const LAS float* s = T + (16 * kc) * 129 + n; unsigned w[4];
#pragma unroll
        for (int j = 0; j < 4; ++j) w[j] = q8(s[(4 * j) * 129]) | (q8(s[(4 * j + 1) * 129]) << 8) | (q8(s[(4 * j + 2) * 129]) << 16) | (q8(s[(4 * j + 3) * 129]) << 24);
        v4u o; o.x = w[0]; o.y = w[1]; o.z = w[2]; o.w = w[3];
        *(v4u*)(WT + (size_t)(dst0 + 64 * (n >> 5) + (n & 31)) * K + k0 + 16 * kc) = o; }
    __syncthreads();
}
__device__ __forceinline__ void xq_row(const bf16* __restrict__ xrow, unsigned char* qrow, const float* __restrict__ ssq32, float* rowf, float s_w, int lane) {
    v4u v[4]; float m = 0.f;
#pragma unroll
    for (int j = 0; j < 4; ++j) { v[j] = *(const v4u*)(xrow + 8 * (lane + 64 * j)); const unsigned w[4] = {v[j].x, v[j].y, v[j].z, v[j].w};
#pragma unroll
        for (int i = 0; i < 4; ++i) m = fmaxf(m, fmaxf(fabsf(bflo(w[i])), fabsf(bfhi(w[i])))); }
    float ss = (lane < 32) ? ssq32[lane] : 0.f;
#pragma unroll
    for (int o = 1; o < 64; o <<= 1) { m = fmaxf(m, __shfl_xor(m, o)); ss += __shfl_xor(ss, o); }
    m = fmaxf(m, 1e-30f); const float inv = 127.0f / m;
    if (lane == 0) *rowf = (1.0f / sqrtf(ss * (1.f / DM) + EPS)) * (m * (1.0f / 127.0f)) * s_w;
#pragma unroll
    for (int j = 0; j < 4; ++j) { const unsigned w[4] = {v[j].x, v[j].y, v[j].z, v[j].w}; v2u o;
        o.x = q8(bflo(w[0]) * inv) | (q8(bfhi(w[0]) * inv) << 8) | (q8(bflo(w[1]) * inv) << 16) | (q8(bfhi(w[1]) * inv) << 24);
        o.y = q8(bflo(w[2]) * inv) | (q8(bfhi(w[2]) * inv) << 8) | (q8(bflo(w[3]) * inv) << 16) | (q8(bfhi(w[3]) * inv) << 24);
        *(v2u*)(qrow + 8 * (lane + 64 * j)) = o; }
}
__device__ __forceinline__ void xb_row(const float* xrow, bf16* orow, float* rstd, int lane) {
    const f32x4* xr = (const f32x4*)xrow + lane;
    f32x4 v[8]; float s = 0.f;
#pragma unroll
    for (int j = 0; j < 8; ++j) { v[j] = xr[64 * j]; s += (v[j].x * v[j].x + v[j].y * v[j].y) + (v[j].z * v[j].z + v[j].w * v[j].w); }
    const float r = 1.0f / sqrtf(wave_sum(s) * (1.f / DM) + EPS);
    if (lane == 0) *rstd = r;
    v2u* o8 = (v2u*)orow + lane;
#pragma unroll
    for (int j = 0; j < 8; ++j) { v2u w; w.x = pk2(v[j].x, v[j].y); w.y = pk2(v[j].z, v[j].w); o8[64 * j] = w; }
}
__device__ __forceinline__ void rstd_from_partials(const float* __restrict__ ssqp, float* rstd, size_t gtid, size_t gthreads) {
    for (size_t r = gtid; r < (size_t)M; r += gthreads) { const f32x4* p = (const f32x4*)(ssqp + r * 32); f32x4 a = p[0];
#pragma unroll
        for (int i = 1; i < 8; ++i) a += p[i];
        rstd[r] = 1.0f / sqrtf(((a.x + a.y) + (a.z + a.w)) * (1.f / DM) + EPS); }
}
__device__ __forceinline__ void tile_norm_store(LAS float* tile, bf16* dst, int row0, int col_off, int wave, int lane) {
#pragma unroll
    for (int i = 0; i < 8; ++i) { const int t = wave * 8 + i;
        const f32x4 a = *(LAS f32x4*)(tile + t * 512 + 8 * lane), b = *(LAS f32x4*)(tile + t * 512 + 8 * lane + 4);
        const float s = (a.x * a.x + a.y * a.y) + (a.z * a.z + a.w * a.w) + (b.x * b.x + b.y * b.y) + (b.z * b.z + b.w * b.w);
        const float rstd = 1.0f / sqrtf(wave_sum(s) * (1.f / 512.f) + EPS);
        v4u o; o.x = pk2(a.x * rstd, a.y * rstd); o.y = pk2(a.z * rstd, a.w * rstd); o.z = pk2(b.x * rstd, b.y * rstd); o.w = pk2(b.z * rstd, b.w * rstd);
        *(v4u*)(dst + (size_t)(row0 + t) * DM + col_off + 8 * lane) = o; }
}
__device__ __forceinline__ void poolfold_item(Frame& F, const float* __restrict__ win, const float* __restrict__ pw, const float* __restrict__ ps, const float* __restrict__ g1, bf16* BtIn, int g, int kb) {
    LAS float* At = (LAS float*)F.lds; LAS float* Bt = (LAS float*)(F.lds + 32768);
    const int k0 = 64 * kb;
#pragma unroll
    for (int i = 0; i < 4; ++i) { const int q = F.tid + 512 * i, row = q >> 5, c4 = q & 31; *(LAS f32x4*)(At + row * 128 + 4 * c4) = *(const f32x4*)(win + (size_t)(k0 + row) * DIN + 128 * g + 4 * c4) * g1[k0 + row]; }
#pragma unroll
    for (int i = 0; i < 8; ++i) { const int q = F.tid + 512 * i, row = q >> 5, c4 = q & 31; *(LAS f32x4*)(Bt + row * 128 + 4 * c4) = *(const f32x4*)(pw + (size_t)(g * 128 + row) * 128 + 4 * c4); }
    __syncthreads();
    const int n = F.tid & 127, kg = F.tid >> 7;
    float acc[16];
#pragma unroll
    for (int i = 0; i < 16; ++i) acc[i] = 0.f;
    for (int j = 0; j < 128; j += 4) {
        const float b0 = Bt[(j + 0) * 128 + n], b1 = Bt[(j + 1) * 128 + n], b2 = Bt[(j + 2) * 128 + n], b3 = Bt[(j + 3) * 128 + n];
#pragma unroll
        for (int i = 0; i < 16; ++i) { const f32x4 a = *(LAS f32x4*)(At + (kg * 16 + i) * 128 + j); acc[i] += a.x * b0 + a.y * b1 + a.z * b2 + a.w * b3; }
    }
    const float sc = ps[128 * g + n];
    v4u o0, o1;
    o0.x = pk2(acc[0] * sc, acc[1] * sc); o0.y = pk2(acc[2] * sc, acc[3] * sc); o0.z = pk2(acc[4] * sc, acc[5] * sc); o0.w = pk2(acc[6] * sc, acc[7] * sc);
    o1.x = pk2(acc[8] * sc, acc[9] * sc); o1.y = pk2(acc[10] * sc, acc[11] * sc); o1.z = pk2(acc[12] * sc, acc[13] * sc); o1.w = pk2(acc[14] * sc, acc[15] * sc);
    bf16* dst = BtIn + (size_t)(128 * g + n) * DM + k0 + kg * 16;
    *(v4u*)dst = o0; *(v4u*)(dst + 8) = o1;
    __syncthreads();
}
__device__ __forceinline__ void filter_item(Frame& F, const float* __restrict__ w1, const float* __restrict__ b1, const float* __restrict__ fr, const float* __restrict__ w2, const float* __restrict__ b2,
                                            const float* __restrict__ w3, const float* __restrict__ b3, const float* __restrict__ hbias, bf16* RF, int fi) {
    LAS float* ZF = (LAS float*)F.lds; LAS float* H1 = ZF + 512; LAS float* H2 = ZF + 1536; LAS float* W1s = ZF + 2560; LAS float* W2s = ZF + 3712;
    const int t0 = 16 * fi;
    for (int q = F.tid; q < 272; q += 512) *(LAS f32x4*)(W1s + 4 * q) = *(const f32x4*)(w1 + 4 * q);
#pragma unroll
    for (int i = 0; i < 2; ++i) { const int q = F.tid + 512 * i; *(LAS f32x4*)(W2s + 4 * q) = *(const f32x4*)(w2 + 4 * q); }
    if (F.tid < 272) { const int tt = F.tid / 17, f = F.tid % 17; const float t = (float)(t0 + tt);
        float v;
        if (f == 0) v = t / 2047.0f;
        else { const int j = (f - 1) & 7; const float band = 1e-4f + (float)j * ((7.0f - 1e-4f) / 7.0f); const float w = (6.283185307179586f * t) / 2048.0f; const float a = band * w; v = (f <= 8) ? __cosf(a) : -__sinf(a); }
        ZF[tt * 17 + f] = v; }
    __syncthreads();
#pragma unroll
    for (int rep = 0; rep < 2; ++rep) { const int p = F.tid + 512 * rep, tt = p >> 6, j = p & 63; float s = b1[j];
#pragma unroll
        for (int i = 0; i < 17; ++i) s += ZF[tt * 17 + i] * W1s[i * 64 + j];
        H1[tt * 64 + j] = __sinf(fr[j] * s); }
    __syncthreads();
#pragma unroll
    for (int rep = 0; rep < 2; ++rep) { const int p = F.tid + 512 * rep, tt = p >> 6, j = p & 63; float s = b2[j];
#pragma unroll 16
        for (int i = 0; i < 64; ++i) s += H1[tt * 64 + i] * W2s[i * 64 + j];
        H2[tt * 64 + j] = __sinf(fr[j] * s); }
    __syncthreads();
    const int c = F.tid;
    const float delta = -3.0701134573253944f + (float)c * ((-15.350567286626972f + 3.0701134573253944f) / 511.0f);
    const float ad = fabsf(delta);
    bf16* rf = RF + (size_t)c * hy::RFS;
#pragma unroll 1
    for (int dir = 0; dir < 2; ++dir) { const int o = dir * 512 + c; const float bo = b3[o];
        float wc[64];
#pragma unroll
        for (int i = 0; i < 64; ++i) wc[i] = w3[i * 1024 + o];
#pragma unroll 1
        for (int tt = 0; tt < 16; ++tt) { float s = bo;
#pragma unroll
            for (int i = 0; i < 64; i += 4) { const f32x4 hv = *(LAS f32x4*)(H2 + tt * 64 + i); s += (hv.x * wc[i] + hv.y * wc[i + 1]) + (hv.z * wc[i + 2] + hv.w * wc[i + 3]); }
            const int t = t0 + tt; const float tl = (float)t / 2047.0f; float val = s * __expf(-tl * ad);
            if (dir == 0) { if (t == 0) val += hbias[c]; rf[2048 - t] = (bf16)f2bf(val); }
            else if (t >= 1) rf[2048 + t] = (bf16)f2bf(val); } }
    if (fi == 0) { rf[0] = 0;
#pragma unroll
        for (int i = 4096; i < hy::RFS; ++i) rf[i] = 0; }
    __syncthreads();
}
__device__ __forceinline__ void unpack4(const v2u w, float (&x)[4]) { x[0] = bflo(w.x); x[1] = bfhi(w.x); x[2] = bflo(w.y); x[3] = bfhi(w.y); }
__device__ __forceinline__ void pair_norm_store(Frame& F, const float (&y)[8][4], bf16* dst, size_t row0, int col_off, int cq) {
    LAS float* part = (LAS float*)F.lds;
    float ss[8];
#pragma unroll
    for (int k = 0; k < 8; ++k) ss[k] = wave_sum((y[k][0] * y[k][0] + y[k][1] * y[k][1]) + (y[k][2] * y[k][2] + y[k][3] * y[k][3]));
    if (F.lane == 0) { *(LAS f32x4*)(part + F.wave * 8) = (f32x4){ss[0], ss[1], ss[2], ss[3]}; *(LAS f32x4*)(part + F.wave * 8 + 4) = (f32x4){ss[4], ss[5], ss[6], ss[7]}; }
    __syncthreads();
    const f32x4 pa = *(LAS f32x4*)(part + (F.wave ^ 1) * 8), pb = *(LAS f32x4*)(part + (F.wave ^ 1) * 8 + 4);
    const float po[8] = {pa.x, pa.y, pa.z, pa.w, pb.x, pb.y, pb.z, pb.w};
#pragma unroll
    for (int k = 0; k < 8; ++k) { const float rstd = 1.0f / sqrtf((ss[k] + po[k]) * (1.f / 512.f) + EPS);
        v2u o; o.x = pk2(y[k][0] * rstd, y[k][1] * rstd); o.y = pk2(y[k][2] * rstd, y[k][3] * rstd);
        *(v2u*)(dst + (row0 + k) * DM + col_off + 4 * cq) = o; }
    __syncthreads();
}
__device__ __forceinline__ void hyprep_item(Frame& F, const bf16* __restrict__ PROJ, const float* __restrict__ cw, const float* __restrict__ cb, bf16* ZT, bf16* X0, int b, int tile) {
    const int tb = F.tid >> 7, cq = F.tid & 127, c0 = 4 * cq, tw = tile * 32 + tb * 8; const size_t rb = (size_t)b * SEQ;
    float z[8][4];
    v2u rh[3][10];
#pragma unroll
    for (int j = 0; j < 3; ++j)
#pragma unroll
        for (int o = 0; o < 10; ++o) { const int t = tw - 1 + o; const int tc = ((t >= 0) && (t < SEQ)) ? t : tw; rh[j][o] = *(const v2u*)(PROJ + (rb + tc) * DINP + O_HY + 512 * j + c0); }
#pragma unroll
    for (int jj = 0; jj < 3; ++jj) { const int j = (jj == 0) ? 1 : (jj == 1) ? 2 : 0; const int cc = 512 * j + c0;
        const f32x4 w0 = *(const f32x4*)(cw + cc), w1 = *(const f32x4*)(cw + 1536 + cc), w2 = *(const f32x4*)(cw + 3072 + cc), bs = *(const f32x4*)(cb + cc);
        float x[10][4];
#pragma unroll
        for (int o = 0; o < 10; ++o) { const int t = tw - 1 + o; const bool ok = (t >= 0) && (t < SEQ); unpack4(rh[j][o], x[o]);
            if (!ok) { x[o][0] = 0.f; x[o][1] = 0.f; x[o][2] = 0.f; x[o][3] = 0.f; } }
        if (jj == 0) {
#pragma unroll
            for (int k = 0; k < 8; ++k)
#pragma unroll
                for (int i = 0; i < 4; ++i) z[k][i] = w0[i] * x[k][i] + w1[i] * x[k + 1][i] + w2[i] * x[k + 2][i] + bs[i];
        } else if (jj == 1) {
#pragma unroll
            for (int k = 0; k < 8; ++k)
#pragma unroll
                for (int i = 0; i < 4; ++i) z[k][i] *= w0[i] * x[k][i] + w1[i] * x[k + 1][i] + w2[i] * x[k + 2][i] + bs[i];
#pragma unroll
            for (int i = 0; i < 4; ++i) { v4u o; o.x = pk2(z[0][i], z[1][i]); o.y = pk2(z[2][i], z[3][i]); o.z = pk2(z[4][i], z[5][i]); o.w = pk2(z[6][i], z[7][i]);
                *(v4u*)(ZT + ((size_t)(c0 + i) * NSEQ + b) * SEQ + tw) = o; }
        } else {
#pragma unroll
            for (int k = 0; k < 8; ++k) { float u0[4];
#pragma unroll
                for (int i = 0; i < 4; ++i) u0[i] = w0[i] * x[k][i] + w1[i] * x[k + 1][i] + w2[i] * x[k + 2][i] + bs[i];
                v2u o; o.x = pk2(u0[0], u0[1]); o.y = pk2(u0[2], u0[3]); *(v2u*)(X0 + (rb + tw + k) * HYC + c0) = o; }
        }
    }
}
__device__ __forceinline__ void pool_item(Frame& F, const bf16* __restrict__ PROJ, bf16* MIXED, int b, int tile) {
    const int tb = F.tid >> 7, cq = F.tid & 127, c0 = 4 * cq, g = cq >> 5, half = 1 << g, tw = tile * 32 + tb * 8; const size_t rb = (size_t)b * SEQ;
    float x[23][4];
#pragma unroll
    for (int o = 0; o < 23; ++o) { const int t = tw - 8 + o; const bool ok = (t >= 0) && (t < SEQ); const int tc = ok ? t : tw;
        const v2u w = *(const v2u*)(PROJ + (rb + tc) * DINP + c0); unpack4(w, x[o]);
        if (!ok) { x[o][0] = 0.f; x[o][1] = 0.f; x[o][2] = 0.f; x[o][3] = 0.f; } }
    float y[8][4];
#pragma unroll
    for (int k = 0; k < 8; ++k) { const int oc = 8 + k, t = tw + k; const int lo = (t - half > 0) ? t - half : 0, hi = (t + half < SEQ) ? t + half : SEQ; const float inv = 1.0f / (float)(hi - lo);
#pragma unroll
        for (int i = 0; i < 4; ++i) {
            const float w1 = x[oc - 1][i] + x[oc][i];
            const float w2 = w1 + (x[oc - 2][i] + x[oc + 1][i]);
            const float w4 = w2 + ((x[oc - 4][i] + x[oc - 3][i]) + (x[oc + 2][i] + x[oc + 3][i]));
            const float w8 = w4 + (((x[oc - 8][i] + x[oc - 7][i]) + (x[oc - 6][i] + x[oc - 5][i])) + ((x[oc + 4][i] + x[oc + 5][i]) + (x[oc + 6][i] + x[oc + 7][i])));
            const float S = (g == 0) ? w1 : (g == 1) ? w2 : (g == 2) ? w4 : w8;
            y[k][i] = S * inv - x[oc][i]; } }
    pair_norm_store(F, y, MIXED, rb + tw, 0, cq);
}
__device__ __forceinline__ void hyfin_item(Frame& F, const bf16* __restrict__ YC, const bf16* __restrict__ X0, bf16* MIXED, int b, int tile) {
    const int tb = F.tid >> 7, cq = F.tid & 127, c0 = 4 * cq, tw = tile * 32 + tb * 8; const size_t rb = (size_t)b * SEQ;
    float yc[4][8], y[8][4];
#pragma unroll
    for (int i = 0; i < 4; ++i) { const v4u v = *(const v4u*)(YC + ((size_t)(c0 + i) * NSEQ + b) * SEQ + tw);
        yc[i][0] = bflo(v.x); yc[i][1] = bfhi(v.x); yc[i][2] = bflo(v.y); yc[i][3] = bfhi(v.y); yc[i][4] = bflo(v.z); yc[i][5] = bfhi(v.z); yc[i][6] = bflo(v.w); yc[i][7] = bfhi(v.w); }
#pragma unroll
    for (int k = 0; k < 8; ++k) { float xv[4]; unpack4(*(const v2u*)(X0 + (rb + tw + k) * HYC + c0), xv);
#pragma unroll
        for (int i = 0; i < 4; ++i) y[k][i] = yc[i][k] * xv[i]; }
    pair_norm_store(F, y, MIXED, rb + tw, 1536, cq);
}
struct PrepGains { float q[3][8], k[3][8]; };
__device__ __forceinline__ void load8(const float* p, float (&o)[8]) { const f32x4 a = *(const f32x4*)p, b = *(const f32x4*)(p + 4); o[0] = a.x; o[1] = a.y; o[2] = a.z; o[3] = a.w; o[4] = b.x; o[5] = b.y; o[6] = b.z; o[7] = b.w; }
__device__ __forceinline__ void unpack8(const v4u w, float (&x)[8]) { x[0] = bflo(w.x); x[1] = bfhi(w.x); x[2] = bflo(w.y); x[3] = bfhi(w.y); x[4] = bflo(w.z); x[5] = bfhi(w.z); x[6] = bflo(w.w); x[7] = bfhi(w.w); }
__device__ __forceinline__ v4u pack8(const float (&x)[8]) { v4u o; o.x = pk2(x[0], x[1]); o.y = pk2(x[2], x[3]); o.z = pk2(x[4], x[5]); o.w = pk2(x[6], x[7]); return o; }
__device__ __forceinline__ float ssq8(const float (&x)[8]) { return ((x[0] * x[0] + x[1] * x[1]) + (x[2] * x[2] + x[3] * x[3])) + ((x[4] * x[4] + x[5] * x[5]) + (x[6] * x[6] + x[7] * x[7])); }
__device__ __forceinline__ float sum8lanes(float v) { v += __shfl_xor(v, 1); v += __shfl_xor(v, 2); v += __shfl_xor(v, 4); return v; }
__device__ __forceinline__ void prep_row(const bf16* __restrict__ PROJ, bf16* Q, bf16* KV, const PrepGains& G, const float* __restrict__ ROPE, int m, int lane) {
    const int h = lane >> 3, sub = lane & 7;
    const bf16* pr = PROJ + (size_t)m * DINP; bf16* qr = Q + (size_t)m * NQ + 192 * h + 8 * sub; bf16* kr = KV + (size_t)m * NKVP + KVHS * h + 8 * sub;
    const v4u cqv = *(const v4u*)(pr + O_CQ + 8 * lane); const v4u ckv = *(const v4u*)(pr + O_CKV + 8 * (lane & 31)); const v4u pev = *(const v4u*)(pr + O_KPE + 8 * sub);
    const v4u q0 = *(const v4u*)(qr), q1 = *(const v4u*)(qr + 64), q2 = *(const v4u*)(qr + 128);
    const v4u k0 = *(const v4u*)(kr), k1 = *(const v4u*)(kr + 64), v0 = *(const v4u*)(kr + 192), v1 = *(const v4u*)(kr + 256);
    float cs[8], sn[8]; { const float* rp = ROPE + (size_t)(m & (SEQ - 1)) * 64 + 8 * (sub & 3); load8(rp, cs); load8(rp + 32, sn); }
    float t[8];
    unpack8(cqv, t); const float rq = 1.0f / sqrtf(wave_sum(ssq8(t)) * (1.f / 512.f) + EPS);
    unpack8(ckv, t); const float rkv = 1.0f / sqrtf(wave_sum(lane < 32 ? ssq8(t) : 0.f) * (1.f / 256.f) + EPS);
    const float sg = (sub < 4) ? -1.f : 1.f;
    { float a0[8], a1[8], a2[8]; unpack8(q0, a0); unpack8(q1, a1); unpack8(q2, a2);
      const float ss = sum8lanes(ssq8(a0) + ssq8(a1) + ssq8(a2)) * (rq * rq);
      const float sc = (rq * (at::SCALE * 1.4426950408889634f)) / sqrtf(ss * (1.f / 192.f) + EPS);
      float r[8], o[8];
#pragma unroll
      for (int i = 0; i < 8; ++i) { a0[i] *= sc * G.q[0][i]; a1[i] *= sc * G.q[1][i]; r[i] = a2[i] * sc * G.q[2][i]; }
#pragma unroll
      for (int i = 0; i < 8; ++i) { const float rp = __shfl_xor(r[i], 4); o[i] = r[i] * cs[i] + sg * rp * sn[i]; }
      *(v4u*)(qr) = pack8(a0); *(v4u*)(qr + 64) = pack8(a1); *(v4u*)(qr + 128) = pack8(o); }
    { float a0[8], a1[8], pe[8], b0[8], b1[8]; unpack8(k0, a0); unpack8(k1, a1); unpack8(pev, pe); unpack8(v0, b0); unpack8(v1, b1);
      const float ss = sum8lanes((ssq8(a0) + ssq8(a1)) * (rkv * rkv) + ssq8(pe));
      const float sk = 1.0f / sqrtf(ss * (1.f / 192.f) + EPS);
      float r[8], o[8];
#pragma unroll
      for (int i = 0; i < 8; ++i) { a0[i] *= rkv * sk * G.k[0][i]; a1[i] *= rkv * sk * G.k[1][i]; r[i] = pe[i] * sk * G.k[2][i]; b0[i] *= rkv; b1[i] *= rkv; }
#pragma unroll
      for (int i = 0; i < 8; ++i) { const float rp = __shfl_xor(r[i], 4); o[i] = r[i] * cs[i] + sg * rp * sn[i]; }
      *(v4u*)(kr) = pack8(a0); *(v4u*)(kr + 64) = pack8(a1); *(v4u*)(kr + 128) = pack8(o); *(v4u*)(kr + 192) = pack8(b0); *(v4u*)(kr + 256) = pack8(b1); }
}
__device__ __forceinline__ void attn_norm_row(bf16* MIXED, int m, int lane) {
    v4u* p = (v4u*)(MIXED + (size_t)m * DM + 512 + 16 * lane); v4u a = p[0], b = p[1];
    unsigned w[8] = {a.x, a.y, a.z, a.w, b.x, b.y, b.z, b.w}; float s = 0.f;
#pragma unroll
    for (int i = 0; i < 8; ++i) { const float x = bflo(w[i]), y = bfhi(w[i]); s += x * x + y * y; }
    const float rstd = 1.0f / sqrtf(wave_sum(s) * (1.f / 1024.f) + EPS);
#pragma unroll
    for (int i = 0; i < 8; ++i) w[i] = pk2(bflo(w[i]) * rstd, bfhi(w[i]) * rstd);
    a.x = w[0]; a.y = w[1]; a.z = w[2]; a.w = w[3]; b.x = w[4]; b.y = w[5]; b.z = w[6]; b.w = w[7]; p[0] = a; p[1] = b;
}

#define DEFPTRS() unsigned char* ws = args.ws; \
    bf16* BtIn = (bf16*)(ws + WS_BTIN); bf16* BtUq = (bf16*)(ws + WS_BTUQ); bf16* BtKv = (bf16*)(ws + WS_BTKV); bf16* BtOut = (bf16*)(ws + WS_BTOUT); bf16* BtUp = (bf16*)(ws + WS_BTUP); bf16* BtDn = (bf16*)(ws + WS_BTDN); \
    bf16* RF = (bf16*)(ws + WS_RF); bf16* Hb = (bf16*)(ws + WS_H); bf16* PROJ = (bf16*)(ws + WS_PROJ); bf16* Qb = (bf16*)(ws + WS_Q); bf16* KVb = (bf16*)(ws + WS_KV); \
    bf16* ZT = (bf16*)(ws + WS_ZT); bf16* X0 = (bf16*)(ws + WS_X0); bf16* YC = (bf16*)(ws + WS_YC); float* EDGE = (float*)(ws + WS_EDGE); float* ROPE = (float*)(ws + WS_ROPE); float* SSQP = (float*)(ws + WS_SSQP); float* RSTD = (float*)(ws + WS_RSTD); bf16* XB2 = (bf16*)(ws + WS_XB2); unsigned char* XQ = (unsigned char*)(ws + WS_XQ); unsigned char* BtUpQ = (unsigned char*)(ws + WS_BTUP); bf16* ACT = (bf16*)(ws + WS_ACT); \
    bf16* XA = (bf16*)args.out; \
    (void)BtIn; (void)BtUq; (void)BtKv; (void)BtOut; (void)BtUp; (void)BtDn; (void)RF; (void)Hb; (void)PROJ; (void)Qb; (void)KVb; (void)ZT; (void)X0; (void)YC; (void)EDGE; (void)ROPE; (void)SSQP; (void)RSTD; (void)XB2; (void)XQ; (void)BtUpQ; (void)ACT; (void)XA
__global__ void __launch_bounds__(NWAVES * 64, 2) fwd(Args args) {
    extern __shared__ __attribute__((aligned(16))) unsigned char lds_raw[];
    Frame F;
    F.lds = (LAS unsigned char*)lds_raw;
    F.tid = threadIdx.x; F.lane = F.tid & 63; F.wave = __builtin_amdgcn_readfirstlane(F.tid >> 6);
    F.G = gridDim.x; { const int bx = blockIdx.x; F.vcu = (F.G % 8 == 0) ? (bx % 8) * (F.G / 8) + bx / 8 : bx; }
    volatile LAS unsigned* MISC = (volatile LAS unsigned*)(F.lds + MISC_OFF);
    if (F.tid < 64) MISC[F.tid] = 0u;
    __syncthreads();
    unsigned* ctl = (unsigned*)(args.ws + WS_CTL);
    const int lo = args.ph_lo, hi = args.ph_hi;
    XcdBarrier bar; bar.bar = ctl + CW_BAR; bar.x = 0; bar.st = MISC + 8;
    if (hi - lo > 1) bar = xcd_barrier_post(ctl + CW_BAR, MISC + 8);
    float* out = args.out;

#pragma unroll 1
    for (int layer = 0; layer < DEPTH; ++layer) {
        const int pb = layer * NPH;
        if (pb + NPH <= lo || pb >= hi) continue;
#define IN(k) (lo <= pb + (k) && pb + (k) < hi)
#define ENTER() DEFPTRS(); F.tid = opq(threadIdx.x); F.lane = F.tid & 63; F.wave = __builtin_amdgcn_readfirstlane(F.tid >> 6); const int gw = F.vcu * NWAVES + F.wave, NGW = F.G * NWAVES, wg = F.vcu; const size_t gtid = (size_t)wg * 512 + F.tid, gthreads = (size_t)F.G * 512; (void)gw; (void)NGW; (void)wg; (void)gtid; (void)gthreads
#define SEAM(k) do { if (pb + (k) + 1 < hi) xcd_barrier(bar); } while (0)

        if (IN(0)) { ENTER();
            const float* win = args.in[I_WIN] + (size_t)layer * DM * DIN; const float* g1 = args.in[I_ANG] + layer * DM;
            for (int it = wg; it < 256; it += F.G) {
                if (it < 128) poolfold_item(F, win, args.in[I_PW] + (size_t)layer * 4 * 128 * 128, args.in[I_PS] + (size_t)layer * 512, g1, BtIn, it >> 5, it & 31);
                else filter_item(F, args.in[I_FW1] + (size_t)layer * 17 * 64, args.in[I_FB1] + layer * 64, args.in[I_FFR] + layer * 64, args.in[I_FW2] + (size_t)layer * 64 * 64, args.in[I_FB2] + layer * 64,
                                 args.in[I_FW3] + (size_t)layer * 64 * 1024, args.in[I_FB3] + layer * 1024, args.in[I_HBIAS] + layer * 512, RF, it - 128);
            }
            constexpr int T_IN = 19 * 16, T_UQ = 12 * 4, T_KV = 16 * 2, T_OUT = 16 * 16, T_UP = 88 * 16, T_DN = 16 * 44, T_ALL = T_IN + T_UQ + T_KV + T_OUT + T_UP + T_DN;
            for (int it = wg; it < T_ALL; it += F.G) {
                int r = it; CvtTile d;
                if (r < T_IN) { const int nt = r >> 4, kt = r & 15, n0 = 512 + 128 * nt; d = CvtTile{win, g1, BtIn, DIN, DM, n0, 128 * kt, DIN, {n0, n0 + 32, n0 + 64, n0 + 96}}; }
                else if ((r -= T_IN) < T_UQ) { const int nt = r >> 2, kt = r & 3, n0 = 128 * nt; d = CvtTile{args.in[I_WUQ] + (size_t)layer * 512 * NQ, args.in[I_QNG] + layer * 512, BtUq, NQ, 512, n0, 128 * kt, NQ, {n0, n0 + 32, n0 + 64, n0 + 96}}; }
                else if ((r -= T_UQ) < T_KV) { const int nt = r >> 1, kt = r & 1, n0 = 128 * nt;
                    d = CvtTile{args.in[I_WUKV] + (size_t)layer * 256 * 2048, args.in[I_KVNG] + layer * 256, BtKv, 2048, 256, n0, 128 * kt, 2048, {n0, n0 + 32, n0 + 64, n0 + 96}}; }
                else if ((r -= T_KV) < T_OUT) { const int nt = r >> 4, kt = r & 15, n0 = 128 * nt; d = CvtTile{args.in[I_WOUT] + (size_t)layer * DM * DM, args.in[I_GNG] + layer * DM, BtOut, DM, DM, n0, 128 * kt, DM, {n0, n0 + 32, n0 + 64, n0 + 96}}; }
                else if ((r -= T_OUT) < T_UP) { const int nt = r >> 4, kt = r & 15;
                    absmax_tile(F, args.in[I_WUP] + (size_t)layer * DM * NUP, args.in[I_FNG] + layer * DM, NUP, 128 * nt, 128 * kt, ctl + CW_WMAXC + layer * NUP); continue; }
                else { r -= T_UP; const int nt = r / 44, kt = r % 44, n0 = 128 * nt; d = CvtTile{args.in[I_WDN] + (size_t)layer * DFF * DM, nullptr, BtDn, DM, DFF, n0, 128 * kt, DM, {n0, n0 + 32, n0 + 64, n0 + 96}}; }
                cvt_tile(F, d);
            }
            { unsigned zz = 0u; asm volatile("" : "+v"(zz)); v4u z = {zz, zz, zz, zz};
              for (size_t i = gtid; i < (size_t)(DINP - DIN) * DM / 8; i += gthreads) *(v4u*)(BtIn + (size_t)DIN * DM + i * 8) = z;
}
            if (layer == 0) for (size_t i = gtid; i < (size_t)SEQ * 32; i += gthreads) { const int pos = (int)(i >> 5), ri = (int)(i & 31);
                const float freq = exp2f(-(float)ri * (13.287712379549449f / 32.0f)); float sn, cs; sincosf((float)pos * freq, &sn, &cs); ROPE[pos * 64 + ri] = cs; ROPE[pos * 64 + 32 + ri] = sn; }
            if (layer == 0) { for (int m = gw; m < M; m += NGW) xb_row(m < MP ? args.in[I_XP] + (size_t)m * DM : args.in[I_XS] + (size_t)(m - MP) * DM, XA + (size_t)m * DM, RSTD + m, F.lane); }
            else rstd_from_partials(SSQP, RSTD, gtid, gthreads);
            SEAM(0);
        }
        if (IN(1)) { ENTER();
            pg8::Gemm g{XA, BtIn, M, DINP, DM, DM}; pg8::StaticOrder S; S.init(M, DINP, F.G, (int)blockIdx.x);
            pg8::EpiBf16 E{PROJ, DINP, RSTD, 0};
            pg8::gemm_phase<pg8::EpiBf16, pg8::StaticOrder>(F.lds, g, S, E);
            SEAM(1);
        }
        if (IN(2)) { ENTER();
            { pg8::Gemm g{PROJ + O_CQ, BtUq, M, NQ, 512, DINP}; pg8::StaticOrder S; S.init(M, NQ, F.G, (int)blockIdx.x); pg8::EpiBf16 E{Qb, NQ, nullptr, 0};
              pg8::gemm_phase<pg8::EpiBf16, pg8::StaticOrder>(F.lds, g, S, E); }
            { pg8::Gemm g{PROJ + O_CKV, BtKv, M, 2048, 256, DINP}; pg8::StaticOrder S; S.init(M, 2048, F.G, (int)blockIdx.x); pg8::EpiBf16 E{KVb, NKVP, nullptr, 1};
              pg8::gemm_phase<pg8::EpiBf16, pg8::StaticOrder>(F.lds, g, S, E); }
            const float* hcw = args.in[I_HCW] + (size_t)layer * 3 * 1536; const float* hcb = args.in[I_HCB] + layer * 1536;
            for (int it = wg; it < 2 * NSEQ * 64; it += F.G) {
                if (it < NSEQ * 64) hyprep_item(F, PROJ, hcw, hcb, ZT, X0, it >> 6, it & 63);
                else pool_item(F, PROJ, Hb, (it - NSEQ * 64) >> 6, it & 63);
            }
            SEAM(2);
        }
        if (IN(3)) { ENTER();
            const int odd = __builtin_amdgcn_readfirstlane(opq((int)(blockIdx.x >> 3) & 1));
            const float* qhg = args.in[I_QHG] + layer * 192; const float* khg = args.in[I_KHG] + layer * 192;
            if (!odd) { for (int u = wg; u < 2 * HYC; u += F.G) hy::conv_unit(F.lds, ZT, RF, YC, u >> 1, u & 1); }
            { PrepGains PG; { const int sub = F.lane & 7;
#pragma unroll
                for (int i = 0; i < 3; ++i) { load8(qhg + 64 * i + 8 * sub, PG.q[i]); load8(khg + 64 * i + 8 * sub, PG.k[i]); } }
              for (int m = gw; m < M; m += NGW) prep_row(PROJ, Qb, KVb, PG, ROPE, m, F.lane); }
            if (odd) { __syncthreads(); for (int u = wg; u < 2 * HYC; u += F.G) hy::conv_unit(F.lds, ZT, RF, YC, u >> 1, u & 1); }
            SEAM(3);
        }
        if (IN(4)) { ENTER();
            float gqm, gkm; { const float* qhg = args.in[I_QHG] + layer * 192; const float* khg = args.in[I_KHG] + layer * 192;
                gqm = fmaxf(fmaxf(fabsf(qhg[F.lane]), fabsf(qhg[64 + F.lane])), fabsf(qhg[128 + F.lane])); gkm = fmaxf(fmaxf(fabsf(khg[F.lane]), fabsf(khg[64 + F.lane])), fabsf(khg[128 + F.lane]));
#pragma unroll
                for (int o = 1; o < 64; o <<= 1) { gqm = fmaxf(gqm, __shfl_xor(gqm, o)); gkm = fmaxf(gkm, __shfl_xor(gkm, o)); } }
            const float Mnat = 13.856406460551018f * gqm * gkm;
            const bool sm_fast = __builtin_amdgcn_readfirstlane((Mnat <= 40.0f) ? 1 : 0) != 0;
            const float negMC = __builtin_bit_cast(float, __builtin_amdgcn_readfirstlane(__builtin_bit_cast(int, -Mnat * 1.4426950408889634f)));
            for (int i = 0; i * F.G < NSEQ * NH * 8; ++i) {
                int p, qb; const int c = (int)blockIdx.x;
                if (F.G == 256) { p = i * 32 + (c & 7) * 4 + (c >> 6); qb = (c >> 3) & 7; } else { const int Lq = i * F.G + c; p = Lq >> 3; qb = Lq & 7; }
                if (p < NSEQ * NH) { const int b = p >> 3, h = p & 7;
                    const bf16* qp = Qb + (size_t)(b * SEQ + qb * 256) * NQ + h * 192; const bf16* kp = KVb + (size_t)(b * SEQ) * NKVP + h * KVHS; bf16* op = Hb + (size_t)(b * SEQ + qb * 256) * DM + 512 + h * 128;
                    if (sm_fast) at::attn_unit<true>(negMC, qp, kp, kp + 192, op, SEQ, (char*)lds_raw);
                    else at::attn_unit<false>(0.f, qp, kp, kp + 192, op, SEQ, (char*)lds_raw); }
            }
            for (int it = wg; it < NSEQ * 64; it += F.G) hyfin_item(F, YC, X0, Hb, it >> 6, it & 63);
            SEAM(4);
        }
        if (IN(5)) { ENTER();
            for (int m = gw; m < M; m += NGW) attn_norm_row(Hb, m, F.lane);
            SEAM(5);
        }
        if (IN(6)) { ENTER();
            pg8::Gemm g{Hb, BtOut, M, DM, DM, DM}; pg8::StaticOrder S; S.init(M, DM, F.G, (int)blockIdx.x);
            pg8::EpiResid16 E{XA, XB2, out, DM, SSQP, 0};
            pg8::gemm_phase<pg8::EpiResid16, pg8::StaticOrder>(F.lds, g, S, E);
            SEAM(6);
        }
        if (IN(7)) { ENTER();
            const unsigned* wmaxc = ctl + CW_WMAXC + layer * NUP;
            for (int it = wg; it < 88 * 16; it += F.G) { const int nt = it >> 4, kt = it & 15; const int nv = (nt < 44) ? nt : nt - 44;
                cvtq_tile(F, args.in[I_WUP] + (size_t)layer * DM * NUP, args.in[I_FNG] + layer * DM, NUP, DM, BtUpQ, 128 * nt, 128 * kt, 256 * nv + ((nt < 44) ? 0 : 32), wmaxc); }
            for (int m = gw; m < M; m += NGW) xq_row(XB2 + (size_t)m * DM, XQ + (size_t)m * DM, SSQP + (size_t)m * 32, RSTD + m, 1.0f, F.lane);
            SEAM(7);
        }
        if (IN(8)) { ENTER();
            pg8::Gemm g{(const bf16*)XQ, (const bf16*)BtUpQ, M, NUP, DM / 2, DM / 2}; pg8::StaticOrder S; S.init(M, NUP, F.G, (int)blockIdx.x);
            pg8::EpiGate E{ACT, DFF, EDGE, args.in[I_FCW] + (size_t)layer * 3 * DFF, args.in[I_FCB] + layer * DFF, DFF, (LAS float*)(F.lds + HALO_OFF), RSTD, ctl + CW_WMAXC + layer * NUP};
            pg8::gemm_phase<pg8::EpiGate, pg8::StaticOrder, true>(F.lds, g, S, E);
            SEAM(8);
        }
        if (IN(9)) { ENTER();
            const float* fcw = args.in[I_FCW] + (size_t)layer * 3 * DFF;
            for (size_t i = gtid; i < (size_t)(M / 256) * 2 * (DFF / 4); i += gthreads) {
                const int ri = (int)(i / (DFF / 4)), c4 = (int)(i % (DFF / 4)) * 4, pm = ri >> 1, e = ri & 1;
                const float* eb = EDGE + (size_t)(ri * 3) * DFF + c4;
                f32x4 pre = *(const f32x4*)(eb + DFF); const f32x4 v = *(const f32x4*)(eb + 2 * DFF);
                if (e == 0 && (pm & 7) != 0) { const f32x4 gp = *(const f32x4*)(EDGE + (size_t)(((pm - 1) * 2 + 1) * 3) * DFF + c4); pre += *(const f32x4*)(fcw + c4) * gp; }
                if (e == 1 && (pm & 7) != 7) { const f32x4 gn = *(const f32x4*)(EDGE + (size_t)(((pm + 1) * 2 + 0) * 3) * DFF + c4); pre += *(const f32x4*)(fcw + 2 * DFF + c4) * gn; }
                v2u o; o.x = pk2(pg8::silu_f(pre.x) * v.x, pg8::silu_f(pre.y) * v.y); o.y = pk2(pg8::silu_f(pre.z) * v.z, pg8::silu_f(pre.w) * v.w);
                *(v2u*)(ACT + (size_t)(pm * 256 + (e ? 255 : 0)) * DFF + c4) = o;
            }
            SEAM(9);
        }
        if (IN(10)) { ENTER();
            pg8::Gemm g{ACT, BtDn, M, DM, DFF, DFF}; pg8::StaticOrder S; S.init(M, DM, F.G, (int)blockIdx.x);
            pg8::EpiResid16 E{XB2, XA, out, DM, SSQP, (layer + 1 < DEPTH) ? 0 : 1};
            pg8::gemm_phase<pg8::EpiResid16, pg8::StaticOrder>(F.lds, g, S, E);
            SEAM(10);
        }
#undef IN
#undef ENTER
#undef SEAM
    }
}

extern "C" void kernel_launch(void* const* d_in, const int* in_sizes, int n_in, void* d_out, int out_size, void* d_ws, size_t ws_size, hipStream_t stream) {
    static int grid = 0;
    if (grid == 0) {
        if (n_in != N_IN || out_size != M * DM || ws_size < WS_END) { fprintf(stderr, "kernel_launch: unexpected shapes (n_in %d, out %d, ws %zu, need %zu)\n", n_in, out_size, ws_size, (size_t)WS_END); grid = -1; return; }
        int dev = 0, cus = 0;
        if (hipGetDevice(&dev) != hipSuccess || hipDeviceGetAttribute(&cus, hipDeviceAttributeMultiprocessorCount, dev) != hipSuccess) { grid = -1; return; }
        if (hipFuncSetAttribute((const void*)fwd, hipFuncAttributeMaxDynamicSharedMemorySize, LDS_BYTES) != hipSuccess) { fprintf(stderr, "kernel_launch: hipFuncSetAttribute failed\n"); grid = -1; return; }
        int per_cu = 0;
        if (hipOccupancyMaxActiveBlocksPerMultiprocessor(&per_cu, (const void*)fwd, NWAVES * 64, LDS_BYTES) != hipSuccess || per_cu < 1) fprintf(stderr, "kernel_launch: occupancy query reports %d\n", per_cu);
        (void)hipGetLastError();
        grid = cus;
    }
    if (grid < 0) return;
    (void)hipMemsetAsync((char*)d_ws + WS_CTL, 0, CTL_BYTES, stream);
    Args a{};
    for (int i = 0; i < N_IN; ++i) a.in[i] = (const float*)d_in[i];
    a.out = (float*)d_out; a.ws = (unsigned char*)d_ws;
#if MK_ONE_LAUNCH
    a.ph_lo = 0; a.ph_hi = DEPTH * NPH;
    hipLaunchKernelGGL(fwd, dim3(grid), dim3(NWAVES * 64), LDS_BYTES, stream, a);
#else
    for (int p = 0; p < DEPTH * NPH; ++p) { a.ph_lo = p; a.ph_hi = p + 1; hipLaunchKernelGGL(fwd, dim3(grid), dim3(NWAVES * 64), LDS_BYTES, stream, a); }
#endif
    const hipError_t le = hipPeekAtLastError();
    if (le != hipSuccess) fprintf(stderr, "kernel_launch: launch failed: %s\n", hipGetErrorName(le));
}
```

```cpp
#include <hip/hip_runtime.h>
#include <cstdio>
#include <cstdint>
__device__ __forceinline__ int opq(int x) { asm volatile("" : "+v"(x)); return x; }
namespace pg8 {
#define PG8_LAS __attribute__((address_space(3)))
typedef unsigned short bf16_t;
typedef short bf16x8 __attribute__((ext_vector_type(8)));
typedef float f32x4 __attribute__((ext_vector_type(4)));
typedef unsigned u32x4 __attribute__((ext_vector_type(4)));
typedef int i32x4 __attribute__((ext_vector_type(4)));
template <bool I8> struct AccSel { typedef f32x4 T; }; template <> struct AccSel<true> { typedef i32x4 T; };
constexpr int BM = 256, BK = 64, HALF = 128, HTB = HALF * BK * 2  , STAGE_BYTES = 8 * HTB, NXCD = 8, WGM = 8;

__host__ __device__ __forceinline__ int lds_byte(int r, int c) { const int st = (r >> 4) * 2 + (c >> 5), rr = r & 15, cc = c & 31, ob = rr * 64 + cc * 2; return st * 1024 + (ob ^ (((ob >> 9) & 1) << 5)); }
__host__ __device__ __forceinline__ void stage_rc(int b, int& R, int& C) { const int st = b / 1024, sb = b % 1024, swz = sb ^ (((sb >> 9) & 1) << 5); R = (st >> 1) * 16 + swz / 64; C = (st & 1) * 32 + (swz % 64) / 2; }
__host__ __device__ __forceinline__ int perm32(int rho) { const int n = rho >> 4, i = rho & 15; return 8 * (i >> 2) + 4 * n + (i & 3); }

struct Unit { int pm, pn; };
struct Gemm { const bf16_t* A; const bf16_t* Bt; int M, N, K, lda; };

struct StaticOrder {
    int nM, nN, nwg, G, c;
    __host__ __device__ void init(int M, int N, int G_, int c_) { nM = M / BM; nN = N / BM; nwg = nM * nN; G = G_; c = c_; }
    __host__ __device__ bool next(int i, Unit& u) const {
        const long L = (long)i * G + c; if (L >= nwg) return false;
        int wgid = (int)L; { const int q = nwg / NXCD, r = nwg % NXCD, xcd = wgid % NXCD, off = wgid / NXCD; wgid = (xcd < r ? xcd * (q + 1) : r * (q + 1) + (xcd - r) * q) + off; }
        const int nig = WGM * nN, gid = wgid / nig, fm = gid * WGM, gsz = (nM - fm) < WGM ? (nM - fm) : WGM;
        u.pm = fm + ((wgid % nig) % gsz); u.pn = (wgid % nig) / gsz; return true;
    }
    __device__ __forceinline__ void a_ready(const Unit&) const {}
    __device__ __forceinline__ void done(const Unit&) const {}
};

__device__ __forceinline__ unsigned cvt_pk_bf16(float lo, float hi) { unsigned r; asm volatile("v_cvt_pk_bf16_f32 %0, %1, %2" : "=v"(r) : "v"(lo), "v"(hi)); return r; }

__device__ __forceinline__ float dpp_ror1(float v) { return __builtin_bit_cast(float, __builtin_amdgcn_update_dpp(0, __builtin_bit_cast(int, v), 0x121, 0xF, 0xF, false)); }
__device__ __forceinline__ float dpp_ror15(float v) { return __builtin_bit_cast(float, __builtin_amdgcn_update_dpp(0, __builtin_bit_cast(int, v), 0x12F, 0xF, 0xF, false)); }
__device__ __forceinline__ unsigned dpp_swap1(unsigned v) { return (unsigned)__builtin_amdgcn_update_dpp(0, (int)v, 0xB1, 0xF, 0xF, false); }
struct LineOffs { unsigned o0, o1; bool odd; };
__device__ __forceinline__ LineOffs line_offs(unsigned lo, int pitch, int fr) { LineOffs L; L.odd = fr & 1; L.o0 = L.odd ? lo - (unsigned)pitch + 32u : lo; L.o1 = L.odd ? lo + 32u : lo + (unsigned)pitch; return L; }
__device__ __forceinline__ void store_lines(bf16_t* base, const LineOffs& L, u32x4 a, u32x4 b) {
    const u32x4 snd = L.odd ? a : b; u32x4 rcv;
    rcv.x = dpp_swap1(snd.x); rcv.y = dpp_swap1(snd.y); rcv.z = dpp_swap1(snd.z); rcv.w = dpp_swap1(snd.w);
    *(u32x4*)(base + L.o0) = L.odd ? rcv : a;
    *(u32x4*)(base + L.o1) = L.odd ? b : rcv;
}
struct EpiBf16 {
    static constexpr bool PERM = true;
    bf16_t* O; int ldc; const float* rstd; int kvscatter;
    int norm_pn; PG8_LAS float* red; float eps;
    __device__ __forceinline__ void operator()(f32x4 (&acc)[2][2][4][2], const Unit& u, int wr, int wc, int fr, int fq) const {
        bf16_t* Ot = O + (size_t)(u.pm * BM) * ldc + (kvscatter ? u.pn * 320 : u.pn * BM);
        const int wcol = kvscatter ? (wc < 2 ? wc * 64 : 64 + wc * 64) : wc * 64;
        const LineOffs L = line_offs((unsigned)((wr * 64 + fr) * ldc + wcol + 8 * fq), ldc, fr); const int row0 = u.pm * BM + wr * 64 + fr;
        float rsv[8];
#pragma unroll
        for (int i = 0; i < 8; ++i) rsv[i] = rstd ? rstd[row0 + (i >> 2) * HALF + (i & 3) * 16] : 1.0f;
        if (u.pn == norm_pn) {
#pragma unroll
            for (int ai = 0; ai < 2; ++ai)
#pragma unroll
                for (int m = 0; m < 4; ++m) { const float rs = rsv[ai * 4 + m]; float s = 0.f;
#pragma unroll
                    for (int bj = 0; bj < 2; ++bj) { acc[ai][bj][m][0] *= rs; acc[ai][bj][m][1] *= rs; const f32x4 a = acc[ai][bj][m][0], b = acc[ai][bj][m][1];
                        s += ((a[0] * a[0] + a[1] * a[1]) + (a[2] * a[2] + a[3] * a[3])) + ((b[0] * b[0] + b[1] * b[1]) + (b[2] * b[2] + b[3] * b[3])); }
                    s += __shfl_xor(s, 16); s += __shfl_xor(s, 32); if (fq == 0) red[(ai * HALF + wr * 64 + m * 16 + fr) * 4 + wc] = s; }
            asm volatile("s_waitcnt lgkmcnt(0)" ::: "memory"); __builtin_amdgcn_s_barrier(); asm volatile("" ::: "memory");
#pragma unroll
            for (int ai = 0; ai < 2; ++ai)
#pragma unroll
                for (int m = 0; m < 4; ++m) { const f32x4 p = *(const PG8_LAS f32x4*)(red + (ai * HALF + wr * 64 + m * 16 + fr) * 4); const float rs = 1.0f / __builtin_sqrtf(((p[0] + p[1]) + (p[2] + p[3])) * (1.0f / 256.0f) + eps);
                    u32x4 w[2];
#pragma unroll
                    for (int bj = 0; bj < 2; ++bj) { const f32x4 v0 = acc[ai][bj][m][0] * rs, v1 = acc[ai][bj][m][1] * rs;
                        w[bj].x = cvt_pk_bf16(v0[0], v0[1]); w[bj].y = cvt_pk_bf16(v0[2], v0[3]); w[bj].z = cvt_pk_bf16(v1[0], v1[1]); w[bj].w = cvt_pk_bf16(v1[2], v1[3]); }
                    store_lines(Ot + (size_t)((ai * HALF + m * 16) * ldc), L, w[0], w[1]);
                    asm volatile("" ::: "memory"); }
            return;
        }
#pragma unroll
        for (int ai = 0; ai < 2; ++ai)
#pragma unroll
            for (int m = 0; m < 4; ++m) { const float rs = rsv[ai * 4 + m];
                u32x4 w[2];
#pragma unroll
                for (int bj = 0; bj < 2; ++bj) { const f32x4 v0 = acc[ai][bj][m][0] * rs, v1 = acc[ai][bj][m][1] * rs;
                    w[bj].x = cvt_pk_bf16(v0[0], v0[1]); w[bj].y = cvt_pk_bf16(v0[2], v0[3]); w[bj].z = cvt_pk_bf16(v1[0], v1[1]); w[bj].w = cvt_pk_bf16(v1[2], v1[3]); }
                store_lines(Ot + (size_t)((ai * HALF + m * 16) * ldc), L, w[0], w[1]);
                asm volatile("" ::: "memory"); }
    }
};
struct EpiResid16 {
    static constexpr bool PERM = true;
    const bf16_t* base; bf16_t* xo; float* out; int ldc; float* ssqp; int f32out;
    __device__ __forceinline__ static void addx(const u32x4 b, const f32x4 a0, const f32x4 a1, f32x4& x0, f32x4& x1) {
        x0[0] = __builtin_bit_cast(float, b.x << 16) + a0[0]; x0[1] = __builtin_bit_cast(float, b.x & 0xffff0000u) + a0[1]; x0[2] = __builtin_bit_cast(float, b.y << 16) + a0[2]; x0[3] = __builtin_bit_cast(float, b.y & 0xffff0000u) + a0[3];
        x1[0] = __builtin_bit_cast(float, b.z << 16) + a1[0]; x1[1] = __builtin_bit_cast(float, b.z & 0xffff0000u) + a1[1]; x1[2] = __builtin_bit_cast(float, b.w << 16) + a1[2]; x1[3] = __builtin_bit_cast(float, b.w & 0xffff0000u) + a1[3]; }
    __device__ __forceinline__ void operator()(f32x4 (&acc)[2][2][4][2], const Unit& u, int wr, int wc, int fr, int fq) const {
        const size_t tb = (size_t)(u.pm * BM) * ldc + u.pn * BM;
        const bf16_t* bs = base + tb;
        const unsigned lo = (unsigned)((wr * 64 + fr) * ldc + wc * 64 + 8 * fq);
        if (f32out != 0) {
            float* op = out + tb;
#pragma unroll
            for (int ai = 0; ai < 2; ++ai)
#pragma unroll
                for (int m = 0; m < 4; ++m) { const unsigned off = lo + (unsigned)((ai * HALF + m * 16) * ldc);
#pragma unroll
                    for (int bj = 0; bj < 2; ++bj) { const u32x4 b = *(const u32x4*)(bs + off + bj * 32); f32x4 x0, x1; addx(b, acc[ai][bj][m][0], acc[ai][bj][m][1], x0, x1);
                        *(f32x4*)(op + off + bj * 32) = x0; *(f32x4*)(op + off + bj * 32 + 4) = x1; }
                    asm volatile("" ::: "memory"); }
            return;
        }
        bf16_t* xp = xo + tb; const LineOffs L = line_offs(lo, ldc, fr);
#pragma unroll
        for (int aim = 0; aim < 4; ++aim) { const int ai = aim >> 1, mp = aim & 1;
            u32x4 bv[2][2];
#pragma unroll
            for (int mm = 0; mm < 2; ++mm)
#pragma unroll
                for (int bj = 0; bj < 2; ++bj) bv[mm][bj] = *(const u32x4*)(bs + lo + (unsigned)((ai * HALF + (2 * mp + mm) * 16) * ldc) + bj * 32);
#pragma unroll
            for (int mm = 0; mm < 2; ++mm) { const int m = 2 * mp + mm; float s = 0.f; u32x4 wv[2];
#pragma unroll
                for (int bj = 0; bj < 2; ++bj) { f32x4 x0, x1; addx(bv[mm][bj], acc[ai][bj][m][0], acc[ai][bj][m][1], x0, x1);
                    wv[bj].x = cvt_pk_bf16(x0[0], x0[1]); wv[bj].y = cvt_pk_bf16(x0[2], x0[3]); wv[bj].z = cvt_pk_bf16(x1[0], x1[1]); wv[bj].w = cvt_pk_bf16(x1[2], x1[3]);
                    s += ((x0[0] * x0[0] + x0[1] * x0[1]) + (x0[2] * x0[2] + x0[3] * x0[3])) + ((x1[0] * x1[0] + x1[1] * x1[1]) + (x1[2] * x1[2] + x1[3] * x1[3])); }
                store_lines(xp + (size_t)((ai * HALF + m * 16) * ldc), L, wv[0], wv[1]);
                s += __shfl_xor(s, 16); s += __shfl_xor(s, 32); if (fq == 0) ssqp[(size_t)(u.pm * BM + wr * 64 + fr + ai * HALF + m * 16) * 32 + u.pn * 4 + wc] = s; }
            asm volatile("" ::: "memory"); }
    }
};
__device__ __forceinline__ float silu_f(float x) { return x * __builtin_amdgcn_rcpf(1.0f + __builtin_amdgcn_exp2f(-1.4426950408889634f * x)); }
struct EpiGate {
    static constexpr bool PERM = true;
    bf16_t* act; int ldact; float* edge; const float* cw; const float* cb; int dff; PG8_LAS float* halo; const float* rstd; const unsigned* wmaxc;
    __device__ __forceinline__ void operator()(f32x4 (&acc)[2][2][4][2], const Unit& u, int wr, int wc, int fr, int fq) const {
        const int lane = fq * 16 + fr; const int colL = wc * 32 + 8 * fq; const int colG = u.pn * HALF + colL;
        f32x4 csc[2][2];
#pragma unroll
        for (int bj = 0; bj < 2; ++bj)
#pragma unroll
            for (int n = 0; n < 2; ++n) { const u32x4 mb = *(const u32x4*)(wmaxc + bj * dff + colG + 4 * n);
                csc[bj][n] = (f32x4){__builtin_bit_cast(float, mb.x), __builtin_bit_cast(float, mb.y), __builtin_bit_cast(float, mb.z), __builtin_bit_cast(float, mb.w)} * (1.0f / 127.0f); }
#pragma unroll
        for (int ai = 0; ai < 2; ++ai)
#pragma unroll
            for (int m = 0; m < 4; ++m) { const float rs = rstd[u.pm * BM + ai * HALF + wr * 64 + m * 16 + fr];
#pragma unroll
                for (int bj = 0; bj < 2; ++bj) { acc[ai][bj][m][0] *= csc[bj][0] * rs; acc[ai][bj][m][1] *= csc[bj][1] * rs; } }
#pragma unroll
        for (int ai = 0; ai < 2; ++ai) { const int q = 2 * ai + wr;
            if (fr == 0) { *(PG8_LAS f32x4*)(halo + (q * 2 + 0) * 128 + colL) = acc[ai][0][0][0]; *(PG8_LAS f32x4*)(halo + (q * 2 + 0) * 128 + colL + 4) = acc[ai][0][0][1]; }
            if (fr == 15) { *(PG8_LAS f32x4*)(halo + (q * 2 + 1) * 128 + colL) = acc[ai][0][3][0]; *(PG8_LAS f32x4*)(halo + (q * 2 + 1) * 128 + colL + 4) = acc[ai][0][3][1]; } }
        asm volatile("s_waitcnt lgkmcnt(0)" ::: "memory"); __builtin_amdgcn_s_barrier(); asm volatile("" ::: "memory");
        bf16_t* actp = act + (size_t)(u.pm * BM) * ldact + colG; const unsigned rlo = (unsigned)((wr * 64 + fr) * ldact);
#pragma unroll
        for (int ai = 0; ai < 2; ++ai) { const int q = 2 * ai + wr;
            typedef unsigned u32x2 __attribute__((ext_vector_type(2)));
            u32x2 pk[4][2];
#pragma unroll
            for (int n = 0; n < 2; ++n) {
                const f32x4 w0 = *(const f32x4*)(cw + colG + 4 * n), w1 = *(const f32x4*)(cw + dff + colG + 4 * n), w2 = *(const f32x4*)(cw + 2 * dff + colG + 4 * n), bb = *(const f32x4*)(cb + colG + 4 * n);
                f32x4 ht = *(PG8_LAS f32x4*)(halo + ((q > 0 ? q - 1 : 0) * 2 + 1) * 128 + colL + 4 * n), hb = *(PG8_LAS f32x4*)(halo + ((q < 3 ? q + 1 : 3) * 2 + 0) * 128 + colL + 4 * n);
                if (q == 0) ht = ht * 0.f; if (q == 3) hb = hb * 0.f;
                f32x4 pre[4];
#pragma unroll
                for (int j = 0; j < 4; ++j) {
                    float g[4], rr[4], rl[4];
#pragma unroll
                    for (int m = 0; m < 4; ++m) { g[m] = acc[ai][0][m][n][j]; rr[m] = dpp_ror1(g[m]); rl[m] = dpp_ror15(g[m]); }
#pragma unroll
                    for (int m = 0; m < 4; ++m) {
                        const float up = (fr > 0) ? rr[m] : (m > 0 ? rr[m > 0 ? m - 1 : 0] : ht[j]);
                        const float dn = (fr < 15) ? rl[m] : (m < 3 ? rl[m < 3 ? m + 1 : 3] : hb[j]);
                        pre[m][j] = w0[j] * up + w1[j] * g[m] + w2[j] * dn + bb[j];
                    }
                }
                if (q == 0 && fr == 0) { float* e = edge + (size_t)((u.pm * 2 + 0) * 3) * dff + colG + 4 * n;
                    *(f32x4*)(e) = acc[ai][0][0][n]; *(f32x4*)(e + dff) = pre[0]; *(f32x4*)(e + 2 * dff) = acc[ai][1][0][n]; }
                if (q == 3 && fr == 15) { float* e = edge + (size_t)((u.pm * 2 + 1) * 3) * dff + colG + 4 * n;
                    *(f32x4*)(e) = acc[ai][0][3][n]; *(f32x4*)(e + dff) = pre[3]; *(f32x4*)(e + 2 * dff) = acc[ai][1][3][n]; }
#pragma unroll
                for (int m = 0; m < 4; ++m) { const f32x4 v = acc[ai][1][m][n];
                    pk[m][n].x = cvt_pk_bf16(silu_f(pre[m][0]) * v[0], silu_f(pre[m][1]) * v[1]); pk[m][n].y = cvt_pk_bf16(silu_f(pre[m][2]) * v[2], silu_f(pre[m][3]) * v[3]); }
            }
#pragma unroll
            for (int m = 0; m < 4; ++m) { u32x4 w; w.x = pk[m][0].x; w.y = pk[m][0].y; w.z = pk[m][1].x; w.w = pk[m][1].y;
                *(u32x4*)(actp + rlo + (unsigned)((ai * HALF + m * 16) * ldact)) = w; }
        }
    }
};

template <class Epi, class Sched, bool I8 = false>
__device__ __forceinline__ void gemm_phase(PG8_LAS unsigned char* lds, const Gemm g, const Sched& S, const Epi& E) {
    typedef typename AccSel<I8>::T acc_t;
    const int tid = opq(threadIdx.x), wid = __builtin_amdgcn_readfirstlane(tid >> 6), lane = tid & 63, wr = wid >> 2, wc = wid & 3, fr = lane & 15, fq = lane >> 4;
    const int K = g.K, nt = K / BK, lda = g.lda;
    unsigned voffA[2], voffB[2];
#pragma unroll
    for (int i = 0; i < 2; ++i) { int R, C; stage_rc(tid * 16 + i * 8192, R, C); const int Rb = Epi::PERM ? (64 * (R >> 5) + perm32(R & 31)) : R;
        voffA[i] = (unsigned)(R * lda + C) * 2u; voffB[i] = (unsigned)(Rb * K + C) * 2u; }
    const size_t kstep = (size_t)(BK * 2);
    const size_t hstepA = (size_t)HALF * lda * 2, hstepB = (size_t)(Epi::PERM ? 32 : HALF) * K * 2;
    const size_t tstepA = 2 * hstepA, tstepB = (size_t)BM * K * 2;
    const unsigned ldsw = (unsigned)wid * 1024u;
    const int aoff = lds_byte(wr * 64 + fr, fq * 8), boff = lds_byte(wc * 32 + fr, fq * 8);
#define PG8_SA(b, h) (((b) * 2 + (h)) * HTB)
#define PG8_SB(b, h) ((4 + (b) * 2 + (h)) * HTB)
#define PG8_STAGE(bufoff, gbase, voff) do { _Pragma("unroll") for (int _i = 0; _i < 2; ++_i) \
        __builtin_amdgcn_global_load_lds((const unsigned*)((const char*)(gbase) + (voff)[_i]), (PG8_LAS unsigned*)(lds + (bufoff) + ldsw + _i * 8192), 16, 0, 0); } while (0)
#define PG8_LDA(dst, b, h) do { _Pragma("unroll") for (int m = 0; m < 4; ++m) _Pragma("unroll") for (int k = 0; k < 2; ++k) dst[m][k] = *(const PG8_LAS bf16x8*)(lds + PG8_SA(b, h) + aoff + m * 2048 + k * 1024); } while (0)
#define PG8_LDB(dst, b, h) do { _Pragma("unroll") for (int n = 0; n < 2; ++n) _Pragma("unroll") for (int k = 0; k < 2; ++k) dst[n][k] = *(const PG8_LAS bf16x8*)(lds + PG8_SB(b, h) + boff + n * 2048 + k * 1024); } while (0)
#define PG8_MMA(ai, bj, At, Bt) do { __builtin_amdgcn_s_setprio(1); _Pragma("unroll") for (int m = 0; m < 4; ++m) _Pragma("unroll") for (int n = 0; n < 2; ++n) _Pragma("unroll") for (int k = 0; k < 2; ++k) { \
        if constexpr (I8) acc[ai][bj][m][n] = __builtin_amdgcn_mfma_i32_16x16x64_i8(__builtin_bit_cast(i32x4, Bt[n][k]), __builtin_bit_cast(i32x4, At[m][k]), acc[ai][bj][m][n], 0, 0, 0); \
        else acc[ai][bj][m][n] = __builtin_amdgcn_mfma_f32_16x16x32_bf16(Bt[n][k], At[m][k], acc[ai][bj][m][n], 0, 0, 0); } __builtin_amdgcn_s_setprio(0); } while (0)
#define PG8_WAIT_V(n) asm volatile("s_waitcnt vmcnt(" #n ")" ::: "memory")
#define PG8_WAIT_L(n) asm volatile("s_waitcnt lgkmcnt(" #n ")" ::: "memory")
#define PG8_BAR __builtin_amdgcn_s_barrier()
#define PG8_SCHED __builtin_amdgcn_sched_barrier(0)
    Unit cur, nxt; int ui = 0;
    if (!S.next(0, cur)) return;
    acc_t acc[2][2][4][2];
{ float zf = 0.f; asm volatile("" : "+v"(zf));
    #pragma unroll
    for (int a = 0; a < 2; ++a)
#pragma unroll
        for (int b = 0; b < 2; ++b)
#pragma unroll
            for (int m = 0; m < 4; ++m)
#pragma unroll
                for (int n = 0; n < 2; ++n) acc[a][b][m][n] = __builtin_bit_cast(acc_t, (f32x4){zf, zf, zf, zf}); }
    bf16x8 At[4][2], B0[2][2], B1[2][2];
    const char* cA = (const char*)g.A + (size_t)cur.pm * tstepA; const char* cB = (const char*)g.Bt + (size_t)cur.pn * tstepB;
    S.a_ready(cur);
    PG8_STAGE(PG8_SB(0, 0), cB, voffB); PG8_STAGE(PG8_SB(0, 1), cB + hstepB, voffB); PG8_STAGE(PG8_SA(0, 0), cA, voffA); PG8_STAGE(PG8_SA(0, 1), cA + hstepA, voffA);
    if (wr == 1) PG8_BAR;
    PG8_WAIT_V(2); PG8_BAR;
    PG8_STAGE(PG8_SB(1, 0), cB + kstep, voffB); PG8_STAGE(PG8_SA(1, 0), cA + kstep, voffA); PG8_STAGE(PG8_SB(1, 1), cB + hstepB + kstep, voffB);
    PG8_WAIT_V(6); PG8_BAR;
    for (;;) {
        const bool has_next = S.next(ui + 1, nxt);
        const char* nA = has_next ? (const char*)g.A + (size_t)nxt.pm * tstepA : cA; const char* nB = has_next ? (const char*)g.Bt + (size_t)nxt.pn * tstepB : cB;
#pragma unroll 1
        for (int t = 0; t < nt; t += 2) {
            const bool last = (t == nt - 2);
            const char* a1 = cA + (size_t)(t + 1) * kstep;
            const char* a2 = last ? nA : cA + (size_t)(t + 2) * kstep; const char* b2 = last ? nB : cB + (size_t)(t + 2) * kstep;
            const char* a3 = a2 + kstep; const char* b3 = b2 + kstep;
            if (last && has_next) S.a_ready(nxt);
            PG8_LDB(B0, 0, 0); PG8_LDB(B1, 0, 1); PG8_SCHED; PG8_LDA(At, 0, 0); PG8_STAGE(PG8_SA(1, 1), a1 + hstepA, voffA);
            PG8_WAIT_V(8); PG8_WAIT_L(0); PG8_BAR; PG8_MMA(0, 0, At, B0); PG8_MMA(0, 1, At, B1); PG8_BAR; PG8_SCHED;
            PG8_LDA(At, 0, 1); PG8_STAGE(PG8_SB(0, 0), b2, voffB); PG8_STAGE(PG8_SB(0, 1), b2 + hstepB, voffB); PG8_STAGE(PG8_SA(0, 0), a2, voffA);
            PG8_WAIT_V(8); PG8_WAIT_L(0); PG8_BAR; PG8_MMA(1, 0, At, B0); PG8_MMA(1, 1, At, B1); PG8_BAR; PG8_SCHED;
            PG8_LDB(B0, 1, 0); PG8_LDB(B1, 1, 1); PG8_SCHED; PG8_LDA(At, 1, 0); PG8_STAGE(PG8_SA(0, 1), a2 + hstepA, voffA);
            PG8_WAIT_V(8); PG8_WAIT_L(0); PG8_BAR; PG8_MMA(0, 0, At, B0); PG8_MMA(0, 1, At, B1); PG8_BAR; PG8_SCHED;
            PG8_LDA(At, 1, 1); PG8_STAGE(PG8_SB(1, 0), b3, voffB); PG8_STAGE(PG8_SB(1, 1), b3 + hstepB, voffB); PG8_STAGE(PG8_SA(1, 0), a3, voffA);
            PG8_WAIT_V(8); PG8_WAIT_L(0); PG8_BAR; PG8_MMA(1, 0, At, B0); PG8_MMA(1, 1, At, B1); PG8_BAR; PG8_SCHED;
        }
        if (wr == 0) PG8_BAR;
        if constexpr (I8) { f32x4 accf[2][2][4][2];
#pragma unroll
            for (int a = 0; a < 2; ++a)
#pragma unroll
                for (int b = 0; b < 2; ++b)
#pragma unroll
                    for (int m = 0; m < 4; ++m)
#pragma unroll
                        for (int n = 0; n < 2; ++n) accf[a][b][m][n] = __builtin_convertvector(acc[a][b][m][n], f32x4);
            E(accf, cur, wr, wc, fr, fq); }
        else E(acc, cur, wr, wc, fr, fq);
        S.done(cur);
        if (!has_next) break;
{ float zf = 0.f; asm volatile("" : "+v"(zf));
        #pragma unroll
        for (int a = 0; a < 2; ++a)
#pragma unroll
            for (int b = 0; b < 2; ++b)
#pragma unroll
                for (int m = 0; m < 4; ++m)
#pragma unroll
                    for (int n = 0; n < 2; ++n) acc[a][b][m][n] = __builtin_bit_cast(acc_t, (f32x4){zf, zf, zf, zf}); }
        cur = nxt; cA = nA; cB = nB; ++ui;
        if (wr == 1) PG8_BAR;
    }
    PG8_WAIT_V(0);
    PG8_BAR;
#undef PG8_SA
#undef PG8_SB
#undef PG8_STAGE
#undef PG8_LDA
#undef PG8_LDB
#undef PG8_MMA
#undef PG8_WAIT_V
#undef PG8_WAIT_L
#undef PG8_BAR
#undef PG8_SCHED
}
}
namespace at {
using bf16 = unsigned short;
using bf16x8 = __attribute__((ext_vector_type(8))) short;
using s16x4  = __attribute__((ext_vector_type(4))) short;
using f32x16 = __attribute__((ext_vector_type(16))) float;
using u32x4  = __attribute__((ext_vector_type(4))) unsigned;
constexpr int DQK = 192, DV = 128, KVBLK = 64, NW = 8, QBLK = 32;
constexpr float SCALE = 0.07216878364870322f;
constexpr float THR = 8.f;
constexpr int LDQ = 1536, LDK = 2560, LDO = 2048;
constexpr int SHM_V = KVBLK * DV * 2, SHM_K = 12 * 2080;
constexpr int QR_OFF = 2 * SHM_V + 2 * SHM_K + NW * 64 * 4;
constexpr int SHM_ATTN = QR_OFF + NW * 4096;
#define SBAR() __builtin_amdgcn_sched_barrier(0)
constexpr int KPL = 2080;
__host__ __device__ __forceinline__ int k_st(int row, int c) { return (c >> 1) * KPL + row * 32 + (((c & 1) ^ ((row >> 3) & 1)) << 4); }
__host__ __device__ __forceinline__ int k_rd_base(int r32, int hi) { return r32 * 32 + ((hi ^ ((r32 >> 3) & 1)) << 4); }
__device__ __forceinline__ int crow(int r, int hi) { return (r & 3) + 8 * (r >> 2) + 4 * hi; }
__device__ __forceinline__ unsigned cvtpk(float lo, float hi) { unsigned r; asm volatile("v_cvt_pk_bf16_f32 %0, %1, %2" : "=v"(r) : "v"(lo), "v"(hi)); return r; }

__device__ __forceinline__ void partialSM(f32x16& p0, f32x16& p1, float& m_reg, float& mn, float& alpha) {
  constexpr float C = 1.0f;
  float pmax = p0[0];
#pragma unroll
  for (int r = 1; r < 16; ++r) pmax = fmaxf(pmax, p0[r]);
#pragma unroll
  for (int r = 0; r < 16; ++r) pmax = fmaxf(pmax, p1[r]);
  { auto rr = __builtin_amdgcn_permlane32_swap(__float_as_uint(pmax), __float_as_uint(pmax), false, false);
    pmax = fmaxf(__uint_as_float(rr[0]), __uint_as_float(rr[1])); }
  if (__builtin_expect(__all(pmax - m_reg <= THR * 1.4426950408889634f), 1)) { mn = m_reg; alpha = 1.f; }
  else { mn = fmaxf(m_reg, pmax); alpha = __builtin_amdgcn_exp2f((m_reg - mn) * C); m_reg = mn; }
  float mnC = -mn * C;
#pragma unroll
  for (int r = 0; r < 16; ++r) p0[r] = fmaf(p0[r], C, mnC);
#pragma unroll
  for (int r = 0; r < 16; ++r) p1[r] = fmaf(p1[r], C, mnC);
#pragma unroll
  for (int r = 0; r < 16; ++r) p0[r] = __builtin_amdgcn_exp2f(p0[r]);
}
__device__ __forceinline__ void partialSM_fast(f32x16& p0, f32x16& p1, float negMC) {
  (void)negMC; (void)p1;
#pragma unroll
  for (int r = 0; r < 16; ++r) p0[r] = __builtin_amdgcn_exp2f(p0[r]);
}
__device__ __forceinline__ void finishSM(f32x16& p0, f32x16& p1, float alpha, float& l_reg, bf16x8& pa0, bf16x8& pa1, bf16x8& pa2, bf16x8& pa3) {
#pragma unroll
  for (int r = 0; r < 16; ++r) p1[r] = __builtin_amdgcn_exp2f(p1[r]);
  float ps = 0;
#pragma unroll
  for (int r = 0; r < 16; ++r) ps += p0[r];
#pragma unroll
  for (int r = 0; r < 16; ++r) ps += p1[r];
  { auto rr = __builtin_amdgcn_permlane32_swap(__float_as_uint(ps), __float_as_uint(ps), false, false);
    ps = __uint_as_float(rr[0]) + __uint_as_float(rr[1]); }
  l_reg = l_reg * alpha + ps;
#define PK4(P, BASE, OUT) do { unsigned a0 = cvtpk(P[BASE + 0], P[BASE + 1]), a1 = cvtpk(P[BASE + 2], P[BASE + 3]);   \
    unsigned b0 = cvtpk(P[BASE + 4], P[BASE + 5]), b1 = cvtpk(P[BASE + 6], P[BASE + 7]);                              \
    auto r0 = __builtin_amdgcn_permlane32_swap(a0, b0, false, false); auto r1 = __builtin_amdgcn_permlane32_swap(a1, b1, false, false); \
    u32x4 w = {r0[0], r1[0], r0[1], r1[1]}; OUT = *reinterpret_cast<bf16x8*>(&w); } while (0)
  PK4(p0, 0, pa0); PK4(p0, 8, pa1); PK4(p1, 0, pa2); PK4(p1, 8, pa3);
#undef PK4
}
template <int OFF> __device__ __forceinline__ bf16x8 k_read(int kb) {
  bf16x8 r; asm volatile("ds_read_b128 %0, %1 offset:%2" : "=v"(r) : "v"(kb), "i"(OFF) : "memory"); return r;
}
__device__ __forceinline__ void qkt(f32x16& p0, f32x16& p1, int kb, const bf16x8* qr, int qb) {
  p0 = f32x16{}; p1 = f32x16{};
#define QK1(d0) { const bf16x8 b0 = *(const __attribute__((address_space(3))) bf16x8*)(kb + d0 * KPL), b1 = *(const __attribute__((address_space(3))) bf16x8*)(kb + d0 * KPL + 1024); \
    p0 = __builtin_amdgcn_mfma_f32_32x32x16_bf16(b0, qr[d0], p0, 0, 0, 0); p1 = __builtin_amdgcn_mfma_f32_32x32x16_bf16(b1, qr[d0], p1, 0, 0, 0); }
#define QK2(d0) { const bf16x8 b0 = *(const __attribute__((address_space(3))) bf16x8*)(kb + d0 * KPL), b1 = *(const __attribute__((address_space(3))) bf16x8*)(kb + d0 * KPL + 1024); \
    const bf16x8 qf = *(const __attribute__((address_space(3))) bf16x8*)(qb + (d0 - 8) * 1024); \
    p0 = __builtin_amdgcn_mfma_f32_32x32x16_bf16(b0, qf, p0, 0, 0, 0); p1 = __builtin_amdgcn_mfma_f32_32x32x16_bf16(b1, qf, p1, 0, 0, 0); }
  QK1(0) QK1(1) QK1(2) QK1(3) QK1(4) QK1(5) QK1(6) QK1(7) QK2(8) QK2(9) QK2(10) QK2(11)
#undef QK1
#undef QK2
}
__host__ __device__ __forceinline__ int v_st(int k, int c) { const int kk = (k & ~0xC) | ((k & 4) << 1) | ((k & 8) >> 1); return ((kk >> 3) * 4 + (c >> 5)) * 512 + ((kk & 7) * 32 + (c & 31)) * 2; }
__device__ __forceinline__ int v_rd_base(int lane) { return ((lane & 3) << 3) | (((lane >> 2) & 3) << 6) | (((lane >> 4) & 1) << 5) | (((lane >> 5) & 1) << 8); }
constexpr int v_rd_off(int d0, int ks, int half) { return d0 * 512 + ks * 4096 + half * 2048; }
template <int OFF> __device__ __forceinline__ s16x4 tr_read(int vb) {
  s16x4 r; asm volatile("ds_read_b64_tr_b16 %0, %1 offset:%2" : "=&v"(r) : "v"(vb), "i"(OFF) : "memory"); return r;
}
template <int D0> __device__ __forceinline__ void pv_one(f32x16& od, int vb, bf16x8 pa0, bf16x8 pa1, bf16x8 pa2, bf16x8 pa3) {
  const s16x4 l0 = tr_read<v_rd_off(D0, 0, 0)>(vb), h0 = tr_read<v_rd_off(D0, 0, 1)>(vb), l1 = tr_read<v_rd_off(D0, 1, 0)>(vb), h1 = tr_read<v_rd_off(D0, 1, 1)>(vb);
  const s16x4 l2 = tr_read<v_rd_off(D0, 2, 0)>(vb), h2 = tr_read<v_rd_off(D0, 2, 1)>(vb), l3 = tr_read<v_rd_off(D0, 3, 0)>(vb), h3 = tr_read<v_rd_off(D0, 3, 1)>(vb);
  asm volatile("s_waitcnt lgkmcnt(0)" ::: "memory"); SBAR();
#define PK(L, H) (bf16x8){L[0], L[1], L[2], L[3], H[0], H[1], H[2], H[3]}
  od = __builtin_amdgcn_mfma_f32_32x32x16_bf16(pa0, PK(l0, h0), od, 0, 0, 0);
  od = __builtin_amdgcn_mfma_f32_32x32x16_bf16(pa1, PK(l1, h1), od, 0, 0, 0);
  od = __builtin_amdgcn_mfma_f32_32x32x16_bf16(pa2, PK(l2, h2), od, 0, 0, 0);
  od = __builtin_amdgcn_mfma_f32_32x32x16_bf16(pa3, PK(l3, h3), od, 0, 0, 0);
#undef PK
}
__device__ __forceinline__ void pv_d0(f32x16* o, int vb, bf16x8 pa0, bf16x8 pa1, bf16x8 pa2, bf16x8 pa3) {
  pv_one<0>(o[0], vb, pa0, pa1, pa2, pa3); pv_one<1>(o[1], vb, pa0, pa1, pa2, pa3); pv_one<2>(o[2], vb, pa0, pa1, pa2, pa3); pv_one<3>(o[3], vb, pa0, pa1, pa2, pa3);
}

template <bool FAST>
__device__ __forceinline__ void attn_unit(const float negMC, const bf16* __restrict__ Qb, const bf16* __restrict__ Kh, const bf16* __restrict__ Vh, bf16* __restrict__ Ob, int seq, char* lds) {
  const int tid = opq(threadIdx.x), wid = tid >> 6, lane = tid & 63, r32 = lane & 31, hi = lane >> 5;
  char* V_lds = lds; char* K_lds = lds + 2 * SHM_V;
  float* ws = (float*)(lds + 2 * SHM_V + 2 * SHM_K) + wid * 64; float* li_l = ws; float* al_l = ws + 32;
  float m_reg = -1e30f, l_reg = 0; f32x16 o[4] = {}; bf16x8 qr[8];
  const bf16* Qw = Qb + (unsigned)((wid * QBLK + r32) * LDQ + hi * 8);
#pragma unroll
  for (int d0 = 0; d0 < 8; ++d0) qr[d0] = *reinterpret_cast<const bf16x8*>(Qw + d0 * 16);
  const int qb0 = (int)(uintptr_t)lds + QR_OFF + wid * 4096 + k_rd_base(r32, hi);
#pragma unroll
  for (int d0 = 8; d0 < 12; ++d0) *(__attribute__((address_space(3))) bf16x8*)(qb0 + (d0 - 8) * 1024) = *reinterpret_cast<const bf16x8*>(Qw + d0 * 16);
  const int sr = tid >> 4, sc = (tid & 15) * 8, vst0 = v_st(sr, sc), vst1 = v_st(32 + sr, sc);
  unsigned koff[3]; int kst[3];
#pragma unroll
  for (int i = 0; i < 3; ++i) { const int q = tid + 512 * i; koff[i] = (unsigned)((q / 24) * LDK + (q % 24) * 8); kst[i] = k_st(q / 24, q % 24); }
  const unsigned voff0 = (unsigned)(sr * LDK + sc), voff1 = (unsigned)((32 + sr) * LDK + sc);
  const int vb0 = (int)(uintptr_t)V_lds + v_rd_base(lane); const int kb0 = (int)(uintptr_t)K_lds + k_rd_base(r32, hi);
  struct { bf16x8 vs0, vs1, ks0, ks1, ks2; } sr_[1];
#define SLOAD(i, k0) do { const bf16* vt = Vh + (size_t)(k0) * LDK; const bf16* kt = Kh + (size_t)(k0) * LDK; \
    sr_[i].vs0 = *(const bf16x8*)(vt + voff0); sr_[i].vs1 = *(const bf16x8*)(vt + voff1); \
    sr_[i].ks0 = *(const bf16x8*)(kt + koff[0]); sr_[i].ks1 = *(const bf16x8*)(kt + koff[1]); sr_[i].ks2 = *(const bf16x8*)(kt + koff[2]); } while (0)
#define SWRITE(b, i) do { *(bf16x8*)(V_lds + (b) * SHM_V + vst0) = sr_[i].vs0; *(bf16x8*)(V_lds + (b) * SHM_V + vst1) = sr_[i].vs1; \
    *(bf16x8*)(K_lds + (b) * SHM_K + kst[0]) = sr_[i].ks0; *(bf16x8*)(K_lds + (b) * SHM_K + kst[1]) = sr_[i].ks1; *(bf16x8*)(K_lds + (b) * SHM_K + kst[2]) = sr_[i].ks2; } while (0)
#define SWAIT() do { if constexpr (SDEPTH == 2) asm volatile("s_waitcnt vmcnt(5)" ::: "memory"); else asm volatile("s_waitcnt vmcnt(0)" ::: "memory"); } while (0)
#define RESC(a) do { if (__any((a) < 1.f)) { if (hi == 0) al_l[r32] = (a); asm volatile("s_waitcnt lgkmcnt(0)" ::: "memory"); \
    _Pragma("unroll") for (int d = 0; d < 4; ++d) _Pragma("unroll") for (int r = 0; r < 16; ++r) o[d][r] *= al_l[crow(r, hi)]; } } while (0)
  f32x16 pA0, pA1, pB0, pB1; float mnA, mnB, alA, alB; bf16x8 pa0, pa1, pa2, pa3; const int NT = seq / KVBLK;
#define PSM(P0, P1, MN, AL) do { if constexpr (FAST) { partialSM_fast(P0, P1, negMC); AL = 1.f; } else partialSM(P0, P1, m_reg, MN, AL); } while (0)
#define RSC(AL) do { if constexpr (!FAST) RESC(AL); } while (0)
  SLOAD(0, 0); asm volatile("s_waitcnt vmcnt(0)" ::: "memory"); SWRITE(0, 0); __syncthreads();
  qkt(pA0, pA1, kb0, qr, qb0); PSM(pA0, pA1, mnA, alA);
  SLOAD(0, KVBLK);
  asm volatile("s_waitcnt vmcnt(0)" ::: "memory"); SWRITE(1, 0); __syncthreads();
  for (int j = 1; j + 1 < NT; j += 2) {
    SBAR(); qkt(pB0, pB1, kb0 + SHM_K, qr, qb0);
    finishSM(pA0, pA1, alA, l_reg, pa0, pa1, pa2, pa3); SBAR();
    SLOAD(0, (j + 1) * KVBLK); SBAR();
    pv_d0(o, vb0, pa0, pa1, pa2, pa3); PSM(pB0, pB1, mnB, alB);
    __syncthreads(); asm volatile("s_waitcnt vmcnt(0)" ::: "memory"); SWRITE(0, 0);
    RSC(alB); __syncthreads();
    SBAR(); qkt(pA0, pA1, kb0, qr, qb0);
    finishSM(pB0, pB1, alB, l_reg, pa0, pa1, pa2, pa3); SBAR();
    SLOAD(0, (j + 2) * KVBLK); SBAR();
    pv_d0(o, vb0 + (int)SHM_V, pa0, pa1, pa2, pa3); PSM(pA0, pA1, mnA, alA);
    __syncthreads(); asm volatile("s_waitcnt vmcnt(0)" ::: "memory"); SWRITE(1, 0);
    RSC(alA); __syncthreads();
  }
  SBAR(); qkt(pB0, pB1, kb0 + SHM_K, qr, qb0);
  finishSM(pA0, pA1, alA, l_reg, pa0, pa1, pa2, pa3); SBAR();
  pv_d0(o, vb0, pa0, pa1, pa2, pa3); PSM(pB0, pB1, mnB, alB);
  __syncthreads(); RSC(alB);
  finishSM(pB0, pB1, alB, l_reg, pa0, pa1, pa2, pa3); SBAR();
  pv_d0(o, vb0 + (int)SHM_V, pa0, pa1, pa2, pa3);
  if (hi == 0) li_l[r32] = l_reg; asm volatile("s_waitcnt lgkmcnt(0)" ::: "memory");
  bf16* Ow = Ob + (unsigned)(wid * QBLK * LDO + r32);
#pragma unroll
  for (int r = 0; r < 16; ++r) { const int orow = crow(r, hi); const float rl = __builtin_amdgcn_rcpf(li_l[orow]);
#pragma unroll
    for (int d0 = 0; d0 < 4; ++d0) { const unsigned w = cvtpk(o[d0][r] * rl, 0.f); Ow[(unsigned)(orow * LDO + d0 * 32)] = (bf16)(w & 0xffffu); } }
  __syncthreads();
#undef SLOAD
#undef SWRITE
#undef SWAIT
#undef RESC
#undef PSM
#undef RSC
}
}
namespace hy {
#define HY_LAS __attribute__((address_space(3)))
typedef unsigned short bf16;
typedef short bf16x8 __attribute__((ext_vector_type(8)));
typedef float f32x16 __attribute__((ext_vector_type(16)));
typedef unsigned u32x2 __attribute__((ext_vector_type(2)));
typedef unsigned u32x4 __attribute__((ext_vector_type(4)));
constexpr int L = 2048, NB = 24, CH = 512;
constexpr int RFS = 4112;
constexpr int ZROW = 4112;
constexpr int ZL_BYTES = NB * ZROW;
constexpr int RCS = 8256;
constexpr int RC_OFF = ZL_BYTES;
constexpr int HY_LDS_BYTES = RC_OFF + 4 * RCS;
__device__ __forceinline__ unsigned cvtpk(float lo, float hi) { unsigned r; asm volatile("v_cvt_pk_bf16_f32 %0, %1, %2" : "=v"(r) : "v"(lo), "v"(hi)); return r; }
__host__ __device__ __forceinline__ int frag_base(int tw, int r, int h) { const int a = (4 - (r & 3)) & 3; return RC_OFF + a * RCS + 2 * (2048 - tw - r + 8 * h - a); }
__host__ __device__ __forceinline__ int zfrag_base(int r, int h) { return (r < NB ? r : NB - 1) * ZROW + 16 * h; }

__device__ __forceinline__ bf16x8 ld_frag(HY_LAS unsigned char* lds, int off) {
    const u32x2 lo = *(const HY_LAS u32x2*)(lds + off), hi = *(const HY_LAS u32x2*)(lds + off + 8);
    u32x4 w = {lo.x, lo.y, hi.x, hi.y}; return *reinterpret_cast<bf16x8*>(&w);
}
__device__ __forceinline__ bf16x8 ld_b128(HY_LAS unsigned char* lds, int off) { return *(const HY_LAS bf16x8*)(lds + off); }

__device__ __forceinline__ void conv_unit(HY_LAS unsigned char* lds, const bf16* __restrict__ ZT, const bf16* __restrict__ RF, bf16* __restrict__ YC, int c, int half) {
    const int tid = opq(threadIdx.x), wid = tid >> 6, lane = tid & 63, r = lane & 31, h = lane >> 5;
    { const u32x4* src = (const u32x4*)(ZT + (size_t)c * NB * L);
#pragma unroll
      for (int i = 0; i < 12; ++i) { const int q = tid + 512 * i; const u32x4 v = src[q]; *(HY_LAS u32x4*)(lds + (q >> 8) * ZROW + (q & 255) * 16) = v; } }
    { const bf16* rf = RF + (size_t)c * RFS;
      for (int ch = tid; ch < RFS / 8; ch += 512) {
          const u32x4 v = *(const u32x4*)(rf + ch * 8); const unsigned w[4] = {v.x, v.y, v.z, v.w};
#pragma unroll
          for (int j = 0; j < 8; ++j) { const unsigned short e = (unsigned short)((w[j >> 1] >> ((j & 1) * 16)) & 0xffffu); const int idx = ch * 8 + j;
#pragma unroll
              for (int a = 0; a < 4; ++a) if (idx - a >= 0) *(HY_LAS unsigned short*)(lds + RC_OFF + a * RCS + 2 * (idx - a)) = e; } } }
    __syncthreads();
    const int tw = half * 1024 + wid * 128;
    const int fb = frag_base(tw, r, h), zb = zfrag_base(r, h);
    f32x16 acc[4] = {};
    bf16x8 S0[2], S1[2], S2[2], S3[2], Bc[2], Bn[2];
#define HY_LDG(S, d) do { S[0] = ld_frag(lds, fb + 64 * (d)); S[1] = ld_frag(lds, fb + 64 * (d) + 32); } while (0)
#define HY_LDB(Bx, n) do { Bx[0] = ld_b128(lds, zb + 64 * (n)); Bx[1] = ld_b128(lds, zb + 64 * (n) + 32); } while (0)
#define HY_MM(i, S, Bx) do { acc[i] = __builtin_amdgcn_mfma_f32_32x32x16_bf16(S[0], Bx[0], acc[i], 0, 0, 0); acc[i] = __builtin_amdgcn_mfma_f32_32x32x16_bf16(S[1], Bx[1], acc[i], 0, 0, 0); } while (0)
#define HY_ITER(n, Sa, Sb, Sc, Sd, Bcur, Bnext) do { HY_LDG(Sa, (n)); if ((n) + 1 < 64) HY_LDB(Bnext, (n) + 1); \
        HY_MM(1, Sb, Bcur); HY_MM(2, Sc, Bcur); HY_MM(3, Sd, Bcur); HY_MM(0, Sa, Bcur); } while (0)
    HY_LDG(S3, -1); HY_LDG(S2, -2); HY_LDG(S1, -3); HY_LDB(Bc, 0);
    for (int n = 0; n < 64; n += 4) {
        HY_ITER(n, S0, S3, S2, S1, Bc, Bn);
        HY_ITER(n + 1, S1, S0, S3, S2, Bn, Bc);
        HY_ITER(n + 2, S2, S1, S0, S3, Bc, Bn);
        HY_ITER(n + 3, S3, S2, S1, S0, Bn, Bc);
    }
#undef HY_LDG
#undef HY_LDB
#undef HY_MM
#undef HY_ITER
    if (r < NB) { bf16* yp = YC + ((size_t)c * NB + r) * L + tw + 4 * h;
#pragma unroll
        for (int i = 0; i < 4; ++i)
#pragma unroll
            for (int q4 = 0; q4 < 4; ++q4) { u32x2 w; w.x = cvtpk(acc[i][4 * q4 + 0], acc[i][4 * q4 + 1]); w.y = cvtpk(acc[i][4 * q4 + 2], acc[i][4 * q4 + 3]);
                *(u32x2*)(yp + 32 * i + 8 * q4) = w; } }
    __syncthreads();
}
}
constexpr int NWAVES = 8;
#ifndef MK_ONE_LAUNCH
#define MK_ONE_LAUNCH 1
#endif
constexpr int DM = 2048, NSEQ = 24, SEQ = 2048, M = NSEQ * SEQ, MP = 8 * SEQ;
constexpr int DEPTH = 4;
constexpr int DIN = 2880, DINP = 3072;
constexpr int O_CQ = 512, O_CKV = 1024, O_KPE = 1280, O_HY = 1344;
constexpr int NH = 8, NQ = 1536, NKVP = 2560, KVHS = 320;
constexpr int DFF = 5632, NUP = 11264, HYC = 512;
constexpr float EPS = 1e-6f;
constexpr int NPH = 11;
constexpr size_t WS_CTL = 0, CTL_BYTES = 1u << 20;
constexpr size_t SZ_BTIN = (size_t)DINP * DM * 2, SZ_BTUQ = (size_t)NQ * 512 * 2, SZ_BTKV = (size_t)NKVP * 256 * 2, SZ_BTOUT = (size_t)DM * DM * 2, SZ_BTUP = (size_t)NUP * DM * 2, SZ_BTDN = (size_t)DM * DFF * 2;
constexpr size_t WS_BTIN = WS_CTL + CTL_BYTES, WS_BTUQ = WS_BTIN + SZ_BTIN, WS_BTKV = WS_BTUQ + SZ_BTUQ, WS_BTOUT = WS_BTKV + SZ_BTKV, WS_BTUP = WS_BTOUT + SZ_BTOUT, WS_BTDN = WS_BTUP + SZ_BTUP;
constexpr size_t WS_RF = WS_BTDN + SZ_BTDN, SZ_RF = (size_t)HYC * hy::RFS * 2;
constexpr size_t WS_H = WS_RF + SZ_RF, SZ_H = (size_t)M * DM * 2;
constexpr size_t WS_PROJ = WS_H + SZ_H, SZ_PROJ = (size_t)M * DINP * 2;
constexpr size_t WS_Q = WS_PROJ + SZ_PROJ, SZ_Q = (size_t)M * NQ * 2;
constexpr size_t WS_KV = WS_Q + SZ_Q, SZ_KV = (size_t)M * NKVP * 2;
constexpr size_t WS_ZT = WS_KV + SZ_KV, SZ_ZT = (size_t)HYC * NSEQ * SEQ * 2;
constexpr size_t WS_X0 = WS_ZT + SZ_ZT, WS_YC = WS_X0 + SZ_ZT;
constexpr size_t WS_EDGE = WS_YC + SZ_ZT, SZ_EDGE = (size_t)(M / 256) * 2 * 3 * DFF * 4;
constexpr size_t WS_ROPE = WS_EDGE + SZ_EDGE, SZ_ROPE = (size_t)SEQ * 64 * 4;
constexpr size_t WS_SSQP = WS_ROPE + SZ_ROPE, SZ_SSQP = (size_t)M * 32 * 4;
constexpr size_t WS_RSTD = WS_SSQP + SZ_SSQP, SZ_RSTD = (size_t)M * 4;
constexpr size_t WS_XQ = WS_RSTD + SZ_RSTD, SZ_XQ = (size_t)M * DM;
constexpr size_t WS_END = WS_XQ + SZ_XQ;
constexpr size_t WS_ACT = WS_PROJ;
static_assert((size_t)M * DFF * 2 <= SZ_PROJ + SZ_Q + SZ_KV, "ACT overlay");
constexpr size_t WS_XB2 = WS_ACT + (size_t)M * DFF * 2;
static_assert(WS_XB2 + (size_t)M * DM * 2 <= WS_EDGE && WS_XB2 % 256 == 0, "XB2 overlay");
static_assert(WS_BTIN % 256 == 0 && WS_RF % 256 == 0 && WS_H % 256 == 0 && WS_PROJ % 256 == 0 && WS_Q % 256 == 0 && WS_KV % 256 == 0 && WS_ZT % 256 == 0 && WS_EDGE % 256 == 0, "alignment");
constexpr int CW_WMAXC = 65536;
constexpr int CW_WMAX = 1024;
constexpr int CW_BAR = 4096;
constexpr int RING_BYTES = 135168;
constexpr int HALO_OFF = RING_BYTES, HALO_BYTES = 4096;
constexpr int MISC_OFF = HALO_OFF + HALO_BYTES;
constexpr int LDS_BYTES = 147456;
static_assert(hy::HY_LDS_BYTES <= RING_BYTES && at::SHM_ATTN <= RING_BYTES && MISC_OFF + 256 <= LDS_BYTES, "LDS map");

#define GAS __attribute__((address_space(1)))
#define LAS __attribute__((address_space(3)))
typedef unsigned short bf16;
typedef unsigned v4u __attribute__((ext_vector_type(4)));
typedef unsigned v2u __attribute__((ext_vector_type(2)));
typedef float f32x4 __attribute__((ext_vector_type(4)));
#define LDS_WAIT() asm volatile("s_waitcnt lgkmcnt(0)" ::: "memory")
__device__ __forceinline__ unsigned f2bf(float f) { unsigned u = __builtin_bit_cast(unsigned, f); return (u + 0x7fffu + ((u >> 16) & 1u)) >> 16; }
__device__ __forceinline__ unsigned pk2(float lo, float hi) { return f2bf(lo) | (f2bf(hi) << 16); }
__device__ __forceinline__ float bf2f(unsigned short b) { return __builtin_bit_cast(float, (unsigned)b << 16); }
__device__ __forceinline__ float bflo(unsigned w) { return __builtin_bit_cast(float, w << 16); }
__device__ __forceinline__ float bfhi(unsigned w) { return __builtin_bit_cast(float, w & 0xffff0000u); }
__device__ __forceinline__ float wave_sum(float v) {
#pragma unroll
    for (int o = 1; o < 64; o <<= 1) v += __shfl_xor(v, o);
    return v;
}

#define XB_TMO      128
#define XB_XCNT(j)  (256  + 64 * (j))
#define XB_XSUB(j)  (1280 + 64 * (j))
#define XB_XGEN(j)  (2304 + 64 * (j))
#define XB_TOP      3328
#define XB_TOPGEN   3392
#define XCD_BAR_WORDS 3456
#define XB_SPIN_CAP (1u << 18)
__device__ __forceinline__ unsigned xb_ld(unsigned* p)              { return __hip_atomic_load(p, __ATOMIC_RELAXED, __HIP_MEMORY_SCOPE_AGENT); }
__device__ __forceinline__ unsigned xb_add(unsigned* p, unsigned v) { return __hip_atomic_fetch_add(p, v, __ATOMIC_RELAXED, __HIP_MEMORY_SCOPE_AGENT); }
__device__ __forceinline__ unsigned xb_xcc_id() { return (unsigned)__builtin_amdgcn_s_getreg((3 << 11) | 20) & 0xFu; }
#define XB_SPIN(cond, bar) do { unsigned _sp = 0; while (cond) { __builtin_amdgcn_s_sleep(1); \
    if ((++_sp & 255u) == 0u) { if (xb_ld(&(bar)[XB_TMO])) break; if (_sp > XB_SPIN_CAP) { atomicAdd(&(bar)[XB_TMO], 1u); break; } } } } while (0)
struct XcdBarrier { unsigned* bar; unsigned x; volatile LAS unsigned* st; };
__device__ __forceinline__ XcdBarrier xcd_barrier_post(unsigned* bar, volatile LAS unsigned* st) {
    XcdBarrier b; b.bar = bar; b.x = xb_xcc_id(); b.st = st;
    if (threadIdx.x == 0) (void)xb_add(&bar[XB_XCNT(b.x)], 1u);
    return b;
}
__device__ __forceinline__ void xcd_barrier_complete(unsigned* bar, unsigned x, unsigned& nloc, unsigned& nx) {
    const unsigned G = gridDim.x * gridDim.y * gridDim.z;
    unsigned sum, cnt, mine, sp = 0u;
    for (;;) {
        sum = 0u; cnt = 0u; mine = 0u;
#pragma unroll
        for (unsigned j = 0; j < 16; ++j) { const unsigned c = xb_ld(&bar[XB_XCNT(j)]); sum += c; cnt += (c > 0u) ? 1u : 0u; mine = (j == x) ? c : mine; }
        if (sum == G) break;
        __builtin_amdgcn_s_sleep(1);
        if ((++sp & 255u) == 0u) { if (xb_ld(&bar[XB_TMO])) break; if (sp > XB_SPIN_CAP) { atomicAdd(&bar[XB_TMO], 1u); break; } }
    }
    nloc = mine > 0u ? mine : 1u; nx = cnt > 0u ? cnt : 1u;
}
__device__ __forceinline__ void xcd_barrier(const XcdBarrier& b) {
    asm volatile("s_waitcnt vmcnt(0)" ::: "memory");
    __syncthreads();
    if (threadIdx.x == 0) {
        unsigned* bar = b.bar;
        __builtin_amdgcn_s_waitcnt(0);
        unsigned nloc = b.st[0], nx = b.st[1];
        if (nloc == 0u) { xcd_barrier_complete(bar, b.x, nloc, nx); b.st[0] = nloc; b.st[1] = nx; }
        const unsigned old = xb_add(&bar[XB_XSUB(b.x)], 1u);
        const unsigned gen = old / nloc;
        if (old + 1u == (gen + 1u) * nloc) {
            __builtin_amdgcn_fence(__ATOMIC_RELEASE, "agent");
            asm volatile("s_waitcnt vmcnt(0)" ::: "memory");
            const unsigned og = xb_add(&bar[XB_TOP], 1u);
            const unsigned tg = og / nx;
            if (og + 1u == (tg + 1u) * nx) xb_add(&bar[XB_TOPGEN], 1u);
            else XB_SPIN(xb_ld(&bar[XB_TOPGEN]) == tg, bar);
            __builtin_amdgcn_fence(__ATOMIC_ACQUIRE, "agent");
            xb_add(&bar[XB_XGEN(b.x)], 1u);
            asm volatile("s_waitcnt vmcnt(0)" ::: "memory");
        } else {
            XB_SPIN(xb_ld(&bar[XB_XGEN(b.x)]) == gen, bar);
            __builtin_amdgcn_fence(__ATOMIC_ACQUIRE, "agent");
            asm volatile("s_waitcnt vmcnt(0)" ::: "memory");
        }
    }
    __syncthreads();
}

struct Frame {
    LAS unsigned char* lds;
    int tid, lane, wave, vcu, G;
};
enum { I_XP = 0, I_XS, I_ANG, I_WIN, I_PW, I_PS, I_QNG, I_WUQ, I_KVNG, I_WUKV, I_QHG, I_KHG, I_HCW, I_HCB, I_FW1, I_FB1, I_FFR, I_FW2, I_FB2, I_FW3, I_FB3, I_HBIAS, I_GNG, I_WOUT, I_FNG, I_WUP, I_FCW, I_FCB, I_WDN, N_IN };
struct Args { const float* in[N_IN]; float* out; unsigned char* ws; int ph_lo, ph_hi; };
static_assert(sizeof(Args) == (N_IN + 2) * 8 + 8, "Args has no padding");

__device__ __forceinline__ void cvt_item(const float* __restrict__ W, int ldw, int K, bf16* WT, int dst_n0, int src_n0, int k0, const float* __restrict__ ks, LAS float* scr, int lane) {
#pragma unroll
    for (int i = 0; i < 32; ++i) { const int kk = 2 * i + (lane >> 5); float v = W[(size_t)(k0 + kk) * ldw + src_n0 + (lane & 31)]; if (ks) v *= ks[k0 + kk]; scr[kk * 33 + (lane & 31)] = v; }
    LDS_WAIT(); asm volatile("" ::: "memory");
    const int c = lane & 7;
#pragma unroll
    for (int j = 0; j < 4; ++j) { const int n = (lane >> 3) + 8 * j; const LAS float* s = scr + (8 * c) * 33 + n;
        v4u o; o.x = pk2(s[0 * 33], s[1 * 33]); o.y = pk2(s[2 * 33], s[3 * 33]); o.z = pk2(s[4 * 33], s[5 * 33]); o.w = pk2(s[6 * 33], s[7 * 33]);
        *(v4u*)(WT + (size_t)(dst_n0 + n) * K + k0 + 8 * c) = o; }
    LDS_WAIT(); asm volatile("" ::: "memory");
}
struct CvtTile { const float* W; const float* ks; bf16* WT; int ldw, K, src_n0, k0, ncols; int dst[4]; };
__device__ __forceinline__ void cvt_tile(Frame& F, const CvtTile& d) {
    LAS float* T = (LAS float*)F.lds;
#pragma unroll
    for (int i = 0; i < 8; ++i) { const int q = F.tid + 512 * i, row = q >> 5, c4 = q & 31;
        f32x4 v = {0.f, 0.f, 0.f, 0.f};
        if (d.src_n0 + 4 * c4 < d.ncols) v = *(const f32x4*)(d.W + (size_t)(d.k0 + row) * d.ldw + d.src_n0 + 4 * c4);
        if (d.ks) v *= d.ks[d.k0 + row];
        LAS float* t = T + row * 129 + 4 * c4; t[0] = v.x; t[1] = v.y; t[2] = v.z; t[3] = v.w; }
    __syncthreads();
#pragma unroll
    for (int i = 0; i < 4; ++i) { const int n = (F.tid >> 4) + 32 * i, kc = F.tid & 15;
        if (d.src_n0 + n < d.ncols) { const LAS float* s = T + (8 * kc) * 129 + n;
            v4u o; o.x = pk2(s[0], s[129]); o.y = pk2(s[2 * 129], s[3 * 129]); o.z = pk2(s[4 * 129], s[5 * 129]); o.w = pk2(s[6 * 129], s[7 * 129]);
            *(v4u*)(d.WT + (size_t)(d.dst[i] + (n & 31)) * d.K + d.k0 + 8 * kc) = o; } }
    __syncthreads();
}
__device__ __forceinline__ void absmax_tile(Frame& F, const float* __restrict__ W, const float* __restrict__ ks, int ldw, int src_n0, int k0, unsigned* outc) {
    LAS float* P = (LAS float*)F.lds;
    f32x4 m = {0.f, 0.f, 0.f, 0.f};
#pragma unroll
    for (int i = 0; i < 8; ++i) { const int q = F.tid + 512 * i, row = q >> 5, c4 = q & 31;
        const f32x4 v = *(const f32x4*)(W + (size_t)(k0 + row) * ldw + src_n0 + 4 * c4) * ks[k0 + row];
        m.x = fmaxf(m.x, fabsf(v.x)); m.y = fmaxf(m.y, fabsf(v.y)); m.z = fmaxf(m.z, fabsf(v.z)); m.w = fmaxf(m.w, fabsf(v.w)); }
    *(LAS f32x4*)(P + (F.tid >> 5) * 128 + 4 * (F.tid & 31)) = m;
    __syncthreads();
    if (F.tid < 128) { float c = P[F.tid];
#pragma unroll
        for (int g = 1; g < 16; ++g) c = fmaxf(c, P[g * 128 + F.tid]);
        atomicMax(outc + src_n0 + F.tid, __builtin_bit_cast(unsigned, c)); }
    __syncthreads();
}
__device__ __forceinline__ unsigned q8(float v) { const int q = (int)__builtin_rintf(v); return (unsigned)(q < -127 ? -127 : (q > 127 ? 127 : q)) & 0xffu; }
__device__ __forceinline__ void cvtq_tile(Frame& F, const float* __restrict__ W, const float* __restrict__ ks, int ldw, int K, unsigned char* WT, int src_n0, int k0, int dst0, const unsigned* __restrict__ wmaxc) {
    LAS float* T = (LAS float*)F.lds;
    f32x4 inv4; { const v4u mb = *(const v4u*)(wmaxc + src_n0 + 4 * (F.tid & 31));
        inv4.x = 127.0f / fmaxf(__builtin_bit_cast(float, mb.x), 1e-30f); inv4.y = 127.0f / fmaxf(__builtin_bit_cast(float, mb.y), 1e-30f); inv4.z = 127.0f / fmaxf(__builtin_bit_cast(float, mb.z), 1e-30f); inv4.w = 127.0f / fmaxf(__builtin_bit_cast(float, mb.w), 1e-30f); }
#pragma unroll
    for (int i = 0; i < 8; ++i) { const int q = F.tid + 512 * i, row = q >> 5, c4 = q & 31;
        const f32x4 v = *(const f32x4*)(W + (size_t)(k0 + row) * ldw + src_n0 + 4 * c4) * ks[k0 + row] * inv4;
        LAS float* t = T + row * 129 + 4 * c4; t[0] = v.x; t[1] = v.y; t[2] = v.z; t[3] = v.w; }
    __syncthreads();
#pragma unroll
    for (int i = 0; i < 2; ++i) { const int n = (F.tid >> 3) + 64 * i, kc = F.tid & 7;
        const LAS float* s = T + (16 * kc) * 129 + n; unsigned w[4];
#pragma unroll
        for (int j = 0; j < 4; ++j) w[j] = q8(s[(4 * j) * 129]) | (q8(s[(4 * j + 1) * 129]) << 8) | (q8(s[(4 * j + 2) * 129]) << 16) | (q8(s[(4 * j + 3) * 129]) << 24);
        v4u o; o.x = w[0]; o.y = w[1]; o.z = w[2]; o.w = w[3];
        *(v4u*)(WT + (size_t)(dst0 + 64 * (n >> 5) + (n & 31)) * K + k0 + 16 * kc) = o; }
    __syncthreads();
}
__device__ __forceinline__ void xq_row(const bf16* __restrict__ xrow, unsigned char* qrow, const float* __restrict__ ssq32, float* rowf, float s_w, int lane) {
    v4u v[4]; float m = 0.f;
#pragma unroll
    for (int j = 0; j < 4; ++j) { v[j] = *(const v4u*)(xrow + 8 * (lane + 64 * j)); const unsigned w[4] = {v[j].x, v[j].y, v[j].z, v[j].w};
#pragma unroll
        for (int i = 0; i < 4; ++i) m = fmaxf(m, fmaxf(fabsf(bflo(w[i])), fabsf(bfhi(w[i])))); }
    float ss = (lane < 32) ? ssq32[lane] : 0.f;
#pragma unroll
    for (int o = 1; o < 64; o <<= 1) { m = fmaxf(m, __shfl_xor(m, o)); ss += __shfl_xor(ss, o); }
    m = fmaxf(m, 1e-30f); const float inv = 127.0f / m;
    if (lane == 0) *rowf = (1.0f / sqrtf(ss * (1.f / DM) + EPS)) * (m * (1.0f / 127.0f)) * s_w;
#pragma unroll
    for (int j = 0; j < 4; ++j) { const unsigned w[4] = {v[j].x, v[j].y, v[j].z, v[j].w}; v2u o;
        o.x = q8(bflo(w[0]) * inv) | (q8(bfhi(w[0]) * inv) << 8) | (q8(bflo(w[1]) * inv) << 16) | (q8(bfhi(w[1]) * inv) << 24);
        o.y = q8(bflo(w[2]) * inv) | (q8(bfhi(w[2]) * inv) << 8) | (q8(bflo(w[3]) * inv) << 16) | (q8(bfhi(w[3]) * inv) << 24);
        *(v2u*)(qrow + 8 * (lane + 64 * j)) = o; }
}
__device__ __forceinline__ void xb_row(const float* xrow, bf16* orow, float* rstd, int lane) {
    const f32x4* xr = (const f32x4*)xrow + lane;
    f32x4 v[8]; float s = 0.f;
#pragma unroll
    for (int j = 0; j < 8; ++j) { v[j] = xr[64 * j]; s += (v[j].x * v[j].x + v[j].y * v[j].y) + (v[j].z * v[j].z + v[j].w * v[j].w); }
    const float r = 1.0f / sqrtf(wave_sum(s) * (1.f / DM) + EPS);
    if (lane == 0) *rstd = r;
    v2u* o8 = (v2u*)orow + lane;
#pragma unroll
    for (int j = 0; j < 8; ++j) { v2u w; w.x = pk2(v[j].x, v[j].y); w.y = pk2(v[j].z, v[j].w); o8[64 * j] = w; }
}
__device__ __forceinline__ void rstd_from_partials(const float* __restrict__ ssqp, float* rstd, size_t gtid, size_t gthreads) {
    for (size_t r = gtid; r < (size_t)M; r += gthreads) { const f32x4* p = (const f32x4*)(ssqp + r * 32); f32x4 a = p[0];
#pragma unroll
        for (int i = 1; i < 8; ++i) a += p[i];
        rstd[r] = 1.0f / sqrtf(((a.x + a.y) + (a.z + a.w)) * (1.f / DM) + EPS); }
}
__device__ __forceinline__ void tile_norm_store(LAS float* tile, bf16* dst, int row0, int col_off, int wave, int lane) {
#pragma unroll
    for (int i = 0; i < 8; ++i) { const int t = wave * 8 + i;
        const f32x4 a = *(LAS f32x4*)(tile + t * 512 + 8 * lane), b = *(LAS f32x4*)(tile + t * 512 + 8 * lane + 4);
        const float s = (a.x * a.x + a.y * a.y) + (a.z * a.z + a.w * a.w) + (b.x * b.x + b.y * b.y) + (b.z * b.z + b.w * b.w);
        const float rstd = 1.0f / sqrtf(wave_sum(s) * (1.f / 512.f) + EPS);
        v4u o; o.x = pk2(a.x * rstd, a.y * rstd); o.y = pk2(a.z * rstd, a.w * rstd); o.z = pk2(b.x * rstd, b.y * rstd); o.w = pk2(b.z * rstd, b.w * rstd);
        *(v4u*)(dst + (size_t)(row0 + t) * DM + col_off + 8 * lane) = o; }
}
__device__ __forceinline__ void poolfold_item(Frame& F, const float* __restrict__ win, const float* __restrict__ pw, const float* __restrict__ ps, const float* __restrict__ g1, bf16* BtIn, int g, int kb) {
    LAS float* At = (LAS float*)F.lds; LAS float* Bt = (LAS float*)(F.lds + 32768);
    const int k0 = 64 * kb;
#pragma unroll
    for (int i = 0; i < 4; ++i) { const int q = F.tid + 512 * i, row = q >> 5, c4 = q & 31; *(LAS f32x4*)(At + row * 128 + 4 * c4) = *(const f32x4*)(win + (size_t)(k0 + row) * DIN + 128 * g + 4 * c4) * g1[k0 + row]; }
#pragma unroll
    for (int i = 0; i < 8; ++i) { const int q = F.tid + 512 * i, row = q >> 5, c4 = q & 31; *(LAS f32x4*)(Bt + row * 128 + 4 * c4) = *(const f32x4*)(pw + (size_t)(g * 128 + row) * 128 + 4 * c4); }
    __syncthreads();
    const int n = F.tid & 127, kg = F.tid >> 7;
    float acc[16];
#pragma unroll
    for (int i = 0; i < 16; ++i) acc[i] = 0.f;
    for (int j = 0; j < 128; j += 4) {
        const float b0 = Bt[(j + 0) * 128 + n], b1 = Bt[(j + 1) * 128 + n], b2 = Bt[(j + 2) * 128 + n], b3 = Bt[(j + 3) * 128 + n];
#pragma unroll
        for (int i = 0; i < 16; ++i) { const f32x4 a = *(LAS f32x4*)(At + (kg * 16 + i) * 128 + j); acc[i] += a.x * b0 + a.y * b1 + a.z * b2 + a.w * b3; }
    }
    const float sc = ps[128 * g + n];
    v4u o0, o1;
    o0.x = pk2(acc[0] * sc, acc[1] * sc); o0.y = pk2(acc[2] * sc, acc[3] * sc); o0.z = pk2(acc[4] * sc, acc[5] * sc); o0.w = pk2(acc[6] * sc, acc[7] * sc);
    o1.x = pk2(acc[8] * sc, acc[9] * sc); o1.y = pk2(acc[10] * sc, acc[11] * sc); o1.z = pk2(acc[12] * sc, acc[13] * sc); o1.w = pk2(acc[14] * sc, acc[15] * sc);
    bf16* dst = BtIn + (size_t)(128 * g + n) * DM + k0 + kg * 16;
    *(v4u*)dst = o0; *(v4u*)(dst + 8) = o1;
    __syncthreads();
}
__device__ __forceinline__ void filter_item(Frame& F, const float* __restrict__ w1, const float* __restrict__ b1, const float* __restrict__ fr, const float* __restrict__ w2, const float* __restrict__ b2,
                                            const float* __restrict__ w3, const float* __restrict__ b3, const float* __restrict__ hbias, bf16* RF, int fi) {
    LAS float* ZF = (LAS float*)F.lds; LAS float* H1 = ZF + 512; LAS float* H2 = ZF + 1536; LAS float* W1s = ZF + 2560; LAS float* W2s = ZF + 3712;
    const int t0 = 16 * fi;
    for (int q = F.tid; q < 272; q += 512) *(LAS f32x4*)(W1s + 4 * q) = *(const f32x4*)(w1 + 4 * q);
#pragma unroll
    for (int i = 0; i < 2; ++i) { const int q = F.tid + 512 * i; *(LAS f32x4*)(W2s + 4 * q) = *(const f32x4*)(w2 + 4 * q); }
    if (F.tid < 272) { const int tt = F.tid / 17, f = F.tid % 17; const float t = (float)(t0 + tt);
        float v;
        if (f == 0) v = t / 2047.0f;
        else { const int j = (f - 1) & 7; const float band = 1e-4f + (float)j * ((7.0f - 1e-4f) / 7.0f); const float w = (6.283185307179586f * t) / 2048.0f; const float a = band * w; v = (f <= 8) ? __cosf(a) : -__sinf(a); }
        ZF[tt * 17 + f] = v; }
    __syncthreads();
#pragma unroll
    for (int rep = 0; rep < 2; ++rep) { const int p = F.tid + 512 * rep, tt = p >> 6, j = p & 63; float s = b1[j];
#pragma unroll
        for (int i = 0; i < 17; ++i) s += ZF[tt * 17 + i] * W1s[i * 64 + j];
        H1[tt * 64 + j] = __sinf(fr[j] * s); }
    __syncthreads();
#pragma unroll
    for (int rep = 0; rep < 2; ++rep) { const int p = F.tid + 512 * rep, tt = p >> 6, j = p & 63; float s = b2[j];
#pragma unroll 16
        for (int i = 0; i < 64; ++i) s += H1[tt * 64 + i] * W2s[i * 64 + j];
        H2[tt * 64 + j] = __sinf(fr[j] * s); }
    __syncthreads();
    const int c = F.tid;
    const float delta = -3.0701134573253944f + (float)c * ((-15.350567286626972f + 3.0701134573253944f) / 511.0f);
    const float ad = fabsf(delta);
    bf16* rf = RF + (size_t)c * hy::RFS;
#pragma unroll 1
    for (int dir = 0; dir < 2; ++dir) { const int o = dir * 512 + c; const float bo = b3[o];
        float wc[64];
#pragma unroll
        for (int i = 0; i < 64; ++i) wc[i] = w3[i * 1024 + o];
#pragma unroll 1
        for (int tt = 0; tt < 16; ++tt) { float s = bo;
#pragma unroll
            for (int i = 0; i < 64; i += 4) { const f32x4 hv = *(LAS f32x4*)(H2 + tt * 64 + i); s += (hv.x * wc[i] + hv.y * wc[i + 1]) + (hv.z * wc[i + 2] + hv.w * wc[i + 3]); }
            const int t = t0 + tt; const float tl = (float)t / 2047.0f; float val = s * __expf(-tl * ad);
            if (dir == 0) { if (t == 0) val += hbias[c]; rf[2048 - t] = (bf16)f2bf(val); }
            else if (t >= 1) rf[2048 + t] = (bf16)f2bf(val); } }
    if (fi == 0) { rf[0] = 0;
#pragma unroll
        for (int i = 4096; i < hy::RFS; ++i) rf[i] = 0; }
    __syncthreads();
}
__device__ __forceinline__ void unpack4(const v2u w, float (&x)[4]) { x[0] = bflo(w.x); x[1] = bfhi(w.x); x[2] = bflo(w.y); x[3] = bfhi(w.y); }
__device__ __forceinline__ void pair_norm_store(Frame& F, const float (&y)[8][4], bf16* dst, size_t row0, int col_off, int cq) {
    LAS float* part = (LAS float*)F.lds;
    float ss[8];
#pragma unroll
    for (int k = 0; k < 8; ++k) ss[k] = wave_sum((y[k][0] * y[k][0] + y[k][1] * y[k][1]) + (y[k][2] * y[k][2] + y[k][3] * y[k][3]));
    if (F.lane == 0) { *(LAS f32x4*)(part + F.wave * 8) = (f32x4){ss[0], ss[1], ss[2], ss[3]}; *(LAS f32x4*)(part + F.wave * 8 + 4) = (f32x4){ss[4], ss[5], ss[6], ss[7]}; }
    __syncthreads();
    const f32x4 pa = *(LAS f32x4*)(part + (F.wave ^ 1) * 8), pb = *(LAS f32x4*)(part + (F.wave ^ 1) * 8 + 4);
    const float po[8] = {pa.x, pa.y, pa.z, pa.w, pb.x, pb.y, pb.z, pb.w};
#pragma unroll
    for (int k = 0; k < 8; ++k) { const float rstd = 1.0f / sqrtf((ss[k] + po[k]) * (1.f / 512.f) + EPS);
        v2u o; o.x = pk2(y[k][0] * rstd, y[k][1] * rstd); o.y = pk2(y[k][2] * rstd, y[k][3] * rstd);
        *(v2u*)(dst + (row0 + k) * DM + col_off + 4 * cq) = o; }
    __syncthreads();
}
__device__ __forceinline__ void hyprep_item(Frame& F, const bf16* __restrict__ PROJ, const float* __restrict__ cw, const float* __restrict__ cb, bf16* ZT, bf16* X0, int b, int tile) {
    const int tb = F.tid >> 7, cq = F.tid & 127, c0 = 4 * cq, tw = tile * 32 + tb * 8; const size_t rb = (size_t)b * SEQ;
    float z[8][4];
    v2u rh[3][10];
#pragma unroll
    for (int j = 0; j < 3; ++j)
#pragma unroll
        for (int o = 0; o < 10; ++o) { const int t = tw - 1 + o; const int tc = ((t >= 0) && (t < SEQ)) ? t : tw; rh[j][o] = *(const v2u*)(PROJ + (rb + tc) * DINP + O_HY + 512 * j + c0); }
#pragma unroll
    for (int jj = 0; jj < 3; ++jj) { const int j = (jj == 0) ? 1 : (jj == 1) ? 2 : 0; const int cc = 512 * j + c0;
        const f32x4 w0 = *(const f32x4*)(cw + cc), w1 = *(const f32x4*)(cw + 1536 + cc), w2 = *(const f32x4*)(cw + 3072 + cc), bs = *(const f32x4*)(cb + cc);
        float x[10][4];
#pragma unroll
        for (int o = 0; o < 10; ++o) { const int t = tw - 1 + o; const bool ok = (t >= 0) && (t < SEQ); unpack4(rh[j][o], x[o]);
            if (!ok) { x[o][0] = 0.f; x[o][1] = 0.f; x[o][2] = 0.f; x[o][3] = 0.f; } }
        if (jj == 0) {
#pragma unroll
            for (int k = 0; k < 8; ++k)
#pragma unroll
                for (int i = 0; i < 4; ++i) z[k][i] = w0[i] * x[k][i] + w1[i] * x[k + 1][i] + w2[i] * x[k + 2][i] + bs[i];
        } else if (jj == 1) {
#pragma unroll
            for (int k = 0; k < 8; ++k)
#pragma unroll
                for (int i = 0; i < 4; ++i) z[k][i] *= w0[i] * x[k][i] + w1[i] * x[k + 1][i] + w2[i] * x[k + 2][i] + bs[i];
#pragma unroll
            for (int i = 0; i < 4; ++i) { v4u o; o.x = pk2(z[0][i], z[1][i]); o.y = pk2(z[2][i], z[3][i]); o.z = pk2(z[4][i], z[5][i]); o.w = pk2(z[6][i], z[7][i]);
                *(v4u*)(ZT + ((size_t)(c0 + i) * NSEQ + b) * SEQ + tw) = o; }
        } else {
#pragma unroll
            for (int k = 0; k < 8; ++k) { float u0[4];
#pragma unroll
                for (int i = 0; i < 4; ++i) u0[i] = w0[i] * x[k][i] + w1[i] * x[k + 1][i] + w2[i] * x[k + 2][i] + bs[i];
                v2u o; o.x = pk2(u0[0], u0[1]); o.y = pk2(u0[2], u0[3]); *(v2u*)(X0 + (rb + tw + k) * HYC + c0) = o; }
        }
    }
}
__device__ __forceinline__ void pool_item(Frame& F, const bf16* __restrict__ PROJ, bf16* MIXED, int b, int tile) {
    const int tb = F.tid >> 7, cq = F.tid & 127, c0 = 4 * cq, g = cq >> 5, half = 1 << g, tw = tile * 32 + tb * 8; const size_t rb = (size_t)b * SEQ;
    float x[23][4];
#pragma unroll
    for (int o = 0; o < 23; ++o) { const int t = tw - 8 + o; const bool ok = (t >= 0) && (t < SEQ); const int tc = ok ? t : tw;
        const v2u w = *(const v2u*)(PROJ + (rb + tc) * DINP + c0); unpack4(w, x[o]);
        if (!ok) { x[o][0] = 0.f; x[o][1] = 0.f; x[o][2] = 0.f; x[o][3] = 0.f; } }
    float y[8][4];
#pragma unroll
    for (int k = 0; k < 8; ++k) { const int oc = 8 + k, t = tw + k; const int lo = (t - half > 0) ? t - half : 0, hi = (t + half < SEQ) ? t + half : SEQ; const float inv = 1.0f / (float)(hi - lo);
#pragma unroll
        for (int i = 0; i < 4; ++i) {
            const float w1 = x[oc - 1][i] + x[oc][i];
            const float w2 = w1 + (x[oc - 2][i] + x[oc + 1][i]);
            const float w4 = w2 + ((x[oc - 4][i] + x[oc - 3][i]) + (x[oc + 2][i] + x[oc + 3][i]));
            const float w8 = w4 + (((x[oc - 8][i] + x[oc - 7][i]) + (x[oc - 6][i] + x[oc - 5][i])) + ((x[oc + 4][i] + x[oc + 5][i]) + (x[oc + 6][i] + x[oc + 7][i])));
            const float S = (g == 0) ? w1 : (g == 1) ? w2 : (g == 2) ? w4 : w8;
            y[k][i] = S * inv - x[oc][i]; } }
    pair_norm_store(F, y, MIXED, rb + tw, 0, cq);
}
__device__ __forceinline__ void hyfin_item(Frame& F, const bf16* __restrict__ YC, const bf16* __restrict__ X0, bf16* MIXED, int b, int tile) {
    const int tb = F.tid >> 7, cq = F.tid & 127, c0 = 4 * cq, tw = tile * 32 + tb * 8; const size_t rb = (size_t)b * SEQ;
    float yc[4][8], y[8][4];
#pragma unroll
    for (int i = 0; i < 4; ++i) { const v4u v = *(const v4u*)(YC + ((size_t)(c0 + i) * NSEQ + b) * SEQ + tw);
        yc[i][0] = bflo(v.x); yc[i][1] = bfhi(v.x); yc[i][2] = bflo(v.y); yc[i][3] = bfhi(v.y); yc[i][4] = bflo(v.z); yc[i][5] = bfhi(v.z); yc[i][6] = bflo(v.w); yc[i][7] = bfhi(v.w); }
#pragma unroll
    for (int k = 0; k < 8; ++k) { float xv[4]; unpack4(*(const v2u*)(X0 + (rb + tw + k) * HYC + c0), xv);
#pragma unroll
        for (int i = 0; i < 4; ++i) y[k][i] = yc[i][k] * xv[i]; }
    pair_norm_store(F, y, MIXED, rb + tw, 1536, cq);
}
struct PrepGains { float q[3][8], k[3][8]; };
__device__ __forceinline__ void load8(const float* p, float (&o)[8]) { const f32x4 a = *(const f32x4*)p, b = *(const f32x4*)(p + 4); o[0] = a.x; o[1] = a.y; o[2] = a.z; o[3] = a.w; o[4] = b.x; o[5] = b.y; o[6] = b.z; o[7] = b.w; }
__device__ __forceinline__ void unpack8(const v4u w, float (&x)[8]) { x[0] = bflo(w.x); x[1] = bfhi(w.x); x[2] = bflo(w.y); x[3] = bfhi(w.y); x[4] = bflo(w.z); x[5] = bfhi(w.z); x[6] = bflo(w.w); x[7] = bfhi(w.w); }
__device__ __forceinline__ v4u pack8(const float (&x)[8]) { v4u o; o.x = pk2(x[0], x[1]); o.y = pk2(x[2], x[3]); o.z = pk2(x[4], x[5]); o.w = pk2(x[6], x[7]); return o; }
__device__ __forceinline__ float ssq8(const float (&x)[8]) { return ((x[0] * x[0] + x[1] * x[1]) + (x[2] * x[2] + x[3] * x[3])) + ((x[4] * x[4] + x[5] * x[5]) + (x[6] * x[6] + x[7] * x[7])); }
__device__ __forceinline__ float sum8lanes(float v) { v += __shfl_xor(v, 1); v += __shfl_xor(v, 2); v += __shfl_xor(v, 4); return v; }
__device__ __forceinline__ void prep_row(const bf16* __restrict__ PROJ, bf16* Q, bf16* KV, const PrepGains& G, const float* __restrict__ ROPE, int m, int lane) {
    const int h = lane >> 3, sub = lane & 7;
    const bf16* pr = PROJ + (size_t)m * DINP; bf16* qr = Q + (size_t)m * NQ + 192 * h + 8 * sub; bf16* kr = KV + (size_t)m * NKVP + KVHS * h + 8 * sub;
    const v4u cqv = *(const v4u*)(pr + O_CQ + 8 * lane); const v4u pev = *(const v4u*)(pr + O_KPE + 8 * sub);
    const v4u q0 = *(const v4u*)(qr), q1 = *(const v4u*)(qr + 64), q2 = *(const v4u*)(qr + 128);
    const v4u k0 = *(const v4u*)(kr), k1 = *(const v4u*)(kr + 64);
    float cs[8], sn[8]; { const float* rp = ROPE + (size_t)(m & (SEQ - 1)) * 64 + 8 * (sub & 3); load8(rp, cs); load8(rp + 32, sn); }
    float t[8];
    unpack8(cqv, t); const float rq = 1.0f / sqrtf(wave_sum(ssq8(t)) * (1.f / 512.f) + EPS);
    const float sg = (sub < 4) ? -1.f : 1.f;
    { float a0[8], a1[8], a2[8]; unpack8(q0, a0); unpack8(q1, a1); unpack8(q2, a2);
      const float ss = sum8lanes(ssq8(a0) + ssq8(a1) + ssq8(a2)) * (rq * rq);
      const float sc = (rq * (at::SCALE * 1.4426950408889634f)) / sqrtf(ss * (1.f / 192.f) + EPS);
      float r[8], o[8];
#pragma unroll
      for (int i = 0; i < 8; ++i) { a0[i] *= sc * G.q[0][i]; a1[i] *= sc * G.q[1][i]; r[i] = a2[i] * sc * G.q[2][i]; }
#pragma unroll
      for (int i = 0; i < 8; ++i) { const float rp = __shfl_xor(r[i], 4); o[i] = r[i] * cs[i] + sg * rp * sn[i]; }
      *(v4u*)(qr) = pack8(a0); *(v4u*)(qr + 64) = pack8(a1); *(v4u*)(qr + 128) = pack8(o); }
    { float a0[8], a1[8], pe[8]; unpack8(k0, a0); unpack8(k1, a1); unpack8(pev, pe);
      const float ss = sum8lanes((ssq8(a0) + ssq8(a1)) + ssq8(pe));
      const float sk = 1.0f / sqrtf(ss * (1.f / 192.f) + EPS);
      float r[8], o[8];
#pragma unroll
      for (int i = 0; i < 8; ++i) { a0[i] *= sk * G.k[0][i]; a1[i] *= sk * G.k[1][i]; r[i] = pe[i] * sk * G.k[2][i]; }
#pragma unroll
      for (int i = 0; i < 8; ++i) { const float rp = __shfl_xor(r[i], 4); o[i] = r[i] * cs[i] + sg * rp * sn[i]; }
      *(v4u*)(kr) = pack8(a0); *(v4u*)(kr + 64) = pack8(a1); *(v4u*)(kr + 128) = pack8(o); }
}
__device__ __forceinline__ void attn_norm_row(bf16* MIXED, int m, int lane) {
    v4u* p = (v4u*)(MIXED + (size_t)m * DM + 512 + 16 * lane); v4u a = p[0], b = p[1];
    unsigned w[8] = {a.x, a.y, a.z, a.w, b.x, b.y, b.z, b.w}; float s = 0.f;
#pragma unroll
    for (int i = 0; i < 8; ++i) { const float x = bflo(w[i]), y = bfhi(w[i]); s += x * x + y * y; }
    const float rstd = 1.0f / sqrtf(wave_sum(s) * (1.f / 1024.f) + EPS);
#pragma unroll
    for (int i = 0; i < 8; ++i) w[i] = pk2(bflo(w[i]) * rstd, bfhi(w[i]) * rstd);
    a.x = w[0]; a.y = w[1]; a.z = w[2]; a.w = w[3]; b.x = w[4]; b.y = w[5]; b.z = w[6]; b.w = w[7]; p[0] = a; p[1] = b;
}

#define DEFPTRS() unsigned char* ws = args.ws; \
    bf16* BtIn = (bf16*)(ws + WS_BTIN); bf16* BtUq = (bf16*)(ws + WS_BTUQ); bf16* BtKv = (bf16*)(ws + WS_BTKV); bf16* BtOut = (bf16*)(ws + WS_BTOUT); bf16* BtUp = (bf16*)(ws + WS_BTUP); bf16* BtDn = (bf16*)(ws + WS_BTDN); \
    bf16* RF = (bf16*)(ws + WS_RF); bf16* Hb = (bf16*)(ws + WS_H); bf16* PROJ = (bf16*)(ws + WS_PROJ); bf16* Qb = (bf16*)(ws + WS_Q); bf16* KVb = (bf16*)(ws + WS_KV); \
    bf16* ZT = (bf16*)(ws + WS_ZT); bf16* X0 = (bf16*)(ws + WS_X0); bf16* YC = (bf16*)(ws + WS_YC); float* EDGE = (float*)(ws + WS_EDGE); float* ROPE = (float*)(ws + WS_ROPE); float* SSQP = (float*)(ws + WS_SSQP); float* RSTD = (float*)(ws + WS_RSTD); bf16* XB2 = (bf16*)(ws + WS_XB2); unsigned char* XQ = (unsigned char*)(ws + WS_XQ); unsigned char* BtUpQ = (unsigned char*)(ws + WS_BTUP); bf16* ACT = (bf16*)(ws + WS_ACT); \
    bf16* XA = (bf16*)args.out; \
    (void)BtIn; (void)BtUq; (void)BtKv; (void)BtOut; (void)BtUp; (void)BtDn; (void)RF; (void)Hb; (void)PROJ; (void)Qb; (void)KVb; (void)ZT; (void)X0; (void)YC; (void)EDGE; (void)ROPE; (void)SSQP; (void)RSTD; (void)XB2; (void)XQ; (void)BtUpQ; (void)ACT; (void)XA
__global__ void __launch_bounds__(NWAVES * 64, 2) fwd(Args args) {
    extern __shared__ __attribute__((aligned(16))) unsigned char lds_raw[];
    Frame F;
    F.lds = (LAS unsigned char*)lds_raw;
    F.tid = threadIdx.x; F.lane = F.tid & 63; F.wave = __builtin_amdgcn_readfirstlane(F.tid >> 6);
    F.G = gridDim.x; { const int bx = blockIdx.x; F.vcu = (F.G % 8 == 0) ? (bx % 8) * (F.G / 8) + bx / 8 : bx; }
    volatile LAS unsigned* MISC = (volatile LAS unsigned*)(F.lds + MISC_OFF);
    if (F.tid < 64) MISC[F.tid] = 0u;
    __syncthreads();
    unsigned* ctl = (unsigned*)(args.ws + WS_CTL);
    const int lo = args.ph_lo, hi = args.ph_hi;
    XcdBarrier bar; bar.bar = ctl + CW_BAR; bar.x = 0; bar.st = MISC + 8;
    if (hi - lo > 1) bar = xcd_barrier_post(ctl + CW_BAR, MISC + 8);
    float* out = args.out;

#pragma unroll 1
    for (int layer = 0; layer < DEPTH; ++layer) {
        const int pb = layer * NPH;
        if (pb + NPH <= lo || pb >= hi) continue;
#define IN(k) (lo <= pb + (k) && pb + (k) < hi)
#define ENTER() DEFPTRS(); F.tid = opq(threadIdx.x); F.lane = F.tid & 63; F.wave = __builtin_amdgcn_readfirstlane(F.tid >> 6); const int gw = F.vcu * NWAVES + F.wave, NGW = F.G * NWAVES, wg = F.vcu; const size_t gtid = (size_t)wg * 512 + F.tid, gthreads = (size_t)F.G * 512; (void)gw; (void)NGW; (void)wg; (void)gtid; (void)gthreads
#define SEAM(k) do { if (pb + (k) + 1 < hi) xcd_barrier(bar); } while (0)

        if (IN(0)) { ENTER();
            const float* win = args.in[I_WIN] + (size_t)layer * DM * DIN; const float* g1 = args.in[I_ANG] + layer * DM;
            for (int it = wg; it < 256; it += F.G) {
                if (it < 128) poolfold_item(F, win, args.in[I_PW] + (size_t)layer * 4 * 128 * 128, args.in[I_PS] + (size_t)layer * 512, g1, BtIn, it >> 5, it & 31);
                else filter_item(F, args.in[I_FW1] + (size_t)layer * 17 * 64, args.in[I_FB1] + layer * 64, args.in[I_FFR] + layer * 64, args.in[I_FW2] + (size_t)layer * 64 * 64, args.in[I_FB2] + layer * 64,
                                 args.in[I_FW3] + (size_t)layer * 64 * 1024, args.in[I_FB3] + layer * 1024, args.in[I_HBIAS] + layer * 512, RF, it - 128);
            }
            constexpr int T_IN = 19 * 16, T_UQ = 12 * 4, T_KV = 16 * 2, T_OUT = 16 * 16, T_UP = 88 * 16, T_DN = 16 * 44, T_ALL = T_IN + T_UQ + T_KV + T_OUT + T_UP + T_DN;
            for (int it = wg; it < T_ALL; it += F.G) {
                int r = it; CvtTile d;
                if (r < T_IN) { const int nt = r >> 4, kt = r & 15, n0 = 512 + 128 * nt; d = CvtTile{win, g1, BtIn, DIN, DM, n0, 128 * kt, DIN, {n0, n0 + 32, n0 + 64, n0 + 96}}; }
                else if ((r -= T_IN) < T_UQ) { const int nt = r >> 2, kt = r & 3, n0 = 128 * nt; d = CvtTile{args.in[I_WUQ] + (size_t)layer * 512 * NQ, args.in[I_QNG] + layer * 512, BtUq, NQ, 512, n0, 128 * kt, NQ, {n0, n0 + 32, n0 + 64, n0 + 96}}; }
                else if ((r -= T_UQ) < T_KV) { const int nt = r >> 1, kt = r & 1, n0 = 128 * nt;
                    d = CvtTile{args.in[I_WUKV] + (size_t)layer * 256 * 2048, args.in[I_KVNG] + layer * 256, BtKv, 2048, 256, n0, 128 * kt, 2048, {n0, n0 + 32, n0 + 64, n0 + 96}}; }
                else if ((r -= T_KV) < T_OUT) { const int nt = r >> 4, kt = r & 15, n0 = 128 * nt; d = CvtTile{args.in[I_WOUT] + (size_t)layer * DM * DM, args.in[I_GNG] + layer * DM, BtOut, DM, DM, n0, 128 * kt, DM, {n0, n0 + 32, n0 + 64, n0 + 96}}; }
                else if ((r -= T_OUT) < T_UP) { const int nt = r >> 4, kt = r & 15;
                    absmax_tile(F, args.in[I_WUP] + (size_t)layer * DM * NUP, args.in[I_FNG] + layer * DM, NUP, 128 * nt, 128 * kt, ctl + CW_WMAXC + layer * NUP); continue; }
                else { r -= T_UP; const int nt = r / 44, kt = r % 44, n0 = 128 * nt; d = CvtTile{args.in[I_WDN] + (size_t)layer * DFF * DM, nullptr, BtDn, DM, DFF, n0, 128 * kt, DM, {n0, n0 + 32, n0 + 64, n0 + 96}}; }
                cvt_tile(F, d);
            }
            { unsigned zz = 0u; asm volatile("" : "+v"(zz)); v4u z = {zz, zz, zz, zz};
              for (size_t i = gtid; i < (size_t)(DINP - DIN) * DM / 8; i += gthreads) *(v4u*)(BtIn + (size_t)DIN * DM + i * 8) = z;
}
            if (layer == 0) for (size_t i = gtid; i < (size_t)SEQ * 32; i += gthreads) { const int pos = (int)(i >> 5), ri = (int)(i & 31);
                const float freq = exp2f(-(float)ri * (13.287712379549449f / 32.0f)); float sn, cs; sincosf((float)pos * freq, &sn, &cs); ROPE[pos * 64 + ri] = cs; ROPE[pos * 64 + 32 + ri] = sn; }
            if (layer == 0) { for (int m = gw; m < M; m += NGW) xb_row(m < MP ? args.in[I_XP] + (size_t)m * DM : args.in[I_XS] + (size_t)(m - MP) * DM, XA + (size_t)m * DM, RSTD + m, F.lane); }
            else rstd_from_partials(SSQP, RSTD, gtid, gthreads);
            SEAM(0);
        }
        if (IN(1)) { ENTER();
            pg8::Gemm g{XA, BtIn, M, DINP, DM, DM}; pg8::StaticOrder S; S.init(M, DINP, F.G, (int)blockIdx.x);
            pg8::EpiBf16 E{PROJ, DINP, RSTD, 0, O_CKV / 256, (LAS float*)(F.lds + HALO_OFF), EPS};
            pg8::gemm_phase<pg8::EpiBf16, pg8::StaticOrder>(F.lds, g, S, E);
            SEAM(1);
        }
        if (IN(2)) { ENTER();
            { pg8::Gemm g{PROJ + O_CQ, BtUq, M, NQ, 512, DINP}; pg8::StaticOrder S; S.init(M, NQ, F.G, (int)blockIdx.x); pg8::EpiBf16 E{Qb, NQ, nullptr, 0, -1, nullptr, 0.f};
              pg8::gemm_phase<pg8::EpiBf16, pg8::StaticOrder>(F.lds, g, S, E); }
            { pg8::Gemm g{PROJ + O_CKV, BtKv, M, 2048, 256, DINP}; pg8::StaticOrder S; S.init(M, 2048, F.G, (int)blockIdx.x); pg8::EpiBf16 E{KVb, NKVP, nullptr, 1, -1, nullptr, 0.f};
              pg8::gemm_phase<pg8::EpiBf16, pg8::StaticOrder>(F.lds, g, S, E); }
            const float* hcw = args.in[I_HCW] + (size_t)layer * 3 * 1536; const float* hcb = args.in[I_HCB] + layer * 1536;
            for (int it = wg; it < 2 * NSEQ * 64; it += F.G) {
                if (it < NSEQ * 64) hyprep_item(F, PROJ, hcw, hcb, ZT, X0, it >> 6, it & 63);
                else pool_item(F, PROJ, Hb, (it - NSEQ * 64) >> 6, it & 63);
            }
            SEAM(2);
        }
        if (IN(3)) { ENTER();
            const int odd = __builtin_amdgcn_readfirstlane(opq((int)(blockIdx.x >> 3) & 1));
            const float* qhg = args.in[I_QHG] + layer * 192; const float* khg = args.in[I_KHG] + layer * 192;
            if (!odd) { for (int u = wg; u < 2 * HYC; u += F.G) hy::conv_unit(F.lds, ZT, RF, YC, u >> 1, u & 1); }
            { PrepGains PG; { const int sub = F.lane & 7;
#pragma unroll
                for (int i = 0; i < 3; ++i) { load8(qhg + 64 * i + 8 * sub, PG.q[i]); load8(khg + 64 * i + 8 * sub, PG.k[i]); } }
              for (int m = gw; m < M; m += NGW) prep_row(PROJ, Qb, KVb, PG, ROPE, m, F.lane); }
            if (odd) { __syncthreads(); for (int u = wg; u < 2 * HYC; u += F.G) hy::conv_unit(F.lds, ZT, RF, YC, u >> 1, u & 1); }
            SEAM(3);
        }
        if (IN(4)) { ENTER();
            float gqm, gkm; { const float* qhg = args.in[I_QHG] + layer * 192; const float* khg = args.in[I_KHG] + layer * 192;
                gqm = fmaxf(fmaxf(fabsf(qhg[F.lane]), fabsf(qhg[64 + F.lane])), fabsf(qhg[128 + F.lane])); gkm = fmaxf(fmaxf(fabsf(khg[F.lane]), fabsf(khg[64 + F.lane])), fabsf(khg[128 + F.lane]));
#pragma unroll
                for (int o = 1; o < 64; o <<= 1) { gqm = fmaxf(gqm, __shfl_xor(gqm, o)); gkm = fmaxf(gkm, __shfl_xor(gkm, o)); } }
            const float Mnat = 13.856406460551018f * gqm * gkm;
            const bool sm_fast = __builtin_amdgcn_readfirstlane((Mnat <= 40.0f) ? 1 : 0) != 0;
            const float negMC = __builtin_bit_cast(float, __builtin_amdgcn_readfirstlane(__builtin_bit_cast(int, -Mnat * 1.4426950408889634f)));
            for (int i = 0; i * F.G < NSEQ * NH * 8; ++i) {
                int p, qb; const int c = (int)blockIdx.x;
                if (F.G == 256) { p = i * 32 + (c & 7) * 4 + (c >> 6); qb = (c >> 3) & 7; } else { const int Lq = i * F.G + c; p = Lq >> 3; qb = Lq & 7; }
                if (p < NSEQ * NH) { const int b = p >> 3, h = p & 7;
                    const bf16* qp = Qb + (size_t)(b * SEQ + qb * 256) * NQ + h * 192; const bf16* kp = KVb + (size_t)(b * SEQ) * NKVP + h * KVHS; bf16* op = Hb + (size_t)(b * SEQ + qb * 256) * DM + 512 + h * 128;
                    if (sm_fast) at::attn_unit<true>(negMC, qp, kp, kp + 192, op, SEQ, (char*)lds_raw);
                    else at::attn_unit<false>(0.f, qp, kp, kp + 192, op, SEQ, (char*)lds_raw); }
            }
            for (int it = wg; it < NSEQ * 64; it += F.G) hyfin_item(F, YC, X0, Hb, it >> 6, it & 63);
            SEAM(4);
        }
        if (IN(5)) { ENTER();
            for (int m = gw; m < M; m += NGW) attn_norm_row(Hb, m, F.lane);
            SEAM(5);
        }
        if (IN(6)) { ENTER();
            pg8::Gemm g{Hb, BtOut, M, DM, DM, DM}; pg8::StaticOrder S; S.init(M, DM, F.G, (int)blockIdx.x);
            pg8::EpiResid16 E{XA, XB2, out, DM, SSQP, 0};
            pg8::gemm_phase<pg8::EpiResid16, pg8::StaticOrder>(F.lds, g, S, E);
            SEAM(6);
        }
        if (IN(7)) { ENTER();
            const unsigned* wmaxc = ctl + CW_WMAXC + layer * NUP;
            for (int it = wg; it < 88 * 16; it += F.G) { const int nt = it >> 4, kt = it & 15; const int nv = (nt < 44) ? nt : nt - 44;
                cvtq_tile(F, args.in[I_WUP] + (size_t)layer * DM * NUP, args.in[I_FNG] + layer * DM, NUP, DM, BtUpQ, 128 * nt, 128 * kt, 256 * nv + ((nt < 44) ? 0 : 32), wmaxc); }
            for (int m = gw; m < M; m += NGW) xq_row(XB2 + (size_t)m * DM, XQ + (size_t)m * DM, SSQP + (size_t)m * 32, RSTD + m, 1.0f, F.lane);
            SEAM(7);
        }
        if (IN(8)) { ENTER();
            pg8::Gemm g{(const bf16*)XQ, (const bf16*)BtUpQ, M, NUP, DM / 2, DM / 2}; pg8::StaticOrder S; S.init(M, NUP, F.G, (int)blockIdx.x);
            pg8::EpiGate E{ACT, DFF, EDGE, args.in[I_FCW] + (size_t)layer * 3 * DFF, args.in[I_FCB] + layer * DFF, DFF, (LAS float*)(F.lds + HALO_OFF), RSTD, ctl + CW_WMAXC + layer * NUP};
            pg8::gemm_phase<pg8::EpiGate, pg8::StaticOrder, true>(F.lds, g, S, E);
            SEAM(8);
        }
        if (IN(9)) { ENTER();
            const float* fcw = args.in[I_FCW] + (size_t)layer * 3 * DFF;
            for (size_t i = gtid; i < (size_t)(M / 256) * 2 * (DFF / 4); i += gthreads) {
                const int ri = (int)(i / (DFF / 4)), c4 = (int)(i % (DFF / 4)) * 4, pm = ri >> 1, e = ri & 1;
                const float* eb = EDGE + (size_t)(ri * 3) * DFF + c4;
                f32x4 pre = *(const f32x4*)(eb + DFF); const f32x4 v = *(const f32x4*)(eb + 2 * DFF);
                if (e == 0 && (pm & 7) != 0) { const f32x4 gp = *(const f32x4*)(EDGE + (size_t)(((pm - 1) * 2 + 1) * 3) * DFF + c4); pre += *(const f32x4*)(fcw + c4) * gp; }
                if (e == 1 && (pm & 7) != 7) { const f32x4 gn = *(const f32x4*)(EDGE + (size_t)(((pm + 1) * 2 + 0) * 3) * DFF + c4); pre += *(const f32x4*)(fcw + 2 * DFF + c4) * gn; }
                v2u o; o.x = pk2(pg8::silu_f(pre.x) * v.x, pg8::silu_f(pre.y) * v.y); o.y = pk2(pg8::silu_f(pre.z) * v.z, pg8::silu_f(pre.w) * v.w);
                *(v2u*)(ACT + (size_t)(pm * 256 + (e ? 255 : 0)) * DFF + c4) = o;
            }
            SEAM(9);
        }
        if (IN(10)) { ENTER();
            pg8::Gemm g{ACT, BtDn, M, DM, DFF, DFF}; pg8::StaticOrder S; S.init(M, DM, F.G, (int)blockIdx.x);
            pg8::EpiResid16 E{XB2, XA, out, DM, SSQP, (layer + 1 < DEPTH) ? 0 : 1};
            pg8::gemm_phase<pg8::EpiResid16, pg8::StaticOrder>(F.lds, g, S, E);
            SEAM(10);
        }
#undef IN
#undef ENTER
#undef SEAM
    }
}

extern "C" void kernel_launch(void* const* d_in, const int* in_sizes, int n_in, void* d_out, int out_size, void* d_ws, size_t ws_size, hipStream_t stream) {
    static int grid = 0;
    if (grid == 0) {
        if (n_in != N_IN || out_size != M * DM || ws_size < WS_END) { fprintf(stderr, "kernel_launch: unexpected shapes (n_in %d, out %d, ws %zu, need %zu)\n", n_in, out_size, ws_size, (size_t)WS_END); grid = -1; return; }
        int dev = 0, cus = 0;
        if (hipGetDevice(&dev) != hipSuccess || hipDeviceGetAttribute(&cus, hipDeviceAttributeMultiprocessorCount, dev) != hipSuccess) { grid = -1; return; }
        if (hipFuncSetAttribute((const void*)fwd, hipFuncAttributeMaxDynamicSharedMemorySize, LDS_BYTES) != hipSuccess) { fprintf(stderr, "kernel_launch: hipFuncSetAttribute failed\n"); grid = -1; return; }
        int per_cu = 0;
        if (hipOccupancyMaxActiveBlocksPerMultiprocessor(&per_cu, (const void*)fwd, NWAVES * 64, LDS_BYTES) != hipSuccess || per_cu < 1) fprintf(stderr, "kernel_launch: occupancy query reports %d\n", per_cu);
        (void)hipGetLastError();
        grid = cus;
    }
    if (grid < 0) return;
    (void)hipMemsetAsync((char*)d_ws + WS_CTL, 0, CTL_BYTES, stream);
    Args a{};
    for (int i = 0; i < N_IN; ++i) a.in[i] = (const float*)d_in[i];
    a.out = (float*)d_out; a.ws = (unsigned char*)d_ws;
#if MK_ONE_LAUNCH
    a.ph_lo = 0; a.ph_hi = DEPTH * NPH;
    hipLaunchKernelGGL(fwd, dim3(grid), dim3(NWAVES * 64), LDS_BYTES, stream, a);
#else
    for (int p = 0; p < DEPTH * NPH; ++p) { a.ph_lo = p; a.ph_hi = p + 1; hipLaunchKernelGGL(fwd, dim3(grid), dim3(NWAVES * 64), LDS_BYTES, stream, a); }
#endif
    const hipError_t le = hipPeekAtLastError();
    if (le != hipSuccess) fprintf(stderr, "kernel_launch: launch failed: %s\n", hipGetErrorName(le));
}
```

```cpp
#include <hip/hip_runtime.h>
#include <cstdio>
#include <cstdint>
__device__ __forceinline__ int opq(int x) { asm volatile("" : "+v"(x)); return x; }
namespace pg8 {
#define PG8_LAS __attribute__((address_space(3)))
typedef unsigned short bf16_t;
typedef short bf16x8 __attribute__((ext_vector_type(8)));
typedef float f32x4 __attribute__((ext_vector_type(4)));
typedef unsigned u32x4 __attribute__((ext_vector_type(4)));
typedef int i32x4 __attribute__((ext_vector_type(4)));
template <bool I8> struct AccSel { typedef f32x4 T; }; template <> struct AccSel<true> { typedef i32x4 T; };
constexpr int BM = 256, BK = 64, HALF = 128, HTB = HALF * BK * 2  , STAGE_BYTES = 8 * HTB, NXCD = 8, WGM = 8;

__host__ __device__ __forceinline__ int lds_byte(int r, int c) { const int st = (r >> 4) * 2 + (c >> 5), rr = r & 15, cc = c & 31, ob = rr * 64 + cc * 2; return st * 1024 + (ob ^ (((ob >> 9) & 1) << 5)); }
__host__ __device__ __forceinline__ void stage_rc(int b, int& R, int& C) { const int st = b / 1024, sb = b % 1024, swz = sb ^ (((sb >> 9) & 1) << 5); R = (st >> 1) * 16 + swz / 64; C = (st & 1) * 32 + (swz % 64) / 2; }
__host__ __device__ __forceinline__ int perm32(int rho) { const int n = rho >> 4, i = rho & 15; return 8 * (i >> 2) + 4 * n + (i & 3); }

struct Unit { int pm, pn; };
struct Gemm { const bf16_t* A; const bf16_t* Bt; int M, N, K, lda; };

struct StaticOrder {
    int nM, nN, nwg, G, c;
    __host__ __device__ void init(int M, int N, int G_, int c_) { nM = M / BM; nN = N / BM; nwg = nM * nN; G = G_; c = c_; }
    __host__ __device__ bool next(int i, Unit& u) const {
        const long L = (long)i * G + c; if (L >= nwg) return false;
        int wgid = (int)L; { const int q = nwg / NXCD, r = nwg % NXCD, xcd = wgid % NXCD, off = wgid / NXCD; wgid = (xcd < r ? xcd * (q + 1) : r * (q + 1) + (xcd - r) * q) + off; }
        const int nig = WGM * nN, gid = wgid / nig, fm = gid * WGM, gsz = (nM - fm) < WGM ? (nM - fm) : WGM;
        u.pm = fm + ((wgid % nig) % gsz); u.pn = (wgid % nig) / gsz; return true;
    }
    __device__ __forceinline__ void a_ready(const Unit&) const {}
    __device__ __forceinline__ void done(const Unit&) const {}
};

__device__ __forceinline__ unsigned cvt_pk_bf16(float lo, float hi) { unsigned r; asm volatile("v_cvt_pk_bf16_f32 %0, %1, %2" : "=v"(r) : "v"(lo), "v"(hi)); return r; }

__device__ __forceinline__ float dpp_ror1(float v) { return __builtin_bit_cast(float, __builtin_amdgcn_update_dpp(0, __builtin_bit_cast(int, v), 0x121, 0xF, 0xF, false)); }
__device__ __forceinline__ float dpp_ror15(float v) { return __builtin_bit_cast(float, __builtin_amdgcn_update_dpp(0, __builtin_bit_cast(int, v), 0x12F, 0xF, 0xF, false)); }
__device__ __forceinline__ unsigned dpp_swap1(unsigned v) { return (unsigned)__builtin_amdgcn_update_dpp(0, (int)v, 0xB1, 0xF, 0xF, false); }
struct LineOffs { unsigned o0, o1; bool odd; };
__device__ __forceinline__ LineOffs line_offs(unsigned lo, int pitch, int fr) { LineOffs L; L.odd = fr & 1; L.o0 = L.odd ? lo - (unsigned)pitch + 32u : lo; L.o1 = L.odd ? lo + 32u : lo + (unsigned)pitch; return L; }
__device__ __forceinline__ void store_lines(bf16_t* base, const LineOffs& L, u32x4 a, u32x4 b) {
    const u32x4 snd = L.odd ? a : b; u32x4 rcv;
    rcv.x = dpp_swap1(snd.x); rcv.y = dpp_swap1(snd.y); rcv.z = dpp_swap1(snd.z); rcv.w = dpp_swap1(snd.w);
    *(u32x4*)(base + L.o0) = L.odd ? rcv : a;
    *(u32x4*)(base + L.o1) = L.odd ? b : rcv;
}
struct EpiBf16 {
    static constexpr bool PERM = true;
    bf16_t* O; int ldc; const float* rstd; int kvscatter;
    int norm_pn; PG8_LAS float* red; float eps;
    float* ssq_out; int ssq_pn0;
    __device__ __forceinline__ void operator()(f32x4 (&acc)[2][2][4][2], const Unit& u, int wr, int wc, int fr, int fq) const {
        bf16_t* Ot = O + (size_t)(u.pm * BM) * ldc + (kvscatter ? u.pn * 320 : u.pn * BM);
        const int wcol = kvscatter ? (wc < 2 ? wc * 64 : 64 + wc * 64) : wc * 64;
        const LineOffs L = line_offs((unsigned)((wr * 64 + fr) * ldc + wcol + 8 * fq), ldc, fr); const int row0 = u.pm * BM + wr * 64 + fr;
        float rsv[8];
#pragma unroll
        for (int i = 0; i < 8; ++i) rsv[i] = rstd ? rstd[row0 + (i >> 2) * HALF + (i & 3) * 16] : 1.0f;
        if (u.pn == norm_pn) {
#pragma unroll
            for (int ai = 0; ai < 2; ++ai)
#pragma unroll
                for (int m = 0; m < 4; ++m) { const float rs = rsv[ai * 4 + m]; float s = 0.f;
#pragma unroll
                    for (int bj = 0; bj < 2; ++bj) { acc[ai][bj][m][0] *= rs; acc[ai][bj][m][1] *= rs; const f32x4 a = acc[ai][bj][m][0], b = acc[ai][bj][m][1];
                        s += ((a[0] * a[0] + a[1] * a[1]) + (a[2] * a[2] + a[3] * a[3])) + ((b[0] * b[0] + b[1] * b[1]) + (b[2] * b[2] + b[3] * b[3])); }
                    s += __shfl_xor(s, 16); s += __shfl_xor(s, 32); if (fq == 0) red[(ai * HALF + wr * 64 + m * 16 + fr) * 4 + wc] = s; }
            asm volatile("s_waitcnt lgkmcnt(0)" ::: "memory"); __builtin_amdgcn_s_barrier(); asm volatile("" ::: "memory");
#pragma unroll
            for (int ai = 0; ai < 2; ++ai)
#pragma unroll
                for (int m = 0; m < 4; ++m) { const f32x4 p = *(const PG8_LAS f32x4*)(red + (ai * HALF + wr * 64 + m * 16 + fr) * 4); const float rs = 1.0f / __builtin_sqrtf(((p[0] + p[1]) + (p[2] + p[3])) * (1.0f / 256.0f) + eps);
                    u32x4 w[2];
#pragma unroll
                    for (int bj = 0; bj < 2; ++bj) { const f32x4 v0 = acc[ai][bj][m][0] * rs, v1 = acc[ai][bj][m][1] * rs;
                        w[bj].x = cvt_pk_bf16(v0[0], v0[1]); w[bj].y = cvt_pk_bf16(v0[2], v0[3]); w[bj].z = cvt_pk_bf16(v1[0], v1[1]); w[bj].w = cvt_pk_bf16(v1[2], v1[3]); }
                    store_lines(Ot + (size_t)((ai * HALF + m * 16) * ldc), L, w[0], w[1]);
                    asm volatile("" ::: "memory"); }
            return;
        }
        const bool want_ssq = ssq_out != nullptr && (unsigned)(u.pn - ssq_pn0) < 2u;
#pragma unroll
        for (int ai = 0; ai < 2; ++ai)
#pragma unroll
            for (int m = 0; m < 4; ++m) { const float rs = rsv[ai * 4 + m];
                u32x4 w[2]; float s = 0.f;
#pragma unroll
                for (int bj = 0; bj < 2; ++bj) { const f32x4 v0 = acc[ai][bj][m][0] * rs, v1 = acc[ai][bj][m][1] * rs;
                    s += ((v0[0] * v0[0] + v0[1] * v0[1]) + (v0[2] * v0[2] + v0[3] * v0[3])) + ((v1[0] * v1[0] + v1[1] * v1[1]) + (v1[2] * v1[2] + v1[3] * v1[3]));
                    w[bj].x = cvt_pk_bf16(v0[0], v0[1]); w[bj].y = cvt_pk_bf16(v0[2], v0[3]); w[bj].z = cvt_pk_bf16(v1[0], v1[1]); w[bj].w = cvt_pk_bf16(v1[2], v1[3]); }
                store_lines(Ot + (size_t)((ai * HALF + m * 16) * ldc), L, w[0], w[1]);
                if (want_ssq) { s += __shfl_xor(s, 16); s += __shfl_xor(s, 32); if (fq == 0) ssq_out[(size_t)(row0 + ai * HALF + m * 16) * 8 + (u.pn - ssq_pn0) * 4 + wc] = s; }
                asm volatile("" ::: "memory"); }
    }
};
struct EpiResid16 {
    static constexpr bool PERM = true;
    const bf16_t* base; bf16_t* xo; float* out; int ldc; float* ssqp; int f32out;
    __device__ __forceinline__ static void addx(const u32x4 b, const f32x4 a0, const f32x4 a1, f32x4& x0, f32x4& x1) {
        x0[0] = __builtin_bit_cast(float, b.x << 16) + a0[0]; x0[1] = __builtin_bit_cast(float, b.x & 0xffff0000u) + a0[1]; x0[2] = __builtin_bit_cast(float, b.y << 16) + a0[2]; x0[3] = __builtin_bit_cast(float, b.y & 0xffff0000u) + a0[3];
        x1[0] = __builtin_bit_cast(float, b.z << 16) + a1[0]; x1[1] = __builtin_bit_cast(float, b.z & 0xffff0000u) + a1[1]; x1[2] = __builtin_bit_cast(float, b.w << 16) + a1[2]; x1[3] = __builtin_bit_cast(float, b.w & 0xffff0000u) + a1[3]; }
    __device__ __forceinline__ void operator()(f32x4 (&acc)[2][2][4][2], const Unit& u, int wr, int wc, int fr, int fq) const {
        const size_t tb = (size_t)(u.pm * BM) * ldc + u.pn * BM;
        const bf16_t* bs = base + tb;
        const unsigned lo = (unsigned)((wr * 64 + fr) * ldc + wc * 64 + 8 * fq);
        if (f32out != 0) {
            float* op = out + tb;
#pragma unroll
            for (int ai = 0; ai < 2; ++ai)
#pragma unroll
                for (int m = 0; m < 4; ++m) { const unsigned off = lo + (unsigned)((ai * HALF + m * 16) * ldc);
#pragma unroll
                    for (int bj = 0; bj < 2; ++bj) { const u32x4 b = *(const u32x4*)(bs + off + bj * 32); f32x4 x0, x1; addx(b, acc[ai][bj][m][0], acc[ai][bj][m][1], x0, x1);
                        *(f32x4*)(op + off + bj * 32) = x0; *(f32x4*)(op + off + bj * 32 + 4) = x1; }
                    asm volatile("" ::: "memory"); }
            return;
        }
        bf16_t* xp = xo + tb; const LineOffs L = line_offs(lo, ldc, fr);
#pragma unroll
        for (int aim = 0; aim < 4; ++aim) { const int ai = aim >> 1, mp = aim & 1;
            u32x4 bv[2][2];
#pragma unroll
            for (int mm = 0; mm < 2; ++mm)
#pragma unroll
                for (int bj = 0; bj < 2; ++bj) bv[mm][bj] = *(const u32x4*)(bs + lo + (unsigned)((ai * HALF + (2 * mp + mm) * 16) * ldc) + bj * 32);
#pragma unroll
            for (int mm = 0; mm < 2; ++mm) { const int m = 2 * mp + mm; float s = 0.f; u32x4 wv[2];
#pragma unroll
                for (int bj = 0; bj < 2; ++bj) { f32x4 x0, x1; addx(bv[mm][bj], acc[ai][bj][m][0], acc[ai][bj][m][1], x0, x1);
                    wv[bj].x = cvt_pk_bf16(x0[0], x0[1]); wv[bj].y = cvt_pk_bf16(x0[2], x0[3]); wv[bj].z = cvt_pk_bf16(x1[0], x1[1]); wv[bj].w = cvt_pk_bf16(x1[2], x1[3]);
                    s += ((x0[0] * x0[0] + x0[1] * x0[1]) + (x0[2] * x0[2] + x0[3] * x0[3])) + ((x1[0] * x1[0] + x1[1] * x1[1]) + (x1[2] * x1[2] + x1[3] * x1[3])); }
                store_lines(xp + (size_t)((ai * HALF + m * 16) * ldc), L, wv[0], wv[1]);
                s += __shfl_xor(s, 16); s += __shfl_xor(s, 32); if (fq == 0) ssqp[(size_t)(u.pm * BM + wr * 64 + fr + ai * HALF + m * 16) * 32 + u.pn * 4 + wc] = s; }
            asm volatile("" ::: "memory"); }
    }
};
__device__ __forceinline__ float silu_f(float x) { return x * __builtin_amdgcn_rcpf(1.0f + __builtin_amdgcn_exp2f(-1.4426950408889634f * x)); }
struct EpiGate {
    static constexpr bool PERM = true;
    bf16_t* act; int ldact; float* edge; const float* cw; const float* cb; int dff; PG8_LAS float* halo; const float* rstd; const unsigned* wmaxc;
    __device__ __forceinline__ void operator()(f32x4 (&acc)[2][2][4][2], const Unit& u, int wr, int wc, int fr, int fq) const {
        const int lane = fq * 16 + fr; const int colL = wc * 32 + 8 * fq; const int colG = u.pn * HALF + colL;
        f32x4 csc[2][2];
#pragma unroll
        for (int bj = 0; bj < 2; ++bj)
#pragma unroll
            for (int n = 0; n < 2; ++n) { const u32x4 mb = *(const u32x4*)(wmaxc + bj * dff + colG + 4 * n);
                csc[bj][n] = (f32x4){__builtin_bit_cast(float, mb.x), __builtin_bit_cast(float, mb.y), __builtin_bit_cast(float, mb.z), __builtin_bit_cast(float, mb.w)} * (1.0f / 127.0f); }
#pragma unroll
        for (int ai = 0; ai < 2; ++ai)
#pragma unroll
            for (int m = 0; m < 4; ++m) { const float rs = rstd[u.pm * BM + ai * HALF + wr * 64 + m * 16 + fr];
#pragma unroll
                for (int bj = 0; bj < 2; ++bj) { acc[ai][bj][m][0] *= csc[bj][0] * rs; acc[ai][bj][m][1] *= csc[bj][1] * rs; } }
#pragma unroll
        for (int ai = 0; ai < 2; ++ai) { const int q = 2 * ai + wr;
            if (fr == 0) { *(PG8_LAS f32x4*)(halo + (q * 2 + 0) * 128 + colL) = acc[ai][0][0][0]; *(PG8_LAS f32x4*)(halo + (q * 2 + 0) * 128 + colL + 4) = acc[ai][0][0][1]; }
            if (fr == 15) { *(PG8_LAS f32x4*)(halo + (q * 2 + 1) * 128 + colL) = acc[ai][0][3][0]; *(PG8_LAS f32x4*)(halo + (q * 2 + 1) * 128 + colL + 4) = acc[ai][0][3][1]; } }
        asm volatile("s_waitcnt lgkmcnt(0)" ::: "memory"); __builtin_amdgcn_s_barrier(); asm volatile("" ::: "memory");
        bf16_t* actp = act + (size_t)(u.pm * BM) * ldact + colG; const unsigned rlo = (unsigned)((wr * 64 + fr) * ldact);
#pragma unroll
        for (int ai = 0; ai < 2; ++ai) { const int q = 2 * ai + wr;
            typedef unsigned u32x2 __attribute__((ext_vector_type(2)));
            u32x2 pk[4][2];
#pragma unroll
            for (int n = 0; n < 2; ++n) {
                const f32x4 w0 = *(const f32x4*)(cw + colG + 4 * n), w1 = *(const f32x4*)(cw + dff + colG + 4 * n), w2 = *(const f32x4*)(cw + 2 * dff + colG + 4 * n), bb = *(const f32x4*)(cb + colG + 4 * n);
                f32x4 ht = *(PG8_LAS f32x4*)(halo + ((q > 0 ? q - 1 : 0) * 2 + 1) * 128 + colL + 4 * n), hb = *(PG8_LAS f32x4*)(halo + ((q < 3 ? q + 1 : 3) * 2 + 0) * 128 + colL + 4 * n);
                if (q == 0) ht = ht * 0.f; if (q == 3) hb = hb * 0.f;
                f32x4 pre[4];
#pragma unroll
                for (int j = 0; j < 4; ++j) {
                    float g[4], rr[4], rl[4];
#pragma unroll
                    for (int m = 0; m < 4; ++m) { g[m] = acc[ai][0][m][n][j]; rr[m] = dpp_ror1(g[m]); rl[m] = dpp_ror15(g[m]); }
#pragma unroll
                    for (int m = 0; m < 4; ++m) {
                        const float up = (fr > 0) ? rr[m] : (m > 0 ? rr[m > 0 ? m - 1 : 0] : ht[j]);
                        const float dn = (fr < 15) ? rl[m] : (m < 3 ? rl[m < 3 ? m + 1 : 3] : hb[j]);
                        pre[m][j] = w0[j] * up + w1[j] * g[m] + w2[j] * dn + bb[j];
                    }
                }
                if (q == 0 && fr == 0) { float* e = edge + (size_t)((u.pm * 2 + 0) * 3) * dff + colG + 4 * n;
                    *(f32x4*)(e) = acc[ai][0][0][n]; *(f32x4*)(e + dff) = pre[0]; *(f32x4*)(e + 2 * dff) = acc[ai][1][0][n]; }
                if (q == 3 && fr == 15) { float* e = edge + (size_t)((u.pm * 2 + 1) * 3) * dff + colG + 4 * n;
                    *(f32x4*)(e) = acc[ai][0][3][n]; *(f32x4*)(e + dff) = pre[3]; *(f32x4*)(e + 2 * dff) = acc[ai][1][3][n]; }
#pragma unroll
                for (int m = 0; m < 4; ++m) { const f32x4 v = acc[ai][1][m][n];
                    pk[m][n].x = cvt_pk_bf16(silu_f(pre[m][0]) * v[0], silu_f(pre[m][1]) * v[1]); pk[m][n].y = cvt_pk_bf16(silu_f(pre[m][2]) * v[2], silu_f(pre[m][3]) * v[3]); }
            }
#pragma unroll
            for (int m = 0; m < 4; ++m) { u32x4 w; w.x = pk[m][0].x; w.y = pk[m][0].y; w.z = pk[m][1].x; w.w = pk[m][1].y;
                *(u32x4*)(actp + rlo + (unsigned)((ai * HALF + m * 16) * ldact)) = w; }
        }
    }
};

template <class Epi, class Sched, bool I8 = false>
__device__ __forceinline__ void gemm_phase(PG8_LAS unsigned char* lds, const Gemm g, const Sched& S, const Epi& E) {
    typedef typename AccSel<I8>::T acc_t;
    const int tid = opq(threadIdx.x), wid = __builtin_amdgcn_readfirstlane(tid >> 6), lane = tid & 63, wr = wid >> 2, wc = wid & 3, fr = lane & 15, fq = lane >> 4;
    const int K = g.K, nt = K / BK, lda = g.lda;
    unsigned voffA[2], voffB[2];
#pragma unroll
    for (int i = 0; i < 2; ++i) { int R, C; stage_rc(tid * 16 + i * 8192, R, C); const int Rb = Epi::PERM ? (64 * (R >> 5) + perm32(R & 31)) : R;
        voffA[i] = (unsigned)(R * lda + C) * 2u; voffB[i] = (unsigned)(Rb * K + C) * 2u; }
    const size_t kstep = (size_t)(BK * 2);
    const size_t hstepA = (size_t)HALF * lda * 2, hstepB = (size_t)(Epi::PERM ? 32 : HALF) * K * 2;
    const size_t tstepA = 2 * hstepA, tstepB = (size_t)BM * K * 2;
    const unsigned ldsw = (unsigned)wid * 1024u;
    const int aoff = lds_byte(wr * 64 + fr, fq * 8), boff = lds_byte(wc * 32 + fr, fq * 8);
#define PG8_SA(b, h) (((b) * 2 + (h)) * HTB)
#define PG8_SB(b, h) ((4 + (b) * 2 + (h)) * HTB)
#define PG8_STAGE(bufoff, gbase, voff) do { _Pragma("unroll") for (int _i = 0; _i < 2; ++_i) \
        __builtin_amdgcn_global_load_lds((const unsigned*)((const char*)(gbase) + (voff)[_i]), (PG8_LAS unsigned*)(lds + (bufoff) + ldsw + _i * 8192), 16, 0, 0); } while (0)
#define PG8_LDA(dst, b, h) do { _Pragma("unroll") for (int m = 0; m < 4; ++m) _Pragma("unroll") for (int k = 0; k < 2; ++k) dst[m][k] = *(const PG8_LAS bf16x8*)(lds + PG8_SA(b, h) + aoff + m * 2048 + k * 1024); } while (0)
#define PG8_LDB(dst, b, h) do { _Pragma("unroll") for (int n = 0; n < 2; ++n) _Pragma("unroll") for (int k = 0; k < 2; ++k) dst[n][k] = *(const PG8_LAS bf16x8*)(lds + PG8_SB(b, h) + boff + n * 2048 + k * 1024); } while (0)
#define PG8_MMA(ai, bj, At, Bt) do { __builtin_amdgcn_s_setprio(1); _Pragma("unroll") for (int m = 0; m < 4; ++m) _Pragma("unroll") for (int n = 0; n < 2; ++n) _Pragma("unroll") for (int k = 0; k < 2; ++k) { \
        if constexpr (I8) acc[ai][bj][m][n] = __builtin_amdgcn_mfma_i32_16x16x64_i8(__builtin_bit_cast(i32x4, Bt[n][k]), __builtin_bit_cast(i32x4, At[m][k]), acc[ai][bj][m][n], 0, 0, 0); \
        else acc[ai][bj][m][n] = __builtin_amdgcn_mfma_f32_16x16x32_bf16(Bt[n][k], At[m][k], acc[ai][bj][m][n], 0, 0, 0); } __builtin_amdgcn_s_setprio(0); } while (0)
#define PG8_WAIT_V(n) asm volatile("s_waitcnt vmcnt(" #n ")" ::: "memory")
#define PG8_WAIT_L(n) asm volatile("s_waitcnt lgkmcnt(" #n ")" ::: "memory")
#define PG8_BAR __builtin_amdgcn_s_barrier()
#define PG8_SCHED __builtin_amdgcn_sched_barrier(0)
    Unit cur, nxt; int ui = 0;
    if (!S.next(0, cur)) return;
    acc_t acc[2][2][4][2];
{ float zf = 0.f; asm volatile("" : "+v"(zf));
    #pragma unroll
    for (int a = 0; a < 2; ++a)
#pragma unroll
        for (int b = 0; b < 2; ++b)
#pragma unroll
            for (int m = 0; m < 4; ++m)
#pragma unroll
                for (int n = 0; n < 2; ++n) acc[a][b][m][n] = __builtin_bit_cast(acc_t, (f32x4){zf, zf, zf, zf}); }
    bf16x8 At[4][2], B0[2][2], B1[2][2];
    const char* cA = (const char*)g.A + (size_t)cur.pm * tstepA; const char* cB = (const char*)g.Bt + (size_t)cur.pn * tstepB;
    S.a_ready(cur);
    PG8_STAGE(PG8_SB(0, 0), cB, voffB); PG8_STAGE(PG8_SB(0, 1), cB + hstepB, voffB); PG8_STAGE(PG8_SA(0, 0), cA, voffA); PG8_STAGE(PG8_SA(0, 1), cA + hstepA, voffA);
    if (wr == 1) PG8_BAR;
    PG8_WAIT_V(2); PG8_BAR;
    PG8_STAGE(PG8_SB(1, 0), cB + kstep, voffB); PG8_STAGE(PG8_SA(1, 0), cA + kstep, voffA); PG8_STAGE(PG8_SB(1, 1), cB + hstepB + kstep, voffB);
    PG8_WAIT_V(6); PG8_BAR;
    for (;;) {
        const bool has_next = S.next(ui + 1, nxt);
        const char* nA = has_next ? (const char*)g.A + (size_t)nxt.pm * tstepA : cA; const char* nB = has_next ? (const char*)g.Bt + (size_t)nxt.pn * tstepB : cB;
#pragma unroll 1
        for (int t = 0; t < nt; t += 2) {
            const bool last = (t == nt - 2);
            const char* a1 = cA + (size_t)(t + 1) * kstep;
            const char* a2 = last ? nA : cA + (size_t)(t + 2) * kstep; const char* b2 = last ? nB : cB + (size_t)(t + 2) * kstep;
            const char* a3 = a2 + kstep; const char* b3 = b2 + kstep;
            if (last && has_next) S.a_ready(nxt);
            PG8_LDB(B0, 0, 0); PG8_LDB(B1, 0, 1); PG8_SCHED; PG8_LDA(At, 0, 0); PG8_STAGE(PG8_SA(1, 1), a1 + hstepA, voffA);
            PG8_WAIT_V(8); PG8_WAIT_L(0); PG8_BAR; PG8_MMA(0, 0, At, B0); PG8_MMA(0, 1, At, B1); PG8_BAR; PG8_SCHED;
            PG8_LDA(At, 0, 1); PG8_STAGE(PG8_SB(0, 0), b2, voffB); PG8_STAGE(PG8_SB(0, 1), b2 + hstepB, voffB); PG8_STAGE(PG8_SA(0, 0), a2, voffA);
            PG8_WAIT_V(8); PG8_WAIT_L(0); PG8_BAR; PG8_MMA(1, 0, At, B0); PG8_MMA(1, 1, At, B1); PG8_BAR; PG8_SCHED;
            PG8_LDB(B0, 1, 0); PG8_LDB(B1, 1, 1); PG8_SCHED; PG8_LDA(At, 1, 0); PG8_STAGE(PG8_SA(0, 1), a2 + hstepA, voffA);
            PG8_WAIT_V(8); PG8_WAIT_L(0); PG8_BAR; PG8_MMA(0, 0, At, B0); PG8_MMA(0, 1, At, B1); PG8_BAR; PG8_SCHED;
            PG8_LDA(At, 1, 1); PG8_STAGE(PG8_SB(1, 0), b3, voffB); PG8_STAGE(PG8_SB(1, 1), b3 + hstepB, voffB); PG8_STAGE(PG8_SA(1, 0), a3, voffA);
            PG8_WAIT_V(8); PG8_WAIT_L(0); PG8_BAR; PG8_MMA(1, 0, At, B0); PG8_MMA(1, 1, At, B1); PG8_BAR; PG8_SCHED;
        }
        if (wr == 0) PG8_BAR;
        if constexpr (I8) { f32x4 accf[2][2][4][2];
#pragma unroll
            for (int a = 0; a < 2; ++a)
#pragma unroll
                for (int b = 0; b < 2; ++b)
#pragma unroll
                    for (int m = 0; m < 4; ++m)
#pragma unroll
                        for (int n = 0; n < 2; ++n) accf[a][b][m][n] = __builtin_convertvector(acc[a][b][m][n], f32x4);
            E(accf, cur, wr, wc, fr, fq); }
        else E(acc, cur, wr, wc, fr, fq);
        S.done(cur);
        if (!has_next) break;
{ float zf = 0.f; asm volatile("" : "+v"(zf));
        #pragma unroll
        for (int a = 0; a < 2; ++a)
#pragma unroll
            for (int b = 0; b < 2; ++b)
#pragma unroll
                for (int m = 0; m < 4; ++m)
#pragma unroll
                    for (int n = 0; n < 2; ++n) acc[a][b][m][n] = __builtin_bit_cast(acc_t, (f32x4){zf, zf, zf, zf}); }
        cur = nxt; cA = nA; cB = nB; ++ui;
        if (wr == 1) PG8_BAR;
    }
    PG8_WAIT_V(0);
    PG8_BAR;
#undef PG8_SA
#undef PG8_SB
#undef PG8_STAGE
#undef PG8_LDA
#undef PG8_LDB
#undef PG8_MMA
#undef PG8_WAIT_V
#undef PG8_WAIT_L
#undef PG8_BAR
#undef PG8_SCHED
}
}
namespace at {
using bf16 = unsigned short;
using bf16x8 = __attribute__((ext_vector_type(8))) short;
using s16x4  = __attribute__((ext_vector_type(4))) short;
using f32x16 = __attribute__((ext_vector_type(16))) float;
using u32x4  = __attribute__((ext_vector_type(4))) unsigned;
using f32x4  = __attribute__((ext_vector_type(4))) float;
constexpr int DQK = 192, DV = 128, KVBLK = 64, NW = 8, QBLK = 32;
constexpr float SCALE = 0.07216878364870322f;
constexpr float THR = 8.f;
constexpr int LDQ = 1536, LDK = 2560, LDO = 2048;
constexpr int SHM_V = KVBLK * DV * 2, SHM_K = 12 * 2080;
constexpr int QR_OFF = 2 * SHM_V + 2 * SHM_K + NW * 64 * 4;
constexpr int SHM_ATTN = QR_OFF + NW * 4096;
#define SBAR() __builtin_amdgcn_sched_barrier(0)
constexpr int KPL = 2080;
__host__ __device__ __forceinline__ int k_st(int row, int c) { return (c >> 1) * KPL + row * 32 + (((c & 1) ^ ((row >> 3) & 1)) << 4); }
__host__ __device__ __forceinline__ int k_rd_base(int r32, int hi) { return r32 * 32 + ((hi ^ ((r32 >> 3) & 1)) << 4); }
__device__ __forceinline__ int crow(int r, int hi) { return (r & 3) + 8 * (r >> 2) + 4 * hi; }
__device__ __forceinline__ unsigned cvtpk(float lo, float hi) { unsigned r; asm volatile("v_cvt_pk_bf16_f32 %0, %1, %2" : "=v"(r) : "v"(lo), "v"(hi)); return r; }

__device__ __forceinline__ void partialSM(f32x16& p0, f32x16& p1, float& m_reg, float& mn, float& alpha) {
  constexpr float C = 1.0f;
  float pmax = p0[0];
#pragma unroll
  for (int r = 1; r < 16; ++r) pmax = fmaxf(pmax, p0[r]);
#pragma unroll
  for (int r = 0; r < 16; ++r) pmax = fmaxf(pmax, p1[r]);
  { auto rr = __builtin_amdgcn_permlane32_swap(__float_as_uint(pmax), __float_as_uint(pmax), false, false);
    pmax = fmaxf(__uint_as_float(rr[0]), __uint_as_float(rr[1])); }
  if (__builtin_expect(__all(pmax - m_reg <= THR * 1.4426950408889634f), 1)) { mn = m_reg; alpha = 1.f; }
  else { mn = fmaxf(m_reg, pmax); alpha = __builtin_amdgcn_exp2f((m_reg - mn) * C); m_reg = mn; }
  float mnC = -mn * C;
#pragma unroll
  for (int r = 0; r < 16; ++r) p0[r] = fmaf(p0[r], C, mnC);
#pragma unroll
  for (int r = 0; r < 16; ++r) p1[r] = fmaf(p1[r], C, mnC);
#pragma unroll
  for (int r = 0; r < 16; ++r) p0[r] = __builtin_amdgcn_exp2f(p0[r]);
}
__device__ __forceinline__ void partialSM_fast(f32x16& p0, f32x16& p1, float negMC) {
  (void)negMC; (void)p1;
#pragma unroll
  for (int r = 0; r < 16; ++r) p0[r] = __builtin_amdgcn_exp2f(p0[r]);
}
__device__ __forceinline__ void finishSM(f32x16& p0, f32x16& p1, float alpha, float& l_reg, bf16x8& pa0, bf16x8& pa1, bf16x8& pa2, bf16x8& pa3) {
#pragma unroll
  for (int r = 0; r < 16; ++r) p1[r] = __builtin_amdgcn_exp2f(p1[r]);
  float ps = 0;
#pragma unroll
  for (int r = 0; r < 16; ++r) ps += p0[r];
#pragma unroll
  for (int r = 0; r < 16; ++r) ps += p1[r];
  { auto rr = __builtin_amdgcn_permlane32_swap(__float_as_uint(ps), __float_as_uint(ps), false, false);
    ps = __uint_as_float(rr[0]) + __uint_as_float(rr[1]); }
  l_reg = l_reg * alpha + ps;
#define PK4(P, BASE, OUT) do { unsigned a0 = cvtpk(P[BASE + 0], P[BASE + 1]), a1 = cvtpk(P[BASE + 2], P[BASE + 3]);   \
    unsigned b0 = cvtpk(P[BASE + 4], P[BASE + 5]), b1 = cvtpk(P[BASE + 6], P[BASE + 7]);                              \
    auto r0 = __builtin_amdgcn_permlane32_swap(a0, b0, false, false); auto r1 = __builtin_amdgcn_permlane32_swap(a1, b1, false, false); \
    u32x4 w = {r0[0], r1[0], r0[1], r1[1]}; OUT = *reinterpret_cast<bf16x8*>(&w); } while (0)
  PK4(p0, 0, pa0); PK4(p0, 8, pa1); PK4(p1, 0, pa2); PK4(p1, 8, pa3);
#undef PK4
}
template <int OFF> __device__ __forceinline__ bf16x8 k_read(int kb) {
  bf16x8 r; asm volatile("ds_read_b128 %0, %1 offset:%2" : "=v"(r) : "v"(kb), "i"(OFF) : "memory"); return r;
}
__device__ __forceinline__ void qkt(f32x16& p0, f32x16& p1, int kb, const bf16x8* qr, int qb) {
  p0 = f32x16{}; p1 = f32x16{};
#define QK1(d0) { const bf16x8 b0 = *(const __attribute__((address_space(3))) bf16x8*)(kb + d0 * KPL), b1 = *(const __attribute__((address_space(3))) bf16x8*)(kb + d0 * KPL + 1024); \
    p0 = __builtin_amdgcn_mfma_f32_32x32x16_bf16(b0, qr[d0], p0, 0, 0, 0); p1 = __builtin_amdgcn_mfma_f32_32x32x16_bf16(b1, qr[d0], p1, 0, 0, 0); }
#define QK2(d0) { const bf16x8 b0 = *(const __attribute__((address_space(3))) bf16x8*)(kb + d0 * KPL), b1 = *(const __attribute__((address_space(3))) bf16x8*)(kb + d0 * KPL + 1024); \
    const bf16x8 qf = *(const __attribute__((address_space(3))) bf16x8*)(qb + (d0 - 8) * 1024); \
    p0 = __builtin_amdgcn_mfma_f32_32x32x16_bf16(b0, qf, p0, 0, 0, 0); p1 = __builtin_amdgcn_mfma_f32_32x32x16_bf16(b1, qf, p1, 0, 0, 0); }
  QK1(0) QK1(1) QK1(2) QK1(3) QK1(4) QK1(5) QK1(6) QK1(7) QK2(8) QK2(9) QK2(10) QK2(11)
#undef QK1
#undef QK2
}
__host__ __device__ __forceinline__ int v_st(int k, int c) { const int kk = (k & ~0xC) | ((k & 4) << 1) | ((k & 8) >> 1); return ((kk >> 3) * 4 + (c >> 5)) * 512 + ((kk & 7) * 32 + (c & 31)) * 2; }
__device__ __forceinline__ int v_rd_base(int lane) { return ((lane & 3) << 3) | (((lane >> 2) & 3) << 6) | (((lane >> 4) & 1) << 5) | (((lane >> 5) & 1) << 8); }
constexpr int v_rd_off(int d0, int ks, int half) { return d0 * 512 + ks * 4096 + half * 2048; }
template <int OFF> __device__ __forceinline__ s16x4 tr_read(int vb) {
  s16x4 r; asm volatile("ds_read_b64_tr_b16 %0, %1 offset:%2" : "=&v"(r) : "v"(vb), "i"(OFF) : "memory"); return r;
}
template <int D0> __device__ __forceinline__ void pv_one(f32x16& od, int vb, bf16x8 pa0, bf16x8 pa1, bf16x8 pa2, bf16x8 pa3) {
  const s16x4 l0 = tr_read<v_rd_off(D0, 0, 0)>(vb), h0 = tr_read<v_rd_off(D0, 0, 1)>(vb), l1 = tr_read<v_rd_off(D0, 1, 0)>(vb), h1 = tr_read<v_rd_off(D0, 1, 1)>(vb);
  const s16x4 l2 = tr_read<v_rd_off(D0, 2, 0)>(vb), h2 = tr_read<v_rd_off(D0, 2, 1)>(vb), l3 = tr_read<v_rd_off(D0, 3, 0)>(vb), h3 = tr_read<v_rd_off(D0, 3, 1)>(vb);
  asm volatile("s_waitcnt lgkmcnt(0)" ::: "memory"); SBAR();
#define PK(L, H) (bf16x8){L[0], L[1], L[2], L[3], H[0], H[1], H[2], H[3]}
  od = __builtin_amdgcn_mfma_f32_32x32x16_bf16(pa0, PK(l0, h0), od, 0, 0, 0);
  od = __builtin_amdgcn_mfma_f32_32x32x16_bf16(pa1, PK(l1, h1), od, 0, 0, 0);
  od = __builtin_amdgcn_mfma_f32_32x32x16_bf16(pa2, PK(l2, h2), od, 0, 0, 0);
  od = __builtin_amdgcn_mfma_f32_32x32x16_bf16(pa3, PK(l3, h3), od, 0, 0, 0);
#undef PK
}
__device__ __forceinline__ void pv_d0(f32x16* o, int vb, bf16x8 pa0, bf16x8 pa1, bf16x8 pa2, bf16x8 pa3) {
  pv_one<0>(o[0], vb, pa0, pa1, pa2, pa3); pv_one<1>(o[1], vb, pa0, pa1, pa2, pa3); pv_one<2>(o[2], vb, pa0, pa1, pa2, pa3); pv_one<3>(o[3], vb, pa0, pa1, pa2, pa3);
}

template <bool FAST>
__device__ __forceinline__ void attn_unit(const float negMC, const bf16* __restrict__ Qb, const bf16* __restrict__ Kh, const bf16* __restrict__ Vh, bf16* __restrict__ Ob, int seq, char* lds,
                                          const float* __restrict__ ssqcq, const float* __restrict__ qg, const float* __restrict__ rope0) {
  const int tid = opq(threadIdx.x), wid = tid >> 6, lane = tid & 63, r32 = lane & 31, hi = lane >> 5;
  char* V_lds = lds; char* K_lds = lds + 2 * SHM_V;
  float* ws = (float*)(lds + 2 * SHM_V + 2 * SHM_K) + wid * 64; float* li_l = ws; float* al_l = ws + 32;
  float m_reg = -1e30f, l_reg = 0; f32x16 o[4] = {}; bf16x8 qr[8];
  const bf16* Qw = Qb + (unsigned)((wid * QBLK + r32) * LDQ + hi * 8);
  const int qb0 = (int)(uintptr_t)lds + QR_OFF + wid * 4096 + k_rd_base(r32, hi);
  { const int row = wid * QBLK + r32;
    bf16x8 raw[12];
#pragma unroll
    for (int d0 = 0; d0 < 12; ++d0) raw[d0] = *reinterpret_cast<const bf16x8*>(Qw + d0 * 16);
    const f32x4 pa = *(const f32x4*)(ssqcq + row * 8), pb = *(const f32x4*)(ssqcq + row * 8 + 4);
    const float rq = 1.0f / __builtin_sqrtf((((pa.x + pa.y) + (pa.z + pa.w)) + ((pb.x + pb.y) + (pb.z + pb.w))) * (1.f / 512.f) + 1e-6f);
    float ss = 0.f;
#pragma unroll
    for (int d0 = 0; d0 < 12; ++d0)
#pragma unroll
      for (int i = 0; i < 8; ++i) { const float x = __builtin_bit_cast(float, (unsigned)(unsigned short)raw[d0][i] << 16); ss += x * x; }
    ss += __shfl_xor(ss, 32);
    const float sc = (rq * (SCALE * 1.4426950408889634f)) / __builtin_sqrtf(ss * (rq * rq) * (1.f / 192.f) + 1e-6f);
#define QX(d0, i) (__builtin_bit_cast(float, (unsigned)(unsigned short)raw[d0][i] << 16) * sc)
#pragma unroll
    for (int d0 = 0; d0 < 8; ++d0) { const f32x4 g0 = *(const f32x4*)(qg + 16 * d0 + 8 * hi), g1 = *(const f32x4*)(qg + 16 * d0 + 8 * hi + 4);
      u32x4 w = {cvtpk(QX(d0, 0) * g0.x, QX(d0, 1) * g0.y), cvtpk(QX(d0, 2) * g0.z, QX(d0, 3) * g0.w), cvtpk(QX(d0, 4) * g1.x, QX(d0, 5) * g1.y), cvtpk(QX(d0, 6) * g1.z, QX(d0, 7) * g1.w)};
      qr[d0] = *reinterpret_cast<bf16x8*>(&w); }
#pragma unroll
    for (int t = 0; t < 2; ++t) { const int da = 8 + t, db = 10 + t, j0 = 16 * t + 8 * hi;
      const float* rp = rope0 + row * 64 + j0;
      const f32x4 c0 = *(const f32x4*)rp, c1 = *(const f32x4*)(rp + 4), s0 = *(const f32x4*)(rp + 32), s1 = *(const f32x4*)(rp + 36);
      const f32x4 ga0 = *(const f32x4*)(qg + 16 * da + 8 * hi), ga1 = *(const f32x4*)(qg + 16 * da + 8 * hi + 4), gb0 = *(const f32x4*)(qg + 16 * db + 8 * hi), gb1 = *(const f32x4*)(qg + 16 * db + 8 * hi + 4);
      const float cs[8] = {c0.x, c0.y, c0.z, c0.w, c1.x, c1.y, c1.z, c1.w}, sn[8] = {s0.x, s0.y, s0.z, s0.w, s1.x, s1.y, s1.z, s1.w};
      const float ga[8] = {ga0.x, ga0.y, ga0.z, ga0.w, ga1.x, ga1.y, ga1.z, ga1.w}, gb[8] = {gb0.x, gb0.y, gb0.z, gb0.w, gb1.x, gb1.y, gb1.z, gb1.w};
      float oa[8], ob[8];
#pragma unroll
      for (int i = 0; i < 8; ++i) { const float xa = QX(da, i) * ga[i], xb = QX(db, i) * gb[i]; oa[i] = xa * cs[i] - xb * sn[i]; ob[i] = xb * cs[i] + xa * sn[i]; }
      u32x4 wa = {cvtpk(oa[0], oa[1]), cvtpk(oa[2], oa[3]), cvtpk(oa[4], oa[5]), cvtpk(oa[6], oa[7])}, wb = {cvtpk(ob[0], ob[1]), cvtpk(ob[2], ob[3]), cvtpk(ob[4], ob[5]), cvtpk(ob[6], ob[7])};
      *(__attribute__((address_space(3))) bf16x8*)(qb0 + (da - 8) * 1024) = *reinterpret_cast<bf16x8*>(&wa);
      *(__attribute__((address_space(3))) bf16x8*)(qb0 + (db - 8) * 1024) = *reinterpret_cast<bf16x8*>(&wb); }
#undef QX
  }
  const int sr = tid >> 4, sc = (tid & 15) * 8, vst0 = v_st(sr, sc), vst1 = v_st(32 + sr, sc);
  unsigned koff[3]; int kst[3];
#pragma unroll
  for (int i = 0; i < 3; ++i) { const int q = tid + 512 * i; koff[i] = (unsigned)((q / 24) * LDK + (q % 24) * 8); kst[i] = k_st(q / 24, q % 24); }
  const unsigned voff0 = (unsigned)(sr * LDK + sc), voff1 = (unsigned)((32 + sr) * LDK + sc);
  const int vb0 = (int)(uintptr_t)V_lds + v_rd_base(lane); const int kb0 = (int)(uintptr_t)K_lds + k_rd_base(r32, hi);
  struct { bf16x8 vs0, vs1, ks0, ks1, ks2; } sr_[1];
#define SLOAD(i, k0) do { const bf16* vt = Vh + (size_t)(k0) * LDK; const bf16* kt = Kh + (size_t)(k0) * LDK; \
    sr_[i].vs0 = *(const bf16x8*)(vt + voff0); sr_[i].vs1 = *(const bf16x8*)(vt + voff1); \
    sr_[i].ks0 = *(const bf16x8*)(kt + koff[0]); sr_[i].ks1 = *(const bf16x8*)(kt + koff[1]); sr_[i].ks2 = *(const bf16x8*)(kt + koff[2]); } while (0)
#define SWRITE(b, i) do { *(bf16x8*)(V_lds + (b) * SHM_V + vst0) = sr_[i].vs0; *(bf16x8*)(V_lds + (b) * SHM_V + vst1) = sr_[i].vs1; \
    *(bf16x8*)(K_lds + (b) * SHM_K + kst[0]) = sr_[i].ks0; *(bf16x8*)(K_lds + (b) * SHM_K + kst[1]) = sr_[i].ks1; *(bf16x8*)(K_lds + (b) * SHM_K + kst[2]) = sr_[i].ks2; } while (0)
#define SWAIT() do { if constexpr (SDEPTH == 2) asm volatile("s_waitcnt vmcnt(5)" ::: "memory"); else asm volatile("s_waitcnt vmcnt(0)" ::: "memory"); } while (0)
#define RESC(a) do { if (__any((a) < 1.f)) { if (hi == 0) al_l[r32] = (a); asm volatile("s_waitcnt lgkmcnt(0)" ::: "memory"); \
    _Pragma("unroll") for (int d = 0; d < 4; ++d) _Pragma("unroll") for (int r = 0; r < 16; ++r) o[d][r] *= al_l[crow(r, hi)]; } } while (0)
  f32x16 pA0, pA1, pB0, pB1; float mnA, mnB, alA, alB; bf16x8 pa0, pa1, pa2, pa3; const int NT = seq / KVBLK;
#define PSM(P0, P1, MN, AL) do { if constexpr (FAST) { partialSM_fast(P0, P1, negMC); AL = 1.f; } else partialSM(P0, P1, m_reg, MN, AL); } while (0)
#define RSC(AL) do { if constexpr (!FAST) RESC(AL); } while (0)
  SLOAD(0, 0); asm volatile("s_waitcnt vmcnt(0)" ::: "memory"); SWRITE(0, 0); __syncthreads();
  qkt(pA0, pA1, kb0, qr, qb0); PSM(pA0, pA1, mnA, alA);
  SLOAD(0, KVBLK);
  asm volatile("s_waitcnt vmcnt(0)" ::: "memory"); SWRITE(1, 0); __syncthreads();
  for (int j = 1; j + 1 < NT; j += 2) {
    SBAR(); qkt(pB0, pB1, kb0 + SHM_K, qr, qb0);
    finishSM(pA0, pA1, alA, l_reg, pa0, pa1, pa2, pa3); SBAR();
    SLOAD(0, (j + 1) * KVBLK); SBAR();
    pv_d0(o, vb0, pa0, pa1, pa2, pa3); PSM(pB0, pB1, mnB, alB);
    __syncthreads(); asm volatile("s_waitcnt vmcnt(0)" ::: "memory"); SWRITE(0, 0);
    RSC(alB); __syncthreads();
    SBAR(); qkt(pA0, pA1, kb0, qr, qb0);
    finishSM(pB0, pB1, alB, l_reg, pa0, pa1, pa2, pa3); SBAR();
    SLOAD(0, (j + 2) * KVBLK); SBAR();
    pv_d0(o, vb0 + (int)SHM_V, pa0, pa1, pa2, pa3); PSM(pA0, pA1, mnA, alA);
    __syncthreads(); asm volatile("s_waitcnt vmcnt(0)" ::: "memory"); SWRITE(1, 0);
    RSC(alA); __syncthreads();
  }
  SBAR(); qkt(pB0, pB1, kb0 + SHM_K, qr, qb0);
  finishSM(pA0, pA1, alA, l_reg, pa0, pa1, pa2, pa3); SBAR();
  pv_d0(o, vb0, pa0, pa1, pa2, pa3); PSM(pB0, pB1, mnB, alB);
  __syncthreads(); RSC(alB);
  finishSM(pB0, pB1, alB, l_reg, pa0, pa1, pa2, pa3); SBAR();
  pv_d0(o, vb0 + (int)SHM_V, pa0, pa1, pa2, pa3);
  if (hi == 0) li_l[r32] = l_reg; asm volatile("s_waitcnt lgkmcnt(0)" ::: "memory");
  bf16* Ow = Ob + (unsigned)(wid * QBLK * LDO + r32);
#pragma unroll
  for (int r = 0; r < 16; ++r) { const int orow = crow(r, hi); const float rl = __builtin_amdgcn_rcpf(li_l[orow]);
#pragma unroll
    for (int d0 = 0; d0 < 4; ++d0) { const unsigned w = cvtpk(o[d0][r] * rl, 0.f); Ow[(unsigned)(orow * LDO + d0 * 32)] = (bf16)(w & 0xffffu); } }
  __syncthreads();
#undef SLOAD
#undef SWRITE
#undef SWAIT
#undef RESC
#undef PSM
#undef RSC
}
}
namespace hy {
#define HY_LAS __attribute__((address_space(3)))
typedef unsigned short bf16;
typedef short bf16x8 __attribute__((ext_vector_type(8)));
typedef float f32x16 __attribute__((ext_vector_type(16)));
typedef unsigned u32x2 __attribute__((ext_vector_type(2)));
typedef unsigned u32x4 __attribute__((ext_vector_type(4)));
constexpr int L = 2048, NB = 24, CH = 512;
constexpr int RFS = 4112;
constexpr int ZROW = 4112;
constexpr int ZL_BYTES = NB * ZROW;
constexpr int RCS = 8256;
constexpr int RC_OFF = ZL_BYTES;
constexpr int HY_LDS_BYTES = RC_OFF + 4 * RCS;
__device__ __forceinline__ unsigned cvtpk(float lo, float hi) { unsigned r; asm volatile("v_cvt_pk_bf16_f32 %0, %1, %2" : "=v"(r) : "v"(lo), "v"(hi)); return r; }
__host__ __device__ __forceinline__ int frag_base(int tw, int r, int h) { const int a = (4 - (r & 3)) & 3; return RC_OFF + a * RCS + 2 * (2048 - tw - r + 8 * h - a); }
__host__ __device__ __forceinline__ int zfrag_base(int r, int h) { return (r < NB ? r : NB - 1) * ZROW + 16 * h; }

__device__ __forceinline__ bf16x8 ld_frag(HY_LAS unsigned char* lds, int off) {
    const u32x2 lo = *(const HY_LAS u32x2*)(lds + off), hi = *(const HY_LAS u32x2*)(lds + off + 8);
    u32x4 w = {lo.x, lo.y, hi.x, hi.y}; return *reinterpret_cast<bf16x8*>(&w);
}
__device__ __forceinline__ bf16x8 ld_b128(HY_LAS unsigned char* lds, int off) { return *(const HY_LAS bf16x8*)(lds + off); }

__device__ __forceinline__ void conv_unit(HY_LAS unsigned char* lds, const bf16* __restrict__ ZT, const bf16* __restrict__ RF, bf16* __restrict__ YC, int c, int half) {
    const int tid = opq(threadIdx.x), wid = tid >> 6, lane = tid & 63, r = lane & 31, h = lane >> 5;
    { const u32x4* src = (const u32x4*)(ZT + (size_t)c * NB * L);
#pragma unroll
      for (int i = 0; i < 12; ++i) { const int q = tid + 512 * i; const u32x4 v = src[q]; *(HY_LAS u32x4*)(lds + (q >> 8) * ZROW + (q & 255) * 16) = v; } }
    { const bf16* rf = RF + (size_t)c * RFS;
      for (int ch = tid; ch < RFS / 8; ch += 512) {
          const u32x4 v = *(const u32x4*)(rf + ch * 8); const unsigned w[4] = {v.x, v.y, v.z, v.w};
#pragma unroll
          for (int j = 0; j < 8; ++j) { const unsigned short e = (unsigned short)((w[j >> 1] >> ((j & 1) * 16)) & 0xffffu); const int idx = ch * 8 + j;
#pragma unroll
              for (int a = 0; a < 4; ++a) if (idx - a >= 0) *(HY_LAS unsigned short*)(lds + RC_OFF + a * RCS + 2 * (idx - a)) = e; } } }
    __syncthreads();
    const int tw = half * 1024 + wid * 128;
    const int fb = frag_base(tw, r, h), zb = zfrag_base(r, h);
    f32x16 acc[4] = {};
    bf16x8 S0[2], S1[2], S2[2], S3[2], Bc[2], Bn[2];
#define HY_LDG(S, d) do { S[0] = ld_frag(lds, fb + 64 * (d)); S[1] = ld_frag(lds, fb + 64 * (d) + 32); } while (0)
#define HY_LDB(Bx, n) do { Bx[0] = ld_b128(lds, zb + 64 * (n)); Bx[1] = ld_b128(lds, zb + 64 * (n) + 32); } while (0)
#define HY_MM(i, S, Bx) do { acc[i] = __builtin_amdgcn_mfma_f32_32x32x16_bf16(S[0], Bx[0], acc[i], 0, 0, 0); acc[i] = __builtin_amdgcn_mfma_f32_32x32x16_bf16(S[1], Bx[1], acc[i], 0, 0, 0); } while (0)
#define HY_ITER(n, Sa, Sb, Sc, Sd, Bcur, Bnext) do { HY_LDG(Sa, (n)); if ((n) + 1 < 64) HY_LDB(Bnext, (n) + 1); \
        HY_MM(1, Sb, Bcur); HY_MM(2, Sc, Bcur); HY_MM(3, Sd, Bcur); HY_MM(0, Sa, Bcur); } while (0)
    HY_LDG(S3, -1); HY_LDG(S2, -2); HY_LDG(S1, -3); HY_LDB(Bc, 0);
    for (int n = 0; n < 64; n += 4) {
        HY_ITER(n, S0, S3, S2, S1, Bc, Bn);
        HY_ITER(n + 1, S1, S0, S3, S2, Bn, Bc);
        HY_ITER(n + 2, S2, S1, S0, S3, Bc, Bn);
        HY_ITER(n + 3, S3, S2, S1, S0, Bn, Bc);
    }
#undef HY_LDG
#undef HY_LDB
#undef HY_MM
#undef HY_ITER
    if (r < NB) { bf16* yp = YC + ((size_t)c * NB + r) * L + tw + 4 * h;
#pragma unroll
        for (int i = 0; i < 4; ++i)
#pragma unroll
            for (int q4 = 0; q4 < 4; ++q4) { u32x2 w; w.x = cvtpk(acc[i][4 * q4 + 0], acc[i][4 * q4 + 1]); w.y = cvtpk(acc[i][4 * q4 + 2], acc[i][4 * q4 + 3]);
                *(u32x2*)(yp + 32 * i + 8 * q4) = w; } }
    __syncthreads();
}
}
constexpr int NWAVES = 8;
#ifndef MK_ONE_LAUNCH
#define MK_ONE_LAUNCH 1
#endif
constexpr int DM = 2048, NSEQ = 24, SEQ = 2048, M = NSEQ * SEQ, MP = 8 * SEQ;
constexpr int DEPTH = 4;
constexpr int DIN = 2880, DINP = 3072;
constexpr int O_CQ = 512, O_CKV = 1024, O_KPE = 1280, O_HY = 1344;
constexpr int NH = 8, NQ = 1536, NKVP = 2560, KVHS = 320;
constexpr int DFF = 5632, NUP = 11264, HYC = 512;
constexpr float EPS = 1e-6f;
constexpr int NPH = 11;
constexpr size_t WS_CTL = 0, CTL_BYTES = 1u << 20;
constexpr size_t SZ_BTIN = (size_t)DINP * DM * 2, SZ_BTUQ = (size_t)NQ * 512 * 2, SZ_BTKV = (size_t)NKVP * 256 * 2, SZ_BTOUT = (size_t)DM * DM * 2, SZ_BTUP = (size_t)NUP * DM * 2, SZ_BTDN = (size_t)DM * DFF * 2;
constexpr size_t WS_BTIN = WS_CTL + CTL_BYTES, WS_BTUQ = WS_BTIN + SZ_BTIN, WS_BTKV = WS_BTUQ + SZ_BTUQ, WS_BTOUT = WS_BTKV + SZ_BTKV, WS_BTUP = WS_BTOUT + SZ_BTOUT, WS_BTDN = WS_BTUP + SZ_BTUP;
constexpr size_t WS_RF = WS_BTDN + SZ_BTDN, SZ_RF = (size_t)HYC * hy::RFS * 2;
constexpr size_t WS_H = WS_RF + SZ_RF, SZ_H = (size_t)M * DM * 2;
constexpr size_t WS_PROJ = WS_H + SZ_H, SZ_PROJ = (size_t)M * DINP * 2;
constexpr size_t WS_Q = WS_PROJ + SZ_PROJ, SZ_Q = (size_t)M * NQ * 2;
constexpr size_t WS_KV = WS_Q + SZ_Q, SZ_KV = (size_t)M * NKVP * 2;
constexpr size_t WS_ZT = WS_KV + SZ_KV, SZ_ZT = (size_t)HYC * NSEQ * SEQ * 2;
constexpr size_t WS_X0 = WS_ZT + SZ_ZT, WS_YC = WS_X0 + SZ_ZT;
constexpr size_t WS_EDGE = WS_YC + SZ_ZT, SZ_EDGE = (size_t)(M / 256) * 2 * 3 * DFF * 4;
constexpr size_t WS_ROPE = WS_EDGE + SZ_EDGE, SZ_ROPE = (size_t)SEQ * 64 * 4;
constexpr size_t WS_SSQP = WS_ROPE + SZ_ROPE, SZ_SSQP = (size_t)M * 32 * 4;
constexpr size_t WS_RSTD = WS_SSQP + SZ_SSQP, SZ_RSTD = (size_t)M * 4;
constexpr size_t WS_XQ = WS_RSTD + SZ_RSTD, SZ_XQ = (size_t)M * DM;
constexpr size_t WS_SSQCQ = WS_XQ + SZ_XQ, SZ_SSQCQ = (size_t)M * 8 * 4;
constexpr size_t WS_END = WS_SSQCQ + SZ_SSQCQ;
constexpr size_t WS_ACT = WS_PROJ;
static_assert((size_t)M * DFF * 2 <= SZ_PROJ + SZ_Q + SZ_KV, "ACT overlay");
constexpr size_t WS_XB2 = WS_ACT + (size_t)M * DFF * 2;
static_assert(WS_XB2 + (size_t)M * DM * 2 <= WS_EDGE && WS_XB2 % 256 == 0, "XB2 overlay");
static_assert(WS_BTIN % 256 == 0 && WS_RF % 256 == 0 && WS_H % 256 == 0 && WS_PROJ % 256 == 0 && WS_Q % 256 == 0 && WS_KV % 256 == 0 && WS_ZT % 256 == 0 && WS_EDGE % 256 == 0, "alignment");
constexpr int CW_WMAXC = 65536;
constexpr int CW_WMAX = 1024;
constexpr int CW_BAR = 4096;
constexpr int RING_BYTES = 135168;
constexpr int HALO_OFF = RING_BYTES, HALO_BYTES = 4096;
constexpr int MISC_OFF = HALO_OFF + HALO_BYTES;
constexpr int LDS_BYTES = 147456;
static_assert(hy::HY_LDS_BYTES <= RING_BYTES && at::SHM_ATTN <= RING_BYTES && MISC_OFF + 256 <= LDS_BYTES, "LDS map");

#define GAS __attribute__((address_space(1)))
#define LAS __attribute__((address_space(3)))
typedef unsigned short bf16;
typedef unsigned v4u __attribute__((ext_vector_type(4)));
typedef unsigned v2u __attribute__((ext_vector_type(2)));
typedef float f32x4 __attribute__((ext_vector_type(4)));
#define LDS_WAIT() asm volatile("s_waitcnt lgkmcnt(0)" ::: "memory")
__device__ __forceinline__ unsigned f2bf(float f) { unsigned u = __builtin_bit_cast(unsigned, f); return (u + 0x7fffu + ((u >> 16) & 1u)) >> 16; }
__device__ __forceinline__ unsigned pk2(float lo, float hi) { return f2bf(lo) | (f2bf(hi) << 16); }
__device__ __forceinline__ float bf2f(unsigned short b) { return __builtin_bit_cast(float, (unsigned)b << 16); }
__device__ __forceinline__ float bflo(unsigned w) { return __builtin_bit_cast(float, w << 16); }
__device__ __forceinline__ float bfhi(unsigned w) { return __builtin_bit_cast(float, w & 0xffff0000u); }
__device__ __forceinline__ float wave_sum(float v) {
#pragma unroll
    for (int o = 1; o < 64; o <<= 1) v += __shfl_xor(v, o);
    return v;
}

#define XB_TMO      128
#define XB_XCNT(j)  (256  + 64 * (j))
#define XB_XSUB(j)  (1280 + 64 * (j))
#define XB_XGEN(j)  (2304 + 64 * (j))
#define XB_TOP      3328
#define XB_TOPGEN   3392
#define XCD_BAR_WORDS 3456
#define XB_SPIN_CAP (1u << 18)
__device__ __forceinline__ unsigned xb_ld(unsigned* p)              { return __hip_atomic_load(p, __ATOMIC_RELAXED, __HIP_MEMORY_SCOPE_AGENT); }
__device__ __forceinline__ unsigned xb_add(unsigned* p, unsigned v) { return __hip_atomic_fetch_add(p, v, __ATOMIC_RELAXED, __HIP_MEMORY_SCOPE_AGENT); }
__device__ __forceinline__ unsigned xb_xcc_id() { return (unsigned)__builtin_amdgcn_s_getreg((3 << 11) | 20) & 0xFu; }
#define XB_SPIN(cond, bar) do { unsigned _sp = 0; while (cond) { __builtin_amdgcn_s_sleep(1); \
    if ((++_sp & 255u) == 0u) { if (xb_ld(&(bar)[XB_TMO])) break; if (_sp > XB_SPIN_CAP) { atomicAdd(&(bar)[XB_TMO], 1u); break; } } } } while (0)
struct XcdBarrier { unsigned* bar; unsigned x; volatile LAS unsigned* st; };
__device__ __forceinline__ XcdBarrier xcd_barrier_post(unsigned* bar, volatile LAS unsigned* st) {
    XcdBarrier b; b.bar = bar; b.x = xb_xcc_id(); b.st = st;
    if (threadIdx.x == 0) (void)xb_add(&bar[XB_XCNT(b.x)], 1u);
    return b;
}
__device__ __forceinline__ void xcd_barrier_complete(unsigned* bar, unsigned x, unsigned& nloc, unsigned& nx) {
    const unsigned G = gridDim.x * gridDim.y * gridDim.z;
    unsigned sum, cnt, mine, sp = 0u;
    for (;;) {
        sum = 0u; cnt = 0u; mine = 0u;
#pragma unroll
        for (unsigned j = 0; j < 16; ++j) { const unsigned c = xb_ld(&bar[XB_XCNT(j)]); sum += c; cnt += (c > 0u) ? 1u : 0u; mine = (j == x) ? c : mine; }
        if (sum == G) break;
        __builtin_amdgcn_s_sleep(1);
        if ((++sp & 255u) == 0u) { if (xb_ld(&bar[XB_TMO])) break; if (sp > XB_SPIN_CAP) { atomicAdd(&bar[XB_TMO], 1u); break; } }
    }
    nloc = mine > 0u ? mine : 1u; nx = cnt > 0u ? cnt : 1u;
}
__device__ __forceinline__ void xcd_barrier(const XcdBarrier& b) {
    asm volatile("s_waitcnt vmcnt(0)" ::: "memory");
    __syncthreads();
    if (threadIdx.x == 0) {
        unsigned* bar = b.bar;
        __builtin_amdgcn_s_waitcnt(0);
        unsigned nloc = b.st[0], nx = b.st[1];
        if (nloc == 0u) { xcd_barrier_complete(bar, b.x, nloc, nx); b.st[0] = nloc; b.st[1] = nx; }
        const unsigned old = xb_add(&bar[XB_XSUB(b.x)], 1u);
        const unsigned gen = old / nloc;
        if (old + 1u == (gen + 1u) * nloc) {
            __builtin_amdgcn_fence(__ATOMIC_RELEASE, "agent");
            asm volatile("s_waitcnt vmcnt(0)" ::: "memory");
            const unsigned og = xb_add(&bar[XB_TOP], 1u);
            const unsigned tg = og / nx;
            if (og + 1u == (tg + 1u) * nx) xb_add(&bar[XB_TOPGEN], 1u);
            else XB_SPIN(xb_ld(&bar[XB_TOPGEN]) == tg, bar);
            __builtin_amdgcn_fence(__ATOMIC_ACQUIRE, "agent");
            xb_add(&bar[XB_XGEN(b.x)], 1u);
            asm volatile("s_waitcnt vmcnt(0)" ::: "memory");
        } else {
            XB_SPIN(xb_ld(&bar[XB_XGEN(b.x)]) == gen, bar);
            __builtin_amdgcn_fence(__ATOMIC_ACQUIRE, "agent");
            asm volatile("s_waitcnt vmcnt(0)" ::: "memory");
        }
    }
    __syncthreads();
}

struct Frame {
    LAS unsigned char* lds;
    int tid, lane, wave, vcu, G;
};
enum { I_XP = 0, I_XS, I_ANG, I_WIN, I_PW, I_PS, I_QNG, I_WUQ, I_KVNG, I_WUKV, I_QHG, I_KHG, I_HCW, I_HCB, I_FW1, I_FB1, I_FFR, I_FW2, I_FB2, I_FW3, I_FB3, I_HBIAS, I_GNG, I_WOUT, I_FNG, I_WUP, I_FCW, I_FCB, I_WDN, N_IN };
struct Args { const float* in[N_IN]; float* out; unsigned char* ws; int ph_lo, ph_hi; };
static_assert(sizeof(Args) == (N_IN + 2) * 8 + 8, "Args has no padding");

__device__ __forceinline__ void cvt_item(const float* __restrict__ W, int ldw, int K, bf16* WT, int dst_n0, int src_n0, int k0, const float* __restrict__ ks, LAS float* scr, int lane) {
#pragma unroll
    for (int i = 0; i < 32; ++i) { const int kk = 2 * i + (lane >> 5); float v = W[(size_t)(k0 + kk) * ldw + src_n0 + (lane & 31)]; if (ks) v *= ks[k0 + kk]; scr[kk * 33 + (lane & 31)] = v; }
    LDS_WAIT(); asm volatile("" ::: "memory");
    const int c = lane & 7;
#pragma unroll
    for (int j = 0; j < 4; ++j) { const int n = (lane >> 3) + 8 * j; const LAS float* s = scr + (8 * c) * 33 + n;
        v4u o; o.x = pk2(s[0 * 33], s[1 * 33]); o.y = pk2(s[2 * 33], s[3 * 33]); o.z = pk2(s[4 * 33], s[5 * 33]); o.w = pk2(s[6 * 33], s[7 * 33]);
        *(v4u*)(WT + (size_t)(dst_n0 + n) * K + k0 + 8 * c) = o; }
    LDS_WAIT(); asm volatile("" ::: "memory");
}
struct CvtTile { const float* W; const float* ks; bf16* WT; int ldw, K, src_n0, k0, ncols; int dst[4]; };
__device__ __forceinline__ void cvt_tile(Frame& F, const CvtTile& d) {
    LAS float* T = (LAS float*)F.lds;
#pragma unroll
    for (int i = 0; i < 8; ++i) { const int q = F.tid + 512 * i, row = q >> 5, c4 = q & 31;
        f32x4 v = {0.f, 0.f, 0.f, 0.f};
        if (d.src_n0 + 4 * c4 < d.ncols) v = *(const f32x4*)(d.W + (size_t)(d.k0 + row) * d.ldw + d.src_n0 + 4 * c4);
        if (d.ks) v *= d.ks[d.k0 + row];
        LAS float* t = T + row * 129 + 4 * c4; t[0] = v.x; t[1] = v.y; t[2] = v.z; t[3] = v.w; }
    __syncthreads();
#pragma unroll
    for (int i = 0; i < 4; ++i) { const int n = (F.tid >> 4) + 32 * i, kc = F.tid & 15;
        if (d.src_n0 + n < d.ncols) { const LAS float* s = T + (8 * kc) * 129 + n;
            v4u o; o.x = pk2(s[0], s[129]); o.y = pk2(s[2 * 129], s[3 * 129]); o.z = pk2(s[4 * 129], s[5 * 129]); o.w = pk2(s[6 * 129], s[7 * 129]);
            *(v4u*)(d.WT + (size_t)(d.dst[i] + (n & 31)) * d.K + d.k0 + 8 * kc) = o; } }
    __syncthreads();
}
__device__ __forceinline__ void absmax_tile(Frame& F, const float* __restrict__ W, const float* __restrict__ ks, int ldw, int src_n0, int k0, unsigned* outc) {
    LAS float* P = (LAS float*)F.lds;
    f32x4 m = {0.f, 0.f, 0.f, 0.f};
#pragma unroll
    for (int i = 0; i < 8; ++i) { const int q = F.tid + 512 * i, row = q >> 5, c4 = q & 31;
        const f32x4 v = *(const f32x4*)(W + (size_t)(k0 + row) * ldw + src_n0 + 4 * c4) * ks[k0 + row];
        m.x = fmaxf(m.x, fabsf(v.x)); m.y = fmaxf(m.y, fabsf(v.y)); m.z = fmaxf(m.z, fabsf(v.z)); m.w = fmaxf(m.w, fabsf(v.w)); }
    *(LAS f32x4*)(P + (F.tid >> 5) * 128 + 4 * (F.tid & 31)) = m;
    __syncthreads();
    if (F.tid < 128) { float c = P[F.tid];
#pragma unroll
        for (int g = 1; g < 16; ++g) c = fmaxf(c, P[g * 128 + F.tid]);
        atomicMax(outc + src_n0 + F.tid, __builtin_bit_cast(unsigned, c)); }
    __syncthreads();
}
__device__ __forceinline__ unsigned q8(float v) { const int q = (int)__builtin_rintf(v); return (unsigned)(q < -127 ? -127 : (q > 127 ? 127 : q)) & 0xffu; }
__device__ __forceinline__ void cvtq_tile(Frame& F, const float* __restrict__ W, const float* __restrict__ ks, int ldw, int K, unsigned char* WT, int src_n0, int k0, int dst0, const unsigned* __restrict__ wmaxc) {
    LAS float* T = (LAS float*)F.lds;
    f32x4 inv4; { const v4u mb = *(const v4u*)(wmaxc + src_n0 + 4 * (F.tid & 31));
        inv4.x = 127.0f / fmaxf(__builtin_bit_cast(float, mb.x), 1e-30f); inv4.y = 127.0f / fmaxf(__builtin_bit_cast(float, mb.y), 1e-30f); inv4.z = 127.0f / fmaxf(__builtin_bit_cast(float, mb.z), 1e-30f); inv4.w = 127.0f / fmaxf(__builtin_bit_cast(float, mb.w), 1e-30f); }
#pragma unroll
    for (int i = 0; i < 8; ++i) { const int q = F.tid + 512 * i, row = q >> 5, c4 = q & 31;
        const f32x4 v = *(const f32x4*)(W + (size_t)(k0 + row) * ldw + src_n0 + 4 * c4) * ks[k0 + row] * inv4;
        LAS float* t = T + row * 129 + 4 * c4; t[0] = v.x; t[1] = v.y; t[2] = v.z; t[3] = v.w; }
    __syncthreads();
#pragma unroll
    for (int i = 0; i < 2; ++i) { const int n = (F.tid >> 3) + 64 * i, kc = F.tid & 7;
        const LAS float* s = T + (16 * kc) * 129 + n; unsigned w[4];
#pragma unroll
        for (int j = 0; j < 4; ++j) w[j] = q8(s[(4 * j) * 129]) | (q8(s[(4 * j + 1) * 129]) << 8) | (q8(s[(4 * j + 2) * 129]) << 16) | (q8(s[(4 * j + 3) * 129]) << 24);
        v4u o; o.x = w[0]; o.y = w[1]; o.z = w[2]; o.w = w[3];
        *(v4u*)(WT + (size_t)(dst0 + 64 * (n >> 5) + (n & 31)) * K + k0 + 16 * kc) = o; }
    __syncthreads();
}
__device__ __forceinline__ void xq_row(const bf16* __restrict__ xrow, unsigned char* qrow, const float* __restrict__ ssq32, float* rowf, float s_w, int lane) {
    v4u v[4]; float m = 0.f;
#pragma unroll
    for (int j = 0; j < 4; ++j) { v[j] = *(const v4u*)(xrow + 8 * (lane + 64 * j)); const unsigned w[4] = {v[j].x, v[j].y, v[j].z, v[j].w};
#pragma unroll
        for (int i = 0; i < 4; ++i) m = fmaxf(m, fmaxf(fabsf(bflo(w[i])), fabsf(bfhi(w[i])))); }
    float ss = (lane < 32) ? ssq32[lane] : 0.f;
#pragma unroll
    for (int o = 1; o < 64; o <<= 1) { m = fmaxf(m, __shfl_xor(m, o)); ss += __shfl_xor(ss, o); }
    m = fmaxf(m, 1e-30f); const float inv = 127.0f / m;
    if (lane == 0) *rowf = (1.0f / sqrtf(ss * (1.f / DM) + EPS)) * (m * (1.0f / 127.0f)) * s_w;
#pragma unroll
    for (int j = 0; j < 4; ++j) { const unsigned w[4] = {v[j].x, v[j].y, v[j].z, v[j].w}; v2u o;
        o.x = q8(bflo(w[0]) * inv) | (q8(bfhi(w[0]) * inv) << 8) | (q8(bflo(w[1]) * inv) << 16) | (q8(bfhi(w[1]) * inv) << 24);
        o.y = q8(bflo(w[2]) * inv) | (q8(bfhi(w[2]) * inv) << 8) | (q8(bflo(w[3]) * inv) << 16) | (q8(bfhi(w[3]) * inv) << 24);
        *(v2u*)(qrow + 8 * (lane + 64 * j)) = o; }
}
__device__ __forceinline__ void xb_row(const float* xrow, bf16* orow, float* rstd, int lane) {
    const f32x4* xr = (const f32x4*)xrow + lane;
    f32x4 v[8]; float s = 0.f;
#pragma unroll
    for (int j = 0; j < 8; ++j) { v[j] = xr[64 * j]; s += (v[j].x * v[j].x + v[j].y * v[j].y) + (v[j].z * v[j].z + v[j].w * v[j].w); }
    const float r = 1.0f / sqrtf(wave_sum(s) * (1.f / DM) + EPS);
    if (lane == 0) *rstd = r;
    v2u* o8 = (v2u*)orow + lane;
#pragma unroll
    for (int j = 0; j < 8; ++j) { v2u w; w.x = pk2(v[j].x, v[j].y); w.y = pk2(v[j].z, v[j].w); o8[64 * j] = w; }
}
__device__ __forceinline__ void rstd_from_partials(const float* __restrict__ ssqp, float* rstd, size_t gtid, size_t gthreads) {
    for (size_t r = gtid; r < (size_t)M; r += gthreads) { const f32x4* p = (const f32x4*)(ssqp + r * 32); f32x4 a = p[0];
#pragma unroll
        for (int i = 1; i < 8; ++i) a += p[i];
        rstd[r] = 1.0f / sqrtf(((a.x + a.y) + (a.z + a.w)) * (1.f / DM) + EPS); }
}
__device__ __forceinline__ void tile_norm_store(LAS float* tile, bf16* dst, int row0, int col_off, int wave, int lane) {
#pragma unroll
    for (int i = 0; i < 8; ++i) { const int t = wave * 8 + i;
        const f32x4 a = *(LAS f32x4*)(tile + t * 512 + 8 * lane), b = *(LAS f32x4*)(tile + t * 512 + 8 * lane + 4);
        const float s = (a.x * a.x + a.y * a.y) + (a.z * a.z + a.w * a.w) + (b.x * b.x + b.y * b.y) + (b.z * b.z + b.w * b.w);
        const float rstd = 1.0f / sqrtf(wave_sum(s) * (1.f / 512.f) + EPS);
        v4u o; o.x = pk2(a.x * rstd, a.y * rstd); o.y = pk2(a.z * rstd, a.w * rstd); o.z = pk2(b.x * rstd, b.y * rstd); o.w = pk2(b.z * rstd, b.w * rstd);
        *(v4u*)(dst + (size_t)(row0 + t) * DM + col_off + 8 * lane) = o; }
}
__device__ __forceinline__ void poolfold_item(Frame& F, const float* __restrict__ win, const float* __restrict__ pw, const float* __restrict__ ps, const float* __restrict__ g1, bf16* BtIn, int g, int kb) {
    LAS float* At = (LAS float*)F.lds; LAS float* Bt = (LAS float*)(F.lds + 32768);
    const int k0 = 64 * kb;
#pragma unroll
    for (int i = 0; i < 4; ++i) { const int q = F.tid + 512 * i, row = q >> 5, c4 = q & 31; *(LAS f32x4*)(At + row * 128 + 4 * c4) = *(const f32x4*)(win + (size_t)(k0 + row) * DIN + 128 * g + 4 * c4) * g1[k0 + row]; }
#pragma unroll
    for (int i = 0; i < 8; ++i) { const int q = F.tid + 512 * i, row = q >> 5, c4 = q & 31; *(LAS f32x4*)(Bt + row * 128 + 4 * c4) = *(const f32x4*)(pw + (size_t)(g * 128 + row) * 128 + 4 * c4); }
    __syncthreads();
    const int n = F.tid & 127, kg = F.tid >> 7;
    float acc[16];
#pragma unroll
    for (int i = 0; i < 16; ++i) acc[i] = 0.f;
    for (int j = 0; j < 128; j += 4) {
        const float b0 = Bt[(j + 0) * 128 + n], b1 = Bt[(j + 1) * 128 + n], b2 = Bt[(j + 2) * 128 + n], b3 = Bt[(j + 3) * 128 + n];
#pragma unroll
        for (int i = 0; i < 16; ++i) { const f32x4 a = *(LAS f32x4*)(At + (kg * 16 + i) * 128 + j); acc[i] += a.x * b0 + a.y * b1 + a.z * b2 + a.w * b3; }
    }
    const float sc = ps[128 * g + n];
    v4u o0, o1;
    o0.x = pk2(acc[0] * sc, acc[1] * sc); o0.y = pk2(acc[2] * sc, acc[3] * sc); o0.z = pk2(acc[4] * sc, acc[5] * sc); o0.w = pk2(acc[6] * sc, acc[7] * sc);
    o1.x = pk2(acc[8] * sc, acc[9] * sc); o1.y = pk2(acc[10] * sc, acc[11] * sc); o1.z = pk2(acc[12] * sc, acc[13] * sc); o1.w = pk2(acc[14] * sc, acc[15] * sc);
    bf16* dst = BtIn + (size_t)(128 * g + n) * DM + k0 + kg * 16;
    *(v4u*)dst = o0; *(v4u*)(dst + 8) = o1;
    __syncthreads();
}
__device__ __forceinline__ void filter_item(Frame& F, const float* __restrict__ w1, const float* __restrict__ b1, const float* __restrict__ fr, const float* __restrict__ w2, const float* __restrict__ b2,
                                            const float* __restrict__ w3, const float* __restrict__ b3, const float* __restrict__ hbias, bf16* RF, int fi) {
    LAS float* ZF = (LAS float*)F.lds; LAS float* H1 = ZF + 512; LAS float* H2 = ZF + 1536; LAS float* W1s = ZF + 2560; LAS float* W2s = ZF + 3712;
    const int t0 = 16 * fi;
    for (int q = F.tid; q < 272; q += 512) *(LAS f32x4*)(W1s + 4 * q) = *(const f32x4*)(w1 + 4 * q);
#pragma unroll
    for (int i = 0; i < 2; ++i) { const int q = F.tid + 512 * i; *(LAS f32x4*)(W2s + 4 * q) = *(const f32x4*)(w2 + 4 * q); }
    if (F.tid < 272) { const int tt = F.tid / 17, f = F.tid % 17; const float t = (float)(t0 + tt);
        float v;
        if (f == 0) v = t / 2047.0f;
        else { const int j = (f - 1) & 7; const float band = 1e-4f + (float)j * ((7.0f - 1e-4f) / 7.0f); const float w = (6.283185307179586f * t) / 2048.0f; const float a = band * w; v = (f <= 8) ? __cosf(a) : -__sinf(a); }
        ZF[tt * 17 + f] = v; }
    __syncthreads();
#pragma unroll
    for (int rep = 0; rep < 2; ++rep) { const int p = F.tid + 512 * rep, tt = p >> 6, j = p & 63; float s = b1[j];
#pragma unroll
        for (int i = 0; i < 17; ++i) s += ZF[tt * 17 + i] * W1s[i * 64 + j];
        H1[tt * 64 + j] = __sinf(fr[j] * s); }
    __syncthreads();
#pragma unroll
    for (int rep = 0; rep < 2; ++rep) { const int p = F.tid + 512 * rep, tt = p >> 6, j = p & 63; float s = b2[j];
#pragma unroll 16
        for (int i = 0; i < 64; ++i) s += H1[tt * 64 + i] * W2s[i * 64 + j];
        H2[tt * 64 + j] = __sinf(fr[j] * s); }
    __syncthreads();
    const int c = F.tid;
    const float delta = -3.0701134573253944f + (float)c * ((-15.350567286626972f + 3.0701134573253944f) / 511.0f);
    const float ad = fabsf(delta);
    bf16* rf = RF + (size_t)c * hy::RFS;
#pragma unroll 1
    for (int dir = 0; dir < 2; ++dir) { const int o = dir * 512 + c; const float bo = b3[o];
        float wc[64];
#pragma unroll
        for (int i = 0; i < 64; ++i) wc[i] = w3[i * 1024 + o];
#pragma unroll 1
        for (int tt = 0; tt < 16; ++tt) { float s = bo;
#pragma unroll
            for (int i = 0; i < 64; i += 4) { const f32x4 hv = *(LAS f32x4*)(H2 + tt * 64 + i); s += (hv.x * wc[i] + hv.y * wc[i + 1]) + (hv.z * wc[i + 2] + hv.w * wc[i + 3]); }
            const int t = t0 + tt; const float tl = (float)t / 2047.0f; float val = s * __expf(-tl * ad);
            if (dir == 0) { if (t == 0) val += hbias[c]; rf[2048 - t] = (bf16)f2bf(val); }
            else if (t >= 1) rf[2048 + t] = (bf16)f2bf(val); } }
    if (fi == 0) { rf[0] = 0;
#pragma unroll
        for (int i = 4096; i < hy::RFS; ++i) rf[i] = 0; }
    __syncthreads();
}
__device__ __forceinline__ void unpack4(const v2u w, float (&x)[4]) { x[0] = bflo(w.x); x[1] = bfhi(w.x); x[2] = bflo(w.y); x[3] = bfhi(w.y); }
__device__ __forceinline__ void pair_norm_store(Frame& F, const float (&y)[8][4], bf16* dst, size_t row0, int col_off, int cq) {
    LAS float* part = (LAS float*)F.lds;
    float ss[8];
#pragma unroll
    for (int k = 0; k < 8; ++k) ss[k] = wave_sum((y[k][0] * y[k][0] + y[k][1] * y[k][1]) + (y[k][2] * y[k][2] + y[k][3] * y[k][3]));
    if (F.lane == 0) { *(LAS f32x4*)(part + F.wave * 8) = (f32x4){ss[0], ss[1], ss[2], ss[3]}; *(LAS f32x4*)(part + F.wave * 8 + 4) = (f32x4){ss[4], ss[5], ss[6], ss[7]}; }
    __syncthreads();
    const f32x4 pa = *(LAS f32x4*)(part + (F.wave ^ 1) * 8), pb = *(LAS f32x4*)(part + (F.wave ^ 1) * 8 + 4);
    const float po[8] = {pa.x, pa.y, pa.z, pa.w, pb.x, pb.y, pb.z, pb.w};
#pragma unroll
    for (int k = 0; k < 8; ++k) { const float rstd = 1.0f / sqrtf((ss[k] + po[k]) * (1.f / 512.f) + EPS);
        v2u o; o.x = pk2(y[k][0] * rstd, y[k][1] * rstd); o.y = pk2(y[k][2] * rstd, y[k][3] * rstd);
        *(v2u*)(dst + (row0 + k) * DM + col_off + 4 * cq) = o; }
    __syncthreads();
}
__device__ __forceinline__ void hyprep_item(Frame& F, const bf16* __restrict__ PROJ, const float* __restrict__ cw, const float* __restrict__ cb, bf16* ZT, bf16* X0, int b, int tile) {
    const int tb = F.tid >> 7, cq = F.tid & 127, c0 = 4 * cq, tw = tile * 32 + tb * 8; const size_t rb = (size_t)b * SEQ;
    float z[8][4];
    v2u rh[3][10];
#pragma unroll
    for (int j = 0; j < 3; ++j)
#pragma unroll
        for (int o = 0; o < 10; ++o) { const int t = tw - 1 + o; const int tc = ((t >= 0) && (t < SEQ)) ? t : tw; rh[j][o] = *(const v2u*)(PROJ + (rb + tc) * DINP + O_HY + 512 * j + c0); }
#pragma unroll
    for (int jj = 0; jj < 3; ++jj) { const int j = (jj == 0) ? 1 : (jj == 1) ? 2 : 0; const int cc = 512 * j + c0;
        const f32x4 w0 = *(const f32x4*)(cw + cc), w1 = *(const f32x4*)(cw + 1536 + cc), w2 = *(const f32x4*)(cw + 3072 + cc), bs = *(const f32x4*)(cb + cc);
        float x[10][4];
#pragma unroll
        for (int o = 0; o < 10; ++o) { const int t = tw - 1 + o; const bool ok = (t >= 0) && (t < SEQ); unpack4(rh[j][o], x[o]);
            if (!ok) { x[o][0] = 0.f; x[o][1] = 0.f; x[o][2] = 0.f; x[o][3] = 0.f; } }
        if (jj == 0) {
#pragma unroll
            for (int k = 0; k < 8; ++k)
#pragma unroll
                for (int i = 0; i < 4; ++i) z[k][i] = w0[i] * x[k][i] + w1[i] * x[k + 1][i] + w2[i] * x[k + 2][i] + bs[i];
        } else if (jj == 1) {
#pragma unroll
            for (int k = 0; k < 8; ++k)
#pragma unroll
                for (int i = 0; i < 4; ++i) z[k][i] *= w0[i] * x[k][i] + w1[i] * x[k + 1][i] + w2[i] * x[k + 2][i] + bs[i];
#pragma unroll
            for (int i = 0; i < 4; ++i) { v4u o; o.x = pk2(z[0][i], z[1][i]); o.y = pk2(z[2][i], z[3][i]); o.z = pk2(z[4][i], z[5][i]); o.w = pk2(z[6][i], z[7][i]);
                *(v4u*)(ZT + ((size_t)(c0 + i) * NSEQ + b) * SEQ + tw) = o; }
        } else {
#pragma unroll
            for (int k = 0; k < 8; ++k) { float u0[4];
#pragma unroll
                for (int i = 0; i < 4; ++i) u0[i] = w0[i] * x[k][i] + w1[i] * x[k + 1][i] + w2[i] * x[k + 2][i] + bs[i];
                v2u o; o.x = pk2(u0[0], u0[1]); o.y = pk2(u0[2], u0[3]); *(v2u*)(X0 + (rb + tw + k) * HYC + c0) = o; }
        }
    }
}
__device__ __forceinline__ void pool_item(Frame& F, const bf16* __restrict__ PROJ, bf16* MIXED, int b, int tile) {
    const int tb = F.tid >> 7, cq = F.tid & 127, c0 = 4 * cq, g = cq >> 5, half = 1 << g, tw = tile * 32 + tb * 8; const size_t rb = (size_t)b * SEQ;
    float x[23][4];
#pragma unroll
    for (int o = 0; o < 23; ++o) { const int t = tw - 8 + o; const bool ok = (t >= 0) && (t < SEQ); const int tc = ok ? t : tw;
        const v2u w = *(const v2u*)(PROJ + (rb + tc) * DINP + c0); unpack4(w, x[o]);
        if (!ok) { x[o][0] = 0.f; x[o][1] = 0.f; x[o][2] = 0.f; x[o][3] = 0.f; } }
    float y[8][4];
#pragma unroll
    for (int k = 0; k < 8; ++k) { const int oc = 8 + k, t = tw + k; const int lo = (t - half > 0) ? t - half : 0, hi = (t + half < SEQ) ? t + half : SEQ; const float inv = 1.0f / (float)(hi - lo);
#pragma unroll
        for (int i = 0; i < 4; ++i) {
            const float w1 = x[oc - 1][i] + x[oc][i];
            const float w2 = w1 + (x[oc - 2][i] + x[oc + 1][i]);
            const float w4 = w2 + ((x[oc - 4][i] + x[oc - 3][i]) + (x[oc + 2][i] + x[oc + 3][i]));
            const float w8 = w4 + (((x[oc - 8][i] + x[oc - 7][i]) + (x[oc - 6][i] + x[oc - 5][i])) + ((x[oc + 4][i] + x[oc + 5][i]) + (x[oc + 6][i] + x[oc + 7][i])));
            const float S = (g == 0) ? w1 : (g == 1) ? w2 : (g == 2) ? w4 : w8;
            y[k][i] = S * inv - x[oc][i]; } }
    pair_norm_store(F, y, MIXED, rb + tw, 0, cq);
}
__device__ __forceinline__ void hyfin_item(Frame& F, const bf16* __restrict__ YC, const bf16* __restrict__ X0, bf16* MIXED, int b, int tile) {
    const int tb = F.tid >> 7, cq = F.tid & 127, c0 = 4 * cq, tw = tile * 32 + tb * 8; const size_t rb = (size_t)b * SEQ;
    float yc[4][8], y[8][4];
#pragma unroll
    for (int i = 0; i < 4; ++i) { const v4u v = *(const v4u*)(YC + ((size_t)(c0 + i) * NSEQ + b) * SEQ + tw);
        yc[i][0] = bflo(v.x); yc[i][1] = bfhi(v.x); yc[i][2] = bflo(v.y); yc[i][3] = bfhi(v.y); yc[i][4] = bflo(v.z); yc[i][5] = bfhi(v.z); yc[i][6] = bflo(v.w); yc[i][7] = bfhi(v.w); }
#pragma unroll
    for (int k = 0; k < 8; ++k) { float xv[4]; unpack4(*(const v2u*)(X0 + (rb + tw + k) * HYC + c0), xv);
#pragma unroll
        for (int i = 0; i < 4; ++i) y[k][i] = yc[i][k] * xv[i]; }
    pair_norm_store(F, y, MIXED, rb + tw, 1536, cq);
}
struct PrepGains { float q[3][8], k[3][8]; };
__device__ __forceinline__ void load8(const float* p, float (&o)[8]) { const f32x4 a = *(const f32x4*)p, b = *(const f32x4*)(p + 4); o[0] = a.x; o[1] = a.y; o[2] = a.z; o[3] = a.w; o[4] = b.x; o[5] = b.y; o[6] = b.z; o[7] = b.w; }
__device__ __forceinline__ void unpack8(const v4u w, float (&x)[8]) { x[0] = bflo(w.x); x[1] = bfhi(w.x); x[2] = bflo(w.y); x[3] = bfhi(w.y); x[4] = bflo(w.z); x[5] = bfhi(w.z); x[6] = bflo(w.w); x[7] = bfhi(w.w); }
__device__ __forceinline__ v4u pack8(const float (&x)[8]) { v4u o; o.x = pk2(x[0], x[1]); o.y = pk2(x[2], x[3]); o.z = pk2(x[4], x[5]); o.w = pk2(x[6], x[7]); return o; }
__device__ __forceinline__ float ssq8(const float (&x)[8]) { return ((x[0] * x[0] + x[1] * x[1]) + (x[2] * x[2] + x[3] * x[3])) + ((x[4] * x[4] + x[5] * x[5]) + (x[6] * x[6] + x[7] * x[7])); }
__device__ __forceinline__ float sum8lanes(float v) { v += __shfl_xor(v, 1); v += __shfl_xor(v, 2); v += __shfl_xor(v, 4); return v; }
__device__ __forceinline__ void prep_row(const bf16* __restrict__ PROJ, bf16* Q, bf16* KV, const PrepGains& G, const float* __restrict__ ROPE, int m, int lane) {
    const int h = lane >> 3, sub = lane & 7;
    const bf16* pr = PROJ + (size_t)m * DINP; bf16* qr = Q + (size_t)m * NQ + 192 * h + 8 * sub; bf16* kr = KV + (size_t)m * NKVP + KVHS * h + 8 * sub;
    const v4u pev = *(const v4u*)(pr + O_KPE + 8 * sub);
    const v4u k0 = *(const v4u*)(kr), k1 = *(const v4u*)(kr + 64);
    float cs[8], sn[8]; { const float* rp = ROPE + (size_t)(m & (SEQ - 1)) * 64 + 8 * (sub & 3); load8(rp, cs); load8(rp + 32, sn); }
    const float sg = (sub < 4) ? -1.f : 1.f;
    { float a0[8], a1[8], pe[8]; unpack8(k0, a0); unpack8(k1, a1); unpack8(pev, pe);
      const float ss = sum8lanes((ssq8(a0) + ssq8(a1)) + ssq8(pe));
      const float sk = 1.0f / sqrtf(ss * (1.f / 192.f) + EPS);
      float r[8], o[8];
#pragma unroll
      for (int i = 0; i < 8; ++i) { a0[i] *= sk * G.k[0][i]; a1[i] *= sk * G.k[1][i]; r[i] = pe[i] * sk * G.k[2][i]; }
#pragma unroll
      for (int i = 0; i < 8; ++i) { const float rp = __shfl_xor(r[i], 4); o[i] = r[i] * cs[i] + sg * rp * sn[i]; }
      *(v4u*)(kr) = pack8(a0); *(v4u*)(kr + 64) = pack8(a1); *(v4u*)(kr + 128) = pack8(o); }
}
__device__ __forceinline__ void attn_norm_row(bf16* MIXED, int m, int lane) {
    v4u* p = (v4u*)(MIXED + (size_t)m * DM + 512 + 16 * lane); v4u a = p[0], b = p[1];
    unsigned w[8] = {a.x, a.y, a.z, a.w, b.x, b.y, b.z, b.w}; float s = 0.f;
#pragma unroll
    for (int i = 0; i < 8; ++i) { const float x = bflo(w[i]), y = bfhi(w[i]); s += x * x + y * y; }
    const float rstd = 1.0f / sqrtf(wave_sum(s) * (1.f / 1024.f) + EPS);
#pragma unroll
    for (int i = 0; i < 8; ++i) w[i] = pk2(bflo(w[i]) * rstd, bfhi(w[i]) * rstd);
    a.x = w[0]; a.y = w[1]; a.z = w[2]; a.w = w[3]; b.x = w[4]; b.y = w[5]; b.z = w[6]; b.w = w[7]; p[0] = a; p[1] = b;
}

#define DEFPTRS() unsigned char* ws = args.ws; \
    bf16* BtIn = (bf16*)(ws + WS_BTIN); bf16* BtUq = (bf16*)(ws + WS_BTUQ); bf16* BtKv = (bf16*)(ws + WS_BTKV); bf16* BtOut = (bf16*)(ws + WS_BTOUT); bf16* BtUp = (bf16*)(ws + WS_BTUP); bf16* BtDn = (bf16*)(ws + WS_BTDN); \
    bf16* RF = (bf16*)(ws + WS_RF); bf16* Hb = (bf16*)(ws + WS_H); bf16* PROJ = (bf16*)(ws + WS_PROJ); bf16* Qb = (bf16*)(ws + WS_Q); bf16* KVb = (bf16*)(ws + WS_KV); \
    bf16* ZT = (bf16*)(ws + WS_ZT); bf16* X0 = (bf16*)(ws + WS_X0); bf16* YC = (bf16*)(ws + WS_YC); float* EDGE = (float*)(ws + WS_EDGE); float* ROPE = (float*)(ws + WS_ROPE); float* SSQP = (float*)(ws + WS_SSQP); float* RSTD = (float*)(ws + WS_RSTD); bf16* XB2 = (bf16*)(ws + WS_XB2); unsigned char* XQ = (unsigned char*)(ws + WS_XQ); float* SSQCQ = (float*)(ws + WS_SSQCQ); unsigned char* BtUpQ = (unsigned char*)(ws + WS_BTUP); bf16* ACT = (bf16*)(ws + WS_ACT); \
    bf16* XA = (bf16*)args.out; \
    (void)BtIn; (void)BtUq; (void)BtKv; (void)BtOut; (void)BtUp; (void)BtDn; (void)RF; (void)Hb; (void)PROJ; (void)Qb; (void)KVb; (void)ZT; (void)X0; (void)YC; (void)EDGE; (void)ROPE; (void)SSQP; (void)RSTD; (void)XB2; (void)XQ; (void)SSQCQ; (void)BtUpQ; (void)ACT; (void)XA
__global__ void __launch_bounds__(NWAVES * 64, 2) fwd(Args args) {
    extern __shared__ __attribute__((aligned(16))) unsigned char lds_raw[];
    Frame F;
    F.lds = (LAS unsigned char*)lds_raw;
    F.tid = threadIdx.x; F.lane = F.tid & 63; F.wave = __builtin_amdgcn_readfirstlane(F.tid >> 6);
    F.G = gridDim.x; { const int bx = blockIdx.x; F.vcu = (F.G % 8 == 0) ? (bx % 8) * (F.G / 8) + bx / 8 : bx; }
    volatile LAS unsigned* MISC = (volatile LAS unsigned*)(F.lds + MISC_OFF);
    if (F.tid < 64) MISC[F.tid] = 0u;
    __syncthreads();
    unsigned* ctl = (unsigned*)(args.ws + WS_CTL);
    const int lo = args.ph_lo, hi = args.ph_hi;
    XcdBarrier bar; bar.bar = ctl + CW_BAR; bar.x = 0; bar.st = MISC + 8;
    if (hi - lo > 1) bar = xcd_barrier_post(ctl + CW_BAR, MISC + 8);
    float* out = args.out;

#pragma unroll 1
    for (int layer = 0; layer < DEPTH; ++layer) {
        const int pb = layer * NPH;
        if (pb + NPH <= lo || pb >= hi) continue;
#define IN(k) (lo <= pb + (k) && pb + (k) < hi)
#define ENTER() DEFPTRS(); F.tid = opq(threadIdx.x); F.lane = F.tid & 63; F.wave = __builtin_amdgcn_readfirstlane(F.tid >> 6); const int gw = F.vcu * NWAVES + F.wave, NGW = F.G * NWAVES, wg = F.vcu; const size_t gtid = (size_t)wg * 512 + F.tid, gthreads = (size_t)F.G * 512; (void)gw; (void)NGW; (void)wg; (void)gtid; (void)gthreads
#define SEAM(k) do { if (pb + (k) + 1 < hi) xcd_barrier(bar); } while (0)

        if (IN(0)) { ENTER();
            const float* win = args.in[I_WIN] + (size_t)layer * DM * DIN; const float* g1 = args.in[I_ANG] + layer * DM;
            for (int it = wg; it < 256; it += F.G) {
                if (it < 128) poolfold_item(F, win, args.in[I_PW] + (size_t)layer * 4 * 128 * 128, args.in[I_PS] + (size_t)layer * 512, g1, BtIn, it >> 5, it & 31);
                else filter_item(F, args.in[I_FW1] + (size_t)layer * 17 * 64, args.in[I_FB1] + layer * 64, args.in[I_FFR] + layer * 64, args.in[I_FW2] + (size_t)layer * 64 * 64, args.in[I_FB2] + layer * 64,
                                 args.in[I_FW3] + (size_t)layer * 64 * 1024, args.in[I_FB3] + layer * 1024, args.in[I_HBIAS] + layer * 512, RF, it - 128);
            }
            constexpr int T_IN = 19 * 16, T_UQ = 12 * 4, T_KV = 16 * 2, T_OUT = 16 * 16, T_UP = 88 * 16, T_DN = 16 * 44, T_ALL = T_IN + T_UQ + T_KV + T_OUT + T_UP + T_DN;
            for (int it = wg; it < T_ALL; it += F.G) {
                int r = it; CvtTile d;
                if (r < T_IN) { const int nt = r >> 4, kt = r & 15, n0 = 512 + 128 * nt; d = CvtTile{win, g1, BtIn, DIN, DM, n0, 128 * kt, DIN, {n0, n0 + 32, n0 + 64, n0 + 96}}; }
                else if ((r -= T_IN) < T_UQ) { const int nt = r >> 2, kt = r & 3, n0 = 128 * nt; d = CvtTile{args.in[I_WUQ] + (size_t)layer * 512 * NQ, args.in[I_QNG] + layer * 512, BtUq, NQ, 512, n0, 128 * kt, NQ, {n0, n0 + 32, n0 + 64, n0 + 96}}; }
                else if ((r -= T_UQ) < T_KV) { const int nt = r >> 1, kt = r & 1, n0 = 128 * nt;
                    d = CvtTile{args.in[I_WUKV] + (size_t)layer * 256 * 2048, args.in[I_KVNG] + layer * 256, BtKv, 2048, 256, n0, 128 * kt, 2048, {n0, n0 + 32, n0 + 64, n0 + 96}}; }
                else if ((r -= T_KV) < T_OUT) { const int nt = r >> 4, kt = r & 15, n0 = 128 * nt; d = CvtTile{args.in[I_WOUT] + (size_t)layer * DM * DM, args.in[I_GNG] + layer * DM, BtOut, DM, DM, n0, 128 * kt, DM, {n0, n0 + 32, n0 + 64, n0 + 96}}; }
                else if ((r -= T_OUT) < T_UP) { const int nt = r >> 4, kt = r & 15;
                    absmax_tile(F, args.in[I_WUP] + (size_t)layer * DM * NUP, args.in[I_FNG] + layer * DM, NUP, 128 * nt, 128 * kt, ctl + CW_WMAXC + layer * NUP); continue; }
                else { r -= T_UP; const int nt = r / 44, kt = r % 44, n0 = 128 * nt; d = CvtTile{args.in[I_WDN] + (size_t)layer * DFF * DM, nullptr, BtDn, DM, DFF, n0, 128 * kt, DM, {n0, n0 + 32, n0 + 64, n0 + 96}}; }
                cvt_tile(F, d);
            }
            { unsigned zz = 0u; asm volatile("" : "+v"(zz)); v4u z = {zz, zz, zz, zz};
              for (size_t i = gtid; i < (size_t)(DINP - DIN) * DM / 8; i += gthreads) *(v4u*)(BtIn + (size_t)DIN * DM + i * 8) = z;
}
            if (layer == 0) for (size_t i = gtid; i < (size_t)SEQ * 32; i += gthreads) { const int pos = (int)(i >> 5), ri = (int)(i & 31);
                const float freq = exp2f(-(float)ri * (13.287712379549449f / 32.0f)); float sn, cs; sincosf((float)pos * freq, &sn, &cs); ROPE[pos * 64 + ri] = cs; ROPE[pos * 64 + 32 + ri] = sn; }
            if (layer == 0) { for (int m = gw; m < M; m += NGW) xb_row(m < MP ? args.in[I_XP] + (size_t)m * DM : args.in[I_XS] + (size_t)(m - MP) * DM, XA + (size_t)m * DM, RSTD + m, F.lane); }
            else rstd_from_partials(SSQP, RSTD, gtid, gthreads);
            SEAM(0);
        }
        if (IN(1)) { ENTER();
            pg8::Gemm g{XA, BtIn, M, DINP, DM, DM}; pg8::StaticOrder S; S.init(M, DINP, F.G, (int)blockIdx.x);
            pg8::EpiBf16 E{PROJ, DINP, RSTD, 0, O_CKV / 256, (LAS float*)(F.lds + HALO_OFF), EPS, SSQCQ, O_CQ / 256};
            pg8::gemm_phase<pg8::EpiBf16, pg8::StaticOrder>(F.lds, g, S, E);
            SEAM(1);
        }
        if (IN(2)) { ENTER();
            { pg8::Gemm g{PROJ + O_CQ, BtUq, M, NQ, 512, DINP}; pg8::StaticOrder S; S.init(M, NQ, F.G, (int)blockIdx.x); pg8::EpiBf16 E{Qb, NQ, nullptr, 0, -1, nullptr, 0.f, nullptr, 0};
              pg8::gemm_phase<pg8::EpiBf16, pg8::StaticOrder>(F.lds, g, S, E); }
            { pg8::Gemm g{PROJ + O_CKV, BtKv, M, 2048, 256, DINP}; pg8::StaticOrder S; S.init(M, 2048, F.G, (int)blockIdx.x); pg8::EpiBf16 E{KVb, NKVP, nullptr, 1, -1, nullptr, 0.f, nullptr, 0};
              pg8::gemm_phase<pg8::EpiBf16, pg8::StaticOrder>(F.lds, g, S, E); }
            const float* hcw = args.in[I_HCW] + (size_t)layer * 3 * 1536; const float* hcb = args.in[I_HCB] + layer * 1536;
            for (int it = wg; it < 2 * NSEQ * 64; it += F.G) {
                if (it < NSEQ * 64) hyprep_item(F, PROJ, hcw, hcb, ZT, X0, it >> 6, it & 63);
                else pool_item(F, PROJ, Hb, (it - NSEQ * 64) >> 6, it & 63);
            }
            SEAM(2);
        }
        if (IN(3)) { ENTER();
            const int odd = __builtin_amdgcn_readfirstlane(opq((int)(blockIdx.x >> 3) & 1));
            const float* qhg = args.in[I_QHG] + layer * 192; const float* khg = args.in[I_KHG] + layer * 192;
            if (!odd) { for (int u = wg; u < 2 * HYC; u += F.G) hy::conv_unit(F.lds, ZT, RF, YC, u >> 1, u & 1); }
            { PrepGains PG; { const int sub = F.lane & 7;
#pragma unroll
                for (int i = 0; i < 3; ++i) { load8(qhg + 64 * i + 8 * sub, PG.q[i]); load8(khg + 64 * i + 8 * sub, PG.k[i]); } }
              for (int m = gw; m < M; m += NGW) prep_row(PROJ, Qb, KVb, PG, ROPE, m, F.lane); }
            if (odd) { __syncthreads(); for (int u = wg; u < 2 * HYC; u += F.G) hy::conv_unit(F.lds, ZT, RF, YC, u >> 1, u & 1); }
            SEAM(3);
        }
        if (IN(4)) { ENTER();
            float gqm, gkm; { const float* qhg = args.in[I_QHG] + layer * 192; const float* khg = args.in[I_KHG] + layer * 192;
                gqm = fmaxf(fmaxf(fabsf(qhg[F.lane]), fabsf(qhg[64 + F.lane])), fabsf(qhg[128 + F.lane])); gkm = fmaxf(fmaxf(fabsf(khg[F.lane]), fabsf(khg[64 + F.lane])), fabsf(khg[128 + F.lane]));
#pragma unroll
                for (int o = 1; o < 64; o <<= 1) { gqm = fmaxf(gqm, __shfl_xor(gqm, o)); gkm = fmaxf(gkm, __shfl_xor(gkm, o)); } }
            const float Mnat = 13.856406460551018f * gqm * gkm;
            const bool sm_fast = __builtin_amdgcn_readfirstlane((Mnat <= 40.0f) ? 1 : 0) != 0;
            const float negMC = __builtin_bit_cast(float, __builtin_amdgcn_readfirstlane(__builtin_bit_cast(int, -Mnat * 1.4426950408889634f)));
            for (int i = 0; i * F.G < NSEQ * NH * 8; ++i) {
                int p, qb; const int c = (int)blockIdx.x;
                if (F.G == 256) { p = i * 32 + (c & 7) * 4 + (c >> 6); qb = (c >> 3) & 7; } else { const int Lq = i * F.G + c; p = Lq >> 3; qb = Lq & 7; }
                if (p < NSEQ * NH) { const int b = p >> 3, h = p & 7;
                    const bf16* qp = Qb + (size_t)(b * SEQ + qb * 256) * NQ + h * 192; const bf16* kp = KVb + (size_t)(b * SEQ) * NKVP + h * KVHS; bf16* op = Hb + (size_t)(b * SEQ + qb * 256) * DM + 512 + h * 128;
                    const float* sq = SSQCQ + (size_t)(b * SEQ + qb * 256) * 8; const float* qgp = args.in[I_QHG] + layer * 192; const float* rp0 = ROPE + (size_t)(qb * 256) * 64;
                    if (sm_fast) at::attn_unit<true>(negMC, qp, kp, kp + 192, op, SEQ, (char*)lds_raw, sq, qgp, rp0);
                    else at::attn_unit<false>(0.f, qp, kp, kp + 192, op, SEQ, (char*)lds_raw, sq, qgp, rp0); }
            }
            for (int it = wg; it < NSEQ * 64; it += F.G) hyfin_item(F, YC, X0, Hb, it >> 6, it & 63);
            SEAM(4);
        }
        if (IN(5)) { ENTER();
            for (int m = gw; m < M; m += NGW) attn_norm_row(Hb, m, F.lane);
            SEAM(5);
        }
        if (IN(6)) { ENTER();
            pg8::Gemm g{Hb, BtOut, M, DM, DM, DM}; pg8::StaticOrder S; S.init(M, DM, F.G, (int)blockIdx.x);
            pg8::EpiResid16 E{XA, XB2, out, DM, SSQP, 0};
            pg8::gemm_phase<pg8::EpiResid16, pg8::StaticOrder>(F.lds, g, S, E);
            SEAM(6);
        }
        if (IN(7)) { ENTER();
            const unsigned* wmaxc = ctl + CW_WMAXC + layer * NUP;
            for (int it = wg; it < 88 * 16; it += F.G) { const int nt = it >> 4, kt = it & 15; const int nv = (nt < 44) ? nt : nt - 44;
                cvtq_tile(F, args.in[I_WUP] + (size_t)layer * DM * NUP, args.in[I_FNG] + layer * DM, NUP, DM, BtUpQ, 128 * nt, 128 * kt, 256 * nv + ((nt < 44) ? 0 : 32), wmaxc); }
            for (int m = gw; m < M; m += NGW) xq_row(XB2 + (size_t)m * DM, XQ + (size_t)m * DM, SSQP + (size_t)m * 32, RSTD + m, 1.0f, F.lane);
            SEAM(7);
        }
        if (IN(8)) { ENTER();
            pg8::Gemm g{(const bf16*)XQ, (const bf16*)BtUpQ, M, NUP, DM / 2, DM / 2}; pg8::StaticOrder S; S.init(M, NUP, F.G, (int)blockIdx.x);
            pg8::EpiGate E{ACT, DFF, EDGE, args.in[I_FCW] + (size_t)layer * 3 * DFF, args.in[I_FCB] + layer * DFF, DFF, (LAS float*)(F.lds + HALO_OFF), RSTD, ctl + CW_WMAXC + layer * NUP};
            pg8::gemm_phase<pg8::EpiGate, pg8::StaticOrder, true>(F.lds, g, S, E);
            SEAM(8);
        }
        if (IN(9)) { ENTER();
            const float* fcw = args.in[I_FCW] + (size_t)layer * 3 * DFF;
            for (size_t i = gtid; i < (size_t)(M / 256) * 2 * (DFF / 4); i += gthreads) {
                const int ri = (int)(i / (DFF / 4)), c4 = (int)(i % (DFF / 4)) * 4, pm = ri >> 1, e = ri & 1;
                const float* eb = EDGE + (size_t)(ri * 3) * DFF + c4;
                f32x4 pre = *(const f32x4*)(eb + DFF); const f32x4 v = *(const f32x4*)(eb + 2 * DFF);
                if (e == 0 && (pm & 7) != 0) { const f32x4 gp = *(const f32x4*)(EDGE + (size_t)(((pm - 1) * 2 + 1) * 3) * DFF + c4); pre += *(const f32x4*)(fcw + c4) * gp; }
                if (e == 1 && (pm & 7) != 7) { const f32x4 gn = *(const f32x4*)(EDGE + (size_t)(((pm + 1) * 2 + 0) * 3) * DFF + c4); pre += *(const f32x4*)(fcw + 2 * DFF + c4) * gn; }
                v2u o; o.x = pk2(pg8::silu_f(pre.x) * v.x, pg8::silu_f(pre.y) * v.y); o.y = pk2(pg8::silu_f(pre.z) * v.z, pg8::silu_f(pre.w) * v.w);
                *(v2u*)(ACT + (size_t)(pm * 256 + (e ? 255 : 0)) * DFF + c4) = o;
            }
            SEAM(9);
        }
        if (IN(10)) { ENTER();
            pg8::Gemm g{ACT, BtDn, M, DM, DFF, DFF}; pg8::StaticOrder S; S.init(M, DM, F.G, (int)blockIdx.x);
            pg8::EpiResid16 E{XB2, XA, out, DM, SSQP, (layer + 1 < DEPTH) ? 0 : 1};
            pg8::gemm_phase<pg8::EpiResid16, pg8::StaticOrder>(F.lds, g, S, E);
            SEAM(10);
        }
#undef IN
#undef ENTER
#undef SEAM
    }
}

extern "C" void kernel_launch(void* const* d_in, const int* in_sizes, int n_in, void* d_out, int out_size, void* d_ws, size_t ws_size, hipStream_t stream) {
    static int grid = 0;
    if (grid == 0) {
        if (n_in != N_IN || out_size != M * DM || ws_size < WS_END) { fprintf(stderr, "kernel_launch: unexpected shapes (n_in %d, out %d, ws %zu, need %zu)\n", n_in, out_size, ws_size, (size_t)WS_END); grid = -1; return; }
        int dev = 0, cus = 0;
        if (hipGetDevice(&dev) != hipSuccess || hipDeviceGetAttribute(&cus, hipDeviceAttributeMultiprocessorCount, dev) != hipSuccess) { grid = -1; return; }
        if (hipFuncSetAttribute((const void*)fwd, hipFuncAttributeMaxDynamicSharedMemorySize, LDS_BYTES) != hipSuccess) { fprintf(stderr, "kernel_launch: hipFuncSetAttribute failed\n"); grid = -1; return; }
        int per_cu = 0;
        if (hipOccupancyMaxActiveBlocksPerMultiprocessor(&per_cu, (const void*)fwd, NWAVES * 64, LDS_BYTES) != hipSuccess || per_cu < 1) fprintf(stderr, "kernel_launch: occupancy query reports %d\n", per_cu);
        (void)hipGetLastError();
        grid = cus;
    }
    if (grid < 0) return;
    (void)hipMemsetAsync((char*)d_ws + WS_CTL, 0, CTL_BYTES, stream);
    Args a{};
    for (int i = 0; i < N_IN; ++i) a.in[i] = (const float*)d_in[i];
    a.out = (float*)d_out; a.ws = (unsigned char*)d_ws;
#if MK_ONE_LAUNCH
    a.ph_lo = 0; a.ph_hi = DEPTH * NPH;
    hipLaunchKernelGGL(fwd, dim3(grid), dim3(NWAVES * 64), LDS_BYTES, stream, a);
#else
    for (int p = 0; p < DEPTH * NPH; ++p) { a.ph_lo = p; a.ph_hi = p + 1; hipLaunchKernelGGL(fwd, dim3(grid), dim3(NWAVES * 64), LDS_BYTES, stream, a); }
#endif
    const hipError_t le = hipPeekAtLastError();
    if (le != hipSuccess) fprintf(stderr, "kernel_launch: launch failed: %s\n", hipGetErrorName(le));
}
```

```cpp
#include <hip/hip_runtime.h>
#include <cstdio>
#include <cstdint>
__device__ __forceinline__ int opq(int x) { asm volatile("" : "+v"(x)); return x; }
namespace pg8 {
#define PG8_LAS __attribute__((address_space(3)))
typedef unsigned short bf16_t;
typedef short bf16x8 __attribute__((ext_vector_type(8)));
typedef float f32x4 __attribute__((ext_vector_type(4)));
typedef unsigned u32x4 __attribute__((ext_vector_type(4)));
typedef int i32x4 __attribute__((ext_vector_type(4)));
template <bool I8> struct AccSel { typedef f32x4 T; }; template <> struct AccSel<true> { typedef i32x4 T; };
constexpr int BM = 256, BK = 64, HALF = 128, HTB = HALF * BK * 2  , STAGE_BYTES = 8 * HTB, NXCD = 8, WGM = 8;

__host__ __device__ __forceinline__ int lds_byte(int r, int c) { const int st = (r >> 4) * 2 + (c >> 5), rr = r & 15, cc = c & 31, ob = rr * 64 + cc * 2; return st * 1024 + (ob ^ (((ob >> 9) & 1) << 5)); }
__host__ __device__ __forceinline__ void stage_rc(int b, int& R, int& C) { const int st = b / 1024, sb = b % 1024, swz = sb ^ (((sb >> 9) & 1) << 5); R = (st >> 1) * 16 + swz / 64; C = (st & 1) * 32 + (swz % 64) / 2; }
__host__ __device__ __forceinline__ int perm32(int rho) { const int n = rho >> 4, i = rho & 15; return 8 * (i >> 2) + 4 * n + (i & 3); }

struct Unit { int pm, pn; };
struct Gemm { const bf16_t* A; const bf16_t* Bt; int M, N, K, lda; };

struct StaticOrder {
    int nM, nN, nwg, G, c;
    __host__ __device__ void init(int M, int N, int G_, int c_) { nM = M / BM; nN = N / BM; nwg = nM * nN; G = G_; c = c_; }
    __host__ __device__ bool next(int i, Unit& u) const {
        const long L = (long)i * G + c; if (L >= nwg) return false;
        int wgid = (int)L; { const int q = nwg / NXCD, r = nwg % NXCD, xcd = wgid % NXCD, off = wgid / NXCD; wgid = (xcd < r ? xcd * (q + 1) : r * (q + 1) + (xcd - r) * q) + off; }
        const int nig = WGM * nN, gid = wgid / nig, fm = gid * WGM, gsz = (nM - fm) < WGM ? (nM - fm) : WGM;
        u.pm = fm + ((wgid % nig) % gsz); u.pn = (wgid % nig) / gsz; return true;
    }
    __device__ __forceinline__ void a_ready(const Unit&) const {}
    __device__ __forceinline__ void done(const Unit&) const {}
};

__device__ __forceinline__ unsigned cvt_pk_bf16(float lo, float hi) { unsigned r; asm volatile("v_cvt_pk_bf16_f32 %0, %1, %2" : "=v"(r) : "v"(lo), "v"(hi)); return r; }

__device__ __forceinline__ float dpp_ror1(float v) { return __builtin_bit_cast(float, __builtin_amdgcn_update_dpp(0, __builtin_bit_cast(int, v), 0x121, 0xF, 0xF, false)); }
__device__ __forceinline__ float dpp_ror15(float v) { return __builtin_bit_cast(float, __builtin_amdgcn_update_dpp(0, __builtin_bit_cast(int, v), 0x12F, 0xF, 0xF, false)); }
__device__ __forceinline__ unsigned dpp_swap1(unsigned v) { return (unsigned)__builtin_amdgcn_update_dpp(0, (int)v, 0xB1, 0xF, 0xF, false); }
struct LineOffs { unsigned o0, o1; bool odd; };
__device__ __forceinline__ LineOffs line_offs(unsigned lo, int pitch, int fr) { LineOffs L; L.odd = fr & 1; L.o0 = L.odd ? lo - (unsigned)pitch + 32u : lo; L.o1 = L.odd ? lo + 32u : lo + (unsigned)pitch; return L; }
__device__ __forceinline__ void store_lines(bf16_t* base, const LineOffs& L, u32x4 a, u32x4 b) {
    const u32x4 snd = L.odd ? a : b; u32x4 rcv;
    rcv.x = dpp_swap1(snd.x); rcv.y = dpp_swap1(snd.y); rcv.z = dpp_swap1(snd.z); rcv.w = dpp_swap1(snd.w);
    *(u32x4*)(base + L.o0) = L.odd ? rcv : a;
    *(u32x4*)(base + L.o1) = L.odd ? b : rcv;
}
struct EpiBf16 {
    static constexpr bool PERM = true;
    bf16_t* O; int ldc; const float* rstd; int kvscatter;
    int norm_pn; PG8_LAS float* red; float eps;
    float* ssq_out; int ssq_pn0;
    __device__ __forceinline__ void operator()(f32x4 (&acc)[2][2][4][2], const Unit& u, int wr, int wc, int fr, int fq) const {
        bf16_t* Ot = O + (size_t)(u.pm * BM) * ldc + (kvscatter ? u.pn * 320 : u.pn * BM);
        const int wcol = kvscatter ? (wc < 2 ? wc * 64 : 64 + wc * 64) : wc * 64;
        const LineOffs L = line_offs((unsigned)((wr * 64 + fr) * ldc + wcol + 8 * fq), ldc, fr); const int row0 = u.pm * BM + wr * 64 + fr;
        float rsv[8];
#pragma unroll
        for (int i = 0; i < 8; ++i) rsv[i] = rstd ? rstd[row0 + (i >> 2) * HALF + (i & 3) * 16] : 1.0f;
        if (u.pn == norm_pn) {
#pragma unroll
            for (int ai = 0; ai < 2; ++ai)
#pragma unroll
                for (int m = 0; m < 4; ++m) { const float rs = rsv[ai * 4 + m]; float s = 0.f;
#pragma unroll
                    for (int bj = 0; bj < 2; ++bj) { acc[ai][bj][m][0] *= rs; acc[ai][bj][m][1] *= rs; const f32x4 a = acc[ai][bj][m][0], b = acc[ai][bj][m][1];
                        s += ((a[0] * a[0] + a[1] * a[1]) + (a[2] * a[2] + a[3] * a[3])) + ((b[0] * b[0] + b[1] * b[1]) + (b[2] * b[2] + b[3] * b[3])); }
                    s += __shfl_xor(s, 16); s += __shfl_xor(s, 32); if (fq == 0) red[(ai * HALF + wr * 64 + m * 16 + fr) * 4 + wc] = s; }
            asm volatile("s_waitcnt lgkmcnt(0)" ::: "memory"); __builtin_amdgcn_s_barrier(); asm volatile("" ::: "memory");
#pragma unroll
            for (int ai = 0; ai < 2; ++ai)
#pragma unroll
                for (int m = 0; m < 4; ++m) { const f32x4 p = *(const PG8_LAS f32x4*)(red + (ai * HALF + wr * 64 + m * 16 + fr) * 4); const float rs = 1.0f / __builtin_sqrtf(((p[0] + p[1]) + (p[2] + p[3])) * (1.0f / 256.0f) + eps);
                    u32x4 w[2];
#pragma unroll
                    for (int bj = 0; bj < 2; ++bj) { const f32x4 v0 = acc[ai][bj][m][0] * rs, v1 = acc[ai][bj][m][1] * rs;
                        w[bj].x = cvt_pk_bf16(v0[0], v0[1]); w[bj].y = cvt_pk_bf16(v0[2], v0[3]); w[bj].z = cvt_pk_bf16(v1[0], v1[1]); w[bj].w = cvt_pk_bf16(v1[2], v1[3]); }
                    store_lines(Ot + (size_t)((ai * HALF + m * 16) * ldc), L, w[0], w[1]);
                    asm volatile("" ::: "memory"); }
            return;
        }
        const bool want_ssq = ssq_out != nullptr && (unsigned)(u.pn - ssq_pn0) < 2u;
#pragma unroll
        for (int ai = 0; ai < 2; ++ai)
#pragma unroll
            for (int m = 0; m < 4; ++m) { const float rs = rsv[ai * 4 + m];
                u32x4 w[2]; float s = 0.f;
#pragma unroll
                for (int bj = 0; bj < 2; ++bj) { const f32x4 v0 = acc[ai][bj][m][0] * rs, v1 = acc[ai][bj][m][1] * rs;
                    s += ((v0[0] * v0[0] + v0[1] * v0[1]) + (v0[2] * v0[2] + v0[3] * v0[3])) + ((v1[0] * v1[0] + v1[1] * v1[1]) + (v1[2] * v1[2] + v1[3] * v1[3]));
                    w[bj].x = cvt_pk_bf16(v0[0], v0[1]); w[bj].y = cvt_pk_bf16(v0[2], v0[3]); w[bj].z = cvt_pk_bf16(v1[0], v1[1]); w[bj].w = cvt_pk_bf16(v1[2], v1[3]); }
                store_lines(Ot + (size_t)((ai * HALF + m * 16) * ldc), L, w[0], w[1]);
                if (want_ssq) { s += __shfl_xor(s, 16); s += __shfl_xor(s, 32); if (fq == 0) ssq_out[(size_t)(row0 + ai * HALF + m * 16) * 8 + (u.pn - ssq_pn0) * 4 + wc] = s; }
                asm volatile("" ::: "memory"); }
    }
};
struct EpiResid16 {
    static constexpr bool PERM = true;
    const bf16_t* base; bf16_t* xo; float* out; int ldc; float* ssqp; int f32out;
    __device__ __forceinline__ static void addx(const u32x4 b, const f32x4 a0, const f32x4 a1, f32x4& x0, f32x4& x1) {
        x0[0] = __builtin_bit_cast(float, b.x << 16) + a0[0]; x0[1] = __builtin_bit_cast(float, b.x & 0xffff0000u) + a0[1]; x0[2] = __builtin_bit_cast(float, b.y << 16) + a0[2]; x0[3] = __builtin_bit_cast(float, b.y & 0xffff0000u) + a0[3];
        x1[0] = __builtin_bit_cast(float, b.z << 16) + a1[0]; x1[1] = __builtin_bit_cast(float, b.z & 0xffff0000u) + a1[1]; x1[2] = __builtin_bit_cast(float, b.w << 16) + a1[2]; x1[3] = __builtin_bit_cast(float, b.w & 0xffff0000u) + a1[3]; }
    __device__ __forceinline__ void operator()(f32x4 (&acc)[2][2][4][2], const Unit& u, int wr, int wc, int fr, int fq) const {
        const size_t tb = (size_t)(u.pm * BM) * ldc + u.pn * BM;
        const bf16_t* bs = base + tb;
        const unsigned lo = (unsigned)((wr * 64 + fr) * ldc + wc * 64 + 8 * fq);
        if (f32out != 0) {
            float* op = out + tb;
#pragma unroll
            for (int ai = 0; ai < 2; ++ai)
#pragma unroll
                for (int m = 0; m < 4; ++m) { const unsigned off = lo + (unsigned)((ai * HALF + m * 16) * ldc);
#pragma unroll
                    for (int bj = 0; bj < 2; ++bj) { const u32x4 b = *(const u32x4*)(bs + off + bj * 32); f32x4 x0, x1; addx(b, acc[ai][bj][m][0], acc[ai][bj][m][1], x0, x1);
                        *(f32x4*)(op + off + bj * 32) = x0; *(f32x4*)(op + off + bj * 32 + 4) = x1; }
                    asm volatile("" ::: "memory"); }
            return;
        }
        bf16_t* xp = xo + tb; const LineOffs L = line_offs(lo, ldc, fr);
#pragma unroll
        for (int aim = 0; aim < 4; ++aim) { const int ai = aim >> 1, mp = aim & 1;
            u32x4 bv[2][2];
#pragma unroll
            for (int mm = 0; mm < 2; ++mm)
#pragma unroll
                for (int bj = 0; bj < 2; ++bj) bv[mm][bj] = *(const u32x4*)(bs + lo + (unsigned)((ai * HALF + (2 * mp + mm) * 16) * ldc) + bj * 32);
#pragma unroll
            for (int mm = 0; mm < 2; ++mm) { const int m = 2 * mp + mm; float s = 0.f; u32x4 wv[2];
#pragma unroll
                for (int bj = 0; bj < 2; ++bj) { f32x4 x0, x1; addx(bv[mm][bj], acc[ai][bj][m][0], acc[ai][bj][m][1], x0, x1);
                    wv[bj].x = cvt_pk_bf16(x0[0], x0[1]); wv[bj].y = cvt_pk_bf16(x0[2], x0[3]); wv[bj].z = cvt_pk_bf16(x1[0], x1[1]); wv[bj].w = cvt_pk_bf16(x1[2], x1[3]);
                    s += ((x0[0] * x0[0] + x0[1] * x0[1]) + (x0[2] * x0[2] + x0[3] * x0[3])) + ((x1[0] * x1[0] + x1[1] * x1[1]) + (x1[2] * x1[2] + x1[3] * x1[3])); }
                store_lines(xp + (size_t)((ai * HALF + m * 16) * ldc), L, wv[0], wv[1]);
                s += __shfl_xor(s, 16); s += __shfl_xor(s, 32); if (fq == 0) ssqp[(size_t)(u.pm * BM + wr * 64 + fr + ai * HALF + m * 16) * 32 + u.pn * 4 + wc] = s; }
            asm volatile("" ::: "memory"); }
    }
};
__device__ __forceinline__ float silu_f(float x) { return x * __builtin_amdgcn_rcpf(1.0f + __builtin_amdgcn_exp2f(-1.4426950408889634f * x)); }
struct EpiGate {
    static constexpr bool PERM = true;
    bf16_t* act; int ldact; float* edge; const float* cw; const float* cb; int dff; PG8_LAS float* halo; const float* rstd; const unsigned* wmaxc;
    __device__ __forceinline__ void operator()(f32x4 (&acc)[2][2][4][2], const Unit& u, int wr, int wc, int fr, int fq) const {
        const int lane = fq * 16 + fr; const int colL = wc * 32 + 8 * fq; const int colG = u.pn * HALF + colL;
        f32x4 csc[2][2];
#pragma unroll
        for (int bj = 0; bj < 2; ++bj)
#pragma unroll
            for (int n = 0; n < 2; ++n) { const u32x4 mb = *(const u32x4*)(wmaxc + bj * dff + colG + 4 * n);
                csc[bj][n] = (f32x4){__builtin_bit_cast(float, mb.x), __builtin_bit_cast(float, mb.y), __builtin_bit_cast(float, mb.z), __builtin_bit_cast(float, mb.w)} * (1.0f / 127.0f); }
#pragma unroll
        for (int ai = 0; ai < 2; ++ai)
#pragma unroll
            for (int m = 0; m < 4; ++m) { const float rs = rstd[u.pm * BM + ai * HALF + wr * 64 + m * 16 + fr];
#pragma unroll
                for (int bj = 0; bj < 2; ++bj) { acc[ai][bj][m][0] *= csc[bj][0] * rs; acc[ai][bj][m][1] *= csc[bj][1] * rs; } }
#pragma unroll
        for (int ai = 0; ai < 2; ++ai) { const int q = 2 * ai + wr;
            if (fr == 0) { *(PG8_LAS f32x4*)(halo + (q * 2 + 0) * 128 + colL) = acc[ai][0][0][0]; *(PG8_LAS f32x4*)(halo + (q * 2 + 0) * 128 + colL + 4) = acc[ai][0][0][1]; }
            if (fr == 15) { *(PG8_LAS f32x4*)(halo + (q * 2 + 1) * 128 + colL) = acc[ai][0][3][0]; *(PG8_LAS f32x4*)(halo + (q * 2 + 1) * 128 + colL + 4) = acc[ai][0][3][1]; } }
        asm volatile("s_waitcnt lgkmcnt(0)" ::: "memory"); __builtin_amdgcn_s_barrier(); asm volatile("" ::: "memory");
        bf16_t* actp = act + (size_t)(u.pm * BM) * ldact + colG; const unsigned rlo = (unsigned)((wr * 64 + fr) * ldact);
#pragma unroll
        for (int ai = 0; ai < 2; ++ai) { const int q = 2 * ai + wr;
            typedef unsigned u32x2 __attribute__((ext_vector_type(2)));
            u32x2 pk[4][2];
#pragma unroll
            for (int n = 0; n < 2; ++n) {
                const f32x4 w0 = *(const f32x4*)(cw + colG + 4 * n), w1 = *(const f32x4*)(cw + dff + colG + 4 * n), w2 = *(const f32x4*)(cw + 2 * dff + colG + 4 * n), bb = *(const f32x4*)(cb + colG + 4 * n);
                f32x4 ht = *(PG8_LAS f32x4*)(halo + ((q > 0 ? q - 1 : 0) * 2 + 1) * 128 + colL + 4 * n), hb = *(PG8_LAS f32x4*)(halo + ((q < 3 ? q + 1 : 3) * 2 + 0) * 128 + colL + 4 * n);
                if (q == 0) ht = ht * 0.f; if (q == 3) hb = hb * 0.f;
                f32x4 pre[4];
#pragma unroll
                for (int j = 0; j < 4; ++j) {
                    float g[4], rr[4], rl[4];
#pragma unroll
                    for (int m = 0; m < 4; ++m) { g[m] = acc[ai][0][m][n][j]; rr[m] = dpp_ror1(g[m]); rl[m] = dpp_ror15(g[m]); }
#pragma unroll
                    for (int m = 0; m < 4; ++m) {
                        const float up = (fr > 0) ? rr[m] : (m > 0 ? rr[m > 0 ? m - 1 : 0] : ht[j]);
                        const float dn = (fr < 15) ? rl[m] : (m < 3 ? rl[m < 3 ? m + 1 : 3] : hb[j]);
                        pre[m][j] = w0[j] * up + w1[j] * g[m] + w2[j] * dn + bb[j];
                    }
                }
                if (q == 0 && fr == 0) { float* e = edge + (size_t)((u.pm * 2 + 0) * 3) * dff + colG + 4 * n;
                    *(f32x4*)(e) = acc[ai][0][0][n]; *(f32x4*)(e + dff) = pre[0]; *(f32x4*)(e + 2 * dff) = acc[ai][1][0][n]; }
                if (q == 3 && fr == 15) { float* e = edge + (size_t)((u.pm * 2 + 1) * 3) * dff + colG + 4 * n;
                    *(f32x4*)(e) = acc[ai][0][3][n]; *(f32x4*)(e + dff) = pre[3]; *(f32x4*)(e + 2 * dff) = acc[ai][1][3][n]; }
#pragma unroll
                for (int m = 0; m < 4; ++m) { const f32x4 v = acc[ai][1][m][n];
                    pk[m][n].x = cvt_pk_bf16(silu_f(pre[m][0]) * v[0], silu_f(pre[m][1]) * v[1]); pk[m][n].y = cvt_pk_bf16(silu_f(pre[m][2]) * v[2], silu_f(pre[m][3]) * v[3]); }
            }
#pragma unroll
            for (int m = 0; m < 4; ++m) { u32x4 w; w.x = pk[m][0].x; w.y = pk[m][0].y; w.z = pk[m][1].x; w.w = pk[m][1].y;
                *(u32x4*)(actp + rlo + (unsigned)((ai * HALF + m * 16) * ldact)) = w; }
        }
    }
};

template <class Epi, class Sched, bool I8 = false>
__device__ __forceinline__ void gemm_phase(PG8_LAS unsigned char* lds, const Gemm g, const Sched& S, const Epi& E) {
    typedef typename AccSel<I8>::T acc_t;
    const int tid = opq(threadIdx.x), wid = __builtin_amdgcn_readfirstlane(tid >> 6), lane = tid & 63, wr = wid >> 2, wc = wid & 3, fr = lane & 15, fq = lane >> 4;
    const int K = g.K, nt = K / BK, lda = g.lda;
    unsigned voffA[2], voffB[2];
#pragma unroll
    for (int i = 0; i < 2; ++i) { int R, C; stage_rc(tid * 16 + i * 8192, R, C); const int Rb = Epi::PERM ? (64 * (R >> 5) + perm32(R & 31)) : R;
        voffA[i] = (unsigned)(R * lda + C) * 2u; voffB[i] = (unsigned)(Rb * K + C) * 2u; }
    const size_t kstep = (size_t)(BK * 2);
    const size_t hstepA = (size_t)HALF * lda * 2, hstepB = (size_t)(Epi::PERM ? 32 : HALF) * K * 2;
    const size_t tstepA = 2 * hstepA, tstepB = (size_t)BM * K * 2;
    const unsigned ldsw = (unsigned)wid * 1024u;
    const int aoff = lds_byte(wr * 64 + fr, fq * 8), boff = lds_byte(wc * 32 + fr, fq * 8);
#define PG8_SA(b, h) (((b) * 2 + (h)) * HTB)
#define PG8_SB(b, h) ((4 + (b) * 2 + (h)) * HTB)
#define PG8_STAGE(bufoff, gbase, voff) do { _Pragma("unroll") for (int _i = 0; _i < 2; ++_i) \
        __builtin_amdgcn_global_load_lds((const unsigned*)((const char*)(gbase) + (voff)[_i]), (PG8_LAS unsigned*)(lds + (bufoff) + ldsw + _i * 8192), 16, 0, 0); } while (0)
#define PG8_LDA(dst, b, h) do { _Pragma("unroll") for (int m = 0; m < 4; ++m) _Pragma("unroll") for (int k = 0; k < 2; ++k) dst[m][k] = *(const PG8_LAS bf16x8*)(lds + PG8_SA(b, h) + aoff + m * 2048 + k * 1024); } while (0)
#define PG8_LDB(dst, b, h) do { _Pragma("unroll") for (int n = 0; n < 2; ++n) _Pragma("unroll") for (int k = 0; k < 2; ++k) dst[n][k] = *(const PG8_LAS bf16x8*)(lds + PG8_SB(b, h) + boff + n * 2048 + k * 1024); } while (0)
#define PG8_MMA(ai, bj, At, Bt) do { __builtin_amdgcn_s_setprio(1); _Pragma("unroll") for (int m = 0; m < 4; ++m) _Pragma("unroll") for (int n = 0; n < 2; ++n) _Pragma("unroll") for (int k = 0; k < 2; ++k) { \
        if constexpr (I8) acc[ai][bj][m][n] = __builtin_amdgcn_mfma_i32_16x16x64_i8(__builtin_bit_cast(i32x4, Bt[n][k]), __builtin_bit_cast(i32x4, At[m][k]), acc[ai][bj][m][n], 0, 0, 0); \
        else acc[ai][bj][m][n] = __builtin_amdgcn_mfma_f32_16x16x32_bf16(Bt[n][k], At[m][k], acc[ai][bj][m][n], 0, 0, 0); } __builtin_amdgcn_s_setprio(0); } while (0)
#define PG8_WAIT_V(n) asm volatile("s_waitcnt vmcnt(" #n ")" ::: "memory")
#define PG8_WAIT_L(n) asm volatile("s_waitcnt lgkmcnt(" #n ")" ::: "memory")
#define PG8_BAR __builtin_amdgcn_s_barrier()
#define PG8_SCHED __builtin_amdgcn_sched_barrier(0)
    Unit cur, nxt; int ui = 0;
    if (!S.next(0, cur)) return;
    acc_t acc[2][2][4][2];
{ float zf = 0.f; asm volatile("" : "+v"(zf));
    #pragma unroll
    for (int a = 0; a < 2; ++a)
#pragma unroll
        for (int b = 0; b < 2; ++b)
#pragma unroll
            for (int m = 0; m < 4; ++m)
#pragma unroll
                for (int n = 0; n < 2; ++n) acc[a][b][m][n] = __builtin_bit_cast(acc_t, (f32x4){zf, zf, zf, zf}); }
    bf16x8 At[4][2], B0[2][2], B1[2][2];
    const char* cA = (const char*)g.A + (size_t)cur.pm * tstepA; const char* cB = (const char*)g.Bt + (size_t)cur.pn * tstepB;
    S.a_ready(cur);
    PG8_STAGE(PG8_SB(0, 0), cB, voffB); PG8_STAGE(PG8_SB(0, 1), cB + hstepB, voffB); PG8_STAGE(PG8_SA(0, 0), cA, voffA); PG8_STAGE(PG8_SA(0, 1), cA + hstepA, voffA);
    if (wr == 1) PG8_BAR;
    PG8_WAIT_V(2); PG8_BAR;
    PG8_STAGE(PG8_SB(1, 0), cB + kstep, voffB); PG8_STAGE(PG8_SA(1, 0), cA + kstep, voffA); PG8_STAGE(PG8_SB(1, 1), cB + hstepB + kstep, voffB);
    PG8_WAIT_V(6); PG8_BAR;
    for (;;) {
        const bool has_next = S.next(ui + 1, nxt);
        const char* nA = has_next ? (const char*)g.A + (size_t)nxt.pm * tstepA : cA; const char* nB = has_next ? (const char*)g.Bt + (size_t)nxt.pn * tstepB : cB;
#pragma unroll 1
        for (int t = 0; t < nt; t += 2) {
            const bool last = (t == nt - 2);
            const char* a1 = cA + (size_t)(t + 1) * kstep;
            const char* a2 = last ? nA : cA + (size_t)(t + 2) * kstep; const char* b2 = last ? nB : cB + (size_t)(t + 2) * kstep;
            const char* a3 = a2 + kstep; const char* b3 = b2 + kstep;
            if (last && has_next) S.a_ready(nxt);
            PG8_LDB(B0, 0, 0); PG8_LDB(B1, 0, 1); PG8_SCHED; PG8_LDA(At, 0, 0); PG8_STAGE(PG8_SA(1, 1), a1 + hstepA, voffA);
            PG8_WAIT_V(8); PG8_WAIT_L(0); PG8_BAR; PG8_MMA(0, 0, At, B0); PG8_MMA(0, 1, At, B1); PG8_BAR; PG8_SCHED;
            PG8_LDA(At, 0, 1); PG8_STAGE(PG8_SB(0, 0), b2, voffB); PG8_STAGE(PG8_SB(0, 1), b2 + hstepB, voffB); PG8_STAGE(PG8_SA(0, 0), a2, voffA);
            PG8_WAIT_V(8); PG8_WAIT_L(0); PG8_BAR; PG8_MMA(1, 0, At, B0); PG8_MMA(1, 1, At, B1); PG8_BAR; PG8_SCHED;
            PG8_LDB(B0, 1, 0); PG8_LDB(B1, 1, 1); PG8_SCHED; PG8_LDA(At, 1, 0); PG8_STAGE(PG8_SA(0, 1), a2 + hstepA, voffA);
            PG8_WAIT_V(8); PG8_WAIT_L(0); PG8_BAR; PG8_MMA(0, 0, At, B0); PG8_MMA(0, 1, At, B1); PG8_BAR; PG8_SCHED;
            PG8_LDA(At, 1, 1); PG8_STAGE(PG8_SB(1, 0), b3, voffB); PG8_STAGE(PG8_SB(1, 1), b3 + hstepB, voffB); PG8_STAGE(PG8_SA(1, 0), a3, voffA);
            PG8_WAIT_V(8); PG8_WAIT_L(0); PG8_BAR; PG8_MMA(1, 0, At, B0); PG8_MMA(1, 1, At, B1); PG8_BAR; PG8_SCHED;
        }
        if (wr == 0) PG8_BAR;
        if constexpr (I8) { f32x4 accf[2][2][4][2];
#pragma unroll
            for (int a = 0; a < 2; ++a)
#pragma unroll
                for (int b = 0; b < 2; ++b)
#pragma unroll
                    for (int m = 0; m < 4; ++m)
#pragma unroll
                        for (int n = 0; n < 2; ++n) accf[a][b][m][n] = __builtin_convertvector(acc[a][b][m][n], f32x4);
            E(accf, cur, wr, wc, fr, fq); }
        else E(acc, cur, wr, wc, fr, fq);
        S.done(cur);
        if (!has_next) break;
{ float zf = 0.f; asm volatile("" : "+v"(zf));
        #pragma unroll
        for (int a = 0; a < 2; ++a)
#pragma unroll
            for (int b = 0; b < 2; ++b)
#pragma unroll
                for (int m = 0; m < 4; ++m)
#pragma unroll
                    for (int n = 0; n < 2; ++n) acc[a][b][m][n] = __builtin_bit_cast(acc_t, (f32x4){zf, zf, zf, zf}); }
        cur = nxt; cA = nA; cB = nB; ++ui;
        if (wr == 1) PG8_BAR;
    }
    PG8_WAIT_V(0);
    PG8_BAR;
#undef PG8_SA
#undef PG8_SB
#undef PG8_STAGE
#undef PG8_LDA
#undef PG8_LDB
#undef PG8_MMA
#undef PG8_WAIT_V
#undef PG8_WAIT_L
#undef PG8_BAR
#undef PG8_SCHED
}
}
namespace at {
using bf16 = unsigned short;
using bf16x8 = __attribute__((ext_vector_type(8))) short;
using s16x4  = __attribute__((ext_vector_type(4))) short;
using f32x16 = __attribute__((ext_vector_type(16))) float;
using u32x4  = __attribute__((ext_vector_type(4))) unsigned;
using f32x4  = __attribute__((ext_vector_type(4))) float;
constexpr int DQK = 192, DV = 128, KVBLK = 64, NW = 8, QBLK = 32;
constexpr float SCALE = 0.07216878364870322f;
constexpr float THR = 8.f;
constexpr int LDQ = 1536, LDK = 2560, LDO = 2048;
constexpr int SHM_V = KVBLK * DV * 2, SHM_K = 12 * 2080;
constexpr int QR_OFF = 2 * SHM_V + 2 * SHM_K + NW * 64 * 4;
constexpr int SHM_ATTN = QR_OFF + NW * 4096;
#define SBAR() __builtin_amdgcn_sched_barrier(0)
constexpr int KPL = 2080;
__host__ __device__ __forceinline__ int k_st(int row, int c) { return (c >> 1) * KPL + row * 32 + (((c & 1) ^ ((row >> 3) & 1)) << 4); }
__host__ __device__ __forceinline__ int k_rd_base(int r32, int hi) { return r32 * 32 + ((hi ^ ((r32 >> 3) & 1)) << 4); }
__device__ __forceinline__ int crow(int r, int hi) { return (r & 3) + 8 * (r >> 2) + 4 * hi; }
__device__ __forceinline__ unsigned cvtpk(float lo, float hi) { unsigned r; asm volatile("v_cvt_pk_bf16_f32 %0, %1, %2" : "=v"(r) : "v"(lo), "v"(hi)); return r; }

__device__ __forceinline__ void partialSM(f32x16& p0, f32x16& p1, float& m_reg, float& mn, float& alpha) {
  constexpr float C = 1.0f;
  float pmax = p0[0];
#pragma unroll
  for (int r = 1; r < 16; ++r) pmax = fmaxf(pmax, p0[r]);
#pragma unroll
  for (int r = 0; r < 16; ++r) pmax = fmaxf(pmax, p1[r]);
  { auto rr = __builtin_amdgcn_permlane32_swap(__float_as_uint(pmax), __float_as_uint(pmax), false, false);
    pmax = fmaxf(__uint_as_float(rr[0]), __uint_as_float(rr[1])); }
  if (__builtin_expect(__all(pmax - m_reg <= THR * 1.4426950408889634f), 1)) { mn = m_reg; alpha = 1.f; }
  else { mn = fmaxf(m_reg, pmax); alpha = __builtin_amdgcn_exp2f((m_reg - mn) * C); m_reg = mn; }
  float mnC = -mn * C;
#pragma unroll
  for (int r = 0; r < 16; ++r) p0[r] = fmaf(p0[r], C, mnC);
#pragma unroll
  for (int r = 0; r < 16; ++r) p1[r] = fmaf(p1[r], C, mnC);
#pragma unroll
  for (int r = 0; r < 16; ++r) p0[r] = __builtin_amdgcn_exp2f(p0[r]);
}
__device__ __forceinline__ void partialSM_fast(f32x16& p0, f32x16& p1, float negMC) {
  (void)negMC; (void)p1;
#pragma unroll
  for (int r = 0; r < 16; ++r) p0[r] = __builtin_amdgcn_exp2f(p0[r]);
}
__device__ __forceinline__ void finishSM(f32x16& p0, f32x16& p1, float alpha, float& l_reg, bf16x8& pa0, bf16x8& pa1, bf16x8& pa2, bf16x8& pa3) {
#pragma unroll
  for (int r = 0; r < 16; ++r) p1[r] = __builtin_amdgcn_exp2f(p1[r]);
  float ps = 0;
#pragma unroll
  for (int r = 0; r < 16; ++r) ps += p0[r];
#pragma unroll
  for (int r = 0; r < 16; ++r) ps += p1[r];
  { auto rr = __builtin_amdgcn_permlane32_swap(__float_as_uint(ps), __float_as_uint(ps), false, false);
    ps = __uint_as_float(rr[0]) + __uint_as_float(rr[1]); }
  l_reg = l_reg * alpha + ps;
#define PK4(P, BASE, OUT) do { unsigned a0 = cvtpk(P[BASE + 0], P[BASE + 1]), a1 = cvtpk(P[BASE + 2], P[BASE + 3]);   \
    unsigned b0 = cvtpk(P[BASE + 4], P[BASE + 5]), b1 = cvtpk(P[BASE + 6], P[BASE + 7]);                              \
    auto r0 = __builtin_amdgcn_permlane32_swap(a0, b0, false, false); auto r1 = __builtin_amdgcn_permlane32_swap(a1, b1, false, false); \
    u32x4 w = {r0[0], r1[0], r0[1], r1[1]}; OUT = *reinterpret_cast<bf16x8*>(&w); } while (0)
  PK4(p0, 0, pa0); PK4(p0, 8, pa1); PK4(p1, 0, pa2); PK4(p1, 8, pa3);
#undef PK4
}
template <int OFF> __device__ __forceinline__ bf16x8 k_read(int kb) {
  bf16x8 r; asm volatile("ds_read_b128 %0, %1 offset:%2" : "=v"(r) : "v"(kb), "i"(OFF) : "memory"); return r;
}
__device__ __forceinline__ void qkt(f32x16& p0, f32x16& p1, int kb, const bf16x8* qr, int qb) {
  p0 = f32x16{}; p1 = f32x16{};
#define QK1(d0) { const bf16x8 b0 = *(const __attribute__((address_space(3))) bf16x8*)(kb + d0 * KPL), b1 = *(const __attribute__((address_space(3))) bf16x8*)(kb + d0 * KPL + 1024); \
    p0 = __builtin_amdgcn_mfma_f32_32x32x16_bf16(b0, qr[d0], p0, 0, 0, 0); p1 = __builtin_amdgcn_mfma_f32_32x32x16_bf16(b1, qr[d0], p1, 0, 0, 0); }
#define QK2(d0) { const bf16x8 b0 = *(const __attribute__((address_space(3))) bf16x8*)(kb + d0 * KPL), b1 = *(const __attribute__((address_space(3))) bf16x8*)(kb + d0 * KPL + 1024); \
    const bf16x8 qf = *(const __attribute__((address_space(3))) bf16x8*)(qb + (d0 - 8) * 1024); \
    p0 = __builtin_amdgcn_mfma_f32_32x32x16_bf16(b0, qf, p0, 0, 0, 0); p1 = __builtin_amdgcn_mfma_f32_32x32x16_bf16(b1, qf, p1, 0, 0, 0); }
  QK1(0) QK1(1) QK1(2) QK1(3) QK1(4) QK1(5) QK1(6) QK1(7) QK2(8) QK2(9) QK2(10) QK2(11)
#undef QK1
#undef QK2
}
__host__ __device__ __forceinline__ int v_st(int k, int c) { const int kk = (k & ~0xC) | ((k & 4) << 1) | ((k & 8) >> 1); return ((kk >> 3) * 4 + (c >> 5)) * 512 + ((kk & 7) * 32 + (c & 31)) * 2; }
__device__ __forceinline__ int v_rd_base(int lane) { return ((lane & 3) << 3) | (((lane >> 2) & 3) << 6) | (((lane >> 4) & 1) << 5) | (((lane >> 5) & 1) << 8); }
constexpr int v_rd_off(int d0, int ks, int half) { return d0 * 512 + ks * 4096 + half * 2048; }
template <int OFF> __device__ __forceinline__ s16x4 tr_read(int vb) {
  s16x4 r; asm volatile("ds_read_b64_tr_b16 %0, %1 offset:%2" : "=&v"(r) : "v"(vb), "i"(OFF) : "memory"); return r;
}
template <int D0> __device__ __forceinline__ void pv_one(f32x16& od, int vb, bf16x8 pa0, bf16x8 pa1, bf16x8 pa2, bf16x8 pa3) {
  const s16x4 l0 = tr_read<v_rd_off(D0, 0, 0)>(vb), h0 = tr_read<v_rd_off(D0, 0, 1)>(vb), l1 = tr_read<v_rd_off(D0, 1, 0)>(vb), h1 = tr_read<v_rd_off(D0, 1, 1)>(vb);
  const s16x4 l2 = tr_read<v_rd_off(D0, 2, 0)>(vb), h2 = tr_read<v_rd_off(D0, 2, 1)>(vb), l3 = tr_read<v_rd_off(D0, 3, 0)>(vb), h3 = tr_read<v_rd_off(D0, 3, 1)>(vb);
  asm volatile("s_waitcnt lgkmcnt(0)" ::: "memory"); SBAR();
#define PK(L, H) (bf16x8){L[0], L[1], L[2], L[3], H[0], H[1], H[2], H[3]}
  od = __builtin_amdgcn_mfma_f32_32x32x16_bf16(pa0, PK(l0, h0), od, 0, 0, 0);
  od = __builtin_amdgcn_mfma_f32_32x32x16_bf16(pa1, PK(l1, h1), od, 0, 0, 0);
  od = __builtin_amdgcn_mfma_f32_32x32x16_bf16(pa2, PK(l2, h2), od, 0, 0, 0);
  od = __builtin_amdgcn_mfma_f32_32x32x16_bf16(pa3, PK(l3, h3), od, 0, 0, 0);
#undef PK
}
__device__ __forceinline__ void pv_d0(f32x16* o, int vb, bf16x8 pa0, bf16x8 pa1, bf16x8 pa2, bf16x8 pa3) {
  pv_one<0>(o[0], vb, pa0, pa1, pa2, pa3); pv_one<1>(o[1], vb, pa0, pa1, pa2, pa3); pv_one<2>(o[2], vb, pa0, pa1, pa2, pa3); pv_one<3>(o[3], vb, pa0, pa1, pa2, pa3);
}

template <bool FAST>
__device__ __forceinline__ void attn_unit(const float negMC, const bf16* __restrict__ Qb, const bf16* __restrict__ Kh, const bf16* __restrict__ Vh, bf16* __restrict__ Ob, int seq, char* lds,
                                          const float* __restrict__ ssqcq, const float* __restrict__ qg, const float* __restrict__ rope0) {
  const int tid = opq(threadIdx.x), wid = tid >> 6, lane = tid & 63, r32 = lane & 31, hi = lane >> 5;
  char* V_lds = lds; char* K_lds = lds + 2 * SHM_V;
  float* ws = (float*)(lds + 2 * SHM_V + 2 * SHM_K) + wid * 64; float* li_l = ws; float* al_l = ws + 32;
  float m_reg = -1e30f, l_reg = 0; f32x16 o[4] = {}; bf16x8 qr[8];
  const bf16* Qw = Qb + (unsigned)((wid * QBLK + r32) * LDQ + hi * 8);
  const int qb0 = (int)(uintptr_t)lds + QR_OFF + wid * 4096 + k_rd_base(r32, hi);
  { const int row = wid * QBLK + r32;
    bf16x8 raw[12];
#pragma unroll
    for (int d0 = 0; d0 < 12; ++d0) raw[d0] = *reinterpret_cast<const bf16x8*>(Qw + d0 * 16);
    const f32x4 pa = *(const f32x4*)(ssqcq + row * 8), pb = *(const f32x4*)(ssqcq + row * 8 + 4);
    const float rq = 1.0f / __builtin_sqrtf((((pa.x + pa.y) + (pa.z + pa.w)) + ((pb.x + pb.y) + (pb.z + pb.w))) * (1.f / 512.f) + 1e-6f);
    float ss = 0.f;
#pragma unroll
    for (int d0 = 0; d0 < 12; ++d0)
#pragma unroll
      for (int i = 0; i < 8; ++i) { const float x = __builtin_bit_cast(float, (unsigned)(unsigned short)raw[d0][i] << 16); ss += x * x; }
    ss += __shfl_xor(ss, 32);
    const float sc = (rq * (SCALE * 1.4426950408889634f)) / __builtin_sqrtf(ss * (rq * rq) * (1.f / 192.f) + 1e-6f);
#define QX(d0, i) (__builtin_bit_cast(float, (unsigned)(unsigned short)raw[d0][i] << 16) * sc)
#pragma unroll
    for (int d0 = 0; d0 < 8; ++d0) { const f32x4 g0 = *(const f32x4*)(qg + 16 * d0 + 8 * hi), g1 = *(const f32x4*)(qg + 16 * d0 + 8 * hi + 4);
      u32x4 w = {cvtpk(QX(d0, 0) * g0.x, QX(d0, 1) * g0.y), cvtpk(QX(d0, 2) * g0.z, QX(d0, 3) * g0.w), cvtpk(QX(d0, 4) * g1.x, QX(d0, 5) * g1.y), cvtpk(QX(d0, 6) * g1.z, QX(d0, 7) * g1.w)};
      qr[d0] = *reinterpret_cast<bf16x8*>(&w); }
#pragma unroll
    for (int t = 0; t < 2; ++t) { const int da = 8 + t, db = 10 + t, j0 = 16 * t + 8 * hi;
      const float* rp = rope0 + row * 64 + j0;
      const f32x4 c0 = *(const f32x4*)rp, c1 = *(const f32x4*)(rp + 4), s0 = *(const f32x4*)(rp + 32), s1 = *(const f32x4*)(rp + 36);
      const f32x4 ga0 = *(const f32x4*)(qg + 16 * da + 8 * hi), ga1 = *(const f32x4*)(qg + 16 * da + 8 * hi + 4), gb0 = *(const f32x4*)(qg + 16 * db + 8 * hi), gb1 = *(const f32x4*)(qg + 16 * db + 8 * hi + 4);
      const float cs[8] = {c0.x, c0.y, c0.z, c0.w, c1.x, c1.y, c1.z, c1.w}, sn[8] = {s0.x, s0.y, s0.z, s0.w, s1.x, s1.y, s1.z, s1.w};
      const float ga[8] = {ga0.x, ga0.y, ga0.z, ga0.w, ga1.x, ga1.y, ga1.z, ga1.w}, gb[8] = {gb0.x, gb0.y, gb0.z, gb0.w, gb1.x, gb1.y, gb1.z, gb1.w};
      float oa[8], ob[8];
#pragma unroll
      for (int i = 0; i < 8; ++i) { const float xa = QX(da, i) * ga[i], xb = QX(db, i) * gb[i]; oa[i] = xa * cs[i] - xb * sn[i]; ob[i] = xb * cs[i] + xa * sn[i]; }
      u32x4 wa = {cvtpk(oa[0], oa[1]), cvtpk(oa[2], oa[3]), cvtpk(oa[4], oa[5]), cvtpk(oa[6], oa[7])}, wb = {cvtpk(ob[0], ob[1]), cvtpk(ob[2], ob[3]), cvtpk(ob[4], ob[5]), cvtpk(ob[6], ob[7])};
      *(__attribute__((address_space(3))) bf16x8*)(qb0 + (da - 8) * 1024) = *reinterpret_cast<bf16x8*>(&wa);
      *(__attribute__((address_space(3))) bf16x8*)(qb0 + (db - 8) * 1024) = *reinterpret_cast<bf16x8*>(&wb); }
#undef QX
  }
  const int sr = tid >> 4, sc = (tid & 15) * 8, vst0 = v_st(sr, sc), vst1 = v_st(32 + sr, sc);
  unsigned koff[3]; int kst[3];
#pragma unroll
  for (int i = 0; i < 3; ++i) { const int q = tid + 512 * i; koff[i] = (unsigned)((q / 24) * LDK + (q % 24) * 8); kst[i] = k_st(q / 24, q % 24); }
  const unsigned voff0 = (unsigned)(sr * LDK + sc), voff1 = (unsigned)((32 + sr) * LDK + sc);
  const int vb0 = (int)(uintptr_t)V_lds + v_rd_base(lane); const int kb0 = (int)(uintptr_t)K_lds + k_rd_base(r32, hi);
  struct { bf16x8 vs0, vs1, ks0, ks1, ks2; } sr_[1];
#define SLOAD(i, k0) do { const bf16* vt = Vh + (size_t)(k0) * LDK; const bf16* kt = Kh + (size_t)(k0) * LDK; \
    sr_[i].vs0 = *(const bf16x8*)(vt + voff0); sr_[i].vs1 = *(const bf16x8*)(vt + voff1); \
    sr_[i].ks0 = *(const bf16x8*)(kt + koff[0]); sr_[i].ks1 = *(const bf16x8*)(kt + koff[1]); sr_[i].ks2 = *(const bf16x8*)(kt + koff[2]); } while (0)
#define SWRITE(b, i) do { *(bf16x8*)(V_lds + (b) * SHM_V + vst0) = sr_[i].vs0; *(bf16x8*)(V_lds + (b) * SHM_V + vst1) = sr_[i].vs1; \
    *(bf16x8*)(K_lds + (b) * SHM_K + kst[0]) = sr_[i].ks0; *(bf16x8*)(K_lds + (b) * SHM_K + kst[1]) = sr_[i].ks1; *(bf16x8*)(K_lds + (b) * SHM_K + kst[2]) = sr_[i].ks2; } while (0)
#define SWAIT() do { if constexpr (SDEPTH == 2) asm volatile("s_waitcnt vmcnt(5)" ::: "memory"); else asm volatile("s_waitcnt vmcnt(0)" ::: "memory"); } while (0)
#define RESC(a) do { if (__any((a) < 1.f)) { if (hi == 0) al_l[r32] = (a); asm volatile("s_waitcnt lgkmcnt(0)" ::: "memory"); \
    _Pragma("unroll") for (int d = 0; d < 4; ++d) _Pragma("unroll") for (int r = 0; r < 16; ++r) o[d][r] *= al_l[crow(r, hi)]; } } while (0)
  f32x16 pA0, pA1, pB0, pB1; float mnA, mnB, alA, alB; bf16x8 pa0, pa1, pa2, pa3; const int NT = seq / KVBLK;
#define PSM(P0, P1, MN, AL) do { if constexpr (FAST) { partialSM_fast(P0, P1, negMC); AL = 1.f; } else partialSM(P0, P1, m_reg, MN, AL); } while (0)
#define RSC(AL) do { if constexpr (!FAST) RESC(AL); } while (0)
  SLOAD(0, 0); asm volatile("s_waitcnt vmcnt(0)" ::: "memory"); SWRITE(0, 0); __syncthreads();
  qkt(pA0, pA1, kb0, qr, qb0); PSM(pA0, pA1, mnA, alA);
  SLOAD(0, KVBLK);
  asm volatile("s_waitcnt vmcnt(0)" ::: "memory"); SWRITE(1, 0); __syncthreads();
  for (int j = 1; j + 1 < NT; j += 2) {
    SBAR(); qkt(pB0, pB1, kb0 + SHM_K, qr, qb0);
    finishSM(pA0, pA1, alA, l_reg, pa0, pa1, pa2, pa3); SBAR();
    SLOAD(0, (j + 1) * KVBLK); SBAR();
    pv_d0(o, vb0, pa0, pa1, pa2, pa3); PSM(pB0, pB1, mnB, alB);
    __syncthreads(); asm volatile("s_waitcnt vmcnt(0)" ::: "memory"); SWRITE(0, 0);
    RSC(alB); __syncthreads();
    SBAR(); qkt(pA0, pA1, kb0, qr, qb0);
    finishSM(pB0, pB1, alB, l_reg, pa0, pa1, pa2, pa3); SBAR();
    SLOAD(0, (j + 2) * KVBLK); SBAR();
    pv_d0(o, vb0 + (int)SHM_V, pa0, pa1, pa2, pa3); PSM(pA0, pA1, mnA, alA);
    __syncthreads(); asm volatile("s_waitcnt vmcnt(0)" ::: "memory"); SWRITE(1, 0);
    RSC(alA); __syncthreads();
  }
  SBAR(); qkt(pB0, pB1, kb0 + SHM_K, qr, qb0);
  finishSM(pA0, pA1, alA, l_reg, pa0, pa1, pa2, pa3); SBAR();
  pv_d0(o, vb0, pa0, pa1, pa2, pa3); PSM(pB0, pB1, mnB, alB);
  __syncthreads(); RSC(alB);
  finishSM(pB0, pB1, alB, l_reg, pa0, pa1, pa2, pa3); SBAR();
  pv_d0(o, vb0 + (int)SHM_V, pa0, pa1, pa2, pa3);
  if (hi == 0) li_l[r32] = l_reg; asm volatile("s_waitcnt lgkmcnt(0)" ::: "memory");
  bf16* Ow = Ob + (unsigned)(wid * QBLK * LDO + r32);
#pragma unroll
  for (int r = 0; r < 16; ++r) { const int orow = crow(r, hi); const float rl = __builtin_amdgcn_rcpf(li_l[orow]);
#pragma unroll
    for (int d0 = 0; d0 < 4; ++d0) { const unsigned w = cvtpk(o[d0][r] * rl, 0.f); Ow[(unsigned)(orow * LDO + d0 * 32)] = (bf16)(w & 0xffffu); } }
  __syncthreads();
#undef SLOAD
#undef SWRITE
#undef SWAIT
#undef RESC
#undef PSM
#undef RSC
}
}
namespace hy {
#define HY_LAS __attribute__((address_space(3)))
typedef unsigned short bf16;
typedef short bf16x8 __attribute__((ext_vector_type(8)));
typedef float f32x16 __attribute__((ext_vector_type(16)));
typedef unsigned u32x2 __attribute__((ext_vector_type(2)));
typedef unsigned u32x4 __attribute__((ext_vector_type(4)));
constexpr int L = 2048, NB = 24, CH = 512;
constexpr int RFS = 4112;
constexpr int ZROW = 4112;
constexpr int ZL_BYTES = NB * ZROW;
constexpr int RCS = 8256;
constexpr int RC_OFF = ZL_BYTES;
constexpr int HY_LDS_BYTES = RC_OFF + 4 * RCS;
__device__ __forceinline__ unsigned cvtpk(float lo, float hi) { unsigned r; asm volatile("v_cvt_pk_bf16_f32 %0, %1, %2" : "=v"(r) : "v"(lo), "v"(hi)); return r; }
__host__ __device__ __forceinline__ int frag_base(int tw, int r, int h) { const int a = (4 - (r & 3)) & 3; return RC_OFF + a * RCS + 2 * (2048 - tw - r + 8 * h - a); }
__host__ __device__ __forceinline__ int zfrag_base(int r, int h) { return (r < NB ? r : NB - 1) * ZROW + 16 * h; }

__device__ __forceinline__ bf16x8 ld_frag(HY_LAS unsigned char* lds, int off) {
    const u32x2 lo = *(const HY_LAS u32x2*)(lds + off), hi = *(const HY_LAS u32x2*)(lds + off + 8);
    u32x4 w = {lo.x, lo.y, hi.x, hi.y}; return *reinterpret_cast<bf16x8*>(&w);
}
__device__ __forceinline__ bf16x8 ld_b128(HY_LAS unsigned char* lds, int off) { return *(const HY_LAS bf16x8*)(lds + off); }

__device__ __forceinline__ void conv_unit(HY_LAS unsigned char* lds, const bf16* __restrict__ ZT, const bf16* __restrict__ RF, bf16* __restrict__ YC, int c, int half) {
    const int tid = opq(threadIdx.x), wid = tid >> 6, lane = tid & 63, r = lane & 31, h = lane >> 5;
    { const u32x4* src = (const u32x4*)(ZT + (size_t)c * NB * L);
#pragma unroll
      for (int i = 0; i < 12; ++i) { const int q = tid + 512 * i; const u32x4 v = src[q]; *(HY_LAS u32x4*)(lds + (q >> 8) * ZROW + (q & 255) * 16) = v; } }
    { const bf16* rf = RF + (size_t)c * RFS;
      for (int ch = tid; ch < RFS / 8; ch += 512) {
          const u32x4 v = *(const u32x4*)(rf + ch * 8); const unsigned w[4] = {v.x, v.y, v.z, v.w};
#pragma unroll
          for (int j = 0; j < 8; ++j) { const unsigned short e = (unsigned short)((w[j >> 1] >> ((j & 1) * 16)) & 0xffffu); const int idx = ch * 8 + j;
#pragma unroll
              for (int a = 0; a < 4; ++a) if (idx - a >= 0) *(HY_LAS unsigned short*)(lds + RC_OFF + a * RCS + 2 * (idx - a)) = e; } } }
    __syncthreads();
    const int tw = half * 1024 + wid * 128;
    const int fb = frag_base(tw, r, h), zb = zfrag_base(r, h);
    f32x16 acc[4] = {};
    bf16x8 S0[2], S1[2], S2[2], S3[2], Bc[2], Bn[2];
#define HY_LDG(S, d) do { S[0] = ld_frag(lds, fb + 64 * (d)); S[1] = ld_frag(lds, fb + 64 * (d) + 32); } while (0)
#define HY_LDB(Bx, n) do { Bx[0] = ld_b128(lds, zb + 64 * (n)); Bx[1] = ld_b128(lds, zb + 64 * (n) + 32); } while (0)
#define HY_MM(i, S, Bx) do { acc[i] = __builtin_amdgcn_mfma_f32_32x32x16_bf16(S[0], Bx[0], acc[i], 0, 0, 0); acc[i] = __builtin_amdgcn_mfma_f32_32x32x16_bf16(S[1], Bx[1], acc[i], 0, 0, 0); } while (0)
#define HY_ITER(n, Sa, Sb, Sc, Sd, Bcur, Bnext) do { HY_LDG(Sa, (n)); if ((n) + 1 < 64) HY_LDB(Bnext, (n) + 1); \
        HY_MM(1, Sb, Bcur); HY_MM(2, Sc, Bcur); HY_MM(3, Sd, Bcur); HY_MM(0, Sa, Bcur); } while (0)
    HY_LDG(S3, -1); HY_LDG(S2, -2); HY_LDG(S1, -3); HY_LDB(Bc, 0);
    for (int n = 0; n < 64; n += 4) {
        HY_ITER(n, S0, S3, S2, S1, Bc, Bn);
        HY_ITER(n + 1, S1, S0, S3, S2, Bn, Bc);
        HY_ITER(n + 2, S2, S1, S0, S3, Bc, Bn);
        HY_ITER(n + 3, S3, S2, S1, S0, Bn, Bc);
    }
#undef HY_LDG
#undef HY_LDB
#undef HY_MM
#undef HY_ITER
    if (r < NB) { bf16* yp = YC + ((size_t)c * NB + r) * L + tw + 4 * h;
#pragma unroll
        for (int i = 0; i < 4; ++i)
#pragma unroll
            for (int q4 = 0; q4 < 4; ++q4) { u32x2 w; w.x = cvtpk(acc[i][4 * q4 + 0], acc[i][4 * q4 + 1]); w.y = cvtpk(acc[i][4 * q4 + 2], acc[i][4 * q4 + 3]);
                *(u32x2*)(yp + 32 * i + 8 * q4) = w; } }
    __syncthreads();
}
}
constexpr int NWAVES = 8;
#ifndef MK_ONE_LAUNCH
#define MK_ONE_LAUNCH 1
#endif
constexpr int DM = 2048, NSEQ = 24, SEQ = 2048, M = NSEQ * SEQ, MP = 8 * SEQ;
constexpr int DEPTH = 4;
constexpr int DIN = 2880, DINP = 3072;
constexpr int O_CQ = 512, O_CKV = 1024, O_KPE = 1280, O_HY = 1344;
constexpr int NH = 8, NQ = 1536, NKVP = 2560, KVHS = 320;
constexpr int DFF = 5632, NUP = 11264, HYC = 512;
constexpr float EPS = 1e-6f;
constexpr int NPH = 11;
constexpr size_t WS_CTL = 0, CTL_BYTES = 1u << 20;
constexpr size_t SZ_BTIN = (size_t)DINP * DM * 2, SZ_BTUQ = (size_t)NQ * 512 * 2, SZ_BTKV = (size_t)NKVP * 256 * 2, SZ_BTOUT = (size_t)DM * DM * 2, SZ_BTUP = (size_t)NUP * DM * 2, SZ_BTDN = (size_t)DM * DFF * 2;
constexpr size_t WS_BTIN = WS_CTL + CTL_BYTES, WS_BTUQ = WS_BTIN + SZ_BTIN, WS_BTKV = WS_BTUQ + SZ_BTUQ, WS_BTOUT = WS_BTKV + SZ_BTKV, WS_BTUP = WS_BTOUT + SZ_BTOUT, WS_BTDN = WS_BTUP + SZ_BTUP;
constexpr size_t WS_RF = WS_BTDN + SZ_BTDN, SZ_RF = (size_t)HYC * hy::RFS * 2;
constexpr size_t WS_H = WS_RF + SZ_RF, SZ_H = (size_t)M * DM * 2;
constexpr size_t WS_PROJ = WS_H + SZ_H, SZ_PROJ = (size_t)M * DINP * 2;
constexpr size_t WS_Q = WS_PROJ + SZ_PROJ, SZ_Q = (size_t)M * NQ * 2;
constexpr size_t WS_KV = WS_Q + SZ_Q, SZ_KV = (size_t)M * NKVP * 2;
constexpr size_t WS_ZT = WS_KV + SZ_KV, SZ_ZT = (size_t)HYC * NSEQ * SEQ * 2;
constexpr size_t WS_X0 = WS_ZT + SZ_ZT, WS_YC = WS_X0 + SZ_ZT;
constexpr size_t WS_EDGE = WS_YC + SZ_ZT, SZ_EDGE = (size_t)(M / 256) * 2 * 3 * DFF * 4;
constexpr size_t WS_ROPE = WS_EDGE + SZ_EDGE, SZ_ROPE = (size_t)SEQ * 64 * 4;
constexpr size_t WS_SSQP = WS_ROPE + SZ_ROPE, SZ_SSQP = (size_t)M * 32 * 4;
constexpr size_t WS_RSTD = WS_SSQP + SZ_SSQP, SZ_RSTD = (size_t)M * 4;
constexpr size_t WS_XQ = WS_RSTD + SZ_RSTD, SZ_XQ = (size_t)M * DM;
constexpr size_t WS_SSQCQ = WS_XQ + SZ_XQ, SZ_SSQCQ = (size_t)M * 8 * 4;
constexpr size_t WS_END = WS_SSQCQ + SZ_SSQCQ;
constexpr size_t WS_ACT = WS_PROJ;
static_assert((size_t)M * DFF * 2 <= SZ_PROJ + SZ_Q + SZ_KV, "ACT overlay");
constexpr size_t WS_XB2 = WS_ACT + (size_t)M * DFF * 2;
static_assert(WS_XB2 + (size_t)M * DM * 2 <= WS_EDGE && WS_XB2 % 256 == 0, "XB2 overlay");
static_assert(WS_BTIN % 256 == 0 && WS_RF % 256 == 0 && WS_H % 256 == 0 && WS_PROJ % 256 == 0 && WS_Q % 256 == 0 && WS_KV % 256 == 0 && WS_ZT % 256 == 0 && WS_EDGE % 256 == 0, "alignment");
constexpr int CW_WMAXC = 65536;
constexpr int CW_WMAX = 1024;
constexpr int CW_BAR = 4096;
constexpr int RING_BYTES = 135168;
constexpr int HALO_OFF = RING_BYTES, HALO_BYTES = 4096;
constexpr int MISC_OFF = HALO_OFF + HALO_BYTES;
constexpr int LDS_BYTES = 147456;
static_assert(hy::HY_LDS_BYTES <= RING_BYTES && at::SHM_ATTN <= RING_BYTES && MISC_OFF + 256 <= LDS_BYTES, "LDS map");

#define GAS __attribute__((address_space(1)))
#define LAS __attribute__((address_space(3)))
typedef unsigned short bf16;
typedef unsigned v4u __attribute__((ext_vector_type(4)));
typedef unsigned v2u __attribute__((ext_vector_type(2)));
typedef float f32x4 __attribute__((ext_vector_type(4)));
#define LDS_WAIT() asm volatile("s_waitcnt lgkmcnt(0)" ::: "memory")
__device__ __forceinline__ unsigned f2bf(float f) { unsigned u = __builtin_bit_cast(unsigned, f); return (u + 0x7fffu + ((u >> 16) & 1u)) >> 16; }
__device__ __forceinline__ unsigned pk2(float lo, float hi) { return f2bf(lo) | (f2bf(hi) << 16); }
__device__ __forceinline__ float bf2f(unsigned short b) { return __builtin_bit_cast(float, (unsigned)b << 16); }
__device__ __forceinline__ float bflo(unsigned w) { return __builtin_bit_cast(float, w << 16); }
__device__ __forceinline__ float bfhi(unsigned w) { return __builtin_bit_cast(float, w & 0xffff0000u); }
__device__ __forceinline__ float wave_sum(float v) {
#pragma unroll
    for (int o = 1; o < 64; o <<= 1) v += __shfl_xor(v, o);
    return v;
}

#define XB_TMO      128
#define XB_XCNT(j)  (256  + 64 * (j))
#define XB_XSUB(j)  (1280 + 64 * (j))
#define XB_XGEN(j)  (2304 + 64 * (j))
#define XB_TOP      3328
#define XB_TOPGEN   3392
#define XCD_BAR_WORDS 3456
#define XB_SPIN_CAP (1u << 18)
__device__ __forceinline__ unsigned xb_ld(unsigned* p)              { return __hip_atomic_load(p, __ATOMIC_RELAXED, __HIP_MEMORY_SCOPE_AGENT); }
__device__ __forceinline__ unsigned xb_add(unsigned* p, unsigned v) { return __hip_atomic_fetch_add(p, v, __ATOMIC_RELAXED, __HIP_MEMORY_SCOPE_AGENT); }
__device__ __forceinline__ unsigned xb_xcc_id() { return (unsigned)__builtin_amdgcn_s_getreg((3 << 11) | 20) & 0xFu; }
#define XB_SPIN(cond, bar) do { unsigned _sp = 0; while (cond) { __builtin_amdgcn_s_sleep(1); \
    if ((++_sp & 255u) == 0u) { if (xb_ld(&(bar)[XB_TMO])) break; if (_sp > XB_SPIN_CAP) { atomicAdd(&(bar)[XB_TMO], 1u); break; } } } } while (0)
struct XcdBarrier { unsigned* bar; unsigned x; volatile LAS unsigned* st; };
__device__ __forceinline__ XcdBarrier xcd_barrier_post(unsigned* bar, volatile LAS unsigned* st) {
    XcdBarrier b; b.bar = bar; b.x = xb_xcc_id(); b.st = st;
    if (threadIdx.x == 0) (void)xb_add(&bar[XB_XCNT(b.x)], 1u);
    return b;
}
__device__ __forceinline__ void xcd_barrier_complete(unsigned* bar, unsigned x, unsigned& nloc, unsigned& nx) {
    const unsigned G = gridDim.x * gridDim.y * gridDim.z;
    unsigned sum, cnt, mine, sp = 0u;
    for (;;) {
        sum = 0u; cnt = 0u; mine = 0u;
#pragma unroll
        for (unsigned j = 0; j < 16; ++j) { const unsigned c = xb_ld(&bar[XB_XCNT(j)]); sum += c; cnt += (c > 0u) ? 1u : 0u; mine = (j == x) ? c : mine; }
        if (sum == G) break;
        __builtin_amdgcn_s_sleep(1);
        if ((++sp & 255u) == 0u) { if (xb_ld(&bar[XB_TMO])) break; if (sp > XB_SPIN_CAP) { atomicAdd(&bar[XB_TMO], 1u); break; } }
    }
    nloc = mine > 0u ? mine : 1u; nx = cnt > 0u ? cnt : 1u;
}
__device__ __forceinline__ void xcd_barrier(const XcdBarrier& b) {
    asm volatile("s_waitcnt vmcnt(0)" ::: "memory");
    __syncthreads();
    if (threadIdx.x == 0) {
        unsigned* bar = b.bar;
        __builtin_amdgcn_s_waitcnt(0);
        unsigned nloc = b.st[0], nx = b.st[1];
        if (nloc == 0u) { xcd_barrier_complete(bar, b.x, nloc, nx); b.st[0] = nloc; b.st[1] = nx; }
        const unsigned old = xb_add(&bar[XB_XSUB(b.x)], 1u);
        const unsigned gen = old / nloc;
        if (old + 1u == (gen + 1u) * nloc) {
            __builtin_amdgcn_fence(__ATOMIC_RELEASE, "agent");
            asm volatile("s_waitcnt vmcnt(0)" ::: "memory");
            const unsigned og = xb_add(&bar[XB_TOP], 1u);
            const unsigned tg = og / nx;
            if (og + 1u == (tg + 1u) * nx) xb_add(&bar[XB_TOPGEN], 1u);
            else XB_SPIN(xb_ld(&bar[XB_TOPGEN]) == tg, bar);
            __builtin_amdgcn_fence(__ATOMIC_ACQUIRE, "agent");
            xb_add(&bar[XB_XGEN(b.x)], 1u);
            asm volatile("s_waitcnt vmcnt(0)" ::: "memory");
        } else {
            XB_SPIN(xb_ld(&bar[XB_XGEN(b.x)]) == gen, bar);
            __builtin_amdgcn_fence(__ATOMIC_ACQUIRE, "agent");
            asm volatile("s_waitcnt vmcnt(0)" ::: "memory");
        }
    }
    __syncthreads();
}

struct Frame {
    LAS unsigned char* lds;
    int tid, lane, wave, vcu, G;
};
enum { I_XP = 0, I_XS, I_ANG, I_WIN, I_PW, I_PS, I_QNG, I_WUQ, I_KVNG, I_WUKV, I_QHG, I_KHG, I_HCW, I_HCB, I_FW1, I_FB1, I_FFR, I_FW2, I_FB2, I_FW3, I_FB3, I_HBIAS, I_GNG, I_WOUT, I_FNG, I_WUP, I_FCW, I_FCB, I_WDN, N_IN };
struct Args { const float* in[N_IN]; float* out; unsigned char* ws; int ph_lo, ph_hi; };
static_assert(sizeof(Args) == (N_IN + 2) * 8 + 8, "Args has no padding");

__device__ __forceinline__ void cvt_item(const float* __restrict__ W, int ldw, int K, bf16* WT, int dst_n0, int src_n0, int k0, const float* __restrict__ ks, LAS float* scr, int lane) {
#pragma unroll
    for (int i = 0; i < 32; ++i) { const int kk = 2 * i + (lane >> 5); float v = W[(size_t)(k0 + kk) * ldw + src_n0 + (lane & 31)]; if (ks) v *= ks[k0 + kk]; scr[kk * 33 + (lane & 31)] = v; }
    LDS_WAIT(); asm volatile("" ::: "memory");
    const int c = lane & 7;
#pragma unroll
    for (int j = 0; j < 4; ++j) { const int n = (lane >> 3) + 8 * j; const LAS float* s = scr + (8 * c) * 33 + n;
        v4u o; o.x = pk2(s[0 * 33], s[1 * 33]); o.y = pk2(s[2 * 33], s[3 * 33]); o.z = pk2(s[4 * 33], s[5 * 33]); o.w = pk2(s[6 * 33], s[7 * 33]);
        *(v4u*)(WT + (size_t)(dst_n0 + n) * K + k0 + 8 * c) = o; }
    LDS_WAIT(); asm volatile("" ::: "memory");
}
struct CvtTile { const float* W; const float* ks; bf16* WT; int ldw, K, src_n0, k0, ncols; int dst[4]; };
__device__ __forceinline__ void cvt_tile(Frame& F, const CvtTile& d) {
    LAS float* T = (LAS float*)F.lds;
#pragma unroll
    for (int i = 0; i < 8; ++i) { const int q = F.tid + 512 * i, row = q >> 5, c4 = q & 31;
        f32x4 v = {0.f, 0.f, 0.f, 0.f};
        if (d.src_n0 + 4 * c4 < d.ncols) v = *(const f32x4*)(d.W + (size_t)(d.k0 + row) * d.ldw + d.src_n0 + 4 * c4);
        if (d.ks) v *= d.ks[d.k0 + row];
        LAS float* t = T + row * 129 + 4 * c4; t[0] = v.x; t[1] = v.y; t[2] = v.z; t[3] = v.w; }
    __syncthreads();
#pragma unroll
    for (int i = 0; i < 4; ++i) { const int n = (F.tid >> 4) + 32 * i, kc = F.tid & 15;
        if (d.src_n0 + n < d.ncols) { const LAS float* s = T + (8 * kc) * 129 + n;
            v4u o; o.x = pk2(s[0], s[129]); o.y = pk2(s[2 * 129], s[3 * 129]); o.z = pk2(s[4 * 129], s[5 * 129]); o.w = pk2(s[6 * 129], s[7 * 129]);
            *(v4u*)(d.WT + (size_t)(d.dst[i] + (n & 31)) * d.K + d.k0 + 8 * kc) = o; } }
    __syncthreads();
}
__device__ __forceinline__ void absmax_tile(Frame& F, const float* __restrict__ W, const float* __restrict__ ks, int ldw, int src_n0, int k0, unsigned* outc) {
    LAS float* P = (LAS float*)F.lds;
    f32x4 m = {0.f, 0.f, 0.f, 0.f};
#pragma unroll
    for (int i = 0; i < 8; ++i) { const int q = F.tid + 512 * i, row = q >> 5, c4 = q & 31;
        const f32x4 v = *(const f32x4*)(W + (size_t)(k0 + row) * ldw + src_n0 + 4 * c4) * ks[k0 + row];
        m.x = fmaxf(m.x, fabsf(v.x)); m.y = fmaxf(m.y, fabsf(v.y)); m.z = fmaxf(m.z, fabsf(v.z)); m.w = fmaxf(m.w, fabsf(v.w)); }
    *(LAS f32x4*)(P + (F.tid >> 5) * 128 + 4 * (F.tid & 31)) = m;
    __syncthreads();
    if (F.tid < 128) { float c = P[F.tid];
#pragma unroll
        for (int g = 1; g < 16; ++g) c = fmaxf(c, P[g * 128 + F.tid]);
        atomicMax(outc + src_n0 + F.tid, __builtin_bit_cast(unsigned, c)); }
    __syncthreads();
}
__device__ __forceinline__ unsigned q8(float v) { const int q = (int)__builtin_rintf(v); return (unsigned)(q < -127 ? -127 : (q > 127 ? 127 : q)) & 0xffu; }
__device__ __forceinline__ void cvtq_tile(Frame& F, const float* __restrict__ W, const float* __restrict__ ks, int ldw, int K, unsigned char* WT, int src_n0, int k0, int dst0, const unsigned* __restrict__ wmaxc) {
    LAS float* T = (LAS float*)F.lds;
    f32x4 inv4; { const v4u mb = *(const v4u*)(wmaxc + src_n0 + 4 * (F.tid & 31));
        inv4.x = 127.0f / fmaxf(__builtin_bit_cast(float, mb.x), 1e-30f); inv4.y = 127.0f / fmaxf(__builtin_bit_cast(float, mb.y), 1e-30f); inv4.z = 127.0f / fmaxf(__builtin_bit_cast(float, mb.z), 1e-30f); inv4.w = 127.0f / fmaxf(__builtin_bit_cast(float, mb.w), 1e-30f); }
#pragma unroll
    for (int i = 0; i < 8; ++i) { const int q = F.tid + 512 * i, row = q >> 5, c4 = q & 31;
        const f32x4 v = *(const f32x4*)(W + (size_t)(k0 + row) * ldw + src_n0 + 4 * c4) * ks[k0 + row] * inv4;
        LAS float* t = T + row * 129 + 4 * c4; t[0] = v.x; t[1] = v.y; t[2] = v.z; t[3] = v.w; }
    __syncthreads();
#pragma unroll
    for (int i = 0; i < 2; ++i) { const int n = (F.tid >> 3) + 64 * i, kc = F.tid & 7;
        const LAS float* s = T + (16 * kc) * 129 + n; unsigned w[4];
#pragma unroll
        for (int j = 0; j < 4; ++j) w[j] = q8(s[(4 * j) * 129]) | (q8(s[(4 * j + 1) * 129]) << 8) | (q8(s[(4 * j + 2) * 129]) << 16) | (q8(s[(4 * j + 3) * 129]) << 24);
        v4u o; o.x = w[0]; o.y = w[1]; o.z = w[2]; o.w = w[3];
        *(v4u*)(WT + (size_t)(dst0 + 64 * (n >> 5) + (n & 31)) * K + k0 + 16 * kc) = o; }
    __syncthreads();
}
__device__ __forceinline__ void xq_row(const bf16* __restrict__ xrow, unsigned char* qrow, const float* __restrict__ ssq32, float* rowf, float s_w, int lane) {
    v4u v[4]; float m = 0.f;
#pragma unroll
    for (int j = 0; j < 4; ++j) { v[j] = *(const v4u*)(xrow + 8 * (lane + 64 * j)); const unsigned w[4] = {v[j].x, v[j].y, v[j].z, v[j].w};
#pragma unroll
        for (int i = 0; i < 4; ++i) m = fmaxf(m, fmaxf(fabsf(bflo(w[i])), fabsf(bfhi(w[i])))); }
    float ss = (lane < 32) ? ssq32[lane] : 0.f;
#pragma unroll
    for (int o = 1; o < 64; o <<= 1) { m = fmaxf(m, __shfl_xor(m, o)); ss += __shfl_xor(ss, o); }
    m = fmaxf(m, 1e-30f); const float inv = 127.0f / m;
    if (lane == 0) *rowf = (1.0f / sqrtf(ss * (1.f / DM) + EPS)) * (m * (1.0f / 127.0f)) * s_w;
#pragma unroll
    for (int j = 0; j < 4; ++j) { const unsigned w[4] = {v[j].x, v[j].y, v[j].z, v[j].w}; v2u o;
        o.x = q8(bflo(w[0]) * inv) | (q8(bfhi(w[0]) * inv) << 8) | (q8(bflo(w[1]) * inv) << 16) | (q8(bfhi(w[1]) * inv) << 24);
        o.y = q8(bflo(w[2]) * inv) | (q8(bfhi(w[2]) * inv) << 8) | (q8(bflo(w[3]) * inv) << 16) | (q8(bfhi(w[3]) * inv) << 24);
        *(v2u*)(qrow + 8 * (lane + 64 * j)) = o; }
}
__device__ __forceinline__ void xb_row(const float* xrow, bf16* orow, float* rstd, int lane) {
    const f32x4* xr = (const f32x4*)xrow + lane;
    f32x4 v[8]; float s = 0.f;
#pragma unroll
    for (int j = 0; j < 8; ++j) { v[j] = xr[64 * j]; s += (v[j].x * v[j].x + v[j].y * v[j].y) + (v[j].z * v[j].z + v[j].w * v[j].w); }
    const float r = 1.0f / sqrtf(wave_sum(s) * (1.f / DM) + EPS);
    if (lane == 0) *rstd = r;
    v2u* o8 = (v2u*)orow + lane;
#pragma unroll
    for (int j = 0; j < 8; ++j) { v2u w; w.x = pk2(v[j].x, v[j].y); w.y = pk2(v[j].z, v[j].w); o8[64 * j] = w; }
}
__device__ __forceinline__ void rstd_from_partials(const float* __restrict__ ssqp, float* rstd, size_t gtid, size_t gthreads) {
    for (size_t r = gtid; r < (size_t)M; r += gthreads) { const f32x4* p = (const f32x4*)(ssqp + r * 32); f32x4 a = p[0];
#pragma unroll
        for (int i = 1; i < 8; ++i) a += p[i];
        rstd[r] = 1.0f / sqrtf(((a.x + a.y) + (a.z + a.w)) * (1.f / DM) + EPS); }
}
__device__ __forceinline__ void tile_norm_store(LAS float* tile, bf16* dst, int row0, int col_off, int wave, int lane) {
#pragma unroll
    for (int i = 0; i < 8; ++i) { const int t = wave * 8 + i;
        const f32x4 a = *(LAS f32x4*)(tile + t * 512 + 8 * lane), b = *(LAS f32x4*)(tile + t * 512 + 8 * lane + 4);
        const float s = (a.x * a.x + a.y * a.y) + (a.z * a.z + a.w * a.w) + (b.x * b.x + b.y * b.y) + (b.z * b.z + b.w * b.w);
        const float rstd = 1.0f / sqrtf(wave_sum(s) * (1.f / 512.f) + EPS);
        v4u o; o.x = pk2(a.x * rstd, a.y * rstd); o.y = pk2(a.z * rstd, a.w * rstd); o.z = pk2(b.x * rstd, b.y * rstd); o.w = pk2(b.z * rstd, b.w * rstd);
        *(v4u*)(dst + (size_t)(row0 + t) * DM + col_off + 8 * lane) = o; }
}
__device__ __forceinline__ void poolfold_item(Frame& F, const float* __restrict__ win, const float* __restrict__ pw, const float* __restrict__ ps, const float* __restrict__ g1, bf16* BtIn, int g, int kb) {
    LAS float* At = (LAS float*)F.lds; LAS float* Bt = (LAS float*)(F.lds + 32768);
    const int k0 = 64 * kb;
#pragma unroll
    for (int i = 0; i < 4; ++i) { const int q = F.tid + 512 * i, row = q >> 5, c4 = q & 31; *(LAS f32x4*)(At + row * 128 + 4 * c4) = *(const f32x4*)(win + (size_t)(k0 + row) * DIN + 128 * g + 4 * c4) * g1[k0 + row]; }
#pragma unroll
    for (int i = 0; i < 8; ++i) { const int q = F.tid + 512 * i, row = q >> 5, c4 = q & 31; *(LAS f32x4*)(Bt + row * 128 + 4 * c4) = *(const f32x4*)(pw + (size_t)(g * 128 + row) * 128 + 4 * c4); }
    __syncthreads();
    const int n = F.tid & 127, kg = F.tid >> 7;
    float acc[16];
#pragma unroll
    for (int i = 0; i < 16; ++i) acc[i] = 0.f;
    for (int j = 0; j < 128; j += 4) {
        const float b0 = Bt[(j + 0) * 128 + n], b1 = Bt[(j + 1) * 128 + n], b2 = Bt[(j + 2) * 128 + n], b3 = Bt[(j + 3) * 128 + n];
#pragma unroll
        for (int i = 0; i < 16; ++i) { const f32x4 a = *(LAS f32x4*)(At + (kg * 16 + i) * 128 + j); acc[i] += a.x * b0 + a.y * b1 + a.z * b2 + a.w * b3; }
    }
    const float sc = ps[128 * g + n];
    v4u o0, o1;
    o0.x = pk2(acc[0] * sc, acc[1] * sc); o0.y = pk2(acc[2] * sc, acc[3] * sc); o0.z = pk2(acc[4] * sc, acc[5] * sc); o0.w = pk2(acc[6] * sc, acc[7] * sc);
    o1.x = pk2(acc[8] * sc, acc[9] * sc); o1.y = pk2(acc[10] * sc, acc[11] * sc); o1.z = pk2(acc[12] * sc, acc[13] * sc); o1.w = pk2(acc[14] * sc, acc[15] * sc);
    bf16* dst = BtIn + (size_t)(128 * g + n) * DM + k0 + kg * 16;
    *(v4u*)dst = o0; *(v4u*)(dst + 8) = o1;
    __syncthreads();
}
__device__ __forceinline__ void filter_item(Frame& F, const float* __restrict__ w1, const float* __restrict__ b1, const float* __restrict__ fr, const float* __restrict__ w2, const float* __restrict__ b2,
                                            const float* __restrict__ w3, const float* __restrict__ b3, const float* __restrict__ hbias, bf16* RF, int fi) {
    LAS float* ZF = (LAS float*)F.lds; LAS float* H1 = ZF + 512; LAS float* H2 = ZF + 1536; LAS float* W1s = ZF + 2560; LAS float* W2s = ZF + 3712;
    const int t0 = 16 * fi;
    for (int q = F.tid; q < 272; q += 512) *(LAS f32x4*)(W1s + 4 * q) = *(const f32x4*)(w1 + 4 * q);
#pragma unroll
    for (int i = 0; i < 2; ++i) { const int q = F.tid + 512 * i; *(LAS f32x4*)(W2s + 4 * q) = *(const f32x4*)(w2 + 4 * q); }
    if (F.tid < 272) { const int tt = F.tid / 17, f = F.tid % 17; const float t = (float)(t0 + tt);
        float v;
        if (f == 0) v = t / 2047.0f;
        else { const int j = (f - 1) & 7; const float band = 1e-4f + (float)j * ((7.0f - 1e-4f) / 7.0f); const float w = (6.283185307179586f * t) / 2048.0f; const float a = band * w; v = (f <= 8) ? __cosf(a) : -__sinf(a); }
        ZF[tt * 17 + f] = v; }
    __syncthreads();
#pragma unroll
    for (int rep = 0; rep < 2; ++rep) { const int p = F.tid + 512 * rep, tt = p >> 6, j = p & 63; float s = b1[j];
#pragma unroll
        for (int i = 0; i < 17; ++i) s += ZF[tt * 17 + i] * W1s[i * 64 + j];
        H1[tt * 64 + j] = __sinf(fr[j] * s); }
    __syncthreads();
#pragma unroll
    for (int rep = 0; rep < 2; ++rep) { const int p = F.tid + 512 * rep, tt = p >> 6, j = p & 63; float s = b2[j];
#pragma unroll 16
        for (int i = 0; i < 64; ++i) s += H1[tt * 64 + i] * W2s[i * 64 + j];
        H2[tt * 64 + j] = __sinf(fr[j] * s); }
    __syncthreads();
    const int c = F.tid;
    const float delta = -3.0701134573253944f + (float)c * ((-15.350567286626972f + 3.0701134573253944f) / 511.0f);
    const float ad = fabsf(delta);
    bf16* rf = RF + (size_t)c * hy::RFS;
#pragma unroll 1
    for (int dir = 0; dir < 2; ++dir) { const int o = dir * 512 + c; const float bo = b3[o];
        float wc[64];
#pragma unroll
        for (int i = 0; i < 64; ++i) wc[i] = w3[i * 1024 + o];
#pragma unroll 1
        for (int tt = 0; tt < 16; ++tt) { float s = bo;
#pragma unroll
            for (int i = 0; i < 64; i += 4) { const f32x4 hv = *(LAS f32x4*)(H2 + tt * 64 + i); s += (hv.x * wc[i] + hv.y * wc[i + 1]) + (hv.z * wc[i + 2] + hv.w * wc[i + 3]); }
            const int t = t0 + tt; const float tl = (float)t / 2047.0f; float val = s * __expf(-tl * ad);
            if (dir == 0) { if (t == 0) val += hbias[c]; rf[2048 - t] = (bf16)f2bf(val); }
            else if (t >= 1) rf[2048 + t] = (bf16)f2bf(val); } }
    if (fi == 0) { rf[0] = 0;
#pragma unroll
        for (int i = 4096; i < hy::RFS; ++i) rf[i] = 0; }
    __syncthreads();
}
__device__ __forceinline__ void unpack4(const v2u w, float (&x)[4]) { x[0] = bflo(w.x); x[1] = bfhi(w.x); x[2] = bflo(w.y); x[3] = bfhi(w.y); }
__device__ __forceinline__ void pair_norm_store(Frame& F, const float (&y)[8][4], bf16* dst, size_t row0, int col_off, int cq) {
    LAS float* part = (LAS float*)F.lds;
    float ss[8];
#pragma unroll
    for (int k = 0; k < 8; ++k) ss[k] = wave_sum((y[k][0] * y[k][0] + y[k][1] * y[k][1]) + (y[k][2] * y[k][2] + y[k][3] * y[k][3]));
    if (F.lane == 0) { *(LAS f32x4*)(part + F.wave * 8) = (f32x4){ss[0], ss[1], ss[2], ss[3]}; *(LAS f32x4*)(part + F.wave * 8 + 4) = (f32x4){ss[4], ss[5], ss[6], ss[7]}; }
    __syncthreads();
    const f32x4 pa = *(LAS f32x4*)(part + (F.wave ^ 1) * 8), pb = *(LAS f32x4*)(part + (F.wave ^ 1) * 8 + 4);
    const float po[8] = {pa.x, pa.y, pa.z, pa.w, pb.x, pb.y, pb.z, pb.w};
#pragma unroll
    for (int k = 0; k < 8; ++k) { const float rstd = 1.0f / sqrtf((ss[k] + po[k]) * (1.f / 512.f) + EPS);
        v2u o; o.x = pk2(y[k][0] * rstd, y[k][1] * rstd); o.y = pk2(y[k][2] * rstd, y[k][3] * rstd);
        *(v2u*)(dst + (row0 + k) * DM + col_off + 4 * cq) = o; }
    __syncthreads();
}
__device__ __forceinline__ void hyprep_item(Frame& F, const bf16* __restrict__ PROJ, const float* __restrict__ cw, const float* __restrict__ cb, bf16* ZT, bf16* X0, int b, int tile) {
    const int tb = F.tid >> 7, cq = F.tid & 127, c0 = 4 * cq, tw = tile * 32 + tb * 8; const size_t rb = (size_t)b * SEQ;
    float z[8][4];
    v2u rh[3][10];
#pragma unroll
    for (int j = 0; j < 3; ++j)
#pragma unroll
        for (int o = 0; o < 10; ++o) { const int t = tw - 1 + o; const int tc = ((t >= 0) && (t < SEQ)) ? t : tw; rh[j][o] = *(const v2u*)(PROJ + (rb + tc) * DINP + O_HY + 512 * j + c0); }
#pragma unroll
    for (int jj = 0; jj < 3; ++jj) { const int j = (jj == 0) ? 1 : (jj == 1) ? 2 : 0; const int cc = 512 * j + c0;
        const f32x4 w0 = *(const f32x4*)(cw + cc), w1 = *(const f32x4*)(cw + 1536 + cc), w2 = *(const f32x4*)(cw + 3072 + cc), bs = *(const f32x4*)(cb + cc);
        float x[10][4];
#pragma unroll
        for (int o = 0; o < 10; ++o) { const int t = tw - 1 + o; const bool ok = (t >= 0) && (t < SEQ); unpack4(rh[j][o], x[o]);
            if (!ok) { x[o][0] = 0.f; x[o][1] = 0.f; x[o][2] = 0.f; x[o][3] = 0.f; } }
        if (jj == 0) {
#pragma unroll
            for (int k = 0; k < 8; ++k)
#pragma unroll
                for (int i = 0; i < 4; ++i) z[k][i] = w0[i] * x[k][i] + w1[i] * x[k + 1][i] + w2[i] * x[k + 2][i] + bs[i];
        } else if (jj == 1) {
#pragma unroll
            for (int k = 0; k < 8; ++k)
#pragma unroll
                for (int i = 0; i < 4; ++i) z[k][i] *= w0[i] * x[k][i] + w1[i] * x[k + 1][i] + w2[i] * x[k + 2][i] + bs[i];
#pragma unroll
            for (int i = 0; i < 4; ++i) { v4u o; o.x = pk2(z[0][i], z[1][i]); o.y = pk2(z[2][i], z[3][i]); o.z = pk2(z[4][i], z[5][i]); o.w = pk2(z[6][i], z[7][i]);
                *(v4u*)(ZT + ((size_t)(c0 + i) * NSEQ + b) * SEQ + tw) = o; }
        } else {
#pragma unroll
            for (int k = 0; k < 8; ++k) { float u0[4];
#pragma unroll
                for (int i = 0; i < 4; ++i) u0[i] = w0[i] * x[k][i] + w1[i] * x[k + 1][i] + w2[i] * x[k + 2][i] + bs[i];
                v2u o; o.x = pk2(u0[0], u0[1]); o.y = pk2(u0[2], u0[3]); *(v2u*)(X0 + (rb + tw + k) * HYC + c0) = o; }
        }
    }
}
__device__ __forceinline__ void pool_item(Frame& F, const bf16* __restrict__ PROJ, bf16* MIXED, int b, int tile) {
    const int tb = F.tid >> 7, cq = F.tid & 127, c0 = 4 * cq, g = cq >> 5, half = 1 << g, tw = tile * 32 + tb * 8; const size_t rb = (size_t)b * SEQ;
    float x[23][4];
#pragma unroll
    for (int o = 0; o < 23; ++o) { const int t = tw - 8 + o; const bool ok = (t >= 0) && (t < SEQ); const int tc = ok ? t : tw;
        const v2u w = *(const v2u*)(PROJ + (rb + tc) * DINP + c0); unpack4(w, x[o]);
        if (!ok) { x[o][0] = 0.f; x[o][1] = 0.f; x[o][2] = 0.f; x[o][3] = 0.f; } }
    float y[8][4];
#pragma unroll
    for (int k = 0; k < 8; ++k) { const int oc = 8 + k, t = tw + k; const int lo = (t - half > 0) ? t - half : 0, hi = (t + half < SEQ) ? t + half : SEQ; const float inv = 1.0f / (float)(hi - lo);
#pragma unroll
        for (int i = 0; i < 4; ++i) {
            const float w1 = x[oc - 1][i] + x[oc][i];
            const float w2 = w1 + (x[oc - 2][i] + x[oc + 1][i]);
            const float w4 = w2 + ((x[oc - 4][i] + x[oc - 3][i]) + (x[oc + 2][i] + x[oc + 3][i]));
            const float w8 = w4 + (((x[oc - 8][i] + x[oc - 7][i]) + (x[oc - 6][i] + x[oc - 5][i])) + ((x[oc + 4][i] + x[oc + 5][i]) + (x[oc + 6][i] + x[oc + 7][i])));
            const float S = (g == 0) ? w1 : (g == 1) ? w2 : (g == 2) ? w4 : w8;
            y[k][i] = S * inv - x[oc][i]; } }
    pair_norm_store(F, y, MIXED, rb + tw, 0, cq);
}
__device__ __forceinline__ void hyfin_item(Frame& F, const bf16* __restrict__ YC, const bf16* __restrict__ X0, bf16* MIXED, int b, int tile) {
    const int tb = F.tid >> 7, cq = F.tid & 127, c0 = 4 * cq, tw = tile * 32 + tb * 8; const size_t rb = (size_t)b * SEQ;
    float yc[4][8], y[8][4];
#pragma unroll
    for (int i = 0; i < 4; ++i) { const v4u v = *(const v4u*)(YC + ((size_t)(c0 + i) * NSEQ + b) * SEQ + tw);
        yc[i][0] = bflo(v.x); yc[i][1] = bfhi(v.x); yc[i][2] = bflo(v.y); yc[i][3] = bfhi(v.y); yc[i][4] = bflo(v.z); yc[i][5] = bfhi(v.z); yc[i][6] = bflo(v.w); yc[i][7] = bfhi(v.w); }
#pragma unroll
    for (int k = 0; k < 8; ++k) { float xv[4]; unpack4(*(const v2u*)(X0 + (rb + tw + k) * HYC + c0), xv);
#pragma unroll
        for (int i = 0; i < 4; ++i) y[k][i] = yc[i][k] * xv[i]; }
    pair_norm_store(F, y, MIXED, rb + tw, 1536, cq);
}
struct PrepGains { float q[3][8], k[3][8]; };
__device__ __forceinline__ void load8(const float* p, float (&o)[8]) { const f32x4 a = *(const f32x4*)p, b = *(const f32x4*)(p + 4); o[0] = a.x; o[1] = a.y; o[2] = a.z; o[3] = a.w; o[4] = b.x; o[5] = b.y; o[6] = b.z; o[7] = b.w; }
__device__ __forceinline__ void unpack8(const v4u w, float (&x)[8]) { x[0] = bflo(w.x); x[1] = bfhi(w.x); x[2] = bflo(w.y); x[3] = bfhi(w.y); x[4] = bflo(w.z); x[5] = bfhi(w.z); x[6] = bflo(w.w); x[7] = bfhi(w.w); }
__device__ __forceinline__ v4u pack8(const float (&x)[8]) { v4u o; o.x = pk2(x[0], x[1]); o.y = pk2(x[2], x[3]); o.z = pk2(x[4], x[5]); o.w = pk2(x[6], x[7]); return o; }
__device__ __forceinline__ float ssq8(const float (&x)[8]) { return ((x[0] * x[0] + x[1] * x[1]) + (x[2] * x[2] + x[3] * x[3])) + ((x[4] * x[4] + x[5] * x[5]) + (x[6] * x[6] + x[7] * x[7])); }
__device__ __forceinline__ float sum8lanes(float v) { v += __shfl_xor(v, 1); v += __shfl_xor(v, 2); v += __shfl_xor(v, 4); return v; }
__device__ __forceinline__ void prep_row(const bf16* __restrict__ PROJ, bf16* Q, bf16* KV, const PrepGains& G, const float* __restrict__ ROPE, int m, int lane) {
    const int h = lane >> 3, sub = lane & 7;
    const bf16* pr = PROJ + (size_t)m * DINP; bf16* qr = Q + (size_t)m * NQ + 192 * h + 8 * sub; bf16* kr = KV + (size_t)m * NKVP + KVHS * h + 8 * sub;
    const v4u pev = *(const v4u*)(pr + O_KPE + 8 * sub);
    const v4u k0 = *(const v4u*)(kr), k1 = *(const v4u*)(kr + 64);
    float cs[8], sn[8]; { const float* rp = ROPE + (size_t)(m & (SEQ - 1)) * 64 + 8 * (sub & 3); load8(rp, cs); load8(rp + 32, sn); }
    const float sg = (sub < 4) ? -1.f : 1.f;
    { float a0[8], a1[8], pe[8]; unpack8(k0, a0); unpack8(k1, a1); unpack8(pev, pe);
      const float ss = sum8lanes((ssq8(a0) + ssq8(a1)) + ssq8(pe));
      const float sk = 1.0f / sqrtf(ss * (1.f / 192.f) + EPS);
      float r[8], o[8];
#pragma unroll
      for (int i = 0; i < 8; ++i) { a0[i] *= sk * G.k[0][i]; a1[i] *= sk * G.k[1][i]; r[i] = pe[i] * sk * G.k[2][i]; }
#pragma unroll
      for (int i = 0; i < 8; ++i) { const float rp = __shfl_xor(r[i], 4); o[i] = r[i] * cs[i] + sg * rp * sn[i]; }
      *(v4u*)(kr) = pack8(a0); *(v4u*)(kr + 64) = pack8(a1); *(v4u*)(kr + 128) = pack8(o); }
}
__device__ __forceinline__ void attn_norm_row(bf16* MIXED, int m, int lane) {
    v4u* p = (v4u*)(MIXED + (size_t)m * DM + 512 + 16 * lane); v4u a = p[0], b = p[1];
    unsigned w[8] = {a.x, a.y, a.z, a.w, b.x, b.y, b.z, b.w}; float s = 0.f;
#pragma unroll
    for (int i = 0; i < 8; ++i) { const float x = bflo(w[i]), y = bfhi(w[i]); s += x * x + y * y; }
    const float rstd = 1.0f / sqrtf(wave_sum(s) * (1.f / 1024.f) + EPS);
#pragma unroll
    for (int i = 0; i < 8; ++i) w[i] = pk2(bflo(w[i]) * rstd, bfhi(w[i]) * rstd);
    a.x = w[0]; a.y = w[1]; a.z = w[2]; a.w = w[3]; b.x = w[4]; b.y = w[5]; b.z = w[6]; b.w = w[7]; p[0] = a; p[1] = b;
}

#define DEFPTRS() unsigned char* ws = args.ws; \
    bf16* BtIn = (bf16*)(ws + WS_BTIN); bf16* BtUq = (bf16*)(ws + WS_BTUQ); bf16* BtKv = (bf16*)(ws + WS_BTKV); bf16* BtOut = (bf16*)(ws + WS_BTOUT); bf16* BtUp = (bf16*)(ws + WS_BTUP); bf16* BtDn = (bf16*)(ws + WS_BTDN); \
    bf16* RF = (bf16*)(ws + WS_RF); bf16* Hb = (bf16*)(ws + WS_H); bf16* PROJ = (bf16*)(ws + WS_PROJ); bf16* Qb = (bf16*)(ws + WS_Q); bf16* KVb = (bf16*)(ws + WS_KV); \
    bf16* ZT = (bf16*)(ws + WS_ZT); bf16* X0 = (bf16*)(ws + WS_X0); bf16* YC = (bf16*)(ws + WS_YC); float* EDGE = (float*)(ws + WS_EDGE); float* ROPE = (float*)(ws + WS_ROPE); float* SSQP = (float*)(ws + WS_SSQP); float* RSTD = (float*)(ws + WS_RSTD); bf16* XB2 = (bf16*)(ws + WS_XB2); unsigned char* XQ = (unsigned char*)(ws + WS_XQ); float* SSQCQ = (float*)(ws + WS_SSQCQ); unsigned char* BtUpQ = (unsigned char*)(ws + WS_BTUP); bf16* ACT = (bf16*)(ws + WS_ACT); \
    bf16* XA = (bf16*)args.out; \
    (void)BtIn; (void)BtUq; (void)BtKv; (void)BtOut; (void)BtUp; (void)BtDn; (void)RF; (void)Hb; (void)PROJ; (void)Qb; (void)KVb; (void)ZT; (void)X0; (void)YC; (void)EDGE; (void)ROPE; (void)SSQP; (void)RSTD; (void)XB2; (void)XQ; (void)SSQCQ; (void)BtUpQ; (void)ACT; (void)XA
__global__ void __launch_bounds__(NWAVES * 64, 2) fwd(Args args) {
    extern __shared__ __attribute__((aligned(16))) unsigned char lds_raw[];
    Frame F;
    F.lds = (LAS unsigned char*)lds_raw;
    F.tid = threadIdx.x; F.lane = F.tid & 63; F.wave = __builtin_amdgcn_readfirstlane(F.tid >> 6);
    F.G = gridDim.x; { const int bx = blockIdx.x; F.vcu = (F.G % 8 == 0) ? (bx % 8) * (F.G / 8) + bx / 8 : bx; }
    volatile LAS unsigned* MISC = (volatile LAS unsigned*)(F.lds + MISC_OFF);
    if (F.tid < 64) MISC[F.tid] = 0u;
    __syncthreads();
    unsigned* ctl = (unsigned*)(args.ws + WS_CTL);
    const int lo = args.ph_lo, hi = args.ph_hi;
    XcdBarrier bar; bar.bar = ctl + CW_BAR; bar.x = 0; bar.st = MISC + 8;
    if (hi - lo > 1) bar = xcd_barrier_post(ctl + CW_BAR, MISC + 8);
    float* out = args.out;

#pragma unroll 1
    for (int layer = 0; layer < DEPTH; ++layer) {
        const int pb = layer * NPH;
        if (pb + NPH <= lo || pb >= hi) continue;
#define IN(k) (lo <= pb + (k) && pb + (k) < hi)
#define ENTER() DEFPTRS(); F.tid = opq(threadIdx.x); F.lane = F.tid & 63; F.wave = __builtin_amdgcn_readfirstlane(F.tid >> 6); const int gw = F.vcu * NWAVES + F.wave, NGW = F.G * NWAVES, wg = F.vcu; const size_t gtid = (size_t)wg * 512 + F.tid, gthreads = (size_t)F.G * 512; (void)gw; (void)NGW; (void)wg; (void)gtid; (void)gthreads
#define SEAM(k) do { if (pb + (k) + 1 < hi) xcd_barrier(bar); } while (0)

        if (IN(0)) { ENTER();
            const float* win = args.in[I_WIN] + (size_t)layer * DM * DIN; const float* g1 = args.in[I_ANG] + layer * DM;
            for (int it = wg; it < 256; it += F.G) {
                if (it < 128) poolfold_item(F, win, args.in[I_PW] + (size_t)layer * 4 * 128 * 128, args.in[I_PS] + (size_t)layer * 512, g1, BtIn, it >> 5, it & 31);
                else filter_item(F, args.in[I_FW1] + (size_t)layer * 17 * 64, args.in[I_FB1] + layer * 64, args.in[I_FFR] + layer * 64, args.in[I_FW2] + (size_t)layer * 64 * 64, args.in[I_FB2] + layer * 64,
                                 args.in[I_FW3] + (size_t)layer * 64 * 1024, args.in[I_FB3] + layer * 1024, args.in[I_HBIAS] + layer * 512, RF, it - 128);
            }
            constexpr int T_IN = 19 * 16, T_UQ = 12 * 4, T_KV = 16 * 2, T_OUT = 16 * 16, T_UP = 88 * 16, T_DN = 16 * 44, T_ALL = T_IN + T_UQ + T_KV + T_OUT + T_UP + T_DN;
            for (int it = wg; it < T_ALL; it += F.G) {
                int r = it; CvtTile d;
                if (r < T_IN) { const int nt = r >> 4, kt = r & 15, n0 = 512 + 128 * nt; d = CvtTile{win, g1, BtIn, DIN, DM, n0, 128 * kt, DIN, {n0, n0 + 32, n0 + 64, n0 + 96}}; }
                else if ((r -= T_IN) < T_UQ) { const int nt = r >> 2, kt = r & 3, n0 = 128 * nt; d = CvtTile{args.in[I_WUQ] + (size_t)layer * 512 * NQ, args.in[I_QNG] + layer * 512, BtUq, NQ, 512, n0, 128 * kt, NQ, {n0, n0 + 32, n0 + 64, n0 + 96}}; }
                else if ((r -= T_UQ) < T_KV) { const int nt = r >> 1, kt = r & 1, n0 = 128 * nt;
                    d = CvtTile{args.in[I_WUKV] + (size_t)layer * 256 * 2048, args.in[I_KVNG] + layer * 256, BtKv, 2048, 256, n0, 128 * kt, 2048, {n0, n0 + 32, n0 + 64, n0 + 96}}; }
                else if ((r -= T_KV) < T_OUT) { const int nt = r >> 4, kt = r & 15, n0 = 128 * nt; d = CvtTile{args.in[I_WOUT] + (size_t)layer * DM * DM, args.in[I_GNG] + layer * DM, BtOut, DM, DM, n0, 128 * kt, DM, {n0, n0 + 32, n0 + 64, n0 + 96}}; }
                else if ((r -= T_OUT) < T_UP) { const int nt = r >> 4, kt = r & 15;
                    absmax_tile(F, args.in[I_WUP] + (size_t)layer * DM * NUP, args.in[I_FNG] + layer * DM, NUP, 128 * nt, 128 * kt, ctl + CW_WMAXC + layer * NUP); continue; }
                else { r -= T_UP; const int nt = r / 44, kt = r % 44, n0 = 128 * nt; d = CvtTile{args.in[I_WDN] + (size_t)layer * DFF * DM, nullptr, BtDn, DM, DFF, n0, 128 * kt, DM, {n0, n0 + 32, n0 + 64, n0 + 96}}; }
                cvt_tile(F, d);
            }
            { unsigned zz = 0u; asm volatile("" : "+v"(zz)); v4u z = {zz, zz, zz, zz};
              for (size_t i = gtid; i < (size_t)(DINP - DIN) * DM / 8; i += gthreads) *(v4u*)(BtIn + (size_t)DIN * DM + i * 8) = z;
}
            if (layer == 0) for (size_t i = gtid; i < (size_t)SEQ * 32; i += gthreads) { const int pos = (int)(i >> 5), ri = (int)(i & 31);
                const float freq = exp2f(-(float)ri * (13.287712379549449f / 32.0f)); float sn, cs; sincosf((float)pos * freq, &sn, &cs); ROPE[pos * 64 + ri] = cs; ROPE[pos * 64 + 32 + ri] = sn; }
            if (layer == 0) { for (int m = gw; m < M; m += NGW) xb_row(m < MP ? args.in[I_XP] + (size_t)m * DM : args.in[I_XS] + (size_t)(m - MP) * DM, XA + (size_t)m * DM, RSTD + m, F.lane); }
            else rstd_from_partials(SSQP, RSTD, gtid, gthreads);
            SEAM(0);
        }
        if (IN(1)) { ENTER();
            pg8::Gemm g{XA, BtIn, M, DINP, DM, DM}; pg8::StaticOrder S; S.init(M, DINP, F.G, (int)blockIdx.x);
            pg8::EpiBf16 E{PROJ, DINP, RSTD, 0, O_CKV / 256, (LAS float*)(F.lds + HALO_OFF), EPS, SSQCQ, O_CQ / 256};
            pg8::gemm_phase<pg8::EpiBf16, pg8::StaticOrder>(F.lds, g, S, E);
            SEAM(1);
        }
        if (IN(2)) { ENTER();
            { pg8::Gemm g{PROJ + O_CQ, BtUq, M, NQ, 512, DINP}; pg8::StaticOrder S; S.init(M, NQ, F.G, (int)blockIdx.x); pg8::EpiBf16 E{Qb, NQ, nullptr, 0, -1, nullptr, 0.f, nullptr, 0};
              pg8::gemm_phase<pg8::EpiBf16, pg8::StaticOrder>(F.lds, g, S, E); }
            { pg8::Gemm g{PROJ + O_CKV, BtKv, M, 2048, 256, DINP}; pg8::StaticOrder S; S.init(M, 2048, F.G, (int)blockIdx.x); pg8::EpiBf16 E{KVb, NKVP, nullptr, 1, -1, nullptr, 0.f, nullptr, 0};
              pg8::gemm_phase<pg8::EpiBf16, pg8::StaticOrder>(F.lds, g, S, E); }
            const float* hcw = args.in[I_HCW] + (size_t)layer * 3 * 1536; const float* hcb = args.in[I_HCB] + layer * 1536;
            for (int it = wg; it < 2 * NSEQ * 64; it += F.G) {
                if (it < NSEQ * 64) hyprep_item(F, PROJ, hcw, hcb, ZT, X0, it >> 6, it & 63);
                else pool_item(F, PROJ, Hb, (it - NSEQ * 64) >> 6, it & 63);
            }
            SEAM(2);
        }
        if (IN(3)) { ENTER();
            const int odd = __builtin_amdgcn_readfirstlane(opq((int)(blockIdx.x >> 3) & 1));
            const float* qhg = args.in[I_QHG] + layer * 192; const float* khg = args.in[I_KHG] + layer * 192;
            if (!odd) { for (int u = wg; u < 2 * HYC; u += F.G) hy::conv_unit(F.lds, ZT, RF, YC, u >> 1, u & 1); }
            { PrepGains PG; { const int sub = F.lane & 7;
#pragma unroll
                for (int i = 0; i < 3; ++i) { load8(qhg + 64 * i + 8 * sub, PG.q[i]); load8(khg + 64 * i + 8 * sub, PG.k[i]); } }
              for (int m = gw; m < M; m += NGW) prep_row(PROJ, Qb, KVb, PG, ROPE, m, F.lane); }
            if (odd) { __syncthreads(); for (int u = wg; u < 2 * HYC; u += F.G) hy::conv_unit(F.lds, ZT, RF, YC, u >> 1, u & 1); }
            SEAM(3);
        }
        if (IN(4)) { ENTER();
            float gqm, gkm; { const float* qhg = args.in[I_QHG] + layer * 192; const float* khg = args.in[I_KHG] + layer * 192;
                gqm = fmaxf(fmaxf(fabsf(qhg[F.lane]), fabsf(qhg[64 + F.lane])), fabsf(qhg[128 + F.lane])); gkm = fmaxf(fmaxf(fabsf(khg[F.lane]), fabsf(khg[64 + F.lane])), fabsf(khg[128 + F.lane]));
#pragma unroll
                for (int o = 1; o < 64; o <<= 1) { gqm = fmaxf(gqm, __shfl_xor(gqm, o)); gkm = fmaxf(gkm, __shfl_xor(gkm, o)); } }
            const float Mnat = 13.856406460551018f * gqm * gkm;
            const bool sm_fast = __builtin_amdgcn_readfirstlane((Mnat <= 40.0f) ? 1 : 0) != 0;
            const float negMC = __builtin_bit_cast(float, __builtin_amdgcn_readfirstlane(__builtin_bit_cast(int, -Mnat * 1.4426950408889634f)));
            for (int i = 0; i * F.G < NSEQ * NH * 8; ++i) {
                int p, qb; const int c = (int)blockIdx.x;
                if (F.G == 256) { p = i * 32 + (c & 7) * 4 + (c >> 6); qb = (c >> 3) & 7; } else { const int Lq = i * F.G + c; p = Lq >> 3; qb = Lq & 7; }
                if (p < NSEQ * NH) { const int b = p >> 3, h = p & 7;
                    const bf16* qp = Qb + (size_t)(b * SEQ + qb * 256) * NQ + h * 192; const bf16* kp = KVb + (size_t)(b * SEQ) * NKVP + h * KVHS; bf16* op = Hb + (size_t)(b * SEQ + qb * 256) * DM + 512 + h * 128;
                    const float* sq = SSQCQ + (size_t)(b * SEQ + qb * 256) * 8; const float* qgp = args.in[I_QHG] + layer * 192; const float* rp0 = ROPE + (size_t)(qb * 256) * 64;
                    if (sm_fast) at::attn_unit<true>(negMC, qp, kp, kp + 192, op, SEQ, (char*)lds_raw, sq, qgp, rp0);
                    else at::attn_unit<false>(0.f, qp, kp, kp + 192, op, SEQ, (char*)lds_raw, sq, qgp, rp0); }
            }
            for (int it = wg; it < NSEQ * 64; it += F.G) hyfin_item(F, YC, X0, Hb, it >> 6, it & 63);
            SEAM(4);
        }
        if (IN(5)) { ENTER();
            for (int m = gw; m < M; m += NGW) attn_norm_row(Hb, m, F.lane);
            SEAM(5);
        }
        if (IN(6)) { ENTER();
            pg8::Gemm g{Hb, BtOut, M, DM, DM, DM}; pg8::StaticOrder S; S.init(M, DM, F.G, (int)blockIdx.x);
            pg8::EpiResid16 E{XA, XB2, out, DM, SSQP, 0};
            pg8::gemm_phase<pg8::EpiResid16, pg8::StaticOrder>(F.lds, g, S, E);
            SEAM(6);
        }
        if (IN(7)) { ENTER();
            const unsigned* wmaxc = ctl + CW_WMAXC + layer * NUP;
            const int p7odd = __builtin_amdgcn_readfirstlane(opq((int)(blockIdx.x >> 3) & 1));
            if (p7odd) { for (int m = gw; m < M; m += NGW) xq_row(XB2 + (size_t)m * DM, XQ + (size_t)m * DM, SSQP + (size_t)m * 32, RSTD + m, 1.0f, F.lane); __syncthreads(); }
            for (int it = wg; it < 88 * 16; it += F.G) { const int nt = it >> 4, kt = it & 15; const int nv = (nt < 44) ? nt : nt - 44;
                cvtq_tile(F, args.in[I_WUP] + (size_t)layer * DM * NUP, args.in[I_FNG] + layer * DM, NUP, DM, BtUpQ, 128 * nt, 128 * kt, 256 * nv + ((nt < 44) ? 0 : 32), wmaxc); }
            if (!p7odd) { for (int m = gw; m < M; m += NGW) xq_row(XB2 + (size_t)m * DM, XQ + (size_t)m * DM, SSQP + (size_t)m * 32, RSTD + m, 1.0f, F.lane); }
            SEAM(7);
        }
        if (IN(8)) { ENTER();
            pg8::Gemm g{(const bf16*)XQ, (const bf16*)BtUpQ, M, NUP, DM / 2, DM / 2}; pg8::StaticOrder S; S.init(M, NUP, F.G, (int)blockIdx.x);
            pg8::EpiGate E{ACT, DFF, EDGE, args.in[I_FCW] + (size_t)layer * 3 * DFF, args.in[I_FCB] + layer * DFF, DFF, (LAS float*)(F.lds + HALO_OFF), RSTD, ctl + CW_WMAXC + layer * NUP};
            pg8::gemm_phase<pg8::EpiGate, pg8::StaticOrder, true>(F.lds, g, S, E);
            SEAM(8);
        }
        if (IN(9)) { ENTER();
            const float* fcw = args.in[I_FCW] + (size_t)layer * 3 * DFF;
            for (size_t i = gtid; i < (size_t)(M / 256) * 2 * (DFF / 4); i += gthreads) {
                const int ri = (int)(i / (DFF / 4)), c4 = (int)(i % (DFF / 4)) * 4, pm = ri >> 1, e = ri & 1;
                const float* eb = EDGE + (size_t)(ri * 3) * DFF + c4;
                f32x4 pre = *(const f32x4*)(eb + DFF); const f32x4 v = *(const f32x4*)(eb + 2 * DFF);
                if (e == 0 && (pm & 7) != 0) { const f32x4 gp = *(const f32x4*)(EDGE + (size_t)(((pm - 1) * 2 + 1) * 3) * DFF + c4); pre += *(const f32x4*)(fcw + c4) * gp; }
                if (e == 1 && (pm & 7) != 7) { const f32x4 gn = *(const f32x4*)(EDGE + (size_t)(((pm + 1) * 2 + 0) * 3) * DFF + c4); pre += *(const f32x4*)(fcw + 2 * DFF + c4) * gn; }
                v2u o; o.x = pk2(pg8::silu_f(pre.x) * v.x, pg8::silu_f(pre.y) * v.y); o.y = pk2(pg8::silu_f(pre.z) * v.z, pg8::silu_f(pre.w) * v.w);
                *(v2u*)(ACT + (size_t)(pm * 256 + (e ? 255 : 0)) * DFF + c4) = o;
            }
            SEAM(9);
        }
        if (IN(10)) { ENTER();
            pg8::Gemm g{ACT, BtDn, M, DM, DFF, DFF}; pg8::StaticOrder S; S.init(M, DM, F.G, (int)blockIdx.x);
            pg8::EpiResid16 E{XB2, XA, out, DM, SSQP, (layer + 1 < DEPTH) ? 0 : 1};
            pg8::gemm_phase<pg8::EpiResid16, pg8::StaticOrder>(F.lds, g, S, E);
            SEAM(10);
        }
#undef IN
#undef ENTER
#undef SEAM
    }
}

extern "C" void kernel_launch(void* const* d_in, const int* in_sizes, int n_in, void* d_out, int out_size, void* d_ws, size_t ws_size, hipStream_t stream) {
    static int grid = 0;
    if (grid == 0) {
        if (n_in != N_IN || out_size != M * DM || ws_size < WS_END) { fprintf(stderr, "kernel_launch: unexpected shapes (n_in %d, out %d, ws %zu, need %zu)\n", n_in, out_size, ws_size, (size_t)WS_END); grid = -1; return; }
        int dev = 0, cus = 0;
        if (hipGetDevice(&dev) != hipSuccess || hipDeviceGetAttribute(&cus, hipDeviceAttributeMultiprocessorCount, dev) != hipSuccess) { grid = -1; return; }
        if (hipFuncSetAttribute((const void*)fwd, hipFuncAttributeMaxDynamicSharedMemorySize, LDS_BYTES) != hipSuccess) { fprintf(stderr, "kernel_launch: hipFuncSetAttribute failed\n"); grid = -1; return; }
        int per_cu = 0;
        if (hipOccupancyMaxActiveBlocksPerMultiprocessor(&per_cu, (const void*)fwd, NWAVES * 64, LDS_BYTES) != hipSuccess || per_cu < 1) fprintf(stderr, "kernel_launch: occupancy query reports %d\n", per_cu);
        (void)hipGetLastError();
        grid = cus;
    }
    if (grid < 0) return;
    (void)hipMemsetAsync((char*)d_ws + WS_CTL, 0, CTL_BYTES, stream);
    Args a{};
    for (int i = 0; i < N_IN; ++i) a.in[i] = (const float*)d_in[i];
    a.out = (float*)d_out; a.ws = (unsigned char*)d_ws;
#if MK_ONE_LAUNCH
    a.ph_lo = 0; a.ph_hi = DEPTH * NPH;
    hipLaunchKernelGGL(fwd, dim3(grid), dim3(NWAVES * 64), LDS_BYTES, stream, a);
#else
    for (int p = 0; p < DEPTH * NPH; ++p) { a.ph_lo = p; a.ph_hi = p + 1; hipLaunchKernelGGL(fwd, dim3(grid), dim3(NWAVES * 64), LDS_BYTES, stream, a); }
#endif
    const hipError_t le = hipPeekAtLastError();
    if (le != hipSuccess) fprintf(stderr, "kernel_launch: launch failed: %s\n", hipGetErrorName(le));
}
```

```cpp
#include <hip/hip_runtime.h>
#include <cstdio>
#include <cstdint>
__device__ __forceinline__ int opq(int x) { asm volatile("" : "+v"(x)); return x; }
__device__ __forceinline__ int opq_s(int x) { asm volatile("" : "+s"(x)); return x; }
namespace pg8 {
#define PG8_LAS __attribute__((address_space(3)))
typedef unsigned short bf16_t;
typedef short bf16x8 __attribute__((ext_vector_type(8)));
typedef float f32x4 __attribute__((ext_vector_type(4)));
typedef unsigned u32x4 __attribute__((ext_vector_type(4)));
typedef int i32x4 __attribute__((ext_vector_type(4)));
template <bool I8> struct AccSel { typedef f32x4 T; }; template <> struct AccSel<true> { typedef i32x4 T; };
constexpr int BM = 256, BK = 64, HALF = 128, HTB = HALF * BK * 2  , STAGE_BYTES = 8 * HTB, NXCD = 8, WGM = 8;

__host__ __device__ __forceinline__ int lds_byte(int r, int c) { const int st = (r >> 4) * 2 + (c >> 5), rr = r & 15, cc = c & 31, ob = rr * 64 + cc * 2; return st * 1024 + (ob ^ (((ob >> 9) & 1) << 5)); }
__host__ __device__ __forceinline__ void stage_rc(int b, int& R, int& C) { const int st = b / 1024, sb = b % 1024, swz = sb ^ (((sb >> 9) & 1) << 5); R = (st >> 1) * 16 + swz / 64; C = (st & 1) * 32 + (swz % 64) / 2; }
__host__ __device__ __forceinline__ int perm32(int rho) { const int n = rho >> 4, i = rho & 15; return 8 * (i >> 2) + 4 * n + (i & 3); }

struct Unit { int pm, pn; };
struct Gemm { const bf16_t* A; const bf16_t* Bt; int M, N, K, lda; };

struct StaticOrder {
    int nM, nN, nwg, G, c;
    __host__ __device__ void init(int M, int N, int G_, int c_) { nM = M / BM; nN = N / BM; nwg = nM * nN; G = G_; c = c_; }
    __host__ __device__ bool next(int i, Unit& u) const {
        const long L = (long)i * G + c; if (L >= nwg) return false;
        int wgid = (int)L; { const int q = nwg / NXCD, r = nwg % NXCD, xcd = wgid % NXCD, off = wgid / NXCD; wgid = (xcd < r ? xcd * (q + 1) : r * (q + 1) + (xcd - r) * q) + off; }
        const int nig = WGM * nN, gid = wgid / nig, fm = gid * WGM, gsz = (nM - fm) < WGM ? (nM - fm) : WGM;
        u.pm = fm + ((wgid % nig) % gsz); u.pn = (wgid % nig) / gsz; return true;
    }
    __device__ __forceinline__ void a_ready(const Unit&) const {}
    __device__ __forceinline__ void done(const Unit&) const {}
};

__device__ __forceinline__ unsigned cvt_pk_bf16(float lo, float hi) { unsigned r; asm volatile("v_cvt_pk_bf16_f32 %0, %1, %2" : "=v"(r) : "v"(lo), "v"(hi)); return r; }

__device__ __forceinline__ float dpp_ror1(float v) { return __builtin_bit_cast(float, __builtin_amdgcn_update_dpp(0, __builtin_bit_cast(int, v), 0x121, 0xF, 0xF, false)); }
__device__ __forceinline__ float dpp_ror15(float v) { return __builtin_bit_cast(float, __builtin_amdgcn_update_dpp(0, __builtin_bit_cast(int, v), 0x12F, 0xF, 0xF, false)); }
__device__ __forceinline__ unsigned dpp_swap1(unsigned v) { return (unsigned)__builtin_amdgcn_update_dpp(0, (int)v, 0xB1, 0xF, 0xF, false); }
struct LineOffs { unsigned o0, o1; bool odd; };
__device__ __forceinline__ LineOffs line_offs(unsigned lo, int pitch, int fr) { LineOffs L; L.odd = fr & 1; L.o0 = L.odd ? lo - (unsigned)pitch + 32u : lo; L.o1 = L.odd ? lo + 32u : lo + (unsigned)pitch; return L; }
__device__ __forceinline__ void store_lines(bf16_t* base, const LineOffs& L, u32x4 a, u32x4 b) {
    const u32x4 snd = L.odd ? a : b; u32x4 rcv;
    rcv.x = dpp_swap1(snd.x); rcv.y = dpp_swap1(snd.y); rcv.z = dpp_swap1(snd.z); rcv.w = dpp_swap1(snd.w);
    *(u32x4*)(base + L.o0) = L.odd ? rcv : a;
    *(u32x4*)(base + L.o1) = L.odd ? b : rcv;
}
struct EpiBf16 {
    static constexpr bool PERM = true;
    bf16_t* O; int ldc; const float* rstd; int kvscatter;
    int norm_pn; PG8_LAS float* red; float eps;
    float* ssq_out; int ssq_pn0;
    const float* cscale; int pn_skip_from, pn_skip;
    float* ssq_kpe_out; int kpe_pn;
    const bf16_t* kpe_src; int kpe_ld; const float* rope; const float* kgain; const float* ssq_kpe_in; int pos_mask;
    __device__ __forceinline__ void operator()(f32x4 (&acc)[2][2][4][2], const Unit& u, int wr, int wc, int fr, int fq) const {
        const int pno = (u.pn >= pn_skip_from) ? u.pn + pn_skip : u.pn;
        bf16_t* Ot = O + (size_t)(u.pm * BM) * ldc + (kvscatter ? u.pn * 320 : pno * BM);
        const int wcol = kvscatter ? (wc < 2 ? wc * 64 : 64 + wc * 64) : wc * 64;
        const LineOffs L = line_offs((unsigned)((wr * 64 + fr) * ldc + wcol + 8 * fq), ldc, fr); const int row0 = u.pm * BM + wr * 64 + fr;
        float rsv[8];
#pragma unroll
        for (int i = 0; i < 8; ++i) rsv[i] = rstd ? rstd[row0 + (i >> 2) * HALF + (i & 3) * 16] : 1.0f;
        if (u.pn == norm_pn) {
#pragma unroll
            for (int ai = 0; ai < 2; ++ai)
#pragma unroll
                for (int m = 0; m < 4; ++m) { const float rs = rsv[ai * 4 + m]; float s = 0.f;
#pragma unroll
                    for (int bj = 0; bj < 2; ++bj) { acc[ai][bj][m][0] *= rs; acc[ai][bj][m][1] *= rs; const f32x4 a = acc[ai][bj][m][0], b = acc[ai][bj][m][1];
                        s += ((a[0] * a[0] + a[1] * a[1]) + (a[2] * a[2] + a[3] * a[3])) + ((b[0] * b[0] + b[1] * b[1]) + (b[2] * b[2] + b[3] * b[3])); }
                    s += __shfl_xor(s, 16); s += __shfl_xor(s, 32); if (fq == 0) red[(ai * HALF + wr * 64 + m * 16 + fr) * 4 + wc] = s; }
            asm volatile("s_waitcnt lgkmcnt(0)" ::: "memory"); __builtin_amdgcn_s_barrier(); asm volatile("" ::: "memory");
#pragma unroll
            for (int ai = 0; ai < 2; ++ai)
#pragma unroll
                for (int m = 0; m < 4; ++m) { const f32x4 p = *(const PG8_LAS f32x4*)(red + (ai * HALF + wr * 64 + m * 16 + fr) * 4); const float rs = 1.0f / __builtin_sqrtf(((p[0] + p[1]) + (p[2] + p[3])) * (1.0f / 256.0f) + eps);
                    u32x4 w[2];
#pragma unroll
                    for (int bj = 0; bj < 2; ++bj) { const f32x4 v0 = acc[ai][bj][m][0] * rs, v1 = acc[ai][bj][m][1] * rs;
                        w[bj].x = cvt_pk_bf16(v0[0], v0[1]); w[bj].y = cvt_pk_bf16(v0[2], v0[3]); w[bj].z = cvt_pk_bf16(v1[0], v1[1]); w[bj].w = cvt_pk_bf16(v1[2], v1[3]); }
                    store_lines(Ot + (size_t)((ai * HALF + m * 16) * ldc), L, w[0], w[1]);
                    asm volatile("" ::: "memory"); }
            return;
        }
        if (kpe_src != nullptr) {
            const int frl = opq(fr);
            if (wc < 2) {
#pragma unroll
                for (int ai = 0; ai < 2; ++ai)
#pragma unroll
                    for (int m = 0; m < 4; ++m) { float s = 0.f;
#pragma unroll
                        for (int bj = 0; bj < 2; ++bj) { const f32x4 a = acc[ai][bj][m][0], b = acc[ai][bj][m][1];
                            s += ((a[0] * a[0] + a[1] * a[1]) + (a[2] * a[2] + a[3] * a[3])) + ((b[0] * b[0] + b[1] * b[1]) + (b[2] * b[2] + b[3] * b[3])); }
                        s += __shfl_xor(s, 16); s += __shfl_xor(s, 32); if (fq == 0) red[(ai * HALF + wr * 64 + m * 16 + frl) * 2 + wc] = s; }
            }
            asm volatile("s_waitcnt lgkmcnt(0)" ::: "memory"); __builtin_amdgcn_s_barrier(); asm volatile("" ::: "memory");
            typedef float f32x2 __attribute__((ext_vector_type(2)));
            if (wc < 2) {
#pragma unroll
                for (int ai = 0; ai < 2; ++ai)
#pragma unroll
                    for (int m = 0; m < 4; ++m) { const int rl = ai * HALF + wr * 64 + m * 16 + frl; const f32x2 p = *(const PG8_LAS f32x2*)(red + rl * 2);
                        const float sk = 1.0f / __builtin_sqrtf(((p[0] + p[1]) + ssq_kpe_in[u.pm * BM + rl]) * (1.0f / 192.0f) + eps);
                        u32x4 w[2];
#pragma unroll
                        for (int bj = 0; bj < 2; ++bj) { const float* kgp = kgain + wc * 64 + bj * 32 + 8 * fq;
                            const f32x4 v0 = acc[ai][bj][m][0] * sk * *(const f32x4*)kgp, v1 = acc[ai][bj][m][1] * sk * *(const f32x4*)(kgp + 4);
                            w[bj].x = cvt_pk_bf16(v0[0], v0[1]); w[bj].y = cvt_pk_bf16(v0[2], v0[3]); w[bj].z = cvt_pk_bf16(v1[0], v1[1]); w[bj].w = cvt_pk_bf16(v1[2], v1[3]); }
                        store_lines(Ot + (size_t)((ai * HALF + m * 16) * ldc), L, w[0], w[1]);
                        asm volatile("" ::: "memory"); }
            } else {
#pragma unroll
                for (int ai = 0; ai < 2; ++ai)
#pragma unroll
                    for (int m = 0; m < 4; ++m) { u32x4 w[2];
#pragma unroll
                        for (int bj = 0; bj < 2; ++bj) { const f32x4 v0 = acc[ai][bj][m][0], v1 = acc[ai][bj][m][1];
                            w[bj].x = cvt_pk_bf16(v0[0], v0[1]); w[bj].y = cvt_pk_bf16(v0[2], v0[3]); w[bj].z = cvt_pk_bf16(v1[0], v1[1]); w[bj].w = cvt_pk_bf16(v1[2], v1[3]); }
                        store_lines(Ot + (size_t)((ai * HALF + m * 16) * ldc), L, w[0], w[1]);
                        asm volatile("" ::: "memory"); }
                __builtin_amdgcn_sched_barrier(0);
                const int ai2 = wc - 2;
                const f32x4 ga0 = *(const f32x4*)(kgain + 128 + 8 * fq), ga1 = *(const f32x4*)(kgain + 132 + 8 * fq), gb0 = *(const f32x4*)(kgain + 160 + 8 * fq), gb1 = *(const f32x4*)(kgain + 164 + 8 * fq);
                const float ga[8] = {ga0[0], ga0[1], ga0[2], ga0[3], ga1[0], ga1[1], ga1[2], ga1[3]}, gb[8] = {gb0[0], gb0[1], gb0[2], gb0[3], gb1[0], gb1[1], gb1[2], gb1[3]};
#pragma unroll 1
                for (int m = 0; m < 4; ++m) { const int rl = ai2 * HALF + wr * 64 + m * 16 + frl, grow = u.pm * BM + rl; const f32x2 p = *(const PG8_LAS f32x2*)(red + rl * 2);
                    const float sk = 1.0f / __builtin_sqrtf(((p[0] + p[1]) + ssq_kpe_in[grow]) * (1.0f / 192.0f) + eps);
                    const u32x4 ra = *(const u32x4*)(kpe_src + (size_t)grow * kpe_ld + 8 * fq), rb = *(const u32x4*)(kpe_src + (size_t)grow * kpe_ld + 32 + 8 * fq);
                    const float* rp = rope + (size_t)(grow & pos_mask) * 64 + 8 * fq;
                    const f32x4 c0 = *(const f32x4*)rp, c1 = *(const f32x4*)(rp + 4), s0 = *(const f32x4*)(rp + 32), s1 = *(const f32x4*)(rp + 36);
                    const float cs[8] = {c0[0], c0[1], c0[2], c0[3], c1[0], c1[1], c1[2], c1[3]}, sn[8] = {s0[0], s0[1], s0[2], s0[3], s1[0], s1[1], s1[2], s1[3]};
                    const unsigned wa[4] = {ra.x, ra.y, ra.z, ra.w}, wb[4] = {rb.x, rb.y, rb.z, rb.w}; float oa[8], ob[8];
#pragma unroll
                    for (int i = 0; i < 8; ++i) { const unsigned ua = wa[i >> 1], ub = wb[i >> 1];
                        const float xa = __builtin_bit_cast(float, (i & 1) ? (ua & 0xffff0000u) : (ua << 16)) * sk * ga[i], xb = __builtin_bit_cast(float, (i & 1) ? (ub & 0xffff0000u) : (ub << 16)) * sk * gb[i];
                        oa[i] = xa * cs[i] - xb * sn[i]; ob[i] = xb * cs[i] + xa * sn[i]; }
                    u32x4 qa, qb; qa.x = cvt_pk_bf16(oa[0], oa[1]); qa.y = cvt_pk_bf16(oa[2], oa[3]); qa.z = cvt_pk_bf16(oa[4], oa[5]); qa.w = cvt_pk_bf16(oa[6], oa[7]);
                    qb.x = cvt_pk_bf16(ob[0], ob[1]); qb.y = cvt_pk_bf16(ob[2], ob[3]); qb.z = cvt_pk_bf16(ob[4], ob[5]); qb.w = cvt_pk_bf16(ob[6], ob[7]);
                    bf16_t* kp = O + (size_t)grow * ldc + u.pn * 320 + 128 + 8 * fq; *(u32x4*)kp = qa; *(u32x4*)(kp + 32) = qb; }
            }
            return;
        }
        const bool want_ssq = (ssq_out != nullptr && (unsigned)(u.pn - ssq_pn0) < 2u) || (ssq_kpe_out != nullptr && u.pn == kpe_pn);
        f32x4 csc[2][2];
        if (cscale) {
#pragma unroll
            for (int bj = 0; bj < 2; ++bj)
#pragma unroll
                for (int n = 0; n < 2; ++n) csc[bj][n] = *(const f32x4*)(cscale + u.pn * BM + wc * 64 + bj * 32 + 8 * fq + 4 * n);
        }
#pragma unroll
        for (int ai = 0; ai < 2; ++ai)
#pragma unroll
            for (int m = 0; m < 4; ++m) { const float rs = rsv[ai * 4 + m];
                u32x4 w[2]; float s = 0.f;
#pragma unroll
                for (int bj = 0; bj < 2; ++bj) { f32x4 v0 = acc[ai][bj][m][0] * rs, v1 = acc[ai][bj][m][1] * rs;
                    if (cscale) { v0 *= csc[bj][0]; v1 *= csc[bj][1]; }
                    s += ((v0[0] * v0[0] + v0[1] * v0[1]) + (v0[2] * v0[2] + v0[3] * v0[3])) + ((v1[0] * v1[0] + v1[1] * v1[1]) + (v1[2] * v1[2] + v1[3] * v1[3]));
                    w[bj].x = cvt_pk_bf16(v0[0], v0[1]); w[bj].y = cvt_pk_bf16(v0[2], v0[3]); w[bj].z = cvt_pk_bf16(v1[0], v1[1]); w[bj].w = cvt_pk_bf16(v1[2], v1[3]); }
                store_lines(Ot + (size_t)((ai * HALF + m * 16) * ldc), L, w[0], w[1]);
                if (want_ssq) { s += __shfl_xor(s, 16); s += __shfl_xor(s, 32);
                    if (fq == 0) { if (ssq_kpe_out != nullptr && u.pn == kpe_pn) { if (wc == 0) ssq_kpe_out[row0 + ai * HALF + m * 16] = s; } else ssq_out[(size_t)(row0 + ai * HALF + m * 16) * 8 + (u.pn - ssq_pn0) * 4 + wc] = s; } }
                asm volatile("" ::: "memory"); }
    }
};
struct EpiResid16 {
    static constexpr bool PERM = true;
    const bf16_t* base; bf16_t* xo; float* out; int ldc; float* ssqp; int f32out;
    __device__ __forceinline__ static void addx(const u32x4 b, const f32x4 a0, const f32x4 a1, f32x4& x0, f32x4& x1) {
        x0[0] = __builtin_bit_cast(float, b.x << 16) + a0[0]; x0[1] = __builtin_bit_cast(float, b.x & 0xffff0000u) + a0[1]; x0[2] = __builtin_bit_cast(float, b.y << 16) + a0[2]; x0[3] = __builtin_bit_cast(float, b.y & 0xffff0000u) + a0[3];
        x1[0] = __builtin_bit_cast(float, b.z << 16) + a1[0]; x1[1] = __builtin_bit_cast(float, b.z & 0xffff0000u) + a1[1]; x1[2] = __builtin_bit_cast(float, b.w << 16) + a1[2]; x1[3] = __builtin_bit_cast(float, b.w & 0xffff0000u) + a1[3]; }
    __device__ __forceinline__ void operator()(f32x4 (&acc)[2][2][4][2], const Unit& u, int wr, int wc, int fr, int fq) const {
        const size_t tb = (size_t)(u.pm * BM) * ldc + u.pn * BM;
        const bf16_t* bs = base + tb;
        const unsigned lo = (unsigned)((wr * 64 + fr) * ldc + wc * 64 + 8 * fq);
        if (f32out != 0) {
            float* op = out + tb;
#pragma unroll
            for (int ai = 0; ai < 2; ++ai)
#pragma unroll
                for (int m = 0; m < 4; ++m) { const unsigned off = lo + (unsigned)((ai * HALF + m * 16) * ldc);
#pragma unroll
                    for (int bj = 0; bj < 2; ++bj) { const u32x4 b = *(const u32x4*)(bs + off + bj * 32); f32x4 x0, x1; addx(b, acc[ai][bj][m][0], acc[ai][bj][m][1], x0, x1);
                        *(f32x4*)(op + off + bj * 32) = x0; *(f32x4*)(op + off + bj * 32 + 4) = x1; }
                    asm volatile("" ::: "memory"); }
            return;
        }
        bf16_t* xp = xo + tb; const LineOffs L = line_offs(lo, ldc, fr);
#pragma unroll
        for (int aim = 0; aim < 4; ++aim) { const int ai = aim >> 1, mp = aim & 1;
            u32x4 bv[2][2];
#pragma unroll
            for (int mm = 0; mm < 2; ++mm)
#pragma unroll
                for (int bj = 0; bj < 2; ++bj) bv[mm][bj] = *(const u32x4*)(bs + lo + (unsigned)((ai * HALF + (2 * mp + mm) * 16) * ldc) + bj * 32);
#pragma unroll
            for (int mm = 0; mm < 2; ++mm) { const int m = 2 * mp + mm; float s = 0.f; u32x4 wv[2];
#pragma unroll
                for (int bj = 0; bj < 2; ++bj) { f32x4 x0, x1; addx(bv[mm][bj], acc[ai][bj][m][0], acc[ai][bj][m][1], x0, x1);
                    wv[bj].x = cvt_pk_bf16(x0[0], x0[1]); wv[bj].y = cvt_pk_bf16(x0[2], x0[3]); wv[bj].z = cvt_pk_bf16(x1[0], x1[1]); wv[bj].w = cvt_pk_bf16(x1[2], x1[3]);
                    s += ((x0[0] * x0[0] + x0[1] * x0[1]) + (x0[2] * x0[2] + x0[3] * x0[3])) + ((x1[0] * x1[0] + x1[1] * x1[1]) + (x1[2] * x1[2] + x1[3] * x1[3])); }
                store_lines(xp + (size_t)((ai * HALF + m * 16) * ldc), L, wv[0], wv[1]);
                s += __shfl_xor(s, 16); s += __shfl_xor(s, 32); if (fq == 0) ssqp[(size_t)(u.pm * BM + wr * 64 + fr + ai * HALF + m * 16) * 32 + u.pn * 4 + wc] = s; }
            asm volatile("" ::: "memory"); }
    }
};
__device__ __forceinline__ float silu_f(float x) { return x * __builtin_amdgcn_rcpf(1.0f + __builtin_amdgcn_exp2f(-1.4426950408889634f * x)); }
struct EpiGate {
    static constexpr bool PERM = true;
    bf16_t* act; int ldact; float* edge; const float* cw; const float* cb; int dff; PG8_LAS float* halo; const float* rstd; const unsigned* wmaxc;
    __device__ __forceinline__ void operator()(f32x4 (&acc)[2][2][4][2], const Unit& u, int wr, int wc, int fr, int fq) const {
        const int lane = fq * 16 + fr; const int colL = wc * 32 + 8 * fq; const int colG = u.pn * HALF + colL;
        f32x4 csc[2][2];
#pragma unroll
        for (int bj = 0; bj < 2; ++bj)
#pragma unroll
            for (int n = 0; n < 2; ++n) { const u32x4 mb = *(const u32x4*)(wmaxc + bj * dff + colG + 4 * n);
                csc[bj][n] = (f32x4){__builtin_bit_cast(float, mb.x), __builtin_bit_cast(float, mb.y), __builtin_bit_cast(float, mb.z), __builtin_bit_cast(float, mb.w)} * (1.0f / 127.0f); }
#pragma unroll
        for (int ai = 0; ai < 2; ++ai)
#pragma unroll
            for (int m = 0; m < 4; ++m) { const float rs = rstd[u.pm * BM + ai * HALF + wr * 64 + m * 16 + fr];
#pragma unroll
                for (int bj = 0; bj < 2; ++bj) { acc[ai][bj][m][0] *= csc[bj][0] * rs; acc[ai][bj][m][1] *= csc[bj][1] * rs; } }
#pragma unroll
        for (int ai = 0; ai < 2; ++ai) { const int q = 2 * ai + wr;
            if (fr == 0) { *(PG8_LAS f32x4*)(halo + (q * 2 + 0) * 128 + colL) = acc[ai][0][0][0]; *(PG8_LAS f32x4*)(halo + (q * 2 + 0) * 128 + colL + 4) = acc[ai][0][0][1]; }
            if (fr == 15) { *(PG8_LAS f32x4*)(halo + (q * 2 + 1) * 128 + colL) = acc[ai][0][3][0]; *(PG8_LAS f32x4*)(halo + (q * 2 + 1) * 128 + colL + 4) = acc[ai][0][3][1]; } }
        asm volatile("s_waitcnt lgkmcnt(0)" ::: "memory"); __builtin_amdgcn_s_barrier(); asm volatile("" ::: "memory");
        bf16_t* actp = act + (size_t)(u.pm * BM) * ldact + colG; const unsigned rlo = (unsigned)((wr * 64 + fr) * ldact);
#pragma unroll
        for (int ai = 0; ai < 2; ++ai) { const int q = 2 * ai + wr;
            typedef unsigned u32x2 __attribute__((ext_vector_type(2)));
            u32x2 pk[4][2];
#pragma unroll
            for (int n = 0; n < 2; ++n) {
                const f32x4 w0 = *(const f32x4*)(cw + colG + 4 * n), w1 = *(const f32x4*)(cw + dff + colG + 4 * n), w2 = *(const f32x4*)(cw + 2 * dff + colG + 4 * n), bb = *(const f32x4*)(cb + colG + 4 * n);
                f32x4 ht = *(PG8_LAS f32x4*)(halo + ((q > 0 ? q - 1 : 0) * 2 + 1) * 128 + colL + 4 * n), hb = *(PG8_LAS f32x4*)(halo + ((q < 3 ? q + 1 : 3) * 2 + 0) * 128 + colL + 4 * n);
                if (q == 0) ht = ht * 0.f; if (q == 3) hb = hb * 0.f;
                f32x4 pre[4];
#pragma unroll
                for (int j = 0; j < 4; ++j) {
                    float g[4], rr[4], rl[4];
#pragma unroll
                    for (int m = 0; m < 4; ++m) { g[m] = acc[ai][0][m][n][j]; rr[m] = dpp_ror1(g[m]); rl[m] = dpp_ror15(g[m]); }
#pragma unroll
                    for (int m = 0; m < 4; ++m) {
                        const float up = (fr > 0) ? rr[m] : (m > 0 ? rr[m > 0 ? m - 1 : 0] : ht[j]);
                        const float dn = (fr < 15) ? rl[m] : (m < 3 ? rl[m < 3 ? m + 1 : 3] : hb[j]);
                        pre[m][j] = w0[j] * up + w1[j] * g[m] + w2[j] * dn + bb[j];
                    }
                }
                if (q == 0 && fr == 0) { float* e = edge + (size_t)((u.pm * 2 + 0) * 3) * dff + colG + 4 * n;
                    *(f32x4*)(e) = acc[ai][0][0][n]; *(f32x4*)(e + dff) = pre[0]; *(f32x4*)(e + 2 * dff) = acc[ai][1][0][n]; }
                if (q == 3 && fr == 15) { float* e = edge + (size_t)((u.pm * 2 + 1) * 3) * dff + colG + 4 * n;
                    *(f32x4*)(e) = acc[ai][0][3][n]; *(f32x4*)(e + dff) = pre[3]; *(f32x4*)(e + 2 * dff) = acc[ai][1][3][n]; }
#pragma unroll
                for (int m = 0; m < 4; ++m) { const f32x4 v = acc[ai][1][m][n];
                    pk[m][n].x = cvt_pk_bf16(silu_f(pre[m][0]) * v[0], silu_f(pre[m][1]) * v[1]); pk[m][n].y = cvt_pk_bf16(silu_f(pre[m][2]) * v[2], silu_f(pre[m][3]) * v[3]); }
            }
#pragma unroll
            for (int m = 0; m < 4; ++m) { u32x4 w; w.x = pk[m][0].x; w.y = pk[m][0].y; w.z = pk[m][1].x; w.w = pk[m][1].y;
                *(u32x4*)(actp + rlo + (unsigned)((ai * HALF + m * 16) * ldact)) = w; }
        }
    }
};

template <class Epi, class Sched, bool I8 = false>
__device__ __forceinline__ void gemm_phase(PG8_LAS unsigned char* lds, const Gemm g, const Sched& S, const Epi& E) {
    typedef typename AccSel<I8>::T acc_t;
    const int tid = opq(threadIdx.x), wid = __builtin_amdgcn_readfirstlane(tid >> 6), lane = tid & 63, wr = wid >> 2, wc = wid & 3, fr = lane & 15, fq = lane >> 4;
    const int K = g.K, nt = K / BK, lda = g.lda;
    unsigned voffA[2], voffB[2];
#pragma unroll
    for (int i = 0; i < 2; ++i) { int R, C; stage_rc(tid * 16 + i * 8192, R, C); const int Rb = Epi::PERM ? (64 * (R >> 5) + perm32(R & 31)) : R;
        voffA[i] = (unsigned)(R * lda + C) * 2u; voffB[i] = (unsigned)(Rb * K + C) * 2u; }
    const size_t kstep = (size_t)(BK * 2);
    const size_t hstepA = (size_t)HALF * lda * 2, hstepB = (size_t)(Epi::PERM ? 32 : HALF) * K * 2;
    const size_t tstepA = 2 * hstepA, tstepB = (size_t)BM * K * 2;
    const unsigned ldsw = (unsigned)wid * 1024u;
    const int aoff = lds_byte(wr * 64 + fr, fq * 8), boff = lds_byte(wc * 32 + fr, fq * 8);
#define PG8_SA(b, h) (((b) * 2 + (h)) * HTB)
#define PG8_SB(b, h) ((4 + (b) * 2 + (h)) * HTB)
#define PG8_STAGE(bufoff, gbase, voff) do { _Pragma("unroll") for (int _i = 0; _i < 2; ++_i) \
        __builtin_amdgcn_global_load_lds((const unsigned*)((const char*)(gbase) + (voff)[_i]), (PG8_LAS unsigned*)(lds + (bufoff) + ldsw + _i * 8192), 16, 0, 0); } while (0)
#define PG8_LDA(dst, b, h) do { _Pragma("unroll") for (int m = 0; m < 4; ++m) _Pragma("unroll") for (int k = 0; k < 2; ++k) dst[m][k] = *(const PG8_LAS bf16x8*)(lds + PG8_SA(b, h) + aoff + m * 2048 + k * 1024); } while (0)
#define PG8_LDB(dst, b, h) do { _Pragma("unroll") for (int n = 0; n < 2; ++n) _Pragma("unroll") for (int k = 0; k < 2; ++k) dst[n][k] = *(const PG8_LAS bf16x8*)(lds + PG8_SB(b, h) + boff + n * 2048 + k * 1024); } while (0)
#define PG8_MMA(ai, bj, At, Bt) do { __builtin_amdgcn_s_setprio(1); _Pragma("unroll") for (int m = 0; m < 4; ++m) _Pragma("unroll") for (int n = 0; n < 2; ++n) _Pragma("unroll") for (int k = 0; k < 2; ++k) { \
        if constexpr (I8) acc[ai][bj][m][n] = __builtin_amdgcn_mfma_i32_16x16x64_i8(__builtin_bit_cast(i32x4, Bt[n][k]), __builtin_bit_cast(i32x4, At[m][k]), acc[ai][bj][m][n], 0, 0, 0); \
        else acc[ai][bj][m][n] = __builtin_amdgcn_mfma_f32_16x16x32_bf16(Bt[n][k], At[m][k], acc[ai][bj][m][n], 0, 0, 0); } __builtin_amdgcn_s_setprio(0); } while (0)
#define PG8_WAIT_V(n) asm volatile("s_waitcnt vmcnt(" #n ")" ::: "memory")
#define PG8_WAIT_L(n) asm volatile("s_waitcnt lgkmcnt(" #n ")" ::: "memory")
#define PG8_BAR __builtin_amdgcn_s_barrier()
#define PG8_SCHED __builtin_amdgcn_sched_barrier(0)
    Unit cur, nxt; int ui = 0;
    if (!S.next(0, cur)) return;
    acc_t acc[2][2][4][2];
{ float zf = 0.f; asm volatile("" : "+v"(zf));
    #pragma unroll
    for (int a = 0; a < 2; ++a)
#pragma unroll
        for (int b = 0; b < 2; ++b)
#pragma unroll
            for (int m = 0; m < 4; ++m)
#pragma unroll
                for (int n = 0; n < 2; ++n) acc[a][b][m][n] = __builtin_bit_cast(acc_t, (f32x4){zf, zf, zf, zf}); }
    bf16x8 At[4][2], B0[2][2], B1[2][2];
    const char* cA = (const char*)g.A + (size_t)cur.pm * tstepA; const char* cB = (const char*)g.Bt + (size_t)cur.pn * tstepB;
    S.a_ready(cur);
    PG8_STAGE(PG8_SB(0, 0), cB, voffB); PG8_STAGE(PG8_SB(0, 1), cB + hstepB, voffB); PG8_STAGE(PG8_SA(0, 0), cA, voffA); PG8_STAGE(PG8_SA(0, 1), cA + hstepA, voffA);
    if (wr == 1) PG8_BAR;
    PG8_WAIT_V(2); PG8_BAR;
    PG8_STAGE(PG8_SB(1, 0), cB + kstep, voffB); PG8_STAGE(PG8_SA(1, 0), cA + kstep, voffA); PG8_STAGE(PG8_SB(1, 1), cB + hstepB + kstep, voffB);
    PG8_WAIT_V(6); PG8_BAR;
    for (;;) {
        const bool has_next = S.next(ui + 1, nxt);
        const char* nA = has_next ? (const char*)g.A + (size_t)nxt.pm * tstepA : cA; const char* nB = has_next ? (const char*)g.Bt + (size_t)nxt.pn * tstepB : cB;
#pragma unroll 1
        for (int t = 0; t < nt; t += 2) {
            const bool last = (t == nt - 2);
            const char* a1 = cA + (size_t)(t + 1) * kstep;
            const char* a2 = last ? nA : cA + (size_t)(t + 2) * kstep; const char* b2 = last ? nB : cB + (size_t)(t + 2) * kstep;
            const char* a3 = a2 + kstep; const char* b3 = b2 + kstep;
            if (last && has_next) S.a_ready(nxt);
            PG8_LDB(B0, 0, 0); PG8_LDB(B1, 0, 1); PG8_SCHED; PG8_LDA(At, 0, 0); PG8_STAGE(PG8_SA(1, 1), a1 + hstepA, voffA);
            PG8_WAIT_V(8); PG8_WAIT_L(0); PG8_BAR; PG8_MMA(0, 0, At, B0); PG8_MMA(0, 1, At, B1); PG8_BAR; PG8_SCHED;
            PG8_LDA(At, 0, 1); PG8_STAGE(PG8_SB(0, 0), b2, voffB); PG8_STAGE(PG8_SB(0, 1), b2 + hstepB, voffB); PG8_STAGE(PG8_SA(0, 0), a2, voffA);
            PG8_WAIT_V(8); PG8_WAIT_L(0); PG8_BAR; PG8_MMA(1, 0, At, B0); PG8_MMA(1, 1, At, B1); PG8_BAR; PG8_SCHED;
            PG8_LDB(B0, 1, 0); PG8_LDB(B1, 1, 1); PG8_SCHED; PG8_LDA(At, 1, 0); PG8_STAGE(PG8_SA(0, 1), a2 + hstepA, voffA);
            PG8_WAIT_V(8); PG8_WAIT_L(0); PG8_BAR; PG8_MMA(0, 0, At, B0); PG8_MMA(0, 1, At, B1); PG8_BAR; PG8_SCHED;
            PG8_LDA(At, 1, 1); PG8_STAGE(PG8_SB(1, 0), b3, voffB); PG8_STAGE(PG8_SB(1, 1), b3 + hstepB, voffB); PG8_STAGE(PG8_SA(1, 0), a3, voffA);
            PG8_WAIT_V(8); PG8_WAIT_L(0); PG8_BAR; PG8_MMA(1, 0, At, B0); PG8_MMA(1, 1, At, B1); PG8_BAR; PG8_SCHED;
        }
        if (wr == 0) PG8_BAR;
        if constexpr (I8) { f32x4 accf[2][2][4][2];
#pragma unroll
            for (int a = 0; a < 2; ++a)
#pragma unroll
                for (int b = 0; b < 2; ++b)
#pragma unroll
                    for (int m = 0; m < 4; ++m)
#pragma unroll
                        for (int n = 0; n < 2; ++n) accf[a][b][m][n] = __builtin_convertvector(acc[a][b][m][n], f32x4);
            E(accf, cur, wr, wc, fr, fq); }
        else E(acc, cur, wr, wc, fr, fq);
        S.done(cur);
        if (!has_next) break;
{ float zf = 0.f; asm volatile("" : "+v"(zf));
        #pragma unroll
        for (int a = 0; a < 2; ++a)
#pragma unroll
            for (int b = 0; b < 2; ++b)
#pragma unroll
                for (int m = 0; m < 4; ++m)
#pragma unroll
                    for (int n = 0; n < 2; ++n) acc[a][b][m][n] = __builtin_bit_cast(acc_t, (f32x4){zf, zf, zf, zf}); }
        cur = nxt; cA = nA; cB = nB; ++ui;
        if (wr == 1) PG8_BAR;
    }
    PG8_WAIT_V(0);
    PG8_BAR;
#undef PG8_SA
#undef PG8_SB
#undef PG8_STAGE
#undef PG8_LDA
#undef PG8_LDB
#undef PG8_MMA
#undef PG8_WAIT_V
#undef PG8_WAIT_L
#undef PG8_BAR
#undef PG8_SCHED
}
}
namespace at {
using bf16 = unsigned short;
using bf16x8 = __attribute__((ext_vector_type(8))) short;
using s16x4  = __attribute__((ext_vector_type(4))) short;
using f32x16 = __attribute__((ext_vector_type(16))) float;
using u32x4  = __attribute__((ext_vector_type(4))) unsigned;
using f32x4  = __attribute__((ext_vector_type(4))) float;
constexpr int DQK = 192, DV = 128, KVBLK = 64, NW = 8, QBLK = 32;
constexpr float SCALE = 0.07216878364870322f;
constexpr float THR = 8.f;
constexpr int LDQ = 1536, LDK = 2560, LDO = 2048;
constexpr int SHM_V = KVBLK * DV * 2, SHM_K = 12 * 2080;
constexpr int QR_OFF = 2 * SHM_V + 2 * SHM_K + NW * 64 * 4;
constexpr int SHM_ATTN = QR_OFF + NW * 4096;
#define SBAR() __builtin_amdgcn_sched_barrier(0)
constexpr int KPL = 2080;
__host__ __device__ __forceinline__ int k_st(int row, int c) { return (c >> 1) * KPL + row * 32 + (((c & 1) ^ ((row >> 3) & 1)) << 4); }
__host__ __device__ __forceinline__ int k_rd_base(int r32, int hi) { return r32 * 32 + ((hi ^ ((r32 >> 3) & 1)) << 4); }
__device__ __forceinline__ int crow(int r, int hi) { return (r & 3) + 8 * (r >> 2) + 4 * hi; }
__device__ __forceinline__ unsigned cvtpk(float lo, float hi) { unsigned r; asm volatile("v_cvt_pk_bf16_f32 %0, %1, %2" : "=v"(r) : "v"(lo), "v"(hi)); return r; }

__device__ __forceinline__ void partialSM(f32x16& p0, f32x16& p1, float& m_reg, float& mn, float& alpha) {
  constexpr float C = 1.0f;
  float pmax = p0[0];
#pragma unroll
  for (int r = 1; r < 16; ++r) pmax = fmaxf(pmax, p0[r]);
#pragma unroll
  for (int r = 0; r < 16; ++r) pmax = fmaxf(pmax, p1[r]);
  { auto rr = __builtin_amdgcn_permlane32_swap(__float_as_uint(pmax), __float_as_uint(pmax), false, false);
    pmax = fmaxf(__uint_as_float(rr[0]), __uint_as_float(rr[1])); }
  if (__builtin_expect(__all(pmax - m_reg <= THR * 1.4426950408889634f), 1)) { mn = m_reg; alpha = 1.f; }
  else { mn = fmaxf(m_reg, pmax); alpha = __builtin_amdgcn_exp2f((m_reg - mn) * C); m_reg = mn; }
  float mnC = -mn * C;
#pragma unroll
  for (int r = 0; r < 16; ++r) p0[r] = fmaf(p0[r], C, mnC);
#pragma unroll
  for (int r = 0; r < 16; ++r) p1[r] = fmaf(p1[r], C, mnC);
#pragma unroll
  for (int r = 0; r < 16; ++r) p0[r] = __builtin_amdgcn_exp2f(p0[r]);
}
__device__ __forceinline__ void partialSM_fast(f32x16& p0, f32x16& p1, float negMC) {
  (void)negMC; (void)p1;
#pragma unroll
  for (int r = 0; r < 16; ++r) p0[r] = __builtin_amdgcn_exp2f(p0[r]);
}
__device__ __forceinline__ void finishSM(f32x16& p0, f32x16& p1, float alpha, float& l_reg, bf16x8& pa0, bf16x8& pa1, bf16x8& pa2, bf16x8& pa3) {
#pragma unroll
  for (int r = 0; r < 16; ++r) p1[r] = __builtin_amdgcn_exp2f(p1[r]);
  float ps = 0;
#pragma unroll
  for (int r = 0; r < 16; ++r) ps += p0[r];
#pragma unroll
  for (int r = 0; r < 16; ++r) ps += p1[r];
  { auto rr = __builtin_amdgcn_permlane32_swap(__float_as_uint(ps), __float_as_uint(ps), false, false);
    ps = __uint_as_float(rr[0]) + __uint_as_float(rr[1]); }
  l_reg = l_reg * alpha + ps;
#define PK4(P, BASE, OUT) do { unsigned a0 = cvtpk(P[BASE + 0], P[BASE + 1]), a1 = cvtpk(P[BASE + 2], P[BASE + 3]);   \
    unsigned b0 = cvtpk(P[BASE + 4], P[BASE + 5]), b1 = cvtpk(P[BASE + 6], P[BASE + 7]);                              \
    auto r0 = __builtin_amdgcn_permlane32_swap(a0, b0, false, false); auto r1 = __builtin_amdgcn_permlane32_swap(a1, b1, false, false); \
    u32x4 w = {r0[0], r1[0], r0[1], r1[1]}; OUT = *reinterpret_cast<bf16x8*>(&w); } while (0)
  PK4(p0, 0, pa0); PK4(p0, 8, pa1); PK4(p1, 0, pa2); PK4(p1, 8, pa3);
#undef PK4
}
template <int OFF> __device__ __forceinline__ bf16x8 k_read(int kb) {
  bf16x8 r; asm volatile("ds_read_b128 %0, %1 offset:%2" : "=v"(r) : "v"(kb), "i"(OFF) : "memory"); return r;
}
__device__ __forceinline__ void qkt(f32x16& p0, f32x16& p1, int kb, const bf16x8* qr, int qb) {
  p0 = f32x16{}; p1 = f32x16{};
#define QK1(d0) { const bf16x8 b0 = *(const __attribute__((address_space(3))) bf16x8*)(kb + d0 * KPL), b1 = *(const __attribute__((address_space(3))) bf16x8*)(kb + d0 * KPL + 1024); \
    p0 = __builtin_amdgcn_mfma_f32_32x32x16_bf16(b0, qr[d0], p0, 0, 0, 0); p1 = __builtin_amdgcn_mfma_f32_32x32x16_bf16(b1, qr[d0], p1, 0, 0, 0); }
#define QK2(d0) { const bf16x8 b0 = *(const __attribute__((address_space(3))) bf16x8*)(kb + d0 * KPL), b1 = *(const __attribute__((address_space(3))) bf16x8*)(kb + d0 * KPL + 1024); \
    const bf16x8 qf = *(const __attribute__((address_space(3))) bf16x8*)(qb + (d0 - 8) * 1024); \
    p0 = __builtin_amdgcn_mfma_f32_32x32x16_bf16(b0, qf, p0, 0, 0, 0); p1 = __builtin_amdgcn_mfma_f32_32x32x16_bf16(b1, qf, p1, 0, 0, 0); }
  QK1(0) QK1(1) QK1(2) QK1(3) QK1(4) QK1(5) QK1(6) QK1(7) QK2(8) QK2(9) QK2(10) QK2(11)
#undef QK1
#undef QK2
}
__host__ __device__ __forceinline__ int v_st(int k, int c) { const int kk = (k & ~0xC) | ((k & 4) << 1) | ((k & 8) >> 1); return ((kk >> 3) * 4 + (c >> 5)) * 512 + ((kk & 7) * 32 + (c & 31)) * 2; }
__device__ __forceinline__ int v_rd_base(int lane) { return ((lane & 3) << 3) | (((lane >> 2) & 3) << 6) | (((lane >> 4) & 1) << 5) | (((lane >> 5) & 1) << 8); }
constexpr int v_rd_off(int d0, int ks, int half) { return d0 * 512 + ks * 4096 + half * 2048; }
template <int OFF> __device__ __forceinline__ s16x4 tr_read(int vb) {
  s16x4 r; asm volatile("ds_read_b64_tr_b16 %0, %1 offset:%2" : "=&v"(r) : "v"(vb), "i"(OFF) : "memory"); return r;
}
template <int D0> __device__ __forceinline__ void pv_one(f32x16& od, int vb, bf16x8 pa0, bf16x8 pa1, bf16x8 pa2, bf16x8 pa3) {
  const s16x4 l0 = tr_read<v_rd_off(D0, 0, 0)>(vb), h0 = tr_read<v_rd_off(D0, 0, 1)>(vb), l1 = tr_read<v_rd_off(D0, 1, 0)>(vb), h1 = tr_read<v_rd_off(D0, 1, 1)>(vb);
  const s16x4 l2 = tr_read<v_rd_off(D0, 2, 0)>(vb), h2 = tr_read<v_rd_off(D0, 2, 1)>(vb), l3 = tr_read<v_rd_off(D0, 3, 0)>(vb), h3 = tr_read<v_rd_off(D0, 3, 1)>(vb);
  asm volatile("s_waitcnt lgkmcnt(0)" ::: "memory"); SBAR();
#define PK(L, H) (bf16x8){L[0], L[1], L[2], L[3], H[0], H[1], H[2], H[3]}
  od = __builtin_amdgcn_mfma_f32_32x32x16_bf16(pa0, PK(l0, h0), od, 0, 0, 0);
  od = __builtin_amdgcn_mfma_f32_32x32x16_bf16(pa1, PK(l1, h1), od, 0, 0, 0);
  od = __builtin_amdgcn_mfma_f32_32x32x16_bf16(pa2, PK(l2, h2), od, 0, 0, 0);
  od = __builtin_amdgcn_mfma_f32_32x32x16_bf16(pa3, PK(l3, h3), od, 0, 0, 0);
#undef PK
}
__device__ __forceinline__ void pv_d0(f32x16* o, int vb, bf16x8 pa0, bf16x8 pa1, bf16x8 pa2, bf16x8 pa3) {
  pv_one<0>(o[0], vb, pa0, pa1, pa2, pa3); pv_one<1>(o[1], vb, pa0, pa1, pa2, pa3); pv_one<2>(o[2], vb, pa0, pa1, pa2, pa3); pv_one<3>(o[3], vb, pa0, pa1, pa2, pa3);
}

template <bool FAST>
__device__ __forceinline__ void attn_unit(const float negMC, const bf16* __restrict__ Qb, const bf16* __restrict__ Kh, const bf16* __restrict__ Vh, bf16* __restrict__ Ob, int seq, char* lds,
                                          const float* __restrict__ ssqcq, const float* __restrict__ qg, const float* __restrict__ rope0) {
  const int tid = opq(threadIdx.x), wid = tid >> 6, lane = tid & 63, r32 = lane & 31, hi = lane >> 5;
  char* V_lds = lds; char* K_lds = lds + 2 * SHM_V;
  float* ws = (float*)(lds + 2 * SHM_V + 2 * SHM_K) + wid * 64; float* li_l = ws; float* al_l = ws + 32;
  float m_reg = -1e30f, l_reg = 0; f32x16 o[4] = {}; bf16x8 qr[8];
  const bf16* Qw = Qb + (unsigned)((wid * QBLK + r32) * LDQ + hi * 8);
  const int qb0 = (int)(uintptr_t)lds + QR_OFF + wid * 4096 + k_rd_base(r32, hi);
  { const int row = wid * QBLK + r32;
    bf16x8 raw[12];
#pragma unroll
    for (int d0 = 0; d0 < 12; ++d0) raw[d0] = *reinterpret_cast<const bf16x8*>(Qw + d0 * 16);
    const f32x4 pa = *(const f32x4*)(ssqcq + row * 8), pb = *(const f32x4*)(ssqcq + row * 8 + 4);
    const float rq = 1.0f / __builtin_sqrtf((((pa.x + pa.y) + (pa.z + pa.w)) + ((pb.x + pb.y) + (pb.z + pb.w))) * (1.f / 512.f) + 1e-6f);
    float ss = 0.f;
#pragma unroll
    for (int d0 = 0; d0 < 12; ++d0)
#pragma unroll
      for (int i = 0; i < 8; ++i) { const float x = __builtin_bit_cast(float, (unsigned)(unsigned short)raw[d0][i] << 16); ss += x * x; }
    ss += __shfl_xor(ss, 32);
    const float sc = (rq * (SCALE * 1.4426950408889634f)) / __builtin_sqrtf(ss * (rq * rq) * (1.f / 192.f) + 1e-6f);
#define QX(d0, i) (__builtin_bit_cast(float, (unsigned)(unsigned short)raw[d0][i] << 16) * sc)
#pragma unroll
    for (int d0 = 0; d0 < 8; ++d0) { const f32x4 g0 = *(const f32x4*)(qg + 16 * d0 + 8 * hi), g1 = *(const f32x4*)(qg + 16 * d0 + 8 * hi + 4);
      u32x4 w = {cvtpk(QX(d0, 0) * g0.x, QX(d0, 1) * g0.y), cvtpk(QX(d0, 2) * g0.z, QX(d0, 3) * g0.w), cvtpk(QX(d0, 4) * g1.x, QX(d0, 5) * g1.y), cvtpk(QX(d0, 6) * g1.z, QX(d0, 7) * g1.w)};
      qr[d0] = *reinterpret_cast<bf16x8*>(&w); }
#pragma unroll
    for (int t = 0; t < 2; ++t) { const int da = 8 + t, db = 10 + t, j0 = 16 * t + 8 * hi;
      const float* rp = rope0 + row * 64 + j0;
      const f32x4 c0 = *(const f32x4*)rp, c1 = *(const f32x4*)(rp + 4), s0 = *(const f32x4*)(rp + 32), s1 = *(const f32x4*)(rp + 36);
      const f32x4 ga0 = *(const f32x4*)(qg + 16 * da + 8 * hi), ga1 = *(const f32x4*)(qg + 16 * da + 8 * hi + 4), gb0 = *(const f32x4*)(qg + 16 * db + 8 * hi), gb1 = *(const f32x4*)(qg + 16 * db + 8 * hi + 4);
      const float cs[8] = {c0.x, c0.y, c0.z, c0.w, c1.x, c1.y, c1.z, c1.w}, sn[8] = {s0.x, s0.y, s0.z, s0.w, s1.x, s1.y, s1.z, s1.w};
      const float ga[8] = {ga0.x, ga0.y, ga0.z, ga0.w, ga1.x, ga1.y, ga1.z, ga1.w}, gb[8] = {gb0.x, gb0.y, gb0.z, gb0.w, gb1.x, gb1.y, gb1.z, gb1.w};
      float oa[8], ob[8];
#pragma unroll
      for (int i = 0; i < 8; ++i) { const float xa = QX(da, i) * ga[i], xb = QX(db, i) * gb[i]; oa[i] = xa * cs[i] - xb * sn[i]; ob[i] = xb * cs[i] + xa * sn[i]; }
      u32x4 wa = {cvtpk(oa[0], oa[1]), cvtpk(oa[2], oa[3]), cvtpk(oa[4], oa[5]), cvtpk(oa[6], oa[7])}, wb = {cvtpk(ob[0], ob[1]), cvtpk(ob[2], ob[3]), cvtpk(ob[4], ob[5]), cvtpk(ob[6], ob[7])};
      *(__attribute__((address_space(3))) bf16x8*)(qb0 + (da - 8) * 1024) = *reinterpret_cast<bf16x8*>(&wa);
      *(__attribute__((address_space(3))) bf16x8*)(qb0 + (db - 8) * 1024) = *reinterpret_cast<bf16x8*>(&wb); }
#undef QX
  }
  const int sr = tid >> 4, sc = (tid & 15) * 8, vst0 = v_st(sr, sc), vst1 = v_st(32 + sr, sc);
  unsigned koff[3]; int kst[3];
#pragma unroll
  for (int i = 0; i < 3; ++i) { const int q = tid + 512 * i; koff[i] = (unsigned)((q / 24) * LDK + (q % 24) * 8); kst[i] = k_st(q / 24, q % 24); }
  const unsigned voff0 = (unsigned)(sr * LDK + sc), voff1 = (unsigned)((32 + sr) * LDK + sc);
  const int vb0 = (int)(uintptr_t)V_lds + v_rd_base(lane); const int kb0 = (int)(uintptr_t)K_lds + k_rd_base(r32, hi);
  struct { bf16x8 vs0, vs1, ks0, ks1, ks2; } sr_[1];
#define SLOAD(i, k0) do { const bf16* vt = Vh + (size_t)(k0) * LDK; const bf16* kt = Kh + (size_t)(k0) * LDK; \
    sr_[i].vs0 = *(const bf16x8*)(vt + voff0); sr_[i].vs1 = *(const bf16x8*)(vt + voff1); \
    sr_[i].ks0 = *(const bf16x8*)(kt + koff[0]); sr_[i].ks1 = *(const bf16x8*)(kt + koff[1]); sr_[i].ks2 = *(const bf16x8*)(kt + koff[2]); } while (0)
#define SWRITE(b, i) do { *(bf16x8*)(V_lds + (b) * SHM_V + vst0) = sr_[i].vs0; *(bf16x8*)(V_lds + (b) * SHM_V + vst1) = sr_[i].vs1; \
    *(bf16x8*)(K_lds + (b) * SHM_K + kst[0]) = sr_[i].ks0; *(bf16x8*)(K_lds + (b) * SHM_K + kst[1]) = sr_[i].ks1; *(bf16x8*)(K_lds + (b) * SHM_K + kst[2]) = sr_[i].ks2; } while (0)
#define SWAIT() do { if constexpr (SDEPTH == 2) asm volatile("s_waitcnt vmcnt(5)" ::: "memory"); else asm volatile("s_waitcnt vmcnt(0)" ::: "memory"); } while (0)
#define RESC(a) do { if (__any((a) < 1.f)) { if (hi == 0) al_l[r32] = (a); asm volatile("s_waitcnt lgkmcnt(0)" ::: "memory"); \
    _Pragma("unroll") for (int d = 0; d < 4; ++d) _Pragma("unroll") for (int r = 0; r < 16; ++r) o[d][r] *= al_l[crow(r, hi)]; } } while (0)
  f32x16 pA0, pA1, pB0, pB1; float mnA, mnB, alA, alB; bf16x8 pa0, pa1, pa2, pa3; const int NT = seq / KVBLK;
#define PSM(P0, P1, MN, AL) do { if constexpr (FAST) { partialSM_fast(P0, P1, negMC); AL = 1.f; } else partialSM(P0, P1, m_reg, MN, AL); } while (0)
#define RSC(AL) do { if constexpr (!FAST) RESC(AL); } while (0)
  SLOAD(0, 0); asm volatile("s_waitcnt vmcnt(0)" ::: "memory"); SWRITE(0, 0); __syncthreads();
  qkt(pA0, pA1, kb0, qr, qb0); PSM(pA0, pA1, mnA, alA);
  SLOAD(0, KVBLK);
  asm volatile("s_waitcnt vmcnt(0)" ::: "memory"); SWRITE(1, 0); __syncthreads();
  for (int j = 1; j + 1 < NT; j += 2) {
    SBAR(); qkt(pB0, pB1, kb0 + SHM_K, qr, qb0);
    finishSM(pA0, pA1, alA, l_reg, pa0, pa1, pa2, pa3); SBAR();
    SLOAD(0, (j + 1) * KVBLK); SBAR();
    pv_d0(o, vb0, pa0, pa1, pa2, pa3); PSM(pB0, pB1, mnB, alB);
    __syncthreads(); asm volatile("s_waitcnt vmcnt(0)" ::: "memory"); SWRITE(0, 0);
    RSC(alB); __syncthreads();
    SBAR(); qkt(pA0, pA1, kb0, qr, qb0);
    finishSM(pB0, pB1, alB, l_reg, pa0, pa1, pa2, pa3); SBAR();
    SLOAD(0, (j + 2) * KVBLK); SBAR();
    pv_d0(o, vb0 + (int)SHM_V, pa0, pa1, pa2, pa3); PSM(pA0, pA1, mnA, alA);
    __syncthreads(); asm volatile("s_waitcnt vmcnt(0)" ::: "memory"); SWRITE(1, 0);
    RSC(alA); __syncthreads();
  }
  SBAR(); qkt(pB0, pB1, kb0 + SHM_K, qr, qb0);
  finishSM(pA0, pA1, alA, l_reg, pa0, pa1, pa2, pa3); SBAR();
  pv_d0(o, vb0, pa0, pa1, pa2, pa3); PSM(pB0, pB1, mnB, alB);
  __syncthreads(); RSC(alB);
  finishSM(pB0, pB1, alB, l_reg, pa0, pa1, pa2, pa3); SBAR();
  pv_d0(o, vb0 + (int)SHM_V, pa0, pa1, pa2, pa3);
  if (hi == 0) li_l[r32] = l_reg; asm volatile("s_waitcnt lgkmcnt(0)" ::: "memory");
  bf16* Ow = Ob + (unsigned)(wid * QBLK * LDO + r32);
#pragma unroll
  for (int r = 0; r < 16; ++r) { const int orow = crow(r, hi); const float rl = __builtin_amdgcn_rcpf(li_l[orow]);
#pragma unroll
    for (int d0 = 0; d0 < 4; ++d0) { const unsigned w = cvtpk(o[d0][r] * rl, 0.f); Ow[(unsigned)(orow * LDO + d0 * 32)] = (bf16)(w & 0xffffu); } }
  __syncthreads();
#undef SLOAD
#undef SWRITE
#undef SWAIT
#undef RESC
#undef PSM
#undef RSC
}
}
namespace hy {
#define HY_LAS __attribute__((address_space(3)))
typedef unsigned short bf16;
typedef short bf16x8 __attribute__((ext_vector_type(8)));
typedef float f32x16 __attribute__((ext_vector_type(16)));
typedef unsigned u32x2 __attribute__((ext_vector_type(2)));
typedef unsigned u32x4 __attribute__((ext_vector_type(4)));
constexpr int L = 2048, NB = 24, CH = 512;
constexpr int RFS = 4112;
constexpr int ZROW = 4112;
constexpr int ZL_BYTES = NB * ZROW;
constexpr int RCS = 8256;
constexpr int RC_OFF = ZL_BYTES;
constexpr int HY_LDS_BYTES = RC_OFF + 4 * RCS;
__device__ __forceinline__ unsigned cvtpk(float lo, float hi) { unsigned r; asm volatile("v_cvt_pk_bf16_f32 %0, %1, %2" : "=v"(r) : "v"(lo), "v"(hi)); return r; }
__host__ __device__ __forceinline__ int frag_base(int tw, int r, int h) { const int a = (4 - (r & 3)) & 3; return RC_OFF + a * RCS + 2 * (2048 - tw - r + 8 * h - a); }
__host__ __device__ __forceinline__ int zfrag_base(int r, int h) { return (r < NB ? r : NB - 1) * ZROW + 16 * h; }

__device__ __forceinline__ bf16x8 ld_frag(HY_LAS unsigned char* lds, int off) {
    const u32x2 lo = *(const HY_LAS u32x2*)(lds + off), hi = *(const HY_LAS u32x2*)(lds + off + 8);
    u32x4 w = {lo.x, lo.y, hi.x, hi.y}; return *reinterpret_cast<bf16x8*>(&w);
}
__device__ __forceinline__ bf16x8 ld_b128(HY_LAS unsigned char* lds, int off) { return *(const HY_LAS bf16x8*)(lds + off); }

__device__ __forceinline__ void conv_unit(HY_LAS unsigned char* lds, const bf16* __restrict__ ZT, const bf16* __restrict__ RF, bf16* __restrict__ YC, int c, int half) {
    const int tid = opq(threadIdx.x), wid = tid >> 6, lane = tid & 63, r = lane & 31, h = lane >> 5;
    { const u32x4* src = (const u32x4*)(ZT + (size_t)c * NB * L);
#pragma unroll
      for (int i = 0; i < 12; ++i) { const int q = tid + 512 * i; const u32x4 v = src[q]; *(HY_LAS u32x4*)(lds + (q >> 8) * ZROW + (q & 255) * 16) = v; } }
    { const bf16* rf = RF + (size_t)c * RFS;
      for (int ch = tid; ch < RFS / 8; ch += 512) {
          const u32x4 v = *(const u32x4*)(rf + ch * 8); const unsigned w[4] = {v.x, v.y, v.z, v.w};
#pragma unroll
          for (int j = 0; j < 8; ++j) { const unsigned short e = (unsigned short)((w[j >> 1] >> ((j & 1) * 16)) & 0xffffu); const int idx = ch * 8 + j;
#pragma unroll
              for (int a = 0; a < 4; ++a) if (idx - a >= 0) *(HY_LAS unsigned short*)(lds + RC_OFF + a * RCS + 2 * (idx - a)) = e; } } }
    __syncthreads();
    const int tw = half * 1024 + wid * 128;
    const int fb = frag_base(tw, r, h), zb = zfrag_base(r, h);
    f32x16 acc[4] = {};
    bf16x8 S0[2], S1[2], S2[2], S3[2], Bc[2], Bn[2];
#define HY_LDG(S, d) do { S[0] = ld_frag(lds, fb + 64 * (d)); S[1] = ld_frag(lds, fb + 64 * (d) + 32); } while (0)
#define HY_LDB(Bx, n) do { Bx[0] = ld_b128(lds, zb + 64 * (n)); Bx[1] = ld_b128(lds, zb + 64 * (n) + 32); } while (0)
#define HY_MM(i, S, Bx) do { acc[i] = __builtin_amdgcn_mfma_f32_32x32x16_bf16(S[0], Bx[0], acc[i], 0, 0, 0); acc[i] = __builtin_amdgcn_mfma_f32_32x32x16_bf16(S[1], Bx[1], acc[i], 0, 0, 0); } while (0)
#define HY_ITER(n, Sa, Sb, Sc, Sd, Bcur, Bnext) do { HY_LDG(Sa, (n)); if ((n) + 1 < 64) HY_LDB(Bnext, (n) + 1); \
        HY_MM(1, Sb, Bcur); HY_MM(2, Sc, Bcur); HY_MM(3, Sd, Bcur); HY_MM(0, Sa, Bcur); } while (0)
    HY_LDG(S3, -1); HY_LDG(S2, -2); HY_LDG(S1, -3); HY_LDB(Bc, 0);
    for (int n = 0; n < 64; n += 4) {
        HY_ITER(n, S0, S3, S2, S1, Bc, Bn);
        HY_ITER(n + 1, S1, S0, S3, S2, Bn, Bc);
        HY_ITER(n + 2, S2, S1, S0, S3, Bc, Bn);
        HY_ITER(n + 3, S3, S2, S1, S0, Bn, Bc);
    }
#undef HY_LDG
#undef HY_LDB
#undef HY_MM
#undef HY_ITER
    if (r < NB) { bf16* yp = YC + ((size_t)c * NB + r) * L + tw + 4 * h;
#pragma unroll
        for (int i = 0; i < 4; ++i)
#pragma unroll
            for (int q4 = 0; q4 < 4; ++q4) { u32x2 w; w.x = cvtpk(acc[i][4 * q4 + 0], acc[i][4 * q4 + 1]); w.y = cvtpk(acc[i][4 * q4 + 2], acc[i][4 * q4 + 3]);
                *(u32x2*)(yp + 32 * i + 8 * q4) = w; } }
    __syncthreads();
}
}
constexpr int NWAVES = 8;
#ifndef MK_ONE_LAUNCH
#define MK_ONE_LAUNCH 1
#endif
constexpr int DM = 2048, NSEQ = 24, SEQ = 2048, M = NSEQ * SEQ, MP = 8 * SEQ;
constexpr int DEPTH = 4;
constexpr int DIN = 2880, DINP = 3072;
constexpr int O_CQ = 512, O_CKV = 1024, O_KPE = 1280, O_HY = 1344;
constexpr int NH = 8, NQ = 1536, NKVP = 2560, KVHS = 320;
constexpr int DFF = 5632, NUP = 11264, HYC = 512;
constexpr float EPS = 1e-6f;
constexpr int NPH = 11;
constexpr size_t WS_CTL = 0, CTL_BYTES = 1u << 20;
constexpr size_t SZ_BTIN = (size_t)DINP * DM * 2, SZ_BTUQ = (size_t)NQ * 512 * 2, SZ_BTKV = (size_t)NKVP * 256 * 2, SZ_BTOUT = (size_t)DM * DM * 2, SZ_BTUP = (size_t)NUP * DM * 2, SZ_BTDN = (size_t)DM * DFF * 2;
constexpr size_t WS_BTIN = WS_CTL + CTL_BYTES, WS_BTUQ = WS_BTIN + SZ_BTIN, WS_BTKV = WS_BTUQ + SZ_BTUQ, WS_BTOUT = WS_BTKV + SZ_BTKV, WS_BTUP = WS_BTOUT + SZ_BTOUT, WS_BTDN = WS_BTUP + SZ_BTUP;
constexpr size_t WS_RF = WS_BTDN + SZ_BTDN, SZ_RF = (size_t)HYC * hy::RFS * 2;
constexpr size_t WS_H = WS_RF + SZ_RF, SZ_H = (size_t)M * DM * 2;
constexpr size_t WS_PROJ = WS_H + SZ_H, SZ_PROJ = (size_t)M * DINP * 2;
constexpr size_t WS_Q = WS_PROJ + SZ_PROJ, SZ_Q = (size_t)M * NQ * 2;
constexpr size_t WS_KV = WS_Q + SZ_Q, SZ_KV = (size_t)M * NKVP * 2;
constexpr size_t WS_ZT = WS_KV + SZ_KV, SZ_ZT = (size_t)HYC * NSEQ * SEQ * 2;
constexpr size_t WS_X0 = WS_ZT + SZ_ZT, WS_YC = WS_X0 + SZ_ZT;
constexpr size_t WS_EDGE = WS_YC + SZ_ZT, SZ_EDGE = (size_t)(M / 256) * 2 * 3 * DFF * 4;
constexpr size_t WS_ROPE = WS_EDGE + SZ_EDGE, SZ_ROPE = (size_t)SEQ * 64 * 4;
constexpr size_t WS_SSQP = WS_ROPE + SZ_ROPE, SZ_SSQP = (size_t)M * 32 * 4;
constexpr size_t WS_RSTD = WS_SSQP + SZ_SSQP, SZ_RSTD = (size_t)M * 4;
constexpr size_t WS_XQ = WS_RSTD + SZ_RSTD, SZ_XQ = (size_t)M * DM;
constexpr size_t WS_SSQCQ = WS_XQ + SZ_XQ, SZ_SSQCQ = (size_t)M * 8 * 4;
constexpr int NINQ = 2048;
constexpr size_t WS_BTINQ = WS_SSQCQ + SZ_SSQCQ, SZ_BTINQ = (size_t)NINQ * DM;
constexpr size_t WS_CSIN = WS_BTINQ + SZ_BTINQ, SZ_CSIN = (size_t)NINQ * 4;
constexpr size_t WS_RSTDQ = WS_CSIN + SZ_CSIN, SZ_RSTDQ = (size_t)M * 4;
constexpr size_t WS_SSQKPE = WS_RSTDQ + SZ_RSTDQ, SZ_SSQKPE = (size_t)M * 4;
constexpr size_t WS_END = WS_SSQKPE + SZ_SSQKPE;
constexpr size_t WS_ACT = WS_PROJ;
static_assert((size_t)M * DFF * 2 <= SZ_PROJ + SZ_Q + SZ_KV, "ACT overlay");
constexpr size_t WS_XB2 = WS_ACT + (size_t)M * DFF * 2;
static_assert(WS_XB2 + (size_t)M * DM * 2 <= WS_EDGE && WS_XB2 % 256 == 0, "XB2 overlay");
static_assert(WS_BTIN % 256 == 0 && WS_RF % 256 == 0 && WS_H % 256 == 0 && WS_PROJ % 256 == 0 && WS_Q % 256 == 0 && WS_KV % 256 == 0 && WS_ZT % 256 == 0 && WS_EDGE % 256 == 0, "alignment");
constexpr int CW_WMAXC = 65536;
constexpr int CW_WMAX = 1024;
constexpr int CW_BAR = 4096;
constexpr int RING_BYTES = 135168;
constexpr int HALO_OFF = RING_BYTES, HALO_BYTES = 4096;
constexpr int MISC_OFF = HALO_OFF + HALO_BYTES;
constexpr int LDS_BYTES = 147456;
static_assert(hy::HY_LDS_BYTES <= RING_BYTES && at::SHM_ATTN <= RING_BYTES && MISC_OFF + 256 <= LDS_BYTES, "LDS map");

#define GAS __attribute__((address_space(1)))
#define LAS __attribute__((address_space(3)))
typedef unsigned short bf16;
typedef unsigned v4u __attribute__((ext_vector_type(4)));
typedef unsigned v2u __attribute__((ext_vector_type(2)));
typedef float f32x4 __attribute__((ext_vector_type(4)));
#define LDS_WAIT() asm volatile("s_waitcnt lgkmcnt(0)" ::: "memory")
__device__ __forceinline__ unsigned f2bf(float f) { unsigned u = __builtin_bit_cast(unsigned, f); return (u + 0x7fffu + ((u >> 16) & 1u)) >> 16; }
__device__ __forceinline__ unsigned pk2(float lo, float hi) { return f2bf(lo) | (f2bf(hi) << 16); }
__device__ __forceinline__ float bf2f(unsigned short b) { return __builtin_bit_cast(float, (unsigned)b << 16); }
__device__ __forceinline__ float bflo(unsigned w) { return __builtin_bit_cast(float, w << 16); }
__device__ __forceinline__ float bfhi(unsigned w) { return __builtin_bit_cast(float, w & 0xffff0000u); }
__device__ __forceinline__ float wave_sum(float v) {
#pragma unroll
    for (int o = 1; o < 64; o <<= 1) v += __shfl_xor(v, o);
    return v;
}

#define XB_TMO      128
#define XB_XCNT(j)  (256  + 64 * (j))
#define XB_XSUB(j)  (1280 + 64 * (j))
#define XB_XGEN(j)  (2304 + 64 * (j))
#define XB_TOP      3328
#define XB_TOPGEN   3392
#define XCD_BAR_WORDS 3456
#define XB_SPIN_CAP (1u << 18)
__device__ __forceinline__ unsigned xb_ld(unsigned* p)              { return __hip_atomic_load(p, __ATOMIC_RELAXED, __HIP_MEMORY_SCOPE_AGENT); }
__device__ __forceinline__ unsigned xb_add(unsigned* p, unsigned v) { return __hip_atomic_fetch_add(p, v, __ATOMIC_RELAXED, __HIP_MEMORY_SCOPE_AGENT); }
__device__ __forceinline__ unsigned xb_xcc_id() { return (unsigned)__builtin_amdgcn_s_getreg((3 << 11) | 20) & 0xFu; }
#define XB_SPIN(cond, bar) do { unsigned _sp = 0; while (cond) { __builtin_amdgcn_s_sleep(1); \
    if ((++_sp & 255u) == 0u) { if (xb_ld(&(bar)[XB_TMO])) break; if (_sp > XB_SPIN_CAP) { atomicAdd(&(bar)[XB_TMO], 1u); break; } } } } while (0)
struct XcdBarrier { unsigned* bar; unsigned x; volatile LAS unsigned* st; };
__device__ __forceinline__ XcdBarrier xcd_barrier_post(unsigned* bar, volatile LAS unsigned* st) {
    XcdBarrier b; b.bar = bar; b.x = xb_xcc_id(); b.st = st;
    if (threadIdx.x == 0) (void)xb_add(&bar[XB_XCNT(b.x)], 1u);
    return b;
}
__device__ __forceinline__ void xcd_barrier_complete(unsigned* bar, unsigned x, unsigned& nloc, unsigned& nx) {
    const unsigned G = gridDim.x * gridDim.y * gridDim.z;
    unsigned sum, cnt, mine, sp = 0u;
    for (;;) {
        sum = 0u; cnt = 0u; mine = 0u;
#pragma unroll
        for (unsigned j = 0; j < 16; ++j) { const unsigned c = xb_ld(&bar[XB_XCNT(j)]); sum += c; cnt += (c > 0u) ? 1u : 0u; mine = (j == x) ? c : mine; }
        if (sum == G) break;
        __builtin_amdgcn_s_sleep(1);
        if ((++sp & 255u) == 0u) { if (xb_ld(&bar[XB_TMO])) break; if (sp > XB_SPIN_CAP) { atomicAdd(&bar[XB_TMO], 1u); break; } }
    }
    nloc = mine > 0u ? mine : 1u; nx = cnt > 0u ? cnt : 1u;
}
__device__ __forceinline__ void xcd_barrier(const XcdBarrier& b) {
    asm volatile("s_waitcnt vmcnt(0)" ::: "memory");
    __syncthreads();
    if (threadIdx.x == 0) {
        unsigned* bar = b.bar + opq_s(0);
        __builtin_amdgcn_s_waitcnt(0);
        unsigned nloc = b.st[0], nx = b.st[1];
        if (nloc == 0u) { xcd_barrier_complete(bar, b.x, nloc, nx); b.st[0] = nloc; b.st[1] = nx; }
        const unsigned old = xb_add(&bar[XB_XSUB(b.x)], 1u);
        const unsigned gen = old / nloc;
        if (old + 1u == (gen + 1u) * nloc) {
            __builtin_amdgcn_fence(__ATOMIC_RELEASE, "agent");
            asm volatile("s_waitcnt vmcnt(0)" ::: "memory");
            const unsigned og = xb_add(&bar[XB_TOP], 1u);
            const unsigned tg = og / nx;
            if (og + 1u == (tg + 1u) * nx) xb_add(&bar[XB_TOPGEN], 1u);
            else XB_SPIN(xb_ld(&bar[XB_TOPGEN]) == tg, bar);
            __builtin_amdgcn_fence(__ATOMIC_ACQUIRE, "agent");
            xb_add(&bar[XB_XGEN(b.x)], 1u);
            asm volatile("s_waitcnt vmcnt(0)" ::: "memory");
        } else {
            XB_SPIN(xb_ld(&bar[XB_XGEN(b.x)]) == gen, bar);
            __builtin_amdgcn_fence(__ATOMIC_ACQUIRE, "agent");
            asm volatile("s_waitcnt vmcnt(0)" ::: "memory");
        }
    }
    __syncthreads();
}

struct Frame {
    LAS unsigned char* lds;
    int tid, lane, wave, vcu, G, bx, vcu0, G0, bx0;
};
enum { I_XP = 0, I_XS, I_ANG, I_WIN, I_PW, I_PS, I_QNG, I_WUQ, I_KVNG, I_WUKV, I_QHG, I_KHG, I_HCW, I_HCB, I_FW1, I_FB1, I_FFR, I_FW2, I_FB2, I_FW3, I_FB3, I_HBIAS, I_GNG, I_WOUT, I_FNG, I_WUP, I_FCW, I_FCB, I_WDN, N_IN };
struct Args { const float* in[N_IN]; float* out; unsigned char* ws; int ph_lo, ph_hi; };
static_assert(sizeof(Args) == (N_IN + 2) * 8 + 8, "Args has no padding");

__device__ __forceinline__ void cvt_item(const float* __restrict__ W, int ldw, int K, bf16* WT, int dst_n0, int src_n0, int k0, const float* __restrict__ ks, LAS float* scr, int lane) {
#pragma unroll
    for (int i = 0; i < 32; ++i) { const int kk = 2 * i + (lane >> 5); float v = W[(size_t)(k0 + kk) * ldw + src_n0 + (lane & 31)]; if (ks) v *= ks[k0 + kk]; scr[kk * 33 + (lane & 31)] = v; }
    LDS_WAIT(); asm volatile("" ::: "memory");
    const int c = lane & 7;
#pragma unroll
    for (int j = 0; j < 4; ++j) { const int n = (lane >> 3) + 8 * j; const LAS float* s = scr + (8 * c) * 33 + n;
        v4u o; o.x = pk2(s[0 * 33], s[1 * 33]); o.y = pk2(s[2 * 33], s[3 * 33]); o.z = pk2(s[4 * 33], s[5 * 33]); o.w = pk2(s[6 * 33], s[7 * 33]);
        *(v4u*)(WT + (size_t)(dst_n0 + n) * K + k0 + 8 * c) = o; }
    LDS_WAIT(); asm volatile("" ::: "memory");
}
struct CvtTile { const float* W; const float* ks; bf16* WT; int ldw, K, src_n0, k0, ncols; int dst[4]; };
__device__ __forceinline__ void cvt_tile(Frame& F, const CvtTile& d) {
    LAS float* T = (LAS float*)F.lds;
#pragma unroll
    for (int i = 0; i < 8; ++i) { const int q = F.tid + 512 * i, row = q >> 5, c4 = q & 31;
        f32x4 v = {0.f, 0.f, 0.f, 0.f};
        if (d.src_n0 + 4 * c4 < d.ncols) v = *(const f32x4*)(d.W + (size_t)(d.k0 + row) * d.ldw + d.src_n0 + 4 * c4);
        if (d.ks) v *= d.ks[d.k0 + row];
        LAS float* t = T + row * 129 + 4 * c4; t[0] = v.x; t[1] = v.y; t[2] = v.z; t[3] = v.w; }
    __syncthreads();
#pragma unroll
    for (int i = 0; i < 4; ++i) { const int n = (F.tid >> 4) + 32 * i, kc = F.tid & 15;
        if (d.src_n0 + n < d.ncols) { const LAS float* s = T + (8 * kc) * 129 + n;
            v4u o; o.x = pk2(s[0], s[129]); o.y = pk2(s[2 * 129], s[3 * 129]); o.z = pk2(s[4 * 129], s[5 * 129]); o.w = pk2(s[6 * 129], s[7 * 129]);
            *(v4u*)(d.WT + (size_t)(d.dst[i] + (n & 31)) * d.K + d.k0 + 8 * kc) = o; } }
    __syncthreads();
}
__device__ __forceinline__ void absmax_tile(Frame& F, const float* __restrict__ W, const float* __restrict__ ks, int ldw, int src_n0, int k0, unsigned* outc) {
    LAS float* P = (LAS float*)F.lds;
    f32x4 m = {0.f, 0.f, 0.f, 0.f};
#pragma unroll
    for (int i = 0; i < 8; ++i) { const int q = F.tid + 512 * i, row = q >> 5, c4 = q & 31;
        const f32x4 v = *(const f32x4*)(W + (size_t)(k0 + row) * ldw + src_n0 + 4 * c4) * ks[k0 + row];
        m.x = fmaxf(m.x, fabsf(v.x)); m.y = fmaxf(m.y, fabsf(v.y)); m.z = fmaxf(m.z, fabsf(v.z)); m.w = fmaxf(m.w, fabsf(v.w)); }
    *(LAS f32x4*)(P + (F.tid >> 5) * 128 + 4 * (F.tid & 31)) = m;
    __syncthreads();
    if (F.tid < 128) { float c = P[F.tid];
#pragma unroll
        for (int g = 1; g < 16; ++g) c = fmaxf(c, P[g * 128 + F.tid]);
        atomicMax(outc + src_n0 + F.tid, __builtin_bit_cast(unsigned, c)); }
    __syncthreads();
}
__device__ __forceinline__ unsigned q8(float v) { const int q = (int)__builtin_rintf(v); return (unsigned)(q < -127 ? -127 : (q > 127 ? 127 : q)) & 0xffu; }
__device__ __forceinline__ void cvtq_tile(Frame& F, const float* __restrict__ W, const float* __restrict__ ks, int ldw, int K, unsigned char* WT, int src_n0, int k0, int dst0, const unsigned* __restrict__ wmaxc) {
    LAS float* T = (LAS float*)F.lds;
    f32x4 inv4; { const v4u mb = *(const v4u*)(wmaxc + src_n0 + 4 * (F.tid & 31));
        inv4.x = 127.0f / fmaxf(__builtin_bit_cast(float, mb.x), 1e-30f); inv4.y = 127.0f / fmaxf(__builtin_bit_cast(float, mb.y), 1e-30f); inv4.z = 127.0f / fmaxf(__builtin_bit_cast(float, mb.z), 1e-30f); inv4.w = 127.0f / fmaxf(__builtin_bit_cast(float, mb.w), 1e-30f); }
#pragma unroll
    for (int i = 0; i < 8; ++i) { const int q = F.tid + 512 * i, row = q >> 5, c4 = q & 31;
        const f32x4 v = *(const f32x4*)(W + (size_t)(k0 + row) * ldw + src_n0 + 4 * c4) * ks[k0 + row] * inv4;
        LAS float* t = T + row * 129 + 4 * c4; t[0] = v.x; t[1] = v.y; t[2] = v.z; t[3] = v.w; }
    __syncthreads();
#pragma unroll
    for (int i = 0; i < 2; ++i) { const int n = (F.tid >> 3) + 64 * i, kc = F.tid & 7;
        const LAS float* s = T + (16 * kc) * 129 + n; unsigned w[4];
#pragma unroll
        for (int j = 0; j < 4; ++j) w[j] = q8(s[(4 * j) * 129]) | (q8(s[(4 * j + 1) * 129]) << 8) | (q8(s[(4 * j + 2) * 129]) << 16) | (q8(s[(4 * j + 3) * 129]) << 24);
        v4u o; o.x = w[0]; o.y = w[1]; o.z = w[2]; o.w = w[3];
        *(v4u*)(WT + (size_t)(dst0 + 64 * (n >> 5) + (n & 31)) * K + k0 + 16 * kc) = o; }
    __syncthreads();
}
__device__ __forceinline__ void xq_row(const bf16* __restrict__ xrow, unsigned char* qrow, const float* __restrict__ ssq32, float* rowf, float s_w, int lane) {
    v4u v[4]; float m = 0.f;
#pragma unroll
    for (int j = 0; j < 4; ++j) { v[j] = *(const v4u*)(xrow + 8 * (lane + 64 * j)); const unsigned w[4] = {v[j].x, v[j].y, v[j].z, v[j].w};
#pragma unroll
        for (int i = 0; i < 4; ++i) m = fmaxf(m, fmaxf(fabsf(bflo(w[i])), fabsf(bfhi(w[i])))); }
    float ss = (lane < 32) ? ssq32[lane] : 0.f;
#pragma unroll
    for (int o = 1; o < 64; o <<= 1) { m = fmaxf(m, __shfl_xor(m, o)); ss += __shfl_xor(ss, o); }
    m = fmaxf(m, 1e-30f); const float inv = 127.0f / m;
    if (lane == 0) *rowf = (1.0f / sqrtf(ss * (1.f / DM) + EPS)) * (m * (1.0f / 127.0f)) * s_w;
#pragma unroll
    for (int j = 0; j < 4; ++j) { const unsigned w[4] = {v[j].x, v[j].y, v[j].z, v[j].w}; v2u o;
        o.x = q8(bflo(w[0]) * inv) | (q8(bfhi(w[0]) * inv) << 8) | (q8(bflo(w[1]) * inv) << 16) | (q8(bfhi(w[1]) * inv) << 24);
        o.y = q8(bflo(w[2]) * inv) | (q8(bfhi(w[2]) * inv) << 8) | (q8(bflo(w[3]) * inv) << 16) | (q8(bfhi(w[3]) * inv) << 24);
        *(v2u*)(qrow + 8 * (lane + 64 * j)) = o; }
}
__device__ __forceinline__ void q8_row(const bf16* __restrict__ xrow, unsigned char* qrow, float rs, float* rowf, int lane) {
    v4u v[4]; float m = 0.f;
#pragma unroll
    for (int j = 0; j < 4; ++j) { v[j] = *(const v4u*)(xrow + 8 * (lane + 64 * j)); const unsigned w[4] = {v[j].x, v[j].y, v[j].z, v[j].w};
#pragma unroll
        for (int i = 0; i < 4; ++i) m = fmaxf(m, fmaxf(fabsf(bflo(w[i])), fabsf(bfhi(w[i])))); }
#pragma unroll
    for (int o = 1; o < 64; o <<= 1) m = fmaxf(m, __shfl_xor(m, o));
    m = fmaxf(m, 1e-30f); const float inv = 127.0f / m;
    if (lane == 0) *rowf = rs * (m * (1.0f / 127.0f));
#pragma unroll
    for (int j = 0; j < 4; ++j) { const unsigned w[4] = {v[j].x, v[j].y, v[j].z, v[j].w}; v2u o;
        o.x = q8(bflo(w[0]) * inv) | (q8(bfhi(w[0]) * inv) << 8) | (q8(bflo(w[1]) * inv) << 16) | (q8(bfhi(w[1]) * inv) << 24);
        o.y = q8(bflo(w[2]) * inv) | (q8(bfhi(w[2]) * inv) << 8) | (q8(bflo(w[3]) * inv) << 16) | (q8(bfhi(w[3]) * inv) << 24);
        *(v2u*)(qrow + 8 * (lane + 64 * j)) = o; }
}
__device__ __forceinline__ void xb_row(const float* xrow, bf16* orow, float* rstd, unsigned char* qrow, float* rowfq, int lane) {
    const f32x4* xr = (const f32x4*)xrow + lane;
    f32x4 v[8]; float s = 0.f;
#pragma unroll
    for (int j = 0; j < 8; ++j) { v[j] = xr[64 * j]; s += (v[j].x * v[j].x + v[j].y * v[j].y) + (v[j].z * v[j].z + v[j].w * v[j].w); }
    const float r = 1.0f / sqrtf(wave_sum(s) * (1.f / DM) + EPS);
    if (lane == 0) *rstd = r;
    v2u* o8 = (v2u*)orow + lane; float mx = 0.f;
#pragma unroll
    for (int j = 0; j < 8; ++j) { v2u w; w.x = pk2(v[j].x, v[j].y); w.y = pk2(v[j].z, v[j].w); o8[64 * j] = w;
        v[j].x = bflo(w.x); v[j].y = bfhi(w.x); v[j].z = bflo(w.y); v[j].w = bfhi(w.y);
        mx = fmaxf(mx, fmaxf(fmaxf(fabsf(v[j].x), fabsf(v[j].y)), fmaxf(fabsf(v[j].z), fabsf(v[j].w)))); }
#pragma unroll
    for (int o = 1; o < 64; o <<= 1) mx = fmaxf(mx, __shfl_xor(mx, o));
    mx = fmaxf(mx, 1e-30f); const float inv = 127.0f / mx;
    if (lane == 0) *rowfq = r * (mx * (1.0f / 127.0f));
    unsigned* q4 = (unsigned*)qrow + lane;
#pragma unroll
    for (int j = 0; j < 8; ++j) q4[64 * j] = q8(v[j].x * inv) | (q8(v[j].y * inv) << 8) | (q8(v[j].z * inv) << 16) | (q8(v[j].w * inv) << 24);
}
__device__ __forceinline__ void rstd_from_partials(const float* __restrict__ ssqp, float* rstd, size_t gtid, size_t gthreads) {
    for (size_t r = gtid; r < (size_t)M; r += gthreads) { const f32x4* p = (const f32x4*)(ssqp + r * 32); f32x4 a = p[0];
#pragma unroll
        for (int i = 1; i < 8; ++i) a += p[i];
        rstd[r] = 1.0f / sqrtf(((a.x + a.y) + (a.z + a.w)) * (1.f / DM) + EPS); }
}
__device__ __forceinline__ void tile_norm_store(LAS float* tile, bf16* dst, int row0, int col_off, int wave, int lane) {
#pragma unroll
    for (int i = 0; i < 8; ++i) { const int t = wave * 8 + i;
        const f32x4 a = *(LAS f32x4*)(tile + t * 512 + 8 * lane), b = *(LAS f32x4*)(tile + t * 512 + 8 * lane + 4);
        const float s = (a.x * a.x + a.y * a.y) + (a.z * a.z + a.w * a.w) + (b.x * b.x + b.y * b.y) + (b.z * b.z + b.w * b.w);
        const float rstd = 1.0f / sqrtf(wave_sum(s) * (1.f / 512.f) + EPS);
        v4u o; o.x = pk2(a.x * rstd, a.y * rstd); o.y = pk2(a.z * rstd, a.w * rstd); o.z = pk2(b.x * rstd, b.y * rstd); o.w = pk2(b.z * rstd, b.w * rstd);
        *(v4u*)(dst + (size_t)(row0 + t) * DM + col_off + 8 * lane) = o; }
}
__device__ __forceinline__ void poolfold_item(Frame& F, const float* __restrict__ win, const float* __restrict__ pw, const float* __restrict__ ps, const float* __restrict__ g1, bf16* BtIn, int g, int kb) {
    LAS float* At = (LAS float*)F.lds; LAS float* Bt = (LAS float*)(F.lds + 32768);
    const int k0 = 64 * kb;
#pragma unroll
    for (int i = 0; i < 4; ++i) { const int q = F.tid + 512 * i, row = q >> 5, c4 = q & 31; *(LAS f32x4*)(At + row * 128 + 4 * c4) = *(const f32x4*)(win + (size_t)(k0 + row) * DIN + 128 * g + 4 * c4) * g1[k0 + row]; }
#pragma unroll
    for (int i = 0; i < 8; ++i) { const int q = F.tid + 512 * i, row = q >> 5, c4 = q & 31; *(LAS f32x4*)(Bt + row * 128 + 4 * c4) = *(const f32x4*)(pw + (size_t)(g * 128 + row) * 128 + 4 * c4); }
    __syncthreads();
    const int n = F.tid & 127, kg = F.tid >> 7;
    float acc[16];
#pragma unroll
    for (int i = 0; i < 16; ++i) acc[i] = 0.f;
    for (int j = 0; j < 128; j += 4) {
        const float b0 = Bt[(j + 0) * 128 + n], b1 = Bt[(j + 1) * 128 + n], b2 = Bt[(j + 2) * 128 + n], b3 = Bt[(j + 3) * 128 + n];
#pragma unroll
        for (int i = 0; i < 16; ++i) { const f32x4 a = *(LAS f32x4*)(At + (kg * 16 + i) * 128 + j); acc[i] += a.x * b0 + a.y * b1 + a.z * b2 + a.w * b3; }
    }
    const float sc = ps[128 * g + n];
    v4u o0, o1;
    o0.x = pk2(acc[0] * sc, acc[1] * sc); o0.y = pk2(acc[2] * sc, acc[3] * sc); o0.z = pk2(acc[4] * sc, acc[5] * sc); o0.w = pk2(acc[6] * sc, acc[7] * sc);
    o1.x = pk2(acc[8] * sc, acc[9] * sc); o1.y = pk2(acc[10] * sc, acc[11] * sc); o1.z = pk2(acc[12] * sc, acc[13] * sc); o1.w = pk2(acc[14] * sc, acc[15] * sc);
    bf16* dst = BtIn + (size_t)(128 * g + n) * DM + k0 + kg * 16;
    *(v4u*)dst = o0; *(v4u*)(dst + 8) = o1;
    __syncthreads();
}
__device__ __forceinline__ void filter_item(Frame& F, const float* __restrict__ w1, const float* __restrict__ b1, const float* __restrict__ fr, const float* __restrict__ w2, const float* __restrict__ b2,
                                            const float* __restrict__ w3, const float* __restrict__ b3, const float* __restrict__ hbias, bf16* RF, int fi) {
    LAS float* ZF = (LAS float*)F.lds; LAS float* H1 = ZF + 512; LAS float* H2 = ZF + 1536; LAS float* W1s = ZF + 2560; LAS float* W2s = ZF + 3712;
    const int t0 = 16 * fi;
    for (int q = F.tid; q < 272; q += 512) *(LAS f32x4*)(W1s + 4 * q) = *(const f32x4*)(w1 + 4 * q);
#pragma unroll
    for (int i = 0; i < 2; ++i) { const int q = F.tid + 512 * i; *(LAS f32x4*)(W2s + 4 * q) = *(const f32x4*)(w2 + 4 * q); }
    if (F.tid < 272) { const int tt = F.tid / 17, f = F.tid % 17; const float t = (float)(t0 + tt);
        float v;
        if (f == 0) v = t / 2047.0f;
        else { const int j = (f - 1) & 7; const float band = 1e-4f + (float)j * ((7.0f - 1e-4f) / 7.0f); const float w = (6.283185307179586f * t) / 2048.0f; const float a = band * w; v = (f <= 8) ? __cosf(a) : -__sinf(a); }
        ZF[tt * 17 + f] = v; }
    __syncthreads();
#pragma unroll
    for (int rep = 0; rep < 2; ++rep) { const int p = F.tid + 512 * rep, tt = p >> 6, j = p & 63; float s = b1[j];
#pragma unroll
        for (int i = 0; i < 17; ++i) s += ZF[tt * 17 + i] * W1s[i * 64 + j];
        H1[tt * 64 + j] = __sinf(fr[j] * s); }
    __syncthreads();
#pragma unroll
    for (int rep = 0; rep < 2; ++rep) { const int p = F.tid + 512 * rep, tt = p >> 6, j = p & 63; float s = b2[j];
#pragma unroll 16
        for (int i = 0; i < 64; ++i) s += H1[tt * 64 + i] * W2s[i * 64 + j];
        H2[tt * 64 + j] = __sinf(fr[j] * s); }
    __syncthreads();
    const int c = F.tid;
    const float delta = -3.0701134573253944f + (float)c * ((-15.350567286626972f + 3.0701134573253944f) / 511.0f);
    const float ad = fabsf(delta);
    bf16* rf = RF + (size_t)c * hy::RFS;
#pragma unroll 1
    for (int dir = 0; dir < 2; ++dir) { const int o = dir * 512 + c; const float bo = b3[o];
        float wc[64];
#pragma unroll
        for (int i = 0; i < 64; ++i) wc[i] = w3[i * 1024 + o];
#pragma unroll 1
        for (int tt = 0; tt < 16; ++tt) { float s = bo;
#pragma unroll
            for (int i = 0; i < 64; i += 4) { const f32x4 hv = *(LAS f32x4*)(H2 + tt * 64 + i); s += (hv.x * wc[i] + hv.y * wc[i + 1]) + (hv.z * wc[i + 2] + hv.w * wc[i + 3]); }
            const int t = t0 + tt; const float tl = (float)t / 2047.0f; float val = s * __expf(-tl * ad);
            if (dir == 0) { if (t == 0) val += hbias[c]; rf[2048 - t] = (bf16)f2bf(val); }
            else if (t >= 1) rf[2048 + t] = (bf16)f2bf(val); } }
    if (fi == 0) { rf[0] = 0;
#pragma unroll
        for (int i = 4096; i < hy::RFS; ++i) rf[i] = 0; }
    __syncthreads();
}
__device__ __forceinline__ void unpack4(const v2u w, float (&x)[4]) { x[0] = bflo(w.x); x[1] = bfhi(w.x); x[2] = bflo(w.y); x[3] = bfhi(w.y); }
__device__ __forceinline__ void pair_norm_store(Frame& F, const float (&y)[8][4], bf16* dst, size_t row0, int col_off, int cq) {
    LAS float* part = (LAS float*)F.lds;
    float ss[8];
#pragma unroll
    for (int k = 0; k < 8; ++k) ss[k] = wave_sum((y[k][0] * y[k][0] + y[k][1] * y[k][1]) + (y[k][2] * y[k][2] + y[k][3] * y[k][3]));
    if (F.lane == 0) { *(LAS f32x4*)(part + F.wave * 8) = (f32x4){ss[0], ss[1], ss[2], ss[3]}; *(LAS f32x4*)(part + F.wave * 8 + 4) = (f32x4){ss[4], ss[5], ss[6], ss[7]}; }
    __syncthreads();
    const f32x4 pa = *(LAS f32x4*)(part + (F.wave ^ 1) * 8), pb = *(LAS f32x4*)(part + (F.wave ^ 1) * 8 + 4);
    const float po[8] = {pa.x, pa.y, pa.z, pa.w, pb.x, pb.y, pb.z, pb.w};
#pragma unroll
    for (int k = 0; k < 8; ++k) { const float rstd = 1.0f / sqrtf((ss[k] + po[k]) * (1.f / 512.f) + EPS);
        v2u o; o.x = pk2(y[k][0] * rstd, y[k][1] * rstd); o.y = pk2(y[k][2] * rstd, y[k][3] * rstd);
        *(v2u*)(dst + (row0 + k) * DM + col_off + 4 * cq) = o; }
    __syncthreads();
}
__device__ __forceinline__ void hyprep_item(Frame& F, const bf16* __restrict__ PROJ, const float* __restrict__ cw, const float* __restrict__ cb, bf16* ZT, bf16* X0, int b, int tile) {
    const int tb = F.tid >> 7, cq = F.tid & 127, c0 = 4 * cq, tw = tile * 32 + tb * 8; const size_t rb = (size_t)b * SEQ;
    float z[8][4];
    v2u rh[3][10];
#pragma unroll
    for (int j = 0; j < 3; ++j)
#pragma unroll
        for (int o = 0; o < 10; ++o) { const int t = tw - 1 + o; const int tc = ((t >= 0) && (t < SEQ)) ? t : tw; rh[j][o] = *(const v2u*)(PROJ + (rb + tc) * DINP + O_HY + 512 * j + c0); }
#pragma unroll
    for (int jj = 0; jj < 3; ++jj) { const int j = (jj == 0) ? 1 : (jj == 1) ? 2 : 0; const int cc = 512 * j + c0;
        const f32x4 w0 = *(const f32x4*)(cw + cc), w1 = *(const f32x4*)(cw + 1536 + cc), w2 = *(const f32x4*)(cw + 3072 + cc), bs = *(const f32x4*)(cb + cc);
        float x[10][4];
#pragma unroll
        for (int o = 0; o < 10; ++o) { const int t = tw - 1 + o; const bool ok = (t >= 0) && (t < SEQ); unpack4(rh[j][o], x[o]);
            if (!ok) { x[o][0] = 0.f; x[o][1] = 0.f; x[o][2] = 0.f; x[o][3] = 0.f; } }
        if (jj == 0) {
#pragma unroll
            for (int k = 0; k < 8; ++k)
#pragma unroll
                for (int i = 0; i < 4; ++i) z[k][i] = w0[i] * x[k][i] + w1[i] * x[k + 1][i] + w2[i] * x[k + 2][i] + bs[i];
        } else if (jj == 1) {
#pragma unroll
            for (int k = 0; k < 8; ++k)
#pragma unroll
                for (int i = 0; i < 4; ++i) z[k][i] *= w0[i] * x[k][i] + w1[i] * x[k + 1][i] + w2[i] * x[k + 2][i] + bs[i];
#pragma unroll
            for (int i = 0; i < 4; ++i) { v4u o; o.x = pk2(z[0][i], z[1][i]); o.y = pk2(z[2][i], z[3][i]); o.z = pk2(z[4][i], z[5][i]); o.w = pk2(z[6][i], z[7][i]);
                *(v4u*)(ZT + ((size_t)(c0 + i) * NSEQ + b) * SEQ + tw) = o; }
        } else {
#pragma unroll
            for (int k = 0; k < 8; ++k) { float u0[4];
#pragma unroll
                for (int i = 0; i < 4; ++i) u0[i] = w0[i] * x[k][i] + w1[i] * x[k + 1][i] + w2[i] * x[k + 2][i] + bs[i];
                v2u o; o.x = pk2(u0[0], u0[1]); o.y = pk2(u0[2], u0[3]); *(v2u*)(X0 + (rb + tw + k) * HYC + c0) = o; }
        }
    }
}
__device__ __forceinline__ void pool_item(Frame& F, const bf16* __restrict__ PROJ, bf16* MIXED, int b, int tile) {
    const int tb = F.tid >> 7, cq = F.tid & 127, c0 = 4 * cq, g = cq >> 5, half = 1 << g, tw = tile * 32 + tb * 8; const size_t rb = (size_t)b * SEQ;
    float x[23][4];
#pragma unroll
    for (int o = 0; o < 23; ++o) { const int t = tw - 8 + o; const bool ok = (t >= 0) && (t < SEQ); const int tc = ok ? t : tw;
        const v2u w = *(const v2u*)(PROJ + (rb + tc) * DINP + c0); unpack4(w, x[o]);
        if (!ok) { x[o][0] = 0.f; x[o][1] = 0.f; x[o][2] = 0.f; x[o][3] = 0.f; } }
    float y[8][4];
#pragma unroll
    for (int k = 0; k < 8; ++k) { const int oc = 8 + k, t = tw + k; const int lo = (t - half > 0) ? t - half : 0, hi = (t + half < SEQ) ? t + half : SEQ; const float inv = 1.0f / (float)(hi - lo);
#pragma unroll
        for (int i = 0; i < 4; ++i) {
            const float w1 = x[oc - 1][i] + x[oc][i];
            const float w2 = w1 + (x[oc - 2][i] + x[oc + 1][i]);
            const float w4 = w2 + ((x[oc - 4][i] + x[oc - 3][i]) + (x[oc + 2][i] + x[oc + 3][i]));
            const float w8 = w4 + (((x[oc - 8][i] + x[oc - 7][i]) + (x[oc - 6][i] + x[oc - 5][i])) + ((x[oc + 4][i] + x[oc + 5][i]) + (x[oc + 6][i] + x[oc + 7][i])));
            const float S = (g == 0) ? w1 : (g == 1) ? w2 : (g == 2) ? w4 : w8;
            y[k][i] = S * inv - x[oc][i]; } }
    pair_norm_store(F, y, MIXED, rb + tw, 0, cq);
}
__device__ __forceinline__ void hyfin_item(Frame& F, const bf16* __restrict__ YC, const bf16* __restrict__ X0, bf16* MIXED, int b, int tile) {
    const int tb = F.tid >> 7, cq = F.tid & 127, c0 = 4 * cq, tw = tile * 32 + tb * 8; const size_t rb = (size_t)b * SEQ;
    float yc[4][8], y[8][4];
#pragma unroll
    for (int i = 0; i < 4; ++i) { const v4u v = *(const v4u*)(YC + ((size_t)(c0 + i) * NSEQ + b) * SEQ + tw);
        yc[i][0] = bflo(v.x); yc[i][1] = bfhi(v.x); yc[i][2] = bflo(v.y); yc[i][3] = bfhi(v.y); yc[i][4] = bflo(v.z); yc[i][5] = bfhi(v.z); yc[i][6] = bflo(v.w); yc[i][7] = bfhi(v.w); }
#pragma unroll
    for (int k = 0; k < 8; ++k) { float xv[4]; unpack4(*(const v2u*)(X0 + (rb + tw + k) * HYC + c0), xv);
#pragma unroll
        for (int i = 0; i < 4; ++i) y[k][i] = yc[i][k] * xv[i]; }
    pair_norm_store(F, y, MIXED, rb + tw, 1536, cq);
}
struct PrepGains { float q[3][8], k[3][8]; };
__device__ __forceinline__ void load8(const float* p, float (&o)[8]) { const f32x4 a = *(const f32x4*)p, b = *(const f32x4*)(p + 4); o[0] = a.x; o[1] = a.y; o[2] = a.z; o[3] = a.w; o[4] = b.x; o[5] = b.y; o[6] = b.z; o[7] = b.w; }
__device__ __forceinline__ void unpack8(const v4u w, float (&x)[8]) { x[0] = bflo(w.x); x[1] = bfhi(w.x); x[2] = bflo(w.y); x[3] = bfhi(w.y); x[4] = bflo(w.z); x[5] = bfhi(w.z); x[6] = bflo(w.w); x[7] = bfhi(w.w); }
__device__ __forceinline__ v4u pack8(const float (&x)[8]) { v4u o; o.x = pk2(x[0], x[1]); o.y = pk2(x[2], x[3]); o.z = pk2(x[4], x[5]); o.w = pk2(x[6], x[7]); return o; }
__device__ __forceinline__ float ssq8(const float (&x)[8]) { return ((x[0] * x[0] + x[1] * x[1]) + (x[2] * x[2] + x[3] * x[3])) + ((x[4] * x[4] + x[5] * x[5]) + (x[6] * x[6] + x[7] * x[7])); }
__device__ __forceinline__ float sum8lanes(float v) { v += __shfl_xor(v, 1); v += __shfl_xor(v, 2); v += __shfl_xor(v, 4); return v; }
__device__ __forceinline__ void prep_row(const bf16* __restrict__ PROJ, bf16* Q, bf16* KV, const PrepGains& G, const float* __restrict__ ROPE, int m, int lane) {
    const int h = lane >> 3, sub = lane & 7;
    const bf16* pr = PROJ + (size_t)m * DINP; bf16* qr = Q + (size_t)m * NQ + 192 * h + 8 * sub; bf16* kr = KV + (size_t)m * NKVP + KVHS * h + 8 * sub;
    const v4u pev = *(const v4u*)(pr + O_KPE + 8 * sub);
    const v4u k0 = *(const v4u*)(kr), k1 = *(const v4u*)(kr + 64);
    float cs[8], sn[8]; { const float* rp = ROPE + (size_t)(m & (SEQ - 1)) * 64 + 8 * (sub & 3); load8(rp, cs); load8(rp + 32, sn); }
    const float sg = (sub < 4) ? -1.f : 1.f;
    { float a0[8], a1[8], pe[8]; unpack8(k0, a0); unpack8(k1, a1); unpack8(pev, pe);
      const float ss = sum8lanes((ssq8(a0) + ssq8(a1)) + ssq8(pe));
      const float sk = 1.0f / sqrtf(ss * (1.f / 192.f) + EPS);
      float r[8], o[8];
#pragma unroll
      for (int i = 0; i < 8; ++i) { a0[i] *= sk * G.k[0][i]; a1[i] *= sk * G.k[1][i]; r[i] = pe[i] * sk * G.k[2][i]; }
#pragma unroll
      for (int i = 0; i < 8; ++i) { const float rp = __shfl_xor(r[i], 4); o[i] = r[i] * cs[i] + sg * rp * sn[i]; }
      *(v4u*)(kr) = pack8(a0); *(v4u*)(kr + 64) = pack8(a1); *(v4u*)(kr + 128) = pack8(o); }
}
__device__ __forceinline__ void attn_norm_row(bf16* MIXED, int m, int lane) {
    v4u* p = (v4u*)(MIXED + (size_t)m * DM + 512 + 16 * lane); v4u a = p[0], b = p[1];
    unsigned w[8] = {a.x, a.y, a.z, a.w, b.x, b.y, b.z, b.w}; float s = 0.f;
#pragma unroll
    for (int i = 0; i < 8; ++i) { const float x = bflo(w[i]), y = bfhi(w[i]); s += x * x + y * y; }
    const float rstd = 1.0f / sqrtf(wave_sum(s) * (1.f / 1024.f) + EPS);
#pragma unroll
    for (int i = 0; i < 8; ++i) w[i] = pk2(bflo(w[i]) * rstd, bfhi(w[i]) * rstd);
    a.x = w[0]; a.y = w[1]; a.z = w[2]; a.w = w[3]; b.x = w[4]; b.y = w[5]; b.z = w[6]; b.w = w[7]; p[0] = a; p[1] = b;
}

#define DEFPTRS() unsigned char* ws = args.ws + (size_t)(unsigned)opq_s(0); \
    bf16* BtIn = (bf16*)(ws + WS_BTIN); bf16* BtUq = (bf16*)(ws + WS_BTUQ); bf16* BtKv = (bf16*)(ws + WS_BTKV); bf16* BtOut = (bf16*)(ws + WS_BTOUT); bf16* BtUp = (bf16*)(ws + WS_BTUP); bf16* BtDn = (bf16*)(ws + WS_BTDN); \
    bf16* RF = (bf16*)(ws + WS_RF); bf16* Hb = (bf16*)(ws + WS_H); bf16* PROJ = (bf16*)(ws + WS_PROJ); bf16* Qb = (bf16*)(ws + WS_Q); bf16* KVb = (bf16*)(ws + WS_KV); \
    bf16* ZT = (bf16*)(ws + WS_ZT); bf16* X0 = (bf16*)(ws + WS_X0); bf16* YC = (bf16*)(ws + WS_YC); float* EDGE = (float*)(ws + WS_EDGE); float* ROPE = (float*)(ws + WS_ROPE); float* SSQP = (float*)(ws + WS_SSQP); float* RSTD = (float*)(ws + WS_RSTD); bf16* XB2 = (bf16*)(ws + WS_XB2); unsigned char* XQ = (unsigned char*)(ws + WS_XQ); float* SSQCQ = (float*)(ws + WS_SSQCQ); unsigned char* BtInQ = (unsigned char*)(ws + WS_BTINQ); float* CSIN = (float*)(ws + WS_CSIN); float* RSTDQ = (float*)(ws + WS_RSTDQ); float* SSQKPE = (float*)(ws + WS_SSQKPE); unsigned char* BtUpQ = (unsigned char*)(ws + WS_BTUP); bf16* ACT = (bf16*)(ws + WS_ACT); \
    bf16* XA = (bf16*)args.out; \
    (void)BtIn; (void)BtUq; (void)BtKv; (void)BtOut; (void)BtUp; (void)BtDn; (void)RF; (void)Hb; (void)PROJ; (void)Qb; (void)KVb; (void)ZT; (void)X0; (void)YC; (void)EDGE; (void)ROPE; (void)SSQP; (void)RSTD; (void)XB2; (void)XQ; (void)SSQCQ; (void)BtInQ; (void)CSIN; (void)RSTDQ; (void)SSQKPE; (void)BtUpQ; (void)ACT; (void)XA
__global__ void __launch_bounds__(NWAVES * 64, 2) fwd(Args args) {
    extern __shared__ __attribute__((aligned(16))) unsigned char lds_raw[];
    Frame F;
    F.lds = (LAS unsigned char*)lds_raw;
    F.tid = threadIdx.x; F.lane = F.tid & 63; F.wave = __builtin_amdgcn_readfirstlane(F.tid >> 6);
    F.G = gridDim.x; { const int bx = blockIdx.x; F.vcu = (F.G % 8 == 0) ? (bx % 8) * (F.G / 8) + bx / 8 : bx; F.bx = bx; } F.G0 = F.G; F.vcu0 = F.vcu; F.bx0 = F.bx;
    volatile LAS unsigned* MISC = (volatile LAS unsigned*)(F.lds + MISC_OFF);
    if (F.tid < 64) MISC[F.tid] = 0u;
    __syncthreads();
    unsigned* ctl = (unsigned*)(args.ws + WS_CTL);
    const int lo = args.ph_lo, hi = args.ph_hi;
    XcdBarrier bar; bar.bar = ctl + CW_BAR; bar.x = 0; bar.st = MISC + 8;
    if (hi - lo > 1) bar = xcd_barrier_post(ctl + CW_BAR, MISC + 8);
    float* out = args.out;

#pragma unroll 1
    for (int layer = 0; layer < DEPTH; ++layer) {
        const int pb = layer * NPH;
        if (pb + NPH <= lo || pb >= hi) continue;
#define IN(k) (lo <= pb + (k) && pb + (k) < hi)
#define ENTER() DEFPTRS(); F.G = opq_s(F.G0); F.vcu = opq_s(F.vcu0); F.bx = opq_s(F.bx0); F.tid = opq(threadIdx.x); F.lane = F.tid & 63; F.wave = __builtin_amdgcn_readfirstlane(F.tid >> 6); const int gw = F.vcu * NWAVES + F.wave, NGW = F.G * NWAVES, wg = F.vcu; const size_t gtid = (size_t)wg * 512 + F.tid, gthreads = (size_t)F.G * 512; (void)gw; (void)NGW; (void)wg; (void)gtid; (void)gthreads
#define SEAM(k) do { if (pb + (k) + 1 < hi) xcd_barrier(bar); } while (0)

        if (IN(0)) { ENTER();
            const float* win = args.in[I_WIN] + (size_t)layer * DM * DIN; const float* g1 = args.in[I_ANG] + layer * DM;
            for (int it = wg; it < 256; it += F.G) {
                if (it < 128) poolfold_item(F, win, args.in[I_PW] + (size_t)layer * 4 * 128 * 128, args.in[I_PS] + (size_t)layer * 512, g1, BtIn, it >> 5, it & 31);
                else filter_item(F, args.in[I_FW1] + (size_t)layer * 17 * 64, args.in[I_FB1] + layer * 64, args.in[I_FFR] + layer * 64, args.in[I_FW2] + (size_t)layer * 64 * 64, args.in[I_FB2] + layer * 64,
                                 args.in[I_FW3] + (size_t)layer * 64 * 1024, args.in[I_FB3] + layer * 1024, args.in[I_HBIAS] + layer * 512, RF, it - 128);
            }
            constexpr int T_IN = 19 * 16, T_UQ = 12 * 4, T_KV = 16 * 2, T_OUT = 16 * 16, T_UP = 88 * 16, T_DN = 16 * 44, T_ALL = T_IN + T_UQ + T_KV + T_OUT + T_UP + T_DN;
            for (int it = wg; it < T_ALL; it += F.G) {
                int r = it; CvtTile d;
                if (r < T_IN) { const int nt = r >> 4, kt = r & 15, n0 = 512 + 128 * nt; d = CvtTile{win, g1, BtIn, DIN, DM, n0, 128 * kt, DIN, {n0, n0 + 32, n0 + 64, n0 + 96}}; }
                else if ((r -= T_IN) < T_UQ) { const int nt = r >> 2, kt = r & 3, n0 = 128 * nt; d = CvtTile{args.in[I_WUQ] + (size_t)layer * 512 * NQ, args.in[I_QNG] + layer * 512, BtUq, NQ, 512, n0, 128 * kt, NQ, {n0, n0 + 32, n0 + 64, n0 + 96}}; }
                else if ((r -= T_UQ) < T_KV) { const int nt = r >> 1, kt = r & 1, n0 = 128 * nt;
                    d = CvtTile{args.in[I_WUKV] + (size_t)layer * 256 * 2048, args.in[I_KVNG] + layer * 256, BtKv, 2048, 256, n0, 128 * kt, 2048, {n0, n0 + 32, n0 + 64, n0 + 96}}; }
                else if ((r -= T_KV) < T_OUT) { const int nt = r >> 4, kt = r & 15, n0 = 128 * nt; d = CvtTile{args.in[I_WOUT] + (size_t)layer * DM * DM, args.in[I_GNG] + layer * DM, BtOut, DM, DM, n0, 128 * kt, DM, {n0, n0 + 32, n0 + 64, n0 + 96}}; }
                else if ((r -= T_OUT) < T_UP) { const int nt = r >> 4, kt = r & 15;
                    absmax_tile(F, args.in[I_WUP] + (size_t)layer * DM * NUP, args.in[I_FNG] + layer * DM, NUP, 128 * nt, 128 * kt, ctl + CW_WMAXC + layer * NUP); continue; }
                else { r -= T_UP; const int nt = r / 44, kt = r % 44, n0 = 128 * nt; d = CvtTile{args.in[I_WDN] + (size_t)layer * DFF * DM, nullptr, BtDn, DM, DFF, n0, 128 * kt, DM, {n0, n0 + 32, n0 + 64, n0 + 96}}; }
                cvt_tile(F, d);
            }
            { unsigned zz = 0u; asm volatile("" : "+v"(zz)); v4u z = {zz, zz, zz, zz};
              for (size_t i = gtid; i < (size_t)(DINP - DIN) * DM / 8; i += gthreads) *(v4u*)(BtIn + (size_t)DIN * DM + i * 8) = z;
}
            if (layer == 0) for (size_t i = gtid; i < (size_t)SEQ * 32; i += gthreads) { const int pos = (int)(i >> 5), ri = (int)(i & 31);
                const float freq = exp2f(-(float)ri * (13.287712379549449f / 32.0f)); float sn, cs; sincosf((float)pos * freq, &sn, &cs); ROPE[pos * 64 + ri] = cs; ROPE[pos * 64 + 32 + ri] = sn; }
            if (layer == 0) { for (int m = gw; m < M; m += NGW) xb_row(m < MP ? args.in[I_XP] + (size_t)m * DM : args.in[I_XS] + (size_t)(m - MP) * DM, XA + (size_t)m * DM, RSTD + m, XQ + (size_t)m * DM, RSTDQ + m, F.lane); }
            else rstd_from_partials(SSQP, RSTD, gtid, gthreads);
            xcd_barrier(bar);
            for (int r = gw; r < NINQ; r += NGW) q8_row(BtIn + (size_t)(r < 512 ? r : r + 1024) * DM, BtInQ + (size_t)r * DM, 1.0f, CSIN + r, F.lane);
            if (layer > 0) for (int m = gw; m < M; m += NGW) q8_row(XA + (size_t)m * DM, XQ + (size_t)m * DM, RSTD[m], RSTDQ + m, F.lane);
            SEAM(0);
        }
        if (IN(1)) { ENTER();
            { pg8::Gemm g{(const bf16*)XQ, (const bf16*)BtInQ, M, NINQ, DM / 2, DM / 2}; pg8::StaticOrder S; S.init(M, NINQ, F.G, F.bx);
              pg8::EpiBf16 E{PROJ, DINP, RSTDQ, 0, -1, nullptr, 0.f, nullptr, 0, CSIN, 2, 4, nullptr, -1, nullptr, 0, nullptr, nullptr, nullptr, 0};
              pg8::gemm_phase<pg8::EpiBf16, pg8::StaticOrder, true>(F.lds, g, S, E); }
            { pg8::Gemm g{XA, BtIn + (size_t)512 * DM, M, 1024, DM, DM}; pg8::StaticOrder S; S.init(M, 1024, F.G, F.bx);
              pg8::EpiBf16 E{PROJ + 512, DINP, RSTD, 0, O_CKV / 256 - 2, (LAS float*)(F.lds + HALO_OFF), EPS, SSQCQ, O_CQ / 256 - 2, nullptr, 1 << 30, 0, SSQKPE, O_KPE / 256 - 2, nullptr, 0, nullptr, nullptr, nullptr, 0};
              pg8::gemm_phase<pg8::EpiBf16, pg8::StaticOrder>(F.lds, g, S, E); }
            SEAM(1);
        }
        if (IN(2)) { ENTER();
            { pg8::Gemm g{PROJ + O_CQ, BtUq, M, NQ, 512, DINP}; pg8::StaticOrder S; S.init(M, NQ, F.G, F.bx); pg8::EpiBf16 E{Qb, NQ, nullptr, 0, -1, nullptr, 0.f, nullptr, 0, nullptr, 1 << 30, 0, nullptr, -1, nullptr, 0, nullptr, nullptr, nullptr, 0};
              pg8::gemm_phase<pg8::EpiBf16, pg8::StaticOrder>(F.lds, g, S, E); }
            { pg8::Gemm g{PROJ + O_CKV, BtKv, M, 2048, 256, DINP}; pg8::StaticOrder S; S.init(M, 2048, F.G, F.bx); pg8::EpiBf16 E{KVb, NKVP, nullptr, 1, -1, (LAS float*)(F.lds + HALO_OFF), EPS, nullptr, 0, nullptr, 1 << 30, 0, nullptr, -1, PROJ + O_KPE, DINP, ROPE, args.in[I_KHG] + layer * 192, SSQKPE, SEQ - 1};
              pg8::gemm_phase<pg8::EpiBf16, pg8::StaticOrder>(F.lds, g, S, E); }
            const float* hcw = args.in[I_HCW] + (size_t)layer * 3 * 1536; const float* hcb = args.in[I_HCB] + layer * 1536;
            for (int it = wg; it < NSEQ * 64; it += F.G) hyprep_item(F, PROJ, hcw, hcb, ZT, X0, it >> 6, it & 63);
            SEAM(2);
        }
        if (IN(3)) { ENTER();
            const int odd = __builtin_amdgcn_readfirstlane(opq((F.bx >> 3) & 1));
            if (!odd) { for (int u = wg; u < 2 * HYC; u += F.G) hy::conv_unit(F.lds, ZT, RF, YC, u >> 1, u & 1); __syncthreads(); F.tid = opq(threadIdx.x); }
            for (int it = wg; it < NSEQ * 64; it += F.G) pool_item(F, PROJ, Hb, it >> 6, it & 63);
            if (odd) { __syncthreads(); for (int u = wg; u < 2 * HYC; u += F.G) hy::conv_unit(F.lds, ZT, RF, YC, u >> 1, u & 1); }
            SEAM(3);
        }
        if (IN(4)) { ENTER();
            float gqm, gkm; { const float* qhg = args.in[I_QHG] + layer * 192; const float* khg = args.in[I_KHG] + layer * 192;
                gqm = fmaxf(fmaxf(fabsf(qhg[F.lane]), fabsf(qhg[64 + F.lane])), fabsf(qhg[128 + F.lane])); gkm = fmaxf(fmaxf(fabsf(khg[F.lane]), fabsf(khg[64 + F.lane])), fabsf(khg[128 + F.lane]));
#pragma unroll
                for (int o = 1; o < 64; o <<= 1) { gqm = fmaxf(gqm, __shfl_xor(gqm, o)); gkm = fmaxf(gkm, __shfl_xor(gkm, o)); } }
            const float Mnat = 13.856406460551018f * gqm * gkm;
            const bool sm_fast = __builtin_amdgcn_readfirstlane((Mnat <= 40.0f) ? 1 : 0) != 0;
            const float negMC = __builtin_bit_cast(float, __builtin_amdgcn_readfirstlane(__builtin_bit_cast(int, -Mnat * 1.4426950408889634f)));
            for (int i = 0; i * F.G < NSEQ * NH * 8; ++i) {
                int p, qb; const int c = F.bx;
                if (F.G == 256) { p = i * 32 + (c & 7) * 4 + (c >> 6); qb = (c >> 3) & 7; } else { const int Lq = i * F.G + c; p = Lq >> 3; qb = Lq & 7; }
                if (p < NSEQ * NH) { const int b = p >> 3, h = p & 7;
                    const bf16* qp = Qb + (size_t)(b * SEQ + qb * 256) * NQ + h * 192; const bf16* kp = KVb + (size_t)(b * SEQ) * NKVP + h * KVHS; bf16* op = Hb + (size_t)(b * SEQ + qb * 256) * DM + 512 + h * 128;
                    const float* sq = SSQCQ + (size_t)(b * SEQ + qb * 256) * 8; const float* qgp = args.in[I_QHG] + layer * 192; const float* rp0 = ROPE + (size_t)(qb * 256) * 64;
                    if (sm_fast) at::attn_unit<true>(negMC, qp, kp, kp + 192, op, SEQ, (char*)lds_raw, sq, qgp, rp0);
                    else at::attn_unit<false>(0.f, qp, kp, kp + 192, op, SEQ, (char*)lds_raw, sq, qgp, rp0); }
            }
            for (int it = wg; it < NSEQ * 64; it += F.G) hyfin_item(F, YC, X0, Hb, it >> 6, it & 63);
            SEAM(4);
        }
        if (IN(5)) { ENTER();
            for (int m = gw; m < M; m += NGW) attn_norm_row(Hb, m, F.lane);
            SEAM(5);
        }
        if (IN(6)) { ENTER();
            pg8::Gemm g{Hb, BtOut, M, DM, DM, DM}; pg8::StaticOrder S; S.init(M, DM, F.G, F.bx);
            pg8::EpiResid16 E{XA, XB2, out, DM, SSQP, 0};
            pg8::gemm_phase<pg8::EpiResid16, pg8::StaticOrder>(F.lds, g, S, E);
            SEAM(6);
        }
        if (IN(7)) { ENTER();
            const unsigned* wmaxc = ctl + CW_WMAXC + layer * NUP;
            const int p7odd = __builtin_amdgcn_readfirstlane(opq((F.bx >> 3) & 1));
            if (p7odd) { for (int m = gw; m < M; m += NGW) xq_row(XB2 + (size_t)m * DM, XQ + (size_t)m * DM, SSQP + (size_t)m * 32, RSTD + m, 1.0f, F.lane); __syncthreads(); }
            for (int it = wg; it < 88 * 16; it += F.G) { const int nt = it >> 4, kt = it & 15; const int nv = (nt < 44) ? nt : nt - 44;
                cvtq_tile(F, args.in[I_WUP] + (size_t)layer * DM * NUP, args.in[I_FNG] + layer * DM, NUP, DM, BtUpQ, 128 * nt, 128 * kt, 256 * nv + ((nt < 44) ? 0 : 32), wmaxc); }
            if (!p7odd) { for (int m = gw; m < M; m += NGW) xq_row(XB2 + (size_t)m * DM, XQ + (size_t)m * DM, SSQP + (size_t)m * 32, RSTD + m, 1.0f, F.lane); }
            SEAM(7);
        }
        if (IN(8)) { ENTER();
            pg8::Gemm g{(const bf16*)XQ, (const bf16*)BtUpQ, M, NUP, DM / 2, DM / 2}; pg8::StaticOrder S; S.init(M, NUP, F.G, F.bx);
            pg8::EpiGate E{ACT, DFF, EDGE, args.in[I_FCW] + (size_t)layer * 3 * DFF, args.in[I_FCB] + layer * DFF, DFF, (LAS float*)(F.lds + HALO_OFF), RSTD, ctl + CW_WMAXC + layer * NUP};
            pg8::gemm_phase<pg8::EpiGate, pg8::StaticOrder, true>(F.lds, g, S, E);
            SEAM(8);
        }
        if (IN(9)) { ENTER();
            const float* fcw = args.in[I_FCW] + (size_t)layer * 3 * DFF;
            for (unsigned i = (unsigned)gtid; i < (unsigned)((M / 256) * 2 * (DFF / 4)); i += (unsigned)gthreads) {
                const unsigned ri = i / (unsigned)(DFF / 4), c4 = (i % (unsigned)(DFF / 4)) * 4u, pm = ri >> 1, e = ri & 1u;
                const float* eb = EDGE + (ri * 3u) * (unsigned)DFF + c4;
                f32x4 pre = *(const f32x4*)(eb + DFF); const f32x4 v = *(const f32x4*)(eb + 2 * DFF);
                if (e == 0u && (pm & 7u) != 0u) { const f32x4 gp = *(const f32x4*)(EDGE + (((pm - 1u) * 2u + 1u) * 3u) * (unsigned)DFF + c4); pre += *(const f32x4*)(fcw + c4) * gp; }
                if (e == 1u && (pm & 7u) != 7u) { const f32x4 gn = *(const f32x4*)(EDGE + (((pm + 1u) * 2u + 0u) * 3u) * (unsigned)DFF + c4); pre += *(const f32x4*)(fcw + 2 * DFF + c4) * gn; }
                v2u o; o.x = pk2(pg8::silu_f(pre.x) * v.x, pg8::silu_f(pre.y) * v.y); o.y = pk2(pg8::silu_f(pre.z) * v.z, pg8::silu_f(pre.w) * v.w);
                *(v2u*)(ACT + (pm * 256u + (e ? 255u : 0u)) * (unsigned)DFF + c4) = o;
            }
            SEAM(9);
        }
        if (IN(10)) { ENTER();
            pg8::Gemm g{ACT, BtDn, M, DM, DFF, DFF}; pg8::StaticOrder S; S.init(M, DM, F.G, F.bx);
            pg8::EpiResid16 E{XB2, XA, out, DM, SSQP, (layer + 1 < DEPTH) ? 0 : 1};
            pg8::gemm_phase<pg8::EpiResid16, pg8::StaticOrder>(F.lds, g, S, E);
            SEAM(10);
        }
#undef IN
#undef ENTER
#undef SEAM
    }
}

extern "C" void kernel_launch(void* const* d_in, const int* in_sizes, int n_in, void* d_out, int out_size, void* d_ws, size_t ws_size, hipStream_t stream) {
    static int grid = 0;
    if (grid == 0) {
        if (n_in != N_IN || out_size != M * DM || ws_size < WS_END) { fprintf(stderr, "kernel_launch: unexpected shapes (n_in %d, out %d, ws %zu, need %zu)\n", n_in, out_size, ws_size, (size_t)WS_END); grid = -1; return; }
        int dev = 0, cus = 0;
        if (hipGetDevice(&dev) != hipSuccess || hipDeviceGetAttribute(&cus, hipDeviceAttributeMultiprocessorCount, dev) != hipSuccess) { grid = -1; return; }
        if (hipFuncSetAttribute((const void*)fwd, hipFuncAttributeMaxDynamicSharedMemorySize, LDS_BYTES) != hipSuccess) { fprintf(stderr, "kernel_launch: hipFuncSetAttribute failed\n"); grid = -1; return; }
        int per_cu = 0;
        if (hipOccupancyMaxActiveBlocksPerMultiprocessor(&per_cu, (const void*)fwd, NWAVES * 64, LDS_BYTES) != hipSuccess || per_cu < 1) fprintf(stderr, "kernel_launch: occupancy query reports %d\n", per_cu);
        (void)hipGetLastError();
        grid = cus;
    }
    if (grid < 0) return;
    (void)hipMemsetAsync((char*)d_ws + WS_CTL, 0, CTL_BYTES, stream);
    Args a{};
    for (int i = 0; i < N_IN; ++i) a.in[i] = (const float*)d_in[i];
    a.out = (float*)d_out; a.ws = (unsigned char*)d_ws;
#if MK_ONE_LAUNCH
    a.ph_lo = 0; a.ph_hi = DEPTH * NPH;
    hipLaunchKernelGGL(fwd, dim3(grid), dim3(NWAVES * 64), LDS_BYTES, stream, a);
#else
    for (int p = 0; p < DEPTH * NPH; ++p) { a.ph_lo = p; a.ph_hi = p + 1; hipLaunchKernelGGL(fwd, dim3(grid), dim3(NWAVES * 64), LDS_BYTES, stream, a); }
#endif
    const hipError_t le = hipPeekAtLastError();
    if (le != hipSuccess) fprintf(stderr, "kernel_launch: launch failed: %s\n", hipGetErrorName(le));
}
```

```cpp
#include <hip/hip_runtime.h>
#include <cstdio>
#include <cstdint>
__device__ __forceinline__ int opq(int x) { asm volatile("" : "+v"(x)); return x; }
__device__ __forceinline__ int opq_s(int x) { asm volatile("" : "+s"(x)); return x; }
namespace pg8 {
#define PG8_LAS __attribute__((address_space(3)))
typedef unsigned short bf16_t;
typedef short bf16x8 __attribute__((ext_vector_type(8)));
typedef float f32x4 __attribute__((ext_vector_type(4)));
typedef unsigned u32x4 __attribute__((ext_vector_type(4)));
typedef int i32x4 __attribute__((ext_vector_type(4)));
template <bool I8> struct AccSel { typedef f32x4 T; }; template <> struct AccSel<true> { typedef i32x4 T; };
constexpr int BM = 256, BK = 64, HALF = 128, HTB = HALF * BK * 2  , STAGE_BYTES = 8 * HTB, NXCD = 8, WGM = 8;

__host__ __device__ __forceinline__ int lds_byte(int r, int c) { const int st = (r >> 4) * 2 + (c >> 5), rr = r & 15, cc = c & 31, ob = rr * 64 + cc * 2; return st * 1024 + (ob ^ (((ob >> 9) & 1) << 5)); }
__host__ __device__ __forceinline__ void stage_rc(int b, int& R, int& C) { const int st = b / 1024, sb = b % 1024, swz = sb ^ (((sb >> 9) & 1) << 5); R = (st >> 1) * 16 + swz / 64; C = (st & 1) * 32 + (swz % 64) / 2; }
__host__ __device__ __forceinline__ int perm32(int rho) { const int n = rho >> 4, i = rho & 15; return 8 * (i >> 2) + 4 * n + (i & 3); }

struct Unit { int pm, pn; };
struct Gemm { const bf16_t* A; const bf16_t* Bt; int M, N, K, lda; };

struct StaticOrder {
    int nM, nN, nwg, G, c;
    __host__ __device__ void init(int M, int N, int G_, int c_) { nM = M / BM; nN = N / BM; nwg = nM * nN; G = G_; c = c_; }
    __host__ __device__ bool next(int i, Unit& u) const {
        const long L = (long)i * G + c; if (L >= nwg) return false;
        int wgid = (int)L; { const int q = nwg / NXCD, r = nwg % NXCD, xcd = wgid % NXCD, off = wgid / NXCD; wgid = (xcd < r ? xcd * (q + 1) : r * (q + 1) + (xcd - r) * q) + off; }
        const int nig = WGM * nN, gid = wgid / nig, fm = gid * WGM, gsz = (nM - fm) < WGM ? (nM - fm) : WGM;
        u.pm = fm + ((wgid % nig) % gsz); u.pn = (wgid % nig) / gsz; return true;
    }
    __device__ __forceinline__ void a_ready(const Unit&) const {}
    __device__ __forceinline__ void done(const Unit&) const {}
};

__device__ __forceinline__ unsigned cvt_pk_bf16(float lo, float hi) { unsigned r; asm volatile("v_cvt_pk_bf16_f32 %0, %1, %2" : "=v"(r) : "v"(lo), "v"(hi)); return r; }

__device__ __forceinline__ float dpp_ror1(float v) { return __builtin_bit_cast(float, __builtin_amdgcn_update_dpp(0, __builtin_bit_cast(int, v), 0x121, 0xF, 0xF, false)); }
__device__ __forceinline__ float dpp_ror15(float v) { return __builtin_bit_cast(float, __builtin_amdgcn_update_dpp(0, __builtin_bit_cast(int, v), 0x12F, 0xF, 0xF, false)); }
__device__ __forceinline__ unsigned dpp_swap1(unsigned v) { return (unsigned)__builtin_amdgcn_update_dpp(0, (int)v, 0xB1, 0xF, 0xF, false); }
struct LineOffs { unsigned o0, o1; bool odd; };
__device__ __forceinline__ LineOffs line_offs(unsigned lo, int pitch, int fr) { LineOffs L; L.odd = fr & 1; L.o0 = L.odd ? lo - (unsigned)pitch + 32u : lo; L.o1 = L.odd ? lo + 32u : lo + (unsigned)pitch; return L; }
__device__ __forceinline__ void store_lines(bf16_t* base, const LineOffs& L, u32x4 a, u32x4 b) {
    const u32x4 snd = L.odd ? a : b; u32x4 rcv;
    rcv.x = dpp_swap1(snd.x); rcv.y = dpp_swap1(snd.y); rcv.z = dpp_swap1(snd.z); rcv.w = dpp_swap1(snd.w);
    *(u32x4*)(base + L.o0) = L.odd ? rcv : a;
    *(u32x4*)(base + L.o1) = L.odd ? b : rcv;
}
struct EpiBf16 {
    static constexpr bool PERM = true;
    bf16_t* O; int ldc; const float* rstd; int kvscatter;
    int norm_pn; PG8_LAS float* red; float eps;
    float* ssq_out; int ssq_pn0;
    const float* cscale; int pn_skip_from, pn_skip;
    __device__ __forceinline__ void operator()(f32x4 (&acc)[2][2][4][2], const Unit& u, int wr, int wc, int fr, int fq) const {
        const int pno = (u.pn >= pn_skip_from) ? u.pn + pn_skip : u.pn;
        bf16_t* Ot = O + (size_t)(u.pm * BM) * ldc + (kvscatter ? u.pn * 320 : pno * BM);
        const int wcol = kvscatter ? (wc < 2 ? wc * 64 : 64 + wc * 64) : wc * 64;
        const LineOffs L = line_offs((unsigned)((wr * 64 + fr) * ldc + wcol + 8 * fq), ldc, fr); const int row0 = u.pm * BM + wr * 64 + fr;
        float rsv[8];
#pragma unroll
        for (int i = 0; i < 8; ++i) rsv[i] = rstd ? rstd[row0 + (i >> 2) * HALF + (i & 3) * 16] : 1.0f;
        if (u.pn == norm_pn) {
#pragma unroll
            for (int ai = 0; ai < 2; ++ai)
#pragma unroll
                for (int m = 0; m < 4; ++m) { const float rs = rsv[ai * 4 + m]; float s = 0.f;
#pragma unroll
                    for (int bj = 0; bj < 2; ++bj) { acc[ai][bj][m][0] *= rs; acc[ai][bj][m][1] *= rs; const f32x4 a = acc[ai][bj][m][0], b = acc[ai][bj][m][1];
                        s += ((a[0] * a[0] + a[1] * a[1]) + (a[2] * a[2] + a[3] * a[3])) + ((b[0] * b[0] + b[1] * b[1]) + (b[2] * b[2] + b[3] * b[3])); }
                    s += __shfl_xor(s, 16); s += __shfl_xor(s, 32); if (fq == 0) red[(ai * HALF + wr * 64 + m * 16 + fr) * 4 + wc] = s; }
            asm volatile("s_waitcnt lgkmcnt(0)" ::: "memory"); __builtin_amdgcn_s_barrier(); asm volatile("" ::: "memory");
#pragma unroll
            for (int ai = 0; ai < 2; ++ai)
#pragma unroll
                for (int m = 0; m < 4; ++m) { const f32x4 p = *(const PG8_LAS f32x4*)(red + (ai * HALF + wr * 64 + m * 16 + fr) * 4); const float rs = 1.0f / __builtin_sqrtf(((p[0] + p[1]) + (p[2] + p[3])) * (1.0f / 256.0f) + eps);
                    u32x4 w[2];
#pragma unroll
                    for (int bj = 0; bj < 2; ++bj) { const f32x4 v0 = acc[ai][bj][m][0] * rs, v1 = acc[ai][bj][m][1] * rs;
                        w[bj].x = cvt_pk_bf16(v0[0], v0[1]); w[bj].y = cvt_pk_bf16(v0[2], v0[3]); w[bj].z = cvt_pk_bf16(v1[0], v1[1]); w[bj].w = cvt_pk_bf16(v1[2], v1[3]); }
                    store_lines(Ot + (size_t)((ai * HALF + m * 16) * ldc), L, w[0], w[1]);
                    asm volatile("" ::: "memory"); }
            return;
        }
        const bool want_ssq = ssq_out != nullptr && (unsigned)(u.pn - ssq_pn0) < 2u;
        f32x4 csc[2][2];
        if (cscale) {
#pragma unroll
            for (int bj = 0; bj < 2; ++bj)
#pragma unroll
                for (int n = 0; n < 2; ++n) csc[bj][n] = *(const f32x4*)(cscale + u.pn * BM + wc * 64 + bj * 32 + 8 * fq + 4 * n);
        }
#pragma unroll
        for (int ai = 0; ai < 2; ++ai)
#pragma unroll
            for (int m = 0; m < 4; ++m) { const float rs = rsv[ai * 4 + m];
                u32x4 w[2]; float s = 0.f;
#pragma unroll
                for (int bj = 0; bj < 2; ++bj) { f32x4 v0 = acc[ai][bj][m][0] * rs, v1 = acc[ai][bj][m][1] * rs;
                    if (cscale) { v0 *= csc[bj][0]; v1 *= csc[bj][1]; }
                    s += ((v0[0] * v0[0] + v0[1] * v0[1]) + (v0[2] * v0[2] + v0[3] * v0[3])) + ((v1[0] * v1[0] + v1[1] * v1[1]) + (v1[2] * v1[2] + v1[3] * v1[3]));
                    w[bj].x = cvt_pk_bf16(v0[0], v0[1]); w[bj].y = cvt_pk_bf16(v0[2], v0[3]); w[bj].z = cvt_pk_bf16(v1[0], v1[1]); w[bj].w = cvt_pk_bf16(v1[2], v1[3]); }
                store_lines(Ot + (size_t)((ai * HALF + m * 16) * ldc), L, w[0], w[1]);
                if (want_ssq) { s += __shfl_xor(s, 16); s += __shfl_xor(s, 32); if (fq == 0) ssq_out[(size_t)(row0 + ai * HALF + m * 16) * 8 + (u.pn - ssq_pn0) * 4 + wc] = s; }
                asm volatile("" ::: "memory"); }
    }
};
struct EpiResid16 {
    static constexpr bool PERM = true;
    const bf16_t* base; bf16_t* xo; float* out; int ldc; float* ssqp; int f32out;
    __device__ __forceinline__ static void addx(const u32x4 b, const f32x4 a0, const f32x4 a1, f32x4& x0, f32x4& x1) {
        x0[0] = __builtin_bit_cast(float, b.x << 16) + a0[0]; x0[1] = __builtin_bit_cast(float, b.x & 0xffff0000u) + a0[1]; x0[2] = __builtin_bit_cast(float, b.y << 16) + a0[2]; x0[3] = __builtin_bit_cast(float, b.y & 0xffff0000u) + a0[3];
        x1[0] = __builtin_bit_cast(float, b.z << 16) + a1[0]; x1[1] = __builtin_bit_cast(float, b.z & 0xffff0000u) + a1[1]; x1[2] = __builtin_bit_cast(float, b.w << 16) + a1[2]; x1[3] = __builtin_bit_cast(float, b.w & 0xffff0000u) + a1[3]; }
    __device__ __forceinline__ void operator()(f32x4 (&acc)[2][2][4][2], const Unit& u, int wr, int wc, int fr, int fq) const {
        const size_t tb = (size_t)(u.pm * BM) * ldc + u.pn * BM;
        const bf16_t* bs = base + tb;
        const unsigned lo = (unsigned)((wr * 64 + fr) * ldc + wc * 64 + 8 * fq);
        if (f32out != 0) {
            float* op = out + tb;
#pragma unroll
            for (int ai = 0; ai < 2; ++ai)
#pragma unroll
                for (int m = 0; m < 4; ++m) { const unsigned off = lo + (unsigned)((ai * HALF + m * 16) * ldc);
#pragma unroll
                    for (int bj = 0; bj < 2; ++bj) { const u32x4 b = *(const u32x4*)(bs + off + bj * 32); f32x4 x0, x1; addx(b, acc[ai][bj][m][0], acc[ai][bj][m][1], x0, x1);
                        *(f32x4*)(op + off + bj * 32) = x0; *(f32x4*)(op + off + bj * 32 + 4) = x1; }
                    asm volatile("" ::: "memory"); }
            return;
        }
        bf16_t* xp = xo + tb; const LineOffs L = line_offs(lo, ldc, fr);
#pragma unroll
        for (int aim = 0; aim < 4; ++aim) { const int ai = aim >> 1, mp = aim & 1;
            u32x4 bv[2][2];
#pragma unroll
            for (int mm = 0; mm < 2; ++mm)
#pragma unroll
                for (int bj = 0; bj < 2; ++bj) bv[mm][bj] = *(const u32x4*)(bs + lo + (unsigned)((ai * HALF + (2 * mp + mm) * 16) * ldc) + bj * 32);
#pragma unroll
            for (int mm = 0; mm < 2; ++mm) { const int m = 2 * mp + mm; float s = 0.f; u32x4 wv[2];
#pragma unroll
                for (int bj = 0; bj < 2; ++bj) { f32x4 x0, x1; addx(bv[mm][bj], acc[ai][bj][m][0], acc[ai][bj][m][1], x0, x1);
                    wv[bj].x = cvt_pk_bf16(x0[0], x0[1]); wv[bj].y = cvt_pk_bf16(x0[2], x0[3]); wv[bj].z = cvt_pk_bf16(x1[0], x1[1]); wv[bj].w = cvt_pk_bf16(x1[2], x1[3]);
                    s += ((x0[0] * x0[0] + x0[1] * x0[1]) + (x0[2] * x0[2] + x0[3] * x0[3])) + ((x1[0] * x1[0] + x1[1] * x1[1]) + (x1[2] * x1[2] + x1[3] * x1[3])); }
                store_lines(xp + (size_t)((ai * HALF + m * 16) * ldc), L, wv[0], wv[1]);
                s += __shfl_xor(s, 16); s += __shfl_xor(s, 32); if (fq == 0) ssqp[(size_t)(u.pm * BM + wr * 64 + fr + ai * HALF + m * 16) * 32 + u.pn * 4 + wc] = s; }
            asm volatile("" ::: "memory"); }
    }
};
__device__ __forceinline__ float silu_f(float x) { return x * __builtin_amdgcn_rcpf(1.0f + __builtin_amdgcn_exp2f(-1.4426950408889634f * x)); }
struct EpiGate {
    static constexpr bool PERM = true;
    bf16_t* act; int ldact; float* edge; const float* cw; const float* cb; int dff; PG8_LAS float* halo; const float* rstd; const unsigned* wmaxc;
    __device__ __forceinline__ void operator()(f32x4 (&acc)[2][2][4][2], const Unit& u, int wr, int wc, int fr, int fq) const {
        const int lane = fq * 16 + fr; const int colL = wc * 32 + 8 * fq; const int colG = u.pn * HALF + colL;
        f32x4 csc[2][2];
#pragma unroll
        for (int bj = 0; bj < 2; ++bj)
#pragma unroll
            for (int n = 0; n < 2; ++n) { const u32x4 mb = *(const u32x4*)(wmaxc + bj * dff + colG + 4 * n);
                csc[bj][n] = (f32x4){__builtin_bit_cast(float, mb.x), __builtin_bit_cast(float, mb.y), __builtin_bit_cast(float, mb.z), __builtin_bit_cast(float, mb.w)} * (1.0f / 127.0f); }
#pragma unroll
        for (int ai = 0; ai < 2; ++ai)
#pragma unroll
            for (int m = 0; m < 4; ++m) { const float rs = rstd[u.pm * BM + ai * HALF + wr * 64 + m * 16 + fr];
#pragma unroll
                for (int bj = 0; bj < 2; ++bj) { acc[ai][bj][m][0] *= csc[bj][0] * rs; acc[ai][bj][m][1] *= csc[bj][1] * rs; } }
#pragma unroll
        for (int ai = 0; ai < 2; ++ai) { const int q = 2 * ai + wr;
            if (fr == 0) { *(PG8_LAS f32x4*)(halo + (q * 2 + 0) * 128 + colL) = acc[ai][0][0][0]; *(PG8_LAS f32x4*)(halo + (q * 2 + 0) * 128 + colL + 4) = acc[ai][0][0][1]; }
            if (fr == 15) { *(PG8_LAS f32x4*)(halo + (q * 2 + 1) * 128 + colL) = acc[ai][0][3][0]; *(PG8_LAS f32x4*)(halo + (q * 2 + 1) * 128 + colL + 4) = acc[ai][0][3][1]; } }
        asm volatile("s_waitcnt lgkmcnt(0)" ::: "memory"); __builtin_amdgcn_s_barrier(); asm volatile("" ::: "memory");
        bf16_t* actp = act + (size_t)(u.pm * BM) * ldact + colG; const unsigned rlo = (unsigned)((wr * 64 + fr) * ldact);
#pragma unroll
        for (int ai = 0; ai < 2; ++ai) { const int q = 2 * ai + wr;
            typedef unsigned u32x2 __attribute__((ext_vector_type(2)));
            u32x2 pk[4][2];
#pragma unroll
            for (int n = 0; n < 2; ++n) {
                const f32x4 w0 = *(const f32x4*)(cw + colG + 4 * n), w1 = *(const f32x4*)(cw + dff + colG + 4 * n), w2 = *(const f32x4*)(cw + 2 * dff + colG + 4 * n), bb = *(const f32x4*)(cb + colG + 4 * n);
                f32x4 ht = *(PG8_LAS f32x4*)(halo + ((q > 0 ? q - 1 : 0) * 2 + 1) * 128 + colL + 4 * n), hb = *(PG8_LAS f32x4*)(halo + ((q < 3 ? q + 1 : 3) * 2 + 0) * 128 + colL + 4 * n);
                if (q == 0) ht = ht * 0.f; if (q == 3) hb = hb * 0.f;
                f32x4 pre[4];
#pragma unroll
                for (int j = 0; j < 4; ++j) {
                    float g[4], rr[4], rl[4];
#pragma unroll
                    for (int m = 0; m < 4; ++m) { g[m] = acc[ai][0][m][n][j]; rr[m] = dpp_ror1(g[m]); rl[m] = dpp_ror15(g[m]); }
#pragma unroll
                    for (int m = 0; m < 4; ++m) {
                        const float up = (fr > 0) ? rr[m] : (m > 0 ? rr[m > 0 ? m - 1 : 0] : ht[j]);
                        const float dn = (fr < 15) ? rl[m] : (m < 3 ? rl[m < 3 ? m + 1 : 3] : hb[j]);
                        pre[m][j] = w0[j] * up + w1[j] * g[m] + w2[j] * dn + bb[j];
                    }
                }
                if (q == 0 && fr == 0) { float* e = edge + (size_t)((u.pm * 2 + 0) * 3) * dff + colG + 4 * n;
                    *(f32x4*)(e) = acc[ai][0][0][n]; *(f32x4*)(e + dff) = pre[0]; *(f32x4*)(e + 2 * dff) = acc[ai][1][0][n]; }
                if (q == 3 && fr == 15) { float* e = edge + (size_t)((u.pm * 2 + 1) * 3) * dff + colG + 4 * n;
                    *(f32x4*)(e) = acc[ai][0][3][n]; *(f32x4*)(e + dff) = pre[3]; *(f32x4*)(e + 2 * dff) = acc[ai][1][3][n]; }
#pragma unroll
                for (int m = 0; m < 4; ++m) { const f32x4 v = acc[ai][1][m][n];
                    pk[m][n].x = cvt_pk_bf16(silu_f(pre[m][0]) * v[0], silu_f(pre[m][1]) * v[1]); pk[m][n].y = cvt_pk_bf16(silu_f(pre[m][2]) * v[2], silu_f(pre[m][3]) * v[3]); }
            }
#pragma unroll
            for (int m = 0; m < 4; ++m) { u32x4 w; w.x = pk[m][0].x; w.y = pk[m][0].y; w.z = pk[m][1].x; w.w = pk[m][1].y;
                *(u32x4*)(actp + rlo + (unsigned)((ai * HALF + m * 16) * ldact)) = w; }
        }
    }
};

template <class Epi, class Sched, bool I8 = false>
__device__ __forceinline__ void gemm_phase(PG8_LAS unsigned char* lds, const Gemm g, const Sched& S, const Epi& E) {
    typedef typename AccSel<I8>::T acc_t;
    const int tid = opq(threadIdx.x), wid = __builtin_amdgcn_readfirstlane(tid >> 6), lane = tid & 63, wr = wid >> 2, wc = wid & 3, fr = lane & 15, fq = lane >> 4;
    const int K = g.K, nt = K / BK, lda = g.lda;
    unsigned voffA[2], voffB[2];
#pragma unroll
    for (int i = 0; i < 2; ++i) { int R, C; stage_rc(tid * 16 + i * 8192, R, C); const int Rb = Epi::PERM ? (64 * (R >> 5) + perm32(R & 31)) : R;
        voffA[i] = (unsigned)(R * lda + C) * 2u; voffB[i] = (unsigned)(Rb * K + C) * 2u; }
    const size_t kstep = (size_t)(BK * 2);
    const size_t hstepA = (size_t)HALF * lda * 2, hstepB = (size_t)(Epi::PERM ? 32 : HALF) * K * 2;
    const size_t tstepA = 2 * hstepA, tstepB = (size_t)BM * K * 2;
    const unsigned ldsw = (unsigned)wid * 1024u;
    const int aoff = lds_byte(wr * 64 + fr, fq * 8), boff = lds_byte(wc * 32 + fr, fq * 8);
#define PG8_SA(b, h) (((b) * 2 + (h)) * HTB)
#define PG8_SB(b, h) ((4 + (b) * 2 + (h)) * HTB)
#define PG8_STAGE(bufoff, gbase, voff) do { _Pragma("unroll") for (int _i = 0; _i < 2; ++_i) \
        __builtin_amdgcn_global_load_lds((const unsigned*)((const char*)(gbase) + (voff)[_i]), (PG8_LAS unsigned*)(lds + (bufoff) + ldsw + _i * 8192), 16, 0, 0); } while (0)
#define PG8_LDA(dst, b, h) do { _Pragma("unroll") for (int m = 0; m < 4; ++m) _Pragma("unroll") for (int k = 0; k < 2; ++k) dst[m][k] = *(const PG8_LAS bf16x8*)(lds + PG8_SA(b, h) + aoff + m * 2048 + k * 1024); } while (0)
#define PG8_LDB(dst, b, h) do { _Pragma("unroll") for (int n = 0; n < 2; ++n) _Pragma("unroll") for (int k = 0; k < 2; ++k) dst[n][k] = *(const PG8_LAS bf16x8*)(lds + PG8_SB(b, h) + boff + n * 2048 + k * 1024); } while (0)
#define PG8_MMA(ai, bj, At, Bt) do { __builtin_amdgcn_s_setprio(1); _Pragma("unroll") for (int m = 0; m < 4; ++m) _Pragma("unroll") for (int n = 0; n < 2; ++n) _Pragma("unroll") for (int k = 0; k < 2; ++k) { \
        if constexpr (I8) acc[ai][bj][m][n] = __builtin_amdgcn_mfma_i32_16x16x64_i8(__builtin_bit_cast(i32x4, Bt[n][k]), __builtin_bit_cast(i32x4, At[m][k]), acc[ai][bj][m][n], 0, 0, 0); \
        else acc[ai][bj][m][n] = __builtin_amdgcn_mfma_f32_16x16x32_bf16(Bt[n][k], At[m][k], acc[ai][bj][m][n], 0, 0, 0); } __builtin_amdgcn_s_setprio(0); } while (0)
#define PG8_WAIT_V(n) asm volatile("s_waitcnt vmcnt(" #n ")" ::: "memory")
#define PG8_WAIT_L(n) asm volatile("s_waitcnt lgkmcnt(" #n ")" ::: "memory")
#define PG8_BAR __builtin_amdgcn_s_barrier()
#define PG8_SCHED __builtin_amdgcn_sched_barrier(0)
    Unit cur, nxt; int ui = 0;
    if (!S.next(0, cur)) return;
    acc_t acc[2][2][4][2];
{ float zf = 0.f; asm volatile("" : "+v"(zf));
    #pragma unroll
    for (int a = 0; a < 2; ++a)
#pragma unroll
        for (int b = 0; b < 2; ++b)
#pragma unroll
            for (int m = 0; m < 4; ++m)
#pragma unroll
                for (int n = 0; n < 2; ++n) acc[a][b][m][n] = __builtin_bit_cast(acc_t, (f32x4){zf, zf, zf, zf}); }
    bf16x8 At[4][2], B0[2][2], B1[2][2];
    const char* cA = (const char*)g.A + (size_t)cur.pm * tstepA; const char* cB = (const char*)g.Bt + (size_t)cur.pn * tstepB;
    S.a_ready(cur);
    PG8_STAGE(PG8_SB(0, 0), cB, voffB); PG8_STAGE(PG8_SB(0, 1), cB + hstepB, voffB); PG8_STAGE(PG8_SA(0, 0), cA, voffA); PG8_STAGE(PG8_SA(0, 1), cA + hstepA, voffA);
    if (wr == 1) PG8_BAR;
    PG8_WAIT_V(2); PG8_BAR;
    PG8_STAGE(PG8_SB(1, 0), cB + kstep, voffB); PG8_STAGE(PG8_SA(1, 0), cA + kstep, voffA); PG8_STAGE(PG8_SB(1, 1), cB + hstepB + kstep, voffB);
    PG8_WAIT_V(6); PG8_BAR;
    for (;;) {
        const bool has_next = S.next(ui + 1, nxt);
        const char* nA = has_next ? (const char*)g.A + (size_t)nxt.pm * tstepA : cA; const char* nB = has_next ? (const char*)g.Bt + (size_t)nxt.pn * tstepB : cB;
#pragma unroll 1
        for (int t = 0; t < nt; t += 2) {
            const bool last = (t == nt - 2);
            const char* a1 = cA + (size_t)(t + 1) * kstep;
            const char* a2 = last ? nA : cA + (size_t)(t + 2) * kstep; const char* b2 = last ? nB : cB + (size_t)(t + 2) * kstep;
            const char* a3 = a2 + kstep; const char* b3 = b2 + kstep;
            if (last && has_next) S.a_ready(nxt);
            PG8_LDB(B0, 0, 0); PG8_LDB(B1, 0, 1); PG8_SCHED; PG8_LDA(At, 0, 0); PG8_STAGE(PG8_SA(1, 1), a1 + hstepA, voffA);
            PG8_WAIT_V(8); PG8_WAIT_L(0); PG8_BAR; PG8_MMA(0, 0, At, B0); PG8_MMA(0, 1, At, B1); PG8_BAR; PG8_SCHED;
            PG8_LDA(At, 0, 1); PG8_STAGE(PG8_SB(0, 0), b2, voffB); PG8_STAGE(PG8_SB(0, 1), b2 + hstepB, voffB); PG8_STAGE(PG8_SA(0, 0), a2, voffA);
            PG8_WAIT_V(8); PG8_WAIT_L(0); PG8_BAR; PG8_MMA(1, 0, At, B0); PG8_MMA(1, 1, At, B1); PG8_BAR; PG8_SCHED;
            PG8_LDB(B0, 1, 0); PG8_LDB(B1, 1, 1); PG8_SCHED; PG8_LDA(At, 1, 0); PG8_STAGE(PG8_SA(0, 1), a2 + hstepA, voffA);
            PG8_WAIT_V(8); PG8_WAIT_L(0); PG8_BAR; PG8_MMA(0, 0, At, B0); PG8_MMA(0, 1, At, B1); PG8_BAR; PG8_SCHED;
            PG8_LDA(At, 1, 1); PG8_STAGE(PG8_SB(1, 0), b3, voffB); PG8_STAGE(PG8_SB(1, 1), b3 + hstepB, voffB); PG8_STAGE(PG8_SA(1, 0), a3, voffA);
            PG8_WAIT_V(8); PG8_WAIT_L(0); PG8_BAR; PG8_MMA(1, 0, At, B0); PG8_MMA(1, 1, At, B1); PG8_BAR; PG8_SCHED;
        }
        if (wr == 0) PG8_BAR;
        if constexpr (I8) { f32x4 accf[2][2][4][2];
#pragma unroll
            for (int a = 0; a < 2; ++a)
#pragma unroll
                for (int b = 0; b < 2; ++b)
#pragma unroll
                    for (int m = 0; m < 4; ++m)
#pragma unroll
                        for (int n = 0; n < 2; ++n) accf[a][b][m][n] = __builtin_convertvector(acc[a][b][m][n], f32x4);
            E(accf, cur, wr, wc, fr, fq); }
        else E(acc, cur, wr, wc, fr, fq);
        S.done(cur);
        if (!has_next) break;
{ float zf = 0.f; asm volatile("" : "+v"(zf));
        #pragma unroll
        for (int a = 0; a < 2; ++a)
#pragma unroll
            for (int b = 0; b < 2; ++b)
#pragma unroll
                for (int m = 0; m < 4; ++m)
#pragma unroll
                    for (int n = 0; n < 2; ++n) acc[a][b][m][n] = __builtin_bit_cast(acc_t, (f32x4){zf, zf, zf, zf}); }
        cur = nxt; cA = nA; cB = nB; ++ui;
        if (wr == 1) PG8_BAR;
    }
    PG8_WAIT_V(0);
    PG8_BAR;
#undef PG8_SA
#undef PG8_SB
#undef PG8_STAGE
#undef PG8_LDA
#undef PG8_LDB
#undef PG8_MMA
#undef PG8_WAIT_V
#undef PG8_WAIT_L
#undef PG8_BAR
#undef PG8_SCHED
}
}
namespace at {
using bf16 = unsigned short;
using bf16x8 = __attribute__((ext_vector_type(8))) short;
using s16x4  = __attribute__((ext_vector_type(4))) short;
using f32x16 = __attribute__((ext_vector_type(16))) float;
using u32x4  = __attribute__((ext_vector_type(4))) unsigned;
using f32x4  = __attribute__((ext_vector_type(4))) float;
constexpr int DQK = 192, DV = 128, KVBLK = 64, NW = 8, QBLK = 32;
constexpr float SCALE = 0.07216878364870322f;
constexpr float THR = 8.f;
constexpr int LDQ = 1536, LDK = 2560, LDO = 2048;
constexpr int SHM_V = KVBLK * DV * 2, SHM_K = 12 * 2080;
constexpr int QR_OFF = 2 * SHM_V + 2 * SHM_K + NW * 64 * 4;
constexpr int SHM_ATTN = QR_OFF + NW * 4096;
#define SBAR() __builtin_amdgcn_sched_barrier(0)
constexpr int KPL = 2080;
__host__ __device__ __forceinline__ int k_st(int row, int c) { return (c >> 1) * KPL + row * 32 + (((c & 1) ^ ((row >> 3) & 1)) << 4); }
__host__ __device__ __forceinline__ int k_rd_base(int r32, int hi) { return r32 * 32 + ((hi ^ ((r32 >> 3) & 1)) << 4); }
__device__ __forceinline__ int crow(int r, int hi) { return (r & 3) + 8 * (r >> 2) + 4 * hi; }
__device__ __forceinline__ unsigned cvtpk(float lo, float hi) { unsigned r; asm volatile("v_cvt_pk_bf16_f32 %0, %1, %2" : "=v"(r) : "v"(lo), "v"(hi)); return r; }

__device__ __forceinline__ void partialSM(f32x16& p0, f32x16& p1, float& m_reg, float& mn, float& alpha) {
  constexpr float C = 1.0f;
  float pmax = p0[0];
#pragma unroll
  for (int r = 1; r < 16; ++r) pmax = fmaxf(pmax, p0[r]);
#pragma unroll
  for (int r = 0; r < 16; ++r) pmax = fmaxf(pmax, p1[r]);
  { auto rr = __builtin_amdgcn_permlane32_swap(__float_as_uint(pmax), __float_as_uint(pmax), false, false);
    pmax = fmaxf(__uint_as_float(rr[0]), __uint_as_float(rr[1])); }
  if (__builtin_expect(__all(pmax - m_reg <= THR * 1.4426950408889634f), 1)) { mn = m_reg; alpha = 1.f; }
  else { mn = fmaxf(m_reg, pmax); alpha = __builtin_amdgcn_exp2f((m_reg - mn) * C); m_reg = mn; }
  float mnC = -mn * C;
#pragma unroll
  for (int r = 0; r < 16; ++r) p0[r] = fmaf(p0[r], C, mnC);
#pragma unroll
  for (int r = 0; r < 16; ++r) p1[r] = fmaf(p1[r], C, mnC);
#pragma unroll
  for (int r = 0; r < 16; ++r) p0[r] = __builtin_amdgcn_exp2f(p0[r]);
}
__device__ __forceinline__ void partialSM_fast(f32x16& p0, f32x16& p1, float negMC) {
  (void)negMC; (void)p1;
#pragma unroll
  for (int r = 0; r < 16; ++r) p0[r] = __builtin_amdgcn_exp2f(p0[r]);
}
__device__ __forceinline__ void finishSM(f32x16& p0, f32x16& p1, float alpha, float& l_reg, bf16x8& pa0, bf16x8& pa1, bf16x8& pa2, bf16x8& pa3) {
#pragma unroll
  for (int r = 0; r < 16; ++r) p1[r] = __builtin_amdgcn_exp2f(p1[r]);
  float ps = 0;
#pragma unroll
  for (int r = 0; r < 16; ++r) ps += p0[r];
#pragma unroll
  for (int r = 0; r < 16; ++r) ps += p1[r];
  { auto rr = __builtin_amdgcn_permlane32_swap(__float_as_uint(ps), __float_as_uint(ps), false, false);
    ps = __uint_as_float(rr[0]) + __uint_as_float(rr[1]); }
  l_reg = l_reg * alpha + ps;
#define PK4(P, BASE, OUT) do { unsigned a0 = cvtpk(P[BASE + 0], P[BASE + 1]), a1 = cvtpk(P[BASE + 2], P[BASE + 3]);   \
    unsigned b0 = cvtpk(P[BASE + 4], P[BASE + 5]), b1 = cvtpk(P[BASE + 6], P[BASE + 7]);                              \
    auto r0 = __builtin_amdgcn_permlane32_swap(a0, b0, false, false); auto r1 = __builtin_amdgcn_permlane32_swap(a1, b1, false, false); \
    u32x4 w = {r0[0], r1[0], r0[1], r1[1]}; OUT = *reinterpret_cast<bf16x8*>(&w); } while (0)
  PK4(p0, 0, pa0); PK4(p0, 8, pa1); PK4(p1, 0, pa2); PK4(p1, 8, pa3);
#undef PK4
}
template <int OFF> __device__ __forceinline__ bf16x8 k_read(int kb) {
  bf16x8 r; asm volatile("ds_read_b128 %0, %1 offset:%2" : "=v"(r) : "v"(kb), "i"(OFF) : "memory"); return r;
}
__device__ __forceinline__ void qkt(f32x16& p0, f32x16& p1, int kb, const bf16x8* qr, int qb) {
  p0 = f32x16{}; p1 = f32x16{};
#define QK1(d0) { const bf16x8 b0 = *(const __attribute__((address_space(3))) bf16x8*)(kb + d0 * KPL), b1 = *(const __attribute__((address_space(3))) bf16x8*)(kb + d0 * KPL + 1024); \
    p0 = __builtin_amdgcn_mfma_f32_32x32x16_bf16(b0, qr[d0], p0, 0, 0, 0); p1 = __builtin_amdgcn_mfma_f32_32x32x16_bf16(b1, qr[d0], p1, 0, 0, 0); }
#define QK2(d0) { const bf16x8 b0 = *(const __attribute__((address_space(3))) bf16x8*)(kb + d0 * KPL), b1 = *(const __attribute__((address_space(3))) bf16x8*)(kb + d0 * KPL + 1024); \
    const bf16x8 qf = *(const __attribute__((address_space(3))) bf16x8*)(qb + (d0 - 8) * 1024); \
    p0 = __builtin_amdgcn_mfma_f32_32x32x16_bf16(b0, qf, p0, 0, 0, 0); p1 = __builtin_amdgcn_mfma_f32_32x32x16_bf16(b1, qf, p1, 0, 0, 0); }
  QK1(0) QK1(1) QK1(2) QK1(3) QK1(4) QK1(5) QK1(6) QK1(7) QK2(8) QK2(9) QK2(10) QK2(11)
#undef QK1
#undef QK2
}
__host__ __device__ __forceinline__ int v_st(int k, int c) { const int kk = (k & ~0xC) | ((k & 4) << 1) | ((k & 8) >> 1); return ((kk >> 3) * 4 + (c >> 5)) * 512 + ((kk & 7) * 32 + (c & 31)) * 2; }
__device__ __forceinline__ int v_rd_base(int lane) { return ((lane & 3) << 3) | (((lane >> 2) & 3) << 6) | (((lane >> 4) & 1) << 5) | (((lane >> 5) & 1) << 8); }
constexpr int v_rd_off(int d0, int ks, int half) { return d0 * 512 + ks * 4096 + half * 2048; }
template <int OFF> __device__ __forceinline__ s16x4 tr_read(int vb) {
  s16x4 r; asm volatile("ds_read_b64_tr_b16 %0, %1 offset:%2" : "=&v"(r) : "v"(vb), "i"(OFF) : "memory"); return r;
}
template <int D0> __device__ __forceinline__ void pv_one(f32x16& od, int vb, bf16x8 pa0, bf16x8 pa1, bf16x8 pa2, bf16x8 pa3) {
  const s16x4 l0 = tr_read<v_rd_off(D0, 0, 0)>(vb), h0 = tr_read<v_rd_off(D0, 0, 1)>(vb), l1 = tr_read<v_rd_off(D0, 1, 0)>(vb), h1 = tr_read<v_rd_off(D0, 1, 1)>(vb);
  const s16x4 l2 = tr_read<v_rd_off(D0, 2, 0)>(vb), h2 = tr_read<v_rd_off(D0, 2, 1)>(vb), l3 = tr_read<v_rd_off(D0, 3, 0)>(vb), h3 = tr_read<v_rd_off(D0, 3, 1)>(vb);
  asm volatile("s_waitcnt lgkmcnt(0)" ::: "memory"); SBAR();
#define PK(L, H) (bf16x8){L[0], L[1], L[2], L[3], H[0], H[1], H[2], H[3]}
  od = __builtin_amdgcn_mfma_f32_32x32x16_bf16(pa0, PK(l0, h0), od, 0, 0, 0);
  od = __builtin_amdgcn_mfma_f32_32x32x16_bf16(pa1, PK(l1, h1), od, 0, 0, 0);
  od = __builtin_amdgcn_mfma_f32_32x32x16_bf16(pa2, PK(l2, h2), od, 0, 0, 0);
  od = __builtin_amdgcn_mfma_f32_32x32x16_bf16(pa3, PK(l3, h3), od, 0, 0, 0);
#undef PK
}
__device__ __forceinline__ void pv_d0(f32x16* o, int vb, bf16x8 pa0, bf16x8 pa1, bf16x8 pa2, bf16x8 pa3) {
  pv_one<0>(o[0], vb, pa0, pa1, pa2, pa3); pv_one<1>(o[1], vb, pa0, pa1, pa2, pa3); pv_one<2>(o[2], vb, pa0, pa1, pa2, pa3); pv_one<3>(o[3], vb, pa0, pa1, pa2, pa3);
}

template <bool FAST>
__device__ __forceinline__ void attn_unit(const float negMC, const bf16* __restrict__ Qb, const bf16* __restrict__ Kh, const bf16* __restrict__ Vh, bf16* __restrict__ Ob, int seq, char* lds,
                                          const float* __restrict__ ssqcq, const float* __restrict__ qg, const float* __restrict__ rope0) {
  const int tid = opq(threadIdx.x), wid = tid >> 6, lane = tid & 63, r32 = lane & 31, hi = lane >> 5;
  char* V_lds = lds; char* K_lds = lds + 2 * SHM_V;
  float* ws = (float*)(lds + 2 * SHM_V + 2 * SHM_K) + wid * 64; float* li_l = ws; float* al_l = ws + 32;
  float m_reg = -1e30f, l_reg = 0; f32x16 o[4] = {}; bf16x8 qr[8];
  const bf16* Qw = Qb + (unsigned)((wid * QBLK + r32) * LDQ + hi * 8);
  const int qb0 = (int)(uintptr_t)lds + QR_OFF + wid * 4096 + k_rd_base(r32, hi);
  { const int row = wid * QBLK + r32;
    bf16x8 raw[12];
#pragma unroll
    for (int d0 = 0; d0 < 12; ++d0) raw[d0] = *reinterpret_cast<const bf16x8*>(Qw + d0 * 16);
    const f32x4 pa = *(const f32x4*)(ssqcq + row * 8), pb = *(const f32x4*)(ssqcq + row * 8 + 4);
    const float rq = 1.0f / __builtin_sqrtf((((pa.x + pa.y) + (pa.z + pa.w)) + ((pb.x + pb.y) + (pb.z + pb.w))) * (1.f / 512.f) + 1e-6f);
    float ss = 0.f;
#pragma unroll
    for (int d0 = 0; d0 < 12; ++d0)
#pragma unroll
      for (int i = 0; i < 8; ++i) { const float x = __builtin_bit_cast(float, (unsigned)(unsigned short)raw[d0][i] << 16); ss += x * x; }
    ss += __shfl_xor(ss, 32);
    const float sc = (rq * (SCALE * 1.4426950408889634f)) / __builtin_sqrtf(ss * (rq * rq) * (1.f / 192.f) + 1e-6f);
#define QX(d0, i) (__builtin_bit_cast(float, (unsigned)(unsigned short)raw[d0][i] << 16) * sc)
#pragma unroll
    for (int d0 = 0; d0 < 8; ++d0) { const f32x4 g0 = *(const f32x4*)(qg + 16 * d0 + 8 * hi), g1 = *(const f32x4*)(qg + 16 * d0 + 8 * hi + 4);
      u32x4 w = {cvtpk(QX(d0, 0) * g0.x, QX(d0, 1) * g0.y), cvtpk(QX(d0, 2) * g0.z, QX(d0, 3) * g0.w), cvtpk(QX(d0, 4) * g1.x, QX(d0, 5) * g1.y), cvtpk(QX(d0, 6) * g1.z, QX(d0, 7) * g1.w)};
      qr[d0] = *reinterpret_cast<bf16x8*>(&w); }
#pragma unroll
    for (int t = 0; t < 2; ++t) { const int da = 8 + t, db = 10 + t, j0 = 16 * t + 8 * hi;
      const float* rp = rope0 + row * 64 + j0;
      const f32x4 c0 = *(const f32x4*)rp, c1 = *(const f32x4*)(rp + 4), s0 = *(const f32x4*)(rp + 32), s1 = *(const f32x4*)(rp + 36);
      const f32x4 ga0 = *(const f32x4*)(qg + 16 * da + 8 * hi), ga1 = *(const f32x4*)(qg + 16 * da + 8 * hi + 4), gb0 = *(const f32x4*)(qg + 16 * db + 8 * hi), gb1 = *(const f32x4*)(qg + 16 * db + 8 * hi + 4);
      const float cs[8] = {c0.x, c0.y, c0.z, c0.w, c1.x, c1.y, c1.z, c1.w}, sn[8] = {s0.x, s0.y, s0.z, s0.w, s1.x, s1.y, s1.z, s1.w};
      const float ga[8] = {ga0.x, ga0.y, ga0.z, ga0.w, ga1.x, ga1.y, ga1.z, ga1.w}, gb[8] = {gb0.x, gb0.y, gb0.z, gb0.w, gb1.x, gb1.y, gb1.z, gb1.w};
      float oa[8], ob[8];
#pragma unroll
      for (int i = 0; i < 8; ++i) { const float xa = QX(da, i) * ga[i], xb = QX(db, i) * gb[i]; oa[i] = xa * cs[i] - xb * sn[i]; ob[i] = xb * cs[i] + xa * sn[i]; }
      u32x4 wa = {cvtpk(oa[0], oa[1]), cvtpk(oa[2], oa[3]), cvtpk(oa[4], oa[5]), cvtpk(oa[6], oa[7])}, wb = {cvtpk(ob[0], ob[1]), cvtpk(ob[2], ob[3]), cvtpk(ob[4], ob[5]), cvtpk(ob[6], ob[7])};
      *(__attribute__((address_space(3))) bf16x8*)(qb0 + (da - 8) * 1024) = *reinterpret_cast<bf16x8*>(&wa);
      *(__attribute__((address_space(3))) bf16x8*)(qb0 + (db - 8) * 1024) = *reinterpret_cast<bf16x8*>(&wb); }
#undef QX
  }
  const int sr = tid >> 4, sc = (tid & 15) * 8, vst0 = v_st(sr, sc), vst1 = v_st(32 + sr, sc);
  unsigned koff[3]; int kst[3];
#pragma unroll
  for (int i = 0; i < 3; ++i) { const int q = tid + 512 * i; koff[i] = (unsigned)((q / 24) * LDK + (q % 24) * 8); kst[i] = k_st(q / 24, q % 24); }
  const unsigned voff0 = (unsigned)(sr * LDK + sc), voff1 = (unsigned)((32 + sr) * LDK + sc);
  const int vb0 = (int)(uintptr_t)V_lds + v_rd_base(lane); const int kb0 = (int)(uintptr_t)K_lds + k_rd_base(r32, hi);
  struct { bf16x8 vs0, vs1, ks0, ks1, ks2; } sr_[1];
#define SLOAD(i, k0) do { const bf16* vt = Vh + (size_t)(k0) * LDK; const bf16* kt = Kh + (size_t)(k0) * LDK; \
    sr_[i].vs0 = *(const bf16x8*)(vt + voff0); sr_[i].vs1 = *(const bf16x8*)(vt + voff1); \
    sr_[i].ks0 = *(const bf16x8*)(kt + koff[0]); sr_[i].ks1 = *(const bf16x8*)(kt + koff[1]); sr_[i].ks2 = *(const bf16x8*)(kt + koff[2]); } while (0)
#define SWRITE(b, i) do { *(bf16x8*)(V_lds + (b) * SHM_V + vst0) = sr_[i].vs0; *(bf16x8*)(V_lds + (b) * SHM_V + vst1) = sr_[i].vs1; \
    *(bf16x8*)(K_lds + (b) * SHM_K + kst[0]) = sr_[i].ks0; *(bf16x8*)(K_lds + (b) * SHM_K + kst[1]) = sr_[i].ks1; *(bf16x8*)(K_lds + (b) * SHM_K + kst[2]) = sr_[i].ks2; } while (0)
#define SWAIT() do { if constexpr (SDEPTH == 2) asm volatile("s_waitcnt vmcnt(5)" ::: "memory"); else asm volatile("s_waitcnt vmcnt(0)" ::: "memory"); } while (0)
#define RESC(a) do { if (__any((a) < 1.f)) { if (hi == 0) al_l[r32] = (a); asm volatile("s_waitcnt lgkmcnt(0)" ::: "memory"); \
    _Pragma("unroll") for (int d = 0; d < 4; ++d) _Pragma("unroll") for (int r = 0; r < 16; ++r) o[d][r] *= al_l[crow(r, hi)]; } } while (0)
  f32x16 pA0, pA1, pB0, pB1; float mnA, mnB, alA, alB; bf16x8 pa0, pa1, pa2, pa3; const int NT = seq / KVBLK;
#define PSM(P0, P1, MN, AL) do { if constexpr (FAST) { partialSM_fast(P0, P1, negMC); AL = 1.f; } else partialSM(P0, P1, m_reg, MN, AL); } while (0)
#define RSC(AL) do { if constexpr (!FAST) RESC(AL); } while (0)
  SLOAD(0, 0); asm volatile("s_waitcnt vmcnt(0)" ::: "memory"); SWRITE(0, 0); __syncthreads();
  qkt(pA0, pA1, kb0, qr, qb0); PSM(pA0, pA1, mnA, alA);
  SLOAD(0, KVBLK);
  asm volatile("s_waitcnt vmcnt(0)" ::: "memory"); SWRITE(1, 0); __syncthreads();
  for (int j = 1; j + 1 < NT; j += 2) {
    SBAR(); qkt(pB0, pB1, kb0 + SHM_K, qr, qb0);
    finishSM(pA0, pA1, alA, l_reg, pa0, pa1, pa2, pa3); SBAR();
    SLOAD(0, (j + 1) * KVBLK); SBAR();
    pv_d0(o, vb0, pa0, pa1, pa2, pa3); PSM(pB0, pB1, mnB, alB);
    __syncthreads(); asm volatile("s_waitcnt vmcnt(0)" ::: "memory"); SWRITE(0, 0);
    RSC(alB); __syncthreads();
    SBAR(); qkt(pA0, pA1, kb0, qr, qb0);
    finishSM(pB0, pB1, alB, l_reg, pa0, pa1, pa2, pa3); SBAR();
    SLOAD(0, (j + 2) * KVBLK); SBAR();
    pv_d0(o, vb0 + (int)SHM_V, pa0, pa1, pa2, pa3); PSM(pA0, pA1, mnA, alA);
    __syncthreads(); asm volatile("s_waitcnt vmcnt(0)" ::: "memory"); SWRITE(1, 0);
    RSC(alA); __syncthreads();
  }
  SBAR(); qkt(pB0, pB1, kb0 + SHM_K, qr, qb0);
  finishSM(pA0, pA1, alA, l_reg, pa0, pa1, pa2, pa3); SBAR();
  pv_d0(o, vb0, pa0, pa1, pa2, pa3); PSM(pB0, pB1, mnB, alB);
  __syncthreads(); RSC(alB);
  finishSM(pB0, pB1, alB, l_reg, pa0, pa1, pa2, pa3); SBAR();
  pv_d0(o, vb0 + (int)SHM_V, pa0, pa1, pa2, pa3);
  if (hi == 0) li_l[r32] = l_reg; asm volatile("s_waitcnt lgkmcnt(0)" ::: "memory");
  bf16* Ow = Ob + (unsigned)(wid * QBLK * LDO + r32);
#pragma unroll
  for (int r = 0; r < 16; ++r) { const int orow = crow(r, hi); const float rl = __builtin_amdgcn_rcpf(li_l[orow]);
#pragma unroll
    for (int d0 = 0; d0 < 4; ++d0) { const unsigned w = cvtpk(o[d0][r] * rl, 0.f); Ow[(unsigned)(orow * LDO + d0 * 32)] = (bf16)(w & 0xffffu); } }
  __syncthreads();
#undef SLOAD
#undef SWRITE
#undef SWAIT
#undef RESC
#undef PSM
#undef RSC
}
}
namespace hy {
#define HY_LAS __attribute__((address_space(3)))
typedef unsigned short bf16;
typedef short bf16x8 __attribute__((ext_vector_type(8)));
typedef float f32x16 __attribute__((ext_vector_type(16)));
typedef unsigned u32x2 __attribute__((ext_vector_type(2)));
typedef unsigned u32x4 __attribute__((ext_vector_type(4)));
constexpr int L = 2048, NB = 24, CH = 512;
constexpr int RFS = 4112;
constexpr int ZROW = 4112;
constexpr int ZL_BYTES = NB * ZROW;
constexpr int RCS = 8256;
constexpr int RC_OFF = ZL_BYTES;
constexpr int HY_LDS_BYTES = RC_OFF + 4 * RCS;
__device__ __forceinline__ unsigned cvtpk(float lo, float hi) { unsigned r; asm volatile("v_cvt_pk_bf16_f32 %0, %1, %2" : "=v"(r) : "v"(lo), "v"(hi)); return r; }
__host__ __device__ __forceinline__ int frag_base(int tw, int r, int h) { const int a = (4 - (r & 3)) & 3; return RC_OFF + a * RCS + 2 * (2048 - tw - r + 8 * h - a); }
__host__ __device__ __forceinline__ int zfrag_base(int r, int h) { return (r < NB ? r : NB - 1) * ZROW + 16 * h; }

__device__ __forceinline__ bf16x8 ld_frag(HY_LAS unsigned char* lds, int off) {
    const u32x2 lo = *(const HY_LAS u32x2*)(lds + off), hi = *(const HY_LAS u32x2*)(lds + off + 8);
    u32x4 w = {lo.x, lo.y, hi.x, hi.y}; return *reinterpret_cast<bf16x8*>(&w);
}
__device__ __forceinline__ bf16x8 ld_b128(HY_LAS unsigned char* lds, int off) { return *(const HY_LAS bf16x8*)(lds + off); }

__device__ __forceinline__ void conv_unit(HY_LAS unsigned char* lds, const bf16* __restrict__ ZT, const bf16* __restrict__ RF, bf16* __restrict__ YC, int c, int half) {
    const int tid = opq(threadIdx.x), wid = tid >> 6, lane = tid & 63, r = lane & 31, h = lane >> 5;
    { const u32x4* src = (const u32x4*)(ZT + (size_t)c * NB * L);
#pragma unroll
      for (int i = 0; i < 12; ++i) { const int q = tid + 512 * i; const u32x4 v = src[q]; *(HY_LAS u32x4*)(lds + (q >> 8) * ZROW + (q & 255) * 16) = v; } }
    { const bf16* rf = RF + (size_t)c * RFS;
      for (int ch = tid; ch < RFS / 8; ch += 512) {
          const u32x4 v = *(const u32x4*)(rf + ch * 8); const unsigned w[4] = {v.x, v.y, v.z, v.w};
#pragma unroll
          for (int j = 0; j < 8; ++j) { const unsigned short e = (unsigned short)((w[j >> 1] >> ((j & 1) * 16)) & 0xffffu); const int idx = ch * 8 + j;
#pragma unroll
              for (int a = 0; a < 4; ++a) if (idx - a >= 0) *(HY_LAS unsigned short*)(lds + RC_OFF + a * RCS + 2 * (idx - a)) = e; } } }
    __syncthreads();
    const int tw = half * 1024 + wid * 128;
    const int fb = frag_base(tw, r, h), zb = zfrag_base(r, h);
    f32x16 acc[4] = {};
    bf16x8 S0[2], S1[2], S2[2], S3[2], Bc[2], Bn[2];
#define HY_LDG(S, d) do { S[0] = ld_frag(lds, fb + 64 * (d)); S[1] = ld_frag(lds, fb + 64 * (d) + 32); } while (0)
#define HY_LDB(Bx, n) do { Bx[0] = ld_b128(lds, zb + 64 * (n)); Bx[1] = ld_b128(lds, zb + 64 * (n) + 32); } while (0)
#define HY_MM(i, S, Bx) do { acc[i] = __builtin_amdgcn_mfma_f32_32x32x16_bf16(S[0], Bx[0], acc[i], 0, 0, 0); acc[i] = __builtin_amdgcn_mfma_f32_32x32x16_bf16(S[1], Bx[1], acc[i], 0, 0, 0); } while (0)
#define HY_ITER(n, Sa, Sb, Sc, Sd, Bcur, Bnext) do { HY_LDG(Sa, (n)); if ((n) + 1 < 64) HY_LDB(Bnext, (n) + 1); \
        HY_MM(1, Sb, Bcur); HY_MM(2, Sc, Bcur); HY_MM(3, Sd, Bcur); HY_MM(0, Sa, Bcur); } while (0)
    HY_LDG(S3, -1); HY_LDG(S2, -2); HY_LDG(S1, -3); HY_LDB(Bc, 0);
    for (int n = 0; n < 64; n += 4) {
        HY_ITER(n, S0, S3, S2, S1, Bc, Bn);
        HY_ITER(n + 1, S1, S0, S3, S2, Bn, Bc);
        HY_ITER(n + 2, S2, S1, S0, S3, Bc, Bn);
        HY_ITER(n + 3, S3, S2, S1, S0, Bn, Bc);
    }
#undef HY_LDG
#undef HY_LDB
#undef HY_MM
#undef HY_ITER
    if (r < NB) { bf16* yp = YC + ((size_t)c * NB + r) * L + tw + 4 * h;
#pragma unroll
        for (int i = 0; i < 4; ++i)
#pragma unroll
            for (int q4 = 0; q4 < 4; ++q4) { u32x2 w; w.x = cvtpk(acc[i][4 * q4 + 0], acc[i][4 * q4 + 1]); w.y = cvtpk(acc[i][4 * q4 + 2], acc[i][4 * q4 + 3]);
                *(u32x2*)(yp + 32 * i + 8 * q4) = w; } }
    __syncthreads();
}
}
constexpr int NWAVES = 8;
#ifndef MK_ONE_LAUNCH
#define MK_ONE_LAUNCH 1
#endif
constexpr int DM = 2048, NSEQ = 24, SEQ = 2048, M = NSEQ * SEQ, MP = 8 * SEQ;
constexpr int DEPTH = 4;
constexpr int DIN = 2880, DINP = 3072;
constexpr int O_CQ = 512, O_CKV = 1024, O_KPE = 1280, O_HY = 1344;
constexpr int NH = 8, NQ = 1536, NKVP = 2560, KVHS = 320;
constexpr int DFF = 5632, NUP = 11264, HYC = 512;
constexpr float EPS = 1e-6f;
constexpr int NPH = 11;
constexpr size_t WS_CTL = 0, CTL_BYTES = 1u << 20;
constexpr size_t SZ_BTIN = (size_t)DINP * DM * 2, SZ_BTUQ = (size_t)NQ * 512 * 2, SZ_BTKV = (size_t)NKVP * 256 * 2, SZ_BTOUT = (size_t)DM * DM * 2, SZ_BTUP = (size_t)NUP * DM * 2, SZ_BTDN = (size_t)DM * DFF * 2;
constexpr size_t WS_BTIN = WS_CTL + CTL_BYTES, WS_BTUQ = WS_BTIN + SZ_BTIN, WS_BTKV = WS_BTUQ + SZ_BTUQ, WS_BTOUT = WS_BTKV + SZ_BTKV, WS_BTUP = WS_BTOUT + SZ_BTOUT, WS_BTDN = WS_BTUP + SZ_BTUP;
constexpr size_t WS_RF = WS_BTDN + SZ_BTDN, SZ_RF = (size_t)HYC * hy::RFS * 2;
constexpr size_t WS_H = WS_RF + SZ_RF, SZ_H = (size_t)M * DM * 2;
constexpr size_t WS_PROJ = WS_H + SZ_H, SZ_PROJ = (size_t)M * DINP * 2;
constexpr size_t WS_Q = WS_PROJ + SZ_PROJ, SZ_Q = (size_t)M * NQ * 2;
constexpr size_t WS_KV = WS_Q + SZ_Q, SZ_KV = (size_t)M * NKVP * 2;
constexpr size_t WS_ZT = WS_KV + SZ_KV, SZ_ZT = (size_t)HYC * NSEQ * SEQ * 2;
constexpr size_t WS_X0 = WS_ZT + SZ_ZT, WS_YC = WS_X0 + SZ_ZT;
constexpr size_t WS_EDGE = WS_YC + SZ_ZT, SZ_EDGE = (size_t)(M / 256) * 2 * 3 * DFF * 4;
constexpr size_t WS_ROPE = WS_EDGE + SZ_EDGE, SZ_ROPE = (size_t)SEQ * 64 * 4;
constexpr size_t WS_SSQP = WS_ROPE + SZ_ROPE, SZ_SSQP = (size_t)M * 32 * 4;
constexpr size_t WS_RSTD = WS_SSQP + SZ_SSQP, SZ_RSTD = (size_t)M * 4;
constexpr size_t WS_XQ = WS_RSTD + SZ_RSTD, SZ_XQ = (size_t)M * DM;
constexpr size_t WS_SSQCQ = WS_XQ + SZ_XQ, SZ_SSQCQ = (size_t)M * 8 * 4;
constexpr int NINQ = 2048;
constexpr size_t WS_BTINQ = WS_SSQCQ + SZ_SSQCQ, SZ_BTINQ = (size_t)NINQ * DM;
constexpr size_t WS_CSIN = WS_BTINQ + SZ_BTINQ, SZ_CSIN = (size_t)NINQ * 4;
constexpr size_t WS_RSTDQ = WS_CSIN + SZ_CSIN, SZ_RSTDQ = (size_t)M * 4;
constexpr size_t WS_END = WS_RSTDQ + SZ_RSTDQ;
constexpr size_t WS_ACT = WS_PROJ;
static_assert((size_t)M * DFF * 2 <= SZ_PROJ + SZ_Q + SZ_KV, "ACT overlay");
constexpr size_t WS_XB2 = WS_ACT + (size_t)M * DFF * 2;
static_assert(WS_XB2 + (size_t)M * DM * 2 <= WS_EDGE && WS_XB2 % 256 == 0, "XB2 overlay");
static_assert(WS_BTIN % 256 == 0 && WS_RF % 256 == 0 && WS_H % 256 == 0 && WS_PROJ % 256 == 0 && WS_Q % 256 == 0 && WS_KV % 256 == 0 && WS_ZT % 256 == 0 && WS_EDGE % 256 == 0, "alignment");
constexpr int CW_WMAXC = 65536;
constexpr int CW_WMAX = 1024;
constexpr int CW_BAR = 4096;
constexpr int RING_BYTES = 135168;
constexpr int HALO_OFF = RING_BYTES, HALO_BYTES = 4096;
constexpr int MISC_OFF = HALO_OFF + HALO_BYTES;
constexpr int LDS_BYTES = 147456;
static_assert(hy::HY_LDS_BYTES <= RING_BYTES && at::SHM_ATTN <= RING_BYTES && MISC_OFF + 256 <= LDS_BYTES, "LDS map");

#define GAS __attribute__((address_space(1)))
#define LAS __attribute__((address_space(3)))
typedef unsigned short bf16;
typedef unsigned v4u __attribute__((ext_vector_type(4)));
typedef unsigned v2u __attribute__((ext_vector_type(2)));
typedef float f32x4 __attribute__((ext_vector_type(4)));
#define LDS_WAIT() asm volatile("s_waitcnt lgkmcnt(0)" ::: "memory")
__device__ __forceinline__ unsigned f2bf(float f) { unsigned u = __builtin_bit_cast(unsigned, f); return (u + 0x7fffu + ((u >> 16) & 1u)) >> 16; }
__device__ __forceinline__ unsigned pk2(float lo, float hi) { return f2bf(lo) | (f2bf(hi) << 16); }
__device__ __forceinline__ float bf2f(unsigned short b) { return __builtin_bit_cast(float, (unsigned)b << 16); }
__device__ __forceinline__ float bflo(unsigned w) { return __builtin_bit_cast(float, w << 16); }
__device__ __forceinline__ float bfhi(unsigned w) { return __builtin_bit_cast(float, w & 0xffff0000u); }
__device__ __forceinline__ float wave_sum(float v) {
#pragma unroll
    for (int o = 1; o < 64; o <<= 1) v += __shfl_xor(v, o);
    return v;
}

#define XB_TMO      128
#define XB_XCNT(j)  (256  + 64 * (j))
#define XB_XSUB(j)  (1280 + 64 * (j))
#define XB_XGEN(j)  (2304 + 64 * (j))
#define XB_TOP      3328
#define XB_TOPGEN   3392
#define XCD_BAR_WORDS 3456
#define XB_SPIN_CAP (1u << 18)
__device__ __forceinline__ unsigned xb_ld(unsigned* p)              { return __hip_atomic_load(p, __ATOMIC_RELAXED, __HIP_MEMORY_SCOPE_AGENT); }
__device__ __forceinline__ unsigned xb_add(unsigned* p, unsigned v) { return __hip_atomic_fetch_add(p, v, __ATOMIC_RELAXED, __HIP_MEMORY_SCOPE_AGENT); }
__device__ __forceinline__ unsigned xb_xcc_id() { return (unsigned)__builtin_amdgcn_s_getreg((3 << 11) | 20) & 0xFu; }
#define XB_SPIN(cond, bar) do { unsigned _sp = 0; while (cond) { __builtin_amdgcn_s_sleep(1); \
    if ((++_sp & 255u) == 0u) { if (xb_ld(&(bar)[XB_TMO])) break; if (_sp > XB_SPIN_CAP) { atomicAdd(&(bar)[XB_TMO], 1u); break; } } } } while (0)
struct XcdBarrier { unsigned* bar; unsigned x; volatile LAS unsigned* st; };
__device__ __forceinline__ XcdBarrier xcd_barrier_post(unsigned* bar, volatile LAS unsigned* st) {
    XcdBarrier b; b.bar = bar; b.x = xb_xcc_id(); b.st = st;
    if (threadIdx.x == 0) (void)xb_add(&bar[XB_XCNT(b.x)], 1u);
    return b;
}
__device__ __forceinline__ void xcd_barrier_complete(unsigned* bar, unsigned x, unsigned& nloc, unsigned& nx) {
    const unsigned G = gridDim.x * gridDim.y * gridDim.z;
    unsigned sum, cnt, mine, sp = 0u;
    for (;;) {
        sum = 0u; cnt = 0u; mine = 0u;
#pragma unroll
        for (unsigned j = 0; j < 16; ++j) { const unsigned c = xb_ld(&bar[XB_XCNT(j)]); sum += c; cnt += (c > 0u) ? 1u : 0u; mine = (j == x) ? c : mine; }
        if (sum == G) break;
        __builtin_amdgcn_s_sleep(1);
        if ((++sp & 255u) == 0u) { if (xb_ld(&bar[XB_TMO])) break; if (sp > XB_SPIN_CAP) { atomicAdd(&bar[XB_TMO], 1u); break; } }
    }
    nloc = mine > 0u ? mine : 1u; nx = cnt > 0u ? cnt : 1u;
}
__device__ __forceinline__ void xcd_barrier(const XcdBarrier& b) {
    asm volatile("s_waitcnt vmcnt(0)" ::: "memory");
    __syncthreads();
    if (threadIdx.x == 0) {
        unsigned* bar = b.bar;
        __builtin_amdgcn_s_waitcnt(0);
        unsigned nloc = b.st[0], nx = b.st[1];
        if (nloc == 0u) { xcd_barrier_complete(bar, b.x, nloc, nx); b.st[0] = nloc; b.st[1] = nx; }
        const unsigned old = xb_add(&bar[XB_XSUB(b.x)], 1u);
        const unsigned gen = old / nloc;
        if (old + 1u == (gen + 1u) * nloc) {
            __builtin_amdgcn_fence(__ATOMIC_RELEASE, "agent");
            asm volatile("s_waitcnt vmcnt(0)" ::: "memory");
            const unsigned og = xb_add(&bar[XB_TOP], 1u);
            const unsigned tg = og / nx;
            if (og + 1u == (tg + 1u) * nx) xb_add(&bar[XB_TOPGEN], 1u);
            else XB_SPIN(xb_ld(&bar[XB_TOPGEN]) == tg, bar);
            __builtin_amdgcn_fence(__ATOMIC_ACQUIRE, "agent");
            xb_add(&bar[XB_XGEN(b.x)], 1u);
            asm volatile("s_waitcnt vmcnt(0)" ::: "memory");
        } else {
            XB_SPIN(xb_ld(&bar[XB_XGEN(b.x)]) == gen, bar);
            __builtin_amdgcn_fence(__ATOMIC_ACQUIRE, "agent");
            asm volatile("s_waitcnt vmcnt(0)" ::: "memory");
        }
    }
    __syncthreads();
}

struct Frame {
    LAS unsigned char* lds;
    int tid, lane, wave, vcu, G, bx, vcu0, G0, bx0;
};
enum { I_XP = 0, I_XS, I_ANG, I_WIN, I_PW, I_PS, I_QNG, I_WUQ, I_KVNG, I_WUKV, I_QHG, I_KHG, I_HCW, I_HCB, I_FW1, I_FB1, I_FFR, I_FW2, I_FB2, I_FW3, I_FB3, I_HBIAS, I_GNG, I_WOUT, I_FNG, I_WUP, I_FCW, I_FCB, I_WDN, N_IN };
struct Args { const float* in[N_IN]; float* out; unsigned char* ws; int ph_lo, ph_hi; };
static_assert(sizeof(Args) == (N_IN + 2) * 8 + 8, "Args has no padding");

__device__ __forceinline__ void cvt_item(const float* __restrict__ W, int ldw, int K, bf16* WT, int dst_n0, int src_n0, int k0, const float* __restrict__ ks, LAS float* scr, int lane) {
#pragma unroll
    for (int i = 0; i < 32; ++i) { const int kk = 2 * i + (lane >> 5); float v = W[(size_t)(k0 + kk) * ldw + src_n0 + (lane & 31)]; if (ks) v *= ks[k0 + kk]; scr[kk * 33 + (lane & 31)] = v; }
    LDS_WAIT(); asm volatile("" ::: "memory");
    const int c = lane & 7;
#pragma unroll
    for (int j = 0; j < 4; ++j) { const int n = (lane >> 3) + 8 * j; const LAS float* s = scr + (8 * c) * 33 + n;
        v4u o; o.x = pk2(s[0 * 33], s[1 * 33]); o.y = pk2(s[2 * 33], s[3 * 33]); o.z = pk2(s[4 * 33], s[5 * 33]); o.w = pk2(s[6 * 33], s[7 * 33]);
        *(v4u*)(WT + (size_t)(dst_n0 + n) * K + k0 + 8 * c) = o; }
    LDS_WAIT(); asm volatile("" ::: "memory");
}
struct CvtTile { const float* W; const float* ks; bf16* WT; int ldw, K, src_n0, k0, ncols; int dst[4]; };
__device__ __forceinline__ void cvt_tile(Frame& F, const CvtTile& d) {
    LAS float* T = (LAS float*)F.lds;
#pragma unroll
    for (int i = 0; i < 8; ++i) { const int q = F.tid + 512 * i, row = q >> 5, c4 = q & 31;
        f32x4 v = {0.f, 0.f, 0.f, 0.f};
        if (d.src_n0 + 4 * c4 < d.ncols) v = *(const f32x4*)(d.W + (size_t)(d.k0 + row) * d.ldw + d.src_n0 + 4 * c4);
        if (d.ks) v *= d.ks[d.k0 + row];
        LAS float* t = T + row * 129 + 4 * c4; t[0] = v.x; t[1] = v.y; t[2] = v.z; t[3] = v.w; }
    __syncthreads();
#pragma unroll
    for (int i = 0; i < 4; ++i) { const int n = (F.tid >> 4) + 32 * i, kc = F.tid & 15;
        if (d.src_n0 + n < d.ncols) { const LAS float* s = T + (8 * kc) * 129 + n;
            v4u o; o.x = pk2(s[0], s[129]); o.y = pk2(s[2 * 129], s[3 * 129]); o.z = pk2(s[4 * 129], s[5 * 129]); o.w = pk2(s[6 * 129], s[7 * 129]);
            *(v4u*)(d.WT + (size_t)(d.dst[i] + (n & 31)) * d.K + d.k0 + 8 * kc) = o; } }
    __syncthreads();
}
__device__ __forceinline__ void absmax_tile(Frame& F, const float* __restrict__ W, const float* __restrict__ ks, int ldw, int src_n0, int k0, unsigned* outc) {
    LAS float* P = (LAS float*)F.lds;
    f32x4 m = {0.f, 0.f, 0.f, 0.f};
#pragma unroll
    for (int i = 0; i < 8; ++i) { const int q = F.tid + 512 * i, row = q >> 5, c4 = q & 31;
        const f32x4 v = *(const f32x4*)(W + (size_t)(k0 + row) * ldw + src_n0 + 4 * c4) * ks[k0 + row];
        m.x = fmaxf(m.x, fabsf(v.x)); m.y = fmaxf(m.y, fabsf(v.y)); m.z = fmaxf(m.z, fabsf(v.z)); m.w = fmaxf(m.w, fabsf(v.w)); }
    *(LAS f32x4*)(P + (F.tid >> 5) * 128 + 4 * (F.tid & 31)) = m;
    __syncthreads();
    if (F.tid < 128) { float c = P[F.tid];
#pragma unroll
        for (int g = 1; g < 16; ++g) c = fmaxf(c, P[g * 128 + F.tid]);
        atomicMax(outc + src_n0 + F.tid, __builtin_bit_cast(unsigned, c)); }
    __syncthreads();
}
__device__ __forceinline__ unsigned q8(float v) { const int q = (int)__builtin_rintf(v); return (unsigned)(q < -127 ? -127 : (q > 127 ? 127 : q)) & 0xffu; }
__device__ __forceinline__ void cvtq_tile(Frame& F, const float* __restrict__ W, const float* __restrict__ ks, int ldw, int K, unsigned char* WT, int src_n0, int k0, int dst0, const unsigned* __restrict__ wmaxc) {
    LAS float* T = (LAS float*)F.lds;
    f32x4 inv4; { const v4u mb = *(const v4u*)(wmaxc + src_n0 + 4 * (F.tid & 31));
        inv4.x = 127.0f / fmaxf(__builtin_bit_cast(float, mb.x), 1e-30f); inv4.y = 127.0f / fmaxf(__builtin_bit_cast(float, mb.y), 1e-30f); inv4.z = 127.0f / fmaxf(__builtin_bit_cast(float, mb.z), 1e-30f); inv4.w = 127.0f / fmaxf(__builtin_bit_cast(float, mb.w), 1e-30f); }
#pragma unroll
    for (int i = 0; i < 8; ++i) { const int q = F.tid + 512 * i, row = q >> 5, c4 = q & 31;
        const f32x4 v = *(const f32x4*)(W + (size_t)(k0 + row) * ldw + src_n0 + 4 * c4) * ks[k0 + row] * inv4;
        LAS float* t = T + row * 129 + 4 * c4; t[0] = v.x; t[1] = v.y; t[2] = v.z; t[3] = v.w; }
    __syncthreads();
#pragma unroll
    for (int i = 0; i < 2; ++i) { const int n = (F.tid >> 3) + 64 * i, kc = F.tid & 7;
        const LAS float* s = T + (16 * kc) * 129 + n; unsigned w[4];
#pragma unroll
        for (int j = 0; j < 4; ++j) w[j] = q8(s[(4 * j) * 129]) | (q8(s[(4 * j + 1) * 129]) << 8) | (q8(s[(4 * j + 2) * 129]) << 16) | (q8(s[(4 * j + 3) * 129]) << 24);
        v4u o; o.x = w[0]; o.y = w[1]; o.z = w[2]; o.w = w[3];
        *(v4u*)(WT + (size_t)(dst0 + 64 * (n >> 5) + (n & 31)) * K + k0 + 16 * kc) = o; }
    __syncthreads();
}
__device__ __forceinline__ void xq_row(const bf16* __restrict__ xrow, unsigned char* qrow, const float* __restrict__ ssq32, float* rowf, float s_w, int lane) {
    v4u v[4]; float m = 0.f;
#pragma unroll
    for (int j = 0; j < 4; ++j) { v[j] = *(const v4u*)(xrow + 8 * (lane + 64 * j)); const unsigned w[4] = {v[j].x, v[j].y, v[j].z, v[j].w};
#pragma unroll
        for (int i = 0; i < 4; ++i) m = fmaxf(m, fmaxf(fabsf(bflo(w[i])), fabsf(bfhi(w[i])))); }
    float ss = (lane < 32) ? ssq32[lane] : 0.f;
#pragma unroll
    for (int o = 1; o < 64; o <<= 1) { m = fmaxf(m, __shfl_xor(m, o)); ss += __shfl_xor(ss, o); }
    m = fmaxf(m, 1e-30f); const float inv = 127.0f / m;
    if (lane == 0) *rowf = (1.0f / sqrtf(ss * (1.f / DM) + EPS)) * (m * (1.0f / 127.0f)) * s_w;
#pragma unroll
    for (int j = 0; j < 4; ++j) { const unsigned w[4] = {v[j].x, v[j].y, v[j].z, v[j].w}; v2u o;
        o.x = q8(bflo(w[0]) * inv) | (q8(bfhi(w[0]) * inv) << 8) | (q8(bflo(w[1]) * inv) << 16) | (q8(bfhi(w[1]) * inv) << 24);
        o.y = q8(bflo(w[2]) * inv) | (q8(bfhi(w[2]) * inv) << 8) | (q8(bflo(w[3]) * inv) << 16) | (q8(bfhi(w[3]) * inv) << 24);
        *(v2u*)(qrow + 8 * (lane + 64 * j)) = o; }
}
__device__ __forceinline__ void q8_row(const bf16* __restrict__ xrow, unsigned char* qrow, float rs, float* rowf, int lane) {
    v4u v[4]; float m = 0.f;
#pragma unroll
    for (int j = 0; j < 4; ++j) { v[j] = *(const v4u*)(xrow + 8 * (lane + 64 * j)); const unsigned w[4] = {v[j].x, v[j].y, v[j].z, v[j].w};
#pragma unroll
        for (int i = 0; i < 4; ++i) m = fmaxf(m, fmaxf(fabsf(bflo(w[i])), fabsf(bfhi(w[i])))); }
#pragma unroll
    for (int o = 1; o < 64; o <<= 1) m = fmaxf(m, __shfl_xor(m, o));
    m = fmaxf(m, 1e-30f); const float inv = 127.0f / m;
    if (lane == 0) *rowf = rs * (m * (1.0f / 127.0f));
#pragma unroll
    for (int j = 0; j < 4; ++j) { const unsigned w[4] = {v[j].x, v[j].y, v[j].z, v[j].w}; v2u o;
        o.x = q8(bflo(w[0]) * inv) | (q8(bfhi(w[0]) * inv) << 8) | (q8(bflo(w[1]) * inv) << 16) | (q8(bfhi(w[1]) * inv) << 24);
        o.y = q8(bflo(w[2]) * inv) | (q8(bfhi(w[2]) * inv) << 8) | (q8(bflo(w[3]) * inv) << 16) | (q8(bfhi(w[3]) * inv) << 24);
        *(v2u*)(qrow + 8 * (lane + 64 * j)) = o; }
}
__device__ __forceinline__ void xb_row(const float* xrow, bf16* orow, float* rstd, unsigned char* qrow, float* rowfq, int lane) {
    const f32x4* xr = (const f32x4*)xrow + lane;
    f32x4 v[8]; float s = 0.f;
#pragma unroll
    for (int j = 0; j < 8; ++j) { v[j] = xr[64 * j]; s += (v[j].x * v[j].x + v[j].y * v[j].y) + (v[j].z * v[j].z + v[j].w * v[j].w); }
    const float r = 1.0f / sqrtf(wave_sum(s) * (1.f / DM) + EPS);
    if (lane == 0) *rstd = r;
    v2u* o8 = (v2u*)orow + lane; float mx = 0.f;
#pragma unroll
    for (int j = 0; j < 8; ++j) { v2u w; w.x = pk2(v[j].x, v[j].y); w.y = pk2(v[j].z, v[j].w); o8[64 * j] = w;
        v[j].x = bflo(w.x); v[j].y = bfhi(w.x); v[j].z = bflo(w.y); v[j].w = bfhi(w.y);
        mx = fmaxf(mx, fmaxf(fmaxf(fabsf(v[j].x), fabsf(v[j].y)), fmaxf(fabsf(v[j].z), fabsf(v[j].w)))); }
#pragma unroll
    for (int o = 1; o < 64; o <<= 1) mx = fmaxf(mx, __shfl_xor(mx, o));
    mx = fmaxf(mx, 1e-30f); const float inv = 127.0f / mx;
    if (lane == 0) *rowfq = r * (mx * (1.0f / 127.0f));
    unsigned* q4 = (unsigned*)qrow + lane;
#pragma unroll
    for (int j = 0; j < 8; ++j) q4[64 * j] = q8(v[j].x * inv) | (q8(v[j].y * inv) << 8) | (q8(v[j].z * inv) << 16) | (q8(v[j].w * inv) << 24);
}
__device__ __forceinline__ void rstd_from_partials(const float* __restrict__ ssqp, float* rstd, size_t gtid, size_t gthreads) {
    for (size_t r = gtid; r < (size_t)M; r += gthreads) { const f32x4* p = (const f32x4*)(ssqp + r * 32); f32x4 a = p[0];
#pragma unroll
        for (int i = 1; i < 8; ++i) a += p[i];
        rstd[r] = 1.0f / sqrtf(((a.x + a.y) + (a.z + a.w)) * (1.f / DM) + EPS); }
}
__device__ __forceinline__ void tile_norm_store(LAS float* tile, bf16* dst, int row0, int col_off, int wave, int lane) {
#pragma unroll
    for (int i = 0; i < 8; ++i) { const int t = wave * 8 + i;
        const f32x4 a = *(LAS f32x4*)(tile + t * 512 + 8 * lane), b = *(LAS f32x4*)(tile + t * 512 + 8 * lane + 4);
        const float s = (a.x * a.x + a.y * a.y) + (a.z * a.z + a.w * a.w) + (b.x * b.x + b.y * b.y) + (b.z * b.z + b.w * b.w);
        const float rstd = 1.0f / sqrtf(wave_sum(s) * (1.f / 512.f) + EPS);
        v4u o; o.x = pk2(a.x * rstd, a.y * rstd); o.y = pk2(a.z * rstd, a.w * rstd); o.z = pk2(b.x * rstd, b.y * rstd); o.w = pk2(b.z * rstd, b.w * rstd);
        *(v4u*)(dst + (size_t)(row0 + t) * DM + col_off + 8 * lane) = o; }
}
__device__ __forceinline__ void poolfold_item(Frame& F, const float* __restrict__ win, const float* __restrict__ pw, const float* __restrict__ ps, const float* __restrict__ g1, bf16* BtIn, int g, int kb) {
    LAS float* At = (LAS float*)F.lds; LAS float* Bt = (LAS float*)(F.lds + 32768);
    const int k0 = 64 * kb;
#pragma unroll
    for (int i = 0; i < 4; ++i) { const int q = F.tid + 512 * i, row = q >> 5, c4 = q & 31; *(LAS f32x4*)(At + row * 128 + 4 * c4) = *(const f32x4*)(win + (size_t)(k0 + row) * DIN + 128 * g + 4 * c4) * g1[k0 + row]; }
#pragma unroll
    for (int i = 0; i < 8; ++i) { const int q = F.tid + 512 * i, row = q >> 5, c4 = q & 31; *(LAS f32x4*)(Bt + row * 128 + 4 * c4) = *(const f32x4*)(pw + (size_t)(g * 128 + row) * 128 + 4 * c4); }
    __syncthreads();
    const int n = F.tid & 127, kg = F.tid >> 7;
    float acc[16];
#pragma unroll
    for (int i = 0; i < 16; ++i) acc[i] = 0.f;
    for (int j = 0; j < 128; j += 4) {
        const float b0 = Bt[(j + 0) * 128 + n], b1 = Bt[(j + 1) * 128 + n], b2 = Bt[(j + 2) * 128 + n], b3 = Bt[(j + 3) * 128 + n];
#pragma unroll
        for (int i = 0; i < 16; ++i) { const f32x4 a = *(LAS f32x4*)(At + (kg * 16 + i) * 128 + j); acc[i] += a.x * b0 + a.y * b1 + a.z * b2 + a.w * b3; }
    }
    const float sc = ps[128 * g + n];
    v4u o0, o1;
    o0.x = pk2(acc[0] * sc, acc[1] * sc); o0.y = pk2(acc[2] * sc, acc[3] * sc); o0.z = pk2(acc[4] * sc, acc[5] * sc); o0.w = pk2(acc[6] * sc, acc[7] * sc);
    o1.x = pk2(acc[8] * sc, acc[9] * sc); o1.y = pk2(acc[10] * sc, acc[11] * sc); o1.z = pk2(acc[12] * sc, acc[13] * sc); o1.w = pk2(acc[14] * sc, acc[15] * sc);
    bf16* dst = BtIn + (size_t)(128 * g + n) * DM + k0 + kg * 16;
    *(v4u*)dst = o0; *(v4u*)(dst + 8) = o1;
    __syncthreads();
}
__device__ __forceinline__ void filter_item(Frame& F, const float* __restrict__ w1, const float* __restrict__ b1, const float* __restrict__ fr, const float* __restrict__ w2, const float* __restrict__ b2,
                                            const float* __restrict__ w3, const float* __restrict__ b3, const float* __restrict__ hbias, bf16* RF, int fi) {
    LAS float* ZF = (LAS float*)F.lds; LAS float* H1 = ZF + 512; LAS float* H2 = ZF + 1536; LAS float* W1s = ZF + 2560; LAS float* W2s = ZF + 3712;
    const int t0 = 16 * fi;
    for (int q = F.tid; q < 272; q += 512) *(LAS f32x4*)(W1s + 4 * q) = *(const f32x4*)(w1 + 4 * q);
#pragma unroll
    for (int i = 0; i < 2; ++i) { const int q = F.tid + 512 * i; *(LAS f32x4*)(W2s + 4 * q) = *(const f32x4*)(w2 + 4 * q); }
    if (F.tid < 272) { const int tt = F.tid / 17, f = F.tid % 17; const float t = (float)(t0 + tt);
        float v;
        if (f == 0) v = t / 2047.0f;
        else { const int j = (f - 1) & 7; const float band = 1e-4f + (float)j * ((7.0f - 1e-4f) / 7.0f); const float w = (6.283185307179586f * t) / 2048.0f; const float a = band * w; v = (f <= 8) ? __cosf(a) : -__sinf(a); }
        ZF[tt * 17 + f] = v; }
    __syncthreads();
#pragma unroll
    for (int rep = 0; rep < 2; ++rep) { const int p = F.tid + 512 * rep, tt = p >> 6, j = p & 63; float s = b1[j];
#pragma unroll
        for (int i = 0; i < 17; ++i) s += ZF[tt * 17 + i] * W1s[i * 64 + j];
        H1[tt * 64 + j] = __sinf(fr[j] * s); }
    __syncthreads();
#pragma unroll
    for (int rep = 0; rep < 2; ++rep) { const int p = F.tid + 512 * rep, tt = p >> 6, j = p & 63; float s = b2[j];
#pragma unroll 16
        for (int i = 0; i < 64; ++i) s += H1[tt * 64 + i] * W2s[i * 64 + j];
        H2[tt * 64 + j] = __sinf(fr[j] * s); }
    __syncthreads();
    const int c = F.tid;
    const float delta = -3.0701134573253944f + (float)c * ((-15.350567286626972f + 3.0701134573253944f) / 511.0f);
    const float ad = fabsf(delta);
    bf16* rf = RF + (size_t)c * hy::RFS;
#pragma unroll 1
    for (int dir = 0; dir < 2; ++dir) { const int o = dir * 512 + c; const float bo = b3[o];
        float wc[64];
#pragma unroll
        for (int i = 0; i < 64; ++i) wc[i] = w3[i * 1024 + o];
#pragma unroll 1
        for (int tt = 0; tt < 16; ++tt) { float s = bo;
#pragma unroll
            for (int i = 0; i < 64; i += 4) { const f32x4 hv = *(LAS f32x4*)(H2 + tt * 64 + i); s += (hv.x * wc[i] + hv.y * wc[i + 1]) + (hv.z * wc[i + 2] + hv.w * wc[i + 3]); }
            const int t = t0 + tt; const float tl = (float)t / 2047.0f; float val = s * __expf(-tl * ad);
            if (dir == 0) { if (t == 0) val += hbias[c]; rf[2048 - t] = (bf16)f2bf(val); }
            else if (t >= 1) rf[2048 + t] = (bf16)f2bf(val); } }
    if (fi == 0) { rf[0] = 0;
#pragma unroll
        for (int i = 4096; i < hy::RFS; ++i) rf[i] = 0; }
    __syncthreads();
}
__device__ __forceinline__ void unpack4(const v2u w, float (&x)[4]) { x[0] = bflo(w.x); x[1] = bfhi(w.x); x[2] = bflo(w.y); x[3] = bfhi(w.y); }
__device__ __forceinline__ void pair_norm_store(Frame& F, const float (&y)[8][4], bf16* dst, size_t row0, int col_off, int cq) {
    LAS float* part = (LAS float*)F.lds;
    float ss[8];
#pragma unroll
    for (int k = 0; k < 8; ++k) ss[k] = wave_sum((y[k][0] * y[k][0] + y[k][1] * y[k][1]) + (y[k][2] * y[k][2] + y[k][3] * y[k][3]));
    if (F.lane == 0) { *(LAS f32x4*)(part + F.wave * 8) = (f32x4){ss[0], ss[1], ss[2], ss[3]}; *(LAS f32x4*)(part + F.wave * 8 + 4) = (f32x4){ss[4], ss[5], ss[6], ss[7]}; }
    __syncthreads();
    const f32x4 pa = *(LAS f32x4*)(part + (F.wave ^ 1) * 8), pb = *(LAS f32x4*)(part + (F.wave ^ 1) * 8 + 4);
    const float po[8] = {pa.x, pa.y, pa.z, pa.w, pb.x, pb.y, pb.z, pb.w};
#pragma unroll
    for (int k = 0; k < 8; ++k) { const float rstd = 1.0f / sqrtf((ss[k] + po[k]) * (1.f / 512.f) + EPS);
        v2u o; o.x = pk2(y[k][0] * rstd, y[k][1] * rstd); o.y = pk2(y[k][2] * rstd, y[k][3] * rstd);
        *(v2u*)(dst + (row0 + k) * DM + col_off + 4 * cq) = o; }
    __syncthreads();
}
__device__ __forceinline__ void hyprep_item(Frame& F, const bf16* __restrict__ PROJ, const float* __restrict__ cw, const float* __restrict__ cb, bf16* ZT, bf16* X0, int b, int tile) {
    const int tb = F.tid >> 7, cq = F.tid & 127, c0 = 4 * cq, tw = tile * 32 + tb * 8; const size_t rb = (size_t)b * SEQ;
    float z[8][4];
    v2u rh[3][10];
#pragma unroll
    for (int j = 0; j < 3; ++j)
#pragma unroll
        for (int o = 0; o < 10; ++o) { const int t = tw - 1 + o; const int tc = ((t >= 0) && (t < SEQ)) ? t : tw; rh[j][o] = *(const v2u*)(PROJ + (rb + tc) * DINP + O_HY + 512 * j + c0); }
#pragma unroll
    for (int jj = 0; jj < 3; ++jj) { const int j = (jj == 0) ? 1 : (jj == 1) ? 2 : 0; const int cc = 512 * j + c0;
        const f32x4 w0 = *(const f32x4*)(cw + cc), w1 = *(const f32x4*)(cw + 1536 + cc), w2 = *(const f32x4*)(cw + 3072 + cc), bs = *(const f32x4*)(cb + cc);
        float x[10][4];
#pragma unroll
        for (int o = 0; o < 10; ++o) { const int t = tw - 1 + o; const bool ok = (t >= 0) && (t < SEQ); unpack4(rh[j][o], x[o]);
            if (!ok) { x[o][0] = 0.f; x[o][1] = 0.f; x[o][2] = 0.f; x[o][3] = 0.f; } }
        if (jj == 0) {
#pragma unroll
            for (int k = 0; k < 8; ++k)
#pragma unroll
                for (int i = 0; i < 4; ++i) z[k][i] = w0[i] * x[k][i] + w1[i] * x[k + 1][i] + w2[i] * x[k + 2][i] + bs[i];
        } else if (jj == 1) {
#pragma unroll
            for (int k = 0; k < 8; ++k)
#pragma unroll
                for (int i = 0; i < 4; ++i) z[k][i] *= w0[i] * x[k][i] + w1[i] * x[k + 1][i] + w2[i] * x[k + 2][i] + bs[i];
#pragma unroll
            for (int i = 0; i < 4; ++i) { v4u o; o.x = pk2(z[0][i], z[1][i]); o.y = pk2(z[2][i], z[3][i]); o.z = pk2(z[4][i], z[5][i]); o.w = pk2(z[6][i], z[7][i]);
                *(v4u*)(ZT + ((size_t)(c0 + i) * NSEQ + b) * SEQ + tw) = o; }
        } else {
#pragma unroll
            for (int k = 0; k < 8; ++k) { float u0[4];
#pragma unroll
                for (int i = 0; i < 4; ++i) u0[i] = w0[i] * x[k][i] + w1[i] * x[k + 1][i] + w2[i] * x[k + 2][i] + bs[i];
                v2u o; o.x = pk2(u0[0], u0[1]); o.y = pk2(u0[2], u0[3]); *(v2u*)(X0 + (rb + tw + k) * HYC + c0) = o; }
        }
    }
}
__device__ __forceinline__ void pool_item(Frame& F, const bf16* __restrict__ PROJ, bf16* MIXED, int b, int tile) {
    const int tb = F.tid >> 7, cq = F.tid & 127, c0 = 4 * cq, g = cq >> 5, half = 1 << g, tw = tile * 32 + tb * 8; const size_t rb = (size_t)b * SEQ;
    float x[23][4];
#pragma unroll
    for (int o = 0; o < 23; ++o) { const int t = tw - 8 + o; const bool ok = (t >= 0) && (t < SEQ); const int tc = ok ? t : tw;
        const v2u w = *(const v2u*)(PROJ + (rb + tc) * DINP + c0); unpack4(w, x[o]);
        if (!ok) { x[o][0] = 0.f; x[o][1] = 0.f; x[o][2] = 0.f; x[o][3] = 0.f; } }
    float y[8][4];
#pragma unroll
    for (int k = 0; k < 8; ++k) { const int oc = 8 + k, t = tw + k; const int lo = (t - half > 0) ? t - half : 0, hi = (t + half < SEQ) ? t + half : SEQ; const float inv = 1.0f / (float)(hi - lo);
#pragma unroll
        for (int i = 0; i < 4; ++i) {
            const float w1 = x[oc - 1][i] + x[oc][i];
            const float w2 = w1 + (x[oc - 2][i] + x[oc + 1][i]);
            const float w4 = w2 + ((x[oc - 4][i] + x[oc - 3][i]) + (x[oc + 2][i] + x[oc + 3][i]));
            const float w8 = w4 + (((x[oc - 8][i] + x[oc - 7][i]) + (x[oc - 6][i] + x[oc - 5][i])) + ((x[oc + 4][i] + x[oc + 5][i]) + (x[oc + 6][i] + x[oc + 7][i])));
            const float S = (g == 0) ? w1 : (g == 1) ? w2 : (g == 2) ? w4 : w8;
            y[k][i] = S * inv - x[oc][i]; } }
    pair_norm_store(F, y, MIXED, rb + tw, 0, cq);
}
__device__ __forceinline__ void hyfin_item(Frame& F, const bf16* __restrict__ YC, const bf16* __restrict__ X0, bf16* MIXED, int b, int tile) {
    const int tb = F.tid >> 7, cq = F.tid & 127, c0 = 4 * cq, tw = tile * 32 + tb * 8; const size_t rb = (size_t)b * SEQ;
    float yc[4][8], y[8][4];
#pragma unroll
    for (int i = 0; i < 4; ++i) { const v4u v = *(const v4u*)(YC + ((size_t)(c0 + i) * NSEQ + b) * SEQ + tw);
        yc[i][0] = bflo(v.x); yc[i][1] = bfhi(v.x); yc[i][2] = bflo(v.y); yc[i][3] = bfhi(v.y); yc[i][4] = bflo(v.z); yc[i][5] = bfhi(v.z); yc[i][6] = bflo(v.w); yc[i][7] = bfhi(v.w); }
#pragma unroll
    for (int k = 0; k < 8; ++k) { float xv[4]; unpack4(*(const v2u*)(X0 + (rb + tw + k) * HYC + c0), xv);
#pragma unroll
        for (int i = 0; i < 4; ++i) y[k][i] = yc[i][k] * xv[i]; }
    pair_norm_store(F, y, MIXED, rb + tw, 1536, cq);
}
struct PrepGains { float q[3][8], k[3][8]; };
__device__ __forceinline__ void load8(const float* p, float (&o)[8]) { const f32x4 a = *(const f32x4*)p, b = *(const f32x4*)(p + 4); o[0] = a.x; o[1] = a.y; o[2] = a.z; o[3] = a.w; o[4] = b.x; o[5] = b.y; o[6] = b.z; o[7] = b.w; }
__device__ __forceinline__ void unpack8(const v4u w, float (&x)[8]) { x[0] = bflo(w.x); x[1] = bfhi(w.x); x[2] = bflo(w.y); x[3] = bfhi(w.y); x[4] = bflo(w.z); x[5] = bfhi(w.z); x[6] = bflo(w.w); x[7] = bfhi(w.w); }
__device__ __forceinline__ v4u pack8(const float (&x)[8]) { v4u o; o.x = pk2(x[0], x[1]); o.y = pk2(x[2], x[3]); o.z = pk2(x[4], x[5]); o.w = pk2(x[6], x[7]); return o; }
__device__ __forceinline__ float ssq8(const float (&x)[8]) { return ((x[0] * x[0] + x[1] * x[1]) + (x[2] * x[2] + x[3] * x[3])) + ((x[4] * x[4] + x[5] * x[5]) + (x[6] * x[6] + x[7] * x[7])); }
__device__ __forceinline__ float sum8lanes(float v) { v += __shfl_xor(v, 1); v += __shfl_xor(v, 2); v += __shfl_xor(v, 4); return v; }
__device__ __forceinline__ void prep_row(const bf16* __restrict__ PROJ, bf16* Q, bf16* KV, const PrepGains& G, const float* __restrict__ ROPE, int m, int lane) {
    const int h = lane >> 3, sub = lane & 7;
    const bf16* pr = PROJ + (size_t)m * DINP; bf16* qr = Q + (size_t)m * NQ + 192 * h + 8 * sub; bf16* kr = KV + (size_t)m * NKVP + KVHS * h + 8 * sub;
    const v4u pev = *(const v4u*)(pr + O_KPE + 8 * sub);
    const v4u k0 = *(const v4u*)(kr), k1 = *(const v4u*)(kr + 64);
    float cs[8], sn[8]; { const float* rp = ROPE + (size_t)(m & (SEQ - 1)) * 64 + 8 * (sub & 3); load8(rp, cs); load8(rp + 32, sn); }
    const float sg = (sub < 4) ? -1.f : 1.f;
    { float a0[8], a1[8], pe[8]; unpack8(k0, a0); unpack8(k1, a1); unpack8(pev, pe);
      const float ss = sum8lanes((ssq8(a0) + ssq8(a1)) + ssq8(pe));
      const float sk = 1.0f / sqrtf(ss * (1.f / 192.f) + EPS);
      float r[8], o[8];
#pragma unroll
      for (int i = 0; i < 8; ++i) { a0[i] *= sk * G.k[0][i]; a1[i] *= sk * G.k[1][i]; r[i] = pe[i] * sk * G.k[2][i]; }
#pragma unroll
      for (int i = 0; i < 8; ++i) { const float rp = __shfl_xor(r[i], 4); o[i] = r[i] * cs[i] + sg * rp * sn[i]; }
      *(v4u*)(kr) = pack8(a0); *(v4u*)(kr + 64) = pack8(a1); *(v4u*)(kr + 128) = pack8(o); }
}
__device__ __forceinline__ void attn_norm_row(bf16* MIXED, int m, int lane) {
    v4u* p = (v4u*)(MIXED + (size_t)m * DM + 512 + 16 * lane); v4u a = p[0], b = p[1];
    unsigned w[8] = {a.x, a.y, a.z, a.w, b.x, b.y, b.z, b.w}; float s = 0.f;
#pragma unroll
    for (int i = 0; i < 8; ++i) { const float x = bflo(w[i]), y = bfhi(w[i]); s += x * x + y * y; }
    const float rstd = 1.0f / sqrtf(wave_sum(s) * (1.f / 1024.f) + EPS);
#pragma unroll
    for (int i = 0; i < 8; ++i) w[i] = pk2(bflo(w[i]) * rstd, bfhi(w[i]) * rstd);
    a.x = w[0]; a.y = w[1]; a.z = w[2]; a.w = w[3]; b.x = w[4]; b.y = w[5]; b.z = w[6]; b.w = w[7]; p[0] = a; p[1] = b;
}

#define DEFPTRS() unsigned char* ws = args.ws + (size_t)(unsigned)opq_s(0); \
    bf16* BtIn = (bf16*)(ws + WS_BTIN); bf16* BtUq = (bf16*)(ws + WS_BTUQ); bf16* BtKv = (bf16*)(ws + WS_BTKV); bf16* BtOut = (bf16*)(ws + WS_BTOUT); bf16* BtUp = (bf16*)(ws + WS_BTUP); bf16* BtDn = (bf16*)(ws + WS_BTDN); \
    bf16* RF = (bf16*)(ws + WS_RF); bf16* Hb = (bf16*)(ws + WS_H); bf16* PROJ = (bf16*)(ws + WS_PROJ); bf16* Qb = (bf16*)(ws + WS_Q); bf16* KVb = (bf16*)(ws + WS_KV); \
    bf16* ZT = (bf16*)(ws + WS_ZT); bf16* X0 = (bf16*)(ws + WS_X0); bf16* YC = (bf16*)(ws + WS_YC); float* EDGE = (float*)(ws + WS_EDGE); float* ROPE = (float*)(ws + WS_ROPE); float* SSQP = (float*)(ws + WS_SSQP); float* RSTD = (float*)(ws + WS_RSTD); bf16* XB2 = (bf16*)(ws + WS_XB2); unsigned char* XQ = (unsigned char*)(ws + WS_XQ); float* SSQCQ = (float*)(ws + WS_SSQCQ); unsigned char* BtInQ = (unsigned char*)(ws + WS_BTINQ); float* CSIN = (float*)(ws + WS_CSIN); float* RSTDQ = (float*)(ws + WS_RSTDQ); unsigned char* BtUpQ = (unsigned char*)(ws + WS_BTUP); bf16* ACT = (bf16*)(ws + WS_ACT); \
    bf16* XA = (bf16*)args.out; \
    (void)BtIn; (void)BtUq; (void)BtKv; (void)BtOut; (void)BtUp; (void)BtDn; (void)RF; (void)Hb; (void)PROJ; (void)Qb; (void)KVb; (void)ZT; (void)X0; (void)YC; (void)EDGE; (void)ROPE; (void)SSQP; (void)RSTD; (void)XB2; (void)XQ; (void)SSQCQ; (void)BtInQ; (void)CSIN; (void)RSTDQ; (void)BtUpQ; (void)ACT; (void)XA
__global__ void __launch_bounds__(NWAVES * 64, 2) fwd(Args args) {
    extern __shared__ __attribute__((aligned(16))) unsigned char lds_raw[];
    Frame F;
    F.lds = (LAS unsigned char*)lds_raw;
    F.tid = threadIdx.x; F.lane = F.tid & 63; F.wave = __builtin_amdgcn_readfirstlane(F.tid >> 6);
    F.G = gridDim.x; { const int bx = blockIdx.x; F.vcu = (F.G % 8 == 0) ? (bx % 8) * (F.G / 8) + bx / 8 : bx; F.bx = bx; } F.G0 = F.G; F.vcu0 = F.vcu; F.bx0 = F.bx;
    volatile LAS unsigned* MISC = (volatile LAS unsigned*)(F.lds + MISC_OFF);
    if (F.tid < 64) MISC[F.tid] = 0u;
    __syncthreads();
    unsigned* ctl = (unsigned*)(args.ws + WS_CTL);
    const int lo = args.ph_lo, hi = args.ph_hi;
    XcdBarrier bar; bar.bar = ctl + CW_BAR; bar.x = 0; bar.st = MISC + 8;
    if (hi - lo > 1) bar = xcd_barrier_post(ctl + CW_BAR, MISC + 8);
    float* out = args.out;

#pragma unroll 1
    for (int layer = 0; layer < DEPTH; ++layer) {
        const int pb = layer * NPH;
        if (pb + NPH <= lo || pb >= hi) continue;
#define IN(k) (lo <= pb + (k) && pb + (k) < hi)
#define ENTER() DEFPTRS(); F.G = opq_s(F.G0); F.vcu = opq_s(F.vcu0); F.bx = opq_s(F.bx0); F.tid = opq(threadIdx.x); F.lane = F.tid & 63; F.wave = __builtin_amdgcn_readfirstlane(F.tid >> 6); const int gw = F.vcu * NWAVES + F.wave, NGW = F.G * NWAVES, wg = F.vcu; const size_t gtid = (size_t)wg * 512 + F.tid, gthreads = (size_t)F.G * 512; (void)gw; (void)NGW; (void)wg; (void)gtid; (void)gthreads; const bool row_xl = (F.G % 8 == 0) && ((M / 8) % F.G == 0); const int row_step = row_xl ? F.G : NGW, row_iters = row_xl ? (M / 8) / F.G : (M + NGW - 1 - gw) / NGW, row_first = row_xl ? (F.bx & 7) * (M / 8) + (F.bx >> 3) * NWAVES + F.wave : gw; (void)row_step; (void)row_iters; (void)row_first
#define SEAM(k) do { if (pb + (k) + 1 < hi) xcd_barrier(bar); } while (0)
#define ROW_LOOP(mvar) for (int rk_ = 0, mvar = row_first; rk_ < row_iters; ++rk_, mvar += row_step)

        if (IN(0)) { ENTER();
            const float* win = args.in[I_WIN] + (size_t)layer * DM * DIN; const float* g1 = args.in[I_ANG] + layer * DM;
            for (int it = wg; it < 256; it += F.G) {
                if (it < 128) poolfold_item(F, win, args.in[I_PW] + (size_t)layer * 4 * 128 * 128, args.in[I_PS] + (size_t)layer * 512, g1, BtIn, it >> 5, it & 31);
                else filter_item(F, args.in[I_FW1] + (size_t)layer * 17 * 64, args.in[I_FB1] + layer * 64, args.in[I_FFR] + layer * 64, args.in[I_FW2] + (size_t)layer * 64 * 64, args.in[I_FB2] + layer * 64,
                                 args.in[I_FW3] + (size_t)layer * 64 * 1024, args.in[I_FB3] + layer * 1024, args.in[I_HBIAS] + layer * 512, RF, it - 128);
            }
            constexpr int T_IN = 19 * 16, T_UQ = 12 * 4, T_KV = 16 * 2, T_OUT = 16 * 16, T_UP = 88 * 16, T_DN = 16 * 44, T_ALL = T_IN + T_UQ + T_KV + T_OUT + T_UP + T_DN;
            for (int it = wg; it < T_ALL; it += F.G) {
                int r = it; CvtTile d;
                if (r < T_IN) { const int nt = r >> 4, kt = r & 15, n0 = 512 + 128 * nt; d = CvtTile{win, g1, BtIn, DIN, DM, n0, 128 * kt, DIN, {n0, n0 + 32, n0 + 64, n0 + 96}}; }
                else if ((r -= T_IN) < T_UQ) { const int nt = r >> 2, kt = r & 3, n0 = 128 * nt; d = CvtTile{args.in[I_WUQ] + (size_t)layer * 512 * NQ, args.in[I_QNG] + layer * 512, BtUq, NQ, 512, n0, 128 * kt, NQ, {n0, n0 + 32, n0 + 64, n0 + 96}}; }
                else if ((r -= T_UQ) < T_KV) { const int nt = r >> 1, kt = r & 1, n0 = 128 * nt;
                    d = CvtTile{args.in[I_WUKV] + (size_t)layer * 256 * 2048, args.in[I_KVNG] + layer * 256, BtKv, 2048, 256, n0, 128 * kt, 2048, {n0, n0 + 32, n0 + 64, n0 + 96}}; }
                else if ((r -= T_KV) < T_OUT) { const int nt = r >> 4, kt = r & 15, n0 = 128 * nt; d = CvtTile{args.in[I_WOUT] + (size_t)layer * DM * DM, args.in[I_GNG] + layer * DM, BtOut, DM, DM, n0, 128 * kt, DM, {n0, n0 + 32, n0 + 64, n0 + 96}}; }
                else if ((r -= T_OUT) < T_UP) { const int nt = r >> 4, kt = r & 15;
                    absmax_tile(F, args.in[I_WUP] + (size_t)layer * DM * NUP, args.in[I_FNG] + layer * DM, NUP, 128 * nt, 128 * kt, ctl + CW_WMAXC + layer * NUP); continue; }
                else { r -= T_UP; const int nt = r / 44, kt = r % 44, n0 = 128 * nt; d = CvtTile{args.in[I_WDN] + (size_t)layer * DFF * DM, nullptr, BtDn, DM, DFF, n0, 128 * kt, DM, {n0, n0 + 32, n0 + 64, n0 + 96}}; }
                cvt_tile(F, d);
            }
            { unsigned zz = 0u; asm volatile("" : "+v"(zz)); v4u z = {zz, zz, zz, zz};
              for (size_t i = gtid; i < (size_t)(DINP - DIN) * DM / 8; i += gthreads) *(v4u*)(BtIn + (size_t)DIN * DM + i * 8) = z;
}
            if (layer == 0) for (size_t i = gtid; i < (size_t)SEQ * 32; i += gthreads) { const int pos = (int)(i >> 5), ri = (int)(i & 31);
                const float freq = exp2f(-(float)ri * (13.287712379549449f / 32.0f)); float sn, cs; sincosf((float)pos * freq, &sn, &cs); ROPE[pos * 64 + ri] = cs; ROPE[pos * 64 + 32 + ri] = sn; }
            if (layer == 0) { ROW_LOOP(m) xb_row(m < MP ? args.in[I_XP] + (size_t)m * DM : args.in[I_XS] + (size_t)(m - MP) * DM, XA + (size_t)m * DM, RSTD + m, XQ + (size_t)m * DM, RSTDQ + m, F.lane); }
            else rstd_from_partials(SSQP, RSTD, gtid, gthreads);
            xcd_barrier(bar);
            for (int r = gw; r < NINQ; r += NGW) q8_row(BtIn + (size_t)(r < 512 ? r : r + 1024) * DM, BtInQ + (size_t)r * DM, 1.0f, CSIN + r, F.lane);
            if (layer > 0) ROW_LOOP(m) q8_row(XA + (size_t)m * DM, XQ + (size_t)m * DM, RSTD[m], RSTDQ + m, F.lane);
            SEAM(0);
        }
        if (IN(1)) { ENTER();
            { pg8::Gemm g{(const bf16*)XQ, (const bf16*)BtInQ, M, NINQ, DM / 2, DM / 2}; pg8::StaticOrder S; S.init(M, NINQ, F.G, F.bx);
              pg8::EpiBf16 E{PROJ, DINP, RSTDQ, 0, -1, nullptr, 0.f, nullptr, 0, CSIN, 2, 4};
              pg8::gemm_phase<pg8::EpiBf16, pg8::StaticOrder, true>(F.lds, g, S, E); }
            { pg8::Gemm g{XA, BtIn + (size_t)512 * DM, M, 1024, DM, DM}; pg8::StaticOrder S; S.init(M, 1024, F.G, F.bx);
              pg8::EpiBf16 E{PROJ + 512, DINP, RSTD, 0, O_CKV / 256 - 2, (LAS float*)(F.lds + HALO_OFF), EPS, SSQCQ, O_CQ / 256 - 2, nullptr, 1 << 30, 0};
              pg8::gemm_phase<pg8::EpiBf16, pg8::StaticOrder>(F.lds, g, S, E); }
            SEAM(1);
        }
        if (IN(2)) { ENTER();
            { pg8::Gemm g{PROJ + O_CQ, BtUq, M, NQ, 512, DINP}; pg8::StaticOrder S; S.init(M, NQ, F.G, F.bx); pg8::EpiBf16 E{Qb, NQ, nullptr, 0, -1, nullptr, 0.f, nullptr, 0, nullptr, 1 << 30, 0};
              pg8::gemm_phase<pg8::EpiBf16, pg8::StaticOrder>(F.lds, g, S, E); }
            { pg8::Gemm g{PROJ + O_CKV, BtKv, M, 2048, 256, DINP}; pg8::StaticOrder S; S.init(M, 2048, F.G, F.bx); pg8::EpiBf16 E{KVb, NKVP, nullptr, 1, -1, nullptr, 0.f, nullptr, 0, nullptr, 1 << 30, 0};
              pg8::gemm_phase<pg8::EpiBf16, pg8::StaticOrder>(F.lds, g, S, E); }
            const float* hcw = args.in[I_HCW] + (size_t)layer * 3 * 1536; const float* hcb = args.in[I_HCB] + layer * 1536;
            for (int it = wg; it < 2 * NSEQ * 64; it += F.G) {
                if (it < NSEQ * 64) hyprep_item(F, PROJ, hcw, hcb, ZT, X0, it >> 6, it & 63);
                else pool_item(F, PROJ, Hb, (it - NSEQ * 64) >> 6, it & 63);
            }
            SEAM(2);
        }
        if (IN(3)) { ENTER();
            const int odd = __builtin_amdgcn_readfirstlane(opq((F.bx >> 3) & 1));
            const float* qhg = args.in[I_QHG] + layer * 192; const float* khg = args.in[I_KHG] + layer * 192;
            if (!odd) { for (int u = wg; u < 2 * HYC; u += F.G) hy::conv_unit(F.lds, ZT, RF, YC, u >> 1, u & 1); }
            { PrepGains PG; { const int sub = F.lane & 7;
#pragma unroll
                for (int i = 0; i < 3; ++i) { load8(qhg + 64 * i + 8 * sub, PG.q[i]); load8(khg + 64 * i + 8 * sub, PG.k[i]); } }
              for (int m = gw; m < M; m += NGW) prep_row(PROJ, Qb, KVb, PG, ROPE, m, F.lane); }
            if (odd) { __syncthreads(); for (int u = wg; u < 2 * HYC; u += F.G) hy::conv_unit(F.lds, ZT, RF, YC, u >> 1, u & 1); }
            SEAM(3);
        }
        if (IN(4)) { ENTER();
            float gqm, gkm; { const float* qhg = args.in[I_QHG] + layer * 192; const float* khg = args.in[I_KHG] + layer * 192;
                gqm = fmaxf(fmaxf(fabsf(qhg[F.lane]), fabsf(qhg[64 + F.lane])), fabsf(qhg[128 + F.lane])); gkm = fmaxf(fmaxf(fabsf(khg[F.lane]), fabsf(khg[64 + F.lane])), fabsf(khg[128 + F.lane]));
#pragma unroll
                for (int o = 1; o < 64; o <<= 1) { gqm = fmaxf(gqm, __shfl_xor(gqm, o)); gkm = fmaxf(gkm, __shfl_xor(gkm, o)); } }
            const float Mnat = 13.856406460551018f * gqm * gkm;
            const bool sm_fast = __builtin_amdgcn_readfirstlane((Mnat <= 40.0f) ? 1 : 0) != 0;
            const float negMC = __builtin_bit_cast(float, __builtin_amdgcn_readfirstlane(__builtin_bit_cast(int, -Mnat * 1.4426950408889634f)));
            for (int i = 0; i * F.G < NSEQ * NH * 8; ++i) {
                int p, qb; const int c = F.bx;
                if (F.G == 256) { p = i * 32 + (c & 7) * 4 + (c >> 6); qb = (c >> 3) & 7; } else { const int Lq = i * F.G + c; p = Lq >> 3; qb = Lq & 7; }
                if (p < NSEQ * NH) { const int b = p >> 3, h = p & 7;
                    const bf16* qp = Qb + (size_t)(b * SEQ + qb * 256) * NQ + h * 192; const bf16* kp = KVb + (size_t)(b * SEQ) * NKVP + h * KVHS; bf16* op = Hb + (size_t)(b * SEQ + qb * 256) * DM + 512 + h * 128;
                    const float* sq = SSQCQ + (size_t)(b * SEQ + qb * 256) * 8; const float* qgp = args.in[I_QHG] + layer * 192; const float* rp0 = ROPE + (size_t)(qb * 256) * 64;
                    if (sm_fast) at::attn_unit<true>(negMC, qp, kp, kp + 192, op, SEQ, (char*)lds_raw, sq, qgp, rp0);
                    else at::attn_unit<false>(0.f, qp, kp, kp + 192, op, SEQ, (char*)lds_raw, sq, qgp, rp0); }
            }
            for (int it = wg; it < NSEQ * 64; it += F.G) hyfin_item(F, YC, X0, Hb, it >> 6, it & 63);
            SEAM(4);
        }
        if (IN(5)) { ENTER();
            ROW_LOOP(m) attn_norm_row(Hb, m, F.lane);
            SEAM(5);
        }
        if (IN(6)) { ENTER();
            pg8::Gemm g{Hb, BtOut, M, DM, DM, DM}; pg8::StaticOrder S; S.init(M, DM, F.G, F.bx);
            pg8::EpiResid16 E{XA, XB2, out, DM, SSQP, 0};
            pg8::gemm_phase<pg8::EpiResid16, pg8::StaticOrder>(F.lds, g, S, E);
            SEAM(6);
        }
        if (IN(7)) { ENTER();
            const unsigned* wmaxc = ctl + CW_WMAXC + layer * NUP;
            const int p7odd = __builtin_amdgcn_readfirstlane(opq((F.bx >> 3) & 1));
            if (p7odd) { ROW_LOOP(m) xq_row(XB2 + (size_t)m * DM, XQ + (size_t)m * DM, SSQP + (size_t)m * 32, RSTD + m, 1.0f, F.lane); __syncthreads(); }
            for (int it = wg; it < 88 * 16; it += F.G) { const int nt = it >> 4, kt = it & 15; const int nv = (nt < 44) ? nt : nt - 44;
                cvtq_tile(F, args.in[I_WUP] + (size_t)layer * DM * NUP, args.in[I_FNG] + layer * DM, NUP, DM, BtUpQ, 128 * nt, 128 * kt, 256 * nv + ((nt < 44) ? 0 : 32), wmaxc); }
            if (!p7odd) { ROW_LOOP(m) xq_row(XB2 + (size_t)m * DM, XQ + (size_t)m * DM, SSQP + (size_t)m * 32, RSTD + m, 1.0f, F.lane); }
            SEAM(7);
        }
        if (IN(8)) { ENTER();
            pg8::Gemm g{(const bf16*)XQ, (const bf16*)BtUpQ, M, NUP, DM / 2, DM / 2}; pg8::StaticOrder S; S.init(M, NUP, F.G, F.bx);
            pg8::EpiGate E{ACT, DFF, EDGE, args.in[I_FCW] + (size_t)layer * 3 * DFF, args.in[I_FCB] + layer * DFF, DFF, (LAS float*)(F.lds + HALO_OFF), RSTD, ctl + CW_WMAXC + layer * NUP};
            pg8::gemm_phase<pg8::EpiGate, pg8::StaticOrder, true>(F.lds, g, S, E);
            SEAM(8);
        }
        if (IN(9)) { ENTER();
            const float* fcw = args.in[I_FCW] + (size_t)layer * 3 * DFF;
            for (unsigned i = (unsigned)gtid; i < (unsigned)((M / 256) * 2 * (DFF / 4)); i += (unsigned)gthreads) {
                const unsigned ri = i / (unsigned)(DFF / 4), c4 = (i % (unsigned)(DFF / 4)) * 4u, pm = ri >> 1, e = ri & 1u;
                const float* eb = EDGE + (ri * 3u) * (unsigned)DFF + c4;
                f32x4 pre = *(const f32x4*)(eb + DFF); const f32x4 v = *(const f32x4*)(eb + 2 * DFF);
                if (e == 0u && (pm & 7u) != 0u) { const f32x4 gp = *(const f32x4*)(EDGE + (((pm - 1u) * 2u + 1u) * 3u) * (unsigned)DFF + c4); pre += *(const f32x4*)(fcw + c4) * gp; }
                if (e == 1u && (pm & 7u) != 7u) { const f32x4 gn = *(const f32x4*)(EDGE + (((pm + 1u) * 2u + 0u) * 3u) * (unsigned)DFF + c4); pre += *(const f32x4*)(fcw + 2 * DFF + c4) * gn; }
                v2u o; o.x = pk2(pg8::silu_f(pre.x) * v.x, pg8::silu_f(pre.y) * v.y); o.y = pk2(pg8::silu_f(pre.z) * v.z, pg8::silu_f(pre.w) * v.w);
                *(v2u*)(ACT + (pm * 256u + (e ? 255u : 0u)) * (unsigned)DFF + c4) = o;
            }
            SEAM(9);
        }
        if (IN(10)) { ENTER();
            pg8::Gemm g{ACT, BtDn, M, DM, DFF, DFF}; pg8::StaticOrder S; S.init(M, DM, F.G, F.bx);
            pg8::EpiResid16 E{XB2, XA, out, DM, SSQP, (layer + 1 < DEPTH) ? 0 : 1};
            pg8::gemm_phase<pg8::EpiResid16, pg8::StaticOrder>(F.lds, g, S, E);
            SEAM(10);
        }
#undef IN
#undef ENTER
#undef SEAM
#undef ROW_LOOP
    }
}

extern "C" void kernel_launch(void* const* d_in, const int* in_sizes, int n_in, void* d_out, int out_size, void* d_ws, size_t ws_size, hipStream_t stream) {
    static int grid = 0;
    if (grid == 0) {
        if (n_in != N_IN || out_size != M * DM || ws_size < WS_END) { fprintf(stderr, "kernel_launch: unexpected shapes (n_in %d, out %d, ws %zu, need %zu)\n", n_in, out_size, ws_size, (size_t)WS_END); grid = -1; return; }
        int dev = 0, cus = 0;
        if (hipGetDevice(&dev) != hipSuccess || hipDeviceGetAttribute(&cus, hipDeviceAttributeMultiprocessorCount, dev) != hipSuccess) { grid = -1; return; }
        if (hipFuncSetAttribute((const void*)fwd, hipFuncAttributeMaxDynamicSharedMemorySize, LDS_BYTES) != hipSuccess) { fprintf(stderr, "kernel_launch: hipFuncSetAttribute failed\n"); grid = -1; return; }
        int per_cu = 0;
        if (hipOccupancyMaxActiveBlocksPerMultiprocessor(&per_cu, (const void*)fwd, NWAVES * 64, LDS_BYTES) != hipSuccess || per_cu < 1) fprintf(stderr, "kernel_launch: occupancy query reports %d\n", per_cu);
        (void)hipGetLastError();
        grid = cus;
    }
    if (grid < 0) return;
    (void)hipMemsetAsync((char*)d_ws + WS_CTL, 0, CTL_BYTES, stream);
    Args a{};
    for (int i = 0; i < N_IN; ++i) a.in[i] = (const float*)d_in[i];
    a.out = (float*)d_out; a.ws = (unsigned char*)d_ws;
#if MK_ONE_LAUNCH
    a.ph_lo = 0; a.ph_hi = DEPTH * NPH;
    hipLaunchKernelGGL(fwd, dim3(grid), dim3(NWAVES * 64), LDS_BYTES, stream, a);
#else
    for (int p = 0; p < DEPTH * NPH; ++p) { a.ph_lo = p; a.ph_hi = p + 1; hipLaunchKernelGGL(fwd, dim3(grid), dim3(NWAVES * 64), LDS_BYTES, stream, a); }
#endif
    const hipError_t le = hipPeekAtLastError();
    if (le != hipSuccess) fprintf(stderr, "kernel_launch: launch failed: %s\n", hipGetErrorName(le));
}
```

```cpp
#include <hip/hip_runtime.h>
#include <cstdio>
#include <cstdint>
__device__ __forceinline__ int opq(int x) { asm volatile("" : "+v"(x)); return x; }
__device__ __forceinline__ int opq_s(int x) { asm volatile("" : "+s"(x)); return x; }
namespace pg8 {
#define PG8_LAS __attribute__((address_space(3)))
typedef unsigned short bf16_t;
typedef short bf16x8 __attribute__((ext_vector_type(8)));
typedef float f32x4 __attribute__((ext_vector_type(4)));
typedef unsigned u32x4 __attribute__((ext_vector_type(4)));
typedef int i32x4 __attribute__((ext_vector_type(4)));
template <bool I8> struct AccSel { typedef f32x4 T; }; template <> struct AccSel<true> { typedef i32x4 T; };
constexpr int BM = 256, BK = 64, HALF = 128, HTB = HALF * BK * 2  , STAGE_BYTES = 8 * HTB, NXCD = 8, WGM = 8;

__host__ __device__ __forceinline__ int lds_byte(int r, int c) { const int st = (r >> 4) * 2 + (c >> 5), rr = r & 15, cc = c & 31, ob = rr * 64 + cc * 2; return st * 1024 + (ob ^ (((ob >> 9) & 1) << 5)); }
__host__ __device__ __forceinline__ void stage_rc(int b, int& R, int& C) { const int st = b / 1024, sb = b % 1024, swz = sb ^ (((sb >> 9) & 1) << 5); R = (st >> 1) * 16 + swz / 64; C = (st & 1) * 32 + (swz % 64) / 2; }
__host__ __device__ __forceinline__ int perm32(int rho) { const int n = rho >> 4, i = rho & 15; return 8 * (i >> 2) + 4 * n + (i & 3); }

struct Unit { int pm, pn; };
struct Gemm { const bf16_t* A; const bf16_t* Bt; int M, N, K, lda; int a_tiled; };

struct StaticOrder {
    int nM, nN, nwg, G, c;
    __host__ __device__ void init(int M, int N, int G_, int c_) { nM = M / BM; nN = N / BM; nwg = nM * nN; G = G_; c = c_; }
    __host__ __device__ bool next(int i, Unit& u) const {
        const long L = (long)i * G + c; if (L >= nwg) return false;
        int wgid = (int)L; { const int q = nwg / NXCD, r = nwg % NXCD, xcd = wgid % NXCD, off = wgid / NXCD; wgid = (xcd < r ? xcd * (q + 1) : r * (q + 1) + (xcd - r) * q) + off; }
        const int nig = WGM * nN, gid = wgid / nig, fm = gid * WGM, gsz = (nM - fm) < WGM ? (nM - fm) : WGM;
        u.pm = fm + ((wgid % nig) % gsz); u.pn = (wgid % nig) / gsz; return true;
    }
    __device__ __forceinline__ void a_ready(const Unit&) const {}
    __device__ __forceinline__ void done(const Unit&) const {}
};

__device__ __forceinline__ unsigned cvt_pk_bf16(float lo, float hi) { unsigned r; asm volatile("v_cvt_pk_bf16_f32 %0, %1, %2" : "=v"(r) : "v"(lo), "v"(hi)); return r; }

__device__ __forceinline__ float dpp_ror1(float v) { return __builtin_bit_cast(float, __builtin_amdgcn_update_dpp(0, __builtin_bit_cast(int, v), 0x121, 0xF, 0xF, false)); }
__device__ __forceinline__ float dpp_ror15(float v) { return __builtin_bit_cast(float, __builtin_amdgcn_update_dpp(0, __builtin_bit_cast(int, v), 0x12F, 0xF, 0xF, false)); }
__device__ __forceinline__ unsigned dpp_swap1(unsigned v) { return (unsigned)__builtin_amdgcn_update_dpp(0, (int)v, 0xB1, 0xF, 0xF, false); }
struct LineOffs { unsigned o0, o1; bool odd; };
__device__ __forceinline__ LineOffs line_offs(unsigned lo, int pitch, int fr) { LineOffs L; L.odd = fr & 1; L.o0 = L.odd ? lo - (unsigned)pitch + 32u : lo; L.o1 = L.odd ? lo + 32u : lo + (unsigned)pitch; return L; }
__device__ __forceinline__ void store_lines(bf16_t* base, const LineOffs& L, u32x4 a, u32x4 b) {
    const u32x4 snd = L.odd ? a : b; u32x4 rcv;
    rcv.x = dpp_swap1(snd.x); rcv.y = dpp_swap1(snd.y); rcv.z = dpp_swap1(snd.z); rcv.w = dpp_swap1(snd.w);
    *(u32x4*)(base + L.o0) = L.odd ? rcv : a;
    *(u32x4*)(base + L.o1) = L.odd ? b : rcv;
}
struct EpiBf16 {
    static constexpr bool PERM = true;
    bf16_t* O; int ldc; const float* rstd; int kvscatter;
    int norm_pn; PG8_LAS float* red; float eps;
    float* ssq_out; int ssq_pn0;
    const float* cscale; int pn_skip_from, pn_skip;
    __device__ __forceinline__ void operator()(f32x4 (&acc)[2][2][4][2], const Unit& u, int wr, int wc, int fr, int fq) const {
        const int pno = (u.pn >= pn_skip_from) ? u.pn + pn_skip : u.pn;
        bf16_t* Ot = O + (size_t)(u.pm * BM) * ldc + (kvscatter ? u.pn * 320 : pno * BM);
        const int wcol = kvscatter ? (wc < 2 ? wc * 64 : 64 + wc * 64) : wc * 64;
        const LineOffs L = line_offs((unsigned)((wr * 64 + fr) * ldc + wcol + 8 * fq), ldc, fr); const int row0 = u.pm * BM + wr * 64 + fr;
        float rsv[8];
#pragma unroll
        for (int i = 0; i < 8; ++i) rsv[i] = rstd ? rstd[row0 + (i >> 2) * HALF + (i & 3) * 16] : 1.0f;
        if (u.pn == norm_pn) {
#pragma unroll
            for (int ai = 0; ai < 2; ++ai)
#pragma unroll
                for (int m = 0; m < 4; ++m) { const float rs = rsv[ai * 4 + m]; float s = 0.f;
#pragma unroll
                    for (int bj = 0; bj < 2; ++bj) { acc[ai][bj][m][0] *= rs; acc[ai][bj][m][1] *= rs; const f32x4 a = acc[ai][bj][m][0], b = acc[ai][bj][m][1];
                        s += ((a[0] * a[0] + a[1] * a[1]) + (a[2] * a[2] + a[3] * a[3])) + ((b[0] * b[0] + b[1] * b[1]) + (b[2] * b[2] + b[3] * b[3])); }
                    s += __shfl_xor(s, 16); s += __shfl_xor(s, 32); if (fq == 0) red[(ai * HALF + wr * 64 + m * 16 + fr) * 4 + wc] = s; }
            asm volatile("s_waitcnt lgkmcnt(0)" ::: "memory"); __builtin_amdgcn_s_barrier(); asm volatile("" ::: "memory");
#pragma unroll
            for (int ai = 0; ai < 2; ++ai)
#pragma unroll
                for (int m = 0; m < 4; ++m) { const f32x4 p = *(const PG8_LAS f32x4*)(red + (ai * HALF + wr * 64 + m * 16 + fr) * 4); const float rs = 1.0f / __builtin_sqrtf(((p[0] + p[1]) + (p[2] + p[3])) * (1.0f / 256.0f) + eps);
                    u32x4 w[2];
#pragma unroll
                    for (int bj = 0; bj < 2; ++bj) { const f32x4 v0 = acc[ai][bj][m][0] * rs, v1 = acc[ai][bj][m][1] * rs;
                        w[bj].x = cvt_pk_bf16(v0[0], v0[1]); w[bj].y = cvt_pk_bf16(v0[2], v0[3]); w[bj].z = cvt_pk_bf16(v1[0], v1[1]); w[bj].w = cvt_pk_bf16(v1[2], v1[3]); }
                    store_lines(Ot + (size_t)((ai * HALF + m * 16) * ldc), L, w[0], w[1]);
                    asm volatile("" ::: "memory"); }
            return;
        }
        const bool want_ssq = ssq_out != nullptr && (unsigned)(u.pn - ssq_pn0) < 2u;
        f32x4 csc[2][2];
        if (cscale) {
#pragma unroll
            for (int bj = 0; bj < 2; ++bj)
#pragma unroll
                for (int n = 0; n < 2; ++n) csc[bj][n] = *(const f32x4*)(cscale + u.pn * BM + wc * 64 + bj * 32 + 8 * fq + 4 * n);
        }
#pragma unroll
        for (int ai = 0; ai < 2; ++ai)
#pragma unroll
            for (int m = 0; m < 4; ++m) { const float rs = rsv[ai * 4 + m];
                u32x4 w[2]; float s = 0.f;
#pragma unroll
                for (int bj = 0; bj < 2; ++bj) { f32x4 v0 = acc[ai][bj][m][0] * rs, v1 = acc[ai][bj][m][1] * rs;
                    if (cscale) { v0 *= csc[bj][0]; v1 *= csc[bj][1]; }
                    s += ((v0[0] * v0[0] + v0[1] * v0[1]) + (v0[2] * v0[2] + v0[3] * v0[3])) + ((v1[0] * v1[0] + v1[1] * v1[1]) + (v1[2] * v1[2] + v1[3] * v1[3]));
                    w[bj].x = cvt_pk_bf16(v0[0], v0[1]); w[bj].y = cvt_pk_bf16(v0[2], v0[3]); w[bj].z = cvt_pk_bf16(v1[0], v1[1]); w[bj].w = cvt_pk_bf16(v1[2], v1[3]); }
                store_lines(Ot + (size_t)((ai * HALF + m * 16) * ldc), L, w[0], w[1]);
                if (want_ssq) { s += __shfl_xor(s, 16); s += __shfl_xor(s, 32); if (fq == 0) ssq_out[(size_t)(row0 + ai * HALF + m * 16) * 8 + (u.pn - ssq_pn0) * 4 + wc] = s; }
                asm volatile("" ::: "memory"); }
    }
};
struct EpiResid16 {
    static constexpr bool PERM = true;
    const bf16_t* base; bf16_t* xo; float* out; int ldc; float* ssqp; int f32out;
    __device__ __forceinline__ static void addx(const u32x4 b, const f32x4 a0, const f32x4 a1, f32x4& x0, f32x4& x1) {
        x0[0] = __builtin_bit_cast(float, b.x << 16) + a0[0]; x0[1] = __builtin_bit_cast(float, b.x & 0xffff0000u) + a0[1]; x0[2] = __builtin_bit_cast(float, b.y << 16) + a0[2]; x0[3] = __builtin_bit_cast(float, b.y & 0xffff0000u) + a0[3];
        x1[0] = __builtin_bit_cast(float, b.z << 16) + a1[0]; x1[1] = __builtin_bit_cast(float, b.z & 0xffff0000u) + a1[1]; x1[2] = __builtin_bit_cast(float, b.w << 16) + a1[2]; x1[3] = __builtin_bit_cast(float, b.w & 0xffff0000u) + a1[3]; }
    __device__ __forceinline__ void operator()(f32x4 (&acc)[2][2][4][2], const Unit& u, int wr, int wc, int fr, int fq) const {
        const size_t tb = (size_t)(u.pm * BM) * ldc + u.pn * BM;
        const bf16_t* bs = base + tb;
        const unsigned lo = (unsigned)((wr * 64 + fr) * ldc + wc * 64 + 8 * fq);
        if (f32out != 0) {
            float* op = out + tb;
#pragma unroll
            for (int ai = 0; ai < 2; ++ai)
#pragma unroll
                for (int m = 0; m < 4; ++m) { const unsigned off = lo + (unsigned)((ai * HALF + m * 16) * ldc);
#pragma unroll
                    for (int bj = 0; bj < 2; ++bj) { const u32x4 b = *(const u32x4*)(bs + off + bj * 32); f32x4 x0, x1; addx(b, acc[ai][bj][m][0], acc[ai][bj][m][1], x0, x1);
                        *(f32x4*)(op + off + bj * 32) = x0; *(f32x4*)(op + off + bj * 32 + 4) = x1; }
                    asm volatile("" ::: "memory"); }
            return;
        }
        bf16_t* xp = xo + tb; const LineOffs L = line_offs(lo, ldc, fr);
#pragma unroll
        for (int aim = 0; aim < 4; ++aim) { const int ai = aim >> 1, mp = aim & 1;
            u32x4 bv[2][2];
#pragma unroll
            for (int mm = 0; mm < 2; ++mm)
#pragma unroll
                for (int bj = 0; bj < 2; ++bj) bv[mm][bj] = *(const u32x4*)(bs + lo + (unsigned)((ai * HALF + (2 * mp + mm) * 16) * ldc) + bj * 32);
#pragma unroll
            for (int mm = 0; mm < 2; ++mm) { const int m = 2 * mp + mm; float s = 0.f; u32x4 wv[2];
#pragma unroll
                for (int bj = 0; bj < 2; ++bj) { f32x4 x0, x1; addx(bv[mm][bj], acc[ai][bj][m][0], acc[ai][bj][m][1], x0, x1);
                    wv[bj].x = cvt_pk_bf16(x0[0], x0[1]); wv[bj].y = cvt_pk_bf16(x0[2], x0[3]); wv[bj].z = cvt_pk_bf16(x1[0], x1[1]); wv[bj].w = cvt_pk_bf16(x1[2], x1[3]);
                    s += ((x0[0] * x0[0] + x0[1] * x0[1]) + (x0[2] * x0[2] + x0[3] * x0[3])) + ((x1[0] * x1[0] + x1[1] * x1[1]) + (x1[2] * x1[2] + x1[3] * x1[3])); }
                store_lines(xp + (size_t)((ai * HALF + m * 16) * ldc), L, wv[0], wv[1]);
                s += __shfl_xor(s, 16); s += __shfl_xor(s, 32); if (fq == 0) ssqp[(size_t)(u.pm * BM + wr * 64 + fr + ai * HALF + m * 16) * 32 + u.pn * 4 + wc] = s; }
            asm volatile("" ::: "memory"); }
    }
};
__device__ __forceinline__ float silu_f(float x) { return x * __builtin_amdgcn_rcpf(1.0f + __builtin_amdgcn_exp2f(-1.4426950408889634f * x)); }
struct EpiGate {
    static constexpr bool PERM = true;
    bf16_t* act; int ldact; float* edge; const float* cw; const float* cb; int dff; PG8_LAS float* halo; const float* rstd; const unsigned* wmaxc;
    __device__ __forceinline__ void operator()(f32x4 (&acc)[2][2][4][2], const Unit& u, int wr, int wc, int fr, int fq) const {
        const int lane = fq * 16 + fr; const int colL = wc * 32 + 8 * fq; const int colG = u.pn * HALF + colL;
        f32x4 csc[2][2];
#pragma unroll
        for (int bj = 0; bj < 2; ++bj)
#pragma unroll
            for (int n = 0; n < 2; ++n) { const u32x4 mb = *(const u32x4*)(wmaxc + bj * dff + colG + 4 * n);
                csc[bj][n] = (f32x4){__builtin_bit_cast(float, mb.x), __builtin_bit_cast(float, mb.y), __builtin_bit_cast(float, mb.z), __builtin_bit_cast(float, mb.w)} * (1.0f / 127.0f); }
#pragma unroll
        for (int ai = 0; ai < 2; ++ai)
#pragma unroll
            for (int m = 0; m < 4; ++m) { const float rs = rstd[u.pm * BM + ai * HALF + wr * 64 + m * 16 + fr];
#pragma unroll
                for (int bj = 0; bj < 2; ++bj) { acc[ai][bj][m][0] *= csc[bj][0] * rs; acc[ai][bj][m][1] *= csc[bj][1] * rs; } }
#pragma unroll
        for (int ai = 0; ai < 2; ++ai) { const int q = 2 * ai + wr;
            if (fr == 0) { *(PG8_LAS f32x4*)(halo + (q * 2 + 0) * 128 + colL) = acc[ai][0][0][0]; *(PG8_LAS f32x4*)(halo + (q * 2 + 0) * 128 + colL + 4) = acc[ai][0][0][1]; }
            if (fr == 15) { *(PG8_LAS f32x4*)(halo + (q * 2 + 1) * 128 + colL) = acc[ai][0][3][0]; *(PG8_LAS f32x4*)(halo + (q * 2 + 1) * 128 + colL + 4) = acc[ai][0][3][1]; } }
        asm volatile("s_waitcnt lgkmcnt(0)" ::: "memory"); __builtin_amdgcn_s_barrier(); asm volatile("" ::: "memory");
        const unsigned nbl = (unsigned)(ldact >> 5); bf16_t* actp = act + (size_t)(u.pm * (BM / 2)) * nbl * 64; const unsigned rlo = ((unsigned)(wr * 32 + (fr >> 1)) * nbl + (unsigned)(4 * u.pn + wc)) * 64u + (unsigned)((fr & 1) * 32 + 8 * fq);
#pragma unroll
        for (int ai = 0; ai < 2; ++ai) { const int q = 2 * ai + wr;
            typedef unsigned u32x2 __attribute__((ext_vector_type(2)));
            u32x2 pk[4][2];
#pragma unroll
            for (int n = 0; n < 2; ++n) {
                const f32x4 w0 = *(const f32x4*)(cw + colG + 4 * n), w1 = *(const f32x4*)(cw + dff + colG + 4 * n), w2 = *(const f32x4*)(cw + 2 * dff + colG + 4 * n), bb = *(const f32x4*)(cb + colG + 4 * n);
                f32x4 ht = *(PG8_LAS f32x4*)(halo + ((q > 0 ? q - 1 : 0) * 2 + 1) * 128 + colL + 4 * n), hb = *(PG8_LAS f32x4*)(halo + ((q < 3 ? q + 1 : 3) * 2 + 0) * 128 + colL + 4 * n);
                if (q == 0) ht = ht * 0.f; if (q == 3) hb = hb * 0.f;
                f32x4 pre[4];
#pragma unroll
                for (int j = 0; j < 4; ++j) {
                    float g[4], rr[4], rl[4];
#pragma unroll
                    for (int m = 0; m < 4; ++m) { g[m] = acc[ai][0][m][n][j]; rr[m] = dpp_ror1(g[m]); rl[m] = dpp_ror15(g[m]); }
#pragma unroll
                    for (int m = 0; m < 4; ++m) {
                        const float up = (fr > 0) ? rr[m] : (m > 0 ? rr[m > 0 ? m - 1 : 0] : ht[j]);
                        const float dn = (fr < 15) ? rl[m] : (m < 3 ? rl[m < 3 ? m + 1 : 3] : hb[j]);
                        pre[m][j] = w0[j] * up + w1[j] * g[m] + w2[j] * dn + bb[j];
                    }
                }
                if (q == 0 && fr == 0) { float* e = edge + (size_t)((u.pm * 2 + 0) * 3) * dff + colG + 4 * n;
                    *(f32x4*)(e) = acc[ai][0][0][n]; *(f32x4*)(e + dff) = pre[0]; *(f32x4*)(e + 2 * dff) = acc[ai][1][0][n]; }
                if (q == 3 && fr == 15) { float* e = edge + (size_t)((u.pm * 2 + 1) * 3) * dff + colG + 4 * n;
                    *(f32x4*)(e) = acc[ai][0][3][n]; *(f32x4*)(e + dff) = pre[3]; *(f32x4*)(e + 2 * dff) = acc[ai][1][3][n]; }
#pragma unroll
                for (int m = 0; m < 4; ++m) { const f32x4 v = acc[ai][1][m][n];
                    pk[m][n].x = cvt_pk_bf16(silu_f(pre[m][0]) * v[0], silu_f(pre[m][1]) * v[1]); pk[m][n].y = cvt_pk_bf16(silu_f(pre[m][2]) * v[2], silu_f(pre[m][3]) * v[3]); }
            }
#pragma unroll
            for (int m = 0; m < 4; ++m) { u32x4 w; w.x = pk[m][0].x; w.y = pk[m][0].y; w.z = pk[m][1].x; w.w = pk[m][1].y;
                *(u32x4*)(actp + rlo + (unsigned)(ai * 64 + m * 8) * nbl * 64u) = w; }
        }
    }
};

template <class Epi, class Sched, bool I8 = false>
__device__ __forceinline__ void gemm_phase(PG8_LAS unsigned char* lds, const Gemm g, const Sched& S, const Epi& E) {
    typedef typename AccSel<I8>::T acc_t;
    const int tid = opq(threadIdx.x), wid = __builtin_amdgcn_readfirstlane(tid >> 6), lane = tid & 63, wr = wid >> 2, wc = wid & 3, fr = lane & 15, fq = lane >> 4;
    const int K = g.K, nt = K / BK, lda = g.lda;
    unsigned voffA[2], voffB[2];
#pragma unroll
    for (int i = 0; i < 2; ++i) { int R, C; stage_rc(tid * 16 + i * 8192, R, C); const int Rb = Epi::PERM ? (64 * (R >> 5) + perm32(R & 31)) : R;
        voffA[i] = g.a_tiled ? (unsigned)(((R >> 1) * (lda >> 5) + (C >> 5)) * 128 + (R & 1) * 64 + (C & 31) * 2) : (unsigned)(R * lda + C) * 2u; voffB[i] = (unsigned)(Rb * K + C) * 2u; }
    const size_t kstepB = (size_t)(BK * 2), kstepA = g.a_tiled ? (size_t)(BK * 4) : kstepB;
    const size_t hstepA = (size_t)HALF * lda * 2, hstepB = (size_t)(Epi::PERM ? 32 : HALF) * K * 2;
    const size_t tstepA = 2 * hstepA, tstepB = (size_t)BM * K * 2;
    const unsigned ldsw = (unsigned)wid * 1024u;
    const int aoff = lds_byte(wr * 64 + fr, fq * 8), boff = lds_byte(wc * 32 + fr, fq * 8);
#define PG8_SA(b, h) (((b) * 2 + (h)) * HTB)
#define PG8_SB(b, h) ((4 + (b) * 2 + (h)) * HTB)
#define PG8_STAGE(bufoff, gbase, voff) do { _Pragma("unroll") for (int _i = 0; _i < 2; ++_i) \
        __builtin_amdgcn_global_load_lds((const unsigned*)((const char*)(gbase) + (voff)[_i]), (PG8_LAS unsigned*)(lds + (bufoff) + ldsw + _i * 8192), 16, 0, 0); } while (0)
#define PG8_LDA(dst, b, h) do { _Pragma("unroll") for (int m = 0; m < 4; ++m) _Pragma("unroll") for (int k = 0; k < 2; ++k) dst[m][k] = *(const PG8_LAS bf16x8*)(lds + PG8_SA(b, h) + aoff + m * 2048 + k * 1024); } while (0)
#define PG8_LDB(dst, b, h) do { _Pragma("unroll") for (int n = 0; n < 2; ++n) _Pragma("unroll") for (int k = 0; k < 2; ++k) dst[n][k] = *(const PG8_LAS bf16x8*)(lds + PG8_SB(b, h) + boff + n * 2048 + k * 1024); } while (0)
#define PG8_MMA(ai, bj, At, Bt) do { __builtin_amdgcn_s_setprio(1); _Pragma("unroll") for (int m = 0; m < 4; ++m) _Pragma("unroll") for (int n = 0; n < 2; ++n) _Pragma("unroll") for (int k = 0; k < 2; ++k) { \
        if constexpr (I8) acc[ai][bj][m][n] = __builtin_amdgcn_mfma_i32_16x16x64_i8(__builtin_bit_cast(i32x4, Bt[n][k]), __builtin_bit_cast(i32x4, At[m][k]), acc[ai][bj][m][n], 0, 0, 0); \
        else acc[ai][bj][m][n] = __builtin_amdgcn_mfma_f32_16x16x32_bf16(Bt[n][k], At[m][k], acc[ai][bj][m][n], 0, 0, 0); } __builtin_amdgcn_s_setprio(0); } while (0)
#define PG8_WAIT_V(n) asm volatile("s_waitcnt vmcnt(" #n ")" ::: "memory")
#define PG8_WAIT_L(n) asm volatile("s_waitcnt lgkmcnt(" #n ")" ::: "memory")
#define PG8_BAR __builtin_amdgcn_s_barrier()
#define PG8_SCHED __builtin_amdgcn_sched_barrier(0)
    Unit cur, nxt; int ui = 0;
    if (!S.next(0, cur)) return;
    acc_t acc[2][2][4][2];
{ float zf = 0.f; asm volatile("" : "+v"(zf));
    #pragma unroll
    for (int a = 0; a < 2; ++a)
#pragma unroll
        for (int b = 0; b < 2; ++b)
#pragma unroll
            for (int m = 0; m < 4; ++m)
#pragma unroll
                for (int n = 0; n < 2; ++n) acc[a][b][m][n] = __builtin_bit_cast(acc_t, (f32x4){zf, zf, zf, zf}); }
    bf16x8 At[4][2], B0[2][2], B1[2][2];
    const char* cA = (const char*)g.A + (size_t)cur.pm * tstepA; const char* cB = (const char*)g.Bt + (size_t)cur.pn * tstepB;
    S.a_ready(cur);
    PG8_STAGE(PG8_SB(0, 0), cB, voffB); PG8_STAGE(PG8_SB(0, 1), cB + hstepB, voffB); PG8_STAGE(PG8_SA(0, 0), cA, voffA); PG8_STAGE(PG8_SA(0, 1), cA + hstepA, voffA);
    if (wr == 1) PG8_BAR;
    PG8_WAIT_V(2); PG8_BAR;
    PG8_STAGE(PG8_SB(1, 0), cB + kstepB, voffB); PG8_STAGE(PG8_SA(1, 0), cA + kstepA, voffA); PG8_STAGE(PG8_SB(1, 1), cB + hstepB + kstepB, voffB);
    PG8_WAIT_V(6); PG8_BAR;
    for (;;) {
        const bool has_next = S.next(ui + 1, nxt);
        const char* nA = has_next ? (const char*)g.A + (size_t)nxt.pm * tstepA : cA; const char* nB = has_next ? (const char*)g.Bt + (size_t)nxt.pn * tstepB : cB;
#pragma unroll 1
        for (int t = 0; t < nt; t += 2) {
            const bool last = (t == nt - 2);
            const char* a1 = cA + (size_t)(t + 1) * kstepA;
            const char* a2 = last ? nA : cA + (size_t)(t + 2) * kstepA; const char* b2 = last ? nB : cB + (size_t)(t + 2) * kstepB;
            const char* a3 = a2 + kstepA; const char* b3 = b2 + kstepB;
            if (last && has_next) S.a_ready(nxt);
            PG8_LDB(B0, 0, 0); PG8_LDB(B1, 0, 1); PG8_SCHED; PG8_LDA(At, 0, 0); PG8_STAGE(PG8_SA(1, 1), a1 + hstepA, voffA);
            PG8_WAIT_V(8); PG8_WAIT_L(0); PG8_BAR; PG8_MMA(0, 0, At, B0); PG8_MMA(0, 1, At, B1); PG8_BAR; PG8_SCHED;
            PG8_LDA(At, 0, 1); PG8_STAGE(PG8_SB(0, 0), b2, voffB); PG8_STAGE(PG8_SB(0, 1), b2 + hstepB, voffB); PG8_STAGE(PG8_SA(0, 0), a2, voffA);
            PG8_WAIT_V(8); PG8_WAIT_L(0); PG8_BAR; PG8_MMA(1, 0, At, B0); PG8_MMA(1, 1, At, B1); PG8_BAR; PG8_SCHED;
            PG8_LDB(B0, 1, 0); PG8_LDB(B1, 1, 1); PG8_SCHED; PG8_LDA(At, 1, 0); PG8_STAGE(PG8_SA(0, 1), a2 + hstepA, voffA);
            PG8_WAIT_V(8); PG8_WAIT_L(0); PG8_BAR; PG8_MMA(0, 0, At, B0); PG8_MMA(0, 1, At, B1); PG8_BAR; PG8_SCHED;
            PG8_LDA(At, 1, 1); PG8_STAGE(PG8_SB(1, 0), b3, voffB); PG8_STAGE(PG8_SB(1, 1), b3 + hstepB, voffB); PG8_STAGE(PG8_SA(1, 0), a3, voffA);
            PG8_WAIT_V(8); PG8_WAIT_L(0); PG8_BAR; PG8_MMA(1, 0, At, B0); PG8_MMA(1, 1, At, B1); PG8_BAR; PG8_SCHED;
        }
        if (wr == 0) PG8_BAR;
        if constexpr (I8) { f32x4 accf[2][2][4][2];
#pragma unroll
            for (int a = 0; a < 2; ++a)
#pragma unroll
                for (int b = 0; b < 2; ++b)
#pragma unroll
                    for (int m = 0; m < 4; ++m)
#pragma unroll
                        for (int n = 0; n < 2; ++n) accf[a][b][m][n] = __builtin_convertvector(acc[a][b][m][n], f32x4);
            E(accf, cur, wr, wc, fr, fq); }
        else E(acc, cur, wr, wc, fr, fq);
        S.done(cur);
        if (!has_next) break;
{ float zf = 0.f; asm volatile("" : "+v"(zf));
        #pragma unroll
        for (int a = 0; a < 2; ++a)
#pragma unroll
            for (int b = 0; b < 2; ++b)
#pragma unroll
                for (int m = 0; m < 4; ++m)
#pragma unroll
                    for (int n = 0; n < 2; ++n) acc[a][b][m][n] = __builtin_bit_cast(acc_t, (f32x4){zf, zf, zf, zf}); }
        cur = nxt; cA = nA; cB = nB; ++ui;
        if (wr == 1) PG8_BAR;
    }
    PG8_WAIT_V(0);
    PG8_BAR;
#undef PG8_SA
#undef PG8_SB
#undef PG8_STAGE
#undef PG8_LDA
#undef PG8_LDB
#undef PG8_MMA
#undef PG8_WAIT_V
#undef PG8_WAIT_L
#undef PG8_BAR
#undef PG8_SCHED
}
}
namespace at {
using bf16 = unsigned short;
using bf16x8 = __attribute__((ext_vector_type(8))) short;
using s16x4  = __attribute__((ext_vector_type(4))) short;
using f32x16 = __attribute__((ext_vector_type(16))) float;
using u32x4  = __attribute__((ext_vector_type(4))) unsigned;
using f32x4  = __attribute__((ext_vector_type(4))) float;
constexpr int DQK = 192, DV = 128, KVBLK = 64, NW = 8, QBLK = 32;
constexpr float SCALE = 0.07216878364870322f;
constexpr float THR = 8.f;
constexpr int LDQ = 1536, LDK = 2560, LDO = 2048;
constexpr int SHM_V = KVBLK * DV * 2, SHM_K = 12 * 2080;
constexpr int QR_OFF = 2 * SHM_V + 2 * SHM_K + NW * 64 * 4;
constexpr int SHM_ATTN = QR_OFF + NW * 4096;
#define SBAR() __builtin_amdgcn_sched_barrier(0)
constexpr int KPL = 2080;
__host__ __device__ __forceinline__ int k_st(int row, int c) { return (c >> 1) * KPL + row * 32 + (((c & 1) ^ ((row >> 3) & 1)) << 4); }
__host__ __device__ __forceinline__ int k_rd_base(int r32, int hi) { return r32 * 32 + ((hi ^ ((r32 >> 3) & 1)) << 4); }
__device__ __forceinline__ int crow(int r, int hi) { return (r & 3) + 8 * (r >> 2) + 4 * hi; }
__device__ __forceinline__ unsigned cvtpk(float lo, float hi) { unsigned r; asm volatile("v_cvt_pk_bf16_f32 %0, %1, %2" : "=v"(r) : "v"(lo), "v"(hi)); return r; }

__device__ __forceinline__ void partialSM(f32x16& p0, f32x16& p1, float& m_reg, float& mn, float& alpha) {
  constexpr float C = 1.0f;
  float pmax = p0[0];
#pragma unroll
  for (int r = 1; r < 16; ++r) pmax = fmaxf(pmax, p0[r]);
#pragma unroll
  for (int r = 0; r < 16; ++r) pmax = fmaxf(pmax, p1[r]);
  { auto rr = __builtin_amdgcn_permlane32_swap(__float_as_uint(pmax), __float_as_uint(pmax), false, false);
    pmax = fmaxf(__uint_as_float(rr[0]), __uint_as_float(rr[1])); }
  if (__builtin_expect(__all(pmax - m_reg <= THR * 1.4426950408889634f), 1)) { mn = m_reg; alpha = 1.f; }
  else { mn = fmaxf(m_reg, pmax); alpha = __builtin_amdgcn_exp2f((m_reg - mn) * C); m_reg = mn; }
  float mnC = -mn * C;
#pragma unroll
  for (int r = 0; r < 16; ++r) p0[r] = fmaf(p0[r], C, mnC);
#pragma unroll
  for (int r = 0; r < 16; ++r) p1[r] = fmaf(p1[r], C, mnC);
#pragma unroll
  for (int r = 0; r < 16; ++r) p0[r] = __builtin_amdgcn_exp2f(p0[r]);
}
__device__ __forceinline__ void partialSM_fast(f32x16& p0, f32x16& p1, float negMC) {
  (void)negMC; (void)p1;
#pragma unroll
  for (int r = 0; r < 16; ++r) p0[r] = __builtin_amdgcn_exp2f(p0[r]);
}
__device__ __forceinline__ void finishSM(f32x16& p0, f32x16& p1, float alpha, float& l_reg, bf16x8& pa0, bf16x8& pa1, bf16x8& pa2, bf16x8& pa3) {
#pragma unroll
  for (int r = 0; r < 16; ++r) p1[r] = __builtin_amdgcn_exp2f(p1[r]);
  float ps = 0;
#pragma unroll
  for (int r = 0; r < 16; ++r) ps += p0[r];
#pragma unroll
  for (int r = 0; r < 16; ++r) ps += p1[r];
  { auto rr = __builtin_amdgcn_permlane32_swap(__float_as_uint(ps), __float_as_uint(ps), false, false);
    ps = __uint_as_float(rr[0]) + __uint_as_float(rr[1]); }
  l_reg = l_reg * alpha + ps;
#define PK4(P, BASE, OUT) do { unsigned a0 = cvtpk(P[BASE + 0], P[BASE + 1]), a1 = cvtpk(P[BASE + 2], P[BASE + 3]);   \
    unsigned b0 = cvtpk(P[BASE + 4], P[BASE + 5]), b1 = cvtpk(P[BASE + 6], P[BASE + 7]);                              \
    auto r0 = __builtin_amdgcn_permlane32_swap(a0, b0, false, false); auto r1 = __builtin_amdgcn_permlane32_swap(a1, b1, false, false); \
    u32x4 w = {r0[0], r1[0], r0[1], r1[1]}; OUT = *reinterpret_cast<bf16x8*>(&w); } while (0)
  PK4(p0, 0, pa0); PK4(p0, 8, pa1); PK4(p1, 0, pa2); PK4(p1, 8, pa3);
#undef PK4
}
template <int OFF> __device__ __forceinline__ bf16x8 k_read(int kb) {
  bf16x8 r; asm volatile("ds_read_b128 %0, %1 offset:%2" : "=v"(r) : "v"(kb), "i"(OFF) : "memory"); return r;
}
__device__ __forceinline__ void qkt(f32x16& p0, f32x16& p1, int kb, const bf16x8* qr, int qb) {
  p0 = f32x16{}; p1 = f32x16{};
#define QK1(d0) { const bf16x8 b0 = *(const __attribute__((address_space(3))) bf16x8*)(kb + d0 * KPL), b1 = *(const __attribute__((address_space(3))) bf16x8*)(kb + d0 * KPL + 1024); \
    p0 = __builtin_amdgcn_mfma_f32_32x32x16_bf16(b0, qr[d0], p0, 0, 0, 0); p1 = __builtin_amdgcn_mfma_f32_32x32x16_bf16(b1, qr[d0], p1, 0, 0, 0); }
#define QK2(d0) { const bf16x8 b0 = *(const __attribute__((address_space(3))) bf16x8*)(kb + d0 * KPL), b1 = *(const __attribute__((address_space(3))) bf16x8*)(kb + d0 * KPL + 1024); \
    const bf16x8 qf = *(const __attribute__((address_space(3))) bf16x8*)(qb + (d0 - 8) * 1024); \
    p0 = __builtin_amdgcn_mfma_f32_32x32x16_bf16(b0, qf, p0, 0, 0, 0); p1 = __builtin_amdgcn_mfma_f32_32x32x16_bf16(b1, qf, p1, 0, 0, 0); }
  QK1(0) QK1(1) QK1(2) QK1(3) QK1(4) QK1(5) QK1(6) QK1(7) QK2(8) QK2(9) QK2(10) QK2(11)
#undef QK1
#undef QK2
}
__host__ __device__ __forceinline__ int v_st(int k, int c) { const int kk = (k & ~0xC) | ((k & 4) << 1) | ((k & 8) >> 1); return ((kk >> 3) * 4 + (c >> 5)) * 512 + ((kk & 7) * 32 + (c & 31)) * 2; }
__device__ __forceinline__ int v_rd_base(int lane) { return ((lane & 3) << 3) | (((lane >> 2) & 3) << 6) | (((lane >> 4) & 1) << 5) | (((lane >> 5) & 1) << 8); }
constexpr int v_rd_off(int d0, int ks, int half) { return d0 * 512 + ks * 4096 + half * 2048; }
template <int OFF> __device__ __forceinline__ s16x4 tr_read(int vb) {
  s16x4 r; asm volatile("ds_read_b64_tr_b16 %0, %1 offset:%2" : "=&v"(r) : "v"(vb), "i"(OFF) : "memory"); return r;
}
template <int D0> __device__ __forceinline__ void pv_one(f32x16& od, int vb, bf16x8 pa0, bf16x8 pa1, bf16x8 pa2, bf16x8 pa3) {
  const s16x4 l0 = tr_read<v_rd_off(D0, 0, 0)>(vb), h0 = tr_read<v_rd_off(D0, 0, 1)>(vb), l1 = tr_read<v_rd_off(D0, 1, 0)>(vb), h1 = tr_read<v_rd_off(D0, 1, 1)>(vb);
  const s16x4 l2 = tr_read<v_rd_off(D0, 2, 0)>(vb), h2 = tr_read<v_rd_off(D0, 2, 1)>(vb), l3 = tr_read<v_rd_off(D0, 3, 0)>(vb), h3 = tr_read<v_rd_off(D0, 3, 1)>(vb);
  asm volatile("s_waitcnt lgkmcnt(0)" ::: "memory"); SBAR();
#define PK(L, H) (bf16x8){L[0], L[1], L[2], L[3], H[0], H[1], H[2], H[3]}
  od = __builtin_amdgcn_mfma_f32_32x32x16_bf16(pa0, PK(l0, h0), od, 0, 0, 0);
  od = __builtin_amdgcn_mfma_f32_32x32x16_bf16(pa1, PK(l1, h1), od, 0, 0, 0);
  od = __builtin_amdgcn_mfma_f32_32x32x16_bf16(pa2, PK(l2, h2), od, 0, 0, 0);
  od = __builtin_amdgcn_mfma_f32_32x32x16_bf16(pa3, PK(l3, h3), od, 0, 0, 0);
#undef PK
}
__device__ __forceinline__ void pv_d0(f32x16* o, int vb, bf16x8 pa0, bf16x8 pa1, bf16x8 pa2, bf16x8 pa3) {
  pv_one<0>(o[0], vb, pa0, pa1, pa2, pa3); pv_one<1>(o[1], vb, pa0, pa1, pa2, pa3); pv_one<2>(o[2], vb, pa0, pa1, pa2, pa3); pv_one<3>(o[3], vb, pa0, pa1, pa2, pa3);
}

template <bool FAST>
__device__ __forceinline__ void attn_unit(const float negMC, const bf16* __restrict__ Qb, const bf16* __restrict__ Kh, const bf16* __restrict__ Vh, bf16* __restrict__ Ob, int seq, char* lds,
                                          const float* __restrict__ ssqcq, const float* __restrict__ qg, const float* __restrict__ rope0) {
  const int tid = opq(threadIdx.x), wid = tid >> 6, lane = tid & 63, r32 = lane & 31, hi = lane >> 5;
  char* V_lds = lds; char* K_lds = lds + 2 * SHM_V;
  float* ws = (float*)(lds + 2 * SHM_V + 2 * SHM_K) + wid * 64; float* li_l = ws; float* al_l = ws + 32;
  float m_reg = -1e30f, l_reg = 0; f32x16 o[4] = {}; bf16x8 qr[8];
  const bf16* Qw = Qb + (unsigned)((wid * QBLK + r32) * LDQ + hi * 8);
  const int qb0 = (int)(uintptr_t)lds + QR_OFF + wid * 4096 + k_rd_base(r32, hi);
  { const int row = wid * QBLK + r32;
    bf16x8 raw[12];
#pragma unroll
    for (int d0 = 0; d0 < 12; ++d0) raw[d0] = *reinterpret_cast<const bf16x8*>(Qw + d0 * 16);
    const f32x4 pa = *(const f32x4*)(ssqcq + row * 8), pb = *(const f32x4*)(ssqcq + row * 8 + 4);
    const float rq = 1.0f / __builtin_sqrtf((((pa.x + pa.y) + (pa.z + pa.w)) + ((pb.x + pb.y) + (pb.z + pb.w))) * (1.f / 512.f) + 1e-6f);
    float ss = 0.f;
#pragma unroll
    for (int d0 = 0; d0 < 12; ++d0)
#pragma unroll
      for (int i = 0; i < 8; ++i) { const float x = __builtin_bit_cast(float, (unsigned)(unsigned short)raw[d0][i] << 16); ss += x * x; }
    ss += __shfl_xor(ss, 32);
    const float sc = (rq * (SCALE * 1.4426950408889634f)) / __builtin_sqrtf(ss * (rq * rq) * (1.f / 192.f) + 1e-6f);
#define QX(d0, i) (__builtin_bit_cast(float, (unsigned)(unsigned short)raw[d0][i] << 16) * sc)
#pragma unroll
    for (int d0 = 0; d0 < 8; ++d0) { const f32x4 g0 = *(const f32x4*)(qg + 16 * d0 + 8 * hi), g1 = *(const f32x4*)(qg + 16 * d0 + 8 * hi + 4);
      u32x4 w = {cvtpk(QX(d0, 0) * g0.x, QX(d0, 1) * g0.y), cvtpk(QX(d0, 2) * g0.z, QX(d0, 3) * g0.w), cvtpk(QX(d0, 4) * g1.x, QX(d0, 5) * g1.y), cvtpk(QX(d0, 6) * g1.z, QX(d0, 7) * g1.w)};
      qr[d0] = *reinterpret_cast<bf16x8*>(&w); }
#pragma unroll
    for (int t = 0; t < 2; ++t) { const int da = 8 + t, db = 10 + t, j0 = 16 * t + 8 * hi;
      const float* rp = rope0 + row * 64 + j0;
      const f32x4 c0 = *(const f32x4*)rp, c1 = *(const f32x4*)(rp + 4), s0 = *(const f32x4*)(rp + 32), s1 = *(const f32x4*)(rp + 36);
      const f32x4 ga0 = *(const f32x4*)(qg + 16 * da + 8 * hi), ga1 = *(const f32x4*)(qg + 16 * da + 8 * hi + 4), gb0 = *(const f32x4*)(qg + 16 * db + 8 * hi), gb1 = *(const f32x4*)(qg + 16 * db + 8 * hi + 4);
      const float cs[8] = {c0.x, c0.y, c0.z, c0.w, c1.x, c1.y, c1.z, c1.w}, sn[8] = {s0.x, s0.y, s0.z, s0.w, s1.x, s1.y, s1.z, s1.w};
      const float ga[8] = {ga0.x, ga0.y, ga0.z, ga0.w, ga1.x, ga1.y, ga1.z, ga1.w}, gb[8] = {gb0.x, gb0.y, gb0.z, gb0.w, gb1.x, gb1.y, gb1.z, gb1.w};
      float oa[8], ob[8];
#pragma unroll
      for (int i = 0; i < 8; ++i) { const float xa = QX(da, i) * ga[i], xb = QX(db, i) * gb[i]; oa[i] = xa * cs[i] - xb * sn[i]; ob[i] = xb * cs[i] + xa * sn[i]; }
      u32x4 wa = {cvtpk(oa[0], oa[1]), cvtpk(oa[2], oa[3]), cvtpk(oa[4], oa[5]), cvtpk(oa[6], oa[7])}, wb = {cvtpk(ob[0], ob[1]), cvtpk(ob[2], ob[3]), cvtpk(ob[4], ob[5]), cvtpk(ob[6], ob[7])};
      *(__attribute__((address_space(3))) bf16x8*)(qb0 + (da - 8) * 1024) = *reinterpret_cast<bf16x8*>(&wa);
      *(__attribute__((address_space(3))) bf16x8*)(qb0 + (db - 8) * 1024) = *reinterpret_cast<bf16x8*>(&wb); }
#undef QX
  }
  const int sr = tid >> 4, sc = (tid & 15) * 8, vst0 = v_st(sr, sc), vst1 = v_st(32 + sr, sc);
  unsigned koff[3]; int kst[3];
#pragma unroll
  for (int i = 0; i < 3; ++i) { const int q = tid + 512 * i; koff[i] = (unsigned)((q / 24) * LDK + (q % 24) * 8); kst[i] = k_st(q / 24, q % 24); }
  const unsigned voff0 = (unsigned)(sr * LDK + sc), voff1 = (unsigned)((32 + sr) * LDK + sc);
  const int vb0 = (int)(uintptr_t)V_lds + v_rd_base(lane); const int kb0 = (int)(uintptr_t)K_lds + k_rd_base(r32, hi);
  struct { bf16x8 vs0, vs1, ks0, ks1, ks2; } sr_[1];
#define SLOAD(i, k0) do { const bf16* vt = Vh + (size_t)(k0) * LDK; const bf16* kt = Kh + (size_t)(k0) * LDK; \
    sr_[i].vs0 = *(const bf16x8*)(vt + voff0); sr_[i].vs1 = *(const bf16x8*)(vt + voff1); \
    sr_[i].ks0 = *(const bf16x8*)(kt + koff[0]); sr_[i].ks1 = *(const bf16x8*)(kt + koff[1]); sr_[i].ks2 = *(const bf16x8*)(kt + koff[2]); } while (0)
#define SWRITE(b, i) do { *(bf16x8*)(V_lds + (b) * SHM_V + vst0) = sr_[i].vs0; *(bf16x8*)(V_lds + (b) * SHM_V + vst1) = sr_[i].vs1; \
    *(bf16x8*)(K_lds + (b) * SHM_K + kst[0]) = sr_[i].ks0; *(bf16x8*)(K_lds + (b) * SHM_K + kst[1]) = sr_[i].ks1; *(bf16x8*)(K_lds + (b) * SHM_K + kst[2]) = sr_[i].ks2; } while (0)
#define SWAIT() do { if constexpr (SDEPTH == 2) asm volatile("s_waitcnt vmcnt(5)" ::: "memory"); else asm volatile("s_waitcnt vmcnt(0)" ::: "memory"); } while (0)
#define RESC(a) do { if (__any((a) < 1.f)) { if (hi == 0) al_l[r32] = (a); asm volatile("s_waitcnt lgkmcnt(0)" ::: "memory"); \
    _Pragma("unroll") for (int d = 0; d < 4; ++d) _Pragma("unroll") for (int r = 0; r < 16; ++r) o[d][r] *= al_l[crow(r, hi)]; } } while (0)
  f32x16 pA0, pA1, pB0, pB1; float mnA, mnB, alA, alB; bf16x8 pa0, pa1, pa2, pa3; const int NT = seq / KVBLK;
#define PSM(P0, P1, MN, AL) do { if constexpr (FAST) { partialSM_fast(P0, P1, negMC); AL = 1.f; } else partialSM(P0, P1, m_reg, MN, AL); } while (0)
#define RSC(AL) do { if constexpr (!FAST) RESC(AL); } while (0)
  SLOAD(0, 0); asm volatile("s_waitcnt vmcnt(0)" ::: "memory"); SWRITE(0, 0); __syncthreads();
  qkt(pA0, pA1, kb0, qr, qb0); PSM(pA0, pA1, mnA, alA);
  SLOAD(0, KVBLK);
  asm volatile("s_waitcnt vmcnt(0)" ::: "memory"); SWRITE(1, 0); __syncthreads();
  for (int j = 1; j + 1 < NT; j += 2) {
    SBAR(); qkt(pB0, pB1, kb0 + SHM_K, qr, qb0);
    finishSM(pA0, pA1, alA, l_reg, pa0, pa1, pa2, pa3); SBAR();
    SLOAD(0, (j + 1) * KVBLK); SBAR();
    pv_d0(o, vb0, pa0, pa1, pa2, pa3); PSM(pB0, pB1, mnB, alB);
    __syncthreads(); asm volatile("s_waitcnt vmcnt(0)" ::: "memory"); SWRITE(0, 0);
    RSC(alB); __syncthreads();
    SBAR(); qkt(pA0, pA1, kb0, qr, qb0);
    finishSM(pB0, pB1, alB, l_reg, pa0, pa1, pa2, pa3); SBAR();
    SLOAD(0, (j + 2) * KVBLK); SBAR();
    pv_d0(o, vb0 + (int)SHM_V, pa0, pa1, pa2, pa3); PSM(pA0, pA1, mnA, alA);
    __syncthreads(); asm volatile("s_waitcnt vmcnt(0)" ::: "memory"); SWRITE(1, 0);
    RSC(alA); __syncthreads();
  }
  SBAR(); qkt(pB0, pB1, kb0 + SHM_K, qr, qb0);
  finishSM(pA0, pA1, alA, l_reg, pa0, pa1, pa2, pa3); SBAR();
  pv_d0(o, vb0, pa0, pa1, pa2, pa3); PSM(pB0, pB1, mnB, alB);
  __syncthreads(); RSC(alB);
  finishSM(pB0, pB1, alB, l_reg, pa0, pa1, pa2, pa3); SBAR();
  pv_d0(o, vb0 + (int)SHM_V, pa0, pa1, pa2, pa3);
  if (hi == 0) li_l[r32] = l_reg; asm volatile("s_waitcnt lgkmcnt(0)" ::: "memory");
  bf16* Ow = Ob + (unsigned)(wid * QBLK * LDO + r32);
#pragma unroll
  for (int r = 0; r < 16; ++r) { const int orow = crow(r, hi); const float rl = __builtin_amdgcn_rcpf(li_l[orow]);
#pragma unroll
    for (int d0 = 0; d0 < 4; ++d0) { const unsigned w = cvtpk(o[d0][r] * rl, 0.f); Ow[(unsigned)(orow * LDO + d0 * 32)] = (bf16)(w & 0xffffu); } }
  __syncthreads();
#undef SLOAD
#undef SWRITE
#undef SWAIT
#undef RESC
#undef PSM
#undef RSC
}
}
namespace hy {
#define HY_LAS __attribute__((address_space(3)))
typedef unsigned short bf16;
typedef short bf16x8 __attribute__((ext_vector_type(8)));
typedef float f32x16 __attribute__((ext_vector_type(16)));
typedef unsigned u32x2 __attribute__((ext_vector_type(2)));
typedef unsigned u32x4 __attribute__((ext_vector_type(4)));
constexpr int L = 2048, NB = 24, CH = 512;
constexpr int RFS = 4112;
constexpr int ZROW = 4112;
constexpr int ZL_BYTES = NB * ZROW;
constexpr int RCS = 8256;
constexpr int RC_OFF = ZL_BYTES;
constexpr int HY_LDS_BYTES = RC_OFF + 4 * RCS;
__device__ __forceinline__ unsigned cvtpk(float lo, float hi) { unsigned r; asm volatile("v_cvt_pk_bf16_f32 %0, %1, %2" : "=v"(r) : "v"(lo), "v"(hi)); return r; }
__host__ __device__ __forceinline__ int frag_base(int tw, int r, int h) { const int a = (4 - (r & 3)) & 3; return RC_OFF + a * RCS + 2 * (2048 - tw - r + 8 * h - a); }
__host__ __device__ __forceinline__ int zfrag_base(int r, int h) { return (r < NB ? r : NB - 1) * ZROW + 16 * h; }

__device__ __forceinline__ bf16x8 ld_frag(HY_LAS unsigned char* lds, int off) {
    const u32x2 lo = *(const HY_LAS u32x2*)(lds + off), hi = *(const HY_LAS u32x2*)(lds + off + 8);
    u32x4 w = {lo.x, lo.y, hi.x, hi.y}; return *reinterpret_cast<bf16x8*>(&w);
}
__device__ __forceinline__ bf16x8 ld_b128(HY_LAS unsigned char* lds, int off) { return *(const HY_LAS bf16x8*)(lds + off); }

__device__ __forceinline__ void conv_unit(HY_LAS unsigned char* lds, const bf16* __restrict__ ZT, const bf16* __restrict__ RF, bf16* __restrict__ YC, int c, int half) {
    const int tid = opq(threadIdx.x), wid = tid >> 6, lane = tid & 63, r = lane & 31, h = lane >> 5;
    { const u32x4* src = (const u32x4*)(ZT + (size_t)c * NB * L);
#pragma unroll
      for (int i = 0; i < 12; ++i) { const int q = tid + 512 * i; const u32x4 v = src[q]; *(HY_LAS u32x4*)(lds + (q >> 8) * ZROW + (q & 255) * 16) = v; } }
    { const bf16* rf = RF + (size_t)c * RFS;
      for (int ch = tid; ch < RFS / 8; ch += 512) {
          const u32x4 v = *(const u32x4*)(rf + ch * 8); const unsigned w[4] = {v.x, v.y, v.z, v.w};
#pragma unroll
          for (int j = 0; j < 8; ++j) { const unsigned short e = (unsigned short)((w[j >> 1] >> ((j & 1) * 16)) & 0xffffu); const int idx = ch * 8 + j;
#pragma unroll
              for (int a = 0; a < 4; ++a) if (idx - a >= 0) *(HY_LAS unsigned short*)(lds + RC_OFF + a * RCS + 2 * (idx - a)) = e; } } }
    __syncthreads();
    const int tw = half * 1024 + wid * 128;
    const int fb = frag_base(tw, r, h), zb = zfrag_base(r, h);
    f32x16 acc[4] = {};
    bf16x8 S0[2], S1[2], S2[2], S3[2], Bc[2], Bn[2];
#define HY_LDG(S, d) do { S[0] = ld_frag(lds, fb + 64 * (d)); S[1] = ld_frag(lds, fb + 64 * (d) + 32); } while (0)
#define HY_LDB(Bx, n) do { Bx[0] = ld_b128(lds, zb + 64 * (n)); Bx[1] = ld_b128(lds, zb + 64 * (n) + 32); } while (0)
#define HY_MM(i, S, Bx) do { acc[i] = __builtin_amdgcn_mfma_f32_32x32x16_bf16(S[0], Bx[0], acc[i], 0, 0, 0); acc[i] = __builtin_amdgcn_mfma_f32_32x32x16_bf16(S[1], Bx[1], acc[i], 0, 0, 0); } while (0)
#define HY_ITER(n, Sa, Sb, Sc, Sd, Bcur, Bnext) do { HY_LDG(Sa, (n)); if ((n) + 1 < 64) HY_LDB(Bnext, (n) + 1); \
        HY_MM(1, Sb, Bcur); HY_MM(2, Sc, Bcur); HY_MM(3, Sd, Bcur); HY_MM(0, Sa, Bcur); } while (0)
    HY_LDG(S3, -1); HY_LDG(S2, -2); HY_LDG(S1, -3); HY_LDB(Bc, 0);
    for (int n = 0; n < 64; n += 4) {
        HY_ITER(n, S0, S3, S2, S1, Bc, Bn);
        HY_ITER(n + 1, S1, S0, S3, S2, Bn, Bc);
        HY_ITER(n + 2, S2, S1, S0, S3, Bc, Bn);
        HY_ITER(n + 3, S3, S2, S1, S0, Bn, Bc);
    }
#undef HY_LDG
#undef HY_LDB
#undef HY_MM
#undef HY_ITER
    if (r < NB) { bf16* yp = YC + ((size_t)c * NB + r) * L + tw + 4 * h;
#pragma unroll
        for (int i = 0; i < 4; ++i)
#pragma unroll
            for (int q4 = 0; q4 < 4; ++q4) { u32x2 w; w.x = cvtpk(acc[i][4 * q4 + 0], acc[i][4 * q4 + 1]); w.y = cvtpk(acc[i][4 * q4 + 2], acc[i][4 * q4 + 3]);
                *(u32x2*)(yp + 32 * i + 8 * q4) = w; } }
    __syncthreads();
}
}
constexpr int NWAVES = 8;
#ifndef MK_ONE_LAUNCH
#define MK_ONE_LAUNCH 1
#endif
constexpr int DM = 2048, NSEQ = 24, SEQ = 2048, M = NSEQ * SEQ, MP = 8 * SEQ;
constexpr int DEPTH = 4;
constexpr int DIN = 2880, DINP = 3072;
constexpr int O_CQ = 512, O_CKV = 1024, O_KPE = 1280, O_HY = 1344;
constexpr int NH = 8, NQ = 1536, NKVP = 2560, KVHS = 320;
constexpr int DFF = 5632, NUP = 11264, HYC = 512;
constexpr float EPS = 1e-6f;
constexpr int NPH = 11;
constexpr size_t WS_CTL = 0, CTL_BYTES = 1u << 20;
constexpr size_t SZ_BTIN = (size_t)DINP * DM * 2, SZ_BTUQ = (size_t)NQ * 512 * 2, SZ_BTKV = (size_t)NKVP * 256 * 2, SZ_BTOUT = (size_t)DM * DM * 2, SZ_BTUP = (size_t)NUP * DM * 2, SZ_BTDN = (size_t)DM * DFF * 2;
constexpr size_t WS_BTIN = WS_CTL + CTL_BYTES, WS_BTUQ = WS_BTIN + SZ_BTIN, WS_BTKV = WS_BTUQ + SZ_BTUQ, WS_BTOUT = WS_BTKV + SZ_BTKV, WS_BTUP = WS_BTOUT + SZ_BTOUT, WS_BTDN = WS_BTUP + SZ_BTUP;
constexpr size_t WS_RF = WS_BTDN + SZ_BTDN, SZ_RF = (size_t)HYC * hy::RFS * 2;
constexpr size_t WS_H = WS_RF + SZ_RF, SZ_H = (size_t)M * DM * 2;
constexpr size_t WS_PROJ = WS_H + SZ_H, SZ_PROJ = (size_t)M * DINP * 2;
constexpr size_t WS_Q = WS_PROJ + SZ_PROJ, SZ_Q = (size_t)M * NQ * 2;
constexpr size_t WS_KV = WS_Q + SZ_Q, SZ_KV = (size_t)M * NKVP * 2;
constexpr size_t WS_ZT = WS_KV + SZ_KV, SZ_ZT = (size_t)HYC * NSEQ * SEQ * 2;
constexpr size_t WS_X0 = WS_ZT + SZ_ZT, WS_YC = WS_X0 + SZ_ZT;
constexpr size_t WS_EDGE = WS_YC + SZ_ZT, SZ_EDGE = (size_t)(M / 256) * 2 * 3 * DFF * 4;
constexpr size_t WS_ROPE = WS_EDGE + SZ_EDGE, SZ_ROPE = (size_t)SEQ * 64 * 4;
constexpr size_t WS_SSQP = WS_ROPE + SZ_ROPE, SZ_SSQP = (size_t)M * 32 * 4;
constexpr size_t WS_RSTD = WS_SSQP + SZ_SSQP, SZ_RSTD = (size_t)M * 4;
constexpr size_t WS_XQ = WS_RSTD + SZ_RSTD, SZ_XQ = (size_t)M * DM;
constexpr size_t WS_SSQCQ = WS_XQ + SZ_XQ, SZ_SSQCQ = (size_t)M * 8 * 4;
constexpr int NINQ = 2048;
constexpr size_t WS_BTINQ = WS_SSQCQ + SZ_SSQCQ, SZ_BTINQ = (size_t)NINQ * DM;
constexpr size_t WS_CSIN = WS_BTINQ + SZ_BTINQ, SZ_CSIN = (size_t)NINQ * 4;
constexpr size_t WS_RSTDQ = WS_CSIN + SZ_CSIN, SZ_RSTDQ = (size_t)M * 4;
constexpr size_t WS_END = WS_RSTDQ + SZ_RSTDQ;
constexpr size_t WS_ACT = WS_PROJ;
static_assert((size_t)M * DFF * 2 <= SZ_PROJ + SZ_Q + SZ_KV, "ACT overlay");
constexpr size_t WS_XB2 = WS_ACT + (size_t)M * DFF * 2;
static_assert(WS_XB2 + (size_t)M * DM * 2 <= WS_EDGE && WS_XB2 % 256 == 0, "XB2 overlay");
static_assert(WS_BTIN % 256 == 0 && WS_RF % 256 == 0 && WS_H % 256 == 0 && WS_PROJ % 256 == 0 && WS_Q % 256 == 0 && WS_KV % 256 == 0 && WS_ZT % 256 == 0 && WS_EDGE % 256 == 0, "alignment");
constexpr int CW_WMAXC = 65536;
constexpr int CW_WMAX = 1024;
constexpr int CW_BAR = 4096;
constexpr int RING_BYTES = 135168;
constexpr int HALO_OFF = RING_BYTES, HALO_BYTES = 4096;
constexpr int MISC_OFF = HALO_OFF + HALO_BYTES;
constexpr int LDS_BYTES = 147456;
static_assert(hy::HY_LDS_BYTES <= RING_BYTES && at::SHM_ATTN <= RING_BYTES && MISC_OFF + 256 <= LDS_BYTES, "LDS map");

#define GAS __attribute__((address_space(1)))
#define LAS __attribute__((address_space(3)))
typedef unsigned short bf16;
typedef unsigned v4u __attribute__((ext_vector_type(4)));
typedef unsigned v2u __attribute__((ext_vector_type(2)));
typedef float f32x4 __attribute__((ext_vector_type(4)));
#define LDS_WAIT() asm volatile("s_waitcnt lgkmcnt(0)" ::: "memory")
__device__ __forceinline__ unsigned f2bf(float f) { unsigned u = __builtin_bit_cast(unsigned, f); return (u + 0x7fffu + ((u >> 16) & 1u)) >> 16; }
__device__ __forceinline__ unsigned pk2(float lo, float hi) { return f2bf(lo) | (f2bf(hi) << 16); }
__device__ __forceinline__ float bf2f(unsigned short b) { return __builtin_bit_cast(float, (unsigned)b << 16); }
__device__ __forceinline__ float bflo(unsigned w) { return __builtin_bit_cast(float, w << 16); }
__device__ __forceinline__ float bfhi(unsigned w) { return __builtin_bit_cast(float, w & 0xffff0000u); }
__device__ __forceinline__ float wave_sum(float v) {
#pragma unroll
    for (int o = 1; o < 64; o <<= 1) v += __shfl_xor(v, o);
    return v;
}

#define XB_TMO      128
#define XB_XCNT(j)  (256  + 64 * (j))
#define XB_XSUB(j)  (1280 + 64 * (j))
#define XB_XGEN(j)  (2304 + 64 * (j))
#define XB_TOP      3328
#define XB_TOPGEN   3392
#define XCD_BAR_WORDS 3456
#define XB_SPIN_CAP (1u << 18)
__device__ __forceinline__ unsigned xb_ld(unsigned* p)              { return __hip_atomic_load(p, __ATOMIC_RELAXED, __HIP_MEMORY_SCOPE_AGENT); }
__device__ __forceinline__ unsigned xb_add(unsigned* p, unsigned v) { return __hip_atomic_fetch_add(p, v, __ATOMIC_RELAXED, __HIP_MEMORY_SCOPE_AGENT); }
__device__ __forceinline__ unsigned xb_xcc_id() { return (unsigned)__builtin_amdgcn_s_getreg((3 << 11) | 20) & 0xFu; }
#define XB_SPIN(cond, bar) do { unsigned _sp = 0; while (cond) { __builtin_amdgcn_s_sleep(1); \
    if ((++_sp & 255u) == 0u) { if (xb_ld(&(bar)[XB_TMO])) break; if (_sp > XB_SPIN_CAP) { atomicAdd(&(bar)[XB_TMO], 1u); break; } } } } while (0)
struct XcdBarrier { unsigned* bar; unsigned x; volatile LAS unsigned* st; };
__device__ __forceinline__ XcdBarrier xcd_barrier_post(unsigned* bar, volatile LAS unsigned* st) {
    XcdBarrier b; b.bar = bar; b.x = xb_xcc_id(); b.st = st;
    if (threadIdx.x == 0) (void)xb_add(&bar[XB_XCNT(b.x)], 1u);
    return b;
}
__device__ __forceinline__ void xcd_barrier_complete(unsigned* bar, unsigned x, unsigned& nloc, unsigned& nx) {
    const unsigned G = gridDim.x * gridDim.y * gridDim.z;
    unsigned sum, cnt, mine, sp = 0u;
    for (;;) {
        sum = 0u; cnt = 0u; mine = 0u;
#pragma unroll
        for (unsigned j = 0; j < 16; ++j) { const unsigned c = xb_ld(&bar[XB_XCNT(j)]); sum += c; cnt += (c > 0u) ? 1u : 0u; mine = (j == x) ? c : mine; }
        if (sum == G) break;
        __builtin_amdgcn_s_sleep(1);
        if ((++sp & 255u) == 0u) { if (xb_ld(&bar[XB_TMO])) break; if (sp > XB_SPIN_CAP) { atomicAdd(&bar[XB_TMO], 1u); break; } }
    }
    nloc = mine > 0u ? mine : 1u; nx = cnt > 0u ? cnt : 1u;
}
__device__ __forceinline__ void xcd_barrier(const XcdBarrier& b) {
    asm volatile("s_waitcnt vmcnt(0)" ::: "memory");
    __syncthreads();
    if (threadIdx.x == 0) {
        unsigned* bar = b.bar;
        __builtin_amdgcn_s_waitcnt(0);
        unsigned nloc = b.st[0], nx = b.st[1];
        if (nloc == 0u) { xcd_barrier_complete(bar, b.x, nloc, nx); b.st[0] = nloc; b.st[1] = nx; }
        const unsigned old = xb_add(&bar[XB_XSUB(b.x)], 1u);
        const unsigned gen = old / nloc;
        if (old + 1u == (gen + 1u) * nloc) {
            __builtin_amdgcn_fence(__ATOMIC_RELEASE, "agent");
            asm volatile("s_waitcnt vmcnt(0)" ::: "memory");
            const unsigned og = xb_add(&bar[XB_TOP], 1u);
            const unsigned tg = og / nx;
            if (og + 1u == (tg + 1u) * nx) xb_add(&bar[XB_TOPGEN], 1u);
            else XB_SPIN(xb_ld(&bar[XB_TOPGEN]) == tg, bar);
            __builtin_amdgcn_fence(__ATOMIC_ACQUIRE, "agent");
            xb_add(&bar[XB_XGEN(b.x)], 1u);
            asm volatile("s_waitcnt vmcnt(0)" ::: "memory");
        } else {
            XB_SPIN(xb_ld(&bar[XB_XGEN(b.x)]) == gen, bar);
            __builtin_amdgcn_fence(__ATOMIC_ACQUIRE, "agent");
            asm volatile("s_waitcnt vmcnt(0)" ::: "memory");
        }
    }
    __syncthreads();
}

struct Frame {
    LAS unsigned char* lds;
    int tid, lane, wave, vcu, G, bx, vcu0, G0, bx0;
};
enum { I_XP = 0, I_XS, I_ANG, I_WIN, I_PW, I_PS, I_QNG, I_WUQ, I_KVNG, I_WUKV, I_QHG, I_KHG, I_HCW, I_HCB, I_FW1, I_FB1, I_FFR, I_FW2, I_FB2, I_FW3, I_FB3, I_HBIAS, I_GNG, I_WOUT, I_FNG, I_WUP, I_FCW, I_FCB, I_WDN, N_IN };
struct Args { const float* in[N_IN]; float* out; unsigned char* ws; int ph_lo, ph_hi; };
static_assert(sizeof(Args) == (N_IN + 2) * 8 + 8, "Args has no padding");

__device__ __forceinline__ void cvt_item(const float* __restrict__ W, int ldw, int K, bf16* WT, int dst_n0, int src_n0, int k0, const float* __restrict__ ks, LAS float* scr, int lane) {
#pragma unroll
    for (int i = 0; i < 32; ++i) { const int kk = 2 * i + (lane >> 5); float v = W[(size_t)(k0 + kk) * ldw + src_n0 + (lane & 31)]; if (ks) v *= ks[k0 + kk]; scr[kk * 33 + (lane & 31)] = v; }
    LDS_WAIT(); asm volatile("" ::: "memory");
    const int c = lane & 7;
#pragma unroll
    for (int j = 0; j < 4; ++j) { const int n = (lane >> 3) + 8 * j; const LAS float* s = scr + (8 * c) * 33 + n;
        v4u o; o.x = pk2(s[0 * 33], s[1 * 33]); o.y = pk2(s[2 * 33], s[3 * 33]); o.z = pk2(s[4 * 33], s[5 * 33]); o.w = pk2(s[6 * 33], s[7 * 33]);
        *(v4u*)(WT + (size_t)(dst_n0 + n) * K + k0 + 8 * c) = o; }
    LDS_WAIT(); asm volatile("" ::: "memory");
}
struct CvtTile { const float* W; const float* ks; bf16* WT; int ldw, K, src_n0, k0, ncols; int dst[4]; };
__device__ __forceinline__ void cvt_tile(Frame& F, const CvtTile& d) {
    LAS float* T = (LAS float*)F.lds;
#pragma unroll
    for (int i = 0; i < 8; ++i) { const int q = F.tid + 512 * i, row = q >> 5, c4 = q & 31;
        f32x4 v = {0.f, 0.f, 0.f, 0.f};
        if (d.src_n0 + 4 * c4 < d.ncols) v = *(const f32x4*)(d.W + (size_t)(d.k0 + row) * d.ldw + d.src_n0 + 4 * c4);
        if (d.ks) v *= d.ks[d.k0 + row];
        LAS float* t = T + row * 129 + 4 * c4; t[0] = v.x; t[1] = v.y; t[2] = v.z; t[3] = v.w; }
    __syncthreads();
#pragma unroll
    for (int i = 0; i < 4; ++i) { const int n = (F.tid >> 4) + 32 * i, kc = F.tid & 15;
        if (d.src_n0 + n < d.ncols) { const LAS float* s = T + (8 * kc) * 129 + n;
            v4u o; o.x = pk2(s[0], s[129]); o.y = pk2(s[2 * 129], s[3 * 129]); o.z = pk2(s[4 * 129], s[5 * 129]); o.w = pk2(s[6 * 129], s[7 * 129]);
            *(v4u*)(d.WT + (size_t)(d.dst[i] + (n & 31)) * d.K + d.k0 + 8 * kc) = o; } }
    __syncthreads();
}
__device__ __forceinline__ void absmax_tile(Frame& F, const float* __restrict__ W, const float* __restrict__ ks, int ldw, int src_n0, int k0, unsigned* outc) {
    LAS float* P = (LAS float*)F.lds;
    f32x4 m = {0.f, 0.f, 0.f, 0.f};
#pragma unroll
    for (int i = 0; i < 8; ++i) { const int q = F.tid + 512 * i, row = q >> 5, c4 = q & 31;
        const f32x4 v = *(const f32x4*)(W + (size_t)(k0 + row) * ldw + src_n0 + 4 * c4) * ks[k0 + row];
        m.x = fmaxf(m.x, fabsf(v.x)); m.y = fmaxf(m.y, fabsf(v.y)); m.z = fmaxf(m.z, fabsf(v.z)); m.w = fmaxf(m.w, fabsf(v.w)); }
    *(LAS f32x4*)(P + (F.tid >> 5) * 128 + 4 * (F.tid & 31)) = m;
    __syncthreads();
    if (F.tid < 128) { float c = P[F.tid];
#pragma unroll
        for (int g = 1; g < 16; ++g) c = fmaxf(c, P[g * 128 + F.tid]);
        atomicMax(outc + src_n0 + F.tid, __builtin_bit_cast(unsigned, c)); }
    __syncthreads();
}
__device__ __forceinline__ unsigned q8(float v) { const int q = (int)__builtin_rintf(v); return (unsigned)(q < -127 ? -127 : (q > 127 ? 127 : q)) & 0xffu; }
__device__ __forceinline__ void cvtq_tile(Frame& F, const float* __restrict__ W, const float* __restrict__ ks, int ldw, int K, unsigned char* WT, int src_n0, int k0, int dst0, const unsigned* __restrict__ wmaxc) {
    LAS float* T = (LAS float*)F.lds;
    f32x4 inv4; { const v4u mb = *(const v4u*)(wmaxc + src_n0 + 4 * (F.tid & 31));
        inv4.x = 127.0f / fmaxf(__builtin_bit_cast(float, mb.x), 1e-30f); inv4.y = 127.0f / fmaxf(__builtin_bit_cast(float, mb.y), 1e-30f); inv4.z = 127.0f / fmaxf(__builtin_bit_cast(float, mb.z), 1e-30f); inv4.w = 127.0f / fmaxf(__builtin_bit_cast(float, mb.w), 1e-30f); }
#pragma unroll
    for (int i = 0; i < 8; ++i) { const int q = F.tid + 512 * i, row = q >> 5, c4 = q & 31;
        const f32x4 v = *(const f32x4*)(W + (size_t)(k0 + row) * ldw + src_n0 + 4 * c4) * ks[k0 + row] * inv4;
        LAS float* t = T + row * 129 + 4 * c4; t[0] = v.x; t[1] = v.y; t[2] = v.z; t[3] = v.w; }
    __syncthreads();
#pragma unroll
    for (int i = 0; i < 2; ++i) { const int n = (F.tid >> 3) + 64 * i, kc = F.tid & 7;
        const LAS float* s = T + (16 * kc) * 129 + n; unsigned w[4];
#pragma unroll
        for (int j = 0; j < 4; ++j) w[j] = q8(s[(4 * j) * 129]) | (q8(s[(4 * j + 1) * 129]) << 8) | (q8(s[(4 * j + 2) * 129]) << 16) | (q8(s[(4 * j + 3) * 129]) << 24);
        v4u o; o.x = w[0]; o.y = w[1]; o.z = w[2]; o.w = w[3];
        *(v4u*)(WT + (size_t)(dst0 + 64 * (n >> 5) + (n & 31)) * K + k0 + 16 * kc) = o; }
    __syncthreads();
}
__device__ __forceinline__ void xq_row(const bf16* __restrict__ xrow, unsigned char* qrow, const float* __restrict__ ssq32, float* rowf, float s_w, int lane) {
    v4u v[4]; float m = 0.f;
#pragma unroll
    for (int j = 0; j < 4; ++j) { v[j] = *(const v4u*)(xrow + 8 * (lane + 64 * j)); const unsigned w[4] = {v[j].x, v[j].y, v[j].z, v[j].w};
#pragma unroll
        for (int i = 0; i < 4; ++i) m = fmaxf(m, fmaxf(fabsf(bflo(w[i])), fabsf(bfhi(w[i])))); }
    float ss = (lane < 32) ? ssq32[lane] : 0.f;
#pragma unroll
    for (int o = 1; o < 64; o <<= 1) { m = fmaxf(m, __shfl_xor(m, o)); ss += __shfl_xor(ss, o); }
    m = fmaxf(m, 1e-30f); const float inv = 127.0f / m;
    if (lane == 0) *rowf = (1.0f / sqrtf(ss * (1.f / DM) + EPS)) * (m * (1.0f / 127.0f)) * s_w;
#pragma unroll
    for (int j = 0; j < 4; ++j) { const unsigned w[4] = {v[j].x, v[j].y, v[j].z, v[j].w}; v2u o;
        o.x = q8(bflo(w[0]) * inv) | (q8(bfhi(w[0]) * inv) << 8) | (q8(bflo(w[1]) * inv) << 16) | (q8(bfhi(w[1]) * inv) << 24);
        o.y = q8(bflo(w[2]) * inv) | (q8(bfhi(w[2]) * inv) << 8) | (q8(bflo(w[3]) * inv) << 16) | (q8(bfhi(w[3]) * inv) << 24);
        *(v2u*)(qrow + 8 * (lane + 64 * j)) = o; }
}
__device__ __forceinline__ void q8_row(const bf16* __restrict__ xrow, unsigned char* qrow, float rs, float* rowf, int lane) {
    v4u v[4]; float m = 0.f;
#pragma unroll
    for (int j = 0; j < 4; ++j) { v[j] = *(const v4u*)(xrow + 8 * (lane + 64 * j)); const unsigned w[4] = {v[j].x, v[j].y, v[j].z, v[j].w};
#pragma unroll
        for (int i = 0; i < 4; ++i) m = fmaxf(m, fmaxf(fabsf(bflo(w[i])), fabsf(bfhi(w[i])))); }
#pragma unroll
    for (int o = 1; o < 64; o <<= 1) m = fmaxf(m, __shfl_xor(m, o));
    m = fmaxf(m, 1e-30f); const float inv = 127.0f / m;
    if (lane == 0) *rowf = rs * (m * (1.0f / 127.0f));
#pragma unroll
    for (int j = 0; j < 4; ++j) { const unsigned w[4] = {v[j].x, v[j].y, v[j].z, v[j].w}; v2u o;
        o.x = q8(bflo(w[0]) * inv) | (q8(bfhi(w[0]) * inv) << 8) | (q8(bflo(w[1]) * inv) << 16) | (q8(bfhi(w[1]) * inv) << 24);
        o.y = q8(bflo(w[2]) * inv) | (q8(bfhi(w[2]) * inv) << 8) | (q8(bflo(w[3]) * inv) << 16) | (q8(bfhi(w[3]) * inv) << 24);
        *(v2u*)(qrow + 8 * (lane + 64 * j)) = o; }
}
__device__ __forceinline__ void xb_row(const float* xrow, bf16* orow, float* rstd, unsigned char* qrow, float* rowfq, int lane) {
    const f32x4* xr = (const f32x4*)xrow + lane;
    f32x4 v[8]; float s = 0.f;
#pragma unroll
    for (int j = 0; j < 8; ++j) { v[j] = xr[64 * j]; s += (v[j].x * v[j].x + v[j].y * v[j].y) + (v[j].z * v[j].z + v[j].w * v[j].w); }
    const float r = 1.0f / sqrtf(wave_sum(s) * (1.f / DM) + EPS);
    if (lane == 0) *rstd = r;
    v2u* o8 = (v2u*)orow + lane; float mx = 0.f;
#pragma unroll
    for (int j = 0; j < 8; ++j) { v2u w; w.x = pk2(v[j].x, v[j].y); w.y = pk2(v[j].z, v[j].w); o8[64 * j] = w;
        v[j].x = bflo(w.x); v[j].y = bfhi(w.x); v[j].z = bflo(w.y); v[j].w = bfhi(w.y);
        mx = fmaxf(mx, fmaxf(fmaxf(fabsf(v[j].x), fabsf(v[j].y)), fmaxf(fabsf(v[j].z), fabsf(v[j].w)))); }
#pragma unroll
    for (int o = 1; o < 64; o <<= 1) mx = fmaxf(mx, __shfl_xor(mx, o));
    mx = fmaxf(mx, 1e-30f); const float inv = 127.0f / mx;
    if (lane == 0) *rowfq = r * (mx * (1.0f / 127.0f));
    unsigned* q4 = (unsigned*)qrow + lane;
#pragma unroll
    for (int j = 0; j < 8; ++j) q4[64 * j] = q8(v[j].x * inv) | (q8(v[j].y * inv) << 8) | (q8(v[j].z * inv) << 16) | (q8(v[j].w * inv) << 24);
}
__device__ __forceinline__ void rstd_from_partials(const float* __restrict__ ssqp, float* rstd, size_t gtid, size_t gthreads) {
    for (size_t r = gtid; r < (size_t)M; r += gthreads) { const f32x4* p = (const f32x4*)(ssqp + r * 32); f32x4 a = p[0];
#pragma unroll
        for (int i = 1; i < 8; ++i) a += p[i];
        rstd[r] = 1.0f / sqrtf(((a.x + a.y) + (a.z + a.w)) * (1.f / DM) + EPS); }
}
__device__ __forceinline__ void tile_norm_store(LAS float* tile, bf16* dst, int row0, int col_off, int wave, int lane) {
#pragma unroll
    for (int i = 0; i < 8; ++i) { const int t = wave * 8 + i;
        const f32x4 a = *(LAS f32x4*)(tile + t * 512 + 8 * lane), b = *(LAS f32x4*)(tile + t * 512 + 8 * lane + 4);
        const float s = (a.x * a.x + a.y * a.y) + (a.z * a.z + a.w * a.w) + (b.x * b.x + b.y * b.y) + (b.z * b.z + b.w * b.w);
        const float rstd = 1.0f / sqrtf(wave_sum(s) * (1.f / 512.f) + EPS);
        v4u o; o.x = pk2(a.x * rstd, a.y * rstd); o.y = pk2(a.z * rstd, a.w * rstd); o.z = pk2(b.x * rstd, b.y * rstd); o.w = pk2(b.z * rstd, b.w * rstd);
        *(v4u*)(dst + (size_t)(row0 + t) * DM + col_off + 8 * lane) = o; }
}
__device__ __forceinline__ void poolfold_item(Frame& F, const float* __restrict__ win, const float* __restrict__ pw, const float* __restrict__ ps, const float* __restrict__ g1, bf16* BtIn, int g, int kb) {
    LAS float* At = (LAS float*)F.lds; LAS float* Bt = (LAS float*)(F.lds + 32768);
    const int k0 = 64 * kb;
#pragma unroll
    for (int i = 0; i < 4; ++i) { const int q = F.tid + 512 * i, row = q >> 5, c4 = q & 31; *(LAS f32x4*)(At + row * 128 + 4 * c4) = *(const f32x4*)(win + (size_t)(k0 + row) * DIN + 128 * g + 4 * c4) * g1[k0 + row]; }
#pragma unroll
    for (int i = 0; i < 8; ++i) { const int q = F.tid + 512 * i, row = q >> 5, c4 = q & 31; *(LAS f32x4*)(Bt + row * 128 + 4 * c4) = *(const f32x4*)(pw + (size_t)(g * 128 + row) * 128 + 4 * c4); }
    __syncthreads();
    const int n = F.tid & 127, kg = F.tid >> 7;
    float acc[16];
#pragma unroll
    for (int i = 0; i < 16; ++i) acc[i] = 0.f;
    for (int j = 0; j < 128; j += 4) {
        const float b0 = Bt[(j + 0) * 128 + n], b1 = Bt[(j + 1) * 128 + n], b2 = Bt[(j + 2) * 128 + n], b3 = Bt[(j + 3) * 128 + n];
#pragma unroll
        for (int i = 0; i < 16; ++i) { const f32x4 a = *(LAS f32x4*)(At + (kg * 16 + i) * 128 + j); acc[i] += a.x * b0 + a.y * b1 + a.z * b2 + a.w * b3; }
    }
    const float sc = ps[128 * g + n];
    v4u o0, o1;
    o0.x = pk2(acc[0] * sc, acc[1] * sc); o0.y = pk2(acc[2] * sc, acc[3] * sc); o0.z = pk2(acc[4] * sc, acc[5] * sc); o0.w = pk2(acc[6] * sc, acc[7] * sc);
    o1.x = pk2(acc[8] * sc, acc[9] * sc); o1.y = pk2(acc[10] * sc, acc[11] * sc); o1.z = pk2(acc[12] * sc, acc[13] * sc); o1.w = pk2(acc[14] * sc, acc[15] * sc);
    bf16* dst = BtIn + (size_t)(128 * g + n) * DM + k0 + kg * 16;
    *(v4u*)dst = o0; *(v4u*)(dst + 8) = o1;
    __syncthreads();
}
__device__ __forceinline__ void filter_item(Frame& F, const float* __restrict__ w1, const float* __restrict__ b1, const float* __restrict__ fr, const float* __restrict__ w2, const float* __restrict__ b2,
                                            const float* __restrict__ w3, const float* __restrict__ b3, const float* __restrict__ hbias, bf16* RF, int fi) {
    LAS float* ZF = (LAS float*)F.lds; LAS float* H1 = ZF + 512; LAS float* H2 = ZF + 1536; LAS float* W1s = ZF + 2560; LAS float* W2s = ZF + 3712;
    const int t0 = 16 * fi;
    for (int q = F.tid; q < 272; q += 512) *(LAS f32x4*)(W1s + 4 * q) = *(const f32x4*)(w1 + 4 * q);
#pragma unroll
    for (int i = 0; i < 2; ++i) { const int q = F.tid + 512 * i; *(LAS f32x4*)(W2s + 4 * q) = *(const f32x4*)(w2 + 4 * q); }
    if (F.tid < 272) { const int tt = F.tid / 17, f = F.tid % 17; const float t = (float)(t0 + tt);
        float v;
        if (f == 0) v = t / 2047.0f;
        else { const int j = (f - 1) & 7; const float band = 1e-4f + (float)j * ((7.0f - 1e-4f) / 7.0f); const float w = (6.283185307179586f * t) / 2048.0f; const float a = band * w; v = (f <= 8) ? __cosf(a) : -__sinf(a); }
        ZF[tt * 17 + f] = v; }
    __syncthreads();
#pragma unroll
    for (int rep = 0; rep < 2; ++rep) { const int p = F.tid + 512 * rep, tt = p >> 6, j = p & 63; float s = b1[j];
#pragma unroll
        for (int i = 0; i < 17; ++i) s += ZF[tt * 17 + i] * W1s[i * 64 + j];
        H1[tt * 64 + j] = __sinf(fr[j] * s); }
    __syncthreads();
#pragma unroll
    for (int rep = 0; rep < 2; ++rep) { const int p = F.tid + 512 * rep, tt = p >> 6, j = p & 63; float s = b2[j];
#pragma unroll 16
        for (int i = 0; i < 64; ++i) s += H1[tt * 64 + i] * W2s[i * 64 + j];
        H2[tt * 64 + j] = __sinf(fr[j] * s); }
    __syncthreads();
    const int c = F.tid;
    const float delta = -3.0701134573253944f + (float)c * ((-15.350567286626972f + 3.0701134573253944f) / 511.0f);
    const float ad = fabsf(delta);
    bf16* rf = RF + (size_t)c * hy::RFS;
#pragma unroll 1
    for (int dir = 0; dir < 2; ++dir) { const int o = dir * 512 + c; const float bo = b3[o];
        float wc[64];
#pragma unroll
        for (int i = 0; i < 64; ++i) wc[i] = w3[i * 1024 + o];
#pragma unroll 1
        for (int tt = 0; tt < 16; ++tt) { float s = bo;
#pragma unroll
            for (int i = 0; i < 64; i += 4) { const f32x4 hv = *(LAS f32x4*)(H2 + tt * 64 + i); s += (hv.x * wc[i] + hv.y * wc[i + 1]) + (hv.z * wc[i + 2] + hv.w * wc[i + 3]); }
            const int t = t0 + tt; const float tl = (float)t / 2047.0f; float val = s * __expf(-tl * ad);
            if (dir == 0) { if (t == 0) val += hbias[c]; rf[2048 - t] = (bf16)f2bf(val); }
            else if (t >= 1) rf[2048 + t] = (bf16)f2bf(val); } }
    if (fi == 0) { rf[0] = 0;
#pragma unroll
        for (int i = 4096; i < hy::RFS; ++i) rf[i] = 0; }
    __syncthreads();
}
__device__ __forceinline__ void unpack4(const v2u w, float (&x)[4]) { x[0] = bflo(w.x); x[1] = bfhi(w.x); x[2] = bflo(w.y); x[3] = bfhi(w.y); }
__device__ __forceinline__ void pair_norm_store(Frame& F, const float (&y)[8][4], bf16* dst, size_t row0, int col_off, int cq) {
    LAS float* part = (LAS float*)F.lds;
    float ss[8];
#pragma unroll
    for (int k = 0; k < 8; ++k) ss[k] = wave_sum((y[k][0] * y[k][0] + y[k][1] * y[k][1]) + (y[k][2] * y[k][2] + y[k][3] * y[k][3]));
    if (F.lane == 0) { *(LAS f32x4*)(part + F.wave * 8) = (f32x4){ss[0], ss[1], ss[2], ss[3]}; *(LAS f32x4*)(part + F.wave * 8 + 4) = (f32x4){ss[4], ss[5], ss[6], ss[7]}; }
    __syncthreads();
    const f32x4 pa = *(LAS f32x4*)(part + (F.wave ^ 1) * 8), pb = *(LAS f32x4*)(part + (F.wave ^ 1) * 8 + 4);
    const float po[8] = {pa.x, pa.y, pa.z, pa.w, pb.x, pb.y, pb.z, pb.w};
#pragma unroll
    for (int k = 0; k < 8; ++k) { const float rstd = 1.0f / sqrtf((ss[k] + po[k]) * (1.f / 512.f) + EPS);
        v2u o; o.x = pk2(y[k][0] * rstd, y[k][1] * rstd); o.y = pk2(y[k][2] * rstd, y[k][3] * rstd);
        *(v2u*)(dst + (row0 + k) * DM + col_off + 4 * cq) = o; }
    __syncthreads();
}
__device__ __forceinline__ void hyprep_item(Frame& F, const bf16* __restrict__ PROJ, const float* __restrict__ cw, const float* __restrict__ cb, bf16* ZT, bf16* X0, int b, int tile) {
    const int tb = F.tid >> 7, cq = F.tid & 127, c0 = 4 * cq, tw = tile * 32 + tb * 8; const size_t rb = (size_t)b * SEQ;
    float z[8][4];
    v2u rh[3][10];
#pragma unroll
    for (int j = 0; j < 3; ++j)
#pragma unroll
        for (int o = 0; o < 10; ++o) { const int t = tw - 1 + o; const int tc = ((t >= 0) && (t < SEQ)) ? t : tw; rh[j][o] = *(const v2u*)(PROJ + (rb + tc) * DINP + O_HY + 512 * j + c0); }
#pragma unroll
    for (int jj = 0; jj < 3; ++jj) { const int j = (jj == 0) ? 1 : (jj == 1) ? 2 : 0; const int cc = 512 * j + c0;
        const f32x4 w0 = *(const f32x4*)(cw + cc), w1 = *(const f32x4*)(cw + 1536 + cc), w2 = *(const f32x4*)(cw + 3072 + cc), bs = *(const f32x4*)(cb + cc);
        float x[10][4];
#pragma unroll
        for (int o = 0; o < 10; ++o) { const int t = tw - 1 + o; const bool ok = (t >= 0) && (t < SEQ); unpack4(rh[j][o], x[o]);
            if (!ok) { x[o][0] = 0.f; x[o][1] = 0.f; x[o][2] = 0.f; x[o][3] = 0.f; } }
        if (jj == 0) {
#pragma unroll
            for (int k = 0; k < 8; ++k)
#pragma unroll
                for (int i = 0; i < 4; ++i) z[k][i] = w0[i] * x[k][i] + w1[i] * x[k + 1][i] + w2[i] * x[k + 2][i] + bs[i];
        } else if (jj == 1) {
#pragma unroll
            for (int k = 0; k < 8; ++k)
#pragma unroll
                for (int i = 0; i < 4; ++i) z[k][i] *= w0[i] * x[k][i] + w1[i] * x[k + 1][i] + w2[i] * x[k + 2][i] + bs[i];
#pragma unroll
            for (int i = 0; i < 4; ++i) { v4u o; o.x = pk2(z[0][i], z[1][i]); o.y = pk2(z[2][i], z[3][i]); o.z = pk2(z[4][i], z[5][i]); o.w = pk2(z[6][i], z[7][i]);
                *(v4u*)(ZT + ((size_t)(c0 + i) * NSEQ + b) * SEQ + tw) = o; }
        } else {
#pragma unroll
            for (int k = 0; k < 8; ++k) { float u0[4];
#pragma unroll
                for (int i = 0; i < 4; ++i) u0[i] = w0[i] * x[k][i] + w1[i] * x[k + 1][i] + w2[i] * x[k + 2][i] + bs[i];
                v2u o; o.x = pk2(u0[0], u0[1]); o.y = pk2(u0[2], u0[3]); *(v2u*)(X0 + (rb + tw + k) * HYC + c0) = o; }
        }
    }
}
__device__ __forceinline__ void pool_item(Frame& F, const bf16* __restrict__ PROJ, bf16* MIXED, int b, int tile) {
    const int tb = F.tid >> 7, cq = F.tid & 127, c0 = 4 * cq, g = cq >> 5, half = 1 << g, tw = tile * 32 + tb * 8; const size_t rb = (size_t)b * SEQ;
    float x[23][4];
#pragma unroll
    for (int o = 0; o < 23; ++o) { const int t = tw - 8 + o; const bool ok = (t >= 0) && (t < SEQ); const int tc = ok ? t : tw;
        const v2u w = *(const v2u*)(PROJ + (rb + tc) * DINP + c0); unpack4(w, x[o]);
        if (!ok) { x[o][0] = 0.f; x[o][1] = 0.f; x[o][2] = 0.f; x[o][3] = 0.f; } }
    float y[8][4];
#pragma unroll
    for (int k = 0; k < 8; ++k) { const int oc = 8 + k, t = tw + k; const int lo = (t - half > 0) ? t - half : 0, hi = (t + half < SEQ) ? t + half : SEQ; const float inv = 1.0f / (float)(hi - lo);
#pragma unroll
        for (int i = 0; i < 4; ++i) {
            const float w1 = x[oc - 1][i] + x[oc][i];
            const float w2 = w1 + (x[oc - 2][i] + x[oc + 1][i]);
            const float w4 = w2 + ((x[oc - 4][i] + x[oc - 3][i]) + (x[oc + 2][i] + x[oc + 3][i]));
            const float w8 = w4 + (((x[oc - 8][i] + x[oc - 7][i]) + (x[oc - 6][i] + x[oc - 5][i])) + ((x[oc + 4][i] + x[oc + 5][i]) + (x[oc + 6][i] + x[oc + 7][i])));
            const float S = (g == 0) ? w1 : (g == 1) ? w2 : (g == 2) ? w4 : w8;
            y[k][i] = S * inv - x[oc][i]; } }
    pair_norm_store(F, y, MIXED, rb + tw, 0, cq);
}
__device__ __forceinline__ void hyfin_item(Frame& F, const bf16* __restrict__ YC, const bf16* __restrict__ X0, bf16* MIXED, int b, int tile) {
    const int tb = F.tid >> 7, cq = F.tid & 127, c0 = 4 * cq, tw = tile * 32 + tb * 8; const size_t rb = (size_t)b * SEQ;
    float yc[4][8], y[8][4];
#pragma unroll
    for (int i = 0; i < 4; ++i) { const v4u v = *(const v4u*)(YC + ((size_t)(c0 + i) * NSEQ + b) * SEQ + tw);
        yc[i][0] = bflo(v.x); yc[i][1] = bfhi(v.x); yc[i][2] = bflo(v.y); yc[i][3] = bfhi(v.y); yc[i][4] = bflo(v.z); yc[i][5] = bfhi(v.z); yc[i][6] = bflo(v.w); yc[i][7] = bfhi(v.w); }
#pragma unroll
    for (int k = 0; k < 8; ++k) { float xv[4]; unpack4(*(const v2u*)(X0 + (rb + tw + k) * HYC + c0), xv);
#pragma unroll
        for (int i = 0; i < 4; ++i) y[k][i] = yc[i][k] * xv[i]; }
    pair_norm_store(F, y, MIXED, rb + tw, 1536, cq);
}
struct PrepGains { float q[3][8], k[3][8]; };
__device__ __forceinline__ void load8(const float* p, float (&o)[8]) { const f32x4 a = *(const f32x4*)p, b = *(const f32x4*)(p + 4); o[0] = a.x; o[1] = a.y; o[2] = a.z; o[3] = a.w; o[4] = b.x; o[5] = b.y; o[6] = b.z; o[7] = b.w; }
__device__ __forceinline__ void unpack8(const v4u w, float (&x)[8]) { x[0] = bflo(w.x); x[1] = bfhi(w.x); x[2] = bflo(w.y); x[3] = bfhi(w.y); x[4] = bflo(w.z); x[5] = bfhi(w.z); x[6] = bflo(w.w); x[7] = bfhi(w.w); }
__device__ __forceinline__ v4u pack8(const float (&x)[8]) { v4u o; o.x = pk2(x[0], x[1]); o.y = pk2(x[2], x[3]); o.z = pk2(x[4], x[5]); o.w = pk2(x[6], x[7]); return o; }
__device__ __forceinline__ float ssq8(const float (&x)[8]) { return ((x[0] * x[0] + x[1] * x[1]) + (x[2] * x[2] + x[3] * x[3])) + ((x[4] * x[4] + x[5] * x[5]) + (x[6] * x[6] + x[7] * x[7])); }
__device__ __forceinline__ float sum8lanes(float v) { v += __shfl_xor(v, 1); v += __shfl_xor(v, 2); v += __shfl_xor(v, 4); return v; }
__device__ __forceinline__ void prep_row(const bf16* __restrict__ PROJ, bf16* Q, bf16* KV, const PrepGains& G, const float* __restrict__ ROPE, int m, int lane) {
    const int h = lane >> 3, sub = lane & 7;
    const bf16* pr = PROJ + (size_t)m * DINP; bf16* qr = Q + (size_t)m * NQ + 192 * h + 8 * sub; bf16* kr = KV + (size_t)m * NKVP + KVHS * h + 8 * sub;
    const v4u pev = *(const v4u*)(pr + O_KPE + 8 * sub);
    const v4u k0 = *(const v4u*)(kr), k1 = *(const v4u*)(kr + 64);
    float cs[8], sn[8]; { const float* rp = ROPE + (size_t)(m & (SEQ - 1)) * 64 + 8 * (sub & 3); load8(rp, cs); load8(rp + 32, sn); }
    const float sg = (sub < 4) ? -1.f : 1.f;
    { float a0[8], a1[8], pe[8]; unpack8(k0, a0); unpack8(k1, a1); unpack8(pev, pe);
      const float ss = sum8lanes((ssq8(a0) + ssq8(a1)) + ssq8(pe));
      const float sk = 1.0f / sqrtf(ss * (1.f / 192.f) + EPS);
      float r[8], o[8];
#pragma unroll
      for (int i = 0; i < 8; ++i) { a0[i] *= sk * G.k[0][i]; a1[i] *= sk * G.k[1][i]; r[i] = pe[i] * sk * G.k[2][i]; }
#pragma unroll
      for (int i = 0; i < 8; ++i) { const float rp = __shfl_xor(r[i], 4); o[i] = r[i] * cs[i] + sg * rp * sn[i]; }
      *(v4u*)(kr) = pack8(a0); *(v4u*)(kr + 64) = pack8(a1); *(v4u*)(kr + 128) = pack8(o); }
}
__device__ __forceinline__ void attn_norm_row(bf16* MIXED, int m, int lane) {
    v4u* p = (v4u*)(MIXED + (size_t)m * DM + 512 + 16 * lane); v4u a = p[0], b = p[1];
    unsigned w[8] = {a.x, a.y, a.z, a.w, b.x, b.y, b.z, b.w}; float s = 0.f;
#pragma unroll
    for (int i = 0; i < 8; ++i) { const float x = bflo(w[i]), y = bfhi(w[i]); s += x * x + y * y; }
    const float rstd = 1.0f / sqrtf(wave_sum(s) * (1.f / 1024.f) + EPS);
#pragma unroll
    for (int i = 0; i < 8; ++i) w[i] = pk2(bflo(w[i]) * rstd, bfhi(w[i]) * rstd);
    a.x = w[0]; a.y = w[1]; a.z = w[2]; a.w = w[3]; b.x = w[4]; b.y = w[5]; b.z = w[6]; b.w = w[7]; p[0] = a; p[1] = b;
}

#define DEFPTRS() unsigned char* ws = args.ws + (size_t)(unsigned)opq_s(0); \
    bf16* BtIn = (bf16*)(ws + WS_BTIN); bf16* BtUq = (bf16*)(ws + WS_BTUQ); bf16* BtKv = (bf16*)(ws + WS_BTKV); bf16* BtOut = (bf16*)(ws + WS_BTOUT); bf16* BtUp = (bf16*)(ws + WS_BTUP); bf16* BtDn = (bf16*)(ws + WS_BTDN); \
    bf16* RF = (bf16*)(ws + WS_RF); bf16* Hb = (bf16*)(ws + WS_H); bf16* PROJ = (bf16*)(ws + WS_PROJ); bf16* Qb = (bf16*)(ws + WS_Q); bf16* KVb = (bf16*)(ws + WS_KV); \
    bf16* ZT = (bf16*)(ws + WS_ZT); bf16* X0 = (bf16*)(ws + WS_X0); bf16* YC = (bf16*)(ws + WS_YC); float* EDGE = (float*)(ws + WS_EDGE); float* ROPE = (float*)(ws + WS_ROPE); float* SSQP = (float*)(ws + WS_SSQP); float* RSTD = (float*)(ws + WS_RSTD); bf16* XB2 = (bf16*)(ws + WS_XB2); unsigned char* XQ = (unsigned char*)(ws + WS_XQ); float* SSQCQ = (float*)(ws + WS_SSQCQ); unsigned char* BtInQ = (unsigned char*)(ws + WS_BTINQ); float* CSIN = (float*)(ws + WS_CSIN); float* RSTDQ = (float*)(ws + WS_RSTDQ); unsigned char* BtUpQ = (unsigned char*)(ws + WS_BTUP); bf16* ACT = (bf16*)(ws + WS_ACT); \
    bf16* XA = (bf16*)args.out; \
    (void)BtIn; (void)BtUq; (void)BtKv; (void)BtOut; (void)BtUp; (void)BtDn; (void)RF; (void)Hb; (void)PROJ; (void)Qb; (void)KVb; (void)ZT; (void)X0; (void)YC; (void)EDGE; (void)ROPE; (void)SSQP; (void)RSTD; (void)XB2; (void)XQ; (void)SSQCQ; (void)BtInQ; (void)CSIN; (void)RSTDQ; (void)BtUpQ; (void)ACT; (void)XA
__global__ void __launch_bounds__(NWAVES * 64, 2) fwd(Args args) {
    extern __shared__ __attribute__((aligned(16))) unsigned char lds_raw[];
    Frame F;
    F.lds = (LAS unsigned char*)lds_raw;
    F.tid = threadIdx.x; F.lane = F.tid & 63; F.wave = __builtin_amdgcn_readfirstlane(F.tid >> 6);
    F.G = gridDim.x; { const int bx = blockIdx.x; F.vcu = (F.G % 8 == 0) ? (bx % 8) * (F.G / 8) + bx / 8 : bx; F.bx = bx; } F.G0 = F.G; F.vcu0 = F.vcu; F.bx0 = F.bx;
    volatile LAS unsigned* MISC = (volatile LAS unsigned*)(F.lds + MISC_OFF);
    if (F.tid < 64) MISC[F.tid] = 0u;
    __syncthreads();
    unsigned* ctl = (unsigned*)(args.ws + WS_CTL);
    const int lo = args.ph_lo, hi = args.ph_hi;
    XcdBarrier bar; bar.bar = ctl + CW_BAR; bar.x = 0; bar.st = MISC + 8;
    if (hi - lo > 1) bar = xcd_barrier_post(ctl + CW_BAR, MISC + 8);
    float* out = args.out;

#pragma unroll 1
    for (int layer = 0; layer < DEPTH; ++layer) {
        const int pb = layer * NPH;
        if (pb + NPH <= lo || pb >= hi) continue;
#define IN(k) (lo <= pb + (k) && pb + (k) < hi)
#define ENTER() DEFPTRS(); F.G = opq_s(F.G0); F.vcu = opq_s(F.vcu0); F.bx = opq_s(F.bx0); F.tid = opq(threadIdx.x); F.lane = F.tid & 63; F.wave = __builtin_amdgcn_readfirstlane(F.tid >> 6); const int gw = F.vcu * NWAVES + F.wave, NGW = F.G * NWAVES, wg = F.vcu; const size_t gtid = (size_t)wg * 512 + F.tid, gthreads = (size_t)F.G * 512; (void)gw; (void)NGW; (void)wg; (void)gtid; (void)gthreads
#define SEAM(k) do { if (pb + (k) + 1 < hi) xcd_barrier(bar); } while (0)

        if (IN(0)) { ENTER();
            const float* win = args.in[I_WIN] + (size_t)layer * DM * DIN; const float* g1 = args.in[I_ANG] + layer * DM;
            for (int it = wg; it < 256; it += F.G) {
                if (it < 128) poolfold_item(F, win, args.in[I_PW] + (size_t)layer * 4 * 128 * 128, args.in[I_PS] + (size_t)layer * 512, g1, BtIn, it >> 5, it & 31);
                else filter_item(F, args.in[I_FW1] + (size_t)layer * 17 * 64, args.in[I_FB1] + layer * 64, args.in[I_FFR] + layer * 64, args.in[I_FW2] + (size_t)layer * 64 * 64, args.in[I_FB2] + layer * 64,
                                 args.in[I_FW3] + (size_t)layer * 64 * 1024, args.in[I_FB3] + layer * 1024, args.in[I_HBIAS] + layer * 512, RF, it - 128);
            }
            constexpr int T_IN = 19 * 16, T_UQ = 12 * 4, T_KV = 16 * 2, T_OUT = 16 * 16, T_UP = 88 * 16, T_DN = 16 * 44, T_ALL = T_IN + T_UQ + T_KV + T_OUT + T_UP + T_DN;
            for (int it = wg; it < T_ALL; it += F.G) {
                int r = it; CvtTile d;
                if (r < T_IN) { const int nt = r >> 4, kt = r & 15, n0 = 512 + 128 * nt; d = CvtTile{win, g1, BtIn, DIN, DM, n0, 128 * kt, DIN, {n0, n0 + 32, n0 + 64, n0 + 96}}; }
                else if ((r -= T_IN) < T_UQ) { const int nt = r >> 2, kt = r & 3, n0 = 128 * nt; d = CvtTile{args.in[I_WUQ] + (size_t)layer * 512 * NQ, args.in[I_QNG] + layer * 512, BtUq, NQ, 512, n0, 128 * kt, NQ, {n0, n0 + 32, n0 + 64, n0 + 96}}; }
                else if ((r -= T_UQ) < T_KV) { const int nt = r >> 1, kt = r & 1, n0 = 128 * nt;
                    d = CvtTile{args.in[I_WUKV] + (size_t)layer * 256 * 2048, args.in[I_KVNG] + layer * 256, BtKv, 2048, 256, n0, 128 * kt, 2048, {n0, n0 + 32, n0 + 64, n0 + 96}}; }
                else if ((r -= T_KV) < T_OUT) { const int nt = r >> 4, kt = r & 15, n0 = 128 * nt; d = CvtTile{args.in[I_WOUT] + (size_t)layer * DM * DM, args.in[I_GNG] + layer * DM, BtOut, DM, DM, n0, 128 * kt, DM, {n0, n0 + 32, n0 + 64, n0 + 96}}; }
                else if ((r -= T_OUT) < T_UP) { const int nt = r >> 4, kt = r & 15;
                    absmax_tile(F, args.in[I_WUP] + (size_t)layer * DM * NUP, args.in[I_FNG] + layer * DM, NUP, 128 * nt, 128 * kt, ctl + CW_WMAXC + layer * NUP); continue; }
                else { r -= T_UP; const int nt = r / 44, kt = r % 44, n0 = 128 * nt; d = CvtTile{args.in[I_WDN] + (size_t)layer * DFF * DM, nullptr, BtDn, DM, DFF, n0, 128 * kt, DM, {n0, n0 + 32, n0 + 64, n0 + 96}}; }
                cvt_tile(F, d);
            }
            { unsigned zz = 0u; asm volatile("" : "+v"(zz)); v4u z = {zz, zz, zz, zz};
              for (size_t i = gtid; i < (size_t)(DINP - DIN) * DM / 8; i += gthreads) *(v4u*)(BtIn + (size_t)DIN * DM + i * 8) = z;
}
            if (layer == 0) for (size_t i = gtid; i < (size_t)SEQ * 32; i += gthreads) { const int pos = (int)(i >> 5), ri = (int)(i & 31);
                const float freq = exp2f(-(float)ri * (13.287712379549449f / 32.0f)); float sn, cs; sincosf((float)pos * freq, &sn, &cs); ROPE[pos * 64 + ri] = cs; ROPE[pos * 64 + 32 + ri] = sn; }
            if (layer == 0) { for (int m = gw; m < M; m += NGW) xb_row(m < MP ? args.in[I_XP] + (size_t)m * DM : args.in[I_XS] + (size_t)(m - MP) * DM, XA + (size_t)m * DM, RSTD + m, XQ + (size_t)m * DM, RSTDQ + m, F.lane); }
            else rstd_from_partials(SSQP, RSTD, gtid, gthreads);
            xcd_barrier(bar);
            for (int r = gw; r < NINQ; r += NGW) q8_row(BtIn + (size_t)(r < 512 ? r : r + 1024) * DM, BtInQ + (size_t)r * DM, 1.0f, CSIN + r, F.lane);
            if (layer > 0) for (int m = gw; m < M; m += NGW) q8_row(XA + (size_t)m * DM, XQ + (size_t)m * DM, RSTD[m], RSTDQ + m, F.lane);
            SEAM(0);
        }
        if (IN(1)) { ENTER();
            { pg8::Gemm g{(const bf16*)XQ, (const bf16*)BtInQ, M, NINQ, DM / 2, DM / 2}; pg8::StaticOrder S; S.init(M, NINQ, F.G, F.bx);
              pg8::EpiBf16 E{PROJ, DINP, RSTDQ, 0, -1, nullptr, 0.f, nullptr, 0, CSIN, 2, 4};
              pg8::gemm_phase<pg8::EpiBf16, pg8::StaticOrder, true>(F.lds, g, S, E); }
            { pg8::Gemm g{XA, BtIn + (size_t)512 * DM, M, 1024, DM, DM}; pg8::StaticOrder S; S.init(M, 1024, F.G, F.bx);
              pg8::EpiBf16 E{PROJ + 512, DINP, RSTD, 0, O_CKV / 256 - 2, (LAS float*)(F.lds + HALO_OFF), EPS, SSQCQ, O_CQ / 256 - 2, nullptr, 1 << 30, 0};
              pg8::gemm_phase<pg8::EpiBf16, pg8::StaticOrder>(F.lds, g, S, E); }
            SEAM(1);
        }
        if (IN(2)) { ENTER();
            { pg8::Gemm g{PROJ + O_CQ, BtUq, M, NQ, 512, DINP}; pg8::StaticOrder S; S.init(M, NQ, F.G, F.bx); pg8::EpiBf16 E{Qb, NQ, nullptr, 0, -1, nullptr, 0.f, nullptr, 0, nullptr, 1 << 30, 0};
              pg8::gemm_phase<pg8::EpiBf16, pg8::StaticOrder>(F.lds, g, S, E); }
            { pg8::Gemm g{PROJ + O_CKV, BtKv, M, 2048, 256, DINP}; pg8::StaticOrder S; S.init(M, 2048, F.G, F.bx); pg8::EpiBf16 E{KVb, NKVP, nullptr, 1, -1, nullptr, 0.f, nullptr, 0, nullptr, 1 << 30, 0};
              pg8::gemm_phase<pg8::EpiBf16, pg8::StaticOrder>(F.lds, g, S, E); }
            const float* hcw = args.in[I_HCW] + (size_t)layer * 3 * 1536; const float* hcb = args.in[I_HCB] + layer * 1536;
            for (int it = wg; it < 2 * NSEQ * 64; it += F.G) {
                if (it < NSEQ * 64) hyprep_item(F, PROJ, hcw, hcb, ZT, X0, it >> 6, it & 63);
                else pool_item(F, PROJ, Hb, (it - NSEQ * 64) >> 6, it & 63);
            }
            SEAM(2);
        }
        if (IN(3)) { ENTER();
            const int odd = __builtin_amdgcn_readfirstlane(opq((F.bx >> 3) & 1));
            const float* qhg = args.in[I_QHG] + layer * 192; const float* khg = args.in[I_KHG] + layer * 192;
            if (!odd) { for (int u = wg; u < 2 * HYC; u += F.G) hy::conv_unit(F.lds, ZT, RF, YC, u >> 1, u & 1); }
            { PrepGains PG; { const int sub = F.lane & 7;
#pragma unroll
                for (int i = 0; i < 3; ++i) { load8(qhg + 64 * i + 8 * sub, PG.q[i]); load8(khg + 64 * i + 8 * sub, PG.k[i]); } }
              for (int m = gw; m < M; m += NGW) prep_row(PROJ, Qb, KVb, PG, ROPE, m, F.lane); }
            if (odd) { __syncthreads(); for (int u = wg; u < 2 * HYC; u += F.G) hy::conv_unit(F.lds, ZT, RF, YC, u >> 1, u & 1); }
            SEAM(3);
        }
        if (IN(4)) { ENTER();
            float gqm, gkm; { const float* qhg = args.in[I_QHG] + layer * 192; const float* khg = args.in[I_KHG] + layer * 192;
                gqm = fmaxf(fmaxf(fabsf(qhg[F.lane]), fabsf(qhg[64 + F.lane])), fabsf(qhg[128 + F.lane])); gkm = fmaxf(fmaxf(fabsf(khg[F.lane]), fabsf(khg[64 + F.lane])), fabsf(khg[128 + F.lane]));
#pragma unroll
                for (int o = 1; o < 64; o <<= 1) { gqm = fmaxf(gqm, __shfl_xor(gqm, o)); gkm = fmaxf(gkm, __shfl_xor(gkm, o)); } }
            const float Mnat = 13.856406460551018f * gqm * gkm;
            const bool sm_fast = __builtin_amdgcn_readfirstlane((Mnat <= 40.0f) ? 1 : 0) != 0;
            const float negMC = __builtin_bit_cast(float, __builtin_amdgcn_readfirstlane(__builtin_bit_cast(int, -Mnat * 1.4426950408889634f)));
            for (int i = 0; i * F.G < NSEQ * NH * 8; ++i) {
                int p, qb; const int c = F.bx;
                if (F.G == 256) { p = i * 32 + (c & 7) * 4 + (c >> 6); qb = (c >> 3) & 7; } else { const int Lq = i * F.G + c; p = Lq >> 3; qb = Lq & 7; }
                if (p < NSEQ * NH) { const int b = p >> 3, h = p & 7;
                    const bf16* qp = Qb + (size_t)(b * SEQ + qb * 256) * NQ + h * 192; const bf16* kp = KVb + (size_t)(b * SEQ) * NKVP + h * KVHS; bf16* op = Hb + (size_t)(b * SEQ + qb * 256) * DM + 512 + h * 128;
                    const float* sq = SSQCQ + (size_t)(b * SEQ + qb * 256) * 8; const float* qgp = args.in[I_QHG] + layer * 192; const float* rp0 = ROPE + (size_t)(qb * 256) * 64;
                    if (sm_fast) at::attn_unit<true>(negMC, qp, kp, kp + 192, op, SEQ, (char*)lds_raw, sq, qgp, rp0);
                    else at::attn_unit<false>(0.f, qp, kp, kp + 192, op, SEQ, (char*)lds_raw, sq, qgp, rp0); }
            }
            for (int it = wg; it < NSEQ * 64; it += F.G) hyfin_item(F, YC, X0, Hb, it >> 6, it & 63);
            SEAM(4);
        }
        if (IN(5)) { ENTER();
            for (int m = gw; m < M; m += NGW) attn_norm_row(Hb, m, F.lane);
            SEAM(5);
        }
        if (IN(6)) { ENTER();
            pg8::Gemm g{Hb, BtOut, M, DM, DM, DM}; pg8::StaticOrder S; S.init(M, DM, F.G, F.bx);
            pg8::EpiResid16 E{XA, XB2, out, DM, SSQP, 0};
            pg8::gemm_phase<pg8::EpiResid16, pg8::StaticOrder>(F.lds, g, S, E);
            SEAM(6);
        }
        if (IN(7)) { ENTER();
            const unsigned* wmaxc = ctl + CW_WMAXC + layer * NUP;
            const int p7odd = __builtin_amdgcn_readfirstlane(opq((F.bx >> 3) & 1));
            if (p7odd) { for (int m = gw; m < M; m += NGW) xq_row(XB2 + (size_t)m * DM, XQ + (size_t)m * DM, SSQP + (size_t)m * 32, RSTD + m, 1.0f, F.lane); __syncthreads(); }
            for (int it = wg; it < 88 * 16; it += F.G) { const int nt = it >> 4, kt = it & 15; const int nv = (nt < 44) ? nt : nt - 44;
                cvtq_tile(F, args.in[I_WUP] + (size_t)layer * DM * NUP, args.in[I_FNG] + layer * DM, NUP, DM, BtUpQ, 128 * nt, 128 * kt, 256 * nv + ((nt < 44) ? 0 : 32), wmaxc); }
            if (!p7odd) { for (int m = gw; m < M; m += NGW) xq_row(XB2 + (size_t)m * DM, XQ + (size_t)m * DM, SSQP + (size_t)m * 32, RSTD + m, 1.0f, F.lane); }
            SEAM(7);
        }
        if (IN(8)) { ENTER();
            pg8::Gemm g{(const bf16*)XQ, (const bf16*)BtUpQ, M, NUP, DM / 2, DM / 2}; pg8::StaticOrder S; S.init(M, NUP, F.G, F.bx);
            pg8::EpiGate E{ACT, DFF, EDGE, args.in[I_FCW] + (size_t)layer * 3 * DFF, args.in[I_FCB] + layer * DFF, DFF, (LAS float*)(F.lds + HALO_OFF), RSTD, ctl + CW_WMAXC + layer * NUP};
            pg8::gemm_phase<pg8::EpiGate, pg8::StaticOrder, true>(F.lds, g, S, E);
            SEAM(8);
        }
        if (IN(9)) { ENTER();
            const float* fcw = args.in[I_FCW] + (size_t)layer * 3 * DFF;
            for (unsigned i = (unsigned)gtid; i < (unsigned)((M / 256) * 2 * (DFF / 4)); i += (unsigned)gthreads) {
                const unsigned ri = i / (unsigned)(DFF / 4), c4 = (i % (unsigned)(DFF / 4)) * 4u, pm = ri >> 1, e = ri & 1u;
                const float* eb = EDGE + (ri * 3u) * (unsigned)DFF + c4;
                f32x4 pre = *(const f32x4*)(eb + DFF); const f32x4 v = *(const f32x4*)(eb + 2 * DFF);
                if (e == 0u && (pm & 7u) != 0u) { const f32x4 gp = *(const f32x4*)(EDGE + (((pm - 1u) * 2u + 1u) * 3u) * (unsigned)DFF + c4); pre += *(const f32x4*)(fcw + c4) * gp; }
                if (e == 1u && (pm & 7u) != 7u) { const f32x4 gn = *(const f32x4*)(EDGE + (((pm + 1u) * 2u + 0u) * 3u) * (unsigned)DFF + c4); pre += *(const f32x4*)(fcw + 2 * DFF + c4) * gn; }
                v2u o; o.x = pk2(pg8::silu_f(pre.x) * v.x, pg8::silu_f(pre.y) * v.y); o.y = pk2(pg8::silu_f(pre.z) * v.z, pg8::silu_f(pre.w) * v.w);
                { const unsigned row = pm * 256u + (e ? 255u : 0u);
                  *(v2u*)(ACT + ((size_t)(row >> 1) * (DFF / 32) + (c4 >> 5)) * 64 + (row & 1u) * 32u + (c4 & 31u)) = o; }
            }
            SEAM(9);
        }
        if (IN(10)) { ENTER();
            pg8::Gemm g{ACT, BtDn, M, DM, DFF, DFF, 1}; pg8::StaticOrder S; S.init(M, DM, F.G, F.bx);
            pg8::EpiResid16 E{XB2, XA, out, DM, SSQP, (layer + 1 < DEPTH) ? 0 : 1};
            pg8::gemm_phase<pg8::EpiResid16, pg8::StaticOrder>(F.lds, g, S, E);
            SEAM(10);
        }
#undef IN
#undef ENTER
#undef SEAM
    }
}

extern "C" void kernel_launch(void* const* d_in, const int* in_sizes, int n_in, void* d_out, int out_size, void* d_ws, size_t ws_size, hipStream_t stream) {
    static int grid = 0;
    if (grid == 0) {
        if (n_in != N_IN || out_size != M * DM || ws_size < WS_END) { fprintf(stderr, "kernel_launch: unexpected shapes (n_in %d, out %d, ws %zu, need %zu)\n", n_in, out_size, ws_size, (size_t)WS_END); grid = -1; return; }
        int dev = 0, cus = 0;
        if (hipGetDevice(&dev) != hipSuccess || hipDeviceGetAttribute(&cus, hipDeviceAttributeMultiprocessorCount, dev) != hipSuccess) { grid = -1; return; }
        if (hipFuncSetAttribute((const void*)fwd, hipFuncAttributeMaxDynamicSharedMemorySize, LDS_BYTES) != hipSuccess) { fprintf(stderr, "kernel_launch: hipFuncSetAttribute failed\n"); grid = -1; return; }
        int per_cu = 0;
        if (hipOccupancyMaxActiveBlocksPerMultiprocessor(&per_cu, (const void*)fwd, NWAVES * 64, LDS_BYTES) != hipSuccess || per_cu < 1) fprintf(stderr, "kernel_launch: occupancy query reports %d\n", per_cu);
        (void)hipGetLastError();
        grid = cus;
    }
    if (grid < 0) return;
    (void)hipMemsetAsync((char*)d_ws + WS_CTL, 0, CTL_BYTES, stream);
    Args a{};
    for (int i = 0; i < N_IN; ++i) a.in[i] = (const float*)d_in[i];
    a.out = (float*)d_out; a.ws = (unsigned char*)d_ws;
#if MK_ONE_LAUNCH
    a.ph_lo = 0; a.ph_hi = DEPTH * NPH;
    hipLaunchKernelGGL(fwd, dim3(grid), dim3(NWAVES * 64), LDS_BYTES, stream, a);
#else
    for (int p = 0; p < DEPTH * NPH; ++p) { a.ph_lo = p; a.ph_hi = p + 1; hipLaunchKernelGGL(fwd, dim3(grid), dim3(NWAVES * 64), LDS_BYTES, stream, a); }
#endif
    const hipError_t le = hipPeekAtLastError();
    if (le != hipSuccess) fprintf(stderr, "kernel_launch: launch failed: %s\n", hipGetErrorName(le));
}
```
